# Optimizing an MI355X kernel written in HIP

```python
import math
import jax
import jax.numpy as jnp
from jax import lax
import numpy as np

D_MODEL = 1024
BATCH = 2
SEQ = 8192
DEPTH = 2

GRID_W = 64
CTX_LEN = 256
N_BRANCH = 4
BRANCH_W = 256
ROPE_DIM = 32
ROPE_BASE = 10000.0
Q_BLOCK = 128
NORM_EPS = 1e-6

MLA_HEADS = 4
MLA_NOPE = 64
MLA_ROPE = ROPE_DIM
MLA_V = 64
MLA_Q_LORA = 256
MLA_KV_LORA = 128

RW_HEADS = 4
RW_HEAD = 64
RW_W_LORA = 64
RW_A_LORA = 64
RW_G_LORA = 128
RW_LN_EPS = 64e-5

S5_GROUPS = 16
S5_GROUP_CH = 16
S5_STATE = 64

DIFF_HEADS = 4
DIFF_HD = ROPE_DIM
DIFF_EPS = 1e-5

MOE_GROUPS = 4
MOE_PER_GROUP = 8
MOE_EXPERTS = MOE_GROUPS * MOE_PER_GROUP
MOE_TOPK = 2
D_EXPERT = 512
MOE_BLOCK = 128

MLA_IN = MLA_Q_LORA + MLA_KV_LORA + MLA_ROPE
RW_IN = 3 * RW_HEADS * RW_HEAD + RW_W_LORA + RW_A_LORA + RW_G_LORA
S5_IN = S5_GROUPS * S5_GROUP_CH
DIFF_IN = 3 * DIFF_HEADS * 2 * DIFF_HD
GATE_IN = N_BRANCH * D_MODEL
IN_SPLITS = [MLA_IN, MLA_IN + RW_IN, MLA_IN + RW_IN + S5_IN, MLA_IN + RW_IN + S5_IN + DIFF_IN]
N_IN = MLA_IN + RW_IN + S5_IN + DIFF_IN + GATE_IN

kernel_name = 'hybrid_gated_mixers_hmoe_dit'


def rmsnorm(x, g, eps=NORM_EPS):
    x32 = x.astype(jnp.float32)
    y = x32 * lax.rsqrt(jnp.mean(x32 * x32, axis=-1, keepdims=True) + eps)
    return (y * g.astype(jnp.float32)).astype(x.dtype)


def axial_rope_tables(n_lat, dim):
    rows = n_lat // GRID_W
    row = jnp.repeat(jnp.arange(rows, dtype=jnp.float32), GRID_W)
    col = (jnp.arange(rows * GRID_W) % GRID_W).astype(jnp.float32)
    nf = dim // 4
    inv = ROPE_BASE ** (-jnp.arange(nf, dtype=jnp.float32) / nf)
    ar = row[:, None] * inv
    ac = col[:, None] * inv
    ang = jnp.concatenate([ar, ar, ac, ac], axis=-1)
    return jnp.cos(ang), jnp.sin(ang)


def rotate_axial(x):
    s = x.shape
    x4 = x.reshape(s[:-1] + (2, 2, s[-1] // 4))
    return jnp.stack([-x4[..., 1, :], x4[..., 0, :]], axis=-2).reshape(s)


def apply_rope(x, cos, sin):
    return x * cos + rotate_axial(x) * sin


def ctx_last(t, n_ctx):
    return jnp.concatenate([t[:, n_ctx:], t[:, :n_ctx]], axis=1)


def ctx_first(t, n_ctx):
    return jnp.concatenate([t[:, -n_ctx:], t[:, :-n_ctx]], axis=1)


def sweep_query_blocks(fn, q):
    b, s = q.shape[:2]
    nb = s // Q_BLOCK
    qb = jnp.moveaxis(q.reshape((b, nb, Q_BLOCK) + q.shape[2:]), 1, 0)
    out = lax.map(fn, qb)
    return jnp.moveaxis(out, 0, 1).reshape((b, s) + out.shape[3:])


def softmax_attend(q, k, v, scale):
    s = jnp.einsum('bqhd,bkhd->bhqk', q, k).astype(jnp.float32) * scale
    p = jax.nn.softmax(s, axis=-1).astype(v.dtype)
    return jnp.einsum('bhqk,bkhd->bqhd', p, v)


def diff_attend(q, k, v, lam, scale):
    s = jnp.einsum('bqhnd,bkhnd->bhnqk', q, k).astype(jnp.float32) * scale
    p = jax.nn.softmax(s, axis=-1)
    a = (p[:, :, 0] - lam * p[:, :, 1]).astype(v.dtype)
    return jnp.einsum('bhqk,bkhd->bqhd', a, v)


def mla_branch(pc, pl, cos, sin, q_norm_g, kv_norm_g, w_uq, w_ukv, need_ctx):
    scale = (MLA_NOPE + MLA_ROPE) ** -0.5

    def project(pz, rotary):
        b, t, _ = pz.shape
        cq = pz[..., :MLA_Q_LORA]
        ckv = pz[..., MLA_Q_LORA:MLA_Q_LORA + MLA_KV_LORA]
        kr = pz[..., MLA_Q_LORA + MLA_KV_LORA:]
        q = (rmsnorm(cq, q_norm_g) @ w_uq).reshape(b, t, MLA_HEADS, MLA_NOPE + MLA_ROPE)
        kv = (rmsnorm(ckv, kv_norm_g) @ w_ukv).reshape(b, t, MLA_HEADS, MLA_NOPE + MLA_V)
        q_nope, q_rope = q[..., :MLA_NOPE], q[..., MLA_NOPE:]
        k_nope, v = kv[..., :MLA_NOPE], kv[..., MLA_NOPE:]
        if rotary:
            q_rope = apply_rope(q_rope, cos[:, None], sin[:, None])
            kr = apply_rope(kr, cos, sin)
        q = jnp.concatenate([q_nope, q_rope], axis=-1)
        k = jnp.concatenate([k_nope, jnp.broadcast_to(kr[:, :, None], (b, t, MLA_HEADS, MLA_ROPE))], axis=-1)
        return q, k, v

    qc, kc, vc = project(pc, False)
    ql, kl, vl = project(pl, True)
    k_all = jnp.concatenate([kc, kl], axis=1)
    v_all = jnp.concatenate([vc, vl], axis=1)
    yl = sweep_query_blocks(lambda qb: softmax_attend(qb, k_all, v_all, scale), ql)
    yl = yl.reshape(yl.shape[0], yl.shape[1], MLA_HEADS * MLA_V)
    yc = None
    if need_ctx:
        yc = softmax_attend(qc, kc, vc, scale)
        yc = yc.reshape(yc.shape[0], yc.shape[1], MLA_HEADS * MLA_V)
    return yc, yl


def token_shift_centred(z, mu):
    zp = jnp.pad(z, ((0, 0), (1, 1), (0, 0)))
    return z + (0.5 * (zp[:, :-2] + zp[:, 2:]) - z) * mu


def rwkv7_scan(r, decay, k, v, kk, a, reverse):
    b, t, h, n = r.shape

    def step(state, inp):
        r_t, w_t, k_t, v_t, kk_t, a_t = inp
        sa = jnp.einsum('bhvk,bhk->bhv', state, -kk_t)
        state = (state * w_t[:, :, None, :] + sa[..., None] * (kk_t * a_t)[:, :, None, :]
                 + v_t[..., None] * k_t[:, :, None, :])
        return state, jnp.einsum('bhvk,bhk->bhv', state, r_t)

    xs = tuple(jnp.moveaxis(z.astype(jnp.float32), 1, 0) for z in (r, decay, k, v, kk, a))
    _, y = lax.scan(step, jnp.zeros((b, h, n, n), jnp.float32), xs, reverse=reverse)
    return jnp.moveaxis(y, 0, 1)


def rwkv_branch(pc, pl, mu, w0, w2, a0, a2, g2, k_k, k_a, r_k, lnx_g, lnx_b, need_ctx):
    n_ctx = pc.shape[1]
    z = jnp.concatenate([token_shift_centred(pc, mu), token_shift_centred(pl, mu)], axis=1).astype(jnp.float32)
    b, t, _ = z.shape
    hw = RW_HEADS * RW_HEAD
    r, k, v = z[..., :hw], z[..., hw:2 * hw], z[..., 2 * hw:3 * hw]
    o = 3 * hw
    w_lo = z[..., o:o + RW_W_LORA]
    a_lo = z[..., o + RW_W_LORA:o + RW_W_LORA + RW_A_LORA]
    g_lo = z[..., o + RW_W_LORA + RW_A_LORA:]

    def heads(y):
        return y.reshape(b, t, RW_HEADS, RW_HEAD)

    kk = heads(k * k_k)
    kk = kk / jnp.maximum(jnp.sqrt(jnp.sum(kk * kk, axis=-1, keepdims=True)), 1e-12)
    rh, vh = heads(r), heads(v)
    ys, bonuses = [], []
    for d in range(2):
        wd = -jax.nn.softplus(-(w0[d] + jnp.tanh(w_lo) @ w2[d])) - 0.5
        decay = jnp.exp(-jnp.exp(wd))
        ad = jax.nn.sigmoid(a0[d] + a_lo @ a2[d])
        kd = heads(k * (1.0 + (ad - 1.0) * k_a))
        ins = (rh, heads(decay), kd, vh, kk, heads(ad))
        if d == 0:
            ys.append(rwkv7_scan(*ins, reverse=False))
        else:
            ys.append(ctx_first(rwkv7_scan(*[ctx_last(u, n_ctx) for u in ins], reverse=True), n_ctx))
        bonuses.append(jnp.sum(rh * kd * r_k, axis=-1, keepdims=True) * vh)
    y_sum = ys[0] + ys[1]
    mean = jnp.mean(y_sum, axis=-1, keepdims=True)
    var = jnp.mean(jnp.square(y_sum - mean), axis=-1, keepdims=True)
    y = ((y_sum - mean) * lax.rsqrt(var + RW_LN_EPS)).reshape(b, t, hw) * lnx_g + lnx_b
    y = (y + (bonuses[0] + bonuses[1]).reshape(b, t, hw)) * (jax.nn.sigmoid(g_lo) @ g2)
    yc = y[:, :n_ctx] if need_ctx else None
    return yc, y[:, n_ctx:]


def ssm_combine(e, l):
    ar1, ai1, br1, bi1 = e
    ar2, ai2, br2, bi2 = l
    return (ar2 * ar1 - ai2 * ai1, ar2 * ai1 + ai2 * ar1,
            ar2 * br1 - ai2 * bi1 + br2, ar2 * bi1 + ai2 * br1 + bi2)


def s5_branch(uc, ul, a_re, a_im, log_dt, b_re, b_im, c_re, c_im, d_skip, glu_w, glu_b, need_ctx):
    n_ctx = uc.shape[1]
    u = jnp.concatenate([uc, ul], axis=1).astype(jnp.float32)
    b, t, _ = u.shape
    u = u.reshape(b, t, S5_GROUPS, S5_GROUP_CH)
    ys = []
    for d in range(2):
        lr, li = a_re[d].astype(jnp.float32), a_im[d].astype(jnp.float32)
        dt = jnp.exp(log_dt[d].astype(jnp.float32))[:, None]
        mag = jnp.exp(lr * dt)
        ab_re, ab_im = mag * jnp.cos(li * dt), mag * jnp.sin(li * dt)
        den = lr * lr + li * li
        nr, ni = ab_re - 1.0, ab_im
        cf_re = (nr * lr + ni * li) / den
        cf_im = (ni * lr - nr * li) / den
        bre, bim = b_re[d].astype(jnp.float32), b_im[d].astype(jnp.float32)
        bb_re = cf_re[..., None] * bre - cf_im[..., None] * bim
        bb_im = cf_re[..., None] * bim + cf_im[..., None] * bre
        ud = u if d == 0 else ctx_last(u, n_ctx)
        bu_re = jnp.einsum('gpc,btgc->btgp', bb_re, ud)
        bu_im = jnp.einsum('gpc,btgc->btgp', bb_im, ud)
        elems = (jnp.broadcast_to(ab_re, bu_re.shape), jnp.broadcast_to(ab_im, bu_re.shape), bu_re, bu_im)
        _, _, x_re, x_im = lax.associative_scan(ssm_combine, elems, reverse=(d == 1), axis=1)
        yd = (jnp.einsum('gcp,btgp->btgc', c_re[d].astype(jnp.float32), x_re)
              - jnp.einsum('gcp,btgp->btgc', c_im[d].astype(jnp.float32), x_im))
        ys.append(yd if d == 0 else ctx_first(yd, n_ctx))
    y = (ys[0] + ys[1] + d_skip.astype(jnp.float32) * u).reshape(b, t, S5_GROUPS * S5_GROUP_CH)
    zg = jax.nn.gelu(y)
    out = zg * jax.nn.sigmoid(zg @ glu_w + glu_b)
    yc = out[:, :n_ctx] if need_ctx else None
    return yc, out[:, n_ctx:]


def diff_branch(pc, pl, cos, sin, lq1, lk1, lq2, lk2, subln_g, layer, need_ctx):
    nq = DIFF_HEADS * 2 * DIFF_HD

    def project(pz, rotary):
        b, t, _ = pz.shape
        q = pz[..., :nq].reshape(b, t, DIFF_HEADS, 2, DIFF_HD)
        k = pz[..., nq:2 * nq].reshape(b, t, DIFF_HEADS, 2, DIFF_HD)
        v = pz[..., 2 * nq:].reshape(b, t, DIFF_HEADS, 2 * DIFF_HD)
        if rotary:
            q = apply_rope(q, cos[:, None, None], sin[:, None, None])
            k = apply_rope(k, cos[:, None, None], sin[:, None, None])
        return q, k, v

    lam_init = 0.8 - 0.6 * math.exp(-0.3 * layer)
    lam = (jnp.exp(jnp.sum(lq1.astype(jnp.float32) * lk1.astype(jnp.float32)))
           - jnp.exp(jnp.sum(lq2.astype(jnp.float32) * lk2.astype(jnp.float32))) + lam_init)
    scale = DIFF_HD ** -0.5

    def finish(o):
        b, t = o.shape[:2]
        return (rmsnorm(o, subln_g, DIFF_EPS) * (1.0 - lam_init)).reshape(b, t, DIFF_HEADS * 2 * DIFF_HD)

    qc, kc, vc = project(pc, False)
    ql, kl, vl = project(pl, True)
    k_all = jnp.concatenate([kc, kl], axis=1)
    v_all = jnp.concatenate([vc, vl], axis=1)
    yl = finish(sweep_query_blocks(lambda qb: diff_attend(qb, k_all, v_all, lam, scale), ql))
    yc = finish(diff_attend(qc, kc, vc, lam, scale)) if need_ctx else None
    return yc, yl


def merge_branches(ys, gate_pre, w_branch, w_out):
    y = jnp.concatenate(ys, axis=-1)
    b, t, _ = y.shape
    proj = jnp.einsum('btni,nid->btnd', y.reshape(b, t, N_BRANCH, BRANCH_W), w_branch)
    gates = jax.nn.sigmoid(gate_pre.reshape(b, t, N_BRANCH, D_MODEL).astype(jnp.float32))
    return jnp.einsum('btnd,btnd->btd', gates.astype(proj.dtype), proj) @ w_out


def hier_route(x, wg, bg, we, be):
    n = x.shape[0]
    pg = jax.nn.softmax((x @ wg).astype(jnp.float32) + bg.astype(jnp.float32), axis=-1)
    pg_top, g_sel = lax.top_k(pg, 1)
    le = ((x @ we).astype(jnp.float32) + be.astype(jnp.float32)).reshape(n, MOE_GROUPS, MOE_PER_GROUP)
    le_sel = le[jnp.arange(n), g_sel[:, 0]]
    pe_top, e_sel = lax.top_k(jax.nn.softmax(le_sel, axis=-1), MOE_TOPK)
    wts = pg_top * pe_top / jnp.sum(pe_top, axis=-1, keepdims=True)
    return g_sel * MOE_PER_GROUP + e_sel, wts


def moe_dispatch(x, idx, wts, w_gate, w_up, w_down):
    n_tok, d = x.shape
    n_as = n_tok * MOE_TOPK
    flat_e = idx.reshape(n_as)
    order = jnp.argsort(flat_e)
    sorted_e = flat_e[order]
    counts = jnp.bincount(flat_e, length=MOE_EXPERTS)
    padded = (counts + MOE_BLOCK - 1) // MOE_BLOCK * MOE_BLOCK
    pad_end = jnp.cumsum(padded)
    pad_start = pad_end - padded
    start = jnp.cumsum(counts) - counts
    slot = pad_start[sorted_e] + jnp.arange(n_as, dtype=jnp.int32) - start[sorted_e]
    n_blocks = (n_as + MOE_EXPERTS * (MOE_BLOCK - 1) + MOE_BLOCK - 1) // MOE_BLOCK
    n_slots = n_blocks * MOE_BLOCK
    slot_tok = jnp.full((n_slots,), n_tok, jnp.int32).at[slot].set((order // MOE_TOPK).astype(jnp.int32))
    slot_w = jnp.zeros((n_slots,), jnp.float32).at[slot].set(wts.reshape(n_as)[order].astype(jnp.float32))
    block_e = jnp.minimum(jnp.searchsorted(pad_end, jnp.arange(n_blocks) * MOE_BLOCK, side='right'),
                          MOE_EXPERTS - 1)
    x_pad = jnp.concatenate([x, jnp.zeros((1, d), x.dtype)], axis=0)

    def run_block(args):
        tok, e = args
        xb = x_pad[tok]
        hb = jax.nn.silu(xb @ w_gate[e]) * (xb @ w_up[e])
        return hb @ w_down[e]

    yb = lax.map(run_block, (slot_tok.reshape(n_blocks, MOE_BLOCK), block_e))
    yb = yb.reshape(n_slots, d) * slot_w[:, None].astype(yb.dtype)
    y = jnp.zeros((n_tok + 1, d), yb.dtype).at[slot_tok].add(yb)
    return y[:n_tok]


def setup_inputs(seed: int = 0) -> dict:
    key = jax.random.key(seed)
    ks = iter(jax.random.split(key, 64))
    L, D = DEPTH, D_MODEL

    def nrm(shape, std):
        return jax.random.normal(next(ks), shape, jnp.float32) * std

    def uni(shape, lo, hi):
        return jax.random.uniform(next(ks), shape, jnp.float32, lo, hi)

    hw = RW_HEADS * RW_HEAD
    inp = {}
    inp['x'] = nrm((BATCH, SEQ, D), 1.0)
    inp['c'] = nrm((BATCH, D), 1.0)
    inp['ctx'] = nrm((BATCH, CTX_LEN, D), 1.0)
    inp['c_ctx'] = nrm((D,), 1.0)
    inp['w_mod'] = nrm((L, D, 6 * D), 0.5 * D ** -0.5)
    inp['b_mod'] = nrm((L, 6 * D), 0.02)
    inp['norm1_g'] = 1.0 + nrm((L, D), 0.02)
    inp['norm2_g'] = 1.0 + nrm((L, D), 0.02)
    inp['w_in'] = nrm((L, D, N_IN), D ** -0.5)
    inp['mla_q_norm_g'] = 1.0 + nrm((L, MLA_Q_LORA), 0.02)
    inp['mla_kv_norm_g'] = 1.0 + nrm((L, MLA_KV_LORA), 0.02)
    inp['mla_w_uq'] = nrm((L, MLA_Q_LORA, MLA_HEADS * (MLA_NOPE + MLA_ROPE)), MLA_Q_LORA ** -0.5)
    inp['mla_w_ukv'] = nrm((L, MLA_KV_LORA, MLA_HEADS * (MLA_NOPE + MLA_V)), MLA_KV_LORA ** -0.5)
    inp['rw_mu'] = uni((L, RW_IN), 0.0, 1.0)
    inp['rw_w0'] = uni((L, 2, hw), -6.5, -1.5)
    inp['rw_w2'] = nrm((L, 2, RW_W_LORA, hw), 0.1)
    inp['rw_a0'] = nrm((L, 2, hw), 0.01)
    inp['rw_a2'] = nrm((L, 2, RW_A_LORA, hw), 0.1)
    inp['rw_g2'] = nrm((L, RW_G_LORA, hw), RW_G_LORA ** -0.5)
    inp['rw_k_k'] = 0.85 + nrm((L, hw), 0.02)
    inp['rw_k_a'] = 1.0 + nrm((L, hw), 0.02)
    inp['rw_r_k'] = nrm((L, RW_HEADS, RW_HEAD), 0.1)
    inp['rw_lnx_g'] = 1.0 + nrm((L, hw), 0.02)
    inp['rw_lnx_b'] = nrm((L, hw), 0.02)
    inp['s5_a_re'] = -0.5 + nrm((L, 2, S5_GROUPS, S5_STATE), 0.01)
    inp['s5_a_im'] = math.pi * jnp.arange(S5_STATE, dtype=jnp.float32) + nrm((L, 2, S5_GROUPS, S5_STATE), 0.01)
    inp['s5_log_dt'] = uni((L, 2, S5_GROUPS), math.log(1e-3), math.log(1e-1))
    inp['s5_b_re'] = nrm((L, 2, S5_GROUPS, S5_STATE, S5_GROUP_CH), (2 * S5_GROUP_CH) ** -0.5)
    inp['s5_b_im'] = nrm((L, 2, S5_GROUPS, S5_STATE, S5_GROUP_CH), (2 * S5_GROUP_CH) ** -0.5)
    inp['s5_c_re'] = nrm((L, 2, S5_GROUPS, S5_GROUP_CH, S5_STATE), S5_STATE ** -0.5)
    inp['s5_c_im'] = nrm((L, 2, S5_GROUPS, S5_GROUP_CH, S5_STATE), S5_STATE ** -0.5)
    inp['s5_d'] = nrm((L, S5_GROUPS, S5_GROUP_CH), 1.0)
    inp['s5_glu_w'] = nrm((L, S5_IN, S5_IN), S5_IN ** -0.5)
    inp['s5_glu_b'] = nrm((L, S5_IN), 0.02)
    inp['diff_lq1'] = nrm((L, DIFF_HD), 0.1)
    inp['diff_lk1'] = nrm((L, DIFF_HD), 0.1)
    inp['diff_lq2'] = nrm((L, DIFF_HD), 0.1)
    inp['diff_lk2'] = nrm((L, DIFF_HD), 0.1)
    inp['diff_subln_g'] = 1.0 + nrm((L, 2 * DIFF_HD), 0.02)
    inp['w_branch'] = nrm((L, N_BRANCH, BRANCH_W, D), BRANCH_W ** -0.5)
    inp['w_out'] = nrm((L, D, D), D ** -0.5)
    inp['router_g_w'] = nrm((L, D, MOE_GROUPS), D ** -0.5)
    inp['router_g_b'] = nrm((L, MOE_GROUPS), 0.01)
    inp['router_e_w'] = nrm((L, D, MOE_EXPERTS), D ** -0.5)
    inp['router_e_b'] = nrm((L, MOE_EXPERTS), 0.01)
    inp['exp_w_gate'] = nrm((L, MOE_EXPERTS, D, D_EXPERT), D ** -0.5)
    inp['exp_w_up'] = nrm((L, MOE_EXPERTS, D, D_EXPERT), D ** -0.5)
    inp['exp_w_down'] = nrm((L, MOE_EXPERTS, D_EXPERT, D), D_EXPERT ** -0.5)
    inp['final_norm_g'] = 1.0 + nrm((D,), 0.02)
    return inp


def reference(x, c, ctx, c_ctx, w_mod, b_mod, norm1_g, norm2_g, w_in,
              mla_q_norm_g, mla_kv_norm_g, mla_w_uq, mla_w_ukv,
              rw_mu, rw_w0, rw_w2, rw_a0, rw_a2, rw_g2, rw_k_k, rw_k_a, rw_r_k, rw_lnx_g, rw_lnx_b,
              s5_a_re, s5_a_im, s5_log_dt, s5_b_re, s5_b_im, s5_c_re, s5_c_im, s5_d, s5_glu_w, s5_glu_b,
              diff_lq1, diff_lk1, diff_lq2, diff_lk2, diff_subln_g,
              w_branch, w_out,
              router_g_w, router_g_b, router_e_w, router_e_b, exp_w_gate, exp_w_up, exp_w_down,
              final_norm_g):
    n_lat = x.shape[1]
    cos, sin = axial_rope_tables(n_lat, ROPE_DIM)
    silu_c = jax.nn.silu(c)[:, None, :]
    silu_cc = jax.nn.silu(c_ctx)
    h, hc = x, ctx
    for l in range(DEPTH):
        need_ctx = l < DEPTH - 1
        mod = jnp.split(silu_c @ w_mod[l] + b_mod[l], 6, axis=-1)
        mod_c = jnp.split(silu_cc @ w_mod[l] + b_mod[l], 6, axis=-1)

        xl = rmsnorm(h, norm1_g[l]) * (1.0 + mod[1]) + mod[0]
        xc = rmsnorm(hc, norm1_g[l]) * (1.0 + mod_c[1]) + mod_c[0]
        pl = jnp.split(xl @ w_in[l], IN_SPLITS, axis=-1)
        pc = jnp.split(xc @ w_in[l], IN_SPLITS, axis=-1)
        ya = mla_branch(pc[0], pl[0], cos, sin, mla_q_norm_g[l], mla_kv_norm_g[l], mla_w_uq[l], mla_w_ukv[l],
                        need_ctx)
        yb = rwkv_branch(pc[1], pl[1], rw_mu[l], rw_w0[l], rw_w2[l], rw_a0[l], rw_a2[l], rw_g2[l],
                         rw_k_k[l], rw_k_a[l], rw_r_k[l], rw_lnx_g[l], rw_lnx_b[l], need_ctx)
        ys5 = s5_branch(pc[2], pl[2], s5_a_re[l], s5_a_im[l], s5_log_dt[l], s5_b_re[l], s5_b_im[l],
                        s5_c_re[l], s5_c_im[l], s5_d[l], s5_glu_w[l], s5_glu_b[l], need_ctx)
        yd = diff_branch(pc[3], pl[3], cos, sin, diff_lq1[l], diff_lk1[l], diff_lq2[l], diff_lk2[l],
                         diff_subln_g[l], l, need_ctx)
        h = h + mod[2] * merge_branches([ya[1], yb[1], ys5[1], yd[1]], pl[4], w_branch[l], w_out[l])
        if need_ctx:
            hc = hc + mod_c[2] * merge_branches([ya[0], yb[0], ys5[0], yd[0]], pc[4], w_branch[l], w_out[l])

        xl2 = (rmsnorm(h, norm2_g[l]) * (1.0 + mod[4]) + mod[3]).reshape(-1, D_MODEL)
        if need_ctx:
            xc2 = (rmsnorm(hc, norm2_g[l]) * (1.0 + mod_c[4]) + mod_c[3]).reshape(-1, D_MODEL)
            tokens = jnp.concatenate([xl2, xc2], axis=0)
        else:
            tokens = xl2
        idx, wts = hier_route(tokens, router_g_w[l], router_g_b[l], router_e_w[l], router_e_b[l])
        y = moe_dispatch(tokens, idx, wts, exp_w_gate[l], exp_w_up[l], exp_w_down[l])
        n_l = xl2.shape[0]
        h = h + mod[5] * y[:n_l].reshape(h.shape)
        if need_ctx:
            hc = hc + mod_c[5] * y[n_l:].reshape(hc.shape)
    return rmsnorm(h, final_norm_g)
```

```cpp
#include <hip/hip_runtime.h>
#include <stdint.h>
#include <stdio.h>

#define DI __device__ __forceinline__
#define LAS __attribute__((address_space(3)))
typedef unsigned short bf16_t;
typedef short bf16x8 __attribute__((ext_vector_type(8)));
typedef short s16x4 __attribute__((ext_vector_type(4)));
typedef float f32x4 __attribute__((ext_vector_type(4)));
typedef float f32x16 __attribute__((ext_vector_type(16)));
typedef float f32x2 __attribute__((ext_vector_type(2)));
typedef __bf16 bf16x2v __attribute__((ext_vector_type(2)));
typedef unsigned u32x4 __attribute__((ext_vector_type(4)));
typedef unsigned u32x2 __attribute__((ext_vector_type(2)));

constexpr int D = 1024, NB = 2, SEQ = 8192, CTX = 256, TZ = 8448, NZ = 16896, NL = 2;
constexpr int NIN = 6560, NINP = 6656;
constexpr int NTHR = 512;
constexpr float LOG2E = 1.4426950408889634f;

#define XB_TMO      128
#define XB_XCNT(j)  (256  + 64 * (j))
#define XB_XSUB(j)  (1280 + 64 * (j))
#define XB_XGEN(j)  (2304 + 64 * (j))
#define XB_TOP      3328
#define XB_TOPGEN   3392
#define XCD_BAR_WORDS 3456
#define XB_SPIN_CAP (1u << 18)

__device__ __forceinline__ unsigned xb_ld(unsigned* p)              { return __hip_atomic_load(p, __ATOMIC_RELAXED, __HIP_MEMORY_SCOPE_AGENT); }
__device__ __forceinline__ unsigned xb_add(unsigned* p, unsigned v) { return __hip_atomic_fetch_add(p, v, __ATOMIC_RELAXED, __HIP_MEMORY_SCOPE_AGENT); }
__device__ __forceinline__ unsigned xb_xcc_id() { return (unsigned)__builtin_amdgcn_s_getreg((3 << 11) | 20) & 0xFu; }
#define XB_SPIN(cond, bar) do { unsigned _sp = 0; while (cond) { __builtin_amdgcn_s_sleep(1); \
    if ((++_sp & 255u) == 0u) { if (xb_ld(&(bar)[XB_TMO])) break; if (_sp > XB_SPIN_CAP) { atomicAdd(&(bar)[XB_TMO], 1u); break; } } } } while (0)

struct XcdBarrier { unsigned* bar; unsigned x; volatile LAS unsigned* st; };

__device__ __forceinline__ XcdBarrier xcd_barrier_post(unsigned* bar, volatile LAS unsigned* st) {
    XcdBarrier b; b.bar = bar; b.x = xb_xcc_id(); b.st = st;
    if (threadIdx.x == 0) (void)xb_add(&bar[XB_XCNT(b.x)], 1u);
    return b;
}
__device__ __forceinline__ void xcd_barrier_complete(unsigned* bar, unsigned x, unsigned& nloc, unsigned& nx) {
    const unsigned G = gridDim.x * gridDim.y * gridDim.z;
    unsigned sum, cnt, mine, sp = 0u;
    for (;;) {
        sum = 0u; cnt = 0u; mine = 0u;
#pragma unroll
        for (unsigned j = 0; j < 16; ++j) { const unsigned c = xb_ld(&bar[XB_XCNT(j)]); sum += c; cnt += (c > 0u) ? 1u : 0u; mine = (j == x) ? c : mine; }
        if (sum == G) break;
        __builtin_amdgcn_s_sleep(1);
        if ((++sp & 255u) == 0u) { if (xb_ld(&bar[XB_TMO])) break; if (sp > XB_SPIN_CAP) { atomicAdd(&bar[XB_TMO], 1u); break; } }
    }
    nloc = mine > 0u ? mine : 1u; nx = cnt > 0u ? cnt : 1u;
}
__device__ __forceinline__ void xcd_barrier(const XcdBarrier& b) {
    asm volatile("s_waitcnt vmcnt(0)" ::: "memory");
    __syncthreads();
    if (threadIdx.x == 0) {
        unsigned* bar = b.bar;
        __builtin_amdgcn_s_waitcnt(0);
        unsigned nloc = b.st[0], nx = b.st[1];
        if (nloc == 0u) { xcd_barrier_complete(bar, b.x, nloc, nx); b.st[0] = nloc; b.st[1] = nx; }
        const unsigned old = xb_add(&bar[XB_XSUB(b.x)], 1u);
        const unsigned gen = old / nloc;
        if (old + 1u == (gen + 1u) * nloc) {
            __builtin_amdgcn_fence(__ATOMIC_RELEASE, "agent");
            asm volatile("s_waitcnt vmcnt(0)" ::: "memory");
            const unsigned og = xb_add(&bar[XB_TOP], 1u);
            const unsigned tg = og / nx;
            if (og + 1u == (tg + 1u) * nx) xb_add(&bar[XB_TOPGEN], 1u);
            else XB_SPIN(xb_ld(&bar[XB_TOPGEN]) == tg, bar);
            __builtin_amdgcn_fence(__ATOMIC_ACQUIRE, "agent");
            xb_add(&bar[XB_XGEN(b.x)], 1u);
            asm volatile("s_waitcnt vmcnt(0)" ::: "memory");
        } else {
            XB_SPIN(xb_ld(&bar[XB_XGEN(b.x)]) == gen, bar);
            __builtin_amdgcn_fence(__ATOMIC_ACQUIRE, "agent");
            asm volatile("s_waitcnt vmcnt(0)" ::: "memory");
        }
    }
    __syncthreads();
}

DI float bf2f(bf16_t v) { return __uint_as_float((unsigned)v << 16); }
DI unsigned pack2(float a, float b) { f32x2 v = {a, b}; bf16x2v r = __builtin_convertvector(v, bf16x2v); return __builtin_bit_cast(unsigned, r); }
DI bf16_t f2bf(float a) { return (bf16_t)(pack2(a, 0.f) & 0xffffu); }
DI float lo2f(unsigned u) { return __uint_as_float(u << 16); }
DI float hi2f(unsigned u) { return __uint_as_float(u & 0xffff0000u); }
DI float wave_sum(float v) {
#pragma unroll
    for (int m = 32; m >= 1; m >>= 1) v += __shfl_xor(v, m, 64);
    return v;
}
DI float sum16(float v) {
#pragma unroll
    for (int m = 8; m >= 1; m >>= 1) v += __shfl_xor(v, m, 64);
    return v;
}
DI float sigmoidf_(float x) { return 1.f / (1.f + __expf(-x)); }
DI float siluf_(float x) { return x / (1.f + __expf(-x)); }
DI float gelu_tanh(float x) { const float u = 0.7978845608028654f * (x + 0.044715f * x * x * x); return 0.5f * x * (1.f + tanhf(u)); }
DI void unpack4(u32x2 u, float (&f)[4]) { f[0] = lo2f(u.x); f[1] = hi2f(u.x); f[2] = lo2f(u.y); f[3] = hi2f(u.y); }
DI u32x2 pack4(float a, float b, float c, float d) { u32x2 r; r.x = pack2(a, b); r.y = pack2(c, d); return r; }

constexpr size_t algn(size_t x) { return (x + 255) & ~(size_t)255; }
constexpr size_t WS_CTL   = 0;
constexpr size_t CTL_BYTES = 64 * 1024;
constexpr size_t WS_H     = WS_CTL + CTL_BYTES;
constexpr size_t WS_WSM   = WS_H + (size_t)NZ * D * 4;
constexpr size_t SZ_WINT = (size_t)NINP * D * 2, SZ_WUQT = 384 * 256 * 2, SZ_WUKVT = 512 * 128 * 2, SZ_W2T = 512 * 64 * 2, SZ_A2T = 512 * 64 * 2,
                 SZ_G2T = 256 * 128 * 2, SZ_GLUT = 256 * 256 * 2, SZ_WBT = (size_t)D * D * 2, SZ_WOUTT = (size_t)D * D * 2;
constexpr size_t OFF_WINT = 0, OFF_WUQT = OFF_WINT + NL * SZ_WINT, OFF_WUKVT = OFF_WUQT + NL * SZ_WUQT, OFF_W2T = OFF_WUKVT + NL * SZ_WUKVT,
                 OFF_A2T = OFF_W2T + NL * SZ_W2T, OFF_G2T = OFF_A2T + NL * SZ_A2T, OFF_GLUT = OFF_G2T + NL * SZ_G2T, OFF_WBT = OFF_GLUT + NL * SZ_GLUT,
                 OFF_WOUTT = OFF_WBT + NL * SZ_WBT, OFF_MODV = OFF_WOUTT + NL * SZ_WOUTT,
                 OFF_ROPE = OFF_MODV + (size_t)NL * 3 * 6144 * 4,
                 OFF_S5T = OFF_ROPE + (size_t)SEQ * 16 * 2 * 4,
                 OFF_RWT = OFF_S5T + (size_t)NL * 2 * 16 * 64 * 36 * 4,
                 OFF_LAM = OFF_RWT + (size_t)NL * 36 * 1024 * 4,
                 OFF_S5E = OFF_LAM + 256,
                 OFF_S5C = OFF_S5E + (size_t)2 * 2 * 16 * 66 * 64 * 2 * 4,
                 WSM_BYTES = algn(OFF_S5C + (size_t)2 * 2 * 16 * 66 * 64 * 2 * 4);
constexpr size_t WS_EXPW  = WS_WSM + WSM_BYTES;
constexpr size_t SZ_WGU = (size_t)1024 * 1024 * 2, SZ_WD = (size_t)1024 * 512 * 2;
constexpr size_t EXPW_BYTES = 32 * (SZ_WGU + SZ_WD);
constexpr size_t SZ_QM = (size_t)NB * 4 * TZ * 96 * 2, SZ_VMT = (size_t)NB * 4 * 64 * TZ * 2, SZ_QD = (size_t)NB * 4 * TZ * 64 * 2, SZ_R256 = (size_t)NZ * 256 * 2;
constexpr size_t MX_QM = 0, MX_KM = MX_QM + SZ_QM, MX_VMT = MX_KM + SZ_QM, MX_QD = MX_VMT + SZ_VMT, MX_KD = MX_QD + SZ_QD, MX_VDT = MX_KD + SZ_QD,
                 MX_RB = MX_VDT + SZ_VMT, MX_KB = MX_RB + SZ_R256, MX_VB = MX_KB + SZ_R256, MX_KKB = MX_VB + SZ_R256, MX_END = MX_KKB + SZ_R256;
static_assert(MX_END <= EXPW_BYTES, "mixer operands must fit the expert-weight region");
constexpr size_t WS_BUFA  = WS_EXPW + EXPW_BYTES;
constexpr size_t WS_BUFB  = WS_BUFA + (size_t)NZ * D * 2;
constexpr size_t WS_P     = WS_BUFB + (size_t)NZ * D * 2;
constexpr size_t P_PM = 0, P_PS = P_PM + (size_t)NZ * 416 * 2, P_PR = P_PS + (size_t)NZ * 256 * 2, P_PD = P_PR + (size_t)NZ * 1024 * 2, P_BYTES = P_PD + (size_t)NZ * 768 * 2;
static_assert((size_t)6 * SZ_R256 <= (size_t)NZ * (1024 + 768) * 2, "scan operands must fit PR|PD");
static_assert((size_t)NZ * D * 4 <= P_BYTES, "YMOE must fit the P region");
constexpr size_t WS_GT    = WS_P + P_BYTES;
constexpr size_t GT_BYTES = (size_t)NZ * 4096 * 2;
constexpr int MOE_CAP = 33792;
constexpr size_t GT_HM = 0, GT_LIST = GT_HM + (size_t)(33792 + 32 * 128) * 512 * 2, GT_LW = GT_LIST + (size_t)32 * MOE_CAP * 4, GT_END = GT_LW + (size_t)32 * MOE_CAP * 4;
static_assert(GT_END <= GT_BYTES, "MoE scratch must fit the gate region");
constexpr size_t WS_MISC  = WS_GT + GT_BYTES;
constexpr size_t MS_CQN = 0, MS_TW = MS_CQN + (size_t)NZ * 384 * 2, MS_AL = MS_TW + (size_t)NZ * 64 * 2, MS_SG = MS_AL + (size_t)NZ * 64 * 2,
                 MS_GG = MS_SG + (size_t)NZ * 128 * 2, MS_ZG = MS_GG + SZ_R256, MS_END = MS_ZG + SZ_R256;
constexpr size_t WS_END   = WS_MISC + MS_END;

constexpr int CW_BAR = 0;
constexpr int CW_CNT = 4096;

struct Args { const float* in[49]; float* out; unsigned char* ws; int s_lo, s_hi; };

struct Ctx {
    const float* const* in; float* out; unsigned char* ws; unsigned char* smem; int tid, lane, wave;
};

template <int WM> struct GCfg { static constexpr int WN = 8 / WM, BM = 64 * WM, BN = 64 * WN, ABYTES = BM * 64, BBYTES = BN * 64, STAGE = ABYTES + BBYTES; };

template <int WM, int SEGK, class ARow, class BRow, class Hook, class Epi>
DI void gemm_tile(const Ctx& c, int K, ARow arow, BRow brow, Hook hook, Epi epi) {
    typedef GCfg<WM> G;
    const int tid = c.tid, lane = c.lane, wave = c.wave;
    const int wm = wave / G::WN, wn = wave % G::WN, fr = lane & 15, fq = lane >> 4;
    unsigned char* smem = c.smem;
    constexpr int NA = G::BM / 128, NBq = G::BN / 128;
    const bf16_t* asrc[NA]; const bf16_t* bsrc[NBq];
#pragma unroll
    for (int i = 0; i < NA; ++i) { const int ch = tid + i * NTHR; asrc[i] = arow(ch >> 2) + (ch & 3) * 8; }
#pragma unroll
    for (int i = 0; i < NBq; ++i) { const int ch = tid + i * NTHR; bsrc[i] = brow(ch >> 2) + (ch & 3) * 8; }
    auto stage = [&](int kt, int buf) {
        unsigned char* sa = smem + buf * G::STAGE; unsigned char* sb = sa + G::ABYTES;
#pragma unroll
        for (int i = 0; i < NA; ++i) __builtin_amdgcn_global_load_lds((const unsigned*)(asrc[i] + kt * 32), (unsigned*)(sa + (tid + i * NTHR) * 16), 16, 0, 0);
#pragma unroll
        for (int i = 0; i < NBq; ++i) __builtin_amdgcn_global_load_lds((const unsigned*)(bsrc[i] + kt * 32), (unsigned*)(sb + (tid + i * NTHR) * 16), 16, 0, 0);
    };
    f32x4 acc[4][4];
#pragma unroll
    for (int m = 0; m < 4; ++m)
#pragma unroll
        for (int n = 0; n < 4; ++n) acc[m][n] = (f32x4){0.f, 0.f, 0.f, 0.f};
    const int T = K / 32;
    __syncthreads();
    stage(0, 0);
    for (int t = 0; t < T; ++t) {
        asm volatile("s_waitcnt vmcnt(0)" ::: "memory");
        __syncthreads();
        if (t + 1 < T) stage(t + 1, (t + 1) & 1);
        const unsigned char* sa = smem + (t & 1) * G::STAGE; const unsigned char* sb = sa + G::ABYTES;
        bf16x8 af[4], bfr[4];
#pragma unroll
        for (int m = 0; m < 4; ++m) af[m] = *(const bf16x8*)(sa + (wm * 64 + m * 16 + fr) * 64 + fq * 16);
#pragma unroll
        for (int n = 0; n < 4; ++n) bfr[n] = *(const bf16x8*)(sb + (wn * 64 + n * 16 + fr) * 64 + fq * 16);
#pragma unroll
        for (int m = 0; m < 4; ++m)
#pragma unroll
            for (int n = 0; n < 4; ++n) acc[m][n] = __builtin_amdgcn_mfma_f32_16x16x32_bf16(bfr[n], af[m], acc[m][n], 0, 0, 0);
        if (SEGK > 0) { if (((t + 1) * 32) % (SEGK > 0 ? SEGK : 32) == 0) hook(acc, ((t + 1) * 32) / (SEGK > 0 ? SEGK : 32) - 1, wm * 64, wn * 64, fr, fq); }
    }
    epi(acc, wm * 64, wn * 64, fr, fq);
}
struct NoHook { DI void operator()(f32x4 (&)[4][4], int, int, int, int, int) const {} };

DI int rowmap(int n, int mode) { return mode == 0 ? n : ((n >> 4) * 32 + (n & 15) + (mode == 2 ? 16 : 0)); }
DI void tconv_tile(const Ctx& c, const float* src, int ld, int N, bf16_t* dst, int ld_dst, int mode, int tk, int tn) {
    bf16_t* T = (bf16_t*)c.smem;
    const int k0 = tk * 64, n0 = tn * 64, tid = c.tid;
    __syncthreads();
#pragma unroll
    for (int i = 0; i < 2; ++i) {
        const int kk = (tid >> 4) + i * 32, n4 = (tid & 15) * 4;
        float4 v = make_float4(0.f, 0.f, 0.f, 0.f);
        if (n0 + n4 < N) v = *(const float4*)(src + (size_t)(k0 + kk) * ld + n0 + n4);
        T[(n4 + 0) * 72 + kk] = f2bf(v.x); T[(n4 + 1) * 72 + kk] = f2bf(v.y); T[(n4 + 2) * 72 + kk] = f2bf(v.z); T[(n4 + 3) * 72 + kk] = f2bf(v.w);
    }
    __syncthreads();
    const int n = tid >> 3, k8 = (tid & 7) * 8;
    if (n0 + n < N) *(u32x4*)(dst + (size_t)rowmap(n0 + n, mode) * ld_dst + k0 + k8) = *(const u32x4*)(T + n * 72 + k8);
}
DI void tconv(const Ctx& c, const float* src, int ld, int K, int N, bf16_t* dst, int ld_dst, int mode, int rot) {
    const int ntk = K / 64, ntn = (N + 63) / 64, nt = ntk * ntn, G = gridDim.x;
    for (int t = (blockIdx.x + G - (rot % G)) % G; t < nt; t += G) tconv_tile(c, src, ld, N, dst, ld_dst, mode, t / ntn, t % ntn);
}

DI void phase_prologue(const Ctx& c) {
    unsigned char* wsm = c.ws + WS_WSM;
    const int tid = c.tid, G = gridDim.x, gtid = blockIdx.x * NTHR + tid, gn = G * NTHR;
    {
        const float4* x = (const float4*)c.in[0]; const float4* cx = (const float4*)c.in[2]; float4* H = (float4*)(c.ws + WS_H);
        for (size_t i = gtid; i < (size_t)NZ * 256; i += gn) {
            const int z = (int)(i >> 8), q = (int)(i & 255), b = z / TZ, s = z % TZ;
            H[i] = (s < CTX) ? cx[((size_t)b * CTX + s) * 256 + q] : x[((size_t)b * SEQ + (s - CTX)) * 256 + q];
        }
    }
    {
        float* rope = (float*)(wsm + OFF_ROPE);
        for (int i = gtid; i < SEQ * 16; i += gn) {
            const int t = i >> 4, a = (i >> 3) & 1, f = i & 7;
            const float pos = (float)(a == 0 ? (t >> 6) : (t & 63));
            const float inv = powf(10000.f, -(float)f / 8.f);
            float sn, cs; sincosf(pos * inv, &sn, &cs);
            rope[i * 2] = cs; rope[i * 2 + 1] = sn;
        }
    }
    {
        float* s5t = (float*)(wsm + OFF_S5T);
        for (int i = gtid; i < NL * 2 * 16 * 64; i += gn) {
            const int ldg = i >> 6;
            const double lr = c.in[24][i], li = c.in[25][i], dt = exp((double)c.in[26][ldg]);
            const double mag = exp(lr * dt), are = mag * cos(li * dt), aim = mag * sin(li * dt);
            const double m256 = exp(lr * dt * 128.0), a256r = m256 * cos(li * dt * 128.0), a256i = m256 * sin(li * dt * 128.0);
            const double den = lr * lr + li * li, nr = are - 1.0, ni = aim;
            const double cfr = (nr * lr + ni * li) / den, cfi = (ni * lr - nr * li) / den;
            float* o = s5t + (size_t)i * 36;
            o[0] = (float)are; o[1] = (float)aim; o[2] = (float)a256r; o[3] = (float)a256i;
            for (int ch = 0; ch < 16; ++ch) {
                const double br = c.in[27][(size_t)i * 16 + ch], bi = c.in[28][(size_t)i * 16 + ch];
                o[4 + ch] = (float)(cfr * br - cfi * bi); o[20 + ch] = (float)(cfr * bi + cfi * br);
            }
        }
    }
    {
        float* rwt = (float*)(wsm + OFF_RWT);
        for (int i = gtid; i < NL * 36 * 1024; i += gn) {
            const int l = i / (36 * 1024), e = (i / 1024) % 36, d = i & 1023;
            rwt[i] = e < 4 ? c.in[41][((size_t)l * 1024 + d) * 4 + e] : c.in[43][((size_t)l * 1024 + d) * 32 + (e - 4)];
        }
    }
    if (blockIdx.x == 0 && tid < NL) {
        float s1 = 0.f, s2 = 0.f;
        for (int i = 0; i < 32; ++i) { s1 += c.in[34][tid * 32 + i] * c.in[35][tid * 32 + i]; s2 += c.in[36][tid * 32 + i] * c.in[37][tid * 32 + i]; }
        ((float*)(wsm + OFF_LAM))[tid] = expf(s1) - expf(s2) + (0.8f - 0.6f * expf(-0.3f * (float)tid));
    }
    {
        float* sv = (float*)c.smem;
        float* red = sv + 3 * 1024;
        __syncthreads();
        for (int i = tid; i < 3 * 1024; i += NTHR) { const float v = i < 2048 ? c.in[1][i] : c.in[3][i - 2048]; sv[i] = siluf_(v); }
        __syncthreads();
        float* modv = (float*)(wsm + OFF_MODV);
        for (int u = blockIdx.x; u < NL * 96; u += G) {
            const int l = u / 96, col = (u % 96) * 64 + (tid & 63), ks = tid >> 6;
            const float* w = c.in[4] + (size_t)l * 1024 * 6144 + col;
            float a0 = 0.f, a1 = 0.f, a2 = 0.f;
            for (int k = ks * 128; k < ks * 128 + 128; ++k) { const float wv = w[(size_t)k * 6144]; a0 += sv[k] * wv; a1 += sv[1024 + k] * wv; a2 += sv[2048 + k] * wv; }
            red[(ks * 64 + (tid & 63)) * 3 + 0] = a0; red[(ks * 64 + (tid & 63)) * 3 + 1] = a1; red[(ks * 64 + (tid & 63)) * 3 + 2] = a2;
            __syncthreads();
            if (tid < 192) {
                const int cc = tid & 63, sel = tid >> 6; float s = 0.f;
                for (int k2 = 0; k2 < 8; ++k2) s += red[(k2 * 64 + cc) * 3 + sel];
                const int colo = (u % 96) * 64 + cc;
                modv[((size_t)l * 3 + sel) * 6144 + colo] = s + c.in[5][l * 6144 + colo];
            }
            __syncthreads();
        }
    }
    for (int l = 0; l < NL; ++l) {
        tconv(c, c.in[8] + (size_t)l * 1024 * NIN, NIN, 1024, NIN, (bf16_t*)(wsm + OFF_WINT + l * SZ_WINT), 1024, 0, 0);
        tconv(c, c.in[11] + (size_t)l * 256 * 384, 384, 256, 384, (bf16_t*)(wsm + OFF_WUQT + l * SZ_WUQT), 256, 0, 40);
        tconv(c, c.in[12] + (size_t)l * 128 * 512, 512, 128, 512, (bf16_t*)(wsm + OFF_WUKVT + l * SZ_WUKVT), 128, 0, 70);
        for (int d = 0; d < 2; ++d) {
            tconv(c, c.in[15] + (size_t)(l * 2 + d) * 64 * 256, 256, 64, 256, (bf16_t*)(wsm + OFF_W2T + l * SZ_W2T) + d * 256 * 64, 64, 0, 90 + d * 8);
            tconv(c, c.in[17] + (size_t)(l * 2 + d) * 64 * 256, 256, 64, 256, (bf16_t*)(wsm + OFF_A2T + l * SZ_A2T) + d * 256 * 64, 64, 0, 110 + d * 8);
        }
        tconv(c, c.in[18] + (size_t)l * 128 * 256, 256, 128, 256, (bf16_t*)(wsm + OFF_G2T + l * SZ_G2T), 128, 0, 130);
        tconv(c, c.in[32] + (size_t)l * 256 * 256, 256, 256, 256, (bf16_t*)(wsm + OFF_GLUT + l * SZ_GLUT), 256, 0, 140);
        for (int n = 0; n < 4; ++n)
            tconv(c, c.in[39] + (size_t)(l * 4 + n) * 256 * 1024, 1024, 256, 1024, (bf16_t*)(wsm + OFF_WBT + l * SZ_WBT) + n * 256, 1024, 0, 160 + n * 20);
        tconv(c, c.in[40] + (size_t)l * 1024 * 1024, 1024, 1024, 1024, (bf16_t*)(wsm + OFF_WOUTT + l * SZ_WOUTT), 1024, 0, 0);
    }
}

DI void phase_expert_convert(const Ctx& c, int l) {
    const int G = gridDim.x;
    for (int t = blockIdx.x; t < 32 * 384; t += G) {
        const int e = t / 384, r = t % 384;
        bf16_t* wgu = (bf16_t*)(c.ws + WS_EXPW + (size_t)e * SZ_WGU);
        bf16_t* wd = (bf16_t*)(c.ws + WS_EXPW + 32 * SZ_WGU + (size_t)e * SZ_WD);
        if (r < 128)      tconv_tile(c, c.in[45] + ((size_t)l * 32 + e) * 1024 * 512, 512, 512, wgu, 1024, 1, r / 8, r % 8);
        else if (r < 256) tconv_tile(c, c.in[46] + ((size_t)l * 32 + e) * 1024 * 512, 512, 512, wgu, 1024, 2, (r - 128) / 8, (r - 128) % 8);
        else              tconv_tile(c, c.in[47] + ((size_t)l * 32 + e) * 512 * 1024, 1024, 1024, wd, 512, 0, (r - 256) / 16, (r - 256) % 16);
    }
}

DI void phase_norm1(const Ctx& c, int l) {
    const float* modv = (const float*)(c.ws + WS_WSM + OFF_MODV);
    float* H = (float*)(c.ws + WS_H); const float* Y = (const float*)(c.ws + WS_P);
    bf16_t* XN = (bf16_t*)(c.ws + WS_BUFA);
    const float* g1 = c.in[6] + l * 1024;
    for (int row = blockIdx.x * 8 + c.wave; row < NZ; row += gridDim.x * 8) {
        const int b = row / TZ, s = row % TZ, sel = s < CTX ? 2 : b;
        float4 v[4]; float ss = 0.f;
#pragma unroll
        for (int q = 0; q < 4; ++q) {
            const int col = q * 256 + c.lane * 4;
            v[q] = *(const float4*)(H + (size_t)row * D + col);
            if (l > 0) {
                const float4 y = *(const float4*)(Y + (size_t)row * D + col); const float4 m5 = *(const float4*)(modv + ((size_t)(l - 1) * 3 + sel) * 6144 + 5 * 1024 + col);
                v[q].x += m5.x * y.x; v[q].y += m5.y * y.y; v[q].z += m5.z * y.z; v[q].w += m5.w * y.w;
                *(float4*)(H + (size_t)row * D + col) = v[q];
            }
            ss += v[q].x * v[q].x + v[q].y * v[q].y + v[q].z * v[q].z + v[q].w * v[q].w;
        }
        ss = wave_sum(ss);
        const float rs = rsqrtf(ss * (1.f / 1024.f) + 1e-6f);
#pragma unroll
        for (int q = 0; q < 4; ++q) {
            const int col = q * 256 + c.lane * 4;
            const float4 g = *(const float4*)(g1 + col), m0 = *(const float4*)(modv + ((size_t)l * 3 + sel) * 6144 + col), m1 = *(const float4*)(modv + ((size_t)l * 3 + sel) * 6144 + 1024 + col);
            *(u32x2*)(XN + (size_t)row * D + col) = pack4(v[q].x * rs * g.x * (1.f + m1.x) + m0.x, v[q].y * rs * g.y * (1.f + m1.y) + m0.y,
                                                          v[q].z * rs * g.z * (1.f + m1.z) + m0.z, v[q].w * rs * g.w * (1.f + m1.w) + m0.w);
        }
    }
}

DI void phase_final(const Ctx& c) {
    const float* modv = (const float*)(c.ws + WS_WSM + OFF_MODV);
    const float* H = (const float*)(c.ws + WS_H); const float* Y = (const float*)(c.ws + WS_P);
    const float* g = c.in[48];
    for (int r = blockIdx.x * 8 + c.wave; r < NB * SEQ; r += gridDim.x * 8) {
        const int b = r / SEQ, t = r % SEQ, row = b * TZ + CTX + t;
        float4 v[4]; float ss = 0.f;
#pragma unroll
        for (int q = 0; q < 4; ++q) {
            const int col = q * 256 + c.lane * 4;
            v[q] = *(const float4*)(H + (size_t)row * D + col);
            const float4 y = *(const float4*)(Y + (size_t)row * D + col); const float4 m5 = *(const float4*)(modv + ((size_t)(NL - 1) * 3 + b) * 6144 + 5 * 1024 + col);
            v[q].x += m5.x * y.x; v[q].y += m5.y * y.y; v[q].z += m5.z * y.z; v[q].w += m5.w * y.w;
            ss += v[q].x * v[q].x + v[q].y * v[q].y + v[q].z * v[q].z + v[q].w * v[q].w;
        }
        ss = wave_sum(ss);
        const float rs = rsqrtf(ss * (1.f / 1024.f) + 1e-6f);
#pragma unroll
        for (int q = 0; q < 4; ++q) {
            const int col = q * 256 + c.lane * 4; const float4 gg = *(const float4*)(g + col);
            *(float4*)(c.out + (size_t)r * D + col) = make_float4(v[q].x * rs * gg.x, v[q].y * rs * gg.y, v[q].z * rs * gg.z, v[q].w * rs * gg.w);
        }
    }
}

DI void phase_inproj(const Ctx& c, int l) {
    const bf16_t* XN = (const bf16_t*)(c.ws + WS_BUFA);
    const bf16_t* W = (const bf16_t*)(c.ws + WS_WSM + OFF_WINT + l * SZ_WINT);
    bf16_t* PM = (bf16_t*)(c.ws + WS_P + P_PM); bf16_t* PS = (bf16_t*)(c.ws + WS_P + P_PS); bf16_t* PR = (bf16_t*)(c.ws + WS_P + P_PR); bf16_t* PD = (bf16_t*)(c.ws + WS_P + P_PD);
    bf16_t* GT = (bf16_t*)(c.ws + WS_GT);
    constexpr int NMT = NZ / 256, NNT = NINP / 128;
    for (int u = blockIdx.x; u < NMT * NNT; u += gridDim.x) {
        const int mt = u / NNT, nt = u % NNT, r0 = mt * 256, c0 = nt * 128;
        gemm_tile<4, 0>(c, 1024,
            [&](int i) { return XN + (size_t)(r0 + i) * D; },
            [&](int i) { return W + (size_t)(c0 + i) * D; }, NoHook(),
            [&](f32x4 (&acc)[4][4], int wr, int wc, int fr, int fq) {
#pragma unroll
                for (int n = 0; n < 4; ++n) {
                    const int col = c0 + wc + n * 16 + fq * 4;
                    bf16_t* dst; int ld, cc; bool gate = false;
                    if (col < 416) { dst = PM; ld = 416; cc = col; }
                    else if (col < 1440) { dst = PR; ld = 1024; cc = col - 416; }
                    else if (col < 1696) { dst = PS; ld = 256; cc = col - 1440; }
                    else if (col < 2464) { dst = PD; ld = 768; cc = col - 1696; }
                    else if (col < NIN) { dst = GT; ld = 4096; cc = col - 2464; gate = true; }
                    else continue;
#pragma unroll
                    for (int m = 0; m < 4; ++m) {
                        const int row = r0 + wr + m * 16 + fr; f32x4 v = acc[m][n];
                        if (gate) { v[0] = sigmoidf_(v[0]); v[1] = sigmoidf_(v[1]); v[2] = sigmoidf_(v[2]); v[3] = sigmoidf_(v[3]); }
                        *(u32x2*)(dst + (size_t)row * ld + cc) = pack4(v[0], v[1], v[2], v[3]);
                    }
                }
            });
    }
}

DI void phase_prep(const Ctx& c, int l) {
    unsigned char* ws = c.ws; const int lane = c.lane, wave = c.wave, tid = c.tid;
    const bf16_t* PM = (const bf16_t*)(ws + WS_P + P_PM); const bf16_t* PR = (const bf16_t*)(ws + WS_P + P_PR); const bf16_t* PD = (const bf16_t*)(ws + WS_P + P_PD);
    bf16_t* CQN = (bf16_t*)(ws + WS_MISC + MS_CQN); bf16_t* TW = (bf16_t*)(ws + WS_MISC + MS_TW); bf16_t* AL = (bf16_t*)(ws + WS_MISC + MS_AL); bf16_t* SG = (bf16_t*)(ws + WS_MISC + MS_SG);
    bf16_t* KM = (bf16_t*)(ws + WS_EXPW + MX_KM); bf16_t* QD = (bf16_t*)(ws + WS_EXPW + MX_QD); bf16_t* KD_ = (bf16_t*)(ws + WS_EXPW + MX_KD); bf16_t* VDT = (bf16_t*)(ws + WS_EXPW + MX_VDT);
    bf16_t* RB = (bf16_t*)(ws + WS_EXPW + MX_RB); bf16_t* KB = (bf16_t*)(ws + WS_EXPW + MX_KB); bf16_t* VB = (bf16_t*)(ws + WS_EXPW + MX_VB); bf16_t* KKB = (bf16_t*)(ws + WS_EXPW + MX_KKB);
    const float* rope = (const float*)(ws + WS_WSM + OFF_ROPE);
    const float* gq = c.in[9] + l * 256; const float* gkv = c.in[10] + l * 128; const float* mu = c.in[13] + l * 1024; const float* k_k = c.in[19] + l * 256;
    bf16_t* Vs = (bf16_t*)c.smem;
    const float qsc = 0.17677669529663687f * LOG2E;
    for (int tile = blockIdx.x; tile < NZ / 64; tile += gridDim.x) {
        __syncthreads();
        for (int i = 0; i < 8; ++i) {
            const int rt = wave * 8 + i, z = tile * 64 + rt, b = z / TZ, s = z % TZ; const bool lat = s >= CTX; const int tl = lat ? s - CTX : 0;
            {
                const bf16_t* pm = PM + (size_t)z * 416;
                float x[4]; unpack4(*(const u32x2*)(pm + lane * 4), x);
                float ss = wave_sum(x[0] * x[0] + x[1] * x[1] + x[2] * x[2] + x[3] * x[3]);
                float rs = rsqrtf(ss * (1.f / 256.f) + 1e-6f);
                const float4 g = *(const float4*)(gq + lane * 4);
                *(u32x2*)(CQN + (size_t)z * 384 + lane * 4) = pack4(x[0] * rs * g.x, x[1] * rs * g.y, x[2] * rs * g.z, x[3] * rs * g.w);
                const unsigned u2 = *(const unsigned*)(pm + 256 + lane * 2); const float y0 = lo2f(u2), y1 = hi2f(u2);
                ss = wave_sum(y0 * y0 + y1 * y1); rs = rsqrtf(ss * (1.f / 128.f) + 1e-6f);
                const float2 g2 = *(const float2*)(gkv + lane * 2);
                *(unsigned*)(CQN + (size_t)z * 384 + 256 + lane * 2) = pack2(y0 * rs * g2.x, y1 * rs * g2.y);
                float kr = bf2f(pm[384 + (lane & 31)]);
                const float pr = __shfl_xor(kr, 8, 64);
                if (lat) { const float* cs = rope + ((size_t)tl * 16 + ((lane & 31) >> 4) * 8 + (lane & 7)) * 2; kr = kr * cs[0] + ((lane & 8) ? pr : -pr) * cs[1]; }
                if (lane < 32) {
                    const bf16_t kv = f2bf(kr);
#pragma unroll
                    for (int h = 0; h < 4; ++h) KM[((size_t)(b * 4 + h) * TZ + s) * 96 + 64 + lane] = kv;
                }
            }
            {
                const bf16_t* pd = PD + (size_t)z * 768;
                const int i0 = lane * 4, hh = i0 >> 6, ii = i0 & 31, nn = (i0 >> 5) & 1;
                const float* cs = rope + ((size_t)tl * 16 + (ii >> 4) * 8 + (ii & 7)) * 2;
                const bool hi = (ii & 8) != 0;
#pragma unroll
                for (int w = 0; w < 2; ++w) {
                    float x[4]; unpack4(*(const u32x2*)(pd + w * 256 + i0), x);
                    float o[4];
#pragma unroll
                    for (int j = 0; j < 4; ++j) {
                        const float p = __shfl_xor(x[j], 2, 64);
                        o[j] = lat ? (x[j] * cs[2 * j] + (hi ? p : -p) * cs[2 * j + 1]) : x[j];
                        if (w == 0) o[j] *= qsc;
                    }
                    bf16_t* dst = (w == 0 ? QD : KD_) + ((size_t)(b * 4 + hh) * TZ + s) * 64 + nn * 32 + ii;
                    *(u32x2*)dst = pack4(o[0], o[1], o[2], o[3]);
                }
                *(u32x2*)(Vs + rt * 264 + i0) = *(const u32x2*)(pd + 512 + i0);
            }
            {
                const bf16_t* pr = PR + (size_t)z * 1024;
                const bool hp = (s != 0) && (s != CTX), hn = (s != CTX - 1) && (s != TZ - 1);
#pragma unroll
                for (int q = 0; q < 4; ++q) {
                    const int col = q * 256 + lane * 4;
                    float cu[4], pv[4] = {0.f, 0.f, 0.f, 0.f}, nx[4] = {0.f, 0.f, 0.f, 0.f};
                    unpack4(*(const u32x2*)(pr + col), cu);
                    if (hp) unpack4(*(const u32x2*)(pr - 1024 + col), pv);
                    if (hn) unpack4(*(const u32x2*)(pr + 1024 + col), nx);
                    const float4 m = *(const float4*)(mu + col);
                    float zv[4];
                    zv[0] = cu[0] + (0.5f * (pv[0] + nx[0]) - cu[0]) * m.x; zv[1] = cu[1] + (0.5f * (pv[1] + nx[1]) - cu[1]) * m.y;
                    zv[2] = cu[2] + (0.5f * (pv[2] + nx[2]) - cu[2]) * m.z; zv[3] = cu[3] + (0.5f * (pv[3] + nx[3]) - cu[3]) * m.w;
                    if (q == 0) *(u32x2*)(RB + (size_t)z * 256 + lane * 4) = pack4(zv[0], zv[1], zv[2], zv[3]);
                    else if (q == 1) {
                        *(u32x2*)(KB + (size_t)z * 256 + lane * 4) = pack4(zv[0], zv[1], zv[2], zv[3]);
                        const float4 kk4 = *(const float4*)(k_k + lane * 4);
                        const float a0 = zv[0] * kk4.x, a1 = zv[1] * kk4.y, a2 = zv[2] * kk4.z, a3 = zv[3] * kk4.w;
                        const float ssq = sum16(a0 * a0 + a1 * a1 + a2 * a2 + a3 * a3);
                        const float inv = 1.f / fmaxf(sqrtf(ssq), 1e-12f);
                        *(u32x2*)(KKB + (size_t)z * 256 + lane * 4) = pack4(a0 * inv, a1 * inv, a2 * inv, a3 * inv);
                    } else if (q == 2) *(u32x2*)(VB + (size_t)z * 256 + lane * 4) = pack4(zv[0], zv[1], zv[2], zv[3]);
                    else {
                        if (lane < 16) *(u32x2*)(TW + (size_t)z * 64 + lane * 4) = pack4(tanhf(zv[0]), tanhf(zv[1]), tanhf(zv[2]), tanhf(zv[3]));
                        else if (lane < 32) *(u32x2*)(AL + (size_t)z * 64 + (lane - 16) * 4) = pack4(zv[0], zv[1], zv[2], zv[3]);
                        else *(u32x2*)(SG + (size_t)z * 128 + (lane - 32) * 4) = pack4(sigmoidf_(zv[0]), sigmoidf_(zv[1]), sigmoidf_(zv[2]), sigmoidf_(zv[3]));
                    }
                }
            }
        }
        __syncthreads();
        {
            const int z0 = tile * 64, b = z0 / TZ, s0 = z0 % TZ;
#pragma unroll
            for (int i = 0; i < 4; ++i) {
                const int ch = tid + i * NTHR, dv = ch >> 3, r8 = (ch & 7) * 8;
                bf16_t v[8];
#pragma unroll
                for (int j = 0; j < 8; ++j) v[j] = Vs[(r8 + j) * 264 + dv];
                u32x4 o; o.x = v[0] | ((unsigned)v[1] << 16); o.y = v[2] | ((unsigned)v[3] << 16); o.z = v[4] | ((unsigned)v[5] << 16); o.w = v[6] | ((unsigned)v[7] << 16);
                *(u32x4*)(VDT + ((size_t)(b * 4 + (dv >> 6)) * 64 + (dv & 63)) * TZ + s0 + r8) = o;
            }
        }
    }
}

constexpr int S5C = 128, S5N = TZ / S5C;
DI int s5_tok(int dir, int i) { return dir == 0 ? i : (i < CTX ? CTX - 1 - i : TZ - 1 - (i - CTX)); }
DI void s5_stage_u(const Ctx& c, float* U, int b, int dir, int chunk, int g0, int ng) {
    const bf16_t* PS = (const bf16_t*)(c.ws + WS_P + P_PS);
    const int per = ng * 4;
    for (int e = c.tid; e < S5C * per; e += NTHR) {
        const int i = e / per, c4 = (e % per) * 4, s = s5_tok(dir, chunk * S5C + i);
        float x[4]; unpack4(*(const u32x2*)(PS + (size_t)(b * TZ + s) * 256 + g0 * 16 + c4), x);
        *(float4*)(U + i * (ng * 16) + c4) = make_float4(x[0], x[1], x[2], x[3]);
    }
}
DI void phase_s5_local(const Ctx& c, int l) {
    float* U = (float*)c.smem;
    const float* s5t = (const float*)(c.ws + WS_WSM + OFF_S5T);
    float* E = (float*)(c.ws + WS_WSM + OFF_S5E);
    for (int u = blockIdx.x; u < 2 * 2 * S5N * 2; u += gridDim.x) {
        const int gq = u & 1, chunk = (u >> 1) % S5N, dir = (u / (2 * S5N)) & 1, b = u / (4 * S5N);
        __syncthreads();
        s5_stage_u(c, U, b, dir, chunk, gq * 8, 8);
        __syncthreads();
        const int g = gq * 8 + c.wave, p = c.lane;
        const float* tb = s5t + ((size_t)((l * 2 + dir) * 16 + g) * 64 + p) * 36;
        const float are = tb[0], aim = tb[1];
        float br[16], bi[16];
#pragma unroll
        for (int ch = 0; ch < 16; ++ch) { br[ch] = tb[4 + ch]; bi[ch] = tb[20 + ch]; }
        float xr = 0.f, xi = 0.f;
        for (int i = 0; i < S5C; ++i) {
            const float* uu = U + i * 128 + c.wave * 16;
            float sr = 0.f, si = 0.f;
#pragma unroll
            for (int q = 0; q < 4; ++q) { const float4 v = *(const float4*)(uu + q * 4);
                sr += br[q * 4] * v.x + br[q * 4 + 1] * v.y + br[q * 4 + 2] * v.z + br[q * 4 + 3] * v.w;
                si += bi[q * 4] * v.x + bi[q * 4 + 1] * v.y + bi[q * 4 + 2] * v.z + bi[q * 4 + 3] * v.w; }
            const float nr = are * xr - aim * xi + sr, ni = are * xi + aim * xr + si; xr = nr; xi = ni;
        }
        *(float2*)(E + ((size_t)(((b * 2 + dir) * 16 + g) * S5N + chunk) * 64 + p) * 2) = make_float2(xr, xi);
    }
}
DI void phase_s5_carry(const Ctx& c, int l) {
    const int gt = blockIdx.x * NTHR + c.tid;
    if (gt < 2 * 2 * 16 * 64) {
        const int p = gt & 63, g = (gt >> 6) & 15, dir = (gt >> 10) & 1, b = gt >> 11;
        const float* tb = (const float*)(c.ws + WS_WSM + OFF_S5T) + ((size_t)((l * 2 + dir) * 16 + g) * 64 + p) * 36;
        const float ar = tb[2], ai = tb[3];
        const float* E = (const float*)(c.ws + WS_WSM + OFF_S5E) + (size_t)(((b * 2 + dir) * 16 + g) * S5N) * 128;
        float* C = (float*)(c.ws + WS_WSM + OFF_S5C) + (size_t)(((b * 2 + dir) * 16 + g) * S5N) * 128;
        float xr = 0.f, xi = 0.f;
        for (int ch = 0; ch < S5N; ++ch) {
            *(float2*)(C + ch * 128 + p * 2) = make_float2(xr, xi);
            const float2 e = *(const float2*)(E + ch * 128 + p * 2);
            const float nr = ar * xr - ai * xi + e.x, ni = ar * xi + ai * xr + e.y; xr = nr; xi = ni;
        }
    }
}

DI void phase_s5_final_unit(const Ctx& c, int l, int u) {
    float* U = (float*)c.smem;
    float* Y = U + S5C * 64;
    float* X = Y + 2 * S5C * 64;
    const float* s5t = (const float*)(c.ws + WS_WSM + OFF_S5T);
    const float* CIN = (const float*)(c.ws + WS_WSM + OFF_S5C);
    const int gq = u & 3, ct = (u >> 2) % S5N, b = u / (4 * S5N);
    const int wave = c.wave, lane = c.lane, gl = wave >> 1, dir = wave & 1, g = gq * 4 + gl, p = lane;
    __syncthreads();
    s5_stage_u(c, U, b, 0, ct, gq * 4, 4);
    __syncthreads();
    {
        float* Xw = X + wave * 4 * 128;
        const int cd = dir == 0 ? ct : (ct < 2 ? 1 - ct : 67 - ct);
        const float* tb = s5t + ((size_t)((l * 2 + dir) * 16 + g) * 64 + p) * 36;
        const float are = tb[0], aim = tb[1];
        float br[16], bi[16];
#pragma unroll
        for (int ch = 0; ch < 16; ++ch) { br[ch] = tb[4 + ch]; bi[ch] = tb[20 + ch]; }
        const float2 ci = *(const float2*)(CIN + ((size_t)(((b * 2 + dir) * 16 + g) * S5N + cd) * 64 + p) * 2);
        float xr = ci.x, xi = ci.y;
        const int tt = lane >> 4, chn = lane & 15;
        const float* cre = c.in[29] + ((size_t)((l * 2 + dir) * 16 + g) * 16 + chn) * 64;
        const float* cim = c.in[30] + ((size_t)((l * 2 + dir) * 16 + g) * 16 + chn) * 64;
        const float dsk = c.in[31][(size_t)l * 256 + g * 16 + chn];
        for (int i0 = 0; i0 < S5C; i0 += 4) {
#pragma unroll
            for (int k = 0; k < 4; ++k) {
                const int tl = dir == 0 ? (i0 + k) : S5C - 1 - (i0 + k);
                const float* uu = U + tl * 64 + gl * 16;
                float sr = 0.f, si = 0.f;
#pragma unroll
                for (int q = 0; q < 4; ++q) { const float4 v = *(const float4*)(uu + q * 4);
                    sr += br[q * 4] * v.x + br[q * 4 + 1] * v.y + br[q * 4 + 2] * v.z + br[q * 4 + 3] * v.w;
                    si += bi[q * 4] * v.x + bi[q * 4 + 1] * v.y + bi[q * 4 + 2] * v.z + bi[q * 4 + 3] * v.w; }
                const float nr = are * xr - aim * xi + sr, ni = are * xi + aim * xr + si; xr = nr; xi = ni;
                *(float2*)(Xw + k * 128 + p * 2) = make_float2(xr, xi);
            }
            float y = 0.f;
            const float* xs = Xw + tt * 128;
#pragma unroll 4
            for (int pp = 0; pp < 64; pp += 4) {
                const float4 x0 = *(const float4*)(xs + pp * 2), x1 = *(const float4*)(xs + pp * 2 + 4);
                const float4 a = *(const float4*)(cre + pp), bq = *(const float4*)(cim + pp);
                y += a.x * x0.x - bq.x * x0.y + a.y * x0.z - bq.y * x0.w + a.z * x1.x - bq.z * x1.y + a.w * x1.z - bq.w * x1.w;
            }
            const int tl = dir == 0 ? (i0 + tt) : S5C - 1 - (i0 + tt);
            if (dir == 0) y += dsk * U[tl * 64 + gl * 16 + chn];
            Y[(dir * S5C + tl) * 64 + gl * 16 + chn] = y;
        }
    }
    __syncthreads();
    bf16_t* ZG = (bf16_t*)(c.ws + WS_MISC + MS_ZG);
    for (int e = c.tid; e < S5C * 16; e += NTHR) {
        const int i = e >> 4, c4 = (e & 15) * 4; const float4 y0 = *(const float4*)(Y + i * 64 + c4), y1 = *(const float4*)(Y + (S5C + i) * 64 + c4);
        *(u32x2*)(ZG + (size_t)(b * TZ + ct * S5C + i) * 256 + gq * 64 + c4) = pack4(gelu_tanh(y0.x + y1.x), gelu_tanh(y0.y + y1.y), gelu_tanh(y0.z + y1.z), gelu_tanh(y0.w + y1.w));
    }
}

DI void phase_small_gemms(const Ctx& c, int l) {
    unsigned char* ws = c.ws; unsigned char* wsm = ws + WS_WSM;
    const bf16_t* CQN = (const bf16_t*)(ws + WS_MISC + MS_CQN);
    const float* rope = (const float*)(wsm + OFF_ROPE);
    constexpr int NMT = NZ / 256;
    int base = 0;
    const int G = gridDim.x, bid = blockIdx.x;
    {
        const bf16_t* W = (const bf16_t*)(wsm + OFF_WUQT + l * SZ_WUQT); bf16_t* QM = (bf16_t*)(ws + WS_EXPW + MX_QM);
        const float qs = 0.10206207261596577f * LOG2E;
        for (int u = (bid + G - base % G) % G; u < NMT * 3; u += G) {
            const int mt = u / 3, nt = u % 3, r0 = mt * 256, c0 = nt * 128;
            gemm_tile<4, 0>(c, 256, [&](int i) { return CQN + (size_t)(r0 + i) * 384; }, [&](int i) { return W + (size_t)(c0 + i) * 256; }, NoHook(),
                [&](f32x4 (&acc)[4][4], int wr, int wc, int fr, int fq) {
#pragma unroll
                    for (int n = 0; n < 4; ++n) {
                        const int col = c0 + wc + n * 16 + fq * 4, h = col / 96, d = col % 96;
                        const bool rp = d >= 64;
#pragma unroll
                        for (int m = 0; m < 4; ++m) {
                            const int row = r0 + wr + m * 16 + fr, b = row / TZ, s = row % TZ; f32x4 v = acc[m][n];
                            f32x4 pv; pv[0] = __shfl_xor(v[0], 32, 64); pv[1] = __shfl_xor(v[1], 32, 64); pv[2] = __shfl_xor(v[2], 32, 64); pv[3] = __shfl_xor(v[3], 32, 64);
                            if (rp && s >= CTX) {
                                const int i0 = d - 64;
                                const float* cs = rope + ((size_t)(s - CTX) * 16 + (i0 >> 4) * 8 + (i0 & 7)) * 2;
                                const bool hi = (i0 & 8) != 0;
#pragma unroll
                                for (int j = 0; j < 4; ++j) v[j] = v[j] * cs[2 * j] + (hi ? pv[j] : -pv[j]) * cs[2 * j + 1];
                            }
                            *(u32x2*)(QM + ((size_t)(b * 4 + h) * TZ + s) * 96 + d) = pack4(v[0] * qs, v[1] * qs, v[2] * qs, v[3] * qs);
                        }
                    }
                });
        }
        base += NMT * 3;
    }
    {
        const bf16_t* W = (const bf16_t*)(wsm + OFF_WUKVT + l * SZ_WUKVT); bf16_t* KM = (bf16_t*)(ws + WS_EXPW + MX_KM); bf16_t* VMT = (bf16_t*)(ws + WS_EXPW + MX_VMT);
        for (int u = (bid + G - base % G) % G; u < NMT * 4; u += G) {
            const int mt = u / 4, nt = u % 4, r0 = mt * 256, c0 = nt * 128;
            gemm_tile<4, 0>(c, 128, [&](int i) { return CQN + (size_t)(r0 + i) * 384 + 256; }, [&](int i) { return W + (size_t)(c0 + i) * 128; }, NoHook(),
                [&](f32x4 (&acc)[4][4], int wr, int wc, int fr, int fq) {
#pragma unroll
                    for (int n = 0; n < 4; ++n) {
                        const int col = c0 + wc + n * 16 + fq * 4, h = col >> 7, d = col & 127;
#pragma unroll
                        for (int m = 0; m < 4; ++m) {
                            const int row = r0 + wr + m * 16 + fr, b = row / TZ, s = row % TZ; const f32x4 v = acc[m][n];
                            if (d < 64) *(u32x2*)(KM + ((size_t)(b * 4 + h) * TZ + s) * 96 + d) = pack4(v[0], v[1], v[2], v[3]);
                            else {
#pragma unroll
                                for (int j = 0; j < 4; ++j) VMT[((size_t)(b * 4 + h) * 64 + (d - 64 + j)) * TZ + s] = f2bf(v[j]);
                            }
                        }
                    }
                });
        }
        base += NMT * 4;
    }
    bf16_t* SE = (bf16_t*)(ws + WS_P + P_PR); bf16_t* SAD = SE + (size_t)2 * NZ * 256; bf16_t* SKD = SAD + (size_t)2 * NZ * 256;
    {
        const bf16_t* A = (const bf16_t*)(ws + WS_MISC + MS_TW); const bf16_t* W = (const bf16_t*)(wsm + OFF_W2T + l * SZ_W2T);
        const float* w0 = c.in[14] + (size_t)l * 512;
        for (int u = (bid + G - base % G) % G; u < NMT * 4; u += G) {
            const int mt = u / 4, nt = u % 4, r0 = mt * 256, c0 = nt * 128;
            gemm_tile<4, 0>(c, 64, [&](int i) { return A + (size_t)(r0 + i) * 64; }, [&](int i) { return W + (size_t)(c0 + i) * 64; }, NoHook(),
                [&](f32x4 (&acc)[4][4], int wr, int wc, int fr, int fq) {
#pragma unroll
                    for (int n = 0; n < 4; ++n) {
                        const int col = c0 + wc + n * 16 + fq * 4, d = col >> 8, cc = col & 255; const float4 w0v = *(const float4*)(w0 + col);
#pragma unroll
                        for (int m = 0; m < 4; ++m) {
                            const int row = r0 + wr + m * 16 + fr; const f32x4 v = acc[m][n]; float e[4];
                            const float x[4] = {w0v.x + v[0], w0v.y + v[1], w0v.z + v[2], w0v.w + v[3]};
#pragma unroll
                            for (int j = 0; j < 4; ++j) { const float sp = (x[j] < -20.f) ? -x[j] : log1pf(__expf(-x[j])); e[j] = __expf(-sp - 0.5f); }
                            *(u32x2*)(SE + ((size_t)d * NZ + row) * 256 + cc) = pack4(e[0], e[1], e[2], e[3]);
                        }
                    }
                });
        }
        base += NMT * 4;
    }
    {
        const bf16_t* A = (const bf16_t*)(ws + WS_MISC + MS_AL); const bf16_t* W = (const bf16_t*)(wsm + OFF_A2T + l * SZ_A2T);
        const float* a0 = c.in[16] + (size_t)l * 512; const float* k_a = c.in[20] + (size_t)l * 256; const bf16_t* KB = (const bf16_t*)(ws + WS_EXPW + MX_KB);
        for (int u = (bid + G - base % G) % G; u < NMT * 4; u += G) {
            const int mt = u / 4, nt = u % 4, r0 = mt * 256, c0 = nt * 128;
            gemm_tile<4, 0>(c, 64, [&](int i) { return A + (size_t)(r0 + i) * 64; }, [&](int i) { return W + (size_t)(c0 + i) * 64; }, NoHook(),
                [&](f32x4 (&acc)[4][4], int wr, int wc, int fr, int fq) {
#pragma unroll
                    for (int n = 0; n < 4; ++n) {
                        const int col = c0 + wc + n * 16 + fq * 4, d = col >> 8, cc = col & 255; const float4 a0v = *(const float4*)(a0 + col), kav = *(const float4*)(k_a + cc);
#pragma unroll
                        for (int m = 0; m < 4; ++m) {
                            const int row = r0 + wr + m * 16 + fr; const f32x4 v = acc[m][n];
                            const float ad0 = sigmoidf_(a0v.x + v[0]), ad1 = sigmoidf_(a0v.y + v[1]), ad2 = sigmoidf_(a0v.z + v[2]), ad3 = sigmoidf_(a0v.w + v[3]);
                            float k[4]; unpack4(*(const u32x2*)(KB + (size_t)row * 256 + cc), k);
                            *(u32x2*)(SAD + ((size_t)d * NZ + row) * 256 + cc) = pack4(ad0, ad1, ad2, ad3);
                            *(u32x2*)(SKD + ((size_t)d * NZ + row) * 256 + cc) = pack4(k[0] * (1.f + (ad0 - 1.f) * kav.x), k[1] * (1.f + (ad1 - 1.f) * kav.y), k[2] * (1.f + (ad2 - 1.f) * kav.z), k[3] * (1.f + (ad3 - 1.f) * kav.w));
                        }
                    }
                });
        }
        base += NMT * 4;
    }
    {
        const bf16_t* A = (const bf16_t*)(ws + WS_MISC + MS_SG); const bf16_t* W = (const bf16_t*)(wsm + OFF_G2T + l * SZ_G2T); bf16_t* GG = (bf16_t*)(ws + WS_MISC + MS_GG);
        for (int u = (bid + G - base % G) % G; u < NMT * 2; u += G) {
            const int mt = u / 2, nt = u % 2, r0 = mt * 256, c0 = nt * 128;
            gemm_tile<4, 0>(c, 128, [&](int i) { return A + (size_t)(r0 + i) * 128; }, [&](int i) { return W + (size_t)(c0 + i) * 128; }, NoHook(),
                [&](f32x4 (&acc)[4][4], int wr, int wc, int fr, int fq) {
#pragma unroll
                    for (int n = 0; n < 4; ++n)
#pragma unroll
                        for (int m = 0; m < 4; ++m) { const f32x4 v = acc[m][n];
                            *(u32x2*)(GG + (size_t)(r0 + wr + m * 16 + fr) * 256 + c0 + wc + n * 16 + fq * 4) = pack4(v[0], v[1], v[2], v[3]); }
                });
        }
        base += NMT * 2;
    }
}

DI int krow(int s, int h, int j) { return 16 * s + 8 * (j >> 2) + 4 * h + (j & 3); }
constexpr int ATT_PARK = 48 * 1024;
template <int MODE>
DI void attn_pass(const Ctx& c, int l, int b, int h, int q0, int nkeys) {
    constexpr int DROW = MODE == 0 ? 96 : 64;
    constexpr int DQ = MODE == 0 ? 96 : 32, KS = DQ / 16;
    constexpr int DOFF = MODE == 2 ? 32 : 0;
    constexpr int KPITCH = DQ * 2 + 16;
    constexpr int VPITCH = 64 * 2 + 16;
    constexpr int KBYTES = 64 * KPITCH, VBYTES = 64 * VPITCH, STG = KBYTES + VBYTES;
    unsigned char* ws = c.ws; const int tid = c.tid, lane = c.lane, wave = c.wave, r = lane & 31, hh = lane >> 5;
    const bf16_t* Q = (const bf16_t*)(ws + WS_EXPW + (MODE == 0 ? MX_QM : MX_QD)) + (size_t)(b * 4 + h) * TZ * DROW + DOFF;
    const bf16_t* Kp = (const bf16_t*)(ws + WS_EXPW + (MODE == 0 ? MX_KM : MX_KD)) + (size_t)(b * 4 + h) * TZ * DROW + DOFF;
    const bf16_t* Vt = (const bf16_t*)(ws + WS_EXPW + (MODE == 0 ? MX_VMT : MX_VDT)) + (size_t)(b * 4 + h) * 64 * TZ;
    unsigned char* smem = c.smem;
    bf16x8 qf[KS];
    const int qrow = q0 + wave * 32 + r;
#pragma unroll
    for (int ks = 0; ks < KS; ++ks) qf[ks] = *(const bf16x8*)(Q + (size_t)qrow * DROW + ks * 16 + hh * 8);
    f32x16 oacc[2];
    float mrun = -1e30f, lrun = 0.f;
#pragma unroll
    for (int t = 0; t < 2; ++t)
#pragma unroll
        for (int i = 0; i < 16; ++i) oacc[t][i] = 0.f;
    constexpr int CPR = DQ / 8, KCH = 64 * CPR;
    u32x4 kreg[2], vreg;
    auto gload = [&](int kt) {
        const int k0 = kt * 64;
#pragma unroll
        for (int i = 0; i < 2; ++i) { const int ch = tid + i * NTHR; if (ch < KCH) kreg[i] = *(const u32x4*)(Kp + (size_t)(k0 + ch / CPR) * DROW + (ch % CPR) * 8); }
        vreg = *(const u32x4*)(Vt + (size_t)(tid >> 3) * TZ + k0 + (tid & 7) * 8);
    };
    auto lstore = [&](int buf) {
        unsigned char* sk = smem + buf * STG; unsigned char* sv = sk + KBYTES;
#pragma unroll
        for (int i = 0; i < 2; ++i) { const int ch = tid + i * NTHR; if (ch < KCH) *(u32x4*)(sk + (ch / CPR) * KPITCH + (ch % CPR) * 16) = kreg[i]; }
        *(u32x4*)(sv + (tid >> 3) * VPITCH + (tid & 7) * 16) = vreg;
    };
    const int NT = nkeys / 64;
    __syncthreads();
    gload(0);
    for (int kt = 0; kt < NT; ++kt) {
        lstore(kt & 1);
        if (kt + 1 < NT) gload(kt + 1);
        __syncthreads();
        const unsigned char* sk = smem + (kt & 1) * STG; const unsigned char* sv = sk + KBYTES;
        f32x16 sacc[2];
#pragma unroll
        for (int kg = 0; kg < 2; ++kg) {
#pragma unroll
            for (int i = 0; i < 16; ++i) sacc[kg][i] = 0.f;
#pragma unroll
            for (int ks = 0; ks < KS; ++ks) {
                const bf16x8 kf = *(const bf16x8*)(sk + (kg * 32 + r) * KPITCH + ks * 32 + hh * 16);
                sacc[kg] = __builtin_amdgcn_mfma_f32_32x32x16_bf16(kf, qf[ks], sacc[kg], 0, 0, 0);
            }
        }
        float mx = sacc[0][0];
#pragma unroll
        for (int kg = 0; kg < 2; ++kg)
#pragma unroll
            for (int i = 0; i < 16; ++i) mx = fmaxf(mx, sacc[kg][i]);
        mx = fmaxf(mx, __shfl_xor(mx, 32, 64));
        const float mnew = fmaxf(mrun, mx), alpha = __builtin_amdgcn_exp2f(mrun - mnew);
        mrun = mnew;
        float psum = 0.f;
#pragma unroll
        for (int kg = 0; kg < 2; ++kg)
#pragma unroll
            for (int i = 0; i < 16; ++i) { const float p = __builtin_amdgcn_exp2f(sacc[kg][i] - mnew); sacc[kg][i] = p; psum += p; }
        lrun = lrun * alpha + psum;
#pragma unroll
        for (int t = 0; t < 2; ++t)
#pragma unroll
            for (int i = 0; i < 16; ++i) oacc[t][i] *= alpha;
#pragma unroll
        for (int kg = 0; kg < 2; ++kg)
#pragma unroll
            for (int s = 0; s < 2; ++s) {
                u32x4 pk; pk.x = pack2(sacc[kg][8 * s + 0], sacc[kg][8 * s + 1]); pk.y = pack2(sacc[kg][8 * s + 2], sacc[kg][8 * s + 3]);
                pk.z = pack2(sacc[kg][8 * s + 4], sacc[kg][8 * s + 5]); pk.w = pack2(sacc[kg][8 * s + 6], sacc[kg][8 * s + 7]);
                const bf16x8 pf = __builtin_bit_cast(bf16x8, pk);
#pragma unroll
                for (int t = 0; t < 2; ++t) {
                    const unsigned char* vrow = sv + (t * 32 + r) * VPITCH + (kg * 32 + 16 * s + 4 * hh) * 2;
                    const u32x2 lo = *(const u32x2*)vrow, hi2 = *(const u32x2*)(vrow + 16);
                    u32x4 vv; vv.x = lo.x; vv.y = lo.y; vv.z = hi2.x; vv.w = hi2.y;
                    oacc[t] = __builtin_amdgcn_mfma_f32_32x32x16_bf16(__builtin_bit_cast(bf16x8, vv), pf, oacc[t], 0, 0, 0);
                }
            }
    }
    const float inv = 1.f / (lrun + __shfl_xor(lrun, 32, 64));
    bf16_t* Ycat = (bf16_t*)(ws + WS_BUFA);
    const int zrow = b * TZ + qrow;
    float* park = (float*)(smem + ATT_PARK) + tid;
    if (MODE == 0) {
#pragma unroll
        for (int t = 0; t < 2; ++t)
#pragma unroll
            for (int i4 = 0; i4 < 4; ++i4) {
                const int dv = t * 32 + 8 * i4 + 4 * hh;
                *(u32x2*)(Ycat + (size_t)zrow * D + h * 64 + dv) = pack4(oacc[t][4 * i4] * inv, oacc[t][4 * i4 + 1] * inv, oacc[t][4 * i4 + 2] * inv, oacc[t][4 * i4 + 3] * inv);
            }
    } else if (MODE == 1) {
#pragma unroll
        for (int t = 0; t < 2; ++t)
#pragma unroll
            for (int i = 0; i < 16; ++i) park[(t * 16 + i) * NTHR] = oacc[t][i] * inv;
    } else {
        const float lam = ((const float*)(ws + WS_WSM + OFF_LAM))[l];
        const float lam_init = 0.8f - 0.6f * __expf(-0.3f * (float)l);
        float ss = 0.f;
#pragma unroll
        for (int t = 0; t < 2; ++t)
#pragma unroll
            for (int i = 0; i < 16; ++i) { const float o = park[(t * 16 + i) * NTHR] - lam * oacc[t][i] * inv; oacc[t][i] = o; ss += o * o; }
        ss += __shfl_xor(ss, 32, 64);
        const float rs = rsqrtf(ss * (1.f / 64.f) + 1e-5f) * (1.f - lam_init);
        const float* sg = c.in[38] + l * 64;
#pragma unroll
        for (int t = 0; t < 2; ++t)
#pragma unroll
            for (int i4 = 0; i4 < 4; ++i4) {
                const int dv = t * 32 + 8 * i4 + 4 * hh; const float4 g = *(const float4*)(sg + dv);
                *(u32x2*)(Ycat + (size_t)zrow * D + 768 + h * 64 + dv) = pack4(oacc[t][4 * i4] * rs * g.x, oacc[t][4 * i4 + 1] * rs * g.y, oacc[t][4 * i4 + 2] * rs * g.z, oacc[t][4 * i4 + 3] * rs * g.w);
            }
    }
}
DI void phase_attention(const Ctx& c, int l) {
    const int nu = 512 + (l == 0 ? 16 : 0);
    for (int u = blockIdx.x; u < nu; u += gridDim.x) {
        int b, h, q0, nk; bool mla;
        if (u < 512) { const int k = u & 255; b = k >> 7; h = (k >> 5) & 3; q0 = CTX + (k & 31) * 256; nk = TZ; mla = u < 256; }
        else { const int k = u - 512; b = (k >> 2) & 1; h = k & 3; q0 = 0; nk = CTX; mla = k < 8; }
        if (mla) attn_pass<0>(c, l, b, h, q0, nk);
        else { attn_pass<1>(c, l, b, h, q0, nk); attn_pass<2>(c, l, b, h, q0, nk); }
    }
}

DI int rw_tok(int dir, int i) { return dir == 0 ? i : (i < CTX ? CTX - 1 - i : TZ - 1 - (i - CTX)); }
constexpr int RW_TS = 16;
constexpr int RW_STEP_F = 6 * 64 + 2;
constexpr int RW_BUF_F = RW_TS * RW_STEP_F;
DI void rw_stage(const Ctx& c, int l, int b, int h, int dir, int chunk, float* buf, int sw  ) {
    const bf16_t* RB = (const bf16_t*)(c.ws + WS_EXPW + MX_RB); const bf16_t* VB = (const bf16_t*)(c.ws + WS_EXPW + MX_VB); const bf16_t* KKB = (const bf16_t*)(c.ws + WS_EXPW + MX_KKB);
    const bf16_t* SE = (const bf16_t*)(c.ws + WS_P + P_PR) + (size_t)dir * NZ * 256; const bf16_t* SAD = SE + (size_t)2 * NZ * 256; const bf16_t* SKD = SAD + (size_t)2 * NZ * 256;
    const int k = c.lane;
    for (int st = sw; st < RW_TS; st += 4) {
        const int i = chunk * RW_TS + st, z = b * TZ + rw_tok(dir, i); const size_t o = (size_t)z * 256 + h * 64 + k;
        const float r = bf2f(RB[o]), v = bf2f(VB[o]), kk = bf2f(KKB[o]), e = bf2f(SE[o]), ad = bf2f(SAD[o]), kd = bf2f(SKD[o]);
        const float w = __expf(-e), bv = kk * ad;
        float* f = buf + st * RW_STEP_F;
        f[k] = w; f[64 + k] = kk; f[128 + k] = bv; f[192 + k] = kd; f[256 + k] = w * r; f[320 + k] = v;
        const float br = wave_sum(bv * r), kr = wave_sum(kd * r);
        if (k == 0) { f[384] = br; f[385] = kr; }
    }
}
template <int CTRL> DI float dpp_add(float x) { return x + __int_as_float(__builtin_amdgcn_update_dpp(0, __float_as_int(x), CTRL, 0xf, 0xf, false)); }
DI float red16(float x) { x = dpp_add<0xB1>(x); x = dpp_add<0x4E>(x); x = dpp_add<0x141>(x); x = dpp_add<0x140>(x); return x; }
DI void phase_rwkv_scan_unit(const Ctx& c, int l, int u) {
    const int rg = u & 3, chain = u >> 2, dir = chain & 1, h = (chain >> 1) & 3, b = chain >> 3;
    float* buf0 = (float*)c.smem; float* buf1 = buf0 + RW_BUF_F;
    float* YO = (float*)(c.ws + WS_BUFB) + (size_t)dir * NZ * 256;
    const int wave = c.wave, lane = c.lane, rr = lane >> 4, kq = lane & 15, row = rg * 16 + (wave & 3) * 4 + rr;
    float S0 = 0.f, S1 = 0.f, S2 = 0.f, S3 = 0.f;
    constexpr int NCH = TZ / RW_TS;
    __syncthreads();
    if (wave >= 4) rw_stage(c, l, b, h, dir, 0, buf0, wave - 4);
    __syncthreads();
    for (int ch = 0; ch < NCH; ++ch) {
        float* cur = (ch & 1) ? buf1 : buf0; float* nxt = (ch & 1) ? buf0 : buf1;
        if (wave >= 4) { if (ch + 1 < NCH) rw_stage(c, l, b, h, dir, ch + 1, nxt, wave - 4); }
        else {
            for (int st = 0; st < RW_TS; ++st) {
                const float* f = cur + st * RW_STEP_F;
                const float4 w = *(const float4*)(f + kq * 4), kk = *(const float4*)(f + 64 + kq * 4), bv = *(const float4*)(f + 128 + kq * 4),
                             kd = *(const float4*)(f + 192 + kq * 4), wr = *(const float4*)(f + 256 + kq * 4);
                const float vv = f[320 + row], br = f[384], kr = f[385];
                float sa = -(S0 * kk.x + S1 * kk.y + S2 * kk.z + S3 * kk.w);
                float q = S0 * wr.x + S1 * wr.y + S2 * wr.z + S3 * wr.w;
                sa = red16(sa); q = red16(q);
                S0 = S0 * w.x + sa * bv.x + vv * kd.x; S1 = S1 * w.y + sa * bv.y + vv * kd.y;
                S2 = S2 * w.z + sa * bv.z + vv * kd.z; S3 = S3 * w.w + sa * bv.w + vv * kd.w;
                if (kq == 0) {
                    const int z = b * TZ + rw_tok(dir, ch * RW_TS + st);
                    YO[(size_t)z * 256 + h * 64 + row] = q + sa * br + vv * kr;
                }
            }
        }
        __syncthreads();
    }
}

DI void phase_mixers2(const Ctx& c, int l) {
    const int G = gridDim.x, bid = blockIdx.x;
    if (G >= 128) {
        if (bid < 64) phase_rwkv_scan_unit(c, l, bid);
        else for (int u = bid - 64; u < 2 * S5N * 4; u += G - 64) phase_s5_final_unit(c, l, u);
    } else {
        for (int u = bid; u < 64; u += G) phase_rwkv_scan_unit(c, l, u);
        for (int u = bid; u < 2 * S5N * 4; u += G) phase_s5_final_unit(c, l, u);
    }
}

DI void phase_post(const Ctx& c, int l) {
    unsigned char* ws = c.ws; const int lane = c.lane;
    const float* YF = (const float*)(ws + WS_BUFB); const float* YB = YF + (size_t)NZ * 256;
    const bf16_t* RB = (const bf16_t*)(ws + WS_EXPW + MX_RB); const bf16_t* VB = (const bf16_t*)(ws + WS_EXPW + MX_VB);
    const bf16_t* SKD = (const bf16_t*)(ws + WS_P + P_PR) + (size_t)4 * NZ * 256; const bf16_t* GG = (const bf16_t*)(ws + WS_MISC + MS_GG);
    bf16_t* Ycat = (bf16_t*)(ws + WS_BUFA);
    const float* r_k = c.in[21] + l * 256; const float* lg = c.in[22] + l * 256; const float* lb = c.in[23] + l * 256;
    for (int z = blockIdx.x * 8 + c.wave; z < NZ; z += gridDim.x * 8) {
        const size_t o = (size_t)z * 256 + lane * 4;
        const float4 yf = *(const float4*)(YF + o), yb = *(const float4*)(YB + o);
        const float y0 = yf.x + yb.x, y1 = yf.y + yb.y, y2 = yf.z + yb.z, y3 = yf.w + yb.w;
        const float mean = sum16(y0 + y1 + y2 + y3) * (1.f / 64.f);
        const float d0 = y0 - mean, d1 = y1 - mean, d2 = y2 - mean, d3 = y3 - mean;
        const float var = sum16(d0 * d0 + d1 * d1 + d2 * d2 + d3 * d3) * (1.f / 64.f);
        const float rs = rsqrtf(var + 64e-5f);
        float r[4], v[4], k0[4], k1[4], gg[4];
        unpack4(*(const u32x2*)(RB + o), r); unpack4(*(const u32x2*)(VB + o), v); unpack4(*(const u32x2*)(SKD + o), k0); unpack4(*(const u32x2*)(SKD + (size_t)NZ * 256 + o), k1);
        unpack4(*(const u32x2*)(GG + o), gg);
        const float4 rk = *(const float4*)(r_k + lane * 4), g4 = *(const float4*)(lg + lane * 4), b4 = *(const float4*)(lb + lane * 4);
        const float bs = sum16(r[0] * (k0[0] + k1[0]) * rk.x + r[1] * (k0[1] + k1[1]) * rk.y + r[2] * (k0[2] + k1[2]) * rk.z + r[3] * (k0[3] + k1[3]) * rk.w);
        *(u32x2*)(Ycat + (size_t)z * D + 256 + lane * 4) = pack4((d0 * rs * g4.x + b4.x + bs * v[0]) * gg[0], (d1 * rs * g4.y + b4.y + bs * v[1]) * gg[1],
                                                                (d2 * rs * g4.z + b4.z + bs * v[2]) * gg[2], (d3 * rs * g4.w + b4.w + bs * v[3]) * gg[3]);
    }
    {
        const bf16_t* ZG = (const bf16_t*)(ws + WS_MISC + MS_ZG); const bf16_t* W = (const bf16_t*)(ws + WS_WSM + OFF_GLUT + l * SZ_GLUT);
        const float* gb = c.in[33] + l * 256;
        for (int u = blockIdx.x; u < (NZ / 256) * 2; u += gridDim.x) {
            const int mt = u / 2, nt = u % 2, r0 = mt * 256, c0 = nt * 128;
            gemm_tile<4, 0>(c, 256, [&](int i) { return ZG + (size_t)(r0 + i) * 256; }, [&](int i) { return W + (size_t)(c0 + i) * 256; }, NoHook(),
                [&](f32x4 (&acc)[4][4], int wr, int wc, int fr, int fq) {
#pragma unroll
                    for (int n = 0; n < 4; ++n) {
                        const int col = c0 + wc + n * 16 + fq * 4; const float4 bb = *(const float4*)(gb + col);
#pragma unroll
                        for (int m = 0; m < 4; ++m) {
                            const int row = r0 + wr + m * 16 + fr; const f32x4 v = acc[m][n];
                            float zg[4]; unpack4(*(const u32x2*)(ZG + (size_t)row * 256 + col), zg);
                            *(u32x2*)(Ycat + (size_t)row * D + 512 + col) = pack4(zg[0] * sigmoidf_(v[0] + bb.x), zg[1] * sigmoidf_(v[1] + bb.y), zg[2] * sigmoidf_(v[2] + bb.z), zg[3] * sigmoidf_(v[3] + bb.w));
                        }
                    }
                });
        }
    }
}

DI bool skip_mt(int l, int mt) { return l == NL - 1 && (mt % 33) == 0; }
DI void phase_merge1(const Ctx& c, int l) {
    const bf16_t* Ycat = (const bf16_t*)(c.ws + WS_BUFA); const bf16_t* W = (const bf16_t*)(c.ws + WS_WSM + OFF_WBT + l * SZ_WBT);
    const bf16_t* GT = (const bf16_t*)(c.ws + WS_GT); bf16_t* MG = (bf16_t*)(c.ws + WS_BUFB);
    if (blockIdx.x == 0 && c.tid < 32) ((unsigned*)(c.ws + WS_CTL))[CW_CNT + l * 32 + c.tid] = 0u;
    for (int u = blockIdx.x; u < (NZ / 256) * 8; u += gridDim.x) {
        const int mt = u / 8, nt = u % 8, r0 = mt * 256, c0 = nt * 128;
        if (skip_mt(l, mt)) continue;
        f32x4 macc[4][4];
#pragma unroll
        for (int m = 0; m < 4; ++m)
#pragma unroll
            for (int n = 0; n < 4; ++n) macc[m][n] = (f32x4){0.f, 0.f, 0.f, 0.f};
        gemm_tile<4, 256>(c, 1024, [&](int i) { return Ycat + (size_t)(r0 + i) * D; }, [&](int i) { return W + (size_t)(c0 + i) * D; },
            [&](f32x4 (&acc)[4][4], int seg, int wr, int wc, int fr, int fq) {
#pragma unroll
                for (int m = 0; m < 4; ++m)
#pragma unroll
                    for (int n = 0; n < 4; ++n) {
                        float g[4]; unpack4(*(const u32x2*)(GT + (size_t)(r0 + wr + m * 16 + fr) * 4096 + seg * 1024 + c0 + wc + n * 16 + fq * 4), g);
                        macc[m][n][0] += g[0] * acc[m][n][0]; macc[m][n][1] += g[1] * acc[m][n][1]; macc[m][n][2] += g[2] * acc[m][n][2]; macc[m][n][3] += g[3] * acc[m][n][3];
                        acc[m][n] = (f32x4){0.f, 0.f, 0.f, 0.f};
                    }
            },
            [&](f32x4 (&)[4][4], int wr, int wc, int fr, int fq) {
#pragma unroll
                for (int m = 0; m < 4; ++m)
#pragma unroll
                    for (int n = 0; n < 4; ++n)
                        *(u32x2*)(MG + (size_t)(r0 + wr + m * 16 + fr) * D + c0 + wc + n * 16 + fq * 4) = pack4(macc[m][n][0], macc[m][n][1], macc[m][n][2], macc[m][n][3]);
            });
    }
}
DI void phase_merge2(const Ctx& c, int l) {
    const bf16_t* MG = (const bf16_t*)(c.ws + WS_BUFB); const bf16_t* W = (const bf16_t*)(c.ws + WS_WSM + OFF_WOUTT + l * SZ_WOUTT);
    float* H = (float*)(c.ws + WS_H); const float* modv = (const float*)(c.ws + WS_WSM + OFF_MODV);
    for (int u = blockIdx.x; u < (NZ / 256) * 8; u += gridDim.x) {
        const int mt = u / 8, nt = u % 8, r0 = mt * 256, c0 = nt * 128;
        if (skip_mt(l, mt)) continue;
        const int sel = (mt % 33) == 0 ? 2 : mt / 33;
        gemm_tile<4, 0>(c, 1024, [&](int i) { return MG + (size_t)(r0 + i) * D; }, [&](int i) { return W + (size_t)(c0 + i) * D; }, NoHook(),
            [&](f32x4 (&acc)[4][4], int wr, int wc, int fr, int fq) {
#pragma unroll
                for (int n = 0; n < 4; ++n) {
                    const int col = c0 + wc + n * 16 + fq * 4; const float4 m2 = *(const float4*)(modv + ((size_t)l * 3 + sel) * 6144 + 2 * 1024 + col);
#pragma unroll
                    for (int m = 0; m < 4; ++m) {
                        float4* hp = (float4*)(H + (size_t)(r0 + wr + m * 16 + fr) * D + col); float4 hv = *hp; const f32x4 v = acc[m][n];
                        hv.x += m2.x * v[0]; hv.y += m2.y * v[1]; hv.z += m2.z * v[2]; hv.w += m2.w * v[3]; *hp = hv;
                    }
                }
            });
    }
}

DI void phase_norm2_route(const Ctx& c, int l) {
    unsigned char* ws = c.ws; const int lane = c.lane;
    {
        float4* Y = (float4*)(ws + WS_P); const size_t n = (size_t)NZ * 256;
        for (size_t i = (size_t)blockIdx.x * NTHR + c.tid; i < n; i += (size_t)gridDim.x * NTHR) Y[i] = make_float4(0.f, 0.f, 0.f, 0.f);
    }
    const float* modv = (const float*)(ws + WS_WSM + OFF_MODV); const float* H = (const float*)(ws + WS_H);
    bf16_t* XN = (bf16_t*)(ws + WS_BUFA); const float* g2 = c.in[7] + l * 1024;
    const float* rwt = (const float*)(ws + WS_WSM + OFF_RWT) + (size_t)l * 36 * 1024;
    const float* bg = c.in[42] + l * 4; const float* be = c.in[44] + l * 32;
    unsigned* cnt = (unsigned*)(ws + WS_CTL) + CW_CNT + l * 32;
    int* list = (int*)(ws + WS_GT + GT_LIST); float* lw = (float*)(ws + WS_GT + GT_LW);
    for (int row = blockIdx.x * 8 + c.wave; row < NZ; row += gridDim.x * 8) {
        const int b = row / TZ, s = row % TZ, sel = s < CTX ? 2 : b;
        if (l == NL - 1 && s < CTX) continue;
        float x[16]; float ss = 0.f;
#pragma unroll
        for (int q = 0; q < 4; ++q) { const float4 v = *(const float4*)(H + (size_t)row * D + q * 256 + lane * 4); x[q * 4] = v.x; x[q * 4 + 1] = v.y; x[q * 4 + 2] = v.z; x[q * 4 + 3] = v.w;
            ss += v.x * v.x + v.y * v.y + v.z * v.z + v.w * v.w; }
        ss = wave_sum(ss);
        const float rs = rsqrtf(ss * (1.f / 1024.f) + 1e-6f);
#pragma unroll
        for (int q = 0; q < 4; ++q) {
            const int col = q * 256 + lane * 4;
            const float4 g = *(const float4*)(g2 + col), m3 = *(const float4*)(modv + ((size_t)l * 3 + sel) * 6144 + 3 * 1024 + col), m4 = *(const float4*)(modv + ((size_t)l * 3 + sel) * 6144 + 4 * 1024 + col);
            x[q * 4] = x[q * 4] * rs * g.x * (1.f + m4.x) + m3.x; x[q * 4 + 1] = x[q * 4 + 1] * rs * g.y * (1.f + m4.y) + m3.y;
            x[q * 4 + 2] = x[q * 4 + 2] * rs * g.z * (1.f + m4.z) + m3.z; x[q * 4 + 3] = x[q * 4 + 3] * rs * g.w * (1.f + m4.w) + m3.w;
            *(u32x2*)(XN + (size_t)row * D + col) = pack4(x[q * 4], x[q * 4 + 1], x[q * 4 + 2], x[q * 4 + 3]);
        }
        volatile float* wl = (volatile float*)(c.smem) + c.wave * 64;
#pragma unroll 1
        for (int e = 0; e < 36; ++e) {
            float a = 0.f;
#pragma unroll
            for (int q = 0; q < 4; ++q) { const float4 w = *(const float4*)(rwt + (size_t)e * 1024 + q * 256 + lane * 4); a += x[q * 4] * w.x + x[q * 4 + 1] * w.y + x[q * 4 + 2] * w.z + x[q * 4 + 3] * w.w; }
            a = wave_sum(a) + (e < 4 ? bg[e] : be[e - 4]);
            if (lane == 0) wl[e] = a;
        }
        __builtin_amdgcn_wave_barrier();
        float lg[36];
#pragma unroll
        for (int e = 0; e < 36; ++e) lg[e] = wl[e];
        __builtin_amdgcn_wave_barrier();
        float gl[4]; float gm = -1e30f;
#pragma unroll
        for (int g = 0; g < 4; ++g) { gl[g] = lg[g]; gm = fmaxf(gm, gl[g]); }
        float gs = 0.f; int gsel = 0; float gbest = -1e30f;
#pragma unroll
        for (int g = 0; g < 4; ++g) { gs += __expf(gl[g] - gm); if (gl[g] > gbest) { gbest = gl[g]; gsel = g; } }
        const float pg = __expf(gbest - gm) / gs;
        float l1 = -1e30f, l2 = -1e30f; int e1 = 0, e2 = 0;
#pragma unroll
        for (int e = 0; e < 32; ++e) {
            const float v = lg[4 + e];
            if ((e >> 3) == gsel) {
                if (v > l1) { l2 = l1; e2 = e1; l1 = v; e1 = e; }
                else if (v > l2) { l2 = v; e2 = e; }
            }
        }
        const float t = __expf(l2 - l1), w1 = pg / (1.f + t), w2 = pg * t / (1.f + t);
        if (lane == 0) {
            const unsigned p1 = atomicAdd(&cnt[e1], 1u); list[(size_t)e1 * MOE_CAP + p1] = row; lw[(size_t)e1 * MOE_CAP + p1] = w1;
            const unsigned p2 = atomicAdd(&cnt[e2], 1u); list[(size_t)e2 * MOE_CAP + p2] = row; lw[(size_t)e2 * MOE_CAP + p2] = w2;
        }
    }
    phase_expert_convert(c, l);
}

DI void moe_prefix(const Ctx& c, int l, int* tiles  , int* cnts  ) {
    __syncthreads();
    if (c.tid == 0) {
        const unsigned* cnt = (const unsigned*)(c.ws + WS_CTL) + CW_CNT + l * 32; int acc = 0;
        for (int e = 0; e < 32; ++e) { const int n = (int)__hip_atomic_load(cnt + e, __ATOMIC_RELAXED, __HIP_MEMORY_SCOPE_AGENT); cnts[e] = n; tiles[e] = acc; acc += (n + 127) / 128; }
        tiles[32] = acc;
    }
    __syncthreads();
}
DI void phase_moe1(const Ctx& c, int l) {
    unsigned char* ws = c.ws;
    int* tiles = (int*)(c.smem + 120 * 1024); int* cnts = tiles + 40;
    moe_prefix(c, l, tiles, cnts);
    const bf16_t* XN = (const bf16_t*)(ws + WS_BUFA); bf16_t* HM = (bf16_t*)(ws + WS_GT + GT_HM); const int* list = (const int*)(ws + WS_GT + GT_LIST);
    const int nt_total = tiles[32];
    for (int u = blockIdx.x; u < nt_total * 4; u += gridDim.x) {
        const int mtg = u >> 2, nt = u & 3;
        int e = 0;
        for (int k = 1; k < 32; ++k) if (tiles[k] <= mtg) e = k;
        const int mt = mtg - tiles[e], n_e = cnts[e];
        const int* le = list + (size_t)e * MOE_CAP;
        const bf16_t* W = (const bf16_t*)(ws + WS_EXPW + (size_t)e * SZ_WGU);
        gemm_tile<2, 0>(c, 1024,
            [&](int i) { int p = mt * 128 + i; if (p >= n_e) p = n_e - 1; return XN + (size_t)le[p] * D; },
            [&](int i) { return W + (size_t)(nt * 256 + i) * D; }, NoHook(),
            [&](f32x4 (&acc)[4][4], int wr, int wc, int fr, int fq) {
#pragma unroll
                for (int np = 0; np < 2; ++np) {
                    const int hc = (nt * 256 + wc + np * 32) / 2 + fq * 4;
#pragma unroll
                    for (int m = 0; m < 4; ++m) {
                        const int p = mt * 128 + wr + m * 16 + fr;
                        const f32x4 g = acc[m][np * 2], uu = acc[m][np * 2 + 1];
                        *(u32x2*)(HM + ((size_t)mtg * 128 + wr + m * 16 + fr) * 512 + hc) = pack4(siluf_(g[0]) * uu[0], siluf_(g[1]) * uu[1], siluf_(g[2]) * uu[2], siluf_(g[3]) * uu[3]);
                        (void)p;
                    }
                }
            });
    }
}
DI void phase_moe2(const Ctx& c, int l) {
    unsigned char* ws = c.ws;
    int* tiles = (int*)(c.smem + 120 * 1024); int* cnts = tiles + 40;
    moe_prefix(c, l, tiles, cnts);
    const bf16_t* HM = (const bf16_t*)(ws + WS_GT + GT_HM); const int* list = (const int*)(ws + WS_GT + GT_LIST); const float* lw = (const float*)(ws + WS_GT + GT_LW);
    float* Y = (float*)(ws + WS_P);
    const int nt_total = tiles[32];
    for (int u = blockIdx.x; u < nt_total * 4; u += gridDim.x) {
        const int mtg = u >> 2, nt = u & 3;
        int e = 0;
        for (int k = 1; k < 32; ++k) if (tiles[k] <= mtg) e = k;
        const int mt = mtg - tiles[e], n_e = cnts[e];
        const int* le = list + (size_t)e * MOE_CAP; const float* lwe = lw + (size_t)e * MOE_CAP;
        const bf16_t* W = (const bf16_t*)(ws + WS_EXPW + 32 * SZ_WGU + (size_t)e * SZ_WD);
        gemm_tile<2, 0>(c, 512,
            [&](int i) { return HM + ((size_t)mtg * 128 + i) * 512; },
            [&](int i) { return W + (size_t)(nt * 256 + i) * 512; }, NoHook(),
            [&](f32x4 (&acc)[4][4], int wr, int wc, int fr, int fq) {
#pragma unroll
                for (int m = 0; m < 4; ++m) {
                    const int p = mt * 128 + wr + m * 16 + fr;
                    if (p < n_e) {
                        const int tok = le[p]; const float wt = lwe[p];
#pragma unroll
                        for (int n = 0; n < 4; ++n) {
                            float* yp = Y + (size_t)tok * D + nt * 256 + wc + n * 16 + fq * 4;
                            atomicAdd(yp, wt * acc[m][n][0]); atomicAdd(yp + 1, wt * acc[m][n][1]); atomicAdd(yp + 2, wt * acc[m][n][2]); atomicAdd(yp + 3, wt * acc[m][n][3]);
                        }
                    }
                }
            });
    }
}

constexpr int LDS_BYTES = 128 * 1024;
constexpr int STEPS_PER_LAYER = 12, N_STEPS = 2 + NL * STEPS_PER_LAYER;
#ifndef FUSED
#define FUSED 1
#endif

DI const void* launder_ptr(const void* p) {
    const unsigned long long v = (unsigned long long)p;
    unsigned lo = __builtin_amdgcn_readfirstlane((unsigned)v), hi = __builtin_amdgcn_readfirstlane((unsigned)(v >> 32));
    asm volatile("" : "+s"(lo), "+s"(hi) :: "memory");
    return (const void*)(((unsigned long long)hi << 32) | lo);
}
template <int KIND> DI void run_step(const Ctx& c0, int l) {
#ifdef PHM
    if (!((PHM >> KIND) & 1)) return;
#endif
    Ctx c = c0;
    { int z = 0; asm volatile("" : "+s"(z) :: "memory"); c.in = c0.in + z; c.ws = c0.ws + z; c.out = c0.out + z; }
    { int t = c0.tid; asm volatile("" : "+v"(t)); c.tid = t; c.lane = t & 63; c.wave = __builtin_amdgcn_readfirstlane(t >> 6); }
    if (KIND == 0) phase_prologue(c);
    if (KIND == 1) phase_norm1(c, l);
    if (KIND == 2) phase_inproj(c, l);
    if (KIND == 3) { phase_prep(c, l); phase_s5_local(c, l); }
    if (KIND == 4) { phase_small_gemms(c, l); phase_s5_carry(c, l); }
    if (KIND == 5) phase_attention(c, l);
    if (KIND == 6) phase_mixers2(c, l);
    if (KIND == 7) phase_post(c, l);
    if (KIND == 8) phase_merge1(c, l);
    if (KIND == 9) phase_merge2(c, l);
    if (KIND == 10) phase_norm2_route(c, l);
    if (KIND == 11) phase_moe1(c, l);
    if (KIND == 12) phase_moe2(c, l);
    if (KIND == 13) phase_final(c);
}

#if !FUSED
template <int KIND> __global__ void __launch_bounds__(NTHR, 2) k_step(Args a) {
    extern __shared__ __attribute__((aligned(16))) unsigned char lds[];
    Ctx c; c.in = a.in; c.out = a.out; c.ws = a.ws; c.smem = lds; c.tid = threadIdx.x; c.lane = threadIdx.x & 63; c.wave = __builtin_amdgcn_readfirstlane(threadIdx.x >> 6);
    run_step<KIND>(c, a.s_lo);
}
template <int KIND> static void launch_step(const Args& a, int grid, hipStream_t stream) {
    static bool attr = false;
    if (!attr) { (void)hipFuncSetAttribute((const void*)k_step<KIND>, hipFuncAttributeMaxDynamicSharedMemorySize, LDS_BYTES); attr = true; }
    hipLaunchKernelGGL(k_step<KIND>, dim3(grid), dim3(NTHR), LDS_BYTES, stream, a);
}
#else
__global__ void __launch_bounds__(NTHR, 2) fwd_kernel(Args a) {
    extern __shared__ __attribute__((aligned(16))) unsigned char lds[];
    Ctx c; c.in = a.in; c.out = a.out; c.ws = a.ws; c.smem = lds; c.tid = threadIdx.x; c.lane = threadIdx.x & 63; c.wave = __builtin_amdgcn_readfirstlane(threadIdx.x >> 6);
    volatile LAS unsigned* xbw = (volatile LAS unsigned*)(lds + LDS_BYTES - 16);
    if (threadIdx.x == 0) { xbw[0] = 0u; xbw[1] = 0u; }
    __syncthreads();
    XcdBarrier bar = xcd_barrier_post((unsigned*)(a.ws + WS_CTL) + CW_BAR, xbw);
    run_step<0>(c, 0);
    xcd_barrier(bar);
    for (int l = 0; l < NL; ++l) {
        run_step<1>(c, l); xcd_barrier(bar);
        run_step<2>(c, l); xcd_barrier(bar);
        run_step<3>(c, l); xcd_barrier(bar);
        run_step<4>(c, l); xcd_barrier(bar);
        run_step<5>(c, l); xcd_barrier(bar);
        run_step<6>(c, l); xcd_barrier(bar);
        run_step<7>(c, l); xcd_barrier(bar);
        run_step<8>(c, l); xcd_barrier(bar);
        run_step<9>(c, l); xcd_barrier(bar);
        run_step<10>(c, l); xcd_barrier(bar);
        run_step<11>(c, l); xcd_barrier(bar);
        run_step<12>(c, l); xcd_barrier(bar);
    }
    run_step<13>(c, 0);
}
#endif

extern "C" void kernel_launch(void* const* d_in, const int* in_sizes, int n_in, void* d_out, int out_size, void* d_ws, size_t ws_size, hipStream_t stream) {
    static int grid = 0;
    if (grid == 0) {
        if (n_in != 49 || out_size != NB * SEQ * D || ws_size < WS_END) { fprintf(stderr, "kernel_launch: unexpected problem (n_in %d out %d ws %zu need %zu)\n", n_in, out_size, ws_size, (size_t)WS_END); grid = -1; return; }
        int dev = 0, cus = 0;
        if (hipGetDevice(&dev) != hipSuccess || hipDeviceGetAttribute(&cus, hipDeviceAttributeMultiprocessorCount, dev) != hipSuccess) { grid = -1; return; }
#if FUSED
        int per_cu = 0;
        if (hipFuncSetAttribute((const void*)fwd_kernel, hipFuncAttributeMaxDynamicSharedMemorySize, LDS_BYTES) != hipSuccess) { fprintf(stderr, "kernel_launch: hipFuncSetAttribute failed\n"); grid = -1; return; }
        if (hipOccupancyMaxActiveBlocksPerMultiprocessor(&per_cu, (const void*)fwd_kernel, NTHR, LDS_BYTES) != hipSuccess || per_cu < 1) { fprintf(stderr, "kernel_launch: occupancy query says %d\n", per_cu); }
        (void)hipGetLastError();
#endif
        grid = cus;
    }
    if (grid < 0) return;
    (void)hipMemsetAsync((char*)d_ws + WS_CTL, 0, CTL_BYTES, stream);
    Args a{};
    for (int i = 0; i < 49; ++i) a.in[i] = (const float*)d_in[i];
    a.out = (float*)d_out; a.ws = (unsigned char*)d_ws;
#if !FUSED
    a.s_lo = 0; a.s_hi = 0; launch_step<0>(a, grid, stream);
    for (int l = 0; l < NL; ++l) {
        a.s_lo = l;
        launch_step<1>(a, grid, stream); launch_step<2>(a, grid, stream); launch_step<3>(a, grid, stream); launch_step<4>(a, grid, stream);
        launch_step<5>(a, grid, stream); launch_step<6>(a, grid, stream); launch_step<7>(a, grid, stream); launch_step<8>(a, grid, stream);
        launch_step<9>(a, grid, stream); launch_step<10>(a, grid, stream); launch_step<11>(a, grid, stream); launch_step<12>(a, grid, stream);
    }
    a.s_lo = 0; launch_step<13>(a, grid, stream);
#else
    a.s_lo = 0; a.s_hi = N_STEPS; hipLaunchKernelGGL(fwd_kernel, dim3(grid), dim3(NTHR), LDS_BYTES, stream, a);
#endif
}
```

```cpp
#include <hip/hip_runtime.h>
#include <stdint.h>
#include <stdio.h>

#define DI __device__ __forceinline__
#define LAS __attribute__((address_space(3)))
typedef unsigned short bf16_t;
typedef short bf16x8 __attribute__((ext_vector_type(8)));
typedef short s16x4 __attribute__((ext_vector_type(4)));
typedef float f32x4 __attribute__((ext_vector_type(4)));
typedef float f32x16 __attribute__((ext_vector_type(16)));
typedef float f32x2 __attribute__((ext_vector_type(2)));
typedef __bf16 bf16x2v __attribute__((ext_vector_type(2)));
typedef unsigned u32x4 __attribute__((ext_vector_type(4)));
typedef unsigned u32x2 __attribute__((ext_vector_type(2)));

constexpr int D = 1024, NB = 2, SEQ = 8192, CTX = 256, TZ = 8448, NZ = 16896, NL = 2;
constexpr int NIN = 6560, NINP = 6656;
constexpr int NTHR = 512;
constexpr float LOG2E = 1.4426950408889634f;

#define XB_TMO      128
#define XB_XCNT(j)  (256  + 64 * (j))
#define XB_XSUB(j)  (1280 + 64 * (j))
#define XB_XGEN(j)  (2304 + 64 * (j))
#define XB_TOP      3328
#define XB_TOPGEN   3392
#define XCD_BAR_WORDS 3456
#define XB_SPIN_CAP (1u << 18)

__device__ __forceinline__ unsigned xb_ld(unsigned* p)              { return __hip_atomic_load(p, __ATOMIC_RELAXED, __HIP_MEMORY_SCOPE_AGENT); }
__device__ __forceinline__ unsigned xb_add(unsigned* p, unsigned v) { return __hip_atomic_fetch_add(p, v, __ATOMIC_RELAXED, __HIP_MEMORY_SCOPE_AGENT); }
__device__ __forceinline__ unsigned xb_xcc_id() { return (unsigned)__builtin_amdgcn_s_getreg((3 << 11) | 20) & 0xFu; }
#define XB_SPIN(cond, bar) do { unsigned _sp = 0; while (cond) { __builtin_amdgcn_s_sleep(1); \
    if ((++_sp & 255u) == 0u) { if (xb_ld(&(bar)[XB_TMO])) break; if (_sp > XB_SPIN_CAP) { atomicAdd(&(bar)[XB_TMO], 1u); break; } } } } while (0)

struct XcdBarrier { unsigned* bar; unsigned x; volatile LAS unsigned* st; };

__device__ __forceinline__ XcdBarrier xcd_barrier_post(unsigned* bar, volatile LAS unsigned* st) {
    XcdBarrier b; b.bar = bar; b.x = xb_xcc_id(); b.st = st;
    if (threadIdx.x == 0) (void)xb_add(&bar[XB_XCNT(b.x)], 1u);
    return b;
}
__device__ __forceinline__ void xcd_barrier_complete(unsigned* bar, unsigned x, unsigned& nloc, unsigned& nx) {
    const unsigned G = gridDim.x * gridDim.y * gridDim.z;
    unsigned sum, cnt, mine, sp = 0u;
    for (;;) {
        sum = 0u; cnt = 0u; mine = 0u;
#pragma unroll
        for (unsigned j = 0; j < 16; ++j) { const unsigned c = xb_ld(&bar[XB_XCNT(j)]); sum += c; cnt += (c > 0u) ? 1u : 0u; mine = (j == x) ? c : mine; }
        if (sum == G) break;
        __builtin_amdgcn_s_sleep(1);
        if ((++sp & 255u) == 0u) { if (xb_ld(&bar[XB_TMO])) break; if (sp > XB_SPIN_CAP) { atomicAdd(&bar[XB_TMO], 1u); break; } }
    }
    nloc = mine > 0u ? mine : 1u; nx = cnt > 0u ? cnt : 1u;
}
__device__ __forceinline__ void xcd_barrier(const XcdBarrier& b) {
    asm volatile("s_waitcnt vmcnt(0)" ::: "memory");
    __syncthreads();
    if (threadIdx.x == 0) {
        unsigned* bar = b.bar;
        __builtin_amdgcn_s_waitcnt(0);
        unsigned nloc = b.st[0], nx = b.st[1];
        if (nloc == 0u) { xcd_barrier_complete(bar, b.x, nloc, nx); b.st[0] = nloc; b.st[1] = nx; }
        const unsigned old = xb_add(&bar[XB_XSUB(b.x)], 1u);
        const unsigned gen = old / nloc;
        if (old + 1u == (gen + 1u) * nloc) {
            __builtin_amdgcn_fence(__ATOMIC_RELEASE, "agent");
            asm volatile("s_waitcnt vmcnt(0)" ::: "memory");
            const unsigned og = xb_add(&bar[XB_TOP], 1u);
            const unsigned tg = og / nx;
            if (og + 1u == (tg + 1u) * nx) xb_add(&bar[XB_TOPGEN], 1u);
            else XB_SPIN(xb_ld(&bar[XB_TOPGEN]) == tg, bar);
            __builtin_amdgcn_fence(__ATOMIC_ACQUIRE, "agent");
            xb_add(&bar[XB_XGEN(b.x)], 1u);
            asm volatile("s_waitcnt vmcnt(0)" ::: "memory");
        } else {
            XB_SPIN(xb_ld(&bar[XB_XGEN(b.x)]) == gen, bar);
            __builtin_amdgcn_fence(__ATOMIC_ACQUIRE, "agent");
            asm volatile("s_waitcnt vmcnt(0)" ::: "memory");
        }
    }
    __syncthreads();
}

DI float bf2f(bf16_t v) { return __uint_as_float((unsigned)v << 16); }
DI unsigned pack2(float a, float b) { f32x2 v = {a, b}; bf16x2v r = __builtin_convertvector(v, bf16x2v); return __builtin_bit_cast(unsigned, r); }
DI bf16_t f2bf(float a) { return (bf16_t)(pack2(a, 0.f) & 0xffffu); }
DI float lo2f(unsigned u) { return __uint_as_float(u << 16); }
DI float hi2f(unsigned u) { return __uint_as_float(u & 0xffff0000u); }
DI float wave_sum(float v) {
#pragma unroll
    for (int m = 32; m >= 1; m >>= 1) v += __shfl_xor(v, m, 64);
    return v;
}
DI float sum16(float v) {
#pragma unroll
    for (int m = 8; m >= 1; m >>= 1) v += __shfl_xor(v, m, 64);
    return v;
}
DI float sigmoidf_(float x) { return 1.f / (1.f + __expf(-x)); }
DI float siluf_(float x) { return x / (1.f + __expf(-x)); }
DI float gelu_tanh(float x) { const float u = 0.7978845608028654f * (x + 0.044715f * x * x * x); return 0.5f * x * (1.f + tanhf(u)); }
DI void unpack4(u32x2 u, float (&f)[4]) { f[0] = lo2f(u.x); f[1] = hi2f(u.x); f[2] = lo2f(u.y); f[3] = hi2f(u.y); }
DI u32x2 pack4(float a, float b, float c, float d) { u32x2 r; r.x = pack2(a, b); r.y = pack2(c, d); return r; }

constexpr size_t algn(size_t x) { return (x + 255) & ~(size_t)255; }
constexpr size_t WS_CTL   = 0;
constexpr size_t CTL_BYTES = 64 * 1024;
constexpr size_t WS_H     = WS_CTL + CTL_BYTES;
constexpr size_t WS_WSM   = WS_H + (size_t)NZ * D * 4;
constexpr size_t SZ_WINT = (size_t)NINP * D * 2, SZ_WUQT = 384 * 256 * 2, SZ_WUKVT = 512 * 128 * 2, SZ_W2T = 512 * 64 * 2, SZ_A2T = 512 * 64 * 2,
                 SZ_G2T = 256 * 128 * 2, SZ_GLUT = 256 * 256 * 2, SZ_WBT = (size_t)D * D * 2, SZ_WOUTT = (size_t)D * D * 2;
constexpr size_t OFF_WINT = 0, OFF_WUQT = OFF_WINT + NL * SZ_WINT, OFF_WUKVT = OFF_WUQT + NL * SZ_WUQT, OFF_W2T = OFF_WUKVT + NL * SZ_WUKVT,
                 OFF_A2T = OFF_W2T + NL * SZ_W2T, OFF_G2T = OFF_A2T + NL * SZ_A2T, OFF_GLUT = OFF_G2T + NL * SZ_G2T, OFF_WBT = OFF_GLUT + NL * SZ_GLUT,
                 OFF_WOUTT = OFF_WBT + NL * SZ_WBT, OFF_MODV = OFF_WOUTT + NL * SZ_WOUTT,
                 OFF_ROPE = OFF_MODV + (size_t)NL * 3 * 6144 * 4,
                 OFF_S5T = OFF_ROPE + (size_t)SEQ * 16 * 2 * 4,
                 OFF_RWT = OFF_S5T + (size_t)NL * 2 * 16 * 64 * 36 * 4,
                 OFF_LAM = OFF_RWT + (size_t)NL * 36 * 1024 * 4,
                 OFF_S5E = OFF_LAM + 256,
                 OFF_S5C = OFF_S5E + (size_t)2 * 2 * 16 * 66 * 64 * 2 * 4,
                 WSM_BYTES = algn(OFF_S5C + (size_t)2 * 2 * 16 * 66 * 64 * 2 * 4);
constexpr size_t WS_EXPW  = WS_WSM + WSM_BYTES;
constexpr size_t SZ_WGU = (size_t)1024 * 1024 * 2, SZ_WD = (size_t)1024 * 512 * 2;
constexpr size_t EXPW_BYTES = 32 * (SZ_WGU + SZ_WD);
constexpr size_t SZ_QM = (size_t)NB * 4 * TZ * 96 * 2, SZ_VMT = (size_t)NB * 4 * 64 * TZ * 2, SZ_QD = (size_t)NB * 4 * TZ * 64 * 2, SZ_R256 = (size_t)NZ * 256 * 2;
constexpr size_t MX_QM = 0, MX_KM = MX_QM + SZ_QM, MX_VMT = MX_KM + SZ_QM, MX_QD = MX_VMT + SZ_VMT, MX_KD = MX_QD + SZ_QD, MX_VDT = MX_KD + SZ_QD,
                 MX_RB = MX_VDT + SZ_VMT, MX_KB = MX_RB + SZ_R256, MX_VB = MX_KB + SZ_R256, MX_KKB = MX_VB + SZ_R256, MX_END = MX_KKB + SZ_R256;
static_assert(MX_END <= EXPW_BYTES, "mixer operands must fit the expert-weight region");
constexpr size_t WS_BUFA  = WS_EXPW + EXPW_BYTES;
constexpr size_t WS_BUFB  = WS_BUFA + (size_t)NZ * D * 2;
constexpr size_t WS_P     = WS_BUFB + (size_t)NZ * D * 2;
constexpr size_t P_PM = 0, P_PS = P_PM + (size_t)NZ * 416 * 2, P_PR = P_PS + (size_t)NZ * 256 * 2, P_PD = P_PR + (size_t)NZ * 1024 * 2, P_BYTES = P_PD + (size_t)NZ * 768 * 2;
static_assert((size_t)6 * SZ_R256 <= (size_t)NZ * (1024 + 768) * 2, "scan operands must fit PR|PD");
static_assert((size_t)2 * NZ * D * 2 <= P_BYTES, "the MoE outputs (2 x bf16 [NZ][D]) must fit the P region");
constexpr size_t WS_GT    = WS_P + P_BYTES;
constexpr size_t GT_BYTES = (size_t)NZ * 4096 * 2;
constexpr int MOE_CAP = 33792;
constexpr size_t GT_HM = 0, GT_LIST = GT_HM + (size_t)(33792 + 32 * 128) * 512 * 2, GT_LW = GT_LIST + (size_t)32 * MOE_CAP * 4, GT_END = GT_LW + (size_t)32 * MOE_CAP * 4;
static_assert(GT_END <= GT_BYTES, "MoE scratch must fit the gate region");
constexpr size_t WS_MISC  = WS_GT + GT_BYTES;
constexpr size_t MS_CQN = 0, MS_TW = MS_CQN + (size_t)NZ * 384 * 2, MS_AL = MS_TW + (size_t)NZ * 64 * 2, MS_SG = MS_AL + (size_t)NZ * 64 * 2,
                 MS_GG = MS_SG + (size_t)NZ * 128 * 2, MS_ZG = MS_GG + SZ_R256, MS_END = MS_ZG + SZ_R256;
constexpr size_t WS_END   = WS_MISC + MS_END;

constexpr int CW_BAR = 0;
constexpr int CW_CNT = 4096;

struct Args { const float* in[49]; float* out; unsigned char* ws; int s_lo, s_hi; };

struct Ctx {
    const float* const* in; float* out; unsigned char* ws; unsigned char* smem; int tid, lane, wave;
};

template <int WM> struct GCfg { static constexpr int WN = 8 / WM, BM = 64 * WM, BN = 64 * WN, ABYTES = BM * 64, BBYTES = BN * 64, STAGE = ABYTES + BBYTES; };

template <int WM, int SEGK, class ARow, class BRow, class Hook, class Epi>
DI void gemm_tile(const Ctx& c, int K, ARow arow, BRow brow, Hook hook, Epi epi) {
    typedef GCfg<WM> G;
    const int tid = c.tid, lane = c.lane, wave = c.wave;
    const int wm = wave / G::WN, wn = wave % G::WN, fr = lane & 15, fq = lane >> 4;
    unsigned char* smem = c.smem;
    constexpr int NA = G::BM / 128, NBq = G::BN / 128;
    const bf16_t* asrc[NA]; const bf16_t* bsrc[NBq];
#pragma unroll
    for (int i = 0; i < NA; ++i) { const int ch = tid + i * NTHR; asrc[i] = arow(ch >> 2) + (ch & 3) * 8; }
#pragma unroll
    for (int i = 0; i < NBq; ++i) { const int ch = tid + i * NTHR; bsrc[i] = brow(ch >> 2) + (ch & 3) * 8; }
    auto stage = [&](int kt, int buf) {
        unsigned char* sa = smem + buf * G::STAGE; unsigned char* sb = sa + G::ABYTES;
#pragma unroll
        for (int i = 0; i < NA; ++i) __builtin_amdgcn_global_load_lds((const unsigned*)(asrc[i] + kt * 32), (unsigned*)(sa + (tid + i * NTHR) * 16), 16, 0, 0);
#pragma unroll
        for (int i = 0; i < NBq; ++i) __builtin_amdgcn_global_load_lds((const unsigned*)(bsrc[i] + kt * 32), (unsigned*)(sb + (tid + i * NTHR) * 16), 16, 0, 0);
    };
    f32x4 acc[4][4];
#pragma unroll
    for (int m = 0; m < 4; ++m)
#pragma unroll
        for (int n = 0; n < 4; ++n) acc[m][n] = (f32x4){0.f, 0.f, 0.f, 0.f};
    const int T = K / 32;
    __syncthreads();
    stage(0, 0);
    for (int t = 0; t < T; ++t) {
        asm volatile("s_waitcnt vmcnt(0)" ::: "memory");
        __syncthreads();
        if (t + 1 < T) stage(t + 1, (t + 1) & 1);
        const unsigned char* sa = smem + (t & 1) * G::STAGE; const unsigned char* sb = sa + G::ABYTES;
        bf16x8 af[4], bfr[4];
#pragma unroll
        for (int m = 0; m < 4; ++m) af[m] = *(const bf16x8*)(sa + (wm * 64 + m * 16 + fr) * 64 + fq * 16);
#pragma unroll
        for (int n = 0; n < 4; ++n) bfr[n] = *(const bf16x8*)(sb + (wn * 64 + n * 16 + fr) * 64 + fq * 16);
#pragma unroll
        for (int m = 0; m < 4; ++m)
#pragma unroll
            for (int n = 0; n < 4; ++n) acc[m][n] = __builtin_amdgcn_mfma_f32_16x16x32_bf16(bfr[n], af[m], acc[m][n], 0, 0, 0);
        if (SEGK > 0) { if (((t + 1) * 32) % (SEGK > 0 ? SEGK : 32) == 0) hook(acc, ((t + 1) * 32) / (SEGK > 0 ? SEGK : 32) - 1, wm * 64, wn * 64, fr, fq); }
    }
    epi(acc, wm * 64, wn * 64, fr, fq);
}
struct NoHook { DI void operator()(f32x4 (&)[4][4], int, int, int, int, int) const {} };

DI int rowmap(int n, int mode) { return mode == 0 ? n : ((n >> 4) * 32 + (n & 15) + (mode == 2 ? 16 : 0)); }
DI void tconv_tile(const Ctx& c, const float* src, int ld, int N, bf16_t* dst, int ld_dst, int mode, int tk, int tn) {
    bf16_t* T = (bf16_t*)c.smem;
    const int k0 = tk * 64, n0 = tn * 64, tid = c.tid;
    __syncthreads();
#pragma unroll
    for (int i = 0; i < 2; ++i) {
        const int kk = (tid >> 4) + i * 32, n4 = (tid & 15) * 4;
        float4 v = make_float4(0.f, 0.f, 0.f, 0.f);
        if (n0 + n4 < N) v = *(const float4*)(src + (size_t)(k0 + kk) * ld + n0 + n4);
        T[(n4 + 0) * 72 + kk] = f2bf(v.x); T[(n4 + 1) * 72 + kk] = f2bf(v.y); T[(n4 + 2) * 72 + kk] = f2bf(v.z); T[(n4 + 3) * 72 + kk] = f2bf(v.w);
    }
    __syncthreads();
    const int n = tid >> 3, k8 = (tid & 7) * 8;
    if (n0 + n < N) *(u32x4*)(dst + (size_t)rowmap(n0 + n, mode) * ld_dst + k0 + k8) = *(const u32x4*)(T + n * 72 + k8);
}
DI void tconv(const Ctx& c, const float* src, int ld, int K, int N, bf16_t* dst, int ld_dst, int mode, int rot) {
    const int ntk = K / 64, ntn = (N + 63) / 64, nt = ntk * ntn, G = gridDim.x;
    for (int t = (blockIdx.x + G - (rot % G)) % G; t < nt; t += G) tconv_tile(c, src, ld, N, dst, ld_dst, mode, t / ntn, t % ntn);
}

DI void phase_prologue(const Ctx& c) {
    unsigned char* wsm = c.ws + WS_WSM;
    const int tid = c.tid, G = gridDim.x, gtid = blockIdx.x * NTHR + tid, gn = G * NTHR;
    {
        const float4* x = (const float4*)c.in[0]; const float4* cx = (const float4*)c.in[2]; float4* H = (float4*)(c.ws + WS_H);
        for (size_t i = gtid; i < (size_t)NZ * 256; i += gn) {
            const int z = (int)(i >> 8), q = (int)(i & 255), b = z / TZ, s = z % TZ;
            H[i] = (s < CTX) ? cx[((size_t)b * CTX + s) * 256 + q] : x[((size_t)b * SEQ + (s - CTX)) * 256 + q];
        }
    }
    {
        float* rope = (float*)(wsm + OFF_ROPE);
        for (int i = gtid; i < SEQ * 16; i += gn) {
            const int t = i >> 4, a = (i >> 3) & 1, f = i & 7;
            const float pos = (float)(a == 0 ? (t >> 6) : (t & 63));
            const float inv = powf(10000.f, -(float)f / 8.f);
            float sn, cs; sincosf(pos * inv, &sn, &cs);
            rope[i * 2] = cs; rope[i * 2 + 1] = sn;
        }
    }
    {
        float* s5t = (float*)(wsm + OFF_S5T);
        for (int i = gtid; i < NL * 2 * 16 * 64; i += gn) {
            const int ldg = i >> 6;
            const double lr = c.in[24][i], li = c.in[25][i], dt = exp((double)c.in[26][ldg]);
            const double mag = exp(lr * dt), are = mag * cos(li * dt), aim = mag * sin(li * dt);
            const double m256 = exp(lr * dt * 128.0), a256r = m256 * cos(li * dt * 128.0), a256i = m256 * sin(li * dt * 128.0);
            const double den = lr * lr + li * li, nr = are - 1.0, ni = aim;
            const double cfr = (nr * lr + ni * li) / den, cfi = (ni * lr - nr * li) / den;
            float* o = s5t + (size_t)i * 36;
            o[0] = (float)are; o[1] = (float)aim; o[2] = (float)a256r; o[3] = (float)a256i;
            for (int ch = 0; ch < 16; ++ch) {
                const double br = c.in[27][(size_t)i * 16 + ch], bi = c.in[28][(size_t)i * 16 + ch];
                o[4 + ch] = (float)(cfr * br - cfi * bi); o[20 + ch] = (float)(cfr * bi + cfi * br);
            }
        }
    }
    {
        float* rwt = (float*)(wsm + OFF_RWT);
        for (int i = gtid; i < NL * 36 * 1024; i += gn) {
            const int l = i / (36 * 1024), e = (i / 1024) % 36, d = i & 1023;
            rwt[i] = e < 4 ? c.in[41][((size_t)l * 1024 + d) * 4 + e] : c.in[43][((size_t)l * 1024 + d) * 32 + (e - 4)];
        }
    }
    if (blockIdx.x == 0 && tid < NL) {
        float s1 = 0.f, s2 = 0.f;
        for (int i = 0; i < 32; ++i) { s1 += c.in[34][tid * 32 + i] * c.in[35][tid * 32 + i]; s2 += c.in[36][tid * 32 + i] * c.in[37][tid * 32 + i]; }
        ((float*)(wsm + OFF_LAM))[tid] = expf(s1) - expf(s2) + (0.8f - 0.6f * expf(-0.3f * (float)tid));
    }
    {
        float* sv = (float*)c.smem;
        float* red = sv + 3 * 1024;
        __syncthreads();
        for (int i = tid; i < 3 * 1024; i += NTHR) { const float v = i < 2048 ? c.in[1][i] : c.in[3][i - 2048]; sv[i] = siluf_(v); }
        __syncthreads();
        float* modv = (float*)(wsm + OFF_MODV);
        for (int u = blockIdx.x; u < NL * 96; u += G) {
            const int l = u / 96, col = (u % 96) * 64 + (tid & 63), ks = tid >> 6;
            const float* w = c.in[4] + (size_t)l * 1024 * 6144 + col;
            float a0 = 0.f, a1 = 0.f, a2 = 0.f;
            for (int k = ks * 128; k < ks * 128 + 128; ++k) { const float wv = w[(size_t)k * 6144]; a0 += sv[k] * wv; a1 += sv[1024 + k] * wv; a2 += sv[2048 + k] * wv; }
            red[(ks * 64 + (tid & 63)) * 3 + 0] = a0; red[(ks * 64 + (tid & 63)) * 3 + 1] = a1; red[(ks * 64 + (tid & 63)) * 3 + 2] = a2;
            __syncthreads();
            if (tid < 192) {
                const int cc = tid & 63, sel = tid >> 6; float s = 0.f;
                for (int k2 = 0; k2 < 8; ++k2) s += red[(k2 * 64 + cc) * 3 + sel];
                const int colo = (u % 96) * 64 + cc;
                modv[((size_t)l * 3 + sel) * 6144 + colo] = s + c.in[5][l * 6144 + colo];
            }
            __syncthreads();
        }
    }
    for (int l = 0; l < NL; ++l) {
        tconv(c, c.in[8] + (size_t)l * 1024 * NIN, NIN, 1024, NIN, (bf16_t*)(wsm + OFF_WINT + l * SZ_WINT), 1024, 0, 0);
        tconv(c, c.in[11] + (size_t)l * 256 * 384, 384, 256, 384, (bf16_t*)(wsm + OFF_WUQT + l * SZ_WUQT), 256, 0, 40);
        tconv(c, c.in[12] + (size_t)l * 128 * 512, 512, 128, 512, (bf16_t*)(wsm + OFF_WUKVT + l * SZ_WUKVT), 128, 0, 70);
        for (int d = 0; d < 2; ++d) {
            tconv(c, c.in[15] + (size_t)(l * 2 + d) * 64 * 256, 256, 64, 256, (bf16_t*)(wsm + OFF_W2T + l * SZ_W2T) + d * 256 * 64, 64, 0, 90 + d * 8);
            tconv(c, c.in[17] + (size_t)(l * 2 + d) * 64 * 256, 256, 64, 256, (bf16_t*)(wsm + OFF_A2T + l * SZ_A2T) + d * 256 * 64, 64, 0, 110 + d * 8);
        }
        tconv(c, c.in[18] + (size_t)l * 128 * 256, 256, 128, 256, (bf16_t*)(wsm + OFF_G2T + l * SZ_G2T), 128, 0, 130);
        tconv(c, c.in[32] + (size_t)l * 256 * 256, 256, 256, 256, (bf16_t*)(wsm + OFF_GLUT + l * SZ_GLUT), 256, 0, 140);
        for (int n = 0; n < 4; ++n)
            tconv(c, c.in[39] + (size_t)(l * 4 + n) * 256 * 1024, 1024, 256, 1024, (bf16_t*)(wsm + OFF_WBT + l * SZ_WBT) + n * 256, 1024, 0, 160 + n * 20);
        tconv(c, c.in[40] + (size_t)l * 1024 * 1024, 1024, 1024, 1024, (bf16_t*)(wsm + OFF_WOUTT + l * SZ_WOUTT), 1024, 0, 0);
    }
}

DI void phase_expert_convert(const Ctx& c, int l) {
    const int G = gridDim.x;
    for (int t = blockIdx.x; t < 32 * 384; t += G) {
        const int e = t / 384, r = t % 384;
        bf16_t* wgu = (bf16_t*)(c.ws + WS_EXPW + (size_t)e * SZ_WGU);
        bf16_t* wd = (bf16_t*)(c.ws + WS_EXPW + 32 * SZ_WGU + (size_t)e * SZ_WD);
        if (r < 128)      tconv_tile(c, c.in[45] + ((size_t)l * 32 + e) * 1024 * 512, 512, 512, wgu, 1024, 1, r / 8, r % 8);
        else if (r < 256) tconv_tile(c, c.in[46] + ((size_t)l * 32 + e) * 1024 * 512, 512, 512, wgu, 1024, 2, (r - 128) / 8, (r - 128) % 8);
        else              tconv_tile(c, c.in[47] + ((size_t)l * 32 + e) * 512 * 1024, 1024, 1024, wd, 512, 0, (r - 256) / 16, (r - 256) % 16);
    }
}

DI void phase_norm1(const Ctx& c, int l) {
    const float* modv = (const float*)(c.ws + WS_WSM + OFF_MODV);
    float* H = (float*)(c.ws + WS_H); const bf16_t* Y = (const bf16_t*)(c.ws + WS_P);
    bf16_t* XN = (bf16_t*)(c.ws + WS_BUFA);
    const float* g1 = c.in[6] + l * 1024;
    for (int row = blockIdx.x * 8 + c.wave; row < NZ; row += gridDim.x * 8) {
        const int b = row / TZ, s = row % TZ, sel = s < CTX ? 2 : b;
        float4 v[4]; float ss = 0.f;
#pragma unroll
        for (int q = 0; q < 4; ++q) {
            const int col = q * 256 + c.lane * 4;
            v[q] = *(const float4*)(H + (size_t)row * D + col);
            if (l > 0) {
                float ya[4], yb[4]; unpack4(*(const u32x2*)(Y + (size_t)row * D + col), ya); unpack4(*(const u32x2*)(Y + ((size_t)NZ + row) * D + col), yb);
                const float4 m5 = *(const float4*)(modv + ((size_t)(l - 1) * 3 + sel) * 6144 + 5 * 1024 + col);
                v[q].x += m5.x * (ya[0] + yb[0]); v[q].y += m5.y * (ya[1] + yb[1]); v[q].z += m5.z * (ya[2] + yb[2]); v[q].w += m5.w * (ya[3] + yb[3]);
                *(float4*)(H + (size_t)row * D + col) = v[q];
            }
            ss += v[q].x * v[q].x + v[q].y * v[q].y + v[q].z * v[q].z + v[q].w * v[q].w;
        }
        ss = wave_sum(ss);
        const float rs = rsqrtf(ss * (1.f / 1024.f) + 1e-6f);
#pragma unroll
        for (int q = 0; q < 4; ++q) {
            const int col = q * 256 + c.lane * 4;
            const float4 g = *(const float4*)(g1 + col), m0 = *(const float4*)(modv + ((size_t)l * 3 + sel) * 6144 + col), m1 = *(const float4*)(modv + ((size_t)l * 3 + sel) * 6144 + 1024 + col);
            *(u32x2*)(XN + (size_t)row * D + col) = pack4(v[q].x * rs * g.x * (1.f + m1.x) + m0.x, v[q].y * rs * g.y * (1.f + m1.y) + m0.y,
                                                          v[q].z * rs * g.z * (1.f + m1.z) + m0.z, v[q].w * rs * g.w * (1.f + m1.w) + m0.w);
        }
    }
}

DI void phase_final(const Ctx& c) {
    const float* modv = (const float*)(c.ws + WS_WSM + OFF_MODV);
    const float* H = (const float*)(c.ws + WS_H); const bf16_t* Y = (const bf16_t*)(c.ws + WS_P);
    const float* g = c.in[48];
    for (int r = blockIdx.x * 8 + c.wave; r < NB * SEQ; r += gridDim.x * 8) {
        const int b = r / SEQ, t = r % SEQ, row = b * TZ + CTX + t;
        float4 v[4]; float ss = 0.f;
#pragma unroll
        for (int q = 0; q < 4; ++q) {
            const int col = q * 256 + c.lane * 4;
            v[q] = *(const float4*)(H + (size_t)row * D + col);
            float ya[4], yb[4]; unpack4(*(const u32x2*)(Y + (size_t)row * D + col), ya); unpack4(*(const u32x2*)(Y + ((size_t)NZ + row) * D + col), yb);
            const float4 m5 = *(const float4*)(modv + ((size_t)(NL - 1) * 3 + b) * 6144 + 5 * 1024 + col);
            v[q].x += m5.x * (ya[0] + yb[0]); v[q].y += m5.y * (ya[1] + yb[1]); v[q].z += m5.z * (ya[2] + yb[2]); v[q].w += m5.w * (ya[3] + yb[3]);
            ss += v[q].x * v[q].x + v[q].y * v[q].y + v[q].z * v[q].z + v[q].w * v[q].w;
        }
        ss = wave_sum(ss);
        const float rs = rsqrtf(ss * (1.f / 1024.f) + 1e-6f);
#pragma unroll
        for (int q = 0; q < 4; ++q) {
            const int col = q * 256 + c.lane * 4; const float4 gg = *(const float4*)(g + col);
            *(float4*)(c.out + (size_t)r * D + col) = make_float4(v[q].x * rs * gg.x, v[q].y * rs * gg.y, v[q].z * rs * gg.z, v[q].w * rs * gg.w);
        }
    }
}

DI void phase_inproj(const Ctx& c, int l) {
    const bf16_t* XN = (const bf16_t*)(c.ws + WS_BUFA);
    const bf16_t* W = (const bf16_t*)(c.ws + WS_WSM + OFF_WINT + l * SZ_WINT);
    bf16_t* PM = (bf16_t*)(c.ws + WS_P + P_PM); bf16_t* PS = (bf16_t*)(c.ws + WS_P + P_PS); bf16_t* PR = (bf16_t*)(c.ws + WS_P + P_PR); bf16_t* PD = (bf16_t*)(c.ws + WS_P + P_PD);
    bf16_t* GT = (bf16_t*)(c.ws + WS_GT);
    constexpr int NMT = NZ / 256, NNT = NINP / 128;
    for (int u = blockIdx.x; u < NMT * NNT; u += gridDim.x) {
        const int mt = u / NNT, nt = u % NNT, r0 = mt * 256, c0 = nt * 128;
        gemm_tile<4, 0>(c, 1024,
            [&](int i) { return XN + (size_t)(r0 + i) * D; },
            [&](int i) { return W + (size_t)(c0 + i) * D; }, NoHook(),
            [&](f32x4 (&acc)[4][4], int wr, int wc, int fr, int fq) {
#pragma unroll
                for (int n = 0; n < 4; ++n) {
                    const int col = c0 + wc + n * 16 + fq * 4;
                    bf16_t* dst; int ld, cc; bool gate = false;
                    if (col < 416) { dst = PM; ld = 416; cc = col; }
                    else if (col < 1440) { dst = PR; ld = 1024; cc = col - 416; }
                    else if (col < 1696) { dst = PS; ld = 256; cc = col - 1440; }
                    else if (col < 2464) { dst = PD; ld = 768; cc = col - 1696; }
                    else if (col < NIN) { dst = GT; ld = 4096; cc = col - 2464; gate = true; }
                    else continue;
#pragma unroll
                    for (int m = 0; m < 4; ++m) {
                        const int row = r0 + wr + m * 16 + fr; f32x4 v = acc[m][n];
                        if (gate) { v[0] = sigmoidf_(v[0]); v[1] = sigmoidf_(v[1]); v[2] = sigmoidf_(v[2]); v[3] = sigmoidf_(v[3]); }
                        *(u32x2*)(dst + (size_t)row * ld + cc) = pack4(v[0], v[1], v[2], v[3]);
                    }
                }
            });
    }
}

DI void phase_prep(const Ctx& c, int l) {
    unsigned char* ws = c.ws; const int lane = c.lane, wave = c.wave, tid = c.tid;
    const bf16_t* PM = (const bf16_t*)(ws + WS_P + P_PM); const bf16_t* PR = (const bf16_t*)(ws + WS_P + P_PR); const bf16_t* PD = (const bf16_t*)(ws + WS_P + P_PD);
    bf16_t* CQN = (bf16_t*)(ws + WS_MISC + MS_CQN); bf16_t* TW = (bf16_t*)(ws + WS_MISC + MS_TW); bf16_t* AL = (bf16_t*)(ws + WS_MISC + MS_AL); bf16_t* SG = (bf16_t*)(ws + WS_MISC + MS_SG);
    bf16_t* KM = (bf16_t*)(ws + WS_EXPW + MX_KM); bf16_t* QD = (bf16_t*)(ws + WS_EXPW + MX_QD); bf16_t* KD_ = (bf16_t*)(ws + WS_EXPW + MX_KD); bf16_t* VDT = (bf16_t*)(ws + WS_EXPW + MX_VDT);
    bf16_t* RB = (bf16_t*)(ws + WS_EXPW + MX_RB); bf16_t* KB = (bf16_t*)(ws + WS_EXPW + MX_KB); bf16_t* VB = (bf16_t*)(ws + WS_EXPW + MX_VB); bf16_t* KKB = (bf16_t*)(ws + WS_EXPW + MX_KKB);
    const float* rope = (const float*)(ws + WS_WSM + OFF_ROPE);
    const float* gq = c.in[9] + l * 256; const float* gkv = c.in[10] + l * 128; const float* mu = c.in[13] + l * 1024; const float* k_k = c.in[19] + l * 256;
    bf16_t* Vs = (bf16_t*)c.smem;
    const float qsc = 0.17677669529663687f * LOG2E;
    for (int tile = blockIdx.x; tile < NZ / 64; tile += gridDim.x) {
        __syncthreads();
        for (int i = 0; i < 8; ++i) {
            const int rt = wave * 8 + i, z = tile * 64 + rt, b = z / TZ, s = z % TZ; const bool lat = s >= CTX; const int tl = lat ? s - CTX : 0;
            {
                const bf16_t* pm = PM + (size_t)z * 416;
                float x[4]; unpack4(*(const u32x2*)(pm + lane * 4), x);
                float ss = wave_sum(x[0] * x[0] + x[1] * x[1] + x[2] * x[2] + x[3] * x[3]);
                float rs = rsqrtf(ss * (1.f / 256.f) + 1e-6f);
                const float4 g = *(const float4*)(gq + lane * 4);
                *(u32x2*)(CQN + (size_t)z * 384 + lane * 4) = pack4(x[0] * rs * g.x, x[1] * rs * g.y, x[2] * rs * g.z, x[3] * rs * g.w);
                const unsigned u2 = *(const unsigned*)(pm + 256 + lane * 2); const float y0 = lo2f(u2), y1 = hi2f(u2);
                ss = wave_sum(y0 * y0 + y1 * y1); rs = rsqrtf(ss * (1.f / 128.f) + 1e-6f);
                const float2 g2 = *(const float2*)(gkv + lane * 2);
                *(unsigned*)(CQN + (size_t)z * 384 + 256 + lane * 2) = pack2(y0 * rs * g2.x, y1 * rs * g2.y);
                float kr = bf2f(pm[384 + (lane & 31)]);
                const float pr = __shfl_xor(kr, 8, 64);
                if (lat) { const float* cs = rope + ((size_t)tl * 16 + ((lane & 31) >> 4) * 8 + (lane & 7)) * 2; kr = kr * cs[0] + ((lane & 8) ? pr : -pr) * cs[1]; }
                if (lane < 32) {
                    const bf16_t kv = f2bf(kr);
#pragma unroll
                    for (int h = 0; h < 4; ++h) KM[((size_t)(b * 4 + h) * TZ + s) * 96 + 64 + lane] = kv;
                }
            }
            {
                const bf16_t* pd = PD + (size_t)z * 768;
                const int i0 = lane * 4, hh = i0 >> 6, ii = i0 & 31, nn = (i0 >> 5) & 1;
                const float* cs = rope + ((size_t)tl * 16 + (ii >> 4) * 8 + (ii & 7)) * 2;
                const bool hi = (ii & 8) != 0;
#pragma unroll
                for (int w = 0; w < 2; ++w) {
                    float x[4]; unpack4(*(const u32x2*)(pd + w * 256 + i0), x);
                    float o[4];
#pragma unroll
                    for (int j = 0; j < 4; ++j) {
                        const float p = __shfl_xor(x[j], 2, 64);
                        o[j] = lat ? (x[j] * cs[2 * j] + (hi ? p : -p) * cs[2 * j + 1]) : x[j];
                        if (w == 0) o[j] *= qsc;
                    }
                    bf16_t* dst = (w == 0 ? QD : KD_) + ((size_t)(b * 4 + hh) * TZ + s) * 64 + nn * 32 + ii;
                    *(u32x2*)dst = pack4(o[0], o[1], o[2], o[3]);
                }
                *(u32x2*)(Vs + rt * 264 + i0) = *(const u32x2*)(pd + 512 + i0);
            }
            {
                const bf16_t* pr = PR + (size_t)z * 1024;
                const bool hp = (s != 0) && (s != CTX), hn = (s != CTX - 1) && (s != TZ - 1);
#pragma unroll
                for (int q = 0; q < 4; ++q) {
                    const int col = q * 256 + lane * 4;
                    float cu[4], pv[4] = {0.f, 0.f, 0.f, 0.f}, nx[4] = {0.f, 0.f, 0.f, 0.f};
                    unpack4(*(const u32x2*)(pr + col), cu);
                    if (hp) unpack4(*(const u32x2*)(pr - 1024 + col), pv);
                    if (hn) unpack4(*(const u32x2*)(pr + 1024 + col), nx);
                    const float4 m = *(const float4*)(mu + col);
                    float zv[4];
                    zv[0] = cu[0] + (0.5f * (pv[0] + nx[0]) - cu[0]) * m.x; zv[1] = cu[1] + (0.5f * (pv[1] + nx[1]) - cu[1]) * m.y;
                    zv[2] = cu[2] + (0.5f * (pv[2] + nx[2]) - cu[2]) * m.z; zv[3] = cu[3] + (0.5f * (pv[3] + nx[3]) - cu[3]) * m.w;
                    if (q == 0) *(u32x2*)(RB + (size_t)z * 256 + lane * 4) = pack4(zv[0], zv[1], zv[2], zv[3]);
                    else if (q == 1) {
                        *(u32x2*)(KB + (size_t)z * 256 + lane * 4) = pack4(zv[0], zv[1], zv[2], zv[3]);
                        const float4 kk4 = *(const float4*)(k_k + lane * 4);
                        const float a0 = zv[0] * kk4.x, a1 = zv[1] * kk4.y, a2 = zv[2] * kk4.z, a3 = zv[3] * kk4.w;
                        const float ssq = sum16(a0 * a0 + a1 * a1 + a2 * a2 + a3 * a3);
                        const float inv = 1.f / fmaxf(sqrtf(ssq), 1e-12f);
                        *(u32x2*)(KKB + (size_t)z * 256 + lane * 4) = pack4(a0 * inv, a1 * inv, a2 * inv, a3 * inv);
                    } else if (q == 2) *(u32x2*)(VB + (size_t)z * 256 + lane * 4) = pack4(zv[0], zv[1], zv[2], zv[3]);
                    else {
                        if (lane < 16) *(u32x2*)(TW + (size_t)z * 64 + lane * 4) = pack4(tanhf(zv[0]), tanhf(zv[1]), tanhf(zv[2]), tanhf(zv[3]));
                        else if (lane < 32) *(u32x2*)(AL + (size_t)z * 64 + (lane - 16) * 4) = pack4(zv[0], zv[1], zv[2], zv[3]);
                        else *(u32x2*)(SG + (size_t)z * 128 + (lane - 32) * 4) = pack4(sigmoidf_(zv[0]), sigmoidf_(zv[1]), sigmoidf_(zv[2]), sigmoidf_(zv[3]));
                    }
                }
            }
        }
        __syncthreads();
        {
            const int z0 = tile * 64, b = z0 / TZ, s0 = z0 % TZ;
#pragma unroll
            for (int i = 0; i < 4; ++i) {
                const int ch = tid + i * NTHR, dv = ch >> 3, r8 = (ch & 7) * 8;
                bf16_t v[8];
#pragma unroll
                for (int j = 0; j < 8; ++j) v[j] = Vs[(r8 + j) * 264 + dv];
                u32x4 o; o.x = v[0] | ((unsigned)v[1] << 16); o.y = v[2] | ((unsigned)v[3] << 16); o.z = v[4] | ((unsigned)v[5] << 16); o.w = v[6] | ((unsigned)v[7] << 16);
                *(u32x4*)(VDT + ((size_t)(b * 4 + (dv >> 6)) * 64 + (dv & 63)) * TZ + s0 + r8) = o;
            }
        }
    }
}

constexpr int S5C = 128, S5N = TZ / S5C;
DI int s5_tok(int dir, int i) { return dir == 0 ? i : (i < CTX ? CTX - 1 - i : TZ - 1 - (i - CTX)); }
DI void s5_stage_u(const Ctx& c, float* U, int b, int dir, int chunk, int g0, int ng) {
    const bf16_t* PS = (const bf16_t*)(c.ws + WS_P + P_PS);
    const int per = ng * 4;
    for (int e = c.tid; e < S5C * per; e += NTHR) {
        const int i = e / per, c4 = (e % per) * 4, s = s5_tok(dir, chunk * S5C + i);
        float x[4]; unpack4(*(const u32x2*)(PS + (size_t)(b * TZ + s) * 256 + g0 * 16 + c4), x);
        *(float4*)(U + i * (ng * 16) + c4) = make_float4(x[0], x[1], x[2], x[3]);
    }
}
DI void phase_s5_local(const Ctx& c, int l) {
    float* U = (float*)c.smem;
    const float* s5t = (const float*)(c.ws + WS_WSM + OFF_S5T);
    float* E = (float*)(c.ws + WS_WSM + OFF_S5E);
    for (int u = blockIdx.x; u < 2 * 2 * S5N * 2; u += gridDim.x) {
        const int gq = u & 1, chunk = (u >> 1) % S5N, dir = (u / (2 * S5N)) & 1, b = u / (4 * S5N);
        __syncthreads();
        s5_stage_u(c, U, b, dir, chunk, gq * 8, 8);
        __syncthreads();
        const int g = gq * 8 + c.wave, p = c.lane;
        const float* tb = s5t + ((size_t)((l * 2 + dir) * 16 + g) * 64 + p) * 36;
        const float are = tb[0], aim = tb[1];
        float br[16], bi[16];
#pragma unroll
        for (int ch = 0; ch < 16; ++ch) { br[ch] = tb[4 + ch]; bi[ch] = tb[20 + ch]; }
        float xr = 0.f, xi = 0.f;
        for (int i = 0; i < S5C; ++i) {
            const float* uu = U + i * 128 + c.wave * 16;
            float sr = 0.f, si = 0.f;
#pragma unroll
            for (int q = 0; q < 4; ++q) { const float4 v = *(const float4*)(uu + q * 4);
                sr += br[q * 4] * v.x + br[q * 4 + 1] * v.y + br[q * 4 + 2] * v.z + br[q * 4 + 3] * v.w;
                si += bi[q * 4] * v.x + bi[q * 4 + 1] * v.y + bi[q * 4 + 2] * v.z + bi[q * 4 + 3] * v.w; }
            const float nr = are * xr - aim * xi + sr, ni = are * xi + aim * xr + si; xr = nr; xi = ni;
        }
        *(float2*)(E + ((size_t)(((b * 2 + dir) * 16 + g) * S5N + chunk) * 64 + p) * 2) = make_float2(xr, xi);
    }
}
DI void phase_s5_carry(const Ctx& c, int l) {
    const int gt = blockIdx.x * NTHR + c.tid;
    if (gt < 2 * 2 * 16 * 64) {
        const int p = gt & 63, g = (gt >> 6) & 15, dir = (gt >> 10) & 1, b = gt >> 11;
        const float* tb = (const float*)(c.ws + WS_WSM + OFF_S5T) + ((size_t)((l * 2 + dir) * 16 + g) * 64 + p) * 36;
        const float ar = tb[2], ai = tb[3];
        const float* E = (const float*)(c.ws + WS_WSM + OFF_S5E) + (size_t)(((b * 2 + dir) * 16 + g) * S5N) * 128;
        float* C = (float*)(c.ws + WS_WSM + OFF_S5C) + (size_t)(((b * 2 + dir) * 16 + g) * S5N) * 128;
        float xr = 0.f, xi = 0.f;
        for (int ch = 0; ch < S5N; ++ch) {
            *(float2*)(C + ch * 128 + p * 2) = make_float2(xr, xi);
            const float2 e = *(const float2*)(E + ch * 128 + p * 2);
            const float nr = ar * xr - ai * xi + e.x, ni = ar * xi + ai * xr + e.y; xr = nr; xi = ni;
        }
    }
}

DI void phase_s5_final_unit(const Ctx& c, int l, int u) {
    float* U = (float*)c.smem;
    float* Y = U + S5C * 64;
    float* X = Y + 2 * S5C * 64;
    const float* s5t = (const float*)(c.ws + WS_WSM + OFF_S5T);
    const float* CIN = (const float*)(c.ws + WS_WSM + OFF_S5C);
    const int gq = u & 3, ct = (u >> 2) % S5N, b = u / (4 * S5N);
    const int wave = c.wave, lane = c.lane, gl = wave >> 1, dir = wave & 1, g = gq * 4 + gl, p = lane;
    __syncthreads();
    s5_stage_u(c, U, b, 0, ct, gq * 4, 4);
    __syncthreads();
    {
        float* Xw = X + wave * 4 * 128;
        const int cd = dir == 0 ? ct : (ct < 2 ? 1 - ct : 67 - ct);
        const float* tb = s5t + ((size_t)((l * 2 + dir) * 16 + g) * 64 + p) * 36;
        const float are = tb[0], aim = tb[1];
        float br[16], bi[16];
#pragma unroll
        for (int ch = 0; ch < 16; ++ch) { br[ch] = tb[4 + ch]; bi[ch] = tb[20 + ch]; }
        const float2 ci = *(const float2*)(CIN + ((size_t)(((b * 2 + dir) * 16 + g) * S5N + cd) * 64 + p) * 2);
        float xr = ci.x, xi = ci.y;
        const int tt = lane >> 4, chn = lane & 15;
        const float* cre = c.in[29] + ((size_t)((l * 2 + dir) * 16 + g) * 16 + chn) * 64;
        const float* cim = c.in[30] + ((size_t)((l * 2 + dir) * 16 + g) * 16 + chn) * 64;
        const float dsk = c.in[31][(size_t)l * 256 + g * 16 + chn];
        for (int i0 = 0; i0 < S5C; i0 += 4) {
#pragma unroll
            for (int k = 0; k < 4; ++k) {
                const int tl = dir == 0 ? (i0 + k) : S5C - 1 - (i0 + k);
                const float* uu = U + tl * 64 + gl * 16;
                float sr = 0.f, si = 0.f;
#pragma unroll
                for (int q = 0; q < 4; ++q) { const float4 v = *(const float4*)(uu + q * 4);
                    sr += br[q * 4] * v.x + br[q * 4 + 1] * v.y + br[q * 4 + 2] * v.z + br[q * 4 + 3] * v.w;
                    si += bi[q * 4] * v.x + bi[q * 4 + 1] * v.y + bi[q * 4 + 2] * v.z + bi[q * 4 + 3] * v.w; }
                const float nr = are * xr - aim * xi + sr, ni = are * xi + aim * xr + si; xr = nr; xi = ni;
                *(float2*)(Xw + k * 128 + p * 2) = make_float2(xr, xi);
            }
            float y = 0.f;
            const float* xs = Xw + tt * 128;
#pragma unroll 4
            for (int pp = 0; pp < 64; pp += 4) {
                const float4 x0 = *(const float4*)(xs + pp * 2), x1 = *(const float4*)(xs + pp * 2 + 4);
                const float4 a = *(const float4*)(cre + pp), bq = *(const float4*)(cim + pp);
                y += a.x * x0.x - bq.x * x0.y + a.y * x0.z - bq.y * x0.w + a.z * x1.x - bq.z * x1.y + a.w * x1.z - bq.w * x1.w;
            }
            const int tl = dir == 0 ? (i0 + tt) : S5C - 1 - (i0 + tt);
            if (dir == 0) y += dsk * U[tl * 64 + gl * 16 + chn];
            Y[(dir * S5C + tl) * 64 + gl * 16 + chn] = y;
        }
    }
    __syncthreads();
    bf16_t* ZG = (bf16_t*)(c.ws + WS_MISC + MS_ZG);
    for (int e = c.tid; e < S5C * 16; e += NTHR) {
        const int i = e >> 4, c4 = (e & 15) * 4; const float4 y0 = *(const float4*)(Y + i * 64 + c4), y1 = *(const float4*)(Y + (S5C + i) * 64 + c4);
        *(u32x2*)(ZG + (size_t)(b * TZ + ct * S5C + i) * 256 + gq * 64 + c4) = pack4(gelu_tanh(y0.x + y1.x), gelu_tanh(y0.y + y1.y), gelu_tanh(y0.z + y1.z), gelu_tanh(y0.w + y1.w));
    }
}

DI void phase_small_gemms(const Ctx& c, int l) {
    unsigned char* ws = c.ws; unsigned char* wsm = ws + WS_WSM;
    const bf16_t* CQN = (const bf16_t*)(ws + WS_MISC + MS_CQN);
    const float* rope = (const float*)(wsm + OFF_ROPE);
    constexpr int NMT = NZ / 256;
    int base = 0;
    const int G = gridDim.x, bid = blockIdx.x;
    {
        const bf16_t* W = (const bf16_t*)(wsm + OFF_WUQT + l * SZ_WUQT); bf16_t* QM = (bf16_t*)(ws + WS_EXPW + MX_QM);
        const float qs = 0.10206207261596577f * LOG2E;
        for (int u = (bid + G - base % G) % G; u < NMT * 3; u += G) {
            const int mt = u / 3, nt = u % 3, r0 = mt * 256, c0 = nt * 128;
            gemm_tile<4, 0>(c, 256, [&](int i) { return CQN + (size_t)(r0 + i) * 384; }, [&](int i) { return W + (size_t)(c0 + i) * 256; }, NoHook(),
                [&](f32x4 (&acc)[4][4], int wr, int wc, int fr, int fq) {
#pragma unroll
                    for (int n = 0; n < 4; ++n) {
                        const int col = c0 + wc + n * 16 + fq * 4, h = col / 96, d = col % 96;
                        const bool rp = d >= 64;
#pragma unroll
                        for (int m = 0; m < 4; ++m) {
                            const int row = r0 + wr + m * 16 + fr, b = row / TZ, s = row % TZ; f32x4 v = acc[m][n];
                            f32x4 pv; pv[0] = __shfl_xor(v[0], 32, 64); pv[1] = __shfl_xor(v[1], 32, 64); pv[2] = __shfl_xor(v[2], 32, 64); pv[3] = __shfl_xor(v[3], 32, 64);
                            if (rp && s >= CTX) {
                                const int i0 = d - 64;
                                const float* cs = rope + ((size_t)(s - CTX) * 16 + (i0 >> 4) * 8 + (i0 & 7)) * 2;
                                const bool hi = (i0 & 8) != 0;
#pragma unroll
                                for (int j = 0; j < 4; ++j) v[j] = v[j] * cs[2 * j] + (hi ? pv[j] : -pv[j]) * cs[2 * j + 1];
                            }
                            *(u32x2*)(QM + ((size_t)(b * 4 + h) * TZ + s) * 96 + d) = pack4(v[0] * qs, v[1] * qs, v[2] * qs, v[3] * qs);
                        }
                    }
                });
        }
        base += NMT * 3;
    }
    {
        const bf16_t* W = (const bf16_t*)(wsm + OFF_WUKVT + l * SZ_WUKVT); bf16_t* KM = (bf16_t*)(ws + WS_EXPW + MX_KM); bf16_t* VMT = (bf16_t*)(ws + WS_EXPW + MX_VMT);
        for (int u = (bid + G - base % G) % G; u < NMT * 4; u += G) {
            const int mt = u / 4, nt = u % 4, r0 = mt * 256, c0 = nt * 128;
            gemm_tile<4, 0>(c, 128, [&](int i) { return CQN + (size_t)(r0 + i) * 384 + 256; }, [&](int i) { return W + (size_t)(c0 + i) * 128; }, NoHook(),
                [&](f32x4 (&acc)[4][4], int wr, int wc, int fr, int fq) {
#pragma unroll
                    for (int n = 0; n < 4; ++n) {
                        const int col = c0 + wc + n * 16 + fq * 4, h = col >> 7, d = col & 127;
#pragma unroll
                        for (int m = 0; m < 4; ++m) {
                            const int row = r0 + wr + m * 16 + fr, b = row / TZ, s = row % TZ; const f32x4 v = acc[m][n];
                            if (d < 64) *(u32x2*)(KM + ((size_t)(b * 4 + h) * TZ + s) * 96 + d) = pack4(v[0], v[1], v[2], v[3]);
                            else {
#pragma unroll
                                for (int j = 0; j < 4; ++j) VMT[((size_t)(b * 4 + h) * 64 + (d - 64 + j)) * TZ + s] = f2bf(v[j]);
                            }
                        }
                    }
                });
        }
        base += NMT * 4;
    }
    bf16_t* SE = (bf16_t*)(ws + WS_P + P_PR); bf16_t* SAD = SE + (size_t)2 * NZ * 256; bf16_t* SKD = SAD + (size_t)2 * NZ * 256;
    {
        const bf16_t* A = (const bf16_t*)(ws + WS_MISC + MS_TW); const bf16_t* W = (const bf16_t*)(wsm + OFF_W2T + l * SZ_W2T);
        const float* w0 = c.in[14] + (size_t)l * 512;
        for (int u = (bid + G - base % G) % G; u < NMT * 4; u += G) {
            const int mt = u / 4, nt = u % 4, r0 = mt * 256, c0 = nt * 128;
            gemm_tile<4, 0>(c, 64, [&](int i) { return A + (size_t)(r0 + i) * 64; }, [&](int i) { return W + (size_t)(c0 + i) * 64; }, NoHook(),
                [&](f32x4 (&acc)[4][4], int wr, int wc, int fr, int fq) {
#pragma unroll
                    for (int n = 0; n < 4; ++n) {
                        const int col = c0 + wc + n * 16 + fq * 4, d = col >> 8, cc = col & 255; const float4 w0v = *(const float4*)(w0 + col);
#pragma unroll
                        for (int m = 0; m < 4; ++m) {
                            const int row = r0 + wr + m * 16 + fr; const f32x4 v = acc[m][n]; float e[4];
                            const float x[4] = {w0v.x + v[0], w0v.y + v[1], w0v.z + v[2], w0v.w + v[3]};
#pragma unroll
                            for (int j = 0; j < 4; ++j) { const float sp = (x[j] < -20.f) ? -x[j] : log1pf(__expf(-x[j])); e[j] = __expf(-sp - 0.5f); }
                            *(u32x2*)(SE + ((size_t)d * NZ + row) * 256 + cc) = pack4(e[0], e[1], e[2], e[3]);
                        }
                    }
                });
        }
        base += NMT * 4;
    }
    {
        const bf16_t* A = (const bf16_t*)(ws + WS_MISC + MS_AL); const bf16_t* W = (const bf16_t*)(wsm + OFF_A2T + l * SZ_A2T);
        const float* a0 = c.in[16] + (size_t)l * 512; const float* k_a = c.in[20] + (size_t)l * 256; const bf16_t* KB = (const bf16_t*)(ws + WS_EXPW + MX_KB);
        for (int u = (bid + G - base % G) % G; u < NMT * 4; u += G) {
            const int mt = u / 4, nt = u % 4, r0 = mt * 256, c0 = nt * 128;
            gemm_tile<4, 0>(c, 64, [&](int i) { return A + (size_t)(r0 + i) * 64; }, [&](int i) { return W + (size_t)(c0 + i) * 64; }, NoHook(),
                [&](f32x4 (&acc)[4][4], int wr, int wc, int fr, int fq) {
#pragma unroll
                    for (int n = 0; n < 4; ++n) {
                        const int col = c0 + wc + n * 16 + fq * 4, d = col >> 8, cc = col & 255; const float4 a0v = *(const float4*)(a0 + col), kav = *(const float4*)(k_a + cc);
#pragma unroll
                        for (int m = 0; m < 4; ++m) {
                            const int row = r0 + wr + m * 16 + fr; const f32x4 v = acc[m][n];
                            const float ad0 = sigmoidf_(a0v.x + v[0]), ad1 = sigmoidf_(a0v.y + v[1]), ad2 = sigmoidf_(a0v.z + v[2]), ad3 = sigmoidf_(a0v.w + v[3]);
                            float k[4]; unpack4(*(const u32x2*)(KB + (size_t)row * 256 + cc), k);
                            *(u32x2*)(SAD + ((size_t)d * NZ + row) * 256 + cc) = pack4(ad0, ad1, ad2, ad3);
                            *(u32x2*)(SKD + ((size_t)d * NZ + row) * 256 + cc) = pack4(k[0] * (1.f + (ad0 - 1.f) * kav.x), k[1] * (1.f + (ad1 - 1.f) * kav.y), k[2] * (1.f + (ad2 - 1.f) * kav.z), k[3] * (1.f + (ad3 - 1.f) * kav.w));
                        }
                    }
                });
        }
        base += NMT * 4;
    }
    {
        const bf16_t* A = (const bf16_t*)(ws + WS_MISC + MS_SG); const bf16_t* W = (const bf16_t*)(wsm + OFF_G2T + l * SZ_G2T); bf16_t* GG = (bf16_t*)(ws + WS_MISC + MS_GG);
        for (int u = (bid + G - base % G) % G; u < NMT * 2; u += G) {
            const int mt = u / 2, nt = u % 2, r0 = mt * 256, c0 = nt * 128;
            gemm_tile<4, 0>(c, 128, [&](int i) { return A + (size_t)(r0 + i) * 128; }, [&](int i) { return W + (size_t)(c0 + i) * 128; }, NoHook(),
                [&](f32x4 (&acc)[4][4], int wr, int wc, int fr, int fq) {
#pragma unroll
                    for (int n = 0; n < 4; ++n)
#pragma unroll
                        for (int m = 0; m < 4; ++m) { const f32x4 v = acc[m][n];
                            *(u32x2*)(GG + (size_t)(r0 + wr + m * 16 + fr) * 256 + c0 + wc + n * 16 + fq * 4) = pack4(v[0], v[1], v[2], v[3]); }
                });
        }
        base += NMT * 2;
    }
}

DI int krow(int s, int h, int j) { return 16 * s + 8 * (j >> 2) + 4 * h + (j & 3); }
constexpr int ATT_PARK = 48 * 1024;
template <int MODE>
DI void attn_pass(const Ctx& c, int l, int b, int h, int q0, int nkeys) {
    constexpr int DROW = MODE == 0 ? 96 : 64;
    constexpr int DQ = MODE == 0 ? 96 : 32, KS = DQ / 16;
    constexpr int DOFF = MODE == 2 ? 32 : 0;
    constexpr int KPITCH = DQ * 2 + 16;
    constexpr int VPITCH = 64 * 2 + 16;
    constexpr int KBYTES = 64 * KPITCH, VBYTES = 64 * VPITCH, STG = KBYTES + VBYTES;
    unsigned char* ws = c.ws; const int tid = c.tid, lane = c.lane, wave = c.wave, r = lane & 31, hh = lane >> 5;
    const bf16_t* Q = (const bf16_t*)(ws + WS_EXPW + (MODE == 0 ? MX_QM : MX_QD)) + (size_t)(b * 4 + h) * TZ * DROW + DOFF;
    const bf16_t* Kp = (const bf16_t*)(ws + WS_EXPW + (MODE == 0 ? MX_KM : MX_KD)) + (size_t)(b * 4 + h) * TZ * DROW + DOFF;
    const bf16_t* Vt = (const bf16_t*)(ws + WS_EXPW + (MODE == 0 ? MX_VMT : MX_VDT)) + (size_t)(b * 4 + h) * 64 * TZ;
    unsigned char* smem = c.smem;
    bf16x8 qf[KS];
    const int qrow = q0 + wave * 32 + r;
#pragma unroll
    for (int ks = 0; ks < KS; ++ks) qf[ks] = *(const bf16x8*)(Q + (size_t)qrow * DROW + ks * 16 + hh * 8);
    f32x16 oacc[2];
    float mrun = -1e30f, lrun = 0.f;
#pragma unroll
    for (int t = 0; t < 2; ++t)
#pragma unroll
        for (int i = 0; i < 16; ++i) oacc[t][i] = 0.f;
    constexpr int CPR = DQ / 8, KCH = 64 * CPR;
    u32x4 kreg[2], vreg;
    auto gload = [&](int kt) {
        const int k0 = kt * 64;
#pragma unroll
        for (int i = 0; i < 2; ++i) { const int ch = tid + i * NTHR; if (ch < KCH) kreg[i] = *(const u32x4*)(Kp + (size_t)(k0 + ch / CPR) * DROW + (ch % CPR) * 8); }
        vreg = *(const u32x4*)(Vt + (size_t)(tid >> 3) * TZ + k0 + (tid & 7) * 8);
    };
    auto lstore = [&](int buf) {
        unsigned char* sk = smem + buf * STG; unsigned char* sv = sk + KBYTES;
#pragma unroll
        for (int i = 0; i < 2; ++i) { const int ch = tid + i * NTHR; if (ch < KCH) *(u32x4*)(sk + (ch / CPR) * KPITCH + (ch % CPR) * 16) = kreg[i]; }
        *(u32x4*)(sv + (tid >> 3) * VPITCH + (tid & 7) * 16) = vreg;
    };
    const int NT = nkeys / 64;
    __syncthreads();
    gload(0);
    for (int kt = 0; kt < NT; ++kt) {
        lstore(kt & 1);
        if (kt + 1 < NT) gload(kt + 1);
        __syncthreads();
        const unsigned char* sk = smem + (kt & 1) * STG; const unsigned char* sv = sk + KBYTES;
        f32x16 sacc[2];
#pragma unroll
        for (int kg = 0; kg < 2; ++kg) {
#pragma unroll
            for (int i = 0; i < 16; ++i) sacc[kg][i] = 0.f;
#pragma unroll
            for (int ks = 0; ks < KS; ++ks) {
                const bf16x8 kf = *(const bf16x8*)(sk + (kg * 32 + r) * KPITCH + ks * 32 + hh * 16);
                sacc[kg] = __builtin_amdgcn_mfma_f32_32x32x16_bf16(kf, qf[ks], sacc[kg], 0, 0, 0);
            }
        }
        float mx = sacc[0][0];
#pragma unroll
        for (int kg = 0; kg < 2; ++kg)
#pragma unroll
            for (int i = 0; i < 16; ++i) mx = fmaxf(mx, sacc[kg][i]);
        mx = fmaxf(mx, __shfl_xor(mx, 32, 64));
        const float mnew = fmaxf(mrun, mx), alpha = __builtin_amdgcn_exp2f(mrun - mnew);
        mrun = mnew;
        float psum = 0.f;
#pragma unroll
        for (int kg = 0; kg < 2; ++kg)
#pragma unroll
            for (int i = 0; i < 16; ++i) { const float p = __builtin_amdgcn_exp2f(sacc[kg][i] - mnew); sacc[kg][i] = p; psum += p; }
        lrun = lrun * alpha + psum;
#pragma unroll
        for (int t = 0; t < 2; ++t)
#pragma unroll
            for (int i = 0; i < 16; ++i) oacc[t][i] *= alpha;
#pragma unroll
        for (int kg = 0; kg < 2; ++kg)
#pragma unroll
            for (int s = 0; s < 2; ++s) {
                u32x4 pk; pk.x = pack2(sacc[kg][8 * s + 0], sacc[kg][8 * s + 1]); pk.y = pack2(sacc[kg][8 * s + 2], sacc[kg][8 * s + 3]);
                pk.z = pack2(sacc[kg][8 * s + 4], sacc[kg][8 * s + 5]); pk.w = pack2(sacc[kg][8 * s + 6], sacc[kg][8 * s + 7]);
                const bf16x8 pf = __builtin_bit_cast(bf16x8, pk);
#pragma unroll
                for (int t = 0; t < 2; ++t) {
                    const unsigned char* vrow = sv + (t * 32 + r) * VPITCH + (kg * 32 + 16 * s + 4 * hh) * 2;
                    const u32x2 lo = *(const u32x2*)vrow, hi2 = *(const u32x2*)(vrow + 16);
                    u32x4 vv; vv.x = lo.x; vv.y = lo.y; vv.z = hi2.x; vv.w = hi2.y;
                    oacc[t] = __builtin_amdgcn_mfma_f32_32x32x16_bf16(__builtin_bit_cast(bf16x8, vv), pf, oacc[t], 0, 0, 0);
                }
            }
    }
    const float inv = 1.f / (lrun + __shfl_xor(lrun, 32, 64));
    bf16_t* Ycat = (bf16_t*)(ws + WS_BUFA);
    const int zrow = b * TZ + qrow;
    float* park = (float*)(smem + ATT_PARK) + tid;
    if (MODE == 0) {
#pragma unroll
        for (int t = 0; t < 2; ++t)
#pragma unroll
            for (int i4 = 0; i4 < 4; ++i4) {
                const int dv = t * 32 + 8 * i4 + 4 * hh;
                *(u32x2*)(Ycat + (size_t)zrow * D + h * 64 + dv) = pack4(oacc[t][4 * i4] * inv, oacc[t][4 * i4 + 1] * inv, oacc[t][4 * i4 + 2] * inv, oacc[t][4 * i4 + 3] * inv);
            }
    } else if (MODE == 1) {
#pragma unroll
        for (int t = 0; t < 2; ++t)
#pragma unroll
            for (int i = 0; i < 16; ++i) park[(t * 16 + i) * NTHR] = oacc[t][i] * inv;
    } else {
        const float lam = ((const float*)(ws + WS_WSM + OFF_LAM))[l];
        const float lam_init = 0.8f - 0.6f * __expf(-0.3f * (float)l);
        float ss = 0.f;
#pragma unroll
        for (int t = 0; t < 2; ++t)
#pragma unroll
            for (int i = 0; i < 16; ++i) { const float o = park[(t * 16 + i) * NTHR] - lam * oacc[t][i] * inv; oacc[t][i] = o; ss += o * o; }
        ss += __shfl_xor(ss, 32, 64);
        const float rs = rsqrtf(ss * (1.f / 64.f) + 1e-5f) * (1.f - lam_init);
        const float* sg = c.in[38] + l * 64;
#pragma unroll
        for (int t = 0; t < 2; ++t)
#pragma unroll
            for (int i4 = 0; i4 < 4; ++i4) {
                const int dv = t * 32 + 8 * i4 + 4 * hh; const float4 g = *(const float4*)(sg + dv);
                *(u32x2*)(Ycat + (size_t)zrow * D + 768 + h * 64 + dv) = pack4(oacc[t][4 * i4] * rs * g.x, oacc[t][4 * i4 + 1] * rs * g.y, oacc[t][4 * i4 + 2] * rs * g.z, oacc[t][4 * i4 + 3] * rs * g.w);
            }
    }
}
DI void phase_attention(const Ctx& c, int l) {
    const int nu = 512 + (l == 0 ? 16 : 0);
    for (int u = blockIdx.x; u < nu; u += gridDim.x) {
        int b, h, q0, nk; bool mla;
        if (u < 512) { const int k = u & 255; b = k >> 7; h = (k >> 5) & 3; q0 = CTX + (k & 31) * 256; nk = TZ; mla = u < 256; }
        else { const int k = u - 512; b = (k >> 2) & 1; h = k & 3; q0 = 0; nk = CTX; mla = k < 8; }
        if (mla) attn_pass<0>(c, l, b, h, q0, nk);
        else { attn_pass<1>(c, l, b, h, q0, nk); attn_pass<2>(c, l, b, h, q0, nk); }
    }
}

DI int rw_tok(int dir, int i) { return dir == 0 ? i : (i < CTX ? CTX - 1 - i : TZ - 1 - (i - CTX)); }
constexpr int RW_TS = 32;
constexpr int RW_STEP_F = 6 * 64 + 2;
constexpr int RW_BUF_F = RW_TS * RW_STEP_F;
template <int CTRL> DI float dpp_add(float x) { return x + __int_as_float(__builtin_amdgcn_update_dpp(0, __float_as_int(x), CTRL, 0xf, 0xf, false)); }
DI float red16(float x) { x = dpp_add<0xB1>(x); x = dpp_add<0x4E>(x); x = dpp_add<0x141>(x); x = dpp_add<0x140>(x); return x; }
DI float red8(float x) { x = dpp_add<0xB1>(x); x = dpp_add<0x4E>(x); x = dpp_add<0x141>(x); return x; }
struct RwRegs { u32x4 r, v, kk, e, ad, kd; };
DI void rw_load(const Ctx& c, int b, int h, int dir, int chunk, int t, RwRegs& g) {
    const bf16_t* RB = (const bf16_t*)(c.ws + WS_EXPW + MX_RB); const bf16_t* VB = (const bf16_t*)(c.ws + WS_EXPW + MX_VB); const bf16_t* KKB = (const bf16_t*)(c.ws + WS_EXPW + MX_KKB);
    const bf16_t* SE = (const bf16_t*)(c.ws + WS_P + P_PR) + (size_t)dir * NZ * 256; const bf16_t* SAD = SE + (size_t)2 * NZ * 256; const bf16_t* SKD = SAD + (size_t)2 * NZ * 256;
    const int i = chunk * RW_TS + (t >> 3), z = b * TZ + rw_tok(dir, i); const size_t o = (size_t)z * 256 + h * 64 + (t & 7) * 8;
    g.r = *(const u32x4*)(RB + o); g.v = *(const u32x4*)(VB + o); g.kk = *(const u32x4*)(KKB + o);
    g.e = *(const u32x4*)(SE + o); g.ad = *(const u32x4*)(SAD + o); g.kd = *(const u32x4*)(SKD + o);
}
DI void up8(const u32x4& u, float (&f)[8]) { f[0] = lo2f(u.x); f[1] = hi2f(u.x); f[2] = lo2f(u.y); f[3] = hi2f(u.y); f[4] = lo2f(u.z); f[5] = hi2f(u.z); f[6] = lo2f(u.w); f[7] = hi2f(u.w); }
DI void rw_process(const RwRegs& g, int t, float* buf) {
    float r[8], v[8], kk[8], e[8], ad[8], kd[8];
    up8(g.r, r); up8(g.v, v); up8(g.kk, kk); up8(g.e, e); up8(g.ad, ad); up8(g.kd, kd);
    float* f = buf + (t >> 3) * RW_STEP_F + (t & 7) * 8;
    float w[8], bv[8], wr[8]; float br = 0.f, kr = 0.f;
#pragma unroll
    for (int j = 0; j < 8; ++j) { w[j] = __expf(-e[j]); bv[j] = kk[j] * ad[j]; wr[j] = w[j] * r[j]; br += bv[j] * r[j]; kr += kd[j] * r[j]; }
    *(float4*)(f) = make_float4(w[0], w[1], w[2], w[3]); *(float4*)(f + 4) = make_float4(w[4], w[5], w[6], w[7]);
    *(float4*)(f + 64) = make_float4(kk[0], kk[1], kk[2], kk[3]); *(float4*)(f + 68) = make_float4(kk[4], kk[5], kk[6], kk[7]);
    *(float4*)(f + 128) = make_float4(bv[0], bv[1], bv[2], bv[3]); *(float4*)(f + 132) = make_float4(bv[4], bv[5], bv[6], bv[7]);
    *(float4*)(f + 192) = make_float4(kd[0], kd[1], kd[2], kd[3]); *(float4*)(f + 196) = make_float4(kd[4], kd[5], kd[6], kd[7]);
    *(float4*)(f + 256) = make_float4(wr[0], wr[1], wr[2], wr[3]); *(float4*)(f + 260) = make_float4(wr[4], wr[5], wr[6], wr[7]);
    *(float4*)(f + 320) = make_float4(v[0], v[1], v[2], v[3]); *(float4*)(f + 324) = make_float4(v[4], v[5], v[6], v[7]);
    br = red8(br); kr = red8(kr);
    if ((t & 7) == 0) { float* s = buf + (t >> 3) * RW_STEP_F + 384; s[0] = br; s[1] = kr; }
}
struct RwStep { float4 w, kk, bv, kd, wr; float vv, br, kr; };
DI void rw_ld(RwStep& s, const float* f, int kq, int row) {
    s.w = *(const float4*)(f + kq * 4); s.kk = *(const float4*)(f + 64 + kq * 4); s.bv = *(const float4*)(f + 128 + kq * 4);
    s.kd = *(const float4*)(f + 192 + kq * 4); s.wr = *(const float4*)(f + 256 + kq * 4); s.vv = f[320 + row]; s.br = f[384]; s.kr = f[385];
}
DI void phase_rwkv_scan_unit(const Ctx& c, int l, int u) {
    const int rg = u & 3, chain = u >> 2, dir = chain & 1, h = (chain >> 1) & 3, b = chain >> 3;
    float* buf0 = (float*)c.smem; float* buf1 = buf0 + RW_BUF_F;
    float* ybuf = buf1 + RW_BUF_F;
    float* YO = (float*)(c.ws + WS_BUFB) + (size_t)dir * NZ * 256 + (size_t)b * TZ * 256 + h * 64 + rg * 16;
    const int wave = c.wave, lane = c.lane, rr = lane >> 4, kq = lane & 15, rl = (wave & 3) * 4 + rr, row = rg * 16 + rl;
    const int t = c.tid - 256;
    float S0 = 0.f, S1 = 0.f, S2 = 0.f, S3 = 0.f;
    constexpr int NCH = TZ / RW_TS;
    RwRegs g;
    __syncthreads();
    if (wave >= 4) { rw_load(c, b, h, dir, 0, t, g); rw_process(g, t, buf0); rw_load(c, b, h, dir, 1, t, g); }
    __syncthreads();
    for (int ch = 0; ch < NCH; ++ch) {
        float* cur = buf0 + (ch & 1) * RW_BUF_F; float* nxt = buf0 + ((ch + 1) & 1) * RW_BUF_F;
        if (wave >= 4) {
            if (ch > 0) {
                const float* yb = ybuf + ((ch - 1) & 1) * RW_TS * 16;
#pragma unroll
                for (int i = 0; i < 2; ++i) { const int e = t + i * 256, st = e >> 4, rw = e & 15; YO[(size_t)rw_tok(dir, (ch - 1) * RW_TS + st) * 256 + rw] = yb[e]; }
            }
            if (ch + 1 < NCH) rw_process(g, t, nxt);
            if (ch + 2 < NCH) rw_load(c, b, h, dir, ch + 2, t, g);
        } else {
            float* yb = ybuf + (ch & 1) * RW_TS * 16 + rl;
            RwStep s0, s1;
            rw_ld(s0, cur, kq, row);
#pragma unroll 4
            for (int st = 0; st < RW_TS; st += 2) {
                rw_ld(s1, cur + (st + 1) * RW_STEP_F, kq, row);
                {
                    float sa = -((S0 * s0.kk.x + S1 * s0.kk.y) + (S2 * s0.kk.z + S3 * s0.kk.w));
                    float q = (S0 * s0.wr.x + S1 * s0.wr.y) + (S2 * s0.wr.z + S3 * s0.wr.w);
                    sa = red16(sa); q = red16(q);
                    S0 = fmaf(sa, s0.bv.x, fmaf(S0, s0.w.x, s0.vv * s0.kd.x)); S1 = fmaf(sa, s0.bv.y, fmaf(S1, s0.w.y, s0.vv * s0.kd.y));
                    S2 = fmaf(sa, s0.bv.z, fmaf(S2, s0.w.z, s0.vv * s0.kd.z)); S3 = fmaf(sa, s0.bv.w, fmaf(S3, s0.w.w, s0.vv * s0.kd.w));
                    yb[st * 16] = q + sa * s0.br + s0.vv * s0.kr;
                }
                if (st + 2 < RW_TS) rw_ld(s0, cur + (st + 2) * RW_STEP_F, kq, row);
                {
                    float sa = -((S0 * s1.kk.x + S1 * s1.kk.y) + (S2 * s1.kk.z + S3 * s1.kk.w));
                    float q = (S0 * s1.wr.x + S1 * s1.wr.y) + (S2 * s1.wr.z + S3 * s1.wr.w);
                    sa = red16(sa); q = red16(q);
                    S0 = fmaf(sa, s1.bv.x, fmaf(S0, s1.w.x, s1.vv * s1.kd.x)); S1 = fmaf(sa, s1.bv.y, fmaf(S1, s1.w.y, s1.vv * s1.kd.y));
                    S2 = fmaf(sa, s1.bv.z, fmaf(S2, s1.w.z, s1.vv * s1.kd.z)); S3 = fmaf(sa, s1.bv.w, fmaf(S3, s1.w.w, s1.vv * s1.kd.w));
                    yb[(st + 1) * 16] = q + sa * s1.br + s1.vv * s1.kr;
                }
            }
        }
        __syncthreads();
    }
    if (wave >= 4) {
        const float* yb = ybuf + ((NCH - 1) & 1) * RW_TS * 16;
#pragma unroll
        for (int i = 0; i < 2; ++i) { const int e = t + i * 256, st = e >> 4, rw = e & 15; YO[(size_t)rw_tok(dir, (NCH - 1) * RW_TS + st) * 256 + rw] = yb[e]; }
    }
}

DI void phase_mixers2(const Ctx& c, int l) {
    const int G = gridDim.x, bid = blockIdx.x;
    if (G >= 128) {
        if (bid < 64) phase_rwkv_scan_unit(c, l, bid);
        else for (int u = bid - 64; u < 2 * S5N * 4; u += G - 64) phase_s5_final_unit(c, l, u);
    } else {
        for (int u = bid; u < 64; u += G) phase_rwkv_scan_unit(c, l, u);
        for (int u = bid; u < 2 * S5N * 4; u += G) phase_s5_final_unit(c, l, u);
    }
}

DI void phase_post(const Ctx& c, int l) {
    unsigned char* ws = c.ws; const int lane = c.lane;
    const float* YF = (const float*)(ws + WS_BUFB); const float* YB = YF + (size_t)NZ * 256;
    const bf16_t* RB = (const bf16_t*)(ws + WS_EXPW + MX_RB); const bf16_t* VB = (const bf16_t*)(ws + WS_EXPW + MX_VB);
    const bf16_t* SKD = (const bf16_t*)(ws + WS_P + P_PR) + (size_t)4 * NZ * 256; const bf16_t* GG = (const bf16_t*)(ws + WS_MISC + MS_GG);
    bf16_t* Ycat = (bf16_t*)(ws + WS_BUFA);
    const float* r_k = c.in[21] + l * 256; const float* lg = c.in[22] + l * 256; const float* lb = c.in[23] + l * 256;
    for (int z = blockIdx.x * 8 + c.wave; z < NZ; z += gridDim.x * 8) {
        const size_t o = (size_t)z * 256 + lane * 4;
        const float4 yf = *(const float4*)(YF + o), yb = *(const float4*)(YB + o);
        const float y0 = yf.x + yb.x, y1 = yf.y + yb.y, y2 = yf.z + yb.z, y3 = yf.w + yb.w;
        const float mean = sum16(y0 + y1 + y2 + y3) * (1.f / 64.f);
        const float d0 = y0 - mean, d1 = y1 - mean, d2 = y2 - mean, d3 = y3 - mean;
        const float var = sum16(d0 * d0 + d1 * d1 + d2 * d2 + d3 * d3) * (1.f / 64.f);
        const float rs = rsqrtf(var + 64e-5f);
        float r[4], v[4], k0[4], k1[4], gg[4];
        unpack4(*(const u32x2*)(RB + o), r); unpack4(*(const u32x2*)(VB + o), v); unpack4(*(const u32x2*)(SKD + o), k0); unpack4(*(const u32x2*)(SKD + (size_t)NZ * 256 + o), k1);
        unpack4(*(const u32x2*)(GG + o), gg);
        const float4 rk = *(const float4*)(r_k + lane * 4), g4 = *(const float4*)(lg + lane * 4), b4 = *(const float4*)(lb + lane * 4);
        const float bs = sum16(r[0] * (k0[0] + k1[0]) * rk.x + r[1] * (k0[1] + k1[1]) * rk.y + r[2] * (k0[2] + k1[2]) * rk.z + r[3] * (k0[3] + k1[3]) * rk.w);
        *(u32x2*)(Ycat + (size_t)z * D + 256 + lane * 4) = pack4((d0 * rs * g4.x + b4.x + bs * v[0]) * gg[0], (d1 * rs * g4.y + b4.y + bs * v[1]) * gg[1],
                                                                (d2 * rs * g4.z + b4.z + bs * v[2]) * gg[2], (d3 * rs * g4.w + b4.w + bs * v[3]) * gg[3]);
    }
    {
        const bf16_t* ZG = (const bf16_t*)(ws + WS_MISC + MS_ZG); const bf16_t* W = (const bf16_t*)(ws + WS_WSM + OFF_GLUT + l * SZ_GLUT);
        const float* gb = c.in[33] + l * 256;
        for (int u = blockIdx.x; u < (NZ / 256) * 2; u += gridDim.x) {
            const int mt = u / 2, nt = u % 2, r0 = mt * 256, c0 = nt * 128;
            gemm_tile<4, 0>(c, 256, [&](int i) { return ZG + (size_t)(r0 + i) * 256; }, [&](int i) { return W + (size_t)(c0 + i) * 256; }, NoHook(),
                [&](f32x4 (&acc)[4][4], int wr, int wc, int fr, int fq) {
#pragma unroll
                    for (int n = 0; n < 4; ++n) {
                        const int col = c0 + wc + n * 16 + fq * 4; const float4 bb = *(const float4*)(gb + col);
#pragma unroll
                        for (int m = 0; m < 4; ++m) {
                            const int row = r0 + wr + m * 16 + fr; const f32x4 v = acc[m][n];
                            float zg[4]; unpack4(*(const u32x2*)(ZG + (size_t)row * 256 + col), zg);
                            *(u32x2*)(Ycat + (size_t)row * D + 512 + col) = pack4(zg[0] * sigmoidf_(v[0] + bb.x), zg[1] * sigmoidf_(v[1] + bb.y), zg[2] * sigmoidf_(v[2] + bb.z), zg[3] * sigmoidf_(v[3] + bb.w));
                        }
                    }
                });
        }
    }
}

DI bool skip_mt(int l, int mt) { return l == NL - 1 && (mt % 33) == 0; }
DI void phase_merge1(const Ctx& c, int l) {
    const bf16_t* Ycat = (const bf16_t*)(c.ws + WS_BUFA); const bf16_t* W = (const bf16_t*)(c.ws + WS_WSM + OFF_WBT + l * SZ_WBT);
    const bf16_t* GT = (const bf16_t*)(c.ws + WS_GT); bf16_t* MG = (bf16_t*)(c.ws + WS_BUFB);
    if (blockIdx.x == 0 && c.tid < 32) ((unsigned*)(c.ws + WS_CTL))[CW_CNT + l * 32 + c.tid] = 0u;
    for (int u = blockIdx.x; u < (NZ / 256) * 8; u += gridDim.x) {
        const int mt = u / 8, nt = u % 8, r0 = mt * 256, c0 = nt * 128;
        if (skip_mt(l, mt)) continue;
        f32x4 macc[4][4];
#pragma unroll
        for (int m = 0; m < 4; ++m)
#pragma unroll
            for (int n = 0; n < 4; ++n) macc[m][n] = (f32x4){0.f, 0.f, 0.f, 0.f};
        gemm_tile<4, 256>(c, 1024, [&](int i) { return Ycat + (size_t)(r0 + i) * D; }, [&](int i) { return W + (size_t)(c0 + i) * D; },
            [&](f32x4 (&acc)[4][4], int seg, int wr, int wc, int fr, int fq) {
#pragma unroll
                for (int m = 0; m < 4; ++m)
#pragma unroll
                    for (int n = 0; n < 4; ++n) {
                        float g[4]; unpack4(*(const u32x2*)(GT + (size_t)(r0 + wr + m * 16 + fr) * 4096 + seg * 1024 + c0 + wc + n * 16 + fq * 4), g);
                        macc[m][n][0] += g[0] * acc[m][n][0]; macc[m][n][1] += g[1] * acc[m][n][1]; macc[m][n][2] += g[2] * acc[m][n][2]; macc[m][n][3] += g[3] * acc[m][n][3];
                        acc[m][n] = (f32x4){0.f, 0.f, 0.f, 0.f};
                    }
            },
            [&](f32x4 (&)[4][4], int wr, int wc, int fr, int fq) {
#pragma unroll
                for (int m = 0; m < 4; ++m)
#pragma unroll
                    for (int n = 0; n < 4; ++n)
                        *(u32x2*)(MG + (size_t)(r0 + wr + m * 16 + fr) * D + c0 + wc + n * 16 + fq * 4) = pack4(macc[m][n][0], macc[m][n][1], macc[m][n][2], macc[m][n][3]);
            });
    }
}
DI void phase_merge2(const Ctx& c, int l) {
    const bf16_t* MG = (const bf16_t*)(c.ws + WS_BUFB); const bf16_t* W = (const bf16_t*)(c.ws + WS_WSM + OFF_WOUTT + l * SZ_WOUTT);
    float* H = (float*)(c.ws + WS_H); const float* modv = (const float*)(c.ws + WS_WSM + OFF_MODV);
    for (int u = blockIdx.x; u < (NZ / 256) * 8; u += gridDim.x) {
        const int mt = u / 8, nt = u % 8, r0 = mt * 256, c0 = nt * 128;
        if (skip_mt(l, mt)) continue;
        const int sel = (mt % 33) == 0 ? 2 : mt / 33;
        gemm_tile<4, 0>(c, 1024, [&](int i) { return MG + (size_t)(r0 + i) * D; }, [&](int i) { return W + (size_t)(c0 + i) * D; }, NoHook(),
            [&](f32x4 (&acc)[4][4], int wr, int wc, int fr, int fq) {
#pragma unroll
                for (int n = 0; n < 4; ++n) {
                    const int col = c0 + wc + n * 16 + fq * 4; const float4 m2 = *(const float4*)(modv + ((size_t)l * 3 + sel) * 6144 + 2 * 1024 + col);
#pragma unroll
                    for (int m = 0; m < 4; ++m) {
                        float4* hp = (float4*)(H + (size_t)(r0 + wr + m * 16 + fr) * D + col); float4 hv = *hp; const f32x4 v = acc[m][n];
                        hv.x += m2.x * v[0]; hv.y += m2.y * v[1]; hv.z += m2.z * v[2]; hv.w += m2.w * v[3]; *hp = hv;
                    }
                }
            });
    }
}

DI void phase_norm2_route(const Ctx& c, int l) {
    unsigned char* ws = c.ws; const int lane = c.lane;
    const float* modv = (const float*)(ws + WS_WSM + OFF_MODV); const float* H = (const float*)(ws + WS_H);
    bf16_t* XN = (bf16_t*)(ws + WS_BUFA); const float* g2 = c.in[7] + l * 1024;
    const float* rwt = (const float*)(ws + WS_WSM + OFF_RWT) + (size_t)l * 36 * 1024;
    const float* bg = c.in[42] + l * 4; const float* be = c.in[44] + l * 32;
    unsigned* cnt = (unsigned*)(ws + WS_CTL) + CW_CNT + l * 32;
    int* list = (int*)(ws + WS_GT + GT_LIST); float* lw = (float*)(ws + WS_GT + GT_LW);
    for (int row = blockIdx.x * 8 + c.wave; row < NZ; row += gridDim.x * 8) {
        const int b = row / TZ, s = row % TZ, sel = s < CTX ? 2 : b;
        if (l == NL - 1 && s < CTX) continue;
        float x[16]; float ss = 0.f;
#pragma unroll
        for (int q = 0; q < 4; ++q) { const float4 v = *(const float4*)(H + (size_t)row * D + q * 256 + lane * 4); x[q * 4] = v.x; x[q * 4 + 1] = v.y; x[q * 4 + 2] = v.z; x[q * 4 + 3] = v.w;
            ss += v.x * v.x + v.y * v.y + v.z * v.z + v.w * v.w; }
        ss = wave_sum(ss);
        const float rs = rsqrtf(ss * (1.f / 1024.f) + 1e-6f);
#pragma unroll
        for (int q = 0; q < 4; ++q) {
            const int col = q * 256 + lane * 4;
            const float4 g = *(const float4*)(g2 + col), m3 = *(const float4*)(modv + ((size_t)l * 3 + sel) * 6144 + 3 * 1024 + col), m4 = *(const float4*)(modv + ((size_t)l * 3 + sel) * 6144 + 4 * 1024 + col);
            x[q * 4] = x[q * 4] * rs * g.x * (1.f + m4.x) + m3.x; x[q * 4 + 1] = x[q * 4 + 1] * rs * g.y * (1.f + m4.y) + m3.y;
            x[q * 4 + 2] = x[q * 4 + 2] * rs * g.z * (1.f + m4.z) + m3.z; x[q * 4 + 3] = x[q * 4 + 3] * rs * g.w * (1.f + m4.w) + m3.w;
            *(u32x2*)(XN + (size_t)row * D + col) = pack4(x[q * 4], x[q * 4 + 1], x[q * 4 + 2], x[q * 4 + 3]);
        }
        volatile float* wl = (volatile float*)(c.smem) + c.wave * 64;
#pragma unroll 1
        for (int e = 0; e < 36; ++e) {
            float a = 0.f;
#pragma unroll
            for (int q = 0; q < 4; ++q) { const float4 w = *(const float4*)(rwt + (size_t)e * 1024 + q * 256 + lane * 4); a += x[q * 4] * w.x + x[q * 4 + 1] * w.y + x[q * 4 + 2] * w.z + x[q * 4 + 3] * w.w; }
            a = wave_sum(a) + (e < 4 ? bg[e] : be[e - 4]);
            if (lane == 0) wl[e] = a;
        }
        __builtin_amdgcn_wave_barrier();
        float lg[36];
#pragma unroll
        for (int e = 0; e < 36; ++e) lg[e] = wl[e];
        __builtin_amdgcn_wave_barrier();
        float gl[4]; float gm = -1e30f;
#pragma unroll
        for (int g = 0; g < 4; ++g) { gl[g] = lg[g]; gm = fmaxf(gm, gl[g]); }
        float gs = 0.f; int gsel = 0; float gbest = -1e30f;
#pragma unroll
        for (int g = 0; g < 4; ++g) { gs += __expf(gl[g] - gm); if (gl[g] > gbest) { gbest = gl[g]; gsel = g; } }
        const float pg = __expf(gbest - gm) / gs;
        float l1 = -1e30f, l2 = -1e30f; int e1 = 0, e2 = 0;
#pragma unroll
        for (int e = 0; e < 32; ++e) {
            const float v = lg[4 + e];
            if ((e >> 3) == gsel) {
                if (v > l1) { l2 = l1; e2 = e1; l1 = v; e1 = e; }
                else if (v > l2) { l2 = v; e2 = e; }
            }
        }
        const float t = __expf(l2 - l1), w1 = pg / (1.f + t), w2 = pg * t / (1.f + t);
        if (lane == 0) {
            const unsigned p1 = atomicAdd(&cnt[e1], 1u); list[(size_t)e1 * MOE_CAP + p1] = row * 2; lw[(size_t)e1 * MOE_CAP + p1] = w1;
            const unsigned p2 = atomicAdd(&cnt[e2], 1u); list[(size_t)e2 * MOE_CAP + p2] = row * 2 + 1; lw[(size_t)e2 * MOE_CAP + p2] = w2;
        }
    }
    phase_expert_convert(c, l);
}

DI void moe_prefix(const Ctx& c, int l, int* tiles  , int* cnts  ) {
    __syncthreads();
    if (c.tid == 0) {
        const unsigned* cnt = (const unsigned*)(c.ws + WS_CTL) + CW_CNT + l * 32; int acc = 0;
        for (int e = 0; e < 32; ++e) { const int n = (int)__hip_atomic_load(cnt + e, __ATOMIC_RELAXED, __HIP_MEMORY_SCOPE_AGENT); cnts[e] = n; tiles[e] = acc; acc += (n + 127) / 128; }
        tiles[32] = acc;
    }
    __syncthreads();
}
DI void phase_moe1(const Ctx& c, int l) {
    unsigned char* ws = c.ws;
    int* tiles = (int*)(c.smem + 120 * 1024); int* cnts = tiles + 40;
    moe_prefix(c, l, tiles, cnts);
    const bf16_t* XN = (const bf16_t*)(ws + WS_BUFA); bf16_t* HM = (bf16_t*)(ws + WS_GT + GT_HM); const int* list = (const int*)(ws + WS_GT + GT_LIST);
    const int nt_total = tiles[32];
    for (int u = blockIdx.x; u < nt_total * 4; u += gridDim.x) {
        const int mtg = u >> 2, nt = u & 3;
        int e = 0;
        for (int k = 1; k < 32; ++k) if (tiles[k] <= mtg) e = k;
        const int mt = mtg - tiles[e], n_e = cnts[e];
        const int* le = list + (size_t)e * MOE_CAP;
        const bf16_t* W = (const bf16_t*)(ws + WS_EXPW + (size_t)e * SZ_WGU);
        gemm_tile<2, 0>(c, 1024,
            [&](int i) { int p = mt * 128 + i; if (p >= n_e) p = n_e - 1; return XN + (size_t)(le[p] >> 1) * D; },
            [&](int i) { return W + (size_t)(nt * 256 + i) * D; }, NoHook(),
            [&](f32x4 (&acc)[4][4], int wr, int wc, int fr, int fq) {
#pragma unroll
                for (int np = 0; np < 2; ++np) {
                    const int hc = (nt * 256 + wc + np * 32) / 2 + fq * 4;
#pragma unroll
                    for (int m = 0; m < 4; ++m) {
                        const int p = mt * 128 + wr + m * 16 + fr;
                        const f32x4 g = acc[m][np * 2], uu = acc[m][np * 2 + 1];
                        *(u32x2*)(HM + ((size_t)mtg * 128 + wr + m * 16 + fr) * 512 + hc) = pack4(siluf_(g[0]) * uu[0], siluf_(g[1]) * uu[1], siluf_(g[2]) * uu[2], siluf_(g[3]) * uu[3]);
                        (void)p;
                    }
                }
            });
    }
}
DI void phase_moe2(const Ctx& c, int l) {
    unsigned char* ws = c.ws;
    int* tiles = (int*)(c.smem + 120 * 1024); int* cnts = tiles + 40;
    moe_prefix(c, l, tiles, cnts);
    const bf16_t* HM = (const bf16_t*)(ws + WS_GT + GT_HM); const int* list = (const int*)(ws + WS_GT + GT_LIST); const float* lw = (const float*)(ws + WS_GT + GT_LW);
    bf16_t* Y2 = (bf16_t*)(ws + WS_P);
    const int nt_total = tiles[32];
    for (int u = blockIdx.x; u < nt_total * 4; u += gridDim.x) {
        const int mtg = u >> 2, nt = u & 3;
        int e = 0;
        for (int k = 1; k < 32; ++k) if (tiles[k] <= mtg) e = k;
        const int mt = mtg - tiles[e], n_e = cnts[e];
        const int* le = list + (size_t)e * MOE_CAP; const float* lwe = lw + (size_t)e * MOE_CAP;
        const bf16_t* W = (const bf16_t*)(ws + WS_EXPW + 32 * SZ_WGU + (size_t)e * SZ_WD);
        gemm_tile<2, 0>(c, 512,
            [&](int i) { return HM + ((size_t)mtg * 128 + i) * 512; },
            [&](int i) { return W + (size_t)(nt * 256 + i) * 512; }, NoHook(),
            [&](f32x4 (&acc)[4][4], int wr, int wc, int fr, int fq) {
#pragma unroll
                for (int m = 0; m < 4; ++m) {
                    const int p = mt * 128 + wr + m * 16 + fr;
                    if (p < n_e) {
                        const int ent = le[p]; const float wt = lwe[p];
                        bf16_t* yrow = Y2 + ((size_t)(ent & 1) * NZ + (ent >> 1)) * D + nt * 256 + wc + fq * 4;
#pragma unroll
                        for (int n = 0; n < 4; ++n) *(u32x2*)(yrow + n * 16) = pack4(wt * acc[m][n][0], wt * acc[m][n][1], wt * acc[m][n][2], wt * acc[m][n][3]);
                    }
                }
            });
    }
}

constexpr int LDS_BYTES = 128 * 1024;
constexpr int STEPS_PER_LAYER = 12, N_STEPS = 2 + NL * STEPS_PER_LAYER;
#ifndef FUSED
#define FUSED 1
#endif

DI const void* launder_ptr(const void* p) {
    const unsigned long long v = (unsigned long long)p;
    unsigned lo = __builtin_amdgcn_readfirstlane((unsigned)v), hi = __builtin_amdgcn_readfirstlane((unsigned)(v >> 32));
    asm volatile("" : "+s"(lo), "+s"(hi) :: "memory");
    return (const void*)(((unsigned long long)hi << 32) | lo);
}
template <int KIND> DI void run_step(const Ctx& c0, int l) {
#ifdef PHM
    if (!((PHM >> KIND) & 1)) return;
#endif
    Ctx c = c0;
    { int z = 0; asm volatile("" : "+s"(z) :: "memory"); c.in = c0.in + z; c.ws = c0.ws + z; c.out = c0.out + z; }
    { int t = c0.tid; asm volatile("" : "+v"(t)); c.tid = t; c.lane = t & 63; c.wave = __builtin_amdgcn_readfirstlane(t >> 6); }
    if (KIND == 0) phase_prologue(c);
    if (KIND == 1) phase_norm1(c, l);
    if (KIND == 2) phase_inproj(c, l);
    if (KIND == 3) { phase_prep(c, l); phase_s5_local(c, l); }
    if (KIND == 4) { phase_small_gemms(c, l); phase_s5_carry(c, l); }
    if (KIND == 5) phase_attention(c, l);
    if (KIND == 6) phase_mixers2(c, l);
    if (KIND == 7) phase_post(c, l);
    if (KIND == 8) phase_merge1(c, l);
    if (KIND == 9) phase_merge2(c, l);
    if (KIND == 10) phase_norm2_route(c, l);
    if (KIND == 11) phase_moe1(c, l);
    if (KIND == 12) phase_moe2(c, l);
    if (KIND == 13) phase_final(c);
}

#if !FUSED
template <int KIND> __global__ void __launch_bounds__(NTHR, 2) k_step(Args a) {
    extern __shared__ __attribute__((aligned(16))) unsigned char lds[];
    Ctx c; c.in = a.in; c.out = a.out; c.ws = a.ws; c.smem = lds; c.tid = threadIdx.x; c.lane = threadIdx.x & 63; c.wave = __builtin_amdgcn_readfirstlane(threadIdx.x >> 6);
    run_step<KIND>(c, a.s_lo);
}
template <int KIND> static void launch_step(const Args& a, int grid, hipStream_t stream) {
    static bool attr = false;
    if (!attr) { (void)hipFuncSetAttribute((const void*)k_step<KIND>, hipFuncAttributeMaxDynamicSharedMemorySize, LDS_BYTES); attr = true; }
    hipLaunchKernelGGL(k_step<KIND>, dim3(grid), dim3(NTHR), LDS_BYTES, stream, a);
}
#else
__global__ void __launch_bounds__(NTHR, 2) fwd_kernel(Args a) {
    extern __shared__ __attribute__((aligned(16))) unsigned char lds[];
    Ctx c; c.in = a.in; c.out = a.out; c.ws = a.ws; c.smem = lds; c.tid = threadIdx.x; c.lane = threadIdx.x & 63; c.wave = __builtin_amdgcn_readfirstlane(threadIdx.x >> 6);
    volatile LAS unsigned* xbw = (volatile LAS unsigned*)(lds + LDS_BYTES - 16);
    if (threadIdx.x == 0) { xbw[0] = 0u; xbw[1] = 0u; }
    __syncthreads();
    XcdBarrier bar = xcd_barrier_post((unsigned*)(a.ws + WS_CTL) + CW_BAR, xbw);
#ifndef REP_MASK
#define REP_MASK 0
#endif
#define STEP(K, L) do { run_step<K>(c, L); xcd_barrier(bar); if ((REP_MASK >> K) & 1) { run_step<K>(c, L); xcd_barrier(bar); } } while (0)
    STEP(0, 0);
    for (int l = 0; l < NL; ++l) {
        STEP(1, l); STEP(2, l); STEP(3, l); STEP(4, l); STEP(5, l); STEP(6, l); STEP(7, l); STEP(8, l); STEP(9, l); STEP(10, l); STEP(11, l); STEP(12, l);
    }
#undef STEP
    run_step<13>(c, 0);
}
#endif

extern "C" void kernel_launch(void* const* d_in, const int* in_sizes, int n_in, void* d_out, int out_size, void* d_ws, size_t ws_size, hipStream_t stream) {
    static int grid = 0;
    if (grid == 0) {
        if (n_in != 49 || out_size != NB * SEQ * D || ws_size < WS_END) { fprintf(stderr, "kernel_launch: unexpected problem (n_in %d out %d ws %zu need %zu)\n", n_in, out_size, ws_size, (size_t)WS_END); grid = -1; return; }
        int dev = 0, cus = 0;
        if (hipGetDevice(&dev) != hipSuccess || hipDeviceGetAttribute(&cus, hipDeviceAttributeMultiprocessorCount, dev) != hipSuccess) { grid = -1; return; }
#if FUSED
        int per_cu = 0;
        if (hipFuncSetAttribute((const void*)fwd_kernel, hipFuncAttributeMaxDynamicSharedMemorySize, LDS_BYTES) != hipSuccess) { fprintf(stderr, "kernel_launch: hipFuncSetAttribute failed\n"); grid = -1; return; }
        if (hipOccupancyMaxActiveBlocksPerMultiprocessor(&per_cu, (const void*)fwd_kernel, NTHR, LDS_BYTES) != hipSuccess || per_cu < 1) { fprintf(stderr, "kernel_launch: occupancy query says %d\n", per_cu); }
        (void)hipGetLastError();
#endif
        grid = cus;
    }
    if (grid < 0) return;
    (void)hipMemsetAsync((char*)d_ws + WS_CTL, 0, CTL_BYTES, stream);
    Args a{};
    for (int i = 0; i < 49; ++i) a.in[i] = (const float*)d_in[i];
    a.out = (float*)d_out; a.ws = (unsigned char*)d_ws;
#if !FUSED
    a.s_lo = 0; a.s_hi = 0; launch_step<0>(a, grid, stream);
    for (int l = 0; l < NL; ++l) {
        a.s_lo = l;
        launch_step<1>(a, grid, stream); launch_step<2>(a, grid, stream); launch_step<3>(a, grid, stream); launch_step<4>(a, grid, stream);
        launch_step<5>(a, grid, stream); launch_step<6>(a, grid, stream); launch_step<7>(a, grid, stream); launch_step<8>(a, grid, stream);
        launch_step<9>(a, grid, stream); launch_step<10>(a, grid, stream); launch_step<11>(a, grid, stream); launch_step<12>(a, grid, stream);
    }
    a.s_lo = 0; launch_step<13>(a, grid, stream);
#else
    a.s_lo = 0; a.s_hi = N_STEPS; hipLaunchKernelGGL(fwd_kernel, dim3(grid), dim3(NTHR), LDS_BYTES, stream, a);
#endif
}
```

```cpp
#include <hip/hip_runtime.h>
#include <stdint.h>
#include <stdio.h>

#define DI __device__ __forceinline__
#define LAS __attribute__((address_space(3)))
typedef unsigned short bf16_t;
typedef short bf16x8 __attribute__((ext_vector_type(8)));
typedef short s16x4 __attribute__((ext_vector_type(4)));
typedef float f32x4 __attribute__((ext_vector_type(4)));
typedef float f32x16 __attribute__((ext_vector_type(16)));
typedef float f32x2 __attribute__((ext_vector_type(2)));
typedef __bf16 bf16x2v __attribute__((ext_vector_type(2)));
typedef unsigned u32x4 __attribute__((ext_vector_type(4)));
typedef unsigned u32x2 __attribute__((ext_vector_type(2)));

constexpr int D = 1024, NB = 2, SEQ = 8192, CTX = 256, TZ = 8448, NZ = 16896, NL = 2;
constexpr int NIN = 6560, NINP = 6656;
constexpr int NTHR = 512;
constexpr float LOG2E = 1.4426950408889634f;

#define XB_TMO      128
#define XB_XCNT(j)  (256  + 64 * (j))
#define XB_XSUB(j)  (1280 + 64 * (j))
#define XB_XGEN(j)  (2304 + 64 * (j))
#define XB_TOP      3328
#define XB_TOPGEN   3392
#define XCD_BAR_WORDS 3456
#define XB_SPIN_CAP (1u << 18)

__device__ __forceinline__ unsigned xb_ld(unsigned* p)              { return __hip_atomic_load(p, __ATOMIC_RELAXED, __HIP_MEMORY_SCOPE_AGENT); }
__device__ __forceinline__ unsigned xb_add(unsigned* p, unsigned v) { return __hip_atomic_fetch_add(p, v, __ATOMIC_RELAXED, __HIP_MEMORY_SCOPE_AGENT); }
__device__ __forceinline__ unsigned xb_xcc_id() { return (unsigned)__builtin_amdgcn_s_getreg((3 << 11) | 20) & 0xFu; }
#define XB_SPIN(cond, bar) do { unsigned _sp = 0; while (cond) { __builtin_amdgcn_s_sleep(1); \
    if ((++_sp & 255u) == 0u) { if (xb_ld(&(bar)[XB_TMO])) break; if (_sp > XB_SPIN_CAP) { atomicAdd(&(bar)[XB_TMO], 1u); break; } } } } while (0)

struct XcdBarrier { unsigned* bar; unsigned x; volatile LAS unsigned* st; };

__device__ __forceinline__ XcdBarrier xcd_barrier_post(unsigned* bar, volatile LAS unsigned* st) {
    XcdBarrier b; b.bar = bar; b.x = xb_xcc_id(); b.st = st;
    if (threadIdx.x == 0) (void)xb_add(&bar[XB_XCNT(b.x)], 1u);
    return b;
}
__device__ __forceinline__ void xcd_barrier_complete(unsigned* bar, unsigned x, unsigned& nloc, unsigned& nx) {
    const unsigned G = gridDim.x * gridDim.y * gridDim.z;
    unsigned sum, cnt, mine, sp = 0u;
    for (;;) {
        sum = 0u; cnt = 0u; mine = 0u;
#pragma unroll
        for (unsigned j = 0; j < 16; ++j) { const unsigned c = xb_ld(&bar[XB_XCNT(j)]); sum += c; cnt += (c > 0u) ? 1u : 0u; mine = (j == x) ? c : mine; }
        if (sum == G) break;
        __builtin_amdgcn_s_sleep(1);
        if ((++sp & 255u) == 0u) { if (xb_ld(&bar[XB_TMO])) break; if (sp > XB_SPIN_CAP) { atomicAdd(&bar[XB_TMO], 1u); break; } }
    }
    nloc = mine > 0u ? mine : 1u; nx = cnt > 0u ? cnt : 1u;
}
__device__ __forceinline__ void xcd_barrier(const XcdBarrier& b) {
    asm volatile("s_waitcnt vmcnt(0)" ::: "memory");
    __syncthreads();
    if (threadIdx.x == 0) {
        unsigned* bar = b.bar;
        __builtin_amdgcn_s_waitcnt(0);
        unsigned nloc = b.st[0], nx = b.st[1];
        if (nloc == 0u) { xcd_barrier_complete(bar, b.x, nloc, nx); b.st[0] = nloc; b.st[1] = nx; }
        const unsigned old = xb_add(&bar[XB_XSUB(b.x)], 1u);
        const unsigned gen = old / nloc;
        if (old + 1u == (gen + 1u) * nloc) {
            __builtin_amdgcn_fence(__ATOMIC_RELEASE, "agent");
            asm volatile("s_waitcnt vmcnt(0)" ::: "memory");
            const unsigned og = xb_add(&bar[XB_TOP], 1u);
            const unsigned tg = og / nx;
            if (og + 1u == (tg + 1u) * nx) xb_add(&bar[XB_TOPGEN], 1u);
            else XB_SPIN(xb_ld(&bar[XB_TOPGEN]) == tg, bar);
            __builtin_amdgcn_fence(__ATOMIC_ACQUIRE, "agent");
            xb_add(&bar[XB_XGEN(b.x)], 1u);
            asm volatile("s_waitcnt vmcnt(0)" ::: "memory");
        } else {
            XB_SPIN(xb_ld(&bar[XB_XGEN(b.x)]) == gen, bar);
            __builtin_amdgcn_fence(__ATOMIC_ACQUIRE, "agent");
            asm volatile("s_waitcnt vmcnt(0)" ::: "memory");
        }
    }
    __syncthreads();
}

DI float bf2f(bf16_t v) { return __uint_as_float((unsigned)v << 16); }
DI unsigned pack2(float a, float b) { f32x2 v = {a, b}; bf16x2v r = __builtin_convertvector(v, bf16x2v); return __builtin_bit_cast(unsigned, r); }
DI bf16_t f2bf(float a) { return (bf16_t)(pack2(a, 0.f) & 0xffffu); }
DI float lo2f(unsigned u) { return __uint_as_float(u << 16); }
DI float hi2f(unsigned u) { return __uint_as_float(u & 0xffff0000u); }
DI float wave_sum(float v) {
#pragma unroll
    for (int m = 32; m >= 1; m >>= 1) v += __shfl_xor(v, m, 64);
    return v;
}
DI float sum16(float v) {
#pragma unroll
    for (int m = 8; m >= 1; m >>= 1) v += __shfl_xor(v, m, 64);
    return v;
}
DI float sigmoidf_(float x) { return 1.f / (1.f + __expf(-x)); }
DI float siluf_(float x) { return x / (1.f + __expf(-x)); }
DI float gelu_tanh(float x) { const float u = 0.7978845608028654f * (x + 0.044715f * x * x * x); return 0.5f * x * (1.f + tanhf(u)); }
DI void unpack4(u32x2 u, float (&f)[4]) { f[0] = lo2f(u.x); f[1] = hi2f(u.x); f[2] = lo2f(u.y); f[3] = hi2f(u.y); }
DI u32x2 pack4(float a, float b, float c, float d) { u32x2 r; r.x = pack2(a, b); r.y = pack2(c, d); return r; }

constexpr size_t algn(size_t x) { return (x + 255) & ~(size_t)255; }
constexpr size_t WS_CTL   = 0;
constexpr size_t CTL_BYTES = 64 * 1024;
constexpr size_t WS_H     = WS_CTL + CTL_BYTES;
constexpr size_t WS_WSM   = WS_H + (size_t)NZ * D * 4;
constexpr size_t SZ_WINT = (size_t)NINP * D * 2, SZ_WUQT = 384 * 256 * 2, SZ_WUKVT = 512 * 128 * 2, SZ_W2T = 512 * 64 * 2, SZ_A2T = 512 * 64 * 2,
                 SZ_G2T = 256 * 128 * 2, SZ_GLUT = 256 * 256 * 2, SZ_WBT = (size_t)D * D * 2, SZ_WOUTT = (size_t)D * D * 2;
constexpr size_t OFF_WINT = 0, OFF_WUQT = OFF_WINT + NL * SZ_WINT, OFF_WUKVT = OFF_WUQT + NL * SZ_WUQT, OFF_W2T = OFF_WUKVT + NL * SZ_WUKVT,
                 OFF_A2T = OFF_W2T + NL * SZ_W2T, OFF_G2T = OFF_A2T + NL * SZ_A2T, OFF_GLUT = OFF_G2T + NL * SZ_G2T, OFF_WBT = OFF_GLUT + NL * SZ_GLUT,
                 OFF_WOUTT = OFF_WBT + NL * SZ_WBT, OFF_MODV = OFF_WOUTT + NL * SZ_WOUTT,
                 OFF_ROPE = OFF_MODV + (size_t)NL * 3 * 6144 * 4,
                 OFF_S5T = OFF_ROPE + (size_t)SEQ * 16 * 2 * 4,
                 OFF_RWT = OFF_S5T + (size_t)NL * 2 * 16 * 64 * 36 * 4,
                 OFF_LAM = OFF_RWT + (size_t)NL * 36 * 1024 * 4,
                 OFF_S5E = OFF_LAM + 256,
                 OFF_S5C = OFF_S5E + (size_t)2 * 2 * 16 * 66 * 64 * 2 * 4,
                 WSM_BYTES = algn(OFF_S5C + (size_t)2 * 2 * 16 * 66 * 64 * 2 * 4);
constexpr size_t WS_EXPW  = WS_WSM + WSM_BYTES;
constexpr size_t SZ_WGU = (size_t)1024 * 1024 * 2, SZ_WD = (size_t)1024 * 512 * 2;
constexpr size_t EXPW_BYTES = 32 * (SZ_WGU + SZ_WD);
constexpr size_t SZ_QM = (size_t)NB * 4 * TZ * 96 * 2, SZ_VMT = (size_t)NB * 4 * 64 * TZ * 2, SZ_QD = (size_t)NB * 4 * TZ * 64 * 2, SZ_R256 = (size_t)NZ * 256 * 2;
constexpr size_t MX_QM = 0, MX_KM = MX_QM + SZ_QM, MX_VMT = MX_KM + SZ_QM, MX_QD = MX_VMT + SZ_VMT, MX_KD = MX_QD + SZ_QD, MX_VDT = MX_KD + SZ_QD,
                 MX_RB = MX_VDT + SZ_VMT, MX_KB = MX_RB + SZ_R256, MX_VB = MX_KB + SZ_R256, MX_KKB = MX_VB + SZ_R256, MX_END = MX_KKB + SZ_R256;
static_assert(MX_END <= EXPW_BYTES, "mixer operands must fit the expert-weight region");
constexpr size_t WS_BUFA  = WS_EXPW + EXPW_BYTES;
constexpr size_t WS_BUFB  = WS_BUFA + (size_t)NZ * D * 2;
constexpr size_t WS_P     = WS_BUFB + (size_t)NZ * D * 2;
constexpr size_t P_PM = 0, P_PS = P_PM + (size_t)NZ * 416 * 2, P_PR = P_PS + (size_t)NZ * 256 * 2, P_PD = P_PR + (size_t)NZ * 1024 * 2, P_BYTES = P_PD + (size_t)NZ * 768 * 2;
static_assert((size_t)6 * SZ_R256 <= (size_t)NZ * (1024 + 768) * 2, "scan operands must fit PR|PD");
static_assert((size_t)2 * NZ * D * 2 <= P_BYTES, "the MoE outputs (2 x bf16 [NZ][D]) must fit the P region");
constexpr size_t WS_GT    = WS_P + P_BYTES;
constexpr size_t GT_BYTES = (size_t)NZ * 4096 * 2;
constexpr int MOE_CAP = 33792;
constexpr size_t GT_HM = 0, GT_LIST = GT_HM + (size_t)(33792 + 32 * 128) * 512 * 2, GT_LW = GT_LIST + (size_t)32 * MOE_CAP * 4, GT_END = GT_LW + (size_t)32 * MOE_CAP * 4;
static_assert(GT_END <= GT_BYTES, "MoE scratch must fit the gate region");
constexpr size_t WS_MISC  = WS_GT + GT_BYTES;
constexpr size_t MS_CQN = 0, MS_TW = MS_CQN + (size_t)NZ * 384 * 2, MS_AL = MS_TW + (size_t)NZ * 64 * 2, MS_SG = MS_AL + (size_t)NZ * 64 * 2,
                 MS_GG = MS_SG + (size_t)NZ * 128 * 2, MS_ZG = MS_GG + SZ_R256, MS_END = MS_ZG + SZ_R256;
constexpr size_t WS_RW    = WS_MISC + MS_END;
constexpr int RC = 64, RNC = TZ / RC;
constexpr size_t SZ_RWM = (size_t)16 * RNC * 4096 * 2;
constexpr size_t RW_M3 = 0, RW_M2 = SZ_RWM, RW_Z5 = 2 * SZ_RWM, RW_P63 = 3 * SZ_RWM, RW_END = RW_P63 + (size_t)16 * RNC * 64 * 4;
constexpr size_t WS_END   = WS_RW + RW_END;

constexpr int CW_BAR = 0;
constexpr int CW_CNT = 4096;

struct Args { const float* in[49]; float* out; unsigned char* ws; int s_lo, s_hi; };

struct Ctx {
    const float* const* in; float* out; unsigned char* ws; unsigned char* smem; int tid, lane, wave;
};

template <int WM> struct GCfg { static constexpr int WN = 8 / WM, BM = 64 * WM, BN = 64 * WN, ABYTES = BM * 64, BBYTES = BN * 64, STAGE = ABYTES + BBYTES; };

template <int WM, int SEGK, class ARow, class BRow, class Hook, class Epi>
DI void gemm_tile(const Ctx& c, int K, ARow arow, BRow brow, Hook hook, Epi epi) {
    typedef GCfg<WM> G;
    const int tid = c.tid, lane = c.lane, wave = c.wave;
    const int wm = wave / G::WN, wn = wave % G::WN, fr = lane & 15, fq = lane >> 4;
    unsigned char* smem = c.smem;
    constexpr int NA = G::BM / 128, NBq = G::BN / 128;
    const bf16_t* asrc[NA]; const bf16_t* bsrc[NBq];
#pragma unroll
    for (int i = 0; i < NA; ++i) { const int ch = tid + i * NTHR; asrc[i] = arow(ch >> 2) + (ch & 3) * 8; }
#pragma unroll
    for (int i = 0; i < NBq; ++i) { const int ch = tid + i * NTHR; bsrc[i] = brow(ch >> 2) + (ch & 3) * 8; }
    auto stage = [&](int kt, int buf) {
        unsigned char* sa = smem + buf * G::STAGE; unsigned char* sb = sa + G::ABYTES;
#pragma unroll
        for (int i = 0; i < NA; ++i) __builtin_amdgcn_global_load_lds((const unsigned*)(asrc[i] + kt * 32), (unsigned*)(sa + (tid + i * NTHR) * 16), 16, 0, 0);
#pragma unroll
        for (int i = 0; i < NBq; ++i) __builtin_amdgcn_global_load_lds((const unsigned*)(bsrc[i] + kt * 32), (unsigned*)(sb + (tid + i * NTHR) * 16), 16, 0, 0);
    };
    f32x4 acc[4][4];
#pragma unroll
    for (int m = 0; m < 4; ++m)
#pragma unroll
        for (int n = 0; n < 4; ++n) acc[m][n] = (f32x4){0.f, 0.f, 0.f, 0.f};
    const int T = K / 32;
    __syncthreads();
    stage(0, 0);
    for (int t = 0; t < T; ++t) {
        asm volatile("s_waitcnt vmcnt(0)" ::: "memory");
        __syncthreads();
        if (t + 1 < T) stage(t + 1, (t + 1) & 1);
        const unsigned char* sa = smem + (t & 1) * G::STAGE; const unsigned char* sb = sa + G::ABYTES;
        bf16x8 af[4], bfr[4];
#pragma unroll
        for (int m = 0; m < 4; ++m) af[m] = *(const bf16x8*)(sa + (wm * 64 + m * 16 + fr) * 64 + fq * 16);
#pragma unroll
        for (int n = 0; n < 4; ++n) bfr[n] = *(const bf16x8*)(sb + (wn * 64 + n * 16 + fr) * 64 + fq * 16);
#pragma unroll
        for (int m = 0; m < 4; ++m)
#pragma unroll
            for (int n = 0; n < 4; ++n) acc[m][n] = __builtin_amdgcn_mfma_f32_16x16x32_bf16(bfr[n], af[m], acc[m][n], 0, 0, 0);
        if (SEGK > 0) { if (((t + 1) * 32) % (SEGK > 0 ? SEGK : 32) == 0) hook(acc, ((t + 1) * 32) / (SEGK > 0 ? SEGK : 32) - 1, wm * 64, wn * 64, fr, fq); }
    }
    epi(acc, wm * 64, wn * 64, fr, fq);
}
struct NoHook { DI void operator()(f32x4 (&)[4][4], int, int, int, int, int) const {} };

DI int rowmap(int n, int mode) { return mode == 0 ? n : ((n >> 4) * 32 + (n & 15) + (mode == 2 ? 16 : 0)); }
DI void tconv_tile(const Ctx& c, const float* src, int ld, int N, bf16_t* dst, int ld_dst, int mode, int tk, int tn) {
    bf16_t* T = (bf16_t*)c.smem;
    const int k0 = tk * 64, n0 = tn * 64, tid = c.tid;
    __syncthreads();
#pragma unroll
    for (int i = 0; i < 2; ++i) {
        const int kk = (tid >> 4) + i * 32, n4 = (tid & 15) * 4;
        float4 v = make_float4(0.f, 0.f, 0.f, 0.f);
        if (n0 + n4 < N) v = *(const float4*)(src + (size_t)(k0 + kk) * ld + n0 + n4);
        T[(n4 + 0) * 72 + kk] = f2bf(v.x); T[(n4 + 1) * 72 + kk] = f2bf(v.y); T[(n4 + 2) * 72 + kk] = f2bf(v.z); T[(n4 + 3) * 72 + kk] = f2bf(v.w);
    }
    __syncthreads();
    const int n = tid >> 3, k8 = (tid & 7) * 8;
    if (n0 + n < N) *(u32x4*)(dst + (size_t)rowmap(n0 + n, mode) * ld_dst + k0 + k8) = *(const u32x4*)(T + n * 72 + k8);
}
DI void tconv(const Ctx& c, const float* src, int ld, int K, int N, bf16_t* dst, int ld_dst, int mode, int rot) {
    const int ntk = K / 64, ntn = (N + 63) / 64, nt = ntk * ntn, G = gridDim.x;
    for (int t = (blockIdx.x + G - (rot % G)) % G; t < nt; t += G) tconv_tile(c, src, ld, N, dst, ld_dst, mode, t / ntn, t % ntn);
}

DI void phase_prologue(const Ctx& c) {
    unsigned char* wsm = c.ws + WS_WSM;
    const int tid = c.tid, G = gridDim.x, gtid = blockIdx.x * NTHR + tid, gn = G * NTHR;
    {
        const float4* x = (const float4*)c.in[0]; const float4* cx = (const float4*)c.in[2]; float4* H = (float4*)(c.ws + WS_H);
        for (size_t i = gtid; i < (size_t)NZ * 256; i += gn) {
            const int z = (int)(i >> 8), q = (int)(i & 255), b = z / TZ, s = z % TZ;
            H[i] = (s < CTX) ? cx[((size_t)b * CTX + s) * 256 + q] : x[((size_t)b * SEQ + (s - CTX)) * 256 + q];
        }
    }
    {
        float* rope = (float*)(wsm + OFF_ROPE);
        for (int i = gtid; i < SEQ * 16; i += gn) {
            const int t = i >> 4, a = (i >> 3) & 1, f = i & 7;
            const float pos = (float)(a == 0 ? (t >> 6) : (t & 63));
            const float inv = powf(10000.f, -(float)f / 8.f);
            float sn, cs; sincosf(pos * inv, &sn, &cs);
            rope[i * 2] = cs; rope[i * 2 + 1] = sn;
        }
    }
    {
        float* s5t = (float*)(wsm + OFF_S5T);
        for (int i = gtid; i < NL * 2 * 16 * 64; i += gn) {
            const int ldg = i >> 6;
            const double lr = c.in[24][i], li = c.in[25][i], dt = exp((double)c.in[26][ldg]);
            const double mag = exp(lr * dt), are = mag * cos(li * dt), aim = mag * sin(li * dt);
            const double m256 = exp(lr * dt * 128.0), a256r = m256 * cos(li * dt * 128.0), a256i = m256 * sin(li * dt * 128.0);
            const double den = lr * lr + li * li, nr = are - 1.0, ni = aim;
            const double cfr = (nr * lr + ni * li) / den, cfi = (ni * lr - nr * li) / den;
            float* o = s5t + (size_t)i * 36;
            o[0] = (float)are; o[1] = (float)aim; o[2] = (float)a256r; o[3] = (float)a256i;
            for (int ch = 0; ch < 16; ++ch) {
                const double br = c.in[27][(size_t)i * 16 + ch], bi = c.in[28][(size_t)i * 16 + ch];
                o[4 + ch] = (float)(cfr * br - cfi * bi); o[20 + ch] = (float)(cfr * bi + cfi * br);
            }
        }
    }
    {
        float* rwt = (float*)(wsm + OFF_RWT);
        for (int i = gtid; i < NL * 36 * 1024; i += gn) {
            const int l = i / (36 * 1024), e = (i / 1024) % 36, d = i & 1023;
            rwt[i] = e < 4 ? c.in[41][((size_t)l * 1024 + d) * 4 + e] : c.in[43][((size_t)l * 1024 + d) * 32 + (e - 4)];
        }
    }
    if (blockIdx.x == 0 && tid < NL) {
        float s1 = 0.f, s2 = 0.f;
        for (int i = 0; i < 32; ++i) { s1 += c.in[34][tid * 32 + i] * c.in[35][tid * 32 + i]; s2 += c.in[36][tid * 32 + i] * c.in[37][tid * 32 + i]; }
        ((float*)(wsm + OFF_LAM))[tid] = expf(s1) - expf(s2) + (0.8f - 0.6f * expf(-0.3f * (float)tid));
    }
    {
        float* sv = (float*)c.smem;
        float* red = sv + 3 * 1024;
        __syncthreads();
        for (int i = tid; i < 3 * 1024; i += NTHR) { const float v = i < 2048 ? c.in[1][i] : c.in[3][i - 2048]; sv[i] = siluf_(v); }
        __syncthreads();
        float* modv = (float*)(wsm + OFF_MODV);
        for (int u = blockIdx.x; u < NL * 96; u += G) {
            const int l = u / 96, col = (u % 96) * 64 + (tid & 63), ks = tid >> 6;
            const float* w = c.in[4] + (size_t)l * 1024 * 6144 + col;
            float a0 = 0.f, a1 = 0.f, a2 = 0.f;
            for (int k = ks * 128; k < ks * 128 + 128; ++k) { const float wv = w[(size_t)k * 6144]; a0 += sv[k] * wv; a1 += sv[1024 + k] * wv; a2 += sv[2048 + k] * wv; }
            red[(ks * 64 + (tid & 63)) * 3 + 0] = a0; red[(ks * 64 + (tid & 63)) * 3 + 1] = a1; red[(ks * 64 + (tid & 63)) * 3 + 2] = a2;
            __syncthreads();
            if (tid < 192) {
                const int cc = tid & 63, sel = tid >> 6; float s = 0.f;
                for (int k2 = 0; k2 < 8; ++k2) s += red[(k2 * 64 + cc) * 3 + sel];
                const int colo = (u % 96) * 64 + cc;
                modv[((size_t)l * 3 + sel) * 6144 + colo] = s + c.in[5][l * 6144 + colo];
            }
            __syncthreads();
        }
    }
    for (int l = 0; l < NL; ++l) {
        tconv(c, c.in[8] + (size_t)l * 1024 * NIN, NIN, 1024, NIN, (bf16_t*)(wsm + OFF_WINT + l * SZ_WINT), 1024, 0, 0);
        tconv(c, c.in[11] + (size_t)l * 256 * 384, 384, 256, 384, (bf16_t*)(wsm + OFF_WUQT + l * SZ_WUQT), 256, 0, 40);
        tconv(c, c.in[12] + (size_t)l * 128 * 512, 512, 128, 512, (bf16_t*)(wsm + OFF_WUKVT + l * SZ_WUKVT), 128, 0, 70);
        for (int d = 0; d < 2; ++d) {
            tconv(c, c.in[15] + (size_t)(l * 2 + d) * 64 * 256, 256, 64, 256, (bf16_t*)(wsm + OFF_W2T + l * SZ_W2T) + d * 256 * 64, 64, 0, 90 + d * 8);
            tconv(c, c.in[17] + (size_t)(l * 2 + d) * 64 * 256, 256, 64, 256, (bf16_t*)(wsm + OFF_A2T + l * SZ_A2T) + d * 256 * 64, 64, 0, 110 + d * 8);
        }
        tconv(c, c.in[18] + (size_t)l * 128 * 256, 256, 128, 256, (bf16_t*)(wsm + OFF_G2T + l * SZ_G2T), 128, 0, 130);
        tconv(c, c.in[32] + (size_t)l * 256 * 256, 256, 256, 256, (bf16_t*)(wsm + OFF_GLUT + l * SZ_GLUT), 256, 0, 140);
        for (int n = 0; n < 4; ++n)
            tconv(c, c.in[39] + (size_t)(l * 4 + n) * 256 * 1024, 1024, 256, 1024, (bf16_t*)(wsm + OFF_WBT + l * SZ_WBT) + n * 256, 1024, 0, 160 + n * 20);
        tconv(c, c.in[40] + (size_t)l * 1024 * 1024, 1024, 1024, 1024, (bf16_t*)(wsm + OFF_WOUTT + l * SZ_WOUTT), 1024, 0, 0);
    }
}

DI void phase_expert_convert(const Ctx& c, int l) {
    const int G = gridDim.x;
    for (int t = blockIdx.x; t < 32 * 384; t += G) {
        const int e = t / 384, r = t % 384;
        bf16_t* wgu = (bf16_t*)(c.ws + WS_EXPW + (size_t)e * SZ_WGU);
        bf16_t* wd = (bf16_t*)(c.ws + WS_EXPW + 32 * SZ_WGU + (size_t)e * SZ_WD);
        if (r < 128)      tconv_tile(c, c.in[45] + ((size_t)l * 32 + e) * 1024 * 512, 512, 512, wgu, 1024, 1, r / 8, r % 8);
        else if (r < 256) tconv_tile(c, c.in[46] + ((size_t)l * 32 + e) * 1024 * 512, 512, 512, wgu, 1024, 2, (r - 128) / 8, (r - 128) % 8);
        else              tconv_tile(c, c.in[47] + ((size_t)l * 32 + e) * 512 * 1024, 1024, 1024, wd, 512, 0, (r - 256) / 16, (r - 256) % 16);
    }
}

DI void phase_norm1(const Ctx& c, int l) {
    const float* modv = (const float*)(c.ws + WS_WSM + OFF_MODV);
    float* H = (float*)(c.ws + WS_H); const bf16_t* Y = (const bf16_t*)(c.ws + WS_P);
    bf16_t* XN = (bf16_t*)(c.ws + WS_BUFA);
    const float* g1 = c.in[6] + l * 1024;
    for (int row = blockIdx.x * 8 + c.wave; row < NZ; row += gridDim.x * 8) {
        const int b = row / TZ, s = row % TZ, sel = s < CTX ? 2 : b;
        float4 v[4]; float ss = 0.f;
#pragma unroll
        for (int q = 0; q < 4; ++q) {
            const int col = q * 256 + c.lane * 4;
            v[q] = *(const float4*)(H + (size_t)row * D + col);
            if (l > 0) {
                float ya[4], yb[4]; unpack4(*(const u32x2*)(Y + (size_t)row * D + col), ya); unpack4(*(const u32x2*)(Y + ((size_t)NZ + row) * D + col), yb);
                const float4 m5 = *(const float4*)(modv + ((size_t)(l - 1) * 3 + sel) * 6144 + 5 * 1024 + col);
                v[q].x += m5.x * (ya[0] + yb[0]); v[q].y += m5.y * (ya[1] + yb[1]); v[q].z += m5.z * (ya[2] + yb[2]); v[q].w += m5.w * (ya[3] + yb[3]);
                *(float4*)(H + (size_t)row * D + col) = v[q];
            }
            ss += v[q].x * v[q].x + v[q].y * v[q].y + v[q].z * v[q].z + v[q].w * v[q].w;
        }
        ss = wave_sum(ss);
        const float rs = rsqrtf(ss * (1.f / 1024.f) + 1e-6f);
#pragma unroll
        for (int q = 0; q < 4; ++q) {
            const int col = q * 256 + c.lane * 4;
            const float4 g = *(const float4*)(g1 + col), m0 = *(const float4*)(modv + ((size_t)l * 3 + sel) * 6144 + col), m1 = *(const float4*)(modv + ((size_t)l * 3 + sel) * 6144 + 1024 + col);
            *(u32x2*)(XN + (size_t)row * D + col) = pack4(v[q].x * rs * g.x * (1.f + m1.x) + m0.x, v[q].y * rs * g.y * (1.f + m1.y) + m0.y,
                                                          v[q].z * rs * g.z * (1.f + m1.z) + m0.z, v[q].w * rs * g.w * (1.f + m1.w) + m0.w);
        }
    }
}

DI void phase_final(const Ctx& c) {
    const float* modv = (const float*)(c.ws + WS_WSM + OFF_MODV);
    const float* H = (const float*)(c.ws + WS_H); const bf16_t* Y = (const bf16_t*)(c.ws + WS_P);
    const float* g = c.in[48];
    for (int r = blockIdx.x * 8 + c.wave; r < NB * SEQ; r += gridDim.x * 8) {
        const int b = r / SEQ, t = r % SEQ, row = b * TZ + CTX + t;
        float4 v[4]; float ss = 0.f;
#pragma unroll
        for (int q = 0; q < 4; ++q) {
            const int col = q * 256 + c.lane * 4;
            v[q] = *(const float4*)(H + (size_t)row * D + col);
            float ya[4], yb[4]; unpack4(*(const u32x2*)(Y + (size_t)row * D + col), ya); unpack4(*(const u32x2*)(Y + ((size_t)NZ + row) * D + col), yb);
            const float4 m5 = *(const float4*)(modv + ((size_t)(NL - 1) * 3 + b) * 6144 + 5 * 1024 + col);
            v[q].x += m5.x * (ya[0] + yb[0]); v[q].y += m5.y * (ya[1] + yb[1]); v[q].z += m5.z * (ya[2] + yb[2]); v[q].w += m5.w * (ya[3] + yb[3]);
            ss += v[q].x * v[q].x + v[q].y * v[q].y + v[q].z * v[q].z + v[q].w * v[q].w;
        }
        ss = wave_sum(ss);
        const float rs = rsqrtf(ss * (1.f / 1024.f) + 1e-6f);
#pragma unroll
        for (int q = 0; q < 4; ++q) {
            const int col = q * 256 + c.lane * 4; const float4 gg = *(const float4*)(g + col);
            *(float4*)(c.out + (size_t)r * D + col) = make_float4(v[q].x * rs * gg.x, v[q].y * rs * gg.y, v[q].z * rs * gg.z, v[q].w * rs * gg.w);
        }
    }
}

DI void phase_inproj(const Ctx& c, int l) {
    const bf16_t* XN = (const bf16_t*)(c.ws + WS_BUFA);
    const bf16_t* W = (const bf16_t*)(c.ws + WS_WSM + OFF_WINT + l * SZ_WINT);
    bf16_t* PM = (bf16_t*)(c.ws + WS_P + P_PM); bf16_t* PS = (bf16_t*)(c.ws + WS_P + P_PS); bf16_t* PR = (bf16_t*)(c.ws + WS_P + P_PR); bf16_t* PD = (bf16_t*)(c.ws + WS_P + P_PD);
    bf16_t* GT = (bf16_t*)(c.ws + WS_GT);
    constexpr int NMT = NZ / 256, NNT = NINP / 128;
    for (int u = blockIdx.x; u < NMT * NNT; u += gridDim.x) {
        const int mt = u / NNT, nt = u % NNT, r0 = mt * 256, c0 = nt * 128;
        gemm_tile<4, 0>(c, 1024,
            [&](int i) { return XN + (size_t)(r0 + i) * D; },
            [&](int i) { return W + (size_t)(c0 + i) * D; }, NoHook(),
            [&](f32x4 (&acc)[4][4], int wr, int wc, int fr, int fq) {
#pragma unroll
                for (int n = 0; n < 4; ++n) {
                    const int col = c0 + wc + n * 16 + fq * 4;
                    bf16_t* dst; int ld, cc; bool gate = false;
                    if (col < 416) { dst = PM; ld = 416; cc = col; }
                    else if (col < 1440) { dst = PR; ld = 1024; cc = col - 416; }
                    else if (col < 1696) { dst = PS; ld = 256; cc = col - 1440; }
                    else if (col < 2464) { dst = PD; ld = 768; cc = col - 1696; }
                    else if (col < NIN) { dst = GT; ld = 4096; cc = col - 2464; gate = true; }
                    else continue;
#pragma unroll
                    for (int m = 0; m < 4; ++m) {
                        const int row = r0 + wr + m * 16 + fr; f32x4 v = acc[m][n];
                        if (gate) { v[0] = sigmoidf_(v[0]); v[1] = sigmoidf_(v[1]); v[2] = sigmoidf_(v[2]); v[3] = sigmoidf_(v[3]); }
                        *(u32x2*)(dst + (size_t)row * ld + cc) = pack4(v[0], v[1], v[2], v[3]);
                    }
                }
            });
    }
}

DI void phase_prep(const Ctx& c, int l) {
    unsigned char* ws = c.ws; const int lane = c.lane, wave = c.wave, tid = c.tid;
    const bf16_t* PM = (const bf16_t*)(ws + WS_P + P_PM); const bf16_t* PR = (const bf16_t*)(ws + WS_P + P_PR); const bf16_t* PD = (const bf16_t*)(ws + WS_P + P_PD);
    bf16_t* CQN = (bf16_t*)(ws + WS_MISC + MS_CQN); bf16_t* TW = (bf16_t*)(ws + WS_MISC + MS_TW); bf16_t* AL = (bf16_t*)(ws + WS_MISC + MS_AL); bf16_t* SG = (bf16_t*)(ws + WS_MISC + MS_SG);
    bf16_t* KM = (bf16_t*)(ws + WS_EXPW + MX_KM); bf16_t* QD = (bf16_t*)(ws + WS_EXPW + MX_QD); bf16_t* KD_ = (bf16_t*)(ws + WS_EXPW + MX_KD); bf16_t* VDT = (bf16_t*)(ws + WS_EXPW + MX_VDT);
    bf16_t* RB = (bf16_t*)(ws + WS_EXPW + MX_RB); bf16_t* KB = (bf16_t*)(ws + WS_EXPW + MX_KB); bf16_t* VB = (bf16_t*)(ws + WS_EXPW + MX_VB); bf16_t* KKB = (bf16_t*)(ws + WS_EXPW + MX_KKB);
    const float* rope = (const float*)(ws + WS_WSM + OFF_ROPE);
    const float* gq = c.in[9] + l * 256; const float* gkv = c.in[10] + l * 128; const float* mu = c.in[13] + l * 1024; const float* k_k = c.in[19] + l * 256;
    bf16_t* Vs = (bf16_t*)c.smem;
    const float qsc = 0.17677669529663687f * LOG2E;
    for (int tile = blockIdx.x; tile < NZ / 64; tile += gridDim.x) {
        __syncthreads();
        for (int i = 0; i < 8; ++i) {
            const int rt = wave * 8 + i, z = tile * 64 + rt, b = z / TZ, s = z % TZ; const bool lat = s >= CTX; const int tl = lat ? s - CTX : 0;
            {
                const bf16_t* pm = PM + (size_t)z * 416;
                float x[4]; unpack4(*(const u32x2*)(pm + lane * 4), x);
                float ss = wave_sum(x[0] * x[0] + x[1] * x[1] + x[2] * x[2] + x[3] * x[3]);
                float rs = rsqrtf(ss * (1.f / 256.f) + 1e-6f);
                const float4 g = *(const float4*)(gq + lane * 4);
                *(u32x2*)(CQN + (size_t)z * 384 + lane * 4) = pack4(x[0] * rs * g.x, x[1] * rs * g.y, x[2] * rs * g.z, x[3] * rs * g.w);
                const unsigned u2 = *(const unsigned*)(pm + 256 + lane * 2); const float y0 = lo2f(u2), y1 = hi2f(u2);
                ss = wave_sum(y0 * y0 + y1 * y1); rs = rsqrtf(ss * (1.f / 128.f) + 1e-6f);
                const float2 g2 = *(const float2*)(gkv + lane * 2);
                *(unsigned*)(CQN + (size_t)z * 384 + 256 + lane * 2) = pack2(y0 * rs * g2.x, y1 * rs * g2.y);
                float kr = bf2f(pm[384 + (lane & 31)]);
                const float pr = __shfl_xor(kr, 8, 64);
                if (lat) { const float* cs = rope + ((size_t)tl * 16 + ((lane & 31) >> 4) * 8 + (lane & 7)) * 2; kr = kr * cs[0] + ((lane & 8) ? pr : -pr) * cs[1]; }
                if (lane < 32) {
                    const bf16_t kv = f2bf(kr);
#pragma unroll
                    for (int h = 0; h < 4; ++h) KM[((size_t)(b * 4 + h) * TZ + s) * 96 + 64 + lane] = kv;
                }
            }
            {
                const bf16_t* pd = PD + (size_t)z * 768;
                const int i0 = lane * 4, hh = i0 >> 6, ii = i0 & 31, nn = (i0 >> 5) & 1;
                const float* cs = rope + ((size_t)tl * 16 + (ii >> 4) * 8 + (ii & 7)) * 2;
                const bool hi = (ii & 8) != 0;
#pragma unroll
                for (int w = 0; w < 2; ++w) {
                    float x[4]; unpack4(*(const u32x2*)(pd + w * 256 + i0), x);
                    float o[4];
#pragma unroll
                    for (int j = 0; j < 4; ++j) {
                        const float p = __shfl_xor(x[j], 2, 64);
                        o[j] = lat ? (x[j] * cs[2 * j] + (hi ? p : -p) * cs[2 * j + 1]) : x[j];
                        if (w == 0) o[j] *= qsc;
                    }
                    bf16_t* dst = (w == 0 ? QD : KD_) + ((size_t)(b * 4 + hh) * TZ + s) * 64 + nn * 32 + ii;
                    *(u32x2*)dst = pack4(o[0], o[1], o[2], o[3]);
                }
                *(u32x2*)(Vs + rt * 264 + i0) = *(const u32x2*)(pd + 512 + i0);
            }
            {
                const bf16_t* pr = PR + (size_t)z * 1024;
                const bool hp = (s != 0) && (s != CTX), hn = (s != CTX - 1) && (s != TZ - 1);
#pragma unroll
                for (int q = 0; q < 4; ++q) {
                    const int col = q * 256 + lane * 4;
                    float cu[4], pv[4] = {0.f, 0.f, 0.f, 0.f}, nx[4] = {0.f, 0.f, 0.f, 0.f};
                    unpack4(*(const u32x2*)(pr + col), cu);
                    if (hp) unpack4(*(const u32x2*)(pr - 1024 + col), pv);
                    if (hn) unpack4(*(const u32x2*)(pr + 1024 + col), nx);
                    const float4 m = *(const float4*)(mu + col);
                    float zv[4];
                    zv[0] = cu[0] + (0.5f * (pv[0] + nx[0]) - cu[0]) * m.x; zv[1] = cu[1] + (0.5f * (pv[1] + nx[1]) - cu[1]) * m.y;
                    zv[2] = cu[2] + (0.5f * (pv[2] + nx[2]) - cu[2]) * m.z; zv[3] = cu[3] + (0.5f * (pv[3] + nx[3]) - cu[3]) * m.w;
                    if (q == 0) *(u32x2*)(RB + (size_t)z * 256 + lane * 4) = pack4(zv[0], zv[1], zv[2], zv[3]);
                    else if (q == 1) {
                        *(u32x2*)(KB + (size_t)z * 256 + lane * 4) = pack4(zv[0], zv[1], zv[2], zv[3]);
                        const float4 kk4 = *(const float4*)(k_k + lane * 4);
                        const float a0 = zv[0] * kk4.x, a1 = zv[1] * kk4.y, a2 = zv[2] * kk4.z, a3 = zv[3] * kk4.w;
                        const float ssq = sum16(a0 * a0 + a1 * a1 + a2 * a2 + a3 * a3);
                        const float inv = 1.f / fmaxf(sqrtf(ssq), 1e-12f);
                        *(u32x2*)(KKB + (size_t)z * 256 + lane * 4) = pack4(a0 * inv, a1 * inv, a2 * inv, a3 * inv);
                    } else if (q == 2) *(u32x2*)(VB + (size_t)z * 256 + lane * 4) = pack4(zv[0], zv[1], zv[2], zv[3]);
                    else {
                        if (lane < 16) *(u32x2*)(TW + (size_t)z * 64 + lane * 4) = pack4(tanhf(zv[0]), tanhf(zv[1]), tanhf(zv[2]), tanhf(zv[3]));
                        else if (lane < 32) *(u32x2*)(AL + (size_t)z * 64 + (lane - 16) * 4) = pack4(zv[0], zv[1], zv[2], zv[3]);
                        else *(u32x2*)(SG + (size_t)z * 128 + (lane - 32) * 4) = pack4(sigmoidf_(zv[0]), sigmoidf_(zv[1]), sigmoidf_(zv[2]), sigmoidf_(zv[3]));
                    }
                }
            }
        }
        __syncthreads();
        {
            const int z0 = tile * 64, b = z0 / TZ, s0 = z0 % TZ;
#pragma unroll
            for (int i = 0; i < 4; ++i) {
                const int ch = tid + i * NTHR, dv = ch >> 3, r8 = (ch & 7) * 8;
                bf16_t v[8];
#pragma unroll
                for (int j = 0; j < 8; ++j) v[j] = Vs[(r8 + j) * 264 + dv];
                u32x4 o; o.x = v[0] | ((unsigned)v[1] << 16); o.y = v[2] | ((unsigned)v[3] << 16); o.z = v[4] | ((unsigned)v[5] << 16); o.w = v[6] | ((unsigned)v[7] << 16);
                *(u32x4*)(VDT + ((size_t)(b * 4 + (dv >> 6)) * 64 + (dv & 63)) * TZ + s0 + r8) = o;
            }
        }
    }
}

constexpr int S5C = 128, S5N = TZ / S5C;
DI int s5_tok(int dir, int i) { return dir == 0 ? i : (i < CTX ? CTX - 1 - i : TZ - 1 - (i - CTX)); }
DI void s5_stage_u(const Ctx& c, float* U, int b, int dir, int chunk, int g0, int ng) {
    const bf16_t* PS = (const bf16_t*)(c.ws + WS_P + P_PS);
    const int per = ng * 4;
    for (int e = c.tid; e < S5C * per; e += NTHR) {
        const int i = e / per, c4 = (e % per) * 4, s = s5_tok(dir, chunk * S5C + i);
        float x[4]; unpack4(*(const u32x2*)(PS + (size_t)(b * TZ + s) * 256 + g0 * 16 + c4), x);
        *(float4*)(U + i * (ng * 16) + c4) = make_float4(x[0], x[1], x[2], x[3]);
    }
}
DI void phase_s5_local(const Ctx& c, int l) {
    float* U = (float*)c.smem;
    const float* s5t = (const float*)(c.ws + WS_WSM + OFF_S5T);
    float* E = (float*)(c.ws + WS_WSM + OFF_S5E);
    for (int u = blockIdx.x; u < 2 * 2 * S5N * 2; u += gridDim.x) {
        const int gq = u & 1, chunk = (u >> 1) % S5N, dir = (u / (2 * S5N)) & 1, b = u / (4 * S5N);
        __syncthreads();
        s5_stage_u(c, U, b, dir, chunk, gq * 8, 8);
        __syncthreads();
        const int g = gq * 8 + c.wave, p = c.lane;
        const float* tb = s5t + ((size_t)((l * 2 + dir) * 16 + g) * 64 + p) * 36;
        const float are = tb[0], aim = tb[1];
        float br[16], bi[16];
#pragma unroll
        for (int ch = 0; ch < 16; ++ch) { br[ch] = tb[4 + ch]; bi[ch] = tb[20 + ch]; }
        float xr = 0.f, xi = 0.f;
        for (int i = 0; i < S5C; ++i) {
            const float* uu = U + i * 128 + c.wave * 16;
            float sr = 0.f, si = 0.f;
#pragma unroll
            for (int q = 0; q < 4; ++q) { const float4 v = *(const float4*)(uu + q * 4);
                sr += br[q * 4] * v.x + br[q * 4 + 1] * v.y + br[q * 4 + 2] * v.z + br[q * 4 + 3] * v.w;
                si += bi[q * 4] * v.x + bi[q * 4 + 1] * v.y + bi[q * 4 + 2] * v.z + bi[q * 4 + 3] * v.w; }
            const float nr = are * xr - aim * xi + sr, ni = are * xi + aim * xr + si; xr = nr; xi = ni;
        }
        *(float2*)(E + ((size_t)(((b * 2 + dir) * 16 + g) * S5N + chunk) * 64 + p) * 2) = make_float2(xr, xi);
    }
}
DI void phase_s5_carry(const Ctx& c, int l) {
    const int gt = blockIdx.x * NTHR + c.tid;
    if (gt < 2 * 2 * 16 * 64) {
        const int p = gt & 63, g = (gt >> 6) & 15, dir = (gt >> 10) & 1, b = gt >> 11;
        const float* tb = (const float*)(c.ws + WS_WSM + OFF_S5T) + ((size_t)((l * 2 + dir) * 16 + g) * 64 + p) * 36;
        const float ar = tb[2], ai = tb[3];
        const float* E = (const float*)(c.ws + WS_WSM + OFF_S5E) + (size_t)(((b * 2 + dir) * 16 + g) * S5N) * 128;
        float* C = (float*)(c.ws + WS_WSM + OFF_S5C) + (size_t)(((b * 2 + dir) * 16 + g) * S5N) * 128;
        float xr = 0.f, xi = 0.f;
        for (int ch = 0; ch < S5N; ++ch) {
            *(float2*)(C + ch * 128 + p * 2) = make_float2(xr, xi);
            const float2 e = *(const float2*)(E + ch * 128 + p * 2);
            const float nr = ar * xr - ai * xi + e.x, ni = ar * xi + ai * xr + e.y; xr = nr; xi = ni;
        }
    }
}

DI void phase_s5_final_unit(const Ctx& c, int l, int u) {
    float* U = (float*)c.smem;
    float* Y = U + S5C * 64;
    float* X = Y + 2 * S5C * 64;
    const float* s5t = (const float*)(c.ws + WS_WSM + OFF_S5T);
    const float* CIN = (const float*)(c.ws + WS_WSM + OFF_S5C);
    const int gq = u & 3, ct = (u >> 2) % S5N, b = u / (4 * S5N);
    const int wave = c.wave, lane = c.lane, gl = wave >> 1, dir = wave & 1, g = gq * 4 + gl, p = lane;
    __syncthreads();
    s5_stage_u(c, U, b, 0, ct, gq * 4, 4);
    __syncthreads();
    {
        float* Xw = X + wave * 4 * 128;
        const int cd = dir == 0 ? ct : (ct < 2 ? 1 - ct : 67 - ct);
        const float* tb = s5t + ((size_t)((l * 2 + dir) * 16 + g) * 64 + p) * 36;
        const float are = tb[0], aim = tb[1];
        float br[16], bi[16];
#pragma unroll
        for (int ch = 0; ch < 16; ++ch) { br[ch] = tb[4 + ch]; bi[ch] = tb[20 + ch]; }
        const float2 ci = *(const float2*)(CIN + ((size_t)(((b * 2 + dir) * 16 + g) * S5N + cd) * 64 + p) * 2);
        float xr = ci.x, xi = ci.y;
        const int tt = lane >> 4, chn = lane & 15;
        const float* cre = c.in[29] + ((size_t)((l * 2 + dir) * 16 + g) * 16 + chn) * 64;
        const float* cim = c.in[30] + ((size_t)((l * 2 + dir) * 16 + g) * 16 + chn) * 64;
        const float dsk = c.in[31][(size_t)l * 256 + g * 16 + chn];
        for (int i0 = 0; i0 < S5C; i0 += 4) {
#pragma unroll
            for (int k = 0; k < 4; ++k) {
                const int tl = dir == 0 ? (i0 + k) : S5C - 1 - (i0 + k);
                const float* uu = U + tl * 64 + gl * 16;
                float sr = 0.f, si = 0.f;
#pragma unroll
                for (int q = 0; q < 4; ++q) { const float4 v = *(const float4*)(uu + q * 4);
                    sr += br[q * 4] * v.x + br[q * 4 + 1] * v.y + br[q * 4 + 2] * v.z + br[q * 4 + 3] * v.w;
                    si += bi[q * 4] * v.x + bi[q * 4 + 1] * v.y + bi[q * 4 + 2] * v.z + bi[q * 4 + 3] * v.w; }
                const float nr = are * xr - aim * xi + sr, ni = are * xi + aim * xr + si; xr = nr; xi = ni;
                *(float2*)(Xw + k * 128 + p * 2) = make_float2(xr, xi);
            }
            float y = 0.f;
            const float* xs = Xw + tt * 128;
#pragma unroll 4
            for (int pp = 0; pp < 64; pp += 4) {
                const float4 x0 = *(const float4*)(xs + pp * 2), x1 = *(const float4*)(xs + pp * 2 + 4);
                const float4 a = *(const float4*)(cre + pp), bq = *(const float4*)(cim + pp);
                y += a.x * x0.x - bq.x * x0.y + a.y * x0.z - bq.y * x0.w + a.z * x1.x - bq.z * x1.y + a.w * x1.z - bq.w * x1.w;
            }
            const int tl = dir == 0 ? (i0 + tt) : S5C - 1 - (i0 + tt);
            if (dir == 0) y += dsk * U[tl * 64 + gl * 16 + chn];
            Y[(dir * S5C + tl) * 64 + gl * 16 + chn] = y;
        }
    }
    __syncthreads();
    bf16_t* ZG = (bf16_t*)(c.ws + WS_MISC + MS_ZG);
    for (int e = c.tid; e < S5C * 16; e += NTHR) {
        const int i = e >> 4, c4 = (e & 15) * 4; const float4 y0 = *(const float4*)(Y + i * 64 + c4), y1 = *(const float4*)(Y + (S5C + i) * 64 + c4);
        *(u32x2*)(ZG + (size_t)(b * TZ + ct * S5C + i) * 256 + gq * 64 + c4) = pack4(gelu_tanh(y0.x + y1.x), gelu_tanh(y0.y + y1.y), gelu_tanh(y0.z + y1.z), gelu_tanh(y0.w + y1.w));
    }
}

DI void phase_small_gemms(const Ctx& c, int l) {
    unsigned char* ws = c.ws; unsigned char* wsm = ws + WS_WSM;
    const bf16_t* CQN = (const bf16_t*)(ws + WS_MISC + MS_CQN);
    const float* rope = (const float*)(wsm + OFF_ROPE);
    constexpr int NMT = NZ / 256;
    int base = 0;
    const int G = gridDim.x, bid = blockIdx.x;
    {
        const bf16_t* W = (const bf16_t*)(wsm + OFF_WUQT + l * SZ_WUQT); bf16_t* QM = (bf16_t*)(ws + WS_EXPW + MX_QM);
        const float qs = 0.10206207261596577f * LOG2E;
        for (int u = (bid + G - base % G) % G; u < NMT * 3; u += G) {
            const int mt = u / 3, nt = u % 3, r0 = mt * 256, c0 = nt * 128;
            gemm_tile<4, 0>(c, 256, [&](int i) { return CQN + (size_t)(r0 + i) * 384; }, [&](int i) { return W + (size_t)(c0 + i) * 256; }, NoHook(),
                [&](f32x4 (&acc)[4][4], int wr, int wc, int fr, int fq) {
#pragma unroll
                    for (int n = 0; n < 4; ++n) {
                        const int col = c0 + wc + n * 16 + fq * 4, h = col / 96, d = col % 96;
                        const bool rp = d >= 64;
#pragma unroll
                        for (int m = 0; m < 4; ++m) {
                            const int row = r0 + wr + m * 16 + fr, b = row / TZ, s = row % TZ; f32x4 v = acc[m][n];
                            f32x4 pv; pv[0] = __shfl_xor(v[0], 32, 64); pv[1] = __shfl_xor(v[1], 32, 64); pv[2] = __shfl_xor(v[2], 32, 64); pv[3] = __shfl_xor(v[3], 32, 64);
                            if (rp && s >= CTX) {
                                const int i0 = d - 64;
                                const float* cs = rope + ((size_t)(s - CTX) * 16 + (i0 >> 4) * 8 + (i0 & 7)) * 2;
                                const bool hi = (i0 & 8) != 0;
#pragma unroll
                                for (int j = 0; j < 4; ++j) v[j] = v[j] * cs[2 * j] + (hi ? pv[j] : -pv[j]) * cs[2 * j + 1];
                            }
                            *(u32x2*)(QM + ((size_t)(b * 4 + h) * TZ + s) * 96 + d) = pack4(v[0] * qs, v[1] * qs, v[2] * qs, v[3] * qs);
                        }
                    }
                });
        }
        base += NMT * 3;
    }
    {
        const bf16_t* W = (const bf16_t*)(wsm + OFF_WUKVT + l * SZ_WUKVT); bf16_t* KM = (bf16_t*)(ws + WS_EXPW + MX_KM); bf16_t* VMT = (bf16_t*)(ws + WS_EXPW + MX_VMT);
        for (int u = (bid + G - base % G) % G; u < NMT * 4; u += G) {
            const int mt = u / 4, nt = u % 4, r0 = mt * 256, c0 = nt * 128;
            gemm_tile<4, 0>(c, 128, [&](int i) { return CQN + (size_t)(r0 + i) * 384 + 256; }, [&](int i) { return W + (size_t)(c0 + i) * 128; }, NoHook(),
                [&](f32x4 (&acc)[4][4], int wr, int wc, int fr, int fq) {
#pragma unroll
                    for (int n = 0; n < 4; ++n) {
                        const int col = c0 + wc + n * 16 + fq * 4, h = col >> 7, d = col & 127;
#pragma unroll
                        for (int m = 0; m < 4; ++m) {
                            const int row = r0 + wr + m * 16 + fr, b = row / TZ, s = row % TZ; const f32x4 v = acc[m][n];
                            if (d < 64) *(u32x2*)(KM + ((size_t)(b * 4 + h) * TZ + s) * 96 + d) = pack4(v[0], v[1], v[2], v[3]);
                            else {
#pragma unroll
                                for (int j = 0; j < 4; ++j) VMT[((size_t)(b * 4 + h) * 64 + (d - 64 + j)) * TZ + s] = f2bf(v[j]);
                            }
                        }
                    }
                });
        }
        base += NMT * 4;
    }
    bf16_t* SE = (bf16_t*)(ws + WS_P + P_PR); bf16_t* SAD = SE + (size_t)2 * NZ * 256; bf16_t* SKD = SAD + (size_t)2 * NZ * 256;
    {
        const bf16_t* A = (const bf16_t*)(ws + WS_MISC + MS_TW); const bf16_t* W = (const bf16_t*)(wsm + OFF_W2T + l * SZ_W2T);
        const float* w0 = c.in[14] + (size_t)l * 512;
        for (int u = (bid + G - base % G) % G; u < NMT * 4; u += G) {
            const int mt = u / 4, nt = u % 4, r0 = mt * 256, c0 = nt * 128;
            gemm_tile<4, 0>(c, 64, [&](int i) { return A + (size_t)(r0 + i) * 64; }, [&](int i) { return W + (size_t)(c0 + i) * 64; }, NoHook(),
                [&](f32x4 (&acc)[4][4], int wr, int wc, int fr, int fq) {
#pragma unroll
                    for (int n = 0; n < 4; ++n) {
                        const int col = c0 + wc + n * 16 + fq * 4, d = col >> 8, cc = col & 255; const float4 w0v = *(const float4*)(w0 + col);
#pragma unroll
                        for (int m = 0; m < 4; ++m) {
                            const int row = r0 + wr + m * 16 + fr; const f32x4 v = acc[m][n]; float e[4];
                            const float x[4] = {w0v.x + v[0], w0v.y + v[1], w0v.z + v[2], w0v.w + v[3]};
#pragma unroll
                            for (int j = 0; j < 4; ++j) { const float sp = (x[j] < -20.f) ? -x[j] : log1pf(__expf(-x[j])); e[j] = __expf(-sp - 0.5f); }
                            *(u32x2*)(SE + ((size_t)d * NZ + row) * 256 + cc) = pack4(e[0], e[1], e[2], e[3]);
                        }
                    }
                });
        }
        base += NMT * 4;
    }
    {
        const bf16_t* A = (const bf16_t*)(ws + WS_MISC + MS_AL); const bf16_t* W = (const bf16_t*)(wsm + OFF_A2T + l * SZ_A2T);
        const float* a0 = c.in[16] + (size_t)l * 512; const float* k_a = c.in[20] + (size_t)l * 256; const bf16_t* KB = (const bf16_t*)(ws + WS_EXPW + MX_KB);
        for (int u = (bid + G - base % G) % G; u < NMT * 4; u += G) {
            const int mt = u / 4, nt = u % 4, r0 = mt * 256, c0 = nt * 128;
            gemm_tile<4, 0>(c, 64, [&](int i) { return A + (size_t)(r0 + i) * 64; }, [&](int i) { return W + (size_t)(c0 + i) * 64; }, NoHook(),
                [&](f32x4 (&acc)[4][4], int wr, int wc, int fr, int fq) {
#pragma unroll
                    for (int n = 0; n < 4; ++n) {
                        const int col = c0 + wc + n * 16 + fq * 4, d = col >> 8, cc = col & 255; const float4 a0v = *(const float4*)(a0 + col), kav = *(const float4*)(k_a + cc);
#pragma unroll
                        for (int m = 0; m < 4; ++m) {
                            const int row = r0 + wr + m * 16 + fr; const f32x4 v = acc[m][n];
                            const float ad0 = sigmoidf_(a0v.x + v[0]), ad1 = sigmoidf_(a0v.y + v[1]), ad2 = sigmoidf_(a0v.z + v[2]), ad3 = sigmoidf_(a0v.w + v[3]);
                            float k[4]; unpack4(*(const u32x2*)(KB + (size_t)row * 256 + cc), k);
                            *(u32x2*)(SAD + ((size_t)d * NZ + row) * 256 + cc) = pack4(ad0, ad1, ad2, ad3);
                            *(u32x2*)(SKD + ((size_t)d * NZ + row) * 256 + cc) = pack4(k[0] * (1.f + (ad0 - 1.f) * kav.x), k[1] * (1.f + (ad1 - 1.f) * kav.y), k[2] * (1.f + (ad2 - 1.f) * kav.z), k[3] * (1.f + (ad3 - 1.f) * kav.w));
                        }
                    }
                });
        }
        base += NMT * 4;
    }
    {
        const bf16_t* A = (const bf16_t*)(ws + WS_MISC + MS_SG); const bf16_t* W = (const bf16_t*)(wsm + OFF_G2T + l * SZ_G2T); bf16_t* GG = (bf16_t*)(ws + WS_MISC + MS_GG);
        for (int u = (bid + G - base % G) % G; u < NMT * 2; u += G) {
            const int mt = u / 2, nt = u % 2, r0 = mt * 256, c0 = nt * 128;
            gemm_tile<4, 0>(c, 128, [&](int i) { return A + (size_t)(r0 + i) * 128; }, [&](int i) { return W + (size_t)(c0 + i) * 128; }, NoHook(),
                [&](f32x4 (&acc)[4][4], int wr, int wc, int fr, int fq) {
#pragma unroll
                    for (int n = 0; n < 4; ++n)
#pragma unroll
                        for (int m = 0; m < 4; ++m) { const f32x4 v = acc[m][n];
                            *(u32x2*)(GG + (size_t)(r0 + wr + m * 16 + fr) * 256 + c0 + wc + n * 16 + fq * 4) = pack4(v[0], v[1], v[2], v[3]); }
                });
        }
        base += NMT * 2;
    }
}

DI int krow(int s, int h, int j) { return 16 * s + 8 * (j >> 2) + 4 * h + (j & 3); }
constexpr int ATT_PARK = 48 * 1024;
template <int MODE>
DI void attn_pass(const Ctx& c, int l, int b, int h, int q0, int nkeys) {
    constexpr int DROW = MODE == 0 ? 96 : 64;
    constexpr int DQ = MODE == 0 ? 96 : 32, KS = DQ / 16;
    constexpr int DOFF = MODE == 2 ? 32 : 0;
    constexpr int KPITCH = DQ * 2 + 16;
    constexpr int VPITCH = 64 * 2 + 16;
    constexpr int KBYTES = 64 * KPITCH, VBYTES = 64 * VPITCH, STG = KBYTES + VBYTES;
    unsigned char* ws = c.ws; const int tid = c.tid, lane = c.lane, wave = c.wave, r = lane & 31, hh = lane >> 5;
    const bf16_t* Q = (const bf16_t*)(ws + WS_EXPW + (MODE == 0 ? MX_QM : MX_QD)) + (size_t)(b * 4 + h) * TZ * DROW + DOFF;
    const bf16_t* Kp = (const bf16_t*)(ws + WS_EXPW + (MODE == 0 ? MX_KM : MX_KD)) + (size_t)(b * 4 + h) * TZ * DROW + DOFF;
    const bf16_t* Vt = (const bf16_t*)(ws + WS_EXPW + (MODE == 0 ? MX_VMT : MX_VDT)) + (size_t)(b * 4 + h) * 64 * TZ;
    unsigned char* smem = c.smem;
    bf16x8 qf[KS];
    const int qrow = q0 + wave * 32 + r;
#pragma unroll
    for (int ks = 0; ks < KS; ++ks) qf[ks] = *(const bf16x8*)(Q + (size_t)qrow * DROW + ks * 16 + hh * 8);
    f32x16 oacc[2];
    float mrun = -1e30f, lrun = 0.f;
#pragma unroll
    for (int t = 0; t < 2; ++t)
#pragma unroll
        for (int i = 0; i < 16; ++i) oacc[t][i] = 0.f;
    constexpr int CPR = DQ / 8, KCH = 64 * CPR;
    u32x4 kreg[2], vreg;
    auto gload = [&](int kt) {
        const int k0 = kt * 64;
#pragma unroll
        for (int i = 0; i < 2; ++i) { const int ch = tid + i * NTHR; if (ch < KCH) kreg[i] = *(const u32x4*)(Kp + (size_t)(k0 + ch / CPR) * DROW + (ch % CPR) * 8); }
        vreg = *(const u32x4*)(Vt + (size_t)(tid >> 3) * TZ + k0 + (tid & 7) * 8);
    };
    auto lstore = [&](int buf) {
        unsigned char* sk = smem + buf * STG; unsigned char* sv = sk + KBYTES;
#pragma unroll
        for (int i = 0; i < 2; ++i) { const int ch = tid + i * NTHR; if (ch < KCH) *(u32x4*)(sk + (ch / CPR) * KPITCH + (ch % CPR) * 16) = kreg[i]; }
        *(u32x4*)(sv + (tid >> 3) * VPITCH + (tid & 7) * 16) = vreg;
    };
    const int NT = nkeys / 64;
    __syncthreads();
    gload(0);
    for (int kt = 0; kt < NT; ++kt) {
        lstore(kt & 1);
        if (kt + 1 < NT) gload(kt + 1);
        __syncthreads();
        const unsigned char* sk = smem + (kt & 1) * STG; const unsigned char* sv = sk + KBYTES;
        f32x16 sacc[2];
#pragma unroll
        for (int kg = 0; kg < 2; ++kg) {
#pragma unroll
            for (int i = 0; i < 16; ++i) sacc[kg][i] = 0.f;
#pragma unroll
            for (int ks = 0; ks < KS; ++ks) {
                const bf16x8 kf = *(const bf16x8*)(sk + (kg * 32 + r) * KPITCH + ks * 32 + hh * 16);
                sacc[kg] = __builtin_amdgcn_mfma_f32_32x32x16_bf16(kf, qf[ks], sacc[kg], 0, 0, 0);
            }
        }
        float mx = sacc[0][0];
#pragma unroll
        for (int kg = 0; kg < 2; ++kg)
#pragma unroll
            for (int i = 0; i < 16; ++i) mx = fmaxf(mx, sacc[kg][i]);
        mx = fmaxf(mx, __shfl_xor(mx, 32, 64));
        const float mnew = fmaxf(mrun, mx), alpha = __builtin_amdgcn_exp2f(mrun - mnew);
        mrun = mnew;
        float psum = 0.f;
#pragma unroll
        for (int kg = 0; kg < 2; ++kg)
#pragma unroll
            for (int i = 0; i < 16; ++i) { const float p = __builtin_amdgcn_exp2f(sacc[kg][i] - mnew); sacc[kg][i] = p; psum += p; }
        lrun = lrun * alpha + psum;
#pragma unroll
        for (int t = 0; t < 2; ++t)
#pragma unroll
            for (int i = 0; i < 16; ++i) oacc[t][i] *= alpha;
#pragma unroll
        for (int kg = 0; kg < 2; ++kg)
#pragma unroll
            for (int s = 0; s < 2; ++s) {
                u32x4 pk; pk.x = pack2(sacc[kg][8 * s + 0], sacc[kg][8 * s + 1]); pk.y = pack2(sacc[kg][8 * s + 2], sacc[kg][8 * s + 3]);
                pk.z = pack2(sacc[kg][8 * s + 4], sacc[kg][8 * s + 5]); pk.w = pack2(sacc[kg][8 * s + 6], sacc[kg][8 * s + 7]);
                const bf16x8 pf = __builtin_bit_cast(bf16x8, pk);
#pragma unroll
                for (int t = 0; t < 2; ++t) {
                    const unsigned char* vrow = sv + (t * 32 + r) * VPITCH + (kg * 32 + 16 * s + 4 * hh) * 2;
                    const u32x2 lo = *(const u32x2*)vrow, hi2 = *(const u32x2*)(vrow + 16);
                    u32x4 vv; vv.x = lo.x; vv.y = lo.y; vv.z = hi2.x; vv.w = hi2.y;
                    oacc[t] = __builtin_amdgcn_mfma_f32_32x32x16_bf16(__builtin_bit_cast(bf16x8, vv), pf, oacc[t], 0, 0, 0);
                }
            }
    }
    const float inv = 1.f / (lrun + __shfl_xor(lrun, 32, 64));
    bf16_t* Ycat = (bf16_t*)(ws + WS_BUFA);
    const int zrow = b * TZ + qrow;
    float* park = (float*)(smem + ATT_PARK) + tid;
    if (MODE == 0) {
#pragma unroll
        for (int t = 0; t < 2; ++t)
#pragma unroll
            for (int i4 = 0; i4 < 4; ++i4) {
                const int dv = t * 32 + 8 * i4 + 4 * hh;
                *(u32x2*)(Ycat + (size_t)zrow * D + h * 64 + dv) = pack4(oacc[t][4 * i4] * inv, oacc[t][4 * i4 + 1] * inv, oacc[t][4 * i4 + 2] * inv, oacc[t][4 * i4 + 3] * inv);
            }
    } else if (MODE == 1) {
#pragma unroll
        for (int t = 0; t < 2; ++t)
#pragma unroll
            for (int i = 0; i < 16; ++i) park[(t * 16 + i) * NTHR] = oacc[t][i] * inv;
    } else {
        const float lam = ((const float*)(ws + WS_WSM + OFF_LAM))[l];
        const float lam_init = 0.8f - 0.6f * __expf(-0.3f * (float)l);
        float ss = 0.f;
#pragma unroll
        for (int t = 0; t < 2; ++t)
#pragma unroll
            for (int i = 0; i < 16; ++i) { const float o = park[(t * 16 + i) * NTHR] - lam * oacc[t][i] * inv; oacc[t][i] = o; ss += o * o; }
        ss += __shfl_xor(ss, 32, 64);
        const float rs = rsqrtf(ss * (1.f / 64.f) + 1e-5f) * (1.f - lam_init);
        const float* sg = c.in[38] + l * 64;
#pragma unroll
        for (int t = 0; t < 2; ++t)
#pragma unroll
            for (int i4 = 0; i4 < 4; ++i4) {
                const int dv = t * 32 + 8 * i4 + 4 * hh; const float4 g = *(const float4*)(sg + dv);
                *(u32x2*)(Ycat + (size_t)zrow * D + 768 + h * 64 + dv) = pack4(oacc[t][4 * i4] * rs * g.x, oacc[t][4 * i4 + 1] * rs * g.y, oacc[t][4 * i4 + 2] * rs * g.z, oacc[t][4 * i4 + 3] * rs * g.w);
            }
    }
}
DI void phase_attention(const Ctx& c, int l) {
    const int nu = 512 + (l == 0 ? 16 : 0);
    for (int u = blockIdx.x; u < nu; u += gridDim.x) {
        int b, h, q0, nk; bool mla;
        if (u < 512) { const int k = u & 255; b = k >> 7; h = (k >> 5) & 3; q0 = CTX + (k & 31) * 256; nk = TZ; mla = u < 256; }
        else { const int k = u - 512; b = (k >> 2) & 1; h = k & 3; q0 = 0; nk = CTX; mla = k < 8; }
        if (mla) attn_pass<0>(c, l, b, h, q0, nk);
        else { attn_pass<1>(c, l, b, h, q0, nk); attn_pass<2>(c, l, b, h, q0, nk); }
    }
}

DI int rw_tok(int dir, int i) { return dir == 0 ? i : (i < CTX ? CTX - 1 - i : TZ - 1 - (i - CTX)); }
constexpr int RW_TS = 32;
constexpr int RW_STEP_F = 6 * 64 + 2;
constexpr int RW_BUF_F = RW_TS * RW_STEP_F;
template <int CTRL> DI float dpp_add(float x) { return x + __int_as_float(__builtin_amdgcn_update_dpp(0, __float_as_int(x), CTRL, 0xf, 0xf, false)); }
DI float red16(float x) { x = dpp_add<0xB1>(x); x = dpp_add<0x4E>(x); x = dpp_add<0x141>(x); x = dpp_add<0x140>(x); return x; }
DI float red8(float x) { x = dpp_add<0xB1>(x); x = dpp_add<0x4E>(x); x = dpp_add<0x141>(x); return x; }
struct RwRegs { u32x4 r, v, kk, e, ad, kd; };
DI void rw_load(const Ctx& c, int b, int h, int dir, int chunk, int t, RwRegs& g) {
    const bf16_t* RB = (const bf16_t*)(c.ws + WS_EXPW + MX_RB); const bf16_t* VB = (const bf16_t*)(c.ws + WS_EXPW + MX_VB); const bf16_t* KKB = (const bf16_t*)(c.ws + WS_EXPW + MX_KKB);
    const bf16_t* SE = (const bf16_t*)(c.ws + WS_P + P_PR) + (size_t)dir * NZ * 256; const bf16_t* SAD = SE + (size_t)2 * NZ * 256; const bf16_t* SKD = SAD + (size_t)2 * NZ * 256;
    const int i = chunk * RW_TS + (t >> 3), z = b * TZ + rw_tok(dir, i); const size_t o = (size_t)z * 256 + h * 64 + (t & 7) * 8;
    g.r = *(const u32x4*)(RB + o); g.v = *(const u32x4*)(VB + o); g.kk = *(const u32x4*)(KKB + o);
    g.e = *(const u32x4*)(SE + o); g.ad = *(const u32x4*)(SAD + o); g.kd = *(const u32x4*)(SKD + o);
}
DI void up8(const u32x4& u, float (&f)[8]) { f[0] = lo2f(u.x); f[1] = hi2f(u.x); f[2] = lo2f(u.y); f[3] = hi2f(u.y); f[4] = lo2f(u.z); f[5] = hi2f(u.z); f[6] = lo2f(u.w); f[7] = hi2f(u.w); }
DI void rw_process(const RwRegs& g, int t, float* buf) {
    float r[8], v[8], kk[8], e[8], ad[8], kd[8];
    up8(g.r, r); up8(g.v, v); up8(g.kk, kk); up8(g.e, e); up8(g.ad, ad); up8(g.kd, kd);
    float* f = buf + (t >> 3) * RW_STEP_F + (t & 7) * 8;
    float w[8], bv[8], wr[8]; float br = 0.f, kr = 0.f;
#pragma unroll
    for (int j = 0; j < 8; ++j) { w[j] = __expf(-e[j]); bv[j] = kk[j] * ad[j]; wr[j] = w[j] * r[j]; br += bv[j] * r[j]; kr += kd[j] * r[j]; }
    *(float4*)(f) = make_float4(w[0], w[1], w[2], w[3]); *(float4*)(f + 4) = make_float4(w[4], w[5], w[6], w[7]);
    *(float4*)(f + 64) = make_float4(kk[0], kk[1], kk[2], kk[3]); *(float4*)(f + 68) = make_float4(kk[4], kk[5], kk[6], kk[7]);
    *(float4*)(f + 128) = make_float4(bv[0], bv[1], bv[2], bv[3]); *(float4*)(f + 132) = make_float4(bv[4], bv[5], bv[6], bv[7]);
    *(float4*)(f + 192) = make_float4(kd[0], kd[1], kd[2], kd[3]); *(float4*)(f + 196) = make_float4(kd[4], kd[5], kd[6], kd[7]);
    *(float4*)(f + 256) = make_float4(wr[0], wr[1], wr[2], wr[3]); *(float4*)(f + 260) = make_float4(wr[4], wr[5], wr[6], wr[7]);
    *(float4*)(f + 320) = make_float4(v[0], v[1], v[2], v[3]); *(float4*)(f + 324) = make_float4(v[4], v[5], v[6], v[7]);
    br = red8(br); kr = red8(kr);
    if ((t & 7) == 0) { float* s = buf + (t >> 3) * RW_STEP_F + 384; s[0] = br; s[1] = kr; }
}
struct RwStep { float4 w, kk, bv, kd, wr; float vv, br, kr; };
DI void rw_ld(RwStep& s, const float* f, int kq, int row) {
    s.w = *(const float4*)(f + kq * 4); s.kk = *(const float4*)(f + 64 + kq * 4); s.bv = *(const float4*)(f + 128 + kq * 4);
    s.kd = *(const float4*)(f + 192 + kq * 4); s.wr = *(const float4*)(f + 256 + kq * 4); s.vv = f[320 + row]; s.br = f[384]; s.kr = f[385];
}
DI void phase_rwkv_scan_unit(const Ctx& c, int l, int u) {
    const int rg = u & 3, chain = u >> 2, dir = chain & 1, h = (chain >> 1) & 3, b = chain >> 3;
    float* buf0 = (float*)c.smem; float* buf1 = buf0 + RW_BUF_F;
    float* ybuf = buf1 + RW_BUF_F;
    float* YO = (float*)(c.ws + WS_BUFB) + (size_t)dir * NZ * 256 + (size_t)b * TZ * 256 + h * 64 + rg * 16;
    const int wave = c.wave, lane = c.lane, rr = lane >> 4, kq = lane & 15, rl = (wave & 3) * 4 + rr, row = rg * 16 + rl;
    const int t = c.tid - 256;
    float S0 = 0.f, S1 = 0.f, S2 = 0.f, S3 = 0.f;
    constexpr int NCH = TZ / RW_TS;
    RwRegs g;
    __syncthreads();
    if (wave >= 4) { rw_load(c, b, h, dir, 0, t, g); rw_process(g, t, buf0); rw_load(c, b, h, dir, 1, t, g); }
    __syncthreads();
    for (int ch = 0; ch < NCH; ++ch) {
        float* cur = buf0 + (ch & 1) * RW_BUF_F; float* nxt = buf0 + ((ch + 1) & 1) * RW_BUF_F;
        if (wave >= 4) {
            if (ch > 0) {
                const float* yb = ybuf + ((ch - 1) & 1) * RW_TS * 16;
#pragma unroll
                for (int i = 0; i < 2; ++i) { const int e = t + i * 256, st = e >> 4, rw = e & 15; YO[(size_t)rw_tok(dir, (ch - 1) * RW_TS + st) * 256 + rw] = yb[e]; }
            }
            if (ch + 1 < NCH) rw_process(g, t, nxt);
            if (ch + 2 < NCH) rw_load(c, b, h, dir, ch + 2, t, g);
        } else {
            float* yb = ybuf + (ch & 1) * RW_TS * 16 + rl;
            RwStep s0, s1;
            rw_ld(s0, cur, kq, row);
#pragma unroll 4
            for (int st = 0; st < RW_TS; st += 2) {
                rw_ld(s1, cur + (st + 1) * RW_STEP_F, kq, row);
                {
                    float sa = -((S0 * s0.kk.x + S1 * s0.kk.y) + (S2 * s0.kk.z + S3 * s0.kk.w));
                    float q = (S0 * s0.wr.x + S1 * s0.wr.y) + (S2 * s0.wr.z + S3 * s0.wr.w);
                    sa = red16(sa); q = red16(q);
                    S0 = fmaf(sa, s0.bv.x, fmaf(S0, s0.w.x, s0.vv * s0.kd.x)); S1 = fmaf(sa, s0.bv.y, fmaf(S1, s0.w.y, s0.vv * s0.kd.y));
                    S2 = fmaf(sa, s0.bv.z, fmaf(S2, s0.w.z, s0.vv * s0.kd.z)); S3 = fmaf(sa, s0.bv.w, fmaf(S3, s0.w.w, s0.vv * s0.kd.w));
                    yb[st * 16] = q + sa * s0.br + s0.vv * s0.kr;
                }
                if (st + 2 < RW_TS) rw_ld(s0, cur + (st + 2) * RW_STEP_F, kq, row);
                {
                    float sa = -((S0 * s1.kk.x + S1 * s1.kk.y) + (S2 * s1.kk.z + S3 * s1.kk.w));
                    float q = (S0 * s1.wr.x + S1 * s1.wr.y) + (S2 * s1.wr.z + S3 * s1.wr.w);
                    sa = red16(sa); q = red16(q);
                    S0 = fmaf(sa, s1.bv.x, fmaf(S0, s1.w.x, s1.vv * s1.kd.x)); S1 = fmaf(sa, s1.bv.y, fmaf(S1, s1.w.y, s1.vv * s1.kd.y));
                    S2 = fmaf(sa, s1.bv.z, fmaf(S2, s1.w.z, s1.vv * s1.kd.z)); S3 = fmaf(sa, s1.bv.w, fmaf(S3, s1.w.w, s1.vv * s1.kd.w));
                    yb[(st + 1) * 16] = q + sa * s1.br + s1.vv * s1.kr;
                }
            }
        }
        __syncthreads();
    }
    if (wave >= 4) {
        const float* yb = ybuf + ((NCH - 1) & 1) * RW_TS * 16;
#pragma unroll
        for (int i = 0; i < 2; ++i) { const int e = t + i * 256, st = e >> 4, rw = e & 15; YO[(size_t)rw_tok(dir, (NCH - 1) * RW_TS + st) * 256 + rw] = yb[e]; }
    }
}

constexpr int LA_AN = 0, LA_RN = 8192, LA_BN = 16384, LA_KN = 24576, LA_AT = 32768, LA_BHT = 40960, LA_KHT = 49152, LA_VT = 57344,
              LA_NBA = 65536  , LA_NKA = 81920, LA_NBRT = 90112, LA_NKRT = 98304, LA_P63 = 106496;
constexpr int LA_TMT = LA_AN, LA_M1 = LA_BN, LA_W1T = LA_KN, LA_Z1 = LA_NBA;
DI int crow(int reg, int h) { return (reg & 3) + 8 * (reg >> 2) + 4 * h; }
DI void mm_tile(f32x16& acc, const unsigned char* A, int i0, const unsigned char* BT, int j0, int r, int h) {
#pragma unroll
    for (int ks = 0; ks < 4; ++ks) {
        const bf16x8 a = *(const bf16x8*)(A + (i0 + r) * 128 + ks * 32 + h * 16);
        const bf16x8 b = *(const bf16x8*)(BT + (j0 + r) * 128 + ks * 32 + h * 16);
        acc = __builtin_amdgcn_mfma_f32_32x32x16_bf16(a, b, acc, 0, 0, 0);
    }
}
DI void zero16(f32x16& a) {
#pragma unroll
    for (int i = 0; i < 16; ++i) a[i] = 0.f;
}
DI void phase_rwkv_chunk_unit(const Ctx& c, int l, int unit) {
    unsigned char* L = c.smem; unsigned char* ws = c.ws;
    const int chain = unit / RNC, ch = unit % RNC, dir = chain & 1, hd = (chain >> 1) & 3, b = chain >> 3;
    const int tid = c.tid, lane = c.lane, wave = c.wave, r = lane & 31, h = lane >> 5;
    const bf16_t* RB = (const bf16_t*)(ws + WS_EXPW + MX_RB); const bf16_t* VB = (const bf16_t*)(ws + WS_EXPW + MX_VB); const bf16_t* KKB = (const bf16_t*)(ws + WS_EXPW + MX_KKB);
    const bf16_t* SE = (const bf16_t*)(ws + WS_P + P_PR) + (size_t)dir * NZ * 256; const bf16_t* SAD = SE + (size_t)2 * NZ * 256; const bf16_t* SKD = SAD + (size_t)2 * NZ * 256;
    float* CUM = (float*)(L + LA_NBA);
    __syncthreads();
    const int t = tid >> 3, k0 = (tid & 7) * 8;
    float rr[8], vv[8], kk[8], ee[8], ad[8], kd[8];
    {
        const int z = b * TZ + rw_tok(dir, ch * RC + t); const size_t o = (size_t)z * 256 + hd * 64 + k0;
        up8(*(const u32x4*)(RB + o), rr); up8(*(const u32x4*)(VB + o), vv); up8(*(const u32x4*)(KKB + o), kk);
        up8(*(const u32x4*)(SE + o), ee); up8(*(const u32x4*)(SAD + o), ad); up8(*(const u32x4*)(SKD + o), kd);
        *(float4*)(CUM + t * 64 + k0) = make_float4(ee[0], ee[1], ee[2], ee[3]); *(float4*)(CUM + t * 64 + k0 + 4) = make_float4(ee[4], ee[5], ee[6], ee[7]);
    }
    __syncthreads();
    if (wave == 0) { float cm = 0.f;
#pragma unroll 8
        for (int i = 0; i < RC; ++i) { cm += CUM[i * 64 + lane]; CUM[i * 64 + lane] = cm; } }
    __syncthreads();
    {
        float cm[8], c63[8];
        { const float4 a = *(const float4*)(CUM + t * 64 + k0), bq = *(const float4*)(CUM + t * 64 + k0 + 4); cm[0] = a.x; cm[1] = a.y; cm[2] = a.z; cm[3] = a.w; cm[4] = bq.x; cm[5] = bq.y; cm[6] = bq.z; cm[7] = bq.w; }
        { const float4 a = *(const float4*)(CUM + 63 * 64 + k0), bq = *(const float4*)(CUM + 63 * 64 + k0 + 4); c63[0] = a.x; c63[1] = a.y; c63[2] = a.z; c63[3] = a.w; c63[4] = bq.x; c63[5] = bq.y; c63[6] = bq.z; c63[7] = bq.w; }
        float at[8], rt[8], bt[8], kt[8], bh[8], kh[8];
#pragma unroll
        for (int j = 0; j < 8; ++j) {
            const float pt = __expf(-cm[j]), pp = __expf(-(cm[j] - ee[j])), ip = __expf(cm[j]), ph = __expf(-(c63[j] - cm[j])), bb = kk[j] * ad[j];
            at[j] = -kk[j] * pp; rt[j] = rr[j] * pt; bt[j] = bb * ip; kt[j] = kd[j] * ip; bh[j] = bb * ph; kh[j] = kd[j] * ph;
        }
        u32x4 w4;
        w4.x = pack2(at[0], at[1]); w4.y = pack2(at[2], at[3]); w4.z = pack2(at[4], at[5]); w4.w = pack2(at[6], at[7]); *(u32x4*)(L + LA_AN + t * 128 + k0 * 2) = w4;
        w4.x = pack2(rt[0], rt[1]); w4.y = pack2(rt[2], rt[3]); w4.z = pack2(rt[4], rt[5]); w4.w = pack2(rt[6], rt[7]); *(u32x4*)(L + LA_RN + t * 128 + k0 * 2) = w4;
        w4.x = pack2(bt[0], bt[1]); w4.y = pack2(bt[2], bt[3]); w4.z = pack2(bt[4], bt[5]); w4.w = pack2(bt[6], bt[7]); *(u32x4*)(L + LA_BN + t * 128 + k0 * 2) = w4;
        w4.x = pack2(kt[0], kt[1]); w4.y = pack2(kt[2], kt[3]); w4.z = pack2(kt[4], kt[5]); w4.w = pack2(kt[6], kt[7]); *(u32x4*)(L + LA_KN + t * 128 + k0 * 2) = w4;
#pragma unroll
        for (int j = 0; j < 8; ++j) {
            *(bf16_t*)(L + LA_AT + (k0 + j) * 128 + t * 2) = f2bf(at[j]); *(bf16_t*)(L + LA_BHT + (k0 + j) * 128 + t * 2) = f2bf(bh[j]);
            *(bf16_t*)(L + LA_KHT + (k0 + j) * 128 + t * 2) = f2bf(kh[j]); *(bf16_t*)(L + LA_VT + (k0 + j) * 128 + t * 2) = f2bf(vv[j]);
        }
        if (t == 63) {
            float* p63 = (float*)(L + LA_P63); float* gp = (float*)(ws + WS_RW + RW_P63) + (size_t)unit * 64;
#pragma unroll
            for (int j = 0; j < 8; ++j) { const float p = __expf(-c63[j]); p63[k0 + j] = p; gp[k0 + j] = p; }
        }
    }
    __syncthreads();
    {
        const int p = wave >> 1, i0 = (wave & 1) * 32;
        const unsigned char* A = L + (p == 0 ? LA_BN : p == 1 ? LA_KN : LA_RN);
        const unsigned char* BT = L + (p < 2 ? LA_AN : p == 2 ? LA_BN : LA_KN);
#pragma unroll
        for (int jt = 0; jt < 2; ++jt) {
            const int j0 = jt * 32; f32x16 acc; zero16(acc);
            mm_tile(acc, A, i0, BT, j0, r, h);
            const int col = j0 + r;
#pragma unroll
            for (int g = 0; g < 16; ++g) {
                const int row = i0 + crow(g, h);
                if (p == 0) ((float*)(L + LA_NBA))[row * 64 + col] = (row < col) ? acc[g] : 0.f;
                else if (p == 1) *(bf16_t*)(L + LA_NKA + row * 128 + col * 2) = f2bf((row < col) ? acc[g] : 0.f);
                else *(bf16_t*)(L + (p == 2 ? LA_NBRT : LA_NKRT) + row * 128 + col * 2) = f2bf((col <= row) ? acc[g] : 0.f);
            }
        }
    }
    __syncthreads();
    if (wave == 0) {
        const float* N = (const float*)(L + LA_NBA);
        float* TC = (float*)(L + LA_BN);
#pragma unroll 1
        for (int s = 63; s >= 0; --s) {
            float a0 = (s == lane) ? 1.f : 0.f, a1 = 0.f, a2 = 0.f, a3 = 0.f;
            int j = s + 1;
#pragma unroll 1
            for (; (j & 3) != 0 && j < 64; ++j) a0 = fmaf(N[s * 64 + j], TC[j * 64 + lane], a0);
#pragma unroll 2
            for (; j < 64; j += 4) {
                const float4 n = *(const float4*)(N + s * 64 + j);
                a0 = fmaf(n.x, TC[j * 64 + lane], a0); a1 = fmaf(n.y, TC[(j + 1) * 64 + lane], a1); a2 = fmaf(n.z, TC[(j + 2) * 64 + lane], a2); a3 = fmaf(n.w, TC[(j + 3) * 64 + lane], a3);
            }
            TC[s * 64 + lane] = (a0 + a1) + (a2 + a3);
        }
        unsigned char* dst = L + LA_TMT + lane * 128;
#pragma unroll
        for (int q = 0; q < 8; ++q) {
            u32x4 w4; w4.x = pack2(TC[(q * 8) * 64 + lane], TC[(q * 8 + 1) * 64 + lane]); w4.y = pack2(TC[(q * 8 + 2) * 64 + lane], TC[(q * 8 + 3) * 64 + lane]);
            w4.z = pack2(TC[(q * 8 + 4) * 64 + lane], TC[(q * 8 + 5) * 64 + lane]); w4.w = pack2(TC[(q * 8 + 6) * 64 + lane], TC[(q * 8 + 7) * 64 + lane]);
            *(u32x4*)(dst + q * 16) = w4;
        }
    }
    __syncthreads();
    {
        const int p = wave >> 2, i0 = ((wave >> 1) & 1) * 32, j0 = (wave & 1) * 32; f32x16 acc; zero16(acc);
        if (p == 0) {
            mm_tile(acc, L + LA_TMT, i0, L + LA_AT, j0, r, h);
#pragma unroll
            for (int g4 = 0; g4 < 4; ++g4) *(u32x2*)(L + LA_M1 + (j0 + r) * 128 + (i0 + 8 * g4 + 4 * h) * 2) = pack4(acc[4 * g4], acc[4 * g4 + 1], acc[4 * g4 + 2], acc[4 * g4 + 3]);
        } else {
            mm_tile(acc, L + LA_NKA, i0, L + LA_TMT, j0, r, h);
#pragma unroll
            for (int g4 = 0; g4 < 4; ++g4) *(u32x2*)(L + LA_W1T + (j0 + r) * 128 + (i0 + 8 * g4 + 4 * h) * 2) = pack4(acc[4 * g4], acc[4 * g4 + 1], acc[4 * g4 + 2], acc[4 * g4 + 3]);
        }
    }
    __syncthreads();
    if (wave < 4) {
        const int i0 = (wave >> 1) * 32, j0 = (wave & 1) * 32; f32x16 acc; zero16(acc);
        mm_tile(acc, L + LA_W1T, i0, L + LA_VT, j0, r, h);
#pragma unroll
        for (int g4 = 0; g4 < 4; ++g4) *(u32x2*)(L + LA_Z1 + (j0 + r) * 128 + (i0 + 8 * g4 + 4 * h) * 2) = pack4(acc[4 * g4], acc[4 * g4 + 1], acc[4 * g4 + 2], acc[4 * g4 + 3]);
    }
    __syncthreads();
    {
        const int p = wave >> 1, i0 = (wave & 1) * 32;
        bf16_t* GM3 = (bf16_t*)(ws + WS_RW + RW_M3) + (size_t)unit * 4096; bf16_t* GM2 = (bf16_t*)(ws + WS_RW + RW_M2) + (size_t)unit * 4096; bf16_t* GZ5 = (bf16_t*)(ws + WS_RW + RW_Z5) + (size_t)unit * 4096;
        float* YO = (float*)(ws + WS_BUFB) + (size_t)dir * NZ * 256;
#pragma unroll
        for (int jt = 0; jt < 2; ++jt) {
            const int j0 = jt * 32; f32x16 acc; zero16(acc);
            if (p == 0) {
                mm_tile(acc, L + LA_M1, i0, L + LA_NBRT, j0, r, h);
#pragma unroll
                for (int g4 = 0; g4 < 4; ++g4) { const int tt = j0 + r, kq = i0 + 8 * g4 + 4 * h; float rv[4]; unpack4(*(const u32x2*)(L + LA_RN + tt * 128 + kq * 2), rv);
                    *(u32x2*)(GM2 + tt * 64 + kq) = pack4(acc[4 * g4] + rv[0], acc[4 * g4 + 1] + rv[1], acc[4 * g4 + 2] + rv[2], acc[4 * g4 + 3] + rv[3]); }
            } else if (p == 1) {
                mm_tile(acc, L + LA_NBRT, i0, L + LA_Z1, j0, r, h); mm_tile(acc, L + LA_NKRT, i0, L + LA_VT, j0, r, h);
#pragma unroll
                for (int g = 0; g < 16; ++g) { const int tt = i0 + crow(g, h); YO[(size_t)(b * TZ + rw_tok(dir, ch * RC + tt)) * 256 + hd * 64 + j0 + r] = acc[g]; }
            } else if (p == 2) {
                mm_tile(acc, L + LA_M1, i0, L + LA_BHT, j0, r, h);
#pragma unroll
                for (int g4 = 0; g4 < 4; ++g4) *(u32x2*)(GM3 + (j0 + r) * 64 + i0 + 8 * g4 + 4 * h) = pack4(acc[4 * g4], acc[4 * g4 + 1], acc[4 * g4 + 2], acc[4 * g4 + 3]);
            } else {
                mm_tile(acc, L + LA_BHT, i0, L + LA_Z1, j0, r, h); mm_tile(acc, L + LA_KHT, i0, L + LA_VT, j0, r, h);
#pragma unroll
                for (int g4 = 0; g4 < 4; ++g4) *(u32x2*)(GZ5 + (j0 + r) * 64 + i0 + 8 * g4 + 4 * h) = pack4(acc[4 * g4], acc[4 * g4 + 1], acc[4 * g4 + 2], acc[4 * g4 + 3]);
            }
        }
    }
}
DI void phase_rwkv_chunks(const Ctx& c, int l) {
    for (int u = blockIdx.x; u < 16 * RNC; u += gridDim.x) phase_rwkv_chunk_unit(c, l, u);
}
DI bf16x8 pack8(const f32x16& x, int s) {
    u32x4 p; p.x = pack2(x[8 * s], x[8 * s + 1]); p.y = pack2(x[8 * s + 2], x[8 * s + 3]); p.z = pack2(x[8 * s + 4], x[8 * s + 5]); p.w = pack2(x[8 * s + 6], x[8 * s + 7]);
    return __builtin_bit_cast(bf16x8, p);
}
DI bf16x8 ldfrag(const bf16_t* rowp, int s, int h) {
    const u32x2 lo = *(const u32x2*)(rowp + 16 * s + 4 * h), hi = *(const u32x2*)(rowp + 16 * s + 8 + 4 * h);
    u32x4 v; v.x = lo.x; v.y = lo.y; v.z = hi.x; v.w = hi.y; return __builtin_bit_cast(bf16x8, v);
}
constexpr int SQ_PITCH = 144, SQ_MAT = 64 * SQ_PITCH, SQ_M3 = 0, SQ_M2 = SQ_MAT, SQ_Z5 = 2 * SQ_MAT, SQ_P63 = 3 * SQ_MAT, SQ_Y = SQ_P63 + 256, SQ_STAGE = SQ_Y + 64 * 64 * 4;
DI bf16x8 ldfrag_l(const unsigned char* rowp, int s, int h) {
    const u32x2 lo = *(const u32x2*)(rowp + (16 * s + 4 * h) * 2), hi = *(const u32x2*)(rowp + (16 * s + 8 + 4 * h) * 2);
    u32x4 v; v.x = lo.x; v.y = lo.y; v.z = hi.x; v.w = hi.y; return __builtin_bit_cast(bf16x8, v);
}
DI void sq_load(const Ctx& c, int chain, int ch, int dir, int b, int hd, unsigned char* st, int lt) {
    unsigned char* ws = c.ws; const size_t unit = (size_t)chain * RNC + ch;
    const unsigned char* g3 = ws + WS_RW + RW_M3 + unit * 8192; const unsigned char* g2 = ws + WS_RW + RW_M2 + unit * 8192; const unsigned char* g5 = ws + WS_RW + RW_Z5 + unit * 8192;
#pragma unroll
    for (int i = 0; i < 2; ++i) { const int id = lt + i * 384; if (id < 512) { const int row = id >> 3, part = id & 7;
        *(u32x4*)(st + SQ_M3 + row * SQ_PITCH + part * 16) = *(const u32x4*)(g3 + id * 16);
        *(u32x4*)(st + SQ_M2 + row * SQ_PITCH + part * 16) = *(const u32x4*)(g2 + id * 16);
        *(u32x4*)(st + SQ_Z5 + row * SQ_PITCH + part * 16) = *(const u32x4*)(g5 + id * 16); } }
    if (lt < 16) *(u32x4*)(st + SQ_P63 + lt * 16) = *(const u32x4*)(ws + WS_RW + RW_P63 + unit * 256 + lt * 16);
    const float* YO = (const float*)(ws + WS_BUFB) + (size_t)dir * NZ * 256 + (size_t)b * TZ * 256 + hd * 64;
#pragma unroll
    for (int i = 0; i < 3; ++i) { const int id = lt + i * 384; if (id < 1024) { const int t = id >> 4, part = id & 15;
        *(u32x4*)(st + SQ_Y + t * 256 + part * 16) = *(const u32x4*)(YO + (size_t)rw_tok(dir, ch * RC + t) * 256 + part * 4); } }
}
DI void sq_store_y(const Ctx& c, int ch, int dir, int b, int hd, const unsigned char* st, int lt) {
    float* YO = (float*)(c.ws + WS_BUFB) + (size_t)dir * NZ * 256 + (size_t)b * TZ * 256 + hd * 64;
#pragma unroll
    for (int i = 0; i < 3; ++i) { const int id = lt + i * 384; if (id < 1024) { const int t = id >> 4, part = id & 15;
        *(u32x4*)(YO + (size_t)rw_tok(dir, ch * RC + t) * 256 + part * 4) = *(const u32x4*)(st + SQ_Y + t * 256 + part * 16); } }
}
DI void phase_rwkv_seq_block(const Ctx& c, int l, int chain) {
    unsigned char* L = c.smem; const int lane = c.lane, wave = c.wave, r = lane & 31, h = lane >> 5;
    const int dir = chain & 1, hd = (chain >> 1) & 3, b = chain >> 3, lt = c.tid - 128, vh = wave;
    f32x16 x[2]; zero16(x[0]); zero16(x[1]);
    __syncthreads();
    if (wave >= 2) sq_load(c, chain, 0, dir, b, hd, L, lt);
    __syncthreads();
    for (int ch = 0; ch < RNC; ++ch) {
        unsigned char* st = L + (ch & 1) * SQ_STAGE; unsigned char* so = L + ((ch + 1) & 1) * SQ_STAGE;
        if (wave >= 2) {
            if (ch > 0) sq_store_y(c, ch - 1, dir, b, hd, so, lt);
            if (ch + 1 < RNC) sq_load(c, chain, ch + 1, dir, b, hd, so, lt);
        } else {
            bf16x8 xb[4], xl[4];
#pragma unroll
            for (int s = 0; s < 4; ++s) {
                xb[s] = pack8(x[s >> 1], s & 1);
                float res[8];
#pragma unroll
                for (int j = 0; j < 8; ++j) res[j] = x[s >> 1][8 * (s & 1) + j] - bf2f((bf16_t)xb[s][j]);
                u32x4 p; p.x = pack2(res[0], res[1]); p.y = pack2(res[2], res[3]); p.z = pack2(res[4], res[5]); p.w = pack2(res[6], res[7]); xl[s] = __builtin_bit_cast(bf16x8, p);
            }
            f32x16 xn[2];
#pragma unroll
            for (int i = 0; i < 2; ++i) {
                f32x16 xa;
#pragma unroll
                for (int g4 = 0; g4 < 4; ++g4) {
                    float z5[4]; unpack4(*(const u32x2*)(st + SQ_Z5 + (vh * 32 + r) * SQ_PITCH + (32 * i + 8 * g4 + 4 * h) * 2), z5);
                    const float4 p4 = *(const float4*)(st + SQ_P63 + (32 * i + 8 * g4 + 4 * h) * 4);
                    xa[4 * g4] = fmaf(p4.x, x[i][4 * g4], z5[0]); xa[4 * g4 + 1] = fmaf(p4.y, x[i][4 * g4 + 1], z5[1]);
                    xa[4 * g4 + 2] = fmaf(p4.z, x[i][4 * g4 + 2], z5[2]); xa[4 * g4 + 3] = fmaf(p4.w, x[i][4 * g4 + 3], z5[3]);
                }
#pragma unroll
                for (int s = 0; s < 4; ++s) { const bf16x8 a = ldfrag_l(st + SQ_M3 + (32 * i + r) * SQ_PITCH, s, h);
                    xa = __builtin_amdgcn_mfma_f32_32x32x16_bf16(a, xb[s], xa, 0, 0, 0); xa = __builtin_amdgcn_mfma_f32_32x32x16_bf16(a, xl[s], xa, 0, 0, 0); }
                xn[i] = xa;
            }
#pragma unroll
            for (int i = 0; i < 2; ++i) {
                f32x16 ya; zero16(ya);
#pragma unroll
                for (int s = 0; s < 4; ++s) ya = __builtin_amdgcn_mfma_f32_32x32x16_bf16(ldfrag_l(st + SQ_M2 + (32 * i + r) * SQ_PITCH, s, h), xb[s], ya, 0, 0, 0);
#pragma unroll
                for (int g = 0; g < 16; ++g) { float* yp = (float*)(st + SQ_Y) + (32 * i + crow(g, h)) * 64 + vh * 32 + r; *yp += ya[g]; }
            }
            x[0] = xn[0]; x[1] = xn[1];
        }
        __syncthreads();
    }
    if (wave >= 2) sq_store_y(c, RNC - 1, dir, b, hd, L + ((RNC - 1) & 1) * SQ_STAGE, lt);
}
DI void phase_mixers2(const Ctx& c, int l) {
    const int G = gridDim.x, bid = blockIdx.x;
    if (G >= 128) {
        if (bid < 16) phase_rwkv_seq_block(c, l, bid);
        else for (int u = bid - 16; u < 2 * S5N * 4; u += G - 16) phase_s5_final_unit(c, l, u);
    } else {
        for (int u = bid; u < 16; u += G) phase_rwkv_seq_block(c, l, u);
        for (int u = bid; u < 2 * S5N * 4; u += G) phase_s5_final_unit(c, l, u);
    }
}

DI void phase_post(const Ctx& c, int l) {
    unsigned char* ws = c.ws; const int lane = c.lane;
    const float* YF = (const float*)(ws + WS_BUFB); const float* YB = YF + (size_t)NZ * 256;
    const bf16_t* RB = (const bf16_t*)(ws + WS_EXPW + MX_RB); const bf16_t* VB = (const bf16_t*)(ws + WS_EXPW + MX_VB);
    const bf16_t* SKD = (const bf16_t*)(ws + WS_P + P_PR) + (size_t)4 * NZ * 256; const bf16_t* GG = (const bf16_t*)(ws + WS_MISC + MS_GG);
    bf16_t* Ycat = (bf16_t*)(ws + WS_BUFA);
    const float* r_k = c.in[21] + l * 256; const float* lg = c.in[22] + l * 256; const float* lb = c.in[23] + l * 256;
    for (int z = blockIdx.x * 8 + c.wave; z < NZ; z += gridDim.x * 8) {
        const size_t o = (size_t)z * 256 + lane * 4;
        const float4 yf = *(const float4*)(YF + o), yb = *(const float4*)(YB + o);
        const float y0 = yf.x + yb.x, y1 = yf.y + yb.y, y2 = yf.z + yb.z, y3 = yf.w + yb.w;
        const float mean = sum16(y0 + y1 + y2 + y3) * (1.f / 64.f);
        const float d0 = y0 - mean, d1 = y1 - mean, d2 = y2 - mean, d3 = y3 - mean;
        const float var = sum16(d0 * d0 + d1 * d1 + d2 * d2 + d3 * d3) * (1.f / 64.f);
        const float rs = rsqrtf(var + 64e-5f);
        float r[4], v[4], k0[4], k1[4], gg[4];
        unpack4(*(const u32x2*)(RB + o), r); unpack4(*(const u32x2*)(VB + o), v); unpack4(*(const u32x2*)(SKD + o), k0); unpack4(*(const u32x2*)(SKD + (size_t)NZ * 256 + o), k1);
        unpack4(*(const u32x2*)(GG + o), gg);
        const float4 rk = *(const float4*)(r_k + lane * 4), g4 = *(const float4*)(lg + lane * 4), b4 = *(const float4*)(lb + lane * 4);
        const float bs = sum16(r[0] * (k0[0] + k1[0]) * rk.x + r[1] * (k0[1] + k1[1]) * rk.y + r[2] * (k0[2] + k1[2]) * rk.z + r[3] * (k0[3] + k1[3]) * rk.w);
        *(u32x2*)(Ycat + (size_t)z * D + 256 + lane * 4) = pack4((d0 * rs * g4.x + b4.x + bs * v[0]) * gg[0], (d1 * rs * g4.y + b4.y + bs * v[1]) * gg[1],
                                                                (d2 * rs * g4.z + b4.z + bs * v[2]) * gg[2], (d3 * rs * g4.w + b4.w + bs * v[3]) * gg[3]);
    }
    {
        const bf16_t* ZG = (const bf16_t*)(ws + WS_MISC + MS_ZG); const bf16_t* W = (const bf16_t*)(ws + WS_WSM + OFF_GLUT + l * SZ_GLUT);
        const float* gb = c.in[33] + l * 256;
        for (int u = blockIdx.x; u < (NZ / 256) * 2; u += gridDim.x) {
            const int mt = u / 2, nt = u % 2, r0 = mt * 256, c0 = nt * 128;
            gemm_tile<4, 0>(c, 256, [&](int i) { return ZG + (size_t)(r0 + i) * 256; }, [&](int i) { return W + (size_t)(c0 + i) * 256; }, NoHook(),
                [&](f32x4 (&acc)[4][4], int wr, int wc, int fr, int fq) {
#pragma unroll
                    for (int n = 0; n < 4; ++n) {
                        const int col = c0 + wc + n * 16 + fq * 4; const float4 bb = *(const float4*)(gb + col);
#pragma unroll
                        for (int m = 0; m < 4; ++m) {
                            const int row = r0 + wr + m * 16 + fr; const f32x4 v = acc[m][n];
                            float zg[4]; unpack4(*(const u32x2*)(ZG + (size_t)row * 256 + col), zg);
                            *(u32x2*)(Ycat + (size_t)row * D + 512 + col) = pack4(zg[0] * sigmoidf_(v[0] + bb.x), zg[1] * sigmoidf_(v[1] + bb.y), zg[2] * sigmoidf_(v[2] + bb.z), zg[3] * sigmoidf_(v[3] + bb.w));
                        }
                    }
                });
        }
    }
}

DI bool skip_mt(int l, int mt) { return l == NL - 1 && (mt % 33) == 0; }
DI void phase_merge1(const Ctx& c, int l) {
    const bf16_t* Ycat = (const bf16_t*)(c.ws + WS_BUFA); const bf16_t* W = (const bf16_t*)(c.ws + WS_WSM + OFF_WBT + l * SZ_WBT);
    const bf16_t* GT = (const bf16_t*)(c.ws + WS_GT); bf16_t* MG = (bf16_t*)(c.ws + WS_BUFB);
    if (blockIdx.x == 0 && c.tid < 32) ((unsigned*)(c.ws + WS_CTL))[CW_CNT + l * 32 + c.tid] = 0u;
    for (int u = blockIdx.x; u < (NZ / 256) * 8; u += gridDim.x) {
        const int mt = u / 8, nt = u % 8, r0 = mt * 256, c0 = nt * 128;
        if (skip_mt(l, mt)) continue;
        f32x4 macc[4][4];
#pragma unroll
        for (int m = 0; m < 4; ++m)
#pragma unroll
            for (int n = 0; n < 4; ++n) macc[m][n] = (f32x4){0.f, 0.f, 0.f, 0.f};
        gemm_tile<4, 256>(c, 1024, [&](int i) { return Ycat + (size_t)(r0 + i) * D; }, [&](int i) { return W + (size_t)(c0 + i) * D; },
            [&](f32x4 (&acc)[4][4], int seg, int wr, int wc, int fr, int fq) {
#pragma unroll
                for (int m = 0; m < 4; ++m)
#pragma unroll
                    for (int n = 0; n < 4; ++n) {
                        float g[4]; unpack4(*(const u32x2*)(GT + (size_t)(r0 + wr + m * 16 + fr) * 4096 + seg * 1024 + c0 + wc + n * 16 + fq * 4), g);
                        macc[m][n][0] += g[0] * acc[m][n][0]; macc[m][n][1] += g[1] * acc[m][n][1]; macc[m][n][2] += g[2] * acc[m][n][2]; macc[m][n][3] += g[3] * acc[m][n][3];
                        acc[m][n] = (f32x4){0.f, 0.f, 0.f, 0.f};
                    }
            },
            [&](f32x4 (&)[4][4], int wr, int wc, int fr, int fq) {
#pragma unroll
                for (int m = 0; m < 4; ++m)
#pragma unroll
                    for (int n = 0; n < 4; ++n)
                        *(u32x2*)(MG + (size_t)(r0 + wr + m * 16 + fr) * D + c0 + wc + n * 16 + fq * 4) = pack4(macc[m][n][0], macc[m][n][1], macc[m][n][2], macc[m][n][3]);
            });
    }
}
DI void phase_merge2(const Ctx& c, int l) {
    const bf16_t* MG = (const bf16_t*)(c.ws + WS_BUFB); const bf16_t* W = (const bf16_t*)(c.ws + WS_WSM + OFF_WOUTT + l * SZ_WOUTT);
    float* H = (float*)(c.ws + WS_H); const float* modv = (const float*)(c.ws + WS_WSM + OFF_MODV);
    for (int u = blockIdx.x; u < (NZ / 256) * 8; u += gridDim.x) {
        const int mt = u / 8, nt = u % 8, r0 = mt * 256, c0 = nt * 128;
        if (skip_mt(l, mt)) continue;
        const int sel = (mt % 33) == 0 ? 2 : mt / 33;
        gemm_tile<4, 0>(c, 1024, [&](int i) { return MG + (size_t)(r0 + i) * D; }, [&](int i) { return W + (size_t)(c0 + i) * D; }, NoHook(),
            [&](f32x4 (&acc)[4][4], int wr, int wc, int fr, int fq) {
#pragma unroll
                for (int n = 0; n < 4; ++n) {
                    const int col = c0 + wc + n * 16 + fq * 4; const float4 m2 = *(const float4*)(modv + ((size_t)l * 3 + sel) * 6144 + 2 * 1024 + col);
#pragma unroll
                    for (int m = 0; m < 4; ++m) {
                        float4* hp = (float4*)(H + (size_t)(r0 + wr + m * 16 + fr) * D + col); float4 hv = *hp; const f32x4 v = acc[m][n];
                        hv.x += m2.x * v[0]; hv.y += m2.y * v[1]; hv.z += m2.z * v[2]; hv.w += m2.w * v[3]; *hp = hv;
                    }
                }
            });
    }
}

DI void phase_norm2_route(const Ctx& c, int l) {
    unsigned char* ws = c.ws; const int lane = c.lane;
    const float* modv = (const float*)(ws + WS_WSM + OFF_MODV); const float* H = (const float*)(ws + WS_H);
    bf16_t* XN = (bf16_t*)(ws + WS_BUFA); const float* g2 = c.in[7] + l * 1024;
    const float* rwt = (const float*)(ws + WS_WSM + OFF_RWT) + (size_t)l * 36 * 1024;
    const float* bg = c.in[42] + l * 4; const float* be = c.in[44] + l * 32;
    unsigned* cnt = (unsigned*)(ws + WS_CTL) + CW_CNT + l * 32;
    int* list = (int*)(ws + WS_GT + GT_LIST); float* lw = (float*)(ws + WS_GT + GT_LW);
    for (int row = blockIdx.x * 8 + c.wave; row < NZ; row += gridDim.x * 8) {
        const int b = row / TZ, s = row % TZ, sel = s < CTX ? 2 : b;
        if (l == NL - 1 && s < CTX) continue;
        float x[16]; float ss = 0.f;
#pragma unroll
        for (int q = 0; q < 4; ++q) { const float4 v = *(const float4*)(H + (size_t)row * D + q * 256 + lane * 4); x[q * 4] = v.x; x[q * 4 + 1] = v.y; x[q * 4 + 2] = v.z; x[q * 4 + 3] = v.w;
            ss += v.x * v.x + v.y * v.y + v.z * v.z + v.w * v.w; }
        ss = wave_sum(ss);
        const float rs = rsqrtf(ss * (1.f / 1024.f) + 1e-6f);
#pragma unroll
        for (int q = 0; q < 4; ++q) {
            const int col = q * 256 + lane * 4;
            const float4 g = *(const float4*)(g2 + col), m3 = *(const float4*)(modv + ((size_t)l * 3 + sel) * 6144 + 3 * 1024 + col), m4 = *(const float4*)(modv + ((size_t)l * 3 + sel) * 6144 + 4 * 1024 + col);
            x[q * 4] = x[q * 4] * rs * g.x * (1.f + m4.x) + m3.x; x[q * 4 + 1] = x[q * 4 + 1] * rs * g.y * (1.f + m4.y) + m3.y;
            x[q * 4 + 2] = x[q * 4 + 2] * rs * g.z * (1.f + m4.z) + m3.z; x[q * 4 + 3] = x[q * 4 + 3] * rs * g.w * (1.f + m4.w) + m3.w;
            *(u32x2*)(XN + (size_t)row * D + col) = pack4(x[q * 4], x[q * 4 + 1], x[q * 4 + 2], x[q * 4 + 3]);
        }
        volatile float* wl = (volatile float*)(c.smem) + c.wave * 64;
#pragma unroll 1
        for (int e = 0; e < 36; ++e) {
            float a = 0.f;
#pragma unroll
            for (int q = 0; q < 4; ++q) { const float4 w = *(const float4*)(rwt + (size_t)e * 1024 + q * 256 + lane * 4); a += x[q * 4] * w.x + x[q * 4 + 1] * w.y + x[q * 4 + 2] * w.z + x[q * 4 + 3] * w.w; }
            a = wave_sum(a) + (e < 4 ? bg[e] : be[e - 4]);
            if (lane == 0) wl[e] = a;
        }
        __builtin_amdgcn_wave_barrier();
        float lg[36];
#pragma unroll
        for (int e = 0; e < 36; ++e) lg[e] = wl[e];
        __builtin_amdgcn_wave_barrier();
        float gl[4]; float gm = -1e30f;
#pragma unroll
        for (int g = 0; g < 4; ++g) { gl[g] = lg[g]; gm = fmaxf(gm, gl[g]); }
        float gs = 0.f; int gsel = 0; float gbest = -1e30f;
#pragma unroll
        for (int g = 0; g < 4; ++g) { gs += __expf(gl[g] - gm); if (gl[g] > gbest) { gbest = gl[g]; gsel = g; } }
        const float pg = __expf(gbest - gm) / gs;
        float l1 = -1e30f, l2 = -1e30f; int e1 = 0, e2 = 0;
#pragma unroll
        for (int e = 0; e < 32; ++e) {
            const float v = lg[4 + e];
            if ((e >> 3) == gsel) {
                if (v > l1) { l2 = l1; e2 = e1; l1 = v; e1 = e; }
                else if (v > l2) { l2 = v; e2 = e; }
            }
        }
        const float t = __expf(l2 - l1), w1 = pg / (1.f + t), w2 = pg * t / (1.f + t);
        if (lane == 0) {
            const unsigned p1 = atomicAdd(&cnt[e1], 1u); list[(size_t)e1 * MOE_CAP + p1] = row * 2; lw[(size_t)e1 * MOE_CAP + p1] = w1;
            const unsigned p2 = atomicAdd(&cnt[e2], 1u); list[(size_t)e2 * MOE_CAP + p2] = row * 2 + 1; lw[(size_t)e2 * MOE_CAP + p2] = w2;
        }
    }
    phase_expert_convert(c, l);
}

DI void moe_prefix(const Ctx& c, int l, int* tiles  , int* cnts  ) {
    __syncthreads();
    if (c.tid == 0) {
        const unsigned* cnt = (const unsigned*)(c.ws + WS_CTL) + CW_CNT + l * 32; int acc = 0;
        for (int e = 0; e < 32; ++e) { const int n = (int)__hip_atomic_load(cnt + e, __ATOMIC_RELAXED, __HIP_MEMORY_SCOPE_AGENT); cnts[e] = n; tiles[e] = acc; acc += (n + 127) / 128; }
        tiles[32] = acc;
    }
    __syncthreads();
}
DI void phase_moe1(const Ctx& c, int l) {
    unsigned char* ws = c.ws;
    int* tiles = (int*)(c.smem + 120 * 1024); int* cnts = tiles + 40;
    moe_prefix(c, l, tiles, cnts);
    const bf16_t* XN = (const bf16_t*)(ws + WS_BUFA); bf16_t* HM = (bf16_t*)(ws + WS_GT + GT_HM); const int* list = (const int*)(ws + WS_GT + GT_LIST);
    const int nt_total = tiles[32];
    for (int u = blockIdx.x; u < nt_total * 4; u += gridDim.x) {
        const int mtg = u >> 2, nt = u & 3;
        int e = 0;
        for (int k = 1; k < 32; ++k) if (tiles[k] <= mtg) e = k;
        const int mt = mtg - tiles[e], n_e = cnts[e];
        const int* le = list + (size_t)e * MOE_CAP;
        const bf16_t* W = (const bf16_t*)(ws + WS_EXPW + (size_t)e * SZ_WGU);
        gemm_tile<2, 0>(c, 1024,
            [&](int i) { int p = mt * 128 + i; if (p >= n_e) p = n_e - 1; return XN + (size_t)(le[p] >> 1) * D; },
            [&](int i) { return W + (size_t)(nt * 256 + i) * D; }, NoHook(),
            [&](f32x4 (&acc)[4][4], int wr, int wc, int fr, int fq) {
#pragma unroll
                for (int np = 0; np < 2; ++np) {
                    const int hc = (nt * 256 + wc + np * 32) / 2 + fq * 4;
#pragma unroll
                    for (int m = 0; m < 4; ++m) {
                        const int p = mt * 128 + wr + m * 16 + fr;
                        const f32x4 g = acc[m][np * 2], uu = acc[m][np * 2 + 1];
                        *(u32x2*)(HM + ((size_t)mtg * 128 + wr + m * 16 + fr) * 512 + hc) = pack4(siluf_(g[0]) * uu[0], siluf_(g[1]) * uu[1], siluf_(g[2]) * uu[2], siluf_(g[3]) * uu[3]);
                        (void)p;
                    }
                }
            });
    }
}
DI void phase_moe2(const Ctx& c, int l) {
    unsigned char* ws = c.ws;
    int* tiles = (int*)(c.smem + 120 * 1024); int* cnts = tiles + 40;
    moe_prefix(c, l, tiles, cnts);
    const bf16_t* HM = (const bf16_t*)(ws + WS_GT + GT_HM); const int* list = (const int*)(ws + WS_GT + GT_LIST); const float* lw = (const float*)(ws + WS_GT + GT_LW);
    bf16_t* Y2 = (bf16_t*)(ws + WS_P);
    const int nt_total = tiles[32];
    for (int u = blockIdx.x; u < nt_total * 4; u += gridDim.x) {
        const int mtg = u >> 2, nt = u & 3;
        int e = 0;
        for (int k = 1; k < 32; ++k) if (tiles[k] <= mtg) e = k;
        const int mt = mtg - tiles[e], n_e = cnts[e];
        const int* le = list + (size_t)e * MOE_CAP; const float* lwe = lw + (size_t)e * MOE_CAP;
        const bf16_t* W = (const bf16_t*)(ws + WS_EXPW + 32 * SZ_WGU + (size_t)e * SZ_WD);
        gemm_tile<2, 0>(c, 512,
            [&](int i) { return HM + ((size_t)mtg * 128 + i) * 512; },
            [&](int i) { return W + (size_t)(nt * 256 + i) * 512; }, NoHook(),
            [&](f32x4 (&acc)[4][4], int wr, int wc, int fr, int fq) {
#pragma unroll
                for (int m = 0; m < 4; ++m) {
                    const int p = mt * 128 + wr + m * 16 + fr;
                    if (p < n_e) {
                        const int ent = le[p]; const float wt = lwe[p];
                        bf16_t* yrow = Y2 + ((size_t)(ent & 1) * NZ + (ent >> 1)) * D + nt * 256 + wc + fq * 4;
#pragma unroll
                        for (int n = 0; n < 4; ++n) *(u32x2*)(yrow + n * 16) = pack4(wt * acc[m][n][0], wt * acc[m][n][1], wt * acc[m][n][2], wt * acc[m][n][3]);
                    }
                }
            });
    }
}

constexpr int LDS_BYTES = 128 * 1024;
constexpr int STEPS_PER_LAYER = 12, N_STEPS = 2 + NL * STEPS_PER_LAYER;
#ifndef FUSED
#define FUSED 1
#endif

DI const void* launder_ptr(const void* p) {
    const unsigned long long v = (unsigned long long)p;
    unsigned lo = __builtin_amdgcn_readfirstlane((unsigned)v), hi = __builtin_amdgcn_readfirstlane((unsigned)(v >> 32));
    asm volatile("" : "+s"(lo), "+s"(hi) :: "memory");
    return (const void*)(((unsigned long long)hi << 32) | lo);
}
template <int KIND> DI void run_step(const Ctx& c0, int l) {
#ifdef PHM
    if (!((PHM >> KIND) & 1)) return;
#endif
    Ctx c = c0;
    { int z = 0; asm volatile("" : "+s"(z) :: "memory"); c.in = c0.in + z; c.ws = c0.ws + z; c.out = c0.out + z; }
    { int t = c0.tid; asm volatile("" : "+v"(t)); c.tid = t; c.lane = t & 63; c.wave = __builtin_amdgcn_readfirstlane(t >> 6); }
    if (KIND == 0) phase_prologue(c);
    if (KIND == 1) phase_norm1(c, l);
    if (KIND == 2) phase_inproj(c, l);
    if (KIND == 3) { phase_prep(c, l); phase_s5_local(c, l); }
    if (KIND == 4) { phase_small_gemms(c, l); phase_s5_carry(c, l); }
    if (KIND == 5) { phase_attention(c, l); phase_rwkv_chunks(c, l); }
    if (KIND == 6) phase_mixers2(c, l);
    if (KIND == 7) phase_post(c, l);
    if (KIND == 8) phase_merge1(c, l);
    if (KIND == 9) phase_merge2(c, l);
    if (KIND == 10) phase_norm2_route(c, l);
    if (KIND == 11) phase_moe1(c, l);
    if (KIND == 12) phase_moe2(c, l);
    if (KIND == 13) phase_final(c);
}

#if !FUSED
template <int KIND> __global__ void __launch_bounds__(NTHR, 2) k_step(Args a) {
    extern __shared__ __attribute__((aligned(16))) unsigned char lds[];
    Ctx c; c.in = a.in; c.out = a.out; c.ws = a.ws; c.smem = lds; c.tid = threadIdx.x; c.lane = threadIdx.x & 63; c.wave = __builtin_amdgcn_readfirstlane(threadIdx.x >> 6);
    run_step<KIND>(c, a.s_lo);
}
template <int KIND> static void launch_step(const Args& a, int grid, hipStream_t stream) {
    static bool attr = false;
    if (!attr) { (void)hipFuncSetAttribute((const void*)k_step<KIND>, hipFuncAttributeMaxDynamicSharedMemorySize, LDS_BYTES); attr = true; }
    hipLaunchKernelGGL(k_step<KIND>, dim3(grid), dim3(NTHR), LDS_BYTES, stream, a);
}
#else
__global__ void __launch_bounds__(NTHR, 2) fwd_kernel(Args a) {
    extern __shared__ __attribute__((aligned(16))) unsigned char lds[];
    Ctx c; c.in = a.in; c.out = a.out; c.ws = a.ws; c.smem = lds; c.tid = threadIdx.x; c.lane = threadIdx.x & 63; c.wave = __builtin_amdgcn_readfirstlane(threadIdx.x >> 6);
    volatile LAS unsigned* xbw = (volatile LAS unsigned*)(lds + LDS_BYTES - 16);
    if (threadIdx.x == 0) { xbw[0] = 0u; xbw[1] = 0u; }
    __syncthreads();
    XcdBarrier bar = xcd_barrier_post((unsigned*)(a.ws + WS_CTL) + CW_BAR, xbw);
#ifndef REP_MASK
#define REP_MASK 0
#endif
#define STEP(K, L) do { run_step<K>(c, L); xcd_barrier(bar); if ((REP_MASK >> K) & 1) { run_step<K>(c, L); xcd_barrier(bar); } } while (0)
    STEP(0, 0);
    for (int l = 0; l < NL; ++l) {
        STEP(1, l); STEP(2, l); STEP(3, l); STEP(4, l); STEP(5, l); STEP(6, l); STEP(7, l); STEP(8, l); STEP(9, l); STEP(10, l); STEP(11, l); STEP(12, l);
    }
#undef STEP
    run_step<13>(c, 0);
}
#endif

extern "C" void kernel_launch(void* const* d_in, const int* in_sizes, int n_in, void* d_out, int out_size, void* d_ws, size_t ws_size, hipStream_t stream) {
    static int grid = 0;
    if (grid == 0) {
        if (n_in != 49 || out_size != NB * SEQ * D || ws_size < WS_END) { fprintf(stderr, "kernel_launch: unexpected problem (n_in %d out %d ws %zu need %zu)\n", n_in, out_size, ws_size, (size_t)WS_END); grid = -1; return; }
        int dev = 0, cus = 0;
        if (hipGetDevice(&dev) != hipSuccess || hipDeviceGetAttribute(&cus, hipDeviceAttributeMultiprocessorCount, dev) != hipSuccess) { grid = -1; return; }
#if FUSED
        int per_cu = 0;
        if (hipFuncSetAttribute((const void*)fwd_kernel, hipFuncAttributeMaxDynamicSharedMemorySize, LDS_BYTES) != hipSuccess) { fprintf(stderr, "kernel_launch: hipFuncSetAttribute failed\n"); grid = -1; return; }
        if (hipOccupancyMaxActiveBlocksPerMultiprocessor(&per_cu, (const void*)fwd_kernel, NTHR, LDS_BYTES) != hipSuccess || per_cu < 1) { fprintf(stderr, "kernel_launch: occupancy query says %d\n", per_cu); }
        (void)hipGetLastError();
#endif
        grid = cus;
    }
    if (grid < 0) return;
    (void)hipMemsetAsync((char*)d_ws + WS_CTL, 0, CTL_BYTES, stream);
    Args a{};
    for (int i = 0; i < 49; ++i) a.in[i] = (const float*)d_in[i];
    a.out = (float*)d_out; a.ws = (unsigned char*)d_ws;
#if !FUSED
    a.s_lo = 0; a.s_hi = 0; launch_step<0>(a, grid, stream);
    for (int l = 0; l < NL; ++l) {
        a.s_lo = l;
        launch_step<1>(a, grid, stream); launch_step<2>(a, grid, stream); launch_step<3>(a, grid, stream); launch_step<4>(a, grid, stream);
        launch_step<5>(a, grid, stream); launch_step<6>(a, grid, stream); launch_step<7>(a, grid, stream); launch_step<8>(a, grid, stream);
        launch_step<9>(a, grid, stream); launch_step<10>(a, grid, stream); launch_step<11>(a, grid, stream); launch_step<12>(a, grid, stream);
    }
    a.s_lo = 0; launch_step<13>(a, grid, stream);
#else
    a.s_lo = 0; a.s_hi = N_STEPS; hipLaunchKernelGGL(fwd_kernel, dim3(grid), dim3(NTHR), LDS_BYTES, stream, a);
#endif
}
```

```cpp
#include <hip/hip_runtime.h>
#include <stdint.h>
#include <stdio.h>

#define DI __device__ __forceinline__
#define LAS __attribute__((address_space(3)))
typedef unsigned short bf16_t;
typedef short bf16x8 __attribute__((ext_vector_type(8)));
typedef short s16x4 __attribute__((ext_vector_type(4)));
typedef float f32x4 __attribute__((ext_vector_type(4)));
typedef float f32x16 __attribute__((ext_vector_type(16)));
typedef float f32x2 __attribute__((ext_vector_type(2)));
typedef __bf16 bf16x2v __attribute__((ext_vector_type(2)));
typedef unsigned u32x4 __attribute__((ext_vector_type(4)));
typedef unsigned u32x2 __attribute__((ext_vector_type(2)));

constexpr int D = 1024, NB = 2, SEQ = 8192, CTX = 256, TZ = 8448, NZ = 16896, NL = 2;
constexpr int NIN = 6560, NINP = 6656;
constexpr int NTHR = 512;
constexpr float LOG2E = 1.4426950408889634f;

#define XB_TMO      128
#define XB_XCNT(j)  (256  + 64 * (j))
#define XB_XSUB(j)  (1280 + 64 * (j))
#define XB_XGEN(j)  (2304 + 64 * (j))
#define XB_TOP      3328
#define XB_TOPGEN   3392
#define XCD_BAR_WORDS 3456
#define XB_SPIN_CAP (1u << 18)

__device__ __forceinline__ unsigned xb_ld(unsigned* p)              { return __hip_atomic_load(p, __ATOMIC_RELAXED, __HIP_MEMORY_SCOPE_AGENT); }
__device__ __forceinline__ unsigned xb_add(unsigned* p, unsigned v) { return __hip_atomic_fetch_add(p, v, __ATOMIC_RELAXED, __HIP_MEMORY_SCOPE_AGENT); }
__device__ __forceinline__ unsigned xb_xcc_id() { return (unsigned)__builtin_amdgcn_s_getreg((3 << 11) | 20) & 0xFu; }
#define XB_SPIN(cond, bar) do { unsigned _sp = 0; while (cond) { __builtin_amdgcn_s_sleep(1); \
    if ((++_sp & 255u) == 0u) { if (xb_ld(&(bar)[XB_TMO])) break; if (_sp > XB_SPIN_CAP) { atomicAdd(&(bar)[XB_TMO], 1u); break; } } } } while (0)

struct XcdBarrier { unsigned* bar; unsigned x; volatile LAS unsigned* st; };

__device__ __forceinline__ XcdBarrier xcd_barrier_post(unsigned* bar, volatile LAS unsigned* st) {
    XcdBarrier b; b.bar = bar; b.x = xb_xcc_id(); b.st = st;
    if (threadIdx.x == 0) (void)xb_add(&bar[XB_XCNT(b.x)], 1u);
    return b;
}
__device__ __forceinline__ void xcd_barrier_complete(unsigned* bar, unsigned x, unsigned& nloc, unsigned& nx) {
    const unsigned G = gridDim.x * gridDim.y * gridDim.z;
    unsigned sum, cnt, mine, sp = 0u;
    for (;;) {
        sum = 0u; cnt = 0u; mine = 0u;
#pragma unroll
        for (unsigned j = 0; j < 16; ++j) { const unsigned c = xb_ld(&bar[XB_XCNT(j)]); sum += c; cnt += (c > 0u) ? 1u : 0u; mine = (j == x) ? c : mine; }
        if (sum == G) break;
        __builtin_amdgcn_s_sleep(1);
        if ((++sp & 255u) == 0u) { if (xb_ld(&bar[XB_TMO])) break; if (sp > XB_SPIN_CAP) { atomicAdd(&bar[XB_TMO], 1u); break; } }
    }
    nloc = mine > 0u ? mine : 1u; nx = cnt > 0u ? cnt : 1u;
}
__device__ __forceinline__ void xcd_barrier(const XcdBarrier& b) {
    asm volatile("s_waitcnt vmcnt(0)" ::: "memory");
    __syncthreads();
    if (threadIdx.x == 0) {
        unsigned* bar = b.bar;
        __builtin_amdgcn_s_waitcnt(0);
        unsigned nloc = b.st[0], nx = b.st[1];
        if (nloc == 0u) { xcd_barrier_complete(bar, b.x, nloc, nx); b.st[0] = nloc; b.st[1] = nx; }
        const unsigned old = xb_add(&bar[XB_XSUB(b.x)], 1u);
        const unsigned gen = old / nloc;
        if (old + 1u == (gen + 1u) * nloc) {
            __builtin_amdgcn_fence(__ATOMIC_RELEASE, "agent");
            asm volatile("s_waitcnt vmcnt(0)" ::: "memory");
            const unsigned og = xb_add(&bar[XB_TOP], 1u);
            const unsigned tg = og / nx;
            if (og + 1u == (tg + 1u) * nx) xb_add(&bar[XB_TOPGEN], 1u);
            else XB_SPIN(xb_ld(&bar[XB_TOPGEN]) == tg, bar);
            __builtin_amdgcn_fence(__ATOMIC_ACQUIRE, "agent");
            xb_add(&bar[XB_XGEN(b.x)], 1u);
            asm volatile("s_waitcnt vmcnt(0)" ::: "memory");
        } else {
            XB_SPIN(xb_ld(&bar[XB_XGEN(b.x)]) == gen, bar);
            __builtin_amdgcn_fence(__ATOMIC_ACQUIRE, "agent");
            asm volatile("s_waitcnt vmcnt(0)" ::: "memory");
        }
    }
    __syncthreads();
}

DI float bf2f(bf16_t v) { return __uint_as_float((unsigned)v << 16); }
DI unsigned pack2(float a, float b) { f32x2 v = {a, b}; bf16x2v r = __builtin_convertvector(v, bf16x2v); return __builtin_bit_cast(unsigned, r); }
DI bf16_t f2bf(float a) { return (bf16_t)(pack2(a, 0.f) & 0xffffu); }
DI float lo2f(unsigned u) { return __uint_as_float(u << 16); }
DI float hi2f(unsigned u) { return __uint_as_float(u & 0xffff0000u); }
DI float wave_sum(float v) {
#pragma unroll
    for (int m = 32; m >= 1; m >>= 1) v += __shfl_xor(v, m, 64);
    return v;
}
DI float sum16(float v) {
#pragma unroll
    for (int m = 8; m >= 1; m >>= 1) v += __shfl_xor(v, m, 64);
    return v;
}
DI float sigmoidf_(float x) { return 1.f / (1.f + __expf(-x)); }
DI float siluf_(float x) { return x / (1.f + __expf(-x)); }
DI float gelu_tanh(float x) { const float u = 0.7978845608028654f * (x + 0.044715f * x * x * x); return 0.5f * x * (1.f + tanhf(u)); }
DI void unpack4(u32x2 u, float (&f)[4]) { f[0] = lo2f(u.x); f[1] = hi2f(u.x); f[2] = lo2f(u.y); f[3] = hi2f(u.y); }
DI u32x2 pack4(float a, float b, float c, float d) { u32x2 r; r.x = pack2(a, b); r.y = pack2(c, d); return r; }

constexpr size_t algn(size_t x) { return (x + 255) & ~(size_t)255; }
constexpr size_t WS_CTL   = 0;
constexpr size_t CTL_BYTES = 64 * 1024;
constexpr size_t WS_H     = WS_CTL + CTL_BYTES;
constexpr size_t WS_WSM   = WS_H + (size_t)NZ * D * 4;
constexpr size_t SZ_WINT = (size_t)NINP * D * 2, SZ_WUQT = 384 * 256 * 2, SZ_WUKVT = 512 * 128 * 2, SZ_W2T = 512 * 64 * 2, SZ_A2T = 512 * 64 * 2,
                 SZ_G2T = 256 * 128 * 2, SZ_GLUT = 256 * 256 * 2, SZ_WBT = (size_t)D * D * 2, SZ_WOUTT = (size_t)D * D * 2;
constexpr size_t OFF_WINT = 0, OFF_WUQT = OFF_WINT + NL * SZ_WINT, OFF_WUKVT = OFF_WUQT + NL * SZ_WUQT, OFF_W2T = OFF_WUKVT + NL * SZ_WUKVT,
                 OFF_A2T = OFF_W2T + NL * SZ_W2T, OFF_G2T = OFF_A2T + NL * SZ_A2T, OFF_GLUT = OFF_G2T + NL * SZ_G2T, OFF_WBT = OFF_GLUT + NL * SZ_GLUT,
                 OFF_WOUTT = OFF_WBT + NL * SZ_WBT, OFF_MODV = OFF_WOUTT + NL * SZ_WOUTT,
                 OFF_ROPE = OFF_MODV + (size_t)NL * 3 * 6144 * 4,
                 OFF_S5T = OFF_ROPE + (size_t)SEQ * 16 * 2 * 4,
                 OFF_RWT = OFF_S5T + (size_t)NL * 2 * 16 * 64 * 36 * 4,
                 OFF_LAM = OFF_RWT + (size_t)NL * 36 * 1024 * 4,
                 OFF_S5E = OFF_LAM + 256,
                 OFF_S5C = OFF_S5E,
                 WSM_BYTES = algn(OFF_S5E + (size_t)2 * 2 * 16 * 132 * 64 * 2 * 4);
constexpr size_t WS_EXPW  = WS_WSM + WSM_BYTES;
constexpr size_t SZ_WGU = (size_t)1024 * 1024 * 2, SZ_WD = (size_t)1024 * 512 * 2;
constexpr size_t EXPW_BYTES = 32 * (SZ_WGU + SZ_WD);
constexpr size_t SZ_QM = (size_t)NB * 4 * TZ * 96 * 2, SZ_VMT = (size_t)NB * 4 * 64 * TZ * 2, SZ_QD = (size_t)NB * 4 * TZ * 64 * 2, SZ_R256 = (size_t)NZ * 256 * 2;
constexpr size_t MX_QM = 0, MX_KM = MX_QM + SZ_QM, MX_VMT = MX_KM + SZ_QM, MX_QD = MX_VMT + SZ_VMT, MX_KD = MX_QD + SZ_QD, MX_VDT = MX_KD + SZ_QD,
                 MX_RB = MX_VDT + SZ_VMT, MX_KB = MX_RB + SZ_R256, MX_VB = MX_KB + SZ_R256, MX_KKB = MX_VB + SZ_R256, MX_END = MX_KKB + SZ_R256;
static_assert(MX_END <= EXPW_BYTES, "mixer operands must fit the expert-weight region");
constexpr size_t WS_BUFA  = WS_EXPW + EXPW_BYTES;
constexpr size_t WS_BUFB  = WS_BUFA + (size_t)NZ * D * 2;
constexpr size_t WS_P     = WS_BUFB + (size_t)NZ * D * 2;
constexpr size_t P_PM = 0, P_PS = P_PM + (size_t)NZ * 416 * 2, P_PR = P_PS + (size_t)NZ * 256 * 2, P_PD = P_PR + (size_t)NZ * 1024 * 2, P_BYTES = P_PD + (size_t)NZ * 768 * 2;
static_assert((size_t)6 * SZ_R256 <= (size_t)NZ * (1024 + 768) * 2, "scan operands must fit PR|PD");
static_assert((size_t)2 * NZ * D * 2 <= P_BYTES, "the MoE outputs (2 x bf16 [NZ][D]) must fit the P region");
constexpr size_t WS_GT    = WS_P + P_BYTES;
constexpr size_t GT_BYTES = (size_t)NZ * 4096 * 2;
constexpr int MOE_CAP = 33792;
constexpr size_t GT_HM = 0, GT_LIST = GT_HM + (size_t)(33792 + 32 * 128) * 512 * 2, GT_LW = GT_LIST + (size_t)32 * MOE_CAP * 4, GT_END = GT_LW + (size_t)32 * MOE_CAP * 4;
static_assert(GT_END <= GT_BYTES, "MoE scratch must fit the gate region");
constexpr size_t WS_MISC  = WS_GT + GT_BYTES;
constexpr size_t MS_CQN = 0, MS_TW = MS_CQN + (size_t)NZ * 384 * 2, MS_AL = MS_TW + (size_t)NZ * 64 * 2, MS_SG = MS_AL + (size_t)NZ * 64 * 2,
                 MS_GG = MS_SG + (size_t)NZ * 128 * 2, MS_ZG = MS_GG + SZ_R256, MS_END = MS_ZG + SZ_R256;
constexpr size_t WS_RW    = WS_MISC + MS_END;
constexpr int RC = 64, RNC = TZ / RC;
constexpr size_t SZ_RWM = (size_t)16 * RNC * 4096 * 2;
constexpr size_t RW_M3 = 0, RW_M2 = SZ_RWM, RW_Z5 = 2 * SZ_RWM, RW_P63 = 3 * SZ_RWM, RW_END = RW_P63 + (size_t)16 * RNC * 64 * 4;
constexpr size_t WS_END   = WS_RW + RW_END;

constexpr int CW_BAR = 0;
constexpr int CW_CNT = 4096;

struct Args { const float* in[49]; float* out; unsigned char* ws; int s_lo, s_hi; };

struct Ctx {
    const float* const* in; float* out; unsigned char* ws; unsigned char* smem; int tid, lane, wave;
};

template <int WM> struct GCfg { static constexpr int WN = 8 / WM, BM = 64 * WM, BN = 64 * WN, ABYTES = BM * 64, BBYTES = BN * 64, STAGE = ABYTES + BBYTES; };

template <int WM, int SEGK, class ARow, class BRow, class Hook, class Epi>
DI void gemm_tile(const Ctx& c, int K, ARow arow, BRow brow, Hook hook, Epi epi) {
    typedef GCfg<WM> G;
    const int tid = c.tid, lane = c.lane, wave = c.wave;
    const int wm = wave / G::WN, wn = wave % G::WN, fr = lane & 15, fq = lane >> 4;
    unsigned char* smem = c.smem;
    constexpr int NA = G::BM / 128, NBq = G::BN / 128;
    const bf16_t* asrc[NA]; const bf16_t* bsrc[NBq];
#pragma unroll
    for (int i = 0; i < NA; ++i) { const int ch = tid + i * NTHR; asrc[i] = arow(ch >> 2) + (ch & 3) * 8; }
#pragma unroll
    for (int i = 0; i < NBq; ++i) { const int ch = tid + i * NTHR; bsrc[i] = brow(ch >> 2) + (ch & 3) * 8; }
    auto stage = [&](int kt, int buf) {
        unsigned char* sa = smem + buf * G::STAGE; unsigned char* sb = sa + G::ABYTES;
#pragma unroll
        for (int i = 0; i < NA; ++i) __builtin_amdgcn_global_load_lds((const unsigned*)(asrc[i] + kt * 32), (unsigned*)(sa + (tid + i * NTHR) * 16), 16, 0, 0);
#pragma unroll
        for (int i = 0; i < NBq; ++i) __builtin_amdgcn_global_load_lds((const unsigned*)(bsrc[i] + kt * 32), (unsigned*)(sb + (tid + i * NTHR) * 16), 16, 0, 0);
    };
    f32x4 acc[4][4];
#pragma unroll
    for (int m = 0; m < 4; ++m)
#pragma unroll
        for (int n = 0; n < 4; ++n) acc[m][n] = (f32x4){0.f, 0.f, 0.f, 0.f};
    const int T = K / 32;
    __syncthreads();
    stage(0, 0);
    for (int t = 0; t < T; ++t) {
        asm volatile("s_waitcnt vmcnt(0)" ::: "memory");
        __syncthreads();
        if (t + 1 < T) stage(t + 1, (t + 1) & 1);
        const unsigned char* sa = smem + (t & 1) * G::STAGE; const unsigned char* sb = sa + G::ABYTES;
        bf16x8 af[4], bfr[4];
#pragma unroll
        for (int m = 0; m < 4; ++m) af[m] = *(const bf16x8*)(sa + (wm * 64 + m * 16 + fr) * 64 + fq * 16);
#pragma unroll
        for (int n = 0; n < 4; ++n) bfr[n] = *(const bf16x8*)(sb + (wn * 64 + n * 16 + fr) * 64 + fq * 16);
#pragma unroll
        for (int m = 0; m < 4; ++m)
#pragma unroll
            for (int n = 0; n < 4; ++n) acc[m][n] = __builtin_amdgcn_mfma_f32_16x16x32_bf16(bfr[n], af[m], acc[m][n], 0, 0, 0);
        if (SEGK > 0) { if (((t + 1) * 32) % (SEGK > 0 ? SEGK : 32) == 0) hook(acc, ((t + 1) * 32) / (SEGK > 0 ? SEGK : 32) - 1, wm * 64, wn * 64, fr, fq); }
    }
    epi(acc, wm * 64, wn * 64, fr, fq);
}
struct NoHook { DI void operator()(f32x4 (&)[4][4], int, int, int, int, int) const {} };

DI int rowmap(int n, int mode) { return mode == 0 ? n : ((n >> 4) * 32 + (n & 15) + (mode == 2 ? 16 : 0)); }
DI void tconv_tile(const Ctx& c, const float* src, int ld, int N, bf16_t* dst, int ld_dst, int mode, int tk, int tn) {
    bf16_t* T = (bf16_t*)c.smem;
    const int k0 = tk * 64, n0 = tn * 64, tid = c.tid;
    __syncthreads();
#pragma unroll
    for (int i = 0; i < 2; ++i) {
        const int kk = (tid >> 4) + i * 32, n4 = (tid & 15) * 4;
        float4 v = make_float4(0.f, 0.f, 0.f, 0.f);
        if (n0 + n4 < N) v = *(const float4*)(src + (size_t)(k0 + kk) * ld + n0 + n4);
        T[(n4 + 0) * 72 + kk] = f2bf(v.x); T[(n4 + 1) * 72 + kk] = f2bf(v.y); T[(n4 + 2) * 72 + kk] = f2bf(v.z); T[(n4 + 3) * 72 + kk] = f2bf(v.w);
    }
    __syncthreads();
    const int n = tid >> 3, k8 = (tid & 7) * 8;
    if (n0 + n < N) *(u32x4*)(dst + (size_t)rowmap(n0 + n, mode) * ld_dst + k0 + k8) = *(const u32x4*)(T + n * 72 + k8);
}
DI void tconv(const Ctx& c, const float* src, int ld, int K, int N, bf16_t* dst, int ld_dst, int mode, int rot) {
    const int ntk = K / 64, ntn = (N + 63) / 64, nt = ntk * ntn, G = gridDim.x;
    for (int t = (blockIdx.x + G - (rot % G)) % G; t < nt; t += G) tconv_tile(c, src, ld, N, dst, ld_dst, mode, t / ntn, t % ntn);
}

DI void phase_prologue(const Ctx& c) {
    unsigned char* wsm = c.ws + WS_WSM;
    const int tid = c.tid, G = gridDim.x, gtid = blockIdx.x * NTHR + tid, gn = G * NTHR;
    {
        const float4* x = (const float4*)c.in[0]; const float4* cx = (const float4*)c.in[2]; float4* H = (float4*)(c.ws + WS_H);
        for (size_t i = gtid; i < (size_t)NZ * 256; i += gn) {
            const int z = (int)(i >> 8), q = (int)(i & 255), b = z / TZ, s = z % TZ;
            H[i] = (s < CTX) ? cx[((size_t)b * CTX + s) * 256 + q] : x[((size_t)b * SEQ + (s - CTX)) * 256 + q];
        }
    }
    {
        float* rope = (float*)(wsm + OFF_ROPE);
        for (int i = gtid; i < SEQ * 16; i += gn) {
            const int t = i >> 4, a = (i >> 3) & 1, f = i & 7;
            const float pos = (float)(a == 0 ? (t >> 6) : (t & 63));
            const float inv = powf(10000.f, -(float)f / 8.f);
            float sn, cs; sincosf(pos * inv, &sn, &cs);
            rope[i * 2] = cs; rope[i * 2 + 1] = sn;
        }
    }
    {
        float* s5t = (float*)(wsm + OFF_S5T);
        for (int i = gtid; i < NL * 2 * 16 * 64; i += gn) {
            const int ldg = i >> 6;
            const double lr = c.in[24][i], li = c.in[25][i], dt = exp((double)c.in[26][ldg]);
            const double mag = exp(lr * dt), are = mag * cos(li * dt), aim = mag * sin(li * dt);
            const double m256 = exp(lr * dt * 64.0), a256r = m256 * cos(li * dt * 64.0), a256i = m256 * sin(li * dt * 64.0);
            const double den = lr * lr + li * li, nr = are - 1.0, ni = aim;
            const double cfr = (nr * lr + ni * li) / den, cfi = (ni * lr - nr * li) / den;
            float* o = s5t + (size_t)i * 36;
            o[0] = (float)are; o[1] = (float)aim; o[2] = (float)a256r; o[3] = (float)a256i;
            for (int ch = 0; ch < 16; ++ch) {
                const double br = c.in[27][(size_t)i * 16 + ch], bi = c.in[28][(size_t)i * 16 + ch];
                o[4 + ch] = (float)(cfr * br - cfi * bi); o[20 + ch] = (float)(cfr * bi + cfi * br);
            }
        }
    }
    {
        float* rwt = (float*)(wsm + OFF_RWT);
        for (int i = gtid; i < NL * 36 * 1024; i += gn) {
            const int l = i / (36 * 1024), e = (i / 1024) % 36, d = i & 1023;
            rwt[i] = e < 4 ? c.in[41][((size_t)l * 1024 + d) * 4 + e] : c.in[43][((size_t)l * 1024 + d) * 32 + (e - 4)];
        }
    }
    if (blockIdx.x == 0 && tid < NL) {
        float s1 = 0.f, s2 = 0.f;
        for (int i = 0; i < 32; ++i) { s1 += c.in[34][tid * 32 + i] * c.in[35][tid * 32 + i]; s2 += c.in[36][tid * 32 + i] * c.in[37][tid * 32 + i]; }
        ((float*)(wsm + OFF_LAM))[tid] = expf(s1) - expf(s2) + (0.8f - 0.6f * expf(-0.3f * (float)tid));
    }
    {
        float* sv = (float*)c.smem;
        float* red = sv + 3 * 1024;
        __syncthreads();
        for (int i = tid; i < 3 * 1024; i += NTHR) { const float v = i < 2048 ? c.in[1][i] : c.in[3][i - 2048]; sv[i] = siluf_(v); }
        __syncthreads();
        float* modv = (float*)(wsm + OFF_MODV);
        for (int u = blockIdx.x; u < NL * 96; u += G) {
            const int l = u / 96, col = (u % 96) * 64 + (tid & 63), ks = tid >> 6;
            const float* w = c.in[4] + (size_t)l * 1024 * 6144 + col;
            float a0 = 0.f, a1 = 0.f, a2 = 0.f;
            for (int k = ks * 128; k < ks * 128 + 128; ++k) { const float wv = w[(size_t)k * 6144]; a0 += sv[k] * wv; a1 += sv[1024 + k] * wv; a2 += sv[2048 + k] * wv; }
            red[(ks * 64 + (tid & 63)) * 3 + 0] = a0; red[(ks * 64 + (tid & 63)) * 3 + 1] = a1; red[(ks * 64 + (tid & 63)) * 3 + 2] = a2;
            __syncthreads();
            if (tid < 192) {
                const int cc = tid & 63, sel = tid >> 6; float s = 0.f;
                for (int k2 = 0; k2 < 8; ++k2) s += red[(k2 * 64 + cc) * 3 + sel];
                const int colo = (u % 96) * 64 + cc;
                modv[((size_t)l * 3 + sel) * 6144 + colo] = s + c.in[5][l * 6144 + colo];
            }
            __syncthreads();
        }
    }
    for (int l = 0; l < NL; ++l) {
        tconv(c, c.in[8] + (size_t)l * 1024 * NIN, NIN, 1024, NIN, (bf16_t*)(wsm + OFF_WINT + l * SZ_WINT), 1024, 0, 0);
        tconv(c, c.in[11] + (size_t)l * 256 * 384, 384, 256, 384, (bf16_t*)(wsm + OFF_WUQT + l * SZ_WUQT), 256, 0, 40);
        tconv(c, c.in[12] + (size_t)l * 128 * 512, 512, 128, 512, (bf16_t*)(wsm + OFF_WUKVT + l * SZ_WUKVT), 128, 0, 70);
        for (int d = 0; d < 2; ++d) {
            tconv(c, c.in[15] + (size_t)(l * 2 + d) * 64 * 256, 256, 64, 256, (bf16_t*)(wsm + OFF_W2T + l * SZ_W2T) + d * 256 * 64, 64, 0, 90 + d * 8);
            tconv(c, c.in[17] + (size_t)(l * 2 + d) * 64 * 256, 256, 64, 256, (bf16_t*)(wsm + OFF_A2T + l * SZ_A2T) + d * 256 * 64, 64, 0, 110 + d * 8);
        }
        tconv(c, c.in[18] + (size_t)l * 128 * 256, 256, 128, 256, (bf16_t*)(wsm + OFF_G2T + l * SZ_G2T), 128, 0, 130);
        tconv(c, c.in[32] + (size_t)l * 256 * 256, 256, 256, 256, (bf16_t*)(wsm + OFF_GLUT + l * SZ_GLUT), 256, 0, 140);
        for (int n = 0; n < 4; ++n)
            tconv(c, c.in[39] + (size_t)(l * 4 + n) * 256 * 1024, 1024, 256, 1024, (bf16_t*)(wsm + OFF_WBT + l * SZ_WBT) + n * 256, 1024, 0, 160 + n * 20);
        tconv(c, c.in[40] + (size_t)l * 1024 * 1024, 1024, 1024, 1024, (bf16_t*)(wsm + OFF_WOUTT + l * SZ_WOUTT), 1024, 0, 0);
    }
}

DI void phase_expert_convert(const Ctx& c, int l) {
    const int G = gridDim.x;
    for (int t = blockIdx.x; t < 32 * 384; t += G) {
        const int e = t / 384, r = t % 384;
        bf16_t* wgu = (bf16_t*)(c.ws + WS_EXPW + (size_t)e * SZ_WGU);
        bf16_t* wd = (bf16_t*)(c.ws + WS_EXPW + 32 * SZ_WGU + (size_t)e * SZ_WD);
        if (r < 128)      tconv_tile(c, c.in[45] + ((size_t)l * 32 + e) * 1024 * 512, 512, 512, wgu, 1024, 1, r / 8, r % 8);
        else if (r < 256) tconv_tile(c, c.in[46] + ((size_t)l * 32 + e) * 1024 * 512, 512, 512, wgu, 1024, 2, (r - 128) / 8, (r - 128) % 8);
        else              tconv_tile(c, c.in[47] + ((size_t)l * 32 + e) * 512 * 1024, 1024, 1024, wd, 512, 0, (r - 256) / 16, (r - 256) % 16);
    }
}

DI void phase_norm1(const Ctx& c, int l) {
    const float* modv = (const float*)(c.ws + WS_WSM + OFF_MODV);
    float* H = (float*)(c.ws + WS_H); const bf16_t* Y = (const bf16_t*)(c.ws + WS_P);
    bf16_t* XN = (bf16_t*)(c.ws + WS_BUFA);
    const float* g1 = c.in[6] + l * 1024;
    for (int row = blockIdx.x * 8 + c.wave; row < NZ; row += gridDim.x * 8) {
        const int b = row / TZ, s = row % TZ, sel = s < CTX ? 2 : b;
        float4 v[4]; float ss = 0.f;
#pragma unroll
        for (int q = 0; q < 4; ++q) {
            const int col = q * 256 + c.lane * 4;
            v[q] = *(const float4*)(H + (size_t)row * D + col);
            if (l > 0) {
                float ya[4], yb[4]; unpack4(*(const u32x2*)(Y + (size_t)row * D + col), ya); unpack4(*(const u32x2*)(Y + ((size_t)NZ + row) * D + col), yb);
                const float4 m5 = *(const float4*)(modv + ((size_t)(l - 1) * 3 + sel) * 6144 + 5 * 1024 + col);
                v[q].x += m5.x * (ya[0] + yb[0]); v[q].y += m5.y * (ya[1] + yb[1]); v[q].z += m5.z * (ya[2] + yb[2]); v[q].w += m5.w * (ya[3] + yb[3]);
                *(float4*)(H + (size_t)row * D + col) = v[q];
            }
            ss += v[q].x * v[q].x + v[q].y * v[q].y + v[q].z * v[q].z + v[q].w * v[q].w;
        }
        ss = wave_sum(ss);
        const float rs = rsqrtf(ss * (1.f / 1024.f) + 1e-6f);
#pragma unroll
        for (int q = 0; q < 4; ++q) {
            const int col = q * 256 + c.lane * 4;
            const float4 g = *(const float4*)(g1 + col), m0 = *(const float4*)(modv + ((size_t)l * 3 + sel) * 6144 + col), m1 = *(const float4*)(modv + ((size_t)l * 3 + sel) * 6144 + 1024 + col);
            *(u32x2*)(XN + (size_t)row * D + col) = pack4(v[q].x * rs * g.x * (1.f + m1.x) + m0.x, v[q].y * rs * g.y * (1.f + m1.y) + m0.y,
                                                          v[q].z * rs * g.z * (1.f + m1.z) + m0.z, v[q].w * rs * g.w * (1.f + m1.w) + m0.w);
        }
    }
}

DI void phase_final(const Ctx& c) {
    const float* modv = (const float*)(c.ws + WS_WSM + OFF_MODV);
    const float* H = (const float*)(c.ws + WS_H); const bf16_t* Y = (const bf16_t*)(c.ws + WS_P);
    const float* g = c.in[48];
    for (int r = blockIdx.x * 8 + c.wave; r < NB * SEQ; r += gridDim.x * 8) {
        const int b = r / SEQ, t = r % SEQ, row = b * TZ + CTX + t;
        float4 v[4]; float ss = 0.f;
#pragma unroll
        for (int q = 0; q < 4; ++q) {
            const int col = q * 256 + c.lane * 4;
            v[q] = *(const float4*)(H + (size_t)row * D + col);
            float ya[4], yb[4]; unpack4(*(const u32x2*)(Y + (size_t)row * D + col), ya); unpack4(*(const u32x2*)(Y + ((size_t)NZ + row) * D + col), yb);
            const float4 m5 = *(const float4*)(modv + ((size_t)(NL - 1) * 3 + b) * 6144 + 5 * 1024 + col);
            v[q].x += m5.x * (ya[0] + yb[0]); v[q].y += m5.y * (ya[1] + yb[1]); v[q].z += m5.z * (ya[2] + yb[2]); v[q].w += m5.w * (ya[3] + yb[3]);
            ss += v[q].x * v[q].x + v[q].y * v[q].y + v[q].z * v[q].z + v[q].w * v[q].w;
        }
        ss = wave_sum(ss);
        const float rs = rsqrtf(ss * (1.f / 1024.f) + 1e-6f);
#pragma unroll
        for (int q = 0; q < 4; ++q) {
            const int col = q * 256 + c.lane * 4; const float4 gg = *(const float4*)(g + col);
            *(float4*)(c.out + (size_t)r * D + col) = make_float4(v[q].x * rs * gg.x, v[q].y * rs * gg.y, v[q].z * rs * gg.z, v[q].w * rs * gg.w);
        }
    }
}

DI void phase_inproj(const Ctx& c, int l) {
    const bf16_t* XN = (const bf16_t*)(c.ws + WS_BUFA);
    const bf16_t* W = (const bf16_t*)(c.ws + WS_WSM + OFF_WINT + l * SZ_WINT);
    bf16_t* PM = (bf16_t*)(c.ws + WS_P + P_PM); bf16_t* PS = (bf16_t*)(c.ws + WS_P + P_PS); bf16_t* PR = (bf16_t*)(c.ws + WS_P + P_PR); bf16_t* PD = (bf16_t*)(c.ws + WS_P + P_PD);
    bf16_t* GT = (bf16_t*)(c.ws + WS_GT);
    constexpr int NMT = NZ / 256, NNT = NINP / 128;
    for (int u = blockIdx.x; u < NMT * NNT; u += gridDim.x) {
        const int mt = u / NNT, nt = u % NNT, r0 = mt * 256, c0 = nt * 128;
        gemm_tile<4, 0>(c, 1024,
            [&](int i) { return XN + (size_t)(r0 + i) * D; },
            [&](int i) { return W + (size_t)(c0 + i) * D; }, NoHook(),
            [&](f32x4 (&acc)[4][4], int wr, int wc, int fr, int fq) {
#pragma unroll
                for (int n = 0; n < 4; ++n) {
                    const int col = c0 + wc + n * 16 + fq * 4;
                    bf16_t* dst; int ld, cc; bool gate = false;
                    if (col < 416) { dst = PM; ld = 416; cc = col; }
                    else if (col < 1440) { dst = PR; ld = 1024; cc = col - 416; }
                    else if (col < 1696) { dst = PS; ld = 256; cc = col - 1440; }
                    else if (col < 2464) { dst = PD; ld = 768; cc = col - 1696; }
                    else if (col < NIN) { dst = GT; ld = 4096; cc = col - 2464; gate = true; }
                    else continue;
#pragma unroll
                    for (int m = 0; m < 4; ++m) {
                        const int row = r0 + wr + m * 16 + fr; f32x4 v = acc[m][n];
                        if (gate) { v[0] = sigmoidf_(v[0]); v[1] = sigmoidf_(v[1]); v[2] = sigmoidf_(v[2]); v[3] = sigmoidf_(v[3]); }
                        *(u32x2*)(dst + (size_t)row * ld + cc) = pack4(v[0], v[1], v[2], v[3]);
                    }
                }
            });
    }
}

DI void phase_prep(const Ctx& c, int l) {
    unsigned char* ws = c.ws; const int lane = c.lane, wave = c.wave, tid = c.tid;
    const bf16_t* PM = (const bf16_t*)(ws + WS_P + P_PM); const bf16_t* PR = (const bf16_t*)(ws + WS_P + P_PR); const bf16_t* PD = (const bf16_t*)(ws + WS_P + P_PD);
    bf16_t* CQN = (bf16_t*)(ws + WS_MISC + MS_CQN); bf16_t* TW = (bf16_t*)(ws + WS_MISC + MS_TW); bf16_t* AL = (bf16_t*)(ws + WS_MISC + MS_AL); bf16_t* SG = (bf16_t*)(ws + WS_MISC + MS_SG);
    bf16_t* KM = (bf16_t*)(ws + WS_EXPW + MX_KM); bf16_t* QD = (bf16_t*)(ws + WS_EXPW + MX_QD); bf16_t* KD_ = (bf16_t*)(ws + WS_EXPW + MX_KD); bf16_t* VDT = (bf16_t*)(ws + WS_EXPW + MX_VDT);
    bf16_t* RB = (bf16_t*)(ws + WS_EXPW + MX_RB); bf16_t* KB = (bf16_t*)(ws + WS_EXPW + MX_KB); bf16_t* VB = (bf16_t*)(ws + WS_EXPW + MX_VB); bf16_t* KKB = (bf16_t*)(ws + WS_EXPW + MX_KKB);
    const float* rope = (const float*)(ws + WS_WSM + OFF_ROPE);
    const float* gq = c.in[9] + l * 256; const float* gkv = c.in[10] + l * 128; const float* mu = c.in[13] + l * 1024; const float* k_k = c.in[19] + l * 256;
    bf16_t* Vs = (bf16_t*)c.smem;
    const float qsc = 0.17677669529663687f * LOG2E;
    for (int tile = blockIdx.x; tile < NZ / 64; tile += gridDim.x) {
        __syncthreads();
        for (int i = 0; i < 8; ++i) {
            const int rt = wave * 8 + i, z = tile * 64 + rt, b = z / TZ, s = z % TZ; const bool lat = s >= CTX; const int tl = lat ? s - CTX : 0;
            {
                const bf16_t* pm = PM + (size_t)z * 416;
                float x[4]; unpack4(*(const u32x2*)(pm + lane * 4), x);
                float ss = wave_sum(x[0] * x[0] + x[1] * x[1] + x[2] * x[2] + x[3] * x[3]);
                float rs = rsqrtf(ss * (1.f / 256.f) + 1e-6f);
                const float4 g = *(const float4*)(gq + lane * 4);
                *(u32x2*)(CQN + (size_t)z * 384 + lane * 4) = pack4(x[0] * rs * g.x, x[1] * rs * g.y, x[2] * rs * g.z, x[3] * rs * g.w);
                const unsigned u2 = *(const unsigned*)(pm + 256 + lane * 2); const float y0 = lo2f(u2), y1 = hi2f(u2);
                ss = wave_sum(y0 * y0 + y1 * y1); rs = rsqrtf(ss * (1.f / 128.f) + 1e-6f);
                const float2 g2 = *(const float2*)(gkv + lane * 2);
                *(unsigned*)(CQN + (size_t)z * 384 + 256 + lane * 2) = pack2(y0 * rs * g2.x, y1 * rs * g2.y);
                float kr = bf2f(pm[384 + (lane & 31)]);
                const float pr = __shfl_xor(kr, 8, 64);
                if (lat) { const float* cs = rope + ((size_t)tl * 16 + ((lane & 31) >> 4) * 8 + (lane & 7)) * 2; kr = kr * cs[0] + ((lane & 8) ? pr : -pr) * cs[1]; }
                if (lane < 32) {
                    const bf16_t kv = f2bf(kr);
#pragma unroll
                    for (int h = 0; h < 4; ++h) KM[((size_t)(b * 4 + h) * TZ + s) * 96 + 64 + lane] = kv;
                }
            }
            {
                const bf16_t* pd = PD + (size_t)z * 768;
                const int i0 = lane * 4, hh = i0 >> 6, ii = i0 & 31, nn = (i0 >> 5) & 1;
                const float* cs = rope + ((size_t)tl * 16 + (ii >> 4) * 8 + (ii & 7)) * 2;
                const bool hi = (ii & 8) != 0;
#pragma unroll
                for (int w = 0; w < 2; ++w) {
                    float x[4]; unpack4(*(const u32x2*)(pd + w * 256 + i0), x);
                    float o[4];
#pragma unroll
                    for (int j = 0; j < 4; ++j) {
                        const float p = __shfl_xor(x[j], 2, 64);
                        o[j] = lat ? (x[j] * cs[2 * j] + (hi ? p : -p) * cs[2 * j + 1]) : x[j];
                        if (w == 0) o[j] *= qsc;
                    }
                    bf16_t* dst = (w == 0 ? QD : KD_) + ((size_t)(b * 4 + hh) * TZ + s) * 64 + nn * 32 + ii;
                    *(u32x2*)dst = pack4(o[0], o[1], o[2], o[3]);
                }
                *(u32x2*)(Vs + rt * 264 + i0) = *(const u32x2*)(pd + 512 + i0);
            }
            {
                const bf16_t* pr = PR + (size_t)z * 1024;
                const bool hp = (s != 0) && (s != CTX), hn = (s != CTX - 1) && (s != TZ - 1);
#pragma unroll
                for (int q = 0; q < 4; ++q) {
                    const int col = q * 256 + lane * 4;
                    float cu[4], pv[4] = {0.f, 0.f, 0.f, 0.f}, nx[4] = {0.f, 0.f, 0.f, 0.f};
                    unpack4(*(const u32x2*)(pr + col), cu);
                    if (hp) unpack4(*(const u32x2*)(pr - 1024 + col), pv);
                    if (hn) unpack4(*(const u32x2*)(pr + 1024 + col), nx);
                    const float4 m = *(const float4*)(mu + col);
                    float zv[4];
                    zv[0] = cu[0] + (0.5f * (pv[0] + nx[0]) - cu[0]) * m.x; zv[1] = cu[1] + (0.5f * (pv[1] + nx[1]) - cu[1]) * m.y;
                    zv[2] = cu[2] + (0.5f * (pv[2] + nx[2]) - cu[2]) * m.z; zv[3] = cu[3] + (0.5f * (pv[3] + nx[3]) - cu[3]) * m.w;
                    if (q == 0) *(u32x2*)(RB + (size_t)z * 256 + lane * 4) = pack4(zv[0], zv[1], zv[2], zv[3]);
                    else if (q == 1) {
                        *(u32x2*)(KB + (size_t)z * 256 + lane * 4) = pack4(zv[0], zv[1], zv[2], zv[3]);
                        const float4 kk4 = *(const float4*)(k_k + lane * 4);
                        const float a0 = zv[0] * kk4.x, a1 = zv[1] * kk4.y, a2 = zv[2] * kk4.z, a3 = zv[3] * kk4.w;
                        const float ssq = sum16(a0 * a0 + a1 * a1 + a2 * a2 + a3 * a3);
                        const float inv = 1.f / fmaxf(sqrtf(ssq), 1e-12f);
                        *(u32x2*)(KKB + (size_t)z * 256 + lane * 4) = pack4(a0 * inv, a1 * inv, a2 * inv, a3 * inv);
                    } else if (q == 2) *(u32x2*)(VB + (size_t)z * 256 + lane * 4) = pack4(zv[0], zv[1], zv[2], zv[3]);
                    else {
                        if (lane < 16) *(u32x2*)(TW + (size_t)z * 64 + lane * 4) = pack4(tanhf(zv[0]), tanhf(zv[1]), tanhf(zv[2]), tanhf(zv[3]));
                        else if (lane < 32) *(u32x2*)(AL + (size_t)z * 64 + (lane - 16) * 4) = pack4(zv[0], zv[1], zv[2], zv[3]);
                        else *(u32x2*)(SG + (size_t)z * 128 + (lane - 32) * 4) = pack4(sigmoidf_(zv[0]), sigmoidf_(zv[1]), sigmoidf_(zv[2]), sigmoidf_(zv[3]));
                    }
                }
            }
        }
        __syncthreads();
        {
            const int z0 = tile * 64, b = z0 / TZ, s0 = z0 % TZ;
#pragma unroll
            for (int i = 0; i < 4; ++i) {
                const int ch = tid + i * NTHR, dv = ch >> 3, r8 = (ch & 7) * 8;
                bf16_t v[8];
#pragma unroll
                for (int j = 0; j < 8; ++j) v[j] = Vs[(r8 + j) * 264 + dv];
                u32x4 o; o.x = v[0] | ((unsigned)v[1] << 16); o.y = v[2] | ((unsigned)v[3] << 16); o.z = v[4] | ((unsigned)v[5] << 16); o.w = v[6] | ((unsigned)v[7] << 16);
                *(u32x4*)(VDT + ((size_t)(b * 4 + (dv >> 6)) * 64 + (dv & 63)) * TZ + s0 + r8) = o;
            }
        }
    }
}

constexpr int S5C = 64, S5N = TZ / S5C, S5NC = CTX / S5C;
DI int s5_tok(int dir, int i) { return dir == 0 ? i : (i < CTX ? CTX - 1 - i : TZ - 1 - (i - CTX)); }
DI void s5_stage_u(const Ctx& c, float* U, int b, int dir, int chunk, int g0, int ng) {
    const bf16_t* PS = (const bf16_t*)(c.ws + WS_P + P_PS);
    const int per = ng * 4;
    for (int e = c.tid; e < S5C * per; e += NTHR) {
        const int i = e / per, c4 = (e % per) * 4, s = s5_tok(dir, chunk * S5C + i);
        float x[4]; unpack4(*(const u32x2*)(PS + (size_t)(b * TZ + s) * 256 + g0 * 16 + c4), x);
        *(float4*)(U + i * (ng * 16) + c4) = make_float4(x[0], x[1], x[2], x[3]);
    }
}
DI void phase_s5_local(const Ctx& c, int l) {
    float* U = (float*)c.smem;
    const float* s5t = (const float*)(c.ws + WS_WSM + OFF_S5T);
    float* E = (float*)(c.ws + WS_WSM + OFF_S5E);
    for (int u = blockIdx.x; u < 2 * 2 * S5N * 2; u += gridDim.x) {
        const int gq = u & 1, chunk = (u >> 1) % S5N, dir = (u / (2 * S5N)) & 1, b = u / (4 * S5N);
        __syncthreads();
        s5_stage_u(c, U, b, dir, chunk, gq * 8, 8);
        __syncthreads();
        const int g = gq * 8 + c.wave, p = c.lane;
        const float* tb = s5t + ((size_t)((l * 2 + dir) * 16 + g) * 64 + p) * 36;
        const float are = tb[0], aim = tb[1];
        float br[16], bi[16];
#pragma unroll
        for (int ch = 0; ch < 16; ++ch) { br[ch] = tb[4 + ch]; bi[ch] = tb[20 + ch]; }
        float xr = 0.f, xi = 0.f;
        for (int i = 0; i < S5C; ++i) {
            const float* uu = U + i * 128 + c.wave * 16;
            float sr = 0.f, si = 0.f;
#pragma unroll
            for (int q = 0; q < 4; ++q) { const float4 v = *(const float4*)(uu + q * 4);
                sr += br[q * 4] * v.x + br[q * 4 + 1] * v.y + br[q * 4 + 2] * v.z + br[q * 4 + 3] * v.w;
                si += bi[q * 4] * v.x + bi[q * 4 + 1] * v.y + bi[q * 4 + 2] * v.z + bi[q * 4 + 3] * v.w; }
            const float nr = are * xr - aim * xi + sr, ni = are * xi + aim * xr + si; xr = nr; xi = ni;
        }
        *(float2*)(E + ((size_t)(((b * 2 + dir) * 16 + g) * S5N + chunk) * 64 + p) * 2) = make_float2(xr, xi);
    }
}
DI void phase_s5_carry(const Ctx& c, int l) {
    const int gt = blockIdx.x * NTHR + c.tid;
    if (gt < 2 * 2 * 16 * 64) {
        const int p = gt & 63, g = (gt >> 6) & 15, dir = (gt >> 10) & 1, b = gt >> 11;
        const float* tb = (const float*)(c.ws + WS_WSM + OFF_S5T) + ((size_t)((l * 2 + dir) * 16 + g) * 64 + p) * 36;
        const float ar = tb[2], ai = tb[3];
        const float* E = (const float*)(c.ws + WS_WSM + OFF_S5E) + (size_t)(((b * 2 + dir) * 16 + g) * S5N) * 128;
        float* C = (float*)(c.ws + WS_WSM + OFF_S5C) + (size_t)(((b * 2 + dir) * 16 + g) * S5N) * 128;
        float xr = 0.f, xi = 0.f;
        for (int ch = 0; ch < S5N; ++ch) {
            const float2 e = *(const float2*)(E + ch * 128 + p * 2);
            *(float2*)(C + ch * 128 + p * 2) = make_float2(xr, xi);
            const float nr = ar * xr - ai * xi + e.x, ni = ar * xi + ai * xr + e.y; xr = nr; xi = ni;
        }
    }
}

constexpr int S5_US = 0, S5_YS = 8192, S5_WV = S5_YS + 2 * 64 * 64 * 4;
DI void phase_s5_final_unit(const Ctx& c, int l, int u) {
    unsigned char* L = c.smem;
    const float* s5t = (const float*)(c.ws + WS_WSM + OFF_S5T);
    const float* CIN = (const float*)(c.ws + WS_WSM + OFF_S5C);
    const bf16_t* PS = (const bf16_t*)(c.ws + WS_P + P_PS);
    const int gq = u & 3, ct = (u >> 2) % S5N, b = u / (4 * S5N);
    const int wave = c.wave, lane = c.lane, gl = wave >> 1, dir = wave & 1, g = gq * 4 + gl, n16 = lane & 15, q4 = lane >> 4;
    __syncthreads();
    {
        const int t = c.tid >> 3, part = c.tid & 7;
        *(u32x4*)(L + S5_US + t * 128 + part * 16) = *(const u32x4*)(PS + (size_t)(b * TZ + ct * S5C + t) * 256 + gq * 64 + part * 8);
    }
    const float* tbase = s5t + ((size_t)((l * 2 + dir) * 16 + g) * 64) * 36;
    bf16x8 bfr[8], cfr[4];
#pragma unroll
    for (int j = 0; j < 8; ++j) {
        const int pp = 16 * j + n16, p = pp & 63; const float* tb = tbase + (size_t)p * 36 + (pp < 64 ? 4 : 20) + 8 * (q4 & 1);
        u32x4 w4 = {0u, 0u, 0u, 0u};
        if (q4 < 2) { w4.x = pack2(tb[0], tb[1]); w4.y = pack2(tb[2], tb[3]); w4.z = pack2(tb[4], tb[5]); w4.w = pack2(tb[6], tb[7]); }
        bfr[j] = __builtin_bit_cast(bf16x8, w4);
    }
    {
        const float* cre = c.in[29] + ((size_t)((l * 2 + dir) * 16 + g) * 16 + n16) * 64; const float* cim = c.in[30] + ((size_t)((l * 2 + dir) * 16 + g) * 16 + n16) * 64;
#pragma unroll
        for (int s = 0; s < 4; ++s) {
            const int pp = 32 * s + 8 * q4; const float sg = pp < 64 ? 1.f : -1.f; const float* src = (pp < 64 ? cre + pp : cim + (pp - 64));
            u32x4 w4; w4.x = pack2(sg * src[0], sg * src[1]); w4.y = pack2(sg * src[2], sg * src[3]); w4.z = pack2(sg * src[4], sg * src[5]); w4.w = pack2(sg * src[6], sg * src[7]);
            cfr[s] = __builtin_bit_cast(bf16x8, w4);
        }
    }
    const float are = tbase[(size_t)lane * 36], aim = tbase[(size_t)lane * 36 + 1];
    const int cd = dir == 0 ? ct : (ct < S5NC ? S5NC - 1 - ct : S5N + S5NC - 1 - ct);
    const float2 ci = *(const float2*)(CIN + ((size_t)(((b * 2 + dir) * 16 + g) * S5N + cd) * 64 + lane) * 2);
    float xr = ci.x, xi = ci.y;
    const float dsk = c.in[31][(size_t)l * 256 + g * 16 + n16];
    bf16_t* BU = (bf16_t*)(L + S5_WV + wave * 8192); bf16_t* XB = BU + 16 * 128;
    float* YS = (float*)(L + S5_YS) + dir * 64 * 64;
    __syncthreads();
#pragma unroll 1
    for (int sb = 0; sb < 4; ++sb) {
        const int stepA = 16 * sb + n16, tlA = dir == 0 ? stepA : 63 - stepA;
        u32x4 a4 = {0u, 0u, 0u, 0u};
        if (q4 < 2) a4 = *(const u32x4*)(L + S5_US + tlA * 128 + gl * 32 + q4 * 16);
        const bf16x8 af = __builtin_bit_cast(bf16x8, a4);
#pragma unroll
        for (int j = 0; j < 8; ++j) {
            f32x4 acc = {0.f, 0.f, 0.f, 0.f};
            acc = __builtin_amdgcn_mfma_f32_16x16x32_bf16(af, bfr[j], acc, 0, 0, 0);
#pragma unroll
            for (int rr = 0; rr < 4; ++rr) BU[(4 * q4 + rr) * 128 + 16 * j + n16] = f2bf(acc[rr]);
        }
#pragma unroll
        for (int ii = 0; ii < 16; ++ii) {
            const float br = bf2f(BU[ii * 128 + lane]), bi = bf2f(BU[ii * 128 + 64 + lane]);
            const float nr = are * xr - aim * xi + br, ni = are * xi + aim * xr + bi; xr = nr; xi = ni;
            XB[ii * 128 + lane] = f2bf(xr); XB[ii * 128 + 64 + lane] = f2bf(xi);
        }
        f32x4 ya = {0.f, 0.f, 0.f, 0.f};
#pragma unroll
        for (int s = 0; s < 4; ++s) {
            const bf16x8 xf = *(const bf16x8*)((const unsigned char*)XB + n16 * 256 + (32 * s + 8 * q4) * 2);
            ya = __builtin_amdgcn_mfma_f32_16x16x32_bf16(xf, cfr[s], ya, 0, 0, 0);
        }
#pragma unroll
        for (int rr = 0; rr < 4; ++rr) {
            const int step = 16 * sb + 4 * q4 + rr, tl = dir == 0 ? step : 63 - step;
            float y = ya[rr];
            if (dir == 0) y += dsk * bf2f(*(const bf16_t*)(L + S5_US + tl * 128 + (gl * 16 + n16) * 2));
            YS[tl * 64 + gl * 16 + n16] = y;
        }
    }
    __syncthreads();
    bf16_t* ZG = (bf16_t*)(c.ws + WS_MISC + MS_ZG);
    {
        const float* Y0 = (const float*)(L + S5_YS); const float* Y1 = Y0 + 64 * 64;
        for (int e = c.tid; e < 64 * 16; e += NTHR) {
            const int i = e >> 4, c4 = (e & 15) * 4; const float4 y0 = *(const float4*)(Y0 + i * 64 + c4), y1 = *(const float4*)(Y1 + i * 64 + c4);
            *(u32x2*)(ZG + (size_t)(b * TZ + ct * S5C + i) * 256 + gq * 64 + c4) = pack4(gelu_tanh(y0.x + y1.x), gelu_tanh(y0.y + y1.y), gelu_tanh(y0.z + y1.z), gelu_tanh(y0.w + y1.w));
        }
    }
}

DI void phase_small_gemms(const Ctx& c, int l) {
    unsigned char* ws = c.ws; unsigned char* wsm = ws + WS_WSM;
    const bf16_t* CQN = (const bf16_t*)(ws + WS_MISC + MS_CQN);
    const float* rope = (const float*)(wsm + OFF_ROPE);
    constexpr int NMT = NZ / 256;
    int base = 0;
    const int G = gridDim.x, bid = blockIdx.x;
    {
        const bf16_t* W = (const bf16_t*)(wsm + OFF_WUQT + l * SZ_WUQT); bf16_t* QM = (bf16_t*)(ws + WS_EXPW + MX_QM);
        const float qs = 0.10206207261596577f * LOG2E;
        for (int u = (bid + G - base % G) % G; u < NMT * 3; u += G) {
            const int mt = u / 3, nt = u % 3, r0 = mt * 256, c0 = nt * 128;
            gemm_tile<4, 0>(c, 256, [&](int i) { return CQN + (size_t)(r0 + i) * 384; }, [&](int i) { return W + (size_t)(c0 + i) * 256; }, NoHook(),
                [&](f32x4 (&acc)[4][4], int wr, int wc, int fr, int fq) {
#pragma unroll
                    for (int n = 0; n < 4; ++n) {
                        const int col = c0 + wc + n * 16 + fq * 4, h = col / 96, d = col % 96;
                        const bool rp = d >= 64;
#pragma unroll
                        for (int m = 0; m < 4; ++m) {
                            const int row = r0 + wr + m * 16 + fr, b = row / TZ, s = row % TZ; f32x4 v = acc[m][n];
                            f32x4 pv; pv[0] = __shfl_xor(v[0], 32, 64); pv[1] = __shfl_xor(v[1], 32, 64); pv[2] = __shfl_xor(v[2], 32, 64); pv[3] = __shfl_xor(v[3], 32, 64);
                            if (rp && s >= CTX) {
                                const int i0 = d - 64;
                                const float* cs = rope + ((size_t)(s - CTX) * 16 + (i0 >> 4) * 8 + (i0 & 7)) * 2;
                                const bool hi = (i0 & 8) != 0;
#pragma unroll
                                for (int j = 0; j < 4; ++j) v[j] = v[j] * cs[2 * j] + (hi ? pv[j] : -pv[j]) * cs[2 * j + 1];
                            }
                            *(u32x2*)(QM + ((size_t)(b * 4 + h) * TZ + s) * 96 + d) = pack4(v[0] * qs, v[1] * qs, v[2] * qs, v[3] * qs);
                        }
                    }
                });
        }
        base += NMT * 3;
    }
    {
        const bf16_t* W = (const bf16_t*)(wsm + OFF_WUKVT + l * SZ_WUKVT); bf16_t* KM = (bf16_t*)(ws + WS_EXPW + MX_KM); bf16_t* VMT = (bf16_t*)(ws + WS_EXPW + MX_VMT);
        for (int u = (bid + G - base % G) % G; u < NMT * 4; u += G) {
            const int mt = u / 4, nt = u % 4, r0 = mt * 256, c0 = nt * 128;
            gemm_tile<4, 0>(c, 128, [&](int i) { return CQN + (size_t)(r0 + i) * 384 + 256; }, [&](int i) { return W + (size_t)(c0 + i) * 128; }, NoHook(),
                [&](f32x4 (&acc)[4][4], int wr, int wc, int fr, int fq) {
#pragma unroll
                    for (int n = 0; n < 4; ++n) {
                        const int col = c0 + wc + n * 16 + fq * 4, h = col >> 7, d = col & 127;
#pragma unroll
                        for (int m = 0; m < 4; ++m) {
                            const int row = r0 + wr + m * 16 + fr, b = row / TZ, s = row % TZ; const f32x4 v = acc[m][n];
                            if (d < 64) *(u32x2*)(KM + ((size_t)(b * 4 + h) * TZ + s) * 96 + d) = pack4(v[0], v[1], v[2], v[3]);
                            else {
#pragma unroll
                                for (int j = 0; j < 4; ++j) VMT[((size_t)(b * 4 + h) * 64 + (d - 64 + j)) * TZ + s] = f2bf(v[j]);
                            }
                        }
                    }
                });
        }
        base += NMT * 4;
    }
    bf16_t* SE = (bf16_t*)(ws + WS_P + P_PR); bf16_t* SAD = SE + (size_t)2 * NZ * 256; bf16_t* SKD = SAD + (size_t)2 * NZ * 256;
    {
        const bf16_t* A = (const bf16_t*)(ws + WS_MISC + MS_TW); const bf16_t* W = (const bf16_t*)(wsm + OFF_W2T + l * SZ_W2T);
        const float* w0 = c.in[14] + (size_t)l * 512;
        for (int u = (bid + G - base % G) % G; u < NMT * 4; u += G) {
            const int mt = u / 4, nt = u % 4, r0 = mt * 256, c0 = nt * 128;
            gemm_tile<4, 0>(c, 64, [&](int i) { return A + (size_t)(r0 + i) * 64; }, [&](int i) { return W + (size_t)(c0 + i) * 64; }, NoHook(),
                [&](f32x4 (&acc)[4][4], int wr, int wc, int fr, int fq) {
#pragma unroll
                    for (int n = 0; n < 4; ++n) {
                        const int col = c0 + wc + n * 16 + fq * 4, d = col >> 8, cc = col & 255; const float4 w0v = *(const float4*)(w0 + col);
#pragma unroll
                        for (int m = 0; m < 4; ++m) {
                            const int row = r0 + wr + m * 16 + fr; const f32x4 v = acc[m][n]; float e[4];
                            const float x[4] = {w0v.x + v[0], w0v.y + v[1], w0v.z + v[2], w0v.w + v[3]};
#pragma unroll
                            for (int j = 0; j < 4; ++j) { const float sp = (x[j] < -20.f) ? -x[j] : log1pf(__expf(-x[j])); e[j] = __expf(-sp - 0.5f); }
                            *(u32x2*)(SE + ((size_t)d * NZ + row) * 256 + cc) = pack4(e[0], e[1], e[2], e[3]);
                        }
                    }
                });
        }
        base += NMT * 4;
    }
    {
        const bf16_t* A = (const bf16_t*)(ws + WS_MISC + MS_AL); const bf16_t* W = (const bf16_t*)(wsm + OFF_A2T + l * SZ_A2T);
        const float* a0 = c.in[16] + (size_t)l * 512; const float* k_a = c.in[20] + (size_t)l * 256; const bf16_t* KB = (const bf16_t*)(ws + WS_EXPW + MX_KB);
        for (int u = (bid + G - base % G) % G; u < NMT * 4; u += G) {
            const int mt = u / 4, nt = u % 4, r0 = mt * 256, c0 = nt * 128;
            gemm_tile<4, 0>(c, 64, [&](int i) { return A + (size_t)(r0 + i) * 64; }, [&](int i) { return W + (size_t)(c0 + i) * 64; }, NoHook(),
                [&](f32x4 (&acc)[4][4], int wr, int wc, int fr, int fq) {
#pragma unroll
                    for (int n = 0; n < 4; ++n) {
                        const int col = c0 + wc + n * 16 + fq * 4, d = col >> 8, cc = col & 255; const float4 a0v = *(const float4*)(a0 + col), kav = *(const float4*)(k_a + cc);
#pragma unroll
                        for (int m = 0; m < 4; ++m) {
                            const int row = r0 + wr + m * 16 + fr; const f32x4 v = acc[m][n];
                            const float ad0 = sigmoidf_(a0v.x + v[0]), ad1 = sigmoidf_(a0v.y + v[1]), ad2 = sigmoidf_(a0v.z + v[2]), ad3 = sigmoidf_(a0v.w + v[3]);
                            float k[4]; unpack4(*(const u32x2*)(KB + (size_t)row * 256 + cc), k);
                            *(u32x2*)(SAD + ((size_t)d * NZ + row) * 256 + cc) = pack4(ad0, ad1, ad2, ad3);
                            *(u32x2*)(SKD + ((size_t)d * NZ + row) * 256 + cc) = pack4(k[0] * (1.f + (ad0 - 1.f) * kav.x), k[1] * (1.f + (ad1 - 1.f) * kav.y), k[2] * (1.f + (ad2 - 1.f) * kav.z), k[3] * (1.f + (ad3 - 1.f) * kav.w));
                        }
                    }
                });
        }
        base += NMT * 4;
    }
    {
        const bf16_t* A = (const bf16_t*)(ws + WS_MISC + MS_SG); const bf16_t* W = (const bf16_t*)(wsm + OFF_G2T + l * SZ_G2T); bf16_t* GG = (bf16_t*)(ws + WS_MISC + MS_GG);
        for (int u = (bid + G - base % G) % G; u < NMT * 2; u += G) {
            const int mt = u / 2, nt = u % 2, r0 = mt * 256, c0 = nt * 128;
            gemm_tile<4, 0>(c, 128, [&](int i) { return A + (size_t)(r0 + i) * 128; }, [&](int i) { return W + (size_t)(c0 + i) * 128; }, NoHook(),
                [&](f32x4 (&acc)[4][4], int wr, int wc, int fr, int fq) {
#pragma unroll
                    for (int n = 0; n < 4; ++n)
#pragma unroll
                        for (int m = 0; m < 4; ++m) { const f32x4 v = acc[m][n];
                            *(u32x2*)(GG + (size_t)(r0 + wr + m * 16 + fr) * 256 + c0 + wc + n * 16 + fq * 4) = pack4(v[0], v[1], v[2], v[3]); }
                });
        }
        base += NMT * 2;
    }
}

DI int krow(int s, int h, int j) { return 16 * s + 8 * (j >> 2) + 4 * h + (j & 3); }
constexpr int ATT_PARK = 48 * 1024;
template <int MODE>
DI void attn_pass(const Ctx& c, int l, int b, int h, int q0, int nkeys) {
    constexpr int DROW = MODE == 0 ? 96 : 64;
    constexpr int DQ = MODE == 0 ? 96 : 32, KS = DQ / 16;
    constexpr int DOFF = MODE == 2 ? 32 : 0;
    constexpr int KPITCH = DQ * 2 + 16;
    constexpr int VPITCH = 64 * 2 + 16;
    constexpr int KBYTES = 64 * KPITCH, VBYTES = 64 * VPITCH, STG = KBYTES + VBYTES;
    unsigned char* ws = c.ws; const int tid = c.tid, lane = c.lane, wave = c.wave, r = lane & 31, hh = lane >> 5;
    const bf16_t* Q = (const bf16_t*)(ws + WS_EXPW + (MODE == 0 ? MX_QM : MX_QD)) + (size_t)(b * 4 + h) * TZ * DROW + DOFF;
    const bf16_t* Kp = (const bf16_t*)(ws + WS_EXPW + (MODE == 0 ? MX_KM : MX_KD)) + (size_t)(b * 4 + h) * TZ * DROW + DOFF;
    const bf16_t* Vt = (const bf16_t*)(ws + WS_EXPW + (MODE == 0 ? MX_VMT : MX_VDT)) + (size_t)(b * 4 + h) * 64 * TZ;
    unsigned char* smem = c.smem;
    bf16x8 qf[KS];
    const int qrow = q0 + wave * 32 + r;
#pragma unroll
    for (int ks = 0; ks < KS; ++ks) qf[ks] = *(const bf16x8*)(Q + (size_t)qrow * DROW + ks * 16 + hh * 8);
    f32x16 oacc[2];
    float mrun = -1e30f, lrun = 0.f;
#pragma unroll
    for (int t = 0; t < 2; ++t)
#pragma unroll
        for (int i = 0; i < 16; ++i) oacc[t][i] = 0.f;
    constexpr int CPR = DQ / 8, KCH = 64 * CPR;
    u32x4 kreg[2], vreg;
    auto gload = [&](int kt) {
        const int k0 = kt * 64;
#pragma unroll
        for (int i = 0; i < 2; ++i) { const int ch = tid + i * NTHR; if (ch < KCH) kreg[i] = *(const u32x4*)(Kp + (size_t)(k0 + ch / CPR) * DROW + (ch % CPR) * 8); }
        vreg = *(const u32x4*)(Vt + (size_t)(tid >> 3) * TZ + k0 + (tid & 7) * 8);
    };
    auto lstore = [&](int buf) {
        unsigned char* sk = smem + buf * STG; unsigned char* sv = sk + KBYTES;
#pragma unroll
        for (int i = 0; i < 2; ++i) { const int ch = tid + i * NTHR; if (ch < KCH) *(u32x4*)(sk + (ch / CPR) * KPITCH + (ch % CPR) * 16) = kreg[i]; }
        *(u32x4*)(sv + (tid >> 3) * VPITCH + (tid & 7) * 16) = vreg;
    };
    const int NT = nkeys / 64;
    __syncthreads();
    gload(0);
    for (int kt = 0; kt < NT; ++kt) {
        lstore(kt & 1);
        if (kt + 1 < NT) gload(kt + 1);
        __syncthreads();
        const unsigned char* sk = smem + (kt & 1) * STG; const unsigned char* sv = sk + KBYTES;
        f32x16 sacc[2];
#pragma unroll
        for (int kg = 0; kg < 2; ++kg) {
#pragma unroll
            for (int i = 0; i < 16; ++i) sacc[kg][i] = 0.f;
#pragma unroll
            for (int ks = 0; ks < KS; ++ks) {
                const bf16x8 kf = *(const bf16x8*)(sk + (kg * 32 + r) * KPITCH + ks * 32 + hh * 16);
                sacc[kg] = __builtin_amdgcn_mfma_f32_32x32x16_bf16(kf, qf[ks], sacc[kg], 0, 0, 0);
            }
        }
        float mx = sacc[0][0];
#pragma unroll
        for (int kg = 0; kg < 2; ++kg)
#pragma unroll
            for (int i = 0; i < 16; ++i) mx = fmaxf(mx, sacc[kg][i]);
        mx = fmaxf(mx, __shfl_xor(mx, 32, 64));
        const float mnew = fmaxf(mrun, mx), alpha = __builtin_amdgcn_exp2f(mrun - mnew);
        mrun = mnew;
        float psum = 0.f;
#pragma unroll
        for (int kg = 0; kg < 2; ++kg)
#pragma unroll
            for (int i = 0; i < 16; ++i) { const float p = __builtin_amdgcn_exp2f(sacc[kg][i] - mnew); sacc[kg][i] = p; psum += p; }
        lrun = lrun * alpha + psum;
#pragma unroll
        for (int t = 0; t < 2; ++t)
#pragma unroll
            for (int i = 0; i < 16; ++i) oacc[t][i] *= alpha;
#pragma unroll
        for (int kg = 0; kg < 2; ++kg)
#pragma unroll
            for (int s = 0; s < 2; ++s) {
                u32x4 pk; pk.x = pack2(sacc[kg][8 * s + 0], sacc[kg][8 * s + 1]); pk.y = pack2(sacc[kg][8 * s + 2], sacc[kg][8 * s + 3]);
                pk.z = pack2(sacc[kg][8 * s + 4], sacc[kg][8 * s + 5]); pk.w = pack2(sacc[kg][8 * s + 6], sacc[kg][8 * s + 7]);
                const bf16x8 pf = __builtin_bit_cast(bf16x8, pk);
#pragma unroll
                for (int t = 0; t < 2; ++t) {
                    const unsigned char* vrow = sv + (t * 32 + r) * VPITCH + (kg * 32 + 16 * s + 4 * hh) * 2;
                    const u32x2 lo = *(const u32x2*)vrow, hi2 = *(const u32x2*)(vrow + 16);
                    u32x4 vv; vv.x = lo.x; vv.y = lo.y; vv.z = hi2.x; vv.w = hi2.y;
                    oacc[t] = __builtin_amdgcn_mfma_f32_32x32x16_bf16(__builtin_bit_cast(bf16x8, vv), pf, oacc[t], 0, 0, 0);
                }
            }
    }
    const float inv = 1.f / (lrun + __shfl_xor(lrun, 32, 64));
    bf16_t* Ycat = (bf16_t*)(ws + WS_BUFA);
    const int zrow = b * TZ + qrow;
    float* park = (float*)(smem + ATT_PARK) + tid;
    if (MODE == 0) {
#pragma unroll
        for (int t = 0; t < 2; ++t)
#pragma unroll
            for (int i4 = 0; i4 < 4; ++i4) {
                const int dv = t * 32 + 8 * i4 + 4 * hh;
                *(u32x2*)(Ycat + (size_t)zrow * D + h * 64 + dv) = pack4(oacc[t][4 * i4] * inv, oacc[t][4 * i4 + 1] * inv, oacc[t][4 * i4 + 2] * inv, oacc[t][4 * i4 + 3] * inv);
            }
    } else if (MODE == 1) {
#pragma unroll
        for (int t = 0; t < 2; ++t)
#pragma unroll
            for (int i = 0; i < 16; ++i) park[(t * 16 + i) * NTHR] = oacc[t][i] * inv;
    } else {
        const float lam = ((const float*)(ws + WS_WSM + OFF_LAM))[l];
        const float lam_init = 0.8f - 0.6f * __expf(-0.3f * (float)l);
        float ss = 0.f;
#pragma unroll
        for (int t = 0; t < 2; ++t)
#pragma unroll
            for (int i = 0; i < 16; ++i) { const float o = park[(t * 16 + i) * NTHR] - lam * oacc[t][i] * inv; oacc[t][i] = o; ss += o * o; }
        ss += __shfl_xor(ss, 32, 64);
        const float rs = rsqrtf(ss * (1.f / 64.f) + 1e-5f) * (1.f - lam_init);
        const float* sg = c.in[38] + l * 64;
#pragma unroll
        for (int t = 0; t < 2; ++t)
#pragma unroll
            for (int i4 = 0; i4 < 4; ++i4) {
                const int dv = t * 32 + 8 * i4 + 4 * hh; const float4 g = *(const float4*)(sg + dv);
                *(u32x2*)(Ycat + (size_t)zrow * D + 768 + h * 64 + dv) = pack4(oacc[t][4 * i4] * rs * g.x, oacc[t][4 * i4 + 1] * rs * g.y, oacc[t][4 * i4 + 2] * rs * g.z, oacc[t][4 * i4 + 3] * rs * g.w);
            }
    }
}
DI void phase_attention(const Ctx& c, int l) {
    const int nu = 512 + (l == 0 ? 16 : 0);
    for (int u = blockIdx.x; u < nu; u += gridDim.x) {
        int b, h, q0, nk; bool mla;
        if (u < 512) { const int k = u & 255; b = k >> 7; h = (k >> 5) & 3; q0 = CTX + (k & 31) * 256; nk = TZ; mla = u < 256; }
        else { const int k = u - 512; b = (k >> 2) & 1; h = k & 3; q0 = 0; nk = CTX; mla = k < 8; }
        if (mla) attn_pass<0>(c, l, b, h, q0, nk);
        else { attn_pass<1>(c, l, b, h, q0, nk); attn_pass<2>(c, l, b, h, q0, nk); }
    }
}

DI int rw_tok(int dir, int i) { return dir == 0 ? i : (i < CTX ? CTX - 1 - i : TZ - 1 - (i - CTX)); }
constexpr int RW_TS = 32;
constexpr int RW_STEP_F = 6 * 64 + 2;
constexpr int RW_BUF_F = RW_TS * RW_STEP_F;
template <int CTRL> DI float dpp_add(float x) { return x + __int_as_float(__builtin_amdgcn_update_dpp(0, __float_as_int(x), CTRL, 0xf, 0xf, false)); }
DI float red16(float x) { x = dpp_add<0xB1>(x); x = dpp_add<0x4E>(x); x = dpp_add<0x141>(x); x = dpp_add<0x140>(x); return x; }
DI float red8(float x) { x = dpp_add<0xB1>(x); x = dpp_add<0x4E>(x); x = dpp_add<0x141>(x); return x; }
struct RwRegs { u32x4 r, v, kk, e, ad, kd; };
DI void rw_load(const Ctx& c, int b, int h, int dir, int chunk, int t, RwRegs& g) {
    const bf16_t* RB = (const bf16_t*)(c.ws + WS_EXPW + MX_RB); const bf16_t* VB = (const bf16_t*)(c.ws + WS_EXPW + MX_VB); const bf16_t* KKB = (const bf16_t*)(c.ws + WS_EXPW + MX_KKB);
    const bf16_t* SE = (const bf16_t*)(c.ws + WS_P + P_PR) + (size_t)dir * NZ * 256; const bf16_t* SAD = SE + (size_t)2 * NZ * 256; const bf16_t* SKD = SAD + (size_t)2 * NZ * 256;
    const int i = chunk * RW_TS + (t >> 3), z = b * TZ + rw_tok(dir, i); const size_t o = (size_t)z * 256 + h * 64 + (t & 7) * 8;
    g.r = *(const u32x4*)(RB + o); g.v = *(const u32x4*)(VB + o); g.kk = *(const u32x4*)(KKB + o);
    g.e = *(const u32x4*)(SE + o); g.ad = *(const u32x4*)(SAD + o); g.kd = *(const u32x4*)(SKD + o);
}
DI void up8(const u32x4& u, float (&f)[8]) { f[0] = lo2f(u.x); f[1] = hi2f(u.x); f[2] = lo2f(u.y); f[3] = hi2f(u.y); f[4] = lo2f(u.z); f[5] = hi2f(u.z); f[6] = lo2f(u.w); f[7] = hi2f(u.w); }
DI void rw_process(const RwRegs& g, int t, float* buf) {
    float r[8], v[8], kk[8], e[8], ad[8], kd[8];
    up8(g.r, r); up8(g.v, v); up8(g.kk, kk); up8(g.e, e); up8(g.ad, ad); up8(g.kd, kd);
    float* f = buf + (t >> 3) * RW_STEP_F + (t & 7) * 8;
    float w[8], bv[8], wr[8]; float br = 0.f, kr = 0.f;
#pragma unroll
    for (int j = 0; j < 8; ++j) { w[j] = __expf(-e[j]); bv[j] = kk[j] * ad[j]; wr[j] = w[j] * r[j]; br += bv[j] * r[j]; kr += kd[j] * r[j]; }
    *(float4*)(f) = make_float4(w[0], w[1], w[2], w[3]); *(float4*)(f + 4) = make_float4(w[4], w[5], w[6], w[7]);
    *(float4*)(f + 64) = make_float4(kk[0], kk[1], kk[2], kk[3]); *(float4*)(f + 68) = make_float4(kk[4], kk[5], kk[6], kk[7]);
    *(float4*)(f + 128) = make_float4(bv[0], bv[1], bv[2], bv[3]); *(float4*)(f + 132) = make_float4(bv[4], bv[5], bv[6], bv[7]);
    *(float4*)(f + 192) = make_float4(kd[0], kd[1], kd[2], kd[3]); *(float4*)(f + 196) = make_float4(kd[4], kd[5], kd[6], kd[7]);
    *(float4*)(f + 256) = make_float4(wr[0], wr[1], wr[2], wr[3]); *(float4*)(f + 260) = make_float4(wr[4], wr[5], wr[6], wr[7]);
    *(float4*)(f + 320) = make_float4(v[0], v[1], v[2], v[3]); *(float4*)(f + 324) = make_float4(v[4], v[5], v[6], v[7]);
    br = red8(br); kr = red8(kr);
    if ((t & 7) == 0) { float* s = buf + (t >> 3) * RW_STEP_F + 384; s[0] = br; s[1] = kr; }
}
struct RwStep { float4 w, kk, bv, kd, wr; float vv, br, kr; };
DI void rw_ld(RwStep& s, const float* f, int kq, int row) {
    s.w = *(const float4*)(f + kq * 4); s.kk = *(const float4*)(f + 64 + kq * 4); s.bv = *(const float4*)(f + 128 + kq * 4);
    s.kd = *(const float4*)(f + 192 + kq * 4); s.wr = *(const float4*)(f + 256 + kq * 4); s.vv = f[320 + row]; s.br = f[384]; s.kr = f[385];
}
DI void phase_rwkv_scan_unit(const Ctx& c, int l, int u) {
    const int rg = u & 3, chain = u >> 2, dir = chain & 1, h = (chain >> 1) & 3, b = chain >> 3;
    float* buf0 = (float*)c.smem; float* buf1 = buf0 + RW_BUF_F;
    float* ybuf = buf1 + RW_BUF_F;
    float* YO = (float*)(c.ws + WS_BUFB) + (size_t)dir * NZ * 256 + (size_t)b * TZ * 256 + h * 64 + rg * 16;
    const int wave = c.wave, lane = c.lane, rr = lane >> 4, kq = lane & 15, rl = (wave & 3) * 4 + rr, row = rg * 16 + rl;
    const int t = c.tid - 256;
    float S0 = 0.f, S1 = 0.f, S2 = 0.f, S3 = 0.f;
    constexpr int NCH = TZ / RW_TS;
    RwRegs g;
    __syncthreads();
    if (wave >= 4) { rw_load(c, b, h, dir, 0, t, g); rw_process(g, t, buf0); rw_load(c, b, h, dir, 1, t, g); }
    __syncthreads();
    for (int ch = 0; ch < NCH; ++ch) {
        float* cur = buf0 + (ch & 1) * RW_BUF_F; float* nxt = buf0 + ((ch + 1) & 1) * RW_BUF_F;
        if (wave >= 4) {
            if (ch > 0) {
                const float* yb = ybuf + ((ch - 1) & 1) * RW_TS * 16;
#pragma unroll
                for (int i = 0; i < 2; ++i) { const int e = t + i * 256, st = e >> 4, rw = e & 15; YO[(size_t)rw_tok(dir, (ch - 1) * RW_TS + st) * 256 + rw] = yb[e]; }
            }
            if (ch + 1 < NCH) rw_process(g, t, nxt);
            if (ch + 2 < NCH) rw_load(c, b, h, dir, ch + 2, t, g);
        } else {
            float* yb = ybuf + (ch & 1) * RW_TS * 16 + rl;
            RwStep s0, s1;
            rw_ld(s0, cur, kq, row);
#pragma unroll 4
            for (int st = 0; st < RW_TS; st += 2) {
                rw_ld(s1, cur + (st + 1) * RW_STEP_F, kq, row);
                {
                    float sa = -((S0 * s0.kk.x + S1 * s0.kk.y) + (S2 * s0.kk.z + S3 * s0.kk.w));
                    float q = (S0 * s0.wr.x + S1 * s0.wr.y) + (S2 * s0.wr.z + S3 * s0.wr.w);
                    sa = red16(sa); q = red16(q);
                    S0 = fmaf(sa, s0.bv.x, fmaf(S0, s0.w.x, s0.vv * s0.kd.x)); S1 = fmaf(sa, s0.bv.y, fmaf(S1, s0.w.y, s0.vv * s0.kd.y));
                    S2 = fmaf(sa, s0.bv.z, fmaf(S2, s0.w.z, s0.vv * s0.kd.z)); S3 = fmaf(sa, s0.bv.w, fmaf(S3, s0.w.w, s0.vv * s0.kd.w));
                    yb[st * 16] = q + sa * s0.br + s0.vv * s0.kr;
                }
                if (st + 2 < RW_TS) rw_ld(s0, cur + (st + 2) * RW_STEP_F, kq, row);
                {
                    float sa = -((S0 * s1.kk.x + S1 * s1.kk.y) + (S2 * s1.kk.z + S3 * s1.kk.w));
                    float q = (S0 * s1.wr.x + S1 * s1.wr.y) + (S2 * s1.wr.z + S3 * s1.wr.w);
                    sa = red16(sa); q = red16(q);
                    S0 = fmaf(sa, s1.bv.x, fmaf(S0, s1.w.x, s1.vv * s1.kd.x)); S1 = fmaf(sa, s1.bv.y, fmaf(S1, s1.w.y, s1.vv * s1.kd.y));
                    S2 = fmaf(sa, s1.bv.z, fmaf(S2, s1.w.z, s1.vv * s1.kd.z)); S3 = fmaf(sa, s1.bv.w, fmaf(S3, s1.w.w, s1.vv * s1.kd.w));
                    yb[(st + 1) * 16] = q + sa * s1.br + s1.vv * s1.kr;
                }
            }
        }
        __syncthreads();
    }
    if (wave >= 4) {
        const float* yb = ybuf + ((NCH - 1) & 1) * RW_TS * 16;
#pragma unroll
        for (int i = 0; i < 2; ++i) { const int e = t + i * 256, st = e >> 4, rw = e & 15; YO[(size_t)rw_tok(dir, (NCH - 1) * RW_TS + st) * 256 + rw] = yb[e]; }
    }
}

constexpr int LA_AN = 0, LA_RN = 8192, LA_BN = 16384, LA_KN = 24576, LA_AT = 32768, LA_BHT = 40960, LA_KHT = 49152, LA_VT = 57344,
              LA_NBA = 65536  , LA_NKA = 81920, LA_NBRT = 90112, LA_NKRT = 98304, LA_P63 = 106496;
constexpr int LA_TMT = LA_AN, LA_M1 = LA_BN, LA_W1T = LA_KN, LA_Z1 = LA_NBA;
DI int crow(int reg, int h) { return (reg & 3) + 8 * (reg >> 2) + 4 * h; }
DI void mm_tile(f32x16& acc, const unsigned char* A, int i0, const unsigned char* BT, int j0, int r, int h) {
#pragma unroll
    for (int ks = 0; ks < 4; ++ks) {
        const bf16x8 a = *(const bf16x8*)(A + (i0 + r) * 128 + ks * 32 + h * 16);
        const bf16x8 b = *(const bf16x8*)(BT + (j0 + r) * 128 + ks * 32 + h * 16);
        acc = __builtin_amdgcn_mfma_f32_32x32x16_bf16(a, b, acc, 0, 0, 0);
    }
}
DI void zero16(f32x16& a) {
#pragma unroll
    for (int i = 0; i < 16; ++i) a[i] = 0.f;
}
DI void phase_rwkv_chunk_unit(const Ctx& c, int l, int unit) {
    unsigned char* L = c.smem; unsigned char* ws = c.ws;
    const int chain = unit / RNC, ch = unit % RNC, dir = chain & 1, hd = (chain >> 1) & 3, b = chain >> 3;
    const int tid = c.tid, lane = c.lane, wave = c.wave, r = lane & 31, h = lane >> 5;
    const bf16_t* RB = (const bf16_t*)(ws + WS_EXPW + MX_RB); const bf16_t* VB = (const bf16_t*)(ws + WS_EXPW + MX_VB); const bf16_t* KKB = (const bf16_t*)(ws + WS_EXPW + MX_KKB);
    const bf16_t* SE = (const bf16_t*)(ws + WS_P + P_PR) + (size_t)dir * NZ * 256; const bf16_t* SAD = SE + (size_t)2 * NZ * 256; const bf16_t* SKD = SAD + (size_t)2 * NZ * 256;
    float* CUM = (float*)(L + LA_NBA);
    __syncthreads();
    const int t = tid >> 3, k0 = (tid & 7) * 8;
    float rr[8], vv[8], kk[8], ee[8], ad[8], kd[8];
    {
        const int z = b * TZ + rw_tok(dir, ch * RC + t); const size_t o = (size_t)z * 256 + hd * 64 + k0;
        up8(*(const u32x4*)(RB + o), rr); up8(*(const u32x4*)(VB + o), vv); up8(*(const u32x4*)(KKB + o), kk);
        up8(*(const u32x4*)(SE + o), ee); up8(*(const u32x4*)(SAD + o), ad); up8(*(const u32x4*)(SKD + o), kd);
        *(float4*)(CUM + t * 64 + k0) = make_float4(ee[0], ee[1], ee[2], ee[3]); *(float4*)(CUM + t * 64 + k0 + 4) = make_float4(ee[4], ee[5], ee[6], ee[7]);
    }
    __syncthreads();
    if (wave == 0) { float cm = 0.f;
#pragma unroll 8
        for (int i = 0; i < RC; ++i) { cm += CUM[i * 64 + lane]; CUM[i * 64 + lane] = cm; } }
    __syncthreads();
    {
        float cm[8], c63[8];
        { const float4 a = *(const float4*)(CUM + t * 64 + k0), bq = *(const float4*)(CUM + t * 64 + k0 + 4); cm[0] = a.x; cm[1] = a.y; cm[2] = a.z; cm[3] = a.w; cm[4] = bq.x; cm[5] = bq.y; cm[6] = bq.z; cm[7] = bq.w; }
        { const float4 a = *(const float4*)(CUM + 63 * 64 + k0), bq = *(const float4*)(CUM + 63 * 64 + k0 + 4); c63[0] = a.x; c63[1] = a.y; c63[2] = a.z; c63[3] = a.w; c63[4] = bq.x; c63[5] = bq.y; c63[6] = bq.z; c63[7] = bq.w; }
        float at[8], rt[8], bt[8], kt[8], bh[8], kh[8];
#pragma unroll
        for (int j = 0; j < 8; ++j) {
            const float pt = __expf(-cm[j]), pp = __expf(-(cm[j] - ee[j])), ip = __expf(cm[j]), ph = __expf(-(c63[j] - cm[j])), bb = kk[j] * ad[j];
            at[j] = -kk[j] * pp; rt[j] = rr[j] * pt; bt[j] = bb * ip; kt[j] = kd[j] * ip; bh[j] = bb * ph; kh[j] = kd[j] * ph;
        }
        u32x4 w4;
        w4.x = pack2(at[0], at[1]); w4.y = pack2(at[2], at[3]); w4.z = pack2(at[4], at[5]); w4.w = pack2(at[6], at[7]); *(u32x4*)(L + LA_AN + t * 128 + k0 * 2) = w4;
        w4.x = pack2(rt[0], rt[1]); w4.y = pack2(rt[2], rt[3]); w4.z = pack2(rt[4], rt[5]); w4.w = pack2(rt[6], rt[7]); *(u32x4*)(L + LA_RN + t * 128 + k0 * 2) = w4;
        w4.x = pack2(bt[0], bt[1]); w4.y = pack2(bt[2], bt[3]); w4.z = pack2(bt[4], bt[5]); w4.w = pack2(bt[6], bt[7]); *(u32x4*)(L + LA_BN + t * 128 + k0 * 2) = w4;
        w4.x = pack2(kt[0], kt[1]); w4.y = pack2(kt[2], kt[3]); w4.z = pack2(kt[4], kt[5]); w4.w = pack2(kt[6], kt[7]); *(u32x4*)(L + LA_KN + t * 128 + k0 * 2) = w4;
#pragma unroll
        for (int j = 0; j < 8; ++j) {
            *(bf16_t*)(L + LA_AT + (k0 + j) * 128 + t * 2) = f2bf(at[j]); *(bf16_t*)(L + LA_BHT + (k0 + j) * 128 + t * 2) = f2bf(bh[j]);
            *(bf16_t*)(L + LA_KHT + (k0 + j) * 128 + t * 2) = f2bf(kh[j]); *(bf16_t*)(L + LA_VT + (k0 + j) * 128 + t * 2) = f2bf(vv[j]);
        }
        if (t == 63) {
            float* p63 = (float*)(L + LA_P63); float* gp = (float*)(ws + WS_RW + RW_P63) + (size_t)unit * 64;
#pragma unroll
            for (int j = 0; j < 8; ++j) { const float p = __expf(-c63[j]); p63[k0 + j] = p; gp[k0 + j] = p; }
        }
    }
    __syncthreads();
    {
        const int p = wave >> 1, i0 = (wave & 1) * 32;
        const unsigned char* A = L + (p == 0 ? LA_BN : p == 1 ? LA_KN : LA_RN);
        const unsigned char* BT = L + (p < 2 ? LA_AN : p == 2 ? LA_BN : LA_KN);
#pragma unroll
        for (int jt = 0; jt < 2; ++jt) {
            const int j0 = jt * 32; f32x16 acc; zero16(acc);
            mm_tile(acc, A, i0, BT, j0, r, h);
            const int col = j0 + r;
#pragma unroll
            for (int g = 0; g < 16; ++g) {
                const int row = i0 + crow(g, h);
                if (p == 0) ((float*)(L + LA_NBA))[row * 64 + col] = (row < col) ? acc[g] : 0.f;
                else if (p == 1) *(bf16_t*)(L + LA_NKA + row * 128 + col * 2) = f2bf((row < col) ? acc[g] : 0.f);
                else *(bf16_t*)(L + (p == 2 ? LA_NBRT : LA_NKRT) + row * 128 + col * 2) = f2bf((col <= row) ? acc[g] : 0.f);
            }
        }
    }
    __syncthreads();
    if (wave == 0) {
        const float* N = (const float*)(L + LA_NBA);
        float* TC = (float*)(L + LA_BN);
#pragma unroll 1
        for (int s = 63; s >= 0; --s) {
            float a0 = (s == lane) ? 1.f : 0.f, a1 = 0.f, a2 = 0.f, a3 = 0.f;
            int j = s + 1;
#pragma unroll 1
            for (; (j & 3) != 0 && j < 64; ++j) a0 = fmaf(N[s * 64 + j], TC[j * 64 + lane], a0);
#pragma unroll 2
            for (; j < 64; j += 4) {
                const float4 n = *(const float4*)(N + s * 64 + j);
                a0 = fmaf(n.x, TC[j * 64 + lane], a0); a1 = fmaf(n.y, TC[(j + 1) * 64 + lane], a1); a2 = fmaf(n.z, TC[(j + 2) * 64 + lane], a2); a3 = fmaf(n.w, TC[(j + 3) * 64 + lane], a3);
            }
            TC[s * 64 + lane] = (a0 + a1) + (a2 + a3);
        }
        unsigned char* dst = L + LA_TMT + lane * 128;
#pragma unroll
        for (int q = 0; q < 8; ++q) {
            u32x4 w4; w4.x = pack2(TC[(q * 8) * 64 + lane], TC[(q * 8 + 1) * 64 + lane]); w4.y = pack2(TC[(q * 8 + 2) * 64 + lane], TC[(q * 8 + 3) * 64 + lane]);
            w4.z = pack2(TC[(q * 8 + 4) * 64 + lane], TC[(q * 8 + 5) * 64 + lane]); w4.w = pack2(TC[(q * 8 + 6) * 64 + lane], TC[(q * 8 + 7) * 64 + lane]);
            *(u32x4*)(dst + q * 16) = w4;
        }
    }
    __syncthreads();
    {
        const int p = wave >> 2, i0 = ((wave >> 1) & 1) * 32, j0 = (wave & 1) * 32; f32x16 acc; zero16(acc);
        if (p == 0) {
            mm_tile(acc, L + LA_TMT, i0, L + LA_AT, j0, r, h);
#pragma unroll
            for (int g4 = 0; g4 < 4; ++g4) *(u32x2*)(L + LA_M1 + (j0 + r) * 128 + (i0 + 8 * g4 + 4 * h) * 2) = pack4(acc[4 * g4], acc[4 * g4 + 1], acc[4 * g4 + 2], acc[4 * g4 + 3]);
        } else {
            mm_tile(acc, L + LA_NKA, i0, L + LA_TMT, j0, r, h);
#pragma unroll
            for (int g4 = 0; g4 < 4; ++g4) *(u32x2*)(L + LA_W1T + (j0 + r) * 128 + (i0 + 8 * g4 + 4 * h) * 2) = pack4(acc[4 * g4], acc[4 * g4 + 1], acc[4 * g4 + 2], acc[4 * g4 + 3]);
        }
    }
    __syncthreads();
    if (wave < 4) {
        const int i0 = (wave >> 1) * 32, j0 = (wave & 1) * 32; f32x16 acc; zero16(acc);
        mm_tile(acc, L + LA_W1T, i0, L + LA_VT, j0, r, h);
#pragma unroll
        for (int g4 = 0; g4 < 4; ++g4) *(u32x2*)(L + LA_Z1 + (j0 + r) * 128 + (i0 + 8 * g4 + 4 * h) * 2) = pack4(acc[4 * g4], acc[4 * g4 + 1], acc[4 * g4 + 2], acc[4 * g4 + 3]);
    }
    __syncthreads();
    {
        const int p = wave >> 1, i0 = (wave & 1) * 32;
        bf16_t* GM3 = (bf16_t*)(ws + WS_RW + RW_M3) + (size_t)unit * 4096; bf16_t* GM2 = (bf16_t*)(ws + WS_RW + RW_M2) + (size_t)unit * 4096; bf16_t* GZ5 = (bf16_t*)(ws + WS_RW + RW_Z5) + (size_t)unit * 4096;
        float* YO = (float*)(ws + WS_BUFB) + (size_t)dir * NZ * 256;
#pragma unroll
        for (int jt = 0; jt < 2; ++jt) {
            const int j0 = jt * 32; f32x16 acc; zero16(acc);
            if (p == 0) {
                mm_tile(acc, L + LA_M1, i0, L + LA_NBRT, j0, r, h);
#pragma unroll
                for (int g4 = 0; g4 < 4; ++g4) { const int tt = j0 + r, kq = i0 + 8 * g4 + 4 * h; float rv[4]; unpack4(*(const u32x2*)(L + LA_RN + tt * 128 + kq * 2), rv);
                    *(u32x2*)(GM2 + tt * 64 + kq) = pack4(acc[4 * g4] + rv[0], acc[4 * g4 + 1] + rv[1], acc[4 * g4 + 2] + rv[2], acc[4 * g4 + 3] + rv[3]); }
            } else if (p == 1) {
                mm_tile(acc, L + LA_NBRT, i0, L + LA_Z1, j0, r, h); mm_tile(acc, L + LA_NKRT, i0, L + LA_VT, j0, r, h);
#pragma unroll
                for (int g = 0; g < 16; ++g) { const int tt = i0 + crow(g, h); YO[(size_t)(b * TZ + rw_tok(dir, ch * RC + tt)) * 256 + hd * 64 + j0 + r] = acc[g]; }
            } else if (p == 2) {
                mm_tile(acc, L + LA_M1, i0, L + LA_BHT, j0, r, h);
#pragma unroll
                for (int g4 = 0; g4 < 4; ++g4) *(u32x2*)(GM3 + (j0 + r) * 64 + i0 + 8 * g4 + 4 * h) = pack4(acc[4 * g4], acc[4 * g4 + 1], acc[4 * g4 + 2], acc[4 * g4 + 3]);
            } else {
                mm_tile(acc, L + LA_BHT, i0, L + LA_Z1, j0, r, h); mm_tile(acc, L + LA_KHT, i0, L + LA_VT, j0, r, h);
#pragma unroll
                for (int g4 = 0; g4 < 4; ++g4) *(u32x2*)(GZ5 + (j0 + r) * 64 + i0 + 8 * g4 + 4 * h) = pack4(acc[4 * g4], acc[4 * g4 + 1], acc[4 * g4 + 2], acc[4 * g4 + 3]);
            }
        }
    }
}
DI void phase_rwkv_chunks(const Ctx& c, int l) {
    for (int u = blockIdx.x; u < 16 * RNC; u += gridDim.x) phase_rwkv_chunk_unit(c, l, u);
}
DI bf16x8 pack8(const f32x16& x, int s) {
    u32x4 p; p.x = pack2(x[8 * s], x[8 * s + 1]); p.y = pack2(x[8 * s + 2], x[8 * s + 3]); p.z = pack2(x[8 * s + 4], x[8 * s + 5]); p.w = pack2(x[8 * s + 6], x[8 * s + 7]);
    return __builtin_bit_cast(bf16x8, p);
}
DI bf16x8 ldfrag(const bf16_t* rowp, int s, int h) {
    const u32x2 lo = *(const u32x2*)(rowp + 16 * s + 4 * h), hi = *(const u32x2*)(rowp + 16 * s + 8 + 4 * h);
    u32x4 v; v.x = lo.x; v.y = lo.y; v.z = hi.x; v.w = hi.y; return __builtin_bit_cast(bf16x8, v);
}
constexpr int SQ_PITCH = 144, SQ_MAT = 64 * SQ_PITCH, SQ_M3 = 0, SQ_M2 = SQ_MAT, SQ_Z5 = 2 * SQ_MAT, SQ_P63 = 3 * SQ_MAT, SQ_Y = SQ_P63 + 256, SQ_STAGE = SQ_Y + 64 * 64 * 4;
DI bf16x8 ldfrag_l(const unsigned char* rowp, int s, int h) {
    const u32x2 lo = *(const u32x2*)(rowp + (16 * s + 4 * h) * 2), hi = *(const u32x2*)(rowp + (16 * s + 8 + 4 * h) * 2);
    u32x4 v; v.x = lo.x; v.y = lo.y; v.z = hi.x; v.w = hi.y; return __builtin_bit_cast(bf16x8, v);
}
struct SqRegs { u32x4 m3[2], m2[2], z5[2], p63, y[3]; };
DI void sq_gload(const Ctx& c, int chain, int ch, int dir, int b, int hd, int lt, SqRegs& g) {
    unsigned char* ws = c.ws; const size_t unit = (size_t)chain * RNC + ch;
    const unsigned char* g3 = ws + WS_RW + RW_M3 + unit * 8192; const unsigned char* g2 = ws + WS_RW + RW_M2 + unit * 8192; const unsigned char* g5 = ws + WS_RW + RW_Z5 + unit * 8192;
#pragma unroll
    for (int i = 0; i < 2; ++i) { const int id = lt + i * 384; if (id < 512) { g.m3[i] = *(const u32x4*)(g3 + id * 16); g.m2[i] = *(const u32x4*)(g2 + id * 16); g.z5[i] = *(const u32x4*)(g5 + id * 16); } }
    if (lt < 16) g.p63 = *(const u32x4*)(ws + WS_RW + RW_P63 + unit * 256 + lt * 16);
    const float* YO = (const float*)(ws + WS_BUFB) + (size_t)dir * NZ * 256 + (size_t)b * TZ * 256 + hd * 64;
#pragma unroll
    for (int i = 0; i < 3; ++i) { const int id = lt + i * 384; if (id < 1024) g.y[i] = *(const u32x4*)(YO + (size_t)rw_tok(dir, ch * RC + (id >> 4)) * 256 + (id & 15) * 4); }
}
DI void sq_lstore(unsigned char* st, int lt, const SqRegs& g) {
#pragma unroll
    for (int i = 0; i < 2; ++i) { const int id = lt + i * 384; if (id < 512) { const int row = id >> 3, part = id & 7;
        *(u32x4*)(st + SQ_M3 + row * SQ_PITCH + part * 16) = g.m3[i]; *(u32x4*)(st + SQ_M2 + row * SQ_PITCH + part * 16) = g.m2[i]; *(u32x4*)(st + SQ_Z5 + row * SQ_PITCH + part * 16) = g.z5[i]; } }
    if (lt < 16) *(u32x4*)(st + SQ_P63 + lt * 16) = g.p63;
#pragma unroll
    for (int i = 0; i < 3; ++i) { const int id = lt + i * 384; if (id < 1024) *(u32x4*)(st + SQ_Y + (id >> 4) * 256 + (id & 15) * 16) = g.y[i]; }
}
DI void sq_store_y(const Ctx& c, int ch, int dir, int b, int hd, const unsigned char* st, int lt) {
    float* YO = (float*)(c.ws + WS_BUFB) + (size_t)dir * NZ * 256 + (size_t)b * TZ * 256 + hd * 64;
#pragma unroll
    for (int i = 0; i < 3; ++i) { const int id = lt + i * 384; if (id < 1024) { const int t = id >> 4, part = id & 15;
        *(u32x4*)(YO + (size_t)rw_tok(dir, ch * RC + t) * 256 + part * 4) = *(const u32x4*)(st + SQ_Y + t * 256 + part * 16); } }
}
DI void phase_rwkv_seq_block(const Ctx& c, int l, int chain) {
    unsigned char* L = c.smem; const int lane = c.lane, wave = c.wave, r = lane & 31, h = lane >> 5;
    const int dir = chain & 1, hd = (chain >> 1) & 3, b = chain >> 3, lt = c.tid - 128, vh = wave;
    __syncthreads();
    if (wave >= 2) {
        SqRegs sg;
        sq_gload(c, chain, 0, dir, b, hd, lt, sg); sq_lstore(L, lt, sg); sq_gload(c, chain, 1, dir, b, hd, lt, sg);
        __syncthreads();
#pragma unroll 1
        for (int ch = 0; ch < RNC; ++ch) {
            unsigned char* so = L + ((ch + 1) & 1) * SQ_STAGE;
            if (ch > 0) sq_store_y(c, ch - 1, dir, b, hd, so, lt);
            if (ch + 1 < RNC) sq_lstore(so, lt, sg);
            if (ch + 2 < RNC) sq_gload(c, chain, ch + 2, dir, b, hd, lt, sg);
            __syncthreads();
        }
        sq_store_y(c, RNC - 1, dir, b, hd, L + ((RNC - 1) & 1) * SQ_STAGE, lt);
    } else {
        f32x16 x[2]; zero16(x[0]); zero16(x[1]);
        __syncthreads();
#pragma unroll 1
        for (int ch = 0; ch < RNC; ++ch) {
            unsigned char* st = L + (ch & 1) * SQ_STAGE;
            bf16x8 xb[4], xl[4];
#pragma unroll
            for (int s = 0; s < 4; ++s) {
                xb[s] = pack8(x[s >> 1], s & 1);
                float res[8];
#pragma unroll
                for (int j = 0; j < 8; ++j) res[j] = x[s >> 1][8 * (s & 1) + j] - bf2f((bf16_t)xb[s][j]);
                u32x4 p; p.x = pack2(res[0], res[1]); p.y = pack2(res[2], res[3]); p.z = pack2(res[4], res[5]); p.w = pack2(res[6], res[7]); xl[s] = __builtin_bit_cast(bf16x8, p);
            }
#pragma unroll
            for (int i = 0; i < 2; ++i) {
                f32x16 ya; zero16(ya);
#pragma unroll
                for (int s = 0; s < 4; ++s) ya = __builtin_amdgcn_mfma_f32_32x32x16_bf16(ldfrag_l(st + SQ_M2 + (32 * i + r) * SQ_PITCH, s, h), xb[s], ya, 0, 0, 0);
#pragma unroll
                for (int g = 0; g < 16; ++g) { float* yp = (float*)(st + SQ_Y) + (32 * i + crow(g, h)) * 64 + vh * 32 + r; *yp += ya[g]; }
            }
            f32x16 xn0, xn1;
#pragma unroll
            for (int i = 0; i < 2; ++i) {
                f32x16 xa;
#pragma unroll
                for (int g4 = 0; g4 < 4; ++g4) {
                    float z5[4]; unpack4(*(const u32x2*)(st + SQ_Z5 + (vh * 32 + r) * SQ_PITCH + (32 * i + 8 * g4 + 4 * h) * 2), z5);
                    const float4 p4 = *(const float4*)(st + SQ_P63 + (32 * i + 8 * g4 + 4 * h) * 4);
                    xa[4 * g4] = fmaf(p4.x, x[i][4 * g4], z5[0]); xa[4 * g4 + 1] = fmaf(p4.y, x[i][4 * g4 + 1], z5[1]);
                    xa[4 * g4 + 2] = fmaf(p4.z, x[i][4 * g4 + 2], z5[2]); xa[4 * g4 + 3] = fmaf(p4.w, x[i][4 * g4 + 3], z5[3]);
                }
#pragma unroll
                for (int s = 0; s < 4; ++s) { const bf16x8 a = ldfrag_l(st + SQ_M3 + (32 * i + r) * SQ_PITCH, s, h);
                    xa = __builtin_amdgcn_mfma_f32_32x32x16_bf16(a, xb[s], xa, 0, 0, 0); xa = __builtin_amdgcn_mfma_f32_32x32x16_bf16(a, xl[s], xa, 0, 0, 0); }
                if (i == 0) xn0 = xa; else xn1 = xa;
            }
            x[0] = xn0; x[1] = xn1;
            __syncthreads();
        }
    }
}
DI void phase_mixers2(const Ctx& c, int l) {
    const int G = gridDim.x, bid = blockIdx.x;
    if (G >= 128) {
        if (bid < 16) phase_rwkv_seq_block(c, l, bid);
        else for (int u = bid - 16; u < 2 * S5N * 4; u += G - 16) phase_s5_final_unit(c, l, u);
    } else {
        for (int u = bid; u < 16; u += G) phase_rwkv_seq_block(c, l, u);
        for (int u = bid; u < 2 * S5N * 4; u += G) phase_s5_final_unit(c, l, u);
    }
}

DI void phase_post(const Ctx& c, int l) {
    unsigned char* ws = c.ws; const int lane = c.lane;
    const float* YF = (const float*)(ws + WS_BUFB); const float* YB = YF + (size_t)NZ * 256;
    const bf16_t* RB = (const bf16_t*)(ws + WS_EXPW + MX_RB); const bf16_t* VB = (const bf16_t*)(ws + WS_EXPW + MX_VB);
    const bf16_t* SKD = (const bf16_t*)(ws + WS_P + P_PR) + (size_t)4 * NZ * 256; const bf16_t* GG = (const bf16_t*)(ws + WS_MISC + MS_GG);
    bf16_t* Ycat = (bf16_t*)(ws + WS_BUFA);
    const float* r_k = c.in[21] + l * 256; const float* lg = c.in[22] + l * 256; const float* lb = c.in[23] + l * 256;
    for (int z = blockIdx.x * 8 + c.wave; z < NZ; z += gridDim.x * 8) {
        const size_t o = (size_t)z * 256 + lane * 4;
        const float4 yf = *(const float4*)(YF + o), yb = *(const float4*)(YB + o);
        const float y0 = yf.x + yb.x, y1 = yf.y + yb.y, y2 = yf.z + yb.z, y3 = yf.w + yb.w;
        const float mean = sum16(y0 + y1 + y2 + y3) * (1.f / 64.f);
        const float d0 = y0 - mean, d1 = y1 - mean, d2 = y2 - mean, d3 = y3 - mean;
        const float var = sum16(d0 * d0 + d1 * d1 + d2 * d2 + d3 * d3) * (1.f / 64.f);
        const float rs = rsqrtf(var + 64e-5f);
        float r[4], v[4], k0[4], k1[4], gg[4];
        unpack4(*(const u32x2*)(RB + o), r); unpack4(*(const u32x2*)(VB + o), v); unpack4(*(const u32x2*)(SKD + o), k0); unpack4(*(const u32x2*)(SKD + (size_t)NZ * 256 + o), k1);
        unpack4(*(const u32x2*)(GG + o), gg);
        const float4 rk = *(const float4*)(r_k + lane * 4), g4 = *(const float4*)(lg + lane * 4), b4 = *(const float4*)(lb + lane * 4);
        const float bs = sum16(r[0] * (k0[0] + k1[0]) * rk.x + r[1] * (k0[1] + k1[1]) * rk.y + r[2] * (k0[2] + k1[2]) * rk.z + r[3] * (k0[3] + k1[3]) * rk.w);
        *(u32x2*)(Ycat + (size_t)z * D + 256 + lane * 4) = pack4((d0 * rs * g4.x + b4.x + bs * v[0]) * gg[0], (d1 * rs * g4.y + b4.y + bs * v[1]) * gg[1],
                                                                (d2 * rs * g4.z + b4.z + bs * v[2]) * gg[2], (d3 * rs * g4.w + b4.w + bs * v[3]) * gg[3]);
    }
    {
        const bf16_t* ZG = (const bf16_t*)(ws + WS_MISC + MS_ZG); const bf16_t* W = (const bf16_t*)(ws + WS_WSM + OFF_GLUT + l * SZ_GLUT);
        const float* gb = c.in[33] + l * 256;
        for (int u = blockIdx.x; u < (NZ / 256) * 2; u += gridDim.x) {
            const int mt = u / 2, nt = u % 2, r0 = mt * 256, c0 = nt * 128;
            gemm_tile<4, 0>(c, 256, [&](int i) { return ZG + (size_t)(r0 + i) * 256; }, [&](int i) { return W + (size_t)(c0 + i) * 256; }, NoHook(),
                [&](f32x4 (&acc)[4][4], int wr, int wc, int fr, int fq) {
#pragma unroll
                    for (int n = 0; n < 4; ++n) {
                        const int col = c0 + wc + n * 16 + fq * 4; const float4 bb = *(const float4*)(gb + col);
#pragma unroll
                        for (int m = 0; m < 4; ++m) {
                            const int row = r0 + wr + m * 16 + fr; const f32x4 v = acc[m][n];
                            float zg[4]; unpack4(*(const u32x2*)(ZG + (size_t)row * 256 + col), zg);
                            *(u32x2*)(Ycat + (size_t)row * D + 512 + col) = pack4(zg[0] * sigmoidf_(v[0] + bb.x), zg[1] * sigmoidf_(v[1] + bb.y), zg[2] * sigmoidf_(v[2] + bb.z), zg[3] * sigmoidf_(v[3] + bb.w));
                        }
                    }
                });
        }
    }
}

DI bool skip_mt(int l, int mt) { return l == NL - 1 && (mt % 33) == 0; }
DI void phase_merge1(const Ctx& c, int l) {
    const bf16_t* Ycat = (const bf16_t*)(c.ws + WS_BUFA); const bf16_t* W = (const bf16_t*)(c.ws + WS_WSM + OFF_WBT + l * SZ_WBT);
    const bf16_t* GT = (const bf16_t*)(c.ws + WS_GT); bf16_t* MG = (bf16_t*)(c.ws + WS_BUFB);
    if (blockIdx.x == 0 && c.tid < 32) ((unsigned*)(c.ws + WS_CTL))[CW_CNT + l * 32 + c.tid] = 0u;
    for (int u = blockIdx.x; u < (NZ / 256) * 8; u += gridDim.x) {
        const int mt = u / 8, nt = u % 8, r0 = mt * 256, c0 = nt * 128;
        if (skip_mt(l, mt)) continue;
        f32x4 macc[4][4];
#pragma unroll
        for (int m = 0; m < 4; ++m)
#pragma unroll
            for (int n = 0; n < 4; ++n) macc[m][n] = (f32x4){0.f, 0.f, 0.f, 0.f};
        gemm_tile<4, 256>(c, 1024, [&](int i) { return Ycat + (size_t)(r0 + i) * D; }, [&](int i) { return W + (size_t)(c0 + i) * D; },
            [&](f32x4 (&acc)[4][4], int seg, int wr, int wc, int fr, int fq) {
#pragma unroll
                for (int m = 0; m < 4; ++m)
#pragma unroll
                    for (int n = 0; n < 4; ++n) {
                        float g[4]; unpack4(*(const u32x2*)(GT + (size_t)(r0 + wr + m * 16 + fr) * 4096 + seg * 1024 + c0 + wc + n * 16 + fq * 4), g);
                        macc[m][n][0] += g[0] * acc[m][n][0]; macc[m][n][1] += g[1] * acc[m][n][1]; macc[m][n][2] += g[2] * acc[m][n][2]; macc[m][n][3] += g[3] * acc[m][n][3];
                        acc[m][n] = (f32x4){0.f, 0.f, 0.f, 0.f};
                    }
            },
            [&](f32x4 (&)[4][4], int wr, int wc, int fr, int fq) {
#pragma unroll
                for (int m = 0; m < 4; ++m)
#pragma unroll
                    for (int n = 0; n < 4; ++n)
                        *(u32x2*)(MG + (size_t)(r0 + wr + m * 16 + fr) * D + c0 + wc + n * 16 + fq * 4) = pack4(macc[m][n][0], macc[m][n][1], macc[m][n][2], macc[m][n][3]);
            });
    }
}
DI void phase_merge2(const Ctx& c, int l) {
    const bf16_t* MG = (const bf16_t*)(c.ws + WS_BUFB); const bf16_t* W = (const bf16_t*)(c.ws + WS_WSM + OFF_WOUTT + l * SZ_WOUTT);
    float* H = (float*)(c.ws + WS_H); const float* modv = (const float*)(c.ws + WS_WSM + OFF_MODV);
    for (int u = blockIdx.x; u < (NZ / 256) * 8; u += gridDim.x) {
        const int mt = u / 8, nt = u % 8, r0 = mt * 256, c0 = nt * 128;
        if (skip_mt(l, mt)) continue;
        const int sel = (mt % 33) == 0 ? 2 : mt / 33;
        gemm_tile<4, 0>(c, 1024, [&](int i) { return MG + (size_t)(r0 + i) * D; }, [&](int i) { return W + (size_t)(c0 + i) * D; }, NoHook(),
            [&](f32x4 (&acc)[4][4], int wr, int wc, int fr, int fq) {
#pragma unroll
                for (int n = 0; n < 4; ++n) {
                    const int col = c0 + wc + n * 16 + fq * 4; const float4 m2 = *(const float4*)(modv + ((size_t)l * 3 + sel) * 6144 + 2 * 1024 + col);
#pragma unroll
                    for (int m = 0; m < 4; ++m) {
                        float4* hp = (float4*)(H + (size_t)(r0 + wr + m * 16 + fr) * D + col); float4 hv = *hp; const f32x4 v = acc[m][n];
                        hv.x += m2.x * v[0]; hv.y += m2.y * v[1]; hv.z += m2.z * v[2]; hv.w += m2.w * v[3]; *hp = hv;
                    }
                }
            });
    }
}

DI void phase_norm2_route(const Ctx& c, int l) {
    unsigned char* ws = c.ws; const int lane = c.lane;
    const float* modv = (const float*)(ws + WS_WSM + OFF_MODV); const float* H = (const float*)(ws + WS_H);
    bf16_t* XN = (bf16_t*)(ws + WS_BUFA); const float* g2 = c.in[7] + l * 1024;
    const float* rwt = (const float*)(ws + WS_WSM + OFF_RWT) + (size_t)l * 36 * 1024;
    const float* bg = c.in[42] + l * 4; const float* be = c.in[44] + l * 32;
    unsigned* cnt = (unsigned*)(ws + WS_CTL) + CW_CNT + l * 32;
    int* list = (int*)(ws + WS_GT + GT_LIST); float* lw = (float*)(ws + WS_GT + GT_LW);
    for (int row = blockIdx.x * 8 + c.wave; row < NZ; row += gridDim.x * 8) {
        const int b = row / TZ, s = row % TZ, sel = s < CTX ? 2 : b;
        if (l == NL - 1 && s < CTX) continue;
        float x[16]; float ss = 0.f;
#pragma unroll
        for (int q = 0; q < 4; ++q) { const float4 v = *(const float4*)(H + (size_t)row * D + q * 256 + lane * 4); x[q * 4] = v.x; x[q * 4 + 1] = v.y; x[q * 4 + 2] = v.z; x[q * 4 + 3] = v.w;
            ss += v.x * v.x + v.y * v.y + v.z * v.z + v.w * v.w; }
        ss = wave_sum(ss);
        const float rs = rsqrtf(ss * (1.f / 1024.f) + 1e-6f);
#pragma unroll
        for (int q = 0; q < 4; ++q) {
            const int col = q * 256 + lane * 4;
            const float4 g = *(const float4*)(g2 + col), m3 = *(const float4*)(modv + ((size_t)l * 3 + sel) * 6144 + 3 * 1024 + col), m4 = *(const float4*)(modv + ((size_t)l * 3 + sel) * 6144 + 4 * 1024 + col);
            x[q * 4] = x[q * 4] * rs * g.x * (1.f + m4.x) + m3.x; x[q * 4 + 1] = x[q * 4 + 1] * rs * g.y * (1.f + m4.y) + m3.y;
            x[q * 4 + 2] = x[q * 4 + 2] * rs * g.z * (1.f + m4.z) + m3.z; x[q * 4 + 3] = x[q * 4 + 3] * rs * g.w * (1.f + m4.w) + m3.w;
            *(u32x2*)(XN + (size_t)row * D + col) = pack4(x[q * 4], x[q * 4 + 1], x[q * 4 + 2], x[q * 4 + 3]);
        }
        volatile float* wl = (volatile float*)(c.smem) + c.wave * 64;
#pragma unroll 1
        for (int e = 0; e < 36; ++e) {
            float a = 0.f;
#pragma unroll
            for (int q = 0; q < 4; ++q) { const float4 w = *(const float4*)(rwt + (size_t)e * 1024 + q * 256 + lane * 4); a += x[q * 4] * w.x + x[q * 4 + 1] * w.y + x[q * 4 + 2] * w.z + x[q * 4 + 3] * w.w; }
            a = wave_sum(a) + (e < 4 ? bg[e] : be[e - 4]);
            if (lane == 0) wl[e] = a;
        }
        __builtin_amdgcn_wave_barrier();
        float lg[36];
#pragma unroll
        for (int e = 0; e < 36; ++e) lg[e] = wl[e];
        __builtin_amdgcn_wave_barrier();
        float gl[4]; float gm = -1e30f;
#pragma unroll
        for (int g = 0; g < 4; ++g) { gl[g] = lg[g]; gm = fmaxf(gm, gl[g]); }
        float gs = 0.f; int gsel = 0; float gbest = -1e30f;
#pragma unroll
        for (int g = 0; g < 4; ++g) { gs += __expf(gl[g] - gm); if (gl[g] > gbest) { gbest = gl[g]; gsel = g; } }
        const float pg = __expf(gbest - gm) / gs;
        float l1 = -1e30f, l2 = -1e30f; int e1 = 0, e2 = 0;
#pragma unroll
        for (int e = 0; e < 32; ++e) {
            const float v = lg[4 + e];
            if ((e >> 3) == gsel) {
                if (v > l1) { l2 = l1; e2 = e1; l1 = v; e1 = e; }
                else if (v > l2) { l2 = v; e2 = e; }
            }
        }
        const float t = __expf(l2 - l1), w1 = pg / (1.f + t), w2 = pg * t / (1.f + t);
        if (lane == 0) {
            const unsigned p1 = atomicAdd(&cnt[e1], 1u); list[(size_t)e1 * MOE_CAP + p1] = row * 2; lw[(size_t)e1 * MOE_CAP + p1] = w1;
            const unsigned p2 = atomicAdd(&cnt[e2], 1u); list[(size_t)e2 * MOE_CAP + p2] = row * 2 + 1; lw[(size_t)e2 * MOE_CAP + p2] = w2;
        }
    }
    phase_expert_convert(c, l);
}

DI void moe_prefix(const Ctx& c, int l, int* tiles  , int* cnts  ) {
    __syncthreads();
    if (c.tid == 0) {
        const unsigned* cnt = (const unsigned*)(c.ws + WS_CTL) + CW_CNT + l * 32; int acc = 0;
        for (int e = 0; e < 32; ++e) { const int n = (int)__hip_atomic_load(cnt + e, __ATOMIC_RELAXED, __HIP_MEMORY_SCOPE_AGENT); cnts[e] = n; tiles[e] = acc; acc += (n + 127) / 128; }
        tiles[32] = acc;
    }
    __syncthreads();
}
DI void phase_moe1(const Ctx& c, int l) {
    unsigned char* ws = c.ws;
    int* tiles = (int*)(c.smem + 120 * 1024); int* cnts = tiles + 40;
    moe_prefix(c, l, tiles, cnts);
    const bf16_t* XN = (const bf16_t*)(ws + WS_BUFA); bf16_t* HM = (bf16_t*)(ws + WS_GT + GT_HM); const int* list = (const int*)(ws + WS_GT + GT_LIST);
    const int nt_total = tiles[32];
    for (int u = blockIdx.x; u < nt_total * 4; u += gridDim.x) {
        const int mtg = u >> 2, nt = u & 3;
        int e = 0;
        for (int k = 1; k < 32; ++k) if (tiles[k] <= mtg) e = k;
        const int mt = mtg - tiles[e], n_e = cnts[e];
        const int* le = list + (size_t)e * MOE_CAP;
        const bf16_t* W = (const bf16_t*)(ws + WS_EXPW + (size_t)e * SZ_WGU);
        gemm_tile<2, 0>(c, 1024,
            [&](int i) { int p = mt * 128 + i; if (p >= n_e) p = n_e - 1; return XN + (size_t)(le[p] >> 1) * D; },
            [&](int i) { return W + (size_t)(nt * 256 + i) * D; }, NoHook(),
            [&](f32x4 (&acc)[4][4], int wr, int wc, int fr, int fq) {
#pragma unroll
                for (int np = 0; np < 2; ++np) {
                    const int hc = (nt * 256 + wc + np * 32) / 2 + fq * 4;
#pragma unroll
                    for (int m = 0; m < 4; ++m) {
                        const int p = mt * 128 + wr + m * 16 + fr;
                        const f32x4 g = acc[m][np * 2], uu = acc[m][np * 2 + 1];
                        *(u32x2*)(HM + ((size_t)mtg * 128 + wr + m * 16 + fr) * 512 + hc) = pack4(siluf_(g[0]) * uu[0], siluf_(g[1]) * uu[1], siluf_(g[2]) * uu[2], siluf_(g[3]) * uu[3]);
                        (void)p;
                    }
                }
            });
    }
}
DI void phase_moe2(const Ctx& c, int l) {
    unsigned char* ws = c.ws;
    int* tiles = (int*)(c.smem + 120 * 1024); int* cnts = tiles + 40;
    moe_prefix(c, l, tiles, cnts);
    const bf16_t* HM = (const bf16_t*)(ws + WS_GT + GT_HM); const int* list = (const int*)(ws + WS_GT + GT_LIST); const float* lw = (const float*)(ws + WS_GT + GT_LW);
    bf16_t* Y2 = (bf16_t*)(ws + WS_P);
    const int nt_total = tiles[32];
    for (int u = blockIdx.x; u < nt_total * 4; u += gridDim.x) {
        const int mtg = u >> 2, nt = u & 3;
        int e = 0;
        for (int k = 1; k < 32; ++k) if (tiles[k] <= mtg) e = k;
        const int mt = mtg - tiles[e], n_e = cnts[e];
        const int* le = list + (size_t)e * MOE_CAP; const float* lwe = lw + (size_t)e * MOE_CAP;
        const bf16_t* W = (const bf16_t*)(ws + WS_EXPW + 32 * SZ_WGU + (size_t)e * SZ_WD);
        gemm_tile<2, 0>(c, 512,
            [&](int i) { return HM + ((size_t)mtg * 128 + i) * 512; },
            [&](int i) { return W + (size_t)(nt * 256 + i) * 512; }, NoHook(),
            [&](f32x4 (&acc)[4][4], int wr, int wc, int fr, int fq) {
#pragma unroll
                for (int m = 0; m < 4; ++m) {
                    const int p = mt * 128 + wr + m * 16 + fr;
                    if (p < n_e) {
                        const int ent = le[p]; const float wt = lwe[p];
                        bf16_t* yrow = Y2 + ((size_t)(ent & 1) * NZ + (ent >> 1)) * D + nt * 256 + wc + fq * 4;
#pragma unroll
                        for (int n = 0; n < 4; ++n) *(u32x2*)(yrow + n * 16) = pack4(wt * acc[m][n][0], wt * acc[m][n][1], wt * acc[m][n][2], wt * acc[m][n][3]);
                    }
                }
            });
    }
}

constexpr int LDS_BYTES = 128 * 1024;
constexpr int STEPS_PER_LAYER = 12, N_STEPS = 2 + NL * STEPS_PER_LAYER;
#ifndef FUSED
#define FUSED 1
#endif

DI const void* launder_ptr(const void* p) {
    const unsigned long long v = (unsigned long long)p;
    unsigned lo = __builtin_amdgcn_readfirstlane((unsigned)v), hi = __builtin_amdgcn_readfirstlane((unsigned)(v >> 32));
    asm volatile("" : "+s"(lo), "+s"(hi) :: "memory");
    return (const void*)(((unsigned long long)hi << 32) | lo);
}
template <int KIND> DI void run_step(const Ctx& c0, int l) {
#ifdef PHM
    if (!((PHM >> KIND) & 1)) return;
#endif
    Ctx c = c0;
    { int z = 0; asm volatile("" : "+s"(z) :: "memory"); c.in = c0.in + z; c.ws = c0.ws + z; c.out = c0.out + z; }
    { int t = c0.tid; asm volatile("" : "+v"(t)); c.tid = t; c.lane = t & 63; c.wave = __builtin_amdgcn_readfirstlane(t >> 6); }
    if (KIND == 0) phase_prologue(c);
    if (KIND == 1) phase_norm1(c, l);
    if (KIND == 2) phase_inproj(c, l);
    if (KIND == 3) { phase_prep(c, l); phase_s5_local(c, l); }
    if (KIND == 4) { phase_small_gemms(c, l); phase_s5_carry(c, l); }
    if (KIND == 5) { phase_attention(c, l); phase_rwkv_chunks(c, l); }
    if (KIND == 6) phase_mixers2(c, l);
    if (KIND == 7) phase_post(c, l);
    if (KIND == 8) phase_merge1(c, l);
    if (KIND == 9) phase_merge2(c, l);
    if (KIND == 10) phase_norm2_route(c, l);
    if (KIND == 11) phase_moe1(c, l);
    if (KIND == 12) phase_moe2(c, l);
    if (KIND == 13) phase_final(c);
}

#if !FUSED
template <int KIND> __global__ void __launch_bounds__(NTHR, 2) k_step(Args a) {
    extern __shared__ __attribute__((aligned(16))) unsigned char lds[];
    Ctx c; c.in = a.in; c.out = a.out; c.ws = a.ws; c.smem = lds; c.tid = threadIdx.x; c.lane = threadIdx.x & 63; c.wave = __builtin_amdgcn_readfirstlane(threadIdx.x >> 6);
    run_step<KIND>(c, a.s_lo);
}
template <int KIND> static void launch_step(const Args& a, int grid, hipStream_t stream) {
    static bool attr = false;
    if (!attr) { (void)hipFuncSetAttribute((const void*)k_step<KIND>, hipFuncAttributeMaxDynamicSharedMemorySize, LDS_BYTES); attr = true; }
    hipLaunchKernelGGL(k_step<KIND>, dim3(grid), dim3(NTHR), LDS_BYTES, stream, a);
}
#else
__global__ void __launch_bounds__(NTHR, 2) fwd_kernel(Args a) {
    extern __shared__ __attribute__((aligned(16))) unsigned char lds[];
    Ctx c; c.in = a.in; c.out = a.out; c.ws = a.ws; c.smem = lds; c.tid = threadIdx.x; c.lane = threadIdx.x & 63; c.wave = __builtin_amdgcn_readfirstlane(threadIdx.x >> 6);
    volatile LAS unsigned* xbw = (volatile LAS unsigned*)(lds + LDS_BYTES - 16);
    if (threadIdx.x == 0) { xbw[0] = 0u; xbw[1] = 0u; }
    __syncthreads();
    XcdBarrier bar = xcd_barrier_post((unsigned*)(a.ws + WS_CTL) + CW_BAR, xbw);
#ifndef REP_MASK
#define REP_MASK 0
#endif
#define STEP(K, L) do { run_step<K>(c, L); xcd_barrier(bar); if ((REP_MASK >> K) & 1) { run_step<K>(c, L); xcd_barrier(bar); } } while (0)
    STEP(0, 0);
    for (int l = 0; l < NL; ++l) {
        STEP(1, l); STEP(2, l); STEP(3, l); STEP(4, l); STEP(5, l); STEP(6, l); STEP(7, l); STEP(8, l); STEP(9, l); STEP(10, l); STEP(11, l); STEP(12, l);
    }
#undef STEP
    run_step<13>(c, 0);
}
#endif

extern "C" void kernel_launch(void* const* d_in, const int* in_sizes, int n_in, void* d_out, int out_size, void* d_ws, size_t ws_size, hipStream_t stream) {
    static int grid = 0;
    if (grid == 0) {
        if (n_in != 49 || out_size != NB * SEQ * D || ws_size < WS_END) { fprintf(stderr, "kernel_launch: unexpected problem (n_in %d out %d ws %zu need %zu)\n", n_in, out_size, ws_size, (size_t)WS_END); grid = -1; return; }
        int dev = 0, cus = 0;
        if (hipGetDevice(&dev) != hipSuccess || hipDeviceGetAttribute(&cus, hipDeviceAttributeMultiprocessorCount, dev) != hipSuccess) { grid = -1; return; }
#if FUSED
        int per_cu = 0;
        if (hipFuncSetAttribute((const void*)fwd_kernel, hipFuncAttributeMaxDynamicSharedMemorySize, LDS_BYTES) != hipSuccess) { fprintf(stderr, "kernel_launch: hipFuncSetAttribute failed\n"); grid = -1; return; }
        if (hipOccupancyMaxActiveBlocksPerMultiprocessor(&per_cu, (const void*)fwd_kernel, NTHR, LDS_BYTES) != hipSuccess || per_cu < 1) { fprintf(stderr, "kernel_launch: occupancy query says %d\n", per_cu); }
        (void)hipGetLastError();
#endif
        grid = cus;
    }
    if (grid < 0) return;
    (void)hipMemsetAsync((char*)d_ws + WS_CTL, 0, CTL_BYTES, stream);
    Args a{};
    for (int i = 0; i < 49; ++i) a.in[i] = (const float*)d_in[i];
    a.out = (float*)d_out; a.ws = (unsigned char*)d_ws;
#if !FUSED
    a.s_lo = 0; a.s_hi = 0; launch_step<0>(a, grid, stream);
    for (int l = 0; l < NL; ++l) {
        a.s_lo = l;
        launch_step<1>(a, grid, stream); launch_step<2>(a, grid, stream); launch_step<3>(a, grid, stream); launch_step<4>(a, grid, stream);
        launch_step<5>(a, grid, stream); launch_step<6>(a, grid, stream); launch_step<7>(a, grid, stream); launch_step<8>(a, grid, stream);
        launch_step<9>(a, grid, stream); launch_step<10>(a, grid, stream); launch_step<11>(a, grid, stream); launch_step<12>(a, grid, stream);
    }
    a.s_lo = 0; launch_step<13>(a, grid, stream);
#else
    a.s_lo = 0; a.s_hi = N_STEPS; hipLaunchKernelGGL(fwd_kernel, dim3(grid), dim3(NTHR), LDS_BYTES, stream, a);
#endif
}
```

```cpp
#include <hip/hip_runtime.h>
#include <stdint.h>
#include <stdio.h>

#define DI __device__ __forceinline__
#define LAS __attribute__((address_space(3)))
typedef unsigned short bf16_t;
typedef short bf16x8 __attribute__((ext_vector_type(8)));
typedef short s16x4 __attribute__((ext_vector_type(4)));
typedef float f32x4 __attribute__((ext_vector_type(4)));
typedef float f32x16 __attribute__((ext_vector_type(16)));
typedef float f32x2 __attribute__((ext_vector_type(2)));
typedef __bf16 bf16x2v __attribute__((ext_vector_type(2)));
typedef unsigned u32x4 __attribute__((ext_vector_type(4)));
typedef unsigned u32x2 __attribute__((ext_vector_type(2)));

constexpr int D = 1024, NB = 2, SEQ = 8192, CTX = 256, TZ = 8448, NZ = 16896, NL = 2;
constexpr int NIN = 6560, NINP = 6656;
constexpr int NTHR = 512;
constexpr float LOG2E = 1.4426950408889634f;

#define XB_TMO      128
#define XB_XCNT(j)  (256  + 64 * (j))
#define XB_XSUB(j)  (1280 + 64 * (j))
#define XB_XGEN(j)  (2304 + 64 * (j))
#define XB_TOP      3328
#define XB_TOPGEN   3392
#define XCD_BAR_WORDS 3456
#define XB_SPIN_CAP (1u << 18)

__device__ __forceinline__ unsigned xb_ld(unsigned* p)              { return __hip_atomic_load(p, __ATOMIC_RELAXED, __HIP_MEMORY_SCOPE_AGENT); }
__device__ __forceinline__ unsigned xb_add(unsigned* p, unsigned v) { return __hip_atomic_fetch_add(p, v, __ATOMIC_RELAXED, __HIP_MEMORY_SCOPE_AGENT); }
__device__ __forceinline__ unsigned xb_xcc_id() { return (unsigned)__builtin_amdgcn_s_getreg((3 << 11) | 20) & 0xFu; }
#define XB_SPIN(cond, bar) do { unsigned _sp = 0; while (cond) { __builtin_amdgcn_s_sleep(1); \
    if ((++_sp & 255u) == 0u) { if (xb_ld(&(bar)[XB_TMO])) break; if (_sp > XB_SPIN_CAP) { atomicAdd(&(bar)[XB_TMO], 1u); break; } } } } while (0)

struct XcdBarrier { unsigned* bar; unsigned x; volatile LAS unsigned* st; };

__device__ __forceinline__ XcdBarrier xcd_barrier_post(unsigned* bar, volatile LAS unsigned* st) {
    XcdBarrier b; b.bar = bar; b.x = xb_xcc_id(); b.st = st;
    if (threadIdx.x == 0) (void)xb_add(&bar[XB_XCNT(b.x)], 1u);
    return b;
}
__device__ __forceinline__ void xcd_barrier_complete(unsigned* bar, unsigned x, unsigned& nloc, unsigned& nx) {
    const unsigned G = gridDim.x * gridDim.y * gridDim.z;
    unsigned sum, cnt, mine, sp = 0u;
    for (;;) {
        sum = 0u; cnt = 0u; mine = 0u;
#pragma unroll
        for (unsigned j = 0; j < 16; ++j) { const unsigned c = xb_ld(&bar[XB_XCNT(j)]); sum += c; cnt += (c > 0u) ? 1u : 0u; mine = (j == x) ? c : mine; }
        if (sum == G) break;
        __builtin_amdgcn_s_sleep(1);
        if ((++sp & 255u) == 0u) { if (xb_ld(&bar[XB_TMO])) break; if (sp > XB_SPIN_CAP) { atomicAdd(&bar[XB_TMO], 1u); break; } }
    }
    nloc = mine > 0u ? mine : 1u; nx = cnt > 0u ? cnt : 1u;
}
__device__ __forceinline__ void xcd_barrier(const XcdBarrier& b) {
    asm volatile("s_waitcnt vmcnt(0)" ::: "memory");
    __syncthreads();
    if (threadIdx.x == 0) {
        unsigned* bar = b.bar;
        __builtin_amdgcn_s_waitcnt(0);
        unsigned nloc = b.st[0], nx = b.st[1];
        if (nloc == 0u) { xcd_barrier_complete(bar, b.x, nloc, nx); b.st[0] = nloc; b.st[1] = nx; }
        const unsigned old = xb_add(&bar[XB_XSUB(b.x)], 1u);
        const unsigned gen = old / nloc;
        if (old + 1u == (gen + 1u) * nloc) {
            __builtin_amdgcn_fence(__ATOMIC_RELEASE, "agent");
            asm volatile("s_waitcnt vmcnt(0)" ::: "memory");
            const unsigned og = xb_add(&bar[XB_TOP], 1u);
            const unsigned tg = og / nx;
            if (og + 1u == (tg + 1u) * nx) xb_add(&bar[XB_TOPGEN], 1u);
            else XB_SPIN(xb_ld(&bar[XB_TOPGEN]) == tg, bar);
            __builtin_amdgcn_fence(__ATOMIC_ACQUIRE, "agent");
            xb_add(&bar[XB_XGEN(b.x)], 1u);
            asm volatile("s_waitcnt vmcnt(0)" ::: "memory");
        } else {
            XB_SPIN(xb_ld(&bar[XB_XGEN(b.x)]) == gen, bar);
            __builtin_amdgcn_fence(__ATOMIC_ACQUIRE, "agent");
            asm volatile("s_waitcnt vmcnt(0)" ::: "memory");
        }
    }
    __syncthreads();
}

DI float bf2f(bf16_t v) { return __uint_as_float((unsigned)v << 16); }
DI unsigned pack2(float a, float b) { f32x2 v = {a, b}; bf16x2v r = __builtin_convertvector(v, bf16x2v); return __builtin_bit_cast(unsigned, r); }
DI bf16_t f2bf(float a) { return (bf16_t)(pack2(a, 0.f) & 0xffffu); }
DI float lo2f(unsigned u) { return __uint_as_float(u << 16); }
DI float hi2f(unsigned u) { return __uint_as_float(u & 0xffff0000u); }
DI float wave_sum(float v) {
#pragma unroll
    for (int m = 32; m >= 1; m >>= 1) v += __shfl_xor(v, m, 64);
    return v;
}
DI float sum16(float v) {
#pragma unroll
    for (int m = 8; m >= 1; m >>= 1) v += __shfl_xor(v, m, 64);
    return v;
}
DI float sigmoidf_(float x) { return 1.f / (1.f + __expf(-x)); }
DI float siluf_(float x) { return x / (1.f + __expf(-x)); }
DI float gelu_tanh(float x) { const float u = 0.7978845608028654f * (x + 0.044715f * x * x * x); return 0.5f * x * (1.f + tanhf(u)); }
DI void unpack4(u32x2 u, float (&f)[4]) { f[0] = lo2f(u.x); f[1] = hi2f(u.x); f[2] = lo2f(u.y); f[3] = hi2f(u.y); }
DI u32x2 pack4(float a, float b, float c, float d) { u32x2 r; r.x = pack2(a, b); r.y = pack2(c, d); return r; }

constexpr size_t algn(size_t x) { return (x + 255) & ~(size_t)255; }
constexpr size_t WS_CTL   = 0;
constexpr size_t CTL_BYTES = 64 * 1024;
constexpr size_t WS_H     = WS_CTL + CTL_BYTES;
constexpr size_t WS_WSM   = WS_H + (size_t)NZ * D * 4;
constexpr size_t SZ_WINT = (size_t)NINP * D * 2, SZ_WUQT = 384 * 256 * 2, SZ_WUKVT = 512 * 128 * 2, SZ_W2T = 512 * 64 * 2, SZ_A2T = 512 * 64 * 2,
                 SZ_G2T = 256 * 128 * 2, SZ_GLUT = 256 * 256 * 2, SZ_WBT = (size_t)D * D * 2, SZ_WOUTT = (size_t)D * D * 2;
constexpr size_t OFF_WINT = 0, OFF_WUQT = OFF_WINT + NL * SZ_WINT, OFF_WUKVT = OFF_WUQT + NL * SZ_WUQT, OFF_W2T = OFF_WUKVT + NL * SZ_WUKVT,
                 OFF_A2T = OFF_W2T + NL * SZ_W2T, OFF_G2T = OFF_A2T + NL * SZ_A2T, OFF_GLUT = OFF_G2T + NL * SZ_G2T, OFF_WBT = OFF_GLUT + NL * SZ_GLUT,
                 OFF_WOUTT = OFF_WBT + NL * SZ_WBT, OFF_MODV = OFF_WOUTT + NL * SZ_WOUTT,
                 OFF_ROPE = OFF_MODV + (size_t)NL * 3 * 6144 * 4,
                 OFF_S5T = OFF_ROPE + (size_t)SEQ * 16 * 2 * 4,
                 OFF_RWT = OFF_S5T + (size_t)NL * 2 * 16 * 64 * 36 * 4,
                 OFF_LAM = OFF_RWT + (size_t)NL * 36 * 1024 * 4,
                 OFF_S5E = OFF_LAM + 256,
                 OFF_S5C = OFF_S5E,
                 WSM_BYTES = algn(OFF_S5E + (size_t)2 * 2 * 16 * 132 * 64 * 2 * 4);
constexpr size_t WS_EXPW  = WS_WSM + WSM_BYTES;
constexpr size_t SZ_WGU = (size_t)1024 * 1024 * 2, SZ_WD = (size_t)1024 * 512 * 2;
constexpr size_t EXPW_BYTES = 32 * (SZ_WGU + SZ_WD);
constexpr size_t SZ_QM = (size_t)NB * 4 * TZ * 96 * 2, SZ_VMT = (size_t)NB * 4 * 64 * TZ * 2, SZ_QD = (size_t)NB * 4 * TZ * 64 * 2, SZ_R256 = (size_t)NZ * 256 * 2;
constexpr size_t MX_QM = 0, MX_KM = MX_QM + SZ_QM, MX_VMT = MX_KM + SZ_QM, MX_QD = MX_VMT + SZ_VMT, MX_KD = MX_QD + SZ_QD, MX_VDT = MX_KD + SZ_QD,
                 MX_RB = MX_VDT + SZ_VMT, MX_KB = MX_RB + SZ_R256, MX_VB = MX_KB + SZ_R256, MX_KKB = MX_VB + SZ_R256, MX_END = MX_KKB + SZ_R256;
static_assert(MX_END <= EXPW_BYTES, "mixer operands must fit the expert-weight region");
constexpr size_t WS_BUFA  = WS_EXPW + EXPW_BYTES;
constexpr size_t WS_BUFB  = WS_BUFA + (size_t)NZ * D * 2;
constexpr size_t WS_P     = WS_BUFB + (size_t)NZ * D * 2;
constexpr size_t P_PM = 0, P_PS = P_PM + (size_t)NZ * 416 * 2, P_PR = P_PS + (size_t)NZ * 256 * 2, P_PD = P_PR + (size_t)NZ * 1024 * 2, P_BYTES = P_PD + (size_t)NZ * 768 * 2;
static_assert((size_t)6 * SZ_R256 <= (size_t)NZ * (1024 + 768) * 2, "scan operands must fit PR|PD");
static_assert((size_t)2 * NZ * D * 2 <= P_BYTES, "the MoE outputs (2 x bf16 [NZ][D]) must fit the P region");
constexpr size_t WS_GT    = WS_P + P_BYTES;
constexpr size_t GT_BYTES = (size_t)NZ * 4096 * 2;
constexpr int MOE_CAP = 33792;
constexpr size_t GT_HM = 0, GT_LIST = GT_HM + (size_t)(33792 + 32 * 128) * 512 * 2, GT_LW = GT_LIST + (size_t)32 * MOE_CAP * 4, GT_END = GT_LW + (size_t)32 * MOE_CAP * 4;
static_assert(GT_END <= GT_BYTES, "MoE scratch must fit the gate region");
constexpr size_t WS_MISC  = WS_GT + GT_BYTES;
constexpr size_t MS_CQN = 0, MS_TW = MS_CQN + (size_t)NZ * 384 * 2, MS_AL = MS_TW + (size_t)NZ * 64 * 2, MS_SG = MS_AL + (size_t)NZ * 64 * 2,
                 MS_GG = MS_SG + (size_t)NZ * 128 * 2, MS_ZG = MS_GG + SZ_R256, MS_END = MS_ZG + SZ_R256;
constexpr size_t WS_RW    = WS_MISC + MS_END;
constexpr int RC = 64, RNC = TZ / RC;
constexpr size_t SZ_RWM = (size_t)16 * RNC * 4096 * 2;
constexpr size_t RW_M3 = 0, RW_M2 = SZ_RWM, RW_Z5 = 2 * SZ_RWM, RW_P63 = 3 * SZ_RWM, RW_END = RW_P63 + (size_t)16 * RNC * 64 * 4;
constexpr size_t WS_END   = WS_RW + RW_END;

constexpr int CW_BAR = 0;
constexpr int CW_CNT = 4096;

struct Args { const float* in[49]; float* out; unsigned char* ws; int s_lo, s_hi; };

struct Ctx {
    const float* const* in; float* out; unsigned char* ws; unsigned char* smem; int tid, lane, wave;
};

template <int WM> struct GCfg { static constexpr int WN = 8 / WM, BM = 64 * WM, BN = 64 * WN, ABYTES = BM * 64, BBYTES = BN * 64, STAGE = ABYTES + BBYTES; };

template <int WM, int SEGK, class ARow, class BRow, class Hook, class Epi>
DI void gemm_tile(const Ctx& c, int K, ARow arow, BRow brow, Hook hook, Epi epi) {
    typedef GCfg<WM> G;
    const int tid = c.tid, lane = c.lane, wave = c.wave;
    const int wm = wave / G::WN, wn = wave % G::WN, fr = lane & 15, fq = lane >> 4;
    unsigned char* smem = c.smem;
    constexpr int NA = G::BM / 128, NBq = G::BN / 128;
    const bf16_t* asrc[NA]; const bf16_t* bsrc[NBq];
#pragma unroll
    for (int i = 0; i < NA; ++i) { const int ch = tid + i * NTHR; asrc[i] = arow(ch >> 2) + (ch & 3) * 8; }
#pragma unroll
    for (int i = 0; i < NBq; ++i) { const int ch = tid + i * NTHR; bsrc[i] = brow(ch >> 2) + (ch & 3) * 8; }
    auto stage = [&](int kt, int buf) {
        unsigned char* sa = smem + buf * G::STAGE; unsigned char* sb = sa + G::ABYTES;
#pragma unroll
        for (int i = 0; i < NA; ++i) __builtin_amdgcn_global_load_lds((const unsigned*)(asrc[i] + kt * 32), (unsigned*)(sa + (tid + i * NTHR) * 16), 16, 0, 0);
#pragma unroll
        for (int i = 0; i < NBq; ++i) __builtin_amdgcn_global_load_lds((const unsigned*)(bsrc[i] + kt * 32), (unsigned*)(sb + (tid + i * NTHR) * 16), 16, 0, 0);
    };
    f32x4 acc[4][4];
#pragma unroll
    for (int m = 0; m < 4; ++m)
#pragma unroll
        for (int n = 0; n < 4; ++n) acc[m][n] = (f32x4){0.f, 0.f, 0.f, 0.f};
    const int T = K / 32;
    __syncthreads();
    stage(0, 0);
    for (int t = 0; t < T; ++t) {
        asm volatile("s_waitcnt vmcnt(0)" ::: "memory");
        __syncthreads();
        if (t + 1 < T) stage(t + 1, (t + 1) & 1);
        const unsigned char* sa = smem + (t & 1) * G::STAGE; const unsigned char* sb = sa + G::ABYTES;
        bf16x8 af[4], bfr[4];
#pragma unroll
        for (int m = 0; m < 4; ++m) af[m] = *(const bf16x8*)(sa + (wm * 64 + m * 16 + fr) * 64 + fq * 16);
#pragma unroll
        for (int n = 0; n < 4; ++n) bfr[n] = *(const bf16x8*)(sb + (wn * 64 + n * 16 + fr) * 64 + fq * 16);
#pragma unroll
        for (int m = 0; m < 4; ++m)
#pragma unroll
            for (int n = 0; n < 4; ++n) acc[m][n] = __builtin_amdgcn_mfma_f32_16x16x32_bf16(bfr[n], af[m], acc[m][n], 0, 0, 0);
        if (SEGK > 0) { if (((t + 1) * 32) % (SEGK > 0 ? SEGK : 32) == 0) hook(acc, ((t + 1) * 32) / (SEGK > 0 ? SEGK : 32) - 1, wm * 64, wn * 64, fr, fq); }
    }
    epi(acc, wm * 64, wn * 64, fr, fq);
}
struct NoHook { DI void operator()(f32x4 (&)[4][4], int, int, int, int, int) const {} };

namespace pg8 {
#define PG8_LAS __attribute__((address_space(3)))
typedef unsigned short bf16_t;
typedef short bf16x8 __attribute__((ext_vector_type(8)));
typedef float f32x4 __attribute__((ext_vector_type(4)));
constexpr int BM = 256, BK = 64, HALF = 128, HTB = HALF * BK * 2  , STAGE_BYTES = 8 * HTB, NXCD = 8, WGM = 8;

__host__ __device__ __forceinline__ int lds_byte(int r, int c) { const int st = (r >> 4) * 2 + (c >> 5), rr = r & 15, cc = c & 31, ob = rr * 64 + cc * 2; return st * 1024 + (ob ^ (((ob >> 9) & 1) << 5)); }
__host__ __device__ __forceinline__ void stage_rc(int b, int& R, int& C) { const int st = b / 1024, sb = b % 1024, swz = sb ^ (((sb >> 9) & 1) << 5); R = (st >> 1) * 16 + swz / 64; C = (st & 1) * 32 + (swz % 64) / 2; }
__host__ __device__ __forceinline__ int perm32(int rho) { const int n = rho >> 4, i = rho & 15; return 8 * (i >> 2) + 4 * n + (i & 3); }

struct Unit { int pm, pn; };
struct Gemm { const bf16_t* A; const bf16_t* Bt; int M, N, K, lda, ldb; };

struct StaticOrder {
    int nM, nN, nwg, G, c;
    __host__ __device__ void init(int M, int N, int G_, int c_) { nM = M / BM; nN = N / BM; nwg = nM * nN; G = G_; c = c_; }
    __host__ __device__ bool next(int i, Unit& u) const {
        const long L = (long)i * G + c; if (L >= nwg) return false;
        int wgid = (int)L; { const int q = nwg / NXCD, r = nwg % NXCD, xcd = wgid % NXCD, off = wgid / NXCD; wgid = (xcd < r ? xcd * (q + 1) : r * (q + 1) + (xcd - r) * q) + off; }
        const int nig = WGM * nN, gid = wgid / nig, fm = gid * WGM, gsz = (nM - fm) < WGM ? (nM - fm) : WGM;
        u.pm = fm + ((wgid % nig) % gsz); u.pn = (wgid % nig) / gsz; return true;
    }
    __device__ __forceinline__ void a_ready(const Unit&) const {}
    __device__ __forceinline__ void done(const Unit&) const {}
};
template <class Epi, class Sched, bool STAMP = false>
__device__ __forceinline__ void gemm_phase(PG8_LAS unsigned char* lds, const Gemm g, const Sched& S, const Epi& E, unsigned long long* stamps) {
    const int tid = threadIdx.x, wid = __builtin_amdgcn_readfirstlane(tid >> 6), lane = tid & 63, wr = wid >> 2, wc = wid & 3, fr = lane & 15, fq = lane >> 4;
    const int K = g.K, nt = K / BK;
    int ts_lo = 0, ts_hi = 0, nts = 0; const unsigned long long rt_entry = STAMP ? (unsigned long long)wall_clock64() : 0ull;
#define PG8_STAMP() do { if (STAMP && wid == 0 && nts < 64) { const unsigned long long _c = (unsigned long long)clock64(); \
        ts_lo = (lane == nts) ? (int)(unsigned)_c : ts_lo; ts_hi = (lane == nts) ? (int)(unsigned)(_c >> 32) : ts_hi; ++nts; } } while (0)
    PG8_STAMP();
    unsigned voffA[2], voffB[2];
#pragma unroll
    for (int i = 0; i < 2; ++i) { int R, C; stage_rc(tid * 16 + i * 8192, R, C); const int Rb = Epi::PERM ? ((R & ~31) + perm32(R & 31)) : R;
        voffA[i] = (unsigned)(R * g.lda + C) * 2u; voffB[i] = (unsigned)(Rb * g.ldb + C) * 2u; }
    const size_t kstep = (size_t)(BK * 2);
    const size_t hstepA = (size_t)HALF * g.lda * 2, hstepB = (size_t)HALF * g.ldb * 2;
    const size_t tstepA = 2 * hstepA, tstepB = 2 * hstepB;
    const unsigned ldsw = (unsigned)wid * 1024u;
    const int aoff = lds_byte(wr * 64 + fr, fq * 8), boff = lds_byte(wc * 32 + fr, fq * 8);
#define PG8_SA(b, h) (((b) * 2 + (h)) * HTB)
#define PG8_SB(b, h) ((4 + (b) * 2 + (h)) * HTB)
#define PG8_STAGE(bufoff, gbase, voff) do { _Pragma("unroll") for (int _i = 0; _i < 2; ++_i) \
        __builtin_amdgcn_global_load_lds((const unsigned*)((const char*)(gbase) + (voff)[_i]), (PG8_LAS unsigned*)(lds + (bufoff) + ldsw + _i * 8192), 16, 0, 0); } while (0)
#define PG8_LDA(dst, b, h) do { _Pragma("unroll") for (int m = 0; m < 4; ++m) _Pragma("unroll") for (int k = 0; k < 2; ++k) dst[m][k] = *(const PG8_LAS bf16x8*)(lds + PG8_SA(b, h) + aoff + m * 2048 + k * 1024); } while (0)
#define PG8_LDB(dst, b, h) do { _Pragma("unroll") for (int n = 0; n < 2; ++n) _Pragma("unroll") for (int k = 0; k < 2; ++k) dst[n][k] = *(const PG8_LAS bf16x8*)(lds + PG8_SB(b, h) + boff + n * 2048 + k * 1024); } while (0)
#define PG8_MMA(ai, bj, At, Bt) do { __builtin_amdgcn_s_setprio(1); _Pragma("unroll") for (int m = 0; m < 4; ++m) _Pragma("unroll") for (int n = 0; n < 2; ++n) _Pragma("unroll") for (int k = 0; k < 2; ++k) \
        acc[ai][bj][m][n] = __builtin_amdgcn_mfma_f32_16x16x32_bf16(Bt[n][k], At[m][k], acc[ai][bj][m][n], 0, 0, 0); __builtin_amdgcn_s_setprio(0); } while (0)
#define PG8_WAIT_V(n) asm volatile("s_waitcnt vmcnt(" #n ")" ::: "memory")
#define PG8_WAIT_L(n) asm volatile("s_waitcnt lgkmcnt(" #n ")" ::: "memory")
#define PG8_BAR __builtin_amdgcn_s_barrier()
#define PG8_SCHED __builtin_amdgcn_sched_barrier(0)
    Unit cur, nxt; int ui = 0;
    if (!S.next(0, cur)) return;
    f32x4 acc[2][2][4][2];
#pragma unroll
    for (int a = 0; a < 2; ++a)
#pragma unroll
        for (int b = 0; b < 2; ++b)
#pragma unroll
            for (int m = 0; m < 4; ++m)
#pragma unroll
                for (int n = 0; n < 2; ++n) acc[a][b][m][n] = (f32x4){0.f, 0.f, 0.f, 0.f};
    bf16x8 At[4][2], B0[2][2], B1[2][2];
    const char* cA = (const char*)g.A + (size_t)cur.pm * tstepA; const char* cB = (const char*)g.Bt + (size_t)cur.pn * tstepB;
    S.a_ready(cur);
    PG8_STAGE(PG8_SB(0, 0), cB, voffB); PG8_STAGE(PG8_SA(0, 0), cA, voffA); PG8_STAGE(PG8_SB(0, 1), cB + hstepB, voffB); PG8_STAGE(PG8_SA(0, 1), cA + hstepA, voffA);
    if (wr == 1) PG8_BAR;
    PG8_WAIT_V(4); PG8_BAR;
    PG8_STAGE(PG8_SB(1, 0), cB + kstep, voffB); PG8_STAGE(PG8_SA(1, 0), cA + kstep, voffA); PG8_STAGE(PG8_SB(1, 1), cB + hstepB + kstep, voffB);
    PG8_WAIT_V(6); PG8_BAR;
    PG8_STAMP();
    for (;;) {
        const bool has_next = S.next(ui + 1, nxt);
        const char* nA = has_next ? (const char*)g.A + (size_t)nxt.pm * tstepA : cA; const char* nB = has_next ? (const char*)g.Bt + (size_t)nxt.pn * tstepB : cB;
        for (int t = 0; t < nt; t += 2) {
            const bool last = (t == nt - 2);
            const char* a1 = cA + (size_t)(t + 1) * kstep;
            const char* a2 = last ? nA : cA + (size_t)(t + 2) * kstep; const char* b2 = last ? nB : cB + (size_t)(t + 2) * kstep;
            const char* a3 = a2 + kstep; const char* b3 = b2 + kstep;
            if (last && has_next) S.a_ready(nxt);
            PG8_LDB(B0, 0, 0); PG8_SCHED; PG8_LDA(At, 0, 0); PG8_STAGE(PG8_SA(1, 1), a1 + hstepA, voffA);
            PG8_WAIT_L(8); PG8_BAR; PG8_WAIT_L(0); PG8_MMA(0, 0, At, B0); PG8_BAR; PG8_SCHED;
            PG8_LDB(B1, 0, 1); PG8_STAGE(PG8_SB(0, 0), b2, voffB);
            PG8_BAR; PG8_WAIT_L(0); PG8_MMA(0, 1, At, B1); PG8_BAR;
            PG8_LDA(At, 0, 1); PG8_STAGE(PG8_SA(0, 0), a2, voffA);
            PG8_BAR; PG8_WAIT_L(0); PG8_MMA(1, 0, At, B0); PG8_BAR; PG8_SCHED;
            PG8_STAGE(PG8_SB(0, 1), b2 + hstepB, voffB);
            PG8_WAIT_V(6); PG8_BAR; PG8_MMA(1, 1, At, B1); PG8_BAR;
            PG8_LDB(B0, 1, 0); PG8_SCHED; PG8_LDA(At, 1, 0); PG8_STAGE(PG8_SA(0, 1), a2 + hstepA, voffA);
            PG8_WAIT_L(8); PG8_BAR; PG8_WAIT_L(0); PG8_MMA(0, 0, At, B0); PG8_BAR; PG8_SCHED;
            PG8_LDB(B1, 1, 1); PG8_STAGE(PG8_SB(1, 0), b3, voffB);
            PG8_BAR; PG8_WAIT_L(0); PG8_MMA(0, 1, At, B1); PG8_BAR;
            PG8_LDA(At, 1, 1); PG8_STAGE(PG8_SA(1, 0), a3, voffA);
            PG8_BAR; PG8_WAIT_L(0); PG8_MMA(1, 0, At, B0); PG8_BAR; PG8_SCHED;
            PG8_STAGE(PG8_SB(1, 1), b3 + hstepB, voffB);
            PG8_WAIT_V(6); PG8_BAR; PG8_MMA(1, 1, At, B1); PG8_BAR;
        }
        PG8_STAMP();
        if constexpr (!Epi::AFTER_DRAIN) { E(acc, cur, wr, wc, fr, fq); S.done(cur); }
        PG8_STAMP();
        if (!has_next) break;
#pragma unroll
        for (int a = 0; a < 2; ++a)
#pragma unroll
            for (int b = 0; b < 2; ++b)
#pragma unroll
                for (int m = 0; m < 4; ++m)
#pragma unroll
                    for (int n = 0; n < 2; ++n) acc[a][b][m][n] = (f32x4){0.f, 0.f, 0.f, 0.f};
        cur = nxt; cA = nA; cB = nB; ++ui;
    }
    PG8_WAIT_V(0);
    if (wr == 0) PG8_BAR;
    PG8_BAR;
    if constexpr (Epi::AFTER_DRAIN) { E.fused(acc, cur, wr, wc, fr, fq, lds, wid, lane); S.done(cur); }
    PG8_STAMP();
    if (STAMP && wid == 0) { stamps[lane] = lane < nts ? (((unsigned long long)(unsigned)ts_hi << 32) | (unsigned)ts_lo) : 0ull;
        if (lane == 62) stamps[62] = rt_entry; if (lane == 63) stamps[63] = (unsigned long long)wall_clock64(); }
#undef PG8_STAMP
#undef PG8_SA
#undef PG8_SB
#undef PG8_STAGE
#undef PG8_LDA
#undef PG8_LDB
#undef PG8_MMA
#undef PG8_WAIT_V
#undef PG8_WAIT_L
#undef PG8_BAR
#undef PG8_SCHED
}
}

DI int rowmap(int n, int mode) { return mode == 0 ? n : ((n >> 4) * 32 + (n & 15) + (mode == 2 ? 16 : 0)); }
DI void tconv_tile(const Ctx& c, const float* src, int ld, int N, bf16_t* dst, int ld_dst, int mode, int tk, int tn) {
    bf16_t* T = (bf16_t*)c.smem;
    const int k0 = tk * 64, n0 = tn * 64, tid = c.tid;
    __syncthreads();
#pragma unroll
    for (int i = 0; i < 2; ++i) {
        const int kk = (tid >> 4) + i * 32, n4 = (tid & 15) * 4;
        float4 v = make_float4(0.f, 0.f, 0.f, 0.f);
        if (n0 + n4 < N) v = *(const float4*)(src + (size_t)(k0 + kk) * ld + n0 + n4);
        T[(n4 + 0) * 72 + kk] = f2bf(v.x); T[(n4 + 1) * 72 + kk] = f2bf(v.y); T[(n4 + 2) * 72 + kk] = f2bf(v.z); T[(n4 + 3) * 72 + kk] = f2bf(v.w);
    }
    __syncthreads();
    const int n = tid >> 3, k8 = (tid & 7) * 8;
    if (n0 + n < N) *(u32x4*)(dst + (size_t)rowmap(n0 + n, mode) * ld_dst + k0 + k8) = *(const u32x4*)(T + n * 72 + k8);
}
DI void tconv(const Ctx& c, const float* src, int ld, int K, int N, bf16_t* dst, int ld_dst, int mode, int rot) {
    const int ntk = K / 64, ntn = (N + 63) / 64, nt = ntk * ntn, G = gridDim.x;
    for (int t = (blockIdx.x + G - (rot % G)) % G; t < nt; t += G) tconv_tile(c, src, ld, N, dst, ld_dst, mode, t / ntn, t % ntn);
}

DI void phase_prologue(const Ctx& c) {
    unsigned char* wsm = c.ws + WS_WSM;
    const int tid = c.tid, G = gridDim.x, gtid = blockIdx.x * NTHR + tid, gn = G * NTHR;
    {
        const float4* x = (const float4*)c.in[0]; const float4* cx = (const float4*)c.in[2]; float4* H = (float4*)(c.ws + WS_H);
        for (size_t i = gtid; i < (size_t)NZ * 256; i += gn) {
            const int z = (int)(i >> 8), q = (int)(i & 255), b = z / TZ, s = z % TZ;
            H[i] = (s < CTX) ? cx[((size_t)b * CTX + s) * 256 + q] : x[((size_t)b * SEQ + (s - CTX)) * 256 + q];
        }
    }
    {
        float* rope = (float*)(wsm + OFF_ROPE);
        for (int i = gtid; i < SEQ * 16; i += gn) {
            const int t = i >> 4, a = (i >> 3) & 1, f = i & 7;
            const float pos = (float)(a == 0 ? (t >> 6) : (t & 63));
            const float inv = powf(10000.f, -(float)f / 8.f);
            float sn, cs; sincosf(pos * inv, &sn, &cs);
            rope[i * 2] = cs; rope[i * 2 + 1] = sn;
        }
    }
    {
        float* s5t = (float*)(wsm + OFF_S5T);
        for (int i = gtid; i < NL * 2 * 16 * 64; i += gn) {
            const int ldg = i >> 6;
            const double lr = c.in[24][i], li = c.in[25][i], dt = exp((double)c.in[26][ldg]);
            const double mag = exp(lr * dt), are = mag * cos(li * dt), aim = mag * sin(li * dt);
            const double m256 = exp(lr * dt * 64.0), a256r = m256 * cos(li * dt * 64.0), a256i = m256 * sin(li * dt * 64.0);
            const double den = lr * lr + li * li, nr = are - 1.0, ni = aim;
            const double cfr = (nr * lr + ni * li) / den, cfi = (ni * lr - nr * li) / den;
            float* o = s5t + (size_t)i * 36;
            o[0] = (float)are; o[1] = (float)aim; o[2] = (float)a256r; o[3] = (float)a256i;
            for (int ch = 0; ch < 16; ++ch) {
                const double br = c.in[27][(size_t)i * 16 + ch], bi = c.in[28][(size_t)i * 16 + ch];
                o[4 + ch] = (float)(cfr * br - cfi * bi); o[20 + ch] = (float)(cfr * bi + cfi * br);
            }
        }
    }
    {
        float* rwt = (float*)(wsm + OFF_RWT);
        for (int i = gtid; i < NL * 36 * 1024; i += gn) {
            const int l = i / (36 * 1024), e = (i / 1024) % 36, d = i & 1023;
            rwt[i] = e < 4 ? c.in[41][((size_t)l * 1024 + d) * 4 + e] : c.in[43][((size_t)l * 1024 + d) * 32 + (e - 4)];
        }
    }
    if (blockIdx.x == 0 && tid < NL) {
        float s1 = 0.f, s2 = 0.f;
        for (int i = 0; i < 32; ++i) { s1 += c.in[34][tid * 32 + i] * c.in[35][tid * 32 + i]; s2 += c.in[36][tid * 32 + i] * c.in[37][tid * 32 + i]; }
        ((float*)(wsm + OFF_LAM))[tid] = expf(s1) - expf(s2) + (0.8f - 0.6f * expf(-0.3f * (float)tid));
    }
    {
        float* sv = (float*)c.smem;
        float* red = sv + 3 * 1024;
        __syncthreads();
        for (int i = tid; i < 3 * 1024; i += NTHR) { const float v = i < 2048 ? c.in[1][i] : c.in[3][i - 2048]; sv[i] = siluf_(v); }
        __syncthreads();
        float* modv = (float*)(wsm + OFF_MODV);
        for (int u = blockIdx.x; u < NL * 96; u += G) {
            const int l = u / 96, col = (u % 96) * 64 + (tid & 63), ks = tid >> 6;
            const float* w = c.in[4] + (size_t)l * 1024 * 6144 + col;
            float a0 = 0.f, a1 = 0.f, a2 = 0.f;
            for (int k = ks * 128; k < ks * 128 + 128; ++k) { const float wv = w[(size_t)k * 6144]; a0 += sv[k] * wv; a1 += sv[1024 + k] * wv; a2 += sv[2048 + k] * wv; }
            red[(ks * 64 + (tid & 63)) * 3 + 0] = a0; red[(ks * 64 + (tid & 63)) * 3 + 1] = a1; red[(ks * 64 + (tid & 63)) * 3 + 2] = a2;
            __syncthreads();
            if (tid < 192) {
                const int cc = tid & 63, sel = tid >> 6; float s = 0.f;
                for (int k2 = 0; k2 < 8; ++k2) s += red[(k2 * 64 + cc) * 3 + sel];
                const int colo = (u % 96) * 64 + cc;
                modv[((size_t)l * 3 + sel) * 6144 + colo] = s + c.in[5][l * 6144 + colo];
            }
            __syncthreads();
        }
    }
    for (int l = 0; l < NL; ++l) {
        tconv(c, c.in[8] + (size_t)l * 1024 * NIN, NIN, 1024, NIN, (bf16_t*)(wsm + OFF_WINT + l * SZ_WINT), 1024, 0, 0);
        tconv(c, c.in[11] + (size_t)l * 256 * 384, 384, 256, 384, (bf16_t*)(wsm + OFF_WUQT + l * SZ_WUQT), 256, 0, 40);
        tconv(c, c.in[12] + (size_t)l * 128 * 512, 512, 128, 512, (bf16_t*)(wsm + OFF_WUKVT + l * SZ_WUKVT), 128, 0, 70);
        for (int d = 0; d < 2; ++d) {
            tconv(c, c.in[15] + (size_t)(l * 2 + d) * 64 * 256, 256, 64, 256, (bf16_t*)(wsm + OFF_W2T + l * SZ_W2T) + d * 256 * 64, 64, 0, 90 + d * 8);
            tconv(c, c.in[17] + (size_t)(l * 2 + d) * 64 * 256, 256, 64, 256, (bf16_t*)(wsm + OFF_A2T + l * SZ_A2T) + d * 256 * 64, 64, 0, 110 + d * 8);
        }
        tconv(c, c.in[18] + (size_t)l * 128 * 256, 256, 128, 256, (bf16_t*)(wsm + OFF_G2T + l * SZ_G2T), 128, 0, 130);
        tconv(c, c.in[32] + (size_t)l * 256 * 256, 256, 256, 256, (bf16_t*)(wsm + OFF_GLUT + l * SZ_GLUT), 256, 0, 140);
        for (int n = 0; n < 4; ++n)
            tconv(c, c.in[39] + (size_t)(l * 4 + n) * 256 * 1024, 1024, 256, 1024, (bf16_t*)(wsm + OFF_WBT + l * SZ_WBT) + n * 256, 1024, 0, 160 + n * 20);
        tconv(c, c.in[40] + (size_t)l * 1024 * 1024, 1024, 1024, 1024, (bf16_t*)(wsm + OFF_WOUTT + l * SZ_WOUTT), 1024, 0, 0);
    }
}

DI void phase_expert_convert(const Ctx& c, int l) {
    const int G = gridDim.x, lane = c.lane;
    for (int t = blockIdx.x * 8 + c.wave; t < 32 * 384; t += G * 8) {
        const int e = t / 384, r = t % 384;
        const float* src; bf16_t* dst; int ld, ldd, mode, tk, tn;
        if (r < 128)      { src = c.in[45] + ((size_t)l * 32 + e) * 1024 * 512; dst = (bf16_t*)(c.ws + WS_EXPW + (size_t)e * SZ_WGU); ld = 512; ldd = 1024; mode = 1; tk = r / 8; tn = r % 8; }
        else if (r < 256) { src = c.in[46] + ((size_t)l * 32 + e) * 1024 * 512; dst = (bf16_t*)(c.ws + WS_EXPW + (size_t)e * SZ_WGU); ld = 512; ldd = 1024; mode = 2; tk = (r - 128) / 8; tn = (r - 128) % 8; }
        else              { src = c.in[47] + ((size_t)l * 32 + e) * 512 * 1024; dst = (bf16_t*)(c.ws + WS_EXPW + 32 * SZ_WGU + (size_t)e * SZ_WD); ld = 1024; ldd = 512; mode = 0; tk = (r - 256) / 16; tn = (r - 256) % 16; }
        const int n = tn * 64 + lane; const float* sp = src + (size_t)(tk * 64) * ld + n; bf16_t* dp = dst + (size_t)rowmap(n, mode) * ldd + tk * 64;
#pragma unroll
        for (int kb = 0; kb < 8; ++kb) {
            float v[8];
#pragma unroll
            for (int j = 0; j < 8; ++j) v[j] = sp[(size_t)(kb * 8 + j) * ld];
            u32x4 w4; w4.x = pack2(v[0], v[1]); w4.y = pack2(v[2], v[3]); w4.z = pack2(v[4], v[5]); w4.w = pack2(v[6], v[7]);
            *(u32x4*)(dp + kb * 8) = w4;
        }
    }
}

DI void phase_norm1(const Ctx& c, int l) {
    const float* modv = (const float*)(c.ws + WS_WSM + OFF_MODV);
    float* H = (float*)(c.ws + WS_H); const bf16_t* Y = (const bf16_t*)(c.ws + WS_P);
    bf16_t* XN = (bf16_t*)(c.ws + WS_BUFA);
    const float* g1 = c.in[6] + l * 1024;
    for (int row = blockIdx.x * 8 + c.wave; row < NZ; row += gridDim.x * 8) {
        const int b = row / TZ, s = row % TZ, sel = s < CTX ? 2 : b;
        float4 v[4]; float ss = 0.f;
#pragma unroll
        for (int q = 0; q < 4; ++q) {
            const int col = q * 256 + c.lane * 4;
            v[q] = *(const float4*)(H + (size_t)row * D + col);
            if (l > 0) {
                float ya[4], yb[4]; unpack4(*(const u32x2*)(Y + (size_t)row * D + col), ya); unpack4(*(const u32x2*)(Y + ((size_t)NZ + row) * D + col), yb);
                const float4 m5 = *(const float4*)(modv + ((size_t)(l - 1) * 3 + sel) * 6144 + 5 * 1024 + col);
                v[q].x += m5.x * (ya[0] + yb[0]); v[q].y += m5.y * (ya[1] + yb[1]); v[q].z += m5.z * (ya[2] + yb[2]); v[q].w += m5.w * (ya[3] + yb[3]);
                *(float4*)(H + (size_t)row * D + col) = v[q];
            }
            ss += v[q].x * v[q].x + v[q].y * v[q].y + v[q].z * v[q].z + v[q].w * v[q].w;
        }
        ss = wave_sum(ss);
        const float rs = rsqrtf(ss * (1.f / 1024.f) + 1e-6f);
#pragma unroll
        for (int q = 0; q < 4; ++q) {
            const int col = q * 256 + c.lane * 4;
            const float4 g = *(const float4*)(g1 + col), m0 = *(const float4*)(modv + ((size_t)l * 3 + sel) * 6144 + col), m1 = *(const float4*)(modv + ((size_t)l * 3 + sel) * 6144 + 1024 + col);
            *(u32x2*)(XN + (size_t)row * D + col) = pack4(v[q].x * rs * g.x * (1.f + m1.x) + m0.x, v[q].y * rs * g.y * (1.f + m1.y) + m0.y,
                                                          v[q].z * rs * g.z * (1.f + m1.z) + m0.z, v[q].w * rs * g.w * (1.f + m1.w) + m0.w);
        }
    }
}

DI void phase_final(const Ctx& c) {
    const float* modv = (const float*)(c.ws + WS_WSM + OFF_MODV);
    const float* H = (const float*)(c.ws + WS_H); const bf16_t* Y = (const bf16_t*)(c.ws + WS_P);
    const float* g = c.in[48];
    for (int r = blockIdx.x * 8 + c.wave; r < NB * SEQ; r += gridDim.x * 8) {
        const int b = r / SEQ, t = r % SEQ, row = b * TZ + CTX + t;
        float4 v[4]; float ss = 0.f;
#pragma unroll
        for (int q = 0; q < 4; ++q) {
            const int col = q * 256 + c.lane * 4;
            v[q] = *(const float4*)(H + (size_t)row * D + col);
            float ya[4], yb[4]; unpack4(*(const u32x2*)(Y + (size_t)row * D + col), ya); unpack4(*(const u32x2*)(Y + ((size_t)NZ + row) * D + col), yb);
            const float4 m5 = *(const float4*)(modv + ((size_t)(NL - 1) * 3 + b) * 6144 + 5 * 1024 + col);
            v[q].x += m5.x * (ya[0] + yb[0]); v[q].y += m5.y * (ya[1] + yb[1]); v[q].z += m5.z * (ya[2] + yb[2]); v[q].w += m5.w * (ya[3] + yb[3]);
            ss += v[q].x * v[q].x + v[q].y * v[q].y + v[q].z * v[q].z + v[q].w * v[q].w;
        }
        ss = wave_sum(ss);
        const float rs = rsqrtf(ss * (1.f / 1024.f) + 1e-6f);
#pragma unroll
        for (int q = 0; q < 4; ++q) {
            const int col = q * 256 + c.lane * 4; const float4 gg = *(const float4*)(g + col);
            *(float4*)(c.out + (size_t)r * D + col) = make_float4(v[q].x * rs * gg.x, v[q].y * rs * gg.y, v[q].z * rs * gg.z, v[q].w * rs * gg.w);
        }
    }
}

struct EpiInproj {
    static constexpr bool PERM = false, AFTER_DRAIN = false;
    bf16_t *PM, *PS, *PR, *PD, *GT;
    DI void operator()(const pg8::f32x4 (&acc)[2][2][4][2], const pg8::Unit& u, int wr, int wc, int fr, int fq) const {
        const int row0 = u.pm * 256 + wr * 64 + fr, col0 = u.pn * 256 + wc * 32 + 4 * fq;
#pragma unroll
        for (int bj = 0; bj < 2; ++bj)
#pragma unroll
            for (int n = 0; n < 2; ++n) {
                const int col = col0 + bj * 128 + n * 16;
                bf16_t* dst; int ld, cc; bool gate = false;
                if (col < 416) { dst = PM; ld = 416; cc = col; }
                else if (col < 1440) { dst = PR; ld = 1024; cc = col - 416; }
                else if (col < 1696) { dst = PS; ld = 256; cc = col - 1440; }
                else if (col < 2464) { dst = PD; ld = 768; cc = col - 1696; }
                else if (col < NIN) { dst = GT; ld = 4096; cc = col - 2464; gate = true; }
                else continue;
#pragma unroll
                for (int ai = 0; ai < 2; ++ai)
#pragma unroll
                    for (int m = 0; m < 4; ++m) {
                        const int row = row0 + ai * 128 + m * 16; pg8::f32x4 v = acc[ai][bj][m][n];
                        if (gate) { v[0] = sigmoidf_(v[0]); v[1] = sigmoidf_(v[1]); v[2] = sigmoidf_(v[2]); v[3] = sigmoidf_(v[3]); }
                        *(u32x2*)(dst + (size_t)row * ld + cc) = pack4(v[0], v[1], v[2], v[3]);
                    }
            }
    }
};
DI void phase_inproj(const Ctx& c, int l) {
    EpiInproj E; E.PM = (bf16_t*)(c.ws + WS_P + P_PM); E.PS = (bf16_t*)(c.ws + WS_P + P_PS); E.PR = (bf16_t*)(c.ws + WS_P + P_PR); E.PD = (bf16_t*)(c.ws + WS_P + P_PD); E.GT = (bf16_t*)(c.ws + WS_GT);
    pg8::Gemm g{(const bf16_t*)(c.ws + WS_BUFA), (const bf16_t*)(c.ws + WS_WSM + OFF_WINT + l * SZ_WINT), NZ, NINP, 1024, 1024, 1024};
    pg8::StaticOrder S; S.init(NZ, NINP, (int)gridDim.x, (int)blockIdx.x);
    __syncthreads();
    pg8::gemm_phase<EpiInproj, pg8::StaticOrder, false>((PG8_LAS unsigned char*)c.smem, g, S, E, nullptr);
}

DI void phase_prep(const Ctx& c, int l) {
    unsigned char* ws = c.ws; const int lane = c.lane, wave = c.wave, tid = c.tid;
    const bf16_t* PM = (const bf16_t*)(ws + WS_P + P_PM); const bf16_t* PR = (const bf16_t*)(ws + WS_P + P_PR); const bf16_t* PD = (const bf16_t*)(ws + WS_P + P_PD);
    bf16_t* CQN = (bf16_t*)(ws + WS_MISC + MS_CQN); bf16_t* TW = (bf16_t*)(ws + WS_MISC + MS_TW); bf16_t* AL = (bf16_t*)(ws + WS_MISC + MS_AL); bf16_t* SG = (bf16_t*)(ws + WS_MISC + MS_SG);
    bf16_t* KM = (bf16_t*)(ws + WS_EXPW + MX_KM); bf16_t* QD = (bf16_t*)(ws + WS_EXPW + MX_QD); bf16_t* KD_ = (bf16_t*)(ws + WS_EXPW + MX_KD); bf16_t* VDT = (bf16_t*)(ws + WS_EXPW + MX_VDT);
    bf16_t* RB = (bf16_t*)(ws + WS_EXPW + MX_RB); bf16_t* KB = (bf16_t*)(ws + WS_EXPW + MX_KB); bf16_t* VB = (bf16_t*)(ws + WS_EXPW + MX_VB); bf16_t* KKB = (bf16_t*)(ws + WS_EXPW + MX_KKB);
    const float* rope = (const float*)(ws + WS_WSM + OFF_ROPE);
    const float* gq = c.in[9] + l * 256; const float* gkv = c.in[10] + l * 128; const float* mu = c.in[13] + l * 1024; const float* k_k = c.in[19] + l * 256;
    bf16_t* Vs = (bf16_t*)c.smem;
    const float qsc = 0.17677669529663687f * LOG2E;
    for (int tile = blockIdx.x; tile < NZ / 64; tile += gridDim.x) {
        __syncthreads();
        for (int i = 0; i < 8; ++i) {
            const int rt = wave * 8 + i, z = tile * 64 + rt, b = z / TZ, s = z % TZ; const bool lat = s >= CTX; const int tl = lat ? s - CTX : 0;
            {
                const bf16_t* pm = PM + (size_t)z * 416;
                float x[4]; unpack4(*(const u32x2*)(pm + lane * 4), x);
                float ss = wave_sum(x[0] * x[0] + x[1] * x[1] + x[2] * x[2] + x[3] * x[3]);
                float rs = rsqrtf(ss * (1.f / 256.f) + 1e-6f);
                const float4 g = *(const float4*)(gq + lane * 4);
                *(u32x2*)(CQN + (size_t)z * 384 + lane * 4) = pack4(x[0] * rs * g.x, x[1] * rs * g.y, x[2] * rs * g.z, x[3] * rs * g.w);
                const unsigned u2 = *(const unsigned*)(pm + 256 + lane * 2); const float y0 = lo2f(u2), y1 = hi2f(u2);
                ss = wave_sum(y0 * y0 + y1 * y1); rs = rsqrtf(ss * (1.f / 128.f) + 1e-6f);
                const float2 g2 = *(const float2*)(gkv + lane * 2);
                *(unsigned*)(CQN + (size_t)z * 384 + 256 + lane * 2) = pack2(y0 * rs * g2.x, y1 * rs * g2.y);
                float kr = bf2f(pm[384 + (lane & 31)]);
                const float pr = __shfl_xor(kr, 8, 64);
                if (lat) { const float* cs = rope + ((size_t)tl * 16 + ((lane & 31) >> 4) * 8 + (lane & 7)) * 2; kr = kr * cs[0] + ((lane & 8) ? pr : -pr) * cs[1]; }
                if (lane < 32) {
                    const bf16_t kv = f2bf(kr);
#pragma unroll
                    for (int h = 0; h < 4; ++h) KM[((size_t)(b * 4 + h) * TZ + s) * 96 + 64 + lane] = kv;
                }
            }
            {
                const bf16_t* pd = PD + (size_t)z * 768;
                const int i0 = lane * 4, hh = i0 >> 6, ii = i0 & 31, nn = (i0 >> 5) & 1;
                const float* cs = rope + ((size_t)tl * 16 + (ii >> 4) * 8 + (ii & 7)) * 2;
                const bool hi = (ii & 8) != 0;
#pragma unroll
                for (int w = 0; w < 2; ++w) {
                    float x[4]; unpack4(*(const u32x2*)(pd + w * 256 + i0), x);
                    float o[4];
#pragma unroll
                    for (int j = 0; j < 4; ++j) {
                        const float p = __shfl_xor(x[j], 2, 64);
                        o[j] = lat ? (x[j] * cs[2 * j] + (hi ? p : -p) * cs[2 * j + 1]) : x[j];
                        if (w == 0) o[j] *= qsc;
                    }
                    bf16_t* dst = (w == 0 ? QD : KD_) + ((size_t)(b * 4 + hh) * TZ + s) * 64 + nn * 32 + ii;
                    *(u32x2*)dst = pack4(o[0], o[1], o[2], o[3]);
                }
                *(u32x2*)(Vs + rt * 264 + i0) = *(const u32x2*)(pd + 512 + i0);
            }
            {
                const bf16_t* pr = PR + (size_t)z * 1024;
                const bool hp = (s != 0) && (s != CTX), hn = (s != CTX - 1) && (s != TZ - 1);
#pragma unroll
                for (int q = 0; q < 4; ++q) {
                    const int col = q * 256 + lane * 4;
                    float cu[4], pv[4] = {0.f, 0.f, 0.f, 0.f}, nx[4] = {0.f, 0.f, 0.f, 0.f};
                    unpack4(*(const u32x2*)(pr + col), cu);
                    if (hp) unpack4(*(const u32x2*)(pr - 1024 + col), pv);
                    if (hn) unpack4(*(const u32x2*)(pr + 1024 + col), nx);
                    const float4 m = *(const float4*)(mu + col);
                    float zv[4];
                    zv[0] = cu[0] + (0.5f * (pv[0] + nx[0]) - cu[0]) * m.x; zv[1] = cu[1] + (0.5f * (pv[1] + nx[1]) - cu[1]) * m.y;
                    zv[2] = cu[2] + (0.5f * (pv[2] + nx[2]) - cu[2]) * m.z; zv[3] = cu[3] + (0.5f * (pv[3] + nx[3]) - cu[3]) * m.w;
                    if (q == 0) *(u32x2*)(RB + (size_t)z * 256 + lane * 4) = pack4(zv[0], zv[1], zv[2], zv[3]);
                    else if (q == 1) {
                        *(u32x2*)(KB + (size_t)z * 256 + lane * 4) = pack4(zv[0], zv[1], zv[2], zv[3]);
                        const float4 kk4 = *(const float4*)(k_k + lane * 4);
                        const float a0 = zv[0] * kk4.x, a1 = zv[1] * kk4.y, a2 = zv[2] * kk4.z, a3 = zv[3] * kk4.w;
                        const float ssq = sum16(a0 * a0 + a1 * a1 + a2 * a2 + a3 * a3);
                        const float inv = 1.f / fmaxf(sqrtf(ssq), 1e-12f);
                        *(u32x2*)(KKB + (size_t)z * 256 + lane * 4) = pack4(a0 * inv, a1 * inv, a2 * inv, a3 * inv);
                    } else if (q == 2) *(u32x2*)(VB + (size_t)z * 256 + lane * 4) = pack4(zv[0], zv[1], zv[2], zv[3]);
                    else {
                        if (lane < 16) *(u32x2*)(TW + (size_t)z * 64 + lane * 4) = pack4(tanhf(zv[0]), tanhf(zv[1]), tanhf(zv[2]), tanhf(zv[3]));
                        else if (lane < 32) *(u32x2*)(AL + (size_t)z * 64 + (lane - 16) * 4) = pack4(zv[0], zv[1], zv[2], zv[3]);
                        else *(u32x2*)(SG + (size_t)z * 128 + (lane - 32) * 4) = pack4(sigmoidf_(zv[0]), sigmoidf_(zv[1]), sigmoidf_(zv[2]), sigmoidf_(zv[3]));
                    }
                }
            }
        }
        __syncthreads();
        {
            const int z0 = tile * 64, b = z0 / TZ, s0 = z0 % TZ;
#pragma unroll
            for (int i = 0; i < 4; ++i) {
                const int ch = tid + i * NTHR, dv = ch >> 3, r8 = (ch & 7) * 8;
                bf16_t v[8];
#pragma unroll
                for (int j = 0; j < 8; ++j) v[j] = Vs[(r8 + j) * 264 + dv];
                u32x4 o; o.x = v[0] | ((unsigned)v[1] << 16); o.y = v[2] | ((unsigned)v[3] << 16); o.z = v[4] | ((unsigned)v[5] << 16); o.w = v[6] | ((unsigned)v[7] << 16);
                *(u32x4*)(VDT + ((size_t)(b * 4 + (dv >> 6)) * 64 + (dv & 63)) * TZ + s0 + r8) = o;
            }
        }
    }
}

constexpr int S5C = 64, S5N = TZ / S5C, S5NC = CTX / S5C;
DI int s5_tok(int dir, int i) { return dir == 0 ? i : (i < CTX ? CTX - 1 - i : TZ - 1 - (i - CTX)); }
DI void s5_stage_u(const Ctx& c, float* U, int b, int dir, int chunk, int g0, int ng) {
    const bf16_t* PS = (const bf16_t*)(c.ws + WS_P + P_PS);
    const int per = ng * 4;
    for (int e = c.tid; e < S5C * per; e += NTHR) {
        const int i = e / per, c4 = (e % per) * 4, s = s5_tok(dir, chunk * S5C + i);
        float x[4]; unpack4(*(const u32x2*)(PS + (size_t)(b * TZ + s) * 256 + g0 * 16 + c4), x);
        *(float4*)(U + i * (ng * 16) + c4) = make_float4(x[0], x[1], x[2], x[3]);
    }
}
DI void phase_s5_local(const Ctx& c, int l) {
    float* U = (float*)c.smem;
    const float* s5t = (const float*)(c.ws + WS_WSM + OFF_S5T);
    float* E = (float*)(c.ws + WS_WSM + OFF_S5E);
    for (int u = blockIdx.x; u < 2 * 2 * S5N * 2; u += gridDim.x) {
        const int gq = u & 1, chunk = (u >> 1) % S5N, dir = (u / (2 * S5N)) & 1, b = u / (4 * S5N);
        __syncthreads();
        s5_stage_u(c, U, b, dir, chunk, gq * 8, 8);
        __syncthreads();
        const int g = gq * 8 + c.wave, p = c.lane;
        const float* tb = s5t + ((size_t)((l * 2 + dir) * 16 + g) * 64 + p) * 36;
        const float are = tb[0], aim = tb[1];
        float br[16], bi[16];
#pragma unroll
        for (int ch = 0; ch < 16; ++ch) { br[ch] = tb[4 + ch]; bi[ch] = tb[20 + ch]; }
        float xr = 0.f, xi = 0.f;
        for (int i = 0; i < S5C; ++i) {
            const float* uu = U + i * 128 + c.wave * 16;
            float sr = 0.f, si = 0.f;
#pragma unroll
            for (int q = 0; q < 4; ++q) { const float4 v = *(const float4*)(uu + q * 4);
                sr += br[q * 4] * v.x + br[q * 4 + 1] * v.y + br[q * 4 + 2] * v.z + br[q * 4 + 3] * v.w;
                si += bi[q * 4] * v.x + bi[q * 4 + 1] * v.y + bi[q * 4 + 2] * v.z + bi[q * 4 + 3] * v.w; }
            const float nr = are * xr - aim * xi + sr, ni = are * xi + aim * xr + si; xr = nr; xi = ni;
        }
        *(float2*)(E + ((size_t)(((b * 2 + dir) * 16 + g) * S5N + chunk) * 64 + p) * 2) = make_float2(xr, xi);
    }
}
DI void phase_s5_carry(const Ctx& c, int l) {
    const int gt = blockIdx.x * NTHR + c.tid;
    if (gt < 2 * 2 * 16 * 64) {
        const int p = gt & 63, g = (gt >> 6) & 15, dir = (gt >> 10) & 1, b = gt >> 11;
        const float* tb = (const float*)(c.ws + WS_WSM + OFF_S5T) + ((size_t)((l * 2 + dir) * 16 + g) * 64 + p) * 36;
        const float ar = tb[2], ai = tb[3];
        const float* E = (const float*)(c.ws + WS_WSM + OFF_S5E) + (size_t)(((b * 2 + dir) * 16 + g) * S5N) * 128;
        float* C = (float*)(c.ws + WS_WSM + OFF_S5C) + (size_t)(((b * 2 + dir) * 16 + g) * S5N) * 128;
        float xr = 0.f, xi = 0.f;
        for (int ch = 0; ch < S5N; ++ch) {
            const float2 e = *(const float2*)(E + ch * 128 + p * 2);
            *(float2*)(C + ch * 128 + p * 2) = make_float2(xr, xi);
            const float nr = ar * xr - ai * xi + e.x, ni = ar * xi + ai * xr + e.y; xr = nr; xi = ni;
        }
    }
}

constexpr int S5_US = 0, S5_YS = 8192, S5_WV = S5_YS + 2 * 64 * 64 * 4;
DI void phase_s5_final_unit(const Ctx& c, int l, int u) {
    unsigned char* L = c.smem;
    const float* s5t = (const float*)(c.ws + WS_WSM + OFF_S5T);
    const float* CIN = (const float*)(c.ws + WS_WSM + OFF_S5C);
    const bf16_t* PS = (const bf16_t*)(c.ws + WS_P + P_PS);
    const int gq = u & 3, ct = (u >> 2) % S5N, b = u / (4 * S5N);
    const int wave = c.wave, lane = c.lane, gl = wave >> 1, dir = wave & 1, g = gq * 4 + gl, n16 = lane & 15, q4 = lane >> 4;
    __syncthreads();
    {
        const int t = c.tid >> 3, part = c.tid & 7;
        *(u32x4*)(L + S5_US + t * 128 + part * 16) = *(const u32x4*)(PS + (size_t)(b * TZ + ct * S5C + t) * 256 + gq * 64 + part * 8);
    }
    const float* tbase = s5t + ((size_t)((l * 2 + dir) * 16 + g) * 64) * 36;
    bf16x8 bfr[8], cfr[4];
#pragma unroll
    for (int j = 0; j < 8; ++j) {
        const int pp = 16 * j + n16, p = pp & 63; const float* tb = tbase + (size_t)p * 36 + (pp < 64 ? 4 : 20) + 8 * (q4 & 1);
        u32x4 w4 = {0u, 0u, 0u, 0u};
        if (q4 < 2) { w4.x = pack2(tb[0], tb[1]); w4.y = pack2(tb[2], tb[3]); w4.z = pack2(tb[4], tb[5]); w4.w = pack2(tb[6], tb[7]); }
        bfr[j] = __builtin_bit_cast(bf16x8, w4);
    }
    {
        const float* cre = c.in[29] + ((size_t)((l * 2 + dir) * 16 + g) * 16 + n16) * 64; const float* cim = c.in[30] + ((size_t)((l * 2 + dir) * 16 + g) * 16 + n16) * 64;
#pragma unroll
        for (int s = 0; s < 4; ++s) {
            const int pp = 32 * s + 8 * q4; const float sg = pp < 64 ? 1.f : -1.f; const float* src = (pp < 64 ? cre + pp : cim + (pp - 64));
            u32x4 w4; w4.x = pack2(sg * src[0], sg * src[1]); w4.y = pack2(sg * src[2], sg * src[3]); w4.z = pack2(sg * src[4], sg * src[5]); w4.w = pack2(sg * src[6], sg * src[7]);
            cfr[s] = __builtin_bit_cast(bf16x8, w4);
        }
    }
    const float are = tbase[(size_t)lane * 36], aim = tbase[(size_t)lane * 36 + 1];
    const int cd = dir == 0 ? ct : (ct < S5NC ? S5NC - 1 - ct : S5N + S5NC - 1 - ct);
    const float2 ci = *(const float2*)(CIN + ((size_t)(((b * 2 + dir) * 16 + g) * S5N + cd) * 64 + lane) * 2);
    float xr = ci.x, xi = ci.y;
    const float dsk = c.in[31][(size_t)l * 256 + g * 16 + n16];
    bf16_t* BU = (bf16_t*)(L + S5_WV + wave * 8192); bf16_t* XB = BU + 16 * 128;
    float* YS = (float*)(L + S5_YS) + dir * 64 * 64;
    __syncthreads();
#pragma unroll 1
    for (int sb = 0; sb < 4; ++sb) {
        const int stepA = 16 * sb + n16, tlA = dir == 0 ? stepA : 63 - stepA;
        u32x4 a4 = {0u, 0u, 0u, 0u};
        if (q4 < 2) a4 = *(const u32x4*)(L + S5_US + tlA * 128 + gl * 32 + q4 * 16);
        const bf16x8 af = __builtin_bit_cast(bf16x8, a4);
#pragma unroll
        for (int j = 0; j < 8; ++j) {
            f32x4 acc = {0.f, 0.f, 0.f, 0.f};
            acc = __builtin_amdgcn_mfma_f32_16x16x32_bf16(af, bfr[j], acc, 0, 0, 0);
#pragma unroll
            for (int rr = 0; rr < 4; ++rr) BU[(4 * q4 + rr) * 128 + 16 * j + n16] = f2bf(acc[rr]);
        }
#pragma unroll
        for (int ii = 0; ii < 16; ++ii) {
            const float br = bf2f(BU[ii * 128 + lane]), bi = bf2f(BU[ii * 128 + 64 + lane]);
            const float nr = are * xr - aim * xi + br, ni = are * xi + aim * xr + bi; xr = nr; xi = ni;
            XB[ii * 128 + lane] = f2bf(xr); XB[ii * 128 + 64 + lane] = f2bf(xi);
        }
        f32x4 ya = {0.f, 0.f, 0.f, 0.f};
#pragma unroll
        for (int s = 0; s < 4; ++s) {
            const bf16x8 xf = *(const bf16x8*)((const unsigned char*)XB + n16 * 256 + (32 * s + 8 * q4) * 2);
            ya = __builtin_amdgcn_mfma_f32_16x16x32_bf16(xf, cfr[s], ya, 0, 0, 0);
        }
#pragma unroll
        for (int rr = 0; rr < 4; ++rr) {
            const int step = 16 * sb + 4 * q4 + rr, tl = dir == 0 ? step : 63 - step;
            float y = ya[rr];
            if (dir == 0) y += dsk * bf2f(*(const bf16_t*)(L + S5_US + tl * 128 + (gl * 16 + n16) * 2));
            YS[tl * 64 + gl * 16 + n16] = y;
        }
    }
    __syncthreads();
    bf16_t* ZG = (bf16_t*)(c.ws + WS_MISC + MS_ZG);
    {
        const float* Y0 = (const float*)(L + S5_YS); const float* Y1 = Y0 + 64 * 64;
        for (int e = c.tid; e < 64 * 16; e += NTHR) {
            const int i = e >> 4, c4 = (e & 15) * 4; const float4 y0 = *(const float4*)(Y0 + i * 64 + c4), y1 = *(const float4*)(Y1 + i * 64 + c4);
            *(u32x2*)(ZG + (size_t)(b * TZ + ct * S5C + i) * 256 + gq * 64 + c4) = pack4(gelu_tanh(y0.x + y1.x), gelu_tanh(y0.y + y1.y), gelu_tanh(y0.z + y1.z), gelu_tanh(y0.w + y1.w));
        }
    }
}

DI void phase_small_gemms(const Ctx& c, int l) {
    unsigned char* ws = c.ws; unsigned char* wsm = ws + WS_WSM;
    const bf16_t* CQN = (const bf16_t*)(ws + WS_MISC + MS_CQN);
    const float* rope = (const float*)(wsm + OFF_ROPE);
    constexpr int NMT = NZ / 256;
    int base = 0;
    const int G = gridDim.x, bid = blockIdx.x;
    {
        const bf16_t* W = (const bf16_t*)(wsm + OFF_WUQT + l * SZ_WUQT); bf16_t* QM = (bf16_t*)(ws + WS_EXPW + MX_QM);
        const float qs = 0.10206207261596577f * LOG2E;
        for (int u = (bid + G - base % G) % G; u < NMT * 3; u += G) {
            const int mt = u / 3, nt = u % 3, r0 = mt * 256, c0 = nt * 128;
            gemm_tile<4, 0>(c, 256, [&](int i) { return CQN + (size_t)(r0 + i) * 384; }, [&](int i) { return W + (size_t)(c0 + i) * 256; }, NoHook(),
                [&](f32x4 (&acc)[4][4], int wr, int wc, int fr, int fq) {
#pragma unroll
                    for (int n = 0; n < 4; ++n) {
                        const int col = c0 + wc + n * 16 + fq * 4, h = col / 96, d = col % 96;
                        const bool rp = d >= 64;
#pragma unroll
                        for (int m = 0; m < 4; ++m) {
                            const int row = r0 + wr + m * 16 + fr, b = row / TZ, s = row % TZ; f32x4 v = acc[m][n];
                            f32x4 pv; pv[0] = __shfl_xor(v[0], 32, 64); pv[1] = __shfl_xor(v[1], 32, 64); pv[2] = __shfl_xor(v[2], 32, 64); pv[3] = __shfl_xor(v[3], 32, 64);
                            if (rp && s >= CTX) {
                                const int i0 = d - 64;
                                const float* cs = rope + ((size_t)(s - CTX) * 16 + (i0 >> 4) * 8 + (i0 & 7)) * 2;
                                const bool hi = (i0 & 8) != 0;
#pragma unroll
                                for (int j = 0; j < 4; ++j) v[j] = v[j] * cs[2 * j] + (hi ? pv[j] : -pv[j]) * cs[2 * j + 1];
                            }
                            *(u32x2*)(QM + ((size_t)(b * 4 + h) * TZ + s) * 96 + d) = pack4(v[0] * qs, v[1] * qs, v[2] * qs, v[3] * qs);
                        }
                    }
                });
        }
        base += NMT * 3;
    }
    {
        const bf16_t* W = (const bf16_t*)(wsm + OFF_WUKVT + l * SZ_WUKVT); bf16_t* KM = (bf16_t*)(ws + WS_EXPW + MX_KM); bf16_t* VMT = (bf16_t*)(ws + WS_EXPW + MX_VMT);
        for (int u = (bid + G - base % G) % G; u < NMT * 4; u += G) {
            const int mt = u / 4, nt = u % 4, r0 = mt * 256, c0 = nt * 128;
            gemm_tile<4, 0>(c, 128, [&](int i) { return CQN + (size_t)(r0 + i) * 384 + 256; }, [&](int i) { return W + (size_t)(c0 + i) * 128; }, NoHook(),
                [&](f32x4 (&acc)[4][4], int wr, int wc, int fr, int fq) {
#pragma unroll
                    for (int n = 0; n < 4; ++n) {
                        const int col = c0 + wc + n * 16 + fq * 4, h = col >> 7, d = col & 127;
#pragma unroll
                        for (int m = 0; m < 4; ++m) {
                            const int row = r0 + wr + m * 16 + fr, b = row / TZ, s = row % TZ; const f32x4 v = acc[m][n];
                            if (d < 64) *(u32x2*)(KM + ((size_t)(b * 4 + h) * TZ + s) * 96 + d) = pack4(v[0], v[1], v[2], v[3]);
                            else {
#pragma unroll
                                for (int j = 0; j < 4; ++j) VMT[((size_t)(b * 4 + h) * 64 + (d - 64 + j)) * TZ + s] = f2bf(v[j]);
                            }
                        }
                    }
                });
        }
        base += NMT * 4;
    }
    bf16_t* SE = (bf16_t*)(ws + WS_P + P_PR); bf16_t* SAD = SE + (size_t)2 * NZ * 256; bf16_t* SKD = SAD + (size_t)2 * NZ * 256;
    {
        const bf16_t* A = (const bf16_t*)(ws + WS_MISC + MS_TW); const bf16_t* W = (const bf16_t*)(wsm + OFF_W2T + l * SZ_W2T);
        const float* w0 = c.in[14] + (size_t)l * 512;
        for (int u = (bid + G - base % G) % G; u < NMT * 4; u += G) {
            const int mt = u / 4, nt = u % 4, r0 = mt * 256, c0 = nt * 128;
            gemm_tile<4, 0>(c, 64, [&](int i) { return A + (size_t)(r0 + i) * 64; }, [&](int i) { return W + (size_t)(c0 + i) * 64; }, NoHook(),
                [&](f32x4 (&acc)[4][4], int wr, int wc, int fr, int fq) {
#pragma unroll
                    for (int n = 0; n < 4; ++n) {
                        const int col = c0 + wc + n * 16 + fq * 4, d = col >> 8, cc = col & 255; const float4 w0v = *(const float4*)(w0 + col);
#pragma unroll
                        for (int m = 0; m < 4; ++m) {
                            const int row = r0 + wr + m * 16 + fr; const f32x4 v = acc[m][n]; float e[4];
                            const float x[4] = {w0v.x + v[0], w0v.y + v[1], w0v.z + v[2], w0v.w + v[3]};
#pragma unroll
                            for (int j = 0; j < 4; ++j) { const float sp = (x[j] < -20.f) ? -x[j] : log1pf(__expf(-x[j])); e[j] = __expf(-sp - 0.5f); }
                            *(u32x2*)(SE + ((size_t)d * NZ + row) * 256 + cc) = pack4(e[0], e[1], e[2], e[3]);
                        }
                    }
                });
        }
        base += NMT * 4;
    }
    {
        const bf16_t* A = (const bf16_t*)(ws + WS_MISC + MS_AL); const bf16_t* W = (const bf16_t*)(wsm + OFF_A2T + l * SZ_A2T);
        const float* a0 = c.in[16] + (size_t)l * 512; const float* k_a = c.in[20] + (size_t)l * 256; const bf16_t* KB = (const bf16_t*)(ws + WS_EXPW + MX_KB);
        for (int u = (bid + G - base % G) % G; u < NMT * 4; u += G) {
            const int mt = u / 4, nt = u % 4, r0 = mt * 256, c0 = nt * 128;
            gemm_tile<4, 0>(c, 64, [&](int i) { return A + (size_t)(r0 + i) * 64; }, [&](int i) { return W + (size_t)(c0 + i) * 64; }, NoHook(),
                [&](f32x4 (&acc)[4][4], int wr, int wc, int fr, int fq) {
#pragma unroll
                    for (int n = 0; n < 4; ++n) {
                        const int col = c0 + wc + n * 16 + fq * 4, d = col >> 8, cc = col & 255; const float4 a0v = *(const float4*)(a0 + col), kav = *(const float4*)(k_a + cc);
#pragma unroll
                        for (int m = 0; m < 4; ++m) {
                            const int row = r0 + wr + m * 16 + fr; const f32x4 v = acc[m][n];
                            const float ad0 = sigmoidf_(a0v.x + v[0]), ad1 = sigmoidf_(a0v.y + v[1]), ad2 = sigmoidf_(a0v.z + v[2]), ad3 = sigmoidf_(a0v.w + v[3]);
                            float k[4]; unpack4(*(const u32x2*)(KB + (size_t)row * 256 + cc), k);
                            *(u32x2*)(SAD + ((size_t)d * NZ + row) * 256 + cc) = pack4(ad0, ad1, ad2, ad3);
                            *(u32x2*)(SKD + ((size_t)d * NZ + row) * 256 + cc) = pack4(k[0] * (1.f + (ad0 - 1.f) * kav.x), k[1] * (1.f + (ad1 - 1.f) * kav.y), k[2] * (1.f + (ad2 - 1.f) * kav.z), k[3] * (1.f + (ad3 - 1.f) * kav.w));
                        }
                    }
                });
        }
        base += NMT * 4;
    }
    {
        const bf16_t* A = (const bf16_t*)(ws + WS_MISC + MS_SG); const bf16_t* W = (const bf16_t*)(wsm + OFF_G2T + l * SZ_G2T); bf16_t* GG = (bf16_t*)(ws + WS_MISC + MS_GG);
        for (int u = (bid + G - base % G) % G; u < NMT * 2; u += G) {
            const int mt = u / 2, nt = u % 2, r0 = mt * 256, c0 = nt * 128;
            gemm_tile<4, 0>(c, 128, [&](int i) { return A + (size_t)(r0 + i) * 128; }, [&](int i) { return W + (size_t)(c0 + i) * 128; }, NoHook(),
                [&](f32x4 (&acc)[4][4], int wr, int wc, int fr, int fq) {
#pragma unroll
                    for (int n = 0; n < 4; ++n)
#pragma unroll
                        for (int m = 0; m < 4; ++m) { const f32x4 v = acc[m][n];
                            *(u32x2*)(GG + (size_t)(r0 + wr + m * 16 + fr) * 256 + c0 + wc + n * 16 + fq * 4) = pack4(v[0], v[1], v[2], v[3]); }
                });
        }
        base += NMT * 2;
    }
}

DI int krow(int s, int h, int j) { return 16 * s + 8 * (j >> 2) + 4 * h + (j & 3); }
constexpr int ATT_PARK = 48 * 1024;
template <int MODE>
DI void attn_pass(const Ctx& c, int l, int b, int h, int q0, int nkeys) {
    constexpr int DROW = MODE == 0 ? 96 : 64;
    constexpr int DQ = MODE == 0 ? 96 : 32, KS = DQ / 16;
    constexpr int DOFF = MODE == 2 ? 32 : 0;
    constexpr int KPITCH = DQ * 2 + 16;
    constexpr int VPITCH = 64 * 2 + 16;
    constexpr int KBYTES = 64 * KPITCH, VBYTES = 64 * VPITCH, STG = KBYTES + VBYTES;
    unsigned char* ws = c.ws; const int tid = c.tid, lane = c.lane, wave = c.wave, r = lane & 31, hh = lane >> 5;
    const bf16_t* Q = (const bf16_t*)(ws + WS_EXPW + (MODE == 0 ? MX_QM : MX_QD)) + (size_t)(b * 4 + h) * TZ * DROW + DOFF;
    const bf16_t* Kp = (const bf16_t*)(ws + WS_EXPW + (MODE == 0 ? MX_KM : MX_KD)) + (size_t)(b * 4 + h) * TZ * DROW + DOFF;
    const bf16_t* Vt = (const bf16_t*)(ws + WS_EXPW + (MODE == 0 ? MX_VMT : MX_VDT)) + (size_t)(b * 4 + h) * 64 * TZ;
    unsigned char* smem = c.smem;
    bf16x8 qf[KS];
    const int qrow = q0 + wave * 32 + r;
#pragma unroll
    for (int ks = 0; ks < KS; ++ks) qf[ks] = *(const bf16x8*)(Q + (size_t)qrow * DROW + ks * 16 + hh * 8);
    f32x16 oacc[2];
    float mrun = -1e30f, lrun = 0.f;
#pragma unroll
    for (int t = 0; t < 2; ++t)
#pragma unroll
        for (int i = 0; i < 16; ++i) oacc[t][i] = 0.f;
    constexpr int CPR = DQ / 8, KCH = 64 * CPR;
    u32x4 kreg[2], vreg;
    auto gload = [&](int kt) {
        const int k0 = kt * 64;
#pragma unroll
        for (int i = 0; i < 2; ++i) { const int ch = tid + i * NTHR; if (ch < KCH) kreg[i] = *(const u32x4*)(Kp + (size_t)(k0 + ch / CPR) * DROW + (ch % CPR) * 8); }
        vreg = *(const u32x4*)(Vt + (size_t)(tid >> 3) * TZ + k0 + (tid & 7) * 8);
    };
    auto lstore = [&](int buf) {
        unsigned char* sk = smem + buf * STG; unsigned char* sv = sk + KBYTES;
#pragma unroll
        for (int i = 0; i < 2; ++i) { const int ch = tid + i * NTHR; if (ch < KCH) *(u32x4*)(sk + (ch / CPR) * KPITCH + (ch % CPR) * 16) = kreg[i]; }
        *(u32x4*)(sv + (tid >> 3) * VPITCH + (tid & 7) * 16) = vreg;
    };
    const int NT = nkeys / 64;
    __syncthreads();
    gload(0);
    for (int kt = 0; kt < NT; ++kt) {
        lstore(kt & 1);
        if (kt + 1 < NT) gload(kt + 1);
        __syncthreads();
        const unsigned char* sk = smem + (kt & 1) * STG; const unsigned char* sv = sk + KBYTES;
        f32x16 sacc[2];
#pragma unroll
        for (int kg = 0; kg < 2; ++kg) {
#pragma unroll
            for (int i = 0; i < 16; ++i) sacc[kg][i] = 0.f;
#pragma unroll
            for (int ks = 0; ks < KS; ++ks) {
                const bf16x8 kf = *(const bf16x8*)(sk + (kg * 32 + r) * KPITCH + ks * 32 + hh * 16);
                sacc[kg] = __builtin_amdgcn_mfma_f32_32x32x16_bf16(kf, qf[ks], sacc[kg], 0, 0, 0);
            }
        }
        float mx = sacc[0][0];
#pragma unroll
        for (int kg = 0; kg < 2; ++kg)
#pragma unroll
            for (int i = 0; i < 16; ++i) mx = fmaxf(mx, sacc[kg][i]);
        mx = fmaxf(mx, __shfl_xor(mx, 32, 64));
        const float mnew = fmaxf(mrun, mx), alpha = __builtin_amdgcn_exp2f(mrun - mnew);
        mrun = mnew;
        float psum = 0.f;
#pragma unroll
        for (int kg = 0; kg < 2; ++kg)
#pragma unroll
            for (int i = 0; i < 16; ++i) { const float p = __builtin_amdgcn_exp2f(sacc[kg][i] - mnew); sacc[kg][i] = p; psum += p; }
        lrun = lrun * alpha + psum;
#pragma unroll
        for (int t = 0; t < 2; ++t)
#pragma unroll
            for (int i = 0; i < 16; ++i) oacc[t][i] *= alpha;
#pragma unroll
        for (int kg = 0; kg < 2; ++kg)
#pragma unroll
            for (int s = 0; s < 2; ++s) {
                u32x4 pk; pk.x = pack2(sacc[kg][8 * s + 0], sacc[kg][8 * s + 1]); pk.y = pack2(sacc[kg][8 * s + 2], sacc[kg][8 * s + 3]);
                pk.z = pack2(sacc[kg][8 * s + 4], sacc[kg][8 * s + 5]); pk.w = pack2(sacc[kg][8 * s + 6], sacc[kg][8 * s + 7]);
                const bf16x8 pf = __builtin_bit_cast(bf16x8, pk);
#pragma unroll
                for (int t = 0; t < 2; ++t) {
                    const unsigned char* vrow = sv + (t * 32 + r) * VPITCH + (kg * 32 + 16 * s + 4 * hh) * 2;
                    const u32x2 lo = *(const u32x2*)vrow, hi2 = *(const u32x2*)(vrow + 16);
                    u32x4 vv; vv.x = lo.x; vv.y = lo.y; vv.z = hi2.x; vv.w = hi2.y;
                    oacc[t] = __builtin_amdgcn_mfma_f32_32x32x16_bf16(__builtin_bit_cast(bf16x8, vv), pf, oacc[t], 0, 0, 0);
                }
            }
    }
    const float inv = 1.f / (lrun + __shfl_xor(lrun, 32, 64));
    bf16_t* Ycat = (bf16_t*)(ws + WS_BUFA);
    const int zrow = b * TZ + qrow;
    float* park = (float*)(smem + ATT_PARK) + tid;
    if (MODE == 0) {
#pragma unroll
        for (int t = 0; t < 2; ++t)
#pragma unroll
            for (int i4 = 0; i4 < 4; ++i4) {
                const int dv = t * 32 + 8 * i4 + 4 * hh;
                *(u32x2*)(Ycat + (size_t)zrow * D + h * 64 + dv) = pack4(oacc[t][4 * i4] * inv, oacc[t][4 * i4 + 1] * inv, oacc[t][4 * i4 + 2] * inv, oacc[t][4 * i4 + 3] * inv);
            }
    } else if (MODE == 1) {
#pragma unroll
        for (int t = 0; t < 2; ++t)
#pragma unroll
            for (int i = 0; i < 16; ++i) park[(t * 16 + i) * NTHR] = oacc[t][i] * inv;
    } else {
        const float lam = ((const float*)(ws + WS_WSM + OFF_LAM))[l];
        const float lam_init = 0.8f - 0.6f * __expf(-0.3f * (float)l);
        float ss = 0.f;
#pragma unroll
        for (int t = 0; t < 2; ++t)
#pragma unroll
            for (int i = 0; i < 16; ++i) { const float o = park[(t * 16 + i) * NTHR] - lam * oacc[t][i] * inv; oacc[t][i] = o; ss += o * o; }
        ss += __shfl_xor(ss, 32, 64);
        const float rs = rsqrtf(ss * (1.f / 64.f) + 1e-5f) * (1.f - lam_init);
        const float* sg = c.in[38] + l * 64;
#pragma unroll
        for (int t = 0; t < 2; ++t)
#pragma unroll
            for (int i4 = 0; i4 < 4; ++i4) {
                const int dv = t * 32 + 8 * i4 + 4 * hh; const float4 g = *(const float4*)(sg + dv);
                *(u32x2*)(Ycat + (size_t)zrow * D + 768 + h * 64 + dv) = pack4(oacc[t][4 * i4] * rs * g.x, oacc[t][4 * i4 + 1] * rs * g.y, oacc[t][4 * i4 + 2] * rs * g.z, oacc[t][4 * i4 + 3] * rs * g.w);
            }
    }
}
DI void phase_attention(const Ctx& c, int l) {
    const int nu = 512 + (l == 0 ? 16 : 0);
    for (int u = blockIdx.x; u < nu; u += gridDim.x) {
        int b, h, q0, nk; bool mla;
        if (u < 512) { const int k = u & 255; b = k >> 7; h = (k >> 5) & 3; q0 = CTX + (k & 31) * 256; nk = TZ; mla = u < 256; }
        else { const int k = u - 512; b = (k >> 2) & 1; h = k & 3; q0 = 0; nk = CTX; mla = k < 8; }
        if (mla) attn_pass<0>(c, l, b, h, q0, nk);
        else { attn_pass<1>(c, l, b, h, q0, nk); attn_pass<2>(c, l, b, h, q0, nk); }
    }
}

DI int rw_tok(int dir, int i) { return dir == 0 ? i : (i < CTX ? CTX - 1 - i : TZ - 1 - (i - CTX)); }
constexpr int RW_TS = 32;
constexpr int RW_STEP_F = 6 * 64 + 2;
constexpr int RW_BUF_F = RW_TS * RW_STEP_F;
template <int CTRL> DI float dpp_add(float x) { return x + __int_as_float(__builtin_amdgcn_update_dpp(0, __float_as_int(x), CTRL, 0xf, 0xf, false)); }
DI float red16(float x) { x = dpp_add<0xB1>(x); x = dpp_add<0x4E>(x); x = dpp_add<0x141>(x); x = dpp_add<0x140>(x); return x; }
DI float red8(float x) { x = dpp_add<0xB1>(x); x = dpp_add<0x4E>(x); x = dpp_add<0x141>(x); return x; }
struct RwRegs { u32x4 r, v, kk, e, ad, kd; };
DI void rw_load(const Ctx& c, int b, int h, int dir, int chunk, int t, RwRegs& g) {
    const bf16_t* RB = (const bf16_t*)(c.ws + WS_EXPW + MX_RB); const bf16_t* VB = (const bf16_t*)(c.ws + WS_EXPW + MX_VB); const bf16_t* KKB = (const bf16_t*)(c.ws + WS_EXPW + MX_KKB);
    const bf16_t* SE = (const bf16_t*)(c.ws + WS_P + P_PR) + (size_t)dir * NZ * 256; const bf16_t* SAD = SE + (size_t)2 * NZ * 256; const bf16_t* SKD = SAD + (size_t)2 * NZ * 256;
    const int i = chunk * RW_TS + (t >> 3), z = b * TZ + rw_tok(dir, i); const size_t o = (size_t)z * 256 + h * 64 + (t & 7) * 8;
    g.r = *(const u32x4*)(RB + o); g.v = *(const u32x4*)(VB + o); g.kk = *(const u32x4*)(KKB + o);
    g.e = *(const u32x4*)(SE + o); g.ad = *(const u32x4*)(SAD + o); g.kd = *(const u32x4*)(SKD + o);
}
DI void up8(const u32x4& u, float (&f)[8]) { f[0] = lo2f(u.x); f[1] = hi2f(u.x); f[2] = lo2f(u.y); f[3] = hi2f(u.y); f[4] = lo2f(u.z); f[5] = hi2f(u.z); f[6] = lo2f(u.w); f[7] = hi2f(u.w); }
DI void rw_process(const RwRegs& g, int t, float* buf) {
    float r[8], v[8], kk[8], e[8], ad[8], kd[8];
    up8(g.r, r); up8(g.v, v); up8(g.kk, kk); up8(g.e, e); up8(g.ad, ad); up8(g.kd, kd);
    float* f = buf + (t >> 3) * RW_STEP_F + (t & 7) * 8;
    float w[8], bv[8], wr[8]; float br = 0.f, kr = 0.f;
#pragma unroll
    for (int j = 0; j < 8; ++j) { w[j] = __expf(-e[j]); bv[j] = kk[j] * ad[j]; wr[j] = w[j] * r[j]; br += bv[j] * r[j]; kr += kd[j] * r[j]; }
    *(float4*)(f) = make_float4(w[0], w[1], w[2], w[3]); *(float4*)(f + 4) = make_float4(w[4], w[5], w[6], w[7]);
    *(float4*)(f + 64) = make_float4(kk[0], kk[1], kk[2], kk[3]); *(float4*)(f + 68) = make_float4(kk[4], kk[5], kk[6], kk[7]);
    *(float4*)(f + 128) = make_float4(bv[0], bv[1], bv[2], bv[3]); *(float4*)(f + 132) = make_float4(bv[4], bv[5], bv[6], bv[7]);
    *(float4*)(f + 192) = make_float4(kd[0], kd[1], kd[2], kd[3]); *(float4*)(f + 196) = make_float4(kd[4], kd[5], kd[6], kd[7]);
    *(float4*)(f + 256) = make_float4(wr[0], wr[1], wr[2], wr[3]); *(float4*)(f + 260) = make_float4(wr[4], wr[5], wr[6], wr[7]);
    *(float4*)(f + 320) = make_float4(v[0], v[1], v[2], v[3]); *(float4*)(f + 324) = make_float4(v[4], v[5], v[6], v[7]);
    br = red8(br); kr = red8(kr);
    if ((t & 7) == 0) { float* s = buf + (t >> 3) * RW_STEP_F + 384; s[0] = br; s[1] = kr; }
}
struct RwStep { float4 w, kk, bv, kd, wr; float vv, br, kr; };
DI void rw_ld(RwStep& s, const float* f, int kq, int row) {
    s.w = *(const float4*)(f + kq * 4); s.kk = *(const float4*)(f + 64 + kq * 4); s.bv = *(const float4*)(f + 128 + kq * 4);
    s.kd = *(const float4*)(f + 192 + kq * 4); s.wr = *(const float4*)(f + 256 + kq * 4); s.vv = f[320 + row]; s.br = f[384]; s.kr = f[385];
}
DI void phase_rwkv_scan_unit(const Ctx& c, int l, int u) {
    const int rg = u & 3, chain = u >> 2, dir = chain & 1, h = (chain >> 1) & 3, b = chain >> 3;
    float* buf0 = (float*)c.smem; float* buf1 = buf0 + RW_BUF_F;
    float* ybuf = buf1 + RW_BUF_F;
    float* YO = (float*)(c.ws + WS_BUFB) + (size_t)dir * NZ * 256 + (size_t)b * TZ * 256 + h * 64 + rg * 16;
    const int wave = c.wave, lane = c.lane, rr = lane >> 4, kq = lane & 15, rl = (wave & 3) * 4 + rr, row = rg * 16 + rl;
    const int t = c.tid - 256;
    float S0 = 0.f, S1 = 0.f, S2 = 0.f, S3 = 0.f;
    constexpr int NCH = TZ / RW_TS;
    RwRegs g;
    __syncthreads();
    if (wave >= 4) { rw_load(c, b, h, dir, 0, t, g); rw_process(g, t, buf0); rw_load(c, b, h, dir, 1, t, g); }
    __syncthreads();
    for (int ch = 0; ch < NCH; ++ch) {
        float* cur = buf0 + (ch & 1) * RW_BUF_F; float* nxt = buf0 + ((ch + 1) & 1) * RW_BUF_F;
        if (wave >= 4) {
            if (ch > 0) {
                const float* yb = ybuf + ((ch - 1) & 1) * RW_TS * 16;
#pragma unroll
                for (int i = 0; i < 2; ++i) { const int e = t + i * 256, st = e >> 4, rw = e & 15; YO[(size_t)rw_tok(dir, (ch - 1) * RW_TS + st) * 256 + rw] = yb[e]; }
            }
            if (ch + 1 < NCH) rw_process(g, t, nxt);
            if (ch + 2 < NCH) rw_load(c, b, h, dir, ch + 2, t, g);
        } else {
            float* yb = ybuf + (ch & 1) * RW_TS * 16 + rl;
            RwStep s0, s1;
            rw_ld(s0, cur, kq, row);
#pragma unroll 4
            for (int st = 0; st < RW_TS; st += 2) {
                rw_ld(s1, cur + (st + 1) * RW_STEP_F, kq, row);
                {
                    float sa = -((S0 * s0.kk.x + S1 * s0.kk.y) + (S2 * s0.kk.z + S3 * s0.kk.w));
                    float q = (S0 * s0.wr.x + S1 * s0.wr.y) + (S2 * s0.wr.z + S3 * s0.wr.w);
                    sa = red16(sa); q = red16(q);
                    S0 = fmaf(sa, s0.bv.x, fmaf(S0, s0.w.x, s0.vv * s0.kd.x)); S1 = fmaf(sa, s0.bv.y, fmaf(S1, s0.w.y, s0.vv * s0.kd.y));
                    S2 = fmaf(sa, s0.bv.z, fmaf(S2, s0.w.z, s0.vv * s0.kd.z)); S3 = fmaf(sa, s0.bv.w, fmaf(S3, s0.w.w, s0.vv * s0.kd.w));
                    yb[st * 16] = q + sa * s0.br + s0.vv * s0.kr;
                }
                if (st + 2 < RW_TS) rw_ld(s0, cur + (st + 2) * RW_STEP_F, kq, row);
                {
                    float sa = -((S0 * s1.kk.x + S1 * s1.kk.y) + (S2 * s1.kk.z + S3 * s1.kk.w));
                    float q = (S0 * s1.wr.x + S1 * s1.wr.y) + (S2 * s1.wr.z + S3 * s1.wr.w);
                    sa = red16(sa); q = red16(q);
                    S0 = fmaf(sa, s1.bv.x, fmaf(S0, s1.w.x, s1.vv * s1.kd.x)); S1 = fmaf(sa, s1.bv.y, fmaf(S1, s1.w.y, s1.vv * s1.kd.y));
                    S2 = fmaf(sa, s1.bv.z, fmaf(S2, s1.w.z, s1.vv * s1.kd.z)); S3 = fmaf(sa, s1.bv.w, fmaf(S3, s1.w.w, s1.vv * s1.kd.w));
                    yb[(st + 1) * 16] = q + sa * s1.br + s1.vv * s1.kr;
                }
            }
        }
        __syncthreads();
    }
    if (wave >= 4) {
        const float* yb = ybuf + ((NCH - 1) & 1) * RW_TS * 16;
#pragma unroll
        for (int i = 0; i < 2; ++i) { const int e = t + i * 256, st = e >> 4, rw = e & 15; YO[(size_t)rw_tok(dir, (NCH - 1) * RW_TS + st) * 256 + rw] = yb[e]; }
    }
}

constexpr int LA_AN = 0, LA_RN = 8192, LA_BN = 16384, LA_KN = 24576, LA_AT = 32768, LA_BHT = 40960, LA_KHT = 49152, LA_VT = 57344,
              LA_NBA = 65536  , LA_NKA = 81920, LA_NBRT = 90112, LA_NKRT = 98304, LA_P63 = 106496;
constexpr int LA_TMT = LA_AN, LA_M1 = LA_BN, LA_W1T = LA_KN, LA_Z1 = LA_NBA;
DI int crow(int reg, int h) { return (reg & 3) + 8 * (reg >> 2) + 4 * h; }
DI void mm_tile(f32x16& acc, const unsigned char* A, int i0, const unsigned char* BT, int j0, int r, int h) {
#pragma unroll
    for (int ks = 0; ks < 4; ++ks) {
        const bf16x8 a = *(const bf16x8*)(A + (i0 + r) * 128 + ks * 32 + h * 16);
        const bf16x8 b = *(const bf16x8*)(BT + (j0 + r) * 128 + ks * 32 + h * 16);
        acc = __builtin_amdgcn_mfma_f32_32x32x16_bf16(a, b, acc, 0, 0, 0);
    }
}
DI void zero16(f32x16& a) {
#pragma unroll
    for (int i = 0; i < 16; ++i) a[i] = 0.f;
}
DI void phase_rwkv_chunk_unit(const Ctx& c, int l, int unit) {
    unsigned char* L = c.smem; unsigned char* ws = c.ws;
    const int chain = unit / RNC, ch = unit % RNC, dir = chain & 1, hd = (chain >> 1) & 3, b = chain >> 3;
    const int tid = c.tid, lane = c.lane, wave = c.wave, r = lane & 31, h = lane >> 5;
    const bf16_t* RB = (const bf16_t*)(ws + WS_EXPW + MX_RB); const bf16_t* VB = (const bf16_t*)(ws + WS_EXPW + MX_VB); const bf16_t* KKB = (const bf16_t*)(ws + WS_EXPW + MX_KKB);
    const bf16_t* SE = (const bf16_t*)(ws + WS_P + P_PR) + (size_t)dir * NZ * 256; const bf16_t* SAD = SE + (size_t)2 * NZ * 256; const bf16_t* SKD = SAD + (size_t)2 * NZ * 256;
    float* CUM = (float*)(L + LA_NBA);
    __syncthreads();
    const int t = tid >> 3, k0 = (tid & 7) * 8;
    float rr[8], vv[8], kk[8], ee[8], ad[8], kd[8];
    {
        const int z = b * TZ + rw_tok(dir, ch * RC + t); const size_t o = (size_t)z * 256 + hd * 64 + k0;
        up8(*(const u32x4*)(RB + o), rr); up8(*(const u32x4*)(VB + o), vv); up8(*(const u32x4*)(KKB + o), kk);
        up8(*(const u32x4*)(SE + o), ee); up8(*(const u32x4*)(SAD + o), ad); up8(*(const u32x4*)(SKD + o), kd);
        *(float4*)(CUM + t * 64 + k0) = make_float4(ee[0], ee[1], ee[2], ee[3]); *(float4*)(CUM + t * 64 + k0 + 4) = make_float4(ee[4], ee[5], ee[6], ee[7]);
    }
    __syncthreads();
    if (wave == 0) { float cm = 0.f;
#pragma unroll 8
        for (int i = 0; i < RC; ++i) { cm += CUM[i * 64 + lane]; CUM[i * 64 + lane] = cm; } }
    __syncthreads();
    {
        float cm[8], c63[8];
        { const float4 a = *(const float4*)(CUM + t * 64 + k0), bq = *(const float4*)(CUM + t * 64 + k0 + 4); cm[0] = a.x; cm[1] = a.y; cm[2] = a.z; cm[3] = a.w; cm[4] = bq.x; cm[5] = bq.y; cm[6] = bq.z; cm[7] = bq.w; }
        { const float4 a = *(const float4*)(CUM + 63 * 64 + k0), bq = *(const float4*)(CUM + 63 * 64 + k0 + 4); c63[0] = a.x; c63[1] = a.y; c63[2] = a.z; c63[3] = a.w; c63[4] = bq.x; c63[5] = bq.y; c63[6] = bq.z; c63[7] = bq.w; }
        float at[8], rt[8], bt[8], kt[8], bh[8], kh[8];
#pragma unroll
        for (int j = 0; j < 8; ++j) {
            const float pt = __expf(-cm[j]), pp = __expf(-(cm[j] - ee[j])), ip = __expf(cm[j]), ph = __expf(-(c63[j] - cm[j])), bb = kk[j] * ad[j];
            at[j] = -kk[j] * pp; rt[j] = rr[j] * pt; bt[j] = bb * ip; kt[j] = kd[j] * ip; bh[j] = bb * ph; kh[j] = kd[j] * ph;
        }
        u32x4 w4;
        w4.x = pack2(at[0], at[1]); w4.y = pack2(at[2], at[3]); w4.z = pack2(at[4], at[5]); w4.w = pack2(at[6], at[7]); *(u32x4*)(L + LA_AN + t * 128 + k0 * 2) = w4;
        w4.x = pack2(rt[0], rt[1]); w4.y = pack2(rt[2], rt[3]); w4.z = pack2(rt[4], rt[5]); w4.w = pack2(rt[6], rt[7]); *(u32x4*)(L + LA_RN + t * 128 + k0 * 2) = w4;
        w4.x = pack2(bt[0], bt[1]); w4.y = pack2(bt[2], bt[3]); w4.z = pack2(bt[4], bt[5]); w4.w = pack2(bt[6], bt[7]); *(u32x4*)(L + LA_BN + t * 128 + k0 * 2) = w4;
        w4.x = pack2(kt[0], kt[1]); w4.y = pack2(kt[2], kt[3]); w4.z = pack2(kt[4], kt[5]); w4.w = pack2(kt[6], kt[7]); *(u32x4*)(L + LA_KN + t * 128 + k0 * 2) = w4;
#pragma unroll
        for (int j = 0; j < 8; ++j) {
            *(bf16_t*)(L + LA_AT + (k0 + j) * 128 + t * 2) = f2bf(at[j]); *(bf16_t*)(L + LA_BHT + (k0 + j) * 128 + t * 2) = f2bf(bh[j]);
            *(bf16_t*)(L + LA_KHT + (k0 + j) * 128 + t * 2) = f2bf(kh[j]); *(bf16_t*)(L + LA_VT + (k0 + j) * 128 + t * 2) = f2bf(vv[j]);
        }
        if (t == 63) {
            float* p63 = (float*)(L + LA_P63); float* gp = (float*)(ws + WS_RW + RW_P63) + (size_t)unit * 64;
#pragma unroll
            for (int j = 0; j < 8; ++j) { const float p = __expf(-c63[j]); p63[k0 + j] = p; gp[k0 + j] = p; }
        }
    }
    __syncthreads();
    {
        const int p = wave >> 1, i0 = (wave & 1) * 32;
        const unsigned char* A = L + (p == 0 ? LA_BN : p == 1 ? LA_KN : LA_RN);
        const unsigned char* BT = L + (p < 2 ? LA_AN : p == 2 ? LA_BN : LA_KN);
#pragma unroll
        for (int jt = 0; jt < 2; ++jt) {
            const int j0 = jt * 32; f32x16 acc; zero16(acc);
            mm_tile(acc, A, i0, BT, j0, r, h);
            const int col = j0 + r;
#pragma unroll
            for (int g = 0; g < 16; ++g) {
                const int row = i0 + crow(g, h);
                if (p == 0) ((float*)(L + LA_NBA))[row * 64 + col] = (row < col) ? acc[g] : 0.f;
                else if (p == 1) *(bf16_t*)(L + LA_NKA + row * 128 + col * 2) = f2bf((row < col) ? acc[g] : 0.f);
                else *(bf16_t*)(L + (p == 2 ? LA_NBRT : LA_NKRT) + row * 128 + col * 2) = f2bf((col <= row) ? acc[g] : 0.f);
            }
        }
    }
    __syncthreads();
    if (wave == 0) {
        const float* N = (const float*)(L + LA_NBA);
        float* TC = (float*)(L + LA_BN);
#pragma unroll 1
        for (int s = 63; s >= 0; --s) {
            float a0 = (s == lane) ? 1.f : 0.f, a1 = 0.f, a2 = 0.f, a3 = 0.f;
            int j = s + 1;
#pragma unroll 1
            for (; (j & 3) != 0 && j < 64; ++j) a0 = fmaf(N[s * 64 + j], TC[j * 64 + lane], a0);
#pragma unroll 2
            for (; j < 64; j += 4) {
                const float4 n = *(const float4*)(N + s * 64 + j);
                a0 = fmaf(n.x, TC[j * 64 + lane], a0); a1 = fmaf(n.y, TC[(j + 1) * 64 + lane], a1); a2 = fmaf(n.z, TC[(j + 2) * 64 + lane], a2); a3 = fmaf(n.w, TC[(j + 3) * 64 + lane], a3);
            }
            TC[s * 64 + lane] = (a0 + a1) + (a2 + a3);
        }
        unsigned char* dst = L + LA_TMT + lane * 128;
#pragma unroll
        for (int q = 0; q < 8; ++q) {
            u32x4 w4; w4.x = pack2(TC[(q * 8) * 64 + lane], TC[(q * 8 + 1) * 64 + lane]); w4.y = pack2(TC[(q * 8 + 2) * 64 + lane], TC[(q * 8 + 3) * 64 + lane]);
            w4.z = pack2(TC[(q * 8 + 4) * 64 + lane], TC[(q * 8 + 5) * 64 + lane]); w4.w = pack2(TC[(q * 8 + 6) * 64 + lane], TC[(q * 8 + 7) * 64 + lane]);
            *(u32x4*)(dst + q * 16) = w4;
        }
    }
    __syncthreads();
    {
        const int p = wave >> 2, i0 = ((wave >> 1) & 1) * 32, j0 = (wave & 1) * 32; f32x16 acc; zero16(acc);
        if (p == 0) {
            mm_tile(acc, L + LA_TMT, i0, L + LA_AT, j0, r, h);
#pragma unroll
            for (int g4 = 0; g4 < 4; ++g4) *(u32x2*)(L + LA_M1 + (j0 + r) * 128 + (i0 + 8 * g4 + 4 * h) * 2) = pack4(acc[4 * g4], acc[4 * g4 + 1], acc[4 * g4 + 2], acc[4 * g4 + 3]);
        } else {
            mm_tile(acc, L + LA_NKA, i0, L + LA_TMT, j0, r, h);
#pragma unroll
            for (int g4 = 0; g4 < 4; ++g4) *(u32x2*)(L + LA_W1T + (j0 + r) * 128 + (i0 + 8 * g4 + 4 * h) * 2) = pack4(acc[4 * g4], acc[4 * g4 + 1], acc[4 * g4 + 2], acc[4 * g4 + 3]);
        }
    }
    __syncthreads();
    if (wave < 4) {
        const int i0 = (wave >> 1) * 32, j0 = (wave & 1) * 32; f32x16 acc; zero16(acc);
        mm_tile(acc, L + LA_W1T, i0, L + LA_VT, j0, r, h);
#pragma unroll
        for (int g4 = 0; g4 < 4; ++g4) *(u32x2*)(L + LA_Z1 + (j0 + r) * 128 + (i0 + 8 * g4 + 4 * h) * 2) = pack4(acc[4 * g4], acc[4 * g4 + 1], acc[4 * g4 + 2], acc[4 * g4 + 3]);
    }
    __syncthreads();
    {
        const int p = wave >> 1, i0 = (wave & 1) * 32;
        bf16_t* GM3 = (bf16_t*)(ws + WS_RW + RW_M3) + (size_t)unit * 4096; bf16_t* GM2 = (bf16_t*)(ws + WS_RW + RW_M2) + (size_t)unit * 4096; bf16_t* GZ5 = (bf16_t*)(ws + WS_RW + RW_Z5) + (size_t)unit * 4096;
        float* YO = (float*)(ws + WS_BUFB) + (size_t)dir * NZ * 256;
#pragma unroll
        for (int jt = 0; jt < 2; ++jt) {
            const int j0 = jt * 32; f32x16 acc; zero16(acc);
            if (p == 0) {
                mm_tile(acc, L + LA_M1, i0, L + LA_NBRT, j0, r, h);
#pragma unroll
                for (int g4 = 0; g4 < 4; ++g4) { const int tt = j0 + r, kq = i0 + 8 * g4 + 4 * h; float rv[4]; unpack4(*(const u32x2*)(L + LA_RN + tt * 128 + kq * 2), rv);
                    *(u32x2*)(GM2 + tt * 64 + kq) = pack4(acc[4 * g4] + rv[0], acc[4 * g4 + 1] + rv[1], acc[4 * g4 + 2] + rv[2], acc[4 * g4 + 3] + rv[3]); }
            } else if (p == 1) {
                mm_tile(acc, L + LA_NBRT, i0, L + LA_Z1, j0, r, h); mm_tile(acc, L + LA_NKRT, i0, L + LA_VT, j0, r, h);
#pragma unroll
                for (int g = 0; g < 16; ++g) { const int tt = i0 + crow(g, h); YO[(size_t)(b * TZ + rw_tok(dir, ch * RC + tt)) * 256 + hd * 64 + j0 + r] = acc[g]; }
            } else if (p == 2) {
                mm_tile(acc, L + LA_M1, i0, L + LA_BHT, j0, r, h);
#pragma unroll
                for (int g4 = 0; g4 < 4; ++g4) *(u32x2*)(GM3 + (j0 + r) * 64 + i0 + 8 * g4 + 4 * h) = pack4(acc[4 * g4], acc[4 * g4 + 1], acc[4 * g4 + 2], acc[4 * g4 + 3]);
            } else {
                mm_tile(acc, L + LA_BHT, i0, L + LA_Z1, j0, r, h); mm_tile(acc, L + LA_KHT, i0, L + LA_VT, j0, r, h);
#pragma unroll
                for (int g4 = 0; g4 < 4; ++g4) *(u32x2*)(GZ5 + (j0 + r) * 64 + i0 + 8 * g4 + 4 * h) = pack4(acc[4 * g4], acc[4 * g4 + 1], acc[4 * g4 + 2], acc[4 * g4 + 3]);
            }
        }
    }
}
DI void phase_rwkv_chunks(const Ctx& c, int l) {
    for (int u = blockIdx.x; u < 16 * RNC; u += gridDim.x) phase_rwkv_chunk_unit(c, l, u);
}
DI bf16x8 pack8(const f32x16& x, int s) {
    u32x4 p; p.x = pack2(x[8 * s], x[8 * s + 1]); p.y = pack2(x[8 * s + 2], x[8 * s + 3]); p.z = pack2(x[8 * s + 4], x[8 * s + 5]); p.w = pack2(x[8 * s + 6], x[8 * s + 7]);
    return __builtin_bit_cast(bf16x8, p);
}
DI bf16x8 ldfrag(const bf16_t* rowp, int s, int h) {
    const u32x2 lo = *(const u32x2*)(rowp + 16 * s + 4 * h), hi = *(const u32x2*)(rowp + 16 * s + 8 + 4 * h);
    u32x4 v; v.x = lo.x; v.y = lo.y; v.z = hi.x; v.w = hi.y; return __builtin_bit_cast(bf16x8, v);
}
constexpr int SQ_PITCH = 144, SQ_MAT = 64 * SQ_PITCH;
constexpr int SQA_M3 = 0, SQA_Z5 = SQ_MAT, SQA_P63 = 2 * SQ_MAT, SQA_BYTES = SQA_P63 + 256;
constexpr int SQB_M2 = 0, SQB_Y = SQ_MAT, SQB_BYTES = SQB_Y + 64 * 64 * 4;
constexpr int SQ_A0 = 0, SQ_B0 = 2 * SQA_BYTES, SQ_XB = SQ_B0 + 2 * SQB_BYTES;
DI bf16x8 ldfrag_l(const unsigned char* rowp, int s, int h) {
    const u32x2 lo = *(const u32x2*)(rowp + (16 * s + 4 * h) * 2), hi = *(const u32x2*)(rowp + (16 * s + 8 + 4 * h) * 2);
    u32x4 v; v.x = lo.x; v.y = lo.y; v.z = hi.x; v.w = hi.y; return __builtin_bit_cast(bf16x8, v);
}
struct SqRegsA { u32x4 m3[2], z5[2], p63; };
struct SqRegsB { u32x4 m2[2], y[4]; };
DI void sqa_gload(const Ctx& c, size_t unit, int lt, SqRegsA& g) {
    const unsigned char* g3 = c.ws + WS_RW + RW_M3 + unit * 8192; const unsigned char* g5 = c.ws + WS_RW + RW_Z5 + unit * 8192;
#pragma unroll
    for (int i = 0; i < 2; ++i) { const int id = lt + i * 256; g.m3[i] = *(const u32x4*)(g3 + id * 16); g.z5[i] = *(const u32x4*)(g5 + id * 16); }
    if (lt < 16) g.p63 = *(const u32x4*)(c.ws + WS_RW + RW_P63 + unit * 256 + lt * 16);
}
DI void sqa_lstore(unsigned char* st, int lt, const SqRegsA& g) {
#pragma unroll
    for (int i = 0; i < 2; ++i) { const int id = lt + i * 256, row = id >> 3, part = id & 7;
        *(u32x4*)(st + SQA_M3 + row * SQ_PITCH + part * 16) = g.m3[i]; *(u32x4*)(st + SQA_Z5 + row * SQ_PITCH + part * 16) = g.z5[i]; }
    if (lt < 16) *(u32x4*)(st + SQA_P63 + lt * 16) = g.p63;
}
DI void sqb_gload(const Ctx& c, size_t unit, const float* YO, int dir, int ch, int lt, SqRegsB& g) {
    const unsigned char* g2 = c.ws + WS_RW + RW_M2 + unit * 8192;
#pragma unroll
    for (int i = 0; i < 2; ++i) g.m2[i] = *(const u32x4*)(g2 + (lt + i * 256) * 16);
#pragma unroll
    for (int i = 0; i < 4; ++i) { const int id = lt + i * 256; g.y[i] = *(const u32x4*)(YO + (size_t)rw_tok(dir, ch * RC + (id >> 4)) * 256 + (id & 15) * 4); }
}
DI void sqb_lstore(unsigned char* st, int lt, const SqRegsB& g) {
#pragma unroll
    for (int i = 0; i < 2; ++i) { const int id = lt + i * 256; *(u32x4*)(st + SQB_M2 + (id >> 3) * SQ_PITCH + (id & 7) * 16) = g.m2[i]; }
#pragma unroll
    for (int i = 0; i < 4; ++i) { const int id = lt + i * 256; *(u32x4*)(st + SQB_Y + (id >> 4) * 256 + (id & 15) * 16) = g.y[i]; }
}
DI void sqb_store_y(float* YO, int dir, int ch, const unsigned char* st, int lt) {
#pragma unroll
    for (int i = 0; i < 4; ++i) { const int id = lt + i * 256; *(u32x4*)(YO + (size_t)rw_tok(dir, ch * RC + (id >> 4)) * 256 + (id & 15) * 4) = *(const u32x4*)(st + SQB_Y + (id >> 4) * 256 + (id & 15) * 16); }
}
DI void phase_rwkv_seq_block(const Ctx& c, int l, int chain) {
    unsigned char* L = c.smem; const int lane = c.lane, wave = c.wave, r = lane & 31, h = lane >> 5;
    const int dir = chain & 1, hd = (chain >> 1) & 3, b = chain >> 3, lt = c.tid - 256, vh = wave & 1;
    const size_t unit0 = (size_t)chain * RNC;
    __syncthreads();
    if (wave >= 4) {
        float* YO = (float*)(c.ws + WS_BUFB) + (size_t)dir * NZ * 256 + (size_t)b * TZ * 256 + hd * 64;
        SqRegsA ga; SqRegsB gb;
        sqa_gload(c, unit0, lt, ga); sqa_lstore(L + SQ_A0, lt, ga); sqa_gload(c, unit0 + 1, lt, ga); sqb_gload(c, unit0, YO, dir, 0, lt, gb);
        __syncthreads();
#pragma unroll 1
        for (int ch = 0; ch <= RNC; ++ch) {
            unsigned char* sb = L + SQ_B0 + (ch & 1) * SQB_BYTES;
            if (ch >= 2) sqb_store_y(YO, dir, ch - 2, sb, lt);
            if (ch < RNC) sqb_lstore(sb, lt, gb);
            if (ch + 1 < RNC) { sqb_gload(c, unit0 + ch + 1, YO, dir, ch + 1, lt, gb); sqa_lstore(L + SQ_A0 + ((ch + 1) & 1) * SQA_BYTES, lt, ga); }
            if (ch + 2 < RNC) sqa_gload(c, unit0 + ch + 2, lt, ga);
            __syncthreads();
        }
        sqb_store_y(YO, dir, RNC - 1, L + SQ_B0 + ((RNC - 1) & 1) * SQB_BYTES, lt);
    } else if (wave < 2) {
        f32x16 x[2]; zero16(x[0]); zero16(x[1]);
        __syncthreads();
#pragma unroll 1
        for (int ch = 0; ch <= RNC; ++ch) {
            if (ch < RNC) {
                const unsigned char* st = L + SQ_A0 + (ch & 1) * SQA_BYTES;
                unsigned char* xbuf = L + SQ_XB + ((ch & 1) * 2 + vh) * 4096 + lane * 16;
                bf16x8 xb[4];
#pragma unroll
                for (int s = 0; s < 4; ++s) { xb[s] = pack8(x[s >> 1], s & 1); *(bf16x8*)(xbuf + s * 1024) = xb[s]; }
                f32x16 xn0, xn1;
#pragma unroll
                for (int i = 0; i < 2; ++i) {
                    f32x16 xa;
#pragma unroll
                    for (int g4 = 0; g4 < 4; ++g4) {
                        float z5[4]; unpack4(*(const u32x2*)(st + SQA_Z5 + (vh * 32 + r) * SQ_PITCH + (32 * i + 8 * g4 + 4 * h) * 2), z5);
                        const float4 p4 = *(const float4*)(st + SQA_P63 + (32 * i + 8 * g4 + 4 * h) * 4);
                        xa[4 * g4] = fmaf(p4.x, x[i][4 * g4], z5[0]); xa[4 * g4 + 1] = fmaf(p4.y, x[i][4 * g4 + 1], z5[1]);
                        xa[4 * g4 + 2] = fmaf(p4.z, x[i][4 * g4 + 2], z5[2]); xa[4 * g4 + 3] = fmaf(p4.w, x[i][4 * g4 + 3], z5[3]);
                    }
#pragma unroll
                    for (int s = 0; s < 4; ++s) xa = __builtin_amdgcn_mfma_f32_32x32x16_bf16(ldfrag_l(st + SQA_M3 + (32 * i + r) * SQ_PITCH, s, h), xb[s], xa, 0, 0, 0);
                    if (i == 0) xn0 = xa; else xn1 = xa;
                }
                x[0] = xn0; x[1] = xn1;
            }
            __syncthreads();
        }
    } else {
        __syncthreads();
#pragma unroll 1
        for (int ch = 0; ch <= RNC; ++ch) {
            if (ch >= 1) {
                const int cy = ch - 1;
                unsigned char* st = L + SQ_B0 + (cy & 1) * SQB_BYTES;
                const unsigned char* xbuf = L + SQ_XB + ((cy & 1) * 2 + vh) * 4096 + lane * 16;
                bf16x8 xb[4];
#pragma unroll
                for (int s = 0; s < 4; ++s) xb[s] = *(const bf16x8*)(xbuf + s * 1024);
#pragma unroll
                for (int i = 0; i < 2; ++i) {
                    f32x16 ya;
#pragma unroll
                    for (int g = 0; g < 16; ++g) ya[g] = *((const float*)(st + SQB_Y) + (32 * i + crow(g, h)) * 64 + vh * 32 + r);
#pragma unroll
                    for (int s = 0; s < 4; ++s) ya = __builtin_amdgcn_mfma_f32_32x32x16_bf16(ldfrag_l(st + SQB_M2 + (32 * i + r) * SQ_PITCH, s, h), xb[s], ya, 0, 0, 0);
#pragma unroll
                    for (int g = 0; g < 16; ++g) *((float*)(st + SQB_Y) + (32 * i + crow(g, h)) * 64 + vh * 32 + r) = ya[g];
                }
            }
            __syncthreads();
        }
    }
}
DI void phase_mixers2(const Ctx& c, int l) {
    const int G = gridDim.x, bid = blockIdx.x;
    if (G >= 128) {
        if (bid < 16) phase_rwkv_seq_block(c, l, bid);
        else for (int u = bid - 16; u < 2 * S5N * 4; u += G - 16) phase_s5_final_unit(c, l, u);
    } else {
        for (int u = bid; u < 16; u += G) phase_rwkv_seq_block(c, l, u);
        for (int u = bid; u < 2 * S5N * 4; u += G) phase_s5_final_unit(c, l, u);
    }
}

DI void phase_post(const Ctx& c, int l) {
    unsigned char* ws = c.ws; const int lane = c.lane;
    const float* YF = (const float*)(ws + WS_BUFB); const float* YB = YF + (size_t)NZ * 256;
    const bf16_t* RB = (const bf16_t*)(ws + WS_EXPW + MX_RB); const bf16_t* VB = (const bf16_t*)(ws + WS_EXPW + MX_VB);
    const bf16_t* SKD = (const bf16_t*)(ws + WS_P + P_PR) + (size_t)4 * NZ * 256; const bf16_t* GG = (const bf16_t*)(ws + WS_MISC + MS_GG);
    bf16_t* Ycat = (bf16_t*)(ws + WS_BUFA);
    const float* r_k = c.in[21] + l * 256; const float* lg = c.in[22] + l * 256; const float* lb = c.in[23] + l * 256;
    for (int z = blockIdx.x * 8 + c.wave; z < NZ; z += gridDim.x * 8) {
        const size_t o = (size_t)z * 256 + lane * 4;
        const float4 yf = *(const float4*)(YF + o), yb = *(const float4*)(YB + o);
        const float y0 = yf.x + yb.x, y1 = yf.y + yb.y, y2 = yf.z + yb.z, y3 = yf.w + yb.w;
        const float mean = sum16(y0 + y1 + y2 + y3) * (1.f / 64.f);
        const float d0 = y0 - mean, d1 = y1 - mean, d2 = y2 - mean, d3 = y3 - mean;
        const float var = sum16(d0 * d0 + d1 * d1 + d2 * d2 + d3 * d3) * (1.f / 64.f);
        const float rs = rsqrtf(var + 64e-5f);
        float r[4], v[4], k0[4], k1[4], gg[4];
        unpack4(*(const u32x2*)(RB + o), r); unpack4(*(const u32x2*)(VB + o), v); unpack4(*(const u32x2*)(SKD + o), k0); unpack4(*(const u32x2*)(SKD + (size_t)NZ * 256 + o), k1);
        unpack4(*(const u32x2*)(GG + o), gg);
        const float4 rk = *(const float4*)(r_k + lane * 4), g4 = *(const float4*)(lg + lane * 4), b4 = *(const float4*)(lb + lane * 4);
        const float bs = sum16(r[0] * (k0[0] + k1[0]) * rk.x + r[1] * (k0[1] + k1[1]) * rk.y + r[2] * (k0[2] + k1[2]) * rk.z + r[3] * (k0[3] + k1[3]) * rk.w);
        *(u32x2*)(Ycat + (size_t)z * D + 256 + lane * 4) = pack4((d0 * rs * g4.x + b4.x + bs * v[0]) * gg[0], (d1 * rs * g4.y + b4.y + bs * v[1]) * gg[1],
                                                                (d2 * rs * g4.z + b4.z + bs * v[2]) * gg[2], (d3 * rs * g4.w + b4.w + bs * v[3]) * gg[3]);
    }
    {
        const bf16_t* ZG = (const bf16_t*)(ws + WS_MISC + MS_ZG); const bf16_t* W = (const bf16_t*)(ws + WS_WSM + OFF_GLUT + l * SZ_GLUT);
        const float* gb = c.in[33] + l * 256;
        for (int u = blockIdx.x; u < (NZ / 256) * 2; u += gridDim.x) {
            const int mt = u / 2, nt = u % 2, r0 = mt * 256, c0 = nt * 128;
            gemm_tile<4, 0>(c, 256, [&](int i) { return ZG + (size_t)(r0 + i) * 256; }, [&](int i) { return W + (size_t)(c0 + i) * 256; }, NoHook(),
                [&](f32x4 (&acc)[4][4], int wr, int wc, int fr, int fq) {
#pragma unroll
                    for (int n = 0; n < 4; ++n) {
                        const int col = c0 + wc + n * 16 + fq * 4; const float4 bb = *(const float4*)(gb + col);
#pragma unroll
                        for (int m = 0; m < 4; ++m) {
                            const int row = r0 + wr + m * 16 + fr; const f32x4 v = acc[m][n];
                            float zg[4]; unpack4(*(const u32x2*)(ZG + (size_t)row * 256 + col), zg);
                            *(u32x2*)(Ycat + (size_t)row * D + 512 + col) = pack4(zg[0] * sigmoidf_(v[0] + bb.x), zg[1] * sigmoidf_(v[1] + bb.y), zg[2] * sigmoidf_(v[2] + bb.z), zg[3] * sigmoidf_(v[3] + bb.w));
                        }
                    }
                });
        }
    }
}

DI bool skip_mt(int l, int mt) { return l == NL - 1 && (mt % 33) == 0; }
DI void phase_merge1(const Ctx& c, int l) {
    const bf16_t* Ycat = (const bf16_t*)(c.ws + WS_BUFA); const bf16_t* W = (const bf16_t*)(c.ws + WS_WSM + OFF_WBT + l * SZ_WBT);
    const bf16_t* GT = (const bf16_t*)(c.ws + WS_GT); bf16_t* MG = (bf16_t*)(c.ws + WS_BUFB);
    if (blockIdx.x == 0 && c.tid < 32) ((unsigned*)(c.ws + WS_CTL))[CW_CNT + l * 32 + c.tid] = 0u;
    for (int u = blockIdx.x; u < (NZ / 256) * 8; u += gridDim.x) {
        const int mt = u / 8, nt = u % 8, r0 = mt * 256, c0 = nt * 128;
        if (skip_mt(l, mt)) continue;
        f32x4 macc[4][4];
#pragma unroll
        for (int m = 0; m < 4; ++m)
#pragma unroll
            for (int n = 0; n < 4; ++n) macc[m][n] = (f32x4){0.f, 0.f, 0.f, 0.f};
        gemm_tile<4, 256>(c, 1024, [&](int i) { return Ycat + (size_t)(r0 + i) * D; }, [&](int i) { return W + (size_t)(c0 + i) * D; },
            [&](f32x4 (&acc)[4][4], int seg, int wr, int wc, int fr, int fq) {
#pragma unroll
                for (int m = 0; m < 4; ++m)
#pragma unroll
                    for (int n = 0; n < 4; ++n) {
                        float g[4]; unpack4(*(const u32x2*)(GT + (size_t)(r0 + wr + m * 16 + fr) * 4096 + seg * 1024 + c0 + wc + n * 16 + fq * 4), g);
                        macc[m][n][0] += g[0] * acc[m][n][0]; macc[m][n][1] += g[1] * acc[m][n][1]; macc[m][n][2] += g[2] * acc[m][n][2]; macc[m][n][3] += g[3] * acc[m][n][3];
                        acc[m][n] = (f32x4){0.f, 0.f, 0.f, 0.f};
                    }
            },
            [&](f32x4 (&)[4][4], int wr, int wc, int fr, int fq) {
#pragma unroll
                for (int m = 0; m < 4; ++m)
#pragma unroll
                    for (int n = 0; n < 4; ++n)
                        *(u32x2*)(MG + (size_t)(r0 + wr + m * 16 + fr) * D + c0 + wc + n * 16 + fq * 4) = pack4(macc[m][n][0], macc[m][n][1], macc[m][n][2], macc[m][n][3]);
            });
    }
}
struct EpiMerge2 {
    static constexpr bool PERM = false, AFTER_DRAIN = false;
    float* H; const float* modv; int l;
    DI void operator()(const pg8::f32x4 (&acc)[2][2][4][2], const pg8::Unit& u, int wr, int wc, int fr, int fq) const {
        if (skip_mt(l, u.pm)) return;
        const int sel = (u.pm % 33) == 0 ? 2 : u.pm / 33;
        const int row0 = u.pm * 256 + wr * 64 + fr, col0 = u.pn * 256 + wc * 32 + 4 * fq;
#pragma unroll
        for (int bj = 0; bj < 2; ++bj)
#pragma unroll
            for (int n = 0; n < 2; ++n) {
                const int col = col0 + bj * 128 + n * 16; const float4 m2 = *(const float4*)(modv + ((size_t)l * 3 + sel) * 6144 + 2 * 1024 + col);
#pragma unroll
                for (int ai = 0; ai < 2; ++ai)
#pragma unroll
                    for (int m = 0; m < 4; ++m) {
                        float4* hp = (float4*)(H + (size_t)(row0 + ai * 128 + m * 16) * D + col); float4 hv = *hp; const pg8::f32x4 v = acc[ai][bj][m][n];
                        hv.x += m2.x * v[0]; hv.y += m2.y * v[1]; hv.z += m2.z * v[2]; hv.w += m2.w * v[3]; *hp = hv;
                    }
            }
    }
};
DI void phase_merge2(const Ctx& c, int l) {
    EpiMerge2 E; E.H = (float*)(c.ws + WS_H); E.modv = (const float*)(c.ws + WS_WSM + OFF_MODV); E.l = l;
    pg8::Gemm g{(const bf16_t*)(c.ws + WS_BUFB), (const bf16_t*)(c.ws + WS_WSM + OFF_WOUTT + l * SZ_WOUTT), NZ, 1024, 1024, 1024, 1024};
    pg8::StaticOrder S; S.init(NZ, 1024, (int)gridDim.x, (int)blockIdx.x);
    __syncthreads();
    pg8::gemm_phase<EpiMerge2, pg8::StaticOrder, false>((PG8_LAS unsigned char*)c.smem, g, S, E, nullptr);
}

constexpr int RT_PITCH = 68;
DI void phase_norm2_route(const Ctx& c, int l) {
    unsigned char* ws = c.ws; const int lane = c.lane, wave = c.wave, tid = c.tid;
    const float* modv = (const float*)(ws + WS_WSM + OFF_MODV); const float* H = (const float*)(ws + WS_H);
    bf16_t* XN = (bf16_t*)(ws + WS_BUFA); const float* g2 = c.in[7] + l * 1024;
    const float* rwt = (const float*)(ws + WS_WSM + OFF_RWT) + (size_t)l * 36 * 1024;
    const float* bg = c.in[42] + l * 4; const float* be = c.in[44] + l * 32;
    unsigned* cnt = (unsigned*)(ws + WS_CTL) + CW_CNT + l * 32;
    int* list = (int*)(ws + WS_GT + GT_LIST); float* lw = (float*)(ws + WS_GT + GT_LW);
    float* red = (float*)c.smem + wave * 36 * RT_PITCH;
    int* hist = (int*)(c.smem + 8 * 36 * RT_PITCH * 4);
    int* sel = hist + 64;
    float* selw = (float*)(sel + 128);
    const int ngroups = (l == NL - 1) ? (NB * SEQ / 64) : (NZ / 64);
    for (int grp = blockIdx.x; grp < ngroups; grp += gridDim.x) {
        __syncthreads();
        if (tid < 32) hist[tid] = 0;
        __syncthreads();
        for (int i = 0; i < 8; ++i) {
            const int rl = wave * 8 + i;
            int row;
            if (l == NL - 1) { const int rr = grp * 64 + rl; row = (rr / SEQ) * TZ + CTX + (rr % SEQ); } else row = grp * 64 + rl;
            const int b = row / TZ, s = row % TZ, sel3 = s < CTX ? 2 : b;
            float x[16]; float ss = 0.f;
#pragma unroll
            for (int q = 0; q < 4; ++q) { const float4 v = *(const float4*)(H + (size_t)row * D + q * 256 + lane * 4); x[q * 4] = v.x; x[q * 4 + 1] = v.y; x[q * 4 + 2] = v.z; x[q * 4 + 3] = v.w;
                ss += v.x * v.x + v.y * v.y + v.z * v.z + v.w * v.w; }
            ss = wave_sum(ss);
            const float rs = rsqrtf(ss * (1.f / 1024.f) + 1e-6f);
#pragma unroll
            for (int q = 0; q < 4; ++q) {
                const int col = q * 256 + lane * 4;
                const float4 g = *(const float4*)(g2 + col), m3 = *(const float4*)(modv + ((size_t)l * 3 + sel3) * 6144 + 3 * 1024 + col), m4 = *(const float4*)(modv + ((size_t)l * 3 + sel3) * 6144 + 4 * 1024 + col);
                x[q * 4] = x[q * 4] * rs * g.x * (1.f + m4.x) + m3.x; x[q * 4 + 1] = x[q * 4 + 1] * rs * g.y * (1.f + m4.y) + m3.y;
                x[q * 4 + 2] = x[q * 4 + 2] * rs * g.z * (1.f + m4.z) + m3.z; x[q * 4 + 3] = x[q * 4 + 3] * rs * g.w * (1.f + m4.w) + m3.w;
                *(u32x2*)(XN + (size_t)row * D + col) = pack4(x[q * 4], x[q * 4 + 1], x[q * 4 + 2], x[q * 4 + 3]);
            }
#pragma unroll 4
            for (int e = 0; e < 36; ++e) {
                float a = 0.f;
#pragma unroll
                for (int q = 0; q < 4; ++q) { const float4 w = *(const float4*)(rwt + (size_t)e * 1024 + q * 256 + lane * 4); a += x[q * 4] * w.x + x[q * 4 + 1] * w.y + x[q * 4 + 2] * w.z + x[q * 4 + 3] * w.w; }
                red[e * RT_PITCH + lane] = a;
            }
            __builtin_amdgcn_wave_barrier();
            float lg = -1e30f;
            if (lane < 36) {
                float s0 = 0.f, s1 = 0.f, s2 = 0.f, s3 = 0.f;
#pragma unroll
                for (int q = 0; q < 16; ++q) { const float4 v = *(const float4*)(red + lane * RT_PITCH + q * 4); s0 += v.x; s1 += v.y; s2 += v.z; s3 += v.w; }
                lg = (s0 + s1) + (s2 + s3) + (lane < 4 ? bg[lane] : be[lane - 4]);
            }
            __builtin_amdgcn_wave_barrier();
            float gm = -1e30f; int gsel = 0; float gl[4];
#pragma unroll
            for (int g = 0; g < 4; ++g) { gl[g] = __shfl(lg, g, 64); if (gl[g] > gm) { gm = gl[g]; gsel = g; } }
            const float gs = __expf(gl[0] - gm) + __expf(gl[1] - gm) + __expf(gl[2] - gm) + __expf(gl[3] - gm);
            const float pg = 1.f / gs;
            float l1 = -1e30f, l2 = -1e30f; int e1 = 0, e2 = 0;
#pragma unroll
            for (int j = 0; j < 8; ++j) {
                const float v = __shfl(lg, 4 + gsel * 8 + j, 64); const int e = gsel * 8 + j;
                if (v > l1) { l2 = l1; e2 = e1; l1 = v; e1 = e; } else if (v > l2) { l2 = v; e2 = e; }
            }
            const float tt = __expf(l2 - l1), w1 = pg / (1.f + tt), w2 = pg * tt / (1.f + tt);
            if (lane == 0) {
                const int r1 = atomicAdd(&hist[e1], 1), r2 = atomicAdd(&hist[e2], 1);
                sel[rl * 2] = e1 | (r1 << 8); sel[rl * 2 + 1] = e2 | (r2 << 8); selw[rl * 2] = w1; selw[rl * 2 + 1] = w2;
            }
        }
        __syncthreads();
        if (tid < 32) hist[32 + tid] = (int)atomicAdd(&cnt[tid], (unsigned)hist[tid]);
        __syncthreads();
        if (tid < 128) {
            const int rl = tid >> 1, j = tid & 1, sv = sel[tid], e = sv & 255, rk = sv >> 8;
            int row;
            if (l == NL - 1) { const int rr = grp * 64 + rl; row = (rr / SEQ) * TZ + CTX + (rr % SEQ); } else row = grp * 64 + rl;
            const size_t pos = (size_t)e * MOE_CAP + hist[32 + e] + rk;
            list[pos] = row * 2 + j; lw[pos] = selw[tid];
        }
    }
    phase_expert_convert(c, l);
}

DI void moe_prefix(const Ctx& c, int l, int* tiles  , int* cnts  ) {
    __syncthreads();
    if (c.tid == 0) {
        const unsigned* cnt = (const unsigned*)(c.ws + WS_CTL) + CW_CNT + l * 32; int acc = 0;
        for (int e = 0; e < 32; ++e) { const int n = (int)__hip_atomic_load(cnt + e, __ATOMIC_RELAXED, __HIP_MEMORY_SCOPE_AGENT); cnts[e] = n; tiles[e] = acc; acc += (n + 127) / 128; }
        tiles[32] = acc;
    }
    __syncthreads();
}
DI void phase_moe1(const Ctx& c, int l) {
    unsigned char* ws = c.ws;
    int* tiles = (int*)(c.smem + 120 * 1024); int* cnts = tiles + 40;
    moe_prefix(c, l, tiles, cnts);
    const bf16_t* XN = (const bf16_t*)(ws + WS_BUFA); bf16_t* HM = (bf16_t*)(ws + WS_GT + GT_HM); const int* list = (const int*)(ws + WS_GT + GT_LIST);
    const int nt_total = tiles[32];
    for (int u = blockIdx.x; u < nt_total * 4; u += gridDim.x) {
        const int mtg = u >> 2, nt = u & 3;
        int e = 0;
        for (int k = 1; k < 32; ++k) if (tiles[k] <= mtg) e = k;
        const int mt = mtg - tiles[e], n_e = cnts[e];
        const int* le = list + (size_t)e * MOE_CAP;
        const bf16_t* W = (const bf16_t*)(ws + WS_EXPW + (size_t)e * SZ_WGU);
        gemm_tile<2, 0>(c, 1024,
            [&](int i) { int p = mt * 128 + i; if (p >= n_e) p = n_e - 1; return XN + (size_t)(le[p] >> 1) * D; },
            [&](int i) { return W + (size_t)(nt * 256 + i) * D; }, NoHook(),
            [&](f32x4 (&acc)[4][4], int wr, int wc, int fr, int fq) {
#pragma unroll
                for (int np = 0; np < 2; ++np) {
                    const int hc = (nt * 256 + wc + np * 32) / 2 + fq * 4;
#pragma unroll
                    for (int m = 0; m < 4; ++m) {
                        const int p = mt * 128 + wr + m * 16 + fr;
                        const f32x4 g = acc[m][np * 2], uu = acc[m][np * 2 + 1];
                        *(u32x2*)(HM + ((size_t)mtg * 128 + wr + m * 16 + fr) * 512 + hc) = pack4(siluf_(g[0]) * uu[0], siluf_(g[1]) * uu[1], siluf_(g[2]) * uu[2], siluf_(g[3]) * uu[3]);
                        (void)p;
                    }
                }
            });
    }
}
DI void phase_moe2(const Ctx& c, int l) {
    unsigned char* ws = c.ws;
    int* tiles = (int*)(c.smem + 120 * 1024); int* cnts = tiles + 40;
    moe_prefix(c, l, tiles, cnts);
    const bf16_t* HM = (const bf16_t*)(ws + WS_GT + GT_HM); const int* list = (const int*)(ws + WS_GT + GT_LIST); const float* lw = (const float*)(ws + WS_GT + GT_LW);
    bf16_t* Y2 = (bf16_t*)(ws + WS_P);
    const int nt_total = tiles[32];
    for (int u = blockIdx.x; u < nt_total * 4; u += gridDim.x) {
        const int mtg = u >> 2, nt = u & 3;
        int e = 0;
        for (int k = 1; k < 32; ++k) if (tiles[k] <= mtg) e = k;
        const int mt = mtg - tiles[e], n_e = cnts[e];
        const int* le = list + (size_t)e * MOE_CAP; const float* lwe = lw + (size_t)e * MOE_CAP;
        const bf16_t* W = (const bf16_t*)(ws + WS_EXPW + 32 * SZ_WGU + (size_t)e * SZ_WD);
        gemm_tile<2, 0>(c, 512,
            [&](int i) { return HM + ((size_t)mtg * 128 + i) * 512; },
            [&](int i) { return W + (size_t)(nt * 256 + i) * 512; }, NoHook(),
            [&](f32x4 (&acc)[4][4], int wr, int wc, int fr, int fq) {
#pragma unroll
                for (int m = 0; m < 4; ++m) {
                    const int p = mt * 128 + wr + m * 16 + fr;
                    if (p < n_e) {
                        const int ent = le[p]; const float wt = lwe[p];
                        bf16_t* yrow = Y2 + ((size_t)(ent & 1) * NZ + (ent >> 1)) * D + nt * 256 + wc + fq * 4;
#pragma unroll
                        for (int n = 0; n < 4; ++n) *(u32x2*)(yrow + n * 16) = pack4(wt * acc[m][n][0], wt * acc[m][n][1], wt * acc[m][n][2], wt * acc[m][n][3]);
                    }
                }
            });
    }
}

constexpr int LDS_BYTES = 128 * 1024 + 256;
constexpr int STEPS_PER_LAYER = 12, N_STEPS = 2 + NL * STEPS_PER_LAYER;
#ifndef FUSED
#define FUSED 1
#endif

DI const void* launder_ptr(const void* p) {
    const unsigned long long v = (unsigned long long)p;
    unsigned lo = __builtin_amdgcn_readfirstlane((unsigned)v), hi = __builtin_amdgcn_readfirstlane((unsigned)(v >> 32));
    asm volatile("" : "+s"(lo), "+s"(hi) :: "memory");
    return (const void*)(((unsigned long long)hi << 32) | lo);
}
template <int KIND> DI void run_step(const Ctx& c0, int l) {
#ifdef PHM
    if (!((PHM >> KIND) & 1)) return;
#endif
    Ctx c = c0;
    { int z = 0; asm volatile("" : "+s"(z) :: "memory"); c.in = c0.in + z; c.ws = c0.ws + z; c.out = c0.out + z; }
    { int t = c0.tid; asm volatile("" : "+v"(t)); c.tid = t; c.lane = t & 63; c.wave = __builtin_amdgcn_readfirstlane(t >> 6); }
    if (KIND == 0) phase_prologue(c);
    if (KIND == 1) phase_norm1(c, l);
    if (KIND == 2) phase_inproj(c, l);
    if (KIND == 3) { phase_prep(c, l); phase_s5_local(c, l); }
    if (KIND == 4) { phase_small_gemms(c, l); phase_s5_carry(c, l); }
    if (KIND == 5) { phase_attention(c, l); phase_rwkv_chunks(c, l); }
    if (KIND == 6) phase_mixers2(c, l);
    if (KIND == 7) phase_post(c, l);
    if (KIND == 8) phase_merge1(c, l);
    if (KIND == 9) phase_merge2(c, l);
    if (KIND == 10) phase_norm2_route(c, l);
    if (KIND == 11) phase_moe1(c, l);
    if (KIND == 12) phase_moe2(c, l);
    if (KIND == 13) phase_final(c);
}

#if !FUSED
template <int KIND> __global__ void __launch_bounds__(NTHR, 2) k_step(Args a) {
    extern __shared__ __attribute__((aligned(16))) unsigned char lds[];
    Ctx c; c.in = a.in; c.out = a.out; c.ws = a.ws; c.smem = lds; c.tid = threadIdx.x; c.lane = threadIdx.x & 63; c.wave = __builtin_amdgcn_readfirstlane(threadIdx.x >> 6);
    run_step<KIND>(c, a.s_lo);
}
template <int KIND> static void launch_step(const Args& a, int grid, hipStream_t stream) {
    static bool attr = false;
    if (!attr) { (void)hipFuncSetAttribute((const void*)k_step<KIND>, hipFuncAttributeMaxDynamicSharedMemorySize, LDS_BYTES); attr = true; }
    hipLaunchKernelGGL(k_step<KIND>, dim3(grid), dim3(NTHR), LDS_BYTES, stream, a);
}
#else
__global__ void __launch_bounds__(NTHR, 2) fwd_kernel(Args a) {
    extern __shared__ __attribute__((aligned(16))) unsigned char lds[];
    Ctx c; c.in = a.in; c.out = a.out; c.ws = a.ws; c.smem = lds; c.tid = threadIdx.x; c.lane = threadIdx.x & 63; c.wave = __builtin_amdgcn_readfirstlane(threadIdx.x >> 6);
    volatile LAS unsigned* xbw = (volatile LAS unsigned*)(lds + LDS_BYTES - 16);
    if (threadIdx.x == 0) { xbw[0] = 0u; xbw[1] = 0u; }
    __syncthreads();
    XcdBarrier bar = xcd_barrier_post((unsigned*)(a.ws + WS_CTL) + CW_BAR, xbw);
#ifndef REP_MASK
#define REP_MASK 0
#endif
#define STEP(K, L) do { run_step<K>(c, L); xcd_barrier(bar); if ((REP_MASK >> K) & 1) { run_step<K>(c, L); xcd_barrier(bar); } } while (0)
    STEP(0, 0);
    for (int l = 0; l < NL; ++l) {
        STEP(1, l); STEP(2, l); STEP(3, l); STEP(4, l); STEP(5, l); STEP(6, l); STEP(7, l); STEP(8, l); STEP(9, l); STEP(10, l); STEP(11, l); STEP(12, l);
    }
#undef STEP
    run_step<13>(c, 0);
}
#endif

extern "C" void kernel_launch(void* const* d_in, const int* in_sizes, int n_in, void* d_out, int out_size, void* d_ws, size_t ws_size, hipStream_t stream) {
    static int grid = 0;
    if (grid == 0) {
        if (n_in != 49 || out_size != NB * SEQ * D || ws_size < WS_END) { fprintf(stderr, "kernel_launch: unexpected problem (n_in %d out %d ws %zu need %zu)\n", n_in, out_size, ws_size, (size_t)WS_END); grid = -1; return; }
        int dev = 0, cus = 0;
        if (hipGetDevice(&dev) != hipSuccess || hipDeviceGetAttribute(&cus, hipDeviceAttributeMultiprocessorCount, dev) != hipSuccess) { grid = -1; return; }
#if FUSED
        int per_cu = 0;
        if (hipFuncSetAttribute((const void*)fwd_kernel, hipFuncAttributeMaxDynamicSharedMemorySize, LDS_BYTES) != hipSuccess) { fprintf(stderr, "kernel_launch: hipFuncSetAttribute failed\n"); grid = -1; return; }
        if (hipOccupancyMaxActiveBlocksPerMultiprocessor(&per_cu, (const void*)fwd_kernel, NTHR, LDS_BYTES) != hipSuccess || per_cu < 1) { fprintf(stderr, "kernel_launch: occupancy query says %d\n", per_cu); }
        (void)hipGetLastError();
#endif
        grid = cus;
    }
    if (grid < 0) return;
    (void)hipMemsetAsync((char*)d_ws + WS_CTL, 0, CTL_BYTES, stream);
    Args a{};
    for (int i = 0; i < 49; ++i) a.in[i] = (const float*)d_in[i];
    a.out = (float*)d_out; a.ws = (unsigned char*)d_ws;
#if !FUSED
    a.s_lo = 0; a.s_hi = 0; launch_step<0>(a, grid, stream);
    for (int l = 0; l < NL; ++l) {
        a.s_lo = l;
        launch_step<1>(a, grid, stream); launch_step<2>(a, grid, stream); launch_step<3>(a, grid, stream); launch_step<4>(a, grid, stream);
        launch_step<5>(a, grid, stream); launch_step<6>(a, grid, stream); launch_step<7>(a, grid, stream); launch_step<8>(a, grid, stream);
        launch_step<9>(a, grid, stream); launch_step<10>(a, grid, stream); launch_step<11>(a, grid, stream); launch_step<12>(a, grid, stream);
    }
    a.s_lo = 0; launch_step<13>(a, grid, stream);
#else
    a.s_lo = 0; a.s_hi = N_STEPS; hipLaunchKernelGGL(fwd_kernel, dim3(grid), dim3(NTHR), LDS_BYTES, stream, a);
#endif
}
```

```cpp
#include <hip/hip_runtime.h>
#include <stdint.h>
#include <stdio.h>

#define DI __device__ __forceinline__
#define LAS __attribute__((address_space(3)))
typedef unsigned short bf16_t;
typedef short bf16x8 __attribute__((ext_vector_type(8)));
typedef short s16x4 __attribute__((ext_vector_type(4)));
typedef float f32x4 __attribute__((ext_vector_type(4)));
typedef float f32x16 __attribute__((ext_vector_type(16)));
typedef float f32x2 __attribute__((ext_vector_type(2)));
typedef __bf16 bf16x2v __attribute__((ext_vector_type(2)));
typedef unsigned u32x4 __attribute__((ext_vector_type(4)));
typedef unsigned u32x2 __attribute__((ext_vector_type(2)));

constexpr int D = 1024, NB = 2, SEQ = 8192, CTX = 256, TZ = 8448, NZ = 16896, NL = 2;
constexpr int NIN = 6560, NINP = 6656;
constexpr int NTHR = 512;
constexpr float LOG2E = 1.4426950408889634f;

#define XB_TMO      128
#define XB_XCNT(j)  (256  + 64 * (j))
#define XB_XSUB(j)  (1280 + 64 * (j))
#define XB_XGEN(j)  (2304 + 64 * (j))
#define XB_TOP      3328
#define XB_TOPGEN   3392
#define XCD_BAR_WORDS 3456
#define XB_SPIN_CAP (1u << 18)

__device__ __forceinline__ unsigned xb_ld(unsigned* p)              { return __hip_atomic_load(p, __ATOMIC_RELAXED, __HIP_MEMORY_SCOPE_AGENT); }
__device__ __forceinline__ unsigned xb_add(unsigned* p, unsigned v) { return __hip_atomic_fetch_add(p, v, __ATOMIC_RELAXED, __HIP_MEMORY_SCOPE_AGENT); }
__device__ __forceinline__ unsigned xb_xcc_id() { return (unsigned)__builtin_amdgcn_s_getreg((3 << 11) | 20) & 0xFu; }
#define XB_SPIN(cond, bar) do { unsigned _sp = 0; while (cond) { __builtin_amdgcn_s_sleep(1); \
    if ((++_sp & 255u) == 0u) { if (xb_ld(&(bar)[XB_TMO])) break; if (_sp > XB_SPIN_CAP) { atomicAdd(&(bar)[XB_TMO], 1u); break; } } } } while (0)

struct XcdBarrier { unsigned* bar; unsigned x; volatile LAS unsigned* st; };

__device__ __forceinline__ XcdBarrier xcd_barrier_post(unsigned* bar, volatile LAS unsigned* st) {
    XcdBarrier b; b.bar = bar; b.x = xb_xcc_id(); b.st = st;
    if (threadIdx.x == 0) (void)xb_add(&bar[XB_XCNT(b.x)], 1u);
    return b;
}
__device__ __forceinline__ void xcd_barrier_complete(unsigned* bar, unsigned x, unsigned& nloc, unsigned& nx) {
    const unsigned G = gridDim.x * gridDim.y * gridDim.z;
    unsigned sum, cnt, mine, sp = 0u;
    for (;;) {
        sum = 0u; cnt = 0u; mine = 0u;
#pragma unroll
        for (unsigned j = 0; j < 16; ++j) { const unsigned c = xb_ld(&bar[XB_XCNT(j)]); sum += c; cnt += (c > 0u) ? 1u : 0u; mine = (j == x) ? c : mine; }
        if (sum == G) break;
        __builtin_amdgcn_s_sleep(1);
        if ((++sp & 255u) == 0u) { if (xb_ld(&bar[XB_TMO])) break; if (sp > XB_SPIN_CAP) { atomicAdd(&bar[XB_TMO], 1u); break; } }
    }
    nloc = mine > 0u ? mine : 1u; nx = cnt > 0u ? cnt : 1u;
}
__device__ __forceinline__ void xcd_barrier(const XcdBarrier& b) {
    asm volatile("s_waitcnt vmcnt(0)" ::: "memory");
    __syncthreads();
    if (threadIdx.x == 0) {
        unsigned* bar = b.bar;
        __builtin_amdgcn_s_waitcnt(0);
        unsigned nloc = b.st[0], nx = b.st[1];
        if (nloc == 0u) { xcd_barrier_complete(bar, b.x, nloc, nx); b.st[0] = nloc; b.st[1] = nx; }
        const unsigned old = xb_add(&bar[XB_XSUB(b.x)], 1u);
        const unsigned gen = old / nloc;
        if (old + 1u == (gen + 1u) * nloc) {
            __builtin_amdgcn_fence(__ATOMIC_RELEASE, "agent");
            asm volatile("s_waitcnt vmcnt(0)" ::: "memory");
            const unsigned og = xb_add(&bar[XB_TOP], 1u);
            const unsigned tg = og / nx;
            if (og + 1u == (tg + 1u) * nx) xb_add(&bar[XB_TOPGEN], 1u);
            else XB_SPIN(xb_ld(&bar[XB_TOPGEN]) == tg, bar);
            __builtin_amdgcn_fence(__ATOMIC_ACQUIRE, "agent");
            xb_add(&bar[XB_XGEN(b.x)], 1u);
            asm volatile("s_waitcnt vmcnt(0)" ::: "memory");
        } else {
            XB_SPIN(xb_ld(&bar[XB_XGEN(b.x)]) == gen, bar);
            __builtin_amdgcn_fence(__ATOMIC_ACQUIRE, "agent");
            asm volatile("s_waitcnt vmcnt(0)" ::: "memory");
        }
    }
    __syncthreads();
}

DI float bf2f(bf16_t v) { return __uint_as_float((unsigned)v << 16); }
DI unsigned pack2(float a, float b) { f32x2 v = {a, b}; bf16x2v r = __builtin_convertvector(v, bf16x2v); return __builtin_bit_cast(unsigned, r); }
DI bf16_t f2bf(float a) { return (bf16_t)(pack2(a, 0.f) & 0xffffu); }
DI float lo2f(unsigned u) { return __uint_as_float(u << 16); }
DI float hi2f(unsigned u) { return __uint_as_float(u & 0xffff0000u); }
DI float wave_sum(float v) {
#pragma unroll
    for (int m = 32; m >= 1; m >>= 1) v += __shfl_xor(v, m, 64);
    return v;
}
DI float sum16(float v) {
#pragma unroll
    for (int m = 8; m >= 1; m >>= 1) v += __shfl_xor(v, m, 64);
    return v;
}
DI float sigmoidf_(float x) { return 1.f / (1.f + __expf(-x)); }
DI float siluf_(float x) { return x / (1.f + __expf(-x)); }
DI float gelu_tanh(float x) { const float u = 0.7978845608028654f * (x + 0.044715f * x * x * x); return 0.5f * x * (1.f + tanhf(u)); }
DI void unpack4(u32x2 u, float (&f)[4]) { f[0] = lo2f(u.x); f[1] = hi2f(u.x); f[2] = lo2f(u.y); f[3] = hi2f(u.y); }
DI u32x2 pack4(float a, float b, float c, float d) { u32x2 r; r.x = pack2(a, b); r.y = pack2(c, d); return r; }

constexpr size_t algn(size_t x) { return (x + 255) & ~(size_t)255; }
constexpr size_t WS_CTL   = 0;
constexpr size_t CTL_BYTES = 64 * 1024;
constexpr size_t WS_H     = WS_CTL + CTL_BYTES;
constexpr size_t WS_WSM   = WS_H + (size_t)NZ * D * 4;
constexpr size_t SZ_WINT = (size_t)NINP * D * 2, SZ_WUQT = 384 * 256 * 2, SZ_WUKVT = 512 * 128 * 2, SZ_W2T = 512 * 64 * 2, SZ_A2T = 512 * 64 * 2,
                 SZ_G2T = 256 * 128 * 2, SZ_GLUT = 256 * 256 * 2, SZ_WBT = (size_t)D * D * 2, SZ_WOUTT = (size_t)D * D * 2;
constexpr size_t OFF_WINT = 0, OFF_WUQT = OFF_WINT + NL * SZ_WINT, OFF_WUKVT = OFF_WUQT + NL * SZ_WUQT, OFF_W2T = OFF_WUKVT + NL * SZ_WUKVT,
                 OFF_A2T = OFF_W2T + NL * SZ_W2T, OFF_G2T = OFF_A2T + NL * SZ_A2T, OFF_GLUT = OFF_G2T + NL * SZ_G2T, OFF_WBT = OFF_GLUT + NL * SZ_GLUT,
                 OFF_WOUTT = OFF_WBT + NL * SZ_WBT, OFF_MODV = OFF_WOUTT + NL * SZ_WOUTT,
                 OFF_ROPE = OFF_MODV + (size_t)NL * 3 * 6144 * 4,
                 OFF_S5T = OFF_ROPE + (size_t)SEQ * 16 * 2 * 4,
                 OFF_RWT = OFF_S5T + (size_t)NL * 2 * 16 * 64 * 36 * 4,
                 OFF_LAM = OFF_RWT + (size_t)NL * 36 * 1024 * 4,
                 OFF_S5E = OFF_LAM + 256,
                 OFF_S5C = OFF_S5E,
                 WSM_BYTES = algn(OFF_S5E + (size_t)2 * 2 * 16 * 132 * 64 * 2 * 4);
constexpr size_t WS_EXPW  = WS_WSM + WSM_BYTES;
constexpr size_t SZ_WGU = (size_t)1024 * 1024 * 2, SZ_WD = (size_t)1024 * 512 * 2;
constexpr size_t EXPW_BYTES = 32 * (SZ_WGU + SZ_WD);
constexpr size_t SZ_QM = (size_t)NB * 4 * TZ * 96 * 2, SZ_VMT = (size_t)NB * 4 * 64 * TZ * 2, SZ_QD = (size_t)NB * 4 * TZ * 64 * 2, SZ_R256 = (size_t)NZ * 256 * 2;
constexpr size_t MX_QM = 0, MX_KM = MX_QM + SZ_QM, MX_VMT = MX_KM + SZ_QM, MX_QD = MX_VMT + SZ_VMT, MX_KD = MX_QD + SZ_QD, MX_VDT = MX_KD + SZ_QD,
                 MX_RB = MX_VDT + SZ_VMT, MX_KB = MX_RB + SZ_R256, MX_VB = MX_KB + SZ_R256, MX_KKB = MX_VB + SZ_R256, MX_END = MX_KKB + SZ_R256;
static_assert(MX_END <= EXPW_BYTES, "mixer operands must fit the expert-weight region");
constexpr size_t WS_BUFA  = WS_EXPW + EXPW_BYTES;
constexpr size_t WS_BUFB  = WS_BUFA + (size_t)NZ * D * 2;
constexpr size_t WS_P     = WS_BUFB + (size_t)NZ * D * 2;
constexpr size_t P_PM = 0, P_PS = P_PM + (size_t)NZ * 416 * 2, P_PR = P_PS + (size_t)NZ * 256 * 2, P_PD = P_PR + (size_t)NZ * 1024 * 2, P_BYTES = P_PD + (size_t)NZ * 768 * 2;
static_assert((size_t)6 * SZ_R256 <= (size_t)NZ * (1024 + 768) * 2, "scan operands must fit PR|PD");
static_assert((size_t)2 * NZ * D * 2 <= P_BYTES, "the MoE outputs (2 x bf16 [NZ][D]) must fit the P region");
constexpr size_t WS_GT    = WS_P + P_BYTES;
constexpr size_t GT_BYTES = (size_t)NZ * 4096 * 2;
constexpr int MOE_CAP = 33792;
constexpr size_t GT_HM = 0, GT_LIST = GT_HM + (size_t)(33792 + 32 * 128) * 512 * 2, GT_LW = GT_LIST + (size_t)32 * MOE_CAP * 4, GT_END = GT_LW + (size_t)32 * MOE_CAP * 4;
static_assert(GT_END <= GT_BYTES, "MoE scratch must fit the gate region");
constexpr size_t WS_MISC  = WS_GT + GT_BYTES;
constexpr size_t MS_CQN = 0, MS_TW = MS_CQN + (size_t)NZ * 384 * 2, MS_AL = MS_TW + (size_t)NZ * 64 * 2, MS_SG = MS_AL + (size_t)NZ * 64 * 2,
                 MS_GG = MS_SG + (size_t)NZ * 128 * 2, MS_ZG = MS_GG + SZ_R256, MS_END = MS_ZG + SZ_R256;
constexpr size_t WS_RW    = WS_MISC + MS_END;
constexpr int RC = 64, RNC = TZ / RC;
constexpr size_t SZ_RWM = (size_t)16 * RNC * 4096 * 2;
constexpr size_t RW_M3 = 0, RW_M2 = SZ_RWM, RW_Z5 = 2 * SZ_RWM, RW_P63 = 3 * SZ_RWM, RW_END = RW_P63 + (size_t)16 * RNC * 64 * 4;
constexpr size_t WS_END   = WS_RW + RW_END;

constexpr int CW_BAR = 0;
constexpr int CW_CNT = 4096;

struct Args { const float* in[49]; float* out; unsigned char* ws; int s_lo, s_hi; };

struct Ctx {
    const float* const* in; float* out; unsigned char* ws; unsigned char* smem; int tid, lane, wave;
};

template <int WM> struct GCfg { static constexpr int WN = 8 / WM, BM = 64 * WM, BN = 64 * WN, ABYTES = BM * 64, BBYTES = BN * 64, STAGE = ABYTES + BBYTES; };

template <int WM, int SEGK, class ARow, class BRow, class Hook, class Epi>
DI void gemm_tile(const Ctx& c, int K, ARow arow, BRow brow, Hook hook, Epi epi) {
    typedef GCfg<WM> G;
    const int tid = c.tid, lane = c.lane, wave = c.wave;
    const int wm = wave / G::WN, wn = wave % G::WN, fr = lane & 15, fq = lane >> 4;
    unsigned char* smem = c.smem;
    constexpr int NA = G::BM / 128, NBq = G::BN / 128;
    const bf16_t* asrc[NA]; const bf16_t* bsrc[NBq];
#pragma unroll
    for (int i = 0; i < NA; ++i) { const int ch = tid + i * NTHR; asrc[i] = arow(ch >> 2) + (ch & 3) * 8; }
#pragma unroll
    for (int i = 0; i < NBq; ++i) { const int ch = tid + i * NTHR; bsrc[i] = brow(ch >> 2) + (ch & 3) * 8; }
    auto stage = [&](int kt, int buf) {
        unsigned char* sa = smem + buf * G::STAGE; unsigned char* sb = sa + G::ABYTES;
#pragma unroll
        for (int i = 0; i < NA; ++i) __builtin_amdgcn_global_load_lds((const unsigned*)(asrc[i] + kt * 32), (unsigned*)(sa + (tid + i * NTHR) * 16), 16, 0, 0);
#pragma unroll
        for (int i = 0; i < NBq; ++i) __builtin_amdgcn_global_load_lds((const unsigned*)(bsrc[i] + kt * 32), (unsigned*)(sb + (tid + i * NTHR) * 16), 16, 0, 0);
    };
    f32x4 acc[4][4];
#pragma unroll
    for (int m = 0; m < 4; ++m)
#pragma unroll
        for (int n = 0; n < 4; ++n) acc[m][n] = (f32x4){0.f, 0.f, 0.f, 0.f};
    const int T = K / 32;
    __syncthreads();
    stage(0, 0);
    for (int t = 0; t < T; ++t) {
        asm volatile("s_waitcnt vmcnt(0)" ::: "memory");
        __syncthreads();
        if (t + 1 < T) stage(t + 1, (t + 1) & 1);
        const unsigned char* sa = smem + (t & 1) * G::STAGE; const unsigned char* sb = sa + G::ABYTES;
        bf16x8 af[4], bfr[4];
#pragma unroll
        for (int m = 0; m < 4; ++m) af[m] = *(const bf16x8*)(sa + (wm * 64 + m * 16 + fr) * 64 + fq * 16);
#pragma unroll
        for (int n = 0; n < 4; ++n) bfr[n] = *(const bf16x8*)(sb + (wn * 64 + n * 16 + fr) * 64 + fq * 16);
#pragma unroll
        for (int m = 0; m < 4; ++m)
#pragma unroll
            for (int n = 0; n < 4; ++n) acc[m][n] = __builtin_amdgcn_mfma_f32_16x16x32_bf16(bfr[n], af[m], acc[m][n], 0, 0, 0);
        if (SEGK > 0) { if (((t + 1) * 32) % (SEGK > 0 ? SEGK : 32) == 0) hook(acc, ((t + 1) * 32) / (SEGK > 0 ? SEGK : 32) - 1, wm * 64, wn * 64, fr, fq); }
    }
    epi(acc, wm * 64, wn * 64, fr, fq);
}
struct NoHook { DI void operator()(f32x4 (&)[4][4], int, int, int, int, int) const {} };

namespace pg8 {
#define PG8_LAS __attribute__((address_space(3)))
typedef unsigned short bf16_t;
typedef short bf16x8 __attribute__((ext_vector_type(8)));
typedef float f32x4 __attribute__((ext_vector_type(4)));
constexpr int BM = 256, BK = 64, HALF = 128, HTB = HALF * BK * 2  , STAGE_BYTES = 8 * HTB, NXCD = 8, WGM = 8;

__host__ __device__ __forceinline__ int lds_byte(int r, int c) { const int st = (r >> 4) * 2 + (c >> 5), rr = r & 15, cc = c & 31, ob = rr * 64 + cc * 2; return st * 1024 + (ob ^ (((ob >> 9) & 1) << 5)); }
__host__ __device__ __forceinline__ void stage_rc(int b, int& R, int& C) { const int st = b / 1024, sb = b % 1024, swz = sb ^ (((sb >> 9) & 1) << 5); R = (st >> 1) * 16 + swz / 64; C = (st & 1) * 32 + (swz % 64) / 2; }
__host__ __device__ __forceinline__ int perm32(int rho) { const int n = rho >> 4, i = rho & 15; return 8 * (i >> 2) + 4 * n + (i & 3); }

struct Unit { int pm, pn; };
struct Gemm { const bf16_t* A; const bf16_t* Bt; int M, N, K, lda, ldb; };

struct StaticOrder {
    int nM, nN, nwg, G, c;
    __host__ __device__ void init(int M, int N, int G_, int c_) { nM = M / BM; nN = N / BM; nwg = nM * nN; G = G_; c = c_; }
    __host__ __device__ bool next(int i, Unit& u) const {
        const long L = (long)i * G + c; if (L >= nwg) return false;
        int wgid = (int)L; { const int q = nwg / NXCD, r = nwg % NXCD, xcd = wgid % NXCD, off = wgid / NXCD; wgid = (xcd < r ? xcd * (q + 1) : r * (q + 1) + (xcd - r) * q) + off; }
        const int nig = WGM * nN, gid = wgid / nig, fm = gid * WGM, gsz = (nM - fm) < WGM ? (nM - fm) : WGM;
        u.pm = fm + ((wgid % nig) % gsz); u.pn = (wgid % nig) / gsz; return true;
    }
    __device__ __forceinline__ void a_ready(const Unit&) const {}
    __device__ __forceinline__ void done(const Unit&) const {}
};
template <class Epi, class Sched, bool STAMP = false>
__device__ __forceinline__ void gemm_phase(PG8_LAS unsigned char* lds, const Gemm g, const Sched& S, const Epi& E, unsigned long long* stamps, int tid_in) {
    const int tid = tid_in, wid = __builtin_amdgcn_readfirstlane(tid >> 6), lane = tid & 63, wr = wid >> 2, wc = wid & 3, fr = lane & 15, fq = lane >> 4;
    const int K = g.K, nt = K / BK;
    int ts_lo = 0, ts_hi = 0, nts = 0; const unsigned long long rt_entry = STAMP ? (unsigned long long)wall_clock64() : 0ull;
#define PG8_STAMP() do { if (STAMP && wid == 0 && nts < 64) { const unsigned long long _c = (unsigned long long)clock64(); \
        ts_lo = (lane == nts) ? (int)(unsigned)_c : ts_lo; ts_hi = (lane == nts) ? (int)(unsigned)(_c >> 32) : ts_hi; ++nts; } } while (0)
    PG8_STAMP();
    unsigned voffA[2], voffB[2];
#pragma unroll
    for (int i = 0; i < 2; ++i) { int R, C; stage_rc(tid * 16 + i * 8192, R, C); const int Rb = Epi::PERM ? ((R & ~31) + perm32(R & 31)) : R;
        voffA[i] = (unsigned)(R * g.lda + C) * 2u; voffB[i] = (unsigned)(Rb * g.ldb + C) * 2u; }
    const size_t kstep = (size_t)(BK * 2);
    const size_t hstepA = (size_t)HALF * g.lda * 2, hstepB = (size_t)HALF * g.ldb * 2;
    const size_t tstepA = 2 * hstepA, tstepB = 2 * hstepB;
    const unsigned ldsw = (unsigned)wid * 1024u;
    const int aoff = lds_byte(wr * 64 + fr, fq * 8), boff = lds_byte(wc * 32 + fr, fq * 8);
#define PG8_SA(b, h) (((b) * 2 + (h)) * HTB)
#define PG8_SB(b, h) ((4 + (b) * 2 + (h)) * HTB)
#define PG8_STAGE(bufoff, gbase, voff) do { _Pragma("unroll") for (int _i = 0; _i < 2; ++_i) \
        __builtin_amdgcn_global_load_lds((const unsigned*)((const char*)(gbase) + (voff)[_i]), (PG8_LAS unsigned*)(lds + (bufoff) + ldsw + _i * 8192), 16, 0, 0); } while (0)
#define PG8_LDA(dst, b, h) do { _Pragma("unroll") for (int m = 0; m < 4; ++m) _Pragma("unroll") for (int k = 0; k < 2; ++k) dst[m][k] = *(const PG8_LAS bf16x8*)(lds + PG8_SA(b, h) + aoff + m * 2048 + k * 1024); } while (0)
#define PG8_LDB(dst, b, h) do { _Pragma("unroll") for (int n = 0; n < 2; ++n) _Pragma("unroll") for (int k = 0; k < 2; ++k) dst[n][k] = *(const PG8_LAS bf16x8*)(lds + PG8_SB(b, h) + boff + n * 2048 + k * 1024); } while (0)
#define PG8_MMA(ai, bj, At, Bt) do { __builtin_amdgcn_s_setprio(1); _Pragma("unroll") for (int m = 0; m < 4; ++m) _Pragma("unroll") for (int n = 0; n < 2; ++n) _Pragma("unroll") for (int k = 0; k < 2; ++k) \
        acc[ai][bj][m][n] = __builtin_amdgcn_mfma_f32_16x16x32_bf16(Bt[n][k], At[m][k], acc[ai][bj][m][n], 0, 0, 0); __builtin_amdgcn_s_setprio(0); } while (0)
#define PG8_WAIT_V(n) asm volatile("s_waitcnt vmcnt(" #n ")" ::: "memory")
#define PG8_WAIT_L(n) asm volatile("s_waitcnt lgkmcnt(" #n ")" ::: "memory")
#define PG8_BAR __builtin_amdgcn_s_barrier()
#define PG8_SCHED __builtin_amdgcn_sched_barrier(0)
    Unit cur, nxt; int ui = 0;
    if (!S.next(0, cur)) return;
    f32x4 acc[2][2][4][2];
#pragma unroll
    for (int a = 0; a < 2; ++a)
#pragma unroll
        for (int b = 0; b < 2; ++b)
#pragma unroll
            for (int m = 0; m < 4; ++m)
#pragma unroll
                for (int n = 0; n < 2; ++n) acc[a][b][m][n] = (f32x4){0.f, 0.f, 0.f, 0.f};
    bf16x8 At[4][2], B0[2][2], B1[2][2];
    const char* cA = (const char*)g.A + (size_t)cur.pm * tstepA; const char* cB = (const char*)g.Bt + (size_t)cur.pn * tstepB;
    S.a_ready(cur);
    PG8_STAGE(PG8_SB(0, 0), cB, voffB); PG8_STAGE(PG8_SA(0, 0), cA, voffA); PG8_STAGE(PG8_SB(0, 1), cB + hstepB, voffB); PG8_STAGE(PG8_SA(0, 1), cA + hstepA, voffA);
    if (wr == 1) PG8_BAR;
    PG8_WAIT_V(4); PG8_BAR;
    PG8_STAGE(PG8_SB(1, 0), cB + kstep, voffB); PG8_STAGE(PG8_SA(1, 0), cA + kstep, voffA); PG8_STAGE(PG8_SB(1, 1), cB + hstepB + kstep, voffB);
    PG8_WAIT_V(6); PG8_BAR;
    PG8_STAMP();
    for (;;) {
        const bool has_next = S.next(ui + 1, nxt);
        const char* nA = has_next ? (const char*)g.A + (size_t)nxt.pm * tstepA : cA; const char* nB = has_next ? (const char*)g.Bt + (size_t)nxt.pn * tstepB : cB;
        for (int t = 0; t < nt; t += 2) {
            const bool last = (t == nt - 2);
            const char* a1 = cA + (size_t)(t + 1) * kstep;
            const char* a2 = last ? nA : cA + (size_t)(t + 2) * kstep; const char* b2 = last ? nB : cB + (size_t)(t + 2) * kstep;
            const char* a3 = a2 + kstep; const char* b3 = b2 + kstep;
            if (last && has_next) S.a_ready(nxt);
            PG8_LDB(B0, 0, 0); PG8_SCHED; PG8_LDA(At, 0, 0); PG8_STAGE(PG8_SA(1, 1), a1 + hstepA, voffA);
            PG8_WAIT_L(8); PG8_BAR; PG8_WAIT_L(0); PG8_MMA(0, 0, At, B0); PG8_BAR; PG8_SCHED;
            PG8_LDB(B1, 0, 1); PG8_STAGE(PG8_SB(0, 0), b2, voffB);
            PG8_BAR; PG8_WAIT_L(0); PG8_MMA(0, 1, At, B1); PG8_BAR;
            PG8_LDA(At, 0, 1); PG8_STAGE(PG8_SA(0, 0), a2, voffA);
            PG8_BAR; PG8_WAIT_L(0); PG8_MMA(1, 0, At, B0); PG8_BAR; PG8_SCHED;
            PG8_STAGE(PG8_SB(0, 1), b2 + hstepB, voffB);
            PG8_WAIT_V(6); PG8_BAR; PG8_MMA(1, 1, At, B1); PG8_BAR;
            PG8_LDB(B0, 1, 0); PG8_SCHED; PG8_LDA(At, 1, 0); PG8_STAGE(PG8_SA(0, 1), a2 + hstepA, voffA);
            PG8_WAIT_L(8); PG8_BAR; PG8_WAIT_L(0); PG8_MMA(0, 0, At, B0); PG8_BAR; PG8_SCHED;
            PG8_LDB(B1, 1, 1); PG8_STAGE(PG8_SB(1, 0), b3, voffB);
            PG8_BAR; PG8_WAIT_L(0); PG8_MMA(0, 1, At, B1); PG8_BAR;
            PG8_LDA(At, 1, 1); PG8_STAGE(PG8_SA(1, 0), a3, voffA);
            PG8_BAR; PG8_WAIT_L(0); PG8_MMA(1, 0, At, B0); PG8_BAR; PG8_SCHED;
            PG8_STAGE(PG8_SB(1, 1), b3 + hstepB, voffB);
            PG8_WAIT_V(6); PG8_BAR; PG8_MMA(1, 1, At, B1); PG8_BAR;
        }
        PG8_STAMP();
        if constexpr (!Epi::AFTER_DRAIN) { E(acc, cur, wr, wc, fr, fq); S.done(cur); }
        PG8_STAMP();
        if (!has_next) break;
#pragma unroll
        for (int a = 0; a < 2; ++a)
#pragma unroll
            for (int b = 0; b < 2; ++b)
#pragma unroll
                for (int m = 0; m < 4; ++m)
#pragma unroll
                    for (int n = 0; n < 2; ++n) acc[a][b][m][n] = (f32x4){0.f, 0.f, 0.f, 0.f};
        cur = nxt; cA = nA; cB = nB; ++ui;
    }
    PG8_WAIT_V(0);
    if (wr == 0) PG8_BAR;
    PG8_BAR;
    if constexpr (Epi::AFTER_DRAIN) { E.fused(acc, cur, wr, wc, fr, fq, lds, wid, lane); S.done(cur); }
    PG8_STAMP();
    if (STAMP && wid == 0) { stamps[lane] = lane < nts ? (((unsigned long long)(unsigned)ts_hi << 32) | (unsigned)ts_lo) : 0ull;
        if (lane == 62) stamps[62] = rt_entry; if (lane == 63) stamps[63] = (unsigned long long)wall_clock64(); }
#undef PG8_STAMP
#undef PG8_SA
#undef PG8_SB
#undef PG8_STAGE
#undef PG8_LDA
#undef PG8_LDB
#undef PG8_MMA
#undef PG8_WAIT_V
#undef PG8_WAIT_L
#undef PG8_BAR
#undef PG8_SCHED
}
}

DI int rowmap(int n, int mode) { return mode == 0 ? n : ((n >> 4) * 32 + (n & 15) + (mode == 2 ? 16 : 0)); }
DI void tconv_tile(const Ctx& c, const float* src, int ld, int N, bf16_t* dst, int ld_dst, int mode, int tk, int tn) {
    bf16_t* T = (bf16_t*)c.smem;
    const int k0 = tk * 64, n0 = tn * 64, tid = c.tid;
    __syncthreads();
#pragma unroll
    for (int i = 0; i < 2; ++i) {
        const int kk = (tid >> 4) + i * 32, n4 = (tid & 15) * 4;
        float4 v = make_float4(0.f, 0.f, 0.f, 0.f);
        if (n0 + n4 < N) v = *(const float4*)(src + (size_t)(k0 + kk) * ld + n0 + n4);
        T[(n4 + 0) * 72 + kk] = f2bf(v.x); T[(n4 + 1) * 72 + kk] = f2bf(v.y); T[(n4 + 2) * 72 + kk] = f2bf(v.z); T[(n4 + 3) * 72 + kk] = f2bf(v.w);
    }
    __syncthreads();
    const int n = tid >> 3, k8 = (tid & 7) * 8;
    if (n0 + n < N) *(u32x4*)(dst + (size_t)rowmap(n0 + n, mode) * ld_dst + k0 + k8) = *(const u32x4*)(T + n * 72 + k8);
}
DI void tconv(const Ctx& c, const float* src, int ld, int K, int N, bf16_t* dst, int ld_dst, int mode, int rot) {
    const int ntk = K / 64, ntn = (N + 63) / 64, nt = ntk * ntn, G = gridDim.x;
    for (int t = (blockIdx.x + G - (rot % G)) % G; t < nt; t += G) tconv_tile(c, src, ld, N, dst, ld_dst, mode, t / ntn, t % ntn);
}

DI void phase_prologue(const Ctx& c) {
    unsigned char* wsm = c.ws + WS_WSM;
    const int tid = c.tid, G = gridDim.x, gtid = blockIdx.x * NTHR + tid, gn = G * NTHR;
    {
        const float4* x = (const float4*)c.in[0]; const float4* cx = (const float4*)c.in[2]; float4* H = (float4*)(c.ws + WS_H);
        for (size_t i = gtid; i < (size_t)NZ * 256; i += gn) {
            const int z = (int)(i >> 8), q = (int)(i & 255), b = z / TZ, s = z % TZ;
            H[i] = (s < CTX) ? cx[((size_t)b * CTX + s) * 256 + q] : x[((size_t)b * SEQ + (s - CTX)) * 256 + q];
        }
    }
    {
        float* rope = (float*)(wsm + OFF_ROPE);
        for (int i = gtid; i < SEQ * 16; i += gn) {
            const int t = i >> 4, a = (i >> 3) & 1, f = i & 7;
            const float pos = (float)(a == 0 ? (t >> 6) : (t & 63));
            const float inv = powf(10000.f, -(float)f / 8.f);
            float sn, cs; sincosf(pos * inv, &sn, &cs);
            rope[i * 2] = cs; rope[i * 2 + 1] = sn;
        }
    }
    {
        float* s5t = (float*)(wsm + OFF_S5T);
        for (int i = gtid; i < NL * 2 * 16 * 64; i += gn) {
            const int ldg = i >> 6;
            const double lr = c.in[24][i], li = c.in[25][i], dt = exp((double)c.in[26][ldg]);
            const double mag = exp(lr * dt), are = mag * cos(li * dt), aim = mag * sin(li * dt);
            const double m256 = exp(lr * dt * 64.0), a256r = m256 * cos(li * dt * 64.0), a256i = m256 * sin(li * dt * 64.0);
            const double den = lr * lr + li * li, nr = are - 1.0, ni = aim;
            const double cfr = (nr * lr + ni * li) / den, cfi = (ni * lr - nr * li) / den;
            float* o = s5t + (size_t)i * 36;
            o[0] = (float)are; o[1] = (float)aim; o[2] = (float)a256r; o[3] = (float)a256i;
            for (int ch = 0; ch < 16; ++ch) {
                const double br = c.in[27][(size_t)i * 16 + ch], bi = c.in[28][(size_t)i * 16 + ch];
                o[4 + ch] = (float)(cfr * br - cfi * bi); o[20 + ch] = (float)(cfr * bi + cfi * br);
            }
        }
    }
    {
        float* rwt = (float*)(wsm + OFF_RWT);
        for (int i = gtid; i < NL * 36 * 1024; i += gn) {
            const int l = i / (36 * 1024), e = (i / 1024) % 36, d = i & 1023;
            rwt[i] = e < 4 ? c.in[41][((size_t)l * 1024 + d) * 4 + e] : c.in[43][((size_t)l * 1024 + d) * 32 + (e - 4)];
        }
    }
    if (blockIdx.x == 0 && tid < NL) {
        float s1 = 0.f, s2 = 0.f;
        for (int i = 0; i < 32; ++i) { s1 += c.in[34][tid * 32 + i] * c.in[35][tid * 32 + i]; s2 += c.in[36][tid * 32 + i] * c.in[37][tid * 32 + i]; }
        ((float*)(wsm + OFF_LAM))[tid] = expf(s1) - expf(s2) + (0.8f - 0.6f * expf(-0.3f * (float)tid));
    }
    {
        float* sv = (float*)c.smem;
        float* red = sv + 3 * 1024;
        __syncthreads();
        for (int i = tid; i < 3 * 1024; i += NTHR) { const float v = i < 2048 ? c.in[1][i] : c.in[3][i - 2048]; sv[i] = siluf_(v); }
        __syncthreads();
        float* modv = (float*)(wsm + OFF_MODV);
        for (int u = blockIdx.x; u < NL * 96; u += G) {
            const int l = u / 96, col = (u % 96) * 64 + (tid & 63), ks = tid >> 6;
            const float* w = c.in[4] + (size_t)l * 1024 * 6144 + col;
            float a0 = 0.f, a1 = 0.f, a2 = 0.f;
            for (int k = ks * 128; k < ks * 128 + 128; ++k) { const float wv = w[(size_t)k * 6144]; a0 += sv[k] * wv; a1 += sv[1024 + k] * wv; a2 += sv[2048 + k] * wv; }
            red[(ks * 64 + (tid & 63)) * 3 + 0] = a0; red[(ks * 64 + (tid & 63)) * 3 + 1] = a1; red[(ks * 64 + (tid & 63)) * 3 + 2] = a2;
            __syncthreads();
            if (tid < 192) {
                const int cc = tid & 63, sel = tid >> 6; float s = 0.f;
                for (int k2 = 0; k2 < 8; ++k2) s += red[(k2 * 64 + cc) * 3 + sel];
                const int colo = (u % 96) * 64 + cc;
                modv[((size_t)l * 3 + sel) * 6144 + colo] = s + c.in[5][l * 6144 + colo];
            }
            __syncthreads();
        }
    }
    for (int l = 0; l < NL; ++l) {
        tconv(c, c.in[8] + (size_t)l * 1024 * NIN, NIN, 1024, NIN, (bf16_t*)(wsm + OFF_WINT + l * SZ_WINT), 1024, 0, 0);
        tconv(c, c.in[11] + (size_t)l * 256 * 384, 384, 256, 384, (bf16_t*)(wsm + OFF_WUQT + l * SZ_WUQT), 256, 0, 40);
        tconv(c, c.in[12] + (size_t)l * 128 * 512, 512, 128, 512, (bf16_t*)(wsm + OFF_WUKVT + l * SZ_WUKVT), 128, 0, 70);
        for (int d = 0; d < 2; ++d) {
            tconv(c, c.in[15] + (size_t)(l * 2 + d) * 64 * 256, 256, 64, 256, (bf16_t*)(wsm + OFF_W2T + l * SZ_W2T) + d * 256 * 64, 64, 0, 90 + d * 8);
            tconv(c, c.in[17] + (size_t)(l * 2 + d) * 64 * 256, 256, 64, 256, (bf16_t*)(wsm + OFF_A2T + l * SZ_A2T) + d * 256 * 64, 64, 0, 110 + d * 8);
        }
        tconv(c, c.in[18] + (size_t)l * 128 * 256, 256, 128, 256, (bf16_t*)(wsm + OFF_G2T + l * SZ_G2T), 128, 0, 130);
        tconv(c, c.in[32] + (size_t)l * 256 * 256, 256, 256, 256, (bf16_t*)(wsm + OFF_GLUT + l * SZ_GLUT), 256, 0, 140);
        for (int n = 0; n < 4; ++n)
            tconv(c, c.in[39] + (size_t)(l * 4 + n) * 256 * 1024, 1024, 256, 1024, (bf16_t*)(wsm + OFF_WBT + l * SZ_WBT) + n * 256, 1024, 0, 160 + n * 20);
        tconv(c, c.in[40] + (size_t)l * 1024 * 1024, 1024, 1024, 1024, (bf16_t*)(wsm + OFF_WOUTT + l * SZ_WOUTT), 1024, 0, 0);
    }
}

DI void phase_expert_convert(const Ctx& c, int l) {
    const int G = gridDim.x, lane = c.lane;
    for (int t = blockIdx.x * 8 + c.wave; t < 32 * 384; t += G * 8) {
        const int e = t / 384, r = t % 384;
        const float* src; bf16_t* dst; int ld, ldd, mode, tk, tn;
        if (r < 128)      { src = c.in[45] + ((size_t)l * 32 + e) * 1024 * 512; dst = (bf16_t*)(c.ws + WS_EXPW + (size_t)e * SZ_WGU); ld = 512; ldd = 1024; mode = 1; tk = r / 8; tn = r % 8; }
        else if (r < 256) { src = c.in[46] + ((size_t)l * 32 + e) * 1024 * 512; dst = (bf16_t*)(c.ws + WS_EXPW + (size_t)e * SZ_WGU); ld = 512; ldd = 1024; mode = 2; tk = (r - 128) / 8; tn = (r - 128) % 8; }
        else              { src = c.in[47] + ((size_t)l * 32 + e) * 512 * 1024; dst = (bf16_t*)(c.ws + WS_EXPW + 32 * SZ_WGU + (size_t)e * SZ_WD); ld = 1024; ldd = 512; mode = 0; tk = (r - 256) / 16; tn = (r - 256) % 16; }
        const int n = tn * 64 + lane; const float* sp = src + (size_t)(tk * 64) * ld + n; bf16_t* dp = dst + (size_t)rowmap(n, mode) * ldd + tk * 64;
#pragma unroll
        for (int kb = 0; kb < 8; ++kb) {
            float v[8];
#pragma unroll
            for (int j = 0; j < 8; ++j) v[j] = sp[(size_t)(kb * 8 + j) * ld];
            u32x4 w4; w4.x = pack2(v[0], v[1]); w4.y = pack2(v[2], v[3]); w4.z = pack2(v[4], v[5]); w4.w = pack2(v[6], v[7]);
            *(u32x4*)(dp + kb * 8) = w4;
        }
    }
}

DI void phase_norm1(const Ctx& c, int l) {
    const float* modv = (const float*)(c.ws + WS_WSM + OFF_MODV);
    float* H = (float*)(c.ws + WS_H); const bf16_t* Y = (const bf16_t*)(c.ws + WS_P);
    bf16_t* XN = (bf16_t*)(c.ws + WS_BUFA);
    const float* g1 = c.in[6] + l * 1024;
    for (int row = blockIdx.x * 8 + c.wave; row < NZ; row += gridDim.x * 8) {
        const int b = row / TZ, s = row % TZ, sel = s < CTX ? 2 : b;
        float4 v[4]; float ss = 0.f;
#pragma unroll
        for (int q = 0; q < 4; ++q) {
            const int col = q * 256 + c.lane * 4;
            v[q] = *(const float4*)(H + (size_t)row * D + col);
            if (l > 0) {
                float ya[4], yb[4]; unpack4(*(const u32x2*)(Y + (size_t)row * D + col), ya); unpack4(*(const u32x2*)(Y + ((size_t)NZ + row) * D + col), yb);
                const float4 m5 = *(const float4*)(modv + ((size_t)(l - 1) * 3 + sel) * 6144 + 5 * 1024 + col);
                v[q].x += m5.x * (ya[0] + yb[0]); v[q].y += m5.y * (ya[1] + yb[1]); v[q].z += m5.z * (ya[2] + yb[2]); v[q].w += m5.w * (ya[3] + yb[3]);
                *(float4*)(H + (size_t)row * D + col) = v[q];
            }
            ss += v[q].x * v[q].x + v[q].y * v[q].y + v[q].z * v[q].z + v[q].w * v[q].w;
        }
        ss = wave_sum(ss);
        const float rs = rsqrtf(ss * (1.f / 1024.f) + 1e-6f);
#pragma unroll
        for (int q = 0; q < 4; ++q) {
            const int col = q * 256 + c.lane * 4;
            const float4 g = *(const float4*)(g1 + col), m0 = *(const float4*)(modv + ((size_t)l * 3 + sel) * 6144 + col), m1 = *(const float4*)(modv + ((size_t)l * 3 + sel) * 6144 + 1024 + col);
            *(u32x2*)(XN + (size_t)row * D + col) = pack4(v[q].x * rs * g.x * (1.f + m1.x) + m0.x, v[q].y * rs * g.y * (1.f + m1.y) + m0.y,
                                                          v[q].z * rs * g.z * (1.f + m1.z) + m0.z, v[q].w * rs * g.w * (1.f + m1.w) + m0.w);
        }
    }
}

DI void phase_final(const Ctx& c) {
    const float* modv = (const float*)(c.ws + WS_WSM + OFF_MODV);
    const float* H = (const float*)(c.ws + WS_H); const bf16_t* Y = (const bf16_t*)(c.ws + WS_P);
    const float* g = c.in[48];
    for (int r = blockIdx.x * 8 + c.wave; r < NB * SEQ; r += gridDim.x * 8) {
        const int b = r / SEQ, t = r % SEQ, row = b * TZ + CTX + t;
        float4 v[4]; float ss = 0.f;
#pragma unroll
        for (int q = 0; q < 4; ++q) {
            const int col = q * 256 + c.lane * 4;
            v[q] = *(const float4*)(H + (size_t)row * D + col);
            float ya[4], yb[4]; unpack4(*(const u32x2*)(Y + (size_t)row * D + col), ya); unpack4(*(const u32x2*)(Y + ((size_t)NZ + row) * D + col), yb);
            const float4 m5 = *(const float4*)(modv + ((size_t)(NL - 1) * 3 + b) * 6144 + 5 * 1024 + col);
            v[q].x += m5.x * (ya[0] + yb[0]); v[q].y += m5.y * (ya[1] + yb[1]); v[q].z += m5.z * (ya[2] + yb[2]); v[q].w += m5.w * (ya[3] + yb[3]);
            ss += v[q].x * v[q].x + v[q].y * v[q].y + v[q].z * v[q].z + v[q].w * v[q].w;
        }
        ss = wave_sum(ss);
        const float rs = rsqrtf(ss * (1.f / 1024.f) + 1e-6f);
#pragma unroll
        for (int q = 0; q < 4; ++q) {
            const int col = q * 256 + c.lane * 4; const float4 gg = *(const float4*)(g + col);
            *(float4*)(c.out + (size_t)r * D + col) = make_float4(v[q].x * rs * gg.x, v[q].y * rs * gg.y, v[q].z * rs * gg.z, v[q].w * rs * gg.w);
        }
    }
}

struct EpiInproj {
    static constexpr bool PERM = false, AFTER_DRAIN = false;
    bf16_t *PM, *PS, *PR, *PD, *GT;
    DI void operator()(const pg8::f32x4 (&acc)[2][2][4][2], const pg8::Unit& u, int wr, int wc, int fr, int fq) const {
        const int row0 = u.pm * 256 + wr * 64 + fr, col0 = u.pn * 256 + wc * 32 + 4 * fq;
#pragma unroll
        for (int bj = 0; bj < 2; ++bj)
#pragma unroll
            for (int n = 0; n < 2; ++n) {
                const int col = col0 + bj * 128 + n * 16;
                bf16_t* dst; int ld, cc; bool gate = false;
                if (col < 416) { dst = PM; ld = 416; cc = col; }
                else if (col < 1440) { dst = PR; ld = 1024; cc = col - 416; }
                else if (col < 1696) { dst = PS; ld = 256; cc = col - 1440; }
                else if (col < 2464) { dst = PD; ld = 768; cc = col - 1696; }
                else if (col < NIN) { dst = GT; ld = 4096; cc = col - 2464; gate = true; }
                else continue;
#pragma unroll
                for (int ai = 0; ai < 2; ++ai)
#pragma unroll
                    for (int m = 0; m < 4; ++m) {
                        const int row = row0 + ai * 128 + m * 16; pg8::f32x4 v = acc[ai][bj][m][n];
                        if (gate) { v[0] = sigmoidf_(v[0]); v[1] = sigmoidf_(v[1]); v[2] = sigmoidf_(v[2]); v[3] = sigmoidf_(v[3]); }
                        *(u32x2*)(dst + (size_t)row * ld + cc) = pack4(v[0], v[1], v[2], v[3]);
                    }
            }
    }
};
DI void phase_inproj(const Ctx& c, int l) {
    EpiInproj E; E.PM = (bf16_t*)(c.ws + WS_P + P_PM); E.PS = (bf16_t*)(c.ws + WS_P + P_PS); E.PR = (bf16_t*)(c.ws + WS_P + P_PR); E.PD = (bf16_t*)(c.ws + WS_P + P_PD); E.GT = (bf16_t*)(c.ws + WS_GT);
    pg8::Gemm g{(const bf16_t*)(c.ws + WS_BUFA), (const bf16_t*)(c.ws + WS_WSM + OFF_WINT + l * SZ_WINT), NZ, NINP, 1024, 1024, 1024};
    pg8::StaticOrder S; S.init(NZ, NINP, (int)gridDim.x, (int)blockIdx.x);
    __syncthreads();
    pg8::gemm_phase<EpiInproj, pg8::StaticOrder, false>((PG8_LAS unsigned char*)c.smem, g, S, E, nullptr, c.tid);
}

DI void phase_prep(const Ctx& c, int l) {
    unsigned char* ws = c.ws; const int lane = c.lane, wave = c.wave, tid = c.tid;
    const bf16_t* PM = (const bf16_t*)(ws + WS_P + P_PM); const bf16_t* PR = (const bf16_t*)(ws + WS_P + P_PR); const bf16_t* PD = (const bf16_t*)(ws + WS_P + P_PD);
    bf16_t* CQN = (bf16_t*)(ws + WS_MISC + MS_CQN); bf16_t* TW = (bf16_t*)(ws + WS_MISC + MS_TW); bf16_t* AL = (bf16_t*)(ws + WS_MISC + MS_AL); bf16_t* SG = (bf16_t*)(ws + WS_MISC + MS_SG);
    bf16_t* KM = (bf16_t*)(ws + WS_EXPW + MX_KM); bf16_t* QD = (bf16_t*)(ws + WS_EXPW + MX_QD); bf16_t* KD_ = (bf16_t*)(ws + WS_EXPW + MX_KD); bf16_t* VDT = (bf16_t*)(ws + WS_EXPW + MX_VDT);
    bf16_t* RB = (bf16_t*)(ws + WS_EXPW + MX_RB); bf16_t* KB = (bf16_t*)(ws + WS_EXPW + MX_KB); bf16_t* VB = (bf16_t*)(ws + WS_EXPW + MX_VB); bf16_t* KKB = (bf16_t*)(ws + WS_EXPW + MX_KKB);
    const float* rope = (const float*)(ws + WS_WSM + OFF_ROPE);
    const float* gq = c.in[9] + l * 256; const float* gkv = c.in[10] + l * 128; const float* mu = c.in[13] + l * 1024; const float* k_k = c.in[19] + l * 256;
    bf16_t* Vs = (bf16_t*)c.smem;
    const float qsc = 0.17677669529663687f * LOG2E;
    for (int tile = blockIdx.x; tile < NZ / 64; tile += gridDim.x) {
        __syncthreads();
        for (int i = 0; i < 8; ++i) {
            const int rt = wave * 8 + i, z = tile * 64 + rt, b = z / TZ, s = z % TZ; const bool lat = s >= CTX; const int tl = lat ? s - CTX : 0;
            {
                const bf16_t* pm = PM + (size_t)z * 416;
                float x[4]; unpack4(*(const u32x2*)(pm + lane * 4), x);
                float ss = wave_sum(x[0] * x[0] + x[1] * x[1] + x[2] * x[2] + x[3] * x[3]);
                float rs = rsqrtf(ss * (1.f / 256.f) + 1e-6f);
                const float4 g = *(const float4*)(gq + lane * 4);
                *(u32x2*)(CQN + (size_t)z * 384 + lane * 4) = pack4(x[0] * rs * g.x, x[1] * rs * g.y, x[2] * rs * g.z, x[3] * rs * g.w);
                const unsigned u2 = *(const unsigned*)(pm + 256 + lane * 2); const float y0 = lo2f(u2), y1 = hi2f(u2);
                ss = wave_sum(y0 * y0 + y1 * y1); rs = rsqrtf(ss * (1.f / 128.f) + 1e-6f);
                const float2 g2 = *(const float2*)(gkv + lane * 2);
                *(unsigned*)(CQN + (size_t)z * 384 + 256 + lane * 2) = pack2(y0 * rs * g2.x, y1 * rs * g2.y);
                float kr = bf2f(pm[384 + (lane & 31)]);
                const float pr = __shfl_xor(kr, 8, 64);
                if (lat) { const float* cs = rope + ((size_t)tl * 16 + ((lane & 31) >> 4) * 8 + (lane & 7)) * 2; kr = kr * cs[0] + ((lane & 8) ? pr : -pr) * cs[1]; }
                if (lane < 32) {
                    const bf16_t kv = f2bf(kr);
#pragma unroll
                    for (int h = 0; h < 4; ++h) KM[((size_t)(b * 4 + h) * TZ + s) * 96 + 64 + lane] = kv;
                }
            }
            {
                const bf16_t* pd = PD + (size_t)z * 768;
                const int i0 = lane * 4, hh = i0 >> 6, ii = i0 & 31, nn = (i0 >> 5) & 1;
                const float* cs = rope + ((size_t)tl * 16 + (ii >> 4) * 8 + (ii & 7)) * 2;
                const bool hi = (ii & 8) != 0;
#pragma unroll
                for (int w = 0; w < 2; ++w) {
                    float x[4]; unpack4(*(const u32x2*)(pd + w * 256 + i0), x);
                    float o[4];
#pragma unroll
                    for (int j = 0; j < 4; ++j) {
                        const float p = __shfl_xor(x[j], 2, 64);
                        o[j] = lat ? (x[j] * cs[2 * j] + (hi ? p : -p) * cs[2 * j + 1]) : x[j];
                        if (w == 0) o[j] *= qsc;
                    }
                    bf16_t* dst = (w == 0 ? QD : KD_) + ((size_t)(b * 4 + hh) * TZ + s) * 64 + nn * 32 + ii;
                    *(u32x2*)dst = pack4(o[0], o[1], o[2], o[3]);
                }
                *(u32x2*)(Vs + rt * 264 + i0) = *(const u32x2*)(pd + 512 + i0);
            }
            {
                const bf16_t* pr = PR + (size_t)z * 1024;
                const bool hp = (s != 0) && (s != CTX), hn = (s != CTX - 1) && (s != TZ - 1);
#pragma unroll
                for (int q = 0; q < 4; ++q) {
                    const int col = q * 256 + lane * 4;
                    float cu[4], pv[4] = {0.f, 0.f, 0.f, 0.f}, nx[4] = {0.f, 0.f, 0.f, 0.f};
                    unpack4(*(const u32x2*)(pr + col), cu);
                    if (hp) unpack4(*(const u32x2*)(pr - 1024 + col), pv);
                    if (hn) unpack4(*(const u32x2*)(pr + 1024 + col), nx);
                    const float4 m = *(const float4*)(mu + col);
                    float zv[4];
                    zv[0] = cu[0] + (0.5f * (pv[0] + nx[0]) - cu[0]) * m.x; zv[1] = cu[1] + (0.5f * (pv[1] + nx[1]) - cu[1]) * m.y;
                    zv[2] = cu[2] + (0.5f * (pv[2] + nx[2]) - cu[2]) * m.z; zv[3] = cu[3] + (0.5f * (pv[3] + nx[3]) - cu[3]) * m.w;
                    if (q == 0) *(u32x2*)(RB + (size_t)z * 256 + lane * 4) = pack4(zv[0], zv[1], zv[2], zv[3]);
                    else if (q == 1) {
                        *(u32x2*)(KB + (size_t)z * 256 + lane * 4) = pack4(zv[0], zv[1], zv[2], zv[3]);
                        const float4 kk4 = *(const float4*)(k_k + lane * 4);
                        const float a0 = zv[0] * kk4.x, a1 = zv[1] * kk4.y, a2 = zv[2] * kk4.z, a3 = zv[3] * kk4.w;
                        const float ssq = sum16(a0 * a0 + a1 * a1 + a2 * a2 + a3 * a3);
                        const float inv = 1.f / fmaxf(sqrtf(ssq), 1e-12f);
                        *(u32x2*)(KKB + (size_t)z * 256 + lane * 4) = pack4(a0 * inv, a1 * inv, a2 * inv, a3 * inv);
                    } else if (q == 2) *(u32x2*)(VB + (size_t)z * 256 + lane * 4) = pack4(zv[0], zv[1], zv[2], zv[3]);
                    else {
                        if (lane < 16) *(u32x2*)(TW + (size_t)z * 64 + lane * 4) = pack4(tanhf(zv[0]), tanhf(zv[1]), tanhf(zv[2]), tanhf(zv[3]));
                        else if (lane < 32) *(u32x2*)(AL + (size_t)z * 64 + (lane - 16) * 4) = pack4(zv[0], zv[1], zv[2], zv[3]);
                        else *(u32x2*)(SG + (size_t)z * 128 + (lane - 32) * 4) = pack4(sigmoidf_(zv[0]), sigmoidf_(zv[1]), sigmoidf_(zv[2]), sigmoidf_(zv[3]));
                    }
                }
            }
        }
        __syncthreads();
        {
            const int z0 = tile * 64, b = z0 / TZ, s0 = z0 % TZ;
#pragma unroll
            for (int i = 0; i < 4; ++i) {
                const int ch = tid + i * NTHR, dv = ch >> 3, r8 = (ch & 7) * 8;
                bf16_t v[8];
#pragma unroll
                for (int j = 0; j < 8; ++j) v[j] = Vs[(r8 + j) * 264 + dv];
                u32x4 o; o.x = v[0] | ((unsigned)v[1] << 16); o.y = v[2] | ((unsigned)v[3] << 16); o.z = v[4] | ((unsigned)v[5] << 16); o.w = v[6] | ((unsigned)v[7] << 16);
                *(u32x4*)(VDT + ((size_t)(b * 4 + (dv >> 6)) * 64 + (dv & 63)) * TZ + s0 + r8) = o;
            }
        }
    }
}

constexpr int S5C = 64, S5N = TZ / S5C, S5NC = CTX / S5C;
DI int s5_tok(int dir, int i) { return dir == 0 ? i : (i < CTX ? CTX - 1 - i : TZ - 1 - (i - CTX)); }
DI void s5_stage_u(const Ctx& c, float* U, int b, int dir, int chunk, int g0, int ng) {
    const bf16_t* PS = (const bf16_t*)(c.ws + WS_P + P_PS);
    const int per = ng * 4;
    for (int e = c.tid; e < S5C * per; e += NTHR) {
        const int i = e / per, c4 = (e % per) * 4, s = s5_tok(dir, chunk * S5C + i);
        float x[4]; unpack4(*(const u32x2*)(PS + (size_t)(b * TZ + s) * 256 + g0 * 16 + c4), x);
        *(float4*)(U + i * (ng * 16) + c4) = make_float4(x[0], x[1], x[2], x[3]);
    }
}
DI void phase_s5_local(const Ctx& c, int l) {
    float* U = (float*)c.smem;
    const float* s5t = (const float*)(c.ws + WS_WSM + OFF_S5T);
    float* E = (float*)(c.ws + WS_WSM + OFF_S5E);
    for (int u = blockIdx.x; u < 2 * 2 * S5N * 2; u += gridDim.x) {
        const int gq = u & 1, chunk = (u >> 1) % S5N, dir = (u / (2 * S5N)) & 1, b = u / (4 * S5N);
        __syncthreads();
        s5_stage_u(c, U, b, dir, chunk, gq * 8, 8);
        __syncthreads();
        const int g = gq * 8 + c.wave, p = c.lane;
        const float* tb = s5t + ((size_t)((l * 2 + dir) * 16 + g) * 64 + p) * 36;
        const float are = tb[0], aim = tb[1];
        float br[16], bi[16];
#pragma unroll
        for (int ch = 0; ch < 16; ++ch) { br[ch] = tb[4 + ch]; bi[ch] = tb[20 + ch]; }
        float xr = 0.f, xi = 0.f;
        for (int i = 0; i < S5C; ++i) {
            const float* uu = U + i * 128 + c.wave * 16;
            float sr = 0.f, si = 0.f;
#pragma unroll
            for (int q = 0; q < 4; ++q) { const float4 v = *(const float4*)(uu + q * 4);
                sr += br[q * 4] * v.x + br[q * 4 + 1] * v.y + br[q * 4 + 2] * v.z + br[q * 4 + 3] * v.w;
                si += bi[q * 4] * v.x + bi[q * 4 + 1] * v.y + bi[q * 4 + 2] * v.z + bi[q * 4 + 3] * v.w; }
            const float nr = are * xr - aim * xi + sr, ni = are * xi + aim * xr + si; xr = nr; xi = ni;
        }
        *(float2*)(E + ((size_t)(((b * 2 + dir) * 16 + g) * S5N + chunk) * 64 + p) * 2) = make_float2(xr, xi);
    }
}
DI void phase_s5_carry(const Ctx& c, int l) {
    const int gt = blockIdx.x * NTHR + c.tid;
    if (gt < 2 * 2 * 16 * 64) {
        const int p = gt & 63, g = (gt >> 6) & 15, dir = (gt >> 10) & 1, b = gt >> 11;
        const float* tb = (const float*)(c.ws + WS_WSM + OFF_S5T) + ((size_t)((l * 2 + dir) * 16 + g) * 64 + p) * 36;
        const float ar = tb[2], ai = tb[3];
        const float* E = (const float*)(c.ws + WS_WSM + OFF_S5E) + (size_t)(((b * 2 + dir) * 16 + g) * S5N) * 128;
        float* C = (float*)(c.ws + WS_WSM + OFF_S5C) + (size_t)(((b * 2 + dir) * 16 + g) * S5N) * 128;
        float xr = 0.f, xi = 0.f;
        for (int ch = 0; ch < S5N; ++ch) {
            const float2 e = *(const float2*)(E + ch * 128 + p * 2);
            *(float2*)(C + ch * 128 + p * 2) = make_float2(xr, xi);
            const float nr = ar * xr - ai * xi + e.x, ni = ar * xi + ai * xr + e.y; xr = nr; xi = ni;
        }
    }
}

constexpr int S5_US = 0, S5_YS = 8192, S5_WV = S5_YS + 2 * 64 * 64 * 4;
template <bool LOCAL>
DI void phase_s5_final_unit(const Ctx& c, int l, int u) {
    unsigned char* L = c.smem;
    const float* s5t = (const float*)(c.ws + WS_WSM + OFF_S5T);
    const float* CIN = (const float*)(c.ws + WS_WSM + OFF_S5C);
    const bf16_t* PS = (const bf16_t*)(c.ws + WS_P + P_PS);
    const int gq = u & 3, ct = (u >> 2) % S5N, b = u / (4 * S5N);
    const int wave = c.wave, lane = c.lane, gl = wave >> 1, dir = wave & 1, g = gq * 4 + gl, n16 = lane & 15, q4 = lane >> 4;
    __syncthreads();
    {
        const int t = c.tid >> 3, part = c.tid & 7;
        *(u32x4*)(L + S5_US + t * 128 + part * 16) = *(const u32x4*)(PS + (size_t)(b * TZ + ct * S5C + t) * 256 + gq * 64 + part * 8);
    }
    const float* tbase = s5t + ((size_t)((l * 2 + dir) * 16 + g) * 64) * 36;
    bf16x8 bfr[8], cfr[4];
#pragma unroll
    for (int j = 0; j < 8; ++j) {
        const int pp = 16 * j + n16, p = pp & 63; const float* tb = tbase + (size_t)p * 36 + (pp < 64 ? 4 : 20) + 8 * (q4 & 1);
        u32x4 w4 = {0u, 0u, 0u, 0u};
        if (q4 < 2) { w4.x = pack2(tb[0], tb[1]); w4.y = pack2(tb[2], tb[3]); w4.z = pack2(tb[4], tb[5]); w4.w = pack2(tb[6], tb[7]); }
        bfr[j] = __builtin_bit_cast(bf16x8, w4);
    }
    {
        const float* cre = c.in[29] + ((size_t)((l * 2 + dir) * 16 + g) * 16 + n16) * 64; const float* cim = c.in[30] + ((size_t)((l * 2 + dir) * 16 + g) * 16 + n16) * 64;
#pragma unroll
        for (int s = 0; s < 4; ++s) {
            const int pp = 32 * s + 8 * q4; const float sg = pp < 64 ? 1.f : -1.f; const float* src = (pp < 64 ? cre + pp : cim + (pp - 64));
            u32x4 w4; w4.x = pack2(sg * src[0], sg * src[1]); w4.y = pack2(sg * src[2], sg * src[3]); w4.z = pack2(sg * src[4], sg * src[5]); w4.w = pack2(sg * src[6], sg * src[7]);
            cfr[s] = __builtin_bit_cast(bf16x8, w4);
        }
    }
    const float are = tbase[(size_t)lane * 36], aim = tbase[(size_t)lane * 36 + 1];
    const int cd = dir == 0 ? ct : (ct < S5NC ? S5NC - 1 - ct : S5N + S5NC - 1 - ct);
    float xr = 0.f, xi = 0.f;
    if (!LOCAL) { const float2 ci = *(const float2*)(CIN + ((size_t)(((b * 2 + dir) * 16 + g) * S5N + cd) * 64 + lane) * 2); xr = ci.x; xi = ci.y; }
    const float dsk = c.in[31][(size_t)l * 256 + g * 16 + n16];
    bf16_t* BU = (bf16_t*)(L + S5_WV + wave * 8192); bf16_t* XB = BU + 16 * 128;
    float* YS = (float*)(L + S5_YS) + dir * 64 * 64;
    __syncthreads();
#pragma unroll 1
    for (int sb = 0; sb < 4; ++sb) {
        const int stepA = 16 * sb + n16, tlA = dir == 0 ? stepA : 63 - stepA;
        u32x4 a4 = {0u, 0u, 0u, 0u};
        if (q4 < 2) a4 = *(const u32x4*)(L + S5_US + tlA * 128 + gl * 32 + q4 * 16);
        const bf16x8 af = __builtin_bit_cast(bf16x8, a4);
#pragma unroll
        for (int j = 0; j < 8; ++j) {
            f32x4 acc = {0.f, 0.f, 0.f, 0.f};
            acc = __builtin_amdgcn_mfma_f32_16x16x32_bf16(af, bfr[j], acc, 0, 0, 0);
#pragma unroll
            for (int rr = 0; rr < 4; ++rr) BU[(4 * q4 + rr) * 128 + 16 * j + n16] = f2bf(acc[rr]);
        }
#pragma unroll
        for (int ii = 0; ii < 16; ++ii) {
            const float br = bf2f(BU[ii * 128 + lane]), bi = bf2f(BU[ii * 128 + 64 + lane]);
            const float nr = are * xr - aim * xi + br, ni = are * xi + aim * xr + bi; xr = nr; xi = ni;
            if (!LOCAL) { XB[ii * 128 + lane] = f2bf(xr); XB[ii * 128 + 64 + lane] = f2bf(xi); }
        }
        if (LOCAL) continue;
        f32x4 ya = {0.f, 0.f, 0.f, 0.f};
#pragma unroll
        for (int s = 0; s < 4; ++s) {
            const bf16x8 xf = *(const bf16x8*)((const unsigned char*)XB + n16 * 256 + (32 * s + 8 * q4) * 2);
            ya = __builtin_amdgcn_mfma_f32_16x16x32_bf16(xf, cfr[s], ya, 0, 0, 0);
        }
#pragma unroll
        for (int rr = 0; rr < 4; ++rr) {
            const int step = 16 * sb + 4 * q4 + rr, tl = dir == 0 ? step : 63 - step;
            float y = ya[rr];
            if (dir == 0) y += dsk * bf2f(*(const bf16_t*)(L + S5_US + tl * 128 + (gl * 16 + n16) * 2));
            YS[tl * 64 + gl * 16 + n16] = y;
        }
    }
    if (LOCAL) { *(float2*)((float*)(c.ws + WS_WSM + OFF_S5E) + ((size_t)(((b * 2 + dir) * 16 + g) * S5N + cd) * 64 + lane) * 2) = make_float2(xr, xi); return; }
    __syncthreads();
    bf16_t* ZG = (bf16_t*)(c.ws + WS_MISC + MS_ZG);
    {
        const float* Y0 = (const float*)(L + S5_YS); const float* Y1 = Y0 + 64 * 64;
        for (int e = c.tid; e < 64 * 16; e += NTHR) {
            const int i = e >> 4, c4 = (e & 15) * 4; const float4 y0 = *(const float4*)(Y0 + i * 64 + c4), y1 = *(const float4*)(Y1 + i * 64 + c4);
            *(u32x2*)(ZG + (size_t)(b * TZ + ct * S5C + i) * 256 + gq * 64 + c4) = pack4(gelu_tanh(y0.x + y1.x), gelu_tanh(y0.y + y1.y), gelu_tanh(y0.z + y1.z), gelu_tanh(y0.w + y1.w));
        }
    }
}

DI void phase_small_gemms(const Ctx& c, int l) {
    unsigned char* ws = c.ws; unsigned char* wsm = ws + WS_WSM;
    const bf16_t* CQN = (const bf16_t*)(ws + WS_MISC + MS_CQN);
    const float* rope = (const float*)(wsm + OFF_ROPE);
    constexpr int NMT = NZ / 256;
    int base = 0;
    const int G = gridDim.x, bid = blockIdx.x;
    {
        const bf16_t* W = (const bf16_t*)(wsm + OFF_WUQT + l * SZ_WUQT); bf16_t* QM = (bf16_t*)(ws + WS_EXPW + MX_QM);
        const float qs = 0.10206207261596577f * LOG2E;
        for (int u = (bid + G - base % G) % G; u < NMT * 3; u += G) {
            const int mt = u / 3, nt = u % 3, r0 = mt * 256, c0 = nt * 128;
            gemm_tile<4, 0>(c, 256, [&](int i) { return CQN + (size_t)(r0 + i) * 384; }, [&](int i) { return W + (size_t)(c0 + i) * 256; }, NoHook(),
                [&](f32x4 (&acc)[4][4], int wr, int wc, int fr, int fq) {
#pragma unroll
                    for (int n = 0; n < 4; ++n) {
                        const int col = c0 + wc + n * 16 + fq * 4, h = col / 96, d = col % 96;
                        const bool rp = d >= 64;
#pragma unroll
                        for (int m = 0; m < 4; ++m) {
                            const int row = r0 + wr + m * 16 + fr, b = row / TZ, s = row % TZ; f32x4 v = acc[m][n];
                            f32x4 pv; pv[0] = __shfl_xor(v[0], 32, 64); pv[1] = __shfl_xor(v[1], 32, 64); pv[2] = __shfl_xor(v[2], 32, 64); pv[3] = __shfl_xor(v[3], 32, 64);
                            if (rp && s >= CTX) {
                                const int i0 = d - 64;
                                const float* cs = rope + ((size_t)(s - CTX) * 16 + (i0 >> 4) * 8 + (i0 & 7)) * 2;
                                const bool hi = (i0 & 8) != 0;
#pragma unroll
                                for (int j = 0; j < 4; ++j) v[j] = v[j] * cs[2 * j] + (hi ? pv[j] : -pv[j]) * cs[2 * j + 1];
                            }
                            *(u32x2*)(QM + ((size_t)(b * 4 + h) * TZ + s) * 96 + d) = pack4(v[0] * qs, v[1] * qs, v[2] * qs, v[3] * qs);
                        }
                    }
                });
        }
        base += NMT * 3;
    }
    {
        const bf16_t* W = (const bf16_t*)(wsm + OFF_WUKVT + l * SZ_WUKVT); bf16_t* KM = (bf16_t*)(ws + WS_EXPW + MX_KM); bf16_t* VMT = (bf16_t*)(ws + WS_EXPW + MX_VMT);
        for (int u = (bid + G - base % G) % G; u < NMT * 4; u += G) {
            const int mt = u / 4, nt = u % 4, r0 = mt * 256, c0 = nt * 128;
            gemm_tile<4, 0>(c, 128, [&](int i) { return CQN + (size_t)(r0 + i) * 384 + 256; }, [&](int i) { return W + (size_t)(c0 + i) * 128; }, NoHook(),
                [&](f32x4 (&acc)[4][4], int wr, int wc, int fr, int fq) {
#pragma unroll
                    for (int n = 0; n < 4; ++n) {
                        const int col = c0 + wc + n * 16 + fq * 4, h = col >> 7, d = col & 127;
#pragma unroll
                        for (int m = 0; m < 4; ++m) {
                            const int row = r0 + wr + m * 16 + fr, b = row / TZ, s = row % TZ; const f32x4 v = acc[m][n];
                            if (d < 64) *(u32x2*)(KM + ((size_t)(b * 4 + h) * TZ + s) * 96 + d) = pack4(v[0], v[1], v[2], v[3]);
                            else {
#pragma unroll
                                for (int j = 0; j < 4; ++j) VMT[((size_t)(b * 4 + h) * 64 + (d - 64 + j)) * TZ + s] = f2bf(v[j]);
                            }
                        }
                    }
                });
        }
        base += NMT * 4;
    }
    bf16_t* SE = (bf16_t*)(ws + WS_P + P_PR); bf16_t* SAD = SE + (size_t)2 * NZ * 256; bf16_t* SKD = SAD + (size_t)2 * NZ * 256;
    {
        const bf16_t* A = (const bf16_t*)(ws + WS_MISC + MS_TW); const bf16_t* W = (const bf16_t*)(wsm + OFF_W2T + l * SZ_W2T);
        const float* w0 = c.in[14] + (size_t)l * 512;
        for (int u = (bid + G - base % G) % G; u < NMT * 4; u += G) {
            const int mt = u / 4, nt = u % 4, r0 = mt * 256, c0 = nt * 128;
            gemm_tile<4, 0>(c, 64, [&](int i) { return A + (size_t)(r0 + i) * 64; }, [&](int i) { return W + (size_t)(c0 + i) * 64; }, NoHook(),
                [&](f32x4 (&acc)[4][4], int wr, int wc, int fr, int fq) {
#pragma unroll
                    for (int n = 0; n < 4; ++n) {
                        const int col = c0 + wc + n * 16 + fq * 4, d = col >> 8, cc = col & 255; const float4 w0v = *(const float4*)(w0 + col);
#pragma unroll
                        for (int m = 0; m < 4; ++m) {
                            const int row = r0 + wr + m * 16 + fr; const f32x4 v = acc[m][n]; float e[4];
                            const float x[4] = {w0v.x + v[0], w0v.y + v[1], w0v.z + v[2], w0v.w + v[3]};
#pragma unroll
                            for (int j = 0; j < 4; ++j) e[j] = 0.6065306597126334f * sigmoidf_(x[j]);
                            *(u32x2*)(SE + ((size_t)d * NZ + row) * 256 + cc) = pack4(e[0], e[1], e[2], e[3]);
                        }
                    }
                });
        }
        base += NMT * 4;
    }
    {
        const bf16_t* A = (const bf16_t*)(ws + WS_MISC + MS_AL); const bf16_t* W = (const bf16_t*)(wsm + OFF_A2T + l * SZ_A2T);
        const float* a0 = c.in[16] + (size_t)l * 512; const float* k_a = c.in[20] + (size_t)l * 256; const bf16_t* KB = (const bf16_t*)(ws + WS_EXPW + MX_KB);
        for (int u = (bid + G - base % G) % G; u < NMT * 4; u += G) {
            const int mt = u / 4, nt = u % 4, r0 = mt * 256, c0 = nt * 128;
            gemm_tile<4, 0>(c, 64, [&](int i) { return A + (size_t)(r0 + i) * 64; }, [&](int i) { return W + (size_t)(c0 + i) * 64; }, NoHook(),
                [&](f32x4 (&acc)[4][4], int wr, int wc, int fr, int fq) {
#pragma unroll
                    for (int n = 0; n < 4; ++n) {
                        const int col = c0 + wc + n * 16 + fq * 4, d = col >> 8, cc = col & 255; const float4 a0v = *(const float4*)(a0 + col), kav = *(const float4*)(k_a + cc);
#pragma unroll
                        for (int m = 0; m < 4; ++m) {
                            const int row = r0 + wr + m * 16 + fr; const f32x4 v = acc[m][n];
                            const float ad0 = sigmoidf_(a0v.x + v[0]), ad1 = sigmoidf_(a0v.y + v[1]), ad2 = sigmoidf_(a0v.z + v[2]), ad3 = sigmoidf_(a0v.w + v[3]);
                            float k[4]; unpack4(*(const u32x2*)(KB + (size_t)row * 256 + cc), k);
                            *(u32x2*)(SAD + ((size_t)d * NZ + row) * 256 + cc) = pack4(ad0, ad1, ad2, ad3);
                            *(u32x2*)(SKD + ((size_t)d * NZ + row) * 256 + cc) = pack4(k[0] * (1.f + (ad0 - 1.f) * kav.x), k[1] * (1.f + (ad1 - 1.f) * kav.y), k[2] * (1.f + (ad2 - 1.f) * kav.z), k[3] * (1.f + (ad3 - 1.f) * kav.w));
                        }
                    }
                });
        }
        base += NMT * 4;
    }
    {
        const bf16_t* A = (const bf16_t*)(ws + WS_MISC + MS_SG); const bf16_t* W = (const bf16_t*)(wsm + OFF_G2T + l * SZ_G2T); bf16_t* GG = (bf16_t*)(ws + WS_MISC + MS_GG);
        for (int u = (bid + G - base % G) % G; u < NMT * 2; u += G) {
            const int mt = u / 2, nt = u % 2, r0 = mt * 256, c0 = nt * 128;
            gemm_tile<4, 0>(c, 128, [&](int i) { return A + (size_t)(r0 + i) * 128; }, [&](int i) { return W + (size_t)(c0 + i) * 128; }, NoHook(),
                [&](f32x4 (&acc)[4][4], int wr, int wc, int fr, int fq) {
#pragma unroll
                    for (int n = 0; n < 4; ++n)
#pragma unroll
                        for (int m = 0; m < 4; ++m) { const f32x4 v = acc[m][n];
                            *(u32x2*)(GG + (size_t)(r0 + wr + m * 16 + fr) * 256 + c0 + wc + n * 16 + fq * 4) = pack4(v[0], v[1], v[2], v[3]); }
                });
        }
        base += NMT * 2;
    }
}

DI int krow(int s, int h, int j) { return 16 * s + 8 * (j >> 2) + 4 * h + (j & 3); }
#ifndef ATT_THR
#define ATT_THR 64.f
#endif
constexpr int ATT_PARK = 56 * 1024;
template <int MODE>
DI void attn_pass(const Ctx& c, int l, int b, int h, int q0, int nkeys) {
    constexpr int DROW = MODE == 0 ? 96 : 64;
    constexpr int DQ = MODE == 0 ? 96 : 32, KS = DQ / 16;
    constexpr int DOFF = MODE == 2 ? 32 : 0;
    constexpr int TK = 128;
    constexpr int KPITCH = DQ * 2 + 16;
    constexpr int VPITCH = TK * 2 + 16;
    constexpr int KBYTES = TK * KPITCH, VBYTES = 64 * VPITCH, STG = KBYTES + VBYTES;
    static_assert(MODE == 0 || 2 * STG <= ATT_PARK, "the staging buffers must stay below the parked o1");
    unsigned char* ws = c.ws; int tid_ = c.tid; asm volatile("" : "+v"(tid_));
    const int tid = tid_, lane = tid & 63, wave = __builtin_amdgcn_readfirstlane(tid >> 6), r = lane & 31, hh = lane >> 5;
    const bf16_t* Q = (const bf16_t*)(ws + WS_EXPW + (MODE == 0 ? MX_QM : MX_QD)) + (size_t)(b * 4 + h) * TZ * DROW + DOFF;
    const bf16_t* Kp = (const bf16_t*)(ws + WS_EXPW + (MODE == 0 ? MX_KM : MX_KD)) + (size_t)(b * 4 + h) * TZ * DROW + DOFF;
    const bf16_t* Vt = (const bf16_t*)(ws + WS_EXPW + (MODE == 0 ? MX_VMT : MX_VDT)) + (size_t)(b * 4 + h) * 64 * TZ;
    unsigned char* smem = c.smem;
    bf16x8 qf[KS];
    const int qrow = q0 + wave * 32 + r;
#pragma unroll
    for (int ks = 0; ks < KS; ++ks) qf[ks] = *(const bf16x8*)(Q + (size_t)qrow * DROW + ks * 16 + hh * 8);
    f32x16 oacc[2];
    float mref = 0.f, lrun = 0.f;
#pragma unroll
    for (int t = 0; t < 2; ++t)
#pragma unroll
        for (int i = 0; i < 16; ++i) oacc[t][i] = 0.f;
    constexpr int CPR = DQ / 8, KCH = TK * CPR, NKR = (KCH + NTHR - 1) / NTHR;
    u32x4 kreg[NKR], vreg[2];
    const bf16_t* kp[NKR]; int koff[NKR];
#pragma unroll
    for (int i = 0; i < NKR; ++i) { const int ch = tid + i * NTHR; kp[i] = Kp + (size_t)(ch / CPR) * DROW + (ch % CPR) * 8; koff[i] = (ch / CPR) * KPITCH + (ch % CPR) * 16; }
    const bf16_t* vp = Vt + (size_t)(tid >> 4) * TZ + (tid & 15) * 8;
    const int voff = (tid >> 4) * VPITCH + (tid & 15) * 16;
    auto gload = [&]() {
#pragma unroll
        for (int i = 0; i < NKR; ++i) { if (tid + i * NTHR < KCH) kreg[i] = *(const u32x4*)kp[i]; kp[i] += TK * DROW; }
        vreg[0] = *(const u32x4*)vp; vreg[1] = *(const u32x4*)(vp + (size_t)32 * TZ); vp += TK;
    };
    auto lstore = [&](int buf) {
        unsigned char* sk = smem + buf * STG; unsigned char* sv = sk + KBYTES;
#pragma unroll
        for (int i = 0; i < NKR; ++i) if (tid + i * NTHR < KCH) *(u32x4*)(sk + koff[i]) = kreg[i];
        *(u32x4*)(sv + voff) = vreg[0]; *(u32x4*)(sv + voff + 32 * VPITCH) = vreg[1];
    };
    const int NT = nkeys / TK;
    __syncthreads();
    gload();
    for (int kt = 0; kt < NT; ++kt) {
        lstore(kt & 1);
        if (kt + 1 < NT) gload();
        __syncthreads();
#pragma unroll 1
        for (int sub = 0; sub < 2; ++sub) {
            const unsigned char* sk = smem + (kt & 1) * STG + sub * 64 * KPITCH; const unsigned char* sv = smem + (kt & 1) * STG + KBYTES + sub * 128;
            f32x16 sacc[2];
#pragma unroll
            for (int kg = 0; kg < 2; ++kg) {
#pragma unroll
                for (int i = 0; i < 16; ++i) sacc[kg][i] = 0.f;
#pragma unroll
                for (int ks = 0; ks < KS; ++ks) sacc[kg] = __builtin_amdgcn_mfma_f32_32x32x16_bf16(*(const bf16x8*)(sk + (kg * 32 + r) * KPITCH + ks * 32 + hh * 16), qf[ks], sacc[kg], 0, 0, 0);
            }
            float mx = sacc[0][0];
#pragma unroll
            for (int kg = 0; kg < 2; ++kg)
#pragma unroll
                for (int i = 0; i < 16; ++i) mx = fmaxf(mx, sacc[kg][i]);
            mx = fmaxf(mx, __shfl_xor(mx, 32, 64));
            const float hi = mx - mref;
            const bool first = (kt == 0) && (sub == 0);
            const bool need = (hi > ATT_THR) || (first && mx < -32.f);
            if (__any(need)) {
                const float d = need ? hi : 0.f;
                const float alpha = first ? 1.f : __builtin_amdgcn_exp2f(-d);
                mref += d; lrun *= alpha;
#pragma unroll
                for (int t = 0; t < 2; ++t)
#pragma unroll
                    for (int i = 0; i < 16; ++i) oacc[t][i] *= alpha;
            }
            if (__any(mref != 0.f)) {
#pragma unroll
                for (int kg = 0; kg < 2; ++kg)
#pragma unroll
                    for (int i = 0; i < 16; ++i) sacc[kg][i] -= mref;
            }
            float psum = 0.f;
#pragma unroll
            for (int kg = 0; kg < 2; ++kg)
#pragma unroll
                for (int i = 0; i < 16; ++i) { const float p = __builtin_amdgcn_exp2f(sacc[kg][i]); sacc[kg][i] = p; psum += p; }
            lrun += psum;
#pragma unroll
            for (int kg = 0; kg < 2; ++kg)
#pragma unroll
                for (int s = 0; s < 2; ++s) {
                    u32x4 pk; pk.x = pack2(sacc[kg][8 * s + 0], sacc[kg][8 * s + 1]); pk.y = pack2(sacc[kg][8 * s + 2], sacc[kg][8 * s + 3]);
                    pk.z = pack2(sacc[kg][8 * s + 4], sacc[kg][8 * s + 5]); pk.w = pack2(sacc[kg][8 * s + 6], sacc[kg][8 * s + 7]);
                    const bf16x8 pf = __builtin_bit_cast(bf16x8, pk);
#pragma unroll
                    for (int t = 0; t < 2; ++t) {
                        const unsigned char* vrow = sv + (t * 32 + r) * VPITCH + (kg * 32 + 16 * s + 4 * hh) * 2;
                        const u32x2 lo = *(const u32x2*)vrow, hi2 = *(const u32x2*)(vrow + 16);
                        u32x4 vv; vv.x = lo.x; vv.y = lo.y; vv.z = hi2.x; vv.w = hi2.y;
                        oacc[t] = __builtin_amdgcn_mfma_f32_32x32x16_bf16(__builtin_bit_cast(bf16x8, vv), pf, oacc[t], 0, 0, 0);
                    }
                }
        }
    }
    const float inv = 1.f / (lrun + __shfl_xor(lrun, 32, 64));
    bf16_t* Ycat = (bf16_t*)(ws + WS_BUFA);
    const int zrow = b * TZ + qrow;
    float* park = (float*)(smem + ATT_PARK) + tid;
    if (MODE == 0) {
#pragma unroll
        for (int t = 0; t < 2; ++t)
#pragma unroll
            for (int i4 = 0; i4 < 4; ++i4) {
                const int dv = t * 32 + 8 * i4 + 4 * hh;
                *(u32x2*)(Ycat + (size_t)zrow * D + h * 64 + dv) = pack4(oacc[t][4 * i4] * inv, oacc[t][4 * i4 + 1] * inv, oacc[t][4 * i4 + 2] * inv, oacc[t][4 * i4 + 3] * inv);
            }
    } else if (MODE == 1) {
#pragma unroll
        for (int t = 0; t < 2; ++t)
#pragma unroll
            for (int i = 0; i < 16; ++i) park[(t * 16 + i) * NTHR] = oacc[t][i] * inv;
    } else {
        const float lam = ((const float*)(ws + WS_WSM + OFF_LAM))[l];
        const float lam_init = 0.8f - 0.6f * __expf(-0.3f * (float)l);
        float ss = 0.f;
#pragma unroll
        for (int t = 0; t < 2; ++t)
#pragma unroll
            for (int i = 0; i < 16; ++i) { const float o = park[(t * 16 + i) * NTHR] - lam * oacc[t][i] * inv; oacc[t][i] = o; ss += o * o; }
        ss += __shfl_xor(ss, 32, 64);
        const float rs = rsqrtf(ss * (1.f / 64.f) + 1e-5f) * (1.f - lam_init);
        const float* sg = c.in[38] + l * 64;
#pragma unroll
        for (int t = 0; t < 2; ++t)
#pragma unroll
            for (int i4 = 0; i4 < 4; ++i4) {
                const int dv = t * 32 + 8 * i4 + 4 * hh; const float4 g = *(const float4*)(sg + dv);
                *(u32x2*)(Ycat + (size_t)zrow * D + 768 + h * 64 + dv) = pack4(oacc[t][4 * i4] * rs * g.x, oacc[t][4 * i4 + 1] * rs * g.y, oacc[t][4 * i4 + 2] * rs * g.z, oacc[t][4 * i4 + 3] * rs * g.w);
            }
    }
}
DI void phase_attention(const Ctx& c, int l) {
    const int nu = 512 + (l == 0 ? 16 : 0);
    for (int u = blockIdx.x; u < nu; u += gridDim.x) {
        int b, h, q0, nk; bool mla;
        if (u < 512) { const int k = u & 255; b = k >> 7; h = (k >> 5) & 3; q0 = CTX + (k & 31) * 256; nk = TZ; mla = u < 256; }
        else { const int k = u - 512; b = (k >> 2) & 1; h = k & 3; q0 = 0; nk = CTX; mla = k < 8; }
        if (mla) attn_pass<0>(c, l, b, h, q0, nk);
        else { attn_pass<1>(c, l, b, h, q0, nk); attn_pass<2>(c, l, b, h, q0, nk); }
    }
}

DI int rw_tok(int dir, int i) { return dir == 0 ? i : (i < CTX ? CTX - 1 - i : TZ - 1 - (i - CTX)); }
constexpr int RW_TS = 32;
constexpr int RW_STEP_F = 6 * 64 + 2;
constexpr int RW_BUF_F = RW_TS * RW_STEP_F;
template <int CTRL> DI float dpp_add(float x) { return x + __int_as_float(__builtin_amdgcn_update_dpp(0, __float_as_int(x), CTRL, 0xf, 0xf, false)); }
DI float red16(float x) { x = dpp_add<0xB1>(x); x = dpp_add<0x4E>(x); x = dpp_add<0x141>(x); x = dpp_add<0x140>(x); return x; }
DI float red8(float x) { x = dpp_add<0xB1>(x); x = dpp_add<0x4E>(x); x = dpp_add<0x141>(x); return x; }
struct RwRegs { u32x4 r, v, kk, e, ad, kd; };
DI void rw_load(const Ctx& c, int b, int h, int dir, int chunk, int t, RwRegs& g) {
    const bf16_t* RB = (const bf16_t*)(c.ws + WS_EXPW + MX_RB); const bf16_t* VB = (const bf16_t*)(c.ws + WS_EXPW + MX_VB); const bf16_t* KKB = (const bf16_t*)(c.ws + WS_EXPW + MX_KKB);
    const bf16_t* SE = (const bf16_t*)(c.ws + WS_P + P_PR) + (size_t)dir * NZ * 256; const bf16_t* SAD = SE + (size_t)2 * NZ * 256; const bf16_t* SKD = SAD + (size_t)2 * NZ * 256;
    const int i = chunk * RW_TS + (t >> 3), z = b * TZ + rw_tok(dir, i); const size_t o = (size_t)z * 256 + h * 64 + (t & 7) * 8;
    g.r = *(const u32x4*)(RB + o); g.v = *(const u32x4*)(VB + o); g.kk = *(const u32x4*)(KKB + o);
    g.e = *(const u32x4*)(SE + o); g.ad = *(const u32x4*)(SAD + o); g.kd = *(const u32x4*)(SKD + o);
}
DI void up8(const u32x4& u, float (&f)[8]) { f[0] = lo2f(u.x); f[1] = hi2f(u.x); f[2] = lo2f(u.y); f[3] = hi2f(u.y); f[4] = lo2f(u.z); f[5] = hi2f(u.z); f[6] = lo2f(u.w); f[7] = hi2f(u.w); }
DI void rw_process(const RwRegs& g, int t, float* buf) {
    float r[8], v[8], kk[8], e[8], ad[8], kd[8];
    up8(g.r, r); up8(g.v, v); up8(g.kk, kk); up8(g.e, e); up8(g.ad, ad); up8(g.kd, kd);
    float* f = buf + (t >> 3) * RW_STEP_F + (t & 7) * 8;
    float w[8], bv[8], wr[8]; float br = 0.f, kr = 0.f;
#pragma unroll
    for (int j = 0; j < 8; ++j) { w[j] = __expf(-e[j]); bv[j] = kk[j] * ad[j]; wr[j] = w[j] * r[j]; br += bv[j] * r[j]; kr += kd[j] * r[j]; }
    *(float4*)(f) = make_float4(w[0], w[1], w[2], w[3]); *(float4*)(f + 4) = make_float4(w[4], w[5], w[6], w[7]);
    *(float4*)(f + 64) = make_float4(kk[0], kk[1], kk[2], kk[3]); *(float4*)(f + 68) = make_float4(kk[4], kk[5], kk[6], kk[7]);
    *(float4*)(f + 128) = make_float4(bv[0], bv[1], bv[2], bv[3]); *(float4*)(f + 132) = make_float4(bv[4], bv[5], bv[6], bv[7]);
    *(float4*)(f + 192) = make_float4(kd[0], kd[1], kd[2], kd[3]); *(float4*)(f + 196) = make_float4(kd[4], kd[5], kd[6], kd[7]);
    *(float4*)(f + 256) = make_float4(wr[0], wr[1], wr[2], wr[3]); *(float4*)(f + 260) = make_float4(wr[4], wr[5], wr[6], wr[7]);
    *(float4*)(f + 320) = make_float4(v[0], v[1], v[2], v[3]); *(float4*)(f + 324) = make_float4(v[4], v[5], v[6], v[7]);
    br = red8(br); kr = red8(kr);
    if ((t & 7) == 0) { float* s = buf + (t >> 3) * RW_STEP_F + 384; s[0] = br; s[1] = kr; }
}
struct RwStep { float4 w, kk, bv, kd, wr; float vv, br, kr; };
DI void rw_ld(RwStep& s, const float* f, int kq, int row) {
    s.w = *(const float4*)(f + kq * 4); s.kk = *(const float4*)(f + 64 + kq * 4); s.bv = *(const float4*)(f + 128 + kq * 4);
    s.kd = *(const float4*)(f + 192 + kq * 4); s.wr = *(const float4*)(f + 256 + kq * 4); s.vv = f[320 + row]; s.br = f[384]; s.kr = f[385];
}
DI void phase_rwkv_scan_unit(const Ctx& c, int l, int u) {
    const int rg = u & 3, chain = u >> 2, dir = chain & 1, h = (chain >> 1) & 3, b = chain >> 3;
    float* buf0 = (float*)c.smem; float* buf1 = buf0 + RW_BUF_F;
    float* ybuf = buf1 + RW_BUF_F;
    float* YO = (float*)(c.ws + WS_BUFB) + (size_t)dir * NZ * 256 + (size_t)b * TZ * 256 + h * 64 + rg * 16;
    const int wave = c.wave, lane = c.lane, rr = lane >> 4, kq = lane & 15, rl = (wave & 3) * 4 + rr, row = rg * 16 + rl;
    const int t = c.tid - 256;
    float S0 = 0.f, S1 = 0.f, S2 = 0.f, S3 = 0.f;
    constexpr int NCH = TZ / RW_TS;
    RwRegs g;
    __syncthreads();
    if (wave >= 4) { rw_load(c, b, h, dir, 0, t, g); rw_process(g, t, buf0); rw_load(c, b, h, dir, 1, t, g); }
    __syncthreads();
    for (int ch = 0; ch < NCH; ++ch) {
        float* cur = buf0 + (ch & 1) * RW_BUF_F; float* nxt = buf0 + ((ch + 1) & 1) * RW_BUF_F;
        if (wave >= 4) {
            if (ch > 0) {
                const float* yb = ybuf + ((ch - 1) & 1) * RW_TS * 16;
#pragma unroll
                for (int i = 0; i < 2; ++i) { const int e = t + i * 256, st = e >> 4, rw = e & 15; YO[(size_t)rw_tok(dir, (ch - 1) * RW_TS + st) * 256 + rw] = yb[e]; }
            }
            if (ch + 1 < NCH) rw_process(g, t, nxt);
            if (ch + 2 < NCH) rw_load(c, b, h, dir, ch + 2, t, g);
        } else {
            float* yb = ybuf + (ch & 1) * RW_TS * 16 + rl;
            RwStep s0, s1;
            rw_ld(s0, cur, kq, row);
#pragma unroll 4
            for (int st = 0; st < RW_TS; st += 2) {
                rw_ld(s1, cur + (st + 1) * RW_STEP_F, kq, row);
                {
                    float sa = -((S0 * s0.kk.x + S1 * s0.kk.y) + (S2 * s0.kk.z + S3 * s0.kk.w));
                    float q = (S0 * s0.wr.x + S1 * s0.wr.y) + (S2 * s0.wr.z + S3 * s0.wr.w);
                    sa = red16(sa); q = red16(q);
                    S0 = fmaf(sa, s0.bv.x, fmaf(S0, s0.w.x, s0.vv * s0.kd.x)); S1 = fmaf(sa, s0.bv.y, fmaf(S1, s0.w.y, s0.vv * s0.kd.y));
                    S2 = fmaf(sa, s0.bv.z, fmaf(S2, s0.w.z, s0.vv * s0.kd.z)); S3 = fmaf(sa, s0.bv.w, fmaf(S3, s0.w.w, s0.vv * s0.kd.w));
                    yb[st * 16] = q + sa * s0.br + s0.vv * s0.kr;
                }
                if (st + 2 < RW_TS) rw_ld(s0, cur + (st + 2) * RW_STEP_F, kq, row);
                {
                    float sa = -((S0 * s1.kk.x + S1 * s1.kk.y) + (S2 * s1.kk.z + S3 * s1.kk.w));
                    float q = (S0 * s1.wr.x + S1 * s1.wr.y) + (S2 * s1.wr.z + S3 * s1.wr.w);
                    sa = red16(sa); q = red16(q);
                    S0 = fmaf(sa, s1.bv.x, fmaf(S0, s1.w.x, s1.vv * s1.kd.x)); S1 = fmaf(sa, s1.bv.y, fmaf(S1, s1.w.y, s1.vv * s1.kd.y));
                    S2 = fmaf(sa, s1.bv.z, fmaf(S2, s1.w.z, s1.vv * s1.kd.z)); S3 = fmaf(sa, s1.bv.w, fmaf(S3, s1.w.w, s1.vv * s1.kd.w));
                    yb[(st + 1) * 16] = q + sa * s1.br + s1.vv * s1.kr;
                }
            }
        }
        __syncthreads();
    }
    if (wave >= 4) {
        const float* yb = ybuf + ((NCH - 1) & 1) * RW_TS * 16;
#pragma unroll
        for (int i = 0; i < 2; ++i) { const int e = t + i * 256, st = e >> 4, rw = e & 15; YO[(size_t)rw_tok(dir, (NCH - 1) * RW_TS + st) * 256 + rw] = yb[e]; }
    }
}

constexpr int LA_AN = 0, LA_RN = 8192, LA_BN = 16384, LA_KN = 24576, LA_AT = 32768, LA_BHT = 40960, LA_KHT = 49152, LA_VT = 57344,
              LA_NBA = 65536  , LA_NKA = 81920, LA_NBRT = 90112, LA_NKRT = 98304, LA_P63 = 106496;
constexpr int LA_TMT = LA_AN, LA_M1 = LA_BN, LA_W1T = LA_KN, LA_Z1 = LA_NBA;
DI int crow(int reg, int h) { return (reg & 3) + 8 * (reg >> 2) + 4 * h; }
DI void mm_tile(f32x16& acc, const unsigned char* A, int i0, const unsigned char* BT, int j0, int r, int h) {
#pragma unroll
    for (int ks = 0; ks < 4; ++ks) {
        const bf16x8 a = *(const bf16x8*)(A + (i0 + r) * 128 + ks * 32 + h * 16);
        const bf16x8 b = *(const bf16x8*)(BT + (j0 + r) * 128 + ks * 32 + h * 16);
        acc = __builtin_amdgcn_mfma_f32_32x32x16_bf16(a, b, acc, 0, 0, 0);
    }
}
DI void zero16(f32x16& a) {
#pragma unroll
    for (int i = 0; i < 16; ++i) a[i] = 0.f;
}
DI void phase_rwkv_chunk_unit(const Ctx& c, int l, int unit) {
    unsigned char* L = c.smem; unsigned char* ws = c.ws;
    const int chain = unit / RNC, ch = unit % RNC, dir = chain & 1, hd = (chain >> 1) & 3, b = chain >> 3;
    const int tid = c.tid, lane = c.lane, wave = c.wave, r = lane & 31, h = lane >> 5;
    const bf16_t* RB = (const bf16_t*)(ws + WS_EXPW + MX_RB); const bf16_t* VB = (const bf16_t*)(ws + WS_EXPW + MX_VB); const bf16_t* KKB = (const bf16_t*)(ws + WS_EXPW + MX_KKB);
    const bf16_t* SE = (const bf16_t*)(ws + WS_P + P_PR) + (size_t)dir * NZ * 256; const bf16_t* SAD = SE + (size_t)2 * NZ * 256; const bf16_t* SKD = SAD + (size_t)2 * NZ * 256;
    float* CUM = (float*)(L + LA_NBA);
    __syncthreads();
    const int t = tid >> 3, k0 = (tid & 7) * 8;
    float rr[8], vv[8], kk[8], ee[8], ad[8], kd[8];
    {
        const int z = b * TZ + rw_tok(dir, ch * RC + t); const size_t o = (size_t)z * 256 + hd * 64 + k0;
        up8(*(const u32x4*)(RB + o), rr); up8(*(const u32x4*)(VB + o), vv); up8(*(const u32x4*)(KKB + o), kk);
        up8(*(const u32x4*)(SE + o), ee); up8(*(const u32x4*)(SAD + o), ad); up8(*(const u32x4*)(SKD + o), kd);
        *(float4*)(CUM + t * 64 + k0) = make_float4(ee[0], ee[1], ee[2], ee[3]); *(float4*)(CUM + t * 64 + k0 + 4) = make_float4(ee[4], ee[5], ee[6], ee[7]);
    }
    __syncthreads();
    if (wave == 0) { float cm = 0.f;
#pragma unroll 8
        for (int i = 0; i < RC; ++i) { cm += CUM[i * 64 + lane]; CUM[i * 64 + lane] = cm; } }
    __syncthreads();
    {
        float cm[8], c63[8];
        { const float4 a = *(const float4*)(CUM + t * 64 + k0), bq = *(const float4*)(CUM + t * 64 + k0 + 4); cm[0] = a.x; cm[1] = a.y; cm[2] = a.z; cm[3] = a.w; cm[4] = bq.x; cm[5] = bq.y; cm[6] = bq.z; cm[7] = bq.w; }
        { const float4 a = *(const float4*)(CUM + 63 * 64 + k0), bq = *(const float4*)(CUM + 63 * 64 + k0 + 4); c63[0] = a.x; c63[1] = a.y; c63[2] = a.z; c63[3] = a.w; c63[4] = bq.x; c63[5] = bq.y; c63[6] = bq.z; c63[7] = bq.w; }
        float at[8], rt[8], bt[8], kt[8], bh[8], kh[8];
#pragma unroll
        for (int j = 0; j < 8; ++j) {
            const float pt = __expf(-cm[j]), pp = __expf(-(cm[j] - ee[j])), ip = __expf(cm[j]), ph = __expf(-(c63[j] - cm[j])), bb = kk[j] * ad[j];
            at[j] = -kk[j] * pp; rt[j] = rr[j] * pt; bt[j] = bb * ip; kt[j] = kd[j] * ip; bh[j] = bb * ph; kh[j] = kd[j] * ph;
        }
        u32x4 w4;
        w4.x = pack2(at[0], at[1]); w4.y = pack2(at[2], at[3]); w4.z = pack2(at[4], at[5]); w4.w = pack2(at[6], at[7]); *(u32x4*)(L + LA_AN + t * 128 + k0 * 2) = w4;
        w4.x = pack2(rt[0], rt[1]); w4.y = pack2(rt[2], rt[3]); w4.z = pack2(rt[4], rt[5]); w4.w = pack2(rt[6], rt[7]); *(u32x4*)(L + LA_RN + t * 128 + k0 * 2) = w4;
        w4.x = pack2(bt[0], bt[1]); w4.y = pack2(bt[2], bt[3]); w4.z = pack2(bt[4], bt[5]); w4.w = pack2(bt[6], bt[7]); *(u32x4*)(L + LA_BN + t * 128 + k0 * 2) = w4;
        w4.x = pack2(kt[0], kt[1]); w4.y = pack2(kt[2], kt[3]); w4.z = pack2(kt[4], kt[5]); w4.w = pack2(kt[6], kt[7]); *(u32x4*)(L + LA_KN + t * 128 + k0 * 2) = w4;
#pragma unroll
        for (int j = 0; j < 8; ++j) {
            *(bf16_t*)(L + LA_AT + (k0 + j) * 128 + t * 2) = f2bf(at[j]); *(bf16_t*)(L + LA_BHT + (k0 + j) * 128 + t * 2) = f2bf(bh[j]);
            *(bf16_t*)(L + LA_KHT + (k0 + j) * 128 + t * 2) = f2bf(kh[j]); *(bf16_t*)(L + LA_VT + (k0 + j) * 128 + t * 2) = f2bf(vv[j]);
        }
        if (t == 63) {
            float* p63 = (float*)(L + LA_P63); float* gp = (float*)(ws + WS_RW + RW_P63) + (size_t)unit * 64;
#pragma unroll
            for (int j = 0; j < 8; ++j) { const float p = __expf(-c63[j]); p63[k0 + j] = p; gp[k0 + j] = p; }
        }
    }
    __syncthreads();
    {
        const int p = wave >> 1, i0 = (wave & 1) * 32;
        const unsigned char* A = L + (p == 0 ? LA_BN : p == 1 ? LA_KN : LA_RN);
        const unsigned char* BT = L + (p < 2 ? LA_AN : p == 2 ? LA_BN : LA_KN);
#pragma unroll
        for (int jt = 0; jt < 2; ++jt) {
            const int j0 = jt * 32; f32x16 acc; zero16(acc);
            mm_tile(acc, A, i0, BT, j0, r, h);
            const int col = j0 + r;
#pragma unroll
            for (int g = 0; g < 16; ++g) {
                const int row = i0 + crow(g, h);
                if (p == 0) ((float*)(L + LA_NBA))[row * 64 + col] = (row < col) ? acc[g] : 0.f;
                else if (p == 1) *(bf16_t*)(L + LA_NKA + row * 128 + col * 2) = f2bf((row < col) ? acc[g] : 0.f);
                else *(bf16_t*)(L + (p == 2 ? LA_NBRT : LA_NKRT) + row * 128 + col * 2) = f2bf((col <= row) ? acc[g] : 0.f);
            }
        }
    }
    __syncthreads();
    {
        constexpr int X0 = LA_BN, X1 = LA_KN, X3 = 108544, X4 = X3 + 8192, X5 = LA_NBA + 16384 - 16384, X6 = LA_NBA + 8192;
        float nv[8];
        { const int s = tid >> 3, t0 = (tid & 7) * 8; const float* N = (const float*)(L + LA_NBA) + s * 64 + t0;
          const float4 a = *(const float4*)N, bq = *(const float4*)(N + 4); nv[0] = a.x; nv[1] = a.y; nv[2] = a.z; nv[3] = a.w; nv[4] = bq.x; nv[5] = bq.y; nv[6] = bq.z; nv[7] = bq.w; }
        __syncthreads();
        {
            const int s = tid >> 3, t0 = (tid & 7) * 8;
            u32x4 w4; w4.x = pack2(nv[0], nv[1]); w4.y = pack2(nv[2], nv[3]); w4.z = pack2(nv[4], nv[5]); w4.w = pack2(nv[6], nv[7]);
            *(u32x4*)(L + X0 + s * 128 + t0 * 2) = w4;
#pragma unroll
            for (int j = 0; j < 8; ++j) *(bf16_t*)(L + X1 + (t0 + j) * 128 + s * 2) = f2bf(nv[j]);
#pragma unroll
            for (int j = 0; j < 8; ++j) if (t0 + j == s) nv[j] += 1.f;
            w4.x = pack2(nv[0], nv[1]); w4.y = pack2(nv[2], nv[3]); w4.z = pack2(nv[4], nv[5]); w4.w = pack2(nv[6], nv[7]);
            *(u32x4*)(L + X5 + s * 128 + t0 * 2) = w4;
        }
        __syncthreads();
        const int ti0 = ((wave >> 1) & 1) * 32, tj0 = (wave & 1) * 32;
        if (wave < 4) {
            f32x16 acc; zero16(acc); mm_tile(acc, L + X0, ti0, L + X1, tj0, r, h);
#pragma unroll
            for (int g4 = 0; g4 < 4; ++g4) *(u32x2*)(L + X4 + (tj0 + r) * 128 + (ti0 + 8 * g4 + 4 * h) * 2) = pack4(acc[4 * g4], acc[4 * g4 + 1], acc[4 * g4 + 2], acc[4 * g4 + 3]);
#pragma unroll
            for (int g = 0; g < 16; ++g) *(bf16_t*)(L + X3 + (ti0 + crow(g, h)) * 128 + (tj0 + r) * 2) = f2bf(acc[g]);
        }
        __syncthreads();
#pragma unroll
        for (int k = 1; k <= 5; ++k) {
            const int qa = (k & 1) ? X3 : X0, qt = (k & 1) ? X4 : X1, nqa = (k & 1) ? X0 : X3, nqt = (k & 1) ? X1 : X4;
            const int pa = (k & 1) ? X5 : X6, npa = (k & 1) ? X6 : X5;
            if (wave >= 4) {
                f32x16 acc; zero16(acc); mm_tile(acc, L + pa, ti0, L + qt, tj0, r, h);
#pragma unroll
                for (int g = 0; g < 16; ++g) acc[g] += bf2f(*(const bf16_t*)(L + pa + (ti0 + crow(g, h)) * 128 + (tj0 + r) * 2));
                if (k < 5) {
#pragma unroll
                    for (int g = 0; g < 16; ++g) *(bf16_t*)(L + npa + (ti0 + crow(g, h)) * 128 + (tj0 + r) * 2) = f2bf(acc[g]);
                } else {
#pragma unroll
                    for (int g4 = 0; g4 < 4; ++g4) *(u32x2*)(L + LA_TMT + (tj0 + r) * 128 + (ti0 + 8 * g4 + 4 * h) * 2) = pack4(acc[4 * g4], acc[4 * g4 + 1], acc[4 * g4 + 2], acc[4 * g4 + 3]);
                }
            } else if (k < 5) {
                f32x16 acc; zero16(acc); mm_tile(acc, L + qa, ti0, L + qt, tj0, r, h);
#pragma unroll
                for (int g4 = 0; g4 < 4; ++g4) *(u32x2*)(L + nqt + (tj0 + r) * 128 + (ti0 + 8 * g4 + 4 * h) * 2) = pack4(acc[4 * g4], acc[4 * g4 + 1], acc[4 * g4 + 2], acc[4 * g4 + 3]);
#pragma unroll
                for (int g = 0; g < 16; ++g) *(bf16_t*)(L + nqa + (ti0 + crow(g, h)) * 128 + (tj0 + r) * 2) = f2bf(acc[g]);
            }
            __syncthreads();
        }
    }
    {
        const int p = wave >> 2, i0 = ((wave >> 1) & 1) * 32, j0 = (wave & 1) * 32; f32x16 acc; zero16(acc);
        if (p == 0) {
            mm_tile(acc, L + LA_TMT, i0, L + LA_AT, j0, r, h);
#pragma unroll
            for (int g4 = 0; g4 < 4; ++g4) *(u32x2*)(L + LA_M1 + (j0 + r) * 128 + (i0 + 8 * g4 + 4 * h) * 2) = pack4(acc[4 * g4], acc[4 * g4 + 1], acc[4 * g4 + 2], acc[4 * g4 + 3]);
        } else {
            mm_tile(acc, L + LA_NKA, i0, L + LA_TMT, j0, r, h);
#pragma unroll
            for (int g4 = 0; g4 < 4; ++g4) *(u32x2*)(L + LA_W1T + (j0 + r) * 128 + (i0 + 8 * g4 + 4 * h) * 2) = pack4(acc[4 * g4], acc[4 * g4 + 1], acc[4 * g4 + 2], acc[4 * g4 + 3]);
        }
    }
    __syncthreads();
    if (wave < 4) {
        const int i0 = (wave >> 1) * 32, j0 = (wave & 1) * 32; f32x16 acc; zero16(acc);
        mm_tile(acc, L + LA_W1T, i0, L + LA_VT, j0, r, h);
#pragma unroll
        for (int g4 = 0; g4 < 4; ++g4) *(u32x2*)(L + LA_Z1 + (j0 + r) * 128 + (i0 + 8 * g4 + 4 * h) * 2) = pack4(acc[4 * g4], acc[4 * g4 + 1], acc[4 * g4 + 2], acc[4 * g4 + 3]);
    }
    __syncthreads();
    {
        const int p = wave >> 1, i0 = (wave & 1) * 32;
        bf16_t* GM3 = (bf16_t*)(ws + WS_RW + RW_M3) + (size_t)unit * 4096; bf16_t* GM2 = (bf16_t*)(ws + WS_RW + RW_M2) + (size_t)unit * 4096; bf16_t* GZ5 = (bf16_t*)(ws + WS_RW + RW_Z5) + (size_t)unit * 4096;
        float* YO = (float*)(ws + WS_BUFB) + (size_t)dir * NZ * 256;
#pragma unroll
        for (int jt = 0; jt < 2; ++jt) {
            const int j0 = jt * 32; f32x16 acc; zero16(acc);
            if (p == 0) {
                mm_tile(acc, L + LA_M1, i0, L + LA_NBRT, j0, r, h);
#pragma unroll
                for (int g4 = 0; g4 < 4; ++g4) { const int tt = j0 + r, kq = i0 + 8 * g4 + 4 * h; float rv[4]; unpack4(*(const u32x2*)(L + LA_RN + tt * 128 + kq * 2), rv);
                    *(u32x2*)(GM2 + tt * 64 + kq) = pack4(acc[4 * g4] + rv[0], acc[4 * g4 + 1] + rv[1], acc[4 * g4 + 2] + rv[2], acc[4 * g4 + 3] + rv[3]); }
            } else if (p == 1) {
                mm_tile(acc, L + LA_NBRT, i0, L + LA_Z1, j0, r, h); mm_tile(acc, L + LA_NKRT, i0, L + LA_VT, j0, r, h);
#pragma unroll
                for (int g = 0; g < 16; ++g) { const int tt = i0 + crow(g, h); YO[(size_t)(b * TZ + rw_tok(dir, ch * RC + tt)) * 256 + hd * 64 + j0 + r] = acc[g]; }
            } else if (p == 2) {
                mm_tile(acc, L + LA_M1, i0, L + LA_BHT, j0, r, h);
#pragma unroll
                for (int g4 = 0; g4 < 4; ++g4) *(u32x2*)(GM3 + (j0 + r) * 64 + i0 + 8 * g4 + 4 * h) = pack4(acc[4 * g4], acc[4 * g4 + 1], acc[4 * g4 + 2], acc[4 * g4 + 3]);
            } else {
                mm_tile(acc, L + LA_BHT, i0, L + LA_Z1, j0, r, h); mm_tile(acc, L + LA_KHT, i0, L + LA_VT, j0, r, h);
#pragma unroll
                for (int g4 = 0; g4 < 4; ++g4) *(u32x2*)(GZ5 + (j0 + r) * 64 + i0 + 8 * g4 + 4 * h) = pack4(acc[4 * g4], acc[4 * g4 + 1], acc[4 * g4 + 2], acc[4 * g4 + 3]);
            }
        }
    }
}
DI void phase_rwkv_chunks(const Ctx& c, int l) {
    for (int u = blockIdx.x; u < 16 * RNC; u += gridDim.x) phase_rwkv_chunk_unit(c, l, u);
}
DI bf16x8 pack8(const f32x16& x, int s) {
    u32x4 p; p.x = pack2(x[8 * s], x[8 * s + 1]); p.y = pack2(x[8 * s + 2], x[8 * s + 3]); p.z = pack2(x[8 * s + 4], x[8 * s + 5]); p.w = pack2(x[8 * s + 6], x[8 * s + 7]);
    return __builtin_bit_cast(bf16x8, p);
}
DI bf16x8 ldfrag(const bf16_t* rowp, int s, int h) {
    const u32x2 lo = *(const u32x2*)(rowp + 16 * s + 4 * h), hi = *(const u32x2*)(rowp + 16 * s + 8 + 4 * h);
    u32x4 v; v.x = lo.x; v.y = lo.y; v.z = hi.x; v.w = hi.y; return __builtin_bit_cast(bf16x8, v);
}
constexpr int SQ_PITCH = 144, SQ_MAT = 64 * SQ_PITCH;
constexpr int SQA_M3 = 0, SQA_Z5 = SQ_MAT, SQA_P63 = 2 * SQ_MAT, SQA_BYTES = SQA_P63 + 256;
constexpr int SQB_M2 = 0, SQB_Y = SQ_MAT, SQB_BYTES = SQB_Y + 64 * 64 * 4;
constexpr int SQ_A0 = 0, SQ_B0 = 2 * SQA_BYTES, SQ_XB = SQ_B0 + 2 * SQB_BYTES;
DI bf16x8 ldfrag_l(const unsigned char* rowp, int s, int h) {
    const u32x2 lo = *(const u32x2*)(rowp + (16 * s + 4 * h) * 2), hi = *(const u32x2*)(rowp + (16 * s + 8 + 4 * h) * 2);
    u32x4 v; v.x = lo.x; v.y = lo.y; v.z = hi.x; v.w = hi.y; return __builtin_bit_cast(bf16x8, v);
}
struct SqRegsA { u32x4 m3[2], z5[2], p63; };
struct SqRegsB { u32x4 m2[2], y[4]; };
DI void sqa_gload(const Ctx& c, size_t unit, int lt, SqRegsA& g) {
    const unsigned char* g3 = c.ws + WS_RW + RW_M3 + unit * 8192; const unsigned char* g5 = c.ws + WS_RW + RW_Z5 + unit * 8192;
#pragma unroll
    for (int i = 0; i < 2; ++i) { const int id = lt + i * 256; g.m3[i] = *(const u32x4*)(g3 + id * 16); g.z5[i] = *(const u32x4*)(g5 + id * 16); }
    if (lt < 16) g.p63 = *(const u32x4*)(c.ws + WS_RW + RW_P63 + unit * 256 + lt * 16);
}
DI void sqa_lstore(unsigned char* st, int lt, const SqRegsA& g) {
#pragma unroll
    for (int i = 0; i < 2; ++i) { const int id = lt + i * 256, row = id >> 3, part = id & 7;
        *(u32x4*)(st + SQA_M3 + row * SQ_PITCH + part * 16) = g.m3[i]; *(u32x4*)(st + SQA_Z5 + row * SQ_PITCH + part * 16) = g.z5[i]; }
    if (lt < 16) *(u32x4*)(st + SQA_P63 + lt * 16) = g.p63;
}
DI void sqb_gload(const Ctx& c, size_t unit, const float* YO, int dir, int ch, int lt, SqRegsB& g) {
    const unsigned char* g2 = c.ws + WS_RW + RW_M2 + unit * 8192;
#pragma unroll
    for (int i = 0; i < 2; ++i) g.m2[i] = *(const u32x4*)(g2 + (lt + i * 256) * 16);
#pragma unroll
    for (int i = 0; i < 4; ++i) { const int id = lt + i * 256; g.y[i] = *(const u32x4*)(YO + (size_t)rw_tok(dir, ch * RC + (id >> 4)) * 256 + (id & 15) * 4); }
}
DI void sqb_lstore(unsigned char* st, int lt, const SqRegsB& g) {
#pragma unroll
    for (int i = 0; i < 2; ++i) { const int id = lt + i * 256; *(u32x4*)(st + SQB_M2 + (id >> 3) * SQ_PITCH + (id & 7) * 16) = g.m2[i]; }
#pragma unroll
    for (int i = 0; i < 4; ++i) { const int id = lt + i * 256; *(u32x4*)(st + SQB_Y + (id >> 4) * 256 + (id & 15) * 16) = g.y[i]; }
}
DI void sqb_store_y(float* YO, int dir, int ch, const unsigned char* st, int lt) {
#pragma unroll
    for (int i = 0; i < 4; ++i) { const int id = lt + i * 256; *(u32x4*)(YO + (size_t)rw_tok(dir, ch * RC + (id >> 4)) * 256 + (id & 15) * 4) = *(const u32x4*)(st + SQB_Y + (id >> 4) * 256 + (id & 15) * 16); }
}
DI void phase_rwkv_seq_block(const Ctx& c, int l, int chain) {
    unsigned char* L = c.smem; const int lane = c.lane, wave = c.wave, r = lane & 31, h = lane >> 5;
    const int dir = chain & 1, hd = (chain >> 1) & 3, b = chain >> 3, lt = c.tid - 256, vh = wave & 1;
    const size_t unit0 = (size_t)chain * RNC;
    __syncthreads();
    if (wave >= 4) {
        float* YO = (float*)(c.ws + WS_BUFB) + (size_t)dir * NZ * 256 + (size_t)b * TZ * 256 + hd * 64;
        SqRegsA ga; SqRegsB gb;
        sqa_gload(c, unit0, lt, ga); sqa_lstore(L + SQ_A0, lt, ga); sqa_gload(c, unit0 + 1, lt, ga); sqb_gload(c, unit0, YO, dir, 0, lt, gb);
        __syncthreads();
#pragma unroll 1
        for (int ch = 0; ch <= RNC; ++ch) {
            unsigned char* sb = L + SQ_B0 + (ch & 1) * SQB_BYTES;
            if (ch >= 2) sqb_store_y(YO, dir, ch - 2, sb, lt);
            if (ch < RNC) sqb_lstore(sb, lt, gb);
            if (ch + 1 < RNC) { sqb_gload(c, unit0 + ch + 1, YO, dir, ch + 1, lt, gb); sqa_lstore(L + SQ_A0 + ((ch + 1) & 1) * SQA_BYTES, lt, ga); }
            if (ch + 2 < RNC) sqa_gload(c, unit0 + ch + 2, lt, ga);
            __syncthreads();
        }
        sqb_store_y(YO, dir, RNC - 1, L + SQ_B0 + ((RNC - 1) & 1) * SQB_BYTES, lt);
    } else if (wave < 2) {
        f32x16 x[2]; zero16(x[0]); zero16(x[1]);
        __syncthreads();
#pragma unroll 1
        for (int ch = 0; ch <= RNC; ++ch) {
            if (ch < RNC) {
                const unsigned char* st = L + SQ_A0 + (ch & 1) * SQA_BYTES;
                unsigned char* xbuf = L + SQ_XB + ((ch & 1) * 2 + vh) * 4096 + lane * 16;
                bf16x8 xb[4];
#pragma unroll
                for (int s = 0; s < 4; ++s) { xb[s] = pack8(x[s >> 1], s & 1); *(bf16x8*)(xbuf + s * 1024) = xb[s]; }
                f32x16 xn0, xn1;
#pragma unroll
                for (int i = 0; i < 2; ++i) {
                    f32x16 xa;
#pragma unroll
                    for (int g4 = 0; g4 < 4; ++g4) {
                        float z5[4]; unpack4(*(const u32x2*)(st + SQA_Z5 + (vh * 32 + r) * SQ_PITCH + (32 * i + 8 * g4 + 4 * h) * 2), z5);
                        const float4 p4 = *(const float4*)(st + SQA_P63 + (32 * i + 8 * g4 + 4 * h) * 4);
                        xa[4 * g4] = fmaf(p4.x, x[i][4 * g4], z5[0]); xa[4 * g4 + 1] = fmaf(p4.y, x[i][4 * g4 + 1], z5[1]);
                        xa[4 * g4 + 2] = fmaf(p4.z, x[i][4 * g4 + 2], z5[2]); xa[4 * g4 + 3] = fmaf(p4.w, x[i][4 * g4 + 3], z5[3]);
                    }
#pragma unroll
                    for (int s = 0; s < 4; ++s) xa = __builtin_amdgcn_mfma_f32_32x32x16_bf16(ldfrag_l(st + SQA_M3 + (32 * i + r) * SQ_PITCH, s, h), xb[s], xa, 0, 0, 0);
                    if (i == 0) xn0 = xa; else xn1 = xa;
                }
                x[0] = xn0; x[1] = xn1;
            }
            __syncthreads();
        }
    } else {
        __syncthreads();
#pragma unroll 1
        for (int ch = 0; ch <= RNC; ++ch) {
            if (ch >= 1) {
                const int cy = ch - 1;
                unsigned char* st = L + SQ_B0 + (cy & 1) * SQB_BYTES;
                const unsigned char* xbuf = L + SQ_XB + ((cy & 1) * 2 + vh) * 4096 + lane * 16;
                bf16x8 xb[4];
#pragma unroll
                for (int s = 0; s < 4; ++s) xb[s] = *(const bf16x8*)(xbuf + s * 1024);
#pragma unroll
                for (int i = 0; i < 2; ++i) {
                    f32x16 ya;
#pragma unroll
                    for (int g = 0; g < 16; ++g) ya[g] = *((const float*)(st + SQB_Y) + (32 * i + crow(g, h)) * 64 + vh * 32 + r);
#pragma unroll
                    for (int s = 0; s < 4; ++s) ya = __builtin_amdgcn_mfma_f32_32x32x16_bf16(ldfrag_l(st + SQB_M2 + (32 * i + r) * SQ_PITCH, s, h), xb[s], ya, 0, 0, 0);
#pragma unroll
                    for (int g = 0; g < 16; ++g) *((float*)(st + SQB_Y) + (32 * i + crow(g, h)) * 64 + vh * 32 + r) = ya[g];
                }
            }
            __syncthreads();
        }
    }
}
DI void phase_mixers2(const Ctx& c, int l) {
    const int G = gridDim.x, bid = blockIdx.x;
    if (G >= 128) {
        if (bid < 16) phase_rwkv_seq_block(c, l, bid);
        else for (int u = bid - 16; u < 2 * S5N * 4; u += G - 16) phase_s5_final_unit<false>(c, l, u);
    } else {
        for (int u = bid; u < 16; u += G) phase_rwkv_seq_block(c, l, u);
        for (int u = bid; u < 2 * S5N * 4; u += G) phase_s5_final_unit<false>(c, l, u);
    }
}

DI void phase_post(const Ctx& c, int l) {
    unsigned char* ws = c.ws; const int lane = c.lane;
    const float* YF = (const float*)(ws + WS_BUFB); const float* YB = YF + (size_t)NZ * 256;
    const bf16_t* RB = (const bf16_t*)(ws + WS_EXPW + MX_RB); const bf16_t* VB = (const bf16_t*)(ws + WS_EXPW + MX_VB);
    const bf16_t* SKD = (const bf16_t*)(ws + WS_P + P_PR) + (size_t)4 * NZ * 256; const bf16_t* GG = (const bf16_t*)(ws + WS_MISC + MS_GG);
    bf16_t* Ycat = (bf16_t*)(ws + WS_BUFA);
    const float* r_k = c.in[21] + l * 256; const float* lg = c.in[22] + l * 256; const float* lb = c.in[23] + l * 256;
    for (int z = blockIdx.x * 8 + c.wave; z < NZ; z += gridDim.x * 8) {
        const size_t o = (size_t)z * 256 + lane * 4;
        const float4 yf = *(const float4*)(YF + o), yb = *(const float4*)(YB + o);
        const float y0 = yf.x + yb.x, y1 = yf.y + yb.y, y2 = yf.z + yb.z, y3 = yf.w + yb.w;
        const float mean = sum16(y0 + y1 + y2 + y3) * (1.f / 64.f);
        const float d0 = y0 - mean, d1 = y1 - mean, d2 = y2 - mean, d3 = y3 - mean;
        const float var = sum16(d0 * d0 + d1 * d1 + d2 * d2 + d3 * d3) * (1.f / 64.f);
        const float rs = rsqrtf(var + 64e-5f);
        float r[4], v[4], k0[4], k1[4], gg[4];
        unpack4(*(const u32x2*)(RB + o), r); unpack4(*(const u32x2*)(VB + o), v); unpack4(*(const u32x2*)(SKD + o), k0); unpack4(*(const u32x2*)(SKD + (size_t)NZ * 256 + o), k1);
        unpack4(*(const u32x2*)(GG + o), gg);
        const float4 rk = *(const float4*)(r_k + lane * 4), g4 = *(const float4*)(lg + lane * 4), b4 = *(const float4*)(lb + lane * 4);
        const float bs = sum16(r[0] * (k0[0] + k1[0]) * rk.x + r[1] * (k0[1] + k1[1]) * rk.y + r[2] * (k0[2] + k1[2]) * rk.z + r[3] * (k0[3] + k1[3]) * rk.w);
        *(u32x2*)(Ycat + (size_t)z * D + 256 + lane * 4) = pack4((d0 * rs * g4.x + b4.x + bs * v[0]) * gg[0], (d1 * rs * g4.y + b4.y + bs * v[1]) * gg[1],
                                                                (d2 * rs * g4.z + b4.z + bs * v[2]) * gg[2], (d3 * rs * g4.w + b4.w + bs * v[3]) * gg[3]);
    }
    {
        const bf16_t* ZG = (const bf16_t*)(ws + WS_MISC + MS_ZG); const bf16_t* W = (const bf16_t*)(ws + WS_WSM + OFF_GLUT + l * SZ_GLUT);
        const float* gb = c.in[33] + l * 256;
        for (int u = blockIdx.x; u < (NZ / 256) * 2; u += gridDim.x) {
            const int mt = u / 2, nt = u % 2, r0 = mt * 256, c0 = nt * 128;
            gemm_tile<4, 0>(c, 256, [&](int i) { return ZG + (size_t)(r0 + i) * 256; }, [&](int i) { return W + (size_t)(c0 + i) * 256; }, NoHook(),
                [&](f32x4 (&acc)[4][4], int wr, int wc, int fr, int fq) {
#pragma unroll
                    for (int n = 0; n < 4; ++n) {
                        const int col = c0 + wc + n * 16 + fq * 4; const float4 bb = *(const float4*)(gb + col);
#pragma unroll
                        for (int m = 0; m < 4; ++m) {
                            const int row = r0 + wr + m * 16 + fr; const f32x4 v = acc[m][n];
                            float zg[4]; unpack4(*(const u32x2*)(ZG + (size_t)row * 256 + col), zg);
                            *(u32x2*)(Ycat + (size_t)row * D + 512 + col) = pack4(zg[0] * sigmoidf_(v[0] + bb.x), zg[1] * sigmoidf_(v[1] + bb.y), zg[2] * sigmoidf_(v[2] + bb.z), zg[3] * sigmoidf_(v[3] + bb.w));
                        }
                    }
                });
        }
    }
}

DI bool skip_mt(int l, int mt) { return l == NL - 1 && (mt % 33) == 0; }
DI void phase_merge1(const Ctx& c, int l) {
    const bf16_t* Ycat = (const bf16_t*)(c.ws + WS_BUFA); const bf16_t* W = (const bf16_t*)(c.ws + WS_WSM + OFF_WBT + l * SZ_WBT);
    const bf16_t* GT = (const bf16_t*)(c.ws + WS_GT); bf16_t* MG = (bf16_t*)(c.ws + WS_BUFB);
    if (blockIdx.x == 0 && c.tid < 32) ((unsigned*)(c.ws + WS_CTL))[CW_CNT + l * 32 + c.tid] = 0u;
    for (int u = blockIdx.x; u < (NZ / 256) * 8; u += gridDim.x) {
        const int mt = u / 8, nt = u % 8, r0 = mt * 256, c0 = nt * 128;
        if (skip_mt(l, mt)) continue;
        f32x4 macc[4][4];
#pragma unroll
        for (int m = 0; m < 4; ++m)
#pragma unroll
            for (int n = 0; n < 4; ++n) macc[m][n] = (f32x4){0.f, 0.f, 0.f, 0.f};
        gemm_tile<4, 256>(c, 1024, [&](int i) { return Ycat + (size_t)(r0 + i) * D; }, [&](int i) { return W + (size_t)(c0 + i) * D; },
            [&](f32x4 (&acc)[4][4], int seg, int wr, int wc, int fr, int fq) {
#pragma unroll
                for (int m = 0; m < 4; ++m)
#pragma unroll
                    for (int n = 0; n < 4; ++n) {
                        float g[4]; unpack4(*(const u32x2*)(GT + (size_t)(r0 + wr + m * 16 + fr) * 4096 + seg * 1024 + c0 + wc + n * 16 + fq * 4), g);
                        macc[m][n][0] += g[0] * acc[m][n][0]; macc[m][n][1] += g[1] * acc[m][n][1]; macc[m][n][2] += g[2] * acc[m][n][2]; macc[m][n][3] += g[3] * acc[m][n][3];
                        acc[m][n] = (f32x4){0.f, 0.f, 0.f, 0.f};
                    }
            },
            [&](f32x4 (&)[4][4], int wr, int wc, int fr, int fq) {
#pragma unroll
                for (int m = 0; m < 4; ++m)
#pragma unroll
                    for (int n = 0; n < 4; ++n)
                        *(u32x2*)(MG + (size_t)(r0 + wr + m * 16 + fr) * D + c0 + wc + n * 16 + fq * 4) = pack4(macc[m][n][0], macc[m][n][1], macc[m][n][2], macc[m][n][3]);
            });
    }
}
struct EpiMerge2 {
    static constexpr bool PERM = false, AFTER_DRAIN = false;
    float* H; const float* modv; int l;
    DI void operator()(const pg8::f32x4 (&acc)[2][2][4][2], const pg8::Unit& u, int wr, int wc, int fr, int fq) const {
        if (skip_mt(l, u.pm)) return;
        const int sel = (u.pm % 33) == 0 ? 2 : u.pm / 33;
        const int row0 = u.pm * 256 + wr * 64 + fr, col0 = u.pn * 256 + wc * 32 + 4 * fq;
#pragma unroll
        for (int bj = 0; bj < 2; ++bj)
#pragma unroll
            for (int n = 0; n < 2; ++n) {
                const int col = col0 + bj * 128 + n * 16; const float4 m2 = *(const float4*)(modv + ((size_t)l * 3 + sel) * 6144 + 2 * 1024 + col);
#pragma unroll
                for (int ai = 0; ai < 2; ++ai)
#pragma unroll
                    for (int m = 0; m < 4; ++m) {
                        float4* hp = (float4*)(H + (size_t)(row0 + ai * 128 + m * 16) * D + col); float4 hv = *hp; const pg8::f32x4 v = acc[ai][bj][m][n];
                        hv.x += m2.x * v[0]; hv.y += m2.y * v[1]; hv.z += m2.z * v[2]; hv.w += m2.w * v[3]; *hp = hv;
                    }
            }
    }
};
DI void phase_merge2(const Ctx& c, int l) {
    EpiMerge2 E; E.H = (float*)(c.ws + WS_H); E.modv = (const float*)(c.ws + WS_WSM + OFF_MODV); E.l = l;
    pg8::Gemm g{(const bf16_t*)(c.ws + WS_BUFB), (const bf16_t*)(c.ws + WS_WSM + OFF_WOUTT + l * SZ_WOUTT), NZ, 1024, 1024, 1024, 1024};
    pg8::StaticOrder S; S.init(NZ, 1024, (int)gridDim.x, (int)blockIdx.x);
    __syncthreads();
    pg8::gemm_phase<EpiMerge2, pg8::StaticOrder, false>((PG8_LAS unsigned char*)c.smem, g, S, E, nullptr, c.tid);
}

constexpr int RT_PITCH = 68;
DI void phase_norm2_route(const Ctx& c, int l) {
    unsigned char* ws = c.ws; const int lane = c.lane, wave = c.wave, tid = c.tid;
    const float* modv = (const float*)(ws + WS_WSM + OFF_MODV); const float* H = (const float*)(ws + WS_H);
    bf16_t* XN = (bf16_t*)(ws + WS_BUFA); const float* g2 = c.in[7] + l * 1024;
    const float* rwt = (const float*)(ws + WS_WSM + OFF_RWT) + (size_t)l * 36 * 1024;
    const float* bg = c.in[42] + l * 4; const float* be = c.in[44] + l * 32;
    unsigned* cnt = (unsigned*)(ws + WS_CTL) + CW_CNT + l * 32;
    int* list = (int*)(ws + WS_GT + GT_LIST); float* lw = (float*)(ws + WS_GT + GT_LW);
    float* red = (float*)c.smem + wave * 36 * RT_PITCH;
    int* hist = (int*)(c.smem + 8 * 36 * RT_PITCH * 4);
    int* sel = hist + 64;
    float* selw = (float*)(sel + 128);
    const int ngroups = (l == NL - 1) ? (NB * SEQ / 64) : (NZ / 64);
    for (int grp = blockIdx.x; grp < ngroups; grp += gridDim.x) {
        __syncthreads();
        if (tid < 32) hist[tid] = 0;
        __syncthreads();
        for (int i = 0; i < 8; ++i) {
            const int rl = wave * 8 + i;
            int row;
            if (l == NL - 1) { const int rr = grp * 64 + rl; row = (rr / SEQ) * TZ + CTX + (rr % SEQ); } else row = grp * 64 + rl;
            const int b = row / TZ, s = row % TZ, sel3 = s < CTX ? 2 : b;
            float x[16]; float ss = 0.f;
#pragma unroll
            for (int q = 0; q < 4; ++q) { const float4 v = *(const float4*)(H + (size_t)row * D + q * 256 + lane * 4); x[q * 4] = v.x; x[q * 4 + 1] = v.y; x[q * 4 + 2] = v.z; x[q * 4 + 3] = v.w;
                ss += v.x * v.x + v.y * v.y + v.z * v.z + v.w * v.w; }
            ss = wave_sum(ss);
            const float rs = rsqrtf(ss * (1.f / 1024.f) + 1e-6f);
#pragma unroll
            for (int q = 0; q < 4; ++q) {
                const int col = q * 256 + lane * 4;
                const float4 g = *(const float4*)(g2 + col), m3 = *(const float4*)(modv + ((size_t)l * 3 + sel3) * 6144 + 3 * 1024 + col), m4 = *(const float4*)(modv + ((size_t)l * 3 + sel3) * 6144 + 4 * 1024 + col);
                x[q * 4] = x[q * 4] * rs * g.x * (1.f + m4.x) + m3.x; x[q * 4 + 1] = x[q * 4 + 1] * rs * g.y * (1.f + m4.y) + m3.y;
                x[q * 4 + 2] = x[q * 4 + 2] * rs * g.z * (1.f + m4.z) + m3.z; x[q * 4 + 3] = x[q * 4 + 3] * rs * g.w * (1.f + m4.w) + m3.w;
                *(u32x2*)(XN + (size_t)row * D + col) = pack4(x[q * 4], x[q * 4 + 1], x[q * 4 + 2], x[q * 4 + 3]);
            }
#pragma unroll 4
            for (int e = 0; e < 36; ++e) {
                float a = 0.f;
#pragma unroll
                for (int q = 0; q < 4; ++q) { const float4 w = *(const float4*)(rwt + (size_t)e * 1024 + q * 256 + lane * 4); a += x[q * 4] * w.x + x[q * 4 + 1] * w.y + x[q * 4 + 2] * w.z + x[q * 4 + 3] * w.w; }
                red[e * RT_PITCH + lane] = a;
            }
            __builtin_amdgcn_wave_barrier();
            float lg = -1e30f;
            if (lane < 36) {
                float s0 = 0.f, s1 = 0.f, s2 = 0.f, s3 = 0.f;
#pragma unroll
                for (int q = 0; q < 16; ++q) { const float4 v = *(const float4*)(red + lane * RT_PITCH + q * 4); s0 += v.x; s1 += v.y; s2 += v.z; s3 += v.w; }
                lg = (s0 + s1) + (s2 + s3) + (lane < 4 ? bg[lane] : be[lane - 4]);
            }
            __builtin_amdgcn_wave_barrier();
            float gm = -1e30f; int gsel = 0; float gl[4];
#pragma unroll
            for (int g = 0; g < 4; ++g) { gl[g] = __shfl(lg, g, 64); if (gl[g] > gm) { gm = gl[g]; gsel = g; } }
            const float gs = __expf(gl[0] - gm) + __expf(gl[1] - gm) + __expf(gl[2] - gm) + __expf(gl[3] - gm);
            const float pg = 1.f / gs;
            float l1 = -1e30f, l2 = -1e30f; int e1 = 0, e2 = 0;
#pragma unroll
            for (int j = 0; j < 8; ++j) {
                const float v = __shfl(lg, 4 + gsel * 8 + j, 64); const int e = gsel * 8 + j;
                if (v > l1) { l2 = l1; e2 = e1; l1 = v; e1 = e; } else if (v > l2) { l2 = v; e2 = e; }
            }
            const float tt = __expf(l2 - l1), w1 = pg / (1.f + tt), w2 = pg * tt / (1.f + tt);
            if (lane == 0) {
                const int r1 = atomicAdd(&hist[e1], 1), r2 = atomicAdd(&hist[e2], 1);
                sel[rl * 2] = e1 | (r1 << 8); sel[rl * 2 + 1] = e2 | (r2 << 8); selw[rl * 2] = w1; selw[rl * 2 + 1] = w2;
            }
        }
        __syncthreads();
        if (tid < 32) hist[32 + tid] = (int)atomicAdd(&cnt[tid], (unsigned)hist[tid]);
        __syncthreads();
        if (tid < 128) {
            const int rl = tid >> 1, j = tid & 1, sv = sel[tid], e = sv & 255, rk = sv >> 8;
            int row;
            if (l == NL - 1) { const int rr = grp * 64 + rl; row = (rr / SEQ) * TZ + CTX + (rr % SEQ); } else row = grp * 64 + rl;
            const size_t pos = (size_t)e * MOE_CAP + hist[32 + e] + rk;
            list[pos] = row * 2 + j; lw[pos] = selw[tid];
        }
    }
    phase_expert_convert(c, l);
}

DI void moe_prefix(const Ctx& c, int l, int* tiles  , int* cnts  ) {
    __syncthreads();
    if (c.tid == 0) {
        const unsigned* cnt = (const unsigned*)(c.ws + WS_CTL) + CW_CNT + l * 32; int acc = 0;
        for (int e = 0; e < 32; ++e) { const int n = (int)__hip_atomic_load(cnt + e, __ATOMIC_RELAXED, __HIP_MEMORY_SCOPE_AGENT); cnts[e] = n; tiles[e] = acc; acc += (n + 127) / 128; }
        tiles[32] = acc;
    }
    __syncthreads();
}
DI void phase_moe1(const Ctx& c, int l) {
    unsigned char* ws = c.ws;
    int* tiles = (int*)(c.smem + 120 * 1024); int* cnts = tiles + 40;
    moe_prefix(c, l, tiles, cnts);
    const bf16_t* XN = (const bf16_t*)(ws + WS_BUFA); bf16_t* HM = (bf16_t*)(ws + WS_GT + GT_HM); const int* list = (const int*)(ws + WS_GT + GT_LIST);
    const int nt_total = tiles[32];
    for (int u = blockIdx.x; u < nt_total * 4; u += gridDim.x) {
        const int mtg = u >> 2, nt = u & 3;
        int e = 0;
        for (int k = 1; k < 32; ++k) if (tiles[k] <= mtg) e = k;
        const int mt = mtg - tiles[e], n_e = cnts[e];
        const int* le = list + (size_t)e * MOE_CAP;
        const bf16_t* W = (const bf16_t*)(ws + WS_EXPW + (size_t)e * SZ_WGU);
        gemm_tile<2, 0>(c, 1024,
            [&](int i) { int p = mt * 128 + i; if (p >= n_e) p = n_e - 1; return XN + (size_t)(le[p] >> 1) * D; },
            [&](int i) { return W + (size_t)(nt * 256 + i) * D; }, NoHook(),
            [&](f32x4 (&acc)[4][4], int wr, int wc, int fr, int fq) {
#pragma unroll
                for (int np = 0; np < 2; ++np) {
                    const int hc = (nt * 256 + wc + np * 32) / 2 + fq * 4;
#pragma unroll
                    for (int m = 0; m < 4; ++m) {
                        const int p = mt * 128 + wr + m * 16 + fr;
                        const f32x4 g = acc[m][np * 2], uu = acc[m][np * 2 + 1];
                        *(u32x2*)(HM + ((size_t)mtg * 128 + wr + m * 16 + fr) * 512 + hc) = pack4(siluf_(g[0]) * uu[0], siluf_(g[1]) * uu[1], siluf_(g[2]) * uu[2], siluf_(g[3]) * uu[3]);
                        (void)p;
                    }
                }
            });
    }
}
DI void phase_moe2(const Ctx& c, int l) {
    unsigned char* ws = c.ws;
    int* tiles = (int*)(c.smem + 120 * 1024); int* cnts = tiles + 40;
    moe_prefix(c, l, tiles, cnts);
    const bf16_t* HM = (const bf16_t*)(ws + WS_GT + GT_HM); const int* list = (const int*)(ws + WS_GT + GT_LIST); const float* lw = (const float*)(ws + WS_GT + GT_LW);
    bf16_t* Y2 = (bf16_t*)(ws + WS_P);
    const int nt_total = tiles[32];
    for (int u = blockIdx.x; u < nt_total * 4; u += gridDim.x) {
        const int mtg = u >> 2, nt = u & 3;
        int e = 0;
        for (int k = 1; k < 32; ++k) if (tiles[k] <= mtg) e = k;
        const int mt = mtg - tiles[e], n_e = cnts[e];
        const int* le = list + (size_t)e * MOE_CAP; const float* lwe = lw + (size_t)e * MOE_CAP;
        const bf16_t* W = (const bf16_t*)(ws + WS_EXPW + 32 * SZ_WGU + (size_t)e * SZ_WD);
        gemm_tile<2, 0>(c, 512,
            [&](int i) { return HM + ((size_t)mtg * 128 + i) * 512; },
            [&](int i) { return W + (size_t)(nt * 256 + i) * 512; }, NoHook(),
            [&](f32x4 (&acc)[4][4], int wr, int wc, int fr, int fq) {
#pragma unroll
                for (int m = 0; m < 4; ++m) {
                    const int p = mt * 128 + wr + m * 16 + fr;
                    if (p < n_e) {
                        const int ent = le[p]; const float wt = lwe[p];
                        bf16_t* yrow = Y2 + ((size_t)(ent & 1) * NZ + (ent >> 1)) * D + nt * 256 + wc + fq * 4;
#pragma unroll
                        for (int n = 0; n < 4; ++n) *(u32x2*)(yrow + n * 16) = pack4(wt * acc[m][n][0], wt * acc[m][n][1], wt * acc[m][n][2], wt * acc[m][n][3]);
                    }
                }
            });
    }
}

constexpr int LDS_BYTES = 128 * 1024 + 256;
constexpr int STEPS_PER_LAYER = 12, N_STEPS = 2 + NL * STEPS_PER_LAYER;
#ifndef FUSED
#define FUSED 1
#endif

DI const void* launder_ptr(const void* p) {
    const unsigned long long v = (unsigned long long)p;
    unsigned lo = __builtin_amdgcn_readfirstlane((unsigned)v), hi = __builtin_amdgcn_readfirstlane((unsigned)(v >> 32));
    asm volatile("" : "+s"(lo), "+s"(hi) :: "memory");
    return (const void*)(((unsigned long long)hi << 32) | lo);
}
template <int KIND> DI void run_step(const Ctx& c0, int l) {
#ifdef PHM
    if (!((PHM >> KIND) & 1)) return;
#endif
    Ctx c = c0;
    { int z = 0; asm volatile("" : "+s"(z) :: "memory"); c.in = c0.in + z; c.ws = c0.ws + z; c.out = c0.out + z; }
    { int t = c0.tid; asm volatile("" : "+v"(t)); c.tid = t; c.lane = t & 63; c.wave = __builtin_amdgcn_readfirstlane(t >> 6); }
    if (KIND == 0) phase_prologue(c);
    if (KIND == 1) phase_norm1(c, l);
    if (KIND == 2) phase_inproj(c, l);
    if (KIND == 3) { phase_prep(c, l); for (int u = blockIdx.x; u < 2 * S5N * 4; u += gridDim.x) phase_s5_final_unit<true>(c, l, u); }
    if (KIND == 4) { phase_small_gemms(c, l); phase_s5_carry(c, l); }
    if (KIND == 5) { phase_attention(c, l); phase_rwkv_chunks(c, l); }
    if (KIND == 6) phase_mixers2(c, l);
    if (KIND == 7) phase_post(c, l);
    if (KIND == 8) phase_merge1(c, l);
    if (KIND == 9) phase_merge2(c, l);
    if (KIND == 10) phase_norm2_route(c, l);
    if (KIND == 11) phase_moe1(c, l);
    if (KIND == 12) phase_moe2(c, l);
    if (KIND == 13) phase_final(c);
}

#if !FUSED
template <int KIND> __global__ void __launch_bounds__(NTHR, 2) k_step(Args a) {
    extern __shared__ __attribute__((aligned(16))) unsigned char lds[];
    Ctx c; c.in = a.in; c.out = a.out; c.ws = a.ws; c.smem = lds; c.tid = threadIdx.x; c.lane = threadIdx.x & 63; c.wave = __builtin_amdgcn_readfirstlane(threadIdx.x >> 6);
    run_step<KIND>(c, a.s_lo);
}
template <int KIND> static void launch_step(const Args& a, int grid, hipStream_t stream) {
    static bool attr = false;
    if (!attr) { (void)hipFuncSetAttribute((const void*)k_step<KIND>, hipFuncAttributeMaxDynamicSharedMemorySize, LDS_BYTES); attr = true; }
    hipLaunchKernelGGL(k_step<KIND>, dim3(grid), dim3(NTHR), LDS_BYTES, stream, a);
}
#else
__global__ void __launch_bounds__(NTHR, 2) fwd_kernel(Args a) {
    extern __shared__ __attribute__((aligned(16))) unsigned char lds[];
    Ctx c; c.in = a.in; c.out = a.out; c.ws = a.ws; c.smem = lds; c.tid = threadIdx.x; c.lane = threadIdx.x & 63; c.wave = __builtin_amdgcn_readfirstlane(threadIdx.x >> 6);
    volatile LAS unsigned* xbw = (volatile LAS unsigned*)(lds + LDS_BYTES - 16);
    for (int i = threadIdx.x; i < LDS_BYTES / 16; i += NTHR) ((uint4*)lds)[i] = make_uint4(0u, 0u, 0u, 0u);
    __syncthreads();
    if (threadIdx.x == 0) { xbw[0] = 0u; xbw[1] = 0u; }
    __syncthreads();
    XcdBarrier bar = xcd_barrier_post((unsigned*)(a.ws + WS_CTL) + CW_BAR, xbw);
#ifndef REP_MASK
#define REP_MASK 0
#endif
#define GBAR() do { XcdBarrier bb = bar; int zz = 0; asm volatile("" : "+s"(zz) :: "memory"); bb.bar = bar.bar + zz; xcd_barrier(bb); } while (0)
#define STEP(K, L) do { run_step<K>(c, L); GBAR(); if ((REP_MASK >> K) & 1) { run_step<K>(c, L); GBAR(); } } while (0)
    STEP(0, 0);
    for (int l = 0; l < NL; ++l) {
        STEP(1, l); STEP(2, l); STEP(3, l); STEP(4, l); STEP(5, l); STEP(6, l); STEP(7, l); STEP(8, l); STEP(9, l); STEP(10, l); STEP(11, l); STEP(12, l);
    }
#undef STEP
    run_step<13>(c, 0);
}
#endif

extern "C" void kernel_launch(void* const* d_in, const int* in_sizes, int n_in, void* d_out, int out_size, void* d_ws, size_t ws_size, hipStream_t stream) {
    static int grid = 0;
    if (grid == 0) {
        if (n_in != 49 || out_size != NB * SEQ * D || ws_size < WS_END) { fprintf(stderr, "kernel_launch: unexpected problem (n_in %d out %d ws %zu need %zu)\n", n_in, out_size, ws_size, (size_t)WS_END); grid = -1; return; }
        int dev = 0, cus = 0;
        if (hipGetDevice(&dev) != hipSuccess || hipDeviceGetAttribute(&cus, hipDeviceAttributeMultiprocessorCount, dev) != hipSuccess) { grid = -1; return; }
#if FUSED
        int per_cu = 0;
        if (hipFuncSetAttribute((const void*)fwd_kernel, hipFuncAttributeMaxDynamicSharedMemorySize, LDS_BYTES) != hipSuccess) { fprintf(stderr, "kernel_launch: hipFuncSetAttribute failed\n"); grid = -1; return; }
        if (hipOccupancyMaxActiveBlocksPerMultiprocessor(&per_cu, (const void*)fwd_kernel, NTHR, LDS_BYTES) != hipSuccess || per_cu < 1) { fprintf(stderr, "kernel_launch: occupancy query says %d\n", per_cu); }
        (void)hipGetLastError();
#endif
        grid = cus;
    }
    if (grid < 0) return;
    (void)hipMemsetAsync((char*)d_ws + WS_CTL, 0, CTL_BYTES, stream);
    Args a{};
    for (int i = 0; i < 49; ++i) a.in[i] = (const float*)d_in[i];
    a.out = (float*)d_out; a.ws = (unsigned char*)d_ws;
#if !FUSED
    a.s_lo = 0; a.s_hi = 0; launch_step<0>(a, grid, stream);
    for (int l = 0; l < NL; ++l) {
        a.s_lo = l;
        launch_step<1>(a, grid, stream); launch_step<2>(a, grid, stream); launch_step<3>(a, grid, stream); launch_step<4>(a, grid, stream);
        launch_step<5>(a, grid, stream); launch_step<6>(a, grid, stream); launch_step<7>(a, grid, stream); launch_step<8>(a, grid, stream);
        launch_step<9>(a, grid, stream); launch_step<10>(a, grid, stream); launch_step<11>(a, grid, stream); launch_step<12>(a, grid, stream);
    }
    a.s_lo = 0; launch_step<13>(a, grid, stream);
#else
    a.s_lo = 0; a.s_hi = N_STEPS; hipLaunchKernelGGL(fwd_kernel, dim3(grid), dim3(NTHR), LDS_BYTES, stream, a);
#endif
}
```

```cpp
#include <hip/hip_runtime.h>
#include <stdint.h>
#include <stdio.h>

#define DI __device__ __forceinline__
#define LAS __attribute__((address_space(3)))
typedef unsigned short bf16_t;
typedef short bf16x8 __attribute__((ext_vector_type(8)));
typedef short s16x4 __attribute__((ext_vector_type(4)));
typedef float f32x4 __attribute__((ext_vector_type(4)));
typedef float f32x16 __attribute__((ext_vector_type(16)));
typedef float f32x2 __attribute__((ext_vector_type(2)));
typedef __bf16 bf16x2v __attribute__((ext_vector_type(2)));
typedef unsigned u32x4 __attribute__((ext_vector_type(4)));
typedef unsigned u32x2 __attribute__((ext_vector_type(2)));

constexpr int D = 1024, NB = 2, SEQ = 8192, CTX = 256, TZ = 8448, NZ = 16896, NL = 2;
constexpr int NIN = 6560, NINP = 6656;
constexpr int NTHR = 512;
constexpr float LOG2E = 1.4426950408889634f;

#define XB_TMO      128
#define XB_XCNT(j)  (256  + 64 * (j))
#define XB_XSUB(j)  (1280 + 64 * (j))
#define XB_XGEN(j)  (2304 + 64 * (j))
#define XB_TOP      3328
#define XB_TOPGEN   3392
#define XCD_BAR_WORDS 3456
#define XB_SPIN_CAP (1u << 18)

__device__ __forceinline__ unsigned xb_ld(unsigned* p)              { return __hip_atomic_load(p, __ATOMIC_RELAXED, __HIP_MEMORY_SCOPE_AGENT); }
__device__ __forceinline__ unsigned xb_add(unsigned* p, unsigned v) { return __hip_atomic_fetch_add(p, v, __ATOMIC_RELAXED, __HIP_MEMORY_SCOPE_AGENT); }
__device__ __forceinline__ unsigned xb_xcc_id() { return (unsigned)__builtin_amdgcn_s_getreg((3 << 11) | 20) & 0xFu; }
#define XB_SPIN(cond, bar) do { unsigned _sp = 0; while (cond) { __builtin_amdgcn_s_sleep(1); \
    if ((++_sp & 255u) == 0u) { if (xb_ld(&(bar)[XB_TMO])) break; if (_sp > XB_SPIN_CAP) { atomicAdd(&(bar)[XB_TMO], 1u); break; } } } } while (0)

struct XcdBarrier { unsigned* bar; unsigned x; volatile LAS unsigned* st; };

__device__ __forceinline__ XcdBarrier xcd_barrier_post(unsigned* bar, volatile LAS unsigned* st) {
    XcdBarrier b; b.bar = bar; b.x = xb_xcc_id(); b.st = st;
    if (threadIdx.x == 0) (void)xb_add(&bar[XB_XCNT(b.x)], 1u);
    return b;
}
__device__ __forceinline__ void xcd_barrier_complete(unsigned* bar, unsigned x, unsigned& nloc, unsigned& nx) {
    const unsigned G = gridDim.x * gridDim.y * gridDim.z;
    unsigned sum, cnt, mine, sp = 0u;
    for (;;) {
        sum = 0u; cnt = 0u; mine = 0u;
#pragma unroll
        for (unsigned j = 0; j < 16; ++j) { const unsigned c = xb_ld(&bar[XB_XCNT(j)]); sum += c; cnt += (c > 0u) ? 1u : 0u; mine = (j == x) ? c : mine; }
        if (sum == G) break;
        __builtin_amdgcn_s_sleep(1);
        if ((++sp & 255u) == 0u) { if (xb_ld(&bar[XB_TMO])) break; if (sp > XB_SPIN_CAP) { atomicAdd(&bar[XB_TMO], 1u); break; } }
    }
    nloc = mine > 0u ? mine : 1u; nx = cnt > 0u ? cnt : 1u;
}
__device__ __forceinline__ void xcd_barrier(const XcdBarrier& b) {
    asm volatile("s_waitcnt vmcnt(0)" ::: "memory");
    __syncthreads();
    if (threadIdx.x == 0) {
        unsigned* bar = b.bar;
        __builtin_amdgcn_s_waitcnt(0);
        unsigned nloc = b.st[0], nx = b.st[1];
        if (nloc == 0u) { xcd_barrier_complete(bar, b.x, nloc, nx); b.st[0] = nloc; b.st[1] = nx; }
        const unsigned old = xb_add(&bar[XB_XSUB(b.x)], 1u);
        const unsigned gen = old / nloc;
        if (old + 1u == (gen + 1u) * nloc) {
            __builtin_amdgcn_fence(__ATOMIC_RELEASE, "agent");
            asm volatile("s_waitcnt vmcnt(0)" ::: "memory");
            const unsigned og = xb_add(&bar[XB_TOP], 1u);
            const unsigned tg = og / nx;
            if (og + 1u == (tg + 1u) * nx) xb_add(&bar[XB_TOPGEN], 1u);
            else XB_SPIN(xb_ld(&bar[XB_TOPGEN]) == tg, bar);
            __builtin_amdgcn_fence(__ATOMIC_ACQUIRE, "agent");
            xb_add(&bar[XB_XGEN(b.x)], 1u);
            asm volatile("s_waitcnt vmcnt(0)" ::: "memory");
        } else {
            XB_SPIN(xb_ld(&bar[XB_XGEN(b.x)]) == gen, bar);
            __builtin_amdgcn_fence(__ATOMIC_ACQUIRE, "agent");
            asm volatile("s_waitcnt vmcnt(0)" ::: "memory");
        }
    }
    __syncthreads();
}

DI float bf2f(bf16_t v) { return __uint_as_float((unsigned)v << 16); }
DI unsigned pack2(float a, float b) { f32x2 v = {a, b}; bf16x2v r = __builtin_convertvector(v, bf16x2v); return __builtin_bit_cast(unsigned, r); }
DI bf16_t f2bf(float a) { return (bf16_t)(pack2(a, 0.f) & 0xffffu); }
DI float lo2f(unsigned u) { return __uint_as_float(u << 16); }
DI float hi2f(unsigned u) { return __uint_as_float(u & 0xffff0000u); }
DI float wave_sum(float v) {
#pragma unroll
    for (int m = 32; m >= 1; m >>= 1) v += __shfl_xor(v, m, 64);
    return v;
}
DI float sum16(float v) {
#pragma unroll
    for (int m = 8; m >= 1; m >>= 1) v += __shfl_xor(v, m, 64);
    return v;
}
DI float sigmoidf_(float x) { return 1.f / (1.f + __expf(-x)); }
DI float siluf_(float x) { return x / (1.f + __expf(-x)); }
DI float gelu_tanh(float x) { const float u = 0.7978845608028654f * (x + 0.044715f * x * x * x); return 0.5f * x * (1.f + tanhf(u)); }
DI void unpack4(u32x2 u, float (&f)[4]) { f[0] = lo2f(u.x); f[1] = hi2f(u.x); f[2] = lo2f(u.y); f[3] = hi2f(u.y); }
DI u32x2 pack4(float a, float b, float c, float d) { u32x2 r; r.x = pack2(a, b); r.y = pack2(c, d); return r; }

constexpr size_t algn(size_t x) { return (x + 255) & ~(size_t)255; }
constexpr size_t WS_CTL   = 0;
constexpr size_t CTL_BYTES = 64 * 1024;
constexpr size_t WS_H     = WS_CTL + CTL_BYTES;
constexpr size_t WS_WSM   = WS_H + (size_t)NZ * D * 4;
constexpr size_t SZ_WINT = (size_t)NINP * D * 2, SZ_WUQT = 384 * 256 * 2, SZ_WUKVT = 512 * 128 * 2, SZ_W2T = 512 * 64 * 2, SZ_A2T = 512 * 64 * 2,
                 SZ_G2T = 256 * 128 * 2, SZ_GLUT = 256 * 256 * 2, SZ_WBT = (size_t)D * D * 2, SZ_WOUTT = (size_t)D * D * 2;
constexpr size_t OFF_WINT = 0, OFF_WUQT = OFF_WINT + NL * SZ_WINT, OFF_WUKVT = OFF_WUQT + NL * SZ_WUQT, OFF_W2T = OFF_WUKVT + NL * SZ_WUKVT,
                 OFF_A2T = OFF_W2T + NL * SZ_W2T, OFF_G2T = OFF_A2T + NL * SZ_A2T, OFF_GLUT = OFF_G2T + NL * SZ_G2T, OFF_WBT = OFF_GLUT + NL * SZ_GLUT,
                 OFF_WOUTT = OFF_WBT + NL * SZ_WBT, OFF_MODV = OFF_WOUTT + NL * SZ_WOUTT,
                 OFF_ROPE = OFF_MODV + (size_t)NL * 3 * 6144 * 4,
                 OFF_S5T = OFF_ROPE + (size_t)SEQ * 16 * 2 * 4,
                 OFF_RWT = OFF_S5T + (size_t)NL * 2 * 16 * 64 * 36 * 4,
                 OFF_LAM = OFF_RWT + (size_t)NL * 36 * 1024 * 4,
                 OFF_S5E = OFF_LAM + 256,
                 OFF_S5C = OFF_S5E,
                 WSM_BYTES = algn(OFF_S5E + (size_t)2 * 2 * 16 * 132 * 64 * 2 * 4);
constexpr size_t WS_EXPW  = WS_WSM + WSM_BYTES;
constexpr size_t SZ_WGU = (size_t)1024 * 1024 * 2, SZ_WD = (size_t)1024 * 512 * 2;
constexpr size_t EXPW_BYTES = 32 * (SZ_WGU + SZ_WD);
constexpr size_t SZ_QM = (size_t)NB * 4 * TZ * 96 * 2, SZ_VMT = (size_t)NB * 4 * 64 * TZ * 2, SZ_QD = (size_t)NB * 4 * TZ * 64 * 2, SZ_R256 = (size_t)NZ * 256 * 2;
constexpr size_t MX_QM = 0, MX_KM = MX_QM + SZ_QM, MX_VMT = MX_KM + SZ_QM, MX_QD = MX_VMT + SZ_VMT, MX_KD = MX_QD + SZ_QD, MX_VDT = MX_KD + SZ_QD,
                 MX_RB = MX_VDT + SZ_VMT, MX_KB = MX_RB + SZ_R256, MX_VB = MX_KB + SZ_R256, MX_KKB = MX_VB + SZ_R256, MX_END = MX_KKB + SZ_R256;
static_assert(MX_END <= EXPW_BYTES, "mixer operands must fit the expert-weight region");
constexpr size_t WS_BUFA  = WS_EXPW + EXPW_BYTES;
constexpr size_t WS_BUFB  = WS_BUFA + (size_t)NZ * D * 2;
constexpr size_t WS_P     = WS_BUFB + (size_t)NZ * D * 2;
constexpr size_t P_PM = 0, P_PS = P_PM + (size_t)NZ * 416 * 2, P_PR = P_PS + (size_t)NZ * 256 * 2, P_PD = P_PR + (size_t)NZ * 1024 * 2, P_BYTES = P_PD + (size_t)NZ * 768 * 2;
static_assert((size_t)6 * SZ_R256 <= (size_t)NZ * (1024 + 768) * 2, "scan operands must fit PR|PD");
static_assert((size_t)2 * NZ * D * 2 <= P_BYTES, "the MoE outputs (2 x bf16 [NZ][D]) must fit the P region");
constexpr size_t WS_GT    = WS_P + P_BYTES;
constexpr size_t GT_BYTES = (size_t)NZ * 4096 * 2;
constexpr int MOE_CAP = 33792;
constexpr size_t GT_HM = 0, GT_LIST = GT_HM + (size_t)(33792 + 32 * 128) * 512 * 2, GT_LW = GT_LIST + (size_t)32 * MOE_CAP * 4, GT_END = GT_LW + (size_t)32 * MOE_CAP * 4;
static_assert(GT_END <= GT_BYTES, "MoE scratch must fit the gate region");
constexpr size_t WS_MISC  = WS_GT + GT_BYTES;
constexpr size_t MS_CQN = 0, MS_TW = MS_CQN + (size_t)NZ * 384 * 2, MS_AL = MS_TW + (size_t)NZ * 64 * 2, MS_SG = MS_AL + (size_t)NZ * 64 * 2,
                 MS_GG = MS_SG + (size_t)NZ * 128 * 2, MS_ZG = MS_GG + SZ_R256, MS_END = MS_ZG + SZ_R256;
constexpr size_t WS_RW    = WS_MISC + MS_END;
constexpr int RC = 64, RNC = TZ / RC;
constexpr size_t SZ_RWM = (size_t)16 * RNC * 4096 * 2;
constexpr size_t RW_M3 = 0, RW_M2 = SZ_RWM, RW_Z5 = 2 * SZ_RWM, RW_P63 = 3 * SZ_RWM, RW_END = RW_P63 + (size_t)16 * RNC * 64 * 4;
constexpr size_t WS_END   = WS_RW + RW_END;

constexpr int CW_BAR = 0;
constexpr int CW_CNT = 4096;

struct Args { const float* in[49]; float* out; unsigned char* ws; int s_lo, s_hi; };

struct Ctx {
    const float* const* in; float* out; unsigned char* ws; unsigned char* smem; int tid, lane, wave;
};

template <int WM> struct GCfg { static constexpr int WN = 8 / WM, BM = 64 * WM, BN = 64 * WN, ABYTES = BM * 128, BBYTES = BN * 128, STAGE = ABYTES + BBYTES; };

template <int WM, int SEGK, class ARow, class BRow, class Hook, class Epi>
DI void gemm_tile(const Ctx& c, int K, ARow arow, BRow brow, Hook hook, Epi epi) {
    typedef GCfg<WM> G;
    const int tid = c.tid, lane = c.lane, wave = c.wave;
    const int wm = wave / G::WN, wn = wave % G::WN, fr = lane & 15, fq = lane >> 4;
    unsigned char* smem = c.smem;
    constexpr int NA = G::BM / 64, NBq = G::BN / 64;
    const int r0 = tid >> 3, coff = ((tid & 7) ^ (r0 & 7)) * 8;
    auto stage = [&](int kt, int buf) {
        unsigned char* sa = smem + buf * G::STAGE; unsigned char* sb = sa + G::ABYTES;
#pragma unroll
        for (int i = 0; i < NA; ++i) __builtin_amdgcn_global_load_lds((const unsigned*)(arow(r0 + 64 * i) + coff + kt * 64), (unsigned*)(sa + (tid + i * NTHR) * 16), 16, 0, 0);
#pragma unroll
        for (int i = 0; i < NBq; ++i) __builtin_amdgcn_global_load_lds((const unsigned*)(brow(r0 + 64 * i) + coff + kt * 64), (unsigned*)(sb + (tid + i * NTHR) * 16), 16, 0, 0);
    };
    f32x4 acc[4][4];
#pragma unroll
    for (int m = 0; m < 4; ++m)
#pragma unroll
        for (int n = 0; n < 4; ++n) acc[m][n] = (f32x4){0.f, 0.f, 0.f, 0.f};
    const int T = K / 64;
    __syncthreads();
    stage(0, 0);
    for (int t = 0; t < T; ++t) {
        asm volatile("s_waitcnt vmcnt(0)" ::: "memory");
        __syncthreads();
        if (t + 1 < T) stage(t + 1, (t + 1) & 1);
        const unsigned char* sa = smem + (t & 1) * G::STAGE; const unsigned char* sb = sa + G::ABYTES;
#pragma unroll
        for (int ks = 0; ks < 2; ++ks) {
            bf16x8 af[4], bfr[4];
            const int sl = ((ks * 4 + fq) ^ (fr & 7)) * 16;
#pragma unroll
            for (int m = 0; m < 4; ++m) af[m] = *(const bf16x8*)(sa + (wm * 64 + m * 16 + fr) * 128 + sl);
#pragma unroll
            for (int n = 0; n < 4; ++n) bfr[n] = *(const bf16x8*)(sb + (wn * 64 + n * 16 + fr) * 128 + sl);
#pragma unroll
            for (int m = 0; m < 4; ++m)
#pragma unroll
                for (int n = 0; n < 4; ++n) acc[m][n] = __builtin_amdgcn_mfma_f32_16x16x32_bf16(bfr[n], af[m], acc[m][n], 0, 0, 0);
        }
        if (SEGK > 0) { if (((t + 1) * 64) % (SEGK > 0 ? SEGK : 64) == 0) hook(acc, ((t + 1) * 64) / (SEGK > 0 ? SEGK : 64) - 1, wm * 64, wn * 64, fr, fq); }
    }
    epi(acc, wm * 64, wn * 64, fr, fq);
}
struct NoHook { DI void operator()(f32x4 (&)[4][4], int, int, int, int, int) const {} };

namespace pg8 {
#define PG8_LAS __attribute__((address_space(3)))
typedef unsigned short bf16_t;
typedef short bf16x8 __attribute__((ext_vector_type(8)));
typedef float f32x4 __attribute__((ext_vector_type(4)));
constexpr int BM = 256, BK = 64, HALF = 128, HTB = HALF * BK * 2  , STAGE_BYTES = 8 * HTB, NXCD = 8, WGM = 8;

__host__ __device__ __forceinline__ int lds_byte(int r, int c) { const int st = (r >> 4) * 2 + (c >> 5), rr = r & 15, cc = c & 31, ob = rr * 64 + cc * 2; return st * 1024 + (ob ^ (((ob >> 9) & 1) << 5)); }
__host__ __device__ __forceinline__ void stage_rc(int b, int& R, int& C) { const int st = b / 1024, sb = b % 1024, swz = sb ^ (((sb >> 9) & 1) << 5); R = (st >> 1) * 16 + swz / 64; C = (st & 1) * 32 + (swz % 64) / 2; }
__host__ __device__ __forceinline__ int perm32(int rho) { const int n = rho >> 4, i = rho & 15; return 8 * (i >> 2) + 4 * n + (i & 3); }

struct Unit { int pm, pn; };
struct Gemm { const bf16_t* A; const bf16_t* Bt; int M, N, K, lda, ldb; };

struct StaticOrder {
    int nM, nN, nwg, G, c;
    __host__ __device__ void init(int M, int N, int G_, int c_) { nM = M / BM; nN = N / BM; nwg = nM * nN; G = G_; c = c_; }
    __host__ __device__ bool next(int i, Unit& u) const {
        const long L = (long)i * G + c; if (L >= nwg) return false;
        int wgid = (int)L; { const int q = nwg / NXCD, r = nwg % NXCD, xcd = wgid % NXCD, off = wgid / NXCD; wgid = (xcd < r ? xcd * (q + 1) : r * (q + 1) + (xcd - r) * q) + off; }
        const int nig = WGM * nN, gid = wgid / nig, fm = gid * WGM, gsz = (nM - fm) < WGM ? (nM - fm) : WGM;
        u.pm = fm + ((wgid % nig) % gsz); u.pn = (wgid % nig) / gsz; return true;
    }
    __device__ __forceinline__ void a_ready(const Unit&) const {}
    __device__ __forceinline__ void done(const Unit&) const {}
};
template <class Epi, class Sched, bool STAMP = false>
__device__ __forceinline__ void gemm_phase(PG8_LAS unsigned char* lds, const Gemm g, const Sched& S, const Epi& E, unsigned long long* stamps, int tid_in) {
    const int tid = tid_in, wid = __builtin_amdgcn_readfirstlane(tid >> 6), lane = tid & 63, wr = wid >> 2, wc = wid & 3, fr = lane & 15, fq = lane >> 4;
    const int K = g.K, nt = K / BK;
    int ts_lo = 0, ts_hi = 0, nts = 0; const unsigned long long rt_entry = STAMP ? (unsigned long long)wall_clock64() : 0ull;
#define PG8_STAMP() do { if (STAMP && wid == 0 && nts < 64) { const unsigned long long _c = (unsigned long long)clock64(); \
        ts_lo = (lane == nts) ? (int)(unsigned)_c : ts_lo; ts_hi = (lane == nts) ? (int)(unsigned)(_c >> 32) : ts_hi; ++nts; } } while (0)
    PG8_STAMP();
    unsigned voffA[2], voffB[2];
#pragma unroll
    for (int i = 0; i < 2; ++i) { int R, C; stage_rc(tid * 16 + i * 8192, R, C); const int Rb = Epi::PERM ? ((R & ~31) + perm32(R & 31)) : R;
        voffA[i] = (unsigned)(R * g.lda + C) * 2u; voffB[i] = (unsigned)(Rb * g.ldb + C) * 2u; }
    const size_t kstep = (size_t)(BK * 2);
    const size_t hstepA = (size_t)HALF * g.lda * 2, hstepB = (size_t)HALF * g.ldb * 2;
    const size_t tstepA = 2 * hstepA, tstepB = 2 * hstepB;
    const unsigned ldsw = (unsigned)wid * 1024u;
    const int aoff = lds_byte(wr * 64 + fr, fq * 8), boff = lds_byte(wc * 32 + fr, fq * 8);
#define PG8_SA(b, h) (((b) * 2 + (h)) * HTB)
#define PG8_SB(b, h) ((4 + (b) * 2 + (h)) * HTB)
#define PG8_STAGE(bufoff, gbase, voff) do { _Pragma("unroll") for (int _i = 0; _i < 2; ++_i) \
        __builtin_amdgcn_global_load_lds((const unsigned*)((const char*)(gbase) + (voff)[_i]), (PG8_LAS unsigned*)(lds + (bufoff) + ldsw + _i * 8192), 16, 0, 0); } while (0)
#define PG8_LDA(dst, b, h) do { _Pragma("unroll") for (int m = 0; m < 4; ++m) _Pragma("unroll") for (int k = 0; k < 2; ++k) dst[m][k] = *(const PG8_LAS bf16x8*)(lds + PG8_SA(b, h) + aoff + m * 2048 + k * 1024); } while (0)
#define PG8_LDB(dst, b, h) do { _Pragma("unroll") for (int n = 0; n < 2; ++n) _Pragma("unroll") for (int k = 0; k < 2; ++k) dst[n][k] = *(const PG8_LAS bf16x8*)(lds + PG8_SB(b, h) + boff + n * 2048 + k * 1024); } while (0)
#define PG8_MMA(ai, bj, At, Bt) do { __builtin_amdgcn_s_setprio(1); _Pragma("unroll") for (int m = 0; m < 4; ++m) _Pragma("unroll") for (int n = 0; n < 2; ++n) _Pragma("unroll") for (int k = 0; k < 2; ++k) \
        acc[ai][bj][m][n] = __builtin_amdgcn_mfma_f32_16x16x32_bf16(Bt[n][k], At[m][k], acc[ai][bj][m][n], 0, 0, 0); __builtin_amdgcn_s_setprio(0); } while (0)
#define PG8_WAIT_V(n) asm volatile("s_waitcnt vmcnt(" #n ")" ::: "memory")
#define PG8_WAIT_L(n) asm volatile("s_waitcnt lgkmcnt(" #n ")" ::: "memory")
#define PG8_BAR __builtin_amdgcn_s_barrier()
#define PG8_SCHED __builtin_amdgcn_sched_barrier(0)
    Unit cur, nxt; int ui = 0;
    if (!S.next(0, cur)) return;
    f32x4 acc[2][2][4][2];
#pragma unroll
    for (int a = 0; a < 2; ++a)
#pragma unroll
        for (int b = 0; b < 2; ++b)
#pragma unroll
            for (int m = 0; m < 4; ++m)
#pragma unroll
                for (int n = 0; n < 2; ++n) acc[a][b][m][n] = (f32x4){0.f, 0.f, 0.f, 0.f};
    bf16x8 At[4][2], B0[2][2], B1[2][2];
    const char* cA = (const char*)g.A + (size_t)cur.pm * tstepA; const char* cB = (const char*)g.Bt + (size_t)cur.pn * tstepB;
    S.a_ready(cur);
    PG8_STAGE(PG8_SB(0, 0), cB, voffB); PG8_STAGE(PG8_SA(0, 0), cA, voffA); PG8_STAGE(PG8_SB(0, 1), cB + hstepB, voffB); PG8_STAGE(PG8_SA(0, 1), cA + hstepA, voffA);
    if (wr == 1) PG8_BAR;
    PG8_WAIT_V(4); PG8_BAR;
    PG8_STAGE(PG8_SB(1, 0), cB + kstep, voffB); PG8_STAGE(PG8_SA(1, 0), cA + kstep, voffA); PG8_STAGE(PG8_SB(1, 1), cB + hstepB + kstep, voffB);
    PG8_WAIT_V(6); PG8_BAR;
    PG8_STAMP();
    for (;;) {
        const bool has_next = S.next(ui + 1, nxt);
        const char* nA = has_next ? (const char*)g.A + (size_t)nxt.pm * tstepA : cA; const char* nB = has_next ? (const char*)g.Bt + (size_t)nxt.pn * tstepB : cB;
        for (int t = 0; t < nt; t += 2) {
            const bool last = (t == nt - 2);
            const char* a1 = cA + (size_t)(t + 1) * kstep;
            const char* a2 = last ? nA : cA + (size_t)(t + 2) * kstep; const char* b2 = last ? nB : cB + (size_t)(t + 2) * kstep;
            const char* a3 = a2 + kstep; const char* b3 = b2 + kstep;
            if (last && has_next) S.a_ready(nxt);
            PG8_LDB(B0, 0, 0); PG8_SCHED; PG8_LDA(At, 0, 0); PG8_STAGE(PG8_SA(1, 1), a1 + hstepA, voffA);
            PG8_WAIT_L(8); PG8_BAR; PG8_WAIT_L(0); PG8_MMA(0, 0, At, B0); PG8_BAR; PG8_SCHED;
            PG8_LDB(B1, 0, 1); PG8_STAGE(PG8_SB(0, 0), b2, voffB);
            PG8_BAR; PG8_WAIT_L(0); PG8_MMA(0, 1, At, B1); PG8_BAR;
            PG8_LDA(At, 0, 1); PG8_STAGE(PG8_SA(0, 0), a2, voffA);
            PG8_BAR; PG8_WAIT_L(0); PG8_MMA(1, 0, At, B0); PG8_BAR; PG8_SCHED;
            PG8_STAGE(PG8_SB(0, 1), b2 + hstepB, voffB);
            PG8_WAIT_V(6); PG8_BAR; PG8_MMA(1, 1, At, B1); PG8_BAR;
            PG8_LDB(B0, 1, 0); PG8_SCHED; PG8_LDA(At, 1, 0); PG8_STAGE(PG8_SA(0, 1), a2 + hstepA, voffA);
            PG8_WAIT_L(8); PG8_BAR; PG8_WAIT_L(0); PG8_MMA(0, 0, At, B0); PG8_BAR; PG8_SCHED;
            PG8_LDB(B1, 1, 1); PG8_STAGE(PG8_SB(1, 0), b3, voffB);
            PG8_BAR; PG8_WAIT_L(0); PG8_MMA(0, 1, At, B1); PG8_BAR;
            PG8_LDA(At, 1, 1); PG8_STAGE(PG8_SA(1, 0), a3, voffA);
            PG8_BAR; PG8_WAIT_L(0); PG8_MMA(1, 0, At, B0); PG8_BAR; PG8_SCHED;
            PG8_STAGE(PG8_SB(1, 1), b3 + hstepB, voffB);
            PG8_WAIT_V(6); PG8_BAR; PG8_MMA(1, 1, At, B1); PG8_BAR;
        }
        PG8_STAMP();
        if constexpr (!Epi::AFTER_DRAIN) { E(acc, cur, wr, wc, fr, fq); S.done(cur); }
        PG8_STAMP();
        if (!has_next) break;
#pragma unroll
        for (int a = 0; a < 2; ++a)
#pragma unroll
            for (int b = 0; b < 2; ++b)
#pragma unroll
                for (int m = 0; m < 4; ++m)
#pragma unroll
                    for (int n = 0; n < 2; ++n) acc[a][b][m][n] = (f32x4){0.f, 0.f, 0.f, 0.f};
        cur = nxt; cA = nA; cB = nB; ++ui;
    }
    PG8_WAIT_V(0);
    if (wr == 0) PG8_BAR;
    PG8_BAR;
    if constexpr (Epi::AFTER_DRAIN) { E.fused(acc, cur, wr, wc, fr, fq, lds, wid, lane); S.done(cur); }
    PG8_STAMP();
    if (STAMP && wid == 0) { stamps[lane] = lane < nts ? (((unsigned long long)(unsigned)ts_hi << 32) | (unsigned)ts_lo) : 0ull;
        if (lane == 62) stamps[62] = rt_entry; if (lane == 63) stamps[63] = (unsigned long long)wall_clock64(); }
#undef PG8_STAMP
#undef PG8_SA
#undef PG8_SB
#undef PG8_STAGE
#undef PG8_LDA
#undef PG8_LDB
#undef PG8_MMA
#undef PG8_WAIT_V
#undef PG8_WAIT_L
#undef PG8_BAR
#undef PG8_SCHED
}
}

DI int rowmap(int n, int mode) { return mode == 0 ? n : ((n >> 4) * 32 + (n & 15) + (mode == 2 ? 16 : 0)); }
DI void tconv_tile(const Ctx& c, const float* src, int ld, int N, bf16_t* dst, int ld_dst, int mode, int tk, int tn) {
    bf16_t* T = (bf16_t*)c.smem;
    const int k0 = tk * 64, n0 = tn * 64, tid = c.tid;
    __syncthreads();
#pragma unroll
    for (int i = 0; i < 2; ++i) {
        const int kk = (tid >> 4) + i * 32, n4 = (tid & 15) * 4;
        float4 v = make_float4(0.f, 0.f, 0.f, 0.f);
        if (n0 + n4 < N) v = *(const float4*)(src + (size_t)(k0 + kk) * ld + n0 + n4);
        T[(n4 + 0) * 72 + kk] = f2bf(v.x); T[(n4 + 1) * 72 + kk] = f2bf(v.y); T[(n4 + 2) * 72 + kk] = f2bf(v.z); T[(n4 + 3) * 72 + kk] = f2bf(v.w);
    }
    __syncthreads();
    const int n = tid >> 3, k8 = (tid & 7) * 8;
    if (n0 + n < N) *(u32x4*)(dst + (size_t)rowmap(n0 + n, mode) * ld_dst + k0 + k8) = *(const u32x4*)(T + n * 72 + k8);
}
DI void tconv(const Ctx& c, const float* src, int ld, int K, int N, bf16_t* dst, int ld_dst, int mode, int rot) {
    const int ntk = K / 64, ntn = (N + 63) / 64, nt = ntk * ntn, G = gridDim.x;
    for (int t = (blockIdx.x + G - (rot % G)) % G; t < nt; t += G) tconv_tile(c, src, ld, N, dst, ld_dst, mode, t / ntn, t % ntn);
}

DI void wconv(const Ctx& c, const float* src, int ld, int K, int N, bf16_t* dst, int ld_dst, int rot) {
    const int ntk = K / 64, ntn = (N + 63) / 64, nt = ntk * ntn, GW = gridDim.x * 8, w0 = blockIdx.x * 8 + c.wave;
    for (int t = (w0 + GW - (rot % GW)) % GW; t < nt; t += GW) {
        const int tk = t / ntn, tn = t % ntn, n = tn * 64 + c.lane;
        if (n < N) {
            const float* sp = src + (size_t)(tk * 64) * ld + n; bf16_t* dp = dst + (size_t)n * ld_dst + tk * 64;
#pragma unroll
            for (int kb = 0; kb < 8; ++kb) {
                float v[8];
#pragma unroll
                for (int j = 0; j < 8; ++j) v[j] = sp[(size_t)(kb * 8 + j) * ld];
                u32x4 w4; w4.x = pack2(v[0], v[1]); w4.y = pack2(v[2], v[3]); w4.z = pack2(v[4], v[5]); w4.w = pack2(v[6], v[7]);
                *(u32x4*)(dp + kb * 8) = w4;
            }
        }
    }
}
DI void phase_prologue(const Ctx& c) {
    unsigned char* wsm = c.ws + WS_WSM;
    const int tid = c.tid, G = gridDim.x, gtid = blockIdx.x * NTHR + tid, gn = G * NTHR;
    {
        const float4* x = (const float4*)c.in[0]; const float4* cx = (const float4*)c.in[2]; float4* H = (float4*)(c.ws + WS_H);
        for (size_t i = gtid; i < (size_t)NZ * 256; i += gn) {
            const int z = (int)(i >> 8), q = (int)(i & 255), b = z / TZ, s = z % TZ;
            H[i] = (s < CTX) ? cx[((size_t)b * CTX + s) * 256 + q] : x[((size_t)b * SEQ + (s - CTX)) * 256 + q];
        }
    }
    {
        float* rope = (float*)(wsm + OFF_ROPE);
        for (int i = gtid; i < SEQ * 16; i += gn) {
            const int t = i >> 4, a = (i >> 3) & 1, f = i & 7;
            const float pos = (float)(a == 0 ? (t >> 6) : (t & 63));
            const float inv = powf(10000.f, -(float)f / 8.f);
            float sn, cs; sincosf(pos * inv, &sn, &cs);
            rope[i * 2] = cs; rope[i * 2 + 1] = sn;
        }
    }
    {
        float* s5t = (float*)(wsm + OFF_S5T);
        for (int i = gtid; i < NL * 2 * 16 * 64; i += gn) {
            const int ldg = i >> 6;
            const double lr = c.in[24][i], li = c.in[25][i], dt = exp((double)c.in[26][ldg]);
            const double mag = exp(lr * dt), are = mag * cos(li * dt), aim = mag * sin(li * dt);
            const double m256 = exp(lr * dt * 64.0), a256r = m256 * cos(li * dt * 64.0), a256i = m256 * sin(li * dt * 64.0);
            const double den = lr * lr + li * li, nr = are - 1.0, ni = aim;
            const double cfr = (nr * lr + ni * li) / den, cfi = (ni * lr - nr * li) / den;
            float* o = s5t + (size_t)i * 36;
            o[0] = (float)are; o[1] = (float)aim; o[2] = (float)a256r; o[3] = (float)a256i;
            for (int ch = 0; ch < 16; ++ch) {
                const double br = c.in[27][(size_t)i * 16 + ch], bi = c.in[28][(size_t)i * 16 + ch];
                o[4 + ch] = (float)(cfr * br - cfi * bi); o[20 + ch] = (float)(cfr * bi + cfi * br);
            }
        }
    }
    {
        float* rwt = (float*)(wsm + OFF_RWT);
        for (int i = gtid; i < NL * 36 * 1024; i += gn) {
            const int l = i / (36 * 1024), e = (i / 1024) % 36, d = i & 1023;
            rwt[i] = e < 4 ? c.in[41][((size_t)l * 1024 + d) * 4 + e] : c.in[43][((size_t)l * 1024 + d) * 32 + (e - 4)];
        }
    }
    if (blockIdx.x == 0 && tid < NL) {
        float s1 = 0.f, s2 = 0.f;
        for (int i = 0; i < 32; ++i) { s1 += c.in[34][tid * 32 + i] * c.in[35][tid * 32 + i]; s2 += c.in[36][tid * 32 + i] * c.in[37][tid * 32 + i]; }
        ((float*)(wsm + OFF_LAM))[tid] = expf(s1) - expf(s2) + (0.8f - 0.6f * expf(-0.3f * (float)tid));
    }
    {
        float* sv = (float*)c.smem;
        float* red = sv + 3 * 1024;
        __syncthreads();
        for (int i = tid; i < 3 * 1024; i += NTHR) { const float v = i < 2048 ? c.in[1][i] : c.in[3][i - 2048]; sv[i] = siluf_(v); }
        __syncthreads();
        float* modv = (float*)(wsm + OFF_MODV);
        for (int u = blockIdx.x; u < NL * 96; u += G) {
            const int l = u / 96, col = (u % 96) * 64 + (tid & 63), ks = tid >> 6;
            const float* w = c.in[4] + (size_t)l * 1024 * 6144 + col;
            float a0 = 0.f, a1 = 0.f, a2 = 0.f;
            for (int k = ks * 128; k < ks * 128 + 128; ++k) { const float wv = w[(size_t)k * 6144]; a0 += sv[k] * wv; a1 += sv[1024 + k] * wv; a2 += sv[2048 + k] * wv; }
            red[(ks * 64 + (tid & 63)) * 3 + 0] = a0; red[(ks * 64 + (tid & 63)) * 3 + 1] = a1; red[(ks * 64 + (tid & 63)) * 3 + 2] = a2;
            __syncthreads();
            if (tid < 192) {
                const int cc = tid & 63, sel = tid >> 6; float s = 0.f;
                for (int k2 = 0; k2 < 8; ++k2) s += red[(k2 * 64 + cc) * 3 + sel];
                const int colo = (u % 96) * 64 + cc;
                modv[((size_t)l * 3 + sel) * 6144 + colo] = s + c.in[5][l * 6144 + colo];
            }
            __syncthreads();
        }
    }
    for (int l = 0; l < NL; ++l) {
        wconv(c, c.in[8] + (size_t)l * 1024 * NIN, NIN, 1024, NIN, (bf16_t*)(wsm + OFF_WINT + l * SZ_WINT), 1024, l * 700);
        tconv(c, c.in[11] + (size_t)l * 256 * 384, 384, 256, 384, (bf16_t*)(wsm + OFF_WUQT + l * SZ_WUQT), 256, 0, 40);
        tconv(c, c.in[12] + (size_t)l * 128 * 512, 512, 128, 512, (bf16_t*)(wsm + OFF_WUKVT + l * SZ_WUKVT), 128, 0, 70);
        for (int d = 0; d < 2; ++d) {
            tconv(c, c.in[15] + (size_t)(l * 2 + d) * 64 * 256, 256, 64, 256, (bf16_t*)(wsm + OFF_W2T + l * SZ_W2T) + d * 256 * 64, 64, 0, 90 + d * 8);
            tconv(c, c.in[17] + (size_t)(l * 2 + d) * 64 * 256, 256, 64, 256, (bf16_t*)(wsm + OFF_A2T + l * SZ_A2T) + d * 256 * 64, 64, 0, 110 + d * 8);
        }
        tconv(c, c.in[18] + (size_t)l * 128 * 256, 256, 128, 256, (bf16_t*)(wsm + OFF_G2T + l * SZ_G2T), 128, 0, 130);
        tconv(c, c.in[32] + (size_t)l * 256 * 256, 256, 256, 256, (bf16_t*)(wsm + OFF_GLUT + l * SZ_GLUT), 256, 0, 140);
        for (int n = 0; n < 4; ++n)
            wconv(c, c.in[39] + (size_t)(l * 4 + n) * 256 * 1024, 1024, 256, 1024, (bf16_t*)(wsm + OFF_WBT + l * SZ_WBT) + n * 256, 1024, 300 + n * 64 + l * 1000);
        wconv(c, c.in[40] + (size_t)l * 1024 * 1024, 1024, 1024, 1024, (bf16_t*)(wsm + OFF_WOUTT + l * SZ_WOUTT), 1024, 1200 + l * 400);
    }
}

DI void phase_expert_convert(const Ctx& c, int l) {
    const int G = gridDim.x, lane = c.lane;
    for (int t = blockIdx.x * 8 + c.wave; t < 32 * 384; t += G * 8) {
        const int e = t / 384, r = t % 384;
        const float* src; bf16_t* dst; int ld, ldd, mode, tk, tn;
        if (r < 128)      { src = c.in[45] + ((size_t)l * 32 + e) * 1024 * 512; dst = (bf16_t*)(c.ws + WS_EXPW + (size_t)e * SZ_WGU); ld = 512; ldd = 1024; mode = 1; tk = r / 8; tn = r % 8; }
        else if (r < 256) { src = c.in[46] + ((size_t)l * 32 + e) * 1024 * 512; dst = (bf16_t*)(c.ws + WS_EXPW + (size_t)e * SZ_WGU); ld = 512; ldd = 1024; mode = 2; tk = (r - 128) / 8; tn = (r - 128) % 8; }
        else              { src = c.in[47] + ((size_t)l * 32 + e) * 512 * 1024; dst = (bf16_t*)(c.ws + WS_EXPW + 32 * SZ_WGU + (size_t)e * SZ_WD); ld = 1024; ldd = 512; mode = 0; tk = (r - 256) / 16; tn = (r - 256) % 16; }
        const int n = tn * 64 + lane; const float* sp = src + (size_t)(tk * 64) * ld + n; bf16_t* dp = dst + (size_t)rowmap(n, mode) * ldd + tk * 64;
#pragma unroll
        for (int kb = 0; kb < 8; ++kb) {
            float v[8];
#pragma unroll
            for (int j = 0; j < 8; ++j) v[j] = sp[(size_t)(kb * 8 + j) * ld];
            u32x4 w4; w4.x = pack2(v[0], v[1]); w4.y = pack2(v[2], v[3]); w4.z = pack2(v[4], v[5]); w4.w = pack2(v[6], v[7]);
            *(u32x4*)(dp + kb * 8) = w4;
        }
    }
}

DI void phase_norm1(const Ctx& c, int l) {
    const float* modv = (const float*)(c.ws + WS_WSM + OFF_MODV);
    float* H = (float*)(c.ws + WS_H); const bf16_t* Y = (const bf16_t*)(c.ws + WS_P);
    bf16_t* XN = (bf16_t*)(c.ws + WS_BUFA);
    const float* g1 = c.in[6] + l * 1024;
    for (int row = blockIdx.x * 8 + c.wave; row < NZ; row += gridDim.x * 8) {
        const int b = row / TZ, s = row % TZ, sel = s < CTX ? 2 : b;
        float4 v[4]; float ss = 0.f;
#pragma unroll
        for (int q = 0; q < 4; ++q) {
            const int col = q * 256 + c.lane * 4;
            v[q] = *(const float4*)(H + (size_t)row * D + col);
            if (l > 0) {
                float ya[4], yb[4]; unpack4(*(const u32x2*)(Y + (size_t)row * D + col), ya); unpack4(*(const u32x2*)(Y + ((size_t)NZ + row) * D + col), yb);
                const float4 m5 = *(const float4*)(modv + ((size_t)(l - 1) * 3 + sel) * 6144 + 5 * 1024 + col);
                v[q].x += m5.x * (ya[0] + yb[0]); v[q].y += m5.y * (ya[1] + yb[1]); v[q].z += m5.z * (ya[2] + yb[2]); v[q].w += m5.w * (ya[3] + yb[3]);
                *(float4*)(H + (size_t)row * D + col) = v[q];
            }
            ss += v[q].x * v[q].x + v[q].y * v[q].y + v[q].z * v[q].z + v[q].w * v[q].w;
        }
        ss = wave_sum(ss);
        const float rs = rsqrtf(ss * (1.f / 1024.f) + 1e-6f);
#pragma unroll
        for (int q = 0; q < 4; ++q) {
            const int col = q * 256 + c.lane * 4;
            const float4 g = *(const float4*)(g1 + col), m0 = *(const float4*)(modv + ((size_t)l * 3 + sel) * 6144 + col), m1 = *(const float4*)(modv + ((size_t)l * 3 + sel) * 6144 + 1024 + col);
            *(u32x2*)(XN + (size_t)row * D + col) = pack4(v[q].x * rs * g.x * (1.f + m1.x) + m0.x, v[q].y * rs * g.y * (1.f + m1.y) + m0.y,
                                                          v[q].z * rs * g.z * (1.f + m1.z) + m0.z, v[q].w * rs * g.w * (1.f + m1.w) + m0.w);
        }
    }
}

DI void phase_final(const Ctx& c) {
    const float* modv = (const float*)(c.ws + WS_WSM + OFF_MODV);
    const float* H = (const float*)(c.ws + WS_H); const bf16_t* Y = (const bf16_t*)(c.ws + WS_P);
    const float* g = c.in[48];
    for (int r = blockIdx.x * 8 + c.wave; r < NB * SEQ; r += gridDim.x * 8) {
        const int b = r / SEQ, t = r % SEQ, row = b * TZ + CTX + t;
        float4 v[4]; float ss = 0.f;
#pragma unroll
        for (int q = 0; q < 4; ++q) {
            const int col = q * 256 + c.lane * 4;
            v[q] = *(const float4*)(H + (size_t)row * D + col);
            float ya[4], yb[4]; unpack4(*(const u32x2*)(Y + (size_t)row * D + col), ya); unpack4(*(const u32x2*)(Y + ((size_t)NZ + row) * D + col), yb);
            const float4 m5 = *(const float4*)(modv + ((size_t)(NL - 1) * 3 + b) * 6144 + 5 * 1024 + col);
            v[q].x += m5.x * (ya[0] + yb[0]); v[q].y += m5.y * (ya[1] + yb[1]); v[q].z += m5.z * (ya[2] + yb[2]); v[q].w += m5.w * (ya[3] + yb[3]);
            ss += v[q].x * v[q].x + v[q].y * v[q].y + v[q].z * v[q].z + v[q].w * v[q].w;
        }
        ss = wave_sum(ss);
        const float rs = rsqrtf(ss * (1.f / 1024.f) + 1e-6f);
#pragma unroll
        for (int q = 0; q < 4; ++q) {
            const int col = q * 256 + c.lane * 4; const float4 gg = *(const float4*)(g + col);
            *(float4*)(c.out + (size_t)r * D + col) = make_float4(v[q].x * rs * gg.x, v[q].y * rs * gg.y, v[q].z * rs * gg.z, v[q].w * rs * gg.w);
        }
    }
}

struct EpiInproj {
    static constexpr bool PERM = true, AFTER_DRAIN = false;
    bf16_t *PM, *PS, *PR, *PD, *GT;
    DI void operator()(const pg8::f32x4 (&acc)[2][2][4][2], const pg8::Unit& u, int wr, int wc, int fr, int fq) const {
        const int row0 = u.pm * 256 + wr * 64 + fr, col0 = u.pn * 256 + wc * 32 + 8 * fq;
#pragma unroll
        for (int bj = 0; bj < 2; ++bj) {
            const int col = col0 + bj * 128;
            bf16_t* dst; int ld, cc; bool gate = false;
            if (col < 416) { dst = PM; ld = 416; cc = col; }
            else if (col < 1440) { dst = PR; ld = 1024; cc = col - 416; }
            else if (col < 1696) { dst = PS; ld = 256; cc = col - 1440; }
            else if (col < 2464) { dst = PD; ld = 768; cc = col - 1696; }
            else if (col < NIN) { dst = GT; ld = 4096; cc = col - 2464; gate = true; }
            else continue;
#pragma unroll
            for (int ai = 0; ai < 2; ++ai)
#pragma unroll
                for (int m = 0; m < 4; ++m) {
                    const int row = row0 + ai * 128 + m * 16; pg8::f32x4 v0 = acc[ai][bj][m][0], v1 = acc[ai][bj][m][1];
                    if (gate) { v0[0] = sigmoidf_(v0[0]); v0[1] = sigmoidf_(v0[1]); v0[2] = sigmoidf_(v0[2]); v0[3] = sigmoidf_(v0[3]);
                                v1[0] = sigmoidf_(v1[0]); v1[1] = sigmoidf_(v1[1]); v1[2] = sigmoidf_(v1[2]); v1[3] = sigmoidf_(v1[3]); }
                    u32x4 w; w.x = pack2(v0[0], v0[1]); w.y = pack2(v0[2], v0[3]); w.z = pack2(v1[0], v1[1]); w.w = pack2(v1[2], v1[3]);
                    *(u32x4*)(dst + (size_t)row * ld + cc) = w;
                }
        }
    }
};
DI void phase_inproj(const Ctx& c, int l) {
    EpiInproj E; E.PM = (bf16_t*)(c.ws + WS_P + P_PM); E.PS = (bf16_t*)(c.ws + WS_P + P_PS); E.PR = (bf16_t*)(c.ws + WS_P + P_PR); E.PD = (bf16_t*)(c.ws + WS_P + P_PD); E.GT = (bf16_t*)(c.ws + WS_GT);
    pg8::Gemm g{(const bf16_t*)(c.ws + WS_BUFA), (const bf16_t*)(c.ws + WS_WSM + OFF_WINT + l * SZ_WINT), NZ, NINP, 1024, 1024, 1024};
    pg8::StaticOrder S; S.init(NZ, NINP, (int)gridDim.x, (int)blockIdx.x);
    __syncthreads();
    pg8::gemm_phase<EpiInproj, pg8::StaticOrder, false>((PG8_LAS unsigned char*)c.smem, g, S, E, nullptr, c.tid);
}

DI void phase_prep(const Ctx& c, int l) {
    unsigned char* ws = c.ws; const int lane = c.lane, wave = c.wave, tid = c.tid;
    const bf16_t* PM = (const bf16_t*)(ws + WS_P + P_PM); const bf16_t* PR = (const bf16_t*)(ws + WS_P + P_PR); const bf16_t* PD = (const bf16_t*)(ws + WS_P + P_PD);
    bf16_t* CQN = (bf16_t*)(ws + WS_MISC + MS_CQN); bf16_t* TW = (bf16_t*)(ws + WS_MISC + MS_TW); bf16_t* AL = (bf16_t*)(ws + WS_MISC + MS_AL); bf16_t* SG = (bf16_t*)(ws + WS_MISC + MS_SG);
    bf16_t* KM = (bf16_t*)(ws + WS_EXPW + MX_KM); bf16_t* QD = (bf16_t*)(ws + WS_EXPW + MX_QD); bf16_t* KD_ = (bf16_t*)(ws + WS_EXPW + MX_KD); bf16_t* VDT = (bf16_t*)(ws + WS_EXPW + MX_VDT);
    bf16_t* RB = (bf16_t*)(ws + WS_EXPW + MX_RB); bf16_t* KB = (bf16_t*)(ws + WS_EXPW + MX_KB); bf16_t* VB = (bf16_t*)(ws + WS_EXPW + MX_VB); bf16_t* KKB = (bf16_t*)(ws + WS_EXPW + MX_KKB);
    const float* rope = (const float*)(ws + WS_WSM + OFF_ROPE);
    const float* gq = c.in[9] + l * 256; const float* gkv = c.in[10] + l * 128; const float* mu = c.in[13] + l * 1024; const float* k_k = c.in[19] + l * 256;
    bf16_t* Vs = (bf16_t*)c.smem;
    const float qsc = 0.17677669529663687f * LOG2E;
    for (int tile = blockIdx.x; tile < NZ / 64; tile += gridDim.x) {
        __syncthreads();
        for (int i = 0; i < 8; ++i) {
            const int rt = wave * 8 + i, z = tile * 64 + rt, b = z / TZ, s = z % TZ; const bool lat = s >= CTX; const int tl = lat ? s - CTX : 0;
            {
                const bf16_t* pm = PM + (size_t)z * 416;
                float x[4]; unpack4(*(const u32x2*)(pm + lane * 4), x);
                float ss = wave_sum(x[0] * x[0] + x[1] * x[1] + x[2] * x[2] + x[3] * x[3]);
                float rs = rsqrtf(ss * (1.f / 256.f) + 1e-6f);
                const float4 g = *(const float4*)(gq + lane * 4);
                *(u32x2*)(CQN + (size_t)z * 384 + lane * 4) = pack4(x[0] * rs * g.x, x[1] * rs * g.y, x[2] * rs * g.z, x[3] * rs * g.w);
                const unsigned u2 = *(const unsigned*)(pm + 256 + lane * 2); const float y0 = lo2f(u2), y1 = hi2f(u2);
                ss = wave_sum(y0 * y0 + y1 * y1); rs = rsqrtf(ss * (1.f / 128.f) + 1e-6f);
                const float2 g2 = *(const float2*)(gkv + lane * 2);
                *(unsigned*)(CQN + (size_t)z * 384 + 256 + lane * 2) = pack2(y0 * rs * g2.x, y1 * rs * g2.y);
                float kr = bf2f(pm[384 + (lane & 31)]);
                const float pr = __shfl_xor(kr, 8, 64);
                if (lat) { const float* cs = rope + ((size_t)tl * 16 + ((lane & 31) >> 4) * 8 + (lane & 7)) * 2; kr = kr * cs[0] + ((lane & 8) ? pr : -pr) * cs[1]; }
                if (lane < 32) {
                    const bf16_t kv = f2bf(kr);
#pragma unroll
                    for (int h = 0; h < 4; ++h) KM[((size_t)(b * 4 + h) * TZ + s) * 96 + 64 + lane] = kv;
                }
            }
            {
                const bf16_t* pd = PD + (size_t)z * 768;
                const int i0 = lane * 4, hh = i0 >> 6, ii = i0 & 31, nn = (i0 >> 5) & 1;
                const float* cs = rope + ((size_t)tl * 16 + (ii >> 4) * 8 + (ii & 7)) * 2;
                const bool hi = (ii & 8) != 0;
#pragma unroll
                for (int w = 0; w < 2; ++w) {
                    float x[4]; unpack4(*(const u32x2*)(pd + w * 256 + i0), x);
                    float o[4];
#pragma unroll
                    for (int j = 0; j < 4; ++j) {
                        const float p = __shfl_xor(x[j], 2, 64);
                        o[j] = lat ? (x[j] * cs[2 * j] + (hi ? p : -p) * cs[2 * j + 1]) : x[j];
                        if (w == 0) o[j] *= qsc;
                    }
                    bf16_t* dst = (w == 0 ? QD : KD_) + ((size_t)(b * 4 + hh) * TZ + s) * 64 + nn * 32 + ii;
                    *(u32x2*)dst = pack4(o[0], o[1], o[2], o[3]);
                }
                *(u32x2*)(Vs + rt * 264 + i0) = *(const u32x2*)(pd + 512 + i0);
            }
            {
                const bf16_t* pr = PR + (size_t)z * 1024;
                const bool hp = (s != 0) && (s != CTX), hn = (s != CTX - 1) && (s != TZ - 1);
#pragma unroll
                for (int q = 0; q < 4; ++q) {
                    const int col = q * 256 + lane * 4;
                    float cu[4], pv[4] = {0.f, 0.f, 0.f, 0.f}, nx[4] = {0.f, 0.f, 0.f, 0.f};
                    unpack4(*(const u32x2*)(pr + col), cu);
                    if (hp) unpack4(*(const u32x2*)(pr - 1024 + col), pv);
                    if (hn) unpack4(*(const u32x2*)(pr + 1024 + col), nx);
                    const float4 m = *(const float4*)(mu + col);
                    float zv[4];
                    zv[0] = cu[0] + (0.5f * (pv[0] + nx[0]) - cu[0]) * m.x; zv[1] = cu[1] + (0.5f * (pv[1] + nx[1]) - cu[1]) * m.y;
                    zv[2] = cu[2] + (0.5f * (pv[2] + nx[2]) - cu[2]) * m.z; zv[3] = cu[3] + (0.5f * (pv[3] + nx[3]) - cu[3]) * m.w;
                    if (q == 0) *(u32x2*)(RB + (size_t)z * 256 + lane * 4) = pack4(zv[0], zv[1], zv[2], zv[3]);
                    else if (q == 1) {
                        *(u32x2*)(KB + (size_t)z * 256 + lane * 4) = pack4(zv[0], zv[1], zv[2], zv[3]);
                        const float4 kk4 = *(const float4*)(k_k + lane * 4);
                        const float a0 = zv[0] * kk4.x, a1 = zv[1] * kk4.y, a2 = zv[2] * kk4.z, a3 = zv[3] * kk4.w;
                        const float ssq = sum16(a0 * a0 + a1 * a1 + a2 * a2 + a3 * a3);
                        const float inv = 1.f / fmaxf(sqrtf(ssq), 1e-12f);
                        *(u32x2*)(KKB + (size_t)z * 256 + lane * 4) = pack4(a0 * inv, a1 * inv, a2 * inv, a3 * inv);
                    } else if (q == 2) *(u32x2*)(VB + (size_t)z * 256 + lane * 4) = pack4(zv[0], zv[1], zv[2], zv[3]);
                    else {
                        if (lane < 16) *(u32x2*)(TW + (size_t)z * 64 + lane * 4) = pack4(tanhf(zv[0]), tanhf(zv[1]), tanhf(zv[2]), tanhf(zv[3]));
                        else if (lane < 32) *(u32x2*)(AL + (size_t)z * 64 + (lane - 16) * 4) = pack4(zv[0], zv[1], zv[2], zv[3]);
                        else *(u32x2*)(SG + (size_t)z * 128 + (lane - 32) * 4) = pack4(sigmoidf_(zv[0]), sigmoidf_(zv[1]), sigmoidf_(zv[2]), sigmoidf_(zv[3]));
                    }
                }
            }
        }
        __syncthreads();
        {
            const int z0 = tile * 64, b = z0 / TZ, s0 = z0 % TZ;
#pragma unroll
            for (int i = 0; i < 4; ++i) {
                const int ch = tid + i * NTHR, dv = ch >> 3, r8 = (ch & 7) * 8;
                bf16_t v[8];
#pragma unroll
                for (int j = 0; j < 8; ++j) v[j] = Vs[(r8 + j) * 264 + dv];
                u32x4 o; o.x = v[0] | ((unsigned)v[1] << 16); o.y = v[2] | ((unsigned)v[3] << 16); o.z = v[4] | ((unsigned)v[5] << 16); o.w = v[6] | ((unsigned)v[7] << 16);
                *(u32x4*)(VDT + ((size_t)(b * 4 + (dv >> 6)) * 64 + (dv & 63)) * TZ + s0 + r8) = o;
            }
        }
    }
}

constexpr int S5C = 64, S5N = TZ / S5C, S5NC = CTX / S5C;
DI int s5_tok(int dir, int i) { return dir == 0 ? i : (i < CTX ? CTX - 1 - i : TZ - 1 - (i - CTX)); }
DI void s5_stage_u(const Ctx& c, float* U, int b, int dir, int chunk, int g0, int ng) {
    const bf16_t* PS = (const bf16_t*)(c.ws + WS_P + P_PS);
    const int per = ng * 4;
    for (int e = c.tid; e < S5C * per; e += NTHR) {
        const int i = e / per, c4 = (e % per) * 4, s = s5_tok(dir, chunk * S5C + i);
        float x[4]; unpack4(*(const u32x2*)(PS + (size_t)(b * TZ + s) * 256 + g0 * 16 + c4), x);
        *(float4*)(U + i * (ng * 16) + c4) = make_float4(x[0], x[1], x[2], x[3]);
    }
}
DI void phase_s5_local(const Ctx& c, int l) {
    float* U = (float*)c.smem;
    const float* s5t = (const float*)(c.ws + WS_WSM + OFF_S5T);
    float* E = (float*)(c.ws + WS_WSM + OFF_S5E);
    for (int u = blockIdx.x; u < 2 * 2 * S5N * 2; u += gridDim.x) {
        const int gq = u & 1, chunk = (u >> 1) % S5N, dir = (u / (2 * S5N)) & 1, b = u / (4 * S5N);
        __syncthreads();
        s5_stage_u(c, U, b, dir, chunk, gq * 8, 8);
        __syncthreads();
        const int g = gq * 8 + c.wave, p = c.lane;
        const float* tb = s5t + ((size_t)((l * 2 + dir) * 16 + g) * 64 + p) * 36;
        const float are = tb[0], aim = tb[1];
        float br[16], bi[16];
#pragma unroll
        for (int ch = 0; ch < 16; ++ch) { br[ch] = tb[4 + ch]; bi[ch] = tb[20 + ch]; }
        float xr = 0.f, xi = 0.f;
        for (int i = 0; i < S5C; ++i) {
            const float* uu = U + i * 128 + c.wave * 16;
            float sr = 0.f, si = 0.f;
#pragma unroll
            for (int q = 0; q < 4; ++q) { const float4 v = *(const float4*)(uu + q * 4);
                sr += br[q * 4] * v.x + br[q * 4 + 1] * v.y + br[q * 4 + 2] * v.z + br[q * 4 + 3] * v.w;
                si += bi[q * 4] * v.x + bi[q * 4 + 1] * v.y + bi[q * 4 + 2] * v.z + bi[q * 4 + 3] * v.w; }
            const float nr = are * xr - aim * xi + sr, ni = are * xi + aim * xr + si; xr = nr; xi = ni;
        }
        *(float2*)(E + ((size_t)(((b * 2 + dir) * 16 + g) * S5N + chunk) * 64 + p) * 2) = make_float2(xr, xi);
    }
}
DI void phase_s5_carry(const Ctx& c, int l) {
    const int gt = blockIdx.x * NTHR + c.tid;
    if (gt < 2 * 2 * 16 * 64) {
        const int p = gt & 63, g = (gt >> 6) & 15, dir = (gt >> 10) & 1, b = gt >> 11;
        const float* tb = (const float*)(c.ws + WS_WSM + OFF_S5T) + ((size_t)((l * 2 + dir) * 16 + g) * 64 + p) * 36;
        const float ar = tb[2], ai = tb[3];
        const float* E = (const float*)(c.ws + WS_WSM + OFF_S5E) + (size_t)(((b * 2 + dir) * 16 + g) * S5N) * 128;
        float* C = (float*)(c.ws + WS_WSM + OFF_S5C) + (size_t)(((b * 2 + dir) * 16 + g) * S5N) * 128;
        float xr = 0.f, xi = 0.f;
        for (int ch = 0; ch < S5N; ++ch) {
            const float2 e = *(const float2*)(E + ch * 128 + p * 2);
            *(float2*)(C + ch * 128 + p * 2) = make_float2(xr, xi);
            const float nr = ar * xr - ai * xi + e.x, ni = ar * xi + ai * xr + e.y; xr = nr; xi = ni;
        }
    }
}

constexpr int S5_US = 0, S5_YS = 8192, S5_WV = S5_YS + 2 * 64 * 64 * 4;
template <bool LOCAL>
DI void phase_s5_final_unit(const Ctx& c, int l, int u) {
    unsigned char* L = c.smem;
    const float* s5t = (const float*)(c.ws + WS_WSM + OFF_S5T);
    const float* CIN = (const float*)(c.ws + WS_WSM + OFF_S5C);
    const bf16_t* PS = (const bf16_t*)(c.ws + WS_P + P_PS);
    const int gq = u & 3, ct = (u >> 2) % S5N, b = u / (4 * S5N);
    const int wave = c.wave, lane = c.lane, gl = wave >> 1, dir = wave & 1, g = gq * 4 + gl, n16 = lane & 15, q4 = lane >> 4;
    __syncthreads();
    {
        const int t = c.tid >> 3, part = c.tid & 7;
        *(u32x4*)(L + S5_US + t * 128 + part * 16) = *(const u32x4*)(PS + (size_t)(b * TZ + ct * S5C + t) * 256 + gq * 64 + part * 8);
    }
    const float* tbase = s5t + ((size_t)((l * 2 + dir) * 16 + g) * 64) * 36;
    bf16x8 bfr[8], cfr[4];
#pragma unroll
    for (int j = 0; j < 8; ++j) {
        const int pp = 16 * j + n16, p = pp & 63; const float* tb = tbase + (size_t)p * 36 + (pp < 64 ? 4 : 20) + 8 * (q4 & 1);
        u32x4 w4 = {0u, 0u, 0u, 0u};
        if (q4 < 2) { w4.x = pack2(tb[0], tb[1]); w4.y = pack2(tb[2], tb[3]); w4.z = pack2(tb[4], tb[5]); w4.w = pack2(tb[6], tb[7]); }
        bfr[j] = __builtin_bit_cast(bf16x8, w4);
    }
    {
        const float* cre = c.in[29] + ((size_t)((l * 2 + dir) * 16 + g) * 16 + n16) * 64; const float* cim = c.in[30] + ((size_t)((l * 2 + dir) * 16 + g) * 16 + n16) * 64;
#pragma unroll
        for (int s = 0; s < 4; ++s) {
            const int pp = 32 * s + 8 * q4; const float sg = pp < 64 ? 1.f : -1.f; const float* src = (pp < 64 ? cre + pp : cim + (pp - 64));
            u32x4 w4; w4.x = pack2(sg * src[0], sg * src[1]); w4.y = pack2(sg * src[2], sg * src[3]); w4.z = pack2(sg * src[4], sg * src[5]); w4.w = pack2(sg * src[6], sg * src[7]);
            cfr[s] = __builtin_bit_cast(bf16x8, w4);
        }
    }
    const float are = tbase[(size_t)lane * 36], aim = tbase[(size_t)lane * 36 + 1];
    const int cd = dir == 0 ? ct : (ct < S5NC ? S5NC - 1 - ct : S5N + S5NC - 1 - ct);
    float xr = 0.f, xi = 0.f;
    if (!LOCAL) { const float2 ci = *(const float2*)(CIN + ((size_t)(((b * 2 + dir) * 16 + g) * S5N + cd) * 64 + lane) * 2); xr = ci.x; xi = ci.y; }
    const float dsk = c.in[31][(size_t)l * 256 + g * 16 + n16];
    bf16_t* BU = (bf16_t*)(L + S5_WV + wave * 8192); bf16_t* XB = BU + 16 * 128;
    float* YS = (float*)(L + S5_YS) + dir * 64 * 64;
    __syncthreads();
#pragma unroll 1
    for (int sb = 0; sb < 4; ++sb) {
        const int stepA = 16 * sb + n16, tlA = dir == 0 ? stepA : 63 - stepA;
        u32x4 a4 = {0u, 0u, 0u, 0u};
        if (q4 < 2) a4 = *(const u32x4*)(L + S5_US + tlA * 128 + gl * 32 + q4 * 16);
        const bf16x8 af = __builtin_bit_cast(bf16x8, a4);
#pragma unroll
        for (int j = 0; j < 8; ++j) {
            f32x4 acc = {0.f, 0.f, 0.f, 0.f};
            acc = __builtin_amdgcn_mfma_f32_16x16x32_bf16(af, bfr[j], acc, 0, 0, 0);
#pragma unroll
            for (int rr = 0; rr < 4; ++rr) BU[(4 * q4 + rr) * 128 + 16 * j + n16] = f2bf(acc[rr]);
        }
#pragma unroll
        for (int ii = 0; ii < 16; ++ii) {
            const float br = bf2f(BU[ii * 128 + lane]), bi = bf2f(BU[ii * 128 + 64 + lane]);
            const float nr = are * xr - aim * xi + br, ni = are * xi + aim * xr + bi; xr = nr; xi = ni;
            if (!LOCAL) { XB[ii * 128 + lane] = f2bf(xr); XB[ii * 128 + 64 + lane] = f2bf(xi); }
        }
        if (LOCAL) continue;
        f32x4 ya = {0.f, 0.f, 0.f, 0.f};
#pragma unroll
        for (int s = 0; s < 4; ++s) {
            const bf16x8 xf = *(const bf16x8*)((const unsigned char*)XB + n16 * 256 + (32 * s + 8 * q4) * 2);
            ya = __builtin_amdgcn_mfma_f32_16x16x32_bf16(xf, cfr[s], ya, 0, 0, 0);
        }
#pragma unroll
        for (int rr = 0; rr < 4; ++rr) {
            const int step = 16 * sb + 4 * q4 + rr, tl = dir == 0 ? step : 63 - step;
            float y = ya[rr];
            if (dir == 0) y += dsk * bf2f(*(const bf16_t*)(L + S5_US + tl * 128 + (gl * 16 + n16) * 2));
            YS[tl * 64 + gl * 16 + n16] = y;
        }
    }
    if (LOCAL) { *(float2*)((float*)(c.ws + WS_WSM + OFF_S5E) + ((size_t)(((b * 2 + dir) * 16 + g) * S5N + cd) * 64 + lane) * 2) = make_float2(xr, xi); return; }
    __syncthreads();
    bf16_t* ZG = (bf16_t*)(c.ws + WS_MISC + MS_ZG);
    {
        const float* Y0 = (const float*)(L + S5_YS); const float* Y1 = Y0 + 64 * 64;
        for (int e = c.tid; e < 64 * 16; e += NTHR) {
            const int i = e >> 4, c4 = (e & 15) * 4; const float4 y0 = *(const float4*)(Y0 + i * 64 + c4), y1 = *(const float4*)(Y1 + i * 64 + c4);
            *(u32x2*)(ZG + (size_t)(b * TZ + ct * S5C + i) * 256 + gq * 64 + c4) = pack4(gelu_tanh(y0.x + y1.x), gelu_tanh(y0.y + y1.y), gelu_tanh(y0.z + y1.z), gelu_tanh(y0.w + y1.w));
        }
    }
}

DI void phase_small_gemms(const Ctx& c, int l) {
    unsigned char* ws = c.ws; unsigned char* wsm = ws + WS_WSM;
    const bf16_t* CQN = (const bf16_t*)(ws + WS_MISC + MS_CQN);
    const float* rope = (const float*)(wsm + OFF_ROPE);
    constexpr int NMT = NZ / 256;
    int base = 0;
    const int G = gridDim.x, bid = blockIdx.x;
    {
        const bf16_t* W = (const bf16_t*)(wsm + OFF_WUQT + l * SZ_WUQT); bf16_t* QM = (bf16_t*)(ws + WS_EXPW + MX_QM);
        const float qs = 0.10206207261596577f * LOG2E;
        for (int u = (bid + G - base % G) % G; u < NMT * 3; u += G) {
            const int mt = u / 3, nt = u % 3, r0 = mt * 256, c0 = nt * 128;
            gemm_tile<4, 0>(c, 256, [&](int i) { return CQN + (size_t)(r0 + i) * 384; }, [&](int i) { return W + (size_t)(c0 + i) * 256; }, NoHook(),
                [&](f32x4 (&acc)[4][4], int wr, int wc, int fr, int fq) {
#pragma unroll
                    for (int n = 0; n < 4; ++n) {
                        const int col = c0 + wc + n * 16 + fq * 4, h = col / 96, d = col % 96;
                        const bool rp = d >= 64;
#pragma unroll
                        for (int m = 0; m < 4; ++m) {
                            const int row = r0 + wr + m * 16 + fr, b = row / TZ, s = row % TZ; f32x4 v = acc[m][n];
                            f32x4 pv; pv[0] = __shfl_xor(v[0], 32, 64); pv[1] = __shfl_xor(v[1], 32, 64); pv[2] = __shfl_xor(v[2], 32, 64); pv[3] = __shfl_xor(v[3], 32, 64);
                            if (rp && s >= CTX) {
                                const int i0 = d - 64;
                                const float* cs = rope + ((size_t)(s - CTX) * 16 + (i0 >> 4) * 8 + (i0 & 7)) * 2;
                                const bool hi = (i0 & 8) != 0;
#pragma unroll
                                for (int j = 0; j < 4; ++j) v[j] = v[j] * cs[2 * j] + (hi ? pv[j] : -pv[j]) * cs[2 * j + 1];
                            }
                            *(u32x2*)(QM + ((size_t)(b * 4 + h) * TZ + s) * 96 + d) = pack4(v[0] * qs, v[1] * qs, v[2] * qs, v[3] * qs);
                        }
                    }
                });
        }
        base += NMT * 3;
    }
    {
        const bf16_t* W = (const bf16_t*)(wsm + OFF_WUKVT + l * SZ_WUKVT); bf16_t* KM = (bf16_t*)(ws + WS_EXPW + MX_KM); bf16_t* VMT = (bf16_t*)(ws + WS_EXPW + MX_VMT);
        for (int u = (bid + G - base % G) % G; u < NMT * 4; u += G) {
            const int mt = u / 4, nt = u % 4, r0 = mt * 256, c0 = nt * 128;
            gemm_tile<4, 0>(c, 128, [&](int i) { return CQN + (size_t)(r0 + i) * 384 + 256; }, [&](int i) { return W + (size_t)(c0 + i) * 128; }, NoHook(),
                [&](f32x4 (&acc)[4][4], int wr, int wc, int fr, int fq) {
#pragma unroll
                    for (int n = 0; n < 4; ++n) {
                        const int col = c0 + wc + n * 16 + fq * 4, h = col >> 7, d = col & 127;
#pragma unroll
                        for (int m = 0; m < 4; ++m) {
                            const int row = r0 + wr + m * 16 + fr, b = row / TZ, s = row % TZ; const f32x4 v = acc[m][n];
                            if (d < 64) *(u32x2*)(KM + ((size_t)(b * 4 + h) * TZ + s) * 96 + d) = pack4(v[0], v[1], v[2], v[3]);
                            else {
#pragma unroll
                                for (int j = 0; j < 4; ++j) VMT[((size_t)(b * 4 + h) * 64 + (d - 64 + j)) * TZ + s] = f2bf(v[j]);
                            }
                        }
                    }
                });
        }
        base += NMT * 4;
    }
    bf16_t* SE = (bf16_t*)(ws + WS_P + P_PR); bf16_t* SAD = SE + (size_t)2 * NZ * 256; bf16_t* SKD = SAD + (size_t)2 * NZ * 256;
    {
        const bf16_t* A = (const bf16_t*)(ws + WS_MISC + MS_TW); const bf16_t* W = (const bf16_t*)(wsm + OFF_W2T + l * SZ_W2T);
        const float* w0 = c.in[14] + (size_t)l * 512;
        for (int u = (bid + G - base % G) % G; u < NMT * 4; u += G) {
            const int mt = u / 4, nt = u % 4, r0 = mt * 256, c0 = nt * 128;
            gemm_tile<4, 0>(c, 64, [&](int i) { return A + (size_t)(r0 + i) * 64; }, [&](int i) { return W + (size_t)(c0 + i) * 64; }, NoHook(),
                [&](f32x4 (&acc)[4][4], int wr, int wc, int fr, int fq) {
#pragma unroll
                    for (int n = 0; n < 4; ++n) {
                        const int col = c0 + wc + n * 16 + fq * 4, d = col >> 8, cc = col & 255; const float4 w0v = *(const float4*)(w0 + col);
#pragma unroll
                        for (int m = 0; m < 4; ++m) {
                            const int row = r0 + wr + m * 16 + fr; const f32x4 v = acc[m][n]; float e[4];
                            const float x[4] = {w0v.x + v[0], w0v.y + v[1], w0v.z + v[2], w0v.w + v[3]};
#pragma unroll
                            for (int j = 0; j < 4; ++j) e[j] = 0.6065306597126334f * sigmoidf_(x[j]);
                            *(u32x2*)(SE + ((size_t)d * NZ + row) * 256 + cc) = pack4(e[0], e[1], e[2], e[3]);
                        }
                    }
                });
        }
        base += NMT * 4;
    }
    {
        const bf16_t* A = (const bf16_t*)(ws + WS_MISC + MS_AL); const bf16_t* W = (const bf16_t*)(wsm + OFF_A2T + l * SZ_A2T);
        const float* a0 = c.in[16] + (size_t)l * 512; const float* k_a = c.in[20] + (size_t)l * 256; const bf16_t* KB = (const bf16_t*)(ws + WS_EXPW + MX_KB);
        for (int u = (bid + G - base % G) % G; u < NMT * 4; u += G) {
            const int mt = u / 4, nt = u % 4, r0 = mt * 256, c0 = nt * 128;
            gemm_tile<4, 0>(c, 64, [&](int i) { return A + (size_t)(r0 + i) * 64; }, [&](int i) { return W + (size_t)(c0 + i) * 64; }, NoHook(),
                [&](f32x4 (&acc)[4][4], int wr, int wc, int fr, int fq) {
#pragma unroll
                    for (int n = 0; n < 4; ++n) {
                        const int col = c0 + wc + n * 16 + fq * 4, d = col >> 8, cc = col & 255; const float4 a0v = *(const float4*)(a0 + col), kav = *(const float4*)(k_a + cc);
#pragma unroll
                        for (int m = 0; m < 4; ++m) {
                            const int row = r0 + wr + m * 16 + fr; const f32x4 v = acc[m][n];
                            const float ad0 = sigmoidf_(a0v.x + v[0]), ad1 = sigmoidf_(a0v.y + v[1]), ad2 = sigmoidf_(a0v.z + v[2]), ad3 = sigmoidf_(a0v.w + v[3]);
                            float k[4]; unpack4(*(const u32x2*)(KB + (size_t)row * 256 + cc), k);
                            *(u32x2*)(SAD + ((size_t)d * NZ + row) * 256 + cc) = pack4(ad0, ad1, ad2, ad3);
                            *(u32x2*)(SKD + ((size_t)d * NZ + row) * 256 + cc) = pack4(k[0] * (1.f + (ad0 - 1.f) * kav.x), k[1] * (1.f + (ad1 - 1.f) * kav.y), k[2] * (1.f + (ad2 - 1.f) * kav.z), k[3] * (1.f + (ad3 - 1.f) * kav.w));
                        }
                    }
                });
        }
        base += NMT * 4;
    }
    {
        const bf16_t* A = (const bf16_t*)(ws + WS_MISC + MS_SG); const bf16_t* W = (const bf16_t*)(wsm + OFF_G2T + l * SZ_G2T); bf16_t* GG = (bf16_t*)(ws + WS_MISC + MS_GG);
        for (int u = (bid + G - base % G) % G; u < NMT * 2; u += G) {
            const int mt = u / 2, nt = u % 2, r0 = mt * 256, c0 = nt * 128;
            gemm_tile<4, 0>(c, 128, [&](int i) { return A + (size_t)(r0 + i) * 128; }, [&](int i) { return W + (size_t)(c0 + i) * 128; }, NoHook(),
                [&](f32x4 (&acc)[4][4], int wr, int wc, int fr, int fq) {
#pragma unroll
                    for (int n = 0; n < 4; ++n)
#pragma unroll
                        for (int m = 0; m < 4; ++m) { const f32x4 v = acc[m][n];
                            *(u32x2*)(GG + (size_t)(r0 + wr + m * 16 + fr) * 256 + c0 + wc + n * 16 + fq * 4) = pack4(v[0], v[1], v[2], v[3]); }
                });
        }
        base += NMT * 2;
    }
}

DI int krow(int s, int h, int j) { return 16 * s + 8 * (j >> 2) + 4 * h + (j & 3); }
#ifndef ATT_THR
#define ATT_THR 64.f
#endif
constexpr int ATT_PARK = 56 * 1024;
template <int MODE>
DI void attn_pass(const Ctx& c, int l, int b, int h, int q0, int nkeys) {
    constexpr int DROW = MODE == 0 ? 96 : 64;
    constexpr int DQ = MODE == 0 ? 96 : 32, KS = DQ / 16;
    constexpr int DOFF = MODE == 2 ? 32 : 0;
    constexpr int TK = 128;
    constexpr int KPITCH = DQ * 2 + 16;
    constexpr int VPITCH = TK * 2 + 16;
    constexpr int KBYTES = TK * KPITCH, VBYTES = 64 * VPITCH, STG = KBYTES + VBYTES;
    static_assert(MODE == 0 || 2 * STG <= ATT_PARK, "the staging buffers must stay below the parked o1");
    unsigned char* ws = c.ws; int tid_ = c.tid; asm volatile("" : "+v"(tid_));
    const int tid = tid_, lane = tid & 63, wave = __builtin_amdgcn_readfirstlane(tid >> 6), r = lane & 31, hh = lane >> 5;
    const bf16_t* Q = (const bf16_t*)(ws + WS_EXPW + (MODE == 0 ? MX_QM : MX_QD)) + (size_t)(b * 4 + h) * TZ * DROW + DOFF;
    const bf16_t* Kp = (const bf16_t*)(ws + WS_EXPW + (MODE == 0 ? MX_KM : MX_KD)) + (size_t)(b * 4 + h) * TZ * DROW + DOFF;
    const bf16_t* Vt = (const bf16_t*)(ws + WS_EXPW + (MODE == 0 ? MX_VMT : MX_VDT)) + (size_t)(b * 4 + h) * 64 * TZ;
    unsigned char* smem = c.smem;
    bf16x8 qf[KS];
    const int qrow = q0 + wave * 32 + r;
#pragma unroll
    for (int ks = 0; ks < KS; ++ks) qf[ks] = *(const bf16x8*)(Q + (size_t)qrow * DROW + ks * 16 + hh * 8);
    f32x16 oacc[2];
    float mref = 0.f, lrun = 0.f;
#pragma unroll
    for (int t = 0; t < 2; ++t)
#pragma unroll
        for (int i = 0; i < 16; ++i) oacc[t][i] = 0.f;
    constexpr int CPR = DQ / 8, KCH = TK * CPR, NKR = (KCH + NTHR - 1) / NTHR;
    u32x4 kreg[NKR], vreg[2];
    const bf16_t* kp[NKR]; int koff[NKR];
#pragma unroll
    for (int i = 0; i < NKR; ++i) { const int ch = tid + i * NTHR; kp[i] = Kp + (size_t)(ch / CPR) * DROW + (ch % CPR) * 8; koff[i] = (ch / CPR) * KPITCH + (ch % CPR) * 16; }
    const bf16_t* vp = Vt + (size_t)(tid >> 4) * TZ + (tid & 15) * 8;
    const int voff = (tid >> 4) * VPITCH + (tid & 15) * 16;
    auto gload = [&]() {
#pragma unroll
        for (int i = 0; i < NKR; ++i) { if (tid + i * NTHR < KCH) kreg[i] = *(const u32x4*)kp[i]; kp[i] += TK * DROW; }
        vreg[0] = *(const u32x4*)vp; vreg[1] = *(const u32x4*)(vp + (size_t)32 * TZ); vp += TK;
    };
    auto lstore = [&](int buf) {
        unsigned char* sk = smem + buf * STG; unsigned char* sv = sk + KBYTES;
#pragma unroll
        for (int i = 0; i < NKR; ++i) if (tid + i * NTHR < KCH) *(u32x4*)(sk + koff[i]) = kreg[i];
        *(u32x4*)(sv + voff) = vreg[0]; *(u32x4*)(sv + voff + 32 * VPITCH) = vreg[1];
    };
    const int NT = nkeys / TK;
    __syncthreads();
    gload();
    for (int kt = 0; kt < NT; ++kt) {
        lstore(kt & 1);
        if (kt + 1 < NT) gload();
        __syncthreads();
#pragma unroll 1
        for (int sub = 0; sub < 2; ++sub) {
            const unsigned char* sk = smem + (kt & 1) * STG + sub * 64 * KPITCH; const unsigned char* sv = smem + (kt & 1) * STG + KBYTES + sub * 128;
            f32x16 sacc[2];
#pragma unroll
            for (int kg = 0; kg < 2; ++kg) {
#pragma unroll
                for (int i = 0; i < 16; ++i) sacc[kg][i] = 0.f;
#pragma unroll
                for (int ks = 0; ks < KS; ++ks) sacc[kg] = __builtin_amdgcn_mfma_f32_32x32x16_bf16(*(const bf16x8*)(sk + (kg * 32 + r) * KPITCH + ks * 32 + hh * 16), qf[ks], sacc[kg], 0, 0, 0);
            }
            float mx = sacc[0][0];
#pragma unroll
            for (int kg = 0; kg < 2; ++kg)
#pragma unroll
                for (int i = 0; i < 16; ++i) mx = fmaxf(mx, sacc[kg][i]);
            mx = fmaxf(mx, __shfl_xor(mx, 32, 64));
            const float hi = mx - mref;
            const bool first = (kt == 0) && (sub == 0);
            const bool need = (hi > ATT_THR) || (first && mx < -32.f);
            if (__any(need)) {
                const float d = need ? hi : 0.f;
                const float alpha = first ? 1.f : __builtin_amdgcn_exp2f(-d);
                mref += d; lrun *= alpha;
#pragma unroll
                for (int t = 0; t < 2; ++t)
#pragma unroll
                    for (int i = 0; i < 16; ++i) oacc[t][i] *= alpha;
            }
            if (__any(mref != 0.f)) {
#pragma unroll
                for (int kg = 0; kg < 2; ++kg)
#pragma unroll
                    for (int i = 0; i < 16; ++i) sacc[kg][i] -= mref;
            }
            float psum = 0.f;
#pragma unroll
            for (int kg = 0; kg < 2; ++kg)
#pragma unroll
                for (int i = 0; i < 16; ++i) { const float p = __builtin_amdgcn_exp2f(sacc[kg][i]); sacc[kg][i] = p; psum += p; }
            lrun += psum;
#pragma unroll
            for (int kg = 0; kg < 2; ++kg)
#pragma unroll
                for (int s = 0; s < 2; ++s) {
                    u32x4 pk; pk.x = pack2(sacc[kg][8 * s + 0], sacc[kg][8 * s + 1]); pk.y = pack2(sacc[kg][8 * s + 2], sacc[kg][8 * s + 3]);
                    pk.z = pack2(sacc[kg][8 * s + 4], sacc[kg][8 * s + 5]); pk.w = pack2(sacc[kg][8 * s + 6], sacc[kg][8 * s + 7]);
                    const bf16x8 pf = __builtin_bit_cast(bf16x8, pk);
#pragma unroll
                    for (int t = 0; t < 2; ++t) {
                        const unsigned char* vrow = sv + (t * 32 + r) * VPITCH + (kg * 32 + 16 * s + 4 * hh) * 2;
                        const u32x2 lo = *(const u32x2*)vrow, hi2 = *(const u32x2*)(vrow + 16);
                        u32x4 vv; vv.x = lo.x; vv.y = lo.y; vv.z = hi2.x; vv.w = hi2.y;
                        oacc[t] = __builtin_amdgcn_mfma_f32_32x32x16_bf16(__builtin_bit_cast(bf16x8, vv), pf, oacc[t], 0, 0, 0);
                    }
                }
        }
    }
    const float inv = 1.f / (lrun + __shfl_xor(lrun, 32, 64));
    bf16_t* Ycat = (bf16_t*)(ws + WS_BUFA);
    const int zrow = b * TZ + qrow;
    float* park = (float*)(smem + ATT_PARK) + tid;
    if (MODE == 0) {
#pragma unroll
        for (int t = 0; t < 2; ++t)
#pragma unroll
            for (int i4 = 0; i4 < 4; ++i4) {
                const int dv = t * 32 + 8 * i4 + 4 * hh;
                *(u32x2*)(Ycat + (size_t)zrow * D + h * 64 + dv) = pack4(oacc[t][4 * i4] * inv, oacc[t][4 * i4 + 1] * inv, oacc[t][4 * i4 + 2] * inv, oacc[t][4 * i4 + 3] * inv);
            }
    } else if (MODE == 1) {
#pragma unroll
        for (int t = 0; t < 2; ++t)
#pragma unroll
            for (int i = 0; i < 16; ++i) park[(t * 16 + i) * NTHR] = oacc[t][i] * inv;
    } else {
        const float lam = ((const float*)(ws + WS_WSM + OFF_LAM))[l];
        const float lam_init = 0.8f - 0.6f * __expf(-0.3f * (float)l);
        float ss = 0.f;
#pragma unroll
        for (int t = 0; t < 2; ++t)
#pragma unroll
            for (int i = 0; i < 16; ++i) { const float o = park[(t * 16 + i) * NTHR] - lam * oacc[t][i] * inv; oacc[t][i] = o; ss += o * o; }
        ss += __shfl_xor(ss, 32, 64);
        const float rs = rsqrtf(ss * (1.f / 64.f) + 1e-5f) * (1.f - lam_init);
        const float* sg = c.in[38] + l * 64;
#pragma unroll
        for (int t = 0; t < 2; ++t)
#pragma unroll
            for (int i4 = 0; i4 < 4; ++i4) {
                const int dv = t * 32 + 8 * i4 + 4 * hh; const float4 g = *(const float4*)(sg + dv);
                *(u32x2*)(Ycat + (size_t)zrow * D + 768 + h * 64 + dv) = pack4(oacc[t][4 * i4] * rs * g.x, oacc[t][4 * i4 + 1] * rs * g.y, oacc[t][4 * i4 + 2] * rs * g.z, oacc[t][4 * i4 + 3] * rs * g.w);
            }
    }
}
DI void phase_attention(const Ctx& c, int l) {
    const int nu = 512 + (l == 0 ? 16 : 0);
    for (int u = blockIdx.x; u < nu; u += gridDim.x) {
        int b, h, q0, nk; bool mla;
        if (u < 512) { const int k = u & 255; b = k >> 7; h = (k >> 5) & 3; q0 = CTX + (k & 31) * 256; nk = TZ; mla = u < 256; }
        else { const int k = u - 512; b = (k >> 2) & 1; h = k & 3; q0 = 0; nk = CTX; mla = k < 8; }
        if (mla) attn_pass<0>(c, l, b, h, q0, nk);
        else { attn_pass<1>(c, l, b, h, q0, nk); attn_pass<2>(c, l, b, h, q0, nk); }
    }
}

DI int rw_tok(int dir, int i) { return dir == 0 ? i : (i < CTX ? CTX - 1 - i : TZ - 1 - (i - CTX)); }
constexpr int RW_TS = 32;
constexpr int RW_STEP_F = 6 * 64 + 2;
constexpr int RW_BUF_F = RW_TS * RW_STEP_F;
template <int CTRL> DI float dpp_add(float x) { return x + __int_as_float(__builtin_amdgcn_update_dpp(0, __float_as_int(x), CTRL, 0xf, 0xf, false)); }
DI float red16(float x) { x = dpp_add<0xB1>(x); x = dpp_add<0x4E>(x); x = dpp_add<0x141>(x); x = dpp_add<0x140>(x); return x; }
DI float red8(float x) { x = dpp_add<0xB1>(x); x = dpp_add<0x4E>(x); x = dpp_add<0x141>(x); return x; }
struct RwRegs { u32x4 r, v, kk, e, ad, kd; };
DI void rw_load(const Ctx& c, int b, int h, int dir, int chunk, int t, RwRegs& g) {
    const bf16_t* RB = (const bf16_t*)(c.ws + WS_EXPW + MX_RB); const bf16_t* VB = (const bf16_t*)(c.ws + WS_EXPW + MX_VB); const bf16_t* KKB = (const bf16_t*)(c.ws + WS_EXPW + MX_KKB);
    const bf16_t* SE = (const bf16_t*)(c.ws + WS_P + P_PR) + (size_t)dir * NZ * 256; const bf16_t* SAD = SE + (size_t)2 * NZ * 256; const bf16_t* SKD = SAD + (size_t)2 * NZ * 256;
    const int i = chunk * RW_TS + (t >> 3), z = b * TZ + rw_tok(dir, i); const size_t o = (size_t)z * 256 + h * 64 + (t & 7) * 8;
    g.r = *(const u32x4*)(RB + o); g.v = *(const u32x4*)(VB + o); g.kk = *(const u32x4*)(KKB + o);
    g.e = *(const u32x4*)(SE + o); g.ad = *(const u32x4*)(SAD + o); g.kd = *(const u32x4*)(SKD + o);
}
DI void up8(const u32x4& u, float (&f)[8]) { f[0] = lo2f(u.x); f[1] = hi2f(u.x); f[2] = lo2f(u.y); f[3] = hi2f(u.y); f[4] = lo2f(u.z); f[5] = hi2f(u.z); f[6] = lo2f(u.w); f[7] = hi2f(u.w); }
DI void rw_process(const RwRegs& g, int t, float* buf) {
    float r[8], v[8], kk[8], e[8], ad[8], kd[8];
    up8(g.r, r); up8(g.v, v); up8(g.kk, kk); up8(g.e, e); up8(g.ad, ad); up8(g.kd, kd);
    float* f = buf + (t >> 3) * RW_STEP_F + (t & 7) * 8;
    float w[8], bv[8], wr[8]; float br = 0.f, kr = 0.f;
#pragma unroll
    for (int j = 0; j < 8; ++j) { w[j] = __expf(-e[j]); bv[j] = kk[j] * ad[j]; wr[j] = w[j] * r[j]; br += bv[j] * r[j]; kr += kd[j] * r[j]; }
    *(float4*)(f) = make_float4(w[0], w[1], w[2], w[3]); *(float4*)(f + 4) = make_float4(w[4], w[5], w[6], w[7]);
    *(float4*)(f + 64) = make_float4(kk[0], kk[1], kk[2], kk[3]); *(float4*)(f + 68) = make_float4(kk[4], kk[5], kk[6], kk[7]);
    *(float4*)(f + 128) = make_float4(bv[0], bv[1], bv[2], bv[3]); *(float4*)(f + 132) = make_float4(bv[4], bv[5], bv[6], bv[7]);
    *(float4*)(f + 192) = make_float4(kd[0], kd[1], kd[2], kd[3]); *(float4*)(f + 196) = make_float4(kd[4], kd[5], kd[6], kd[7]);
    *(float4*)(f + 256) = make_float4(wr[0], wr[1], wr[2], wr[3]); *(float4*)(f + 260) = make_float4(wr[4], wr[5], wr[6], wr[7]);
    *(float4*)(f + 320) = make_float4(v[0], v[1], v[2], v[3]); *(float4*)(f + 324) = make_float4(v[4], v[5], v[6], v[7]);
    br = red8(br); kr = red8(kr);
    if ((t & 7) == 0) { float* s = buf + (t >> 3) * RW_STEP_F + 384; s[0] = br; s[1] = kr; }
}
struct RwStep { float4 w, kk, bv, kd, wr; float vv, br, kr; };
DI void rw_ld(RwStep& s, const float* f, int kq, int row) {
    s.w = *(const float4*)(f + kq * 4); s.kk = *(const float4*)(f + 64 + kq * 4); s.bv = *(const float4*)(f + 128 + kq * 4);
    s.kd = *(const float4*)(f + 192 + kq * 4); s.wr = *(const float4*)(f + 256 + kq * 4); s.vv = f[320 + row]; s.br = f[384]; s.kr = f[385];
}
DI void phase_rwkv_scan_unit(const Ctx& c, int l, int u) {
    const int rg = u & 3, chain = u >> 2, dir = chain & 1, h = (chain >> 1) & 3, b = chain >> 3;
    float* buf0 = (float*)c.smem; float* buf1 = buf0 + RW_BUF_F;
    float* ybuf = buf1 + RW_BUF_F;
    float* YO = (float*)(c.ws + WS_BUFB) + (size_t)dir * NZ * 256 + (size_t)b * TZ * 256 + h * 64 + rg * 16;
    const int wave = c.wave, lane = c.lane, rr = lane >> 4, kq = lane & 15, rl = (wave & 3) * 4 + rr, row = rg * 16 + rl;
    const int t = c.tid - 256;
    float S0 = 0.f, S1 = 0.f, S2 = 0.f, S3 = 0.f;
    constexpr int NCH = TZ / RW_TS;
    RwRegs g;
    __syncthreads();
    if (wave >= 4) { rw_load(c, b, h, dir, 0, t, g); rw_process(g, t, buf0); rw_load(c, b, h, dir, 1, t, g); }
    __syncthreads();
    for (int ch = 0; ch < NCH; ++ch) {
        float* cur = buf0 + (ch & 1) * RW_BUF_F; float* nxt = buf0 + ((ch + 1) & 1) * RW_BUF_F;
        if (wave >= 4) {
            if (ch > 0) {
                const float* yb = ybuf + ((ch - 1) & 1) * RW_TS * 16;
#pragma unroll
                for (int i = 0; i < 2; ++i) { const int e = t + i * 256, st = e >> 4, rw = e & 15; YO[(size_t)rw_tok(dir, (ch - 1) * RW_TS + st) * 256 + rw] = yb[e]; }
            }
            if (ch + 1 < NCH) rw_process(g, t, nxt);
            if (ch + 2 < NCH) rw_load(c, b, h, dir, ch + 2, t, g);
        } else {
            float* yb = ybuf + (ch & 1) * RW_TS * 16 + rl;
            RwStep s0, s1;
            rw_ld(s0, cur, kq, row);
#pragma unroll 4
            for (int st = 0; st < RW_TS; st += 2) {
                rw_ld(s1, cur + (st + 1) * RW_STEP_F, kq, row);
                {
                    float sa = -((S0 * s0.kk.x + S1 * s0.kk.y) + (S2 * s0.kk.z + S3 * s0.kk.w));
                    float q = (S0 * s0.wr.x + S1 * s0.wr.y) + (S2 * s0.wr.z + S3 * s0.wr.w);
                    sa = red16(sa); q = red16(q);
                    S0 = fmaf(sa, s0.bv.x, fmaf(S0, s0.w.x, s0.vv * s0.kd.x)); S1 = fmaf(sa, s0.bv.y, fmaf(S1, s0.w.y, s0.vv * s0.kd.y));
                    S2 = fmaf(sa, s0.bv.z, fmaf(S2, s0.w.z, s0.vv * s0.kd.z)); S3 = fmaf(sa, s0.bv.w, fmaf(S3, s0.w.w, s0.vv * s0.kd.w));
                    yb[st * 16] = q + sa * s0.br + s0.vv * s0.kr;
                }
                if (st + 2 < RW_TS) rw_ld(s0, cur + (st + 2) * RW_STEP_F, kq, row);
                {
                    float sa = -((S0 * s1.kk.x + S1 * s1.kk.y) + (S2 * s1.kk.z + S3 * s1.kk.w));
                    float q = (S0 * s1.wr.x + S1 * s1.wr.y) + (S2 * s1.wr.z + S3 * s1.wr.w);
                    sa = red16(sa); q = red16(q);
                    S0 = fmaf(sa, s1.bv.x, fmaf(S0, s1.w.x, s1.vv * s1.kd.x)); S1 = fmaf(sa, s1.bv.y, fmaf(S1, s1.w.y, s1.vv * s1.kd.y));
                    S2 = fmaf(sa, s1.bv.z, fmaf(S2, s1.w.z, s1.vv * s1.kd.z)); S3 = fmaf(sa, s1.bv.w, fmaf(S3, s1.w.w, s1.vv * s1.kd.w));
                    yb[(st + 1) * 16] = q + sa * s1.br + s1.vv * s1.kr;
                }
            }
        }
        __syncthreads();
    }
    if (wave >= 4) {
        const float* yb = ybuf + ((NCH - 1) & 1) * RW_TS * 16;
#pragma unroll
        for (int i = 0; i < 2; ++i) { const int e = t + i * 256, st = e >> 4, rw = e & 15; YO[(size_t)rw_tok(dir, (NCH - 1) * RW_TS + st) * 256 + rw] = yb[e]; }
    }
}

constexpr int LA_AN = 0, LA_RN = 8192, LA_BN = 16384, LA_KN = 24576, LA_AT = 32768, LA_BHT = 40960, LA_KHT = 49152, LA_VT = 57344,
              LA_NBA = 65536  , LA_NKA = 81920, LA_NBRT = 90112, LA_NKRT = 98304, LA_P63 = 106496;
constexpr int LA_TMT = LA_AN, LA_M1 = LA_BN, LA_W1T = LA_KN, LA_Z1 = LA_NBA;
DI int crow(int reg, int h) { return (reg & 3) + 8 * (reg >> 2) + 4 * h; }
DI void mm_tile(f32x16& acc, const unsigned char* A, int i0, const unsigned char* BT, int j0, int r, int h) {
#pragma unroll
    for (int ks = 0; ks < 4; ++ks) {
        const bf16x8 a = *(const bf16x8*)(A + (i0 + r) * 128 + ks * 32 + h * 16);
        const bf16x8 b = *(const bf16x8*)(BT + (j0 + r) * 128 + ks * 32 + h * 16);
        acc = __builtin_amdgcn_mfma_f32_32x32x16_bf16(a, b, acc, 0, 0, 0);
    }
}
DI void zero16(f32x16& a) {
#pragma unroll
    for (int i = 0; i < 16; ++i) a[i] = 0.f;
}
DI void phase_rwkv_chunk_unit(const Ctx& c, int l, int unit) {
    unsigned char* L = c.smem; unsigned char* ws = c.ws;
    const int chain = unit / RNC, ch = unit % RNC, dir = chain & 1, hd = (chain >> 1) & 3, b = chain >> 3;
    const int tid = c.tid, lane = c.lane, wave = c.wave, r = lane & 31, h = lane >> 5;
    const bf16_t* RB = (const bf16_t*)(ws + WS_EXPW + MX_RB); const bf16_t* VB = (const bf16_t*)(ws + WS_EXPW + MX_VB); const bf16_t* KKB = (const bf16_t*)(ws + WS_EXPW + MX_KKB);
    const bf16_t* SE = (const bf16_t*)(ws + WS_P + P_PR) + (size_t)dir * NZ * 256; const bf16_t* SAD = SE + (size_t)2 * NZ * 256; const bf16_t* SKD = SAD + (size_t)2 * NZ * 256;
    float* CUM = (float*)(L + LA_NBA);
    __syncthreads();
    const int t = tid >> 3, k0 = (tid & 7) * 8;
    float rr[8], vv[8], kk[8], ee[8], ad[8], kd[8];
    {
        const int z = b * TZ + rw_tok(dir, ch * RC + t); const size_t o = (size_t)z * 256 + hd * 64 + k0;
        up8(*(const u32x4*)(RB + o), rr); up8(*(const u32x4*)(VB + o), vv); up8(*(const u32x4*)(KKB + o), kk);
        up8(*(const u32x4*)(SE + o), ee); up8(*(const u32x4*)(SAD + o), ad); up8(*(const u32x4*)(SKD + o), kd);
        *(float4*)(CUM + t * 64 + k0) = make_float4(ee[0], ee[1], ee[2], ee[3]); *(float4*)(CUM + t * 64 + k0 + 4) = make_float4(ee[4], ee[5], ee[6], ee[7]);
    }
    __syncthreads();
    if (wave == 0) { float cm = 0.f;
#pragma unroll 8
        for (int i = 0; i < RC; ++i) { cm += CUM[i * 64 + lane]; CUM[i * 64 + lane] = cm; } }
    __syncthreads();
    {
        float cm[8], c63[8];
        { const float4 a = *(const float4*)(CUM + t * 64 + k0), bq = *(const float4*)(CUM + t * 64 + k0 + 4); cm[0] = a.x; cm[1] = a.y; cm[2] = a.z; cm[3] = a.w; cm[4] = bq.x; cm[5] = bq.y; cm[6] = bq.z; cm[7] = bq.w; }
        { const float4 a = *(const float4*)(CUM + 63 * 64 + k0), bq = *(const float4*)(CUM + 63 * 64 + k0 + 4); c63[0] = a.x; c63[1] = a.y; c63[2] = a.z; c63[3] = a.w; c63[4] = bq.x; c63[5] = bq.y; c63[6] = bq.z; c63[7] = bq.w; }
        float at[8], rt[8], bt[8], kt[8], bh[8], kh[8];
#pragma unroll
        for (int j = 0; j < 8; ++j) {
            const float pt = __expf(-cm[j]), pp = __expf(-(cm[j] - ee[j])), ip = __expf(cm[j]), ph = __expf(-(c63[j] - cm[j])), bb = kk[j] * ad[j];
            at[j] = -kk[j] * pp; rt[j] = rr[j] * pt; bt[j] = bb * ip; kt[j] = kd[j] * ip; bh[j] = bb * ph; kh[j] = kd[j] * ph;
        }
        u32x4 w4;
        w4.x = pack2(at[0], at[1]); w4.y = pack2(at[2], at[3]); w4.z = pack2(at[4], at[5]); w4.w = pack2(at[6], at[7]); *(u32x4*)(L + LA_AN + t * 128 + k0 * 2) = w4;
        w4.x = pack2(rt[0], rt[1]); w4.y = pack2(rt[2], rt[3]); w4.z = pack2(rt[4], rt[5]); w4.w = pack2(rt[6], rt[7]); *(u32x4*)(L + LA_RN + t * 128 + k0 * 2) = w4;
        w4.x = pack2(bt[0], bt[1]); w4.y = pack2(bt[2], bt[3]); w4.z = pack2(bt[4], bt[5]); w4.w = pack2(bt[6], bt[7]); *(u32x4*)(L + LA_BN + t * 128 + k0 * 2) = w4;
        w4.x = pack2(kt[0], kt[1]); w4.y = pack2(kt[2], kt[3]); w4.z = pack2(kt[4], kt[5]); w4.w = pack2(kt[6], kt[7]); *(u32x4*)(L + LA_KN + t * 128 + k0 * 2) = w4;
#pragma unroll
        for (int j = 0; j < 8; ++j) {
            *(bf16_t*)(L + LA_AT + (k0 + j) * 128 + t * 2) = f2bf(at[j]); *(bf16_t*)(L + LA_BHT + (k0 + j) * 128 + t * 2) = f2bf(bh[j]);
            *(bf16_t*)(L + LA_KHT + (k0 + j) * 128 + t * 2) = f2bf(kh[j]); *(bf16_t*)(L + LA_VT + (k0 + j) * 128 + t * 2) = f2bf(vv[j]);
        }
        if (t == 63) {
            float* p63 = (float*)(L + LA_P63); float* gp = (float*)(ws + WS_RW + RW_P63) + (size_t)unit * 64;
#pragma unroll
            for (int j = 0; j < 8; ++j) { const float p = __expf(-c63[j]); p63[k0 + j] = p; gp[k0 + j] = p; }
        }
    }
    __syncthreads();
    {
        const int p = wave >> 1, i0 = (wave & 1) * 32;
        const unsigned char* A = L + (p == 0 ? LA_BN : p == 1 ? LA_KN : LA_RN);
        const unsigned char* BT = L + (p < 2 ? LA_AN : p == 2 ? LA_BN : LA_KN);
#pragma unroll
        for (int jt = 0; jt < 2; ++jt) {
            const int j0 = jt * 32; f32x16 acc; zero16(acc);
            mm_tile(acc, A, i0, BT, j0, r, h);
            const int col = j0 + r;
#pragma unroll
            for (int g = 0; g < 16; ++g) {
                const int row = i0 + crow(g, h);
                if (p == 0) ((float*)(L + LA_NBA))[row * 64 + col] = (row < col) ? acc[g] : 0.f;
                else if (p == 1) *(bf16_t*)(L + LA_NKA + row * 128 + col * 2) = f2bf((row < col) ? acc[g] : 0.f);
                else *(bf16_t*)(L + (p == 2 ? LA_NBRT : LA_NKRT) + row * 128 + col * 2) = f2bf((col <= row) ? acc[g] : 0.f);
            }
        }
    }
    __syncthreads();
    {
        constexpr int X0 = LA_BN, X1 = LA_KN, X3 = 108544, X4 = X3 + 8192, X5 = LA_NBA + 16384 - 16384, X6 = LA_NBA + 8192;
        float nv[8];
        { const int s = tid >> 3, t0 = (tid & 7) * 8; const float* N = (const float*)(L + LA_NBA) + s * 64 + t0;
          const float4 a = *(const float4*)N, bq = *(const float4*)(N + 4); nv[0] = a.x; nv[1] = a.y; nv[2] = a.z; nv[3] = a.w; nv[4] = bq.x; nv[5] = bq.y; nv[6] = bq.z; nv[7] = bq.w; }
        __syncthreads();
        {
            const int s = tid >> 3, t0 = (tid & 7) * 8;
            u32x4 w4; w4.x = pack2(nv[0], nv[1]); w4.y = pack2(nv[2], nv[3]); w4.z = pack2(nv[4], nv[5]); w4.w = pack2(nv[6], nv[7]);
            *(u32x4*)(L + X0 + s * 128 + t0 * 2) = w4;
#pragma unroll
            for (int j = 0; j < 8; ++j) *(bf16_t*)(L + X1 + (t0 + j) * 128 + s * 2) = f2bf(nv[j]);
#pragma unroll
            for (int j = 0; j < 8; ++j) if (t0 + j == s) nv[j] += 1.f;
            w4.x = pack2(nv[0], nv[1]); w4.y = pack2(nv[2], nv[3]); w4.z = pack2(nv[4], nv[5]); w4.w = pack2(nv[6], nv[7]);
            *(u32x4*)(L + X5 + s * 128 + t0 * 2) = w4;
        }
        __syncthreads();
        const int ti0 = ((wave >> 1) & 1) * 32, tj0 = (wave & 1) * 32;
        if (wave < 4) {
            f32x16 acc; zero16(acc); mm_tile(acc, L + X0, ti0, L + X1, tj0, r, h);
#pragma unroll
            for (int g4 = 0; g4 < 4; ++g4) *(u32x2*)(L + X4 + (tj0 + r) * 128 + (ti0 + 8 * g4 + 4 * h) * 2) = pack4(acc[4 * g4], acc[4 * g4 + 1], acc[4 * g4 + 2], acc[4 * g4 + 3]);
#pragma unroll
            for (int g = 0; g < 16; ++g) *(bf16_t*)(L + X3 + (ti0 + crow(g, h)) * 128 + (tj0 + r) * 2) = f2bf(acc[g]);
        }
        __syncthreads();
#pragma unroll
        for (int k = 1; k <= 5; ++k) {
            const int qa = (k & 1) ? X3 : X0, qt = (k & 1) ? X4 : X1, nqa = (k & 1) ? X0 : X3, nqt = (k & 1) ? X1 : X4;
            const int pa = (k & 1) ? X5 : X6, npa = (k & 1) ? X6 : X5;
            if (wave >= 4) {
                f32x16 acc; zero16(acc); mm_tile(acc, L + pa, ti0, L + qt, tj0, r, h);
#pragma unroll
                for (int g = 0; g < 16; ++g) acc[g] += bf2f(*(const bf16_t*)(L + pa + (ti0 + crow(g, h)) * 128 + (tj0 + r) * 2));
                if (k < 5) {
#pragma unroll
                    for (int g = 0; g < 16; ++g) *(bf16_t*)(L + npa + (ti0 + crow(g, h)) * 128 + (tj0 + r) * 2) = f2bf(acc[g]);
                } else {
#pragma unroll
                    for (int g4 = 0; g4 < 4; ++g4) *(u32x2*)(L + LA_TMT + (tj0 + r) * 128 + (ti0 + 8 * g4 + 4 * h) * 2) = pack4(acc[4 * g4], acc[4 * g4 + 1], acc[4 * g4 + 2], acc[4 * g4 + 3]);
                }
            } else if (k < 5) {
                f32x16 acc; zero16(acc); mm_tile(acc, L + qa, ti0, L + qt, tj0, r, h);
#pragma unroll
                for (int g4 = 0; g4 < 4; ++g4) *(u32x2*)(L + nqt + (tj0 + r) * 128 + (ti0 + 8 * g4 + 4 * h) * 2) = pack4(acc[4 * g4], acc[4 * g4 + 1], acc[4 * g4 + 2], acc[4 * g4 + 3]);
#pragma unroll
                for (int g = 0; g < 16; ++g) *(bf16_t*)(L + nqa + (ti0 + crow(g, h)) * 128 + (tj0 + r) * 2) = f2bf(acc[g]);
            }
            __syncthreads();
        }
    }
    {
        const int p = wave >> 2, i0 = ((wave >> 1) & 1) * 32, j0 = (wave & 1) * 32; f32x16 acc; zero16(acc);
        if (p == 0) {
            mm_tile(acc, L + LA_TMT, i0, L + LA_AT, j0, r, h);
#pragma unroll
            for (int g4 = 0; g4 < 4; ++g4) *(u32x2*)(L + LA_M1 + (j0 + r) * 128 + (i0 + 8 * g4 + 4 * h) * 2) = pack4(acc[4 * g4], acc[4 * g4 + 1], acc[4 * g4 + 2], acc[4 * g4 + 3]);
        } else {
            mm_tile(acc, L + LA_NKA, i0, L + LA_TMT, j0, r, h);
#pragma unroll
            for (int g4 = 0; g4 < 4; ++g4) *(u32x2*)(L + LA_W1T + (j0 + r) * 128 + (i0 + 8 * g4 + 4 * h) * 2) = pack4(acc[4 * g4], acc[4 * g4 + 1], acc[4 * g4 + 2], acc[4 * g4 + 3]);
        }
    }
    __syncthreads();
    if (wave < 4) {
        const int i0 = (wave >> 1) * 32, j0 = (wave & 1) * 32; f32x16 acc; zero16(acc);
        mm_tile(acc, L + LA_W1T, i0, L + LA_VT, j0, r, h);
#pragma unroll
        for (int g4 = 0; g4 < 4; ++g4) *(u32x2*)(L + LA_Z1 + (j0 + r) * 128 + (i0 + 8 * g4 + 4 * h) * 2) = pack4(acc[4 * g4], acc[4 * g4 + 1], acc[4 * g4 + 2], acc[4 * g4 + 3]);
    }
    __syncthreads();
    {
        const int p = wave >> 1, i0 = (wave & 1) * 32;
        bf16_t* GM3 = (bf16_t*)(ws + WS_RW + RW_M3) + (size_t)unit * 4096; bf16_t* GM2 = (bf16_t*)(ws + WS_RW + RW_M2) + (size_t)unit * 4096; bf16_t* GZ5 = (bf16_t*)(ws + WS_RW + RW_Z5) + (size_t)unit * 4096;
        float* YO = (float*)(ws + WS_BUFB) + (size_t)dir * NZ * 256;
#pragma unroll
        for (int jt = 0; jt < 2; ++jt) {
            const int j0 = jt * 32; f32x16 acc; zero16(acc);
            if (p == 0) {
                mm_tile(acc, L + LA_M1, i0, L + LA_NBRT, j0, r, h);
#pragma unroll
                for (int g4 = 0; g4 < 4; ++g4) { const int tt = j0 + r, kq = i0 + 8 * g4 + 4 * h; float rv[4]; unpack4(*(const u32x2*)(L + LA_RN + tt * 128 + kq * 2), rv);
                    *(u32x2*)(GM2 + tt * 64 + kq) = pack4(acc[4 * g4] + rv[0], acc[4 * g4 + 1] + rv[1], acc[4 * g4 + 2] + rv[2], acc[4 * g4 + 3] + rv[3]); }
            } else if (p == 1) {
                mm_tile(acc, L + LA_NBRT, i0, L + LA_Z1, j0, r, h); mm_tile(acc, L + LA_NKRT, i0, L + LA_VT, j0, r, h);
#pragma unroll
                for (int g = 0; g < 16; ++g) { const int tt = i0 + crow(g, h); YO[(size_t)(b * TZ + rw_tok(dir, ch * RC + tt)) * 256 + hd * 64 + j0 + r] = acc[g]; }
            } else if (p == 2) {
                mm_tile(acc, L + LA_M1, i0, L + LA_BHT, j0, r, h);
#pragma unroll
                for (int g4 = 0; g4 < 4; ++g4) *(u32x2*)(GM3 + (j0 + r) * 64 + i0 + 8 * g4 + 4 * h) = pack4(acc[4 * g4], acc[4 * g4 + 1], acc[4 * g4 + 2], acc[4 * g4 + 3]);
            } else {
                mm_tile(acc, L + LA_BHT, i0, L + LA_Z1, j0, r, h); mm_tile(acc, L + LA_KHT, i0, L + LA_VT, j0, r, h);
#pragma unroll
                for (int g4 = 0; g4 < 4; ++g4) *(u32x2*)(GZ5 + (j0 + r) * 64 + i0 + 8 * g4 + 4 * h) = pack4(acc[4 * g4], acc[4 * g4 + 1], acc[4 * g4 + 2], acc[4 * g4 + 3]);
            }
        }
    }
}
DI void phase_rwkv_chunks(const Ctx& c, int l) {
    for (int u = blockIdx.x; u < 16 * RNC; u += gridDim.x) phase_rwkv_chunk_unit(c, l, u);
}
DI bf16x8 pack8(const f32x16& x, int s) {
    u32x4 p; p.x = pack2(x[8 * s], x[8 * s + 1]); p.y = pack2(x[8 * s + 2], x[8 * s + 3]); p.z = pack2(x[8 * s + 4], x[8 * s + 5]); p.w = pack2(x[8 * s + 6], x[8 * s + 7]);
    return __builtin_bit_cast(bf16x8, p);
}
DI bf16x8 ldfrag(const bf16_t* rowp, int s, int h) {
    const u32x2 lo = *(const u32x2*)(rowp + 16 * s + 4 * h), hi = *(const u32x2*)(rowp + 16 * s + 8 + 4 * h);
    u32x4 v; v.x = lo.x; v.y = lo.y; v.z = hi.x; v.w = hi.y; return __builtin_bit_cast(bf16x8, v);
}
constexpr int SQ_PITCH = 144, SQ_MAT = 64 * SQ_PITCH;
constexpr int SQA_M3 = 0, SQA_Z5 = SQ_MAT, SQA_P63 = 2 * SQ_MAT, SQA_BYTES = SQA_P63 + 256;
constexpr int SQB_M2 = 0, SQB_Y = SQ_MAT, SQB_BYTES = SQB_Y + 64 * 64 * 4;
constexpr int SQ_A0 = 0, SQ_B0 = 2 * SQA_BYTES, SQ_XB = SQ_B0 + 2 * SQB_BYTES;
DI bf16x8 ldfrag_l(const unsigned char* rowp, int s, int h) {
    const u32x2 lo = *(const u32x2*)(rowp + (16 * s + 4 * h) * 2), hi = *(const u32x2*)(rowp + (16 * s + 8 + 4 * h) * 2);
    u32x4 v; v.x = lo.x; v.y = lo.y; v.z = hi.x; v.w = hi.y; return __builtin_bit_cast(bf16x8, v);
}
struct SqRegsA { u32x4 m3[2], z5[2], p63; };
struct SqRegsB { u32x4 m2[2], y[4]; };
DI void sqa_gload(const Ctx& c, size_t unit, int lt, SqRegsA& g) {
    const unsigned char* g3 = c.ws + WS_RW + RW_M3 + unit * 8192; const unsigned char* g5 = c.ws + WS_RW + RW_Z5 + unit * 8192;
#pragma unroll
    for (int i = 0; i < 2; ++i) { const int id = lt + i * 256; g.m3[i] = *(const u32x4*)(g3 + id * 16); g.z5[i] = *(const u32x4*)(g5 + id * 16); }
    if (lt < 16) g.p63 = *(const u32x4*)(c.ws + WS_RW + RW_P63 + unit * 256 + lt * 16);
}
DI void sqa_lstore(unsigned char* st, int lt, const SqRegsA& g) {
#pragma unroll
    for (int i = 0; i < 2; ++i) { const int id = lt + i * 256, row = id >> 3, part = id & 7;
        *(u32x4*)(st + SQA_M3 + row * SQ_PITCH + part * 16) = g.m3[i]; *(u32x4*)(st + SQA_Z5 + row * SQ_PITCH + part * 16) = g.z5[i]; }
    if (lt < 16) *(u32x4*)(st + SQA_P63 + lt * 16) = g.p63;
}
DI void sqb_gload(const Ctx& c, size_t unit, const float* YO, int dir, int ch, int lt, SqRegsB& g) {
    const unsigned char* g2 = c.ws + WS_RW + RW_M2 + unit * 8192;
#pragma unroll
    for (int i = 0; i < 2; ++i) g.m2[i] = *(const u32x4*)(g2 + (lt + i * 256) * 16);
#pragma unroll
    for (int i = 0; i < 4; ++i) { const int id = lt + i * 256; g.y[i] = *(const u32x4*)(YO + (size_t)rw_tok(dir, ch * RC + (id >> 4)) * 256 + (id & 15) * 4); }
}
DI void sqb_lstore(unsigned char* st, int lt, const SqRegsB& g) {
#pragma unroll
    for (int i = 0; i < 2; ++i) { const int id = lt + i * 256; *(u32x4*)(st + SQB_M2 + (id >> 3) * SQ_PITCH + (id & 7) * 16) = g.m2[i]; }
#pragma unroll
    for (int i = 0; i < 4; ++i) { const int id = lt + i * 256; *(u32x4*)(st + SQB_Y + (id >> 4) * 256 + (id & 15) * 16) = g.y[i]; }
}
DI void sqb_store_y(float* YO, int dir, int ch, const unsigned char* st, int lt) {
#pragma unroll
    for (int i = 0; i < 4; ++i) { const int id = lt + i * 256; *(u32x4*)(YO + (size_t)rw_tok(dir, ch * RC + (id >> 4)) * 256 + (id & 15) * 4) = *(const u32x4*)(st + SQB_Y + (id >> 4) * 256 + (id & 15) * 16); }
}
DI void phase_rwkv_seq_block(const Ctx& c, int l, int chain) {
    unsigned char* L = c.smem; const int lane = c.lane, wave = c.wave, r = lane & 31, h = lane >> 5;
    const int dir = chain & 1, hd = (chain >> 1) & 3, b = chain >> 3, lt = c.tid - 256, vh = wave & 1;
    const size_t unit0 = (size_t)chain * RNC;
    __syncthreads();
    if (wave >= 4) {
        float* YO = (float*)(c.ws + WS_BUFB) + (size_t)dir * NZ * 256 + (size_t)b * TZ * 256 + hd * 64;
        SqRegsA ga; SqRegsB gb;
        sqa_gload(c, unit0, lt, ga); sqa_lstore(L + SQ_A0, lt, ga); sqa_gload(c, unit0 + 1, lt, ga); sqb_gload(c, unit0, YO, dir, 0, lt, gb);
        __syncthreads();
#pragma unroll 1
        for (int ch = 0; ch <= RNC; ++ch) {
            unsigned char* sb = L + SQ_B0 + (ch & 1) * SQB_BYTES;
            if (ch >= 2) sqb_store_y(YO, dir, ch - 2, sb, lt);
            if (ch < RNC) sqb_lstore(sb, lt, gb);
            if (ch + 1 < RNC) { sqb_gload(c, unit0 + ch + 1, YO, dir, ch + 1, lt, gb); sqa_lstore(L + SQ_A0 + ((ch + 1) & 1) * SQA_BYTES, lt, ga); }
            if (ch + 2 < RNC) sqa_gload(c, unit0 + ch + 2, lt, ga);
            __syncthreads();
        }
        sqb_store_y(YO, dir, RNC - 1, L + SQ_B0 + ((RNC - 1) & 1) * SQB_BYTES, lt);
    } else if (wave < 2) {
        f32x16 x[2]; zero16(x[0]); zero16(x[1]);
        __syncthreads();
#pragma unroll 1
        for (int ch = 0; ch <= RNC; ++ch) {
            if (ch < RNC) {
                const unsigned char* st = L + SQ_A0 + (ch & 1) * SQA_BYTES;
                unsigned char* xbuf = L + SQ_XB + ((ch & 1) * 2 + vh) * 4096 + lane * 16;
                bf16x8 xb[4];
#pragma unroll
                for (int s = 0; s < 4; ++s) { xb[s] = pack8(x[s >> 1], s & 1); *(bf16x8*)(xbuf + s * 1024) = xb[s]; }
                f32x16 xn0, xn1;
#pragma unroll
                for (int i = 0; i < 2; ++i) {
                    f32x16 xa;
#pragma unroll
                    for (int g4 = 0; g4 < 4; ++g4) {
                        float z5[4]; unpack4(*(const u32x2*)(st + SQA_Z5 + (vh * 32 + r) * SQ_PITCH + (32 * i + 8 * g4 + 4 * h) * 2), z5);
                        const float4 p4 = *(const float4*)(st + SQA_P63 + (32 * i + 8 * g4 + 4 * h) * 4);
                        xa[4 * g4] = fmaf(p4.x, x[i][4 * g4], z5[0]); xa[4 * g4 + 1] = fmaf(p4.y, x[i][4 * g4 + 1], z5[1]);
                        xa[4 * g4 + 2] = fmaf(p4.z, x[i][4 * g4 + 2], z5[2]); xa[4 * g4 + 3] = fmaf(p4.w, x[i][4 * g4 + 3], z5[3]);
                    }
#pragma unroll
                    for (int s = 0; s < 4; ++s) xa = __builtin_amdgcn_mfma_f32_32x32x16_bf16(ldfrag_l(st + SQA_M3 + (32 * i + r) * SQ_PITCH, s, h), xb[s], xa, 0, 0, 0);
                    if (i == 0) xn0 = xa; else xn1 = xa;
                }
                x[0] = xn0; x[1] = xn1;
            }
            __syncthreads();
        }
    } else {
        __syncthreads();
#pragma unroll 1
        for (int ch = 0; ch <= RNC; ++ch) {
            if (ch >= 1) {
                const int cy = ch - 1;
                unsigned char* st = L + SQ_B0 + (cy & 1) * SQB_BYTES;
                const unsigned char* xbuf = L + SQ_XB + ((cy & 1) * 2 + vh) * 4096 + lane * 16;
                bf16x8 xb[4];
#pragma unroll
                for (int s = 0; s < 4; ++s) xb[s] = *(const bf16x8*)(xbuf + s * 1024);
#pragma unroll
                for (int i = 0; i < 2; ++i) {
                    f32x16 ya;
#pragma unroll
                    for (int g = 0; g < 16; ++g) ya[g] = *((const float*)(st + SQB_Y) + (32 * i + crow(g, h)) * 64 + vh * 32 + r);
#pragma unroll
                    for (int s = 0; s < 4; ++s) ya = __builtin_amdgcn_mfma_f32_32x32x16_bf16(ldfrag_l(st + SQB_M2 + (32 * i + r) * SQ_PITCH, s, h), xb[s], ya, 0, 0, 0);
#pragma unroll
                    for (int g = 0; g < 16; ++g) *((float*)(st + SQB_Y) + (32 * i + crow(g, h)) * 64 + vh * 32 + r) = ya[g];
                }
            }
            __syncthreads();
        }
    }
}
DI void phase_mixers2(const Ctx& c, int l) {
    const int G = gridDim.x, bid = blockIdx.x;
    if (G >= 128) {
        if (bid < 16) phase_rwkv_seq_block(c, l, bid);
        else for (int u = bid - 16; u < 2 * S5N * 4; u += G - 16) phase_s5_final_unit<false>(c, l, u);
    } else {
        for (int u = bid; u < 16; u += G) phase_rwkv_seq_block(c, l, u);
        for (int u = bid; u < 2 * S5N * 4; u += G) phase_s5_final_unit<false>(c, l, u);
    }
}

DI void phase_post(const Ctx& c, int l) {
    unsigned char* ws = c.ws; const int lane = c.lane;
    const float* YF = (const float*)(ws + WS_BUFB); const float* YB = YF + (size_t)NZ * 256;
    const bf16_t* RB = (const bf16_t*)(ws + WS_EXPW + MX_RB); const bf16_t* VB = (const bf16_t*)(ws + WS_EXPW + MX_VB);
    const bf16_t* SKD = (const bf16_t*)(ws + WS_P + P_PR) + (size_t)4 * NZ * 256; const bf16_t* GG = (const bf16_t*)(ws + WS_MISC + MS_GG);
    bf16_t* Ycat = (bf16_t*)(ws + WS_BUFA);
    const float* r_k = c.in[21] + l * 256; const float* lg = c.in[22] + l * 256; const float* lb = c.in[23] + l * 256;
    for (int z = blockIdx.x * 8 + c.wave; z < NZ; z += gridDim.x * 8) {
        const size_t o = (size_t)z * 256 + lane * 4;
        const float4 yf = *(const float4*)(YF + o), yb = *(const float4*)(YB + o);
        const float y0 = yf.x + yb.x, y1 = yf.y + yb.y, y2 = yf.z + yb.z, y3 = yf.w + yb.w;
        const float mean = sum16(y0 + y1 + y2 + y3) * (1.f / 64.f);
        const float d0 = y0 - mean, d1 = y1 - mean, d2 = y2 - mean, d3 = y3 - mean;
        const float var = sum16(d0 * d0 + d1 * d1 + d2 * d2 + d3 * d3) * (1.f / 64.f);
        const float rs = rsqrtf(var + 64e-5f);
        float r[4], v[4], k0[4], k1[4], gg[4];
        unpack4(*(const u32x2*)(RB + o), r); unpack4(*(const u32x2*)(VB + o), v); unpack4(*(const u32x2*)(SKD + o), k0); unpack4(*(const u32x2*)(SKD + (size_t)NZ * 256 + o), k1);
        unpack4(*(const u32x2*)(GG + o), gg);
        const float4 rk = *(const float4*)(r_k + lane * 4), g4 = *(const float4*)(lg + lane * 4), b4 = *(const float4*)(lb + lane * 4);
        const float bs = sum16(r[0] * (k0[0] + k1[0]) * rk.x + r[1] * (k0[1] + k1[1]) * rk.y + r[2] * (k0[2] + k1[2]) * rk.z + r[3] * (k0[3] + k1[3]) * rk.w);
        *(u32x2*)(Ycat + (size_t)z * D + 256 + lane * 4) = pack4((d0 * rs * g4.x + b4.x + bs * v[0]) * gg[0], (d1 * rs * g4.y + b4.y + bs * v[1]) * gg[1],
                                                                (d2 * rs * g4.z + b4.z + bs * v[2]) * gg[2], (d3 * rs * g4.w + b4.w + bs * v[3]) * gg[3]);
    }
    {
        const bf16_t* ZG = (const bf16_t*)(ws + WS_MISC + MS_ZG); const bf16_t* W = (const bf16_t*)(ws + WS_WSM + OFF_GLUT + l * SZ_GLUT);
        const float* gb = c.in[33] + l * 256;
        for (int u = blockIdx.x; u < (NZ / 256) * 2; u += gridDim.x) {
            const int mt = u / 2, nt = u % 2, r0 = mt * 256, c0 = nt * 128;
            gemm_tile<4, 0>(c, 256, [&](int i) { return ZG + (size_t)(r0 + i) * 256; }, [&](int i) { return W + (size_t)(c0 + i) * 256; }, NoHook(),
                [&](f32x4 (&acc)[4][4], int wr, int wc, int fr, int fq) {
#pragma unroll
                    for (int n = 0; n < 4; ++n) {
                        const int col = c0 + wc + n * 16 + fq * 4; const float4 bb = *(const float4*)(gb + col);
#pragma unroll
                        for (int m = 0; m < 4; ++m) {
                            const int row = r0 + wr + m * 16 + fr; const f32x4 v = acc[m][n];
                            float zg[4]; unpack4(*(const u32x2*)(ZG + (size_t)row * 256 + col), zg);
                            *(u32x2*)(Ycat + (size_t)row * D + 512 + col) = pack4(zg[0] * sigmoidf_(v[0] + bb.x), zg[1] * sigmoidf_(v[1] + bb.y), zg[2] * sigmoidf_(v[2] + bb.z), zg[3] * sigmoidf_(v[3] + bb.w));
                        }
                    }
                });
        }
    }
}

DI bool skip_mt(int l, int mt) { return l == NL - 1 && (mt % 33) == 0; }
DI void phase_merge1(const Ctx& c, int l) {
    const bf16_t* Ycat = (const bf16_t*)(c.ws + WS_BUFA); const bf16_t* W = (const bf16_t*)(c.ws + WS_WSM + OFF_WBT + l * SZ_WBT);
    const bf16_t* GT = (const bf16_t*)(c.ws + WS_GT); bf16_t* MG = (bf16_t*)(c.ws + WS_BUFB);
    if (blockIdx.x == 0 && c.tid < 32) ((unsigned*)(c.ws + WS_CTL))[CW_CNT + l * 32 + c.tid] = 0u;
    for (int u = blockIdx.x; u < (NZ / 256) * 8; u += gridDim.x) {
        const int mt = u / 8, nt = u % 8, r0 = mt * 256, c0 = nt * 128;
        if (skip_mt(l, mt)) continue;
        f32x4 macc[4][4];
#pragma unroll
        for (int m = 0; m < 4; ++m)
#pragma unroll
            for (int n = 0; n < 4; ++n) macc[m][n] = (f32x4){0.f, 0.f, 0.f, 0.f};
        gemm_tile<4, 256>(c, 1024, [&](int i) { return Ycat + (size_t)(r0 + i) * D; }, [&](int i) { return W + (size_t)(c0 + i) * D; },
            [&](f32x4 (&acc)[4][4], int seg, int wr, int wc, int fr, int fq) {
#pragma unroll
                for (int m = 0; m < 4; ++m)
#pragma unroll
                    for (int n = 0; n < 4; ++n) {
                        float g[4]; unpack4(*(const u32x2*)(GT + (size_t)(r0 + wr + m * 16 + fr) * 4096 + seg * 1024 + c0 + wc + n * 16 + fq * 4), g);
                        macc[m][n][0] += g[0] * acc[m][n][0]; macc[m][n][1] += g[1] * acc[m][n][1]; macc[m][n][2] += g[2] * acc[m][n][2]; macc[m][n][3] += g[3] * acc[m][n][3];
                        acc[m][n] = (f32x4){0.f, 0.f, 0.f, 0.f};
                    }
            },
            [&](f32x4 (&)[4][4], int wr, int wc, int fr, int fq) {
#pragma unroll
                for (int m = 0; m < 4; ++m)
#pragma unroll
                    for (int n = 0; n < 4; ++n)
                        *(u32x2*)(MG + (size_t)(r0 + wr + m * 16 + fr) * D + c0 + wc + n * 16 + fq * 4) = pack4(macc[m][n][0], macc[m][n][1], macc[m][n][2], macc[m][n][3]);
            });
    }
}
struct EpiMerge2 {
    static constexpr bool PERM = false, AFTER_DRAIN = false;
    float* H; const float* modv; int l;
    DI void operator()(const pg8::f32x4 (&acc)[2][2][4][2], const pg8::Unit& u, int wr, int wc, int fr, int fq) const {
        if (skip_mt(l, u.pm)) return;
        const int sel = (u.pm % 33) == 0 ? 2 : u.pm / 33;
        const int row0 = u.pm * 256 + wr * 64 + fr, col0 = u.pn * 256 + wc * 32 + 4 * fq;
#pragma unroll
        for (int bj = 0; bj < 2; ++bj)
#pragma unroll
            for (int n = 0; n < 2; ++n) {
                const int col = col0 + bj * 128 + n * 16; const float4 m2 = *(const float4*)(modv + ((size_t)l * 3 + sel) * 6144 + 2 * 1024 + col);
#pragma unroll
                for (int ai = 0; ai < 2; ++ai)
#pragma unroll
                    for (int m = 0; m < 4; ++m) {
                        float4* hp = (float4*)(H + (size_t)(row0 + ai * 128 + m * 16) * D + col); float4 hv = *hp; const pg8::f32x4 v = acc[ai][bj][m][n];
                        hv.x += m2.x * v[0]; hv.y += m2.y * v[1]; hv.z += m2.z * v[2]; hv.w += m2.w * v[3]; *hp = hv;
                    }
            }
    }
};
struct LatOrder {
    int G, c;
    DI bool next(int i, pg8::Unit& u) const { const int L = i * G + c; if (L >= 256) return false; const int pl = L >> 2; u.pm = (pl >> 5) * 33 + 1 + (pl & 31); u.pn = L & 3; return true; }
    DI void a_ready(const pg8::Unit&) const {}
    DI void done(const pg8::Unit&) const {}
};
DI void phase_merge2(const Ctx& c, int l) {
    EpiMerge2 E; E.H = (float*)(c.ws + WS_H); E.modv = (const float*)(c.ws + WS_WSM + OFF_MODV); E.l = l;
    pg8::Gemm g{(const bf16_t*)(c.ws + WS_BUFB), (const bf16_t*)(c.ws + WS_WSM + OFF_WOUTT + l * SZ_WOUTT), NZ, 1024, 1024, 1024, 1024};
    __syncthreads();
    if (l == NL - 1) {
        LatOrder S; S.G = (int)gridDim.x; S.c = (int)blockIdx.x;
        pg8::gemm_phase<EpiMerge2, LatOrder, false>((PG8_LAS unsigned char*)c.smem, g, S, E, nullptr, c.tid);
    } else {
        pg8::StaticOrder S; S.init(NZ, 1024, (int)gridDim.x, (int)blockIdx.x);
        pg8::gemm_phase<EpiMerge2, pg8::StaticOrder, false>((PG8_LAS unsigned char*)c.smem, g, S, E, nullptr, c.tid);
    }
}

constexpr int RT_PITCH = 68;
DI void phase_norm2_route(const Ctx& c, int l) {
    unsigned char* ws = c.ws; const int lane = c.lane, wave = c.wave, tid = c.tid;
    const float* modv = (const float*)(ws + WS_WSM + OFF_MODV); const float* H = (const float*)(ws + WS_H);
    bf16_t* XN = (bf16_t*)(ws + WS_BUFA); const float* g2 = c.in[7] + l * 1024;
    const float* rwt = (const float*)(ws + WS_WSM + OFF_RWT) + (size_t)l * 36 * 1024;
    const float* bg = c.in[42] + l * 4; const float* be = c.in[44] + l * 32;
    unsigned* cnt = (unsigned*)(ws + WS_CTL) + CW_CNT + l * 32;
    int* list = (int*)(ws + WS_GT + GT_LIST); float* lw = (float*)(ws + WS_GT + GT_LW);
    float* red = (float*)c.smem + wave * 36 * RT_PITCH;
    int* hist = (int*)(c.smem + 8 * 36 * RT_PITCH * 4);
    int* sel = hist + 64;
    float* selw = (float*)(sel + 128);
    const int ngroups = (l == NL - 1) ? (NB * SEQ / 64) : (NZ / 64);
    for (int grp = blockIdx.x; grp < ngroups; grp += gridDim.x) {
        __syncthreads();
        if (tid < 32) hist[tid] = 0;
        __syncthreads();
        for (int i = 0; i < 8; ++i) {
            const int rl = wave * 8 + i;
            int row;
            if (l == NL - 1) { const int rr = grp * 64 + rl; row = (rr / SEQ) * TZ + CTX + (rr % SEQ); } else row = grp * 64 + rl;
            const int b = row / TZ, s = row % TZ, sel3 = s < CTX ? 2 : b;
            float x[16]; float ss = 0.f;
#pragma unroll
            for (int q = 0; q < 4; ++q) { const float4 v = *(const float4*)(H + (size_t)row * D + q * 256 + lane * 4); x[q * 4] = v.x; x[q * 4 + 1] = v.y; x[q * 4 + 2] = v.z; x[q * 4 + 3] = v.w;
                ss += v.x * v.x + v.y * v.y + v.z * v.z + v.w * v.w; }
            ss = wave_sum(ss);
            const float rs = rsqrtf(ss * (1.f / 1024.f) + 1e-6f);
#pragma unroll
            for (int q = 0; q < 4; ++q) {
                const int col = q * 256 + lane * 4;
                const float4 g = *(const float4*)(g2 + col), m3 = *(const float4*)(modv + ((size_t)l * 3 + sel3) * 6144 + 3 * 1024 + col), m4 = *(const float4*)(modv + ((size_t)l * 3 + sel3) * 6144 + 4 * 1024 + col);
                x[q * 4] = x[q * 4] * rs * g.x * (1.f + m4.x) + m3.x; x[q * 4 + 1] = x[q * 4 + 1] * rs * g.y * (1.f + m4.y) + m3.y;
                x[q * 4 + 2] = x[q * 4 + 2] * rs * g.z * (1.f + m4.z) + m3.z; x[q * 4 + 3] = x[q * 4 + 3] * rs * g.w * (1.f + m4.w) + m3.w;
                *(u32x2*)(XN + (size_t)row * D + col) = pack4(x[q * 4], x[q * 4 + 1], x[q * 4 + 2], x[q * 4 + 3]);
            }
#pragma unroll 4
            for (int e = 0; e < 36; ++e) {
                float a = 0.f;
#pragma unroll
                for (int q = 0; q < 4; ++q) { const float4 w = *(const float4*)(rwt + (size_t)e * 1024 + q * 256 + lane * 4); a += x[q * 4] * w.x + x[q * 4 + 1] * w.y + x[q * 4 + 2] * w.z + x[q * 4 + 3] * w.w; }
                red[e * RT_PITCH + lane] = a;
            }
            __builtin_amdgcn_wave_barrier();
            float lg = -1e30f;
            if (lane < 36) {
                float s0 = 0.f, s1 = 0.f, s2 = 0.f, s3 = 0.f;
#pragma unroll
                for (int q = 0; q < 16; ++q) { const float4 v = *(const float4*)(red + lane * RT_PITCH + q * 4); s0 += v.x; s1 += v.y; s2 += v.z; s3 += v.w; }
                lg = (s0 + s1) + (s2 + s3) + (lane < 4 ? bg[lane] : be[lane - 4]);
            }
            __builtin_amdgcn_wave_barrier();
            float gm = -1e30f; int gsel = 0; float gl[4];
#pragma unroll
            for (int g = 0; g < 4; ++g) { gl[g] = __shfl(lg, g, 64); if (gl[g] > gm) { gm = gl[g]; gsel = g; } }
            const float gs = __expf(gl[0] - gm) + __expf(gl[1] - gm) + __expf(gl[2] - gm) + __expf(gl[3] - gm);
            const float pg = 1.f / gs;
            float l1 = -1e30f, l2 = -1e30f; int e1 = 0, e2 = 0;
#pragma unroll
            for (int j = 0; j < 8; ++j) {
                const float v = __shfl(lg, 4 + gsel * 8 + j, 64); const int e = gsel * 8 + j;
                if (v > l1) { l2 = l1; e2 = e1; l1 = v; e1 = e; } else if (v > l2) { l2 = v; e2 = e; }
            }
            const float tt = __expf(l2 - l1), w1 = pg / (1.f + tt), w2 = pg * tt / (1.f + tt);
            if (lane == 0) {
                const int r1 = atomicAdd(&hist[e1], 1), r2 = atomicAdd(&hist[e2], 1);
                sel[rl * 2] = e1 | (r1 << 8); sel[rl * 2 + 1] = e2 | (r2 << 8); selw[rl * 2] = w1; selw[rl * 2 + 1] = w2;
            }
        }
        __syncthreads();
        if (tid < 32) hist[32 + tid] = (int)atomicAdd(&cnt[tid], (unsigned)hist[tid]);
        __syncthreads();
        if (tid < 128) {
            const int rl = tid >> 1, j = tid & 1, sv = sel[tid], e = sv & 255, rk = sv >> 8;
            int row;
            if (l == NL - 1) { const int rr = grp * 64 + rl; row = (rr / SEQ) * TZ + CTX + (rr % SEQ); } else row = grp * 64 + rl;
            const size_t pos = (size_t)e * MOE_CAP + hist[32 + e] + rk;
            list[pos] = row * 2 + j; lw[pos] = selw[tid];
        }
    }
    phase_expert_convert(c, l);
}

DI void moe_prefix(const Ctx& c, int l, int* tiles  , int* cnts  ) {
    __syncthreads();
    if (c.tid == 0) {
        const unsigned* cnt = (const unsigned*)(c.ws + WS_CTL) + CW_CNT + l * 32; int acc = 0;
        for (int e = 0; e < 32; ++e) { const int n = (int)__hip_atomic_load(cnt + e, __ATOMIC_RELAXED, __HIP_MEMORY_SCOPE_AGENT); cnts[e] = n; tiles[e] = acc; acc += (n + 127) / 128; }
        tiles[32] = acc;
    }
    __syncthreads();
}
DI void phase_moe1(const Ctx& c, int l) {
    unsigned char* ws = c.ws;
    int* tiles = (int*)(c.smem + 120 * 1024); int* cnts = tiles + 40;
    moe_prefix(c, l, tiles, cnts);
    const bf16_t* XN = (const bf16_t*)(ws + WS_BUFA); bf16_t* HM = (bf16_t*)(ws + WS_GT + GT_HM); const int* list = (const int*)(ws + WS_GT + GT_LIST);
    const int nt_total = tiles[32];
    for (int u = blockIdx.x; u < nt_total * 4; u += gridDim.x) {
        const int mtg = u >> 2, nt = u & 3;
        int e = 0;
        for (int k = 1; k < 32; ++k) if (tiles[k] <= mtg) e = k;
        const int mt = mtg - tiles[e], n_e = cnts[e];
        const int* le = list + (size_t)e * MOE_CAP;
        const bf16_t* W = (const bf16_t*)(ws + WS_EXPW + (size_t)e * SZ_WGU);
        gemm_tile<2, 0>(c, 1024,
            [&](int i) { int p = mt * 128 + i; if (p >= n_e) p = n_e - 1; return XN + (size_t)(le[p] >> 1) * D; },
            [&](int i) { return W + (size_t)(nt * 256 + i) * D; }, NoHook(),
            [&](f32x4 (&acc)[4][4], int wr, int wc, int fr, int fq) {
#pragma unroll
                for (int np = 0; np < 2; ++np) {
                    const int hc = (nt * 256 + wc + np * 32) / 2 + fq * 4;
#pragma unroll
                    for (int m = 0; m < 4; ++m) {
                        const int p = mt * 128 + wr + m * 16 + fr;
                        const f32x4 g = acc[m][np * 2], uu = acc[m][np * 2 + 1];
                        *(u32x2*)(HM + ((size_t)mtg * 128 + wr + m * 16 + fr) * 512 + hc) = pack4(siluf_(g[0]) * uu[0], siluf_(g[1]) * uu[1], siluf_(g[2]) * uu[2], siluf_(g[3]) * uu[3]);
                        (void)p;
                    }
                }
            });
    }
}
DI void phase_moe2(const Ctx& c, int l) {
    unsigned char* ws = c.ws;
    int* tiles = (int*)(c.smem + 120 * 1024); int* cnts = tiles + 40;
    moe_prefix(c, l, tiles, cnts);
    const bf16_t* HM = (const bf16_t*)(ws + WS_GT + GT_HM); const int* list = (const int*)(ws + WS_GT + GT_LIST); const float* lw = (const float*)(ws + WS_GT + GT_LW);
    bf16_t* Y2 = (bf16_t*)(ws + WS_P);
    const int nt_total = tiles[32];
    for (int u = blockIdx.x; u < nt_total * 4; u += gridDim.x) {
        const int mtg = u >> 2, nt = u & 3;
        int e = 0;
        for (int k = 1; k < 32; ++k) if (tiles[k] <= mtg) e = k;
        const int mt = mtg - tiles[e], n_e = cnts[e];
        const int* le = list + (size_t)e * MOE_CAP; const float* lwe = lw + (size_t)e * MOE_CAP;
        const bf16_t* W = (const bf16_t*)(ws + WS_EXPW + 32 * SZ_WGU + (size_t)e * SZ_WD);
        gemm_tile<2, 0>(c, 512,
            [&](int i) { return HM + ((size_t)mtg * 128 + i) * 512; },
            [&](int i) { return W + (size_t)(nt * 256 + i) * 512; }, NoHook(),
            [&](f32x4 (&acc)[4][4], int wr, int wc, int fr, int fq) {
#pragma unroll
                for (int m = 0; m < 4; ++m) {
                    const int p = mt * 128 + wr + m * 16 + fr;
                    if (p < n_e) {
                        const int ent = le[p]; const float wt = lwe[p];
                        bf16_t* yrow = Y2 + ((size_t)(ent & 1) * NZ + (ent >> 1)) * D + nt * 256 + wc + fq * 4;
#pragma unroll
                        for (int n = 0; n < 4; ++n) *(u32x2*)(yrow + n * 16) = pack4(wt * acc[m][n][0], wt * acc[m][n][1], wt * acc[m][n][2], wt * acc[m][n][3]);
                    }
                }
            });
    }
}

constexpr int LDS_BYTES = 128 * 1024 + 256;
constexpr int STEPS_PER_LAYER = 12, N_STEPS = 2 + NL * STEPS_PER_LAYER;
#ifndef FUSED
#define FUSED 1
#endif

DI const void* launder_ptr(const void* p) {
    const unsigned long long v = (unsigned long long)p;
    unsigned lo = __builtin_amdgcn_readfirstlane((unsigned)v), hi = __builtin_amdgcn_readfirstlane((unsigned)(v >> 32));
    asm volatile("" : "+s"(lo), "+s"(hi) :: "memory");
    return (const void*)(((unsigned long long)hi << 32) | lo);
}
template <int KIND> DI void run_step(const Ctx& c0, int l) {
#ifdef PHM
    if (!((PHM >> KIND) & 1)) return;
#endif
    Ctx c = c0;
    { int z = 0; asm volatile("" : "+s"(z) :: "memory"); c.in = c0.in + z; c.ws = c0.ws + z; c.out = c0.out + z; }
    { int t = c0.tid; asm volatile("" : "+v"(t)); c.tid = t; c.lane = t & 63; c.wave = __builtin_amdgcn_readfirstlane(t >> 6); }
    if (KIND == 0) phase_prologue(c);
    if (KIND == 1) phase_norm1(c, l);
    if (KIND == 2) phase_inproj(c, l);
    if (KIND == 3) { phase_prep(c, l); for (int u = blockIdx.x; u < 2 * S5N * 4; u += gridDim.x) phase_s5_final_unit<true>(c, l, u); }
    if (KIND == 4) { phase_small_gemms(c, l); phase_s5_carry(c, l); }
    if (KIND == 5) { phase_attention(c, l); phase_rwkv_chunks(c, l); }
    if (KIND == 6) phase_mixers2(c, l);
    if (KIND == 7) phase_post(c, l);
    if (KIND == 8) phase_merge1(c, l);
    if (KIND == 9) phase_merge2(c, l);
    if (KIND == 10) phase_norm2_route(c, l);
    if (KIND == 11) phase_moe1(c, l);
    if (KIND == 12) phase_moe2(c, l);
    if (KIND == 13) phase_final(c);
}

#if !FUSED
template <int KIND> __global__ void __launch_bounds__(NTHR, 2) k_step(Args a) {
    extern __shared__ __attribute__((aligned(16))) unsigned char lds[];
    Ctx c; c.in = a.in; c.out = a.out; c.ws = a.ws; c.smem = lds; c.tid = threadIdx.x; c.lane = threadIdx.x & 63; c.wave = __builtin_amdgcn_readfirstlane(threadIdx.x >> 6);
    run_step<KIND>(c, a.s_lo);
}
template <int KIND> static void launch_step(const Args& a, int grid, hipStream_t stream) {
    static bool attr = false;
    if (!attr) { (void)hipFuncSetAttribute((const void*)k_step<KIND>, hipFuncAttributeMaxDynamicSharedMemorySize, LDS_BYTES); attr = true; }
    hipLaunchKernelGGL(k_step<KIND>, dim3(grid), dim3(NTHR), LDS_BYTES, stream, a);
}
#else
__global__ void __launch_bounds__(NTHR, 2) fwd_kernel(Args a) {
    extern __shared__ __attribute__((aligned(16))) unsigned char lds[];
    Ctx c; c.in = a.in; c.out = a.out; c.ws = a.ws; c.smem = lds; c.tid = threadIdx.x; c.lane = threadIdx.x & 63; c.wave = __builtin_amdgcn_readfirstlane(threadIdx.x >> 6);
    volatile LAS unsigned* xbw = (volatile LAS unsigned*)(lds + LDS_BYTES - 16);
    for (int i = threadIdx.x; i < LDS_BYTES / 16; i += NTHR) ((uint4*)lds)[i] = make_uint4(0u, 0u, 0u, 0u);
    __syncthreads();
    if (threadIdx.x == 0) { xbw[0] = 0u; xbw[1] = 0u; }
    __syncthreads();
    XcdBarrier bar = xcd_barrier_post((unsigned*)(a.ws + WS_CTL) + CW_BAR, xbw);
#ifndef REP_MASK
#define REP_MASK 0
#endif
#define GBAR() do { XcdBarrier bb = bar; int zz = 0; asm volatile("" : "+s"(zz) :: "memory"); bb.bar = bar.bar + zz; xcd_barrier(bb); } while (0)
#define STEP(K, L) do { run_step<K>(c, L); GBAR(); if ((REP_MASK >> K) & 1) { run_step<K>(c, L); GBAR(); } } while (0)
    STEP(0, 0);
    for (int l = 0; l < NL; ++l) {
        STEP(1, l); STEP(2, l); STEP(3, l); STEP(4, l); STEP(5, l); STEP(6, l); STEP(7, l); STEP(8, l); STEP(9, l); STEP(10, l); STEP(11, l); STEP(12, l);
    }
#undef STEP
    run_step<13>(c, 0);
}
#endif

extern "C" void kernel_launch(void* const* d_in, const int* in_sizes, int n_in, void* d_out, int out_size, void* d_ws, size_t ws_size, hipStream_t stream) {
    static int grid = 0;
    if (grid == 0) {
        if (n_in != 49 || out_size != NB * SEQ * D || ws_size < WS_END) { fprintf(stderr, "kernel_launch: unexpected problem (n_in %d out %d ws %zu need %zu)\n", n_in, out_size, ws_size, (size_t)WS_END); grid = -1; return; }
        int dev = 0, cus = 0;
        if (hipGetDevice(&dev) != hipSuccess || hipDeviceGetAttribute(&cus, hipDeviceAttributeMultiprocessorCount, dev) != hipSuccess) { grid = -1; return; }
#if FUSED
        int per_cu = 0;
        if (hipFuncSetAttribute((const void*)fwd_kernel, hipFuncAttributeMaxDynamicSharedMemorySize, LDS_BYTES) != hipSuccess) { fprintf(stderr, "kernel_launch: hipFuncSetAttribute failed\n"); grid = -1; return; }
        if (hipOccupancyMaxActiveBlocksPerMultiprocessor(&per_cu, (const void*)fwd_kernel, NTHR, LDS_BYTES) != hipSuccess || per_cu < 1) { fprintf(stderr, "kernel_launch: occupancy query says %d\n", per_cu); }
        (void)hipGetLastError();
#endif
        grid = cus;
    }
    if (grid < 0) return;
    (void)hipMemsetAsync((char*)d_ws + WS_CTL, 0, CTL_BYTES, stream);
    Args a{};
    for (int i = 0; i < 49; ++i) a.in[i] = (const float*)d_in[i];
    a.out = (float*)d_out; a.ws = (unsigned char*)d_ws;
#if !FUSED
    a.s_lo = 0; a.s_hi = 0; launch_step<0>(a, grid, stream);
    for (int l = 0; l < NL; ++l) {
        a.s_lo = l;
        launch_step<1>(a, grid, stream); launch_step<2>(a, grid, stream); launch_step<3>(a, grid, stream); launch_step<4>(a, grid, stream);
        launch_step<5>(a, grid, stream); launch_step<6>(a, grid, stream); launch_step<7>(a, grid, stream); launch_step<8>(a, grid, stream);
        launch_step<9>(a, grid, stream); launch_step<10>(a, grid, stream); launch_step<11>(a, grid, stream); launch_step<12>(a, grid, stream);
    }
    a.s_lo = 0; launch_step<13>(a, grid, stream);
#else
    a.s_lo = 0; a.s_hi = N_STEPS; hipLaunchKernelGGL(fwd_kernel, dim3(grid), dim3(NTHR), LDS_BYTES, stream, a);
#endif
}
```

```cpp
#include <hip/hip_runtime.h>
#include <stdint.h>
#include <stdio.h>

#define DI __device__ __forceinline__
#define LAS __attribute__((address_space(3)))
typedef unsigned short bf16_t;
typedef short bf16x8 __attribute__((ext_vector_type(8)));
typedef short s16x4 __attribute__((ext_vector_type(4)));
typedef float f32x4 __attribute__((ext_vector_type(4)));
typedef float f32x16 __attribute__((ext_vector_type(16)));
typedef float f32x2 __attribute__((ext_vector_type(2)));
typedef __bf16 bf16x2v __attribute__((ext_vector_type(2)));
typedef unsigned u32x4 __attribute__((ext_vector_type(4)));
typedef unsigned u32x2 __attribute__((ext_vector_type(2)));

constexpr int D = 1024, NB = 2, SEQ = 8192, CTX = 256, TZ = 8448, NZ = 16896, NL = 2;
constexpr int NIN = 6560, NINP = 6656;
constexpr int NTHR = 512;
constexpr float LOG2E = 1.4426950408889634f;

#define XB_TMO      128
#define XB_XCNT(j)  (256  + 64 * (j))
#define XB_XSUB(j)  (1280 + 64 * (j))
#define XB_XGEN(j)  (2304 + 64 * (j))
#define XB_TOP      3328
#define XB_TOPGEN   3392
#define XCD_BAR_WORDS 3456
#define XB_SPIN_CAP (1u << 18)

__device__ __forceinline__ unsigned xb_ld(unsigned* p)              { return __hip_atomic_load(p, __ATOMIC_RELAXED, __HIP_MEMORY_SCOPE_AGENT); }
__device__ __forceinline__ unsigned xb_add(unsigned* p, unsigned v) { return __hip_atomic_fetch_add(p, v, __ATOMIC_RELAXED, __HIP_MEMORY_SCOPE_AGENT); }
__device__ __forceinline__ unsigned xb_xcc_id() { return (unsigned)__builtin_amdgcn_s_getreg((3 << 11) | 20) & 0xFu; }
#define XB_SPIN(cond, bar) do { unsigned _sp = 0; while (cond) { __builtin_amdgcn_s_sleep(1); \
    if ((++_sp & 255u) == 0u) { if (xb_ld(&(bar)[XB_TMO])) break; if (_sp > XB_SPIN_CAP) { atomicAdd(&(bar)[XB_TMO], 1u); break; } } } } while (0)

struct XcdBarrier { unsigned* bar; unsigned x; volatile LAS unsigned* st; };

__device__ __forceinline__ XcdBarrier xcd_barrier_post(unsigned* bar, volatile LAS unsigned* st) {
    XcdBarrier b; b.bar = bar; b.x = xb_xcc_id(); b.st = st;
    if (threadIdx.x == 0) (void)xb_add(&bar[XB_XCNT(b.x)], 1u);
    return b;
}
__device__ __forceinline__ void xcd_barrier_complete(unsigned* bar, unsigned x, unsigned& nloc, unsigned& nx) {
    const unsigned G = gridDim.x * gridDim.y * gridDim.z;
    unsigned sum, cnt, mine, sp = 0u;
    for (;;) {
        sum = 0u; cnt = 0u; mine = 0u;
#pragma unroll
        for (unsigned j = 0; j < 16; ++j) { const unsigned c = xb_ld(&bar[XB_XCNT(j)]); sum += c; cnt += (c > 0u) ? 1u : 0u; mine = (j == x) ? c : mine; }
        if (sum == G) break;
        __builtin_amdgcn_s_sleep(1);
        if ((++sp & 255u) == 0u) { if (xb_ld(&bar[XB_TMO])) break; if (sp > XB_SPIN_CAP) { atomicAdd(&bar[XB_TMO], 1u); break; } }
    }
    nloc = mine > 0u ? mine : 1u; nx = cnt > 0u ? cnt : 1u;
}
__device__ __forceinline__ void xcd_barrier(const XcdBarrier& b) {
    asm volatile("s_waitcnt vmcnt(0)" ::: "memory");
    __syncthreads();
    if (threadIdx.x == 0) {
        unsigned* bar = b.bar;
        __builtin_amdgcn_s_waitcnt(0);
        unsigned nloc = b.st[0], nx = b.st[1];
        if (nloc == 0u) { xcd_barrier_complete(bar, b.x, nloc, nx); b.st[0] = nloc; b.st[1] = nx; }
        const unsigned old = xb_add(&bar[XB_XSUB(b.x)], 1u);
        const unsigned gen = old / nloc;
        if (old + 1u == (gen + 1u) * nloc) {
            __builtin_amdgcn_fence(__ATOMIC_RELEASE, "agent");
            asm volatile("s_waitcnt vmcnt(0)" ::: "memory");
            const unsigned og = xb_add(&bar[XB_TOP], 1u);
            const unsigned tg = og / nx;
            if (og + 1u == (tg + 1u) * nx) xb_add(&bar[XB_TOPGEN], 1u);
            else XB_SPIN(xb_ld(&bar[XB_TOPGEN]) == tg, bar);
            __builtin_amdgcn_fence(__ATOMIC_ACQUIRE, "agent");
            xb_add(&bar[XB_XGEN(b.x)], 1u);
            asm volatile("s_waitcnt vmcnt(0)" ::: "memory");
        } else {
            XB_SPIN(xb_ld(&bar[XB_XGEN(b.x)]) == gen, bar);
            __builtin_amdgcn_fence(__ATOMIC_ACQUIRE, "agent");
            asm volatile("s_waitcnt vmcnt(0)" ::: "memory");
        }
    }
    __syncthreads();
}

DI float bf2f(bf16_t v) { return __uint_as_float((unsigned)v << 16); }
DI unsigned pack2(float a, float b) { f32x2 v = {a, b}; bf16x2v r = __builtin_convertvector(v, bf16x2v); return __builtin_bit_cast(unsigned, r); }
DI bf16_t f2bf(float a) { return (bf16_t)(pack2(a, 0.f) & 0xffffu); }
DI float lo2f(unsigned u) { return __uint_as_float(u << 16); }
DI float hi2f(unsigned u) { return __uint_as_float(u & 0xffff0000u); }
DI float wave_sum(float v) {
#pragma unroll
    for (int m = 32; m >= 1; m >>= 1) v += __shfl_xor(v, m, 64);
    return v;
}
DI float sum16(float v) {
#pragma unroll
    for (int m = 8; m >= 1; m >>= 1) v += __shfl_xor(v, m, 64);
    return v;
}
DI float sigmoidf_(float x) { return 1.f / (1.f + __expf(-x)); }
DI float siluf_(float x) { return x / (1.f + __expf(-x)); }
DI float gelu_tanh(float x) { const float u = 0.7978845608028654f * (x + 0.044715f * x * x * x); return 0.5f * x * (1.f + tanhf(u)); }
DI void unpack4(u32x2 u, float (&f)[4]) { f[0] = lo2f(u.x); f[1] = hi2f(u.x); f[2] = lo2f(u.y); f[3] = hi2f(u.y); }
DI u32x2 pack4(float a, float b, float c, float d) { u32x2 r; r.x = pack2(a, b); r.y = pack2(c, d); return r; }

constexpr size_t algn(size_t x) { return (x + 255) & ~(size_t)255; }
constexpr size_t WS_CTL   = 0;
constexpr size_t CTL_BYTES = 64 * 1024;
constexpr size_t WS_H     = WS_CTL + CTL_BYTES;
constexpr size_t WS_WSM   = WS_H + (size_t)NZ * D * 4;
constexpr size_t SZ_WINT = (size_t)NINP * D * 2, SZ_WUQT = 384 * 256 * 2, SZ_WUKVT = 512 * 128 * 2, SZ_W2T = 512 * 64 * 2, SZ_A2T = 512 * 64 * 2,
                 SZ_G2T = 256 * 128 * 2, SZ_GLUT = 256 * 256 * 2, SZ_WBT = (size_t)D * D * 2, SZ_WOUTT = (size_t)D * D * 2;
constexpr size_t OFF_WINT = 0, OFF_WUQT = OFF_WINT + NL * SZ_WINT, OFF_WUKVT = OFF_WUQT + NL * SZ_WUQT, OFF_W2T = OFF_WUKVT + NL * SZ_WUKVT,
                 OFF_A2T = OFF_W2T + NL * SZ_W2T, OFF_G2T = OFF_A2T + NL * SZ_A2T, OFF_GLUT = OFF_G2T + NL * SZ_G2T, OFF_WBT = OFF_GLUT + NL * SZ_GLUT,
                 OFF_WOUTT = OFF_WBT + NL * SZ_WBT, OFF_MODV = OFF_WOUTT + NL * SZ_WOUTT,
                 OFF_ROPE = OFF_MODV + (size_t)NL * 3 * 6144 * 4,
                 OFF_S5T = OFF_ROPE + (size_t)SEQ * 16 * 2 * 4,
                 OFF_RWT = OFF_S5T + (size_t)NL * 2 * 16 * 64 * 36 * 4,
                 OFF_LAM = OFF_RWT + (size_t)NL * 36 * 1024 * 4,
                 OFF_S5E = OFF_LAM + 256,
                 OFF_S5C = OFF_S5E,
                 WSM_BYTES = algn(OFF_S5E + (size_t)2 * 2 * 16 * 132 * 64 * 2 * 4);
constexpr size_t WS_EXPW  = WS_WSM + WSM_BYTES;
constexpr size_t SZ_WGU = (size_t)1024 * 1024 * 2, SZ_WD = (size_t)1024 * 512 * 2;
constexpr size_t EXPW_BYTES = 32 * (SZ_WGU + SZ_WD);
constexpr size_t SZ_QM = (size_t)NB * 4 * TZ * 96 * 2, SZ_VMT = (size_t)NB * 4 * 64 * TZ * 2, SZ_QD = (size_t)NB * 4 * TZ * 64 * 2, SZ_R256 = (size_t)NZ * 256 * 2;
constexpr size_t MX_QM = 0, MX_KM = MX_QM + SZ_QM, MX_VMT = MX_KM + SZ_QM, MX_QD = MX_VMT + SZ_VMT, MX_KD = MX_QD + SZ_QD, MX_VDT = MX_KD + SZ_QD,
                 MX_RB = MX_VDT + SZ_VMT, MX_KB = MX_RB + SZ_R256, MX_VB = MX_KB + SZ_R256, MX_KKB = MX_VB + SZ_R256, MX_END = MX_KKB + SZ_R256;
static_assert(MX_END <= EXPW_BYTES, "mixer operands must fit the expert-weight region");
constexpr size_t WS_BUFA  = WS_EXPW + EXPW_BYTES;
constexpr size_t WS_BUFB  = WS_BUFA + (size_t)NZ * D * 2;
constexpr size_t WS_P     = WS_BUFB + (size_t)NZ * D * 2;
constexpr size_t P_PM = 0, P_PS = P_PM + (size_t)NZ * 416 * 2, P_PR = P_PS + (size_t)NZ * 256 * 2, P_PD = P_PR + (size_t)NZ * 1024 * 2, P_BYTES = P_PD + (size_t)NZ * 768 * 2;
static_assert((size_t)6 * SZ_R256 <= (size_t)NZ * (1024 + 768) * 2, "scan operands must fit PR|PD");
static_assert((size_t)2 * NZ * D * 2 <= P_BYTES, "the MoE outputs (2 x bf16 [NZ][D]) must fit the P region");
constexpr size_t WS_GT    = WS_P + P_BYTES;
constexpr size_t GT_BYTES = (size_t)NZ * 4096 * 2;
constexpr int MOE_CAP = 33792;
constexpr size_t GT_HM = 0, GT_LIST = GT_HM + (size_t)(33792 + 32 * 128) * 512 * 2, GT_LW = GT_LIST + (size_t)32 * MOE_CAP * 4, GT_END = GT_LW + (size_t)32 * MOE_CAP * 4;
static_assert(GT_END <= GT_BYTES, "MoE scratch must fit the gate region");
constexpr size_t WS_MISC  = WS_GT + GT_BYTES;
constexpr size_t MS_CQN = 0, MS_TW = MS_CQN + (size_t)NZ * 384 * 2, MS_AL = MS_TW + (size_t)NZ * 64 * 2, MS_SG = MS_AL + (size_t)NZ * 64 * 2,
                 MS_GG = MS_SG + (size_t)NZ * 128 * 2, MS_ZG = MS_GG + SZ_R256, MS_END = MS_ZG + SZ_R256;
constexpr size_t WS_RW    = WS_MISC + MS_END;
constexpr int RC = 64, RNC = TZ / RC;
constexpr size_t SZ_RWM = (size_t)16 * RNC * 4096 * 2;
constexpr size_t RW_M3 = 0, RW_M2 = SZ_RWM, RW_Z5 = 2 * SZ_RWM, RW_P63 = 3 * SZ_RWM, RW_END = RW_P63 + (size_t)16 * RNC * 64 * 4;
constexpr size_t WS_END   = WS_RW + RW_END;

constexpr int CW_BAR = 0;
constexpr int CW_CNT = 4096;

struct Args { const float* in[49]; float* out; unsigned char* ws; int s_lo, s_hi; };

struct Ctx {
    const float* const* in; float* out; unsigned char* ws; unsigned char* smem; int tid, lane, wave;
};

template <int WM> struct GCfg { static constexpr int WN = 8 / WM, BM = 64 * WM, BN = 64 * WN, ABYTES = BM * 128, BBYTES = BN * 128, STAGE = ABYTES + BBYTES; };

template <int WM, int SEGK, class ARow, class BRow, class Hook, class Epi>
DI void gemm_tile(const Ctx& c, int K, ARow arow, BRow brow, Hook hook, Epi epi) {
    typedef GCfg<WM> G;
    const int tid = c.tid, lane = c.lane, wave = c.wave;
    const int wm = wave / G::WN, wn = wave % G::WN, fr = lane & 15, fq = lane >> 4;
    unsigned char* smem = c.smem;
    constexpr int NA = G::BM / 64, NBq = G::BN / 64;
    const int r0 = tid >> 3, coff = ((tid & 7) ^ (r0 & 7)) * 8;
    auto stage = [&](int kt, int buf) {
        unsigned char* sa = smem + buf * G::STAGE; unsigned char* sb = sa + G::ABYTES;
#pragma unroll
        for (int i = 0; i < NA; ++i) __builtin_amdgcn_global_load_lds((const unsigned*)(arow(r0 + 64 * i) + coff + kt * 64), (unsigned*)(sa + (tid + i * NTHR) * 16), 16, 0, 0);
#pragma unroll
        for (int i = 0; i < NBq; ++i) __builtin_amdgcn_global_load_lds((const unsigned*)(brow(r0 + 64 * i) + coff + kt * 64), (unsigned*)(sb + (tid + i * NTHR) * 16), 16, 0, 0);
    };
    f32x4 acc[4][4];
#pragma unroll
    for (int m = 0; m < 4; ++m)
#pragma unroll
        for (int n = 0; n < 4; ++n) acc[m][n] = (f32x4){0.f, 0.f, 0.f, 0.f};
    const int T = K / 64;
    __syncthreads();
    stage(0, 0);
    for (int t = 0; t < T; ++t) {
        asm volatile("s_waitcnt vmcnt(0)" ::: "memory");
        __syncthreads();
        if (t + 1 < T) stage(t + 1, (t + 1) & 1);
        const unsigned char* sa = smem + (t & 1) * G::STAGE; const unsigned char* sb = sa + G::ABYTES;
#pragma unroll
        for (int ks = 0; ks < 2; ++ks) {
            bf16x8 af[4], bfr[4];
            const int sl = ((ks * 4 + fq) ^ (fr & 7)) * 16;
#pragma unroll
            for (int m = 0; m < 4; ++m) af[m] = *(const bf16x8*)(sa + (wm * 64 + m * 16 + fr) * 128 + sl);
#pragma unroll
            for (int n = 0; n < 4; ++n) bfr[n] = *(const bf16x8*)(sb + (wn * 64 + n * 16 + fr) * 128 + sl);
#pragma unroll
            for (int m = 0; m < 4; ++m)
#pragma unroll
                for (int n = 0; n < 4; ++n) acc[m][n] = __builtin_amdgcn_mfma_f32_16x16x32_bf16(bfr[n], af[m], acc[m][n], 0, 0, 0);
        }
        if (SEGK > 0) { if (((t + 1) * 64) % (SEGK > 0 ? SEGK : 64) == 0) hook(acc, ((t + 1) * 64) / (SEGK > 0 ? SEGK : 64) - 1, wm * 64, wn * 64, fr, fq); }
    }
    epi(acc, wm * 64, wn * 64, fr, fq);
}
struct NoHook { DI void operator()(f32x4 (&)[4][4], int, int, int, int, int) const {} };

namespace pg8 {
#define PG8_LAS __attribute__((address_space(3)))
typedef unsigned short bf16_t;
typedef short bf16x8 __attribute__((ext_vector_type(8)));
typedef float f32x4 __attribute__((ext_vector_type(4)));
constexpr int BM = 256, BK = 64, HALF = 128, HTB = HALF * BK * 2  , STAGE_BYTES = 8 * HTB, NXCD = 8, WGM = 8;

__host__ __device__ __forceinline__ int lds_byte(int r, int c) { const int st = (r >> 4) * 2 + (c >> 5), rr = r & 15, cc = c & 31, ob = rr * 64 + cc * 2; return st * 1024 + (ob ^ (((ob >> 9) & 1) << 5)); }
__host__ __device__ __forceinline__ void stage_rc(int b, int& R, int& C) { const int st = b / 1024, sb = b % 1024, swz = sb ^ (((sb >> 9) & 1) << 5); R = (st >> 1) * 16 + swz / 64; C = (st & 1) * 32 + (swz % 64) / 2; }
__host__ __device__ __forceinline__ int perm32(int rho) { const int n = rho >> 4, i = rho & 15; return 8 * (i >> 2) + 4 * n + (i & 3); }

struct Unit { int pm, pn; };
struct Gemm { const bf16_t* A; const bf16_t* Bt; int M, N, K, lda, ldb; };

struct StaticOrder {
    int nM, nN, nwg, G, c;
    __host__ __device__ void init(int M, int N, int G_, int c_) { nM = M / BM; nN = N / BM; nwg = nM * nN; G = G_; c = c_; }
    __host__ __device__ bool next(int i, Unit& u) const {
        const long L = (long)i * G + c; if (L >= nwg) return false;
        int wgid = (int)L; { const int q = nwg / NXCD, r = nwg % NXCD, xcd = wgid % NXCD, off = wgid / NXCD; wgid = (xcd < r ? xcd * (q + 1) : r * (q + 1) + (xcd - r) * q) + off; }
        const int nig = WGM * nN, gid = wgid / nig, fm = gid * WGM, gsz = (nM - fm) < WGM ? (nM - fm) : WGM;
        u.pm = fm + ((wgid % nig) % gsz); u.pn = (wgid % nig) / gsz; return true;
    }
    __device__ __forceinline__ void a_ready(const Unit&) const {}
    __device__ __forceinline__ void done(const Unit&) const {}
};
template <class Epi, class Sched, bool STAMP = false>
__device__ __forceinline__ void gemm_phase(PG8_LAS unsigned char* lds, const Gemm g, const Sched& S, const Epi& E, unsigned long long* stamps, int tid_in) {
    const int tid = tid_in, wid = __builtin_amdgcn_readfirstlane(tid >> 6), lane = tid & 63, wr = wid >> 2, wc = wid & 3, fr = lane & 15, fq = lane >> 4;
    const int K = g.K, nt = K / BK;
    int ts_lo = 0, ts_hi = 0, nts = 0; const unsigned long long rt_entry = STAMP ? (unsigned long long)wall_clock64() : 0ull;
#define PG8_STAMP() do { if (STAMP && wid == 0 && nts < 64) { const unsigned long long _c = (unsigned long long)clock64(); \
        ts_lo = (lane == nts) ? (int)(unsigned)_c : ts_lo; ts_hi = (lane == nts) ? (int)(unsigned)(_c >> 32) : ts_hi; ++nts; } } while (0)
    PG8_STAMP();
    unsigned voffA[2], voffB[2];
#pragma unroll
    for (int i = 0; i < 2; ++i) { int R, C; stage_rc(tid * 16 + i * 8192, R, C); const int Rb = Epi::PERM ? ((R & ~31) + perm32(R & 31)) : R;
        voffA[i] = (unsigned)(R * g.lda + C) * 2u; voffB[i] = (unsigned)(Rb * g.ldb + C) * 2u; }
    const size_t kstep = (size_t)(BK * 2);
    const size_t hstepA = (size_t)HALF * g.lda * 2, hstepB = (size_t)HALF * g.ldb * 2;
    const size_t tstepA = 2 * hstepA, tstepB = 2 * hstepB;
    const unsigned ldsw = (unsigned)wid * 1024u;
    const int aoff = lds_byte(wr * 64 + fr, fq * 8), boff = lds_byte(wc * 32 + fr, fq * 8);
#define PG8_SA(b, h) (((b) * 2 + (h)) * HTB)
#define PG8_SB(b, h) ((4 + (b) * 2 + (h)) * HTB)
#define PG8_STAGE(bufoff, gbase, voff) do { _Pragma("unroll") for (int _i = 0; _i < 2; ++_i) \
        __builtin_amdgcn_global_load_lds((const unsigned*)((const char*)(gbase) + (voff)[_i]), (PG8_LAS unsigned*)(lds + (bufoff) + ldsw + _i * 8192), 16, 0, 0); } while (0)
#define PG8_LDA(dst, b, h) do { _Pragma("unroll") for (int m = 0; m < 4; ++m) _Pragma("unroll") for (int k = 0; k < 2; ++k) dst[m][k] = *(const PG8_LAS bf16x8*)(lds + PG8_SA(b, h) + aoff + m * 2048 + k * 1024); } while (0)
#define PG8_LDB(dst, b, h) do { _Pragma("unroll") for (int n = 0; n < 2; ++n) _Pragma("unroll") for (int k = 0; k < 2; ++k) dst[n][k] = *(const PG8_LAS bf16x8*)(lds + PG8_SB(b, h) + boff + n * 2048 + k * 1024); } while (0)
#define PG8_MMA(ai, bj, At, Bt) do { __builtin_amdgcn_s_setprio(1); _Pragma("unroll") for (int m = 0; m < 4; ++m) _Pragma("unroll") for (int n = 0; n < 2; ++n) _Pragma("unroll") for (int k = 0; k < 2; ++k) \
        acc[ai][bj][m][n] = __builtin_amdgcn_mfma_f32_16x16x32_bf16(Bt[n][k], At[m][k], acc[ai][bj][m][n], 0, 0, 0); __builtin_amdgcn_s_setprio(0); } while (0)
#define PG8_WAIT_V(n) asm volatile("s_waitcnt vmcnt(" #n ")" ::: "memory")
#define PG8_WAIT_L(n) asm volatile("s_waitcnt lgkmcnt(" #n ")" ::: "memory")
#define PG8_BAR __builtin_amdgcn_s_barrier()
#define PG8_SCHED __builtin_amdgcn_sched_barrier(0)
    Unit cur, nxt; int ui = 0;
    if (!S.next(0, cur)) return;
    f32x4 acc[2][2][4][2];
#pragma unroll
    for (int a = 0; a < 2; ++a)
#pragma unroll
        for (int b = 0; b < 2; ++b)
#pragma unroll
            for (int m = 0; m < 4; ++m)
#pragma unroll
                for (int n = 0; n < 2; ++n) acc[a][b][m][n] = (f32x4){0.f, 0.f, 0.f, 0.f};
    bf16x8 At[4][2], B0[2][2], B1[2][2];
    const char* cA = (const char*)g.A + (size_t)cur.pm * tstepA; const char* cB = (const char*)g.Bt + (size_t)cur.pn * tstepB;
    S.a_ready(cur);
    PG8_STAGE(PG8_SB(0, 0), cB, voffB); PG8_STAGE(PG8_SA(0, 0), cA, voffA); PG8_STAGE(PG8_SB(0, 1), cB + hstepB, voffB); PG8_STAGE(PG8_SA(0, 1), cA + hstepA, voffA);
    if (wr == 1) PG8_BAR;
    PG8_WAIT_V(4); PG8_BAR;
    PG8_STAGE(PG8_SB(1, 0), cB + kstep, voffB); PG8_STAGE(PG8_SA(1, 0), cA + kstep, voffA); PG8_STAGE(PG8_SB(1, 1), cB + hstepB + kstep, voffB);
    PG8_WAIT_V(6); PG8_BAR;
    PG8_STAMP();
    for (;;) {
        const bool has_next = S.next(ui + 1, nxt);
        const char* nA = has_next ? (const char*)g.A + (size_t)nxt.pm * tstepA : cA; const char* nB = has_next ? (const char*)g.Bt + (size_t)nxt.pn * tstepB : cB;
        for (int t = 0; t < nt; t += 2) {
            const bool last = (t == nt - 2);
            const char* a1 = cA + (size_t)(t + 1) * kstep;
            const char* a2 = last ? nA : cA + (size_t)(t + 2) * kstep; const char* b2 = last ? nB : cB + (size_t)(t + 2) * kstep;
            const char* a3 = a2 + kstep; const char* b3 = b2 + kstep;
            if (last && has_next) S.a_ready(nxt);
            PG8_LDB(B0, 0, 0); PG8_SCHED; PG8_LDA(At, 0, 0); PG8_STAGE(PG8_SA(1, 1), a1 + hstepA, voffA);
            PG8_WAIT_L(8); PG8_BAR; PG8_WAIT_L(0); PG8_MMA(0, 0, At, B0); PG8_BAR; PG8_SCHED;
            PG8_LDB(B1, 0, 1); PG8_STAGE(PG8_SB(0, 0), b2, voffB);
            PG8_BAR; PG8_WAIT_L(0); PG8_MMA(0, 1, At, B1); PG8_BAR;
            PG8_LDA(At, 0, 1); PG8_STAGE(PG8_SA(0, 0), a2, voffA);
            PG8_BAR; PG8_WAIT_L(0); PG8_MMA(1, 0, At, B0); PG8_BAR; PG8_SCHED;
            PG8_STAGE(PG8_SB(0, 1), b2 + hstepB, voffB);
            PG8_WAIT_V(6); PG8_BAR; PG8_MMA(1, 1, At, B1); PG8_BAR;
            PG8_LDB(B0, 1, 0); PG8_SCHED; PG8_LDA(At, 1, 0); PG8_STAGE(PG8_SA(0, 1), a2 + hstepA, voffA);
            PG8_WAIT_L(8); PG8_BAR; PG8_WAIT_L(0); PG8_MMA(0, 0, At, B0); PG8_BAR; PG8_SCHED;
            PG8_LDB(B1, 1, 1); PG8_STAGE(PG8_SB(1, 0), b3, voffB);
            PG8_BAR; PG8_WAIT_L(0); PG8_MMA(0, 1, At, B1); PG8_BAR;
            PG8_LDA(At, 1, 1); PG8_STAGE(PG8_SA(1, 0), a3, voffA);
            PG8_BAR; PG8_WAIT_L(0); PG8_MMA(1, 0, At, B0); PG8_BAR; PG8_SCHED;
            PG8_STAGE(PG8_SB(1, 1), b3 + hstepB, voffB);
            PG8_WAIT_V(6); PG8_BAR; PG8_MMA(1, 1, At, B1); PG8_BAR;
        }
        PG8_STAMP();
        if constexpr (!Epi::AFTER_DRAIN) { E(acc, cur, wr, wc, fr, fq); S.done(cur); }
        PG8_STAMP();
        if (!has_next) break;
#pragma unroll
        for (int a = 0; a < 2; ++a)
#pragma unroll
            for (int b = 0; b < 2; ++b)
#pragma unroll
                for (int m = 0; m < 4; ++m)
#pragma unroll
                    for (int n = 0; n < 2; ++n) acc[a][b][m][n] = (f32x4){0.f, 0.f, 0.f, 0.f};
        cur = nxt; cA = nA; cB = nB; ++ui;
    }
    PG8_WAIT_V(0);
    if (wr == 0) PG8_BAR;
    PG8_BAR;
    if constexpr (Epi::AFTER_DRAIN) { E.fused(acc, cur, wr, wc, fr, fq, lds, wid, lane); S.done(cur); }
    PG8_STAMP();
    if (STAMP && wid == 0) { stamps[lane] = lane < nts ? (((unsigned long long)(unsigned)ts_hi << 32) | (unsigned)ts_lo) : 0ull;
        if (lane == 62) stamps[62] = rt_entry; if (lane == 63) stamps[63] = (unsigned long long)wall_clock64(); }
#undef PG8_STAMP
#undef PG8_SA
#undef PG8_SB
#undef PG8_STAGE
#undef PG8_LDA
#undef PG8_LDB
#undef PG8_MMA
#undef PG8_WAIT_V
#undef PG8_WAIT_L
#undef PG8_BAR
#undef PG8_SCHED
}
}

DI int rowmap(int n, int mode) { return mode == 0 ? n : ((n >> 4) * 32 + (n & 15) + (mode == 2 ? 16 : 0)); }
DI void tconv_tile(const Ctx& c, const float* src, int ld, int N, bf16_t* dst, int ld_dst, int mode, int tk, int tn) {
    bf16_t* T = (bf16_t*)c.smem;
    const int k0 = tk * 64, n0 = tn * 64, tid = c.tid;
    __syncthreads();
#pragma unroll
    for (int i = 0; i < 2; ++i) {
        const int kk = (tid >> 4) + i * 32, n4 = (tid & 15) * 4;
        float4 v = make_float4(0.f, 0.f, 0.f, 0.f);
        if (n0 + n4 < N) v = *(const float4*)(src + (size_t)(k0 + kk) * ld + n0 + n4);
        T[(n4 + 0) * 72 + kk] = f2bf(v.x); T[(n4 + 1) * 72 + kk] = f2bf(v.y); T[(n4 + 2) * 72 + kk] = f2bf(v.z); T[(n4 + 3) * 72 + kk] = f2bf(v.w);
    }
    __syncthreads();
    const int n = tid >> 3, k8 = (tid & 7) * 8;
    if (n0 + n < N) *(u32x4*)(dst + (size_t)rowmap(n0 + n, mode) * ld_dst + k0 + k8) = *(const u32x4*)(T + n * 72 + k8);
}
DI void tconv(const Ctx& c, const float* src, int ld, int K, int N, bf16_t* dst, int ld_dst, int mode, int rot) {
    const int ntk = K / 64, ntn = (N + 63) / 64, nt = ntk * ntn, G = gridDim.x;
    for (int t = (blockIdx.x + G - (rot % G)) % G; t < nt; t += G) tconv_tile(c, src, ld, N, dst, ld_dst, mode, t / ntn, t % ntn);
}

DI void wconv(const Ctx& c, const float* src, int ld, int K, int N, bf16_t* dst, int ld_dst, int rot) {
    const int ntk = K / 64, ntn = (N + 63) / 64, nt = ntk * ntn, GW = gridDim.x * 8, w0 = blockIdx.x * 8 + c.wave;
    for (int t = (w0 + GW - (rot % GW)) % GW; t < nt; t += GW) {
        const int tk = t / ntn, tn = t % ntn, n = tn * 64 + c.lane;
        if (n < N) {
            const float* sp = src + (size_t)(tk * 64) * ld + n; bf16_t* dp = dst + (size_t)n * ld_dst + tk * 64;
#pragma unroll
            for (int kb = 0; kb < 8; ++kb) {
                float v[8];
#pragma unroll
                for (int j = 0; j < 8; ++j) v[j] = sp[(size_t)(kb * 8 + j) * ld];
                u32x4 w4; w4.x = pack2(v[0], v[1]); w4.y = pack2(v[2], v[3]); w4.z = pack2(v[4], v[5]); w4.w = pack2(v[6], v[7]);
                *(u32x4*)(dp + kb * 8) = w4;
            }
        }
    }
}
DI void phase_prologue(const Ctx& c) {
    unsigned char* wsm = c.ws + WS_WSM;
    const int tid = c.tid, G = gridDim.x, gtid = blockIdx.x * NTHR + tid, gn = G * NTHR;
    {
        const float4* x = (const float4*)c.in[0]; const float4* cx = (const float4*)c.in[2]; float4* H = (float4*)(c.ws + WS_H);
        for (size_t i = gtid; i < (size_t)NZ * 256; i += gn) {
            const int z = (int)(i >> 8), q = (int)(i & 255), b = z / TZ, s = z % TZ;
            H[i] = (s < CTX) ? cx[((size_t)b * CTX + s) * 256 + q] : x[((size_t)b * SEQ + (s - CTX)) * 256 + q];
        }
    }
    {
        float* rope = (float*)(wsm + OFF_ROPE);
        for (int i = gtid; i < SEQ * 16; i += gn) {
            const int t = i >> 4, a = (i >> 3) & 1, f = i & 7;
            const float pos = (float)(a == 0 ? (t >> 6) : (t & 63));
            const float inv = powf(10000.f, -(float)f / 8.f);
            float sn, cs; sincosf(pos * inv, &sn, &cs);
            rope[i * 2] = cs; rope[i * 2 + 1] = sn;
        }
    }
    {
        float* s5t = (float*)(wsm + OFF_S5T);
        for (int i = gtid; i < NL * 2 * 16 * 64; i += gn) {
            const int ldg = i >> 6;
            const double lr = c.in[24][i], li = c.in[25][i], dt = exp((double)c.in[26][ldg]);
            const double mag = exp(lr * dt), are = mag * cos(li * dt), aim = mag * sin(li * dt);
            const double m256 = exp(lr * dt * 64.0), a256r = m256 * cos(li * dt * 64.0), a256i = m256 * sin(li * dt * 64.0);
            const double den = lr * lr + li * li, nr = are - 1.0, ni = aim;
            const double cfr = (nr * lr + ni * li) / den, cfi = (ni * lr - nr * li) / den;
            float* o = s5t + (size_t)i * 36;
            o[0] = (float)are; o[1] = (float)aim; o[2] = (float)a256r; o[3] = (float)a256i;
            for (int ch = 0; ch < 16; ++ch) {
                const double br = c.in[27][(size_t)i * 16 + ch], bi = c.in[28][(size_t)i * 16 + ch];
                o[4 + ch] = (float)(cfr * br - cfi * bi); o[20 + ch] = (float)(cfr * bi + cfi * br);
            }
        }
    }
    {
        float* rwt = (float*)(wsm + OFF_RWT);
        for (int i = gtid; i < NL * 36 * 1024; i += gn) {
            const int l = i / (36 * 1024), e = (i / 1024) % 36, d = i & 1023;
            rwt[i] = e < 4 ? c.in[41][((size_t)l * 1024 + d) * 4 + e] : c.in[43][((size_t)l * 1024 + d) * 32 + (e - 4)];
        }
    }
    if (blockIdx.x == 0 && tid < NL) {
        float s1 = 0.f, s2 = 0.f;
        for (int i = 0; i < 32; ++i) { s1 += c.in[34][tid * 32 + i] * c.in[35][tid * 32 + i]; s2 += c.in[36][tid * 32 + i] * c.in[37][tid * 32 + i]; }
        ((float*)(wsm + OFF_LAM))[tid] = expf(s1) - expf(s2) + (0.8f - 0.6f * expf(-0.3f * (float)tid));
    }
    {
        float* sv = (float*)c.smem;
        float* red = sv + 3 * 1024;
        __syncthreads();
        for (int i = tid; i < 3 * 1024; i += NTHR) { const float v = i < 2048 ? c.in[1][i] : c.in[3][i - 2048]; sv[i] = siluf_(v); }
        __syncthreads();
        float* modv = (float*)(wsm + OFF_MODV);
        for (int u = blockIdx.x; u < NL * 96; u += G) {
            const int l = u / 96, col = (u % 96) * 64 + (tid & 63), ks = tid >> 6;
            const float* w = c.in[4] + (size_t)l * 1024 * 6144 + col;
            float a0 = 0.f, a1 = 0.f, a2 = 0.f;
            for (int k = ks * 128; k < ks * 128 + 128; ++k) { const float wv = w[(size_t)k * 6144]; a0 += sv[k] * wv; a1 += sv[1024 + k] * wv; a2 += sv[2048 + k] * wv; }
            red[(ks * 64 + (tid & 63)) * 3 + 0] = a0; red[(ks * 64 + (tid & 63)) * 3 + 1] = a1; red[(ks * 64 + (tid & 63)) * 3 + 2] = a2;
            __syncthreads();
            if (tid < 192) {
                const int cc = tid & 63, sel = tid >> 6; float s = 0.f;
                for (int k2 = 0; k2 < 8; ++k2) s += red[(k2 * 64 + cc) * 3 + sel];
                const int colo = (u % 96) * 64 + cc;
                modv[((size_t)l * 3 + sel) * 6144 + colo] = s + c.in[5][l * 6144 + colo];
            }
            __syncthreads();
        }
    }
    for (int l = 0; l < NL; ++l) {
        wconv(c, c.in[8] + (size_t)l * 1024 * NIN, NIN, 1024, NIN, (bf16_t*)(wsm + OFF_WINT + l * SZ_WINT), 1024, l * 700);
        tconv(c, c.in[11] + (size_t)l * 256 * 384, 384, 256, 384, (bf16_t*)(wsm + OFF_WUQT + l * SZ_WUQT), 256, 0, 40);
        tconv(c, c.in[12] + (size_t)l * 128 * 512, 512, 128, 512, (bf16_t*)(wsm + OFF_WUKVT + l * SZ_WUKVT), 128, 0, 70);
        for (int d = 0; d < 2; ++d) {
            tconv(c, c.in[15] + (size_t)(l * 2 + d) * 64 * 256, 256, 64, 256, (bf16_t*)(wsm + OFF_W2T + l * SZ_W2T) + d * 256 * 64, 64, 0, 90 + d * 8);
            tconv(c, c.in[17] + (size_t)(l * 2 + d) * 64 * 256, 256, 64, 256, (bf16_t*)(wsm + OFF_A2T + l * SZ_A2T) + d * 256 * 64, 64, 0, 110 + d * 8);
        }
        tconv(c, c.in[18] + (size_t)l * 128 * 256, 256, 128, 256, (bf16_t*)(wsm + OFF_G2T + l * SZ_G2T), 128, 0, 130);
        tconv(c, c.in[32] + (size_t)l * 256 * 256, 256, 256, 256, (bf16_t*)(wsm + OFF_GLUT + l * SZ_GLUT), 256, 0, 140);
        for (int n = 0; n < 4; ++n)
            wconv(c, c.in[39] + (size_t)(l * 4 + n) * 256 * 1024, 1024, 256, 1024, (bf16_t*)(wsm + OFF_WBT + l * SZ_WBT) + n * 256, 1024, 300 + n * 64 + l * 1000);
        wconv(c, c.in[40] + (size_t)l * 1024 * 1024, 1024, 1024, 1024, (bf16_t*)(wsm + OFF_WOUTT + l * SZ_WOUTT), 1024, 1200 + l * 400);
    }
}

DI void phase_expert_convert(const Ctx& c, int l) {
    const int G = gridDim.x, lane = c.lane;
    for (int t = blockIdx.x * 8 + c.wave; t < 32 * 384; t += G * 8) {
        const int e = t / 384, r = t % 384;
        const float* src; bf16_t* dst; int ld, ldd, mode, tk, tn;
        if (r < 128)      { src = c.in[45] + ((size_t)l * 32 + e) * 1024 * 512; dst = (bf16_t*)(c.ws + WS_EXPW + (size_t)e * SZ_WGU); ld = 512; ldd = 1024; mode = 1; tk = r / 8; tn = r % 8; }
        else if (r < 256) { src = c.in[46] + ((size_t)l * 32 + e) * 1024 * 512; dst = (bf16_t*)(c.ws + WS_EXPW + (size_t)e * SZ_WGU); ld = 512; ldd = 1024; mode = 2; tk = (r - 128) / 8; tn = (r - 128) % 8; }
        else              { src = c.in[47] + ((size_t)l * 32 + e) * 512 * 1024; dst = (bf16_t*)(c.ws + WS_EXPW + 32 * SZ_WGU + (size_t)e * SZ_WD); ld = 1024; ldd = 512; mode = 0; tk = (r - 256) / 16; tn = (r - 256) % 16; }
        const int n = tn * 64 + lane; const float* sp = src + (size_t)(tk * 64) * ld + n; bf16_t* dp = dst + (size_t)rowmap(n, mode) * ldd + tk * 64;
#pragma unroll
        for (int kb = 0; kb < 8; ++kb) {
            float v[8];
#pragma unroll
            for (int j = 0; j < 8; ++j) v[j] = sp[(size_t)(kb * 8 + j) * ld];
            u32x4 w4; w4.x = pack2(v[0], v[1]); w4.y = pack2(v[2], v[3]); w4.z = pack2(v[4], v[5]); w4.w = pack2(v[6], v[7]);
            *(u32x4*)(dp + kb * 8) = w4;
        }
    }
}

DI void phase_norm1(const Ctx& c, int l) {
    const float* modv = (const float*)(c.ws + WS_WSM + OFF_MODV);
    float* H = (float*)(c.ws + WS_H); const bf16_t* Y = (const bf16_t*)(c.ws + WS_P);
    bf16_t* XN = (bf16_t*)(c.ws + WS_BUFA);
    const float* g1 = c.in[6] + l * 1024;
    for (int row = blockIdx.x * 8 + c.wave; row < NZ; row += gridDim.x * 8) {
        const int b = row / TZ, s = row % TZ, sel = s < CTX ? 2 : b;
        float4 v[4]; float ss = 0.f;
#pragma unroll
        for (int q = 0; q < 4; ++q) {
            const int col = q * 256 + c.lane * 4;
            v[q] = *(const float4*)(H + (size_t)row * D + col);
            if (l > 0) {
                float ya[4], yb[4]; unpack4(*(const u32x2*)(Y + (size_t)row * D + col), ya); unpack4(*(const u32x2*)(Y + ((size_t)NZ + row) * D + col), yb);
                const float4 m5 = *(const float4*)(modv + ((size_t)(l - 1) * 3 + sel) * 6144 + 5 * 1024 + col);
                v[q].x += m5.x * (ya[0] + yb[0]); v[q].y += m5.y * (ya[1] + yb[1]); v[q].z += m5.z * (ya[2] + yb[2]); v[q].w += m5.w * (ya[3] + yb[3]);
                *(float4*)(H + (size_t)row * D + col) = v[q];
            }
            ss += v[q].x * v[q].x + v[q].y * v[q].y + v[q].z * v[q].z + v[q].w * v[q].w;
        }
        ss = wave_sum(ss);
        const float rs = rsqrtf(ss * (1.f / 1024.f) + 1e-6f);
#pragma unroll
        for (int q = 0; q < 4; ++q) {
            const int col = q * 256 + c.lane * 4;
            const float4 g = *(const float4*)(g1 + col), m0 = *(const float4*)(modv + ((size_t)l * 3 + sel) * 6144 + col), m1 = *(const float4*)(modv + ((size_t)l * 3 + sel) * 6144 + 1024 + col);
            *(u32x2*)(XN + (size_t)row * D + col) = pack4(v[q].x * rs * g.x * (1.f + m1.x) + m0.x, v[q].y * rs * g.y * (1.f + m1.y) + m0.y,
                                                          v[q].z * rs * g.z * (1.f + m1.z) + m0.z, v[q].w * rs * g.w * (1.f + m1.w) + m0.w);
        }
    }
}

DI void phase_final(const Ctx& c) {
    const float* modv = (const float*)(c.ws + WS_WSM + OFF_MODV);
    const float* H = (const float*)(c.ws + WS_H); const bf16_t* Y = (const bf16_t*)(c.ws + WS_P);
    const float* g = c.in[48];
    for (int r = blockIdx.x * 8 + c.wave; r < NB * SEQ; r += gridDim.x * 8) {
        const int b = r / SEQ, t = r % SEQ, row = b * TZ + CTX + t;
        float4 v[4]; float ss = 0.f;
#pragma unroll
        for (int q = 0; q < 4; ++q) {
            const int col = q * 256 + c.lane * 4;
            v[q] = *(const float4*)(H + (size_t)row * D + col);
            float ya[4], yb[4]; unpack4(*(const u32x2*)(Y + (size_t)row * D + col), ya); unpack4(*(const u32x2*)(Y + ((size_t)NZ + row) * D + col), yb);
            const float4 m5 = *(const float4*)(modv + ((size_t)(NL - 1) * 3 + b) * 6144 + 5 * 1024 + col);
            v[q].x += m5.x * (ya[0] + yb[0]); v[q].y += m5.y * (ya[1] + yb[1]); v[q].z += m5.z * (ya[2] + yb[2]); v[q].w += m5.w * (ya[3] + yb[3]);
            ss += v[q].x * v[q].x + v[q].y * v[q].y + v[q].z * v[q].z + v[q].w * v[q].w;
        }
        ss = wave_sum(ss);
        const float rs = rsqrtf(ss * (1.f / 1024.f) + 1e-6f);
#pragma unroll
        for (int q = 0; q < 4; ++q) {
            const int col = q * 256 + c.lane * 4; const float4 gg = *(const float4*)(g + col);
            *(float4*)(c.out + (size_t)r * D + col) = make_float4(v[q].x * rs * gg.x, v[q].y * rs * gg.y, v[q].z * rs * gg.z, v[q].w * rs * gg.w);
        }
    }
}

struct EpiInproj {
    static constexpr bool PERM = true, AFTER_DRAIN = false;
    bf16_t *PM, *PS, *PR, *PD, *GT;
    DI void operator()(const pg8::f32x4 (&acc)[2][2][4][2], const pg8::Unit& u, int wr, int wc, int fr, int fq) const {
        const int row0 = u.pm * 256 + wr * 64 + fr, col0 = u.pn * 256 + wc * 32 + 8 * fq;
#pragma unroll
        for (int bj = 0; bj < 2; ++bj) {
            const int col = col0 + bj * 128;
            bf16_t* dst; int ld, cc; bool gate = false;
            if (col < 416) { dst = PM; ld = 416; cc = col; }
            else if (col < 1440) { dst = PR; ld = 1024; cc = col - 416; }
            else if (col < 1696) { dst = PS; ld = 256; cc = col - 1440; }
            else if (col < 2464) { dst = PD; ld = 768; cc = col - 1696; }
            else if (col < NIN) { dst = GT; ld = 4096; cc = col - 2464; gate = true; }
            else continue;
#pragma unroll
            for (int ai = 0; ai < 2; ++ai)
#pragma unroll
                for (int m = 0; m < 4; ++m) {
                    const int row = row0 + ai * 128 + m * 16; pg8::f32x4 v0 = acc[ai][bj][m][0], v1 = acc[ai][bj][m][1];
                    if (gate) { v0[0] = sigmoidf_(v0[0]); v0[1] = sigmoidf_(v0[1]); v0[2] = sigmoidf_(v0[2]); v0[3] = sigmoidf_(v0[3]);
                                v1[0] = sigmoidf_(v1[0]); v1[1] = sigmoidf_(v1[1]); v1[2] = sigmoidf_(v1[2]); v1[3] = sigmoidf_(v1[3]); }
                    u32x4 w; w.x = pack2(v0[0], v0[1]); w.y = pack2(v0[2], v0[3]); w.z = pack2(v1[0], v1[1]); w.w = pack2(v1[2], v1[3]);
                    *(u32x4*)(dst + (size_t)row * ld + cc) = w;
                }
        }
    }
};
DI void phase_inproj(const Ctx& c, int l) {
    EpiInproj E; E.PM = (bf16_t*)(c.ws + WS_P + P_PM); E.PS = (bf16_t*)(c.ws + WS_P + P_PS); E.PR = (bf16_t*)(c.ws + WS_P + P_PR); E.PD = (bf16_t*)(c.ws + WS_P + P_PD); E.GT = (bf16_t*)(c.ws + WS_GT);
    pg8::Gemm g{(const bf16_t*)(c.ws + WS_BUFA), (const bf16_t*)(c.ws + WS_WSM + OFF_WINT + l * SZ_WINT), NZ, NINP, 1024, 1024, 1024};
    pg8::StaticOrder S; S.init(NZ, NINP, (int)gridDim.x, (int)blockIdx.x);
    __syncthreads();
    pg8::gemm_phase<EpiInproj, pg8::StaticOrder, false>((PG8_LAS unsigned char*)c.smem, g, S, E, nullptr, c.tid);
}

DI void phase_prep(const Ctx& c, int l) {
    unsigned char* ws = c.ws; const int lane = c.lane, wave = c.wave, tid = c.tid;
    const bf16_t* PM = (const bf16_t*)(ws + WS_P + P_PM); const bf16_t* PR = (const bf16_t*)(ws + WS_P + P_PR); const bf16_t* PD = (const bf16_t*)(ws + WS_P + P_PD);
    bf16_t* CQN = (bf16_t*)(ws + WS_MISC + MS_CQN); bf16_t* TW = (bf16_t*)(ws + WS_MISC + MS_TW); bf16_t* AL = (bf16_t*)(ws + WS_MISC + MS_AL); bf16_t* SG = (bf16_t*)(ws + WS_MISC + MS_SG);
    bf16_t* KM = (bf16_t*)(ws + WS_EXPW + MX_KM); bf16_t* QD = (bf16_t*)(ws + WS_EXPW + MX_QD); bf16_t* KD_ = (bf16_t*)(ws + WS_EXPW + MX_KD); bf16_t* VDT = (bf16_t*)(ws + WS_EXPW + MX_VDT);
    bf16_t* RB = (bf16_t*)(ws + WS_EXPW + MX_RB); bf16_t* KB = (bf16_t*)(ws + WS_EXPW + MX_KB); bf16_t* VB = (bf16_t*)(ws + WS_EXPW + MX_VB); bf16_t* KKB = (bf16_t*)(ws + WS_EXPW + MX_KKB);
    const float* rope = (const float*)(ws + WS_WSM + OFF_ROPE);
    const float* gq = c.in[9] + l * 256; const float* gkv = c.in[10] + l * 128; const float* mu = c.in[13] + l * 1024; const float* k_k = c.in[19] + l * 256;
    bf16_t* Vs = (bf16_t*)c.smem;
    const float qsc = 0.17677669529663687f * LOG2E;
    for (int tile = blockIdx.x; tile < NZ / 64; tile += gridDim.x) {
        __syncthreads();
        for (int i = 0; i < 8; ++i) {
            const int rt = wave * 8 + i, z = tile * 64 + rt, b = z / TZ, s = z % TZ; const bool lat = s >= CTX; const int tl = lat ? s - CTX : 0;
            {
                const bf16_t* pm = PM + (size_t)z * 416;
                float x[4]; unpack4(*(const u32x2*)(pm + lane * 4), x);
                float ss = wave_sum(x[0] * x[0] + x[1] * x[1] + x[2] * x[2] + x[3] * x[3]);
                float rs = rsqrtf(ss * (1.f / 256.f) + 1e-6f);
                const float4 g = *(const float4*)(gq + lane * 4);
                *(u32x2*)(CQN + (size_t)z * 384 + lane * 4) = pack4(x[0] * rs * g.x, x[1] * rs * g.y, x[2] * rs * g.z, x[3] * rs * g.w);
                const unsigned u2 = *(const unsigned*)(pm + 256 + lane * 2); const float y0 = lo2f(u2), y1 = hi2f(u2);
                ss = wave_sum(y0 * y0 + y1 * y1); rs = rsqrtf(ss * (1.f / 128.f) + 1e-6f);
                const float2 g2 = *(const float2*)(gkv + lane * 2);
                *(unsigned*)(CQN + (size_t)z * 384 + 256 + lane * 2) = pack2(y0 * rs * g2.x, y1 * rs * g2.y);
                float kr = bf2f(pm[384 + (lane & 31)]);
                const float pr = __shfl_xor(kr, 8, 64);
                if (lat) { const float* cs = rope + ((size_t)tl * 16 + ((lane & 31) >> 4) * 8 + (lane & 7)) * 2; kr = kr * cs[0] + ((lane & 8) ? pr : -pr) * cs[1]; }
                if (lane < 32) {
                    const bf16_t kv = f2bf(kr);
#pragma unroll
                    for (int h = 0; h < 4; ++h) KM[((size_t)(b * 4 + h) * TZ + s) * 96 + 64 + lane] = kv;
                }
            }
            {
                const bf16_t* pd = PD + (size_t)z * 768;
                const int i0 = lane * 4, hh = i0 >> 6, ii = i0 & 31, nn = (i0 >> 5) & 1;
                const float* cs = rope + ((size_t)tl * 16 + (ii >> 4) * 8 + (ii & 7)) * 2;
                const bool hi = (ii & 8) != 0;
#pragma unroll
                for (int w = 0; w < 2; ++w) {
                    float x[4]; unpack4(*(const u32x2*)(pd + w * 256 + i0), x);
                    float o[4];
#pragma unroll
                    for (int j = 0; j < 4; ++j) {
                        const float p = __shfl_xor(x[j], 2, 64);
                        o[j] = lat ? (x[j] * cs[2 * j] + (hi ? p : -p) * cs[2 * j + 1]) : x[j];
                        if (w == 0) o[j] *= qsc;
                    }
                    bf16_t* dst = (w == 0 ? QD : KD_) + ((size_t)(b * 4 + hh) * TZ + s) * 64 + nn * 32 + ii;
                    *(u32x2*)dst = pack4(o[0], o[1], o[2], o[3]);
                }
                *(u32x2*)(Vs + rt * 264 + i0) = *(const u32x2*)(pd + 512 + i0);
            }
            {
                const bf16_t* pr = PR + (size_t)z * 1024;
                const bool hp = (s != 0) && (s != CTX), hn = (s != CTX - 1) && (s != TZ - 1);
#pragma unroll
                for (int q = 0; q < 4; ++q) {
                    const int col = q * 256 + lane * 4;
                    float cu[4], pv[4] = {0.f, 0.f, 0.f, 0.f}, nx[4] = {0.f, 0.f, 0.f, 0.f};
                    unpack4(*(const u32x2*)(pr + col), cu);
                    if (hp) unpack4(*(const u32x2*)(pr - 1024 + col), pv);
                    if (hn) unpack4(*(const u32x2*)(pr + 1024 + col), nx);
                    const float4 m = *(const float4*)(mu + col);
                    float zv[4];
                    zv[0] = cu[0] + (0.5f * (pv[0] + nx[0]) - cu[0]) * m.x; zv[1] = cu[1] + (0.5f * (pv[1] + nx[1]) - cu[1]) * m.y;
                    zv[2] = cu[2] + (0.5f * (pv[2] + nx[2]) - cu[2]) * m.z; zv[3] = cu[3] + (0.5f * (pv[3] + nx[3]) - cu[3]) * m.w;
                    if (q == 0) *(u32x2*)(RB + (size_t)z * 256 + lane * 4) = pack4(zv[0], zv[1], zv[2], zv[3]);
                    else if (q == 1) {
                        *(u32x2*)(KB + (size_t)z * 256 + lane * 4) = pack4(zv[0], zv[1], zv[2], zv[3]);
                        const float4 kk4 = *(const float4*)(k_k + lane * 4);
                        const float a0 = zv[0] * kk4.x, a1 = zv[1] * kk4.y, a2 = zv[2] * kk4.z, a3 = zv[3] * kk4.w;
                        const float ssq = sum16(a0 * a0 + a1 * a1 + a2 * a2 + a3 * a3);
                        const float inv = 1.f / fmaxf(sqrtf(ssq), 1e-12f);
                        *(u32x2*)(KKB + (size_t)z * 256 + lane * 4) = pack4(a0 * inv, a1 * inv, a2 * inv, a3 * inv);
                    } else if (q == 2) *(u32x2*)(VB + (size_t)z * 256 + lane * 4) = pack4(zv[0], zv[1], zv[2], zv[3]);
                    else {
                        if (lane < 16) *(u32x2*)(TW + (size_t)z * 64 + lane * 4) = pack4(tanhf(zv[0]), tanhf(zv[1]), tanhf(zv[2]), tanhf(zv[3]));
                        else if (lane < 32) *(u32x2*)(AL + (size_t)z * 64 + (lane - 16) * 4) = pack4(zv[0], zv[1], zv[2], zv[3]);
                        else *(u32x2*)(SG + (size_t)z * 128 + (lane - 32) * 4) = pack4(sigmoidf_(zv[0]), sigmoidf_(zv[1]), sigmoidf_(zv[2]), sigmoidf_(zv[3]));
                    }
                }
            }
        }
        __syncthreads();
        {
            const int z0 = tile * 64, b = z0 / TZ, s0 = z0 % TZ;
#pragma unroll
            for (int i = 0; i < 4; ++i) {
                const int ch = tid + i * NTHR, dv = ch >> 3, r8 = (ch & 7) * 8;
                bf16_t v[8];
#pragma unroll
                for (int j = 0; j < 8; ++j) v[j] = Vs[(r8 + j) * 264 + dv];
                u32x4 o; o.x = v[0] | ((unsigned)v[1] << 16); o.y = v[2] | ((unsigned)v[3] << 16); o.z = v[4] | ((unsigned)v[5] << 16); o.w = v[6] | ((unsigned)v[7] << 16);
                *(u32x4*)(VDT + ((size_t)(b * 4 + (dv >> 6)) * 64 + (dv & 63)) * TZ + s0 + r8) = o;
            }
        }
    }
}

constexpr int S5C = 64, S5N = TZ / S5C, S5NC = CTX / S5C;
DI int s5_tok(int dir, int i) { return dir == 0 ? i : (i < CTX ? CTX - 1 - i : TZ - 1 - (i - CTX)); }
DI void s5_stage_u(const Ctx& c, float* U, int b, int dir, int chunk, int g0, int ng) {
    const bf16_t* PS = (const bf16_t*)(c.ws + WS_P + P_PS);
    const int per = ng * 4;
    for (int e = c.tid; e < S5C * per; e += NTHR) {
        const int i = e / per, c4 = (e % per) * 4, s = s5_tok(dir, chunk * S5C + i);
        float x[4]; unpack4(*(const u32x2*)(PS + (size_t)(b * TZ + s) * 256 + g0 * 16 + c4), x);
        *(float4*)(U + i * (ng * 16) + c4) = make_float4(x[0], x[1], x[2], x[3]);
    }
}
DI void phase_s5_local(const Ctx& c, int l) {
    float* U = (float*)c.smem;
    const float* s5t = (const float*)(c.ws + WS_WSM + OFF_S5T);
    float* E = (float*)(c.ws + WS_WSM + OFF_S5E);
    for (int u = blockIdx.x; u < 2 * 2 * S5N * 2; u += gridDim.x) {
        const int gq = u & 1, chunk = (u >> 1) % S5N, dir = (u / (2 * S5N)) & 1, b = u / (4 * S5N);
        __syncthreads();
        s5_stage_u(c, U, b, dir, chunk, gq * 8, 8);
        __syncthreads();
        const int g = gq * 8 + c.wave, p = c.lane;
        const float* tb = s5t + ((size_t)((l * 2 + dir) * 16 + g) * 64 + p) * 36;
        const float are = tb[0], aim = tb[1];
        float br[16], bi[16];
#pragma unroll
        for (int ch = 0; ch < 16; ++ch) { br[ch] = tb[4 + ch]; bi[ch] = tb[20 + ch]; }
        float xr = 0.f, xi = 0.f;
        for (int i = 0; i < S5C; ++i) {
            const float* uu = U + i * 128 + c.wave * 16;
            float sr = 0.f, si = 0.f;
#pragma unroll
            for (int q = 0; q < 4; ++q) { const float4 v = *(const float4*)(uu + q * 4);
                sr += br[q * 4] * v.x + br[q * 4 + 1] * v.y + br[q * 4 + 2] * v.z + br[q * 4 + 3] * v.w;
                si += bi[q * 4] * v.x + bi[q * 4 + 1] * v.y + bi[q * 4 + 2] * v.z + bi[q * 4 + 3] * v.w; }
            const float nr = are * xr - aim * xi + sr, ni = are * xi + aim * xr + si; xr = nr; xi = ni;
        }
        *(float2*)(E + ((size_t)(((b * 2 + dir) * 16 + g) * S5N + chunk) * 64 + p) * 2) = make_float2(xr, xi);
    }
}
DI void phase_s5_carry(const Ctx& c, int l) {
    const int gt = blockIdx.x * NTHR + c.tid;
    if (gt < 2 * 2 * 16 * 64) {
        const int p = gt & 63, g = (gt >> 6) & 15, dir = (gt >> 10) & 1, b = gt >> 11;
        const float* tb = (const float*)(c.ws + WS_WSM + OFF_S5T) + ((size_t)((l * 2 + dir) * 16 + g) * 64 + p) * 36;
        const float ar = tb[2], ai = tb[3];
        const float* E = (const float*)(c.ws + WS_WSM + OFF_S5E) + (size_t)(((b * 2 + dir) * 16 + g) * S5N) * 128;
        float* C = (float*)(c.ws + WS_WSM + OFF_S5C) + (size_t)(((b * 2 + dir) * 16 + g) * S5N) * 128;
        float xr = 0.f, xi = 0.f;
        for (int ch = 0; ch < S5N; ++ch) {
            const float2 e = *(const float2*)(E + ch * 128 + p * 2);
            *(float2*)(C + ch * 128 + p * 2) = make_float2(xr, xi);
            const float nr = ar * xr - ai * xi + e.x, ni = ar * xi + ai * xr + e.y; xr = nr; xi = ni;
        }
    }
}

constexpr int S5_US = 0, S5_YS = 8192, S5_WV = S5_YS + 2 * 64 * 64 * 4;
template <bool LOCAL>
DI void phase_s5_final_unit(const Ctx& c, int l, int u) {
    unsigned char* L = c.smem;
    const float* s5t = (const float*)(c.ws + WS_WSM + OFF_S5T);
    const float* CIN = (const float*)(c.ws + WS_WSM + OFF_S5C);
    const bf16_t* PS = (const bf16_t*)(c.ws + WS_P + P_PS);
    const int gq = u & 3, ct = (u >> 2) % S5N, b = u / (4 * S5N);
    const int wave = c.wave, lane = c.lane, gl = wave >> 1, dir = wave & 1, g = gq * 4 + gl, n16 = lane & 15, q4 = lane >> 4;
    __syncthreads();
    {
        const int t = c.tid >> 3, part = c.tid & 7;
        *(u32x4*)(L + S5_US + t * 128 + part * 16) = *(const u32x4*)(PS + (size_t)(b * TZ + ct * S5C + t) * 256 + gq * 64 + part * 8);
    }
    const float* tbase = s5t + ((size_t)((l * 2 + dir) * 16 + g) * 64) * 36;
    bf16x8 bfr[8], cfr[4];
#pragma unroll
    for (int j = 0; j < 8; ++j) {
        const int pp = 16 * j + n16, p = pp & 63; const float* tb = tbase + (size_t)p * 36 + (pp < 64 ? 4 : 20) + 8 * (q4 & 1);
        u32x4 w4 = {0u, 0u, 0u, 0u};
        if (q4 < 2) { w4.x = pack2(tb[0], tb[1]); w4.y = pack2(tb[2], tb[3]); w4.z = pack2(tb[4], tb[5]); w4.w = pack2(tb[6], tb[7]); }
        bfr[j] = __builtin_bit_cast(bf16x8, w4);
    }
    {
        const float* cre = c.in[29] + ((size_t)((l * 2 + dir) * 16 + g) * 16 + n16) * 64; const float* cim = c.in[30] + ((size_t)((l * 2 + dir) * 16 + g) * 16 + n16) * 64;
#pragma unroll
        for (int s = 0; s < 4; ++s) {
            const int pp = 32 * s + 8 * q4; const float sg = pp < 64 ? 1.f : -1.f; const float* src = (pp < 64 ? cre + pp : cim + (pp - 64));
            u32x4 w4; w4.x = pack2(sg * src[0], sg * src[1]); w4.y = pack2(sg * src[2], sg * src[3]); w4.z = pack2(sg * src[4], sg * src[5]); w4.w = pack2(sg * src[6], sg * src[7]);
            cfr[s] = __builtin_bit_cast(bf16x8, w4);
        }
    }
    const float are = tbase[(size_t)lane * 36], aim = tbase[(size_t)lane * 36 + 1];
    const int cd = dir == 0 ? ct : (ct < S5NC ? S5NC - 1 - ct : S5N + S5NC - 1 - ct);
    float xr = 0.f, xi = 0.f;
    if (!LOCAL) { const float2 ci = *(const float2*)(CIN + ((size_t)(((b * 2 + dir) * 16 + g) * S5N + cd) * 64 + lane) * 2); xr = ci.x; xi = ci.y; }
    const float dsk = c.in[31][(size_t)l * 256 + g * 16 + n16];
    bf16_t* BU = (bf16_t*)(L + S5_WV + wave * 8192); bf16_t* XB = BU + 16 * 128;
    float* YS = (float*)(L + S5_YS) + dir * 64 * 64;
    __syncthreads();
#pragma unroll 1
    for (int sb = 0; sb < 4; ++sb) {
        const int stepA = 16 * sb + n16, tlA = dir == 0 ? stepA : 63 - stepA;
        u32x4 a4 = {0u, 0u, 0u, 0u};
        if (q4 < 2) a4 = *(const u32x4*)(L + S5_US + tlA * 128 + gl * 32 + q4 * 16);
        const bf16x8 af = __builtin_bit_cast(bf16x8, a4);
#pragma unroll
        for (int j = 0; j < 8; ++j) {
            f32x4 acc = {0.f, 0.f, 0.f, 0.f};
            acc = __builtin_amdgcn_mfma_f32_16x16x32_bf16(af, bfr[j], acc, 0, 0, 0);
#pragma unroll
            for (int rr = 0; rr < 4; ++rr) BU[(4 * q4 + rr) * 128 + 16 * j + n16] = f2bf(acc[rr]);
        }
#pragma unroll
        for (int ii = 0; ii < 16; ++ii) {
            const float br = bf2f(BU[ii * 128 + lane]), bi = bf2f(BU[ii * 128 + 64 + lane]);
            const float nr = are * xr - aim * xi + br, ni = are * xi + aim * xr + bi; xr = nr; xi = ni;
            if (!LOCAL) { XB[ii * 128 + lane] = f2bf(xr); XB[ii * 128 + 64 + lane] = f2bf(xi); }
        }
        if (LOCAL) continue;
        f32x4 ya = {0.f, 0.f, 0.f, 0.f};
#pragma unroll
        for (int s = 0; s < 4; ++s) {
            const bf16x8 xf = *(const bf16x8*)((const unsigned char*)XB + n16 * 256 + (32 * s + 8 * q4) * 2);
            ya = __builtin_amdgcn_mfma_f32_16x16x32_bf16(xf, cfr[s], ya, 0, 0, 0);
        }
#pragma unroll
        for (int rr = 0; rr < 4; ++rr) {
            const int step = 16 * sb + 4 * q4 + rr, tl = dir == 0 ? step : 63 - step;
            float y = ya[rr];
            if (dir == 0) y += dsk * bf2f(*(const bf16_t*)(L + S5_US + tl * 128 + (gl * 16 + n16) * 2));
            YS[tl * 64 + gl * 16 + n16] = y;
        }
    }
    if (LOCAL) { *(float2*)((float*)(c.ws + WS_WSM + OFF_S5E) + ((size_t)(((b * 2 + dir) * 16 + g) * S5N + cd) * 64 + lane) * 2) = make_float2(xr, xi); return; }
    __syncthreads();
    bf16_t* ZG = (bf16_t*)(c.ws + WS_MISC + MS_ZG);
    {
        const float* Y0 = (const float*)(L + S5_YS); const float* Y1 = Y0 + 64 * 64;
        for (int e = c.tid; e < 64 * 16; e += NTHR) {
            const int i = e >> 4, c4 = (e & 15) * 4; const float4 y0 = *(const float4*)(Y0 + i * 64 + c4), y1 = *(const float4*)(Y1 + i * 64 + c4);
            *(u32x2*)(ZG + (size_t)(b * TZ + ct * S5C + i) * 256 + gq * 64 + c4) = pack4(gelu_tanh(y0.x + y1.x), gelu_tanh(y0.y + y1.y), gelu_tanh(y0.z + y1.z), gelu_tanh(y0.w + y1.w));
        }
    }
}

DI void phase_small_gemms(const Ctx& c, int l) {
    unsigned char* ws = c.ws; unsigned char* wsm = ws + WS_WSM;
    const bf16_t* CQN = (const bf16_t*)(ws + WS_MISC + MS_CQN);
    const float* rope = (const float*)(wsm + OFF_ROPE);
    constexpr int NMT = NZ / 256;
    int base = 0;
    const int G = gridDim.x, bid = blockIdx.x;
    {
        const bf16_t* W = (const bf16_t*)(wsm + OFF_WUQT + l * SZ_WUQT); bf16_t* QM = (bf16_t*)(ws + WS_EXPW + MX_QM);
        const float qs = 0.10206207261596577f * LOG2E;
        for (int u = (bid + G - base % G) % G; u < NMT * 3; u += G) {
            const int mt = u / 3, nt = u % 3, r0 = mt * 256, c0 = nt * 128;
            gemm_tile<4, 0>(c, 256, [&](int i) { return CQN + (size_t)(r0 + i) * 384; }, [&](int i) { return W + (size_t)(c0 + i) * 256; }, NoHook(),
                [&](f32x4 (&acc)[4][4], int wr, int wc, int fr, int fq) {
#pragma unroll
                    for (int n = 0; n < 4; ++n) {
                        const int col = c0 + wc + n * 16 + fq * 4, h = col / 96, d = col % 96;
                        const bool rp = d >= 64;
#pragma unroll
                        for (int m = 0; m < 4; ++m) {
                            const int row = r0 + wr + m * 16 + fr, b = row / TZ, s = row % TZ; f32x4 v = acc[m][n];
                            f32x4 pv; pv[0] = __shfl_xor(v[0], 32, 64); pv[1] = __shfl_xor(v[1], 32, 64); pv[2] = __shfl_xor(v[2], 32, 64); pv[3] = __shfl_xor(v[3], 32, 64);
                            if (rp && s >= CTX) {
                                const int i0 = d - 64;
                                const float* cs = rope + ((size_t)(s - CTX) * 16 + (i0 >> 4) * 8 + (i0 & 7)) * 2;
                                const bool hi = (i0 & 8) != 0;
#pragma unroll
                                for (int j = 0; j < 4; ++j) v[j] = v[j] * cs[2 * j] + (hi ? pv[j] : -pv[j]) * cs[2 * j + 1];
                            }
                            *(u32x2*)(QM + ((size_t)(b * 4 + h) * TZ + s) * 96 + d) = pack4(v[0] * qs, v[1] * qs, v[2] * qs, v[3] * qs);
                        }
                    }
                });
        }
        base += NMT * 3;
    }
    {
        const bf16_t* W = (const bf16_t*)(wsm + OFF_WUKVT + l * SZ_WUKVT); bf16_t* KM = (bf16_t*)(ws + WS_EXPW + MX_KM); bf16_t* VMT = (bf16_t*)(ws + WS_EXPW + MX_VMT);
        for (int u = (bid + G - base % G) % G; u < NMT * 4; u += G) {
            const int mt = u / 4, nt = u % 4, r0 = mt * 256, c0 = nt * 128;
            gemm_tile<4, 0>(c, 128, [&](int i) { return CQN + (size_t)(r0 + i) * 384 + 256; }, [&](int i) { return W + (size_t)(c0 + i) * 128; }, NoHook(),
                [&](f32x4 (&acc)[4][4], int wr, int wc, int fr, int fq) {
#pragma unroll
                    for (int n = 0; n < 4; ++n) {
                        const int col = c0 + wc + n * 16 + fq * 4, h = col >> 7, d = col & 127;
#pragma unroll
                        for (int m = 0; m < 4; ++m) {
                            const int row = r0 + wr + m * 16 + fr, b = row / TZ, s = row % TZ; const f32x4 v = acc[m][n];
                            if (d < 64) *(u32x2*)(KM + ((size_t)(b * 4 + h) * TZ + s) * 96 + d) = pack4(v[0], v[1], v[2], v[3]);
                            else {
#pragma unroll
                                for (int j = 0; j < 4; ++j) VMT[((size_t)(b * 4 + h) * 64 + (d - 64 + j)) * TZ + s] = f2bf(v[j]);
                            }
                        }
                    }
                });
        }
        base += NMT * 4;
    }
    bf16_t* SE = (bf16_t*)(ws + WS_P + P_PR); bf16_t* SAD = SE + (size_t)2 * NZ * 256; bf16_t* SKD = SAD + (size_t)2 * NZ * 256;
    {
        const bf16_t* A = (const bf16_t*)(ws + WS_MISC + MS_TW); const bf16_t* W = (const bf16_t*)(wsm + OFF_W2T + l * SZ_W2T);
        const float* w0 = c.in[14] + (size_t)l * 512;
        for (int u = (bid + G - base % G) % G; u < NMT * 4; u += G) {
            const int mt = u / 4, nt = u % 4, r0 = mt * 256, c0 = nt * 128;
            gemm_tile<4, 0>(c, 64, [&](int i) { return A + (size_t)(r0 + i) * 64; }, [&](int i) { return W + (size_t)(c0 + i) * 64; }, NoHook(),
                [&](f32x4 (&acc)[4][4], int wr, int wc, int fr, int fq) {
#pragma unroll
                    for (int n = 0; n < 4; ++n) {
                        const int col = c0 + wc + n * 16 + fq * 4, d = col >> 8, cc = col & 255; const float4 w0v = *(const float4*)(w0 + col);
#pragma unroll
                        for (int m = 0; m < 4; ++m) {
                            const int row = r0 + wr + m * 16 + fr; const f32x4 v = acc[m][n]; float e[4];
                            const float x[4] = {w0v.x + v[0], w0v.y + v[1], w0v.z + v[2], w0v.w + v[3]};
#pragma unroll
                            for (int j = 0; j < 4; ++j) e[j] = 0.6065306597126334f * sigmoidf_(x[j]);
                            *(u32x2*)(SE + ((size_t)d * NZ + row) * 256 + cc) = pack4(e[0], e[1], e[2], e[3]);
                        }
                    }
                });
        }
        base += NMT * 4;
    }
    {
        const bf16_t* A = (const bf16_t*)(ws + WS_MISC + MS_AL); const bf16_t* W = (const bf16_t*)(wsm + OFF_A2T + l * SZ_A2T);
        const float* a0 = c.in[16] + (size_t)l * 512; const float* k_a = c.in[20] + (size_t)l * 256; const bf16_t* KB = (const bf16_t*)(ws + WS_EXPW + MX_KB);
        for (int u = (bid + G - base % G) % G; u < NMT * 4; u += G) {
            const int mt = u / 4, nt = u % 4, r0 = mt * 256, c0 = nt * 128;
            gemm_tile<4, 0>(c, 64, [&](int i) { return A + (size_t)(r0 + i) * 64; }, [&](int i) { return W + (size_t)(c0 + i) * 64; }, NoHook(),
                [&](f32x4 (&acc)[4][4], int wr, int wc, int fr, int fq) {
#pragma unroll
                    for (int n = 0; n < 4; ++n) {
                        const int col = c0 + wc + n * 16 + fq * 4, d = col >> 8, cc = col & 255; const float4 a0v = *(const float4*)(a0 + col), kav = *(const float4*)(k_a + cc);
#pragma unroll
                        for (int m = 0; m < 4; ++m) {
                            const int row = r0 + wr + m * 16 + fr; const f32x4 v = acc[m][n];
                            const float ad0 = sigmoidf_(a0v.x + v[0]), ad1 = sigmoidf_(a0v.y + v[1]), ad2 = sigmoidf_(a0v.z + v[2]), ad3 = sigmoidf_(a0v.w + v[3]);
                            float k[4]; unpack4(*(const u32x2*)(KB + (size_t)row * 256 + cc), k);
                            *(u32x2*)(SAD + ((size_t)d * NZ + row) * 256 + cc) = pack4(ad0, ad1, ad2, ad3);
                            *(u32x2*)(SKD + ((size_t)d * NZ + row) * 256 + cc) = pack4(k[0] * (1.f + (ad0 - 1.f) * kav.x), k[1] * (1.f + (ad1 - 1.f) * kav.y), k[2] * (1.f + (ad2 - 1.f) * kav.z), k[3] * (1.f + (ad3 - 1.f) * kav.w));
                        }
                    }
                });
        }
        base += NMT * 4;
    }
    {
        const bf16_t* A = (const bf16_t*)(ws + WS_MISC + MS_SG); const bf16_t* W = (const bf16_t*)(wsm + OFF_G2T + l * SZ_G2T); bf16_t* GG = (bf16_t*)(ws + WS_MISC + MS_GG);
        for (int u = (bid + G - base % G) % G; u < NMT * 2; u += G) {
            const int mt = u / 2, nt = u % 2, r0 = mt * 256, c0 = nt * 128;
            gemm_tile<4, 0>(c, 128, [&](int i) { return A + (size_t)(r0 + i) * 128; }, [&](int i) { return W + (size_t)(c0 + i) * 128; }, NoHook(),
                [&](f32x4 (&acc)[4][4], int wr, int wc, int fr, int fq) {
#pragma unroll
                    for (int n = 0; n < 4; ++n)
#pragma unroll
                        for (int m = 0; m < 4; ++m) { const f32x4 v = acc[m][n];
                            *(u32x2*)(GG + (size_t)(r0 + wr + m * 16 + fr) * 256 + c0 + wc + n * 16 + fq * 4) = pack4(v[0], v[1], v[2], v[3]); }
                });
        }
        base += NMT * 2;
    }
}

DI int krow(int s, int h, int j) { return 16 * s + 8 * (j >> 2) + 4 * h + (j & 3); }
#ifndef ATT_THR
#define ATT_THR 64.f
#endif
constexpr int ATT_PARK = 56 * 1024;
template <int MODE>
DI void attn_pass(const Ctx& c, int l, int b, int h, int q0, int nkeys) {
    constexpr int DROW = MODE == 0 ? 96 : 64;
    constexpr int DQ = MODE == 0 ? 96 : 32, KS = DQ / 16;
    constexpr int DOFF = MODE == 2 ? 32 : 0;
    constexpr int TK = 128;
    constexpr int KPITCH = DQ * 2 + 16;
    constexpr int VPITCH = TK * 2 + 16;
    constexpr int KBYTES = TK * KPITCH, VBYTES = 64 * VPITCH, STG = KBYTES + VBYTES;
    static_assert(MODE == 0 || 2 * STG <= ATT_PARK, "the staging buffers must stay below the parked o1");
    unsigned char* ws = c.ws; int tid_ = c.tid; asm volatile("" : "+v"(tid_));
    const int tid = tid_, lane = tid & 63, wave = __builtin_amdgcn_readfirstlane(tid >> 6), r = lane & 31, hh = lane >> 5;
    const bf16_t* Q = (const bf16_t*)(ws + WS_EXPW + (MODE == 0 ? MX_QM : MX_QD)) + (size_t)(b * 4 + h) * TZ * DROW + DOFF;
    const bf16_t* Kp = (const bf16_t*)(ws + WS_EXPW + (MODE == 0 ? MX_KM : MX_KD)) + (size_t)(b * 4 + h) * TZ * DROW + DOFF;
    const bf16_t* Vt = (const bf16_t*)(ws + WS_EXPW + (MODE == 0 ? MX_VMT : MX_VDT)) + (size_t)(b * 4 + h) * 64 * TZ;
    unsigned char* smem = c.smem;
    bf16x8 qf[KS];
    const int qrow = q0 + wave * 32 + r;
#pragma unroll
    for (int ks = 0; ks < KS; ++ks) qf[ks] = *(const bf16x8*)(Q + (size_t)qrow * DROW + ks * 16 + hh * 8);
    f32x16 oacc[2];
    float mref = 0.f, lrun = 0.f;
#pragma unroll
    for (int t = 0; t < 2; ++t)
#pragma unroll
        for (int i = 0; i < 16; ++i) oacc[t][i] = 0.f;
    constexpr int CPR = DQ / 8, KCH = TK * CPR, NKR = (KCH + NTHR - 1) / NTHR;
    u32x4 kreg[NKR], vreg[2];
    const bf16_t* kp[NKR]; int koff[NKR];
#pragma unroll
    for (int i = 0; i < NKR; ++i) { const int ch = tid + i * NTHR; kp[i] = Kp + (size_t)(ch / CPR) * DROW + (ch % CPR) * 8; koff[i] = (ch / CPR) * KPITCH + (ch % CPR) * 16; }
    const bf16_t* vp = Vt + (size_t)(tid >> 4) * TZ + (tid & 15) * 8;
    const int voff = (tid >> 4) * VPITCH + (tid & 15) * 16;
    auto gload = [&]() {
#pragma unroll
        for (int i = 0; i < NKR; ++i) { if (tid + i * NTHR < KCH) kreg[i] = *(const u32x4*)kp[i]; kp[i] += TK * DROW; }
        vreg[0] = *(const u32x4*)vp; vreg[1] = *(const u32x4*)(vp + (size_t)32 * TZ); vp += TK;
    };
    auto lstore = [&](int buf) {
        unsigned char* sk = smem + buf * STG; unsigned char* sv = sk + KBYTES;
#pragma unroll
        for (int i = 0; i < NKR; ++i) if (tid + i * NTHR < KCH) *(u32x4*)(sk + koff[i]) = kreg[i];
        *(u32x4*)(sv + voff) = vreg[0]; *(u32x4*)(sv + voff + 32 * VPITCH) = vreg[1];
    };
    const int NT = nkeys / TK;
    __syncthreads();
    gload();
    for (int kt = 0; kt < NT; ++kt) {
        lstore(kt & 1);
        if (kt + 1 < NT) gload();
        __syncthreads();
#pragma unroll 1
        for (int sub = 0; sub < 2; ++sub) {
            const unsigned char* sk = smem + (kt & 1) * STG + sub * 64 * KPITCH; const unsigned char* sv = smem + (kt & 1) * STG + KBYTES + sub * 128;
            f32x16 sacc[2];
#pragma unroll
            for (int kg = 0; kg < 2; ++kg) {
#pragma unroll
                for (int i = 0; i < 16; ++i) sacc[kg][i] = 0.f;
#pragma unroll
                for (int ks = 0; ks < KS; ++ks) sacc[kg] = __builtin_amdgcn_mfma_f32_32x32x16_bf16(*(const bf16x8*)(sk + (kg * 32 + r) * KPITCH + ks * 32 + hh * 16), qf[ks], sacc[kg], 0, 0, 0);
            }
            float mx = sacc[0][0];
#pragma unroll
            for (int kg = 0; kg < 2; ++kg)
#pragma unroll
                for (int i = 0; i < 16; ++i) mx = fmaxf(mx, sacc[kg][i]);
            mx = fmaxf(mx, __shfl_xor(mx, 32, 64));
            const float hi = mx - mref;
            const bool first = (kt == 0) && (sub == 0);
            const bool need = (hi > ATT_THR) || (first && mx < -32.f);
            if (__any(need)) {
                const float d = need ? hi : 0.f;
                const float alpha = first ? 1.f : __builtin_amdgcn_exp2f(-d);
                mref += d; lrun *= alpha;
#pragma unroll
                for (int t = 0; t < 2; ++t)
#pragma unroll
                    for (int i = 0; i < 16; ++i) oacc[t][i] *= alpha;
            }
            if (__any(mref != 0.f)) {
#pragma unroll
                for (int kg = 0; kg < 2; ++kg)
#pragma unroll
                    for (int i = 0; i < 16; ++i) sacc[kg][i] -= mref;
            }
            float psum = 0.f;
#pragma unroll
            for (int kg = 0; kg < 2; ++kg)
#pragma unroll
                for (int i = 0; i < 16; ++i) { const float p = __builtin_amdgcn_exp2f(sacc[kg][i]); sacc[kg][i] = p; psum += p; }
            lrun += psum;
#pragma unroll
            for (int kg = 0; kg < 2; ++kg)
#pragma unroll
                for (int s = 0; s < 2; ++s) {
                    u32x4 pk; pk.x = pack2(sacc[kg][8 * s + 0], sacc[kg][8 * s + 1]); pk.y = pack2(sacc[kg][8 * s + 2], sacc[kg][8 * s + 3]);
                    pk.z = pack2(sacc[kg][8 * s + 4], sacc[kg][8 * s + 5]); pk.w = pack2(sacc[kg][8 * s + 6], sacc[kg][8 * s + 7]);
                    const bf16x8 pf = __builtin_bit_cast(bf16x8, pk);
#pragma unroll
                    for (int t = 0; t < 2; ++t) {
                        const unsigned char* vrow = sv + (t * 32 + r) * VPITCH + (kg * 32 + 16 * s + 4 * hh) * 2;
                        const u32x2 lo = *(const u32x2*)vrow, hi2 = *(const u32x2*)(vrow + 16);
                        u32x4 vv; vv.x = lo.x; vv.y = lo.y; vv.z = hi2.x; vv.w = hi2.y;
                        oacc[t] = __builtin_amdgcn_mfma_f32_32x32x16_bf16(__builtin_bit_cast(bf16x8, vv), pf, oacc[t], 0, 0, 0);
                    }
                }
        }
    }
    const float inv = 1.f / (lrun + __shfl_xor(lrun, 32, 64));
    bf16_t* Ycat = (bf16_t*)(ws + WS_BUFA);
    const int zrow = b * TZ + qrow;
    float* park = (float*)(smem + ATT_PARK) + tid;
    if (MODE == 0) {
#pragma unroll
        for (int t = 0; t < 2; ++t)
#pragma unroll
            for (int i4 = 0; i4 < 4; ++i4) {
                const int dv = t * 32 + 8 * i4 + 4 * hh;
                *(u32x2*)(Ycat + (size_t)zrow * D + h * 64 + dv) = pack4(oacc[t][4 * i4] * inv, oacc[t][4 * i4 + 1] * inv, oacc[t][4 * i4 + 2] * inv, oacc[t][4 * i4 + 3] * inv);
            }
    } else if (MODE == 1) {
#pragma unroll
        for (int t = 0; t < 2; ++t)
#pragma unroll
            for (int i = 0; i < 16; ++i) park[(t * 16 + i) * NTHR] = oacc[t][i] * inv;
    } else {
        const float lam = ((const float*)(ws + WS_WSM + OFF_LAM))[l];
        const float lam_init = 0.8f - 0.6f * __expf(-0.3f * (float)l);
        float ss = 0.f;
#pragma unroll
        for (int t = 0; t < 2; ++t)
#pragma unroll
            for (int i = 0; i < 16; ++i) { const float o = park[(t * 16 + i) * NTHR] - lam * oacc[t][i] * inv; oacc[t][i] = o; ss += o * o; }
        ss += __shfl_xor(ss, 32, 64);
        const float rs = rsqrtf(ss * (1.f / 64.f) + 1e-5f) * (1.f - lam_init);
        const float* sg = c.in[38] + l * 64;
#pragma unroll
        for (int t = 0; t < 2; ++t)
#pragma unroll
            for (int i4 = 0; i4 < 4; ++i4) {
                const int dv = t * 32 + 8 * i4 + 4 * hh; const float4 g = *(const float4*)(sg + dv);
                *(u32x2*)(Ycat + (size_t)zrow * D + 768 + h * 64 + dv) = pack4(oacc[t][4 * i4] * rs * g.x, oacc[t][4 * i4 + 1] * rs * g.y, oacc[t][4 * i4 + 2] * rs * g.z, oacc[t][4 * i4 + 3] * rs * g.w);
            }
    }
}
DI void phase_attention(const Ctx& c, int l) {
    const int nu = 512 + (l == 0 ? 16 : 0);
    for (int u = blockIdx.x; u < nu; u += gridDim.x) {
        int b, h, q0, nk; bool mla;
        if (u < 512) { const int k = u & 255; b = k >> 7; h = (k >> 5) & 3; q0 = CTX + (k & 31) * 256; nk = TZ; mla = u < 256; }
        else { const int k = u - 512; b = (k >> 2) & 1; h = k & 3; q0 = 0; nk = CTX; mla = k < 8; }
        if (mla) attn_pass<0>(c, l, b, h, q0, nk);
        else { attn_pass<1>(c, l, b, h, q0, nk); attn_pass<2>(c, l, b, h, q0, nk); }
    }
}

DI int rw_tok(int dir, int i) { return dir == 0 ? i : (i < CTX ? CTX - 1 - i : TZ - 1 - (i - CTX)); }
constexpr int RW_TS = 32;
constexpr int RW_STEP_F = 6 * 64 + 2;
constexpr int RW_BUF_F = RW_TS * RW_STEP_F;
template <int CTRL> DI float dpp_add(float x) { return x + __int_as_float(__builtin_amdgcn_update_dpp(0, __float_as_int(x), CTRL, 0xf, 0xf, false)); }
DI float red16(float x) { x = dpp_add<0xB1>(x); x = dpp_add<0x4E>(x); x = dpp_add<0x141>(x); x = dpp_add<0x140>(x); return x; }
DI float red8(float x) { x = dpp_add<0xB1>(x); x = dpp_add<0x4E>(x); x = dpp_add<0x141>(x); return x; }
struct RwRegs { u32x4 r, v, kk, e, ad, kd; };
DI void rw_load(const Ctx& c, int b, int h, int dir, int chunk, int t, RwRegs& g) {
    const bf16_t* RB = (const bf16_t*)(c.ws + WS_EXPW + MX_RB); const bf16_t* VB = (const bf16_t*)(c.ws + WS_EXPW + MX_VB); const bf16_t* KKB = (const bf16_t*)(c.ws + WS_EXPW + MX_KKB);
    const bf16_t* SE = (const bf16_t*)(c.ws + WS_P + P_PR) + (size_t)dir * NZ * 256; const bf16_t* SAD = SE + (size_t)2 * NZ * 256; const bf16_t* SKD = SAD + (size_t)2 * NZ * 256;
    const int i = chunk * RW_TS + (t >> 3), z = b * TZ + rw_tok(dir, i); const size_t o = (size_t)z * 256 + h * 64 + (t & 7) * 8;
    g.r = *(const u32x4*)(RB + o); g.v = *(const u32x4*)(VB + o); g.kk = *(const u32x4*)(KKB + o);
    g.e = *(const u32x4*)(SE + o); g.ad = *(const u32x4*)(SAD + o); g.kd = *(const u32x4*)(SKD + o);
}
DI void up8(const u32x4& u, float (&f)[8]) { f[0] = lo2f(u.x); f[1] = hi2f(u.x); f[2] = lo2f(u.y); f[3] = hi2f(u.y); f[4] = lo2f(u.z); f[5] = hi2f(u.z); f[6] = lo2f(u.w); f[7] = hi2f(u.w); }
DI void rw_process(const RwRegs& g, int t, float* buf) {
    float r[8], v[8], kk[8], e[8], ad[8], kd[8];
    up8(g.r, r); up8(g.v, v); up8(g.kk, kk); up8(g.e, e); up8(g.ad, ad); up8(g.kd, kd);
    float* f = buf + (t >> 3) * RW_STEP_F + (t & 7) * 8;
    float w[8], bv[8], wr[8]; float br = 0.f, kr = 0.f;
#pragma unroll
    for (int j = 0; j < 8; ++j) { w[j] = __expf(-e[j]); bv[j] = kk[j] * ad[j]; wr[j] = w[j] * r[j]; br += bv[j] * r[j]; kr += kd[j] * r[j]; }
    *(float4*)(f) = make_float4(w[0], w[1], w[2], w[3]); *(float4*)(f + 4) = make_float4(w[4], w[5], w[6], w[7]);
    *(float4*)(f + 64) = make_float4(kk[0], kk[1], kk[2], kk[3]); *(float4*)(f + 68) = make_float4(kk[4], kk[5], kk[6], kk[7]);
    *(float4*)(f + 128) = make_float4(bv[0], bv[1], bv[2], bv[3]); *(float4*)(f + 132) = make_float4(bv[4], bv[5], bv[6], bv[7]);
    *(float4*)(f + 192) = make_float4(kd[0], kd[1], kd[2], kd[3]); *(float4*)(f + 196) = make_float4(kd[4], kd[5], kd[6], kd[7]);
    *(float4*)(f + 256) = make_float4(wr[0], wr[1], wr[2], wr[3]); *(float4*)(f + 260) = make_float4(wr[4], wr[5], wr[6], wr[7]);
    *(float4*)(f + 320) = make_float4(v[0], v[1], v[2], v[3]); *(float4*)(f + 324) = make_float4(v[4], v[5], v[6], v[7]);
    br = red8(br); kr = red8(kr);
    if ((t & 7) == 0) { float* s = buf + (t >> 3) * RW_STEP_F + 384; s[0] = br; s[1] = kr; }
}
struct RwStep { float4 w, kk, bv, kd, wr; float vv, br, kr; };
DI void rw_ld(RwStep& s, const float* f, int kq, int row) {
    s.w = *(const float4*)(f + kq * 4); s.kk = *(const float4*)(f + 64 + kq * 4); s.bv = *(const float4*)(f + 128 + kq * 4);
    s.kd = *(const float4*)(f + 192 + kq * 4); s.wr = *(const float4*)(f + 256 + kq * 4); s.vv = f[320 + row]; s.br = f[384]; s.kr = f[385];
}
DI void phase_rwkv_scan_unit(const Ctx& c, int l, int u) {
    const int rg = u & 3, chain = u >> 2, dir = chain & 1, h = (chain >> 1) & 3, b = chain >> 3;
    float* buf0 = (float*)c.smem; float* buf1 = buf0 + RW_BUF_F;
    float* ybuf = buf1 + RW_BUF_F;
    float* YO = (float*)(c.ws + WS_BUFB) + (size_t)dir * NZ * 256 + (size_t)b * TZ * 256 + h * 64 + rg * 16;
    const int wave = c.wave, lane = c.lane, rr = lane >> 4, kq = lane & 15, rl = (wave & 3) * 4 + rr, row = rg * 16 + rl;
    const int t = c.tid - 256;
    float S0 = 0.f, S1 = 0.f, S2 = 0.f, S3 = 0.f;
    constexpr int NCH = TZ / RW_TS;
    RwRegs g;
    __syncthreads();
    if (wave >= 4) { rw_load(c, b, h, dir, 0, t, g); rw_process(g, t, buf0); rw_load(c, b, h, dir, 1, t, g); }
    __syncthreads();
    for (int ch = 0; ch < NCH; ++ch) {
        float* cur = buf0 + (ch & 1) * RW_BUF_F; float* nxt = buf0 + ((ch + 1) & 1) * RW_BUF_F;
        if (wave >= 4) {
            if (ch > 0) {
                const float* yb = ybuf + ((ch - 1) & 1) * RW_TS * 16;
#pragma unroll
                for (int i = 0; i < 2; ++i) { const int e = t + i * 256, st = e >> 4, rw = e & 15; YO[(size_t)rw_tok(dir, (ch - 1) * RW_TS + st) * 256 + rw] = yb[e]; }
            }
            if (ch + 1 < NCH) rw_process(g, t, nxt);
            if (ch + 2 < NCH) rw_load(c, b, h, dir, ch + 2, t, g);
        } else {
            float* yb = ybuf + (ch & 1) * RW_TS * 16 + rl;
            RwStep s0, s1;
            rw_ld(s0, cur, kq, row);
#pragma unroll 4
            for (int st = 0; st < RW_TS; st += 2) {
                rw_ld(s1, cur + (st + 1) * RW_STEP_F, kq, row);
                {
                    float sa = -((S0 * s0.kk.x + S1 * s0.kk.y) + (S2 * s0.kk.z + S3 * s0.kk.w));
                    float q = (S0 * s0.wr.x + S1 * s0.wr.y) + (S2 * s0.wr.z + S3 * s0.wr.w);
                    sa = red16(sa); q = red16(q);
                    S0 = fmaf(sa, s0.bv.x, fmaf(S0, s0.w.x, s0.vv * s0.kd.x)); S1 = fmaf(sa, s0.bv.y, fmaf(S1, s0.w.y, s0.vv * s0.kd.y));
                    S2 = fmaf(sa, s0.bv.z, fmaf(S2, s0.w.z, s0.vv * s0.kd.z)); S3 = fmaf(sa, s0.bv.w, fmaf(S3, s0.w.w, s0.vv * s0.kd.w));
                    yb[st * 16] = q + sa * s0.br + s0.vv * s0.kr;
                }
                if (st + 2 < RW_TS) rw_ld(s0, cur + (st + 2) * RW_STEP_F, kq, row);
                {
                    float sa = -((S0 * s1.kk.x + S1 * s1.kk.y) + (S2 * s1.kk.z + S3 * s1.kk.w));
                    float q = (S0 * s1.wr.x + S1 * s1.wr.y) + (S2 * s1.wr.z + S3 * s1.wr.w);
                    sa = red16(sa); q = red16(q);
                    S0 = fmaf(sa, s1.bv.x, fmaf(S0, s1.w.x, s1.vv * s1.kd.x)); S1 = fmaf(sa, s1.bv.y, fmaf(S1, s1.w.y, s1.vv * s1.kd.y));
                    S2 = fmaf(sa, s1.bv.z, fmaf(S2, s1.w.z, s1.vv * s1.kd.z)); S3 = fmaf(sa, s1.bv.w, fmaf(S3, s1.w.w, s1.vv * s1.kd.w));
                    yb[(st + 1) * 16] = q + sa * s1.br + s1.vv * s1.kr;
                }
            }
        }
        __syncthreads();
    }
    if (wave >= 4) {
        const float* yb = ybuf + ((NCH - 1) & 1) * RW_TS * 16;
#pragma unroll
        for (int i = 0; i < 2; ++i) { const int e = t + i * 256, st = e >> 4, rw = e & 15; YO[(size_t)rw_tok(dir, (NCH - 1) * RW_TS + st) * 256 + rw] = yb[e]; }
    }
}

constexpr int LA_AN = 0, LA_RN = 8192, LA_BN = 16384, LA_KN = 24576, LA_AT = 32768, LA_BHT = 40960, LA_KHT = 49152, LA_VT = 57344,
              LA_NBA = 65536  , LA_NKA = 81920, LA_NBRT = 90112, LA_NKRT = 98304, LA_P63 = 106496;
constexpr int LA_TMT = LA_AN, LA_M1 = LA_BN, LA_W1T = LA_KN, LA_Z1 = LA_NBA;
DI int crow(int reg, int h) { return (reg & 3) + 8 * (reg >> 2) + 4 * h; }
DI void mm_tile(f32x16& acc, const unsigned char* A, int i0, const unsigned char* BT, int j0, int r, int h) {
#pragma unroll
    for (int ks = 0; ks < 4; ++ks) {
        const bf16x8 a = *(const bf16x8*)(A + (i0 + r) * 128 + ks * 32 + h * 16);
        const bf16x8 b = *(const bf16x8*)(BT + (j0 + r) * 128 + ks * 32 + h * 16);
        acc = __builtin_amdgcn_mfma_f32_32x32x16_bf16(a, b, acc, 0, 0, 0);
    }
}
DI void zero16(f32x16& a) {
#pragma unroll
    for (int i = 0; i < 16; ++i) a[i] = 0.f;
}
DI void phase_rwkv_chunk_unit(const Ctx& c, int l, int unit) {
    unsigned char* L = c.smem; unsigned char* ws = c.ws;
    const int chain = unit / RNC, ch = unit % RNC, dir = chain & 1, hd = (chain >> 1) & 3, b = chain >> 3;
    const int tid = c.tid, lane = c.lane, wave = c.wave, r = lane & 31, h = lane >> 5;
    const bf16_t* RB = (const bf16_t*)(ws + WS_EXPW + MX_RB); const bf16_t* VB = (const bf16_t*)(ws + WS_EXPW + MX_VB); const bf16_t* KKB = (const bf16_t*)(ws + WS_EXPW + MX_KKB);
    const bf16_t* SE = (const bf16_t*)(ws + WS_P + P_PR) + (size_t)dir * NZ * 256; const bf16_t* SAD = SE + (size_t)2 * NZ * 256; const bf16_t* SKD = SAD + (size_t)2 * NZ * 256;
    float* CUM = (float*)(L + LA_NBA);
    __syncthreads();
    const int t = tid >> 3, k0 = (tid & 7) * 8;
    float rr[8], vv[8], kk[8], ee[8], ad[8], kd[8];
    {
        const int z = b * TZ + rw_tok(dir, ch * RC + t); const size_t o = (size_t)z * 256 + hd * 64 + k0;
        up8(*(const u32x4*)(RB + o), rr); up8(*(const u32x4*)(VB + o), vv); up8(*(const u32x4*)(KKB + o), kk);
        up8(*(const u32x4*)(SE + o), ee); up8(*(const u32x4*)(SAD + o), ad); up8(*(const u32x4*)(SKD + o), kd);
        *(float4*)(CUM + t * 64 + k0) = make_float4(ee[0], ee[1], ee[2], ee[3]); *(float4*)(CUM + t * 64 + k0 + 4) = make_float4(ee[4], ee[5], ee[6], ee[7]);
    }
    __syncthreads();
    if (wave == 0) { float cm = 0.f;
#pragma unroll 8
        for (int i = 0; i < RC; ++i) { cm += CUM[i * 64 + lane]; CUM[i * 64 + lane] = cm; } }
    __syncthreads();
    {
        float cm[8], c63[8];
        { const float4 a = *(const float4*)(CUM + t * 64 + k0), bq = *(const float4*)(CUM + t * 64 + k0 + 4); cm[0] = a.x; cm[1] = a.y; cm[2] = a.z; cm[3] = a.w; cm[4] = bq.x; cm[5] = bq.y; cm[6] = bq.z; cm[7] = bq.w; }
        { const float4 a = *(const float4*)(CUM + 63 * 64 + k0), bq = *(const float4*)(CUM + 63 * 64 + k0 + 4); c63[0] = a.x; c63[1] = a.y; c63[2] = a.z; c63[3] = a.w; c63[4] = bq.x; c63[5] = bq.y; c63[6] = bq.z; c63[7] = bq.w; }
        float at[8], rt[8], bt[8], kt[8], bh[8], kh[8];
#pragma unroll
        for (int j = 0; j < 8; ++j) {
            const float pt = __expf(-cm[j]), pp = __expf(-(cm[j] - ee[j])), ip = __expf(cm[j]), ph = __expf(-(c63[j] - cm[j])), bb = kk[j] * ad[j];
            at[j] = -kk[j] * pp; rt[j] = rr[j] * pt; bt[j] = bb * ip; kt[j] = kd[j] * ip; bh[j] = bb * ph; kh[j] = kd[j] * ph;
        }
        u32x4 w4;
        w4.x = pack2(at[0], at[1]); w4.y = pack2(at[2], at[3]); w4.z = pack2(at[4], at[5]); w4.w = pack2(at[6], at[7]); *(u32x4*)(L + LA_AN + t * 128 + k0 * 2) = w4;
        w4.x = pack2(rt[0], rt[1]); w4.y = pack2(rt[2], rt[3]); w4.z = pack2(rt[4], rt[5]); w4.w = pack2(rt[6], rt[7]); *(u32x4*)(L + LA_RN + t * 128 + k0 * 2) = w4;
        w4.x = pack2(bt[0], bt[1]); w4.y = pack2(bt[2], bt[3]); w4.z = pack2(bt[4], bt[5]); w4.w = pack2(bt[6], bt[7]); *(u32x4*)(L + LA_BN + t * 128 + k0 * 2) = w4;
        w4.x = pack2(kt[0], kt[1]); w4.y = pack2(kt[2], kt[3]); w4.z = pack2(kt[4], kt[5]); w4.w = pack2(kt[6], kt[7]); *(u32x4*)(L + LA_KN + t * 128 + k0 * 2) = w4;
#pragma unroll
        for (int j = 0; j < 8; ++j) {
            *(bf16_t*)(L + LA_AT + (k0 + j) * 128 + t * 2) = f2bf(at[j]); *(bf16_t*)(L + LA_BHT + (k0 + j) * 128 + t * 2) = f2bf(bh[j]);
            *(bf16_t*)(L + LA_KHT + (k0 + j) * 128 + t * 2) = f2bf(kh[j]); *(bf16_t*)(L + LA_VT + (k0 + j) * 128 + t * 2) = f2bf(vv[j]);
        }
        if (t == 63) {
            float* p63 = (float*)(L + LA_P63); float* gp = (float*)(ws + WS_RW + RW_P63) + (size_t)unit * 64;
#pragma unroll
            for (int j = 0; j < 8; ++j) { const float p = __expf(-c63[j]); p63[k0 + j] = p; gp[k0 + j] = p; }
        }
    }
    __syncthreads();
    {
        const int p = wave >> 1, i0 = (wave & 1) * 32;
        const unsigned char* A = L + (p == 0 ? LA_BN : p == 1 ? LA_KN : LA_RN);
        const unsigned char* BT = L + (p < 2 ? LA_AN : p == 2 ? LA_BN : LA_KN);
#pragma unroll
        for (int jt = 0; jt < 2; ++jt) {
            const int j0 = jt * 32; f32x16 acc; zero16(acc);
            mm_tile(acc, A, i0, BT, j0, r, h);
            const int col = j0 + r;
#pragma unroll
            for (int g = 0; g < 16; ++g) {
                const int row = i0 + crow(g, h);
                if (p == 0) ((float*)(L + LA_NBA))[row * 64 + col] = (row < col) ? acc[g] : 0.f;
                else if (p == 1) *(bf16_t*)(L + LA_NKA + row * 128 + col * 2) = f2bf((row < col) ? acc[g] : 0.f);
                else *(bf16_t*)(L + (p == 2 ? LA_NBRT : LA_NKRT) + row * 128 + col * 2) = f2bf((col <= row) ? acc[g] : 0.f);
            }
        }
    }
    __syncthreads();
    {
        constexpr int X0 = LA_BN, X1 = LA_KN, X3 = 108544, X4 = X3 + 8192, X5 = LA_NBA + 16384 - 16384, X6 = LA_NBA + 8192;
        float nv[8];
        { const int s = tid >> 3, t0 = (tid & 7) * 8; const float* N = (const float*)(L + LA_NBA) + s * 64 + t0;
          const float4 a = *(const float4*)N, bq = *(const float4*)(N + 4); nv[0] = a.x; nv[1] = a.y; nv[2] = a.z; nv[3] = a.w; nv[4] = bq.x; nv[5] = bq.y; nv[6] = bq.z; nv[7] = bq.w; }
        __syncthreads();
        {
            const int s = tid >> 3, t0 = (tid & 7) * 8;
            u32x4 w4; w4.x = pack2(nv[0], nv[1]); w4.y = pack2(nv[2], nv[3]); w4.z = pack2(nv[4], nv[5]); w4.w = pack2(nv[6], nv[7]);
            *(u32x4*)(L + X0 + s * 128 + t0 * 2) = w4;
#pragma unroll
            for (int j = 0; j < 8; ++j) *(bf16_t*)(L + X1 + (t0 + j) * 128 + s * 2) = f2bf(nv[j]);
#pragma unroll
            for (int j = 0; j < 8; ++j) if (t0 + j == s) nv[j] += 1.f;
            w4.x = pack2(nv[0], nv[1]); w4.y = pack2(nv[2], nv[3]); w4.z = pack2(nv[4], nv[5]); w4.w = pack2(nv[6], nv[7]);
            *(u32x4*)(L + X5 + s * 128 + t0 * 2) = w4;
        }
        __syncthreads();
        const int ti0 = ((wave >> 1) & 1) * 32, tj0 = (wave & 1) * 32;
        if (wave < 4) {
            f32x16 acc; zero16(acc); mm_tile(acc, L + X0, ti0, L + X1, tj0, r, h);
#pragma unroll
            for (int g4 = 0; g4 < 4; ++g4) *(u32x2*)(L + X4 + (tj0 + r) * 128 + (ti0 + 8 * g4 + 4 * h) * 2) = pack4(acc[4 * g4], acc[4 * g4 + 1], acc[4 * g4 + 2], acc[4 * g4 + 3]);
#pragma unroll
            for (int g = 0; g < 16; ++g) *(bf16_t*)(L + X3 + (ti0 + crow(g, h)) * 128 + (tj0 + r) * 2) = f2bf(acc[g]);
        }
        __syncthreads();
#pragma unroll
        for (int k = 1; k <= 5; ++k) {
            const int qa = (k & 1) ? X3 : X0, qt = (k & 1) ? X4 : X1, nqa = (k & 1) ? X0 : X3, nqt = (k & 1) ? X1 : X4;
            const int pa = (k & 1) ? X5 : X6, npa = (k & 1) ? X6 : X5;
            if (wave >= 4) {
                f32x16 acc; zero16(acc); mm_tile(acc, L + pa, ti0, L + qt, tj0, r, h);
#pragma unroll
                for (int g = 0; g < 16; ++g) acc[g] += bf2f(*(const bf16_t*)(L + pa + (ti0 + crow(g, h)) * 128 + (tj0 + r) * 2));
                if (k < 5) {
#pragma unroll
                    for (int g = 0; g < 16; ++g) *(bf16_t*)(L + npa + (ti0 + crow(g, h)) * 128 + (tj0 + r) * 2) = f2bf(acc[g]);
                } else {
#pragma unroll
                    for (int g4 = 0; g4 < 4; ++g4) *(u32x2*)(L + LA_TMT + (tj0 + r) * 128 + (ti0 + 8 * g4 + 4 * h) * 2) = pack4(acc[4 * g4], acc[4 * g4 + 1], acc[4 * g4 + 2], acc[4 * g4 + 3]);
                }
            } else if (k < 5) {
                f32x16 acc; zero16(acc); mm_tile(acc, L + qa, ti0, L + qt, tj0, r, h);
#pragma unroll
                for (int g4 = 0; g4 < 4; ++g4) *(u32x2*)(L + nqt + (tj0 + r) * 128 + (ti0 + 8 * g4 + 4 * h) * 2) = pack4(acc[4 * g4], acc[4 * g4 + 1], acc[4 * g4 + 2], acc[4 * g4 + 3]);
#pragma unroll
                for (int g = 0; g < 16; ++g) *(bf16_t*)(L + nqa + (ti0 + crow(g, h)) * 128 + (tj0 + r) * 2) = f2bf(acc[g]);
            }
            __syncthreads();
        }
    }
    {
        const int p = wave >> 2, i0 = ((wave >> 1) & 1) * 32, j0 = (wave & 1) * 32; f32x16 acc; zero16(acc);
        if (p == 0) {
            mm_tile(acc, L + LA_TMT, i0, L + LA_AT, j0, r, h);
#pragma unroll
            for (int g4 = 0; g4 < 4; ++g4) *(u32x2*)(L + LA_M1 + (j0 + r) * 128 + (i0 + 8 * g4 + 4 * h) * 2) = pack4(acc[4 * g4], acc[4 * g4 + 1], acc[4 * g4 + 2], acc[4 * g4 + 3]);
        } else {
            mm_tile(acc, L + LA_NKA, i0, L + LA_TMT, j0, r, h);
#pragma unroll
            for (int g4 = 0; g4 < 4; ++g4) *(u32x2*)(L + LA_W1T + (j0 + r) * 128 + (i0 + 8 * g4 + 4 * h) * 2) = pack4(acc[4 * g4], acc[4 * g4 + 1], acc[4 * g4 + 2], acc[4 * g4 + 3]);
        }
    }
    __syncthreads();
    if (wave < 4) {
        const int i0 = (wave >> 1) * 32, j0 = (wave & 1) * 32; f32x16 acc; zero16(acc);
        mm_tile(acc, L + LA_W1T, i0, L + LA_VT, j0, r, h);
#pragma unroll
        for (int g4 = 0; g4 < 4; ++g4) *(u32x2*)(L + LA_Z1 + (j0 + r) * 128 + (i0 + 8 * g4 + 4 * h) * 2) = pack4(acc[4 * g4], acc[4 * g4 + 1], acc[4 * g4 + 2], acc[4 * g4 + 3]);
    }
    __syncthreads();
    {
        const int p = wave >> 1, i0 = (wave & 1) * 32;
        bf16_t* GM3 = (bf16_t*)(ws + WS_RW + RW_M3) + (size_t)unit * 4096; bf16_t* GM2 = (bf16_t*)(ws + WS_RW + RW_M2) + (size_t)unit * 4096; bf16_t* GZ5 = (bf16_t*)(ws + WS_RW + RW_Z5) + (size_t)unit * 4096;
        float* YO = (float*)(ws + WS_BUFB) + (size_t)dir * NZ * 256;
#pragma unroll
        for (int jt = 0; jt < 2; ++jt) {
            const int j0 = jt * 32; f32x16 acc; zero16(acc);
            if (p == 0) {
                mm_tile(acc, L + LA_M1, i0, L + LA_NBRT, j0, r, h);
#pragma unroll
                for (int g4 = 0; g4 < 4; ++g4) { const int tt = j0 + r, kq = i0 + 8 * g4 + 4 * h; float rv[4]; unpack4(*(const u32x2*)(L + LA_RN + tt * 128 + kq * 2), rv);
                    *(u32x2*)(GM2 + tt * 64 + kq) = pack4(acc[4 * g4] + rv[0], acc[4 * g4 + 1] + rv[1], acc[4 * g4 + 2] + rv[2], acc[4 * g4 + 3] + rv[3]); }
            } else if (p == 1) {
                mm_tile(acc, L + LA_NBRT, i0, L + LA_Z1, j0, r, h); mm_tile(acc, L + LA_NKRT, i0, L + LA_VT, j0, r, h);
#pragma unroll
                for (int g = 0; g < 16; ++g) { const int tt = i0 + crow(g, h); YO[(size_t)(b * TZ + rw_tok(dir, ch * RC + tt)) * 256 + hd * 64 + j0 + r] = acc[g]; }
            } else if (p == 2) {
                mm_tile(acc, L + LA_M1, i0, L + LA_BHT, j0, r, h);
#pragma unroll
                for (int g4 = 0; g4 < 4; ++g4) *(u32x2*)(GM3 + (j0 + r) * 64 + i0 + 8 * g4 + 4 * h) = pack4(acc[4 * g4], acc[4 * g4 + 1], acc[4 * g4 + 2], acc[4 * g4 + 3]);
            } else {
                mm_tile(acc, L + LA_BHT, i0, L + LA_Z1, j0, r, h); mm_tile(acc, L + LA_KHT, i0, L + LA_VT, j0, r, h);
#pragma unroll
                for (int g4 = 0; g4 < 4; ++g4) *(u32x2*)(GZ5 + (j0 + r) * 64 + i0 + 8 * g4 + 4 * h) = pack4(acc[4 * g4], acc[4 * g4 + 1], acc[4 * g4 + 2], acc[4 * g4 + 3]);
            }
        }
    }
}
DI void phase_rwkv_chunks(const Ctx& c, int l) {
    for (int u = blockIdx.x; u < 16 * RNC; u += gridDim.x) phase_rwkv_chunk_unit(c, l, u);
}
DI bf16x8 pack8(const f32x16& x, int s) {
    u32x4 p; p.x = pack2(x[8 * s], x[8 * s + 1]); p.y = pack2(x[8 * s + 2], x[8 * s + 3]); p.z = pack2(x[8 * s + 4], x[8 * s + 5]); p.w = pack2(x[8 * s + 6], x[8 * s + 7]);
    return __builtin_bit_cast(bf16x8, p);
}
DI bf16x8 ldfrag(const bf16_t* rowp, int s, int h) {
    const u32x2 lo = *(const u32x2*)(rowp + 16 * s + 4 * h), hi = *(const u32x2*)(rowp + 16 * s + 8 + 4 * h);
    u32x4 v; v.x = lo.x; v.y = lo.y; v.z = hi.x; v.w = hi.y; return __builtin_bit_cast(bf16x8, v);
}
constexpr int SQ_PITCH = 144, SQ_MAT = 64 * SQ_PITCH;
constexpr int SQA_M3 = 0, SQA_Z5 = SQ_MAT, SQA_P63 = 2 * SQ_MAT, SQA_BYTES = SQA_P63 + 256;
constexpr int SQB_M2 = 0, SQB_Y = SQ_MAT, SQB_BYTES = SQB_Y + 64 * 64 * 4;
constexpr int SQ_A0 = 0, SQ_B0 = 2 * SQA_BYTES, SQ_XB = SQ_B0 + 2 * SQB_BYTES;
DI bf16x8 ldfrag_l(const unsigned char* rowp, int s, int h) {
    const u32x2 lo = *(const u32x2*)(rowp + (16 * s + 4 * h) * 2), hi = *(const u32x2*)(rowp + (16 * s + 8 + 4 * h) * 2);
    u32x4 v; v.x = lo.x; v.y = lo.y; v.z = hi.x; v.w = hi.y; return __builtin_bit_cast(bf16x8, v);
}
struct SqRegsA { u32x4 m3[2], z5[2], p63; };
struct SqRegsB { u32x4 m2[2], y[4]; };
DI void sqa_gload(const Ctx& c, size_t unit, int lt, SqRegsA& g) {
    const unsigned char* g3 = c.ws + WS_RW + RW_M3 + unit * 8192; const unsigned char* g5 = c.ws + WS_RW + RW_Z5 + unit * 8192;
#pragma unroll
    for (int i = 0; i < 2; ++i) { const int id = lt + i * 256; g.m3[i] = *(const u32x4*)(g3 + id * 16); g.z5[i] = *(const u32x4*)(g5 + id * 16); }
    if (lt < 16) g.p63 = *(const u32x4*)(c.ws + WS_RW + RW_P63 + unit * 256 + lt * 16);
}
DI void sqa_lstore(unsigned char* st, int lt, const SqRegsA& g) {
#pragma unroll
    for (int i = 0; i < 2; ++i) { const int id = lt + i * 256, row = id >> 3, part = id & 7;
        *(u32x4*)(st + SQA_M3 + row * SQ_PITCH + part * 16) = g.m3[i]; *(u32x4*)(st + SQA_Z5 + row * SQ_PITCH + part * 16) = g.z5[i]; }
    if (lt < 16) *(u32x4*)(st + SQA_P63 + lt * 16) = g.p63;
}
DI void sqb_gload(const Ctx& c, size_t unit, const float* YO, int dir, int ch, int lt, SqRegsB& g) {
    const unsigned char* g2 = c.ws + WS_RW + RW_M2 + unit * 8192;
#pragma unroll
    for (int i = 0; i < 2; ++i) g.m2[i] = *(const u32x4*)(g2 + (lt + i * 256) * 16);
#pragma unroll
    for (int i = 0; i < 4; ++i) { const int id = lt + i * 256; g.y[i] = *(const u32x4*)(YO + (size_t)rw_tok(dir, ch * RC + (id >> 4)) * 256 + (id & 15) * 4); }
}
DI void sqb_lstore(unsigned char* st, int lt, const SqRegsB& g) {
#pragma unroll
    for (int i = 0; i < 2; ++i) { const int id = lt + i * 256; *(u32x4*)(st + SQB_M2 + (id >> 3) * SQ_PITCH + (id & 7) * 16) = g.m2[i]; }
#pragma unroll
    for (int i = 0; i < 4; ++i) { const int id = lt + i * 256; *(u32x4*)(st + SQB_Y + (id >> 4) * 256 + (id & 15) * 16) = g.y[i]; }
}
DI void sqb_store_y(float* YO, int dir, int ch, const unsigned char* st, int lt) {
#pragma unroll
    for (int i = 0; i < 4; ++i) { const int id = lt + i * 256; *(u32x4*)(YO + (size_t)rw_tok(dir, ch * RC + (id >> 4)) * 256 + (id & 15) * 4) = *(const u32x4*)(st + SQB_Y + (id >> 4) * 256 + (id & 15) * 16); }
}
DI void phase_rwkv_seq_block(const Ctx& c, int l, int chain) {
    unsigned char* L = c.smem; const int lane = c.lane, wave = c.wave, r = lane & 31, h = lane >> 5;
    const int dir = chain & 1, hd = (chain >> 1) & 3, b = chain >> 3, lt = c.tid - 256, vh = wave & 1;
    const size_t unit0 = (size_t)chain * RNC;
    __syncthreads();
    if (wave >= 4) {
        float* YO = (float*)(c.ws + WS_BUFB) + (size_t)dir * NZ * 256 + (size_t)b * TZ * 256 + hd * 64;
        SqRegsA ga; SqRegsB gb;
        sqa_gload(c, unit0, lt, ga); sqa_lstore(L + SQ_A0, lt, ga); sqa_gload(c, unit0 + 1, lt, ga); sqb_gload(c, unit0, YO, dir, 0, lt, gb);
        __syncthreads();
#pragma unroll 1
        for (int ch = 0; ch <= RNC; ++ch) {
            unsigned char* sb = L + SQ_B0 + (ch & 1) * SQB_BYTES;
            if (ch >= 2) sqb_store_y(YO, dir, ch - 2, sb, lt);
            if (ch < RNC) sqb_lstore(sb, lt, gb);
            if (ch + 1 < RNC) { sqb_gload(c, unit0 + ch + 1, YO, dir, ch + 1, lt, gb); sqa_lstore(L + SQ_A0 + ((ch + 1) & 1) * SQA_BYTES, lt, ga); }
            if (ch + 2 < RNC) sqa_gload(c, unit0 + ch + 2, lt, ga);
            __syncthreads();
        }
        sqb_store_y(YO, dir, RNC - 1, L + SQ_B0 + ((RNC - 1) & 1) * SQB_BYTES, lt);
    } else if (wave < 2) {
        f32x16 x[2]; zero16(x[0]); zero16(x[1]);
        __syncthreads();
#pragma unroll 1
        for (int ch = 0; ch <= RNC; ++ch) {
            if (ch < RNC) {
                const unsigned char* st = L + SQ_A0 + (ch & 1) * SQA_BYTES;
                unsigned char* xbuf = L + SQ_XB + ((ch & 1) * 2 + vh) * 4096 + lane * 16;
                bf16x8 xb[4];
#pragma unroll
                for (int s = 0; s < 4; ++s) { xb[s] = pack8(x[s >> 1], s & 1); *(bf16x8*)(xbuf + s * 1024) = xb[s]; }
                f32x16 xn0, xn1;
#pragma unroll
                for (int i = 0; i < 2; ++i) {
                    f32x16 xa;
#pragma unroll
                    for (int g4 = 0; g4 < 4; ++g4) {
                        float z5[4]; unpack4(*(const u32x2*)(st + SQA_Z5 + (vh * 32 + r) * SQ_PITCH + (32 * i + 8 * g4 + 4 * h) * 2), z5);
                        const float4 p4 = *(const float4*)(st + SQA_P63 + (32 * i + 8 * g4 + 4 * h) * 4);
                        xa[4 * g4] = fmaf(p4.x, x[i][4 * g4], z5[0]); xa[4 * g4 + 1] = fmaf(p4.y, x[i][4 * g4 + 1], z5[1]);
                        xa[4 * g4 + 2] = fmaf(p4.z, x[i][4 * g4 + 2], z5[2]); xa[4 * g4 + 3] = fmaf(p4.w, x[i][4 * g4 + 3], z5[3]);
                    }
#pragma unroll
                    for (int s = 0; s < 4; ++s) xa = __builtin_amdgcn_mfma_f32_32x32x16_bf16(ldfrag_l(st + SQA_M3 + (32 * i + r) * SQ_PITCH, s, h), xb[s], xa, 0, 0, 0);
                    if (i == 0) xn0 = xa; else xn1 = xa;
                }
                x[0] = xn0; x[1] = xn1;
            }
            __syncthreads();
        }
    } else {
        __syncthreads();
#pragma unroll 1
        for (int ch = 0; ch <= RNC; ++ch) {
            if (ch >= 1) {
                const int cy = ch - 1;
                unsigned char* st = L + SQ_B0 + (cy & 1) * SQB_BYTES;
                const unsigned char* xbuf = L + SQ_XB + ((cy & 1) * 2 + vh) * 4096 + lane * 16;
                bf16x8 xb[4];
#pragma unroll
                for (int s = 0; s < 4; ++s) xb[s] = *(const bf16x8*)(xbuf + s * 1024);
#pragma unroll
                for (int i = 0; i < 2; ++i) {
                    f32x16 ya;
#pragma unroll
                    for (int g = 0; g < 16; ++g) ya[g] = *((const float*)(st + SQB_Y) + (32 * i + crow(g, h)) * 64 + vh * 32 + r);
#pragma unroll
                    for (int s = 0; s < 4; ++s) ya = __builtin_amdgcn_mfma_f32_32x32x16_bf16(ldfrag_l(st + SQB_M2 + (32 * i + r) * SQ_PITCH, s, h), xb[s], ya, 0, 0, 0);
#pragma unroll
                    for (int g = 0; g < 16; ++g) *((float*)(st + SQB_Y) + (32 * i + crow(g, h)) * 64 + vh * 32 + r) = ya[g];
                }
            }
            __syncthreads();
        }
    }
}
DI void phase_mixers2(const Ctx& c, int l) {
    const int G = gridDim.x, bid = blockIdx.x;
    if (G >= 128) {
        if (bid < 16) phase_rwkv_seq_block(c, l, bid);
        else for (int u = bid - 16; u < 2 * S5N * 4; u += G - 16) phase_s5_final_unit<false>(c, l, u);
    } else {
        for (int u = bid; u < 16; u += G) phase_rwkv_seq_block(c, l, u);
        for (int u = bid; u < 2 * S5N * 4; u += G) phase_s5_final_unit<false>(c, l, u);
    }
}

DI void phase_post(const Ctx& c, int l) {
    unsigned char* ws = c.ws; const int lane = c.lane;
    const float* YF = (const float*)(ws + WS_BUFB); const float* YB = YF + (size_t)NZ * 256;
    const bf16_t* RB = (const bf16_t*)(ws + WS_EXPW + MX_RB); const bf16_t* VB = (const bf16_t*)(ws + WS_EXPW + MX_VB);
    const bf16_t* SKD = (const bf16_t*)(ws + WS_P + P_PR) + (size_t)4 * NZ * 256; const bf16_t* GG = (const bf16_t*)(ws + WS_MISC + MS_GG);
    bf16_t* Ycat = (bf16_t*)(ws + WS_BUFA);
    const float* r_k = c.in[21] + l * 256; const float* lg = c.in[22] + l * 256; const float* lb = c.in[23] + l * 256;
    for (int z = blockIdx.x * 8 + c.wave; z < NZ; z += gridDim.x * 8) {
        const size_t o = (size_t)z * 256 + lane * 4;
        const float4 yf = *(const float4*)(YF + o), yb = *(const float4*)(YB + o);
        const float y0 = yf.x + yb.x, y1 = yf.y + yb.y, y2 = yf.z + yb.z, y3 = yf.w + yb.w;
        const float mean = sum16(y0 + y1 + y2 + y3) * (1.f / 64.f);
        const float d0 = y0 - mean, d1 = y1 - mean, d2 = y2 - mean, d3 = y3 - mean;
        const float var = sum16(d0 * d0 + d1 * d1 + d2 * d2 + d3 * d3) * (1.f / 64.f);
        const float rs = rsqrtf(var + 64e-5f);
        float r[4], v[4], k0[4], k1[4], gg[4];
        unpack4(*(const u32x2*)(RB + o), r); unpack4(*(const u32x2*)(VB + o), v); unpack4(*(const u32x2*)(SKD + o), k0); unpack4(*(const u32x2*)(SKD + (size_t)NZ * 256 + o), k1);
        unpack4(*(const u32x2*)(GG + o), gg);
        const float4 rk = *(const float4*)(r_k + lane * 4), g4 = *(const float4*)(lg + lane * 4), b4 = *(const float4*)(lb + lane * 4);
        const float bs = sum16(r[0] * (k0[0] + k1[0]) * rk.x + r[1] * (k0[1] + k1[1]) * rk.y + r[2] * (k0[2] + k1[2]) * rk.z + r[3] * (k0[3] + k1[3]) * rk.w);
        *(u32x2*)(Ycat + (size_t)z * D + 256 + lane * 4) = pack4((d0 * rs * g4.x + b4.x + bs * v[0]) * gg[0], (d1 * rs * g4.y + b4.y + bs * v[1]) * gg[1],
                                                                (d2 * rs * g4.z + b4.z + bs * v[2]) * gg[2], (d3 * rs * g4.w + b4.w + bs * v[3]) * gg[3]);
    }
    {
        const bf16_t* ZG = (const bf16_t*)(ws + WS_MISC + MS_ZG); const bf16_t* W = (const bf16_t*)(ws + WS_WSM + OFF_GLUT + l * SZ_GLUT);
        const float* gb = c.in[33] + l * 256;
        for (int u = blockIdx.x; u < (NZ / 256) * 2; u += gridDim.x) {
            const int mt = u / 2, nt = u % 2, r0 = mt * 256, c0 = nt * 128;
            gemm_tile<4, 0>(c, 256, [&](int i) { return ZG + (size_t)(r0 + i) * 256; }, [&](int i) { return W + (size_t)(c0 + i) * 256; }, NoHook(),
                [&](f32x4 (&acc)[4][4], int wr, int wc, int fr, int fq) {
#pragma unroll
                    for (int n = 0; n < 4; ++n) {
                        const int col = c0 + wc + n * 16 + fq * 4; const float4 bb = *(const float4*)(gb + col);
#pragma unroll
                        for (int m = 0; m < 4; ++m) {
                            const int row = r0 + wr + m * 16 + fr; const f32x4 v = acc[m][n];
                            float zg[4]; unpack4(*(const u32x2*)(ZG + (size_t)row * 256 + col), zg);
                            *(u32x2*)(Ycat + (size_t)row * D + 512 + col) = pack4(zg[0] * sigmoidf_(v[0] + bb.x), zg[1] * sigmoidf_(v[1] + bb.y), zg[2] * sigmoidf_(v[2] + bb.z), zg[3] * sigmoidf_(v[3] + bb.w));
                        }
                    }
                });
        }
    }
}

DI bool skip_mt(int l, int mt) { return l == NL - 1 && (mt % 33) == 0; }
DI void phase_merge1(const Ctx& c, int l) {
    const bf16_t* Ycat = (const bf16_t*)(c.ws + WS_BUFA); const bf16_t* W = (const bf16_t*)(c.ws + WS_WSM + OFF_WBT + l * SZ_WBT);
    const bf16_t* GT = (const bf16_t*)(c.ws + WS_GT); bf16_t* MG = (bf16_t*)(c.ws + WS_BUFB);
    if (blockIdx.x == 0 && c.tid < 32) ((unsigned*)(c.ws + WS_CTL))[CW_CNT + l * 32 + c.tid] = 0u;
    for (int u = blockIdx.x; u < (NZ / 256) * 8; u += gridDim.x) {
        const int mt = u / 8, nt = u % 8, r0 = mt * 256, c0 = nt * 128;
        if (skip_mt(l, mt)) continue;
        f32x4 macc[4][4];
#pragma unroll
        for (int m = 0; m < 4; ++m)
#pragma unroll
            for (int n = 0; n < 4; ++n) macc[m][n] = (f32x4){0.f, 0.f, 0.f, 0.f};
        gemm_tile<4, 256>(c, 1024, [&](int i) { return Ycat + (size_t)(r0 + i) * D; }, [&](int i) { return W + (size_t)(c0 + i) * D; },
            [&](f32x4 (&acc)[4][4], int seg, int wr, int wc, int fr, int fq) {
#pragma unroll
                for (int m = 0; m < 4; ++m)
#pragma unroll
                    for (int n = 0; n < 4; ++n) {
                        float g[4]; unpack4(*(const u32x2*)(GT + (size_t)(r0 + wr + m * 16 + fr) * 4096 + seg * 1024 + c0 + wc + n * 16 + fq * 4), g);
                        macc[m][n][0] += g[0] * acc[m][n][0]; macc[m][n][1] += g[1] * acc[m][n][1]; macc[m][n][2] += g[2] * acc[m][n][2]; macc[m][n][3] += g[3] * acc[m][n][3];
                        acc[m][n] = (f32x4){0.f, 0.f, 0.f, 0.f};
                    }
            },
            [&](f32x4 (&)[4][4], int wr, int wc, int fr, int fq) {
#pragma unroll
                for (int m = 0; m < 4; ++m)
#pragma unroll
                    for (int n = 0; n < 4; ++n)
                        *(u32x2*)(MG + (size_t)(r0 + wr + m * 16 + fr) * D + c0 + wc + n * 16 + fq * 4) = pack4(macc[m][n][0], macc[m][n][1], macc[m][n][2], macc[m][n][3]);
            });
    }
}
struct EpiMerge2 {
    static constexpr bool PERM = false, AFTER_DRAIN = false;
    float* H; const float* modv; int l;
    DI void operator()(const pg8::f32x4 (&acc)[2][2][4][2], const pg8::Unit& u, int wr, int wc, int fr, int fq) const {
        if (skip_mt(l, u.pm)) return;
        const int sel = (u.pm % 33) == 0 ? 2 : u.pm / 33;
        const int row0 = u.pm * 256 + wr * 64 + fr, col0 = u.pn * 256 + wc * 32 + 4 * fq;
#pragma unroll
        for (int bj = 0; bj < 2; ++bj)
#pragma unroll
            for (int n = 0; n < 2; ++n) {
                const int col = col0 + bj * 128 + n * 16; const float4 m2 = *(const float4*)(modv + ((size_t)l * 3 + sel) * 6144 + 2 * 1024 + col);
#pragma unroll
                for (int ai = 0; ai < 2; ++ai)
#pragma unroll
                    for (int m = 0; m < 4; ++m) {
                        float4* hp = (float4*)(H + (size_t)(row0 + ai * 128 + m * 16) * D + col); float4 hv = *hp; const pg8::f32x4 v = acc[ai][bj][m][n];
                        hv.x += m2.x * v[0]; hv.y += m2.y * v[1]; hv.z += m2.z * v[2]; hv.w += m2.w * v[3]; *hp = hv;
                    }
            }
    }
};
struct LatOrder {
    int G, c;
    DI bool next(int i, pg8::Unit& u) const { const int L = i * G + c; if (L >= 256) return false; const int pl = L >> 2; u.pm = (pl >> 5) * 33 + 1 + (pl & 31); u.pn = L & 3; return true; }
    DI void a_ready(const pg8::Unit&) const {}
    DI void done(const pg8::Unit&) const {}
};
DI void phase_merge2(const Ctx& c, int l) {
    EpiMerge2 E; E.H = (float*)(c.ws + WS_H); E.modv = (const float*)(c.ws + WS_WSM + OFF_MODV); E.l = l;
    pg8::Gemm g{(const bf16_t*)(c.ws + WS_BUFB), (const bf16_t*)(c.ws + WS_WSM + OFF_WOUTT + l * SZ_WOUTT), NZ, 1024, 1024, 1024, 1024};
    __syncthreads();
    if (l == NL - 1) {
        LatOrder S; S.G = (int)gridDim.x; S.c = (int)blockIdx.x;
        pg8::gemm_phase<EpiMerge2, LatOrder, false>((PG8_LAS unsigned char*)c.smem, g, S, E, nullptr, c.tid);
    } else {
        pg8::StaticOrder S; S.init(NZ, 1024, (int)gridDim.x, (int)blockIdx.x);
        pg8::gemm_phase<EpiMerge2, pg8::StaticOrder, false>((PG8_LAS unsigned char*)c.smem, g, S, E, nullptr, c.tid);
    }
}

constexpr int RT_PITCH = 68;
constexpr int RT_RED_W = 8 * 4 * RT_PITCH;
DI void phase_norm2_route(const Ctx& c, int l) {
    unsigned char* ws = c.ws; const int lane = c.lane, wave = c.wave, tid = c.tid;
    const float* modv = (const float*)(ws + WS_WSM + OFF_MODV); const float* H = (const float*)(ws + WS_H);
    bf16_t* XN = (bf16_t*)(ws + WS_BUFA); const float* g2 = c.in[7] + l * 1024;
    const float* rwt = (const float*)(ws + WS_WSM + OFF_RWT) + (size_t)l * 36 * 1024;
    const float* bg = c.in[42] + l * 4; const float* be = c.in[44] + l * 32;
    unsigned* cnt = (unsigned*)(ws + WS_CTL) + CW_CNT + l * 32;
    int* list = (int*)(ws + WS_GT + GT_LIST); float* lw = (float*)(ws + WS_GT + GT_LW);
    float* red = (float*)c.smem + wave * RT_RED_W;
    float* lgs = (float*)c.smem + 8 * RT_RED_W + wave * 8 * 40;
    int* hist = (int*)((float*)c.smem + 8 * RT_RED_W + 8 * 8 * 40);
    int* sel = hist + 64;
    float* selw = (float*)(sel + 128);
    const int ngroups = (l == NL - 1) ? (NB * SEQ / 64) : (NZ / 64);
    for (int grp = blockIdx.x; grp < ngroups; grp += gridDim.x) {
        __syncthreads();
        if (tid < 32) hist[tid] = 0;
        __syncthreads();
        float x[8][16];
#pragma unroll
        for (int i = 0; i < 8; ++i) {
            const int rl = wave * 8 + i; int row;
            if (l == NL - 1) { const int rr = grp * 64 + rl; row = (rr / SEQ) * TZ + CTX + (rr % SEQ); } else row = grp * 64 + rl;
#pragma unroll
            for (int q = 0; q < 4; ++q) { const float4 v = *(const float4*)(H + (size_t)row * D + q * 256 + lane * 4); x[i][q * 4] = v.x; x[i][q * 4 + 1] = v.y; x[i][q * 4 + 2] = v.z; x[i][q * 4 + 3] = v.w; }
        }
#pragma unroll
        for (int i = 0; i < 8; ++i) {
            const int rl = wave * 8 + i; int row;
            if (l == NL - 1) { const int rr = grp * 64 + rl; row = (rr / SEQ) * TZ + CTX + (rr % SEQ); } else row = grp * 64 + rl;
            const int b = row / TZ, s = row % TZ, sel3 = s < CTX ? 2 : b;
            float ss = 0.f;
#pragma unroll
            for (int j = 0; j < 16; ++j) ss += x[i][j] * x[i][j];
            ss = wave_sum(ss);
            const float rs = rsqrtf(ss * (1.f / 1024.f) + 1e-6f);
#pragma unroll
            for (int q = 0; q < 4; ++q) {
                const int col = q * 256 + lane * 4;
                const float4 g = *(const float4*)(g2 + col), m3 = *(const float4*)(modv + ((size_t)l * 3 + sel3) * 6144 + 3 * 1024 + col), m4 = *(const float4*)(modv + ((size_t)l * 3 + sel3) * 6144 + 4 * 1024 + col);
                x[i][q * 4] = x[i][q * 4] * rs * g.x * (1.f + m4.x) + m3.x; x[i][q * 4 + 1] = x[i][q * 4 + 1] * rs * g.y * (1.f + m4.y) + m3.y;
                x[i][q * 4 + 2] = x[i][q * 4 + 2] * rs * g.z * (1.f + m4.z) + m3.z; x[i][q * 4 + 3] = x[i][q * 4 + 3] * rs * g.w * (1.f + m4.w) + m3.w;
                *(u32x2*)(XN + (size_t)row * D + col) = pack4(x[i][q * 4], x[i][q * 4 + 1], x[i][q * 4 + 2], x[i][q * 4 + 3]);
            }
        }
#pragma unroll 1
        for (int ec = 0; ec < 9; ++ec) {
#pragma unroll
            for (int ee = 0; ee < 4; ++ee) {
                const int e = ec * 4 + ee;
                float4 w[4];
#pragma unroll
                for (int q = 0; q < 4; ++q) w[q] = *(const float4*)(rwt + (size_t)e * 1024 + q * 256 + lane * 4);
#pragma unroll
                for (int i = 0; i < 8; ++i) {
                    float a = 0.f;
#pragma unroll
                    for (int q = 0; q < 4; ++q) a += x[i][q * 4] * w[q].x + x[i][q * 4 + 1] * w[q].y + x[i][q * 4 + 2] * w[q].z + x[i][q * 4 + 3] * w[q].w;
                    red[(i * 4 + ee) * RT_PITCH + lane] = a;
                }
            }
            __builtin_amdgcn_wave_barrier();
            if (lane < 32) {
                float s0 = 0.f, s1 = 0.f, s2 = 0.f, s3 = 0.f;
#pragma unroll
                for (int q = 0; q < 16; ++q) { const float4 v = *(const float4*)(red + lane * RT_PITCH + q * 4); s0 += v.x; s1 += v.y; s2 += v.z; s3 += v.w; }
                const int e = ec * 4 + (lane & 3);
                lgs[(lane >> 2) * 40 + e] = (s0 + s1) + (s2 + s3) + (e < 4 ? bg[e] : be[e - 4]);
            }
            __builtin_amdgcn_wave_barrier();
        }
        if (lane < 8) {
            const float* lg = lgs + lane * 40;
            float gm = lg[0]; int gsel = 0;
#pragma unroll
            for (int g = 1; g < 4; ++g) if (lg[g] > gm) { gm = lg[g]; gsel = g; }
            const float gs = __expf(lg[0] - gm) + __expf(lg[1] - gm) + __expf(lg[2] - gm) + __expf(lg[3] - gm);
            const float pg = 1.f / gs;
            float l1 = -1e30f, l2 = -1e30f; int e1 = 0, e2 = 0;
#pragma unroll
            for (int j = 0; j < 8; ++j) {
                const float v = lg[4 + gsel * 8 + j]; const int e = gsel * 8 + j;
                if (v > l1) { l2 = l1; e2 = e1; l1 = v; e1 = e; } else if (v > l2) { l2 = v; e2 = e; }
            }
            const float tt = __expf(l2 - l1), w1 = pg / (1.f + tt), w2 = pg * tt / (1.f + tt);
            const int rl = wave * 8 + lane;
            const int r1 = atomicAdd(&hist[e1], 1), r2 = atomicAdd(&hist[e2], 1);
            sel[rl * 2] = e1 | (r1 << 8); sel[rl * 2 + 1] = e2 | (r2 << 8); selw[rl * 2] = w1; selw[rl * 2 + 1] = w2;
        }
        __syncthreads();
        if (tid < 32) hist[32 + tid] = (int)atomicAdd(&cnt[tid], (unsigned)hist[tid]);
        __syncthreads();
        if (tid < 128) {
            const int rl = tid >> 1, j = tid & 1, sv = sel[tid], e = sv & 255, rk = sv >> 8;
            int row;
            if (l == NL - 1) { const int rr = grp * 64 + rl; row = (rr / SEQ) * TZ + CTX + (rr % SEQ); } else row = grp * 64 + rl;
            const size_t pos = (size_t)e * MOE_CAP + hist[32 + e] + rk;
            list[pos] = row * 2 + j; lw[pos] = selw[tid];
        }
    }
    phase_expert_convert(c, l);
}

DI void moe_prefix(const Ctx& c, int l, int* tiles  , int* cnts  ) {
    __syncthreads();
    if (c.tid == 0) {
        const unsigned* cnt = (const unsigned*)(c.ws + WS_CTL) + CW_CNT + l * 32; int acc = 0;
        for (int e = 0; e < 32; ++e) { const int n = (int)__hip_atomic_load(cnt + e, __ATOMIC_RELAXED, __HIP_MEMORY_SCOPE_AGENT); cnts[e] = n; tiles[e] = acc; acc += (n + 127) / 128; }
        tiles[32] = acc;
    }
    __syncthreads();
}
DI void phase_moe1(const Ctx& c, int l) {
    unsigned char* ws = c.ws;
    int* tiles = (int*)(c.smem + 120 * 1024); int* cnts = tiles + 40;
    moe_prefix(c, l, tiles, cnts);
    const bf16_t* XN = (const bf16_t*)(ws + WS_BUFA); bf16_t* HM = (bf16_t*)(ws + WS_GT + GT_HM); const int* list = (const int*)(ws + WS_GT + GT_LIST);
    const int nt_total = tiles[32];
    for (int u = blockIdx.x; u < nt_total * 4; u += gridDim.x) {
        const int mtg = u >> 2, nt = u & 3;
        int e = 0;
        for (int k = 1; k < 32; ++k) if (tiles[k] <= mtg) e = k;
        const int mt = mtg - tiles[e], n_e = cnts[e];
        const int* le = list + (size_t)e * MOE_CAP;
        const bf16_t* W = (const bf16_t*)(ws + WS_EXPW + (size_t)e * SZ_WGU);
        gemm_tile<2, 0>(c, 1024,
            [&](int i) { int p = mt * 128 + i; if (p >= n_e) p = n_e - 1; return XN + (size_t)(le[p] >> 1) * D; },
            [&](int i) { return W + (size_t)(nt * 256 + i) * D; }, NoHook(),
            [&](f32x4 (&acc)[4][4], int wr, int wc, int fr, int fq) {
#pragma unroll
                for (int np = 0; np < 2; ++np) {
                    const int hc = (nt * 256 + wc + np * 32) / 2 + fq * 4;
#pragma unroll
                    for (int m = 0; m < 4; ++m) {
                        const int p = mt * 128 + wr + m * 16 + fr;
                        const f32x4 g = acc[m][np * 2], uu = acc[m][np * 2 + 1];
                        *(u32x2*)(HM + ((size_t)mtg * 128 + wr + m * 16 + fr) * 512 + hc) = pack4(siluf_(g[0]) * uu[0], siluf_(g[1]) * uu[1], siluf_(g[2]) * uu[2], siluf_(g[3]) * uu[3]);
                        (void)p;
                    }
                }
            });
    }
}
DI void phase_moe2(const Ctx& c, int l) {
    unsigned char* ws = c.ws;
    int* tiles = (int*)(c.smem + 120 * 1024); int* cnts = tiles + 40;
    moe_prefix(c, l, tiles, cnts);
    const bf16_t* HM = (const bf16_t*)(ws + WS_GT + GT_HM); const int* list = (const int*)(ws + WS_GT + GT_LIST); const float* lw = (const float*)(ws + WS_GT + GT_LW);
    bf16_t* Y2 = (bf16_t*)(ws + WS_P);
    const int nt_total = tiles[32];
    for (int u = blockIdx.x; u < nt_total * 4; u += gridDim.x) {
        const int mtg = u >> 2, nt = u & 3;
        int e = 0;
        for (int k = 1; k < 32; ++k) if (tiles[k] <= mtg) e = k;
        const int mt = mtg - tiles[e], n_e = cnts[e];
        const int* le = list + (size_t)e * MOE_CAP; const float* lwe = lw + (size_t)e * MOE_CAP;
        const bf16_t* W = (const bf16_t*)(ws + WS_EXPW + 32 * SZ_WGU + (size_t)e * SZ_WD);
        gemm_tile<2, 0>(c, 512,
            [&](int i) { return HM + ((size_t)mtg * 128 + i) * 512; },
            [&](int i) { return W + (size_t)(nt * 256 + i) * 512; }, NoHook(),
            [&](f32x4 (&acc)[4][4], int wr, int wc, int fr, int fq) {
#pragma unroll
                for (int m = 0; m < 4; ++m) {
                    const int p = mt * 128 + wr + m * 16 + fr;
                    if (p < n_e) {
                        const int ent = le[p]; const float wt = lwe[p];
                        bf16_t* yrow = Y2 + ((size_t)(ent & 1) * NZ + (ent >> 1)) * D + nt * 256 + wc + fq * 4;
#pragma unroll
                        for (int n = 0; n < 4; ++n) *(u32x2*)(yrow + n * 16) = pack4(wt * acc[m][n][0], wt * acc[m][n][1], wt * acc[m][n][2], wt * acc[m][n][3]);
                    }
                }
            });
    }
}

constexpr int LDS_BYTES = 128 * 1024 + 256;
constexpr int STEPS_PER_LAYER = 12, N_STEPS = 2 + NL * STEPS_PER_LAYER;
#ifndef FUSED
#define FUSED 1
#endif

DI const void* launder_ptr(const void* p) {
    const unsigned long long v = (unsigned long long)p;
    unsigned lo = __builtin_amdgcn_readfirstlane((unsigned)v), hi = __builtin_amdgcn_readfirstlane((unsigned)(v >> 32));
    asm volatile("" : "+s"(lo), "+s"(hi) :: "memory");
    return (const void*)(((unsigned long long)hi << 32) | lo);
}
template <int KIND> DI void run_step(const Ctx& c0, int l) {
#ifdef PHM
    if (!((PHM >> KIND) & 1)) return;
#endif
    Ctx c = c0;
    { int z = 0; asm volatile("" : "+s"(z) :: "memory"); c.in = c0.in + z; c.ws = c0.ws + z; c.out = c0.out + z; }
    { int t = c0.tid; asm volatile("" : "+v"(t)); c.tid = t; c.lane = t & 63; c.wave = __builtin_amdgcn_readfirstlane(t >> 6); }
    if (KIND == 0) phase_prologue(c);
    if (KIND == 1) phase_norm1(c, l);
    if (KIND == 2) phase_inproj(c, l);
    if (KIND == 3) { phase_prep(c, l); for (int u = blockIdx.x; u < 2 * S5N * 4; u += gridDim.x) phase_s5_final_unit<true>(c, l, u); }
    if (KIND == 4) { phase_small_gemms(c, l); phase_s5_carry(c, l); }
    if (KIND == 5) { phase_attention(c, l); phase_rwkv_chunks(c, l); }
    if (KIND == 6) phase_mixers2(c, l);
    if (KIND == 7) phase_post(c, l);
    if (KIND == 8) phase_merge1(c, l);
    if (KIND == 9) phase_merge2(c, l);
    if (KIND == 10) phase_norm2_route(c, l);
    if (KIND == 11) phase_moe1(c, l);
    if (KIND == 12) phase_moe2(c, l);
    if (KIND == 13) phase_final(c);
}

#if !FUSED
template <int KIND> __global__ void __launch_bounds__(NTHR, 2) k_step(Args a) {
    extern __shared__ __attribute__((aligned(16))) unsigned char lds[];
    Ctx c; c.in = a.in; c.out = a.out; c.ws = a.ws; c.smem = lds; c.tid = threadIdx.x; c.lane = threadIdx.x & 63; c.wave = __builtin_amdgcn_readfirstlane(threadIdx.x >> 6);
    run_step<KIND>(c, a.s_lo);
}
template <int KIND> static void launch_step(const Args& a, int grid, hipStream_t stream) {
    static bool attr = false;
    if (!attr) { (void)hipFuncSetAttribute((const void*)k_step<KIND>, hipFuncAttributeMaxDynamicSharedMemorySize, LDS_BYTES); attr = true; }
    hipLaunchKernelGGL(k_step<KIND>, dim3(grid), dim3(NTHR), LDS_BYTES, stream, a);
}
#else
__global__ void __launch_bounds__(NTHR, 2) fwd_kernel(Args a) {
    extern __shared__ __attribute__((aligned(16))) unsigned char lds[];
    Ctx c; c.in = a.in; c.out = a.out; c.ws = a.ws; c.smem = lds; c.tid = threadIdx.x; c.lane = threadIdx.x & 63; c.wave = __builtin_amdgcn_readfirstlane(threadIdx.x >> 6);
    volatile LAS unsigned* xbw = (volatile LAS unsigned*)(lds + LDS_BYTES - 16);
    for (int i = threadIdx.x; i < LDS_BYTES / 16; i += NTHR) ((uint4*)lds)[i] = make_uint4(0u, 0u, 0u, 0u);
    __syncthreads();
    if (threadIdx.x == 0) { xbw[0] = 0u; xbw[1] = 0u; }
    __syncthreads();
    XcdBarrier bar = xcd_barrier_post((unsigned*)(a.ws + WS_CTL) + CW_BAR, xbw);
#ifndef REP_MASK
#define REP_MASK 0
#endif
#define GBAR() do { XcdBarrier bb = bar; int zz = 0; asm volatile("" : "+s"(zz) :: "memory"); bb.bar = bar.bar + zz; xcd_barrier(bb); } while (0)
#define STEP(K, L) do { run_step<K>(c, L); GBAR(); if ((REP_MASK >> K) & 1) { run_step<K>(c, L); GBAR(); } } while (0)
    STEP(0, 0);
    for (int l = 0; l < NL; ++l) {
        STEP(1, l); STEP(2, l); STEP(3, l); STEP(4, l); STEP(5, l); STEP(6, l); STEP(7, l); STEP(8, l); STEP(9, l); STEP(10, l); STEP(11, l); STEP(12, l);
    }
#undef STEP
    run_step<13>(c, 0);
}
#endif

extern "C" void kernel_launch(void* const* d_in, const int* in_sizes, int n_in, void* d_out, int out_size, void* d_ws, size_t ws_size, hipStream_t stream) {
    static int grid = 0;
    if (grid == 0) {
        if (n_in != 49 || out_size != NB * SEQ * D || ws_size < WS_END) { fprintf(stderr, "kernel_launch: unexpected problem (n_in %d out %d ws %zu need %zu)\n", n_in, out_size, ws_size, (size_t)WS_END); grid = -1; return; }
        int dev = 0, cus = 0;
        if (hipGetDevice(&dev) != hipSuccess || hipDeviceGetAttribute(&cus, hipDeviceAttributeMultiprocessorCount, dev) != hipSuccess) { grid = -1; return; }
#if FUSED
        int per_cu = 0;
        if (hipFuncSetAttribute((const void*)fwd_kernel, hipFuncAttributeMaxDynamicSharedMemorySize, LDS_BYTES) != hipSuccess) { fprintf(stderr, "kernel_launch: hipFuncSetAttribute failed\n"); grid = -1; return; }
        if (hipOccupancyMaxActiveBlocksPerMultiprocessor(&per_cu, (const void*)fwd_kernel, NTHR, LDS_BYTES) != hipSuccess || per_cu < 1) { fprintf(stderr, "kernel_launch: occupancy query says %d\n", per_cu); }
        (void)hipGetLastError();
#endif
        grid = cus;
    }
    if (grid < 0) return;
    (void)hipMemsetAsync((char*)d_ws + WS_CTL, 0, CTL_BYTES, stream);
    Args a{};
    for (int i = 0; i < 49; ++i) a.in[i] = (const float*)d_in[i];
    a.out = (float*)d_out; a.ws = (unsigned char*)d_ws;
#if !FUSED
    a.s_lo = 0; a.s_hi = 0; launch_step<0>(a, grid, stream);
    for (int l = 0; l < NL; ++l) {
        a.s_lo = l;
        launch_step<1>(a, grid, stream); launch_step<2>(a, grid, stream); launch_step<3>(a, grid, stream); launch_step<4>(a, grid, stream);
        launch_step<5>(a, grid, stream); launch_step<6>(a, grid, stream); launch_step<7>(a, grid, stream); launch_step<8>(a, grid, stream);
        launch_step<9>(a, grid, stream); launch_step<10>(a, grid, stream); launch_step<11>(a, grid, stream); launch_step<12>(a, grid, stream);
    }
    a.s_lo = 0; launch_step<13>(a, grid, stream);
#else
    a.s_lo = 0; a.s_hi = N_STEPS; hipLaunchKernelGGL(fwd_kernel, dim3(grid), dim3(NTHR), LDS_BYTES, stream, a);
#endif
}
```

```cpp
#include <hip/hip_runtime.h>
#include <stdint.h>
#include <stdio.h>

#define DI __device__ __forceinline__
#define LAS __attribute__((address_space(3)))
typedef unsigned short bf16_t;
typedef short bf16x8 __attribute__((ext_vector_type(8)));
typedef short s16x4 __attribute__((ext_vector_type(4)));
typedef float f32x4 __attribute__((ext_vector_type(4)));
typedef float f32x16 __attribute__((ext_vector_type(16)));
typedef float f32x2 __attribute__((ext_vector_type(2)));
typedef __bf16 bf16x2v __attribute__((ext_vector_type(2)));
typedef unsigned u32x4 __attribute__((ext_vector_type(4)));
typedef unsigned u32x2 __attribute__((ext_vector_type(2)));

constexpr int D = 1024, NB = 2, SEQ = 8192, CTX = 256, TZ = 8448, NZ = 16896, NL = 2;
constexpr int NIN = 6560, NINP = 6656;
constexpr int NTHR = 512;
constexpr float LOG2E = 1.4426950408889634f;

#define XB_TMO      128
#define XB_XCNT(j)  (256  + 64 * (j))
#define XB_XSUB(j)  (1280 + 64 * (j))
#define XB_XGEN(j)  (2304 + 64 * (j))
#define XB_TOP      3328
#define XB_TOPGEN   3392
#define XCD_BAR_WORDS 3456
#define XB_SPIN_CAP (1u << 18)

__device__ __forceinline__ unsigned xb_ld(unsigned* p)              { return __hip_atomic_load(p, __ATOMIC_RELAXED, __HIP_MEMORY_SCOPE_AGENT); }
__device__ __forceinline__ unsigned xb_add(unsigned* p, unsigned v) { return __hip_atomic_fetch_add(p, v, __ATOMIC_RELAXED, __HIP_MEMORY_SCOPE_AGENT); }
__device__ __forceinline__ unsigned xb_xcc_id() { return (unsigned)__builtin_amdgcn_s_getreg((3 << 11) | 20) & 0xFu; }
#define XB_SPIN(cond, bar) do { unsigned _sp = 0; while (cond) { __builtin_amdgcn_s_sleep(1); \
    if ((++_sp & 255u) == 0u) { if (xb_ld(&(bar)[XB_TMO])) break; if (_sp > XB_SPIN_CAP) { atomicAdd(&(bar)[XB_TMO], 1u); break; } } } } while (0)

struct XcdBarrier { unsigned* bar; unsigned x; volatile LAS unsigned* st; };

__device__ __forceinline__ XcdBarrier xcd_barrier_post(unsigned* bar, volatile LAS unsigned* st) {
    XcdBarrier b; b.bar = bar; b.x = xb_xcc_id(); b.st = st;
    if (threadIdx.x == 0) (void)xb_add(&bar[XB_XCNT(b.x)], 1u);
    return b;
}
__device__ __forceinline__ void xcd_barrier_complete(unsigned* bar, unsigned x, unsigned& nloc, unsigned& nx) {
    const unsigned G = gridDim.x * gridDim.y * gridDim.z;
    unsigned sum, cnt, mine, sp = 0u;
    for (;;) {
        sum = 0u; cnt = 0u; mine = 0u;
#pragma unroll
        for (unsigned j = 0; j < 16; ++j) { const unsigned c = xb_ld(&bar[XB_XCNT(j)]); sum += c; cnt += (c > 0u) ? 1u : 0u; mine = (j == x) ? c : mine; }
        if (sum == G) break;
        __builtin_amdgcn_s_sleep(1);
        if ((++sp & 255u) == 0u) { if (xb_ld(&bar[XB_TMO])) break; if (sp > XB_SPIN_CAP) { atomicAdd(&bar[XB_TMO], 1u); break; } }
    }
    nloc = mine > 0u ? mine : 1u; nx = cnt > 0u ? cnt : 1u;
}
__device__ __forceinline__ void xcd_barrier(const XcdBarrier& b) {
    asm volatile("s_waitcnt vmcnt(0)" ::: "memory");
    __syncthreads();
    if (threadIdx.x == 0) {
        unsigned* bar = b.bar;
        __builtin_amdgcn_s_waitcnt(0);
        unsigned nloc = b.st[0], nx = b.st[1];
        if (nloc == 0u) { xcd_barrier_complete(bar, b.x, nloc, nx); b.st[0] = nloc; b.st[1] = nx; }
        const unsigned old = xb_add(&bar[XB_XSUB(b.x)], 1u);
        const unsigned gen = old / nloc;
        if (old + 1u == (gen + 1u) * nloc) {
            __builtin_amdgcn_fence(__ATOMIC_RELEASE, "agent");
            asm volatile("s_waitcnt vmcnt(0)" ::: "memory");
            const unsigned og = xb_add(&bar[XB_TOP], 1u);
            const unsigned tg = og / nx;
            if (og + 1u == (tg + 1u) * nx) xb_add(&bar[XB_TOPGEN], 1u);
            else XB_SPIN(xb_ld(&bar[XB_TOPGEN]) == tg, bar);
            __builtin_amdgcn_fence(__ATOMIC_ACQUIRE, "agent");
            xb_add(&bar[XB_XGEN(b.x)], 1u);
            asm volatile("s_waitcnt vmcnt(0)" ::: "memory");
        } else {
            XB_SPIN(xb_ld(&bar[XB_XGEN(b.x)]) == gen, bar);
            __builtin_amdgcn_fence(__ATOMIC_ACQUIRE, "agent");
            asm volatile("s_waitcnt vmcnt(0)" ::: "memory");
        }
    }
    __syncthreads();
}

DI float bf2f(bf16_t v) { return __uint_as_float((unsigned)v << 16); }
DI unsigned pack2(float a, float b) { f32x2 v = {a, b}; bf16x2v r = __builtin_convertvector(v, bf16x2v); return __builtin_bit_cast(unsigned, r); }
DI bf16_t f2bf(float a) { return (bf16_t)(pack2(a, 0.f) & 0xffffu); }
DI float lo2f(unsigned u) { return __uint_as_float(u << 16); }
DI float hi2f(unsigned u) { return __uint_as_float(u & 0xffff0000u); }
DI float wave_sum(float v) {
#pragma unroll
    for (int m = 32; m >= 1; m >>= 1) v += __shfl_xor(v, m, 64);
    return v;
}
DI float sum16(float v) {
#pragma unroll
    for (int m = 8; m >= 1; m >>= 1) v += __shfl_xor(v, m, 64);
    return v;
}
DI float sigmoidf_(float x) { return 1.f / (1.f + __expf(-x)); }
DI float siluf_(float x) { return x / (1.f + __expf(-x)); }
DI float gelu_tanh(float x) { const float u = 0.7978845608028654f * (x + 0.044715f * x * x * x); return 0.5f * x * (1.f + tanhf(u)); }
DI void unpack4(u32x2 u, float (&f)[4]) { f[0] = lo2f(u.x); f[1] = hi2f(u.x); f[2] = lo2f(u.y); f[3] = hi2f(u.y); }
DI u32x2 pack4(float a, float b, float c, float d) { u32x2 r; r.x = pack2(a, b); r.y = pack2(c, d); return r; }

constexpr size_t algn(size_t x) { return (x + 255) & ~(size_t)255; }
constexpr size_t WS_CTL   = 0;
constexpr size_t CTL_BYTES = 64 * 1024;
constexpr size_t WS_H     = WS_CTL + CTL_BYTES;
constexpr size_t WS_WSM   = WS_H + (size_t)NZ * D * 4;
constexpr size_t SZ_WINT = (size_t)NINP * D * 2, SZ_WUQT = 384 * 256 * 2, SZ_WUKVT = 512 * 128 * 2, SZ_W2T = 512 * 64 * 2, SZ_A2T = 512 * 64 * 2,
                 SZ_G2T = 256 * 128 * 2, SZ_GLUT = 256 * 256 * 2, SZ_WBT = (size_t)D * D * 2, SZ_WOUTT = (size_t)D * D * 2;
constexpr size_t OFF_WINT = 0, OFF_WUQT = OFF_WINT + NL * SZ_WINT, OFF_WUKVT = OFF_WUQT + NL * SZ_WUQT, OFF_W2T = OFF_WUKVT + NL * SZ_WUKVT,
                 OFF_A2T = OFF_W2T + NL * SZ_W2T, OFF_G2T = OFF_A2T + NL * SZ_A2T, OFF_GLUT = OFF_G2T + NL * SZ_G2T, OFF_WBT = OFF_GLUT + NL * SZ_GLUT,
                 OFF_WOUTT = OFF_WBT + NL * SZ_WBT, OFF_MODV = OFF_WOUTT + NL * SZ_WOUTT,
                 OFF_ROPE = OFF_MODV + (size_t)NL * 3 * 6144 * 4,
                 OFF_S5T = OFF_ROPE + (size_t)SEQ * 16 * 2 * 4,
                 OFF_RWT = OFF_S5T + (size_t)NL * 2 * 16 * 64 * 36 * 4,
                 OFF_LAM = OFF_RWT + (size_t)NL * 36 * 1024 * 4,
                 OFF_S5E = OFF_LAM + 256,
                 OFF_S5C = OFF_S5E,
                 WSM_BYTES = algn(OFF_S5E + (size_t)2 * 2 * 16 * 132 * 64 * 2 * 4);
constexpr size_t WS_EXPW  = WS_WSM + WSM_BYTES;
constexpr size_t SZ_WGU = (size_t)1024 * 1024 * 2, SZ_WD = (size_t)1024 * 512 * 2;
constexpr size_t EXPW_BYTES = 32 * (SZ_WGU + SZ_WD);
constexpr size_t SZ_QM = (size_t)NB * 4 * TZ * 96 * 2, SZ_VMT = (size_t)NB * 4 * 64 * TZ * 2, SZ_QD = (size_t)NB * 4 * TZ * 64 * 2, SZ_R256 = (size_t)NZ * 256 * 2;
constexpr size_t MX_QM = 0, MX_KM = MX_QM + SZ_QM, MX_VMT = MX_KM + SZ_QM, MX_QD = MX_VMT + SZ_VMT, MX_KD = MX_QD + SZ_QD, MX_VDT = MX_KD + SZ_QD,
                 MX_RB = MX_VDT + SZ_VMT, MX_KB = MX_RB + SZ_R256, MX_VB = MX_KB + SZ_R256, MX_KKB = MX_VB + SZ_R256, MX_END = MX_KKB + SZ_R256;
static_assert(MX_END <= EXPW_BYTES, "mixer operands must fit the expert-weight region");
constexpr size_t WS_BUFA  = WS_EXPW + EXPW_BYTES;
constexpr size_t WS_BUFB  = WS_BUFA + (size_t)NZ * D * 2;
constexpr size_t WS_P     = WS_BUFB + (size_t)NZ * D * 2;
constexpr size_t P_PM = 0, P_PS = P_PM + (size_t)NZ * 416 * 2, P_PR = P_PS + (size_t)NZ * 256 * 2, P_PD = P_PR + (size_t)NZ * 1024 * 2, P_BYTES = P_PD + (size_t)NZ * 768 * 2;
static_assert((size_t)6 * SZ_R256 <= (size_t)NZ * (1024 + 768) * 2, "scan operands must fit PR|PD");
static_assert((size_t)2 * NZ * D * 2 <= P_BYTES, "the MoE outputs (2 x bf16 [NZ][D]) must fit the P region");
constexpr size_t WS_GT    = WS_P + P_BYTES;
constexpr size_t GT_BYTES = (size_t)NZ * 4096 * 2;
constexpr int MOE_CAP = 33792;
constexpr size_t GT_HM = 0, GT_LIST = GT_HM + (size_t)(33792 + 32 * 128) * 512 * 2, GT_LW = GT_LIST + (size_t)32 * MOE_CAP * 4, GT_END = GT_LW + (size_t)32 * MOE_CAP * 4;
static_assert(GT_END <= GT_BYTES, "MoE scratch must fit the gate region");
constexpr size_t WS_MISC  = WS_GT + GT_BYTES;
constexpr size_t MS_CQN = 0, MS_TW = MS_CQN + (size_t)NZ * 384 * 2, MS_AL = MS_TW + (size_t)NZ * 64 * 2, MS_SG = MS_AL + (size_t)NZ * 64 * 2,
                 MS_GG = MS_SG + (size_t)NZ * 128 * 2, MS_ZG = MS_GG + SZ_R256, MS_END = MS_ZG + SZ_R256;
constexpr size_t WS_RW    = WS_MISC + MS_END;
constexpr int RC = 64, RNC = TZ / RC;
constexpr size_t SZ_RWM = (size_t)16 * RNC * 4096 * 2;
constexpr size_t RW_M3 = 0, RW_M2 = SZ_RWM, RW_Z5 = 2 * SZ_RWM, RW_P63 = 3 * SZ_RWM, RW_END = RW_P63 + (size_t)16 * RNC * 64 * 4;
constexpr size_t WS_END   = WS_RW + RW_END;

constexpr int CW_BAR = 0;
constexpr int CW_CNT = 4096;

struct Args { const float* in[49]; float* out; unsigned char* ws; int s_lo, s_hi; };

struct Ctx {
    const float* const* in; float* out; unsigned char* ws; unsigned char* smem; int tid, lane, wave;
};

template <int WM> struct GCfg { static constexpr int WN = 8 / WM, BM = 64 * WM, BN = 64 * WN, ABYTES = BM * 128, BBYTES = BN * 128, STAGE = ABYTES + BBYTES; };

template <int WM, int SEGK, class ARow, class BRow, class Hook, class Epi>
DI void gemm_tile(const Ctx& c, int K, ARow arow, BRow brow, Hook hook, Epi epi) {
    typedef GCfg<WM> G;
    const int tid = c.tid, lane = c.lane, wave = c.wave;
    const int wm = wave / G::WN, wn = wave % G::WN, fr = lane & 15, fq = lane >> 4;
    unsigned char* smem = c.smem;
    constexpr int NA = G::BM / 64, NBq = G::BN / 64;
    const int r0 = tid >> 3, coff = ((tid & 7) ^ (r0 & 7)) * 8;
    auto stage = [&](int kt, int buf) {
        unsigned char* sa = smem + buf * G::STAGE; unsigned char* sb = sa + G::ABYTES;
#pragma unroll
        for (int i = 0; i < NA; ++i) __builtin_amdgcn_global_load_lds((const unsigned*)(arow(r0 + 64 * i) + coff + kt * 64), (unsigned*)(sa + (tid + i * NTHR) * 16), 16, 0, 0);
#pragma unroll
        for (int i = 0; i < NBq; ++i) __builtin_amdgcn_global_load_lds((const unsigned*)(brow(r0 + 64 * i) + coff + kt * 64), (unsigned*)(sb + (tid + i * NTHR) * 16), 16, 0, 0);
    };
    f32x4 acc[4][4];
#pragma unroll
    for (int m = 0; m < 4; ++m)
#pragma unroll
        for (int n = 0; n < 4; ++n) acc[m][n] = (f32x4){0.f, 0.f, 0.f, 0.f};
    const int T = K / 64;
    __syncthreads();
    stage(0, 0);
    for (int t = 0; t < T; ++t) {
        asm volatile("s_waitcnt vmcnt(0)" ::: "memory");
        __syncthreads();
        if (t + 1 < T) stage(t + 1, (t + 1) & 1);
        const unsigned char* sa = smem + (t & 1) * G::STAGE; const unsigned char* sb = sa + G::ABYTES;
#pragma unroll
        for (int ks = 0; ks < 2; ++ks) {
            bf16x8 af[4], bfr[4];
            const int sl = ((ks * 4 + fq) ^ (fr & 7)) * 16;
#pragma unroll
            for (int m = 0; m < 4; ++m) af[m] = *(const bf16x8*)(sa + (wm * 64 + m * 16 + fr) * 128 + sl);
#pragma unroll
            for (int n = 0; n < 4; ++n) bfr[n] = *(const bf16x8*)(sb + (wn * 64 + n * 16 + fr) * 128 + sl);
#pragma unroll
            for (int m = 0; m < 4; ++m)
#pragma unroll
                for (int n = 0; n < 4; ++n) acc[m][n] = __builtin_amdgcn_mfma_f32_16x16x32_bf16(bfr[n], af[m], acc[m][n], 0, 0, 0);
        }
        if (SEGK > 0) { if (((t + 1) * 64) % (SEGK > 0 ? SEGK : 64) == 0) hook(acc, ((t + 1) * 64) / (SEGK > 0 ? SEGK : 64) - 1, wm * 64, wn * 64, fr, fq); }
    }
    epi(acc, wm * 64, wn * 64, fr, fq);
}
struct NoHook { DI void operator()(f32x4 (&)[4][4], int, int, int, int, int) const {} };

namespace pg8 {
#define PG8_LAS __attribute__((address_space(3)))
typedef unsigned short bf16_t;
typedef short bf16x8 __attribute__((ext_vector_type(8)));
typedef float f32x4 __attribute__((ext_vector_type(4)));
constexpr int BM = 256, BK = 64, HALF = 128, HTB = HALF * BK * 2  , STAGE_BYTES = 8 * HTB, NXCD = 8, WGM = 8;

__host__ __device__ __forceinline__ int lds_byte(int r, int c) { const int st = (r >> 4) * 2 + (c >> 5), rr = r & 15, cc = c & 31, ob = rr * 64 + cc * 2; return st * 1024 + (ob ^ (((ob >> 9) & 1) << 5)); }
__host__ __device__ __forceinline__ void stage_rc(int b, int& R, int& C) { const int st = b / 1024, sb = b % 1024, swz = sb ^ (((sb >> 9) & 1) << 5); R = (st >> 1) * 16 + swz / 64; C = (st & 1) * 32 + (swz % 64) / 2; }
__host__ __device__ __forceinline__ int perm32(int rho) { const int n = rho >> 4, i = rho & 15; return 8 * (i >> 2) + 4 * n + (i & 3); }

struct Unit { int pm, pn; };
struct Gemm { const bf16_t* A; const bf16_t* Bt; int M, N, K, lda, ldb; };

struct StaticOrder {
    int nM, nN, nwg, G, c;
    __host__ __device__ void init(int M, int N, int G_, int c_) { nM = M / BM; nN = N / BM; nwg = nM * nN; G = G_; c = c_; }
    __host__ __device__ bool next(int i, Unit& u) const {
        const long L = (long)i * G + c; if (L >= nwg) return false;
        int wgid = (int)L; { const int q = nwg / NXCD, r = nwg % NXCD, xcd = wgid % NXCD, off = wgid / NXCD; wgid = (xcd < r ? xcd * (q + 1) : r * (q + 1) + (xcd - r) * q) + off; }
        const int nig = WGM * nN, gid = wgid / nig, fm = gid * WGM, gsz = (nM - fm) < WGM ? (nM - fm) : WGM;
        u.pm = fm + ((wgid % nig) % gsz); u.pn = (wgid % nig) / gsz; return true;
    }
    __device__ __forceinline__ void a_ready(const Unit&) const {}
    __device__ __forceinline__ void done(const Unit&) const {}
};
template <class Epi, class Sched, bool STAMP = false>
__device__ __forceinline__ void gemm_phase(PG8_LAS unsigned char* lds, const Gemm g, const Sched& S, const Epi& E, unsigned long long* stamps, int tid_in) {
    const int tid = tid_in, wid = __builtin_amdgcn_readfirstlane(tid >> 6), lane = tid & 63, wr = wid >> 2, wc = wid & 3, fr = lane & 15, fq = lane >> 4;
    const int K = g.K, nt = K / BK;
    int ts_lo = 0, ts_hi = 0, nts = 0; const unsigned long long rt_entry = STAMP ? (unsigned long long)wall_clock64() : 0ull;
#define PG8_STAMP() do { if (STAMP && wid == 0 && nts < 64) { const unsigned long long _c = (unsigned long long)clock64(); \
        ts_lo = (lane == nts) ? (int)(unsigned)_c : ts_lo; ts_hi = (lane == nts) ? (int)(unsigned)(_c >> 32) : ts_hi; ++nts; } } while (0)
    PG8_STAMP();
    unsigned voffA[2], voffB[2];
#pragma unroll
    for (int i = 0; i < 2; ++i) { int R, C; stage_rc(tid * 16 + i * 8192, R, C); const int Rb = Epi::PERM ? ((R & ~31) + perm32(R & 31)) : R;
        voffA[i] = (unsigned)(R * g.lda + C) * 2u; voffB[i] = (unsigned)(Rb * g.ldb + C) * 2u; }
    const size_t kstep = (size_t)(BK * 2);
    const size_t hstepA = (size_t)HALF * g.lda * 2, hstepB = (size_t)HALF * g.ldb * 2;
    const size_t tstepA = 2 * hstepA, tstepB = 2 * hstepB;
    const unsigned ldsw = (unsigned)wid * 1024u;
    const int aoff = lds_byte(wr * 64 + fr, fq * 8), boff = lds_byte(wc * 32 + fr, fq * 8);
#define PG8_SA(b, h) (((b) * 2 + (h)) * HTB)
#define PG8_SB(b, h) ((4 + (b) * 2 + (h)) * HTB)
#define PG8_STAGE(bufoff, gbase, voff) do { _Pragma("unroll") for (int _i = 0; _i < 2; ++_i) \
        __builtin_amdgcn_global_load_lds((const unsigned*)((const char*)(gbase) + (voff)[_i]), (PG8_LAS unsigned*)(lds + (bufoff) + ldsw + _i * 8192), 16, 0, 0); } while (0)
#define PG8_LDA(dst, b, h) do { _Pragma("unroll") for (int m = 0; m < 4; ++m) _Pragma("unroll") for (int k = 0; k < 2; ++k) dst[m][k] = *(const PG8_LAS bf16x8*)(lds + PG8_SA(b, h) + aoff + m * 2048 + k * 1024); } while (0)
#define PG8_LDB(dst, b, h) do { _Pragma("unroll") for (int n = 0; n < 2; ++n) _Pragma("unroll") for (int k = 0; k < 2; ++k) dst[n][k] = *(const PG8_LAS bf16x8*)(lds + PG8_SB(b, h) + boff + n * 2048 + k * 1024); } while (0)
#define PG8_MMA(ai, bj, At, Bt) do { __builtin_amdgcn_s_setprio(1); _Pragma("unroll") for (int m = 0; m < 4; ++m) _Pragma("unroll") for (int n = 0; n < 2; ++n) _Pragma("unroll") for (int k = 0; k < 2; ++k) \
        acc[ai][bj][m][n] = __builtin_amdgcn_mfma_f32_16x16x32_bf16(Bt[n][k], At[m][k], acc[ai][bj][m][n], 0, 0, 0); __builtin_amdgcn_s_setprio(0); } while (0)
#define PG8_WAIT_V(n) asm volatile("s_waitcnt vmcnt(" #n ")" ::: "memory")
#define PG8_WAIT_L(n) asm volatile("s_waitcnt lgkmcnt(" #n ")" ::: "memory")
#define PG8_BAR __builtin_amdgcn_s_barrier()
#define PG8_SCHED __builtin_amdgcn_sched_barrier(0)
    Unit cur, nxt; int ui = 0;
    if (!S.next(0, cur)) return;
    f32x4 acc[2][2][4][2];
#pragma unroll
    for (int a = 0; a < 2; ++a)
#pragma unroll
        for (int b = 0; b < 2; ++b)
#pragma unroll
            for (int m = 0; m < 4; ++m)
#pragma unroll
                for (int n = 0; n < 2; ++n) acc[a][b][m][n] = (f32x4){0.f, 0.f, 0.f, 0.f};
    bf16x8 At[4][2], B0[2][2], B1[2][2];
    const char* cA = (const char*)g.A + (size_t)cur.pm * tstepA; const char* cB = (const char*)g.Bt + (size_t)cur.pn * tstepB;
    S.a_ready(cur);
    PG8_STAGE(PG8_SB(0, 0), cB, voffB); PG8_STAGE(PG8_SA(0, 0), cA, voffA); PG8_STAGE(PG8_SB(0, 1), cB + hstepB, voffB); PG8_STAGE(PG8_SA(0, 1), cA + hstepA, voffA);
    if (wr == 1) PG8_BAR;
    PG8_WAIT_V(4); PG8_BAR;
    PG8_STAGE(PG8_SB(1, 0), cB + kstep, voffB); PG8_STAGE(PG8_SA(1, 0), cA + kstep, voffA); PG8_STAGE(PG8_SB(1, 1), cB + hstepB + kstep, voffB);
    PG8_WAIT_V(6); PG8_BAR;
    PG8_STAMP();
    for (;;) {
        const bool has_next = S.next(ui + 1, nxt);
        const char* nA = has_next ? (const char*)g.A + (size_t)nxt.pm * tstepA : cA; const char* nB = has_next ? (const char*)g.Bt + (size_t)nxt.pn * tstepB : cB;
        for (int t = 0; t < nt; t += 2) {
            const bool last = (t == nt - 2);
            const char* a1 = cA + (size_t)(t + 1) * kstep;
            const char* a2 = last ? nA : cA + (size_t)(t + 2) * kstep; const char* b2 = last ? nB : cB + (size_t)(t + 2) * kstep;
            const char* a3 = a2 + kstep; const char* b3 = b2 + kstep;
            if (last && has_next) S.a_ready(nxt);
            PG8_LDB(B0, 0, 0); PG8_SCHED; PG8_LDA(At, 0, 0); PG8_STAGE(PG8_SA(1, 1), a1 + hstepA, voffA);
            PG8_WAIT_L(8); PG8_BAR; PG8_WAIT_L(0); PG8_MMA(0, 0, At, B0); PG8_BAR; PG8_SCHED;
            PG8_LDB(B1, 0, 1); PG8_STAGE(PG8_SB(0, 0), b2, voffB);
            PG8_BAR; PG8_WAIT_L(0); PG8_MMA(0, 1, At, B1); PG8_BAR;
            PG8_LDA(At, 0, 1); PG8_STAGE(PG8_SA(0, 0), a2, voffA);
            PG8_BAR; PG8_WAIT_L(0); PG8_MMA(1, 0, At, B0); PG8_BAR; PG8_SCHED;
            PG8_STAGE(PG8_SB(0, 1), b2 + hstepB, voffB);
            PG8_WAIT_V(6); PG8_BAR; PG8_MMA(1, 1, At, B1); PG8_BAR;
            PG8_LDB(B0, 1, 0); PG8_SCHED; PG8_LDA(At, 1, 0); PG8_STAGE(PG8_SA(0, 1), a2 + hstepA, voffA);
            PG8_WAIT_L(8); PG8_BAR; PG8_WAIT_L(0); PG8_MMA(0, 0, At, B0); PG8_BAR; PG8_SCHED;
            PG8_LDB(B1, 1, 1); PG8_STAGE(PG8_SB(1, 0), b3, voffB);
            PG8_BAR; PG8_WAIT_L(0); PG8_MMA(0, 1, At, B1); PG8_BAR;
            PG8_LDA(At, 1, 1); PG8_STAGE(PG8_SA(1, 0), a3, voffA);
            PG8_BAR; PG8_WAIT_L(0); PG8_MMA(1, 0, At, B0); PG8_BAR; PG8_SCHED;
            PG8_STAGE(PG8_SB(1, 1), b3 + hstepB, voffB);
            PG8_WAIT_V(6); PG8_BAR; PG8_MMA(1, 1, At, B1); PG8_BAR;
        }
        PG8_STAMP();
        if constexpr (!Epi::AFTER_DRAIN) { E(acc, cur, wr, wc, fr, fq); S.done(cur); }
        PG8_STAMP();
        if (!has_next) break;
#pragma unroll
        for (int a = 0; a < 2; ++a)
#pragma unroll
            for (int b = 0; b < 2; ++b)
#pragma unroll
                for (int m = 0; m < 4; ++m)
#pragma unroll
                    for (int n = 0; n < 2; ++n) acc[a][b][m][n] = (f32x4){0.f, 0.f, 0.f, 0.f};
        cur = nxt; cA = nA; cB = nB; ++ui;
    }
    PG8_WAIT_V(0);
    if (wr == 0) PG8_BAR;
    PG8_BAR;
    if constexpr (Epi::AFTER_DRAIN) { E.fused(acc, cur, wr, wc, fr, fq, lds, wid, lane); S.done(cur); }
    PG8_STAMP();
    if (STAMP && wid == 0) { stamps[lane] = lane < nts ? (((unsigned long long)(unsigned)ts_hi << 32) | (unsigned)ts_lo) : 0ull;
        if (lane == 62) stamps[62] = rt_entry; if (lane == 63) stamps[63] = (unsigned long long)wall_clock64(); }
#undef PG8_STAMP
#undef PG8_SA
#undef PG8_SB
#undef PG8_STAGE
#undef PG8_LDA
#undef PG8_LDB
#undef PG8_MMA
#undef PG8_WAIT_V
#undef PG8_WAIT_L
#undef PG8_BAR
#undef PG8_SCHED
}
}

DI int rowmap(int n, int mode) { return mode == 0 ? n : ((n >> 4) * 32 + (n & 15) + (mode == 2 ? 16 : 0)); }
DI void tconv_tile(const Ctx& c, const float* src, int ld, int N, bf16_t* dst, int ld_dst, int mode, int tk, int tn) {
    bf16_t* T = (bf16_t*)c.smem;
    const int k0 = tk * 64, n0 = tn * 64, tid = c.tid;
    __syncthreads();
#pragma unroll
    for (int i = 0; i < 2; ++i) {
        const int kk = (tid >> 4) + i * 32, n4 = (tid & 15) * 4;
        float4 v = make_float4(0.f, 0.f, 0.f, 0.f);
        if (n0 + n4 < N) v = *(const float4*)(src + (size_t)(k0 + kk) * ld + n0 + n4);
        T[(n4 + 0) * 72 + kk] = f2bf(v.x); T[(n4 + 1) * 72 + kk] = f2bf(v.y); T[(n4 + 2) * 72 + kk] = f2bf(v.z); T[(n4 + 3) * 72 + kk] = f2bf(v.w);
    }
    __syncthreads();
    const int n = tid >> 3, k8 = (tid & 7) * 8;
    if (n0 + n < N) *(u32x4*)(dst + (size_t)rowmap(n0 + n, mode) * ld_dst + k0 + k8) = *(const u32x4*)(T + n * 72 + k8);
}
DI void tconv(const Ctx& c, const float* src, int ld, int K, int N, bf16_t* dst, int ld_dst, int mode, int rot) {
    const int ntk = K / 64, ntn = (N + 63) / 64, nt = ntk * ntn, G = gridDim.x;
    for (int t = (blockIdx.x + G - (rot % G)) % G; t < nt; t += G) tconv_tile(c, src, ld, N, dst, ld_dst, mode, t / ntn, t % ntn);
}

DI void wconv(const Ctx& c, const float* src, int ld, int K, int N, bf16_t* dst, int ld_dst, int rot) {
    const int ntk = K / 64, ntn = (N + 63) / 64, nt = ntk * ntn, GW = gridDim.x * 8, w0 = blockIdx.x * 8 + c.wave;
    for (int t = (w0 + GW - (rot % GW)) % GW; t < nt; t += GW) {
        const int tk = t / ntn, tn = t % ntn, n = tn * 64 + c.lane;
        if (n < N) {
            const float* sp = src + (size_t)(tk * 64) * ld + n; bf16_t* dp = dst + (size_t)n * ld_dst + tk * 64;
#pragma unroll
            for (int kb = 0; kb < 8; ++kb) {
                float v[8];
#pragma unroll
                for (int j = 0; j < 8; ++j) v[j] = sp[(size_t)(kb * 8 + j) * ld];
                u32x4 w4; w4.x = pack2(v[0], v[1]); w4.y = pack2(v[2], v[3]); w4.z = pack2(v[4], v[5]); w4.w = pack2(v[6], v[7]);
                *(u32x4*)(dp + kb * 8) = w4;
            }
        }
    }
}
DI void phase_prologue(const Ctx& c) {
    unsigned char* wsm = c.ws + WS_WSM;
    const int tid = c.tid, G = gridDim.x, gtid = blockIdx.x * NTHR + tid, gn = G * NTHR;
    {
        const float4* x = (const float4*)c.in[0]; const float4* cx = (const float4*)c.in[2]; float4* H = (float4*)(c.ws + WS_H);
        for (size_t i = gtid; i < (size_t)NZ * 256; i += gn) {
            const int z = (int)(i >> 8), q = (int)(i & 255), b = z / TZ, s = z % TZ;
            H[i] = (s < CTX) ? cx[((size_t)b * CTX + s) * 256 + q] : x[((size_t)b * SEQ + (s - CTX)) * 256 + q];
        }
    }
    {
        float* rope = (float*)(wsm + OFF_ROPE);
        for (int i = gtid; i < SEQ * 16; i += gn) {
            const int t = i >> 4, a = (i >> 3) & 1, f = i & 7;
            const float pos = (float)(a == 0 ? (t >> 6) : (t & 63));
            const float inv = powf(10000.f, -(float)f / 8.f);
            float sn, cs; sincosf(pos * inv, &sn, &cs);
            rope[i * 2] = cs; rope[i * 2 + 1] = sn;
        }
    }
    {
        float* s5t = (float*)(wsm + OFF_S5T);
        for (int i = gtid; i < NL * 2 * 16 * 64; i += gn) {
            const int ldg = i >> 6;
            const double lr = c.in[24][i], li = c.in[25][i], dt = exp((double)c.in[26][ldg]);
            const double mag = exp(lr * dt), are = mag * cos(li * dt), aim = mag * sin(li * dt);
            const double m256 = exp(lr * dt * 64.0), a256r = m256 * cos(li * dt * 64.0), a256i = m256 * sin(li * dt * 64.0);
            const double den = lr * lr + li * li, nr = are - 1.0, ni = aim;
            const double cfr = (nr * lr + ni * li) / den, cfi = (ni * lr - nr * li) / den;
            float* o = s5t + (size_t)i * 36;
            o[0] = (float)are; o[1] = (float)aim; o[2] = (float)a256r; o[3] = (float)a256i;
            for (int ch = 0; ch < 16; ++ch) {
                const double br = c.in[27][(size_t)i * 16 + ch], bi = c.in[28][(size_t)i * 16 + ch];
                o[4 + ch] = (float)(cfr * br - cfi * bi); o[20 + ch] = (float)(cfr * bi + cfi * br);
            }
        }
    }
    {
        float* rwt = (float*)(wsm + OFF_RWT);
        for (int i = gtid; i < NL * 36 * 1024; i += gn) {
            const int l = i / (36 * 1024), e = (i / 1024) % 36, d = i & 1023;
            rwt[i] = e < 4 ? c.in[41][((size_t)l * 1024 + d) * 4 + e] : c.in[43][((size_t)l * 1024 + d) * 32 + (e - 4)];
        }
    }
    if (blockIdx.x == 0 && tid < NL) {
        float s1 = 0.f, s2 = 0.f;
        for (int i = 0; i < 32; ++i) { s1 += c.in[34][tid * 32 + i] * c.in[35][tid * 32 + i]; s2 += c.in[36][tid * 32 + i] * c.in[37][tid * 32 + i]; }
        ((float*)(wsm + OFF_LAM))[tid] = expf(s1) - expf(s2) + (0.8f - 0.6f * expf(-0.3f * (float)tid));
    }
    {
        float* sv = (float*)c.smem;
        float* red = sv + 3 * 1024;
        __syncthreads();
        for (int i = tid; i < 3 * 1024; i += NTHR) { const float v = i < 2048 ? c.in[1][i] : c.in[3][i - 2048]; sv[i] = siluf_(v); }
        __syncthreads();
        float* modv = (float*)(wsm + OFF_MODV);
        for (int u = blockIdx.x; u < NL * 96; u += G) {
            const int l = u / 96, col = (u % 96) * 64 + (tid & 63), ks = tid >> 6;
            const float* w = c.in[4] + (size_t)l * 1024 * 6144 + col;
            float a0 = 0.f, a1 = 0.f, a2 = 0.f;
            for (int k = ks * 128; k < ks * 128 + 128; ++k) { const float wv = w[(size_t)k * 6144]; a0 += sv[k] * wv; a1 += sv[1024 + k] * wv; a2 += sv[2048 + k] * wv; }
            red[(ks * 64 + (tid & 63)) * 3 + 0] = a0; red[(ks * 64 + (tid & 63)) * 3 + 1] = a1; red[(ks * 64 + (tid & 63)) * 3 + 2] = a2;
            __syncthreads();
            if (tid < 192) {
                const int cc = tid & 63, sel = tid >> 6; float s = 0.f;
                for (int k2 = 0; k2 < 8; ++k2) s += red[(k2 * 64 + cc) * 3 + sel];
                const int colo = (u % 96) * 64 + cc;
                modv[((size_t)l * 3 + sel) * 6144 + colo] = s + c.in[5][l * 6144 + colo];
            }
            __syncthreads();
        }
    }
    for (int l = 0; l < NL; ++l) {
        wconv(c, c.in[8] + (size_t)l * 1024 * NIN, NIN, 1024, NIN, (bf16_t*)(wsm + OFF_WINT + l * SZ_WINT), 1024, l * 700);
        tconv(c, c.in[11] + (size_t)l * 256 * 384, 384, 256, 384, (bf16_t*)(wsm + OFF_WUQT + l * SZ_WUQT), 256, 0, 40);
        tconv(c, c.in[12] + (size_t)l * 128 * 512, 512, 128, 512, (bf16_t*)(wsm + OFF_WUKVT + l * SZ_WUKVT), 128, 0, 70);
        for (int d = 0; d < 2; ++d) {
            tconv(c, c.in[15] + (size_t)(l * 2 + d) * 64 * 256, 256, 64, 256, (bf16_t*)(wsm + OFF_W2T + l * SZ_W2T) + d * 256 * 64, 64, 0, 90 + d * 8);
            tconv(c, c.in[17] + (size_t)(l * 2 + d) * 64 * 256, 256, 64, 256, (bf16_t*)(wsm + OFF_A2T + l * SZ_A2T) + d * 256 * 64, 64, 0, 110 + d * 8);
        }
        tconv(c, c.in[18] + (size_t)l * 128 * 256, 256, 128, 256, (bf16_t*)(wsm + OFF_G2T + l * SZ_G2T), 128, 0, 130);
        tconv(c, c.in[32] + (size_t)l * 256 * 256, 256, 256, 256, (bf16_t*)(wsm + OFF_GLUT + l * SZ_GLUT), 256, 0, 140);
        for (int n = 0; n < 4; ++n)
            wconv(c, c.in[39] + (size_t)(l * 4 + n) * 256 * 1024, 1024, 256, 1024, (bf16_t*)(wsm + OFF_WBT + l * SZ_WBT) + n * 256, 1024, 300 + n * 64 + l * 1000);
        wconv(c, c.in[40] + (size_t)l * 1024 * 1024, 1024, 1024, 1024, (bf16_t*)(wsm + OFF_WOUTT + l * SZ_WOUTT), 1024, 1200 + l * 400);
    }
}

DI void phase_expert_convert(const Ctx& c, int l) {
    const int G = gridDim.x, lane = c.lane;
    for (int t = blockIdx.x * 8 + c.wave; t < 32 * 384; t += G * 8) {
        const int e = t / 384, r = t % 384;
        const float* src; bf16_t* dst; int ld, ldd, mode, tk, tn;
        if (r < 128)      { src = c.in[45] + ((size_t)l * 32 + e) * 1024 * 512; dst = (bf16_t*)(c.ws + WS_EXPW + (size_t)e * SZ_WGU); ld = 512; ldd = 1024; mode = 1; tk = r / 8; tn = r % 8; }
        else if (r < 256) { src = c.in[46] + ((size_t)l * 32 + e) * 1024 * 512; dst = (bf16_t*)(c.ws + WS_EXPW + (size_t)e * SZ_WGU); ld = 512; ldd = 1024; mode = 2; tk = (r - 128) / 8; tn = (r - 128) % 8; }
        else              { src = c.in[47] + ((size_t)l * 32 + e) * 512 * 1024; dst = (bf16_t*)(c.ws + WS_EXPW + 32 * SZ_WGU + (size_t)e * SZ_WD); ld = 1024; ldd = 512; mode = 0; tk = (r - 256) / 16; tn = (r - 256) % 16; }
        const int n = tn * 64 + lane; const float* sp = src + (size_t)(tk * 64) * ld + n; bf16_t* dp = dst + (size_t)rowmap(n, mode) * ldd + tk * 64;
#pragma unroll
        for (int kb = 0; kb < 8; ++kb) {
            float v[8];
#pragma unroll
            for (int j = 0; j < 8; ++j) v[j] = sp[(size_t)(kb * 8 + j) * ld];
            u32x4 w4; w4.x = pack2(v[0], v[1]); w4.y = pack2(v[2], v[3]); w4.z = pack2(v[4], v[5]); w4.w = pack2(v[6], v[7]);
            *(u32x4*)(dp + kb * 8) = w4;
        }
    }
}

DI void phase_norm1(const Ctx& c, int l) {
    const float* modv = (const float*)(c.ws + WS_WSM + OFF_MODV);
    float* H = (float*)(c.ws + WS_H); const bf16_t* Y = (const bf16_t*)(c.ws + WS_P);
    bf16_t* XN = (bf16_t*)(c.ws + WS_BUFA);
    const float* g1 = c.in[6] + l * 1024;
    for (int row = blockIdx.x * 8 + c.wave; row < NZ; row += gridDim.x * 8) {
        const int b = row / TZ, s = row % TZ, sel = s < CTX ? 2 : b;
        float4 v[4]; float ss = 0.f;
#pragma unroll
        for (int q = 0; q < 4; ++q) {
            const int col = q * 256 + c.lane * 4;
            v[q] = *(const float4*)(H + (size_t)row * D + col);
            if (l > 0) {
                float ya[4], yb[4]; unpack4(*(const u32x2*)(Y + (size_t)row * D + col), ya); unpack4(*(const u32x2*)(Y + ((size_t)NZ + row) * D + col), yb);
                const float4 m5 = *(const float4*)(modv + ((size_t)(l - 1) * 3 + sel) * 6144 + 5 * 1024 + col);
                v[q].x += m5.x * (ya[0] + yb[0]); v[q].y += m5.y * (ya[1] + yb[1]); v[q].z += m5.z * (ya[2] + yb[2]); v[q].w += m5.w * (ya[3] + yb[3]);
                *(float4*)(H + (size_t)row * D + col) = v[q];
            }
            ss += v[q].x * v[q].x + v[q].y * v[q].y + v[q].z * v[q].z + v[q].w * v[q].w;
        }
        ss = wave_sum(ss);
        const float rs = rsqrtf(ss * (1.f / 1024.f) + 1e-6f);
#pragma unroll
        for (int q = 0; q < 4; ++q) {
            const int col = q * 256 + c.lane * 4;
            const float4 g = *(const float4*)(g1 + col), m0 = *(const float4*)(modv + ((size_t)l * 3 + sel) * 6144 + col), m1 = *(const float4*)(modv + ((size_t)l * 3 + sel) * 6144 + 1024 + col);
            *(u32x2*)(XN + (size_t)row * D + col) = pack4(v[q].x * rs * g.x * (1.f + m1.x) + m0.x, v[q].y * rs * g.y * (1.f + m1.y) + m0.y,
                                                          v[q].z * rs * g.z * (1.f + m1.z) + m0.z, v[q].w * rs * g.w * (1.f + m1.w) + m0.w);
        }
    }
}

DI void phase_final(const Ctx& c) {
    const float* modv = (const float*)(c.ws + WS_WSM + OFF_MODV);
    const float* H = (const float*)(c.ws + WS_H); const bf16_t* Y = (const bf16_t*)(c.ws + WS_P);
    const float* g = c.in[48];
    for (int r = blockIdx.x * 8 + c.wave; r < NB * SEQ; r += gridDim.x * 8) {
        const int b = r / SEQ, t = r % SEQ, row = b * TZ + CTX + t;
        float4 v[4]; float ss = 0.f;
#pragma unroll
        for (int q = 0; q < 4; ++q) {
            const int col = q * 256 + c.lane * 4;
            v[q] = *(const float4*)(H + (size_t)row * D + col);
            float ya[4], yb[4]; unpack4(*(const u32x2*)(Y + (size_t)row * D + col), ya); unpack4(*(const u32x2*)(Y + ((size_t)NZ + row) * D + col), yb);
            const float4 m5 = *(const float4*)(modv + ((size_t)(NL - 1) * 3 + b) * 6144 + 5 * 1024 + col);
            v[q].x += m5.x * (ya[0] + yb[0]); v[q].y += m5.y * (ya[1] + yb[1]); v[q].z += m5.z * (ya[2] + yb[2]); v[q].w += m5.w * (ya[3] + yb[3]);
            ss += v[q].x * v[q].x + v[q].y * v[q].y + v[q].z * v[q].z + v[q].w * v[q].w;
        }
        ss = wave_sum(ss);
        const float rs = rsqrtf(ss * (1.f / 1024.f) + 1e-6f);
#pragma unroll
        for (int q = 0; q < 4; ++q) {
            const int col = q * 256 + c.lane * 4; const float4 gg = *(const float4*)(g + col);
            *(float4*)(c.out + (size_t)r * D + col) = make_float4(v[q].x * rs * gg.x, v[q].y * rs * gg.y, v[q].z * rs * gg.z, v[q].w * rs * gg.w);
        }
    }
}

struct EpiInproj {
    static constexpr bool PERM = true, AFTER_DRAIN = false;
    bf16_t *PM, *PS, *PR, *PD, *GT;
    DI void operator()(const pg8::f32x4 (&acc)[2][2][4][2], const pg8::Unit& u, int wr, int wc, int fr, int fq) const {
        const int row0 = u.pm * 256 + wr * 64 + fr, col0 = u.pn * 256 + wc * 32 + 8 * fq;
#pragma unroll
        for (int bj = 0; bj < 2; ++bj) {
            const int col = col0 + bj * 128;
            bf16_t* dst; int ld, cc; bool gate = false;
            if (col < 416) { dst = PM; ld = 416; cc = col; }
            else if (col < 1440) { dst = PR; ld = 1024; cc = col - 416; }
            else if (col < 1696) { dst = PS; ld = 256; cc = col - 1440; }
            else if (col < 2464) { dst = PD; ld = 768; cc = col - 1696; }
            else if (col < NIN) { dst = GT; ld = 4096; cc = col - 2464; gate = true; }
            else continue;
#pragma unroll
            for (int ai = 0; ai < 2; ++ai)
#pragma unroll
                for (int m = 0; m < 4; ++m) {
                    const int row = row0 + ai * 128 + m * 16; pg8::f32x4 v0 = acc[ai][bj][m][0], v1 = acc[ai][bj][m][1];
                    if (gate) { v0[0] = sigmoidf_(v0[0]); v0[1] = sigmoidf_(v0[1]); v0[2] = sigmoidf_(v0[2]); v0[3] = sigmoidf_(v0[3]);
                                v1[0] = sigmoidf_(v1[0]); v1[1] = sigmoidf_(v1[1]); v1[2] = sigmoidf_(v1[2]); v1[3] = sigmoidf_(v1[3]); }
                    u32x4 w; w.x = pack2(v0[0], v0[1]); w.y = pack2(v0[2], v0[3]); w.z = pack2(v1[0], v1[1]); w.w = pack2(v1[2], v1[3]);
                    *(u32x4*)(dst + (size_t)row * ld + cc) = w;
                }
        }
    }
};
DI void phase_inproj(const Ctx& c, int l) {
    EpiInproj E; E.PM = (bf16_t*)(c.ws + WS_P + P_PM); E.PS = (bf16_t*)(c.ws + WS_P + P_PS); E.PR = (bf16_t*)(c.ws + WS_P + P_PR); E.PD = (bf16_t*)(c.ws + WS_P + P_PD); E.GT = (bf16_t*)(c.ws + WS_GT);
    pg8::Gemm g{(const bf16_t*)(c.ws + WS_BUFA), (const bf16_t*)(c.ws + WS_WSM + OFF_WINT + l * SZ_WINT), NZ, NINP, 1024, 1024, 1024};
    pg8::StaticOrder S; S.init(NZ, NINP, (int)gridDim.x, (int)blockIdx.x);
    __syncthreads();
    pg8::gemm_phase<EpiInproj, pg8::StaticOrder, false>((PG8_LAS unsigned char*)c.smem, g, S, E, nullptr, c.tid);
}

DI void phase_prep(const Ctx& c, int l) {
    unsigned char* ws = c.ws; const int lane = c.lane, wave = c.wave, tid = c.tid;
    const bf16_t* PM = (const bf16_t*)(ws + WS_P + P_PM); const bf16_t* PR = (const bf16_t*)(ws + WS_P + P_PR); const bf16_t* PD = (const bf16_t*)(ws + WS_P + P_PD);
    bf16_t* CQN = (bf16_t*)(ws + WS_MISC + MS_CQN); bf16_t* TW = (bf16_t*)(ws + WS_MISC + MS_TW); bf16_t* AL = (bf16_t*)(ws + WS_MISC + MS_AL); bf16_t* SG = (bf16_t*)(ws + WS_MISC + MS_SG);
    bf16_t* KM = (bf16_t*)(ws + WS_EXPW + MX_KM); bf16_t* QD = (bf16_t*)(ws + WS_EXPW + MX_QD); bf16_t* KD_ = (bf16_t*)(ws + WS_EXPW + MX_KD); bf16_t* VDT = (bf16_t*)(ws + WS_EXPW + MX_VDT);
    bf16_t* RB = (bf16_t*)(ws + WS_EXPW + MX_RB); bf16_t* KB = (bf16_t*)(ws + WS_EXPW + MX_KB); bf16_t* VB = (bf16_t*)(ws + WS_EXPW + MX_VB); bf16_t* KKB = (bf16_t*)(ws + WS_EXPW + MX_KKB);
    const float* rope = (const float*)(ws + WS_WSM + OFF_ROPE);
    const float* gq = c.in[9] + l * 256; const float* gkv = c.in[10] + l * 128; const float* mu = c.in[13] + l * 1024; const float* k_k = c.in[19] + l * 256;
    bf16_t* Vs = (bf16_t*)c.smem;
    const float qsc = 0.17677669529663687f * LOG2E;
    for (int tile = blockIdx.x; tile < NZ / 64; tile += gridDim.x) {
        __syncthreads();
        for (int i = 0; i < 8; ++i) {
            const int rt = wave * 8 + i, z = tile * 64 + rt, b = z / TZ, s = z % TZ; const bool lat = s >= CTX; const int tl = lat ? s - CTX : 0;
            {
                const bf16_t* pm = PM + (size_t)z * 416;
                float x[4]; unpack4(*(const u32x2*)(pm + lane * 4), x);
                float ss = wave_sum(x[0] * x[0] + x[1] * x[1] + x[2] * x[2] + x[3] * x[3]);
                float rs = rsqrtf(ss * (1.f / 256.f) + 1e-6f);
                const float4 g = *(const float4*)(gq + lane * 4);
                *(u32x2*)(CQN + (size_t)z * 384 + lane * 4) = pack4(x[0] * rs * g.x, x[1] * rs * g.y, x[2] * rs * g.z, x[3] * rs * g.w);
                const unsigned u2 = *(const unsigned*)(pm + 256 + lane * 2); const float y0 = lo2f(u2), y1 = hi2f(u2);
                ss = wave_sum(y0 * y0 + y1 * y1); rs = rsqrtf(ss * (1.f / 128.f) + 1e-6f);
                const float2 g2 = *(const float2*)(gkv + lane * 2);
                *(unsigned*)(CQN + (size_t)z * 384 + 256 + lane * 2) = pack2(y0 * rs * g2.x, y1 * rs * g2.y);
                float kr = bf2f(pm[384 + (lane & 31)]);
                const float pr = __shfl_xor(kr, 8, 64);
                if (lat) { const float* cs = rope + ((size_t)tl * 16 + ((lane & 31) >> 4) * 8 + (lane & 7)) * 2; kr = kr * cs[0] + ((lane & 8) ? pr : -pr) * cs[1]; }
                if (lane < 32) {
                    const bf16_t kv = f2bf(kr);
#pragma unroll
                    for (int h = 0; h < 4; ++h) KM[((size_t)(b * 4 + h) * TZ + s) * 96 + 64 + lane] = kv;
                }
            }
            {
                const bf16_t* pd = PD + (size_t)z * 768;
                const int i0 = lane * 4, hh = i0 >> 6, ii = i0 & 31, nn = (i0 >> 5) & 1;
                const float* cs = rope + ((size_t)tl * 16 + (ii >> 4) * 8 + (ii & 7)) * 2;
                const bool hi = (ii & 8) != 0;
#pragma unroll
                for (int w = 0; w < 2; ++w) {
                    float x[4]; unpack4(*(const u32x2*)(pd + w * 256 + i0), x);
                    float o[4];
#pragma unroll
                    for (int j = 0; j < 4; ++j) {
                        const float p = __shfl_xor(x[j], 2, 64);
                        o[j] = lat ? (x[j] * cs[2 * j] + (hi ? p : -p) * cs[2 * j + 1]) : x[j];
                        if (w == 0) o[j] *= qsc;
                    }
                    bf16_t* dst = (w == 0 ? QD : KD_) + ((size_t)(b * 4 + hh) * TZ + s) * 64 + nn * 32 + ii;
                    *(u32x2*)dst = pack4(o[0], o[1], o[2], o[3]);
                }
                *(u32x2*)(Vs + rt * 264 + i0) = *(const u32x2*)(pd + 512 + i0);
            }
            {
                const bf16_t* pr = PR + (size_t)z * 1024;
                const bool hp = (s != 0) && (s != CTX), hn = (s != CTX - 1) && (s != TZ - 1);
#pragma unroll
                for (int q = 0; q < 4; ++q) {
                    const int col = q * 256 + lane * 4;
                    float cu[4], pv[4] = {0.f, 0.f, 0.f, 0.f}, nx[4] = {0.f, 0.f, 0.f, 0.f};
                    unpack4(*(const u32x2*)(pr + col), cu);
                    if (hp) unpack4(*(const u32x2*)(pr - 1024 + col), pv);
                    if (hn) unpack4(*(const u32x2*)(pr + 1024 + col), nx);
                    const float4 m = *(const float4*)(mu + col);
                    float zv[4];
                    zv[0] = cu[0] + (0.5f * (pv[0] + nx[0]) - cu[0]) * m.x; zv[1] = cu[1] + (0.5f * (pv[1] + nx[1]) - cu[1]) * m.y;
                    zv[2] = cu[2] + (0.5f * (pv[2] + nx[2]) - cu[2]) * m.z; zv[3] = cu[3] + (0.5f * (pv[3] + nx[3]) - cu[3]) * m.w;
                    if (q == 0) *(u32x2*)(RB + (size_t)z * 256 + lane * 4) = pack4(zv[0], zv[1], zv[2], zv[3]);
                    else if (q == 1) {
                        *(u32x2*)(KB + (size_t)z * 256 + lane * 4) = pack4(zv[0], zv[1], zv[2], zv[3]);
                        const float4 kk4 = *(const float4*)(k_k + lane * 4);
                        const float a0 = zv[0] * kk4.x, a1 = zv[1] * kk4.y, a2 = zv[2] * kk4.z, a3 = zv[3] * kk4.w;
                        const float ssq = sum16(a0 * a0 + a1 * a1 + a2 * a2 + a3 * a3);
                        const float inv = 1.f / fmaxf(sqrtf(ssq), 1e-12f);
                        *(u32x2*)(KKB + (size_t)z * 256 + lane * 4) = pack4(a0 * inv, a1 * inv, a2 * inv, a3 * inv);
                    } else if (q == 2) *(u32x2*)(VB + (size_t)z * 256 + lane * 4) = pack4(zv[0], zv[1], zv[2], zv[3]);
                    else {
                        if (lane < 16) *(u32x2*)(TW + (size_t)z * 64 + lane * 4) = pack4(tanhf(zv[0]), tanhf(zv[1]), tanhf(zv[2]), tanhf(zv[3]));
                        else if (lane < 32) *(u32x2*)(AL + (size_t)z * 64 + (lane - 16) * 4) = pack4(zv[0], zv[1], zv[2], zv[3]);
                        else *(u32x2*)(SG + (size_t)z * 128 + (lane - 32) * 4) = pack4(sigmoidf_(zv[0]), sigmoidf_(zv[1]), sigmoidf_(zv[2]), sigmoidf_(zv[3]));
                    }
                }
            }
        }
        __syncthreads();
        {
            const int z0 = tile * 64, b = z0 / TZ, s0 = z0 % TZ;
#pragma unroll
            for (int i = 0; i < 4; ++i) {
                const int ch = tid + i * NTHR, dv = ch >> 3, r8 = (ch & 7) * 8;
                bf16_t v[8];
#pragma unroll
                for (int j = 0; j < 8; ++j) v[j] = Vs[(r8 + j) * 264 + dv];
                u32x4 o; o.x = v[0] | ((unsigned)v[1] << 16); o.y = v[2] | ((unsigned)v[3] << 16); o.z = v[4] | ((unsigned)v[5] << 16); o.w = v[6] | ((unsigned)v[7] << 16);
                *(u32x4*)(VDT + ((size_t)(b * 4 + (dv >> 6)) * 64 + (dv & 63)) * TZ + s0 + r8) = o;
            }
        }
    }
}

constexpr int S5C = 64, S5N = TZ / S5C, S5NC = CTX / S5C;
DI int s5_tok(int dir, int i) { return dir == 0 ? i : (i < CTX ? CTX - 1 - i : TZ - 1 - (i - CTX)); }
DI void s5_stage_u(const Ctx& c, float* U, int b, int dir, int chunk, int g0, int ng) {
    const bf16_t* PS = (const bf16_t*)(c.ws + WS_P + P_PS);
    const int per = ng * 4;
    for (int e = c.tid; e < S5C * per; e += NTHR) {
        const int i = e / per, c4 = (e % per) * 4, s = s5_tok(dir, chunk * S5C + i);
        float x[4]; unpack4(*(const u32x2*)(PS + (size_t)(b * TZ + s) * 256 + g0 * 16 + c4), x);
        *(float4*)(U + i * (ng * 16) + c4) = make_float4(x[0], x[1], x[2], x[3]);
    }
}
DI void phase_s5_local(const Ctx& c, int l) {
    float* U = (float*)c.smem;
    const float* s5t = (const float*)(c.ws + WS_WSM + OFF_S5T);
    float* E = (float*)(c.ws + WS_WSM + OFF_S5E);
    for (int u = blockIdx.x; u < 2 * 2 * S5N * 2; u += gridDim.x) {
        const int gq = u & 1, chunk = (u >> 1) % S5N, dir = (u / (2 * S5N)) & 1, b = u / (4 * S5N);
        __syncthreads();
        s5_stage_u(c, U, b, dir, chunk, gq * 8, 8);
        __syncthreads();
        const int g = gq * 8 + c.wave, p = c.lane;
        const float* tb = s5t + ((size_t)((l * 2 + dir) * 16 + g) * 64 + p) * 36;
        const float are = tb[0], aim = tb[1];
        float br[16], bi[16];
#pragma unroll
        for (int ch = 0; ch < 16; ++ch) { br[ch] = tb[4 + ch]; bi[ch] = tb[20 + ch]; }
        float xr = 0.f, xi = 0.f;
        for (int i = 0; i < S5C; ++i) {
            const float* uu = U + i * 128 + c.wave * 16;
            float sr = 0.f, si = 0.f;
#pragma unroll
            for (int q = 0; q < 4; ++q) { const float4 v = *(const float4*)(uu + q * 4);
                sr += br[q * 4] * v.x + br[q * 4 + 1] * v.y + br[q * 4 + 2] * v.z + br[q * 4 + 3] * v.w;
                si += bi[q * 4] * v.x + bi[q * 4 + 1] * v.y + bi[q * 4 + 2] * v.z + bi[q * 4 + 3] * v.w; }
            const float nr = are * xr - aim * xi + sr, ni = are * xi + aim * xr + si; xr = nr; xi = ni;
        }
        *(float2*)(E + ((size_t)(((b * 2 + dir) * 16 + g) * S5N + chunk) * 64 + p) * 2) = make_float2(xr, xi);
    }
}
DI void phase_s5_carry(const Ctx& c, int l) {
    const int gt = blockIdx.x * NTHR + c.tid;
    if (gt < 2 * 2 * 16 * 64) {
        const int p = gt & 63, g = (gt >> 6) & 15, dir = (gt >> 10) & 1, b = gt >> 11;
        const float* tb = (const float*)(c.ws + WS_WSM + OFF_S5T) + ((size_t)((l * 2 + dir) * 16 + g) * 64 + p) * 36;
        const float ar = tb[2], ai = tb[3];
        const float* E = (const float*)(c.ws + WS_WSM + OFF_S5E) + (size_t)(((b * 2 + dir) * 16 + g) * S5N) * 128;
        float* C = (float*)(c.ws + WS_WSM + OFF_S5C) + (size_t)(((b * 2 + dir) * 16 + g) * S5N) * 128;
        float xr = 0.f, xi = 0.f;
        for (int ch = 0; ch < S5N; ++ch) {
            const float2 e = *(const float2*)(E + ch * 128 + p * 2);
            *(float2*)(C + ch * 128 + p * 2) = make_float2(xr, xi);
            const float nr = ar * xr - ai * xi + e.x, ni = ar * xi + ai * xr + e.y; xr = nr; xi = ni;
        }
    }
}

constexpr int S5_US = 0, S5_YS = 8192, S5_WV = S5_YS + 2 * 64 * 64 * 4;
template <bool LOCAL>
DI void phase_s5_final_unit(const Ctx& c, int l, int u) {
    unsigned char* L = c.smem;
    const float* s5t = (const float*)(c.ws + WS_WSM + OFF_S5T);
    const float* CIN = (const float*)(c.ws + WS_WSM + OFF_S5C);
    const bf16_t* PS = (const bf16_t*)(c.ws + WS_P + P_PS);
    const int gq = u & 3, ct = (u >> 2) % S5N, b = u / (4 * S5N);
    const int wave = c.wave, lane = c.lane, gl = wave >> 1, dir = wave & 1, g = gq * 4 + gl, n16 = lane & 15, q4 = lane >> 4;
    __syncthreads();
    {
        const int t = c.tid >> 3, part = c.tid & 7;
        *(u32x4*)(L + S5_US + t * 128 + part * 16) = *(const u32x4*)(PS + (size_t)(b * TZ + ct * S5C + t) * 256 + gq * 64 + part * 8);
    }
    typedef short s16x4 __attribute__((ext_vector_type(4)));
    const float* tbase = s5t + ((size_t)((l * 2 + dir) * 16 + g) * 64) * 36;
    s16x4 bfr[8], cfr[8];
#pragma unroll
    for (int j = 0; j < 8; ++j) {
        const int pp = 16 * j + n16, p = pp & 63; const float* tb = tbase + (size_t)p * 36 + (pp < 64 ? 4 : 20) + 4 * q4;
        u32x2 w2; w2.x = pack2(tb[0], tb[1]); w2.y = pack2(tb[2], tb[3]);
        bfr[j] = __builtin_bit_cast(s16x4, w2);
    }
    {
        const float* cre = c.in[29] + ((size_t)((l * 2 + dir) * 16 + g) * 16 + n16) * 64; const float* cim = c.in[30] + ((size_t)((l * 2 + dir) * 16 + g) * 16 + n16) * 64;
#pragma unroll
        for (int s = 0; s < 8; ++s) {
            const int pp = 16 * s + 4 * q4; const float sg = pp < 64 ? 1.f : -1.f; const float* src = (pp < 64 ? cre + pp : cim + (pp - 64));
            u32x2 w2; w2.x = pack2(sg * src[0], sg * src[1]); w2.y = pack2(sg * src[2], sg * src[3]);
            cfr[s] = __builtin_bit_cast(s16x4, w2);
        }
    }
    const float are = tbase[(size_t)lane * 36], aim = tbase[(size_t)lane * 36 + 1];
    const int cd = dir == 0 ? ct : (ct < S5NC ? S5NC - 1 - ct : S5N + S5NC - 1 - ct);
    float xr = 0.f, xi = 0.f;
    if (!LOCAL) { const float2 ci = *(const float2*)(CIN + ((size_t)(((b * 2 + dir) * 16 + g) * S5N + cd) * 64 + lane) * 2); xr = ci.x; xi = ci.y; }
    const float dsk = c.in[31][(size_t)l * 256 + g * 16 + n16];
    bf16_t* BU = (bf16_t*)(L + S5_WV + wave * 8192); bf16_t* XB = BU + 16 * 128;
    float* YS = (float*)(L + S5_YS) + dir * 64 * 64;
    __syncthreads();
#pragma unroll 1
    for (int sb = 0; sb < 4; ++sb) {
        const int stepA = 16 * sb + n16, tlA = dir == 0 ? stepA : 63 - stepA;
        const s16x4 af = __builtin_bit_cast(s16x4, *(const u32x2*)(L + S5_US + tlA * 128 + gl * 32 + q4 * 8));
#pragma unroll
        for (int j = 0; j < 8; ++j) {
            f32x4 acc = {0.f, 0.f, 0.f, 0.f};
            acc = __builtin_amdgcn_mfma_f32_16x16x16bf16_1k(af, bfr[j], acc, 0, 0, 0);
#pragma unroll
            for (int rr = 0; rr < 4; ++rr) {
                const unsigned me = pack2(acc[rr], 0.f) & 0xffffu, nb = (unsigned)__shfl_xor((int)me, 1, 64);
                if ((n16 & 1) == 0) *(unsigned*)(BU + (4 * q4 + rr) * 128 + 16 * j + n16) = me | (nb << 16);
            }
        }
        asm volatile("s_waitcnt lgkmcnt(0)" ::: "memory");
        __builtin_amdgcn_wave_barrier();
#pragma unroll
        for (int ii = 0; ii < 16; ++ii) {
            const float br = bf2f(BU[ii * 128 + lane]), bi = bf2f(BU[ii * 128 + 64 + lane]);
            const float nr = are * xr - aim * xi + br, ni = are * xi + aim * xr + bi; xr = nr; xi = ni;
            if (!LOCAL) {
                const unsigned mr = pack2(xr, 0.f) & 0xffffu, mi = pack2(xi, 0.f) & 0xffffu, nr2 = (unsigned)__shfl_xor((int)mr, 1, 64), ni2 = (unsigned)__shfl_xor((int)mi, 1, 64);
                if ((lane & 1) == 0) { *(unsigned*)(XB + ii * 128 + lane) = mr | (nr2 << 16); *(unsigned*)(XB + ii * 128 + 64 + lane) = mi | (ni2 << 16); }
            }
        }
        asm volatile("s_waitcnt lgkmcnt(0)" ::: "memory");
        __builtin_amdgcn_wave_barrier();
        if (LOCAL) continue;
        f32x4 ya = {0.f, 0.f, 0.f, 0.f};
#pragma unroll
        for (int s = 0; s < 8; ++s) {
            const s16x4 xf = __builtin_bit_cast(s16x4, *(const u32x2*)((const unsigned char*)XB + n16 * 256 + (16 * s + 4 * q4) * 2));
            ya = __builtin_amdgcn_mfma_f32_16x16x16bf16_1k(xf, cfr[s], ya, 0, 0, 0);
        }
#pragma unroll
        for (int rr = 0; rr < 4; ++rr) {
            const int step = 16 * sb + 4 * q4 + rr, tl = dir == 0 ? step : 63 - step;
            float y = ya[rr];
            if (dir == 0) y += dsk * bf2f(*(const bf16_t*)(L + S5_US + tl * 128 + (gl * 16 + n16) * 2));
            YS[tl * 64 + gl * 16 + n16] = y;
        }
    }
    if (LOCAL) { *(float2*)((float*)(c.ws + WS_WSM + OFF_S5E) + ((size_t)(((b * 2 + dir) * 16 + g) * S5N + cd) * 64 + lane) * 2) = make_float2(xr, xi); return; }
    __syncthreads();
    bf16_t* ZG = (bf16_t*)(c.ws + WS_MISC + MS_ZG);
    {
        const float* Y0 = (const float*)(L + S5_YS); const float* Y1 = Y0 + 64 * 64;
        for (int e = c.tid; e < 64 * 16; e += NTHR) {
            const int i = e >> 4, c4 = (e & 15) * 4; const float4 y0 = *(const float4*)(Y0 + i * 64 + c4), y1 = *(const float4*)(Y1 + i * 64 + c4);
            *(u32x2*)(ZG + (size_t)(b * TZ + ct * S5C + i) * 256 + gq * 64 + c4) = pack4(gelu_tanh(y0.x + y1.x), gelu_tanh(y0.y + y1.y), gelu_tanh(y0.z + y1.z), gelu_tanh(y0.w + y1.w));
        }
    }
}

DI void phase_small_gemms(const Ctx& c, int l) {
    unsigned char* ws = c.ws; unsigned char* wsm = ws + WS_WSM;
    const bf16_t* CQN = (const bf16_t*)(ws + WS_MISC + MS_CQN);
    const float* rope = (const float*)(wsm + OFF_ROPE);
    constexpr int NMT = NZ / 256;
    int base = 0;
    const int G = gridDim.x, bid = blockIdx.x;
    {
        const bf16_t* W = (const bf16_t*)(wsm + OFF_WUQT + l * SZ_WUQT); bf16_t* QM = (bf16_t*)(ws + WS_EXPW + MX_QM);
        const float qs = 0.10206207261596577f * LOG2E;
        for (int u = (bid + G - base % G) % G; u < NMT * 3; u += G) {
            const int mt = u / 3, nt = u % 3, r0 = mt * 256, c0 = nt * 128;
            gemm_tile<4, 0>(c, 256, [&](int i) { return CQN + (size_t)(r0 + i) * 384; }, [&](int i) { return W + (size_t)(c0 + i) * 256; }, NoHook(),
                [&](f32x4 (&acc)[4][4], int wr, int wc, int fr, int fq) {
#pragma unroll
                    for (int n = 0; n < 4; ++n) {
                        const int col = c0 + wc + n * 16 + fq * 4, h = col / 96, d = col % 96;
                        const bool rp = d >= 64;
#pragma unroll
                        for (int m = 0; m < 4; ++m) {
                            const int row = r0 + wr + m * 16 + fr, b = row / TZ, s = row % TZ; f32x4 v = acc[m][n];
                            f32x4 pv; pv[0] = __shfl_xor(v[0], 32, 64); pv[1] = __shfl_xor(v[1], 32, 64); pv[2] = __shfl_xor(v[2], 32, 64); pv[3] = __shfl_xor(v[3], 32, 64);
                            if (rp && s >= CTX) {
                                const int i0 = d - 64;
                                const float* cs = rope + ((size_t)(s - CTX) * 16 + (i0 >> 4) * 8 + (i0 & 7)) * 2;
                                const bool hi = (i0 & 8) != 0;
#pragma unroll
                                for (int j = 0; j < 4; ++j) v[j] = v[j] * cs[2 * j] + (hi ? pv[j] : -pv[j]) * cs[2 * j + 1];
                            }
                            *(u32x2*)(QM + ((size_t)(b * 4 + h) * TZ + s) * 96 + d) = pack4(v[0] * qs, v[1] * qs, v[2] * qs, v[3] * qs);
                        }
                    }
                });
        }
        base += NMT * 3;
    }
    {
        const bf16_t* W = (const bf16_t*)(wsm + OFF_WUKVT + l * SZ_WUKVT); bf16_t* KM = (bf16_t*)(ws + WS_EXPW + MX_KM); bf16_t* VMT = (bf16_t*)(ws + WS_EXPW + MX_VMT);
        for (int u = (bid + G - base % G) % G; u < NMT * 4; u += G) {
            const int mt = u / 4, nt = u % 4, r0 = mt * 256, c0 = nt * 128;
            gemm_tile<4, 0>(c, 128, [&](int i) { return CQN + (size_t)(r0 + i) * 384 + 256; }, [&](int i) { return W + (size_t)(c0 + i) * 128; }, NoHook(),
                [&](f32x4 (&acc)[4][4], int wr, int wc, int fr, int fq) {
#pragma unroll
                    for (int n = 0; n < 4; ++n) {
                        const int col = c0 + wc + n * 16 + fq * 4, h = col >> 7, d = col & 127;
#pragma unroll
                        for (int m = 0; m < 4; ++m) {
                            const int row = r0 + wr + m * 16 + fr, b = row / TZ, s = row % TZ; const f32x4 v = acc[m][n];
                            if (d < 64) *(u32x2*)(KM + ((size_t)(b * 4 + h) * TZ + s) * 96 + d) = pack4(v[0], v[1], v[2], v[3]);
                            else {
#pragma unroll
                                for (int j = 0; j < 4; ++j) VMT[((size_t)(b * 4 + h) * 64 + (d - 64 + j)) * TZ + s] = f2bf(v[j]);
                            }
                        }
                    }
                });
        }
        base += NMT * 4;
    }
    bf16_t* SE = (bf16_t*)(ws + WS_P + P_PR); bf16_t* SAD = SE + (size_t)2 * NZ * 256; bf16_t* SKD = SAD + (size_t)2 * NZ * 256;
    {
        const bf16_t* A = (const bf16_t*)(ws + WS_MISC + MS_TW); const bf16_t* W = (const bf16_t*)(wsm + OFF_W2T + l * SZ_W2T);
        const float* w0 = c.in[14] + (size_t)l * 512;
        for (int u = (bid + G - base % G) % G; u < NMT * 4; u += G) {
            const int mt = u / 4, nt = u % 4, r0 = mt * 256, c0 = nt * 128;
            gemm_tile<4, 0>(c, 64, [&](int i) { return A + (size_t)(r0 + i) * 64; }, [&](int i) { return W + (size_t)(c0 + i) * 64; }, NoHook(),
                [&](f32x4 (&acc)[4][4], int wr, int wc, int fr, int fq) {
#pragma unroll
                    for (int n = 0; n < 4; ++n) {
                        const int col = c0 + wc + n * 16 + fq * 4, d = col >> 8, cc = col & 255; const float4 w0v = *(const float4*)(w0 + col);
#pragma unroll
                        for (int m = 0; m < 4; ++m) {
                            const int row = r0 + wr + m * 16 + fr; const f32x4 v = acc[m][n]; float e[4];
                            const float x[4] = {w0v.x + v[0], w0v.y + v[1], w0v.z + v[2], w0v.w + v[3]};
#pragma unroll
                            for (int j = 0; j < 4; ++j) e[j] = 0.6065306597126334f * sigmoidf_(x[j]);
                            *(u32x2*)(SE + ((size_t)d * NZ + row) * 256 + cc) = pack4(e[0], e[1], e[2], e[3]);
                        }
                    }
                });
        }
        base += NMT * 4;
    }
    {
        const bf16_t* A = (const bf16_t*)(ws + WS_MISC + MS_AL); const bf16_t* W = (const bf16_t*)(wsm + OFF_A2T + l * SZ_A2T);
        const float* a0 = c.in[16] + (size_t)l * 512; const float* k_a = c.in[20] + (size_t)l * 256; const bf16_t* KB = (const bf16_t*)(ws + WS_EXPW + MX_KB);
        for (int u = (bid + G - base % G) % G; u < NMT * 4; u += G) {
            const int mt = u / 4, nt = u % 4, r0 = mt * 256, c0 = nt * 128;
            gemm_tile<4, 0>(c, 64, [&](int i) { return A + (size_t)(r0 + i) * 64; }, [&](int i) { return W + (size_t)(c0 + i) * 64; }, NoHook(),
                [&](f32x4 (&acc)[4][4], int wr, int wc, int fr, int fq) {
#pragma unroll
                    for (int n = 0; n < 4; ++n) {
                        const int col = c0 + wc + n * 16 + fq * 4, d = col >> 8, cc = col & 255; const float4 a0v = *(const float4*)(a0 + col), kav = *(const float4*)(k_a + cc);
#pragma unroll
                        for (int m = 0; m < 4; ++m) {
                            const int row = r0 + wr + m * 16 + fr; const f32x4 v = acc[m][n];
                            const float ad0 = sigmoidf_(a0v.x + v[0]), ad1 = sigmoidf_(a0v.y + v[1]), ad2 = sigmoidf_(a0v.z + v[2]), ad3 = sigmoidf_(a0v.w + v[3]);
                            float k[4]; unpack4(*(const u32x2*)(KB + (size_t)row * 256 + cc), k);
                            *(u32x2*)(SAD + ((size_t)d * NZ + row) * 256 + cc) = pack4(ad0, ad1, ad2, ad3);
                            *(u32x2*)(SKD + ((size_t)d * NZ + row) * 256 + cc) = pack4(k[0] * (1.f + (ad0 - 1.f) * kav.x), k[1] * (1.f + (ad1 - 1.f) * kav.y), k[2] * (1.f + (ad2 - 1.f) * kav.z), k[3] * (1.f + (ad3 - 1.f) * kav.w));
                        }
                    }
                });
        }
        base += NMT * 4;
    }
    {
        const bf16_t* A = (const bf16_t*)(ws + WS_MISC + MS_SG); const bf16_t* W = (const bf16_t*)(wsm + OFF_G2T + l * SZ_G2T); bf16_t* GG = (bf16_t*)(ws + WS_MISC + MS_GG);
        for (int u = (bid + G - base % G) % G; u < NMT * 2; u += G) {
            const int mt = u / 2, nt = u % 2, r0 = mt * 256, c0 = nt * 128;
            gemm_tile<4, 0>(c, 128, [&](int i) { return A + (size_t)(r0 + i) * 128; }, [&](int i) { return W + (size_t)(c0 + i) * 128; }, NoHook(),
                [&](f32x4 (&acc)[4][4], int wr, int wc, int fr, int fq) {
#pragma unroll
                    for (int n = 0; n < 4; ++n)
#pragma unroll
                        for (int m = 0; m < 4; ++m) { const f32x4 v = acc[m][n];
                            *(u32x2*)(GG + (size_t)(r0 + wr + m * 16 + fr) * 256 + c0 + wc + n * 16 + fq * 4) = pack4(v[0], v[1], v[2], v[3]); }
                });
        }
        base += NMT * 2;
    }
}

DI int krow(int s, int h, int j) { return 16 * s + 8 * (j >> 2) + 4 * h + (j & 3); }
#ifndef ATT_THR
#define ATT_THR 64.f
#endif
constexpr int ATT_PARK = 56 * 1024;
template <int MODE>
DI void attn_pass(const Ctx& c, int l, int b, int h, int q0, int nkeys) {
    constexpr int DROW = MODE == 0 ? 96 : 64;
    constexpr int DQ = MODE == 0 ? 96 : 32, KS = DQ / 16;
    constexpr int DOFF = MODE == 2 ? 32 : 0;
    constexpr int TK = 128;
    constexpr int KPITCH = DQ * 2 + 16;
    constexpr int VPITCH = TK * 2 + 16;
    constexpr int KBYTES = TK * KPITCH, VBYTES = 64 * VPITCH, STG = KBYTES + VBYTES;
    static_assert(MODE == 0 || 2 * STG <= ATT_PARK, "the staging buffers must stay below the parked o1");
    unsigned char* ws = c.ws; int tid_ = c.tid; asm volatile("" : "+v"(tid_));
    const int tid = tid_, lane = tid & 63, wave = __builtin_amdgcn_readfirstlane(tid >> 6), r = lane & 31, hh = lane >> 5;
    const bf16_t* Q = (const bf16_t*)(ws + WS_EXPW + (MODE == 0 ? MX_QM : MX_QD)) + (size_t)(b * 4 + h) * TZ * DROW + DOFF;
    const bf16_t* Kp = (const bf16_t*)(ws + WS_EXPW + (MODE == 0 ? MX_KM : MX_KD)) + (size_t)(b * 4 + h) * TZ * DROW + DOFF;
    const bf16_t* Vt = (const bf16_t*)(ws + WS_EXPW + (MODE == 0 ? MX_VMT : MX_VDT)) + (size_t)(b * 4 + h) * 64 * TZ;
    unsigned char* smem = c.smem;
    bf16x8 qf[KS];
    const int qrow = q0 + wave * 32 + r;
#pragma unroll
    for (int ks = 0; ks < KS; ++ks) qf[ks] = *(const bf16x8*)(Q + (size_t)qrow * DROW + ks * 16 + hh * 8);
    f32x16 oacc[2];
    float mref = 0.f, lrun = 0.f;
#pragma unroll
    for (int t = 0; t < 2; ++t)
#pragma unroll
        for (int i = 0; i < 16; ++i) oacc[t][i] = 0.f;
    constexpr int CPR = DQ / 8, KCH = TK * CPR, NKR = KCH / NTHR;
    static_assert(KCH % NTHR == 0, "whole staging rounds");
    u32x4 kreg[NKR], vreg[2];
    const bf16_t* kp[NKR]; int koff[NKR];
#pragma unroll
    for (int i = 0; i < NKR; ++i) { const int ch = tid + i * NTHR; kp[i] = Kp + ((long)(ch / CPR) - 64) * DROW + (ch % CPR) * 8; koff[i] = (ch / CPR) * KPITCH + (ch % CPR) * 16; }
    const bf16_t* vp = Vt + (size_t)(tid >> 4) * TZ + (tid & 15) * 8 - 64;
    const int voff = (tid >> 4) * VPITCH + (tid & 15) * 16;
    auto gloadK = [&]() {
#pragma unroll
        for (int i = 0; i < NKR; ++i) { kreg[i] = *(const u32x4*)kp[i]; kp[i] += TK * DROW; }
    };
    auto gloadV = [&]() { vreg[0] = *(const u32x4*)vp; vreg[1] = *(const u32x4*)(vp + (size_t)32 * TZ); vp += TK; };
    auto lstoreK = [&](int buf) {
        unsigned char* sk = smem + buf * STG;
#pragma unroll
        for (int i = 0; i < NKR; ++i) *(u32x4*)(sk + koff[i]) = kreg[i];
    };
    auto lstoreV = [&](int buf) { unsigned char* sv = smem + buf * STG + KBYTES; *(u32x4*)(sv + voff) = vreg[0]; *(u32x4*)(sv + voff + 32 * VPITCH) = vreg[1]; };
    const int kbase = r * KPITCH + hh * 16, vbase = KBYTES + r * VPITCH + hh * 8;
    auto ldfrag = [&](const unsigned char* kb, const unsigned char* vb, int ci) -> u32x4 {
        if (ci < 8) {
            const int kg = ci >> 2, s = (ci >> 1) & 1, t = ci & 1;
            const unsigned char* vrow = vb + t * 32 * VPITCH + (kg * 32 + 16 * s) * 2;
            const u32x2 lo = *(const u32x2*)vrow, hi2 = *(const u32x2*)(vrow + 16);
            u32x4 vv; vv.x = lo.x; vv.y = lo.y; vv.z = hi2.x; vv.w = hi2.y; return vv;
        }
        const int q = ci - 8, kg = q & 1, ks = q >> 1;
        return *(const u32x4*)(kb + kg * 32 * KPITCH + ks * 32);
    };
    constexpr int NM = 8 + 2 * KS;
    const f32x16 zero16 = {0.f, 0.f, 0.f, 0.f, 0.f, 0.f, 0.f, 0.f, 0.f, 0.f, 0.f, 0.f, 0.f, 0.f, 0.f, 0.f};
    auto pv_all = [&](const u32x4 (&P)[4], const unsigned char* vb) {
#pragma unroll
        for (int ci = 0; ci < 8; ++ci) { const u32x4 f = ldfrag(vb, vb, ci); oacc[ci & 1] = __builtin_amdgcn_mfma_f32_32x32x16_bf16(__builtin_bit_cast(bf16x8, f), __builtin_bit_cast(bf16x8, P[ci >> 1]), oacc[ci & 1], 0, 0, 0); }
    };
    auto iter = [&](f32x16 (&Sc)[2], f32x16 (&Sn)[2], u32x4 (&Pp)[4], u32x4 (&Pn)[4], const unsigned char* kb, const unsigned char* vb, bool first) {
        u32x4 fcur = ldfrag(kb, vb, 0), fnx1 = ldfrag(kb, vb, 1);
        float mx = Sc[0][0];
#pragma unroll
        for (int kg = 0; kg < 2; ++kg)
#pragma unroll
            for (int i = 0; i < 16; ++i) mx = fmaxf(mx, Sc[kg][i]);
        const bool need0 = (mx - mref > ATT_THR) || (first && mx < -32.f);
        if (__any(need0)) {
            pv_all(Pp, vb);
#pragma unroll
            for (int q = 0; q < 4; ++q) Pp[q] = (u32x4){0u, 0u, 0u, 0u};
            mx = fmaxf(mx, __shfl_xor(mx, 32, 64));
            const float hi = mx - mref;
            const bool need = (hi > ATT_THR) || (first && mx < -32.f);
            const float d = need ? hi : 0.f;
            const float alpha = first ? 1.f : __builtin_amdgcn_exp2f(-d);
            mref += d; lrun *= alpha;
#pragma unroll
            for (int t = 0; t < 2; ++t)
#pragma unroll
                for (int i = 0; i < 16; ++i) oacc[t][i] *= alpha;
        }
        if (__any(mref != 0.f)) {
#pragma unroll
            for (int kg = 0; kg < 2; ++kg)
#pragma unroll
                for (int i = 0; i < 16; ++i) Sc[kg][i] -= mref;
        }
        f32x2 ps = {0.f, 0.f};
        __builtin_amdgcn_sched_barrier(0);
#pragma unroll
        for (int ci = 0; ci < NM; ++ci) {
            u32x4 fnx2 = fnx1;
            if (ci + 2 < NM) fnx2 = ldfrag(kb, vb, ci + 2);
            if (ci < 8) oacc[ci & 1] = __builtin_amdgcn_mfma_f32_32x32x16_bf16(__builtin_bit_cast(bf16x8, fcur), __builtin_bit_cast(bf16x8, Pp[ci >> 1]), oacc[ci & 1], 0, 0, 0);
            else { const int q = ci - 8, kg = q & 1, ks = q >> 1; Sn[kg] = __builtin_amdgcn_mfma_f32_32x32x16_bf16(__builtin_bit_cast(bf16x8, fcur), qf[ks], ks == 0 ? zero16 : Sn[kg], 0, 0, 0); }
#pragma unroll
            for (int p = (ci * 16) / NM; p < ((ci + 1) * 16) / NM; ++p) {
                const int kg = p >> 3, q = p & 7;
                const float p0 = __builtin_amdgcn_exp2f(Sc[kg][2 * q]), p1 = __builtin_amdgcn_exp2f(Sc[kg][2 * q + 1]);
                ps += (f32x2){p0, p1};
                Pn[kg * 2 + (q >> 2)][q & 3] = pack2(p0, p1);
            }
            asm volatile("" : "+v"(ps));
            fcur = fnx1; fnx1 = fnx2;
            __builtin_amdgcn_sched_barrier(0);
        }
        lrun += ps.x + ps.y;
    };
    const int NT = nkeys / TK;
    f32x16 S0[2], S1[2]; u32x4 PA[4], PB[4];
#pragma unroll
    for (int q = 0; q < 4; ++q) PA[q] = (u32x4){0u, 0u, 0u, 0u};
    __syncthreads();
    gloadK();
    lstoreK(1);
    gloadK();
    if ((tid & 15) >= 8) gloadV(); else { vreg[0] = (u32x4){0u, 0u, 0u, 0u}; vreg[1] = vreg[0]; vp += TK; }
    __syncthreads();
    {
        const unsigned char* kb = smem + STG + 64 * KPITCH + kbase;
#pragma unroll
        for (int q = 0; q < 2 * KS; ++q) { const int kg = q & 1, ks = q >> 1; const u32x4 f = ldfrag(kb, kb, 8 + q); S0[kg] = __builtin_amdgcn_mfma_f32_32x32x16_bf16(__builtin_bit_cast(bf16x8, f), qf[ks], ks == 0 ? zero16 : S0[kg], 0, 0, 0); }
    }
    for (int s = 0; s < NT; ++s) {
        lstoreK(s & 1); lstoreV(s & 1);
        if (s + 1 < NT) gloadK();
        gloadV();
        __syncthreads();
        const unsigned char* sb = smem + (s & 1) * STG;
        iter(S0, S1, PA, PB, sb + kbase, sb + vbase, s == 0);
        iter(S1, S0, PB, PA, sb + 64 * KPITCH + kbase, sb + 128 + vbase, false);
    }
    lstoreV(NT & 1);
    __syncthreads();
    pv_all(PA, smem + (NT & 1) * STG + vbase);
    const float inv = 1.f / (lrun + __shfl_xor(lrun, 32, 64));
    bf16_t* Ycat = (bf16_t*)(ws + WS_BUFA);
    const int zrow = b * TZ + qrow;
    float* park = (float*)(smem + ATT_PARK) + tid;
    if (MODE == 0) {
#pragma unroll
        for (int t = 0; t < 2; ++t)
#pragma unroll
            for (int i4 = 0; i4 < 4; ++i4) {
                const int dv = t * 32 + 8 * i4 + 4 * hh;
                *(u32x2*)(Ycat + (size_t)zrow * D + h * 64 + dv) = pack4(oacc[t][4 * i4] * inv, oacc[t][4 * i4 + 1] * inv, oacc[t][4 * i4 + 2] * inv, oacc[t][4 * i4 + 3] * inv);
            }
    } else if (MODE == 1) {
#pragma unroll
        for (int t = 0; t < 2; ++t)
#pragma unroll
            for (int i = 0; i < 16; ++i) park[(t * 16 + i) * NTHR] = oacc[t][i] * inv;
    } else {
        const float lam = ((const float*)(ws + WS_WSM + OFF_LAM))[l];
        const float lam_init = 0.8f - 0.6f * __expf(-0.3f * (float)l);
        float ss = 0.f;
#pragma unroll
        for (int t = 0; t < 2; ++t)
#pragma unroll
            for (int i = 0; i < 16; ++i) { const float o = park[(t * 16 + i) * NTHR] - lam * oacc[t][i] * inv; oacc[t][i] = o; ss += o * o; }
        ss += __shfl_xor(ss, 32, 64);
        const float rs = rsqrtf(ss * (1.f / 64.f) + 1e-5f) * (1.f - lam_init);
        const float* sg = c.in[38] + l * 64;
#pragma unroll
        for (int t = 0; t < 2; ++t)
#pragma unroll
            for (int i4 = 0; i4 < 4; ++i4) {
                const int dv = t * 32 + 8 * i4 + 4 * hh; const float4 g = *(const float4*)(sg + dv);
                *(u32x2*)(Ycat + (size_t)zrow * D + 768 + h * 64 + dv) = pack4(oacc[t][4 * i4] * rs * g.x, oacc[t][4 * i4 + 1] * rs * g.y, oacc[t][4 * i4 + 2] * rs * g.z, oacc[t][4 * i4 + 3] * rs * g.w);
            }
    }
}
DI void phase_attention(const Ctx& c, int l) {
    const int nu = 512 + (l == 0 ? 16 : 0);
    for (int u = blockIdx.x; u < nu; u += gridDim.x) {
        int b, h, q0, nk; bool mla;
        if (u < 512) { const int k = u & 255, bh = k & 7; b = bh >> 2; h = bh & 3; q0 = CTX + (k >> 3) * 256; nk = TZ; mla = u < 256; }
        else { const int k = u - 512; b = (k >> 2) & 1; h = k & 3; q0 = 0; nk = CTX; mla = k < 8; }
        if (mla) attn_pass<0>(c, l, b, h, q0, nk);
        else { attn_pass<1>(c, l, b, h, q0, nk); attn_pass<2>(c, l, b, h, q0, nk); }
    }
}

DI int rw_tok(int dir, int i) { return dir == 0 ? i : (i < CTX ? CTX - 1 - i : TZ - 1 - (i - CTX)); }
constexpr int RW_TS = 32;
constexpr int RW_STEP_F = 6 * 64 + 2;
constexpr int RW_BUF_F = RW_TS * RW_STEP_F;
template <int CTRL> DI float dpp_add(float x) { return x + __int_as_float(__builtin_amdgcn_update_dpp(0, __float_as_int(x), CTRL, 0xf, 0xf, false)); }
DI float red16(float x) { x = dpp_add<0xB1>(x); x = dpp_add<0x4E>(x); x = dpp_add<0x141>(x); x = dpp_add<0x140>(x); return x; }
DI float red8(float x) { x = dpp_add<0xB1>(x); x = dpp_add<0x4E>(x); x = dpp_add<0x141>(x); return x; }
struct RwRegs { u32x4 r, v, kk, e, ad, kd; };
DI void rw_load(const Ctx& c, int b, int h, int dir, int chunk, int t, RwRegs& g) {
    const bf16_t* RB = (const bf16_t*)(c.ws + WS_EXPW + MX_RB); const bf16_t* VB = (const bf16_t*)(c.ws + WS_EXPW + MX_VB); const bf16_t* KKB = (const bf16_t*)(c.ws + WS_EXPW + MX_KKB);
    const bf16_t* SE = (const bf16_t*)(c.ws + WS_P + P_PR) + (size_t)dir * NZ * 256; const bf16_t* SAD = SE + (size_t)2 * NZ * 256; const bf16_t* SKD = SAD + (size_t)2 * NZ * 256;
    const int i = chunk * RW_TS + (t >> 3), z = b * TZ + rw_tok(dir, i); const size_t o = (size_t)z * 256 + h * 64 + (t & 7) * 8;
    g.r = *(const u32x4*)(RB + o); g.v = *(const u32x4*)(VB + o); g.kk = *(const u32x4*)(KKB + o);
    g.e = *(const u32x4*)(SE + o); g.ad = *(const u32x4*)(SAD + o); g.kd = *(const u32x4*)(SKD + o);
}
DI void up8(const u32x4& u, float (&f)[8]) { f[0] = lo2f(u.x); f[1] = hi2f(u.x); f[2] = lo2f(u.y); f[3] = hi2f(u.y); f[4] = lo2f(u.z); f[5] = hi2f(u.z); f[6] = lo2f(u.w); f[7] = hi2f(u.w); }
DI void rw_process(const RwRegs& g, int t, float* buf) {
    float r[8], v[8], kk[8], e[8], ad[8], kd[8];
    up8(g.r, r); up8(g.v, v); up8(g.kk, kk); up8(g.e, e); up8(g.ad, ad); up8(g.kd, kd);
    float* f = buf + (t >> 3) * RW_STEP_F + (t & 7) * 8;
    float w[8], bv[8], wr[8]; float br = 0.f, kr = 0.f;
#pragma unroll
    for (int j = 0; j < 8; ++j) { w[j] = __expf(-e[j]); bv[j] = kk[j] * ad[j]; wr[j] = w[j] * r[j]; br += bv[j] * r[j]; kr += kd[j] * r[j]; }
    *(float4*)(f) = make_float4(w[0], w[1], w[2], w[3]); *(float4*)(f + 4) = make_float4(w[4], w[5], w[6], w[7]);
    *(float4*)(f + 64) = make_float4(kk[0], kk[1], kk[2], kk[3]); *(float4*)(f + 68) = make_float4(kk[4], kk[5], kk[6], kk[7]);
    *(float4*)(f + 128) = make_float4(bv[0], bv[1], bv[2], bv[3]); *(float4*)(f + 132) = make_float4(bv[4], bv[5], bv[6], bv[7]);
    *(float4*)(f + 192) = make_float4(kd[0], kd[1], kd[2], kd[3]); *(float4*)(f + 196) = make_float4(kd[4], kd[5], kd[6], kd[7]);
    *(float4*)(f + 256) = make_float4(wr[0], wr[1], wr[2], wr[3]); *(float4*)(f + 260) = make_float4(wr[4], wr[5], wr[6], wr[7]);
    *(float4*)(f + 320) = make_float4(v[0], v[1], v[2], v[3]); *(float4*)(f + 324) = make_float4(v[4], v[5], v[6], v[7]);
    br = red8(br); kr = red8(kr);
    if ((t & 7) == 0) { float* s = buf + (t >> 3) * RW_STEP_F + 384; s[0] = br; s[1] = kr; }
}
struct RwStep { float4 w, kk, bv, kd, wr; float vv, br, kr; };
DI void rw_ld(RwStep& s, const float* f, int kq, int row) {
    s.w = *(const float4*)(f + kq * 4); s.kk = *(const float4*)(f + 64 + kq * 4); s.bv = *(const float4*)(f + 128 + kq * 4);
    s.kd = *(const float4*)(f + 192 + kq * 4); s.wr = *(const float4*)(f + 256 + kq * 4); s.vv = f[320 + row]; s.br = f[384]; s.kr = f[385];
}
DI void phase_rwkv_scan_unit(const Ctx& c, int l, int u) {
    const int rg = u & 3, chain = u >> 2, dir = chain & 1, h = (chain >> 1) & 3, b = chain >> 3;
    float* buf0 = (float*)c.smem; float* buf1 = buf0 + RW_BUF_F;
    float* ybuf = buf1 + RW_BUF_F;
    float* YO = (float*)(c.ws + WS_BUFB) + (size_t)dir * NZ * 256 + (size_t)b * TZ * 256 + h * 64 + rg * 16;
    const int wave = c.wave, lane = c.lane, rr = lane >> 4, kq = lane & 15, rl = (wave & 3) * 4 + rr, row = rg * 16 + rl;
    const int t = c.tid - 256;
    float S0 = 0.f, S1 = 0.f, S2 = 0.f, S3 = 0.f;
    constexpr int NCH = TZ / RW_TS;
    RwRegs g;
    __syncthreads();
    if (wave >= 4) { rw_load(c, b, h, dir, 0, t, g); rw_process(g, t, buf0); rw_load(c, b, h, dir, 1, t, g); }
    __syncthreads();
    for (int ch = 0; ch < NCH; ++ch) {
        float* cur = buf0 + (ch & 1) * RW_BUF_F; float* nxt = buf0 + ((ch + 1) & 1) * RW_BUF_F;
        if (wave >= 4) {
            if (ch > 0) {
                const float* yb = ybuf + ((ch - 1) & 1) * RW_TS * 16;
#pragma unroll
                for (int i = 0; i < 2; ++i) { const int e = t + i * 256, st = e >> 4, rw = e & 15; YO[(size_t)rw_tok(dir, (ch - 1) * RW_TS + st) * 256 + rw] = yb[e]; }
            }
            if (ch + 1 < NCH) rw_process(g, t, nxt);
            if (ch + 2 < NCH) rw_load(c, b, h, dir, ch + 2, t, g);
        } else {
            float* yb = ybuf + (ch & 1) * RW_TS * 16 + rl;
            RwStep s0, s1;
            rw_ld(s0, cur, kq, row);
#pragma unroll 4
            for (int st = 0; st < RW_TS; st += 2) {
                rw_ld(s1, cur + (st + 1) * RW_STEP_F, kq, row);
                {
                    float sa = -((S0 * s0.kk.x + S1 * s0.kk.y) + (S2 * s0.kk.z + S3 * s0.kk.w));
                    float q = (S0 * s0.wr.x + S1 * s0.wr.y) + (S2 * s0.wr.z + S3 * s0.wr.w);
                    sa = red16(sa); q = red16(q);
                    S0 = fmaf(sa, s0.bv.x, fmaf(S0, s0.w.x, s0.vv * s0.kd.x)); S1 = fmaf(sa, s0.bv.y, fmaf(S1, s0.w.y, s0.vv * s0.kd.y));
                    S2 = fmaf(sa, s0.bv.z, fmaf(S2, s0.w.z, s0.vv * s0.kd.z)); S3 = fmaf(sa, s0.bv.w, fmaf(S3, s0.w.w, s0.vv * s0.kd.w));
                    yb[st * 16] = q + sa * s0.br + s0.vv * s0.kr;
                }
                if (st + 2 < RW_TS) rw_ld(s0, cur + (st + 2) * RW_STEP_F, kq, row);
                {
                    float sa = -((S0 * s1.kk.x + S1 * s1.kk.y) + (S2 * s1.kk.z + S3 * s1.kk.w));
                    float q = (S0 * s1.wr.x + S1 * s1.wr.y) + (S2 * s1.wr.z + S3 * s1.wr.w);
                    sa = red16(sa); q = red16(q);
                    S0 = fmaf(sa, s1.bv.x, fmaf(S0, s1.w.x, s1.vv * s1.kd.x)); S1 = fmaf(sa, s1.bv.y, fmaf(S1, s1.w.y, s1.vv * s1.kd.y));
                    S2 = fmaf(sa, s1.bv.z, fmaf(S2, s1.w.z, s1.vv * s1.kd.z)); S3 = fmaf(sa, s1.bv.w, fmaf(S3, s1.w.w, s1.vv * s1.kd.w));
                    yb[(st + 1) * 16] = q + sa * s1.br + s1.vv * s1.kr;
                }
            }
        }
        __syncthreads();
    }
    if (wave >= 4) {
        const float* yb = ybuf + ((NCH - 1) & 1) * RW_TS * 16;
#pragma unroll
        for (int i = 0; i < 2; ++i) { const int e = t + i * 256, st = e >> 4, rw = e & 15; YO[(size_t)rw_tok(dir, (NCH - 1) * RW_TS + st) * 256 + rw] = yb[e]; }
    }
}

constexpr int LA_AN = 0, LA_RN = 8192, LA_BN = 16384, LA_KN = 24576, LA_AT = 32768, LA_BHT = 40960, LA_KHT = 49152, LA_VT = 57344,
              LA_NBA = 65536  , LA_NKA = 81920, LA_NBRT = 90112, LA_NKRT = 98304, LA_P63 = 106496;
constexpr int LA_TMT = LA_AN, LA_M1 = LA_BN, LA_W1T = LA_KN, LA_Z1 = LA_NBA;
DI int crow(int reg, int h) { return (reg & 3) + 8 * (reg >> 2) + 4 * h; }
DI void mm_tile(f32x16& acc, const unsigned char* A, int i0, const unsigned char* BT, int j0, int r, int h) {
#pragma unroll
    for (int ks = 0; ks < 4; ++ks) {
        const bf16x8 a = *(const bf16x8*)(A + (i0 + r) * 128 + ks * 32 + h * 16);
        const bf16x8 b = *(const bf16x8*)(BT + (j0 + r) * 128 + ks * 32 + h * 16);
        acc = __builtin_amdgcn_mfma_f32_32x32x16_bf16(a, b, acc, 0, 0, 0);
    }
}
DI void zero16(f32x16& a) {
#pragma unroll
    for (int i = 0; i < 16; ++i) a[i] = 0.f;
}
DI void phase_rwkv_chunk_unit(const Ctx& c, int l, int unit) {
    unsigned char* L = c.smem; unsigned char* ws = c.ws;
    const int chain = unit / RNC, ch = unit % RNC, dir = chain & 1, hd = (chain >> 1) & 3, b = chain >> 3;
    const int tid = c.tid, lane = c.lane, wave = c.wave, r = lane & 31, h = lane >> 5;
    const bf16_t* RB = (const bf16_t*)(ws + WS_EXPW + MX_RB); const bf16_t* VB = (const bf16_t*)(ws + WS_EXPW + MX_VB); const bf16_t* KKB = (const bf16_t*)(ws + WS_EXPW + MX_KKB);
    const bf16_t* SE = (const bf16_t*)(ws + WS_P + P_PR) + (size_t)dir * NZ * 256; const bf16_t* SAD = SE + (size_t)2 * NZ * 256; const bf16_t* SKD = SAD + (size_t)2 * NZ * 256;
    float* CUM = (float*)(L + LA_NBA);
    __syncthreads();
    const int t = tid >> 3, k0 = (tid & 7) * 8;
    float rr[8], vv[8], kk[8], ee[8], ad[8], kd[8];
    {
        const int z = b * TZ + rw_tok(dir, ch * RC + t); const size_t o = (size_t)z * 256 + hd * 64 + k0;
        up8(*(const u32x4*)(RB + o), rr); up8(*(const u32x4*)(VB + o), vv); up8(*(const u32x4*)(KKB + o), kk);
        up8(*(const u32x4*)(SE + o), ee); up8(*(const u32x4*)(SAD + o), ad); up8(*(const u32x4*)(SKD + o), kd);
        *(float4*)(CUM + t * 64 + k0) = make_float4(ee[0], ee[1], ee[2], ee[3]); *(float4*)(CUM + t * 64 + k0 + 4) = make_float4(ee[4], ee[5], ee[6], ee[7]);
    }
    __syncthreads();
    if (wave == 0) { float cm = 0.f;
#pragma unroll 8
        for (int i = 0; i < RC; ++i) { cm += CUM[i * 64 + lane]; CUM[i * 64 + lane] = cm; } }
    __syncthreads();
    {
        float cm[8], c63[8];
        { const float4 a = *(const float4*)(CUM + t * 64 + k0), bq = *(const float4*)(CUM + t * 64 + k0 + 4); cm[0] = a.x; cm[1] = a.y; cm[2] = a.z; cm[3] = a.w; cm[4] = bq.x; cm[5] = bq.y; cm[6] = bq.z; cm[7] = bq.w; }
        { const float4 a = *(const float4*)(CUM + 63 * 64 + k0), bq = *(const float4*)(CUM + 63 * 64 + k0 + 4); c63[0] = a.x; c63[1] = a.y; c63[2] = a.z; c63[3] = a.w; c63[4] = bq.x; c63[5] = bq.y; c63[6] = bq.z; c63[7] = bq.w; }
        float at[8], rt[8], bt[8], kt[8], bh[8], kh[8];
#pragma unroll
        for (int j = 0; j < 8; ++j) {
            const float pt = __expf(-cm[j]), pp = __expf(-(cm[j] - ee[j])), ip = __expf(cm[j]), ph = __expf(-(c63[j] - cm[j])), bb = kk[j] * ad[j];
            at[j] = -kk[j] * pp; rt[j] = rr[j] * pt; bt[j] = bb * ip; kt[j] = kd[j] * ip; bh[j] = bb * ph; kh[j] = kd[j] * ph;
        }
        u32x4 w4;
        w4.x = pack2(at[0], at[1]); w4.y = pack2(at[2], at[3]); w4.z = pack2(at[4], at[5]); w4.w = pack2(at[6], at[7]); *(u32x4*)(L + LA_AN + t * 128 + k0 * 2) = w4;
        w4.x = pack2(rt[0], rt[1]); w4.y = pack2(rt[2], rt[3]); w4.z = pack2(rt[4], rt[5]); w4.w = pack2(rt[6], rt[7]); *(u32x4*)(L + LA_RN + t * 128 + k0 * 2) = w4;
        w4.x = pack2(bt[0], bt[1]); w4.y = pack2(bt[2], bt[3]); w4.z = pack2(bt[4], bt[5]); w4.w = pack2(bt[6], bt[7]); *(u32x4*)(L + LA_BN + t * 128 + k0 * 2) = w4;
        w4.x = pack2(kt[0], kt[1]); w4.y = pack2(kt[2], kt[3]); w4.z = pack2(kt[4], kt[5]); w4.w = pack2(kt[6], kt[7]); *(u32x4*)(L + LA_KN + t * 128 + k0 * 2) = w4;
#pragma unroll
        for (int j = 0; j < 8; ++j) {
            *(bf16_t*)(L + LA_AT + (k0 + j) * 128 + t * 2) = f2bf(at[j]); *(bf16_t*)(L + LA_BHT + (k0 + j) * 128 + t * 2) = f2bf(bh[j]);
            *(bf16_t*)(L + LA_KHT + (k0 + j) * 128 + t * 2) = f2bf(kh[j]); *(bf16_t*)(L + LA_VT + (k0 + j) * 128 + t * 2) = f2bf(vv[j]);
        }
        if (t == 63) {
            float* p63 = (float*)(L + LA_P63); float* gp = (float*)(ws + WS_RW + RW_P63) + (size_t)unit * 64;
#pragma unroll
            for (int j = 0; j < 8; ++j) { const float p = __expf(-c63[j]); p63[k0 + j] = p; gp[k0 + j] = p; }
        }
    }
    __syncthreads();
    {
        const int p = wave >> 1, i0 = (wave & 1) * 32;
        const unsigned char* A = L + (p == 0 ? LA_BN : p == 1 ? LA_KN : LA_RN);
        const unsigned char* BT = L + (p < 2 ? LA_AN : p == 2 ? LA_BN : LA_KN);
#pragma unroll
        for (int jt = 0; jt < 2; ++jt) {
            const int j0 = jt * 32; f32x16 acc; zero16(acc);
            mm_tile(acc, A, i0, BT, j0, r, h);
            const int col = j0 + r;
#pragma unroll
            for (int g = 0; g < 16; ++g) {
                const int row = i0 + crow(g, h);
                if (p == 0) ((float*)(L + LA_NBA))[row * 64 + col] = (row < col) ? acc[g] : 0.f;
                else if (p == 1) *(bf16_t*)(L + LA_NKA + row * 128 + col * 2) = f2bf((row < col) ? acc[g] : 0.f);
                else *(bf16_t*)(L + (p == 2 ? LA_NBRT : LA_NKRT) + row * 128 + col * 2) = f2bf((col <= row) ? acc[g] : 0.f);
            }
        }
    }
    __syncthreads();
    {
        constexpr int X0 = LA_BN, X1 = LA_KN, X3 = 108544, X4 = X3 + 8192, X5 = LA_NBA + 16384 - 16384, X6 = LA_NBA + 8192;
        float nv[8];
        { const int s = tid >> 3, t0 = (tid & 7) * 8; const float* N = (const float*)(L + LA_NBA) + s * 64 + t0;
          const float4 a = *(const float4*)N, bq = *(const float4*)(N + 4); nv[0] = a.x; nv[1] = a.y; nv[2] = a.z; nv[3] = a.w; nv[4] = bq.x; nv[5] = bq.y; nv[6] = bq.z; nv[7] = bq.w; }
        __syncthreads();
        {
            const int s = tid >> 3, t0 = (tid & 7) * 8;
            u32x4 w4; w4.x = pack2(nv[0], nv[1]); w4.y = pack2(nv[2], nv[3]); w4.z = pack2(nv[4], nv[5]); w4.w = pack2(nv[6], nv[7]);
            *(u32x4*)(L + X0 + s * 128 + t0 * 2) = w4;
#pragma unroll
            for (int j = 0; j < 8; ++j) *(bf16_t*)(L + X1 + (t0 + j) * 128 + s * 2) = f2bf(nv[j]);
#pragma unroll
            for (int j = 0; j < 8; ++j) if (t0 + j == s) nv[j] += 1.f;
            w4.x = pack2(nv[0], nv[1]); w4.y = pack2(nv[2], nv[3]); w4.z = pack2(nv[4], nv[5]); w4.w = pack2(nv[6], nv[7]);
            *(u32x4*)(L + X5 + s * 128 + t0 * 2) = w4;
        }
        __syncthreads();
        const int ti0 = ((wave >> 1) & 1) * 32, tj0 = (wave & 1) * 32;
        if (wave < 4) {
            f32x16 acc; zero16(acc); mm_tile(acc, L + X0, ti0, L + X1, tj0, r, h);
#pragma unroll
            for (int g4 = 0; g4 < 4; ++g4) *(u32x2*)(L + X4 + (tj0 + r) * 128 + (ti0 + 8 * g4 + 4 * h) * 2) = pack4(acc[4 * g4], acc[4 * g4 + 1], acc[4 * g4 + 2], acc[4 * g4 + 3]);
#pragma unroll
            for (int g = 0; g < 16; ++g) *(bf16_t*)(L + X3 + (ti0 + crow(g, h)) * 128 + (tj0 + r) * 2) = f2bf(acc[g]);
        }
        __syncthreads();
#pragma unroll
        for (int k = 1; k <= 5; ++k) {
            const int qa = (k & 1) ? X3 : X0, qt = (k & 1) ? X4 : X1, nqa = (k & 1) ? X0 : X3, nqt = (k & 1) ? X1 : X4;
            const int pa = (k & 1) ? X5 : X6, npa = (k & 1) ? X6 : X5;
            if (wave >= 4) {
                f32x16 acc; zero16(acc); mm_tile(acc, L + pa, ti0, L + qt, tj0, r, h);
#pragma unroll
                for (int g = 0; g < 16; ++g) acc[g] += bf2f(*(const bf16_t*)(L + pa + (ti0 + crow(g, h)) * 128 + (tj0 + r) * 2));
                if (k < 5) {
#pragma unroll
                    for (int g = 0; g < 16; ++g) *(bf16_t*)(L + npa + (ti0 + crow(g, h)) * 128 + (tj0 + r) * 2) = f2bf(acc[g]);
                } else {
#pragma unroll
                    for (int g4 = 0; g4 < 4; ++g4) *(u32x2*)(L + LA_TMT + (tj0 + r) * 128 + (ti0 + 8 * g4 + 4 * h) * 2) = pack4(acc[4 * g4], acc[4 * g4 + 1], acc[4 * g4 + 2], acc[4 * g4 + 3]);
                }
            } else if (k < 5) {
                f32x16 acc; zero16(acc); mm_tile(acc, L + qa, ti0, L + qt, tj0, r, h);
#pragma unroll
                for (int g4 = 0; g4 < 4; ++g4) *(u32x2*)(L + nqt + (tj0 + r) * 128 + (ti0 + 8 * g4 + 4 * h) * 2) = pack4(acc[4 * g4], acc[4 * g4 + 1], acc[4 * g4 + 2], acc[4 * g4 + 3]);
#pragma unroll
                for (int g = 0; g < 16; ++g) *(bf16_t*)(L + nqa + (ti0 + crow(g, h)) * 128 + (tj0 + r) * 2) = f2bf(acc[g]);
            }
            __syncthreads();
        }
    }
    {
        const int p = wave >> 2, i0 = ((wave >> 1) & 1) * 32, j0 = (wave & 1) * 32; f32x16 acc; zero16(acc);
        if (p == 0) {
            mm_tile(acc, L + LA_TMT, i0, L + LA_AT, j0, r, h);
#pragma unroll
            for (int g4 = 0; g4 < 4; ++g4) *(u32x2*)(L + LA_M1 + (j0 + r) * 128 + (i0 + 8 * g4 + 4 * h) * 2) = pack4(acc[4 * g4], acc[4 * g4 + 1], acc[4 * g4 + 2], acc[4 * g4 + 3]);
        } else {
            mm_tile(acc, L + LA_NKA, i0, L + LA_TMT, j0, r, h);
#pragma unroll
            for (int g4 = 0; g4 < 4; ++g4) *(u32x2*)(L + LA_W1T + (j0 + r) * 128 + (i0 + 8 * g4 + 4 * h) * 2) = pack4(acc[4 * g4], acc[4 * g4 + 1], acc[4 * g4 + 2], acc[4 * g4 + 3]);
        }
    }
    __syncthreads();
    if (wave < 4) {
        const int i0 = (wave >> 1) * 32, j0 = (wave & 1) * 32; f32x16 acc; zero16(acc);
        mm_tile(acc, L + LA_W1T, i0, L + LA_VT, j0, r, h);
#pragma unroll
        for (int g4 = 0; g4 < 4; ++g4) *(u32x2*)(L + LA_Z1 + (j0 + r) * 128 + (i0 + 8 * g4 + 4 * h) * 2) = pack4(acc[4 * g4], acc[4 * g4 + 1], acc[4 * g4 + 2], acc[4 * g4 + 3]);
    }
    __syncthreads();
    {
        const int p = wave >> 1, i0 = (wave & 1) * 32;
        bf16_t* GM3 = (bf16_t*)(ws + WS_RW + RW_M3) + (size_t)unit * 4096; bf16_t* GM2 = (bf16_t*)(ws + WS_RW + RW_M2) + (size_t)unit * 4096; bf16_t* GZ5 = (bf16_t*)(ws + WS_RW + RW_Z5) + (size_t)unit * 4096;
        float* YO = (float*)(ws + WS_BUFB) + (size_t)dir * NZ * 256;
#pragma unroll
        for (int jt = 0; jt < 2; ++jt) {
            const int j0 = jt * 32; f32x16 acc; zero16(acc);
            if (p == 0) {
                mm_tile(acc, L + LA_M1, i0, L + LA_NBRT, j0, r, h);
#pragma unroll
                for (int g4 = 0; g4 < 4; ++g4) { const int tt = j0 + r, kq = i0 + 8 * g4 + 4 * h; float rv[4]; unpack4(*(const u32x2*)(L + LA_RN + tt * 128 + kq * 2), rv);
                    *(u32x2*)(GM2 + tt * 64 + kq) = pack4(acc[4 * g4] + rv[0], acc[4 * g4 + 1] + rv[1], acc[4 * g4 + 2] + rv[2], acc[4 * g4 + 3] + rv[3]); }
            } else if (p == 1) {
                mm_tile(acc, L + LA_NBRT, i0, L + LA_Z1, j0, r, h); mm_tile(acc, L + LA_NKRT, i0, L + LA_VT, j0, r, h);
#pragma unroll
                for (int g = 0; g < 16; ++g) { const int tt = i0 + crow(g, h); YO[(size_t)(b * TZ + rw_tok(dir, ch * RC + tt)) * 256 + hd * 64 + j0 + r] = acc[g]; }
            } else if (p == 2) {
                mm_tile(acc, L + LA_M1, i0, L + LA_BHT, j0, r, h);
#pragma unroll
                for (int g4 = 0; g4 < 4; ++g4) *(u32x2*)(GM3 + (j0 + r) * 64 + i0 + 8 * g4 + 4 * h) = pack4(acc[4 * g4], acc[4 * g4 + 1], acc[4 * g4 + 2], acc[4 * g4 + 3]);
            } else {
                mm_tile(acc, L + LA_BHT, i0, L + LA_Z1, j0, r, h); mm_tile(acc, L + LA_KHT, i0, L + LA_VT, j0, r, h);
#pragma unroll
                for (int g4 = 0; g4 < 4; ++g4) *(u32x2*)(GZ5 + (j0 + r) * 64 + i0 + 8 * g4 + 4 * h) = pack4(acc[4 * g4], acc[4 * g4 + 1], acc[4 * g4 + 2], acc[4 * g4 + 3]);
            }
        }
    }
}
DI void phase_rwkv_chunks(const Ctx& c, int l) {
    for (int u = blockIdx.x; u < 16 * RNC; u += gridDim.x) phase_rwkv_chunk_unit(c, l, u);
}
DI bf16x8 pack8(const f32x16& x, int s) {
    u32x4 p; p.x = pack2(x[8 * s], x[8 * s + 1]); p.y = pack2(x[8 * s + 2], x[8 * s + 3]); p.z = pack2(x[8 * s + 4], x[8 * s + 5]); p.w = pack2(x[8 * s + 6], x[8 * s + 7]);
    return __builtin_bit_cast(bf16x8, p);
}
DI bf16x8 ldfrag(const bf16_t* rowp, int s, int h) {
    const u32x2 lo = *(const u32x2*)(rowp + 16 * s + 4 * h), hi = *(const u32x2*)(rowp + 16 * s + 8 + 4 * h);
    u32x4 v; v.x = lo.x; v.y = lo.y; v.z = hi.x; v.w = hi.y; return __builtin_bit_cast(bf16x8, v);
}
constexpr int SQ_PITCH = 144, SQ_MAT = 64 * SQ_PITCH;
constexpr int SQA_M3 = 0, SQA_Z5 = SQ_MAT, SQA_P63 = 2 * SQ_MAT, SQA_BYTES = SQA_P63 + 256;
constexpr int SQB_M2 = 0, SQB_Y = SQ_MAT, SQB_BYTES = SQB_Y + 64 * 64 * 4;
constexpr int SQ_A0 = 0, SQ_B0 = 2 * SQA_BYTES, SQ_XB = SQ_B0 + 2 * SQB_BYTES;
DI bf16x8 ldfrag_l(const unsigned char* rowp, int s, int h) {
    const u32x2 lo = *(const u32x2*)(rowp + (16 * s + 4 * h) * 2), hi = *(const u32x2*)(rowp + (16 * s + 8 + 4 * h) * 2);
    u32x4 v; v.x = lo.x; v.y = lo.y; v.z = hi.x; v.w = hi.y; return __builtin_bit_cast(bf16x8, v);
}
struct SqRegsA { u32x4 m3[2], z5[2], p63; };
struct SqRegsB { u32x4 m2[2], y[4]; };
DI void sqa_gload(const Ctx& c, size_t unit, int lt, SqRegsA& g) {
    const unsigned char* g3 = c.ws + WS_RW + RW_M3 + unit * 8192; const unsigned char* g5 = c.ws + WS_RW + RW_Z5 + unit * 8192;
#pragma unroll
    for (int i = 0; i < 2; ++i) { const int id = lt + i * 256; g.m3[i] = *(const u32x4*)(g3 + id * 16); g.z5[i] = *(const u32x4*)(g5 + id * 16); }
    if (lt < 16) g.p63 = *(const u32x4*)(c.ws + WS_RW + RW_P63 + unit * 256 + lt * 16);
}
DI void sqa_lstore(unsigned char* st, int lt, const SqRegsA& g) {
#pragma unroll
    for (int i = 0; i < 2; ++i) { const int id = lt + i * 256, row = id >> 3, part = id & 7;
        *(u32x4*)(st + SQA_M3 + row * SQ_PITCH + part * 16) = g.m3[i]; *(u32x4*)(st + SQA_Z5 + row * SQ_PITCH + part * 16) = g.z5[i]; }
    if (lt < 16) *(u32x4*)(st + SQA_P63 + lt * 16) = g.p63;
}
DI void sqb_gload(const Ctx& c, size_t unit, const float* YO, int dir, int ch, int lt, SqRegsB& g) {
    const unsigned char* g2 = c.ws + WS_RW + RW_M2 + unit * 8192;
#pragma unroll
    for (int i = 0; i < 2; ++i) g.m2[i] = *(const u32x4*)(g2 + (lt + i * 256) * 16);
#pragma unroll
    for (int i = 0; i < 4; ++i) { const int id = lt + i * 256; g.y[i] = *(const u32x4*)(YO + (size_t)rw_tok(dir, ch * RC + (id >> 4)) * 256 + (id & 15) * 4); }
}
DI void sqb_lstore(unsigned char* st, int lt, const SqRegsB& g) {
#pragma unroll
    for (int i = 0; i < 2; ++i) { const int id = lt + i * 256; *(u32x4*)(st + SQB_M2 + (id >> 3) * SQ_PITCH + (id & 7) * 16) = g.m2[i]; }
#pragma unroll
    for (int i = 0; i < 4; ++i) { const int id = lt + i * 256; *(u32x4*)(st + SQB_Y + (id >> 4) * 256 + (id & 15) * 16) = g.y[i]; }
}
DI void sqb_store_y(float* YO, int dir, int ch, const unsigned char* st, int lt) {
#pragma unroll
    for (int i = 0; i < 4; ++i) { const int id = lt + i * 256; *(u32x4*)(YO + (size_t)rw_tok(dir, ch * RC + (id >> 4)) * 256 + (id & 15) * 4) = *(const u32x4*)(st + SQB_Y + (id >> 4) * 256 + (id & 15) * 16); }
}
DI void phase_rwkv_seq_block(const Ctx& c, int l, int chain) {
    unsigned char* L = c.smem; const int lane = c.lane, wave = c.wave, r = lane & 31, h = lane >> 5;
    const int dir = chain & 1, hd = (chain >> 1) & 3, b = chain >> 3, lt = c.tid - 256, vh = wave & 1;
    const size_t unit0 = (size_t)chain * RNC;
    __syncthreads();
    if (wave >= 4) {
        float* YO = (float*)(c.ws + WS_BUFB) + (size_t)dir * NZ * 256 + (size_t)b * TZ * 256 + hd * 64;
        SqRegsA ga; SqRegsB gb;
        sqa_gload(c, unit0, lt, ga); sqa_lstore(L + SQ_A0, lt, ga); sqa_gload(c, unit0 + 1, lt, ga); sqb_gload(c, unit0, YO, dir, 0, lt, gb);
        __syncthreads();
#pragma unroll 1
        for (int ch = 0; ch <= RNC; ++ch) {
            unsigned char* sb = L + SQ_B0 + (ch & 1) * SQB_BYTES;
            if (ch >= 2) sqb_store_y(YO, dir, ch - 2, sb, lt);
            if (ch < RNC) sqb_lstore(sb, lt, gb);
            if (ch + 1 < RNC) { sqb_gload(c, unit0 + ch + 1, YO, dir, ch + 1, lt, gb); sqa_lstore(L + SQ_A0 + ((ch + 1) & 1) * SQA_BYTES, lt, ga); }
            if (ch + 2 < RNC) sqa_gload(c, unit0 + ch + 2, lt, ga);
            __syncthreads();
        }
        sqb_store_y(YO, dir, RNC - 1, L + SQ_B0 + ((RNC - 1) & 1) * SQB_BYTES, lt);
    } else if (wave < 2) {
        f32x16 x[2]; zero16(x[0]); zero16(x[1]);
        __syncthreads();
#pragma unroll 1
        for (int ch = 0; ch <= RNC; ++ch) {
            if (ch < RNC) {
                const unsigned char* st = L + SQ_A0 + (ch & 1) * SQA_BYTES;
                unsigned char* xbuf = L + SQ_XB + ((ch & 1) * 2 + vh) * 4096 + lane * 16;
                bf16x8 xb[4];
#pragma unroll
                for (int s = 0; s < 4; ++s) { xb[s] = pack8(x[s >> 1], s & 1); *(bf16x8*)(xbuf + s * 1024) = xb[s]; }
                f32x16 xn0, xn1;
#pragma unroll
                for (int i = 0; i < 2; ++i) {
                    f32x16 xa;
#pragma unroll
                    for (int g4 = 0; g4 < 4; ++g4) {
                        float z5[4]; unpack4(*(const u32x2*)(st + SQA_Z5 + (vh * 32 + r) * SQ_PITCH + (32 * i + 8 * g4 + 4 * h) * 2), z5);
                        const float4 p4 = *(const float4*)(st + SQA_P63 + (32 * i + 8 * g4 + 4 * h) * 4);
                        xa[4 * g4] = fmaf(p4.x, x[i][4 * g4], z5[0]); xa[4 * g4 + 1] = fmaf(p4.y, x[i][4 * g4 + 1], z5[1]);
                        xa[4 * g4 + 2] = fmaf(p4.z, x[i][4 * g4 + 2], z5[2]); xa[4 * g4 + 3] = fmaf(p4.w, x[i][4 * g4 + 3], z5[3]);
                    }
#pragma unroll
                    for (int s = 0; s < 4; ++s) xa = __builtin_amdgcn_mfma_f32_32x32x16_bf16(ldfrag_l(st + SQA_M3 + (32 * i + r) * SQ_PITCH, s, h), xb[s], xa, 0, 0, 0);
                    if (i == 0) xn0 = xa; else xn1 = xa;
                }
                x[0] = xn0; x[1] = xn1;
            }
            __syncthreads();
        }
    } else {
        __syncthreads();
#pragma unroll 1
        for (int ch = 0; ch <= RNC; ++ch) {
            if (ch >= 1) {
                const int cy = ch - 1;
                unsigned char* st = L + SQ_B0 + (cy & 1) * SQB_BYTES;
                const unsigned char* xbuf = L + SQ_XB + ((cy & 1) * 2 + vh) * 4096 + lane * 16;
                bf16x8 xb[4];
#pragma unroll
                for (int s = 0; s < 4; ++s) xb[s] = *(const bf16x8*)(xbuf + s * 1024);
#pragma unroll
                for (int i = 0; i < 2; ++i) {
                    f32x16 ya;
#pragma unroll
                    for (int g = 0; g < 16; ++g) ya[g] = *((const float*)(st + SQB_Y) + (32 * i + crow(g, h)) * 64 + vh * 32 + r);
#pragma unroll
                    for (int s = 0; s < 4; ++s) ya = __builtin_amdgcn_mfma_f32_32x32x16_bf16(ldfrag_l(st + SQB_M2 + (32 * i + r) * SQ_PITCH, s, h), xb[s], ya, 0, 0, 0);
#pragma unroll
                    for (int g = 0; g < 16; ++g) *((float*)(st + SQB_Y) + (32 * i + crow(g, h)) * 64 + vh * 32 + r) = ya[g];
                }
            }
            __syncthreads();
        }
    }
}
DI void phase_mixers2(const Ctx& c, int l) {
    const int G = gridDim.x, bid = blockIdx.x;
    if (G >= 128) {
        if (bid < 16) phase_rwkv_seq_block(c, l, bid);
        else for (int u = bid - 16; u < 2 * S5N * 4; u += G - 16) phase_s5_final_unit<false>(c, l, u);
    } else {
        for (int u = bid; u < 16; u += G) phase_rwkv_seq_block(c, l, u);
        for (int u = bid; u < 2 * S5N * 4; u += G) phase_s5_final_unit<false>(c, l, u);
    }
}

DI void phase_post(const Ctx& c, int l) {
    unsigned char* ws = c.ws; const int lane = c.lane;
    const float* YF = (const float*)(ws + WS_BUFB); const float* YB = YF + (size_t)NZ * 256;
    const bf16_t* RB = (const bf16_t*)(ws + WS_EXPW + MX_RB); const bf16_t* VB = (const bf16_t*)(ws + WS_EXPW + MX_VB);
    const bf16_t* SKD = (const bf16_t*)(ws + WS_P + P_PR) + (size_t)4 * NZ * 256; const bf16_t* GG = (const bf16_t*)(ws + WS_MISC + MS_GG);
    bf16_t* Ycat = (bf16_t*)(ws + WS_BUFA);
    const float* r_k = c.in[21] + l * 256; const float* lg = c.in[22] + l * 256; const float* lb = c.in[23] + l * 256;
    for (int z = blockIdx.x * 8 + c.wave; z < NZ; z += gridDim.x * 8) {
        const size_t o = (size_t)z * 256 + lane * 4;
        const float4 yf = *(const float4*)(YF + o), yb = *(const float4*)(YB + o);
        const float y0 = yf.x + yb.x, y1 = yf.y + yb.y, y2 = yf.z + yb.z, y3 = yf.w + yb.w;
        const float mean = sum16(y0 + y1 + y2 + y3) * (1.f / 64.f);
        const float d0 = y0 - mean, d1 = y1 - mean, d2 = y2 - mean, d3 = y3 - mean;
        const float var = sum16(d0 * d0 + d1 * d1 + d2 * d2 + d3 * d3) * (1.f / 64.f);
        const float rs = rsqrtf(var + 64e-5f);
        float r[4], v[4], k0[4], k1[4], gg[4];
        unpack4(*(const u32x2*)(RB + o), r); unpack4(*(const u32x2*)(VB + o), v); unpack4(*(const u32x2*)(SKD + o), k0); unpack4(*(const u32x2*)(SKD + (size_t)NZ * 256 + o), k1);
        unpack4(*(const u32x2*)(GG + o), gg);
        const float4 rk = *(const float4*)(r_k + lane * 4), g4 = *(const float4*)(lg + lane * 4), b4 = *(const float4*)(lb + lane * 4);
        const float bs = sum16(r[0] * (k0[0] + k1[0]) * rk.x + r[1] * (k0[1] + k1[1]) * rk.y + r[2] * (k0[2] + k1[2]) * rk.z + r[3] * (k0[3] + k1[3]) * rk.w);
        *(u32x2*)(Ycat + (size_t)z * D + 256 + lane * 4) = pack4((d0 * rs * g4.x + b4.x + bs * v[0]) * gg[0], (d1 * rs * g4.y + b4.y + bs * v[1]) * gg[1],
                                                                (d2 * rs * g4.z + b4.z + bs * v[2]) * gg[2], (d3 * rs * g4.w + b4.w + bs * v[3]) * gg[3]);
    }
    {
        const bf16_t* ZG = (const bf16_t*)(ws + WS_MISC + MS_ZG); const bf16_t* W = (const bf16_t*)(ws + WS_WSM + OFF_GLUT + l * SZ_GLUT);
        const float* gb = c.in[33] + l * 256;
        for (int u = blockIdx.x; u < (NZ / 256) * 2; u += gridDim.x) {
            const int mt = u / 2, nt = u % 2, r0 = mt * 256, c0 = nt * 128;
            gemm_tile<4, 0>(c, 256, [&](int i) { return ZG + (size_t)(r0 + i) * 256; }, [&](int i) { return W + (size_t)(c0 + i) * 256; }, NoHook(),
                [&](f32x4 (&acc)[4][4], int wr, int wc, int fr, int fq) {
#pragma unroll
                    for (int n = 0; n < 4; ++n) {
                        const int col = c0 + wc + n * 16 + fq * 4; const float4 bb = *(const float4*)(gb + col);
#pragma unroll
                        for (int m = 0; m < 4; ++m) {
                            const int row = r0 + wr + m * 16 + fr; const f32x4 v = acc[m][n];
                            float zg[4]; unpack4(*(const u32x2*)(ZG + (size_t)row * 256 + col), zg);
                            *(u32x2*)(Ycat + (size_t)row * D + 512 + col) = pack4(zg[0] * sigmoidf_(v[0] + bb.x), zg[1] * sigmoidf_(v[1] + bb.y), zg[2] * sigmoidf_(v[2] + bb.z), zg[3] * sigmoidf_(v[3] + bb.w));
                        }
                    }
                });
        }
    }
}

DI bool skip_mt(int l, int mt) { return l == NL - 1 && (mt % 33) == 0; }
DI void phase_merge1(const Ctx& c, int l) {
    const bf16_t* Ycat = (const bf16_t*)(c.ws + WS_BUFA); const bf16_t* W = (const bf16_t*)(c.ws + WS_WSM + OFF_WBT + l * SZ_WBT);
    const bf16_t* GT = (const bf16_t*)(c.ws + WS_GT); bf16_t* MG = (bf16_t*)(c.ws + WS_BUFB);
    if (blockIdx.x == 0 && c.tid < 32) ((unsigned*)(c.ws + WS_CTL))[CW_CNT + l * 32 + c.tid] = 0u;
    for (int u = blockIdx.x; u < (NZ / 256) * 8; u += gridDim.x) {
        const int mt = u / 8, nt = u % 8, r0 = mt * 256, c0 = nt * 128;
        if (skip_mt(l, mt)) continue;
        f32x4 macc[4][4];
#pragma unroll
        for (int m = 0; m < 4; ++m)
#pragma unroll
            for (int n = 0; n < 4; ++n) macc[m][n] = (f32x4){0.f, 0.f, 0.f, 0.f};
        gemm_tile<4, 256>(c, 1024, [&](int i) { return Ycat + (size_t)(r0 + i) * D; }, [&](int i) { return W + (size_t)(c0 + i) * D; },
            [&](f32x4 (&acc)[4][4], int seg, int wr, int wc, int fr, int fq) {
#pragma unroll
                for (int m = 0; m < 4; ++m)
#pragma unroll
                    for (int n = 0; n < 4; ++n) {
                        float g[4]; unpack4(*(const u32x2*)(GT + (size_t)(r0 + wr + m * 16 + fr) * 4096 + seg * 1024 + c0 + wc + n * 16 + fq * 4), g);
                        macc[m][n][0] += g[0] * acc[m][n][0]; macc[m][n][1] += g[1] * acc[m][n][1]; macc[m][n][2] += g[2] * acc[m][n][2]; macc[m][n][3] += g[3] * acc[m][n][3];
                        acc[m][n] = (f32x4){0.f, 0.f, 0.f, 0.f};
                    }
            },
            [&](f32x4 (&)[4][4], int wr, int wc, int fr, int fq) {
#pragma unroll
                for (int m = 0; m < 4; ++m)
#pragma unroll
                    for (int n = 0; n < 4; ++n)
                        *(u32x2*)(MG + (size_t)(r0 + wr + m * 16 + fr) * D + c0 + wc + n * 16 + fq * 4) = pack4(macc[m][n][0], macc[m][n][1], macc[m][n][2], macc[m][n][3]);
            });
    }
}
struct EpiMerge2 {
    static constexpr bool PERM = false, AFTER_DRAIN = false;
    float* H; const float* modv; int l;
    DI void operator()(const pg8::f32x4 (&acc)[2][2][4][2], const pg8::Unit& u, int wr, int wc, int fr, int fq) const {
        if (skip_mt(l, u.pm)) return;
        const int sel = (u.pm % 33) == 0 ? 2 : u.pm / 33;
        const int row0 = u.pm * 256 + wr * 64 + fr, col0 = u.pn * 256 + wc * 32 + 4 * fq;
#pragma unroll
        for (int bj = 0; bj < 2; ++bj)
#pragma unroll
            for (int n = 0; n < 2; ++n) {
                const int col = col0 + bj * 128 + n * 16; const float4 m2 = *(const float4*)(modv + ((size_t)l * 3 + sel) * 6144 + 2 * 1024 + col);
#pragma unroll
                for (int ai = 0; ai < 2; ++ai)
#pragma unroll
                    for (int m = 0; m < 4; ++m) {
                        float4* hp = (float4*)(H + (size_t)(row0 + ai * 128 + m * 16) * D + col); float4 hv = *hp; const pg8::f32x4 v = acc[ai][bj][m][n];
                        hv.x += m2.x * v[0]; hv.y += m2.y * v[1]; hv.z += m2.z * v[2]; hv.w += m2.w * v[3]; *hp = hv;
                    }
            }
    }
};
struct LatOrder {
    int G, c;
    DI bool next(int i, pg8::Unit& u) const { const int L = i * G + c; if (L >= 256) return false; const int pl = L >> 2; u.pm = (pl >> 5) * 33 + 1 + (pl & 31); u.pn = L & 3; return true; }
    DI void a_ready(const pg8::Unit&) const {}
    DI void done(const pg8::Unit&) const {}
};
DI void phase_merge2(const Ctx& c, int l) {
    EpiMerge2 E; E.H = (float*)(c.ws + WS_H); E.modv = (const float*)(c.ws + WS_WSM + OFF_MODV); E.l = l;
    pg8::Gemm g{(const bf16_t*)(c.ws + WS_BUFB), (const bf16_t*)(c.ws + WS_WSM + OFF_WOUTT + l * SZ_WOUTT), NZ, 1024, 1024, 1024, 1024};
    __syncthreads();
    if (l == NL - 1) {
        LatOrder S; S.G = (int)gridDim.x; S.c = (int)blockIdx.x;
        pg8::gemm_phase<EpiMerge2, LatOrder, false>((PG8_LAS unsigned char*)c.smem, g, S, E, nullptr, c.tid);
    } else {
        pg8::StaticOrder S; S.init(NZ, 1024, (int)gridDim.x, (int)blockIdx.x);
        pg8::gemm_phase<EpiMerge2, pg8::StaticOrder, false>((PG8_LAS unsigned char*)c.smem, g, S, E, nullptr, c.tid);
    }
}

constexpr int RT_PITCH = 68;
constexpr int RT_RED_W = 8 * 4 * RT_PITCH;
DI void phase_norm2_route(const Ctx& c, int l) {
    unsigned char* ws = c.ws; const int lane = c.lane, wave = c.wave, tid = c.tid;
    const float* modv = (const float*)(ws + WS_WSM + OFF_MODV); const float* H = (const float*)(ws + WS_H);
    bf16_t* XN = (bf16_t*)(ws + WS_BUFA); const float* g2 = c.in[7] + l * 1024;
    const float* rwt = (const float*)(ws + WS_WSM + OFF_RWT) + (size_t)l * 36 * 1024;
    const float* bg = c.in[42] + l * 4; const float* be = c.in[44] + l * 32;
    unsigned* cnt = (unsigned*)(ws + WS_CTL) + CW_CNT + l * 32;
    int* list = (int*)(ws + WS_GT + GT_LIST); float* lw = (float*)(ws + WS_GT + GT_LW);
    float* red = (float*)c.smem + wave * RT_RED_W;
    float* lgs = (float*)c.smem + 8 * RT_RED_W + wave * 8 * 40;
    int* hist = (int*)((float*)c.smem + 8 * RT_RED_W + 8 * 8 * 40);
    int* sel = hist + 64;
    float* selw = (float*)(sel + 128);
    const int ngroups = (l == NL - 1) ? (NB * SEQ / 64) : (NZ / 64);
    for (int grp = blockIdx.x; grp < ngroups; grp += gridDim.x) {
        __syncthreads();
        if (tid < 32) hist[tid] = 0;
        __syncthreads();
        float x[8][16];
#pragma unroll
        for (int i = 0; i < 8; ++i) {
            const int rl = wave * 8 + i; int row;
            if (l == NL - 1) { const int rr = grp * 64 + rl; row = (rr / SEQ) * TZ + CTX + (rr % SEQ); } else row = grp * 64 + rl;
#pragma unroll
            for (int q = 0; q < 4; ++q) { const float4 v = *(const float4*)(H + (size_t)row * D + q * 256 + lane * 4); x[i][q * 4] = v.x; x[i][q * 4 + 1] = v.y; x[i][q * 4 + 2] = v.z; x[i][q * 4 + 3] = v.w; }
        }
#pragma unroll
        for (int i = 0; i < 8; ++i) {
            const int rl = wave * 8 + i; int row;
            if (l == NL - 1) { const int rr = grp * 64 + rl; row = (rr / SEQ) * TZ + CTX + (rr % SEQ); } else row = grp * 64 + rl;
            const int b = row / TZ, s = row % TZ, sel3 = s < CTX ? 2 : b;
            float ss = 0.f;
#pragma unroll
            for (int j = 0; j < 16; ++j) ss += x[i][j] * x[i][j];
            ss = wave_sum(ss);
            const float rs = rsqrtf(ss * (1.f / 1024.f) + 1e-6f);
#pragma unroll
            for (int q = 0; q < 4; ++q) {
                const int col = q * 256 + lane * 4;
                const float4 g = *(const float4*)(g2 + col), m3 = *(const float4*)(modv + ((size_t)l * 3 + sel3) * 6144 + 3 * 1024 + col), m4 = *(const float4*)(modv + ((size_t)l * 3 + sel3) * 6144 + 4 * 1024 + col);
                x[i][q * 4] = x[i][q * 4] * rs * g.x * (1.f + m4.x) + m3.x; x[i][q * 4 + 1] = x[i][q * 4 + 1] * rs * g.y * (1.f + m4.y) + m3.y;
                x[i][q * 4 + 2] = x[i][q * 4 + 2] * rs * g.z * (1.f + m4.z) + m3.z; x[i][q * 4 + 3] = x[i][q * 4 + 3] * rs * g.w * (1.f + m4.w) + m3.w;
                *(u32x2*)(XN + (size_t)row * D + col) = pack4(x[i][q * 4], x[i][q * 4 + 1], x[i][q * 4 + 2], x[i][q * 4 + 3]);
            }
        }
#pragma unroll 1
        for (int ec = 0; ec < 9; ++ec) {
#pragma unroll
            for (int ee = 0; ee < 4; ++ee) {
                const int e = ec * 4 + ee;
                float4 w[4];
#pragma unroll
                for (int q = 0; q < 4; ++q) w[q] = *(const float4*)(rwt + (size_t)e * 1024 + q * 256 + lane * 4);
#pragma unroll
                for (int i = 0; i < 8; ++i) {
                    float a = 0.f;
#pragma unroll
                    for (int q = 0; q < 4; ++q) a += x[i][q * 4] * w[q].x + x[i][q * 4 + 1] * w[q].y + x[i][q * 4 + 2] * w[q].z + x[i][q * 4 + 3] * w[q].w;
                    red[(i * 4 + ee) * RT_PITCH + lane] = a;
                }
            }
            __builtin_amdgcn_wave_barrier();
            if (lane < 32) {
                float s0 = 0.f, s1 = 0.f, s2 = 0.f, s3 = 0.f;
#pragma unroll
                for (int q = 0; q < 16; ++q) { const float4 v = *(const float4*)(red + lane * RT_PITCH + q * 4); s0 += v.x; s1 += v.y; s2 += v.z; s3 += v.w; }
                const int e = ec * 4 + (lane & 3);
                lgs[(lane >> 2) * 40 + e] = (s0 + s1) + (s2 + s3) + (e < 4 ? bg[e] : be[e - 4]);
            }
            __builtin_amdgcn_wave_barrier();
        }
        if (lane < 8) {
            const float* lg = lgs + lane * 40;
            float gm = lg[0]; int gsel = 0;
#pragma unroll
            for (int g = 1; g < 4; ++g) if (lg[g] > gm) { gm = lg[g]; gsel = g; }
            const float gs = __expf(lg[0] - gm) + __expf(lg[1] - gm) + __expf(lg[2] - gm) + __expf(lg[3] - gm);
            const float pg = 1.f / gs;
            float l1 = -1e30f, l2 = -1e30f; int e1 = 0, e2 = 0;
#pragma unroll
            for (int j = 0; j < 8; ++j) {
                const float v = lg[4 + gsel * 8 + j]; const int e = gsel * 8 + j;
                if (v > l1) { l2 = l1; e2 = e1; l1 = v; e1 = e; } else if (v > l2) { l2 = v; e2 = e; }
            }
            const float tt = __expf(l2 - l1), w1 = pg / (1.f + tt), w2 = pg * tt / (1.f + tt);
            const int rl = wave * 8 + lane;
            const int r1 = atomicAdd(&hist[e1], 1), r2 = atomicAdd(&hist[e2], 1);
            sel[rl * 2] = e1 | (r1 << 8); sel[rl * 2 + 1] = e2 | (r2 << 8); selw[rl * 2] = w1; selw[rl * 2 + 1] = w2;
        }
        __syncthreads();
        if (tid < 32) hist[32 + tid] = (int)atomicAdd(&cnt[tid], (unsigned)hist[tid]);
        __syncthreads();
        if (tid < 128) {
            const int rl = tid >> 1, j = tid & 1, sv = sel[tid], e = sv & 255, rk = sv >> 8;
            int row;
            if (l == NL - 1) { const int rr = grp * 64 + rl; row = (rr / SEQ) * TZ + CTX + (rr % SEQ); } else row = grp * 64 + rl;
            const size_t pos = (size_t)e * MOE_CAP + hist[32 + e] + rk;
            list[pos] = row * 2 + j; lw[pos] = selw[tid];
        }
    }
    phase_expert_convert(c, l);
}

DI void moe_prefix(const Ctx& c, int l, int* tiles  , int* cnts  ) {
    __syncthreads();
    if (c.tid == 0) {
        const unsigned* cnt = (const unsigned*)(c.ws + WS_CTL) + CW_CNT + l * 32; int acc = 0;
        for (int e = 0; e < 32; ++e) { const int n = (int)__hip_atomic_load(cnt + e, __ATOMIC_RELAXED, __HIP_MEMORY_SCOPE_AGENT); cnts[e] = n; tiles[e] = acc; acc += (n + 127) / 128; }
        tiles[32] = acc;
    }
    __syncthreads();
}
DI void phase_moe1(const Ctx& c, int l) {
    unsigned char* ws = c.ws;
    int* tiles = (int*)(c.smem + 120 * 1024); int* cnts = tiles + 40;
    moe_prefix(c, l, tiles, cnts);
    const bf16_t* XN = (const bf16_t*)(ws + WS_BUFA); bf16_t* HM = (bf16_t*)(ws + WS_GT + GT_HM); const int* list = (const int*)(ws + WS_GT + GT_LIST);
    const int nt_total = tiles[32];
    for (int u = blockIdx.x; u < nt_total * 4; u += gridDim.x) {
        const int mtg = u >> 2, nt = u & 3;
        int e = 0;
        for (int k = 1; k < 32; ++k) if (tiles[k] <= mtg) e = k;
        const int mt = mtg - tiles[e], n_e = cnts[e];
        const int* le = list + (size_t)e * MOE_CAP;
        const bf16_t* W = (const bf16_t*)(ws + WS_EXPW + (size_t)e * SZ_WGU);
        gemm_tile<2, 0>(c, 1024,
            [&](int i) { int p = mt * 128 + i; if (p >= n_e) p = n_e - 1; return XN + (size_t)(le[p] >> 1) * D; },
            [&](int i) { return W + (size_t)(nt * 256 + i) * D; }, NoHook(),
            [&](f32x4 (&acc)[4][4], int wr, int wc, int fr, int fq) {
#pragma unroll
                for (int np = 0; np < 2; ++np) {
                    const int hc = (nt * 256 + wc + np * 32) / 2 + fq * 4;
#pragma unroll
                    for (int m = 0; m < 4; ++m) {
                        const int p = mt * 128 + wr + m * 16 + fr;
                        const f32x4 g = acc[m][np * 2], uu = acc[m][np * 2 + 1];
                        *(u32x2*)(HM + ((size_t)mtg * 128 + wr + m * 16 + fr) * 512 + hc) = pack4(siluf_(g[0]) * uu[0], siluf_(g[1]) * uu[1], siluf_(g[2]) * uu[2], siluf_(g[3]) * uu[3]);
                        (void)p;
                    }
                }
            });
    }
}
DI void phase_moe2(const Ctx& c, int l) {
    unsigned char* ws = c.ws;
    int* tiles = (int*)(c.smem + 120 * 1024); int* cnts = tiles + 40;
    moe_prefix(c, l, tiles, cnts);
    const bf16_t* HM = (const bf16_t*)(ws + WS_GT + GT_HM); const int* list = (const int*)(ws + WS_GT + GT_LIST); const float* lw = (const float*)(ws + WS_GT + GT_LW);
    bf16_t* Y2 = (bf16_t*)(ws + WS_P);
    const int nt_total = tiles[32];
    for (int u = blockIdx.x; u < nt_total * 4; u += gridDim.x) {
        const int mtg = u >> 2, nt = u & 3;
        int e = 0;
        for (int k = 1; k < 32; ++k) if (tiles[k] <= mtg) e = k;
        const int mt = mtg - tiles[e], n_e = cnts[e];
        const int* le = list + (size_t)e * MOE_CAP; const float* lwe = lw + (size_t)e * MOE_CAP;
        const bf16_t* W = (const bf16_t*)(ws + WS_EXPW + 32 * SZ_WGU + (size_t)e * SZ_WD);
        gemm_tile<2, 0>(c, 512,
            [&](int i) { return HM + ((size_t)mtg * 128 + i) * 512; },
            [&](int i) { return W + (size_t)(nt * 256 + i) * 512; }, NoHook(),
            [&](f32x4 (&acc)[4][4], int wr, int wc, int fr, int fq) {
#pragma unroll
                for (int m = 0; m < 4; ++m) {
                    const int p = mt * 128 + wr + m * 16 + fr;
                    if (p < n_e) {
                        const int ent = le[p]; const float wt = lwe[p];
                        bf16_t* yrow = Y2 + ((size_t)(ent & 1) * NZ + (ent >> 1)) * D + nt * 256 + wc + fq * 4;
#pragma unroll
                        for (int n = 0; n < 4; ++n) *(u32x2*)(yrow + n * 16) = pack4(wt * acc[m][n][0], wt * acc[m][n][1], wt * acc[m][n][2], wt * acc[m][n][3]);
                    }
                }
            });
    }
}

constexpr int LDS_BYTES = 128 * 1024 + 256;
constexpr int STEPS_PER_LAYER = 12, N_STEPS = 2 + NL * STEPS_PER_LAYER;
#ifndef FUSED
#define FUSED 1
#endif

DI const void* launder_ptr(const void* p) {
    const unsigned long long v = (unsigned long long)p;
    unsigned lo = __builtin_amdgcn_readfirstlane((unsigned)v), hi = __builtin_amdgcn_readfirstlane((unsigned)(v >> 32));
    asm volatile("" : "+s"(lo), "+s"(hi) :: "memory");
    return (const void*)(((unsigned long long)hi << 32) | lo);
}
template <int KIND> DI void run_step(const Ctx& c0, int l) {
#ifdef PHM
    if (!((PHM >> KIND) & 1)) return;
#endif
    Ctx c = c0;
    { int z = 0; asm volatile("" : "+s"(z) :: "memory"); c.in = c0.in + z; c.ws = c0.ws + z; c.out = c0.out + z; }
    { int t = c0.tid; asm volatile("" : "+v"(t)); c.tid = t; c.lane = t & 63; c.wave = __builtin_amdgcn_readfirstlane(t >> 6); }
    if (KIND == 0) phase_prologue(c);
    if (KIND == 1) phase_norm1(c, l);
    if (KIND == 2) phase_inproj(c, l);
    if (KIND == 3) { phase_prep(c, l); for (int u = blockIdx.x; u < 2 * S5N * 4; u += gridDim.x) phase_s5_final_unit<true>(c, l, u); }
    if (KIND == 4) { phase_small_gemms(c, l); phase_s5_carry(c, l); }
    if (KIND == 5) { phase_attention(c, l); phase_rwkv_chunks(c, l); }
    if (KIND == 6) phase_mixers2(c, l);
    if (KIND == 7) phase_post(c, l);
    if (KIND == 8) phase_merge1(c, l);
    if (KIND == 9) phase_merge2(c, l);
    if (KIND == 10) phase_norm2_route(c, l);
    if (KIND == 11) phase_moe1(c, l);
    if (KIND == 12) phase_moe2(c, l);
    if (KIND == 13) phase_final(c);
}

#if !FUSED
template <int KIND> __global__ void __launch_bounds__(NTHR, 2) k_step(Args a) {
    extern __shared__ __attribute__((aligned(16))) unsigned char lds[];
    Ctx c; c.in = a.in; c.out = a.out; c.ws = a.ws; c.smem = lds; c.tid = threadIdx.x; c.lane = threadIdx.x & 63; c.wave = __builtin_amdgcn_readfirstlane(threadIdx.x >> 6);
    run_step<KIND>(c, a.s_lo);
}
template <int KIND> static void launch_step(const Args& a, int grid, hipStream_t stream) {
    static bool attr = false;
    if (!attr) { (void)hipFuncSetAttribute((const void*)k_step<KIND>, hipFuncAttributeMaxDynamicSharedMemorySize, LDS_BYTES); attr = true; }
    hipLaunchKernelGGL(k_step<KIND>, dim3(grid), dim3(NTHR), LDS_BYTES, stream, a);
}
#else
__global__ void __launch_bounds__(NTHR, 2) fwd_kernel(Args a) {
    extern __shared__ __attribute__((aligned(16))) unsigned char lds[];
    Ctx c; c.in = a.in; c.out = a.out; c.ws = a.ws; c.smem = lds; c.tid = threadIdx.x; c.lane = threadIdx.x & 63; c.wave = __builtin_amdgcn_readfirstlane(threadIdx.x >> 6);
    volatile LAS unsigned* xbw = (volatile LAS unsigned*)(lds + LDS_BYTES - 16);
    for (int i = threadIdx.x; i < LDS_BYTES / 16; i += NTHR) ((uint4*)lds)[i] = make_uint4(0u, 0u, 0u, 0u);
    __syncthreads();
    if (threadIdx.x == 0) { xbw[0] = 0u; xbw[1] = 0u; }
    __syncthreads();
    XcdBarrier bar = xcd_barrier_post((unsigned*)(a.ws + WS_CTL) + CW_BAR, xbw);
#ifndef REP_MASK
#define REP_MASK 0
#endif
#define GBAR() do { XcdBarrier bb = bar; int zz = 0; asm volatile("" : "+s"(zz) :: "memory"); bb.bar = bar.bar + zz; xcd_barrier(bb); } while (0)
#define STEP(K, L) do { run_step<K>(c, L); GBAR(); if ((REP_MASK >> K) & 1) { run_step<K>(c, L); GBAR(); } } while (0)
    STEP(0, 0);
    for (int l = 0; l < NL; ++l) {
        STEP(1, l); STEP(2, l); STEP(3, l); STEP(4, l); STEP(5, l); STEP(6, l); STEP(7, l); STEP(8, l); STEP(9, l); STEP(10, l); STEP(11, l); STEP(12, l);
    }
#undef STEP
    run_step<13>(c, 0);
}
#endif

extern "C" void kernel_launch(void* const* d_in, const int* in_sizes, int n_in, void* d_out, int out_size, void* d_ws, size_t ws_size, hipStream_t stream) {
    static int grid = 0;
    if (grid == 0) {
        if (n_in != 49 || out_size != NB * SEQ * D || ws_size < WS_END) { fprintf(stderr, "kernel_launch: unexpected problem (n_in %d out %d ws %zu need %zu)\n", n_in, out_size, ws_size, (size_t)WS_END); grid = -1; return; }
        int dev = 0, cus = 0;
        if (hipGetDevice(&dev) != hipSuccess || hipDeviceGetAttribute(&cus, hipDeviceAttributeMultiprocessorCount, dev) != hipSuccess) { grid = -1; return; }
#if FUSED
        int per_cu = 0;
        if (hipFuncSetAttribute((const void*)fwd_kernel, hipFuncAttributeMaxDynamicSharedMemorySize, LDS_BYTES) != hipSuccess) { fprintf(stderr, "kernel_launch: hipFuncSetAttribute failed\n"); grid = -1; return; }
        if (hipOccupancyMaxActiveBlocksPerMultiprocessor(&per_cu, (const void*)fwd_kernel, NTHR, LDS_BYTES) != hipSuccess || per_cu < 1) { fprintf(stderr, "kernel_launch: occupancy query says %d\n", per_cu); }
        (void)hipGetLastError();
#endif
        grid = cus;
    }
    if (grid < 0) return;
    (void)hipMemsetAsync((char*)d_ws + WS_CTL, 0, CTL_BYTES, stream);
    Args a{};
    for (int i = 0; i < 49; ++i) a.in[i] = (const float*)d_in[i];
    a.out = (float*)d_out; a.ws = (unsigned char*)d_ws;
#if !FUSED
    a.s_lo = 0; a.s_hi = 0; launch_step<0>(a, grid, stream);
    for (int l = 0; l < NL; ++l) {
        a.s_lo = l;
        launch_step<1>(a, grid, stream); launch_step<2>(a, grid, stream); launch_step<3>(a, grid, stream); launch_step<4>(a, grid, stream);
        launch_step<5>(a, grid, stream); launch_step<6>(a, grid, stream); launch_step<7>(a, grid, stream); launch_step<8>(a, grid, stream);
        launch_step<9>(a, grid, stream); launch_step<10>(a, grid, stream); launch_step<11>(a, grid, stream); launch_step<12>(a, grid, stream);
    }
    a.s_lo = 0; launch_step<13>(a, grid, stream);
#else
    a.s_lo = 0; a.s_hi = N_STEPS; hipLaunchKernelGGL(fwd_kernel, dim3(grid), dim3(NTHR), LDS_BYTES, stream, a);
#endif
}
```

```cpp
#include <hip/hip_runtime.h>
#include <stdint.h>
#include <stdio.h>

#define DI __device__ __forceinline__
#define LAS __attribute__((address_space(3)))
typedef unsigned short bf16_t;
typedef short bf16x8 __attribute__((ext_vector_type(8)));
typedef short s16x4 __attribute__((ext_vector_type(4)));
typedef float f32x4 __attribute__((ext_vector_type(4)));
typedef float f32x16 __attribute__((ext_vector_type(16)));
typedef float f32x2 __attribute__((ext_vector_type(2)));
typedef __bf16 bf16x2v __attribute__((ext_vector_type(2)));
typedef unsigned u32x4 __attribute__((ext_vector_type(4)));
typedef unsigned u32x2 __attribute__((ext_vector_type(2)));

constexpr int D = 1024, NB = 2, SEQ = 8192, CTX = 256, TZ = 8448, NZ = 16896, NL = 2;
constexpr int NIN = 6560, NINP = 6656;
constexpr int NTHR = 512;
constexpr float LOG2E = 1.4426950408889634f;

#define XB_TMO      128
#define XB_XCNT(j)  (256  + 64 * (j))
#define XB_XSUB(j)  (1280 + 64 * (j))
#define XB_XGEN(j)  (2304 + 64 * (j))
#define XB_TOP      3328
#define XB_TOPGEN   3392
#define XCD_BAR_WORDS 3456
#define XB_SPIN_CAP (1u << 18)

__device__ __forceinline__ unsigned xb_ld(unsigned* p)              { return __hip_atomic_load(p, __ATOMIC_RELAXED, __HIP_MEMORY_SCOPE_AGENT); }
__device__ __forceinline__ unsigned xb_add(unsigned* p, unsigned v) { return __hip_atomic_fetch_add(p, v, __ATOMIC_RELAXED, __HIP_MEMORY_SCOPE_AGENT); }
__device__ __forceinline__ unsigned xb_xcc_id() { return (unsigned)__builtin_amdgcn_s_getreg((3 << 11) | 20) & 0xFu; }
#define XB_SPIN(cond, bar) do { unsigned _sp = 0; while (cond) { __builtin_amdgcn_s_sleep(1); \
    if ((++_sp & 255u) == 0u) { if (xb_ld(&(bar)[XB_TMO])) break; if (_sp > XB_SPIN_CAP) { atomicAdd(&(bar)[XB_TMO], 1u); break; } } } } while (0)

struct XcdBarrier { unsigned* bar; unsigned x; volatile LAS unsigned* st; };

__device__ __forceinline__ XcdBarrier xcd_barrier_post(unsigned* bar, volatile LAS unsigned* st) {
    XcdBarrier b; b.bar = bar; b.x = xb_xcc_id(); b.st = st;
    if (threadIdx.x == 0) (void)xb_add(&bar[XB_XCNT(b.x)], 1u);
    return b;
}
__device__ __forceinline__ void xcd_barrier_complete(unsigned* bar, unsigned x, unsigned& nloc, unsigned& nx) {
    const unsigned G = gridDim.x * gridDim.y * gridDim.z;
    unsigned sum, cnt, mine, sp = 0u;
    for (;;) {
        sum = 0u; cnt = 0u; mine = 0u;
#pragma unroll
        for (unsigned j = 0; j < 16; ++j) { const unsigned c = xb_ld(&bar[XB_XCNT(j)]); sum += c; cnt += (c > 0u) ? 1u : 0u; mine = (j == x) ? c : mine; }
        if (sum == G) break;
        __builtin_amdgcn_s_sleep(1);
        if ((++sp & 255u) == 0u) { if (xb_ld(&bar[XB_TMO])) break; if (sp > XB_SPIN_CAP) { atomicAdd(&bar[XB_TMO], 1u); break; } }
    }
    nloc = mine > 0u ? mine : 1u; nx = cnt > 0u ? cnt : 1u;
}
__device__ __forceinline__ void xcd_barrier(const XcdBarrier& b) {
    asm volatile("s_waitcnt vmcnt(0)" ::: "memory");
    __syncthreads();
    if (threadIdx.x == 0) {
        unsigned* bar = b.bar;
        __builtin_amdgcn_s_waitcnt(0);
        unsigned nloc = b.st[0], nx = b.st[1];
        if (nloc == 0u) { xcd_barrier_complete(bar, b.x, nloc, nx); b.st[0] = nloc; b.st[1] = nx; }
        const unsigned old = xb_add(&bar[XB_XSUB(b.x)], 1u);
        const unsigned gen = old / nloc;
        if (old + 1u == (gen + 1u) * nloc) {
            __builtin_amdgcn_fence(__ATOMIC_RELEASE, "agent");
            asm volatile("s_waitcnt vmcnt(0)" ::: "memory");
            const unsigned og = xb_add(&bar[XB_TOP], 1u);
            const unsigned tg = og / nx;
            if (og + 1u == (tg + 1u) * nx) xb_add(&bar[XB_TOPGEN], 1u);
            else XB_SPIN(xb_ld(&bar[XB_TOPGEN]) == tg, bar);
            __builtin_amdgcn_fence(__ATOMIC_ACQUIRE, "agent");
            xb_add(&bar[XB_XGEN(b.x)], 1u);
            asm volatile("s_waitcnt vmcnt(0)" ::: "memory");
        } else {
            XB_SPIN(xb_ld(&bar[XB_XGEN(b.x)]) == gen, bar);
            __builtin_amdgcn_fence(__ATOMIC_ACQUIRE, "agent");
            asm volatile("s_waitcnt vmcnt(0)" ::: "memory");
        }
    }
    __syncthreads();
}

DI float bf2f(bf16_t v) { return __uint_as_float((unsigned)v << 16); }
DI unsigned pack2(float a, float b) { f32x2 v = {a, b}; bf16x2v r = __builtin_convertvector(v, bf16x2v); return __builtin_bit_cast(unsigned, r); }
DI bf16_t f2bf(float a) { return (bf16_t)(pack2(a, 0.f) & 0xffffu); }
DI float lo2f(unsigned u) { return __uint_as_float(u << 16); }
DI float hi2f(unsigned u) { return __uint_as_float(u & 0xffff0000u); }
DI float wave_sum(float v) {
#pragma unroll
    for (int m = 32; m >= 1; m >>= 1) v += __shfl_xor(v, m, 64);
    return v;
}
DI float sum16(float v) {
#pragma unroll
    for (int m = 8; m >= 1; m >>= 1) v += __shfl_xor(v, m, 64);
    return v;
}
DI float sigmoidf_(float x) { return 1.f / (1.f + __expf(-x)); }
DI float siluf_(float x) { return x / (1.f + __expf(-x)); }
DI float gelu_tanh(float x) { const float u = 0.7978845608028654f * (x + 0.044715f * x * x * x); return 0.5f * x * (1.f + tanhf(u)); }
DI void unpack4(u32x2 u, float (&f)[4]) { f[0] = lo2f(u.x); f[1] = hi2f(u.x); f[2] = lo2f(u.y); f[3] = hi2f(u.y); }
DI u32x2 pack4(float a, float b, float c, float d) { u32x2 r; r.x = pack2(a, b); r.y = pack2(c, d); return r; }

constexpr size_t algn(size_t x) { return (x + 255) & ~(size_t)255; }
constexpr size_t WS_CTL   = 0;
constexpr size_t CTL_BYTES = 64 * 1024;
constexpr size_t WS_H     = WS_CTL + CTL_BYTES;
constexpr size_t WS_WSM   = WS_H + (size_t)NZ * D * 4;
constexpr size_t SZ_WINT = (size_t)NINP * D * 2, SZ_WUQT = 384 * 256 * 2, SZ_WUKVT = 512 * 128 * 2, SZ_W2T = 512 * 64 * 2, SZ_A2T = 512 * 64 * 2,
                 SZ_G2T = 256 * 128 * 2, SZ_GLUT = 256 * 256 * 2, SZ_WBT = (size_t)D * D * 2, SZ_WOUTT = (size_t)D * D * 2;
constexpr size_t OFF_WINT = 0, OFF_WUQT = OFF_WINT + NL * SZ_WINT, OFF_WUKVT = OFF_WUQT + NL * SZ_WUQT, OFF_W2T = OFF_WUKVT + NL * SZ_WUKVT,
                 OFF_A2T = OFF_W2T + NL * SZ_W2T, OFF_G2T = OFF_A2T + NL * SZ_A2T, OFF_GLUT = OFF_G2T + NL * SZ_G2T, OFF_WBT = OFF_GLUT + NL * SZ_GLUT,
                 OFF_WOUTT = OFF_WBT + NL * SZ_WBT, OFF_MODV = OFF_WOUTT + NL * SZ_WOUTT,
                 OFF_ROPE = OFF_MODV + (size_t)NL * 3 * 6144 * 4,
                 OFF_S5T = OFF_ROPE + (size_t)SEQ * 16 * 2 * 4,
                 OFF_RWT = OFF_S5T + (size_t)NL * 2 * 16 * 64 * 36 * 4,
                 OFF_LAM = OFF_RWT + (size_t)NL * 36 * 1024 * 4,
                 OFF_S5E = OFF_LAM + 256,
                 OFF_S5C = OFF_S5E,
                 WSM_BYTES = algn(OFF_S5E + (size_t)2 * 2 * 16 * 132 * 64 * 2 * 4);
constexpr size_t WS_EXPW  = WS_WSM + WSM_BYTES;
constexpr size_t SZ_WGU = (size_t)1024 * 1024 * 2, SZ_WD = (size_t)1024 * 512 * 2;
constexpr size_t EXPW_BYTES = 32 * (SZ_WGU + SZ_WD);
constexpr size_t SZ_QM = (size_t)NB * 4 * TZ * 96 * 2, SZ_VMT = (size_t)NB * 4 * 64 * TZ * 2, SZ_QD = (size_t)NB * 4 * TZ * 64 * 2, SZ_R256 = (size_t)NZ * 256 * 2;
constexpr size_t MX_QM = 0, MX_KM = MX_QM + SZ_QM, MX_VMT = MX_KM + SZ_QM, MX_QD = MX_VMT + SZ_VMT, MX_KD = MX_QD + SZ_QD, MX_VDT = MX_KD + SZ_QD,
                 MX_RB = MX_VDT + SZ_VMT, MX_KB = MX_RB + SZ_R256, MX_VB = MX_KB + SZ_R256, MX_KKB = MX_VB + SZ_R256, MX_END = MX_KKB + SZ_R256;
static_assert(MX_END <= EXPW_BYTES, "mixer operands must fit the expert-weight region");
constexpr size_t WS_BUFA  = WS_EXPW + EXPW_BYTES;
constexpr size_t WS_BUFB  = WS_BUFA + (size_t)NZ * D * 2;
constexpr size_t WS_P     = WS_BUFB + (size_t)NZ * D * 2;
constexpr size_t P_PM = 0, P_PS = P_PM + (size_t)NZ * 416 * 2, P_PR = P_PS + (size_t)NZ * 256 * 2, P_PD = P_PR + (size_t)NZ * 1024 * 2, P_BYTES = P_PD + (size_t)NZ * 768 * 2;
static_assert((size_t)6 * SZ_R256 <= (size_t)NZ * (1024 + 768) * 2, "scan operands must fit PR|PD");
static_assert((size_t)2 * NZ * D * 2 <= P_BYTES, "the MoE outputs (2 x bf16 [NZ][D]) must fit the P region");
constexpr size_t WS_GT    = WS_P + P_BYTES;
constexpr size_t GT_BYTES = (size_t)NZ * 4096 * 2;
constexpr int MOE_CAP = 33792;
constexpr size_t GT_HM = 0, GT_LIST = GT_HM + (size_t)(33792 + 32 * 128) * 512 * 2, GT_LW = GT_LIST + (size_t)32 * MOE_CAP * 4, GT_END = GT_LW + (size_t)32 * MOE_CAP * 4;
static_assert(GT_END <= GT_BYTES, "MoE scratch must fit the gate region");
constexpr size_t WS_MISC  = WS_GT + GT_BYTES;
constexpr size_t MS_CQN = 0, MS_TW = MS_CQN + (size_t)NZ * 384 * 2, MS_AL = MS_TW + (size_t)NZ * 64 * 2, MS_SG = MS_AL + (size_t)NZ * 64 * 2,
                 MS_GG = MS_SG + (size_t)NZ * 128 * 2, MS_ZG = MS_GG + SZ_R256, MS_END = MS_ZG + SZ_R256;
constexpr size_t WS_RW    = WS_MISC + MS_END;
constexpr int RC = 64, RNC = TZ / RC;
constexpr size_t SZ_RWM = (size_t)16 * RNC * 4096 * 2;
constexpr size_t RW_M3 = 0, RW_M2 = SZ_RWM, RW_Z5 = 2 * SZ_RWM, RW_P63 = 3 * SZ_RWM, RW_END = RW_P63 + (size_t)16 * RNC * 64 * 4;
constexpr size_t WS_END   = WS_RW + RW_END;

constexpr int CW_BAR = 0;
constexpr int CW_CNT = 4096;

struct Args { const float* in[49]; float* out; unsigned char* ws; int s_lo, s_hi; };

struct Ctx {
    const float* const* in; float* out; unsigned char* ws; unsigned char* smem; int tid, lane, wave;
};

template <int WM> struct GCfg { static constexpr int WN = 8 / WM, BM = 64 * WM, BN = 64 * WN, ABYTES = BM * 128, BBYTES = BN * 128, STAGE = ABYTES + BBYTES; };

template <int WM, int SEGK, class ARow, class BRow, class Hook, class Epi>
DI void gemm_tile(const Ctx& c, int K, ARow arow, BRow brow, Hook hook, Epi epi) {
    typedef GCfg<WM> G;
    const int tid = c.tid, lane = c.lane, wave = c.wave;
    const int wm = wave / G::WN, wn = wave % G::WN, fr = lane & 15, fq = lane >> 4;
    unsigned char* smem = c.smem;
    constexpr int NA = G::BM / 64, NBq = G::BN / 64;
    const int r0 = tid >> 3, coff = ((tid & 7) ^ (r0 & 7)) * 8;
    auto stage = [&](int kt, int buf) {
        unsigned char* sa = smem + buf * G::STAGE; unsigned char* sb = sa + G::ABYTES;
#pragma unroll
        for (int i = 0; i < NA; ++i) __builtin_amdgcn_global_load_lds((const unsigned*)(arow(r0 + 64 * i) + coff + kt * 64), (unsigned*)(sa + (tid + i * NTHR) * 16), 16, 0, 0);
#pragma unroll
        for (int i = 0; i < NBq; ++i) __builtin_amdgcn_global_load_lds((const unsigned*)(brow(r0 + 64 * i) + coff + kt * 64), (unsigned*)(sb + (tid + i * NTHR) * 16), 16, 0, 0);
    };
    f32x4 acc[4][4];
#pragma unroll
    for (int m = 0; m < 4; ++m)
#pragma unroll
        for (int n = 0; n < 4; ++n) acc[m][n] = (f32x4){0.f, 0.f, 0.f, 0.f};
    const int T = K / 64;
    __syncthreads();
    stage(0, 0);
    for (int t = 0; t < T; ++t) {
        asm volatile("s_waitcnt vmcnt(0)" ::: "memory");
        __syncthreads();
        if (t + 1 < T) stage(t + 1, (t + 1) & 1);
        const unsigned char* sa = smem + (t & 1) * G::STAGE; const unsigned char* sb = sa + G::ABYTES;
#pragma unroll
        for (int ks = 0; ks < 2; ++ks) {
            bf16x8 af[4], bfr[4];
            const int sl = ((ks * 4 + fq) ^ (fr & 7)) * 16;
#pragma unroll
            for (int m = 0; m < 4; ++m) af[m] = *(const bf16x8*)(sa + (wm * 64 + m * 16 + fr) * 128 + sl);
#pragma unroll
            for (int n = 0; n < 4; ++n) bfr[n] = *(const bf16x8*)(sb + (wn * 64 + n * 16 + fr) * 128 + sl);
#pragma unroll
            for (int m = 0; m < 4; ++m)
#pragma unroll
                for (int n = 0; n < 4; ++n) acc[m][n] = __builtin_amdgcn_mfma_f32_16x16x32_bf16(bfr[n], af[m], acc[m][n], 0, 0, 0);
        }
        if (SEGK > 0) { if (((t + 1) * 64) % (SEGK > 0 ? SEGK : 64) == 0) hook(acc, ((t + 1) * 64) / (SEGK > 0 ? SEGK : 64) - 1, wm * 64, wn * 64, fr, fq); }
    }
    epi(acc, wm * 64, wn * 64, fr, fq);
}
struct NoHook { DI void operator()(f32x4 (&)[4][4], int, int, int, int, int) const {} };

namespace pg8 {
#define PG8_LAS __attribute__((address_space(3)))
typedef unsigned short bf16_t;
typedef short bf16x8 __attribute__((ext_vector_type(8)));
typedef float f32x4 __attribute__((ext_vector_type(4)));
constexpr int BM = 256, BK = 64, HALF = 128, HTB = HALF * BK * 2  , STAGE_BYTES = 8 * HTB, NXCD = 8, WGM = 8;

__host__ __device__ __forceinline__ int lds_byte(int r, int c) { const int st = (r >> 4) * 2 + (c >> 5), rr = r & 15, cc = c & 31, ob = rr * 64 + cc * 2; return st * 1024 + (ob ^ (((ob >> 9) & 1) << 5)); }
__host__ __device__ __forceinline__ void stage_rc(int b, int& R, int& C) { const int st = b / 1024, sb = b % 1024, swz = sb ^ (((sb >> 9) & 1) << 5); R = (st >> 1) * 16 + swz / 64; C = (st & 1) * 32 + (swz % 64) / 2; }
__host__ __device__ __forceinline__ int perm32(int rho) { const int n = rho >> 4, i = rho & 15; return 8 * (i >> 2) + 4 * n + (i & 3); }

struct Unit { int pm, pn; };
struct Gemm { const bf16_t* A; const bf16_t* Bt; int M, N, K, lda, ldb; };

struct StaticOrder {
    int nM, nN, nwg, G, c;
    __host__ __device__ void init(int M, int N, int G_, int c_) { nM = M / BM; nN = N / BM; nwg = nM * nN; G = G_; c = c_; }
    __host__ __device__ bool next(int i, Unit& u) const {
        const long L = (long)i * G + c; if (L >= nwg) return false;
        int wgid = (int)L; { const int q = nwg / NXCD, r = nwg % NXCD, xcd = wgid % NXCD, off = wgid / NXCD; wgid = (xcd < r ? xcd * (q + 1) : r * (q + 1) + (xcd - r) * q) + off; }
        const int nig = WGM * nN, gid = wgid / nig, fm = gid * WGM, gsz = (nM - fm) < WGM ? (nM - fm) : WGM;
        u.pm = fm + ((wgid % nig) % gsz); u.pn = (wgid % nig) / gsz; return true;
    }
    __device__ __forceinline__ void a_ready(const Unit&) const {}
    __device__ __forceinline__ void done(const Unit&) const {}
};
template <class Epi, class Sched, bool STAMP = false>
__device__ __forceinline__ void gemm_phase(PG8_LAS unsigned char* lds, const Gemm g, const Sched& S, const Epi& E, unsigned long long* stamps, int tid_in) {
    const int tid = tid_in, wid = __builtin_amdgcn_readfirstlane(tid >> 6), lane = tid & 63, wr = wid >> 2, wc = wid & 3, fr = lane & 15, fq = lane >> 4;
    const int K = g.K, nt = K / BK;
    int ts_lo = 0, ts_hi = 0, nts = 0; const unsigned long long rt_entry = STAMP ? (unsigned long long)wall_clock64() : 0ull;
#define PG8_STAMP() do { if (STAMP && wid == 0 && nts < 64) { const unsigned long long _c = (unsigned long long)clock64(); \
        ts_lo = (lane == nts) ? (int)(unsigned)_c : ts_lo; ts_hi = (lane == nts) ? (int)(unsigned)(_c >> 32) : ts_hi; ++nts; } } while (0)
    PG8_STAMP();
    unsigned voffA[2], voffB[2];
#pragma unroll
    for (int i = 0; i < 2; ++i) { int R, C; stage_rc(tid * 16 + i * 8192, R, C); const int Rb = Epi::PERM ? ((R & ~31) + perm32(R & 31)) : R;
        voffA[i] = (unsigned)(R * g.lda + C) * 2u; voffB[i] = (unsigned)(Rb * g.ldb + C) * 2u; }
    const size_t kstep = (size_t)(BK * 2);
    const size_t hstepA = (size_t)HALF * g.lda * 2, hstepB = (size_t)HALF * g.ldb * 2;
    const size_t tstepA = 2 * hstepA, tstepB = 2 * hstepB;
    const unsigned ldsw = (unsigned)wid * 1024u;
    const int aoff = lds_byte(wr * 64 + fr, fq * 8), boff = lds_byte(wc * 32 + fr, fq * 8);
#define PG8_SA(b, h) (((b) * 2 + (h)) * HTB)
#define PG8_SB(b, h) ((4 + (b) * 2 + (h)) * HTB)
#define PG8_STAGE(bufoff, gbase, voff) do { _Pragma("unroll") for (int _i = 0; _i < 2; ++_i) \
        __builtin_amdgcn_global_load_lds((const unsigned*)((const char*)(gbase) + (voff)[_i]), (PG8_LAS unsigned*)(lds + (bufoff) + ldsw + _i * 8192), 16, 0, 0); } while (0)
#define PG8_LDA(dst, b, h) do { _Pragma("unroll") for (int m = 0; m < 4; ++m) _Pragma("unroll") for (int k = 0; k < 2; ++k) dst[m][k] = *(const PG8_LAS bf16x8*)(lds + PG8_SA(b, h) + aoff + m * 2048 + k * 1024); } while (0)
#define PG8_LDB(dst, b, h) do { _Pragma("unroll") for (int n = 0; n < 2; ++n) _Pragma("unroll") for (int k = 0; k < 2; ++k) dst[n][k] = *(const PG8_LAS bf16x8*)(lds + PG8_SB(b, h) + boff + n * 2048 + k * 1024); } while (0)
#define PG8_MMA(ai, bj, At, Bt) do { __builtin_amdgcn_s_setprio(1); _Pragma("unroll") for (int m = 0; m < 4; ++m) _Pragma("unroll") for (int n = 0; n < 2; ++n) _Pragma("unroll") for (int k = 0; k < 2; ++k) \
        acc[ai][bj][m][n] = __builtin_amdgcn_mfma_f32_16x16x32_bf16(Bt[n][k], At[m][k], acc[ai][bj][m][n], 0, 0, 0); __builtin_amdgcn_s_setprio(0); } while (0)
#define PG8_WAIT_V(n) asm volatile("s_waitcnt vmcnt(" #n ")" ::: "memory")
#define PG8_WAIT_L(n) asm volatile("s_waitcnt lgkmcnt(" #n ")" ::: "memory")
#define PG8_BAR __builtin_amdgcn_s_barrier()
#define PG8_SCHED __builtin_amdgcn_sched_barrier(0)
    Unit cur, nxt; int ui = 0;
    if (!S.next(0, cur)) return;
    f32x4 acc[2][2][4][2];
#pragma unroll
    for (int a = 0; a < 2; ++a)
#pragma unroll
        for (int b = 0; b < 2; ++b)
#pragma unroll
            for (int m = 0; m < 4; ++m)
#pragma unroll
                for (int n = 0; n < 2; ++n) acc[a][b][m][n] = (f32x4){0.f, 0.f, 0.f, 0.f};
    bf16x8 At[4][2], B0[2][2], B1[2][2];
    const char* cA = (const char*)g.A + (size_t)cur.pm * tstepA; const char* cB = (const char*)g.Bt + (size_t)cur.pn * tstepB;
    S.a_ready(cur);
    PG8_STAGE(PG8_SB(0, 0), cB, voffB); PG8_STAGE(PG8_SA(0, 0), cA, voffA); PG8_STAGE(PG8_SB(0, 1), cB + hstepB, voffB); PG8_STAGE(PG8_SA(0, 1), cA + hstepA, voffA);
    if (wr == 1) PG8_BAR;
    PG8_WAIT_V(4); PG8_BAR;
    PG8_STAGE(PG8_SB(1, 0), cB + kstep, voffB); PG8_STAGE(PG8_SA(1, 0), cA + kstep, voffA); PG8_STAGE(PG8_SB(1, 1), cB + hstepB + kstep, voffB);
    PG8_WAIT_V(6); PG8_BAR;
    PG8_STAMP();
    for (;;) {
        const bool has_next = S.next(ui + 1, nxt);
        const char* nA = has_next ? (const char*)g.A + (size_t)nxt.pm * tstepA : cA; const char* nB = has_next ? (const char*)g.Bt + (size_t)nxt.pn * tstepB : cB;
        for (int t = 0; t < nt; t += 2) {
            const bool last = (t == nt - 2);
            const char* a1 = cA + (size_t)(t + 1) * kstep;
            const char* a2 = last ? nA : cA + (size_t)(t + 2) * kstep; const char* b2 = last ? nB : cB + (size_t)(t + 2) * kstep;
            const char* a3 = a2 + kstep; const char* b3 = b2 + kstep;
            if (last && has_next) S.a_ready(nxt);
            PG8_LDB(B0, 0, 0); PG8_SCHED; PG8_LDA(At, 0, 0); PG8_STAGE(PG8_SA(1, 1), a1 + hstepA, voffA);
            PG8_WAIT_L(8); PG8_BAR; PG8_WAIT_L(0); PG8_MMA(0, 0, At, B0); PG8_BAR; PG8_SCHED;
            PG8_LDB(B1, 0, 1); PG8_STAGE(PG8_SB(0, 0), b2, voffB);
            PG8_BAR; PG8_WAIT_L(0); PG8_MMA(0, 1, At, B1); PG8_BAR;
            PG8_LDA(At, 0, 1); PG8_STAGE(PG8_SA(0, 0), a2, voffA);
            PG8_BAR; PG8_WAIT_L(0); PG8_MMA(1, 0, At, B0); PG8_BAR; PG8_SCHED;
            PG8_STAGE(PG8_SB(0, 1), b2 + hstepB, voffB);
            PG8_WAIT_V(6); PG8_BAR; PG8_MMA(1, 1, At, B1); PG8_BAR;
            PG8_LDB(B0, 1, 0); PG8_SCHED; PG8_LDA(At, 1, 0); PG8_STAGE(PG8_SA(0, 1), a2 + hstepA, voffA);
            PG8_WAIT_L(8); PG8_BAR; PG8_WAIT_L(0); PG8_MMA(0, 0, At, B0); PG8_BAR; PG8_SCHED;
            PG8_LDB(B1, 1, 1); PG8_STAGE(PG8_SB(1, 0), b3, voffB);
            PG8_BAR; PG8_WAIT_L(0); PG8_MMA(0, 1, At, B1); PG8_BAR;
            PG8_LDA(At, 1, 1); PG8_STAGE(PG8_SA(1, 0), a3, voffA);
            PG8_BAR; PG8_WAIT_L(0); PG8_MMA(1, 0, At, B0); PG8_BAR; PG8_SCHED;
            PG8_STAGE(PG8_SB(1, 1), b3 + hstepB, voffB);
            PG8_WAIT_V(6); PG8_BAR; PG8_MMA(1, 1, At, B1); PG8_BAR;
        }
        PG8_STAMP();
        if constexpr (!Epi::AFTER_DRAIN) { E(acc, cur, wr, wc, fr, fq); S.done(cur); }
        PG8_STAMP();
        if (!has_next) break;
#pragma unroll
        for (int a = 0; a < 2; ++a)
#pragma unroll
            for (int b = 0; b < 2; ++b)
#pragma unroll
                for (int m = 0; m < 4; ++m)
#pragma unroll
                    for (int n = 0; n < 2; ++n) acc[a][b][m][n] = (f32x4){0.f, 0.f, 0.f, 0.f};
        cur = nxt; cA = nA; cB = nB; ++ui;
    }
    PG8_WAIT_V(0);
    if (wr == 0) PG8_BAR;
    PG8_BAR;
    if constexpr (Epi::AFTER_DRAIN) { E.fused(acc, cur, wr, wc, fr, fq, lds, wid, lane); S.done(cur); }
    PG8_STAMP();
    if (STAMP && wid == 0) { stamps[lane] = lane < nts ? (((unsigned long long)(unsigned)ts_hi << 32) | (unsigned)ts_lo) : 0ull;
        if (lane == 62) stamps[62] = rt_entry; if (lane == 63) stamps[63] = (unsigned long long)wall_clock64(); }
#undef PG8_STAMP
#undef PG8_SA
#undef PG8_SB
#undef PG8_STAGE
#undef PG8_LDA
#undef PG8_LDB
#undef PG8_MMA
#undef PG8_WAIT_V
#undef PG8_WAIT_L
#undef PG8_BAR
#undef PG8_SCHED
}
}

DI int rowmap(int n, int mode) { return mode == 0 ? n : ((n >> 4) * 32 + (n & 15) + (mode == 2 ? 16 : 0)); }
DI void tconv_tile(const Ctx& c, const float* src, int ld, int N, bf16_t* dst, int ld_dst, int mode, int tk, int tn) {
    bf16_t* T = (bf16_t*)c.smem;
    const int k0 = tk * 64, n0 = tn * 64, tid = c.tid;
    __syncthreads();
#pragma unroll
    for (int i = 0; i < 2; ++i) {
        const int kk = (tid >> 4) + i * 32, n4 = (tid & 15) * 4;
        float4 v = make_float4(0.f, 0.f, 0.f, 0.f);
        if (n0 + n4 < N) v = *(const float4*)(src + (size_t)(k0 + kk) * ld + n0 + n4);
        T[(n4 + 0) * 72 + kk] = f2bf(v.x); T[(n4 + 1) * 72 + kk] = f2bf(v.y); T[(n4 + 2) * 72 + kk] = f2bf(v.z); T[(n4 + 3) * 72 + kk] = f2bf(v.w);
    }
    __syncthreads();
    const int n = tid >> 3, k8 = (tid & 7) * 8;
    if (n0 + n < N) *(u32x4*)(dst + (size_t)rowmap(n0 + n, mode) * ld_dst + k0 + k8) = *(const u32x4*)(T + n * 72 + k8);
}
DI void tconv(const Ctx& c, const float* src, int ld, int K, int N, bf16_t* dst, int ld_dst, int mode, int rot) {
    const int ntk = K / 64, ntn = (N + 63) / 64, nt = ntk * ntn, G = gridDim.x;
    for (int t = (blockIdx.x + G - (rot % G)) % G; t < nt; t += G) tconv_tile(c, src, ld, N, dst, ld_dst, mode, t / ntn, t % ntn);
}

DI void wconv(const Ctx& c, const float* src, int ld, int K, int N, bf16_t* dst, int ld_dst, int rot) {
    const int ntk = K / 64, ntn = (N + 63) / 64, nt = ntk * ntn, GW = gridDim.x * 8, w0 = blockIdx.x * 8 + c.wave;
    for (int t = (w0 + GW - (rot % GW)) % GW; t < nt; t += GW) {
        const int tk = t / ntn, tn = t % ntn, n = tn * 64 + c.lane;
        if (n < N) {
            const float* sp = src + (size_t)(tk * 64) * ld + n; bf16_t* dp = dst + (size_t)n * ld_dst + tk * 64;
#pragma unroll
            for (int kb = 0; kb < 8; ++kb) {
                float v[8];
#pragma unroll
                for (int j = 0; j < 8; ++j) v[j] = sp[(size_t)(kb * 8 + j) * ld];
                u32x4 w4; w4.x = pack2(v[0], v[1]); w4.y = pack2(v[2], v[3]); w4.z = pack2(v[4], v[5]); w4.w = pack2(v[6], v[7]);
                *(u32x4*)(dp + kb * 8) = w4;
            }
        }
    }
}
DI void phase_prologue(const Ctx& c) {
    unsigned char* wsm = c.ws + WS_WSM;
    const int tid = c.tid, G = gridDim.x, gtid = blockIdx.x * NTHR + tid, gn = G * NTHR;
    {
        const float4* x = (const float4*)c.in[0]; const float4* cx = (const float4*)c.in[2]; float4* H = (float4*)(c.ws + WS_H);
        for (size_t i = gtid; i < (size_t)NZ * 256; i += gn) {
            const int z = (int)(i >> 8), q = (int)(i & 255), b = z / TZ, s = z % TZ;
            H[i] = (s < CTX) ? cx[((size_t)b * CTX + s) * 256 + q] : x[((size_t)b * SEQ + (s - CTX)) * 256 + q];
        }
    }
    {
        float* rope = (float*)(wsm + OFF_ROPE);
        for (int i = gtid; i < SEQ * 16; i += gn) {
            const int t = i >> 4, a = (i >> 3) & 1, f = i & 7;
            const float pos = (float)(a == 0 ? (t >> 6) : (t & 63));
            const float inv = powf(10000.f, -(float)f / 8.f);
            float sn, cs; sincosf(pos * inv, &sn, &cs);
            rope[i * 2] = cs; rope[i * 2 + 1] = sn;
        }
    }
    {
        float* s5t = (float*)(wsm + OFF_S5T);
        for (int i = gtid; i < NL * 2 * 16 * 64; i += gn) {
            const int ldg = i >> 6;
            const double lr = c.in[24][i], li = c.in[25][i], dt = exp((double)c.in[26][ldg]);
            const double mag = exp(lr * dt), are = mag * cos(li * dt), aim = mag * sin(li * dt);
            const double m256 = exp(lr * dt * 64.0), a256r = m256 * cos(li * dt * 64.0), a256i = m256 * sin(li * dt * 64.0);
            const double den = lr * lr + li * li, nr = are - 1.0, ni = aim;
            const double cfr = (nr * lr + ni * li) / den, cfi = (ni * lr - nr * li) / den;
            float* o = s5t + (size_t)i * 36;
            o[0] = (float)are; o[1] = (float)aim; o[2] = (float)a256r; o[3] = (float)a256i;
            for (int ch = 0; ch < 16; ++ch) {
                const double br = c.in[27][(size_t)i * 16 + ch], bi = c.in[28][(size_t)i * 16 + ch];
                o[4 + ch] = (float)(cfr * br - cfi * bi); o[20 + ch] = (float)(cfr * bi + cfi * br);
            }
        }
    }
    {
        float* rwt = (float*)(wsm + OFF_RWT);
        for (int i = gtid; i < NL * 36 * 1024; i += gn) {
            const int l = i / (36 * 1024), e = (i / 1024) % 36, d = i & 1023;
            rwt[i] = e < 4 ? c.in[41][((size_t)l * 1024 + d) * 4 + e] : c.in[43][((size_t)l * 1024 + d) * 32 + (e - 4)];
        }
    }
    if (blockIdx.x == 0 && tid < NL) {
        float s1 = 0.f, s2 = 0.f;
        for (int i = 0; i < 32; ++i) { s1 += c.in[34][tid * 32 + i] * c.in[35][tid * 32 + i]; s2 += c.in[36][tid * 32 + i] * c.in[37][tid * 32 + i]; }
        ((float*)(wsm + OFF_LAM))[tid] = expf(s1) - expf(s2) + (0.8f - 0.6f * expf(-0.3f * (float)tid));
    }
    {
        float* sv = (float*)c.smem;
        float* red = sv + 3 * 1024;
        __syncthreads();
        for (int i = tid; i < 3 * 1024; i += NTHR) { const float v = i < 2048 ? c.in[1][i] : c.in[3][i - 2048]; sv[i] = siluf_(v); }
        __syncthreads();
        float* modv = (float*)(wsm + OFF_MODV);
        for (int u = blockIdx.x; u < NL * 96; u += G) {
            const int l = u / 96, col = (u % 96) * 64 + (tid & 63), ks = tid >> 6;
            const float* w = c.in[4] + (size_t)l * 1024 * 6144 + col;
            float a0 = 0.f, a1 = 0.f, a2 = 0.f;
            for (int k = ks * 128; k < ks * 128 + 128; ++k) { const float wv = w[(size_t)k * 6144]; a0 += sv[k] * wv; a1 += sv[1024 + k] * wv; a2 += sv[2048 + k] * wv; }
            red[(ks * 64 + (tid & 63)) * 3 + 0] = a0; red[(ks * 64 + (tid & 63)) * 3 + 1] = a1; red[(ks * 64 + (tid & 63)) * 3 + 2] = a2;
            __syncthreads();
            if (tid < 192) {
                const int cc = tid & 63, sel = tid >> 6; float s = 0.f;
                for (int k2 = 0; k2 < 8; ++k2) s += red[(k2 * 64 + cc) * 3 + sel];
                const int colo = (u % 96) * 64 + cc;
                modv[((size_t)l * 3 + sel) * 6144 + colo] = s + c.in[5][l * 6144 + colo];
            }
            __syncthreads();
        }
    }
    for (int l = 0; l < NL; ++l) {
        wconv(c, c.in[8] + (size_t)l * 1024 * NIN, NIN, 1024, NIN, (bf16_t*)(wsm + OFF_WINT + l * SZ_WINT), 1024, l * 700);
        tconv(c, c.in[11] + (size_t)l * 256 * 384, 384, 256, 384, (bf16_t*)(wsm + OFF_WUQT + l * SZ_WUQT), 256, 0, 40);
        tconv(c, c.in[12] + (size_t)l * 128 * 512, 512, 128, 512, (bf16_t*)(wsm + OFF_WUKVT + l * SZ_WUKVT), 128, 0, 70);
        for (int d = 0; d < 2; ++d) {
            tconv(c, c.in[15] + (size_t)(l * 2 + d) * 64 * 256, 256, 64, 256, (bf16_t*)(wsm + OFF_W2T + l * SZ_W2T) + d * 256 * 64, 64, 0, 90 + d * 8);
            tconv(c, c.in[17] + (size_t)(l * 2 + d) * 64 * 256, 256, 64, 256, (bf16_t*)(wsm + OFF_A2T + l * SZ_A2T) + d * 256 * 64, 64, 0, 110 + d * 8);
        }
        tconv(c, c.in[18] + (size_t)l * 128 * 256, 256, 128, 256, (bf16_t*)(wsm + OFF_G2T + l * SZ_G2T), 128, 0, 130);
        tconv(c, c.in[32] + (size_t)l * 256 * 256, 256, 256, 256, (bf16_t*)(wsm + OFF_GLUT + l * SZ_GLUT), 256, 0, 140);
        for (int n = 0; n < 4; ++n)
            wconv(c, c.in[39] + (size_t)(l * 4 + n) * 256 * 1024, 1024, 256, 1024, (bf16_t*)(wsm + OFF_WBT + l * SZ_WBT) + n * 256, 1024, 300 + n * 64 + l * 1000);
        wconv(c, c.in[40] + (size_t)l * 1024 * 1024, 1024, 1024, 1024, (bf16_t*)(wsm + OFF_WOUTT + l * SZ_WOUTT), 1024, 1200 + l * 400);
    }
}

DI void phase_expert_convert(const Ctx& c, int l) {
    const int G = gridDim.x, lane = c.lane;
    for (int t = blockIdx.x * 8 + c.wave; t < 32 * 384; t += G * 8) {
        const int e = t / 384, r = t % 384;
        const float* src; bf16_t* dst; int ld, ldd, mode, tk, tn;
        if (r < 128)      { src = c.in[45] + ((size_t)l * 32 + e) * 1024 * 512; dst = (bf16_t*)(c.ws + WS_EXPW + (size_t)e * SZ_WGU); ld = 512; ldd = 1024; mode = 1; tk = r / 8; tn = r % 8; }
        else if (r < 256) { src = c.in[46] + ((size_t)l * 32 + e) * 1024 * 512; dst = (bf16_t*)(c.ws + WS_EXPW + (size_t)e * SZ_WGU); ld = 512; ldd = 1024; mode = 2; tk = (r - 128) / 8; tn = (r - 128) % 8; }
        else              { src = c.in[47] + ((size_t)l * 32 + e) * 512 * 1024; dst = (bf16_t*)(c.ws + WS_EXPW + 32 * SZ_WGU + (size_t)e * SZ_WD); ld = 1024; ldd = 512; mode = 0; tk = (r - 256) / 16; tn = (r - 256) % 16; }
        const int n = tn * 64 + lane; const float* sp = src + (size_t)(tk * 64) * ld + n; bf16_t* dp = dst + (size_t)rowmap(n, mode) * ldd + tk * 64;
        float v[64];
#pragma unroll
        for (int k = 0; k < 64; ++k) v[k] = __builtin_nontemporal_load(sp + (size_t)k * ld);
#pragma unroll
        for (int kb = 0; kb < 8; ++kb) {
            u32x4 w4; w4.x = pack2(v[kb * 8], v[kb * 8 + 1]); w4.y = pack2(v[kb * 8 + 2], v[kb * 8 + 3]); w4.z = pack2(v[kb * 8 + 4], v[kb * 8 + 5]); w4.w = pack2(v[kb * 8 + 6], v[kb * 8 + 7]);
            *(u32x4*)(dp + kb * 8) = w4;
        }
    }
}

DI void phase_norm1(const Ctx& c, int l) {
    const float* modv = (const float*)(c.ws + WS_WSM + OFF_MODV);
    float* H = (float*)(c.ws + WS_H); const bf16_t* Y = (const bf16_t*)(c.ws + WS_P);
    bf16_t* XN = (bf16_t*)(c.ws + WS_BUFA);
    const float* g1 = c.in[6] + l * 1024;
    for (int row = blockIdx.x * 8 + c.wave; row < NZ; row += gridDim.x * 8) {
        const int b = row / TZ, s = row % TZ, sel = s < CTX ? 2 : b;
        float4 v[4]; float ss = 0.f;
#pragma unroll
        for (int q = 0; q < 4; ++q) {
            const int col = q * 256 + c.lane * 4;
            v[q] = *(const float4*)(H + (size_t)row * D + col);
            if (l > 0) {
                float ya[4], yb[4]; unpack4(*(const u32x2*)(Y + (size_t)row * D + col), ya); unpack4(*(const u32x2*)(Y + ((size_t)NZ + row) * D + col), yb);
                const float4 m5 = *(const float4*)(modv + ((size_t)(l - 1) * 3 + sel) * 6144 + 5 * 1024 + col);
                v[q].x += m5.x * (ya[0] + yb[0]); v[q].y += m5.y * (ya[1] + yb[1]); v[q].z += m5.z * (ya[2] + yb[2]); v[q].w += m5.w * (ya[3] + yb[3]);
                *(float4*)(H + (size_t)row * D + col) = v[q];
            }
            ss += v[q].x * v[q].x + v[q].y * v[q].y + v[q].z * v[q].z + v[q].w * v[q].w;
        }
        ss = wave_sum(ss);
        const float rs = rsqrtf(ss * (1.f / 1024.f) + 1e-6f);
#pragma unroll
        for (int q = 0; q < 4; ++q) {
            const int col = q * 256 + c.lane * 4;
            const float4 g = *(const float4*)(g1 + col), m0 = *(const float4*)(modv + ((size_t)l * 3 + sel) * 6144 + col), m1 = *(const float4*)(modv + ((size_t)l * 3 + sel) * 6144 + 1024 + col);
            *(u32x2*)(XN + (size_t)row * D + col) = pack4(v[q].x * rs * g.x * (1.f + m1.x) + m0.x, v[q].y * rs * g.y * (1.f + m1.y) + m0.y,
                                                          v[q].z * rs * g.z * (1.f + m1.z) + m0.z, v[q].w * rs * g.w * (1.f + m1.w) + m0.w);
        }
    }
}

DI void phase_final(const Ctx& c) {
    const float* modv = (const float*)(c.ws + WS_WSM + OFF_MODV);
    const float* H = (const float*)(c.ws + WS_H); const bf16_t* Y = (const bf16_t*)(c.ws + WS_P);
    const float* g = c.in[48];
    for (int r = blockIdx.x * 8 + c.wave; r < NB * SEQ; r += gridDim.x * 8) {
        const int b = r / SEQ, t = r % SEQ, row = b * TZ + CTX + t;
        float4 v[4]; float ss = 0.f;
#pragma unroll
        for (int q = 0; q < 4; ++q) {
            const int col = q * 256 + c.lane * 4;
            v[q] = *(const float4*)(H + (size_t)row * D + col);
            float ya[4], yb[4]; unpack4(*(const u32x2*)(Y + (size_t)row * D + col), ya); unpack4(*(const u32x2*)(Y + ((size_t)NZ + row) * D + col), yb);
            const float4 m5 = *(const float4*)(modv + ((size_t)(NL - 1) * 3 + b) * 6144 + 5 * 1024 + col);
            v[q].x += m5.x * (ya[0] + yb[0]); v[q].y += m5.y * (ya[1] + yb[1]); v[q].z += m5.z * (ya[2] + yb[2]); v[q].w += m5.w * (ya[3] + yb[3]);
            ss += v[q].x * v[q].x + v[q].y * v[q].y + v[q].z * v[q].z + v[q].w * v[q].w;
        }
        ss = wave_sum(ss);
        const float rs = rsqrtf(ss * (1.f / 1024.f) + 1e-6f);
#pragma unroll
        for (int q = 0; q < 4; ++q) {
            const int col = q * 256 + c.lane * 4; const float4 gg = *(const float4*)(g + col);
            *(float4*)(c.out + (size_t)r * D + col) = make_float4(v[q].x * rs * gg.x, v[q].y * rs * gg.y, v[q].z * rs * gg.z, v[q].w * rs * gg.w);
        }
    }
}

struct EpiInproj {
    static constexpr bool PERM = true, AFTER_DRAIN = false;
    bf16_t *PM, *PS, *PR, *PD, *GT;
    DI void operator()(const pg8::f32x4 (&acc)[2][2][4][2], const pg8::Unit& u, int wr, int wc, int fr, int fq) const {
        const int row0 = u.pm * 256 + wr * 64 + fr, col0 = u.pn * 256 + wc * 32 + 8 * fq;
#pragma unroll
        for (int bj = 0; bj < 2; ++bj) {
            const int col = col0 + bj * 128;
            bf16_t* dst; int ld, cc; bool gate = false;
            if (col < 416) { dst = PM; ld = 416; cc = col; }
            else if (col < 1440) { dst = PR; ld = 1024; cc = col - 416; }
            else if (col < 1696) { dst = PS; ld = 256; cc = col - 1440; }
            else if (col < 2464) { dst = PD; ld = 768; cc = col - 1696; }
            else if (col < NIN) { dst = GT; ld = 4096; cc = col - 2464; gate = true; }
            else continue;
#pragma unroll
            for (int ai = 0; ai < 2; ++ai)
#pragma unroll
                for (int m = 0; m < 4; ++m) {
                    const int row = row0 + ai * 128 + m * 16; pg8::f32x4 v0 = acc[ai][bj][m][0], v1 = acc[ai][bj][m][1];
                    if (gate) { v0[0] = sigmoidf_(v0[0]); v0[1] = sigmoidf_(v0[1]); v0[2] = sigmoidf_(v0[2]); v0[3] = sigmoidf_(v0[3]);
                                v1[0] = sigmoidf_(v1[0]); v1[1] = sigmoidf_(v1[1]); v1[2] = sigmoidf_(v1[2]); v1[3] = sigmoidf_(v1[3]); }
                    u32x4 w; w.x = pack2(v0[0], v0[1]); w.y = pack2(v0[2], v0[3]); w.z = pack2(v1[0], v1[1]); w.w = pack2(v1[2], v1[3]);
                    *(u32x4*)(dst + (size_t)row * ld + cc) = w;
                }
        }
    }
};
DI void phase_inproj(const Ctx& c, int l) {
    EpiInproj E; E.PM = (bf16_t*)(c.ws + WS_P + P_PM); E.PS = (bf16_t*)(c.ws + WS_P + P_PS); E.PR = (bf16_t*)(c.ws + WS_P + P_PR); E.PD = (bf16_t*)(c.ws + WS_P + P_PD); E.GT = (bf16_t*)(c.ws + WS_GT);
    pg8::Gemm g{(const bf16_t*)(c.ws + WS_BUFA), (const bf16_t*)(c.ws + WS_WSM + OFF_WINT + l * SZ_WINT), NZ, NINP, 1024, 1024, 1024};
    pg8::StaticOrder S; S.init(NZ, NINP, (int)gridDim.x, (int)blockIdx.x);
    __syncthreads();
    pg8::gemm_phase<EpiInproj, pg8::StaticOrder, false>((PG8_LAS unsigned char*)c.smem, g, S, E, nullptr, c.tid);
}

DI void phase_prep(const Ctx& c, int l) {
    unsigned char* ws = c.ws; const int lane = c.lane, wave = c.wave, tid = c.tid;
    const bf16_t* PM = (const bf16_t*)(ws + WS_P + P_PM); const bf16_t* PR = (const bf16_t*)(ws + WS_P + P_PR); const bf16_t* PD = (const bf16_t*)(ws + WS_P + P_PD);
    bf16_t* CQN = (bf16_t*)(ws + WS_MISC + MS_CQN); bf16_t* TW = (bf16_t*)(ws + WS_MISC + MS_TW); bf16_t* AL = (bf16_t*)(ws + WS_MISC + MS_AL); bf16_t* SG = (bf16_t*)(ws + WS_MISC + MS_SG);
    bf16_t* KM = (bf16_t*)(ws + WS_EXPW + MX_KM); bf16_t* QD = (bf16_t*)(ws + WS_EXPW + MX_QD); bf16_t* KD_ = (bf16_t*)(ws + WS_EXPW + MX_KD); bf16_t* VDT = (bf16_t*)(ws + WS_EXPW + MX_VDT);
    bf16_t* RB = (bf16_t*)(ws + WS_EXPW + MX_RB); bf16_t* KB = (bf16_t*)(ws + WS_EXPW + MX_KB); bf16_t* VB = (bf16_t*)(ws + WS_EXPW + MX_VB); bf16_t* KKB = (bf16_t*)(ws + WS_EXPW + MX_KKB);
    const float* rope = (const float*)(ws + WS_WSM + OFF_ROPE);
    const float* gq = c.in[9] + l * 256; const float* gkv = c.in[10] + l * 128; const float* mu = c.in[13] + l * 1024; const float* k_k = c.in[19] + l * 256;
    bf16_t* Vs = (bf16_t*)c.smem;
    const float qsc = 0.17677669529663687f * LOG2E;
    for (int tile = blockIdx.x; tile < NZ / 64; tile += gridDim.x) {
        __syncthreads();
        for (int i = 0; i < 8; ++i) {
            const int rt = wave * 8 + i, z = tile * 64 + rt, b = z / TZ, s = z % TZ; const bool lat = s >= CTX; const int tl = lat ? s - CTX : 0;
            {
                const bf16_t* pm = PM + (size_t)z * 416;
                float x[4]; unpack4(*(const u32x2*)(pm + lane * 4), x);
                float ss = wave_sum(x[0] * x[0] + x[1] * x[1] + x[2] * x[2] + x[3] * x[3]);
                float rs = rsqrtf(ss * (1.f / 256.f) + 1e-6f);
                const float4 g = *(const float4*)(gq + lane * 4);
                *(u32x2*)(CQN + (size_t)z * 384 + lane * 4) = pack4(x[0] * rs * g.x, x[1] * rs * g.y, x[2] * rs * g.z, x[3] * rs * g.w);
                const unsigned u2 = *(const unsigned*)(pm + 256 + lane * 2); const float y0 = lo2f(u2), y1 = hi2f(u2);
                ss = wave_sum(y0 * y0 + y1 * y1); rs = rsqrtf(ss * (1.f / 128.f) + 1e-6f);
                const float2 g2 = *(const float2*)(gkv + lane * 2);
                *(unsigned*)(CQN + (size_t)z * 384 + 256 + lane * 2) = pack2(y0 * rs * g2.x, y1 * rs * g2.y);
                float kr = bf2f(pm[384 + (lane & 31)]);
                const float pr = __shfl_xor(kr, 8, 64);
                if (lat) { const float* cs = rope + ((size_t)tl * 16 + ((lane & 31) >> 4) * 8 + (lane & 7)) * 2; kr = kr * cs[0] + ((lane & 8) ? pr : -pr) * cs[1]; }
                if (lane < 32) {
                    const bf16_t kv = f2bf(kr);
#pragma unroll
                    for (int h = 0; h < 4; ++h) KM[((size_t)(b * 4 + h) * TZ + s) * 96 + 64 + lane] = kv;
                }
            }
            {
                const bf16_t* pd = PD + (size_t)z * 768;
                const int i0 = lane * 4, hh = i0 >> 6, ii = i0 & 31, nn = (i0 >> 5) & 1;
                const float* cs = rope + ((size_t)tl * 16 + (ii >> 4) * 8 + (ii & 7)) * 2;
                const bool hi = (ii & 8) != 0;
#pragma unroll
                for (int w = 0; w < 2; ++w) {
                    float x[4]; unpack4(*(const u32x2*)(pd + w * 256 + i0), x);
                    float o[4];
#pragma unroll
                    for (int j = 0; j < 4; ++j) {
                        const float p = __shfl_xor(x[j], 2, 64);
                        o[j] = lat ? (x[j] * cs[2 * j] + (hi ? p : -p) * cs[2 * j + 1]) : x[j];
                        if (w == 0) o[j] *= qsc;
                    }
                    bf16_t* dst = (w == 0 ? QD : KD_) + ((size_t)(b * 4 + hh) * TZ + s) * 64 + nn * 32 + ii;
                    *(u32x2*)dst = pack4(o[0], o[1], o[2], o[3]);
                }
                *(u32x2*)(Vs + rt * 264 + i0) = *(const u32x2*)(pd + 512 + i0);
            }
            {
                const bf16_t* pr = PR + (size_t)z * 1024;
                const bool hp = (s != 0) && (s != CTX), hn = (s != CTX - 1) && (s != TZ - 1);
#pragma unroll
                for (int q = 0; q < 4; ++q) {
                    const int col = q * 256 + lane * 4;
                    float cu[4], pv[4] = {0.f, 0.f, 0.f, 0.f}, nx[4] = {0.f, 0.f, 0.f, 0.f};
                    unpack4(*(const u32x2*)(pr + col), cu);
                    if (hp) unpack4(*(const u32x2*)(pr - 1024 + col), pv);
                    if (hn) unpack4(*(const u32x2*)(pr + 1024 + col), nx);
                    const float4 m = *(const float4*)(mu + col);
                    float zv[4];
                    zv[0] = cu[0] + (0.5f * (pv[0] + nx[0]) - cu[0]) * m.x; zv[1] = cu[1] + (0.5f * (pv[1] + nx[1]) - cu[1]) * m.y;
                    zv[2] = cu[2] + (0.5f * (pv[2] + nx[2]) - cu[2]) * m.z; zv[3] = cu[3] + (0.5f * (pv[3] + nx[3]) - cu[3]) * m.w;
                    if (q == 0) *(u32x2*)(RB + (size_t)z * 256 + lane * 4) = pack4(zv[0], zv[1], zv[2], zv[3]);
                    else if (q == 1) {
                        *(u32x2*)(KB + (size_t)z * 256 + lane * 4) = pack4(zv[0], zv[1], zv[2], zv[3]);
                        const float4 kk4 = *(const float4*)(k_k + lane * 4);
                        const float a0 = zv[0] * kk4.x, a1 = zv[1] * kk4.y, a2 = zv[2] * kk4.z, a3 = zv[3] * kk4.w;
                        const float ssq = sum16(a0 * a0 + a1 * a1 + a2 * a2 + a3 * a3);
                        const float inv = 1.f / fmaxf(sqrtf(ssq), 1e-12f);
                        *(u32x2*)(KKB + (size_t)z * 256 + lane * 4) = pack4(a0 * inv, a1 * inv, a2 * inv, a3 * inv);
                    } else if (q == 2) *(u32x2*)(VB + (size_t)z * 256 + lane * 4) = pack4(zv[0], zv[1], zv[2], zv[3]);
                    else {
                        if (lane < 16) *(u32x2*)(TW + (size_t)z * 64 + lane * 4) = pack4(tanhf(zv[0]), tanhf(zv[1]), tanhf(zv[2]), tanhf(zv[3]));
                        else if (lane < 32) *(u32x2*)(AL + (size_t)z * 64 + (lane - 16) * 4) = pack4(zv[0], zv[1], zv[2], zv[3]);
                        else *(u32x2*)(SG + (size_t)z * 128 + (lane - 32) * 4) = pack4(sigmoidf_(zv[0]), sigmoidf_(zv[1]), sigmoidf_(zv[2]), sigmoidf_(zv[3]));
                    }
                }
            }
        }
        __syncthreads();
        {
            const int z0 = tile * 64, b = z0 / TZ, s0 = z0 % TZ;
#pragma unroll
            for (int i = 0; i < 4; ++i) {
                const int ch = tid + i * NTHR, dv = ch >> 3, r8 = (ch & 7) * 8;
                bf16_t v[8];
#pragma unroll
                for (int j = 0; j < 8; ++j) v[j] = Vs[(r8 + j) * 264 + dv];
                u32x4 o; o.x = v[0] | ((unsigned)v[1] << 16); o.y = v[2] | ((unsigned)v[3] << 16); o.z = v[4] | ((unsigned)v[5] << 16); o.w = v[6] | ((unsigned)v[7] << 16);
                *(u32x4*)(VDT + ((size_t)(b * 4 + (dv >> 6)) * 64 + (dv & 63)) * TZ + s0 + r8) = o;
            }
        }
    }
}

constexpr int S5C = 64, S5N = TZ / S5C, S5NC = CTX / S5C;
DI int s5_tok(int dir, int i) { return dir == 0 ? i : (i < CTX ? CTX - 1 - i : TZ - 1 - (i - CTX)); }
DI void s5_stage_u(const Ctx& c, float* U, int b, int dir, int chunk, int g0, int ng) {
    const bf16_t* PS = (const bf16_t*)(c.ws + WS_P + P_PS);
    const int per = ng * 4;
    for (int e = c.tid; e < S5C * per; e += NTHR) {
        const int i = e / per, c4 = (e % per) * 4, s = s5_tok(dir, chunk * S5C + i);
        float x[4]; unpack4(*(const u32x2*)(PS + (size_t)(b * TZ + s) * 256 + g0 * 16 + c4), x);
        *(float4*)(U + i * (ng * 16) + c4) = make_float4(x[0], x[1], x[2], x[3]);
    }
}
DI void phase_s5_local(const Ctx& c, int l) {
    float* U = (float*)c.smem;
    const float* s5t = (const float*)(c.ws + WS_WSM + OFF_S5T);
    float* E = (float*)(c.ws + WS_WSM + OFF_S5E);
    for (int u = blockIdx.x; u < 2 * 2 * S5N * 2; u += gridDim.x) {
        const int gq = u & 1, chunk = (u >> 1) % S5N, dir = (u / (2 * S5N)) & 1, b = u / (4 * S5N);
        __syncthreads();
        s5_stage_u(c, U, b, dir, chunk, gq * 8, 8);
        __syncthreads();
        const int g = gq * 8 + c.wave, p = c.lane;
        const float* tb = s5t + ((size_t)((l * 2 + dir) * 16 + g) * 64 + p) * 36;
        const float are = tb[0], aim = tb[1];
        float br[16], bi[16];
#pragma unroll
        for (int ch = 0; ch < 16; ++ch) { br[ch] = tb[4 + ch]; bi[ch] = tb[20 + ch]; }
        float xr = 0.f, xi = 0.f;
        for (int i = 0; i < S5C; ++i) {
            const float* uu = U + i * 128 + c.wave * 16;
            float sr = 0.f, si = 0.f;
#pragma unroll
            for (int q = 0; q < 4; ++q) { const float4 v = *(const float4*)(uu + q * 4);
                sr += br[q * 4] * v.x + br[q * 4 + 1] * v.y + br[q * 4 + 2] * v.z + br[q * 4 + 3] * v.w;
                si += bi[q * 4] * v.x + bi[q * 4 + 1] * v.y + bi[q * 4 + 2] * v.z + bi[q * 4 + 3] * v.w; }
            const float nr = are * xr - aim * xi + sr, ni = are * xi + aim * xr + si; xr = nr; xi = ni;
        }
        *(float2*)(E + ((size_t)(((b * 2 + dir) * 16 + g) * S5N + chunk) * 64 + p) * 2) = make_float2(xr, xi);
    }
}
DI void phase_s5_carry(const Ctx& c, int l) {
    const int gt = blockIdx.x * NTHR + c.tid;
    if (gt < 2 * 2 * 16 * 64) {
        const int p = gt & 63, g = (gt >> 6) & 15, dir = (gt >> 10) & 1, b = gt >> 11;
        const float* tb = (const float*)(c.ws + WS_WSM + OFF_S5T) + ((size_t)((l * 2 + dir) * 16 + g) * 64 + p) * 36;
        const float ar = tb[2], ai = tb[3];
        const float* E = (const float*)(c.ws + WS_WSM + OFF_S5E) + (size_t)(((b * 2 + dir) * 16 + g) * S5N) * 128;
        float* C = (float*)(c.ws + WS_WSM + OFF_S5C) + (size_t)(((b * 2 + dir) * 16 + g) * S5N) * 128;
        float xr = 0.f, xi = 0.f;
        for (int ch = 0; ch < S5N; ++ch) {
            const float2 e = *(const float2*)(E + ch * 128 + p * 2);
            *(float2*)(C + ch * 128 + p * 2) = make_float2(xr, xi);
            const float nr = ar * xr - ai * xi + e.x, ni = ar * xi + ai * xr + e.y; xr = nr; xi = ni;
        }
    }
}

constexpr int S5_US = 0, S5_YS = 8192, S5_WV = S5_YS + 2 * 64 * 64 * 4;
template <bool LOCAL>
DI void phase_s5_final_unit(const Ctx& c, int l, int u) {
    unsigned char* L = c.smem;
    const float* s5t = (const float*)(c.ws + WS_WSM + OFF_S5T);
    const float* CIN = (const float*)(c.ws + WS_WSM + OFF_S5C);
    const bf16_t* PS = (const bf16_t*)(c.ws + WS_P + P_PS);
    const int gq = u & 3, ct = (u >> 2) % S5N, b = u / (4 * S5N);
    const int wave = c.wave, lane = c.lane, gl = wave >> 1, dir = wave & 1, g = gq * 4 + gl, n16 = lane & 15, q4 = lane >> 4;
    __syncthreads();
    {
        const int t = c.tid >> 3, part = c.tid & 7;
        *(u32x4*)(L + S5_US + t * 128 + part * 16) = *(const u32x4*)(PS + (size_t)(b * TZ + ct * S5C + t) * 256 + gq * 64 + part * 8);
    }
    typedef short s16x4 __attribute__((ext_vector_type(4)));
    const float* tbase = s5t + ((size_t)((l * 2 + dir) * 16 + g) * 64) * 36;
    s16x4 bfr[8], cfr[8];
#pragma unroll
    for (int j = 0; j < 8; ++j) {
        const int pp = 16 * j + n16, p = pp & 63; const float* tb = tbase + (size_t)p * 36 + (pp < 64 ? 4 : 20) + 4 * q4;
        u32x2 w2; w2.x = pack2(tb[0], tb[1]); w2.y = pack2(tb[2], tb[3]);
        bfr[j] = __builtin_bit_cast(s16x4, w2);
    }
    {
        const float* cre = c.in[29] + ((size_t)((l * 2 + dir) * 16 + g) * 16 + n16) * 64; const float* cim = c.in[30] + ((size_t)((l * 2 + dir) * 16 + g) * 16 + n16) * 64;
#pragma unroll
        for (int s = 0; s < 8; ++s) {
            const int pp = 16 * s + 4 * q4; const float sg = pp < 64 ? 1.f : -1.f; const float* src = (pp < 64 ? cre + pp : cim + (pp - 64));
            u32x2 w2; w2.x = pack2(sg * src[0], sg * src[1]); w2.y = pack2(sg * src[2], sg * src[3]);
            cfr[s] = __builtin_bit_cast(s16x4, w2);
        }
    }
    const float are = tbase[(size_t)lane * 36], aim = tbase[(size_t)lane * 36 + 1];
    const int cd = dir == 0 ? ct : (ct < S5NC ? S5NC - 1 - ct : S5N + S5NC - 1 - ct);
    float xr = 0.f, xi = 0.f;
    if (!LOCAL) { const float2 ci = *(const float2*)(CIN + ((size_t)(((b * 2 + dir) * 16 + g) * S5N + cd) * 64 + lane) * 2); xr = ci.x; xi = ci.y; }
    const float dsk = c.in[31][(size_t)l * 256 + g * 16 + n16];
    bf16_t* BU = (bf16_t*)(L + S5_WV + wave * 8192); bf16_t* XB = BU + 16 * 128;
    float* YS = (float*)(L + S5_YS) + dir * 64 * 64;
    __syncthreads();
#pragma unroll 1
    for (int sb = 0; sb < 4; ++sb) {
        const int stepA = 16 * sb + n16, tlA = dir == 0 ? stepA : 63 - stepA;
        const s16x4 af = __builtin_bit_cast(s16x4, *(const u32x2*)(L + S5_US + tlA * 128 + gl * 32 + q4 * 8));
#pragma unroll
        for (int j = 0; j < 8; ++j) {
            f32x4 acc = {0.f, 0.f, 0.f, 0.f};
            acc = __builtin_amdgcn_mfma_f32_16x16x16bf16_1k(af, bfr[j], acc, 0, 0, 0);
#pragma unroll
            for (int rr = 0; rr < 4; ++rr) {
                const unsigned me = pack2(acc[rr], 0.f) & 0xffffu, nb = (unsigned)__shfl_xor((int)me, 1, 64);
                if ((n16 & 1) == 0) *(unsigned*)(BU + (4 * q4 + rr) * 128 + 16 * j + n16) = me | (nb << 16);
            }
        }
        asm volatile("s_waitcnt lgkmcnt(0)" ::: "memory");
        __builtin_amdgcn_wave_barrier();
#pragma unroll
        for (int ii = 0; ii < 16; ++ii) {
            const float br = bf2f(BU[ii * 128 + lane]), bi = bf2f(BU[ii * 128 + 64 + lane]);
            const float nr = are * xr - aim * xi + br, ni = are * xi + aim * xr + bi; xr = nr; xi = ni;
            if (!LOCAL) {
                const unsigned mr = pack2(xr, 0.f) & 0xffffu, mi = pack2(xi, 0.f) & 0xffffu, nr2 = (unsigned)__shfl_xor((int)mr, 1, 64), ni2 = (unsigned)__shfl_xor((int)mi, 1, 64);
                if ((lane & 1) == 0) { *(unsigned*)(XB + ii * 128 + lane) = mr | (nr2 << 16); *(unsigned*)(XB + ii * 128 + 64 + lane) = mi | (ni2 << 16); }
            }
        }
        asm volatile("s_waitcnt lgkmcnt(0)" ::: "memory");
        __builtin_amdgcn_wave_barrier();
        if (LOCAL) continue;
        f32x4 ya = {0.f, 0.f, 0.f, 0.f};
#pragma unroll
        for (int s = 0; s < 8; ++s) {
            const s16x4 xf = __builtin_bit_cast(s16x4, *(const u32x2*)((const unsigned char*)XB + n16 * 256 + (16 * s + 4 * q4) * 2));
            ya = __builtin_amdgcn_mfma_f32_16x16x16bf16_1k(xf, cfr[s], ya, 0, 0, 0);
        }
#pragma unroll
        for (int rr = 0; rr < 4; ++rr) {
            const int step = 16 * sb + 4 * q4 + rr, tl = dir == 0 ? step : 63 - step;
            float y = ya[rr];
            if (dir == 0) y += dsk * bf2f(*(const bf16_t*)(L + S5_US + tl * 128 + (gl * 16 + n16) * 2));
            YS[tl * 64 + gl * 16 + n16] = y;
        }
    }
    if (LOCAL) { *(float2*)((float*)(c.ws + WS_WSM + OFF_S5E) + ((size_t)(((b * 2 + dir) * 16 + g) * S5N + cd) * 64 + lane) * 2) = make_float2(xr, xi); return; }
    __syncthreads();
    bf16_t* ZG = (bf16_t*)(c.ws + WS_MISC + MS_ZG);
    {
        const float* Y0 = (const float*)(L + S5_YS); const float* Y1 = Y0 + 64 * 64;
        for (int e = c.tid; e < 64 * 16; e += NTHR) {
            const int i = e >> 4, c4 = (e & 15) * 4; const float4 y0 = *(const float4*)(Y0 + i * 64 + c4), y1 = *(const float4*)(Y1 + i * 64 + c4);
            *(u32x2*)(ZG + (size_t)(b * TZ + ct * S5C + i) * 256 + gq * 64 + c4) = pack4(gelu_tanh(y0.x + y1.x), gelu_tanh(y0.y + y1.y), gelu_tanh(y0.z + y1.z), gelu_tanh(y0.w + y1.w));
        }
    }
}

DI void phase_small_gemms(const Ctx& c, int l) {
    unsigned char* ws = c.ws; unsigned char* wsm = ws + WS_WSM;
    const bf16_t* CQN = (const bf16_t*)(ws + WS_MISC + MS_CQN);
    const float* rope = (const float*)(wsm + OFF_ROPE);
    constexpr int NMT = NZ / 256;
    int base = 0;
    const int G = gridDim.x, bid = blockIdx.x;
    {
        const bf16_t* W = (const bf16_t*)(wsm + OFF_WUQT + l * SZ_WUQT); bf16_t* QM = (bf16_t*)(ws + WS_EXPW + MX_QM);
        const float qs = 0.10206207261596577f * LOG2E;
        for (int u = (bid + G - base % G) % G; u < NMT * 3; u += G) {
            const int mt = u / 3, nt = u % 3, r0 = mt * 256, c0 = nt * 128;
            gemm_tile<4, 0>(c, 256, [&](int i) { return CQN + (size_t)(r0 + i) * 384; }, [&](int i) { return W + (size_t)(c0 + i) * 256; }, NoHook(),
                [&](f32x4 (&acc)[4][4], int wr, int wc, int fr, int fq) {
#pragma unroll
                    for (int n = 0; n < 4; ++n) {
                        const int col = c0 + wc + n * 16 + fq * 4, h = col / 96, d = col % 96;
                        const bool rp = d >= 64;
#pragma unroll
                        for (int m = 0; m < 4; ++m) {
                            const int row = r0 + wr + m * 16 + fr, b = row / TZ, s = row % TZ; f32x4 v = acc[m][n];
                            f32x4 pv; pv[0] = __shfl_xor(v[0], 32, 64); pv[1] = __shfl_xor(v[1], 32, 64); pv[2] = __shfl_xor(v[2], 32, 64); pv[3] = __shfl_xor(v[3], 32, 64);
                            if (rp && s >= CTX) {
                                const int i0 = d - 64;
                                const float* cs = rope + ((size_t)(s - CTX) * 16 + (i0 >> 4) * 8 + (i0 & 7)) * 2;
                                const bool hi = (i0 & 8) != 0;
#pragma unroll
                                for (int j = 0; j < 4; ++j) v[j] = v[j] * cs[2 * j] + (hi ? pv[j] : -pv[j]) * cs[2 * j + 1];
                            }
                            *(u32x2*)(QM + ((size_t)(b * 4 + h) * TZ + s) * 96 + d) = pack4(v[0] * qs, v[1] * qs, v[2] * qs, v[3] * qs);
                        }
                    }
                });
        }
        base += NMT * 3;
    }
    {
        const bf16_t* W = (const bf16_t*)(wsm + OFF_WUKVT + l * SZ_WUKVT); bf16_t* KM = (bf16_t*)(ws + WS_EXPW + MX_KM); bf16_t* VMT = (bf16_t*)(ws + WS_EXPW + MX_VMT);
        for (int u = (bid + G - base % G) % G; u < NMT * 4; u += G) {
            const int mt = u / 4, nt = u % 4, r0 = mt * 256, c0 = nt * 128;
            gemm_tile<4, 0>(c, 128, [&](int i) { return CQN + (size_t)(r0 + i) * 384 + 256; }, [&](int i) { return W + (size_t)(c0 + i) * 128; }, NoHook(),
                [&](f32x4 (&acc)[4][4], int wr, int wc, int fr, int fq) {
#pragma unroll
                    for (int n = 0; n < 4; ++n) {
                        const int col = c0 + wc + n * 16 + fq * 4, h = col >> 7, d = col & 127;
#pragma unroll
                        for (int m = 0; m < 4; ++m) {
                            const int row = r0 + wr + m * 16 + fr, b = row / TZ, s = row % TZ; const f32x4 v = acc[m][n];
                            if (d < 64) *(u32x2*)(KM + ((size_t)(b * 4 + h) * TZ + s) * 96 + d) = pack4(v[0], v[1], v[2], v[3]);
                            else {
#pragma unroll
                                for (int j = 0; j < 4; ++j) VMT[((size_t)(b * 4 + h) * 64 + (d - 64 + j)) * TZ + s] = f2bf(v[j]);
                            }
                        }
                    }
                });
        }
        base += NMT * 4;
    }
    bf16_t* SE = (bf16_t*)(ws + WS_P + P_PR); bf16_t* SAD = SE + (size_t)2 * NZ * 256; bf16_t* SKD = SAD + (size_t)2 * NZ * 256;
    {
        const bf16_t* A = (const bf16_t*)(ws + WS_MISC + MS_TW); const bf16_t* W = (const bf16_t*)(wsm + OFF_W2T + l * SZ_W2T);
        const float* w0 = c.in[14] + (size_t)l * 512;
        for (int u = (bid + G - base % G) % G; u < NMT * 4; u += G) {
            const int mt = u / 4, nt = u % 4, r0 = mt * 256, c0 = nt * 128;
            gemm_tile<4, 0>(c, 64, [&](int i) { return A + (size_t)(r0 + i) * 64; }, [&](int i) { return W + (size_t)(c0 + i) * 64; }, NoHook(),
                [&](f32x4 (&acc)[4][4], int wr, int wc, int fr, int fq) {
#pragma unroll
                    for (int n = 0; n < 4; ++n) {
                        const int col = c0 + wc + n * 16 + fq * 4, d = col >> 8, cc = col & 255; const float4 w0v = *(const float4*)(w0 + col);
#pragma unroll
                        for (int m = 0; m < 4; ++m) {
                            const int row = r0 + wr + m * 16 + fr; const f32x4 v = acc[m][n]; float e[4];
                            const float x[4] = {w0v.x + v[0], w0v.y + v[1], w0v.z + v[2], w0v.w + v[3]};
#pragma unroll
                            for (int j = 0; j < 4; ++j) e[j] = 0.6065306597126334f * sigmoidf_(x[j]);
                            *(u32x2*)(SE + ((size_t)d * NZ + row) * 256 + cc) = pack4(e[0], e[1], e[2], e[3]);
                        }
                    }
                });
        }
        base += NMT * 4;
    }
    {
        const bf16_t* A = (const bf16_t*)(ws + WS_MISC + MS_AL); const bf16_t* W = (const bf16_t*)(wsm + OFF_A2T + l * SZ_A2T);
        const float* a0 = c.in[16] + (size_t)l * 512; const float* k_a = c.in[20] + (size_t)l * 256; const bf16_t* KB = (const bf16_t*)(ws + WS_EXPW + MX_KB);
        for (int u = (bid + G - base % G) % G; u < NMT * 4; u += G) {
            const int mt = u / 4, nt = u % 4, r0 = mt * 256, c0 = nt * 128;
            gemm_tile<4, 0>(c, 64, [&](int i) { return A + (size_t)(r0 + i) * 64; }, [&](int i) { return W + (size_t)(c0 + i) * 64; }, NoHook(),
                [&](f32x4 (&acc)[4][4], int wr, int wc, int fr, int fq) {
#pragma unroll
                    for (int n = 0; n < 4; ++n) {
                        const int col = c0 + wc + n * 16 + fq * 4, d = col >> 8, cc = col & 255; const float4 a0v = *(const float4*)(a0 + col), kav = *(const float4*)(k_a + cc);
#pragma unroll
                        for (int m = 0; m < 4; ++m) {
                            const int row = r0 + wr + m * 16 + fr; const f32x4 v = acc[m][n];
                            const float ad0 = sigmoidf_(a0v.x + v[0]), ad1 = sigmoidf_(a0v.y + v[1]), ad2 = sigmoidf_(a0v.z + v[2]), ad3 = sigmoidf_(a0v.w + v[3]);
                            float k[4]; unpack4(*(const u32x2*)(KB + (size_t)row * 256 + cc), k);
                            *(u32x2*)(SAD + ((size_t)d * NZ + row) * 256 + cc) = pack4(ad0, ad1, ad2, ad3);
                            *(u32x2*)(SKD + ((size_t)d * NZ + row) * 256 + cc) = pack4(k[0] * (1.f + (ad0 - 1.f) * kav.x), k[1] * (1.f + (ad1 - 1.f) * kav.y), k[2] * (1.f + (ad2 - 1.f) * kav.z), k[3] * (1.f + (ad3 - 1.f) * kav.w));
                        }
                    }
                });
        }
        base += NMT * 4;
    }
    {
        const bf16_t* A = (const bf16_t*)(ws + WS_MISC + MS_SG); const bf16_t* W = (const bf16_t*)(wsm + OFF_G2T + l * SZ_G2T); bf16_t* GG = (bf16_t*)(ws + WS_MISC + MS_GG);
        for (int u = (bid + G - base % G) % G; u < NMT * 2; u += G) {
            const int mt = u / 2, nt = u % 2, r0 = mt * 256, c0 = nt * 128;
            gemm_tile<4, 0>(c, 128, [&](int i) { return A + (size_t)(r0 + i) * 128; }, [&](int i) { return W + (size_t)(c0 + i) * 128; }, NoHook(),
                [&](f32x4 (&acc)[4][4], int wr, int wc, int fr, int fq) {
#pragma unroll
                    for (int n = 0; n < 4; ++n)
#pragma unroll
                        for (int m = 0; m < 4; ++m) { const f32x4 v = acc[m][n];
                            *(u32x2*)(GG + (size_t)(r0 + wr + m * 16 + fr) * 256 + c0 + wc + n * 16 + fq * 4) = pack4(v[0], v[1], v[2], v[3]); }
                });
        }
        base += NMT * 2;
    }
}

DI int krow(int s, int h, int j) { return 16 * s + 8 * (j >> 2) + 4 * h + (j & 3); }
#ifndef ATT_THR
#define ATT_THR 64.f
#endif
constexpr int ATT_PARK = 56 * 1024;
template <int MODE>
DI void attn_pass(const Ctx& c, int l, int b, int h, int q0, int nkeys) {
    constexpr int DROW = MODE == 0 ? 96 : 64;
    constexpr int DQ = MODE == 0 ? 96 : 32, KS = DQ / 16;
    constexpr int DOFF = MODE == 2 ? 32 : 0;
    constexpr int TK = 128;
    constexpr int KPITCH = DQ * 2 + 16;
    constexpr int VPITCH = TK * 2 + 16;
    constexpr int KBYTES = TK * KPITCH, VBYTES = 64 * VPITCH, STG = KBYTES + VBYTES;
    static_assert(MODE == 0 || 2 * STG <= ATT_PARK, "the staging buffers must stay below the parked o1");
    unsigned char* ws = c.ws; int tid_ = c.tid; asm volatile("" : "+v"(tid_));
    const int tid = tid_, lane = tid & 63, wave = __builtin_amdgcn_readfirstlane(tid >> 6), r = lane & 31, hh = lane >> 5;
    const bf16_t* Q = (const bf16_t*)(ws + WS_EXPW + (MODE == 0 ? MX_QM : MX_QD)) + (size_t)(b * 4 + h) * TZ * DROW + DOFF;
    const bf16_t* Kp = (const bf16_t*)(ws + WS_EXPW + (MODE == 0 ? MX_KM : MX_KD)) + (size_t)(b * 4 + h) * TZ * DROW + DOFF;
    const bf16_t* Vt = (const bf16_t*)(ws + WS_EXPW + (MODE == 0 ? MX_VMT : MX_VDT)) + (size_t)(b * 4 + h) * 64 * TZ;
    unsigned char* smem = c.smem;
    bf16x8 qf[KS];
    const int qrow = q0 + wave * 32 + r;
#pragma unroll
    for (int ks = 0; ks < KS; ++ks) qf[ks] = *(const bf16x8*)(Q + (size_t)qrow * DROW + ks * 16 + hh * 8);
    f32x16 oacc[2];
    float mref = 0.f, lrun = 0.f;
#pragma unroll
    for (int t = 0; t < 2; ++t)
#pragma unroll
        for (int i = 0; i < 16; ++i) oacc[t][i] = 0.f;
    constexpr int CPR = DQ / 8, KCH = TK * CPR, NKR = KCH / NTHR;
    static_assert(KCH % NTHR == 0, "whole staging rounds");
    u32x4 kreg[NKR], vreg[2];
    const bf16_t* kp[NKR]; int koff[NKR];
#pragma unroll
    for (int i = 0; i < NKR; ++i) { const int ch = tid + i * NTHR; kp[i] = Kp + ((long)(ch / CPR) - 64) * DROW + (ch % CPR) * 8; koff[i] = (ch / CPR) * KPITCH + (ch % CPR) * 16; }
    const bf16_t* vp = Vt + (size_t)(tid >> 4) * TZ + (tid & 15) * 8 - 64;
    const int voff = (tid >> 4) * VPITCH + (tid & 15) * 16;
    auto gloadK = [&]() {
#pragma unroll
        for (int i = 0; i < NKR; ++i) { kreg[i] = *(const u32x4*)kp[i]; kp[i] += TK * DROW; }
    };
    auto gloadV = [&]() { vreg[0] = *(const u32x4*)vp; vreg[1] = *(const u32x4*)(vp + (size_t)32 * TZ); vp += TK; };
    auto lstoreK = [&](int buf) {
        unsigned char* sk = smem + buf * STG;
#pragma unroll
        for (int i = 0; i < NKR; ++i) *(u32x4*)(sk + koff[i]) = kreg[i];
    };
    auto lstoreV = [&](int buf) { unsigned char* sv = smem + buf * STG + KBYTES; *(u32x4*)(sv + voff) = vreg[0]; *(u32x4*)(sv + voff + 32 * VPITCH) = vreg[1]; };
    const int kbase = r * KPITCH + hh * 16, vbase = KBYTES + r * VPITCH + hh * 8;
    auto ldfrag = [&](const unsigned char* kb, const unsigned char* vb, int ci) -> u32x4 {
        if (ci < 8) {
            const int kg = ci >> 2, s = (ci >> 1) & 1, t = ci & 1;
            const unsigned char* vrow = vb + t * 32 * VPITCH + (kg * 32 + 16 * s) * 2;
            const u32x2 lo = *(const u32x2*)vrow, hi2 = *(const u32x2*)(vrow + 16);
            u32x4 vv; vv.x = lo.x; vv.y = lo.y; vv.z = hi2.x; vv.w = hi2.y; return vv;
        }
        const int q = ci - 8, kg = q & 1, ks = q >> 1;
        return *(const u32x4*)(kb + kg * 32 * KPITCH + ks * 32);
    };
    constexpr int NM = 8 + 2 * KS;
    const f32x16 zero16 = {0.f, 0.f, 0.f, 0.f, 0.f, 0.f, 0.f, 0.f, 0.f, 0.f, 0.f, 0.f, 0.f, 0.f, 0.f, 0.f};
    auto pv_all = [&](const u32x4 (&P)[4], const unsigned char* vb) {
#pragma unroll
        for (int ci = 0; ci < 8; ++ci) { const u32x4 f = ldfrag(vb, vb, ci); oacc[ci & 1] = __builtin_amdgcn_mfma_f32_32x32x16_bf16(__builtin_bit_cast(bf16x8, f), __builtin_bit_cast(bf16x8, P[ci >> 1]), oacc[ci & 1], 0, 0, 0); }
    };
    auto iter = [&](f32x16 (&Sc)[2], f32x16 (&Sn)[2], u32x4 (&Pp)[4], u32x4 (&Pn)[4], const unsigned char* kb, const unsigned char* vb, bool first) {
        u32x4 fcur = ldfrag(kb, vb, 0), fnx1 = ldfrag(kb, vb, 1);
        float mx = Sc[0][0];
#pragma unroll
        for (int kg = 0; kg < 2; ++kg)
#pragma unroll
            for (int i = 0; i < 16; ++i) mx = fmaxf(mx, Sc[kg][i]);
        const bool need0 = (mx - mref > ATT_THR) || (first && mx < -32.f);
        if (__any(need0)) {
            pv_all(Pp, vb);
#pragma unroll
            for (int q = 0; q < 4; ++q) Pp[q] = (u32x4){0u, 0u, 0u, 0u};
            mx = fmaxf(mx, __shfl_xor(mx, 32, 64));
            const float hi = mx - mref;
            const bool need = (hi > ATT_THR) || (first && mx < -32.f);
            const float d = need ? hi : 0.f;
            const float alpha = first ? 1.f : __builtin_amdgcn_exp2f(-d);
            mref += d; lrun *= alpha;
#pragma unroll
            for (int t = 0; t < 2; ++t)
#pragma unroll
                for (int i = 0; i < 16; ++i) oacc[t][i] *= alpha;
        }
        if (__any(mref != 0.f)) {
#pragma unroll
            for (int kg = 0; kg < 2; ++kg)
#pragma unroll
                for (int i = 0; i < 16; ++i) Sc[kg][i] -= mref;
        }
        f32x2 ps = {0.f, 0.f};
        __builtin_amdgcn_sched_barrier(0);
#pragma unroll
        for (int ci = 0; ci < NM; ++ci) {
            u32x4 fnx2 = fnx1;
            if (ci + 2 < NM) fnx2 = ldfrag(kb, vb, ci + 2);
            if (ci < 8) oacc[ci & 1] = __builtin_amdgcn_mfma_f32_32x32x16_bf16(__builtin_bit_cast(bf16x8, fcur), __builtin_bit_cast(bf16x8, Pp[ci >> 1]), oacc[ci & 1], 0, 0, 0);
            else { const int q = ci - 8, kg = q & 1, ks = q >> 1; Sn[kg] = __builtin_amdgcn_mfma_f32_32x32x16_bf16(__builtin_bit_cast(bf16x8, fcur), qf[ks], ks == 0 ? zero16 : Sn[kg], 0, 0, 0); }
#pragma unroll
            for (int p = (ci * 16) / NM; p < ((ci + 1) * 16) / NM; ++p) {
                const int kg = p >> 3, q = p & 7;
                const float p0 = __builtin_amdgcn_exp2f(Sc[kg][2 * q]), p1 = __builtin_amdgcn_exp2f(Sc[kg][2 * q + 1]);
                ps += (f32x2){p0, p1};
                Pn[kg * 2 + (q >> 2)][q & 3] = pack2(p0, p1);
            }
            asm volatile("" : "+v"(ps));
            fcur = fnx1; fnx1 = fnx2;
            __builtin_amdgcn_sched_barrier(0);
        }
        lrun += ps.x + ps.y;
    };
    const int NT = nkeys / TK;
    f32x16 S0[2], S1[2]; u32x4 PA[4], PB[4];
#pragma unroll
    for (int q = 0; q < 4; ++q) PA[q] = (u32x4){0u, 0u, 0u, 0u};
    __syncthreads();
    gloadK();
    lstoreK(1);
    gloadK();
    if ((tid & 15) >= 8) gloadV(); else { vreg[0] = (u32x4){0u, 0u, 0u, 0u}; vreg[1] = vreg[0]; vp += TK; }
    __syncthreads();
    {
        const unsigned char* kb = smem + STG + 64 * KPITCH + kbase;
#pragma unroll
        for (int q = 0; q < 2 * KS; ++q) { const int kg = q & 1, ks = q >> 1; const u32x4 f = ldfrag(kb, kb, 8 + q); S0[kg] = __builtin_amdgcn_mfma_f32_32x32x16_bf16(__builtin_bit_cast(bf16x8, f), qf[ks], ks == 0 ? zero16 : S0[kg], 0, 0, 0); }
    }
    for (int s = 0; s < NT; ++s) {
        lstoreK(s & 1); lstoreV(s & 1);
        if (s + 1 < NT) gloadK();
        gloadV();
        __syncthreads();
        const unsigned char* sb = smem + (s & 1) * STG;
        iter(S0, S1, PA, PB, sb + kbase, sb + vbase, s == 0);
        iter(S1, S0, PB, PA, sb + 64 * KPITCH + kbase, sb + 128 + vbase, false);
    }
    lstoreV(NT & 1);
    __syncthreads();
    pv_all(PA, smem + (NT & 1) * STG + vbase);
    const float inv = 1.f / (lrun + __shfl_xor(lrun, 32, 64));
    bf16_t* Ycat = (bf16_t*)(ws + WS_BUFA);
    const int zrow = b * TZ + qrow;
    float* park = (float*)(smem + ATT_PARK) + tid;
    if (MODE == 0) {
#pragma unroll
        for (int t = 0; t < 2; ++t)
#pragma unroll
            for (int i4 = 0; i4 < 4; ++i4) {
                const int dv = t * 32 + 8 * i4 + 4 * hh;
                *(u32x2*)(Ycat + (size_t)zrow * D + h * 64 + dv) = pack4(oacc[t][4 * i4] * inv, oacc[t][4 * i4 + 1] * inv, oacc[t][4 * i4 + 2] * inv, oacc[t][4 * i4 + 3] * inv);
            }
    } else if (MODE == 1) {
#pragma unroll
        for (int t = 0; t < 2; ++t)
#pragma unroll
            for (int i = 0; i < 16; ++i) park[(t * 16 + i) * NTHR] = oacc[t][i] * inv;
    } else {
        const float lam = ((const float*)(ws + WS_WSM + OFF_LAM))[l];
        const float lam_init = 0.8f - 0.6f * __expf(-0.3f * (float)l);
        float ss = 0.f;
#pragma unroll
        for (int t = 0; t < 2; ++t)
#pragma unroll
            for (int i = 0; i < 16; ++i) { const float o = park[(t * 16 + i) * NTHR] - lam * oacc[t][i] * inv; oacc[t][i] = o; ss += o * o; }
        ss += __shfl_xor(ss, 32, 64);
        const float rs = rsqrtf(ss * (1.f / 64.f) + 1e-5f) * (1.f - lam_init);
        const float* sg = c.in[38] + l * 64;
#pragma unroll
        for (int t = 0; t < 2; ++t)
#pragma unroll
            for (int i4 = 0; i4 < 4; ++i4) {
                const int dv = t * 32 + 8 * i4 + 4 * hh; const float4 g = *(const float4*)(sg + dv);
                *(u32x2*)(Ycat + (size_t)zrow * D + 768 + h * 64 + dv) = pack4(oacc[t][4 * i4] * rs * g.x, oacc[t][4 * i4 + 1] * rs * g.y, oacc[t][4 * i4 + 2] * rs * g.z, oacc[t][4 * i4 + 3] * rs * g.w);
            }
    }
}
DI void phase_attention(const Ctx& c, int l) {
    const int nu = 512 + (l == 0 ? 16 : 0);
    for (int u = blockIdx.x; u < nu; u += gridDim.x) {
        int b, h, q0, nk; bool mla;
        if (u < 512) { const int k = u & 255, bh = k & 7; b = bh >> 2; h = bh & 3; q0 = CTX + (k >> 3) * 256; nk = TZ; mla = u < 256; }
        else { const int k = u - 512; b = (k >> 2) & 1; h = k & 3; q0 = 0; nk = CTX; mla = k < 8; }
        if (mla) attn_pass<0>(c, l, b, h, q0, nk);
        else { attn_pass<1>(c, l, b, h, q0, nk); attn_pass<2>(c, l, b, h, q0, nk); }
    }
}

DI int rw_tok(int dir, int i) { return dir == 0 ? i : (i < CTX ? CTX - 1 - i : TZ - 1 - (i - CTX)); }
constexpr int RW_TS = 32;
constexpr int RW_STEP_F = 6 * 64 + 2;
constexpr int RW_BUF_F = RW_TS * RW_STEP_F;
template <int CTRL> DI float dpp_add(float x) { return x + __int_as_float(__builtin_amdgcn_update_dpp(0, __float_as_int(x), CTRL, 0xf, 0xf, false)); }
DI float red16(float x) { x = dpp_add<0xB1>(x); x = dpp_add<0x4E>(x); x = dpp_add<0x141>(x); x = dpp_add<0x140>(x); return x; }
DI float red8(float x) { x = dpp_add<0xB1>(x); x = dpp_add<0x4E>(x); x = dpp_add<0x141>(x); return x; }
struct RwRegs { u32x4 r, v, kk, e, ad, kd; };
DI void rw_load(const Ctx& c, int b, int h, int dir, int chunk, int t, RwRegs& g) {
    const bf16_t* RB = (const bf16_t*)(c.ws + WS_EXPW + MX_RB); const bf16_t* VB = (const bf16_t*)(c.ws + WS_EXPW + MX_VB); const bf16_t* KKB = (const bf16_t*)(c.ws + WS_EXPW + MX_KKB);
    const bf16_t* SE = (const bf16_t*)(c.ws + WS_P + P_PR) + (size_t)dir * NZ * 256; const bf16_t* SAD = SE + (size_t)2 * NZ * 256; const bf16_t* SKD = SAD + (size_t)2 * NZ * 256;
    const int i = chunk * RW_TS + (t >> 3), z = b * TZ + rw_tok(dir, i); const size_t o = (size_t)z * 256 + h * 64 + (t & 7) * 8;
    g.r = *(const u32x4*)(RB + o); g.v = *(const u32x4*)(VB + o); g.kk = *(const u32x4*)(KKB + o);
    g.e = *(const u32x4*)(SE + o); g.ad = *(const u32x4*)(SAD + o); g.kd = *(const u32x4*)(SKD + o);
}
DI void up8(const u32x4& u, float (&f)[8]) { f[0] = lo2f(u.x); f[1] = hi2f(u.x); f[2] = lo2f(u.y); f[3] = hi2f(u.y); f[4] = lo2f(u.z); f[5] = hi2f(u.z); f[6] = lo2f(u.w); f[7] = hi2f(u.w); }
DI void rw_process(const RwRegs& g, int t, float* buf) {
    float r[8], v[8], kk[8], e[8], ad[8], kd[8];
    up8(g.r, r); up8(g.v, v); up8(g.kk, kk); up8(g.e, e); up8(g.ad, ad); up8(g.kd, kd);
    float* f = buf + (t >> 3) * RW_STEP_F + (t & 7) * 8;
    float w[8], bv[8], wr[8]; float br = 0.f, kr = 0.f;
#pragma unroll
    for (int j = 0; j < 8; ++j) { w[j] = __expf(-e[j]); bv[j] = kk[j] * ad[j]; wr[j] = w[j] * r[j]; br += bv[j] * r[j]; kr += kd[j] * r[j]; }
    *(float4*)(f) = make_float4(w[0], w[1], w[2], w[3]); *(float4*)(f + 4) = make_float4(w[4], w[5], w[6], w[7]);
    *(float4*)(f + 64) = make_float4(kk[0], kk[1], kk[2], kk[3]); *(float4*)(f + 68) = make_float4(kk[4], kk[5], kk[6], kk[7]);
    *(float4*)(f + 128) = make_float4(bv[0], bv[1], bv[2], bv[3]); *(float4*)(f + 132) = make_float4(bv[4], bv[5], bv[6], bv[7]);
    *(float4*)(f + 192) = make_float4(kd[0], kd[1], kd[2], kd[3]); *(float4*)(f + 196) = make_float4(kd[4], kd[5], kd[6], kd[7]);
    *(float4*)(f + 256) = make_float4(wr[0], wr[1], wr[2], wr[3]); *(float4*)(f + 260) = make_float4(wr[4], wr[5], wr[6], wr[7]);
    *(float4*)(f + 320) = make_float4(v[0], v[1], v[2], v[3]); *(float4*)(f + 324) = make_float4(v[4], v[5], v[6], v[7]);
    br = red8(br); kr = red8(kr);
    if ((t & 7) == 0) { float* s = buf + (t >> 3) * RW_STEP_F + 384; s[0] = br; s[1] = kr; }
}
struct RwStep { float4 w, kk, bv, kd, wr; float vv, br, kr; };
DI void rw_ld(RwStep& s, const float* f, int kq, int row) {
    s.w = *(const float4*)(f + kq * 4); s.kk = *(const float4*)(f + 64 + kq * 4); s.bv = *(const float4*)(f + 128 + kq * 4);
    s.kd = *(const float4*)(f + 192 + kq * 4); s.wr = *(const float4*)(f + 256 + kq * 4); s.vv = f[320 + row]; s.br = f[384]; s.kr = f[385];
}
DI void phase_rwkv_scan_unit(const Ctx& c, int l, int u) {
    const int rg = u & 3, chain = u >> 2, dir = chain & 1, h = (chain >> 1) & 3, b = chain >> 3;
    float* buf0 = (float*)c.smem; float* buf1 = buf0 + RW_BUF_F;
    float* ybuf = buf1 + RW_BUF_F;
    float* YO = (float*)(c.ws + WS_BUFB) + (size_t)dir * NZ * 256 + (size_t)b * TZ * 256 + h * 64 + rg * 16;
    const int wave = c.wave, lane = c.lane, rr = lane >> 4, kq = lane & 15, rl = (wave & 3) * 4 + rr, row = rg * 16 + rl;
    const int t = c.tid - 256;
    float S0 = 0.f, S1 = 0.f, S2 = 0.f, S3 = 0.f;
    constexpr int NCH = TZ / RW_TS;
    RwRegs g;
    __syncthreads();
    if (wave >= 4) { rw_load(c, b, h, dir, 0, t, g); rw_process(g, t, buf0); rw_load(c, b, h, dir, 1, t, g); }
    __syncthreads();
    for (int ch = 0; ch < NCH; ++ch) {
        float* cur = buf0 + (ch & 1) * RW_BUF_F; float* nxt = buf0 + ((ch + 1) & 1) * RW_BUF_F;
        if (wave >= 4) {
            if (ch > 0) {
                const float* yb = ybuf + ((ch - 1) & 1) * RW_TS * 16;
#pragma unroll
                for (int i = 0; i < 2; ++i) { const int e = t + i * 256, st = e >> 4, rw = e & 15; YO[(size_t)rw_tok(dir, (ch - 1) * RW_TS + st) * 256 + rw] = yb[e]; }
            }
            if (ch + 1 < NCH) rw_process(g, t, nxt);
            if (ch + 2 < NCH) rw_load(c, b, h, dir, ch + 2, t, g);
        } else {
            float* yb = ybuf + (ch & 1) * RW_TS * 16 + rl;
            RwStep s0, s1;
            rw_ld(s0, cur, kq, row);
#pragma unroll 4
            for (int st = 0; st < RW_TS; st += 2) {
                rw_ld(s1, cur + (st + 1) * RW_STEP_F, kq, row);
                {
                    float sa = -((S0 * s0.kk.x + S1 * s0.kk.y) + (S2 * s0.kk.z + S3 * s0.kk.w));
                    float q = (S0 * s0.wr.x + S1 * s0.wr.y) + (S2 * s0.wr.z + S3 * s0.wr.w);
                    sa = red16(sa); q = red16(q);
                    S0 = fmaf(sa, s0.bv.x, fmaf(S0, s0.w.x, s0.vv * s0.kd.x)); S1 = fmaf(sa, s0.bv.y, fmaf(S1, s0.w.y, s0.vv * s0.kd.y));
                    S2 = fmaf(sa, s0.bv.z, fmaf(S2, s0.w.z, s0.vv * s0.kd.z)); S3 = fmaf(sa, s0.bv.w, fmaf(S3, s0.w.w, s0.vv * s0.kd.w));
                    yb[st * 16] = q + sa * s0.br + s0.vv * s0.kr;
                }
                if (st + 2 < RW_TS) rw_ld(s0, cur + (st + 2) * RW_STEP_F, kq, row);
                {
                    float sa = -((S0 * s1.kk.x + S1 * s1.kk.y) + (S2 * s1.kk.z + S3 * s1.kk.w));
                    float q = (S0 * s1.wr.x + S1 * s1.wr.y) + (S2 * s1.wr.z + S3 * s1.wr.w);
                    sa = red16(sa); q = red16(q);
                    S0 = fmaf(sa, s1.bv.x, fmaf(S0, s1.w.x, s1.vv * s1.kd.x)); S1 = fmaf(sa, s1.bv.y, fmaf(S1, s1.w.y, s1.vv * s1.kd.y));
                    S2 = fmaf(sa, s1.bv.z, fmaf(S2, s1.w.z, s1.vv * s1.kd.z)); S3 = fmaf(sa, s1.bv.w, fmaf(S3, s1.w.w, s1.vv * s1.kd.w));
                    yb[(st + 1) * 16] = q + sa * s1.br + s1.vv * s1.kr;
                }
            }
        }
        __syncthreads();
    }
    if (wave >= 4) {
        const float* yb = ybuf + ((NCH - 1) & 1) * RW_TS * 16;
#pragma unroll
        for (int i = 0; i < 2; ++i) { const int e = t + i * 256, st = e >> 4, rw = e & 15; YO[(size_t)rw_tok(dir, (NCH - 1) * RW_TS + st) * 256 + rw] = yb[e]; }
    }
}

constexpr int LA_AN = 0, LA_RN = 8192, LA_BN = 16384, LA_KN = 24576, LA_AT = 32768, LA_BHT = 40960, LA_KHT = 49152, LA_VT = 57344,
              LA_NBA = 65536  , LA_NKA = 81920, LA_NBRT = 90112, LA_NKRT = 98304, LA_P63 = 106496;
constexpr int LA_TMT = LA_AN, LA_M1 = LA_BN, LA_W1T = LA_KN, LA_Z1 = LA_NBA;
DI int crow(int reg, int h) { return (reg & 3) + 8 * (reg >> 2) + 4 * h; }
DI void mm_tile(f32x16& acc, const unsigned char* A, int i0, const unsigned char* BT, int j0, int r, int h) {
#pragma unroll
    for (int ks = 0; ks < 4; ++ks) {
        const bf16x8 a = *(const bf16x8*)(A + (i0 + r) * 128 + ks * 32 + h * 16);
        const bf16x8 b = *(const bf16x8*)(BT + (j0 + r) * 128 + ks * 32 + h * 16);
        acc = __builtin_amdgcn_mfma_f32_32x32x16_bf16(a, b, acc, 0, 0, 0);
    }
}
DI void zero16(f32x16& a) {
#pragma unroll
    for (int i = 0; i < 16; ++i) a[i] = 0.f;
}
DI void phase_rwkv_chunk_unit(const Ctx& c, int l, int unit) {
    unsigned char* L = c.smem; unsigned char* ws = c.ws;
    const int chain = unit / RNC, ch = unit % RNC, dir = chain & 1, hd = (chain >> 1) & 3, b = chain >> 3;
    const int tid = c.tid, lane = c.lane, wave = c.wave, r = lane & 31, h = lane >> 5;
    const bf16_t* RB = (const bf16_t*)(ws + WS_EXPW + MX_RB); const bf16_t* VB = (const bf16_t*)(ws + WS_EXPW + MX_VB); const bf16_t* KKB = (const bf16_t*)(ws + WS_EXPW + MX_KKB);
    const bf16_t* SE = (const bf16_t*)(ws + WS_P + P_PR) + (size_t)dir * NZ * 256; const bf16_t* SAD = SE + (size_t)2 * NZ * 256; const bf16_t* SKD = SAD + (size_t)2 * NZ * 256;
    float* CUM = (float*)(L + LA_NBA);
    __syncthreads();
    const int t = tid >> 3, k0 = (tid & 7) * 8;
    float rr[8], vv[8], kk[8], ee[8], ad[8], kd[8];
    {
        const int z = b * TZ + rw_tok(dir, ch * RC + t); const size_t o = (size_t)z * 256 + hd * 64 + k0;
        up8(*(const u32x4*)(RB + o), rr); up8(*(const u32x4*)(VB + o), vv); up8(*(const u32x4*)(KKB + o), kk);
        up8(*(const u32x4*)(SE + o), ee); up8(*(const u32x4*)(SAD + o), ad); up8(*(const u32x4*)(SKD + o), kd);
        *(float4*)(CUM + t * 64 + k0) = make_float4(ee[0], ee[1], ee[2], ee[3]); *(float4*)(CUM + t * 64 + k0 + 4) = make_float4(ee[4], ee[5], ee[6], ee[7]);
    }
    __syncthreads();
    if (wave == 0) { float cm = 0.f;
#pragma unroll 8
        for (int i = 0; i < RC; ++i) { cm += CUM[i * 64 + lane]; CUM[i * 64 + lane] = cm; } }
    __syncthreads();
    {
        float cm[8], c63[8];
        { const float4 a = *(const float4*)(CUM + t * 64 + k0), bq = *(const float4*)(CUM + t * 64 + k0 + 4); cm[0] = a.x; cm[1] = a.y; cm[2] = a.z; cm[3] = a.w; cm[4] = bq.x; cm[5] = bq.y; cm[6] = bq.z; cm[7] = bq.w; }
        { const float4 a = *(const float4*)(CUM + 63 * 64 + k0), bq = *(const float4*)(CUM + 63 * 64 + k0 + 4); c63[0] = a.x; c63[1] = a.y; c63[2] = a.z; c63[3] = a.w; c63[4] = bq.x; c63[5] = bq.y; c63[6] = bq.z; c63[7] = bq.w; }
        float at[8], rt[8], bt[8], kt[8], bh[8], kh[8];
#pragma unroll
        for (int j = 0; j < 8; ++j) {
            const float pt = __expf(-cm[j]), pp = __expf(-(cm[j] - ee[j])), ip = __expf(cm[j]), ph = __expf(-(c63[j] - cm[j])), bb = kk[j] * ad[j];
            at[j] = -kk[j] * pp; rt[j] = rr[j] * pt; bt[j] = bb * ip; kt[j] = kd[j] * ip; bh[j] = bb * ph; kh[j] = kd[j] * ph;
        }
        u32x4 w4;
        w4.x = pack2(at[0], at[1]); w4.y = pack2(at[2], at[3]); w4.z = pack2(at[4], at[5]); w4.w = pack2(at[6], at[7]); *(u32x4*)(L + LA_AN + t * 128 + k0 * 2) = w4;
        w4.x = pack2(rt[0], rt[1]); w4.y = pack2(rt[2], rt[3]); w4.z = pack2(rt[4], rt[5]); w4.w = pack2(rt[6], rt[7]); *(u32x4*)(L + LA_RN + t * 128 + k0 * 2) = w4;
        w4.x = pack2(bt[0], bt[1]); w4.y = pack2(bt[2], bt[3]); w4.z = pack2(bt[4], bt[5]); w4.w = pack2(bt[6], bt[7]); *(u32x4*)(L + LA_BN + t * 128 + k0 * 2) = w4;
        w4.x = pack2(kt[0], kt[1]); w4.y = pack2(kt[2], kt[3]); w4.z = pack2(kt[4], kt[5]); w4.w = pack2(kt[6], kt[7]); *(u32x4*)(L + LA_KN + t * 128 + k0 * 2) = w4;
#pragma unroll
        for (int j = 0; j < 8; ++j) {
            *(bf16_t*)(L + LA_AT + (k0 + j) * 128 + t * 2) = f2bf(at[j]); *(bf16_t*)(L + LA_BHT + (k0 + j) * 128 + t * 2) = f2bf(bh[j]);
            *(bf16_t*)(L + LA_KHT + (k0 + j) * 128 + t * 2) = f2bf(kh[j]); *(bf16_t*)(L + LA_VT + (k0 + j) * 128 + t * 2) = f2bf(vv[j]);
        }
        if (t == 63) {
            float* p63 = (float*)(L + LA_P63); float* gp = (float*)(ws + WS_RW + RW_P63) + (size_t)unit * 64;
#pragma unroll
            for (int j = 0; j < 8; ++j) { const float p = __expf(-c63[j]); p63[k0 + j] = p; gp[k0 + j] = p; }
        }
    }
    __syncthreads();
    {
        const int p = wave >> 1, i0 = (wave & 1) * 32;
        const unsigned char* A = L + (p == 0 ? LA_BN : p == 1 ? LA_KN : LA_RN);
        const unsigned char* BT = L + (p < 2 ? LA_AN : p == 2 ? LA_BN : LA_KN);
#pragma unroll
        for (int jt = 0; jt < 2; ++jt) {
            const int j0 = jt * 32; f32x16 acc; zero16(acc);
            mm_tile(acc, A, i0, BT, j0, r, h);
            const int col = j0 + r;
#pragma unroll
            for (int g = 0; g < 16; ++g) {
                const int row = i0 + crow(g, h);
                if (p == 0) ((float*)(L + LA_NBA))[row * 64 + col] = (row < col) ? acc[g] : 0.f;
                else if (p == 1) *(bf16_t*)(L + LA_NKA + row * 128 + col * 2) = f2bf((row < col) ? acc[g] : 0.f);
                else *(bf16_t*)(L + (p == 2 ? LA_NBRT : LA_NKRT) + row * 128 + col * 2) = f2bf((col <= row) ? acc[g] : 0.f);
            }
        }
    }
    __syncthreads();
    {
        constexpr int X0 = LA_BN, X1 = LA_KN, X3 = 108544, X4 = X3 + 8192, X5 = LA_NBA + 16384 - 16384, X6 = LA_NBA + 8192;
        float nv[8];
        { const int s = tid >> 3, t0 = (tid & 7) * 8; const float* N = (const float*)(L + LA_NBA) + s * 64 + t0;
          const float4 a = *(const float4*)N, bq = *(const float4*)(N + 4); nv[0] = a.x; nv[1] = a.y; nv[2] = a.z; nv[3] = a.w; nv[4] = bq.x; nv[5] = bq.y; nv[6] = bq.z; nv[7] = bq.w; }
        __syncthreads();
        {
            const int s = tid >> 3, t0 = (tid & 7) * 8;
            u32x4 w4; w4.x = pack2(nv[0], nv[1]); w4.y = pack2(nv[2], nv[3]); w4.z = pack2(nv[4], nv[5]); w4.w = pack2(nv[6], nv[7]);
            *(u32x4*)(L + X0 + s * 128 + t0 * 2) = w4;
#pragma unroll
            for (int j = 0; j < 8; ++j) *(bf16_t*)(L + X1 + (t0 + j) * 128 + s * 2) = f2bf(nv[j]);
#pragma unroll
            for (int j = 0; j < 8; ++j) if (t0 + j == s) nv[j] += 1.f;
            w4.x = pack2(nv[0], nv[1]); w4.y = pack2(nv[2], nv[3]); w4.z = pack2(nv[4], nv[5]); w4.w = pack2(nv[6], nv[7]);
            *(u32x4*)(L + X5 + s * 128 + t0 * 2) = w4;
        }
        __syncthreads();
        const int ti0 = ((wave >> 1) & 1) * 32, tj0 = (wave & 1) * 32;
        if (wave < 4) {
            f32x16 acc; zero16(acc); mm_tile(acc, L + X0, ti0, L + X1, tj0, r, h);
#pragma unroll
            for (int g4 = 0; g4 < 4; ++g4) *(u32x2*)(L + X4 + (tj0 + r) * 128 + (ti0 + 8 * g4 + 4 * h) * 2) = pack4(acc[4 * g4], acc[4 * g4 + 1], acc[4 * g4 + 2], acc[4 * g4 + 3]);
#pragma unroll
            for (int g = 0; g < 16; ++g) *(bf16_t*)(L + X3 + (ti0 + crow(g, h)) * 128 + (tj0 + r) * 2) = f2bf(acc[g]);
        }
        __syncthreads();
#pragma unroll
        for (int k = 1; k <= 5; ++k) {
            const int qa = (k & 1) ? X3 : X0, qt = (k & 1) ? X4 : X1, nqa = (k & 1) ? X0 : X3, nqt = (k & 1) ? X1 : X4;
            const int pa = (k & 1) ? X5 : X6, npa = (k & 1) ? X6 : X5;
            if (wave >= 4) {
                f32x16 acc; zero16(acc); mm_tile(acc, L + pa, ti0, L + qt, tj0, r, h);
#pragma unroll
                for (int g = 0; g < 16; ++g) acc[g] += bf2f(*(const bf16_t*)(L + pa + (ti0 + crow(g, h)) * 128 + (tj0 + r) * 2));
                if (k < 5) {
#pragma unroll
                    for (int g = 0; g < 16; ++g) *(bf16_t*)(L + npa + (ti0 + crow(g, h)) * 128 + (tj0 + r) * 2) = f2bf(acc[g]);
                } else {
#pragma unroll
                    for (int g4 = 0; g4 < 4; ++g4) *(u32x2*)(L + LA_TMT + (tj0 + r) * 128 + (ti0 + 8 * g4 + 4 * h) * 2) = pack4(acc[4 * g4], acc[4 * g4 + 1], acc[4 * g4 + 2], acc[4 * g4 + 3]);
                }
            } else if (k < 5) {
                f32x16 acc; zero16(acc); mm_tile(acc, L + qa, ti0, L + qt, tj0, r, h);
#pragma unroll
                for (int g4 = 0; g4 < 4; ++g4) *(u32x2*)(L + nqt + (tj0 + r) * 128 + (ti0 + 8 * g4 + 4 * h) * 2) = pack4(acc[4 * g4], acc[4 * g4 + 1], acc[4 * g4 + 2], acc[4 * g4 + 3]);
#pragma unroll
                for (int g = 0; g < 16; ++g) *(bf16_t*)(L + nqa + (ti0 + crow(g, h)) * 128 + (tj0 + r) * 2) = f2bf(acc[g]);
            }
            __syncthreads();
        }
    }
    {
        const int p = wave >> 2, i0 = ((wave >> 1) & 1) * 32, j0 = (wave & 1) * 32; f32x16 acc; zero16(acc);
        if (p == 0) {
            mm_tile(acc, L + LA_TMT, i0, L + LA_AT, j0, r, h);
#pragma unroll
            for (int g4 = 0; g4 < 4; ++g4) *(u32x2*)(L + LA_M1 + (j0 + r) * 128 + (i0 + 8 * g4 + 4 * h) * 2) = pack4(acc[4 * g4], acc[4 * g4 + 1], acc[4 * g4 + 2], acc[4 * g4 + 3]);
        } else {
            mm_tile(acc, L + LA_NKA, i0, L + LA_TMT, j0, r, h);
#pragma unroll
            for (int g4 = 0; g4 < 4; ++g4) *(u32x2*)(L + LA_W1T + (j0 + r) * 128 + (i0 + 8 * g4 + 4 * h) * 2) = pack4(acc[4 * g4], acc[4 * g4 + 1], acc[4 * g4 + 2], acc[4 * g4 + 3]);
        }
    }
    __syncthreads();
    if (wave < 4) {
        const int i0 = (wave >> 1) * 32, j0 = (wave & 1) * 32; f32x16 acc; zero16(acc);
        mm_tile(acc, L + LA_W1T, i0, L + LA_VT, j0, r, h);
#pragma unroll
        for (int g4 = 0; g4 < 4; ++g4) *(u32x2*)(L + LA_Z1 + (j0 + r) * 128 + (i0 + 8 * g4 + 4 * h) * 2) = pack4(acc[4 * g4], acc[4 * g4 + 1], acc[4 * g4 + 2], acc[4 * g4 + 3]);
    }
    __syncthreads();
    {
        const int p = wave >> 1, i0 = (wave & 1) * 32;
        bf16_t* GM3 = (bf16_t*)(ws + WS_RW + RW_M3) + (size_t)unit * 4096; bf16_t* GM2 = (bf16_t*)(ws + WS_RW + RW_M2) + (size_t)unit * 4096; bf16_t* GZ5 = (bf16_t*)(ws + WS_RW + RW_Z5) + (size_t)unit * 4096;
        float* YO = (float*)(ws + WS_BUFB) + (size_t)dir * NZ * 256;
#pragma unroll
        for (int jt = 0; jt < 2; ++jt) {
            const int j0 = jt * 32; f32x16 acc; zero16(acc);
            if (p == 0) {
                mm_tile(acc, L + LA_M1, i0, L + LA_NBRT, j0, r, h);
#pragma unroll
                for (int g4 = 0; g4 < 4; ++g4) { const int tt = j0 + r, kq = i0 + 8 * g4 + 4 * h; float rv[4]; unpack4(*(const u32x2*)(L + LA_RN + tt * 128 + kq * 2), rv);
                    *(u32x2*)(GM2 + tt * 64 + kq) = pack4(acc[4 * g4] + rv[0], acc[4 * g4 + 1] + rv[1], acc[4 * g4 + 2] + rv[2], acc[4 * g4 + 3] + rv[3]); }
            } else if (p == 1) {
                mm_tile(acc, L + LA_NBRT, i0, L + LA_Z1, j0, r, h); mm_tile(acc, L + LA_NKRT, i0, L + LA_VT, j0, r, h);
#pragma unroll
                for (int g = 0; g < 16; ++g) { const int tt = i0 + crow(g, h); YO[(size_t)(b * TZ + rw_tok(dir, ch * RC + tt)) * 256 + hd * 64 + j0 + r] = acc[g]; }
            } else if (p == 2) {
                mm_tile(acc, L + LA_M1, i0, L + LA_BHT, j0, r, h);
#pragma unroll
                for (int g4 = 0; g4 < 4; ++g4) *(u32x2*)(GM3 + (j0 + r) * 64 + i0 + 8 * g4 + 4 * h) = pack4(acc[4 * g4], acc[4 * g4 + 1], acc[4 * g4 + 2], acc[4 * g4 + 3]);
            } else {
                mm_tile(acc, L + LA_BHT, i0, L + LA_Z1, j0, r, h); mm_tile(acc, L + LA_KHT, i0, L + LA_VT, j0, r, h);
#pragma unroll
                for (int g4 = 0; g4 < 4; ++g4) *(u32x2*)(GZ5 + (j0 + r) * 64 + i0 + 8 * g4 + 4 * h) = pack4(acc[4 * g4], acc[4 * g4 + 1], acc[4 * g4 + 2], acc[4 * g4 + 3]);
            }
        }
    }
}
DI void phase_rwkv_chunks(const Ctx& c, int l) {
    for (int u = blockIdx.x; u < 16 * RNC; u += gridDim.x) phase_rwkv_chunk_unit(c, l, u);
}
DI bf16x8 pack8(const f32x16& x, int s) {
    u32x4 p; p.x = pack2(x[8 * s], x[8 * s + 1]); p.y = pack2(x[8 * s + 2], x[8 * s + 3]); p.z = pack2(x[8 * s + 4], x[8 * s + 5]); p.w = pack2(x[8 * s + 6], x[8 * s + 7]);
    return __builtin_bit_cast(bf16x8, p);
}
DI bf16x8 ldfrag(const bf16_t* rowp, int s, int h) {
    const u32x2 lo = *(const u32x2*)(rowp + 16 * s + 4 * h), hi = *(const u32x2*)(rowp + 16 * s + 8 + 4 * h);
    u32x4 v; v.x = lo.x; v.y = lo.y; v.z = hi.x; v.w = hi.y; return __builtin_bit_cast(bf16x8, v);
}
constexpr int SQ_PITCH = 144, SQ_MAT = 64 * SQ_PITCH;
constexpr int SQA_M3 = 0, SQA_Z5 = SQ_MAT, SQA_P63 = 2 * SQ_MAT, SQA_BYTES = SQA_P63 + 256;
constexpr int SQB_M2 = 0, SQB_Y = SQ_MAT, SQB_BYTES = SQB_Y + 64 * 64 * 4;
constexpr int SQ_A0 = 0, SQ_B0 = 2 * SQA_BYTES, SQ_XB = SQ_B0 + 2 * SQB_BYTES;
DI bf16x8 ldfrag_l(const unsigned char* rowp, int s, int h) {
    const u32x2 lo = *(const u32x2*)(rowp + (16 * s + 4 * h) * 2), hi = *(const u32x2*)(rowp + (16 * s + 8 + 4 * h) * 2);
    u32x4 v; v.x = lo.x; v.y = lo.y; v.z = hi.x; v.w = hi.y; return __builtin_bit_cast(bf16x8, v);
}
struct SqRegsA { u32x4 m3[2], z5[2], p63; };
struct SqRegsB { u32x4 m2[2], y[4]; };
DI void sqa_gload(const Ctx& c, size_t unit, int lt, SqRegsA& g) {
    const unsigned char* g3 = c.ws + WS_RW + RW_M3 + unit * 8192; const unsigned char* g5 = c.ws + WS_RW + RW_Z5 + unit * 8192;
#pragma unroll
    for (int i = 0; i < 2; ++i) { const int id = lt + i * 256; g.m3[i] = *(const u32x4*)(g3 + id * 16); g.z5[i] = *(const u32x4*)(g5 + id * 16); }
    if (lt < 16) g.p63 = *(const u32x4*)(c.ws + WS_RW + RW_P63 + unit * 256 + lt * 16);
}
DI void sqa_lstore(unsigned char* st, int lt, const SqRegsA& g) {
#pragma unroll
    for (int i = 0; i < 2; ++i) { const int id = lt + i * 256, row = id >> 3, part = id & 7;
        *(u32x4*)(st + SQA_M3 + row * SQ_PITCH + part * 16) = g.m3[i]; *(u32x4*)(st + SQA_Z5 + row * SQ_PITCH + part * 16) = g.z5[i]; }
    if (lt < 16) *(u32x4*)(st + SQA_P63 + lt * 16) = g.p63;
}
DI void sqb_gload(const Ctx& c, size_t unit, const float* YO, int dir, int ch, int lt, SqRegsB& g) {
    const unsigned char* g2 = c.ws + WS_RW + RW_M2 + unit * 8192;
#pragma unroll
    for (int i = 0; i < 2; ++i) g.m2[i] = *(const u32x4*)(g2 + (lt + i * 256) * 16);
#pragma unroll
    for (int i = 0; i < 4; ++i) { const int id = lt + i * 256; g.y[i] = *(const u32x4*)(YO + (size_t)rw_tok(dir, ch * RC + (id >> 4)) * 256 + (id & 15) * 4); }
}
DI void sqb_lstore(unsigned char* st, int lt, const SqRegsB& g) {
#pragma unroll
    for (int i = 0; i < 2; ++i) { const int id = lt + i * 256; *(u32x4*)(st + SQB_M2 + (id >> 3) * SQ_PITCH + (id & 7) * 16) = g.m2[i]; }
#pragma unroll
    for (int i = 0; i < 4; ++i) { const int id = lt + i * 256; *(u32x4*)(st + SQB_Y + (id >> 4) * 256 + (id & 15) * 16) = g.y[i]; }
}
DI void sqb_store_y(float* YO, int dir, int ch, const unsigned char* st, int lt) {
#pragma unroll
    for (int i = 0; i < 4; ++i) { const int id = lt + i * 256; *(u32x4*)(YO + (size_t)rw_tok(dir, ch * RC + (id >> 4)) * 256 + (id & 15) * 4) = *(const u32x4*)(st + SQB_Y + (id >> 4) * 256 + (id & 15) * 16); }
}
DI void phase_rwkv_seq_block(const Ctx& c, int l, int chain) {
    unsigned char* L = c.smem; const int lane = c.lane, wave = c.wave, r = lane & 31, h = lane >> 5;
    const int dir = chain & 1, hd = (chain >> 1) & 3, b = chain >> 3, lt = c.tid - 256, vh = wave & 1;
    const size_t unit0 = (size_t)chain * RNC;
    __syncthreads();
    if (wave >= 4) {
        float* YO = (float*)(c.ws + WS_BUFB) + (size_t)dir * NZ * 256 + (size_t)b * TZ * 256 + hd * 64;
        SqRegsA ga; SqRegsB gb;
        sqa_gload(c, unit0, lt, ga); sqa_lstore(L + SQ_A0, lt, ga); sqa_gload(c, unit0 + 1, lt, ga); sqb_gload(c, unit0, YO, dir, 0, lt, gb);
        __syncthreads();
#pragma unroll 1
        for (int ch = 0; ch <= RNC; ++ch) {
            unsigned char* sb = L + SQ_B0 + (ch & 1) * SQB_BYTES;
            if (ch >= 2) sqb_store_y(YO, dir, ch - 2, sb, lt);
            if (ch < RNC) sqb_lstore(sb, lt, gb);
            if (ch + 1 < RNC) { sqb_gload(c, unit0 + ch + 1, YO, dir, ch + 1, lt, gb); sqa_lstore(L + SQ_A0 + ((ch + 1) & 1) * SQA_BYTES, lt, ga); }
            if (ch + 2 < RNC) sqa_gload(c, unit0 + ch + 2, lt, ga);
            __syncthreads();
        }
        sqb_store_y(YO, dir, RNC - 1, L + SQ_B0 + ((RNC - 1) & 1) * SQB_BYTES, lt);
    } else if (wave < 2) {
        f32x16 x[2]; zero16(x[0]); zero16(x[1]);
        __syncthreads();
#pragma unroll 1
        for (int ch = 0; ch <= RNC; ++ch) {
            if (ch < RNC) {
                const unsigned char* st = L + SQ_A0 + (ch & 1) * SQA_BYTES;
                unsigned char* xbuf = L + SQ_XB + ((ch & 1) * 2 + vh) * 4096 + lane * 16;
                bf16x8 xb[4];
#pragma unroll
                for (int s = 0; s < 4; ++s) { xb[s] = pack8(x[s >> 1], s & 1); *(bf16x8*)(xbuf + s * 1024) = xb[s]; }
                f32x16 xn0, xn1;
#pragma unroll
                for (int i = 0; i < 2; ++i) {
                    f32x16 xa;
#pragma unroll
                    for (int g4 = 0; g4 < 4; ++g4) {
                        float z5[4]; unpack4(*(const u32x2*)(st + SQA_Z5 + (vh * 32 + r) * SQ_PITCH + (32 * i + 8 * g4 + 4 * h) * 2), z5);
                        const float4 p4 = *(const float4*)(st + SQA_P63 + (32 * i + 8 * g4 + 4 * h) * 4);
                        xa[4 * g4] = fmaf(p4.x, x[i][4 * g4], z5[0]); xa[4 * g4 + 1] = fmaf(p4.y, x[i][4 * g4 + 1], z5[1]);
                        xa[4 * g4 + 2] = fmaf(p4.z, x[i][4 * g4 + 2], z5[2]); xa[4 * g4 + 3] = fmaf(p4.w, x[i][4 * g4 + 3], z5[3]);
                    }
#pragma unroll
                    for (int s = 0; s < 4; ++s) xa = __builtin_amdgcn_mfma_f32_32x32x16_bf16(ldfrag_l(st + SQA_M3 + (32 * i + r) * SQ_PITCH, s, h), xb[s], xa, 0, 0, 0);
                    if (i == 0) xn0 = xa; else xn1 = xa;
                }
                x[0] = xn0; x[1] = xn1;
            }
            __syncthreads();
        }
    } else {
        __syncthreads();
#pragma unroll 1
        for (int ch = 0; ch <= RNC; ++ch) {
            if (ch >= 1) {
                const int cy = ch - 1;
                unsigned char* st = L + SQ_B0 + (cy & 1) * SQB_BYTES;
                const unsigned char* xbuf = L + SQ_XB + ((cy & 1) * 2 + vh) * 4096 + lane * 16;
                bf16x8 xb[4];
#pragma unroll
                for (int s = 0; s < 4; ++s) xb[s] = *(const bf16x8*)(xbuf + s * 1024);
#pragma unroll
                for (int i = 0; i < 2; ++i) {
                    f32x16 ya;
#pragma unroll
                    for (int g = 0; g < 16; ++g) ya[g] = *((const float*)(st + SQB_Y) + (32 * i + crow(g, h)) * 64 + vh * 32 + r);
#pragma unroll
                    for (int s = 0; s < 4; ++s) ya = __builtin_amdgcn_mfma_f32_32x32x16_bf16(ldfrag_l(st + SQB_M2 + (32 * i + r) * SQ_PITCH, s, h), xb[s], ya, 0, 0, 0);
#pragma unroll
                    for (int g = 0; g < 16; ++g) *((float*)(st + SQB_Y) + (32 * i + crow(g, h)) * 64 + vh * 32 + r) = ya[g];
                }
            }
            __syncthreads();
        }
    }
}
DI void phase_mixers2(const Ctx& c, int l) {
    const int G = gridDim.x, bid = blockIdx.x;
    if (G >= 128) {
        if (bid < 16) phase_rwkv_seq_block(c, l, bid);
        else for (int u = bid - 16; u < 2 * S5N * 4; u += G - 16) phase_s5_final_unit<false>(c, l, u);
    } else {
        for (int u = bid; u < 16; u += G) phase_rwkv_seq_block(c, l, u);
        for (int u = bid; u < 2 * S5N * 4; u += G) phase_s5_final_unit<false>(c, l, u);
    }
}

DI void phase_post(const Ctx& c, int l) {
    unsigned char* ws = c.ws; const int lane = c.lane;
    const float* YF = (const float*)(ws + WS_BUFB); const float* YB = YF + (size_t)NZ * 256;
    const bf16_t* RB = (const bf16_t*)(ws + WS_EXPW + MX_RB); const bf16_t* VB = (const bf16_t*)(ws + WS_EXPW + MX_VB);
    const bf16_t* SKD = (const bf16_t*)(ws + WS_P + P_PR) + (size_t)4 * NZ * 256; const bf16_t* GG = (const bf16_t*)(ws + WS_MISC + MS_GG);
    bf16_t* Ycat = (bf16_t*)(ws + WS_BUFA);
    const float* r_k = c.in[21] + l * 256; const float* lg = c.in[22] + l * 256; const float* lb = c.in[23] + l * 256;
    for (int z = blockIdx.x * 8 + c.wave; z < NZ; z += gridDim.x * 8) {
        const size_t o = (size_t)z * 256 + lane * 4;
        const float4 yf = *(const float4*)(YF + o), yb = *(const float4*)(YB + o);
        const float y0 = yf.x + yb.x, y1 = yf.y + yb.y, y2 = yf.z + yb.z, y3 = yf.w + yb.w;
        const float mean = sum16(y0 + y1 + y2 + y3) * (1.f / 64.f);
        const float d0 = y0 - mean, d1 = y1 - mean, d2 = y2 - mean, d3 = y3 - mean;
        const float var = sum16(d0 * d0 + d1 * d1 + d2 * d2 + d3 * d3) * (1.f / 64.f);
        const float rs = rsqrtf(var + 64e-5f);
        float r[4], v[4], k0[4], k1[4], gg[4];
        unpack4(*(const u32x2*)(RB + o), r); unpack4(*(const u32x2*)(VB + o), v); unpack4(*(const u32x2*)(SKD + o), k0); unpack4(*(const u32x2*)(SKD + (size_t)NZ * 256 + o), k1);
        unpack4(*(const u32x2*)(GG + o), gg);
        const float4 rk = *(const float4*)(r_k + lane * 4), g4 = *(const float4*)(lg + lane * 4), b4 = *(const float4*)(lb + lane * 4);
        const float bs = sum16(r[0] * (k0[0] + k1[0]) * rk.x + r[1] * (k0[1] + k1[1]) * rk.y + r[2] * (k0[2] + k1[2]) * rk.z + r[3] * (k0[3] + k1[3]) * rk.w);
        *(u32x2*)(Ycat + (size_t)z * D + 256 + lane * 4) = pack4((d0 * rs * g4.x + b4.x + bs * v[0]) * gg[0], (d1 * rs * g4.y + b4.y + bs * v[1]) * gg[1],
                                                                (d2 * rs * g4.z + b4.z + bs * v[2]) * gg[2], (d3 * rs * g4.w + b4.w + bs * v[3]) * gg[3]);
    }
    {
        const bf16_t* ZG = (const bf16_t*)(ws + WS_MISC + MS_ZG); const bf16_t* W = (const bf16_t*)(ws + WS_WSM + OFF_GLUT + l * SZ_GLUT);
        const float* gb = c.in[33] + l * 256;
        for (int u = blockIdx.x; u < (NZ / 256) * 2; u += gridDim.x) {
            const int mt = u / 2, nt = u % 2, r0 = mt * 256, c0 = nt * 128;
            gemm_tile<4, 0>(c, 256, [&](int i) { return ZG + (size_t)(r0 + i) * 256; }, [&](int i) { return W + (size_t)(c0 + i) * 256; }, NoHook(),
                [&](f32x4 (&acc)[4][4], int wr, int wc, int fr, int fq) {
#pragma unroll
                    for (int n = 0; n < 4; ++n) {
                        const int col = c0 + wc + n * 16 + fq * 4; const float4 bb = *(const float4*)(gb + col);
#pragma unroll
                        for (int m = 0; m < 4; ++m) {
                            const int row = r0 + wr + m * 16 + fr; const f32x4 v = acc[m][n];
                            float zg[4]; unpack4(*(const u32x2*)(ZG + (size_t)row * 256 + col), zg);
                            *(u32x2*)(Ycat + (size_t)row * D + 512 + col) = pack4(zg[0] * sigmoidf_(v[0] + bb.x), zg[1] * sigmoidf_(v[1] + bb.y), zg[2] * sigmoidf_(v[2] + bb.z), zg[3] * sigmoidf_(v[3] + bb.w));
                        }
                    }
                });
        }
    }
}

DI bool skip_mt(int l, int mt) { return l == NL - 1 && (mt % 33) == 0; }
DI void phase_merge1(const Ctx& c, int l) {
    const bf16_t* Ycat = (const bf16_t*)(c.ws + WS_BUFA); const bf16_t* W = (const bf16_t*)(c.ws + WS_WSM + OFF_WBT + l * SZ_WBT);
    const bf16_t* GT = (const bf16_t*)(c.ws + WS_GT); bf16_t* MG = (bf16_t*)(c.ws + WS_BUFB);
    if (blockIdx.x == 0 && c.tid < 32) ((unsigned*)(c.ws + WS_CTL))[CW_CNT + l * 32 + c.tid] = 0u;
    for (int u = blockIdx.x; u < (NZ / 256) * 8; u += gridDim.x) {
        const int mt = u / 8, nt = u % 8, r0 = mt * 256, c0 = nt * 128;
        if (skip_mt(l, mt)) continue;
        f32x4 macc[4][4];
#pragma unroll
        for (int m = 0; m < 4; ++m)
#pragma unroll
            for (int n = 0; n < 4; ++n) macc[m][n] = (f32x4){0.f, 0.f, 0.f, 0.f};
        gemm_tile<4, 256>(c, 1024, [&](int i) { return Ycat + (size_t)(r0 + i) * D; }, [&](int i) { return W + (size_t)(c0 + i) * D; },
            [&](f32x4 (&acc)[4][4], int seg, int wr, int wc, int fr, int fq) {
#pragma unroll
                for (int m = 0; m < 4; ++m)
#pragma unroll
                    for (int n = 0; n < 4; ++n) {
                        float g[4]; unpack4(*(const u32x2*)(GT + (size_t)(r0 + wr + m * 16 + fr) * 4096 + seg * 1024 + c0 + wc + n * 16 + fq * 4), g);
                        macc[m][n][0] += g[0] * acc[m][n][0]; macc[m][n][1] += g[1] * acc[m][n][1]; macc[m][n][2] += g[2] * acc[m][n][2]; macc[m][n][3] += g[3] * acc[m][n][3];
                        acc[m][n] = (f32x4){0.f, 0.f, 0.f, 0.f};
                    }
            },
            [&](f32x4 (&)[4][4], int wr, int wc, int fr, int fq) {
#pragma unroll
                for (int m = 0; m < 4; ++m)
#pragma unroll
                    for (int n = 0; n < 4; ++n)
                        *(u32x2*)(MG + (size_t)(r0 + wr + m * 16 + fr) * D + c0 + wc + n * 16 + fq * 4) = pack4(macc[m][n][0], macc[m][n][1], macc[m][n][2], macc[m][n][3]);
            });
    }
}
struct EpiMerge2 {
    static constexpr bool PERM = false, AFTER_DRAIN = false;
    float* H; const float* modv; int l;
    DI void operator()(const pg8::f32x4 (&acc)[2][2][4][2], const pg8::Unit& u, int wr, int wc, int fr, int fq) const {
        if (skip_mt(l, u.pm)) return;
        const int sel = (u.pm % 33) == 0 ? 2 : u.pm / 33;
        const int row0 = u.pm * 256 + wr * 64 + fr, col0 = u.pn * 256 + wc * 32 + 4 * fq;
#pragma unroll
        for (int bj = 0; bj < 2; ++bj)
#pragma unroll
            for (int n = 0; n < 2; ++n) {
                const int col = col0 + bj * 128 + n * 16; const float4 m2 = *(const float4*)(modv + ((size_t)l * 3 + sel) * 6144 + 2 * 1024 + col);
#pragma unroll
                for (int ai = 0; ai < 2; ++ai)
#pragma unroll
                    for (int m = 0; m < 4; ++m) {
                        float4* hp = (float4*)(H + (size_t)(row0 + ai * 128 + m * 16) * D + col); float4 hv = *hp; const pg8::f32x4 v = acc[ai][bj][m][n];
                        hv.x += m2.x * v[0]; hv.y += m2.y * v[1]; hv.z += m2.z * v[2]; hv.w += m2.w * v[3]; *hp = hv;
                    }
            }
    }
};
struct LatOrder {
    int G, c;
    DI bool next(int i, pg8::Unit& u) const { const int L = i * G + c; if (L >= 256) return false; const int pl = L >> 2; u.pm = (pl >> 5) * 33 + 1 + (pl & 31); u.pn = L & 3; return true; }
    DI void a_ready(const pg8::Unit&) const {}
    DI void done(const pg8::Unit&) const {}
};
DI void phase_merge2(const Ctx& c, int l) {
    EpiMerge2 E; E.H = (float*)(c.ws + WS_H); E.modv = (const float*)(c.ws + WS_WSM + OFF_MODV); E.l = l;
    pg8::Gemm g{(const bf16_t*)(c.ws + WS_BUFB), (const bf16_t*)(c.ws + WS_WSM + OFF_WOUTT + l * SZ_WOUTT), NZ, 1024, 1024, 1024, 1024};
    __syncthreads();
    if (l == NL - 1) {
        LatOrder S; S.G = (int)gridDim.x; S.c = (int)blockIdx.x;
        pg8::gemm_phase<EpiMerge2, LatOrder, false>((PG8_LAS unsigned char*)c.smem, g, S, E, nullptr, c.tid);
    } else {
        pg8::StaticOrder S; S.init(NZ, 1024, (int)gridDim.x, (int)blockIdx.x);
        pg8::gemm_phase<EpiMerge2, pg8::StaticOrder, false>((PG8_LAS unsigned char*)c.smem, g, S, E, nullptr, c.tid);
    }
}

constexpr int RT_PITCH = 68;
constexpr int RT_RED_W = 8 * 4 * RT_PITCH;
DI void phase_norm2_route(const Ctx& c, int l) {
    unsigned char* ws = c.ws; const int lane = c.lane, wave = c.wave, tid = c.tid;
    const float* modv = (const float*)(ws + WS_WSM + OFF_MODV); const float* H = (const float*)(ws + WS_H);
    bf16_t* XN = (bf16_t*)(ws + WS_BUFA); const float* g2 = c.in[7] + l * 1024;
    const float* rwt = (const float*)(ws + WS_WSM + OFF_RWT) + (size_t)l * 36 * 1024;
    const float* bg = c.in[42] + l * 4; const float* be = c.in[44] + l * 32;
    unsigned* cnt = (unsigned*)(ws + WS_CTL) + CW_CNT + l * 32;
    int* list = (int*)(ws + WS_GT + GT_LIST); float* lw = (float*)(ws + WS_GT + GT_LW);
    float* red = (float*)c.smem + wave * RT_RED_W;
    float* lgs = (float*)c.smem + 8 * RT_RED_W + wave * 8 * 40;
    int* hist = (int*)((float*)c.smem + 8 * RT_RED_W + 8 * 8 * 40);
    int* sel = hist + 64;
    float* selw = (float*)(sel + 128);
    const int ngroups = (l == NL - 1) ? (NB * SEQ / 64) : (NZ / 64);
    for (int grp = blockIdx.x; grp < ngroups; grp += gridDim.x) {
        __syncthreads();
        if (tid < 32) hist[tid] = 0;
        __syncthreads();
        float x[8][16];
#pragma unroll
        for (int i = 0; i < 8; ++i) {
            const int rl = wave * 8 + i; int row;
            if (l == NL - 1) { const int rr = grp * 64 + rl; row = (rr / SEQ) * TZ + CTX + (rr % SEQ); } else row = grp * 64 + rl;
#pragma unroll
            for (int q = 0; q < 4; ++q) { const float4 v = *(const float4*)(H + (size_t)row * D + q * 256 + lane * 4); x[i][q * 4] = v.x; x[i][q * 4 + 1] = v.y; x[i][q * 4 + 2] = v.z; x[i][q * 4 + 3] = v.w; }
        }
#pragma unroll
        for (int i = 0; i < 8; ++i) {
            const int rl = wave * 8 + i; int row;
            if (l == NL - 1) { const int rr = grp * 64 + rl; row = (rr / SEQ) * TZ + CTX + (rr % SEQ); } else row = grp * 64 + rl;
            const int b = row / TZ, s = row % TZ, sel3 = s < CTX ? 2 : b;
            float ss = 0.f;
#pragma unroll
            for (int j = 0; j < 16; ++j) ss += x[i][j] * x[i][j];
            ss = wave_sum(ss);
            const float rs = rsqrtf(ss * (1.f / 1024.f) + 1e-6f);
#pragma unroll
            for (int q = 0; q < 4; ++q) {
                const int col = q * 256 + lane * 4;
                const float4 g = *(const float4*)(g2 + col), m3 = *(const float4*)(modv + ((size_t)l * 3 + sel3) * 6144 + 3 * 1024 + col), m4 = *(const float4*)(modv + ((size_t)l * 3 + sel3) * 6144 + 4 * 1024 + col);
                x[i][q * 4] = x[i][q * 4] * rs * g.x * (1.f + m4.x) + m3.x; x[i][q * 4 + 1] = x[i][q * 4 + 1] * rs * g.y * (1.f + m4.y) + m3.y;
                x[i][q * 4 + 2] = x[i][q * 4 + 2] * rs * g.z * (1.f + m4.z) + m3.z; x[i][q * 4 + 3] = x[i][q * 4 + 3] * rs * g.w * (1.f + m4.w) + m3.w;
                *(u32x2*)(XN + (size_t)row * D + col) = pack4(x[i][q * 4], x[i][q * 4 + 1], x[i][q * 4 + 2], x[i][q * 4 + 3]);
            }
        }
#pragma unroll 1
        for (int ec = 0; ec < 9; ++ec) {
#pragma unroll
            for (int ee = 0; ee < 4; ++ee) {
                const int e = ec * 4 + ee;
                float4 w[4];
#pragma unroll
                for (int q = 0; q < 4; ++q) w[q] = *(const float4*)(rwt + (size_t)e * 1024 + q * 256 + lane * 4);
#pragma unroll
                for (int i = 0; i < 8; ++i) {
                    float a = 0.f;
#pragma unroll
                    for (int q = 0; q < 4; ++q) a += x[i][q * 4] * w[q].x + x[i][q * 4 + 1] * w[q].y + x[i][q * 4 + 2] * w[q].z + x[i][q * 4 + 3] * w[q].w;
                    red[(i * 4 + ee) * RT_PITCH + lane] = a;
                }
            }
            __builtin_amdgcn_wave_barrier();
            if (lane < 32) {
                float s0 = 0.f, s1 = 0.f, s2 = 0.f, s3 = 0.f;
#pragma unroll
                for (int q = 0; q < 16; ++q) { const float4 v = *(const float4*)(red + lane * RT_PITCH + q * 4); s0 += v.x; s1 += v.y; s2 += v.z; s3 += v.w; }
                const int e = ec * 4 + (lane & 3);
                lgs[(lane >> 2) * 40 + e] = (s0 + s1) + (s2 + s3) + (e < 4 ? bg[e] : be[e - 4]);
            }
            __builtin_amdgcn_wave_barrier();
        }
        if (lane < 8) {
            const float* lg = lgs + lane * 40;
            float gm = lg[0]; int gsel = 0;
#pragma unroll
            for (int g = 1; g < 4; ++g) if (lg[g] > gm) { gm = lg[g]; gsel = g; }
            const float gs = __expf(lg[0] - gm) + __expf(lg[1] - gm) + __expf(lg[2] - gm) + __expf(lg[3] - gm);
            const float pg = 1.f / gs;
            float l1 = -1e30f, l2 = -1e30f; int e1 = 0, e2 = 0;
#pragma unroll
            for (int j = 0; j < 8; ++j) {
                const float v = lg[4 + gsel * 8 + j]; const int e = gsel * 8 + j;
                if (v > l1) { l2 = l1; e2 = e1; l1 = v; e1 = e; } else if (v > l2) { l2 = v; e2 = e; }
            }
            const float tt = __expf(l2 - l1), w1 = pg / (1.f + tt), w2 = pg * tt / (1.f + tt);
            const int rl = wave * 8 + lane;
            const int r1 = atomicAdd(&hist[e1], 1), r2 = atomicAdd(&hist[e2], 1);
            sel[rl * 2] = e1 | (r1 << 8); sel[rl * 2 + 1] = e2 | (r2 << 8); selw[rl * 2] = w1; selw[rl * 2 + 1] = w2;
        }
        __syncthreads();
        if (tid < 32) hist[32 + tid] = (int)atomicAdd(&cnt[tid], (unsigned)hist[tid]);
        __syncthreads();
        if (tid < 128) {
            const int rl = tid >> 1, j = tid & 1, sv = sel[tid], e = sv & 255, rk = sv >> 8;
            int row;
            if (l == NL - 1) { const int rr = grp * 64 + rl; row = (rr / SEQ) * TZ + CTX + (rr % SEQ); } else row = grp * 64 + rl;
            const size_t pos = (size_t)e * MOE_CAP + hist[32 + e] + rk;
            list[pos] = row * 2 + j; lw[pos] = selw[tid];
        }
    }
    phase_expert_convert(c, l);
}

DI void moe_prefix(const Ctx& c, int l, int* tiles  , int* cnts  ) {
    __syncthreads();
    if (c.tid == 0) {
        const unsigned* cnt = (const unsigned*)(c.ws + WS_CTL) + CW_CNT + l * 32; int acc = 0;
        for (int e = 0; e < 32; ++e) { const int n = (int)__hip_atomic_load(cnt + e, __ATOMIC_RELAXED, __HIP_MEMORY_SCOPE_AGENT); cnts[e] = n; tiles[e] = acc; acc += (n + 127) / 128; }
        tiles[32] = acc;
    }
    __syncthreads();
}
DI void phase_moe1(const Ctx& c, int l) {
    unsigned char* ws = c.ws;
    int* tiles = (int*)(c.smem + 120 * 1024); int* cnts = tiles + 40;
    moe_prefix(c, l, tiles, cnts);
    const bf16_t* XN = (const bf16_t*)(ws + WS_BUFA); bf16_t* HM = (bf16_t*)(ws + WS_GT + GT_HM); const int* list = (const int*)(ws + WS_GT + GT_LIST);
    const int nt_total = tiles[32];
    for (int u = blockIdx.x; u < nt_total * 4; u += gridDim.x) {
        const int mtg = u >> 2, nt = u & 3;
        int e = 0;
        for (int k = 1; k < 32; ++k) if (tiles[k] <= mtg) e = k;
        const int mt = mtg - tiles[e], n_e = cnts[e];
        const int* le = list + (size_t)e * MOE_CAP;
        const bf16_t* W = (const bf16_t*)(ws + WS_EXPW + (size_t)e * SZ_WGU);
        gemm_tile<2, 0>(c, 1024,
            [&](int i) { int p = mt * 128 + i; if (p >= n_e) p = n_e - 1; return XN + (size_t)(le[p] >> 1) * D; },
            [&](int i) { return W + (size_t)(nt * 256 + i) * D; }, NoHook(),
            [&](f32x4 (&acc)[4][4], int wr, int wc, int fr, int fq) {
#pragma unroll
                for (int np = 0; np < 2; ++np) {
                    const int hc = (nt * 256 + wc + np * 32) / 2 + fq * 4;
#pragma unroll
                    for (int m = 0; m < 4; ++m) {
                        const int p = mt * 128 + wr + m * 16 + fr;
                        const f32x4 g = acc[m][np * 2], uu = acc[m][np * 2 + 1];
                        *(u32x2*)(HM + ((size_t)mtg * 128 + wr + m * 16 + fr) * 512 + hc) = pack4(siluf_(g[0]) * uu[0], siluf_(g[1]) * uu[1], siluf_(g[2]) * uu[2], siluf_(g[3]) * uu[3]);
                        (void)p;
                    }
                }
            });
    }
}
DI void phase_moe2(const Ctx& c, int l) {
    unsigned char* ws = c.ws;
    int* tiles = (int*)(c.smem + 120 * 1024); int* cnts = tiles + 40;
    moe_prefix(c, l, tiles, cnts);
    const bf16_t* HM = (const bf16_t*)(ws + WS_GT + GT_HM); const int* list = (const int*)(ws + WS_GT + GT_LIST); const float* lw = (const float*)(ws + WS_GT + GT_LW);
    bf16_t* Y2 = (bf16_t*)(ws + WS_P);
    const int nt_total = tiles[32];
    for (int u = blockIdx.x; u < nt_total * 4; u += gridDim.x) {
        const int mtg = u >> 2, nt = u & 3;
        int e = 0;
        for (int k = 1; k < 32; ++k) if (tiles[k] <= mtg) e = k;
        const int mt = mtg - tiles[e], n_e = cnts[e];
        const int* le = list + (size_t)e * MOE_CAP; const float* lwe = lw + (size_t)e * MOE_CAP;
        const bf16_t* W = (const bf16_t*)(ws + WS_EXPW + 32 * SZ_WGU + (size_t)e * SZ_WD);
        gemm_tile<2, 0>(c, 512,
            [&](int i) { return HM + ((size_t)mtg * 128 + i) * 512; },
            [&](int i) { return W + (size_t)(nt * 256 + i) * 512; }, NoHook(),
            [&](f32x4 (&acc)[4][4], int wr, int wc, int fr, int fq) {
#pragma unroll
                for (int m = 0; m < 4; ++m) {
                    const int p = mt * 128 + wr + m * 16 + fr;
                    if (p < n_e) {
                        const int ent = le[p]; const float wt = lwe[p];
                        bf16_t* yrow = Y2 + ((size_t)(ent & 1) * NZ + (ent >> 1)) * D + nt * 256 + wc + fq * 4;
#pragma unroll
                        for (int n = 0; n < 4; ++n) *(u32x2*)(yrow + n * 16) = pack4(wt * acc[m][n][0], wt * acc[m][n][1], wt * acc[m][n][2], wt * acc[m][n][3]);
                    }
                }
            });
    }
}

constexpr int LDS_BYTES = 128 * 1024 + 256;
constexpr int STEPS_PER_LAYER = 12, N_STEPS = 2 + NL * STEPS_PER_LAYER;
#ifndef FUSED
#define FUSED 1
#endif

DI const void* launder_ptr(const void* p) {
    const unsigned long long v = (unsigned long long)p;
    unsigned lo = __builtin_amdgcn_readfirstlane((unsigned)v), hi = __builtin_amdgcn_readfirstlane((unsigned)(v >> 32));
    asm volatile("" : "+s"(lo), "+s"(hi) :: "memory");
    return (const void*)(((unsigned long long)hi << 32) | lo);
}
template <int KIND> DI void run_step(const Ctx& c0, int l) {
#ifdef PHM
    if (!((PHM >> KIND) & 1)) return;
#endif
    Ctx c = c0;
    { int z = 0; asm volatile("" : "+s"(z) :: "memory"); c.in = c0.in + z; c.ws = c0.ws + z; c.out = c0.out + z; }
    { int t = c0.tid; asm volatile("" : "+v"(t)); c.tid = t; c.lane = t & 63; c.wave = __builtin_amdgcn_readfirstlane(t >> 6); }
    if (KIND == 0) phase_prologue(c);
    if (KIND == 1) phase_norm1(c, l);
    if (KIND == 2) phase_inproj(c, l);
    if (KIND == 3) { phase_prep(c, l); for (int u = blockIdx.x; u < 2 * S5N * 4; u += gridDim.x) phase_s5_final_unit<true>(c, l, u); }
    if (KIND == 4) { phase_small_gemms(c, l); phase_s5_carry(c, l); }
    if (KIND == 5) { phase_attention(c, l); phase_rwkv_chunks(c, l); }
    if (KIND == 6) phase_mixers2(c, l);
    if (KIND == 7) phase_post(c, l);
    if (KIND == 8) phase_merge1(c, l);
    if (KIND == 9) phase_merge2(c, l);
    if (KIND == 10) phase_norm2_route(c, l);
    if (KIND == 11) phase_moe1(c, l);
    if (KIND == 12) phase_moe2(c, l);
    if (KIND == 13) phase_final(c);
}

#if !FUSED
template <int KIND> __global__ void __launch_bounds__(NTHR, 2) k_step(Args a) {
    extern __shared__ __attribute__((aligned(16))) unsigned char lds[];
    Ctx c; c.in = a.in; c.out = a.out; c.ws = a.ws; c.smem = lds; c.tid = threadIdx.x; c.lane = threadIdx.x & 63; c.wave = __builtin_amdgcn_readfirstlane(threadIdx.x >> 6);
    run_step<KIND>(c, a.s_lo);
}
template <int KIND> static void launch_step(const Args& a, int grid, hipStream_t stream) {
    static bool attr = false;
    if (!attr) { (void)hipFuncSetAttribute((const void*)k_step<KIND>, hipFuncAttributeMaxDynamicSharedMemorySize, LDS_BYTES); attr = true; }
    hipLaunchKernelGGL(k_step<KIND>, dim3(grid), dim3(NTHR), LDS_BYTES, stream, a);
}
#else
__global__ void __launch_bounds__(NTHR, 2) fwd_kernel(Args a) {
    extern __shared__ __attribute__((aligned(16))) unsigned char lds[];
    Ctx c; c.in = a.in; c.out = a.out; c.ws = a.ws; c.smem = lds; c.tid = threadIdx.x; c.lane = threadIdx.x & 63; c.wave = __builtin_amdgcn_readfirstlane(threadIdx.x >> 6);
    volatile LAS unsigned* xbw = (volatile LAS unsigned*)(lds + LDS_BYTES - 16);
    for (int i = threadIdx.x; i < LDS_BYTES / 16; i += NTHR) ((uint4*)lds)[i] = make_uint4(0u, 0u, 0u, 0u);
    __syncthreads();
    if (threadIdx.x == 0) { xbw[0] = 0u; xbw[1] = 0u; }
    __syncthreads();
    XcdBarrier bar = xcd_barrier_post((unsigned*)(a.ws + WS_CTL) + CW_BAR, xbw);
#ifndef REP_MASK
#define REP_MASK 0
#endif
#define GBAR() do { XcdBarrier bb = bar; int zz = 0; asm volatile("" : "+s"(zz) :: "memory"); bb.bar = bar.bar + zz; xcd_barrier(bb); } while (0)
#define STEP(K, L) do { run_step<K>(c, L); GBAR(); if ((REP_MASK >> K) & 1) { run_step<K>(c, L); GBAR(); } } while (0)
    STEP(0, 0);
    for (int l = 0; l < NL; ++l) {
        STEP(1, l); STEP(2, l); STEP(3, l); STEP(4, l); STEP(5, l); STEP(6, l); STEP(7, l); STEP(8, l); STEP(9, l); STEP(10, l); STEP(11, l); STEP(12, l);
    }
#undef STEP
    run_step<13>(c, 0);
}
#endif

extern "C" void kernel_launch(void* const* d_in, const int* in_sizes, int n_in, void* d_out, int out_size, void* d_ws, size_t ws_size, hipStream_t stream) {
    static int grid = 0;
    if (grid == 0) {
        if (n_in != 49 || out_size != NB * SEQ * D || ws_size < WS_END) { fprintf(stderr, "kernel_launch: unexpected problem (n_in %d out %d ws %zu need %zu)\n", n_in, out_size, ws_size, (size_t)WS_END); grid = -1; return; }
        int dev = 0, cus = 0;
        if (hipGetDevice(&dev) != hipSuccess || hipDeviceGetAttribute(&cus, hipDeviceAttributeMultiprocessorCount, dev) != hipSuccess) { grid = -1; return; }
#if FUSED
        int per_cu = 0;
        if (hipFuncSetAttribute((const void*)fwd_kernel, hipFuncAttributeMaxDynamicSharedMemorySize, LDS_BYTES) != hipSuccess) { fprintf(stderr, "kernel_launch: hipFuncSetAttribute failed\n"); grid = -1; return; }
        if (hipOccupancyMaxActiveBlocksPerMultiprocessor(&per_cu, (const void*)fwd_kernel, NTHR, LDS_BYTES) != hipSuccess || per_cu < 1) { fprintf(stderr, "kernel_launch: occupancy query says %d\n", per_cu); }
        (void)hipGetLastError();
#endif
        grid = cus;
    }
    if (grid < 0) return;
    (void)hipMemsetAsync((char*)d_ws + WS_CTL, 0, CTL_BYTES, stream);
    Args a{};
    for (int i = 0; i < 49; ++i) a.in[i] = (const float*)d_in[i];
    a.out = (float*)d_out; a.ws = (unsigned char*)d_ws;
#if !FUSED
    a.s_lo = 0; a.s_hi = 0; launch_step<0>(a, grid, stream);
    for (int l = 0; l < NL; ++l) {
        a.s_lo = l;
        launch_step<1>(a, grid, stream); launch_step<2>(a, grid, stream); launch_step<3>(a, grid, stream); launch_step<4>(a, grid, stream);
        launch_step<5>(a, grid, stream); launch_step<6>(a, grid, stream); launch_step<7>(a, grid, stream); launch_step<8>(a, grid, stream);
        launch_step<9>(a, grid, stream); launch_step<10>(a, grid, stream); launch_step<11>(a, grid, stream); launch_step<12>(a, grid, stream);
    }
    a.s_lo = 0; launch_step<13>(a, grid, stream);
#else
    a.s_lo = 0; a.s_hi = N_STEPS; hipLaunchKernelGGL(fwd_kernel, dim3(grid), dim3(NTHR), LDS_BYTES, stream, a);
#endif
}
```

```cpp
#include <hip/hip_runtime.h>
#include <stdint.h>
#include <stdio.h>

#define DI __device__ __forceinline__
#define LAS __attribute__((address_space(3)))
typedef unsigned short bf16_t;
typedef short bf16x8 __attribute__((ext_vector_type(8)));
typedef short s16x4 __attribute__((ext_vector_type(4)));
typedef float f32x4 __attribute__((ext_vector_type(4)));
typedef float f32x16 __attribute__((ext_vector_type(16)));
typedef float f32x2 __attribute__((ext_vector_type(2)));
typedef __bf16 bf16x2v __attribute__((ext_vector_type(2)));
typedef unsigned u32x4 __attribute__((ext_vector_type(4)));
typedef unsigned u32x2 __attribute__((ext_vector_type(2)));

constexpr int D = 1024, NB = 2, SEQ = 8192, CTX = 256, TZ = 8448, NZ = 16896, NL = 2;
constexpr int NIN = 6560, NINP = 6656;
constexpr int NTHR = 512;
constexpr float LOG2E = 1.4426950408889634f;

#define XB_TMO      128
#define XB_XCNT(j)  (256  + 64 * (j))
#define XB_XSUB(j)  (1280 + 64 * (j))
#define XB_XGEN(j)  (2304 + 64 * (j))
#define XB_TOP      3328
#define XB_TOPGEN   3392
#define XCD_BAR_WORDS 3456
#define XB_SPIN_CAP (1u << 18)

__device__ __forceinline__ unsigned xb_ld(unsigned* p)              { return __hip_atomic_load(p, __ATOMIC_RELAXED, __HIP_MEMORY_SCOPE_AGENT); }
__device__ __forceinline__ unsigned xb_add(unsigned* p, unsigned v) { return __hip_atomic_fetch_add(p, v, __ATOMIC_RELAXED, __HIP_MEMORY_SCOPE_AGENT); }
__device__ __forceinline__ unsigned xb_xcc_id() { return (unsigned)__builtin_amdgcn_s_getreg((3 << 11) | 20) & 0xFu; }
#define XB_SPIN(cond, bar) do { unsigned _sp = 0; while (cond) { __builtin_amdgcn_s_sleep(1); \
    if ((++_sp & 255u) == 0u) { if (xb_ld(&(bar)[XB_TMO])) break; if (_sp > XB_SPIN_CAP) { atomicAdd(&(bar)[XB_TMO], 1u); break; } } } } while (0)

struct XcdBarrier { unsigned* bar; unsigned x; volatile LAS unsigned* st; };

__device__ __forceinline__ XcdBarrier xcd_barrier_post(unsigned* bar, volatile LAS unsigned* st) {
    XcdBarrier b; b.bar = bar; b.x = xb_xcc_id(); b.st = st;
    if (threadIdx.x == 0) (void)xb_add(&bar[XB_XCNT(b.x)], 1u);
    return b;
}
__device__ __forceinline__ void xcd_barrier_complete(unsigned* bar, unsigned x, unsigned& nloc, unsigned& nx) {
    const unsigned G = gridDim.x * gridDim.y * gridDim.z;
    unsigned sum, cnt, mine, sp = 0u;
    for (;;) {
        sum = 0u; cnt = 0u; mine = 0u;
#pragma unroll
        for (unsigned j = 0; j < 16; ++j) { const unsigned c = xb_ld(&bar[XB_XCNT(j)]); sum += c; cnt += (c > 0u) ? 1u : 0u; mine = (j == x) ? c : mine; }
        if (sum == G) break;
        __builtin_amdgcn_s_sleep(1);
        if ((++sp & 255u) == 0u) { if (xb_ld(&bar[XB_TMO])) break; if (sp > XB_SPIN_CAP) { atomicAdd(&bar[XB_TMO], 1u); break; } }
    }
    nloc = mine > 0u ? mine : 1u; nx = cnt > 0u ? cnt : 1u;
}
__device__ __forceinline__ void xcd_barrier(const XcdBarrier& b) {
    asm volatile("s_waitcnt vmcnt(0)" ::: "memory");
    __syncthreads();
    if (threadIdx.x == 0) {
        unsigned* bar = b.bar;
        __builtin_amdgcn_s_waitcnt(0);
        unsigned nloc = b.st[0], nx = b.st[1];
        if (nloc == 0u) { xcd_barrier_complete(bar, b.x, nloc, nx); b.st[0] = nloc; b.st[1] = nx; }
        const unsigned old = xb_add(&bar[XB_XSUB(b.x)], 1u);
        const unsigned gen = old / nloc;
        if (old + 1u == (gen + 1u) * nloc) {
            __builtin_amdgcn_fence(__ATOMIC_RELEASE, "agent");
            asm volatile("s_waitcnt vmcnt(0)" ::: "memory");
            const unsigned og = xb_add(&bar[XB_TOP], 1u);
            const unsigned tg = og / nx;
            if (og + 1u == (tg + 1u) * nx) xb_add(&bar[XB_TOPGEN], 1u);
            else XB_SPIN(xb_ld(&bar[XB_TOPGEN]) == tg, bar);
            __builtin_amdgcn_fence(__ATOMIC_ACQUIRE, "agent");
            xb_add(&bar[XB_XGEN(b.x)], 1u);
            asm volatile("s_waitcnt vmcnt(0)" ::: "memory");
        } else {
            XB_SPIN(xb_ld(&bar[XB_XGEN(b.x)]) == gen, bar);
            __builtin_amdgcn_fence(__ATOMIC_ACQUIRE, "agent");
            asm volatile("s_waitcnt vmcnt(0)" ::: "memory");
        }
    }
    __syncthreads();
}

DI float bf2f(bf16_t v) { return __uint_as_float((unsigned)v << 16); }
DI unsigned pack2(float a, float b) { f32x2 v = {a, b}; bf16x2v r = __builtin_convertvector(v, bf16x2v); return __builtin_bit_cast(unsigned, r); }
DI bf16_t f2bf(float a) { return (bf16_t)(pack2(a, 0.f) & 0xffffu); }
DI float lo2f(unsigned u) { return __uint_as_float(u << 16); }
DI float hi2f(unsigned u) { return __uint_as_float(u & 0xffff0000u); }
DI float wave_sum(float v) {
#pragma unroll
    for (int m = 32; m >= 1; m >>= 1) v += __shfl_xor(v, m, 64);
    return v;
}
DI float sum16(float v) {
#pragma unroll
    for (int m = 8; m >= 1; m >>= 1) v += __shfl_xor(v, m, 64);
    return v;
}
DI float sigmoidf_(float x) { return 1.f / (1.f + __expf(-x)); }
DI float siluf_(float x) { return x / (1.f + __expf(-x)); }
DI float gelu_tanh(float x) { const float u = 0.7978845608028654f * (x + 0.044715f * x * x * x); return 0.5f * x * (1.f + tanhf(u)); }
DI void unpack4(u32x2 u, float (&f)[4]) { f[0] = lo2f(u.x); f[1] = hi2f(u.x); f[2] = lo2f(u.y); f[3] = hi2f(u.y); }
DI u32x2 pack4(float a, float b, float c, float d) { u32x2 r; r.x = pack2(a, b); r.y = pack2(c, d); return r; }

constexpr size_t algn(size_t x) { return (x + 255) & ~(size_t)255; }
constexpr size_t WS_CTL   = 0;
constexpr size_t CTL_BYTES = 64 * 1024;
constexpr size_t WS_H     = WS_CTL + CTL_BYTES;
constexpr size_t WS_WSM   = WS_H + (size_t)NZ * D * 4;
constexpr size_t SZ_WINT = (size_t)NINP * D * 2, SZ_WUQT = 384 * 256 * 2, SZ_WUKVT = 512 * 128 * 2, SZ_W2T = 512 * 64 * 2, SZ_A2T = 512 * 64 * 2,
                 SZ_G2T = 256 * 128 * 2, SZ_GLUT = 256 * 256 * 2, SZ_WBT = (size_t)D * D * 2, SZ_WOUTT = (size_t)D * D * 2;
constexpr size_t OFF_WINT = 0, OFF_WUQT = OFF_WINT + NL * SZ_WINT, OFF_WUKVT = OFF_WUQT + NL * SZ_WUQT, OFF_W2T = OFF_WUKVT + NL * SZ_WUKVT,
                 OFF_A2T = OFF_W2T + NL * SZ_W2T, OFF_G2T = OFF_A2T + NL * SZ_A2T, OFF_GLUT = OFF_G2T + NL * SZ_G2T, OFF_WBT = OFF_GLUT + NL * SZ_GLUT,
                 OFF_WOUTT = OFF_WBT + NL * SZ_WBT, OFF_MODV = OFF_WOUTT + NL * SZ_WOUTT,
                 OFF_ROPE = OFF_MODV + (size_t)NL * 3 * 6144 * 4,
                 OFF_S5T = OFF_ROPE + (size_t)SEQ * 16 * 2 * 4,
                 OFF_RWT = OFF_S5T + (size_t)NL * 2 * 16 * 64 * 36 * 4,
                 OFF_LAM = OFF_RWT + (size_t)NL * 36 * 1024 * 4,
                 OFF_S5E = OFF_LAM + 256,
                 OFF_S5C = OFF_S5E,
                 WSM_BYTES = algn(OFF_S5E + (size_t)2 * 2 * 16 * 132 * 64 * 2 * 4);
constexpr size_t WS_EXPW  = WS_WSM + WSM_BYTES;
constexpr size_t SZ_WGU = (size_t)1024 * 1024 * 2, SZ_WD = (size_t)1024 * 512 * 2;
constexpr size_t EXPW_BYTES = 32 * (SZ_WGU + SZ_WD);
constexpr size_t SZ_QM = (size_t)NB * 4 * TZ * 96 * 2, SZ_VMT = (size_t)NB * 4 * 64 * TZ * 2, SZ_QD = (size_t)NB * 4 * TZ * 64 * 2, SZ_R256 = (size_t)NZ * 256 * 2;
constexpr size_t MX_QM = 0, MX_KM = MX_QM + SZ_QM, MX_VMT = MX_KM + SZ_QM, MX_QD = MX_VMT + SZ_VMT, MX_KD = MX_QD + SZ_QD, MX_VDT = MX_KD + SZ_QD,
                 MX_RB = MX_VDT + SZ_VMT, MX_KB = MX_RB + SZ_R256, MX_VB = MX_KB + SZ_R256, MX_KKB = MX_VB + SZ_R256, MX_END = MX_KKB + SZ_R256;
static_assert(MX_END <= EXPW_BYTES, "mixer operands must fit the expert-weight region");
constexpr size_t WS_BUFA  = WS_EXPW + EXPW_BYTES;
constexpr size_t WS_BUFB  = WS_BUFA + (size_t)NZ * D * 2;
constexpr size_t WS_P     = WS_BUFB + (size_t)NZ * D * 2;
constexpr size_t P_PM = 0, P_PS = P_PM + (size_t)NZ * 416 * 2, P_PR = P_PS + (size_t)NZ * 256 * 2, P_PD = P_PR + (size_t)NZ * 1024 * 2, P_BYTES = P_PD + (size_t)NZ * 768 * 2;
static_assert((size_t)6 * SZ_R256 <= (size_t)NZ * (1024 + 768) * 2, "scan operands must fit PR|PD");
static_assert((size_t)2 * NZ * D * 2 <= P_BYTES, "the MoE outputs (2 x bf16 [NZ][D]) must fit the P region");
constexpr size_t WS_GT    = WS_P + P_BYTES;
constexpr size_t GT_BYTES = (size_t)NZ * 4096 * 2;
constexpr int MOE_CAP = 33792;
constexpr size_t GT_HM = 0, GT_LIST = GT_HM + (size_t)(33792 + 32 * 128) * 512 * 2, GT_LW = GT_LIST + (size_t)32 * MOE_CAP * 4, GT_END = GT_LW + (size_t)32 * MOE_CAP * 4;
static_assert(GT_END <= GT_BYTES, "MoE scratch must fit the gate region");
constexpr size_t WS_MISC  = WS_GT + GT_BYTES;
constexpr size_t MS_CQN = 0, MS_TW = MS_CQN + (size_t)NZ * 384 * 2, MS_AL = MS_TW + (size_t)NZ * 64 * 2, MS_SG = MS_AL + (size_t)NZ * 64 * 2,
                 MS_GG = MS_SG + (size_t)NZ * 128 * 2, MS_ZG = MS_GG + SZ_R256, MS_END = MS_ZG + SZ_R256;
constexpr size_t WS_RW    = WS_MISC + MS_END;
constexpr int RC = 64, RNC = TZ / RC;
constexpr size_t SZ_RWM = (size_t)16 * RNC * 4096 * 2;
constexpr size_t RW_M3 = 0, RW_M2 = SZ_RWM, RW_Z5 = 2 * SZ_RWM, RW_P63 = 3 * SZ_RWM, RW_END = RW_P63 + (size_t)16 * RNC * 64 * 4;
constexpr size_t WS_END   = WS_RW + RW_END;

constexpr int CW_BAR = 0;
constexpr int CW_CNT = 4096;

struct Args { const float* in[49]; float* out; unsigned char* ws; int s_lo, s_hi; };

struct Ctx {
    const float* const* in; float* out; unsigned char* ws; unsigned char* smem; int tid, lane, wave;
};

template <int WM> struct GCfg { static constexpr int WN = 8 / WM, BM = 64 * WM, BN = 64 * WN, ABYTES = BM * 128, BBYTES = BN * 128, STAGE = ABYTES + BBYTES; };

template <int WM, int SEGK, class ARow, class BRow, class Hook, class Epi>
DI void gemm_tile(const Ctx& c, int K, ARow arow, BRow brow, Hook hook, Epi epi) {
    typedef GCfg<WM> G;
    const int tid = c.tid, lane = c.lane, wave = c.wave;
    const int wm = wave / G::WN, wn = wave % G::WN, fr = lane & 15, fq = lane >> 4;
    unsigned char* smem = c.smem;
    constexpr int NA = G::BM / 64, NBq = G::BN / 64;
    const int r0 = tid >> 3, coff = ((tid & 7) ^ (r0 & 7)) * 8;
    auto stage = [&](int kt, int buf) {
        unsigned char* sa = smem + buf * G::STAGE; unsigned char* sb = sa + G::ABYTES;
#pragma unroll
        for (int i = 0; i < NA; ++i) __builtin_amdgcn_global_load_lds((const unsigned*)(arow(r0 + 64 * i) + coff + kt * 64), (unsigned*)(sa + (tid + i * NTHR) * 16), 16, 0, 0);
#pragma unroll
        for (int i = 0; i < NBq; ++i) __builtin_amdgcn_global_load_lds((const unsigned*)(brow(r0 + 64 * i) + coff + kt * 64), (unsigned*)(sb + (tid + i * NTHR) * 16), 16, 0, 0);
    };
    f32x4 acc[4][4];
#pragma unroll
    for (int m = 0; m < 4; ++m)
#pragma unroll
        for (int n = 0; n < 4; ++n) acc[m][n] = (f32x4){0.f, 0.f, 0.f, 0.f};
    const int T = K / 64;
    __syncthreads();
    stage(0, 0);
    for (int t = 0; t < T; ++t) {
        asm volatile("s_waitcnt vmcnt(0)" ::: "memory");
        __syncthreads();
        if (t + 1 < T) stage(t + 1, (t + 1) & 1);
        const unsigned char* sa = smem + (t & 1) * G::STAGE; const unsigned char* sb = sa + G::ABYTES;
#pragma unroll
        for (int ks = 0; ks < 2; ++ks) {
            bf16x8 af[4], bfr[4];
            const int sl = ((ks * 4 + fq) ^ (fr & 7)) * 16;
#pragma unroll
            for (int m = 0; m < 4; ++m) af[m] = *(const bf16x8*)(sa + (wm * 64 + m * 16 + fr) * 128 + sl);
#pragma unroll
            for (int n = 0; n < 4; ++n) bfr[n] = *(const bf16x8*)(sb + (wn * 64 + n * 16 + fr) * 128 + sl);
#pragma unroll
            for (int m = 0; m < 4; ++m)
#pragma unroll
                for (int n = 0; n < 4; ++n) acc[m][n] = __builtin_amdgcn_mfma_f32_16x16x32_bf16(bfr[n], af[m], acc[m][n], 0, 0, 0);
        }
        if (SEGK > 0) { if (((t + 1) * 64) % (SEGK > 0 ? SEGK : 64) == 0) hook(acc, ((t + 1) * 64) / (SEGK > 0 ? SEGK : 64) - 1, wm * 64, wn * 64, fr, fq); }
    }
    epi(acc, wm * 64, wn * 64, fr, fq);
}
struct NoHook { DI void operator()(f32x4 (&)[4][4], int, int, int, int, int) const {} };

namespace pg8 {
#define PG8_LAS __attribute__((address_space(3)))
typedef unsigned short bf16_t;
typedef short bf16x8 __attribute__((ext_vector_type(8)));
typedef float f32x4 __attribute__((ext_vector_type(4)));
constexpr int BM = 256, BK = 64, HALF = 128, HTB = HALF * BK * 2  , STAGE_BYTES = 8 * HTB, NXCD = 8, WGM = 8;

__host__ __device__ __forceinline__ int lds_byte(int r, int c) { const int st = (r >> 4) * 2 + (c >> 5), rr = r & 15, cc = c & 31, ob = rr * 64 + cc * 2; return st * 1024 + (ob ^ (((ob >> 9) & 1) << 5)); }
__host__ __device__ __forceinline__ void stage_rc(int b, int& R, int& C) { const int st = b / 1024, sb = b % 1024, swz = sb ^ (((sb >> 9) & 1) << 5); R = (st >> 1) * 16 + swz / 64; C = (st & 1) * 32 + (swz % 64) / 2; }
__host__ __device__ __forceinline__ int perm32(int rho) { const int n = rho >> 4, i = rho & 15; return 8 * (i >> 2) + 4 * n + (i & 3); }

struct Unit { int pm, pn; };
struct Gemm { const bf16_t* A; const bf16_t* Bt; int M, N, K, lda, ldb; };

struct StaticOrder {
    int nM, nN, nwg, G, c;
    __host__ __device__ void init(int M, int N, int G_, int c_) { nM = M / BM; nN = N / BM; nwg = nM * nN; G = G_; c = c_; }
    __host__ __device__ bool next(int i, Unit& u) const {
        const long L = (long)i * G + c; if (L >= nwg) return false;
        int wgid = (int)L; { const int q = nwg / NXCD, r = nwg % NXCD, xcd = wgid % NXCD, off = wgid / NXCD; wgid = (xcd < r ? xcd * (q + 1) : r * (q + 1) + (xcd - r) * q) + off; }
        const int nig = WGM * nN, gid = wgid / nig, fm = gid * WGM, gsz = (nM - fm) < WGM ? (nM - fm) : WGM;
        u.pm = fm + ((wgid % nig) % gsz); u.pn = (wgid % nig) / gsz; return true;
    }
    __device__ __forceinline__ void a_ready(const Unit&) const {}
    __device__ __forceinline__ void done(const Unit&) const {}
};
template <class Epi, class Sched, bool STAMP = false>
__device__ __forceinline__ void gemm_phase(PG8_LAS unsigned char* lds, const Gemm g, const Sched& S, const Epi& E, unsigned long long* stamps, int tid_in) {
    const int tid = tid_in, wid = __builtin_amdgcn_readfirstlane(tid >> 6), lane = tid & 63, wr = wid >> 2, wc = wid & 3, fr = lane & 15, fq = lane >> 4;
    const int K = g.K, nt = K / BK;
    int ts_lo = 0, ts_hi = 0, nts = 0; const unsigned long long rt_entry = STAMP ? (unsigned long long)wall_clock64() : 0ull;
#define PG8_STAMP() do { if (STAMP && wid == 0 && nts < 64) { const unsigned long long _c = (unsigned long long)clock64(); \
        ts_lo = (lane == nts) ? (int)(unsigned)_c : ts_lo; ts_hi = (lane == nts) ? (int)(unsigned)(_c >> 32) : ts_hi; ++nts; } } while (0)
    PG8_STAMP();
    unsigned voffA[2], voffB[2];
#pragma unroll
    for (int i = 0; i < 2; ++i) { int R, C; stage_rc(tid * 16 + i * 8192, R, C); const int Rb = Epi::PERM ? ((R & ~31) + perm32(R & 31)) : R;
        voffA[i] = (unsigned)(R * g.lda + C) * 2u; voffB[i] = (unsigned)(Rb * g.ldb + C) * 2u; }
    const size_t kstep = (size_t)(BK * 2);
    const size_t hstepA = (size_t)HALF * g.lda * 2, hstepB = (size_t)HALF * g.ldb * 2;
    const size_t tstepA = 2 * hstepA, tstepB = 2 * hstepB;
    const unsigned ldsw = (unsigned)wid * 1024u;
    const int aoff = lds_byte(wr * 64 + fr, fq * 8), boff = lds_byte(wc * 32 + fr, fq * 8);
#define PG8_SA(b, h) (((b) * 2 + (h)) * HTB)
#define PG8_SB(b, h) ((4 + (b) * 2 + (h)) * HTB)
#define PG8_STAGE(bufoff, gbase, voff) do { _Pragma("unroll") for (int _i = 0; _i < 2; ++_i) \
        __builtin_amdgcn_global_load_lds((const unsigned*)((const char*)(gbase) + (voff)[_i]), (PG8_LAS unsigned*)(lds + (bufoff) + ldsw + _i * 8192), 16, 0, 0); } while (0)
#define PG8_LDA(dst, b, h) do { _Pragma("unroll") for (int m = 0; m < 4; ++m) _Pragma("unroll") for (int k = 0; k < 2; ++k) dst[m][k] = *(const PG8_LAS bf16x8*)(lds + PG8_SA(b, h) + aoff + m * 2048 + k * 1024); } while (0)
#define PG8_LDB(dst, b, h) do { _Pragma("unroll") for (int n = 0; n < 2; ++n) _Pragma("unroll") for (int k = 0; k < 2; ++k) dst[n][k] = *(const PG8_LAS bf16x8*)(lds + PG8_SB(b, h) + boff + n * 2048 + k * 1024); } while (0)
#define PG8_MMA(ai, bj, At, Bt) do { __builtin_amdgcn_s_setprio(1); _Pragma("unroll") for (int m = 0; m < 4; ++m) _Pragma("unroll") for (int n = 0; n < 2; ++n) _Pragma("unroll") for (int k = 0; k < 2; ++k) \
        acc[ai][bj][m][n] = __builtin_amdgcn_mfma_f32_16x16x32_bf16(Bt[n][k], At[m][k], acc[ai][bj][m][n], 0, 0, 0); __builtin_amdgcn_s_setprio(0); } while (0)
#define PG8_WAIT_V(n) asm volatile("s_waitcnt vmcnt(" #n ")" ::: "memory")
#define PG8_WAIT_L(n) asm volatile("s_waitcnt lgkmcnt(" #n ")" ::: "memory")
#define PG8_BAR __builtin_amdgcn_s_barrier()
#define PG8_SCHED __builtin_amdgcn_sched_barrier(0)
    Unit cur, nxt; int ui = 0;
    if (!S.next(0, cur)) return;
    f32x4 acc[2][2][4][2];
#pragma unroll
    for (int a = 0; a < 2; ++a)
#pragma unroll
        for (int b = 0; b < 2; ++b)
#pragma unroll
            for (int m = 0; m < 4; ++m)
#pragma unroll
                for (int n = 0; n < 2; ++n) acc[a][b][m][n] = (f32x4){0.f, 0.f, 0.f, 0.f};
    bf16x8 At[4][2], B0[2][2], B1[2][2];
    const char* cA = (const char*)g.A + (size_t)cur.pm * tstepA; const char* cB = (const char*)g.Bt + (size_t)cur.pn * tstepB;
    S.a_ready(cur);
    PG8_STAGE(PG8_SB(0, 0), cB, voffB); PG8_STAGE(PG8_SA(0, 0), cA, voffA); PG8_STAGE(PG8_SB(0, 1), cB + hstepB, voffB); PG8_STAGE(PG8_SA(0, 1), cA + hstepA, voffA);
    if (wr == 1) PG8_BAR;
    PG8_WAIT_V(4); PG8_BAR;
    PG8_STAGE(PG8_SB(1, 0), cB + kstep, voffB); PG8_STAGE(PG8_SA(1, 0), cA + kstep, voffA); PG8_STAGE(PG8_SB(1, 1), cB + hstepB + kstep, voffB);
    PG8_WAIT_V(6); PG8_BAR;
    PG8_STAMP();
    for (;;) {
        const bool has_next = S.next(ui + 1, nxt);
        const char* nA = has_next ? (const char*)g.A + (size_t)nxt.pm * tstepA : cA; const char* nB = has_next ? (const char*)g.Bt + (size_t)nxt.pn * tstepB : cB;
        for (int t = 0; t < nt; t += 2) {
            const bool last = (t == nt - 2);
            const char* a1 = cA + (size_t)(t + 1) * kstep;
            const char* a2 = last ? nA : cA + (size_t)(t + 2) * kstep; const char* b2 = last ? nB : cB + (size_t)(t + 2) * kstep;
            const char* a3 = a2 + kstep; const char* b3 = b2 + kstep;
            if (last && has_next) S.a_ready(nxt);
            PG8_LDB(B0, 0, 0); PG8_SCHED; PG8_LDA(At, 0, 0); PG8_STAGE(PG8_SA(1, 1), a1 + hstepA, voffA);
            PG8_WAIT_L(8); PG8_BAR; PG8_WAIT_L(0); PG8_MMA(0, 0, At, B0); PG8_BAR; PG8_SCHED;
            PG8_LDB(B1, 0, 1); PG8_STAGE(PG8_SB(0, 0), b2, voffB);
            PG8_BAR; PG8_WAIT_L(0); PG8_MMA(0, 1, At, B1); PG8_BAR;
            PG8_LDA(At, 0, 1); PG8_STAGE(PG8_SA(0, 0), a2, voffA);
            PG8_BAR; PG8_WAIT_L(0); PG8_MMA(1, 0, At, B0); PG8_BAR; PG8_SCHED;
            PG8_STAGE(PG8_SB(0, 1), b2 + hstepB, voffB);
            PG8_WAIT_V(6); PG8_BAR; PG8_MMA(1, 1, At, B1); PG8_BAR;
            PG8_LDB(B0, 1, 0); PG8_SCHED; PG8_LDA(At, 1, 0); PG8_STAGE(PG8_SA(0, 1), a2 + hstepA, voffA);
            PG8_WAIT_L(8); PG8_BAR; PG8_WAIT_L(0); PG8_MMA(0, 0, At, B0); PG8_BAR; PG8_SCHED;
            PG8_LDB(B1, 1, 1); PG8_STAGE(PG8_SB(1, 0), b3, voffB);
            PG8_BAR; PG8_WAIT_L(0); PG8_MMA(0, 1, At, B1); PG8_BAR;
            PG8_LDA(At, 1, 1); PG8_STAGE(PG8_SA(1, 0), a3, voffA);
            PG8_BAR; PG8_WAIT_L(0); PG8_MMA(1, 0, At, B0); PG8_BAR; PG8_SCHED;
            PG8_STAGE(PG8_SB(1, 1), b3 + hstepB, voffB);
            PG8_WAIT_V(6); PG8_BAR; PG8_MMA(1, 1, At, B1); PG8_BAR;
        }
        PG8_STAMP();
        if constexpr (!Epi::AFTER_DRAIN) { E(acc, cur, wr, wc, fr, fq); S.done(cur); }
        PG8_STAMP();
        if (!has_next) break;
#pragma unroll
        for (int a = 0; a < 2; ++a)
#pragma unroll
            for (int b = 0; b < 2; ++b)
#pragma unroll
                for (int m = 0; m < 4; ++m)
#pragma unroll
                    for (int n = 0; n < 2; ++n) acc[a][b][m][n] = (f32x4){0.f, 0.f, 0.f, 0.f};
        cur = nxt; cA = nA; cB = nB; ++ui;
    }
    PG8_WAIT_V(0);
    if (wr == 0) PG8_BAR;
    PG8_BAR;
    if constexpr (Epi::AFTER_DRAIN) { E.fused(acc, cur, wr, wc, fr, fq, lds, wid, lane); S.done(cur); }
    PG8_STAMP();
    if (STAMP && wid == 0) { stamps[lane] = lane < nts ? (((unsigned long long)(unsigned)ts_hi << 32) | (unsigned)ts_lo) : 0ull;
        if (lane == 62) stamps[62] = rt_entry; if (lane == 63) stamps[63] = (unsigned long long)wall_clock64(); }
#undef PG8_STAMP
#undef PG8_SA
#undef PG8_SB
#undef PG8_STAGE
#undef PG8_LDA
#undef PG8_LDB
#undef PG8_MMA
#undef PG8_WAIT_V
#undef PG8_WAIT_L
#undef PG8_BAR
#undef PG8_SCHED
}
}

DI int rowmap(int n, int mode) { return mode == 0 ? n : ((n >> 4) * 32 + (n & 15) + (mode == 2 ? 16 : 0)); }
DI void tconv_tile(const Ctx& c, const float* src, int ld, int N, bf16_t* dst, int ld_dst, int mode, int tk, int tn) {
    bf16_t* T = (bf16_t*)c.smem;
    const int k0 = tk * 64, n0 = tn * 64, tid = c.tid;
    __syncthreads();
#pragma unroll
    for (int i = 0; i < 2; ++i) {
        const int kk = (tid >> 4) + i * 32, n4 = (tid & 15) * 4;
        float4 v = make_float4(0.f, 0.f, 0.f, 0.f);
        if (n0 + n4 < N) v = *(const float4*)(src + (size_t)(k0 + kk) * ld + n0 + n4);
        T[(n4 + 0) * 72 + kk] = f2bf(v.x); T[(n4 + 1) * 72 + kk] = f2bf(v.y); T[(n4 + 2) * 72 + kk] = f2bf(v.z); T[(n4 + 3) * 72 + kk] = f2bf(v.w);
    }
    __syncthreads();
    const int n = tid >> 3, k8 = (tid & 7) * 8;
    if (n0 + n < N) *(u32x4*)(dst + (size_t)rowmap(n0 + n, mode) * ld_dst + k0 + k8) = *(const u32x4*)(T + n * 72 + k8);
}
DI void tconv(const Ctx& c, const float* src, int ld, int K, int N, bf16_t* dst, int ld_dst, int mode, int rot) {
    const int ntk = K / 64, ntn = (N + 63) / 64, nt = ntk * ntn, G = gridDim.x;
    for (int t = (blockIdx.x + G - (rot % G)) % G; t < nt; t += G) tconv_tile(c, src, ld, N, dst, ld_dst, mode, t / ntn, t % ntn);
}

DI void wconv(const Ctx& c, const float* src, int ld, int K, int N, bf16_t* dst, int ld_dst, int rot) {
    const int ntk = K / 64, ntn = (N + 63) / 64, nt = ntk * ntn, GW = gridDim.x * 8, w0 = blockIdx.x * 8 + c.wave;
    for (int t = (w0 + GW - (rot % GW)) % GW; t < nt; t += GW) {
        const int tk = t / ntn, tn = t % ntn, n = tn * 64 + c.lane;
        if (n < N) {
            const float* sp = src + (size_t)(tk * 64) * ld + n; bf16_t* dp = dst + (size_t)n * ld_dst + tk * 64;
#pragma unroll
            for (int kb = 0; kb < 8; ++kb) {
                float v[8];
#pragma unroll
                for (int j = 0; j < 8; ++j) v[j] = sp[(size_t)(kb * 8 + j) * ld];
                u32x4 w4; w4.x = pack2(v[0], v[1]); w4.y = pack2(v[2], v[3]); w4.z = pack2(v[4], v[5]); w4.w = pack2(v[6], v[7]);
                *(u32x4*)(dp + kb * 8) = w4;
            }
        }
    }
}
DI void phase_prologue(const Ctx& c) {
    unsigned char* wsm = c.ws + WS_WSM;
    const int tid = c.tid, G = gridDim.x, gtid = blockIdx.x * NTHR + tid, gn = G * NTHR;
    {
        const float4* x = (const float4*)c.in[0]; const float4* cx = (const float4*)c.in[2]; float4* H = (float4*)(c.ws + WS_H);
        for (size_t i = gtid; i < (size_t)NZ * 256; i += gn) {
            const int z = (int)(i >> 8), q = (int)(i & 255), b = z / TZ, s = z % TZ;
            H[i] = (s < CTX) ? cx[((size_t)b * CTX + s) * 256 + q] : x[((size_t)b * SEQ + (s - CTX)) * 256 + q];
        }
    }
    {
        float* rope = (float*)(wsm + OFF_ROPE);
        for (int i = gtid; i < SEQ * 16; i += gn) {
            const int t = i >> 4, a = (i >> 3) & 1, f = i & 7;
            const float pos = (float)(a == 0 ? (t >> 6) : (t & 63));
            const float inv = powf(10000.f, -(float)f / 8.f);
            float sn, cs; sincosf(pos * inv, &sn, &cs);
            rope[i * 2] = cs; rope[i * 2 + 1] = sn;
        }
    }
    {
        float* s5t = (float*)(wsm + OFF_S5T);
        for (int i = gtid; i < NL * 2 * 16 * 64; i += gn) {
            const int ldg = i >> 6;
            const double lr = c.in[24][i], li = c.in[25][i], dt = exp((double)c.in[26][ldg]);
            const double mag = exp(lr * dt), are = mag * cos(li * dt), aim = mag * sin(li * dt);
            const double m256 = exp(lr * dt * 64.0), a256r = m256 * cos(li * dt * 64.0), a256i = m256 * sin(li * dt * 64.0);
            const double den = lr * lr + li * li, nr = are - 1.0, ni = aim;
            const double cfr = (nr * lr + ni * li) / den, cfi = (ni * lr - nr * li) / den;
            float* o = s5t + (size_t)i * 36;
            o[0] = (float)are; o[1] = (float)aim; o[2] = (float)a256r; o[3] = (float)a256i;
            for (int ch = 0; ch < 16; ++ch) {
                const double br = c.in[27][(size_t)i * 16 + ch], bi = c.in[28][(size_t)i * 16 + ch];
                o[4 + ch] = (float)(cfr * br - cfi * bi); o[20 + ch] = (float)(cfr * bi + cfi * br);
            }
        }
    }
    {
        float* rwt = (float*)(wsm + OFF_RWT);
        for (int i = gtid; i < NL * 36 * 1024; i += gn) {
            const int l = i / (36 * 1024), e = (i / 1024) % 36, d = i & 1023;
            rwt[i] = e < 4 ? c.in[41][((size_t)l * 1024 + d) * 4 + e] : c.in[43][((size_t)l * 1024 + d) * 32 + (e - 4)];
        }
    }
    if (blockIdx.x == 0 && tid < NL) {
        float s1 = 0.f, s2 = 0.f;
        for (int i = 0; i < 32; ++i) { s1 += c.in[34][tid * 32 + i] * c.in[35][tid * 32 + i]; s2 += c.in[36][tid * 32 + i] * c.in[37][tid * 32 + i]; }
        ((float*)(wsm + OFF_LAM))[tid] = expf(s1) - expf(s2) + (0.8f - 0.6f * expf(-0.3f * (float)tid));
    }
    {
        float* sv = (float*)c.smem;
        float* red = sv + 3 * 1024;
        __syncthreads();
        for (int i = tid; i < 3 * 1024; i += NTHR) { const float v = i < 2048 ? c.in[1][i] : c.in[3][i - 2048]; sv[i] = siluf_(v); }
        __syncthreads();
        float* modv = (float*)(wsm + OFF_MODV);
        for (int u = blockIdx.x; u < NL * 96; u += G) {
            const int l = u / 96, col = (u % 96) * 64 + (tid & 63), ks = tid >> 6;
            const float* w = c.in[4] + (size_t)l * 1024 * 6144 + col;
            float a0 = 0.f, a1 = 0.f, a2 = 0.f;
            for (int k = ks * 128; k < ks * 128 + 128; ++k) { const float wv = w[(size_t)k * 6144]; a0 += sv[k] * wv; a1 += sv[1024 + k] * wv; a2 += sv[2048 + k] * wv; }
            red[(ks * 64 + (tid & 63)) * 3 + 0] = a0; red[(ks * 64 + (tid & 63)) * 3 + 1] = a1; red[(ks * 64 + (tid & 63)) * 3 + 2] = a2;
            __syncthreads();
            if (tid < 192) {
                const int cc = tid & 63, sel = tid >> 6; float s = 0.f;
                for (int k2 = 0; k2 < 8; ++k2) s += red[(k2 * 64 + cc) * 3 + sel];
                const int colo = (u % 96) * 64 + cc;
                modv[((size_t)l * 3 + sel) * 6144 + colo] = s + c.in[5][l * 6144 + colo];
            }
            __syncthreads();
        }
    }
    for (int l = 0; l < NL; ++l) {
        wconv(c, c.in[8] + (size_t)l * 1024 * NIN, NIN, 1024, NIN, (bf16_t*)(wsm + OFF_WINT + l * SZ_WINT), 1024, l * 700);
        tconv(c, c.in[11] + (size_t)l * 256 * 384, 384, 256, 384, (bf16_t*)(wsm + OFF_WUQT + l * SZ_WUQT), 256, 0, 40);
        tconv(c, c.in[12] + (size_t)l * 128 * 512, 512, 128, 512, (bf16_t*)(wsm + OFF_WUKVT + l * SZ_WUKVT), 128, 0, 70);
        for (int d = 0; d < 2; ++d) {
            tconv(c, c.in[15] + (size_t)(l * 2 + d) * 64 * 256, 256, 64, 256, (bf16_t*)(wsm + OFF_W2T + l * SZ_W2T) + d * 256 * 64, 64, 0, 90 + d * 8);
            tconv(c, c.in[17] + (size_t)(l * 2 + d) * 64 * 256, 256, 64, 256, (bf16_t*)(wsm + OFF_A2T + l * SZ_A2T) + d * 256 * 64, 64, 0, 110 + d * 8);
        }
        tconv(c, c.in[18] + (size_t)l * 128 * 256, 256, 128, 256, (bf16_t*)(wsm + OFF_G2T + l * SZ_G2T), 128, 0, 130);
        tconv(c, c.in[32] + (size_t)l * 256 * 256, 256, 256, 256, (bf16_t*)(wsm + OFF_GLUT + l * SZ_GLUT), 256, 0, 140);
        for (int n = 0; n < 4; ++n)
            wconv(c, c.in[39] + (size_t)(l * 4 + n) * 256 * 1024, 1024, 256, 1024, (bf16_t*)(wsm + OFF_WBT + l * SZ_WBT) + n * 256, 1024, 300 + n * 64 + l * 1000);
        wconv(c, c.in[40] + (size_t)l * 1024 * 1024, 1024, 1024, 1024, (bf16_t*)(wsm + OFF_WOUTT + l * SZ_WOUTT), 1024, 1200 + l * 400);
    }
}

DI void phase_expert_convert(const Ctx& c, int l) {
    const int G = gridDim.x, lane = c.lane;
    for (int t = blockIdx.x * 8 + c.wave; t < 32 * 384; t += G * 8) {
        const int e = t / 384, r = t % 384;
        const float* src; bf16_t* dst; int ld, ldd, mode, tk, tn;
        if (r < 128)      { src = c.in[45] + ((size_t)l * 32 + e) * 1024 * 512; dst = (bf16_t*)(c.ws + WS_EXPW + (size_t)e * SZ_WGU); ld = 512; ldd = 1024; mode = 1; tk = r / 8; tn = r % 8; }
        else if (r < 256) { src = c.in[46] + ((size_t)l * 32 + e) * 1024 * 512; dst = (bf16_t*)(c.ws + WS_EXPW + (size_t)e * SZ_WGU); ld = 512; ldd = 1024; mode = 2; tk = (r - 128) / 8; tn = (r - 128) % 8; }
        else              { src = c.in[47] + ((size_t)l * 32 + e) * 512 * 1024; dst = (bf16_t*)(c.ws + WS_EXPW + 32 * SZ_WGU + (size_t)e * SZ_WD); ld = 1024; ldd = 512; mode = 0; tk = (r - 256) / 16; tn = (r - 256) % 16; }
        const int n = tn * 64 + lane; const float* sp = src + (size_t)(tk * 64) * ld + n; bf16_t* dp = dst + (size_t)rowmap(n, mode) * ldd + tk * 64;
        float v[64];
#pragma unroll
        for (int k = 0; k < 64; ++k) v[k] = __builtin_nontemporal_load(sp + (size_t)k * ld);
#pragma unroll
        for (int kb = 0; kb < 8; ++kb) {
            u32x4 w4; w4.x = pack2(v[kb * 8], v[kb * 8 + 1]); w4.y = pack2(v[kb * 8 + 2], v[kb * 8 + 3]); w4.z = pack2(v[kb * 8 + 4], v[kb * 8 + 5]); w4.w = pack2(v[kb * 8 + 6], v[kb * 8 + 7]);
            *(u32x4*)(dp + kb * 8) = w4;
        }
    }
}

DI void phase_norm1(const Ctx& c, int l) {
    const float* modv = (const float*)(c.ws + WS_WSM + OFF_MODV);
    float* H = (float*)(c.ws + WS_H); const bf16_t* Y = (const bf16_t*)(c.ws + WS_P);
    bf16_t* XN = (bf16_t*)(c.ws + WS_BUFA);
    const float* g1 = c.in[6] + l * 1024;
    for (int row = blockIdx.x * 8 + c.wave; row < NZ; row += gridDim.x * 8) {
        const int b = row / TZ, s = row % TZ, sel = s < CTX ? 2 : b;
        float4 v[4]; float ss = 0.f;
#pragma unroll
        for (int q = 0; q < 4; ++q) {
            const int col = q * 256 + c.lane * 4;
            v[q] = *(const float4*)(H + (size_t)row * D + col);
            if (l > 0) {
                float ya[4], yb[4]; unpack4(*(const u32x2*)(Y + (size_t)row * D + col), ya); unpack4(*(const u32x2*)(Y + ((size_t)NZ + row) * D + col), yb);
                const float4 m5 = *(const float4*)(modv + ((size_t)(l - 1) * 3 + sel) * 6144 + 5 * 1024 + col);
                v[q].x += m5.x * (ya[0] + yb[0]); v[q].y += m5.y * (ya[1] + yb[1]); v[q].z += m5.z * (ya[2] + yb[2]); v[q].w += m5.w * (ya[3] + yb[3]);
                *(float4*)(H + (size_t)row * D + col) = v[q];
            }
            ss += v[q].x * v[q].x + v[q].y * v[q].y + v[q].z * v[q].z + v[q].w * v[q].w;
        }
        ss = wave_sum(ss);
        const float rs = rsqrtf(ss * (1.f / 1024.f) + 1e-6f);
#pragma unroll
        for (int q = 0; q < 4; ++q) {
            const int col = q * 256 + c.lane * 4;
            const float4 g = *(const float4*)(g1 + col), m0 = *(const float4*)(modv + ((size_t)l * 3 + sel) * 6144 + col), m1 = *(const float4*)(modv + ((size_t)l * 3 + sel) * 6144 + 1024 + col);
            *(u32x2*)(XN + (size_t)row * D + col) = pack4(v[q].x * rs * g.x * (1.f + m1.x) + m0.x, v[q].y * rs * g.y * (1.f + m1.y) + m0.y,
                                                          v[q].z * rs * g.z * (1.f + m1.z) + m0.z, v[q].w * rs * g.w * (1.f + m1.w) + m0.w);
        }
    }
}

DI void phase_final(const Ctx& c) {
    const float* modv = (const float*)(c.ws + WS_WSM + OFF_MODV);
    const float* H = (const float*)(c.ws + WS_H); const bf16_t* Y = (const bf16_t*)(c.ws + WS_P);
    const float* g = c.in[48];
    for (int r = blockIdx.x * 8 + c.wave; r < NB * SEQ; r += gridDim.x * 8) {
        const int b = r / SEQ, t = r % SEQ, row = b * TZ + CTX + t;
        float4 v[4]; float ss = 0.f;
#pragma unroll
        for (int q = 0; q < 4; ++q) {
            const int col = q * 256 + c.lane * 4;
            v[q] = *(const float4*)(H + (size_t)row * D + col);
            float ya[4], yb[4]; unpack4(*(const u32x2*)(Y + (size_t)row * D + col), ya); unpack4(*(const u32x2*)(Y + ((size_t)NZ + row) * D + col), yb);
            const float4 m5 = *(const float4*)(modv + ((size_t)(NL - 1) * 3 + b) * 6144 + 5 * 1024 + col);
            v[q].x += m5.x * (ya[0] + yb[0]); v[q].y += m5.y * (ya[1] + yb[1]); v[q].z += m5.z * (ya[2] + yb[2]); v[q].w += m5.w * (ya[3] + yb[3]);
            ss += v[q].x * v[q].x + v[q].y * v[q].y + v[q].z * v[q].z + v[q].w * v[q].w;
        }
        ss = wave_sum(ss);
        const float rs = rsqrtf(ss * (1.f / 1024.f) + 1e-6f);
#pragma unroll
        for (int q = 0; q < 4; ++q) {
            const int col = q * 256 + c.lane * 4; const float4 gg = *(const float4*)(g + col);
            *(float4*)(c.out + (size_t)r * D + col) = make_float4(v[q].x * rs * gg.x, v[q].y * rs * gg.y, v[q].z * rs * gg.z, v[q].w * rs * gg.w);
        }
    }
}

struct EpiInproj {
    static constexpr bool PERM = true, AFTER_DRAIN = false;
    bf16_t *PM, *PS, *PR, *PD, *GT;
    DI void operator()(const pg8::f32x4 (&acc)[2][2][4][2], const pg8::Unit& u, int wr, int wc, int fr, int fq) const {
        const int row0 = u.pm * 256 + wr * 64 + fr, col0 = u.pn * 256 + wc * 32 + 8 * fq;
#pragma unroll
        for (int bj = 0; bj < 2; ++bj) {
            const int col = col0 + bj * 128;
            bf16_t* dst; int ld, cc; bool gate = false;
            if (col < 416) { dst = PM; ld = 416; cc = col; }
            else if (col < 1440) { dst = PR; ld = 1024; cc = col - 416; }
            else if (col < 1696) { dst = PS; ld = 256; cc = col - 1440; }
            else if (col < 2464) { dst = PD; ld = 768; cc = col - 1696; }
            else if (col < NIN) { dst = GT; ld = 4096; cc = col - 2464; gate = true; }
            else continue;
#pragma unroll
            for (int ai = 0; ai < 2; ++ai)
#pragma unroll
                for (int m = 0; m < 4; ++m) {
                    const int row = row0 + ai * 128 + m * 16; pg8::f32x4 v0 = acc[ai][bj][m][0], v1 = acc[ai][bj][m][1];
                    if (gate) { v0[0] = sigmoidf_(v0[0]); v0[1] = sigmoidf_(v0[1]); v0[2] = sigmoidf_(v0[2]); v0[3] = sigmoidf_(v0[3]);
                                v1[0] = sigmoidf_(v1[0]); v1[1] = sigmoidf_(v1[1]); v1[2] = sigmoidf_(v1[2]); v1[3] = sigmoidf_(v1[3]); }
                    u32x4 w; w.x = pack2(v0[0], v0[1]); w.y = pack2(v0[2], v0[3]); w.z = pack2(v1[0], v1[1]); w.w = pack2(v1[2], v1[3]);
                    *(u32x4*)(dst + (size_t)row * ld + cc) = w;
                }
        }
    }
};
DI void phase_inproj(const Ctx& c, int l) {
    EpiInproj E; E.PM = (bf16_t*)(c.ws + WS_P + P_PM); E.PS = (bf16_t*)(c.ws + WS_P + P_PS); E.PR = (bf16_t*)(c.ws + WS_P + P_PR); E.PD = (bf16_t*)(c.ws + WS_P + P_PD); E.GT = (bf16_t*)(c.ws + WS_GT);
    pg8::Gemm g{(const bf16_t*)(c.ws + WS_BUFA), (const bf16_t*)(c.ws + WS_WSM + OFF_WINT + l * SZ_WINT), NZ, NINP, 1024, 1024, 1024};
    pg8::StaticOrder S; S.init(NZ, NINP, (int)gridDim.x, (int)blockIdx.x);
    __syncthreads();
    pg8::gemm_phase<EpiInproj, pg8::StaticOrder, false>((PG8_LAS unsigned char*)c.smem, g, S, E, nullptr, c.tid);
}

DI void phase_prep(const Ctx& c, int l) {
    unsigned char* ws = c.ws; const int lane = c.lane, wave = c.wave, tid = c.tid;
    const bf16_t* PM = (const bf16_t*)(ws + WS_P + P_PM); const bf16_t* PR = (const bf16_t*)(ws + WS_P + P_PR); const bf16_t* PD = (const bf16_t*)(ws + WS_P + P_PD);
    bf16_t* CQN = (bf16_t*)(ws + WS_MISC + MS_CQN); bf16_t* TW = (bf16_t*)(ws + WS_MISC + MS_TW); bf16_t* AL = (bf16_t*)(ws + WS_MISC + MS_AL); bf16_t* SG = (bf16_t*)(ws + WS_MISC + MS_SG);
    bf16_t* KM = (bf16_t*)(ws + WS_EXPW + MX_KM); bf16_t* QD = (bf16_t*)(ws + WS_EXPW + MX_QD); bf16_t* KD_ = (bf16_t*)(ws + WS_EXPW + MX_KD); bf16_t* VDT = (bf16_t*)(ws + WS_EXPW + MX_VDT);
    bf16_t* RB = (bf16_t*)(ws + WS_EXPW + MX_RB); bf16_t* KB = (bf16_t*)(ws + WS_EXPW + MX_KB); bf16_t* VB = (bf16_t*)(ws + WS_EXPW + MX_VB); bf16_t* KKB = (bf16_t*)(ws + WS_EXPW + MX_KKB);
    const float* rope = (const float*)(ws + WS_WSM + OFF_ROPE);
    const float* gq = c.in[9] + l * 256; const float* gkv = c.in[10] + l * 128; const float* mu = c.in[13] + l * 1024; const float* k_k = c.in[19] + l * 256;
    bf16_t* Vs = (bf16_t*)c.smem;
    const float qsc = 0.17677669529663687f * LOG2E;
    for (int tile = blockIdx.x; tile < NZ / 16; tile += gridDim.x) {
        __syncthreads();
#pragma unroll 2
        for (int i = 0; i < 2; ++i) {
            const int rt = wave * 2 + i, z = tile * 16 + rt, b = z / TZ, s = z % TZ; const bool lat = s >= CTX; const int tl = lat ? s - CTX : 0;
            {
                const bf16_t* pm = PM + (size_t)z * 416;
                float x[4]; unpack4(*(const u32x2*)(pm + lane * 4), x);
                float ss = wave_sum(x[0] * x[0] + x[1] * x[1] + x[2] * x[2] + x[3] * x[3]);
                float rs = rsqrtf(ss * (1.f / 256.f) + 1e-6f);
                const float4 g = *(const float4*)(gq + lane * 4);
                *(u32x2*)(CQN + (size_t)z * 384 + lane * 4) = pack4(x[0] * rs * g.x, x[1] * rs * g.y, x[2] * rs * g.z, x[3] * rs * g.w);
                const unsigned u2 = *(const unsigned*)(pm + 256 + lane * 2); const float y0 = lo2f(u2), y1 = hi2f(u2);
                ss = wave_sum(y0 * y0 + y1 * y1); rs = rsqrtf(ss * (1.f / 128.f) + 1e-6f);
                const float2 g2 = *(const float2*)(gkv + lane * 2);
                *(unsigned*)(CQN + (size_t)z * 384 + 256 + lane * 2) = pack2(y0 * rs * g2.x, y1 * rs * g2.y);
                float kr = bf2f(pm[384 + (lane & 31)]);
                const float pr = __shfl_xor(kr, 8, 64);
                if (lat) { const float* cs = rope + ((size_t)tl * 16 + ((lane & 31) >> 4) * 8 + (lane & 7)) * 2; kr = kr * cs[0] + ((lane & 8) ? pr : -pr) * cs[1]; }
                if (lane < 32) {
                    const bf16_t kv = f2bf(kr);
#pragma unroll
                    for (int h = 0; h < 4; ++h) KM[((size_t)(b * 4 + h) * TZ + s) * 96 + 64 + lane] = kv;
                }
            }
            {
                const bf16_t* pd = PD + (size_t)z * 768;
                const int i0 = lane * 4, hh = i0 >> 6, ii = i0 & 31, nn = (i0 >> 5) & 1;
                const float* cs = rope + ((size_t)tl * 16 + (ii >> 4) * 8 + (ii & 7)) * 2;
                const bool hi = (ii & 8) != 0;
#pragma unroll
                for (int w = 0; w < 2; ++w) {
                    float x[4]; unpack4(*(const u32x2*)(pd + w * 256 + i0), x);
                    float o[4];
#pragma unroll
                    for (int j = 0; j < 4; ++j) {
                        const float p = __shfl_xor(x[j], 2, 64);
                        o[j] = lat ? (x[j] * cs[2 * j] + (hi ? p : -p) * cs[2 * j + 1]) : x[j];
                        if (w == 0) o[j] *= qsc;
                    }
                    bf16_t* dst = (w == 0 ? QD : KD_) + ((size_t)(b * 4 + hh) * TZ + s) * 64 + nn * 32 + ii;
                    *(u32x2*)dst = pack4(o[0], o[1], o[2], o[3]);
                }
                *(u32x2*)(Vs + rt * 264 + i0) = *(const u32x2*)(pd + 512 + i0);
            }
            {
                const bf16_t* pr = PR + (size_t)z * 1024;
                const bool hp = (s != 0) && (s != CTX), hn = (s != CTX - 1) && (s != TZ - 1);
#pragma unroll
                for (int q = 0; q < 4; ++q) {
                    const int col = q * 256 + lane * 4;
                    float cu[4], pv[4] = {0.f, 0.f, 0.f, 0.f}, nx[4] = {0.f, 0.f, 0.f, 0.f};
                    unpack4(*(const u32x2*)(pr + col), cu);
                    if (hp) unpack4(*(const u32x2*)(pr - 1024 + col), pv);
                    if (hn) unpack4(*(const u32x2*)(pr + 1024 + col), nx);
                    const float4 m = *(const float4*)(mu + col);
                    float zv[4];
                    zv[0] = cu[0] + (0.5f * (pv[0] + nx[0]) - cu[0]) * m.x; zv[1] = cu[1] + (0.5f * (pv[1] + nx[1]) - cu[1]) * m.y;
                    zv[2] = cu[2] + (0.5f * (pv[2] + nx[2]) - cu[2]) * m.z; zv[3] = cu[3] + (0.5f * (pv[3] + nx[3]) - cu[3]) * m.w;
                    if (q == 0) *(u32x2*)(RB + (size_t)z * 256 + lane * 4) = pack4(zv[0], zv[1], zv[2], zv[3]);
                    else if (q == 1) {
                        *(u32x2*)(KB + (size_t)z * 256 + lane * 4) = pack4(zv[0], zv[1], zv[2], zv[3]);
                        const float4 kk4 = *(const float4*)(k_k + lane * 4);
                        const float a0 = zv[0] * kk4.x, a1 = zv[1] * kk4.y, a2 = zv[2] * kk4.z, a3 = zv[3] * kk4.w;
                        const float ssq = sum16(a0 * a0 + a1 * a1 + a2 * a2 + a3 * a3);
                        const float inv = 1.f / fmaxf(sqrtf(ssq), 1e-12f);
                        *(u32x2*)(KKB + (size_t)z * 256 + lane * 4) = pack4(a0 * inv, a1 * inv, a2 * inv, a3 * inv);
                    } else if (q == 2) *(u32x2*)(VB + (size_t)z * 256 + lane * 4) = pack4(zv[0], zv[1], zv[2], zv[3]);
                    else {
                        if (lane < 16) *(u32x2*)(TW + (size_t)z * 64 + lane * 4) = pack4(tanhf(zv[0]), tanhf(zv[1]), tanhf(zv[2]), tanhf(zv[3]));
                        else if (lane < 32) *(u32x2*)(AL + (size_t)z * 64 + (lane - 16) * 4) = pack4(zv[0], zv[1], zv[2], zv[3]);
                        else *(u32x2*)(SG + (size_t)z * 128 + (lane - 32) * 4) = pack4(sigmoidf_(zv[0]), sigmoidf_(zv[1]), sigmoidf_(zv[2]), sigmoidf_(zv[3]));
                    }
                }
            }
        }
        __syncthreads();
        {
            const int z0 = tile * 16, b = z0 / TZ, s0 = z0 % TZ;
#pragma unroll
            for (int i = 0; i < 1; ++i) {
                const int ch = tid, dv = ch >> 1, r8 = (ch & 1) * 8;
                bf16_t v[8];
#pragma unroll
                for (int j = 0; j < 8; ++j) v[j] = Vs[(r8 + j) * 264 + dv];
                u32x4 o; o.x = v[0] | ((unsigned)v[1] << 16); o.y = v[2] | ((unsigned)v[3] << 16); o.z = v[4] | ((unsigned)v[5] << 16); o.w = v[6] | ((unsigned)v[7] << 16);
                *(u32x4*)(VDT + ((size_t)(b * 4 + (dv >> 6)) * 64 + (dv & 63)) * TZ + s0 + r8) = o;
            }
        }
    }
}

constexpr int S5C = 64, S5N = TZ / S5C, S5NC = CTX / S5C;
DI int s5_tok(int dir, int i) { return dir == 0 ? i : (i < CTX ? CTX - 1 - i : TZ - 1 - (i - CTX)); }
DI void s5_stage_u(const Ctx& c, float* U, int b, int dir, int chunk, int g0, int ng) {
    const bf16_t* PS = (const bf16_t*)(c.ws + WS_P + P_PS);
    const int per = ng * 4;
    for (int e = c.tid; e < S5C * per; e += NTHR) {
        const int i = e / per, c4 = (e % per) * 4, s = s5_tok(dir, chunk * S5C + i);
        float x[4]; unpack4(*(const u32x2*)(PS + (size_t)(b * TZ + s) * 256 + g0 * 16 + c4), x);
        *(float4*)(U + i * (ng * 16) + c4) = make_float4(x[0], x[1], x[2], x[3]);
    }
}
DI void phase_s5_local(const Ctx& c, int l) {
    float* U = (float*)c.smem;
    const float* s5t = (const float*)(c.ws + WS_WSM + OFF_S5T);
    float* E = (float*)(c.ws + WS_WSM + OFF_S5E);
    for (int u = blockIdx.x; u < 2 * 2 * S5N * 2; u += gridDim.x) {
        const int gq = u & 1, chunk = (u >> 1) % S5N, dir = (u / (2 * S5N)) & 1, b = u / (4 * S5N);
        __syncthreads();
        s5_stage_u(c, U, b, dir, chunk, gq * 8, 8);
        __syncthreads();
        const int g = gq * 8 + c.wave, p = c.lane;
        const float* tb = s5t + ((size_t)((l * 2 + dir) * 16 + g) * 64 + p) * 36;
        const float are = tb[0], aim = tb[1];
        float br[16], bi[16];
#pragma unroll
        for (int ch = 0; ch < 16; ++ch) { br[ch] = tb[4 + ch]; bi[ch] = tb[20 + ch]; }
        float xr = 0.f, xi = 0.f;
        for (int i = 0; i < S5C; ++i) {
            const float* uu = U + i * 128 + c.wave * 16;
            float sr = 0.f, si = 0.f;
#pragma unroll
            for (int q = 0; q < 4; ++q) { const float4 v = *(const float4*)(uu + q * 4);
                sr += br[q * 4] * v.x + br[q * 4 + 1] * v.y + br[q * 4 + 2] * v.z + br[q * 4 + 3] * v.w;
                si += bi[q * 4] * v.x + bi[q * 4 + 1] * v.y + bi[q * 4 + 2] * v.z + bi[q * 4 + 3] * v.w; }
            const float nr = are * xr - aim * xi + sr, ni = are * xi + aim * xr + si; xr = nr; xi = ni;
        }
        *(float2*)(E + ((size_t)(((b * 2 + dir) * 16 + g) * S5N + chunk) * 64 + p) * 2) = make_float2(xr, xi);
    }
}
DI void phase_s5_carry(const Ctx& c, int l) {
    const int gt = blockIdx.x * NTHR + c.tid;
    if (gt < 2 * 2 * 16 * 64) {
        const int p = gt & 63, g = (gt >> 6) & 15, dir = (gt >> 10) & 1, b = gt >> 11;
        const float* tb = (const float*)(c.ws + WS_WSM + OFF_S5T) + ((size_t)((l * 2 + dir) * 16 + g) * 64 + p) * 36;
        const float ar = tb[2], ai = tb[3];
        const float* E = (const float*)(c.ws + WS_WSM + OFF_S5E) + (size_t)(((b * 2 + dir) * 16 + g) * S5N) * 128;
        float* C = (float*)(c.ws + WS_WSM + OFF_S5C) + (size_t)(((b * 2 + dir) * 16 + g) * S5N) * 128;
        float xr = 0.f, xi = 0.f;
        for (int ch = 0; ch < S5N; ++ch) {
            const float2 e = *(const float2*)(E + ch * 128 + p * 2);
            *(float2*)(C + ch * 128 + p * 2) = make_float2(xr, xi);
            const float nr = ar * xr - ai * xi + e.x, ni = ar * xi + ai * xr + e.y; xr = nr; xi = ni;
        }
    }
}

constexpr int S5_US = 0, S5_YS = 8192, S5_WV = S5_YS + 2 * 64 * 64 * 4;
template <bool LOCAL>
DI void phase_s5_final_unit(const Ctx& c, int l, int u) {
    unsigned char* L = c.smem;
    const float* s5t = (const float*)(c.ws + WS_WSM + OFF_S5T);
    const float* CIN = (const float*)(c.ws + WS_WSM + OFF_S5C);
    const bf16_t* PS = (const bf16_t*)(c.ws + WS_P + P_PS);
    const int gq = u & 3, ct = (u >> 2) % S5N, b = u / (4 * S5N);
    const int wave = c.wave, lane = c.lane, gl = wave >> 1, dir = wave & 1, g = gq * 4 + gl, n16 = lane & 15, q4 = lane >> 4;
    __syncthreads();
    {
        const int t = c.tid >> 3, part = c.tid & 7;
        *(u32x4*)(L + S5_US + t * 128 + part * 16) = *(const u32x4*)(PS + (size_t)(b * TZ + ct * S5C + t) * 256 + gq * 64 + part * 8);
    }
    typedef short s16x4 __attribute__((ext_vector_type(4)));
    const float* tbase = s5t + ((size_t)((l * 2 + dir) * 16 + g) * 64) * 36;
    s16x4 bfr[8], cfr[8];
#pragma unroll
    for (int j = 0; j < 8; ++j) {
        const int pp = 16 * j + n16, p = pp & 63; const float* tb = tbase + (size_t)p * 36 + (pp < 64 ? 4 : 20) + 4 * q4;
        u32x2 w2; w2.x = pack2(tb[0], tb[1]); w2.y = pack2(tb[2], tb[3]);
        bfr[j] = __builtin_bit_cast(s16x4, w2);
    }
    {
        const float* cre = c.in[29] + ((size_t)((l * 2 + dir) * 16 + g) * 16 + n16) * 64; const float* cim = c.in[30] + ((size_t)((l * 2 + dir) * 16 + g) * 16 + n16) * 64;
#pragma unroll
        for (int s = 0; s < 8; ++s) {
            const int pp = 16 * s + 4 * q4; const float sg = pp < 64 ? 1.f : -1.f; const float* src = (pp < 64 ? cre + pp : cim + (pp - 64));
            u32x2 w2; w2.x = pack2(sg * src[0], sg * src[1]); w2.y = pack2(sg * src[2], sg * src[3]);
            cfr[s] = __builtin_bit_cast(s16x4, w2);
        }
    }
    const float are = tbase[(size_t)lane * 36], aim = tbase[(size_t)lane * 36 + 1];
    const int cd = dir == 0 ? ct : (ct < S5NC ? S5NC - 1 - ct : S5N + S5NC - 1 - ct);
    float xr = 0.f, xi = 0.f;
    if (!LOCAL) { const float2 ci = *(const float2*)(CIN + ((size_t)(((b * 2 + dir) * 16 + g) * S5N + cd) * 64 + lane) * 2); xr = ci.x; xi = ci.y; }
    const float dsk = c.in[31][(size_t)l * 256 + g * 16 + n16];
    bf16_t* BU = (bf16_t*)(L + S5_WV + wave * 8192); bf16_t* XB = BU + 16 * 128;
    float* YS = (float*)(L + S5_YS) + dir * 64 * 64;
    __syncthreads();
#pragma unroll 1
    for (int sb = 0; sb < 4; ++sb) {
        const int stepA = 16 * sb + n16, tlA = dir == 0 ? stepA : 63 - stepA;
        const s16x4 af = __builtin_bit_cast(s16x4, *(const u32x2*)(L + S5_US + tlA * 128 + gl * 32 + q4 * 8));
#pragma unroll
        for (int j = 0; j < 8; ++j) {
            f32x4 acc = {0.f, 0.f, 0.f, 0.f};
            acc = __builtin_amdgcn_mfma_f32_16x16x16bf16_1k(af, bfr[j], acc, 0, 0, 0);
#pragma unroll
            for (int rr = 0; rr < 4; ++rr) {
                const unsigned me = pack2(acc[rr], 0.f) & 0xffffu, nb = (unsigned)__shfl_xor((int)me, 1, 64);
                if ((n16 & 1) == 0) *(unsigned*)(BU + (4 * q4 + rr) * 128 + 16 * j + n16) = me | (nb << 16);
            }
        }
        asm volatile("s_waitcnt lgkmcnt(0)" ::: "memory");
        __builtin_amdgcn_wave_barrier();
#pragma unroll
        for (int ii = 0; ii < 16; ++ii) {
            const float br = bf2f(BU[ii * 128 + lane]), bi = bf2f(BU[ii * 128 + 64 + lane]);
            const float nr = are * xr - aim * xi + br, ni = are * xi + aim * xr + bi; xr = nr; xi = ni;
            if (!LOCAL) {
                const unsigned mr = pack2(xr, 0.f) & 0xffffu, mi = pack2(xi, 0.f) & 0xffffu, nr2 = (unsigned)__shfl_xor((int)mr, 1, 64), ni2 = (unsigned)__shfl_xor((int)mi, 1, 64);
                if ((lane & 1) == 0) { *(unsigned*)(XB + ii * 128 + lane) = mr | (nr2 << 16); *(unsigned*)(XB + ii * 128 + 64 + lane) = mi | (ni2 << 16); }
            }
        }
        asm volatile("s_waitcnt lgkmcnt(0)" ::: "memory");
        __builtin_amdgcn_wave_barrier();
        if (LOCAL) continue;
        f32x4 ya = {0.f, 0.f, 0.f, 0.f};
#pragma unroll
        for (int s = 0; s < 8; ++s) {
            const s16x4 xf = __builtin_bit_cast(s16x4, *(const u32x2*)((const unsigned char*)XB + n16 * 256 + (16 * s + 4 * q4) * 2));
            ya = __builtin_amdgcn_mfma_f32_16x16x16bf16_1k(xf, cfr[s], ya, 0, 0, 0);
        }
#pragma unroll
        for (int rr = 0; rr < 4; ++rr) {
            const int step = 16 * sb + 4 * q4 + rr, tl = dir == 0 ? step : 63 - step;
            float y = ya[rr];
            if (dir == 0) y += dsk * bf2f(*(const bf16_t*)(L + S5_US + tl * 128 + (gl * 16 + n16) * 2));
            YS[tl * 64 + gl * 16 + n16] = y;
        }
    }
    if (LOCAL) { *(float2*)((float*)(c.ws + WS_WSM + OFF_S5E) + ((size_t)(((b * 2 + dir) * 16 + g) * S5N + cd) * 64 + lane) * 2) = make_float2(xr, xi); return; }
    __syncthreads();
    bf16_t* ZG = (bf16_t*)(c.ws + WS_MISC + MS_ZG);
    {
        const float* Y0 = (const float*)(L + S5_YS); const float* Y1 = Y0 + 64 * 64;
        for (int e = c.tid; e < 64 * 16; e += NTHR) {
            const int i = e >> 4, c4 = (e & 15) * 4; const float4 y0 = *(const float4*)(Y0 + i * 64 + c4), y1 = *(const float4*)(Y1 + i * 64 + c4);
            *(u32x2*)(ZG + (size_t)(b * TZ + ct * S5C + i) * 256 + gq * 64 + c4) = pack4(gelu_tanh(y0.x + y1.x), gelu_tanh(y0.y + y1.y), gelu_tanh(y0.z + y1.z), gelu_tanh(y0.w + y1.w));
        }
    }
}

DI void phase_small_gemms(const Ctx& c, int l) {
    unsigned char* ws = c.ws; unsigned char* wsm = ws + WS_WSM;
    const bf16_t* CQN = (const bf16_t*)(ws + WS_MISC + MS_CQN);
    const float* rope = (const float*)(wsm + OFF_ROPE);
    constexpr int NMT = NZ / 256;
    int base = 0;
    const int G = gridDim.x, bid = blockIdx.x;
    {
        const bf16_t* W = (const bf16_t*)(wsm + OFF_WUQT + l * SZ_WUQT); bf16_t* QM = (bf16_t*)(ws + WS_EXPW + MX_QM);
        const float qs = 0.10206207261596577f * LOG2E;
        for (int u = (bid + G - base % G) % G; u < NMT * 3; u += G) {
            const int mt = u / 3, nt = u % 3, r0 = mt * 256, c0 = nt * 128;
            gemm_tile<4, 0>(c, 256, [&](int i) { return CQN + (size_t)(r0 + i) * 384; }, [&](int i) { return W + (size_t)(c0 + i) * 256; }, NoHook(),
                [&](f32x4 (&acc)[4][4], int wr, int wc, int fr, int fq) {
#pragma unroll
                    for (int n = 0; n < 4; ++n) {
                        const int col = c0 + wc + n * 16 + fq * 4, h = col / 96, d = col % 96;
                        const bool rp = d >= 64;
#pragma unroll
                        for (int m = 0; m < 4; ++m) {
                            const int row = r0 + wr + m * 16 + fr, b = row / TZ, s = row % TZ; f32x4 v = acc[m][n];
                            f32x4 pv; pv[0] = __shfl_xor(v[0], 32, 64); pv[1] = __shfl_xor(v[1], 32, 64); pv[2] = __shfl_xor(v[2], 32, 64); pv[3] = __shfl_xor(v[3], 32, 64);
                            if (rp && s >= CTX) {
                                const int i0 = d - 64;
                                const float* cs = rope + ((size_t)(s - CTX) * 16 + (i0 >> 4) * 8 + (i0 & 7)) * 2;
                                const bool hi = (i0 & 8) != 0;
#pragma unroll
                                for (int j = 0; j < 4; ++j) v[j] = v[j] * cs[2 * j] + (hi ? pv[j] : -pv[j]) * cs[2 * j + 1];
                            }
                            *(u32x2*)(QM + ((size_t)(b * 4 + h) * TZ + s) * 96 + d) = pack4(v[0] * qs, v[1] * qs, v[2] * qs, v[3] * qs);
                        }
                    }
                });
        }
        base += NMT * 3;
    }
    {
        const bf16_t* W = (const bf16_t*)(wsm + OFF_WUKVT + l * SZ_WUKVT); bf16_t* KM = (bf16_t*)(ws + WS_EXPW + MX_KM); bf16_t* VMT = (bf16_t*)(ws + WS_EXPW + MX_VMT);
        for (int u = (bid + G - base % G) % G; u < NMT * 4; u += G) {
            const int mt = u / 4, nt = u % 4, r0 = mt * 256, c0 = nt * 128;
            gemm_tile<4, 0>(c, 128, [&](int i) { return CQN + (size_t)(r0 + i) * 384 + 256; }, [&](int i) { return W + (size_t)(c0 + i) * 128; }, NoHook(),
                [&](f32x4 (&acc)[4][4], int wr, int wc, int fr, int fq) {
#pragma unroll
                    for (int n = 0; n < 4; ++n) {
                        const int col = c0 + wc + n * 16 + fq * 4, h = col >> 7, d = col & 127;
#pragma unroll
                        for (int m = 0; m < 4; ++m) {
                            const int row = r0 + wr + m * 16 + fr, b = row / TZ, s = row % TZ; const f32x4 v = acc[m][n];
                            if (d < 64) *(u32x2*)(KM + ((size_t)(b * 4 + h) * TZ + s) * 96 + d) = pack4(v[0], v[1], v[2], v[3]);
                            else {
#pragma unroll
                                for (int j = 0; j < 4; ++j) VMT[((size_t)(b * 4 + h) * 64 + (d - 64 + j)) * TZ + s] = f2bf(v[j]);
                            }
                        }
                    }
                });
        }
        base += NMT * 4;
    }
    bf16_t* SE = (bf16_t*)(ws + WS_P + P_PR); bf16_t* SAD = SE + (size_t)2 * NZ * 256; bf16_t* SKD = SAD + (size_t)2 * NZ * 256;
    {
        const bf16_t* A = (const bf16_t*)(ws + WS_MISC + MS_TW); const bf16_t* W = (const bf16_t*)(wsm + OFF_W2T + l * SZ_W2T);
        const float* w0 = c.in[14] + (size_t)l * 512;
        for (int u = (bid + G - base % G) % G; u < NMT * 4; u += G) {
            const int mt = u / 4, nt = u % 4, r0 = mt * 256, c0 = nt * 128;
            gemm_tile<4, 0>(c, 64, [&](int i) { return A + (size_t)(r0 + i) * 64; }, [&](int i) { return W + (size_t)(c0 + i) * 64; }, NoHook(),
                [&](f32x4 (&acc)[4][4], int wr, int wc, int fr, int fq) {
#pragma unroll
                    for (int n = 0; n < 4; ++n) {
                        const int col = c0 + wc + n * 16 + fq * 4, d = col >> 8, cc = col & 255; const float4 w0v = *(const float4*)(w0 + col);
#pragma unroll
                        for (int m = 0; m < 4; ++m) {
                            const int row = r0 + wr + m * 16 + fr; const f32x4 v = acc[m][n]; float e[4];
                            const float x[4] = {w0v.x + v[0], w0v.y + v[1], w0v.z + v[2], w0v.w + v[3]};
#pragma unroll
                            for (int j = 0; j < 4; ++j) e[j] = 0.6065306597126334f * sigmoidf_(x[j]);
                            *(u32x2*)(SE + ((size_t)d * NZ + row) * 256 + cc) = pack4(e[0], e[1], e[2], e[3]);
                        }
                    }
                });
        }
        base += NMT * 4;
    }
    {
        const bf16_t* A = (const bf16_t*)(ws + WS_MISC + MS_AL); const bf16_t* W = (const bf16_t*)(wsm + OFF_A2T + l * SZ_A2T);
        const float* a0 = c.in[16] + (size_t)l * 512; const float* k_a = c.in[20] + (size_t)l * 256; const bf16_t* KB = (const bf16_t*)(ws + WS_EXPW + MX_KB);
        for (int u = (bid + G - base % G) % G; u < NMT * 4; u += G) {
            const int mt = u / 4, nt = u % 4, r0 = mt * 256, c0 = nt * 128;
            gemm_tile<4, 0>(c, 64, [&](int i) { return A + (size_t)(r0 + i) * 64; }, [&](int i) { return W + (size_t)(c0 + i) * 64; }, NoHook(),
                [&](f32x4 (&acc)[4][4], int wr, int wc, int fr, int fq) {
#pragma unroll
                    for (int n = 0; n < 4; ++n) {
                        const int col = c0 + wc + n * 16 + fq * 4, d = col >> 8, cc = col & 255; const float4 a0v = *(const float4*)(a0 + col), kav = *(const float4*)(k_a + cc);
#pragma unroll
                        for (int m = 0; m < 4; ++m) {
                            const int row = r0 + wr + m * 16 + fr; const f32x4 v = acc[m][n];
                            const float ad0 = sigmoidf_(a0v.x + v[0]), ad1 = sigmoidf_(a0v.y + v[1]), ad2 = sigmoidf_(a0v.z + v[2]), ad3 = sigmoidf_(a0v.w + v[3]);
                            float k[4]; unpack4(*(const u32x2*)(KB + (size_t)row * 256 + cc), k);
                            *(u32x2*)(SAD + ((size_t)d * NZ + row) * 256 + cc) = pack4(ad0, ad1, ad2, ad3);
                            *(u32x2*)(SKD + ((size_t)d * NZ + row) * 256 + cc) = pack4(k[0] * (1.f + (ad0 - 1.f) * kav.x), k[1] * (1.f + (ad1 - 1.f) * kav.y), k[2] * (1.f + (ad2 - 1.f) * kav.z), k[3] * (1.f + (ad3 - 1.f) * kav.w));
                        }
                    }
                });
        }
        base += NMT * 4;
    }
    {
        const bf16_t* A = (const bf16_t*)(ws + WS_MISC + MS_SG); const bf16_t* W = (const bf16_t*)(wsm + OFF_G2T + l * SZ_G2T); bf16_t* GG = (bf16_t*)(ws + WS_MISC + MS_GG);
        for (int u = (bid + G - base % G) % G; u < NMT * 2; u += G) {
            const int mt = u / 2, nt = u % 2, r0 = mt * 256, c0 = nt * 128;
            gemm_tile<4, 0>(c, 128, [&](int i) { return A + (size_t)(r0 + i) * 128; }, [&](int i) { return W + (size_t)(c0 + i) * 128; }, NoHook(),
                [&](f32x4 (&acc)[4][4], int wr, int wc, int fr, int fq) {
#pragma unroll
                    for (int n = 0; n < 4; ++n)
#pragma unroll
                        for (int m = 0; m < 4; ++m) { const f32x4 v = acc[m][n];
                            *(u32x2*)(GG + (size_t)(r0 + wr + m * 16 + fr) * 256 + c0 + wc + n * 16 + fq * 4) = pack4(v[0], v[1], v[2], v[3]); }
                });
        }
        base += NMT * 2;
    }
}

DI int krow(int s, int h, int j) { return 16 * s + 8 * (j >> 2) + 4 * h + (j & 3); }
#ifndef ATT_THR
#define ATT_THR 64.f
#endif
constexpr int ATT_PARK = 56 * 1024;
template <int MODE>
DI void attn_pass(const Ctx& c, int l, int b, int h, int q0, int nkeys) {
    constexpr int DROW = MODE == 0 ? 96 : 64;
    constexpr int DQ = MODE == 0 ? 96 : 32, KS = DQ / 16;
    constexpr int DOFF = MODE == 2 ? 32 : 0;
    constexpr int TK = 128;
    constexpr int KPITCH = DQ * 2 + 16;
    constexpr int VPITCH = TK * 2 + 16;
    constexpr int KBYTES = TK * KPITCH, VBYTES = 64 * VPITCH, STG = KBYTES + VBYTES;
    static_assert(MODE == 0 || 2 * STG <= ATT_PARK, "the staging buffers must stay below the parked o1");
    unsigned char* ws = c.ws; int tid_ = c.tid; asm volatile("" : "+v"(tid_));
    const int tid = tid_, lane = tid & 63, wave = __builtin_amdgcn_readfirstlane(tid >> 6), r = lane & 31, hh = lane >> 5;
    const bf16_t* Q = (const bf16_t*)(ws + WS_EXPW + (MODE == 0 ? MX_QM : MX_QD)) + (size_t)(b * 4 + h) * TZ * DROW + DOFF;
    const bf16_t* Kp = (const bf16_t*)(ws + WS_EXPW + (MODE == 0 ? MX_KM : MX_KD)) + (size_t)(b * 4 + h) * TZ * DROW + DOFF;
    const bf16_t* Vt = (const bf16_t*)(ws + WS_EXPW + (MODE == 0 ? MX_VMT : MX_VDT)) + (size_t)(b * 4 + h) * 64 * TZ;
    unsigned char* smem = c.smem;
    bf16x8 qf[KS];
    const int qrow = q0 + wave * 32 + r;
#pragma unroll
    for (int ks = 0; ks < KS; ++ks) qf[ks] = *(const bf16x8*)(Q + (size_t)qrow * DROW + ks * 16 + hh * 8);
    f32x16 oacc[2];
    float mref = 0.f, lrun = 0.f;
#pragma unroll
    for (int t = 0; t < 2; ++t)
#pragma unroll
        for (int i = 0; i < 16; ++i) oacc[t][i] = 0.f;
    constexpr int CPR = DQ / 8, KCH = TK * CPR, NKR = KCH / NTHR;
    static_assert(KCH % NTHR == 0, "whole staging rounds");
    u32x4 kreg[NKR], vreg[2];
    const bf16_t* kp[NKR]; int koff[NKR];
#pragma unroll
    for (int i = 0; i < NKR; ++i) { const int ch = tid + i * NTHR; kp[i] = Kp + ((long)(ch / CPR) - 64) * DROW + (ch % CPR) * 8; koff[i] = (ch / CPR) * KPITCH + (ch % CPR) * 16; }
    const bf16_t* vp = Vt + (size_t)(tid >> 4) * TZ + (tid & 15) * 8 - 64;
    const int voff = (tid >> 4) * VPITCH + (tid & 15) * 16;
    auto gloadK = [&]() {
#pragma unroll
        for (int i = 0; i < NKR; ++i) { kreg[i] = *(const u32x4*)kp[i]; kp[i] += TK * DROW; }
    };
    auto gloadV = [&]() { vreg[0] = *(const u32x4*)vp; vreg[1] = *(const u32x4*)(vp + (size_t)32 * TZ); vp += TK; };
    auto lstoreK = [&](int buf) {
        unsigned char* sk = smem + buf * STG;
#pragma unroll
        for (int i = 0; i < NKR; ++i) *(u32x4*)(sk + koff[i]) = kreg[i];
    };
    auto lstoreV = [&](int buf) { unsigned char* sv = smem + buf * STG + KBYTES; *(u32x4*)(sv + voff) = vreg[0]; *(u32x4*)(sv + voff + 32 * VPITCH) = vreg[1]; };
    const int kbase = r * KPITCH + hh * 16, vbase = KBYTES + r * VPITCH + hh * 8;
    auto ldfrag = [&](const unsigned char* kb, const unsigned char* vb, int ci) -> u32x4 {
        if (ci < 8) {
            const int kg = ci >> 2, s = (ci >> 1) & 1, t = ci & 1;
            const unsigned char* vrow = vb + t * 32 * VPITCH + (kg * 32 + 16 * s) * 2;
            const u32x2 lo = *(const u32x2*)vrow, hi2 = *(const u32x2*)(vrow + 16);
            u32x4 vv; vv.x = lo.x; vv.y = lo.y; vv.z = hi2.x; vv.w = hi2.y; return vv;
        }
        const int q = ci - 8, kg = q & 1, ks = q >> 1;
        return *(const u32x4*)(kb + kg * 32 * KPITCH + ks * 32);
    };
    constexpr int NM = 8 + 2 * KS;
    const f32x16 zero16 = {0.f, 0.f, 0.f, 0.f, 0.f, 0.f, 0.f, 0.f, 0.f, 0.f, 0.f, 0.f, 0.f, 0.f, 0.f, 0.f};
    auto pv_all = [&](const u32x4 (&P)[4], const unsigned char* vb) {
#pragma unroll
        for (int ci = 0; ci < 8; ++ci) { const u32x4 f = ldfrag(vb, vb, ci); oacc[ci & 1] = __builtin_amdgcn_mfma_f32_32x32x16_bf16(__builtin_bit_cast(bf16x8, f), __builtin_bit_cast(bf16x8, P[ci >> 1]), oacc[ci & 1], 0, 0, 0); }
    };
    auto iter = [&](f32x16 (&Sc)[2], f32x16 (&Sn)[2], u32x4 (&Pp)[4], u32x4 (&Pn)[4], const unsigned char* kb, const unsigned char* vb, bool first) {
        u32x4 fcur = ldfrag(kb, vb, 0), fnx1 = ldfrag(kb, vb, 1);
        float mx = Sc[0][0];
#pragma unroll
        for (int kg = 0; kg < 2; ++kg)
#pragma unroll
            for (int i = 0; i < 16; ++i) mx = fmaxf(mx, Sc[kg][i]);
        const bool need0 = (mx - mref > ATT_THR) || (first && mx < -32.f);
        if (__any(need0)) {
            pv_all(Pp, vb);
#pragma unroll
            for (int q = 0; q < 4; ++q) Pp[q] = (u32x4){0u, 0u, 0u, 0u};
            mx = fmaxf(mx, __shfl_xor(mx, 32, 64));
            const float hi = mx - mref;
            const bool need = (hi > ATT_THR) || (first && mx < -32.f);
            const float d = need ? hi : 0.f;
            const float alpha = first ? 1.f : __builtin_amdgcn_exp2f(-d);
            mref += d; lrun *= alpha;
#pragma unroll
            for (int t = 0; t < 2; ++t)
#pragma unroll
                for (int i = 0; i < 16; ++i) oacc[t][i] *= alpha;
        }
        if (__any(mref != 0.f)) {
#pragma unroll
            for (int kg = 0; kg < 2; ++kg)
#pragma unroll
                for (int i = 0; i < 16; ++i) Sc[kg][i] -= mref;
        }
        f32x2 ps = {0.f, 0.f};
        __builtin_amdgcn_sched_barrier(0);
#pragma unroll
        for (int ci = 0; ci < NM; ++ci) {
            u32x4 fnx2 = fnx1;
            if (ci + 2 < NM) fnx2 = ldfrag(kb, vb, ci + 2);
            if (ci < 8) oacc[ci & 1] = __builtin_amdgcn_mfma_f32_32x32x16_bf16(__builtin_bit_cast(bf16x8, fcur), __builtin_bit_cast(bf16x8, Pp[ci >> 1]), oacc[ci & 1], 0, 0, 0);
            else { const int q = ci - 8, kg = q & 1, ks = q >> 1; Sn[kg] = __builtin_amdgcn_mfma_f32_32x32x16_bf16(__builtin_bit_cast(bf16x8, fcur), qf[ks], ks == 0 ? zero16 : Sn[kg], 0, 0, 0); }
#pragma unroll
            for (int p = (ci * 16) / NM; p < ((ci + 1) * 16) / NM; ++p) {
                const int kg = p >> 3, q = p & 7;
                const float p0 = __builtin_amdgcn_exp2f(Sc[kg][2 * q]), p1 = __builtin_amdgcn_exp2f(Sc[kg][2 * q + 1]);
                ps += (f32x2){p0, p1};
                Pn[kg * 2 + (q >> 2)][q & 3] = pack2(p0, p1);
            }
            asm volatile("" : "+v"(ps));
            fcur = fnx1; fnx1 = fnx2;
            __builtin_amdgcn_sched_barrier(0);
        }
        lrun += ps.x + ps.y;
    };
    const int NT = nkeys / TK;
    f32x16 S0[2], S1[2]; u32x4 PA[4], PB[4];
#pragma unroll
    for (int q = 0; q < 4; ++q) PA[q] = (u32x4){0u, 0u, 0u, 0u};
    __syncthreads();
    gloadK();
    lstoreK(1);
    gloadK();
    if ((tid & 15) >= 8) gloadV(); else { vreg[0] = (u32x4){0u, 0u, 0u, 0u}; vreg[1] = vreg[0]; vp += TK; }
    __syncthreads();
    {
        const unsigned char* kb = smem + STG + 64 * KPITCH + kbase;
#pragma unroll
        for (int q = 0; q < 2 * KS; ++q) { const int kg = q & 1, ks = q >> 1; const u32x4 f = ldfrag(kb, kb, 8 + q); S0[kg] = __builtin_amdgcn_mfma_f32_32x32x16_bf16(__builtin_bit_cast(bf16x8, f), qf[ks], ks == 0 ? zero16 : S0[kg], 0, 0, 0); }
    }
    for (int s = 0; s < NT; ++s) {
        lstoreK(s & 1); lstoreV(s & 1);
        if (s + 1 < NT) gloadK();
        gloadV();
        __syncthreads();
        const unsigned char* sb = smem + (s & 1) * STG;
        iter(S0, S1, PA, PB, sb + kbase, sb + vbase, s == 0);
        iter(S1, S0, PB, PA, sb + 64 * KPITCH + kbase, sb + 128 + vbase, false);
    }
    lstoreV(NT & 1);
    __syncthreads();
    pv_all(PA, smem + (NT & 1) * STG + vbase);
    const float inv = 1.f / (lrun + __shfl_xor(lrun, 32, 64));
    bf16_t* Ycat = (bf16_t*)(ws + WS_BUFA);
    const int zrow = b * TZ + qrow;
    float* park = (float*)(smem + ATT_PARK) + tid;
    if (MODE == 0) {
#pragma unroll
        for (int t = 0; t < 2; ++t)
#pragma unroll
            for (int i4 = 0; i4 < 4; ++i4) {
                const int dv = t * 32 + 8 * i4 + 4 * hh;
                *(u32x2*)(Ycat + (size_t)zrow * D + h * 64 + dv) = pack4(oacc[t][4 * i4] * inv, oacc[t][4 * i4 + 1] * inv, oacc[t][4 * i4 + 2] * inv, oacc[t][4 * i4 + 3] * inv);
            }
    } else if (MODE == 1) {
#pragma unroll
        for (int t = 0; t < 2; ++t)
#pragma unroll
            for (int i = 0; i < 16; ++i) park[(t * 16 + i) * NTHR] = oacc[t][i] * inv;
    } else {
        const float lam = ((const float*)(ws + WS_WSM + OFF_LAM))[l];
        const float lam_init = 0.8f - 0.6f * __expf(-0.3f * (float)l);
        float ss = 0.f;
#pragma unroll
        for (int t = 0; t < 2; ++t)
#pragma unroll
            for (int i = 0; i < 16; ++i) { const float o = park[(t * 16 + i) * NTHR] - lam * oacc[t][i] * inv; oacc[t][i] = o; ss += o * o; }
        ss += __shfl_xor(ss, 32, 64);
        const float rs = rsqrtf(ss * (1.f / 64.f) + 1e-5f) * (1.f - lam_init);
        const float* sg = c.in[38] + l * 64;
#pragma unroll
        for (int t = 0; t < 2; ++t)
#pragma unroll
            for (int i4 = 0; i4 < 4; ++i4) {
                const int dv = t * 32 + 8 * i4 + 4 * hh; const float4 g = *(const float4*)(sg + dv);
                *(u32x2*)(Ycat + (size_t)zrow * D + 768 + h * 64 + dv) = pack4(oacc[t][4 * i4] * rs * g.x, oacc[t][4 * i4 + 1] * rs * g.y, oacc[t][4 * i4 + 2] * rs * g.z, oacc[t][4 * i4 + 3] * rs * g.w);
            }
    }
}
DI void phase_attention(const Ctx& c, int l) {
    const int nu = 512 + (l == 0 ? 16 : 0);
    for (int u = blockIdx.x; u < nu; u += gridDim.x) {
        int b, h, q0, nk; bool mla;
        if (u < 512) { const int k = u & 255, bh = k & 7; b = bh >> 2; h = bh & 3; q0 = CTX + (k >> 3) * 256; nk = TZ; mla = u < 256; }
        else { const int k = u - 512; b = (k >> 2) & 1; h = k & 3; q0 = 0; nk = CTX; mla = k < 8; }
        if (mla) attn_pass<0>(c, l, b, h, q0, nk);
        else { attn_pass<1>(c, l, b, h, q0, nk); attn_pass<2>(c, l, b, h, q0, nk); }
    }
}

DI int rw_tok(int dir, int i) { return dir == 0 ? i : (i < CTX ? CTX - 1 - i : TZ - 1 - (i - CTX)); }
constexpr int RW_TS = 32;
constexpr int RW_STEP_F = 6 * 64 + 2;
constexpr int RW_BUF_F = RW_TS * RW_STEP_F;
template <int CTRL> DI float dpp_add(float x) { return x + __int_as_float(__builtin_amdgcn_update_dpp(0, __float_as_int(x), CTRL, 0xf, 0xf, false)); }
DI float red16(float x) { x = dpp_add<0xB1>(x); x = dpp_add<0x4E>(x); x = dpp_add<0x141>(x); x = dpp_add<0x140>(x); return x; }
DI float red8(float x) { x = dpp_add<0xB1>(x); x = dpp_add<0x4E>(x); x = dpp_add<0x141>(x); return x; }
struct RwRegs { u32x4 r, v, kk, e, ad, kd; };
DI void rw_load(const Ctx& c, int b, int h, int dir, int chunk, int t, RwRegs& g) {
    const bf16_t* RB = (const bf16_t*)(c.ws + WS_EXPW + MX_RB); const bf16_t* VB = (const bf16_t*)(c.ws + WS_EXPW + MX_VB); const bf16_t* KKB = (const bf16_t*)(c.ws + WS_EXPW + MX_KKB);
    const bf16_t* SE = (const bf16_t*)(c.ws + WS_P + P_PR) + (size_t)dir * NZ * 256; const bf16_t* SAD = SE + (size_t)2 * NZ * 256; const bf16_t* SKD = SAD + (size_t)2 * NZ * 256;
    const int i = chunk * RW_TS + (t >> 3), z = b * TZ + rw_tok(dir, i); const size_t o = (size_t)z * 256 + h * 64 + (t & 7) * 8;
    g.r = *(const u32x4*)(RB + o); g.v = *(const u32x4*)(VB + o); g.kk = *(const u32x4*)(KKB + o);
    g.e = *(const u32x4*)(SE + o); g.ad = *(const u32x4*)(SAD + o); g.kd = *(const u32x4*)(SKD + o);
}
DI void up8(const u32x4& u, float (&f)[8]) { f[0] = lo2f(u.x); f[1] = hi2f(u.x); f[2] = lo2f(u.y); f[3] = hi2f(u.y); f[4] = lo2f(u.z); f[5] = hi2f(u.z); f[6] = lo2f(u.w); f[7] = hi2f(u.w); }
DI void rw_process(const RwRegs& g, int t, float* buf) {
    float r[8], v[8], kk[8], e[8], ad[8], kd[8];
    up8(g.r, r); up8(g.v, v); up8(g.kk, kk); up8(g.e, e); up8(g.ad, ad); up8(g.kd, kd);
    float* f = buf + (t >> 3) * RW_STEP_F + (t & 7) * 8;
    float w[8], bv[8], wr[8]; float br = 0.f, kr = 0.f;
#pragma unroll
    for (int j = 0; j < 8; ++j) { w[j] = __expf(-e[j]); bv[j] = kk[j] * ad[j]; wr[j] = w[j] * r[j]; br += bv[j] * r[j]; kr += kd[j] * r[j]; }
    *(float4*)(f) = make_float4(w[0], w[1], w[2], w[3]); *(float4*)(f + 4) = make_float4(w[4], w[5], w[6], w[7]);
    *(float4*)(f + 64) = make_float4(kk[0], kk[1], kk[2], kk[3]); *(float4*)(f + 68) = make_float4(kk[4], kk[5], kk[6], kk[7]);
    *(float4*)(f + 128) = make_float4(bv[0], bv[1], bv[2], bv[3]); *(float4*)(f + 132) = make_float4(bv[4], bv[5], bv[6], bv[7]);
    *(float4*)(f + 192) = make_float4(kd[0], kd[1], kd[2], kd[3]); *(float4*)(f + 196) = make_float4(kd[4], kd[5], kd[6], kd[7]);
    *(float4*)(f + 256) = make_float4(wr[0], wr[1], wr[2], wr[3]); *(float4*)(f + 260) = make_float4(wr[4], wr[5], wr[6], wr[7]);
    *(float4*)(f + 320) = make_float4(v[0], v[1], v[2], v[3]); *(float4*)(f + 324) = make_float4(v[4], v[5], v[6], v[7]);
    br = red8(br); kr = red8(kr);
    if ((t & 7) == 0) { float* s = buf + (t >> 3) * RW_STEP_F + 384; s[0] = br; s[1] = kr; }
}
struct RwStep { float4 w, kk, bv, kd, wr; float vv, br, kr; };
DI void rw_ld(RwStep& s, const float* f, int kq, int row) {
    s.w = *(const float4*)(f + kq * 4); s.kk = *(const float4*)(f + 64 + kq * 4); s.bv = *(const float4*)(f + 128 + kq * 4);
    s.kd = *(const float4*)(f + 192 + kq * 4); s.wr = *(const float4*)(f + 256 + kq * 4); s.vv = f[320 + row]; s.br = f[384]; s.kr = f[385];
}
DI void phase_rwkv_scan_unit(const Ctx& c, int l, int u) {
    const int rg = u & 3, chain = u >> 2, dir = chain & 1, h = (chain >> 1) & 3, b = chain >> 3;
    float* buf0 = (float*)c.smem; float* buf1 = buf0 + RW_BUF_F;
    float* ybuf = buf1 + RW_BUF_F;
    float* YO = (float*)(c.ws + WS_BUFB) + (size_t)dir * NZ * 256 + (size_t)b * TZ * 256 + h * 64 + rg * 16;
    const int wave = c.wave, lane = c.lane, rr = lane >> 4, kq = lane & 15, rl = (wave & 3) * 4 + rr, row = rg * 16 + rl;
    const int t = c.tid - 256;
    float S0 = 0.f, S1 = 0.f, S2 = 0.f, S3 = 0.f;
    constexpr int NCH = TZ / RW_TS;
    RwRegs g;
    __syncthreads();
    if (wave >= 4) { rw_load(c, b, h, dir, 0, t, g); rw_process(g, t, buf0); rw_load(c, b, h, dir, 1, t, g); }
    __syncthreads();
    for (int ch = 0; ch < NCH; ++ch) {
        float* cur = buf0 + (ch & 1) * RW_BUF_F; float* nxt = buf0 + ((ch + 1) & 1) * RW_BUF_F;
        if (wave >= 4) {
            if (ch > 0) {
                const float* yb = ybuf + ((ch - 1) & 1) * RW_TS * 16;
#pragma unroll
                for (int i = 0; i < 2; ++i) { const int e = t + i * 256, st = e >> 4, rw = e & 15; YO[(size_t)rw_tok(dir, (ch - 1) * RW_TS + st) * 256 + rw] = yb[e]; }
            }
            if (ch + 1 < NCH) rw_process(g, t, nxt);
            if (ch + 2 < NCH) rw_load(c, b, h, dir, ch + 2, t, g);
        } else {
            float* yb = ybuf + (ch & 1) * RW_TS * 16 + rl;
            RwStep s0, s1;
            rw_ld(s0, cur, kq, row);
#pragma unroll 4
            for (int st = 0; st < RW_TS; st += 2) {
                rw_ld(s1, cur + (st + 1) * RW_STEP_F, kq, row);
                {
                    float sa = -((S0 * s0.kk.x + S1 * s0.kk.y) + (S2 * s0.kk.z + S3 * s0.kk.w));
                    float q = (S0 * s0.wr.x + S1 * s0.wr.y) + (S2 * s0.wr.z + S3 * s0.wr.w);
                    sa = red16(sa); q = red16(q);
                    S0 = fmaf(sa, s0.bv.x, fmaf(S0, s0.w.x, s0.vv * s0.kd.x)); S1 = fmaf(sa, s0.bv.y, fmaf(S1, s0.w.y, s0.vv * s0.kd.y));
                    S2 = fmaf(sa, s0.bv.z, fmaf(S2, s0.w.z, s0.vv * s0.kd.z)); S3 = fmaf(sa, s0.bv.w, fmaf(S3, s0.w.w, s0.vv * s0.kd.w));
                    yb[st * 16] = q + sa * s0.br + s0.vv * s0.kr;
                }
                if (st + 2 < RW_TS) rw_ld(s0, cur + (st + 2) * RW_STEP_F, kq, row);
                {
                    float sa = -((S0 * s1.kk.x + S1 * s1.kk.y) + (S2 * s1.kk.z + S3 * s1.kk.w));
                    float q = (S0 * s1.wr.x + S1 * s1.wr.y) + (S2 * s1.wr.z + S3 * s1.wr.w);
                    sa = red16(sa); q = red16(q);
                    S0 = fmaf(sa, s1.bv.x, fmaf(S0, s1.w.x, s1.vv * s1.kd.x)); S1 = fmaf(sa, s1.bv.y, fmaf(S1, s1.w.y, s1.vv * s1.kd.y));
                    S2 = fmaf(sa, s1.bv.z, fmaf(S2, s1.w.z, s1.vv * s1.kd.z)); S3 = fmaf(sa, s1.bv.w, fmaf(S3, s1.w.w, s1.vv * s1.kd.w));
                    yb[(st + 1) * 16] = q + sa * s1.br + s1.vv * s1.kr;
                }
            }
        }
        __syncthreads();
    }
    if (wave >= 4) {
        const float* yb = ybuf + ((NCH - 1) & 1) * RW_TS * 16;
#pragma unroll
        for (int i = 0; i < 2; ++i) { const int e = t + i * 256, st = e >> 4, rw = e & 15; YO[(size_t)rw_tok(dir, (NCH - 1) * RW_TS + st) * 256 + rw] = yb[e]; }
    }
}

constexpr int LA_AN = 0, LA_RN = 8192, LA_BN = 16384, LA_KN = 24576, LA_AT = 32768, LA_BHT = 40960, LA_KHT = 49152, LA_VT = 57344,
              LA_NBA = 65536  , LA_NKA = 81920, LA_NBRT = 90112, LA_NKRT = 98304, LA_P63 = 106496;
constexpr int LA_TMT = LA_AN, LA_M1 = LA_BN, LA_W1T = LA_KN, LA_Z1 = LA_NBA;
DI int crow(int reg, int h) { return (reg & 3) + 8 * (reg >> 2) + 4 * h; }
DI void mm_tile(f32x16& acc, const unsigned char* A, int i0, const unsigned char* BT, int j0, int r, int h) {
#pragma unroll
    for (int ks = 0; ks < 4; ++ks) {
        const bf16x8 a = *(const bf16x8*)(A + (i0 + r) * 128 + ks * 32 + h * 16);
        const bf16x8 b = *(const bf16x8*)(BT + (j0 + r) * 128 + ks * 32 + h * 16);
        acc = __builtin_amdgcn_mfma_f32_32x32x16_bf16(a, b, acc, 0, 0, 0);
    }
}
DI void zero16(f32x16& a) {
#pragma unroll
    for (int i = 0; i < 16; ++i) a[i] = 0.f;
}
DI void phase_rwkv_chunk_unit(const Ctx& c, int l, int unit) {
    unsigned char* L = c.smem; unsigned char* ws = c.ws;
    const int chain = unit / RNC, ch = unit % RNC, dir = chain & 1, hd = (chain >> 1) & 3, b = chain >> 3;
    const int tid = c.tid, lane = c.lane, wave = c.wave, r = lane & 31, h = lane >> 5;
    const bf16_t* RB = (const bf16_t*)(ws + WS_EXPW + MX_RB); const bf16_t* VB = (const bf16_t*)(ws + WS_EXPW + MX_VB); const bf16_t* KKB = (const bf16_t*)(ws + WS_EXPW + MX_KKB);
    const bf16_t* SE = (const bf16_t*)(ws + WS_P + P_PR) + (size_t)dir * NZ * 256; const bf16_t* SAD = SE + (size_t)2 * NZ * 256; const bf16_t* SKD = SAD + (size_t)2 * NZ * 256;
    float* CUM = (float*)(L + LA_NBA);
    __syncthreads();
    const int t = tid >> 3, k0 = (tid & 7) * 8;
    float rr[8], vv[8], kk[8], ee[8], ad[8], kd[8];
    {
        const int z = b * TZ + rw_tok(dir, ch * RC + t); const size_t o = (size_t)z * 256 + hd * 64 + k0;
        up8(*(const u32x4*)(RB + o), rr); up8(*(const u32x4*)(VB + o), vv); up8(*(const u32x4*)(KKB + o), kk);
        up8(*(const u32x4*)(SE + o), ee); up8(*(const u32x4*)(SAD + o), ad); up8(*(const u32x4*)(SKD + o), kd);
        *(float4*)(CUM + t * 64 + k0) = make_float4(ee[0], ee[1], ee[2], ee[3]); *(float4*)(CUM + t * 64 + k0 + 4) = make_float4(ee[4], ee[5], ee[6], ee[7]);
    }
    __syncthreads();
    if (wave == 0) { float cm = 0.f;
#pragma unroll 8
        for (int i = 0; i < RC; ++i) { cm += CUM[i * 64 + lane]; CUM[i * 64 + lane] = cm; } }
    __syncthreads();
    {
        float cm[8], c63[8];
        { const float4 a = *(const float4*)(CUM + t * 64 + k0), bq = *(const float4*)(CUM + t * 64 + k0 + 4); cm[0] = a.x; cm[1] = a.y; cm[2] = a.z; cm[3] = a.w; cm[4] = bq.x; cm[5] = bq.y; cm[6] = bq.z; cm[7] = bq.w; }
        { const float4 a = *(const float4*)(CUM + 63 * 64 + k0), bq = *(const float4*)(CUM + 63 * 64 + k0 + 4); c63[0] = a.x; c63[1] = a.y; c63[2] = a.z; c63[3] = a.w; c63[4] = bq.x; c63[5] = bq.y; c63[6] = bq.z; c63[7] = bq.w; }
        float at[8], rt[8], bt[8], kt[8], bh[8], kh[8];
#pragma unroll
        for (int j = 0; j < 8; ++j) {
            const float pt = __expf(-cm[j]), pp = __expf(-(cm[j] - ee[j])), ip = __expf(cm[j]), ph = __expf(-(c63[j] - cm[j])), bb = kk[j] * ad[j];
            at[j] = -kk[j] * pp; rt[j] = rr[j] * pt; bt[j] = bb * ip; kt[j] = kd[j] * ip; bh[j] = bb * ph; kh[j] = kd[j] * ph;
        }
        u32x4 w4;
        w4.x = pack2(at[0], at[1]); w4.y = pack2(at[2], at[3]); w4.z = pack2(at[4], at[5]); w4.w = pack2(at[6], at[7]); *(u32x4*)(L + LA_AN + t * 128 + k0 * 2) = w4;
        w4.x = pack2(rt[0], rt[1]); w4.y = pack2(rt[2], rt[3]); w4.z = pack2(rt[4], rt[5]); w4.w = pack2(rt[6], rt[7]); *(u32x4*)(L + LA_RN + t * 128 + k0 * 2) = w4;
        w4.x = pack2(bt[0], bt[1]); w4.y = pack2(bt[2], bt[3]); w4.z = pack2(bt[4], bt[5]); w4.w = pack2(bt[6], bt[7]); *(u32x4*)(L + LA_BN + t * 128 + k0 * 2) = w4;
        w4.x = pack2(kt[0], kt[1]); w4.y = pack2(kt[2], kt[3]); w4.z = pack2(kt[4], kt[5]); w4.w = pack2(kt[6], kt[7]); *(u32x4*)(L + LA_KN + t * 128 + k0 * 2) = w4;
#pragma unroll
        for (int j = 0; j < 8; ++j) {
            *(bf16_t*)(L + LA_AT + (k0 + j) * 128 + t * 2) = f2bf(at[j]); *(bf16_t*)(L + LA_BHT + (k0 + j) * 128 + t * 2) = f2bf(bh[j]);
            *(bf16_t*)(L + LA_KHT + (k0 + j) * 128 + t * 2) = f2bf(kh[j]); *(bf16_t*)(L + LA_VT + (k0 + j) * 128 + t * 2) = f2bf(vv[j]);
        }
        if (t == 63) {
            float* p63 = (float*)(L + LA_P63); float* gp = (float*)(ws + WS_RW + RW_P63) + (size_t)unit * 64;
#pragma unroll
            for (int j = 0; j < 8; ++j) { const float p = __expf(-c63[j]); p63[k0 + j] = p; gp[k0 + j] = p; }
        }
    }
    __syncthreads();
    {
        const int p = wave >> 1, i0 = (wave & 1) * 32;
        const unsigned char* A = L + (p == 0 ? LA_BN : p == 1 ? LA_KN : LA_RN);
        const unsigned char* BT = L + (p < 2 ? LA_AN : p == 2 ? LA_BN : LA_KN);
#pragma unroll
        for (int jt = 0; jt < 2; ++jt) {
            const int j0 = jt * 32; f32x16 acc; zero16(acc);
            mm_tile(acc, A, i0, BT, j0, r, h);
            const int col = j0 + r;
#pragma unroll
            for (int g = 0; g < 16; ++g) {
                const int row = i0 + crow(g, h);
                if (p == 0) ((float*)(L + LA_NBA))[row * 64 + col] = (row < col) ? acc[g] : 0.f;
                else if (p == 1) *(bf16_t*)(L + LA_NKA + row * 128 + col * 2) = f2bf((row < col) ? acc[g] : 0.f);
                else *(bf16_t*)(L + (p == 2 ? LA_NBRT : LA_NKRT) + row * 128 + col * 2) = f2bf((col <= row) ? acc[g] : 0.f);
            }
        }
    }
    __syncthreads();
    {
        constexpr int X0 = LA_BN, X1 = LA_KN, X3 = 108544, X4 = X3 + 8192, X5 = LA_NBA + 16384 - 16384, X6 = LA_NBA + 8192;
        float nv[8];
        { const int s = tid >> 3, t0 = (tid & 7) * 8; const float* N = (const float*)(L + LA_NBA) + s * 64 + t0;
          const float4 a = *(const float4*)N, bq = *(const float4*)(N + 4); nv[0] = a.x; nv[1] = a.y; nv[2] = a.z; nv[3] = a.w; nv[4] = bq.x; nv[5] = bq.y; nv[6] = bq.z; nv[7] = bq.w; }
        __syncthreads();
        {
            const int s = tid >> 3, t0 = (tid & 7) * 8;
            u32x4 w4; w4.x = pack2(nv[0], nv[1]); w4.y = pack2(nv[2], nv[3]); w4.z = pack2(nv[4], nv[5]); w4.w = pack2(nv[6], nv[7]);
            *(u32x4*)(L + X0 + s * 128 + t0 * 2) = w4;
#pragma unroll
            for (int j = 0; j < 8; ++j) *(bf16_t*)(L + X1 + (t0 + j) * 128 + s * 2) = f2bf(nv[j]);
#pragma unroll
            for (int j = 0; j < 8; ++j) if (t0 + j == s) nv[j] += 1.f;
            w4.x = pack2(nv[0], nv[1]); w4.y = pack2(nv[2], nv[3]); w4.z = pack2(nv[4], nv[5]); w4.w = pack2(nv[6], nv[7]);
            *(u32x4*)(L + X5 + s * 128 + t0 * 2) = w4;
        }
        __syncthreads();
        const int ti0 = ((wave >> 1) & 1) * 32, tj0 = (wave & 1) * 32;
        if (wave < 4) {
            f32x16 acc; zero16(acc); mm_tile(acc, L + X0, ti0, L + X1, tj0, r, h);
#pragma unroll
            for (int g4 = 0; g4 < 4; ++g4) *(u32x2*)(L + X4 + (tj0 + r) * 128 + (ti0 + 8 * g4 + 4 * h) * 2) = pack4(acc[4 * g4], acc[4 * g4 + 1], acc[4 * g4 + 2], acc[4 * g4 + 3]);
#pragma unroll
            for (int g = 0; g < 16; ++g) *(bf16_t*)(L + X3 + (ti0 + crow(g, h)) * 128 + (tj0 + r) * 2) = f2bf(acc[g]);
        }
        __syncthreads();
#pragma unroll
        for (int k = 1; k <= 5; ++k) {
            const int qa = (k & 1) ? X3 : X0, qt = (k & 1) ? X4 : X1, nqa = (k & 1) ? X0 : X3, nqt = (k & 1) ? X1 : X4;
            const int pa = (k & 1) ? X5 : X6, npa = (k & 1) ? X6 : X5;
            if (wave >= 4) {
                f32x16 acc; zero16(acc); mm_tile(acc, L + pa, ti0, L + qt, tj0, r, h);
#pragma unroll
                for (int g = 0; g < 16; ++g) acc[g] += bf2f(*(const bf16_t*)(L + pa + (ti0 + crow(g, h)) * 128 + (tj0 + r) * 2));
                if (k < 5) {
#pragma unroll
                    for (int g = 0; g < 16; ++g) *(bf16_t*)(L + npa + (ti0 + crow(g, h)) * 128 + (tj0 + r) * 2) = f2bf(acc[g]);
                } else {
#pragma unroll
                    for (int g4 = 0; g4 < 4; ++g4) *(u32x2*)(L + LA_TMT + (tj0 + r) * 128 + (ti0 + 8 * g4 + 4 * h) * 2) = pack4(acc[4 * g4], acc[4 * g4 + 1], acc[4 * g4 + 2], acc[4 * g4 + 3]);
                }
            } else if (k < 5) {
                f32x16 acc; zero16(acc); mm_tile(acc, L + qa, ti0, L + qt, tj0, r, h);
#pragma unroll
                for (int g4 = 0; g4 < 4; ++g4) *(u32x2*)(L + nqt + (tj0 + r) * 128 + (ti0 + 8 * g4 + 4 * h) * 2) = pack4(acc[4 * g4], acc[4 * g4 + 1], acc[4 * g4 + 2], acc[4 * g4 + 3]);
#pragma unroll
                for (int g = 0; g < 16; ++g) *(bf16_t*)(L + nqa + (ti0 + crow(g, h)) * 128 + (tj0 + r) * 2) = f2bf(acc[g]);
            }
            __syncthreads();
        }
    }
    {
        const int p = wave >> 2, i0 = ((wave >> 1) & 1) * 32, j0 = (wave & 1) * 32; f32x16 acc; zero16(acc);
        if (p == 0) {
            mm_tile(acc, L + LA_TMT, i0, L + LA_AT, j0, r, h);
#pragma unroll
            for (int g4 = 0; g4 < 4; ++g4) *(u32x2*)(L + LA_M1 + (j0 + r) * 128 + (i0 + 8 * g4 + 4 * h) * 2) = pack4(acc[4 * g4], acc[4 * g4 + 1], acc[4 * g4 + 2], acc[4 * g4 + 3]);
        } else {
            mm_tile(acc, L + LA_NKA, i0, L + LA_TMT, j0, r, h);
#pragma unroll
            for (int g4 = 0; g4 < 4; ++g4) *(u32x2*)(L + LA_W1T + (j0 + r) * 128 + (i0 + 8 * g4 + 4 * h) * 2) = pack4(acc[4 * g4], acc[4 * g4 + 1], acc[4 * g4 + 2], acc[4 * g4 + 3]);
        }
    }
    __syncthreads();
    if (wave < 4) {
        const int i0 = (wave >> 1) * 32, j0 = (wave & 1) * 32; f32x16 acc; zero16(acc);
        mm_tile(acc, L + LA_W1T, i0, L + LA_VT, j0, r, h);
#pragma unroll
        for (int g4 = 0; g4 < 4; ++g4) *(u32x2*)(L + LA_Z1 + (j0 + r) * 128 + (i0 + 8 * g4 + 4 * h) * 2) = pack4(acc[4 * g4], acc[4 * g4 + 1], acc[4 * g4 + 2], acc[4 * g4 + 3]);
    }
    __syncthreads();
    {
        const int p = wave >> 1, i0 = (wave & 1) * 32;
        bf16_t* GM3 = (bf16_t*)(ws + WS_RW + RW_M3) + (size_t)unit * 4096; bf16_t* GM2 = (bf16_t*)(ws + WS_RW + RW_M2) + (size_t)unit * 4096; bf16_t* GZ5 = (bf16_t*)(ws + WS_RW + RW_Z5) + (size_t)unit * 4096;
        float* YO = (float*)(ws + WS_BUFB) + (size_t)dir * NZ * 256;
#pragma unroll
        for (int jt = 0; jt < 2; ++jt) {
            const int j0 = jt * 32; f32x16 acc; zero16(acc);
            if (p == 0) {
                mm_tile(acc, L + LA_M1, i0, L + LA_NBRT, j0, r, h);
#pragma unroll
                for (int g4 = 0; g4 < 4; ++g4) { const int tt = j0 + r, kq = i0 + 8 * g4 + 4 * h; float rv[4]; unpack4(*(const u32x2*)(L + LA_RN + tt * 128 + kq * 2), rv);
                    *(u32x2*)(GM2 + tt * 64 + kq) = pack4(acc[4 * g4] + rv[0], acc[4 * g4 + 1] + rv[1], acc[4 * g4 + 2] + rv[2], acc[4 * g4 + 3] + rv[3]); }
            } else if (p == 1) {
                mm_tile(acc, L + LA_NBRT, i0, L + LA_Z1, j0, r, h); mm_tile(acc, L + LA_NKRT, i0, L + LA_VT, j0, r, h);
#pragma unroll
                for (int g = 0; g < 16; ++g) { const int tt = i0 + crow(g, h); YO[(size_t)(b * TZ + rw_tok(dir, ch * RC + tt)) * 256 + hd * 64 + j0 + r] = acc[g]; }
            } else if (p == 2) {
                mm_tile(acc, L + LA_M1, i0, L + LA_BHT, j0, r, h);
#pragma unroll
                for (int g4 = 0; g4 < 4; ++g4) *(u32x2*)(GM3 + (j0 + r) * 64 + i0 + 8 * g4 + 4 * h) = pack4(acc[4 * g4], acc[4 * g4 + 1], acc[4 * g4 + 2], acc[4 * g4 + 3]);
            } else {
                mm_tile(acc, L + LA_BHT, i0, L + LA_Z1, j0, r, h); mm_tile(acc, L + LA_KHT, i0, L + LA_VT, j0, r, h);
#pragma unroll
                for (int g4 = 0; g4 < 4; ++g4) *(u32x2*)(GZ5 + (j0 + r) * 64 + i0 + 8 * g4 + 4 * h) = pack4(acc[4 * g4], acc[4 * g4 + 1], acc[4 * g4 + 2], acc[4 * g4 + 3]);
            }
        }
    }
}
DI void phase_rwkv_chunks(const Ctx& c, int l) {
    for (int u = blockIdx.x; u < 16 * RNC; u += gridDim.x) phase_rwkv_chunk_unit(c, l, u);
}
DI bf16x8 pack8(const f32x16& x, int s) {
    u32x4 p; p.x = pack2(x[8 * s], x[8 * s + 1]); p.y = pack2(x[8 * s + 2], x[8 * s + 3]); p.z = pack2(x[8 * s + 4], x[8 * s + 5]); p.w = pack2(x[8 * s + 6], x[8 * s + 7]);
    return __builtin_bit_cast(bf16x8, p);
}
DI bf16x8 ldfrag(const bf16_t* rowp, int s, int h) {
    const u32x2 lo = *(const u32x2*)(rowp + 16 * s + 4 * h), hi = *(const u32x2*)(rowp + 16 * s + 8 + 4 * h);
    u32x4 v; v.x = lo.x; v.y = lo.y; v.z = hi.x; v.w = hi.y; return __builtin_bit_cast(bf16x8, v);
}
constexpr int SQ_PITCH = 144, SQ_MAT = 64 * SQ_PITCH;
constexpr int SQA_M3 = 0, SQA_Z5 = SQ_MAT, SQA_P63 = 2 * SQ_MAT, SQA_BYTES = SQA_P63 + 256;
constexpr int SQB_M2 = 0, SQB_Y = SQ_MAT, SQB_BYTES = SQB_Y + 64 * 64 * 4;
constexpr int SQ_A0 = 0, SQ_B0 = 2 * SQA_BYTES, SQ_XB = SQ_B0 + 2 * SQB_BYTES;
DI bf16x8 ldfrag_l(const unsigned char* rowp, int s, int h) {
    const u32x2 lo = *(const u32x2*)(rowp + (16 * s + 4 * h) * 2), hi = *(const u32x2*)(rowp + (16 * s + 8 + 4 * h) * 2);
    u32x4 v; v.x = lo.x; v.y = lo.y; v.z = hi.x; v.w = hi.y; return __builtin_bit_cast(bf16x8, v);
}
struct SqRegsA { u32x4 m3[2], z5[2], p63; };
struct SqRegsB { u32x4 m2[2], y[4]; };
DI void sqa_gload(const Ctx& c, size_t unit, int lt, SqRegsA& g) {
    const unsigned char* g3 = c.ws + WS_RW + RW_M3 + unit * 8192; const unsigned char* g5 = c.ws + WS_RW + RW_Z5 + unit * 8192;
#pragma unroll
    for (int i = 0; i < 2; ++i) { const int id = lt + i * 256; g.m3[i] = *(const u32x4*)(g3 + id * 16); g.z5[i] = *(const u32x4*)(g5 + id * 16); }
    if (lt < 16) g.p63 = *(const u32x4*)(c.ws + WS_RW + RW_P63 + unit * 256 + lt * 16);
}
DI void sqa_lstore(unsigned char* st, int lt, const SqRegsA& g) {
#pragma unroll
    for (int i = 0; i < 2; ++i) { const int id = lt + i * 256, row = id >> 3, part = id & 7;
        *(u32x4*)(st + SQA_M3 + row * SQ_PITCH + part * 16) = g.m3[i]; *(u32x4*)(st + SQA_Z5 + row * SQ_PITCH + part * 16) = g.z5[i]; }
    if (lt < 16) *(u32x4*)(st + SQA_P63 + lt * 16) = g.p63;
}
DI void sqb_gload(const Ctx& c, size_t unit, const float* YO, int dir, int ch, int lt, SqRegsB& g) {
    const unsigned char* g2 = c.ws + WS_RW + RW_M2 + unit * 8192;
#pragma unroll
    for (int i = 0; i < 2; ++i) g.m2[i] = *(const u32x4*)(g2 + (lt + i * 256) * 16);
#pragma unroll
    for (int i = 0; i < 4; ++i) { const int id = lt + i * 256; g.y[i] = *(const u32x4*)(YO + (size_t)rw_tok(dir, ch * RC + (id >> 4)) * 256 + (id & 15) * 4); }
}
DI void sqb_lstore(unsigned char* st, int lt, const SqRegsB& g) {
#pragma unroll
    for (int i = 0; i < 2; ++i) { const int id = lt + i * 256; *(u32x4*)(st + SQB_M2 + (id >> 3) * SQ_PITCH + (id & 7) * 16) = g.m2[i]; }
#pragma unroll
    for (int i = 0; i < 4; ++i) { const int id = lt + i * 256; *(u32x4*)(st + SQB_Y + (id >> 4) * 256 + (id & 15) * 16) = g.y[i]; }
}
DI void sqb_store_y(float* YO, int dir, int ch, const unsigned char* st, int lt) {
#pragma unroll
    for (int i = 0; i < 4; ++i) { const int id = lt + i * 256; *(u32x4*)(YO + (size_t)rw_tok(dir, ch * RC + (id >> 4)) * 256 + (id & 15) * 4) = *(const u32x4*)(st + SQB_Y + (id >> 4) * 256 + (id & 15) * 16); }
}
DI void phase_rwkv_seq_block(const Ctx& c, int l, int chain) {
    unsigned char* L = c.smem; const int lane = c.lane, wave = c.wave, r = lane & 31, h = lane >> 5;
    const int dir = chain & 1, hd = (chain >> 1) & 3, b = chain >> 3, lt = c.tid - 256, vh = wave & 1;
    const size_t unit0 = (size_t)chain * RNC;
    __syncthreads();
    if (wave >= 4) {
        float* YO = (float*)(c.ws + WS_BUFB) + (size_t)dir * NZ * 256 + (size_t)b * TZ * 256 + hd * 64;
        SqRegsA ga; SqRegsB gb;
        sqa_gload(c, unit0, lt, ga); sqa_lstore(L + SQ_A0, lt, ga); sqa_gload(c, unit0 + 1, lt, ga); sqb_gload(c, unit0, YO, dir, 0, lt, gb);
        __syncthreads();
#pragma unroll 1
        for (int ch = 0; ch <= RNC; ++ch) {
            unsigned char* sb = L + SQ_B0 + (ch & 1) * SQB_BYTES;
            if (ch >= 2) sqb_store_y(YO, dir, ch - 2, sb, lt);
            if (ch < RNC) sqb_lstore(sb, lt, gb);
            if (ch + 1 < RNC) { sqb_gload(c, unit0 + ch + 1, YO, dir, ch + 1, lt, gb); sqa_lstore(L + SQ_A0 + ((ch + 1) & 1) * SQA_BYTES, lt, ga); }
            if (ch + 2 < RNC) sqa_gload(c, unit0 + ch + 2, lt, ga);
            __syncthreads();
        }
        sqb_store_y(YO, dir, RNC - 1, L + SQ_B0 + ((RNC - 1) & 1) * SQB_BYTES, lt);
    } else if (wave < 2) {
        f32x16 x[2]; zero16(x[0]); zero16(x[1]);
        __syncthreads();
#pragma unroll 1
        for (int ch = 0; ch <= RNC; ++ch) {
            if (ch < RNC) {
                const unsigned char* st = L + SQ_A0 + (ch & 1) * SQA_BYTES;
                unsigned char* xbuf = L + SQ_XB + ((ch & 1) * 2 + vh) * 4096 + lane * 16;
                bf16x8 xb[4];
#pragma unroll
                for (int s = 0; s < 4; ++s) { xb[s] = pack8(x[s >> 1], s & 1); *(bf16x8*)(xbuf + s * 1024) = xb[s]; }
                f32x16 xn0, xn1;
#pragma unroll
                for (int i = 0; i < 2; ++i) {
                    f32x16 xa;
#pragma unroll
                    for (int g4 = 0; g4 < 4; ++g4) {
                        float z5[4]; unpack4(*(const u32x2*)(st + SQA_Z5 + (vh * 32 + r) * SQ_PITCH + (32 * i + 8 * g4 + 4 * h) * 2), z5);
                        const float4 p4 = *(const float4*)(st + SQA_P63 + (32 * i + 8 * g4 + 4 * h) * 4);
                        xa[4 * g4] = fmaf(p4.x, x[i][4 * g4], z5[0]); xa[4 * g4 + 1] = fmaf(p4.y, x[i][4 * g4 + 1], z5[1]);
                        xa[4 * g4 + 2] = fmaf(p4.z, x[i][4 * g4 + 2], z5[2]); xa[4 * g4 + 3] = fmaf(p4.w, x[i][4 * g4 + 3], z5[3]);
                    }
#pragma unroll
                    for (int s = 0; s < 4; ++s) xa = __builtin_amdgcn_mfma_f32_32x32x16_bf16(ldfrag_l(st + SQA_M3 + (32 * i + r) * SQ_PITCH, s, h), xb[s], xa, 0, 0, 0);
                    if (i == 0) xn0 = xa; else xn1 = xa;
                }
                x[0] = xn0; x[1] = xn1;
            }
            __syncthreads();
        }
    } else {
        __syncthreads();
#pragma unroll 1
        for (int ch = 0; ch <= RNC; ++ch) {
            if (ch >= 1) {
                const int cy = ch - 1;
                unsigned char* st = L + SQ_B0 + (cy & 1) * SQB_BYTES;
                const unsigned char* xbuf = L + SQ_XB + ((cy & 1) * 2 + vh) * 4096 + lane * 16;
                bf16x8 xb[4];
#pragma unroll
                for (int s = 0; s < 4; ++s) xb[s] = *(const bf16x8*)(xbuf + s * 1024);
#pragma unroll
                for (int i = 0; i < 2; ++i) {
                    f32x16 ya;
#pragma unroll
                    for (int g = 0; g < 16; ++g) ya[g] = *((const float*)(st + SQB_Y) + (32 * i + crow(g, h)) * 64 + vh * 32 + r);
#pragma unroll
                    for (int s = 0; s < 4; ++s) ya = __builtin_amdgcn_mfma_f32_32x32x16_bf16(ldfrag_l(st + SQB_M2 + (32 * i + r) * SQ_PITCH, s, h), xb[s], ya, 0, 0, 0);
#pragma unroll
                    for (int g = 0; g < 16; ++g) *((float*)(st + SQB_Y) + (32 * i + crow(g, h)) * 64 + vh * 32 + r) = ya[g];
                }
            }
            __syncthreads();
        }
    }
}
DI void phase_mixers2(const Ctx& c, int l) {
    const int G = gridDim.x, bid = blockIdx.x;
    if (G >= 128) {
        if (bid < 16) phase_rwkv_seq_block(c, l, bid);
        else for (int u = bid - 16; u < 2 * S5N * 4; u += G - 16) phase_s5_final_unit<false>(c, l, u);
    } else {
        for (int u = bid; u < 16; u += G) phase_rwkv_seq_block(c, l, u);
        for (int u = bid; u < 2 * S5N * 4; u += G) phase_s5_final_unit<false>(c, l, u);
    }
}

DI void phase_post(const Ctx& c, int l) {
    unsigned char* ws = c.ws; const int lane = c.lane;
    const float* YF = (const float*)(ws + WS_BUFB); const float* YB = YF + (size_t)NZ * 256;
    const bf16_t* RB = (const bf16_t*)(ws + WS_EXPW + MX_RB); const bf16_t* VB = (const bf16_t*)(ws + WS_EXPW + MX_VB);
    const bf16_t* SKD = (const bf16_t*)(ws + WS_P + P_PR) + (size_t)4 * NZ * 256; const bf16_t* GG = (const bf16_t*)(ws + WS_MISC + MS_GG);
    bf16_t* Ycat = (bf16_t*)(ws + WS_BUFA);
    const float* r_k = c.in[21] + l * 256; const float* lg = c.in[22] + l * 256; const float* lb = c.in[23] + l * 256;
    for (int z = blockIdx.x * 8 + c.wave; z < NZ; z += gridDim.x * 8) {
        const size_t o = (size_t)z * 256 + lane * 4;
        const float4 yf = *(const float4*)(YF + o), yb = *(const float4*)(YB + o);
        const float y0 = yf.x + yb.x, y1 = yf.y + yb.y, y2 = yf.z + yb.z, y3 = yf.w + yb.w;
        const float mean = sum16(y0 + y1 + y2 + y3) * (1.f / 64.f);
        const float d0 = y0 - mean, d1 = y1 - mean, d2 = y2 - mean, d3 = y3 - mean;
        const float var = sum16(d0 * d0 + d1 * d1 + d2 * d2 + d3 * d3) * (1.f / 64.f);
        const float rs = rsqrtf(var + 64e-5f);
        float r[4], v[4], k0[4], k1[4], gg[4];
        unpack4(*(const u32x2*)(RB + o), r); unpack4(*(const u32x2*)(VB + o), v); unpack4(*(const u32x2*)(SKD + o), k0); unpack4(*(const u32x2*)(SKD + (size_t)NZ * 256 + o), k1);
        unpack4(*(const u32x2*)(GG + o), gg);
        const float4 rk = *(const float4*)(r_k + lane * 4), g4 = *(const float4*)(lg + lane * 4), b4 = *(const float4*)(lb + lane * 4);
        const float bs = sum16(r[0] * (k0[0] + k1[0]) * rk.x + r[1] * (k0[1] + k1[1]) * rk.y + r[2] * (k0[2] + k1[2]) * rk.z + r[3] * (k0[3] + k1[3]) * rk.w);
        *(u32x2*)(Ycat + (size_t)z * D + 256 + lane * 4) = pack4((d0 * rs * g4.x + b4.x + bs * v[0]) * gg[0], (d1 * rs * g4.y + b4.y + bs * v[1]) * gg[1],
                                                                (d2 * rs * g4.z + b4.z + bs * v[2]) * gg[2], (d3 * rs * g4.w + b4.w + bs * v[3]) * gg[3]);
    }
    {
        const bf16_t* ZG = (const bf16_t*)(ws + WS_MISC + MS_ZG); const bf16_t* W = (const bf16_t*)(ws + WS_WSM + OFF_GLUT + l * SZ_GLUT);
        const float* gb = c.in[33] + l * 256;
        for (int u = blockIdx.x; u < (NZ / 256) * 2; u += gridDim.x) {
            const int mt = u / 2, nt = u % 2, r0 = mt * 256, c0 = nt * 128;
            gemm_tile<4, 0>(c, 256, [&](int i) { return ZG + (size_t)(r0 + i) * 256; }, [&](int i) { return W + (size_t)(c0 + i) * 256; }, NoHook(),
                [&](f32x4 (&acc)[4][4], int wr, int wc, int fr, int fq) {
#pragma unroll
                    for (int n = 0; n < 4; ++n) {
                        const int col = c0 + wc + n * 16 + fq * 4; const float4 bb = *(const float4*)(gb + col);
#pragma unroll
                        for (int m = 0; m < 4; ++m) {
                            const int row = r0 + wr + m * 16 + fr; const f32x4 v = acc[m][n];
                            float zg[4]; unpack4(*(const u32x2*)(ZG + (size_t)row * 256 + col), zg);
                            *(u32x2*)(Ycat + (size_t)row * D + 512 + col) = pack4(zg[0] * sigmoidf_(v[0] + bb.x), zg[1] * sigmoidf_(v[1] + bb.y), zg[2] * sigmoidf_(v[2] + bb.z), zg[3] * sigmoidf_(v[3] + bb.w));
                        }
                    }
                });
        }
    }
}

DI bool skip_mt(int l, int mt) { return l == NL - 1 && (mt % 33) == 0; }
DI void phase_merge1(const Ctx& c, int l) {
    const bf16_t* Ycat = (const bf16_t*)(c.ws + WS_BUFA); const bf16_t* W = (const bf16_t*)(c.ws + WS_WSM + OFF_WBT + l * SZ_WBT);
    const bf16_t* GT = (const bf16_t*)(c.ws + WS_GT); bf16_t* MG = (bf16_t*)(c.ws + WS_BUFB);
    if (blockIdx.x == 0 && c.tid < 32) ((unsigned*)(c.ws + WS_CTL))[CW_CNT + l * 32 + c.tid] = 0u;
    for (int u = blockIdx.x; u < (NZ / 256) * 8; u += gridDim.x) {
        const int mt = u / 8, nt = u % 8, r0 = mt * 256, c0 = nt * 128;
        if (skip_mt(l, mt)) continue;
        f32x4 macc[4][4];
#pragma unroll
        for (int m = 0; m < 4; ++m)
#pragma unroll
            for (int n = 0; n < 4; ++n) macc[m][n] = (f32x4){0.f, 0.f, 0.f, 0.f};
        gemm_tile<4, 256>(c, 1024, [&](int i) { return Ycat + (size_t)(r0 + i) * D; }, [&](int i) { return W + (size_t)(c0 + i) * D; },
            [&](f32x4 (&acc)[4][4], int seg, int wr, int wc, int fr, int fq) {
#pragma unroll
                for (int m = 0; m < 4; ++m)
#pragma unroll
                    for (int n = 0; n < 4; ++n) {
                        float g[4]; unpack4(*(const u32x2*)(GT + (size_t)(r0 + wr + m * 16 + fr) * 4096 + seg * 1024 + c0 + wc + n * 16 + fq * 4), g);
                        macc[m][n][0] += g[0] * acc[m][n][0]; macc[m][n][1] += g[1] * acc[m][n][1]; macc[m][n][2] += g[2] * acc[m][n][2]; macc[m][n][3] += g[3] * acc[m][n][3];
                        acc[m][n] = (f32x4){0.f, 0.f, 0.f, 0.f};
                    }
            },
            [&](f32x4 (&)[4][4], int wr, int wc, int fr, int fq) {
#pragma unroll
                for (int m = 0; m < 4; ++m)
#pragma unroll
                    for (int n = 0; n < 4; ++n)
                        *(u32x2*)(MG + (size_t)(r0 + wr + m * 16 + fr) * D + c0 + wc + n * 16 + fq * 4) = pack4(macc[m][n][0], macc[m][n][1], macc[m][n][2], macc[m][n][3]);
            });
    }
}
struct EpiMerge2 {
    static constexpr bool PERM = false, AFTER_DRAIN = false;
    float* H; const float* modv; int l;
    DI void operator()(const pg8::f32x4 (&acc)[2][2][4][2], const pg8::Unit& u, int wr, int wc, int fr, int fq) const {
        if (skip_mt(l, u.pm)) return;
        const int sel = (u.pm % 33) == 0 ? 2 : u.pm / 33;
        const int row0 = u.pm * 256 + wr * 64 + fr, col0 = u.pn * 256 + wc * 32 + 4 * fq;
#pragma unroll
        for (int bj = 0; bj < 2; ++bj)
#pragma unroll
            for (int n = 0; n < 2; ++n) {
                const int col = col0 + bj * 128 + n * 16; const float4 m2 = *(const float4*)(modv + ((size_t)l * 3 + sel) * 6144 + 2 * 1024 + col);
#pragma unroll
                for (int ai = 0; ai < 2; ++ai)
#pragma unroll
                    for (int m = 0; m < 4; ++m) {
                        float4* hp = (float4*)(H + (size_t)(row0 + ai * 128 + m * 16) * D + col); float4 hv = *hp; const pg8::f32x4 v = acc[ai][bj][m][n];
                        hv.x += m2.x * v[0]; hv.y += m2.y * v[1]; hv.z += m2.z * v[2]; hv.w += m2.w * v[3]; *hp = hv;
                    }
            }
    }
};
struct LatOrder {
    int G, c;
    DI bool next(int i, pg8::Unit& u) const { const int L = i * G + c; if (L >= 256) return false; const int pl = L >> 2; u.pm = (pl >> 5) * 33 + 1 + (pl & 31); u.pn = L & 3; return true; }
    DI void a_ready(const pg8::Unit&) const {}
    DI void done(const pg8::Unit&) const {}
};
DI void phase_merge2(const Ctx& c, int l) {
    EpiMerge2 E; E.H = (float*)(c.ws + WS_H); E.modv = (const float*)(c.ws + WS_WSM + OFF_MODV); E.l = l;
    pg8::Gemm g{(const bf16_t*)(c.ws + WS_BUFB), (const bf16_t*)(c.ws + WS_WSM + OFF_WOUTT + l * SZ_WOUTT), NZ, 1024, 1024, 1024, 1024};
    __syncthreads();
    if (l == NL - 1) {
        LatOrder S; S.G = (int)gridDim.x; S.c = (int)blockIdx.x;
        pg8::gemm_phase<EpiMerge2, LatOrder, false>((PG8_LAS unsigned char*)c.smem, g, S, E, nullptr, c.tid);
    } else {
        pg8::StaticOrder S; S.init(NZ, 1024, (int)gridDim.x, (int)blockIdx.x);
        pg8::gemm_phase<EpiMerge2, pg8::StaticOrder, false>((PG8_LAS unsigned char*)c.smem, g, S, E, nullptr, c.tid);
    }
}

constexpr int RT_PITCH = 68;
constexpr int RT_RED_W = 8 * 4 * RT_PITCH;
DI void phase_norm2_route(const Ctx& c, int l) {
    unsigned char* ws = c.ws; const int lane = c.lane, wave = c.wave, tid = c.tid;
    const float* modv = (const float*)(ws + WS_WSM + OFF_MODV); const float* H = (const float*)(ws + WS_H);
    bf16_t* XN = (bf16_t*)(ws + WS_BUFA); const float* g2 = c.in[7] + l * 1024;
    const float* rwt = (const float*)(ws + WS_WSM + OFF_RWT) + (size_t)l * 36 * 1024;
    const float* bg = c.in[42] + l * 4; const float* be = c.in[44] + l * 32;
    unsigned* cnt = (unsigned*)(ws + WS_CTL) + CW_CNT + l * 32;
    int* list = (int*)(ws + WS_GT + GT_LIST); float* lw = (float*)(ws + WS_GT + GT_LW);
    float* red = (float*)c.smem + wave * RT_RED_W;
    float* lgs = (float*)c.smem + 8 * RT_RED_W + wave * 8 * 40;
    int* hist = (int*)((float*)c.smem + 8 * RT_RED_W + 8 * 8 * 40);
    int* sel = hist + 64;
    float* selw = (float*)(sel + 128);
    const int ngroups = (l == NL - 1) ? (NB * SEQ / 64) : (NZ / 64);
    for (int grp = blockIdx.x; grp < ngroups; grp += gridDim.x) {
        __syncthreads();
        if (tid < 32) hist[tid] = 0;
        __syncthreads();
        float x[8][16];
#pragma unroll
        for (int i = 0; i < 8; ++i) {
            const int rl = wave * 8 + i; int row;
            if (l == NL - 1) { const int rr = grp * 64 + rl; row = (rr / SEQ) * TZ + CTX + (rr % SEQ); } else row = grp * 64 + rl;
#pragma unroll
            for (int q = 0; q < 4; ++q) { const float4 v = *(const float4*)(H + (size_t)row * D + q * 256 + lane * 4); x[i][q * 4] = v.x; x[i][q * 4 + 1] = v.y; x[i][q * 4 + 2] = v.z; x[i][q * 4 + 3] = v.w; }
        }
#pragma unroll
        for (int i = 0; i < 8; ++i) {
            const int rl = wave * 8 + i; int row;
            if (l == NL - 1) { const int rr = grp * 64 + rl; row = (rr / SEQ) * TZ + CTX + (rr % SEQ); } else row = grp * 64 + rl;
            const int b = row / TZ, s = row % TZ, sel3 = s < CTX ? 2 : b;
            float ss = 0.f;
#pragma unroll
            for (int j = 0; j < 16; ++j) ss += x[i][j] * x[i][j];
            ss = wave_sum(ss);
            const float rs = rsqrtf(ss * (1.f / 1024.f) + 1e-6f);
#pragma unroll
            for (int q = 0; q < 4; ++q) {
                const int col = q * 256 + lane * 4;
                const float4 g = *(const float4*)(g2 + col), m3 = *(const float4*)(modv + ((size_t)l * 3 + sel3) * 6144 + 3 * 1024 + col), m4 = *(const float4*)(modv + ((size_t)l * 3 + sel3) * 6144 + 4 * 1024 + col);
                x[i][q * 4] = x[i][q * 4] * rs * g.x * (1.f + m4.x) + m3.x; x[i][q * 4 + 1] = x[i][q * 4 + 1] * rs * g.y * (1.f + m4.y) + m3.y;
                x[i][q * 4 + 2] = x[i][q * 4 + 2] * rs * g.z * (1.f + m4.z) + m3.z; x[i][q * 4 + 3] = x[i][q * 4 + 3] * rs * g.w * (1.f + m4.w) + m3.w;
                *(u32x2*)(XN + (size_t)row * D + col) = pack4(x[i][q * 4], x[i][q * 4 + 1], x[i][q * 4 + 2], x[i][q * 4 + 3]);
            }
        }
#pragma unroll 1
        for (int ec = 0; ec < 9; ++ec) {
#pragma unroll
            for (int ee = 0; ee < 4; ++ee) {
                const int e = ec * 4 + ee;
                float4 w[4];
#pragma unroll
                for (int q = 0; q < 4; ++q) w[q] = *(const float4*)(rwt + (size_t)e * 1024 + q * 256 + lane * 4);
#pragma unroll
                for (int i = 0; i < 8; ++i) {
                    float a = 0.f;
#pragma unroll
                    for (int q = 0; q < 4; ++q) a += x[i][q * 4] * w[q].x + x[i][q * 4 + 1] * w[q].y + x[i][q * 4 + 2] * w[q].z + x[i][q * 4 + 3] * w[q].w;
                    red[(i * 4 + ee) * RT_PITCH + lane] = a;
                }
            }
            __builtin_amdgcn_wave_barrier();
            if (lane < 32) {
                float s0 = 0.f, s1 = 0.f, s2 = 0.f, s3 = 0.f;
#pragma unroll
                for (int q = 0; q < 16; ++q) { const float4 v = *(const float4*)(red + lane * RT_PITCH + q * 4); s0 += v.x; s1 += v.y; s2 += v.z; s3 += v.w; }
                const int e = ec * 4 + (lane & 3);
                lgs[(lane >> 2) * 40 + e] = (s0 + s1) + (s2 + s3) + (e < 4 ? bg[e] : be[e - 4]);
            }
            __builtin_amdgcn_wave_barrier();
        }
        if (lane < 8) {
            const float* lg = lgs + lane * 40;
            float gm = lg[0]; int gsel = 0;
#pragma unroll
            for (int g = 1; g < 4; ++g) if (lg[g] > gm) { gm = lg[g]; gsel = g; }
            const float gs = __expf(lg[0] - gm) + __expf(lg[1] - gm) + __expf(lg[2] - gm) + __expf(lg[3] - gm);
            const float pg = 1.f / gs;
            float l1 = -1e30f, l2 = -1e30f; int e1 = 0, e2 = 0;
#pragma unroll
            for (int j = 0; j < 8; ++j) {
                const float v = lg[4 + gsel * 8 + j]; const int e = gsel * 8 + j;
                if (v > l1) { l2 = l1; e2 = e1; l1 = v; e1 = e; } else if (v > l2) { l2 = v; e2 = e; }
            }
            const float tt = __expf(l2 - l1), w1 = pg / (1.f + tt), w2 = pg * tt / (1.f + tt);
            const int rl = wave * 8 + lane;
            const int r1 = atomicAdd(&hist[e1], 1), r2 = atomicAdd(&hist[e2], 1);
            sel[rl * 2] = e1 | (r1 << 8); sel[rl * 2 + 1] = e2 | (r2 << 8); selw[rl * 2] = w1; selw[rl * 2 + 1] = w2;
        }
        __syncthreads();
        if (tid < 32) hist[32 + tid] = (int)atomicAdd(&cnt[tid], (unsigned)hist[tid]);
        __syncthreads();
        if (tid < 128) {
            const int rl = tid >> 1, j = tid & 1, sv = sel[tid], e = sv & 255, rk = sv >> 8;
            int row;
            if (l == NL - 1) { const int rr = grp * 64 + rl; row = (rr / SEQ) * TZ + CTX + (rr % SEQ); } else row = grp * 64 + rl;
            const size_t pos = (size_t)e * MOE_CAP + hist[32 + e] + rk;
            list[pos] = row * 2 + j; lw[pos] = selw[tid];
        }
    }
    phase_expert_convert(c, l);
}

DI void moe_prefix(const Ctx& c, int l, int* tiles  , int* cnts  ) {
    __syncthreads();
    if (c.tid == 0) {
        const unsigned* cnt = (const unsigned*)(c.ws + WS_CTL) + CW_CNT + l * 32; int acc = 0;
        for (int e = 0; e < 32; ++e) { const int n = (int)__hip_atomic_load(cnt + e, __ATOMIC_RELAXED, __HIP_MEMORY_SCOPE_AGENT); cnts[e] = n; tiles[e] = acc; acc += (n + 127) / 128; }
        tiles[32] = acc;
    }
    __syncthreads();
}
DI void phase_moe1(const Ctx& c, int l) {
    unsigned char* ws = c.ws;
    int* tiles = (int*)(c.smem + 120 * 1024); int* cnts = tiles + 40;
    moe_prefix(c, l, tiles, cnts);
    const bf16_t* XN = (const bf16_t*)(ws + WS_BUFA); bf16_t* HM = (bf16_t*)(ws + WS_GT + GT_HM); const int* list = (const int*)(ws + WS_GT + GT_LIST);
    const int nt_total = tiles[32];
    for (int u = blockIdx.x; u < nt_total * 4; u += gridDim.x) {
        const int mtg = u >> 2, nt = u & 3;
        int e = 0;
        for (int k = 1; k < 32; ++k) if (tiles[k] <= mtg) e = k;
        const int mt = mtg - tiles[e], n_e = cnts[e];
        const int* le = list + (size_t)e * MOE_CAP;
        const bf16_t* W = (const bf16_t*)(ws + WS_EXPW + (size_t)e * SZ_WGU);
        gemm_tile<2, 0>(c, 1024,
            [&](int i) { int p = mt * 128 + i; if (p >= n_e) p = n_e - 1; return XN + (size_t)(le[p] >> 1) * D; },
            [&](int i) { return W + (size_t)(nt * 256 + i) * D; }, NoHook(),
            [&](f32x4 (&acc)[4][4], int wr, int wc, int fr, int fq) {
#pragma unroll
                for (int np = 0; np < 2; ++np) {
                    const int hc = (nt * 256 + wc + np * 32) / 2 + fq * 4;
#pragma unroll
                    for (int m = 0; m < 4; ++m) {
                        const int p = mt * 128 + wr + m * 16 + fr;
                        const f32x4 g = acc[m][np * 2], uu = acc[m][np * 2 + 1];
                        *(u32x2*)(HM + ((size_t)mtg * 128 + wr + m * 16 + fr) * 512 + hc) = pack4(siluf_(g[0]) * uu[0], siluf_(g[1]) * uu[1], siluf_(g[2]) * uu[2], siluf_(g[3]) * uu[3]);
                        (void)p;
                    }
                }
            });
    }
}
DI void phase_moe2(const Ctx& c, int l) {
    unsigned char* ws = c.ws;
    int* tiles = (int*)(c.smem + 120 * 1024); int* cnts = tiles + 40;
    moe_prefix(c, l, tiles, cnts);
    const bf16_t* HM = (const bf16_t*)(ws + WS_GT + GT_HM); const int* list = (const int*)(ws + WS_GT + GT_LIST); const float* lw = (const float*)(ws + WS_GT + GT_LW);
    bf16_t* Y2 = (bf16_t*)(ws + WS_P);
    const int nt_total = tiles[32];
    for (int u = blockIdx.x; u < nt_total * 4; u += gridDim.x) {
        const int mtg = u >> 2, nt = u & 3;
        int e = 0;
        for (int k = 1; k < 32; ++k) if (tiles[k] <= mtg) e = k;
        const int mt = mtg - tiles[e], n_e = cnts[e];
        const int* le = list + (size_t)e * MOE_CAP; const float* lwe = lw + (size_t)e * MOE_CAP;
        const bf16_t* W = (const bf16_t*)(ws + WS_EXPW + 32 * SZ_WGU + (size_t)e * SZ_WD);
        gemm_tile<2, 0>(c, 512,
            [&](int i) { return HM + ((size_t)mtg * 128 + i) * 512; },
            [&](int i) { return W + (size_t)(nt * 256 + i) * 512; }, NoHook(),
            [&](f32x4 (&acc)[4][4], int wr, int wc, int fr, int fq) {
#pragma unroll
                for (int m = 0; m < 4; ++m) {
                    const int p = mt * 128 + wr + m * 16 + fr;
                    if (p < n_e) {
                        const int ent = le[p]; const float wt = lwe[p];
                        bf16_t* yrow = Y2 + ((size_t)(ent & 1) * NZ + (ent >> 1)) * D + nt * 256 + wc + fq * 4;
#pragma unroll
                        for (int n = 0; n < 4; ++n) *(u32x2*)(yrow + n * 16) = pack4(wt * acc[m][n][0], wt * acc[m][n][1], wt * acc[m][n][2], wt * acc[m][n][3]);
                    }
                }
            });
    }
}

constexpr int LDS_BYTES = 128 * 1024 + 256;
constexpr int STEPS_PER_LAYER = 12, N_STEPS = 2 + NL * STEPS_PER_LAYER;
#ifndef FUSED
#define FUSED 1
#endif

DI const void* launder_ptr(const void* p) {
    const unsigned long long v = (unsigned long long)p;
    unsigned lo = __builtin_amdgcn_readfirstlane((unsigned)v), hi = __builtin_amdgcn_readfirstlane((unsigned)(v >> 32));
    asm volatile("" : "+s"(lo), "+s"(hi) :: "memory");
    return (const void*)(((unsigned long long)hi << 32) | lo);
}
template <int KIND> DI void run_step(const Ctx& c0, int l) {
#ifdef PHM
    if (!((PHM >> KIND) & 1)) return;
#endif
    Ctx c = c0;
    { int z = 0; asm volatile("" : "+s"(z) :: "memory"); c.in = c0.in + z; c.ws = c0.ws + z; c.out = c0.out + z; }
    { int t = c0.tid; asm volatile("" : "+v"(t)); c.tid = t; c.lane = t & 63; c.wave = __builtin_amdgcn_readfirstlane(t >> 6); }
    if (KIND == 0) phase_prologue(c);
    if (KIND == 1) phase_norm1(c, l);
    if (KIND == 2) phase_inproj(c, l);
    if (KIND == 3) { phase_prep(c, l); for (int u = blockIdx.x; u < 2 * S5N * 4; u += gridDim.x) phase_s5_final_unit<true>(c, l, u); }
    if (KIND == 4) { phase_small_gemms(c, l); phase_s5_carry(c, l); }
    if (KIND == 5) { phase_attention(c, l); phase_rwkv_chunks(c, l); }
    if (KIND == 6) phase_mixers2(c, l);
    if (KIND == 7) phase_post(c, l);
    if (KIND == 8) phase_merge1(c, l);
    if (KIND == 9) phase_merge2(c, l);
    if (KIND == 10) phase_norm2_route(c, l);
    if (KIND == 11) phase_moe1(c, l);
    if (KIND == 12) phase_moe2(c, l);
    if (KIND == 13) phase_final(c);
}

#if !FUSED
template <int KIND> __global__ void __launch_bounds__(NTHR, 2) k_step(Args a) {
    extern __shared__ __attribute__((aligned(16))) unsigned char lds[];
    Ctx c; c.in = a.in; c.out = a.out; c.ws = a.ws; c.smem = lds; c.tid = threadIdx.x; c.lane = threadIdx.x & 63; c.wave = __builtin_amdgcn_readfirstlane(threadIdx.x >> 6);
    run_step<KIND>(c, a.s_lo);
}
template <int KIND> static void launch_step(const Args& a, int grid, hipStream_t stream) {
    static bool attr = false;
    if (!attr) { (void)hipFuncSetAttribute((const void*)k_step<KIND>, hipFuncAttributeMaxDynamicSharedMemorySize, LDS_BYTES); attr = true; }
    hipLaunchKernelGGL(k_step<KIND>, dim3(grid), dim3(NTHR), LDS_BYTES, stream, a);
}
#else
__global__ void __launch_bounds__(NTHR, 2) fwd_kernel(Args a) {
    extern __shared__ __attribute__((aligned(16))) unsigned char lds[];
    Ctx c; c.in = a.in; c.out = a.out; c.ws = a.ws; c.smem = lds; c.tid = threadIdx.x; c.lane = threadIdx.x & 63; c.wave = __builtin_amdgcn_readfirstlane(threadIdx.x >> 6);
    volatile LAS unsigned* xbw = (volatile LAS unsigned*)(lds + LDS_BYTES - 16);
    for (int i = threadIdx.x; i < LDS_BYTES / 16; i += NTHR) ((uint4*)lds)[i] = make_uint4(0u, 0u, 0u, 0u);
    __syncthreads();
    if (threadIdx.x == 0) { xbw[0] = 0u; xbw[1] = 0u; }
    __syncthreads();
    XcdBarrier bar = xcd_barrier_post((unsigned*)(a.ws + WS_CTL) + CW_BAR, xbw);
#ifndef REP_MASK
#define REP_MASK 0
#endif
#define GBAR() do { XcdBarrier bb = bar; int zz = 0; asm volatile("" : "+s"(zz) :: "memory"); bb.bar = bar.bar + zz; xcd_barrier(bb); } while (0)
#define STEP(K, L) do { run_step<K>(c, L); GBAR(); if ((REP_MASK >> K) & 1) { run_step<K>(c, L); GBAR(); } } while (0)
    STEP(0, 0);
    for (int l = 0; l < NL; ++l) {
        STEP(1, l); STEP(2, l); STEP(3, l); STEP(4, l); STEP(5, l); STEP(6, l); STEP(7, l); STEP(8, l); STEP(9, l); STEP(10, l); STEP(11, l); STEP(12, l);
    }
#undef STEP
    run_step<13>(c, 0);
}
#endif

extern "C" void kernel_launch(void* const* d_in, const int* in_sizes, int n_in, void* d_out, int out_size, void* d_ws, size_t ws_size, hipStream_t stream) {
    static int grid = 0;
    if (grid == 0) {
        if (n_in != 49 || out_size != NB * SEQ * D || ws_size < WS_END) { fprintf(stderr, "kernel_launch: unexpected problem (n_in %d out %d ws %zu need %zu)\n", n_in, out_size, ws_size, (size_t)WS_END); grid = -1; return; }
        int dev = 0, cus = 0;
        if (hipGetDevice(&dev) != hipSuccess || hipDeviceGetAttribute(&cus, hipDeviceAttributeMultiprocessorCount, dev) != hipSuccess) { grid = -1; return; }
#if FUSED
        int per_cu = 0;
        if (hipFuncSetAttribute((const void*)fwd_kernel, hipFuncAttributeMaxDynamicSharedMemorySize, LDS_BYTES) != hipSuccess) { fprintf(stderr, "kernel_launch: hipFuncSetAttribute failed\n"); grid = -1; return; }
        if (hipOccupancyMaxActiveBlocksPerMultiprocessor(&per_cu, (const void*)fwd_kernel, NTHR, LDS_BYTES) != hipSuccess || per_cu < 1) { fprintf(stderr, "kernel_launch: occupancy query says %d\n", per_cu); }
        (void)hipGetLastError();
#endif
        grid = cus;
    }
    if (grid < 0) return;
    (void)hipMemsetAsync((char*)d_ws + WS_CTL, 0, CTL_BYTES, stream);
    Args a{};
    for (int i = 0; i < 49; ++i) a.in[i] = (const float*)d_in[i];
    a.out = (float*)d_out; a.ws = (unsigned char*)d_ws;
#if !FUSED
    a.s_lo = 0; a.s_hi = 0; launch_step<0>(a, grid, stream);
    for (int l = 0; l < NL; ++l) {
        a.s_lo = l;
        launch_step<1>(a, grid, stream); launch_step<2>(a, grid, stream); launch_step<3>(a, grid, stream); launch_step<4>(a, grid, stream);
        launch_step<5>(a, grid, stream); launch_step<6>(a, grid, stream); launch_step<7>(a, grid, stream); launch_step<8>(a, grid, stream);
        launch_step<9>(a, grid, stream); launch_step<10>(a, grid, stream); launch_step<11>(a, grid, stream); launch_step<12>(a, grid, stream);
    }
    a.s_lo = 0; launch_step<13>(a, grid, stream);
#else
    a.s_lo = 0; a.s_hi = N_STEPS; hipLaunchKernelGGL(fwd_kernel, dim3(grid), dim3(NTHR), LDS_BYTES, stream, a);
#endif
}
```

```cpp
#include <hip/hip_runtime.h>
#include <stdint.h>
#include <stdio.h>

#define DI __device__ __forceinline__
#define LAS __attribute__((address_space(3)))
typedef unsigned short bf16_t;
typedef short bf16x8 __attribute__((ext_vector_type(8)));
typedef short s16x4 __attribute__((ext_vector_type(4)));
typedef float f32x4 __attribute__((ext_vector_type(4)));
typedef float f32x16 __attribute__((ext_vector_type(16)));
typedef float f32x2 __attribute__((ext_vector_type(2)));
typedef __bf16 bf16x2v __attribute__((ext_vector_type(2)));
typedef unsigned u32x4 __attribute__((ext_vector_type(4)));
typedef unsigned u32x2 __attribute__((ext_vector_type(2)));

constexpr int D = 1024, NB = 2, SEQ = 8192, CTX = 256, TZ = 8448, NZ = 16896, NL = 2;
constexpr int NIN = 6560, NINP = 6656;
constexpr int NTHR = 512;
constexpr float LOG2E = 1.4426950408889634f;

#define XB_TMO      128
#define XB_XCNT(j)  (256  + 64 * (j))
#define XB_XSUB(j)  (1280 + 64 * (j))
#define XB_XGEN(j)  (2304 + 64 * (j))
#define XB_TOP      3328
#define XB_TOPGEN   3392
#define XCD_BAR_WORDS 3456
#define XB_SPIN_CAP (1u << 18)

__device__ __forceinline__ unsigned xb_ld(unsigned* p)              { return __hip_atomic_load(p, __ATOMIC_RELAXED, __HIP_MEMORY_SCOPE_AGENT); }
__device__ __forceinline__ unsigned xb_add(unsigned* p, unsigned v) { return __hip_atomic_fetch_add(p, v, __ATOMIC_RELAXED, __HIP_MEMORY_SCOPE_AGENT); }
__device__ __forceinline__ unsigned xb_xcc_id() { return (unsigned)__builtin_amdgcn_s_getreg((3 << 11) | 20) & 0xFu; }
#define XB_SPIN(cond, bar) do { unsigned _sp = 0; while (cond) { __builtin_amdgcn_s_sleep(1); \
    if ((++_sp & 255u) == 0u) { if (xb_ld(&(bar)[XB_TMO])) break; if (_sp > XB_SPIN_CAP) { atomicAdd(&(bar)[XB_TMO], 1u); break; } } } } while (0)

struct XcdBarrier { unsigned* bar; unsigned x; volatile LAS unsigned* st; };

__device__ __forceinline__ XcdBarrier xcd_barrier_post(unsigned* bar, volatile LAS unsigned* st) {
    XcdBarrier b; b.bar = bar; b.x = xb_xcc_id(); b.st = st;
    if (threadIdx.x == 0) (void)xb_add(&bar[XB_XCNT(b.x)], 1u);
    return b;
}
__device__ __forceinline__ void xcd_barrier_complete(unsigned* bar, unsigned x, unsigned& nloc, unsigned& nx) {
    const unsigned G = gridDim.x * gridDim.y * gridDim.z;
    unsigned sum, cnt, mine, sp = 0u;
    for (;;) {
        sum = 0u; cnt = 0u; mine = 0u;
#pragma unroll
        for (unsigned j = 0; j < 16; ++j) { const unsigned c = xb_ld(&bar[XB_XCNT(j)]); sum += c; cnt += (c > 0u) ? 1u : 0u; mine = (j == x) ? c : mine; }
        if (sum == G) break;
        __builtin_amdgcn_s_sleep(1);
        if ((++sp & 255u) == 0u) { if (xb_ld(&bar[XB_TMO])) break; if (sp > XB_SPIN_CAP) { atomicAdd(&bar[XB_TMO], 1u); break; } }
    }
    nloc = mine > 0u ? mine : 1u; nx = cnt > 0u ? cnt : 1u;
}
__device__ __forceinline__ void xcd_barrier(const XcdBarrier& b) {
    asm volatile("s_waitcnt vmcnt(0)" ::: "memory");
    __syncthreads();
    if (threadIdx.x == 0) {
        unsigned* bar = b.bar;
        __builtin_amdgcn_s_waitcnt(0);
        unsigned nloc = b.st[0], nx = b.st[1];
        if (nloc == 0u) { xcd_barrier_complete(bar, b.x, nloc, nx); b.st[0] = nloc; b.st[1] = nx; }
        const unsigned old = xb_add(&bar[XB_XSUB(b.x)], 1u);
        const unsigned gen = old / nloc;
        if (old + 1u == (gen + 1u) * nloc) {
            __builtin_amdgcn_fence(__ATOMIC_RELEASE, "agent");
            asm volatile("s_waitcnt vmcnt(0)" ::: "memory");
            const unsigned og = xb_add(&bar[XB_TOP], 1u);
            const unsigned tg = og / nx;
            if (og + 1u == (tg + 1u) * nx) xb_add(&bar[XB_TOPGEN], 1u);
            else XB_SPIN(xb_ld(&bar[XB_TOPGEN]) == tg, bar);
            __builtin_amdgcn_fence(__ATOMIC_ACQUIRE, "agent");
            xb_add(&bar[XB_XGEN(b.x)], 1u);
            asm volatile("s_waitcnt vmcnt(0)" ::: "memory");
        } else {
            XB_SPIN(xb_ld(&bar[XB_XGEN(b.x)]) == gen, bar);
            __builtin_amdgcn_fence(__ATOMIC_ACQUIRE, "agent");
            asm volatile("s_waitcnt vmcnt(0)" ::: "memory");
        }
    }
    __syncthreads();
}

DI float bf2f(bf16_t v) { return __uint_as_float((unsigned)v << 16); }
DI unsigned pack2(float a, float b) { f32x2 v = {a, b}; bf16x2v r = __builtin_convertvector(v, bf16x2v); return __builtin_bit_cast(unsigned, r); }
DI bf16_t f2bf(float a) { return (bf16_t)(pack2(a, 0.f) & 0xffffu); }
DI float lo2f(unsigned u) { return __uint_as_float(u << 16); }
DI float hi2f(unsigned u) { return __uint_as_float(u & 0xffff0000u); }
DI float wave_sum(float v) {
#pragma unroll
    for (int m = 32; m >= 1; m >>= 1) v += __shfl_xor(v, m, 64);
    return v;
}
DI float sum16(float v) {
#pragma unroll
    for (int m = 8; m >= 1; m >>= 1) v += __shfl_xor(v, m, 64);
    return v;
}
DI float sigmoidf_(float x) { return 1.f / (1.f + __expf(-x)); }
DI float siluf_(float x) { return x / (1.f + __expf(-x)); }
DI float gelu_tanh(float x) { const float u = 0.7978845608028654f * (x + 0.044715f * x * x * x); return 0.5f * x * (1.f + tanhf(u)); }
DI void unpack4(u32x2 u, float (&f)[4]) { f[0] = lo2f(u.x); f[1] = hi2f(u.x); f[2] = lo2f(u.y); f[3] = hi2f(u.y); }
DI u32x2 pack4(float a, float b, float c, float d) { u32x2 r; r.x = pack2(a, b); r.y = pack2(c, d); return r; }

constexpr size_t algn(size_t x) { return (x + 255) & ~(size_t)255; }
constexpr size_t WS_CTL   = 0;
constexpr size_t CTL_BYTES = 64 * 1024;
constexpr size_t WS_H     = WS_CTL + CTL_BYTES;
constexpr size_t WS_WSM   = WS_H + (size_t)NZ * D * 4;
constexpr size_t SZ_WINT = (size_t)NINP * D * 2, SZ_WUQT = 384 * 256 * 2, SZ_WUKVT = 512 * 128 * 2, SZ_W2T = 512 * 64 * 2, SZ_A2T = 512 * 64 * 2,
                 SZ_G2T = 256 * 128 * 2, SZ_GLUT = 256 * 256 * 2, SZ_WBT = (size_t)D * D * 2, SZ_WOUTT = (size_t)D * D * 2;
constexpr size_t OFF_WINT = 0, OFF_WUQT = OFF_WINT + NL * SZ_WINT, OFF_WUKVT = OFF_WUQT + NL * SZ_WUQT, OFF_W2T = OFF_WUKVT + NL * SZ_WUKVT,
                 OFF_A2T = OFF_W2T + NL * SZ_W2T, OFF_G2T = OFF_A2T + NL * SZ_A2T, OFF_GLUT = OFF_G2T + NL * SZ_G2T, OFF_WBT = OFF_GLUT + NL * SZ_GLUT,
                 OFF_WOUTT = OFF_WBT + NL * SZ_WBT, OFF_MODV = OFF_WOUTT + NL * SZ_WOUTT,
                 OFF_ROPE = OFF_MODV + (size_t)NL * 3 * 6144 * 4,
                 OFF_S5T = OFF_ROPE + (size_t)SEQ * 16 * 2 * 4,
                 OFF_RWT = OFF_S5T + (size_t)NL * 2 * 16 * 64 * 36 * 4,
                 OFF_LAM = OFF_RWT + (size_t)NL * 36 * 1024 * 4,
                 OFF_S5E = OFF_LAM + 256,
                 OFF_S5C = OFF_S5E,
                 WSM_BYTES = algn(OFF_S5E + (size_t)2 * 2 * 16 * 132 * 64 * 2 * 4);
constexpr size_t WS_EXPW  = WS_WSM + WSM_BYTES;
constexpr size_t SZ_WGU = (size_t)1024 * 1024 * 2, SZ_WD = (size_t)1024 * 512 * 2;
constexpr size_t EXPW_BYTES = 32 * (SZ_WGU + SZ_WD);
constexpr size_t SZ_QM = (size_t)NB * 4 * TZ * 96 * 2, SZ_VMT = (size_t)NB * 4 * 64 * TZ * 2, SZ_QD = (size_t)NB * 4 * TZ * 64 * 2, SZ_R256 = (size_t)NZ * 256 * 2;
constexpr size_t MX_QM = 0, MX_KM = MX_QM + SZ_QM, MX_VMT = MX_KM + SZ_QM, MX_QD = MX_VMT + SZ_VMT, MX_KD = MX_QD + SZ_QD, MX_VDT = MX_KD + SZ_QD,
                 MX_RB = MX_VDT + SZ_VMT, MX_KB = MX_RB + SZ_R256, MX_VB = MX_KB + SZ_R256, MX_KKB = MX_VB + SZ_R256, MX_END = MX_KKB + SZ_R256;
static_assert(MX_END <= EXPW_BYTES, "mixer operands must fit the expert-weight region");
constexpr size_t WS_BUFA  = WS_EXPW + EXPW_BYTES;
constexpr size_t WS_BUFB  = WS_BUFA + (size_t)NZ * D * 2;
constexpr size_t WS_P     = WS_BUFB + (size_t)NZ * D * 2;
constexpr size_t P_PM = 0, P_PS = P_PM + (size_t)NZ * 416 * 2, P_PR = P_PS + (size_t)NZ * 256 * 2, P_PD = P_PR + (size_t)NZ * 1024 * 2, P_BYTES = P_PD + (size_t)NZ * 768 * 2;
static_assert((size_t)6 * SZ_R256 <= (size_t)NZ * (1024 + 768) * 2, "scan operands must fit PR|PD");
static_assert((size_t)2 * NZ * D * 2 <= P_BYTES, "the MoE outputs (2 x bf16 [NZ][D]) must fit the P region");
constexpr size_t WS_GT    = WS_P + P_BYTES;
constexpr size_t GT_BYTES = (size_t)NZ * 4096 * 2;
constexpr int MOE_CAP = 33792;
constexpr size_t GT_HM = 0, GT_LIST = GT_HM + (size_t)(33792 + 32 * 128) * 512 * 2, GT_LW = GT_LIST + (size_t)32 * MOE_CAP * 4, GT_END = GT_LW + (size_t)32 * MOE_CAP * 4;
static_assert(GT_END <= GT_BYTES, "MoE scratch must fit the gate region");
constexpr size_t WS_MISC  = WS_GT + GT_BYTES;
constexpr size_t MS_CQN = 0, MS_TW = MS_CQN + (size_t)NZ * 384 * 2, MS_AL = MS_TW + (size_t)NZ * 64 * 2, MS_SG = MS_AL + (size_t)NZ * 64 * 2,
                 MS_GG = MS_SG + (size_t)NZ * 128 * 2, MS_ZG = MS_GG + SZ_R256, MS_END = MS_ZG + SZ_R256;
constexpr size_t WS_RW    = WS_MISC + MS_END;
constexpr int RC = 64, RNC = TZ / RC;
constexpr size_t SZ_RWM = (size_t)16 * RNC * 4096 * 2;
constexpr size_t RW_M3 = 0, RW_M2 = SZ_RWM, RW_Z5 = 2 * SZ_RWM, RW_P63 = 3 * SZ_RWM, RW_END = RW_P63 + (size_t)16 * RNC * 64 * 4;
constexpr size_t WS_END   = WS_RW + RW_END;

constexpr int CW_BAR = 0;
constexpr int CW_CNT = 4096;

struct Args { const float* in[49]; float* out; unsigned char* ws; int s_lo, s_hi; };

struct Ctx {
    const float* const* in; float* out; unsigned char* ws; unsigned char* smem; int tid, lane, wave;
};

template <int WM> struct GCfg { static constexpr int WN = 8 / WM, BM = 64 * WM, BN = 64 * WN, ABYTES = BM * 128, BBYTES = BN * 128, STAGE = ABYTES + BBYTES; };

template <int WM, int SEGK, class ARow, class BRow, class Hook, class Epi>
DI void gemm_tile(const Ctx& c, int K, ARow arow, BRow brow, Hook hook, Epi epi) {
    typedef GCfg<WM> G;
    const int tid = c.tid, lane = c.lane, wave = c.wave;
    const int wm = wave / G::WN, wn = wave % G::WN, fr = lane & 15, fq = lane >> 4;
    unsigned char* smem = c.smem;
    constexpr int NA = G::BM / 64, NBq = G::BN / 64;
    const int r0 = tid >> 3, coff = ((tid & 7) ^ (r0 & 7)) * 8;
    auto stage = [&](int kt, int buf) {
        unsigned char* sa = smem + buf * G::STAGE; unsigned char* sb = sa + G::ABYTES;
#pragma unroll
        for (int i = 0; i < NA; ++i) __builtin_amdgcn_global_load_lds((const unsigned*)(arow(r0 + 64 * i) + coff + kt * 64), (unsigned*)(sa + (tid + i * NTHR) * 16), 16, 0, 0);
#pragma unroll
        for (int i = 0; i < NBq; ++i) __builtin_amdgcn_global_load_lds((const unsigned*)(brow(r0 + 64 * i) + coff + kt * 64), (unsigned*)(sb + (tid + i * NTHR) * 16), 16, 0, 0);
    };
    f32x4 acc[4][4];
#pragma unroll
    for (int m = 0; m < 4; ++m)
#pragma unroll
        for (int n = 0; n < 4; ++n) acc[m][n] = (f32x4){0.f, 0.f, 0.f, 0.f};
    const int T = K / 64;
    __syncthreads();
    stage(0, 0);
    for (int t = 0; t < T; ++t) {
        asm volatile("s_waitcnt vmcnt(0)" ::: "memory");
        __syncthreads();
        if (t + 1 < T) stage(t + 1, (t + 1) & 1);
        const unsigned char* sa = smem + (t & 1) * G::STAGE; const unsigned char* sb = sa + G::ABYTES;
#pragma unroll
        for (int ks = 0; ks < 2; ++ks) {
            bf16x8 af[4], bfr[4];
            const int sl = ((ks * 4 + fq) ^ (fr & 7)) * 16;
#pragma unroll
            for (int m = 0; m < 4; ++m) af[m] = *(const bf16x8*)(sa + (wm * 64 + m * 16 + fr) * 128 + sl);
#pragma unroll
            for (int n = 0; n < 4; ++n) bfr[n] = *(const bf16x8*)(sb + (wn * 64 + n * 16 + fr) * 128 + sl);
#pragma unroll
            for (int m = 0; m < 4; ++m)
#pragma unroll
                for (int n = 0; n < 4; ++n) acc[m][n] = __builtin_amdgcn_mfma_f32_16x16x32_bf16(bfr[n], af[m], acc[m][n], 0, 0, 0);
        }
        if (SEGK > 0) { if (((t + 1) * 64) % (SEGK > 0 ? SEGK : 64) == 0) hook(acc, ((t + 1) * 64) / (SEGK > 0 ? SEGK : 64) - 1, wm * 64, wn * 64, fr, fq); }
    }
    epi(acc, wm * 64, wn * 64, fr, fq);
}
struct NoHook { DI void operator()(f32x4 (&)[4][4], int, int, int, int, int) const {} };

namespace pg8 {
#define PG8_LAS __attribute__((address_space(3)))
typedef unsigned short bf16_t;
typedef short bf16x8 __attribute__((ext_vector_type(8)));
typedef float f32x4 __attribute__((ext_vector_type(4)));
constexpr int BM = 256, BK = 64, HALF = 128, HTB = HALF * BK * 2  , STAGE_BYTES = 8 * HTB, NXCD = 8, WGM = 8;

__host__ __device__ __forceinline__ int lds_byte(int r, int c) { const int st = (r >> 4) * 2 + (c >> 5), rr = r & 15, cc = c & 31, ob = rr * 64 + cc * 2; return st * 1024 + (ob ^ (((ob >> 9) & 1) << 5)); }
__host__ __device__ __forceinline__ void stage_rc(int b, int& R, int& C) { const int st = b / 1024, sb = b % 1024, swz = sb ^ (((sb >> 9) & 1) << 5); R = (st >> 1) * 16 + swz / 64; C = (st & 1) * 32 + (swz % 64) / 2; }
__host__ __device__ __forceinline__ int perm32(int rho) { const int n = rho >> 4, i = rho & 15; return 8 * (i >> 2) + 4 * n + (i & 3); }

struct Unit { int pm, pn; };
struct Gemm { const bf16_t* A; const bf16_t* Bt; int M, N, K, lda, ldb; };

struct StaticOrder {
    int nM, nN, nwg, G, c;
    __host__ __device__ void init(int M, int N, int G_, int c_) { nM = M / BM; nN = N / BM; nwg = nM * nN; G = G_; c = c_; }
    __host__ __device__ bool next(int i, Unit& u) const {
        const long L = (long)i * G + c; if (L >= nwg) return false;
        int wgid = (int)L; { const int q = nwg / NXCD, r = nwg % NXCD, xcd = wgid % NXCD, off = wgid / NXCD; wgid = (xcd < r ? xcd * (q + 1) : r * (q + 1) + (xcd - r) * q) + off; }
        const int nig = WGM * nN, gid = wgid / nig, fm = gid * WGM, gsz = (nM - fm) < WGM ? (nM - fm) : WGM;
        u.pm = fm + ((wgid % nig) % gsz); u.pn = (wgid % nig) / gsz; return true;
    }
    __device__ __forceinline__ void a_ready(const Unit&) const {}
    __device__ __forceinline__ void done(const Unit&) const {}
};
template <class Epi, class Sched, bool STAMP = false>
__device__ __forceinline__ void gemm_phase(PG8_LAS unsigned char* lds, const Gemm g, const Sched& S, const Epi& E, unsigned long long* stamps, int tid_in) {
    const int tid = tid_in, wid = __builtin_amdgcn_readfirstlane(tid >> 6), lane = tid & 63, wr = wid >> 2, wc = wid & 3, fr = lane & 15, fq = lane >> 4;
    const int K = g.K, nt = K / BK;
    int ts_lo = 0, ts_hi = 0, nts = 0; const unsigned long long rt_entry = STAMP ? (unsigned long long)wall_clock64() : 0ull;
#define PG8_STAMP() do { if (STAMP && wid == 0 && nts < 64) { const unsigned long long _c = (unsigned long long)clock64(); \
        ts_lo = (lane == nts) ? (int)(unsigned)_c : ts_lo; ts_hi = (lane == nts) ? (int)(unsigned)(_c >> 32) : ts_hi; ++nts; } } while (0)
    PG8_STAMP();
    unsigned voffA[2], voffB[2];
#pragma unroll
    for (int i = 0; i < 2; ++i) { int R, C; stage_rc(tid * 16 + i * 8192, R, C); const int Rb = Epi::PERM ? ((R & ~31) + perm32(R & 31)) : R;
        voffA[i] = (unsigned)(R * g.lda + C) * 2u; voffB[i] = (unsigned)(Rb * g.ldb + C) * 2u; }
    const size_t kstep = (size_t)(BK * 2);
    const size_t hstepA = (size_t)HALF * g.lda * 2, hstepB = (size_t)HALF * g.ldb * 2;
    const size_t tstepA = 2 * hstepA, tstepB = 2 * hstepB;
    const unsigned ldsw = (unsigned)wid * 1024u;
    const int aoff = lds_byte(wr * 64 + fr, fq * 8), boff = lds_byte(wc * 32 + fr, fq * 8);
#define PG8_SA(b, h) (((b) * 2 + (h)) * HTB)
#define PG8_SB(b, h) ((4 + (b) * 2 + (h)) * HTB)
#define PG8_STAGE(bufoff, gbase, voff) do { _Pragma("unroll") for (int _i = 0; _i < 2; ++_i) \
        __builtin_amdgcn_global_load_lds((const unsigned*)((const char*)(gbase) + (voff)[_i]), (PG8_LAS unsigned*)(lds + (bufoff) + ldsw + _i * 8192), 16, 0, 0); } while (0)
#define PG8_LDA(dst, b, h) do { _Pragma("unroll") for (int m = 0; m < 4; ++m) _Pragma("unroll") for (int k = 0; k < 2; ++k) dst[m][k] = *(const PG8_LAS bf16x8*)(lds + PG8_SA(b, h) + aoff + m * 2048 + k * 1024); } while (0)
#define PG8_LDB(dst, b, h) do { _Pragma("unroll") for (int n = 0; n < 2; ++n) _Pragma("unroll") for (int k = 0; k < 2; ++k) dst[n][k] = *(const PG8_LAS bf16x8*)(lds + PG8_SB(b, h) + boff + n * 2048 + k * 1024); } while (0)
#define PG8_MMA(ai, bj, At, Bt) do { __builtin_amdgcn_s_setprio(1); _Pragma("unroll") for (int m = 0; m < 4; ++m) _Pragma("unroll") for (int n = 0; n < 2; ++n) _Pragma("unroll") for (int k = 0; k < 2; ++k) \
        acc[ai][bj][m][n] = __builtin_amdgcn_mfma_f32_16x16x32_bf16(Bt[n][k], At[m][k], acc[ai][bj][m][n], 0, 0, 0); __builtin_amdgcn_s_setprio(0); } while (0)
#define PG8_WAIT_V(n) asm volatile("s_waitcnt vmcnt(" #n ")" ::: "memory")
#define PG8_WAIT_L(n) asm volatile("s_waitcnt lgkmcnt(" #n ")" ::: "memory")
#define PG8_BAR __builtin_amdgcn_s_barrier()
#define PG8_SCHED __builtin_amdgcn_sched_barrier(0)
    Unit cur, nxt; int ui = 0;
    if (!S.next(0, cur)) return;
    f32x4 acc[2][2][4][2];
#pragma unroll
    for (int a = 0; a < 2; ++a)
#pragma unroll
        for (int b = 0; b < 2; ++b)
#pragma unroll
            for (int m = 0; m < 4; ++m)
#pragma unroll
                for (int n = 0; n < 2; ++n) acc[a][b][m][n] = (f32x4){0.f, 0.f, 0.f, 0.f};
    bf16x8 At[4][2], B0[2][2], B1[2][2];
    const char* cA = (const char*)g.A + (size_t)cur.pm * tstepA; const char* cB = (const char*)g.Bt + (size_t)cur.pn * tstepB;
    S.a_ready(cur);
    PG8_STAGE(PG8_SB(0, 0), cB, voffB); PG8_STAGE(PG8_SA(0, 0), cA, voffA); PG8_STAGE(PG8_SB(0, 1), cB + hstepB, voffB); PG8_STAGE(PG8_SA(0, 1), cA + hstepA, voffA);
    if (wr == 1) PG8_BAR;
    PG8_WAIT_V(4); PG8_BAR;
    PG8_STAGE(PG8_SB(1, 0), cB + kstep, voffB); PG8_STAGE(PG8_SA(1, 0), cA + kstep, voffA); PG8_STAGE(PG8_SB(1, 1), cB + hstepB + kstep, voffB);
    PG8_WAIT_V(6); PG8_BAR;
    PG8_STAMP();
    for (;;) {
        const bool has_next = S.next(ui + 1, nxt);
        const char* nA = has_next ? (const char*)g.A + (size_t)nxt.pm * tstepA : cA; const char* nB = has_next ? (const char*)g.Bt + (size_t)nxt.pn * tstepB : cB;
        for (int t = 0; t < nt; t += 2) {
            const bool last = (t == nt - 2);
            const char* a1 = cA + (size_t)(t + 1) * kstep;
            const char* a2 = last ? nA : cA + (size_t)(t + 2) * kstep; const char* b2 = last ? nB : cB + (size_t)(t + 2) * kstep;
            const char* a3 = a2 + kstep; const char* b3 = b2 + kstep;
            if (last && has_next) S.a_ready(nxt);
            PG8_LDB(B0, 0, 0); PG8_SCHED; PG8_LDA(At, 0, 0); PG8_STAGE(PG8_SA(1, 1), a1 + hstepA, voffA);
            PG8_WAIT_L(8); PG8_BAR; PG8_WAIT_L(0); PG8_MMA(0, 0, At, B0); PG8_BAR; PG8_SCHED;
            PG8_LDB(B1, 0, 1); PG8_STAGE(PG8_SB(0, 0), b2, voffB);
            PG8_BAR; PG8_WAIT_L(0); PG8_MMA(0, 1, At, B1); PG8_BAR;
            PG8_LDA(At, 0, 1); PG8_STAGE(PG8_SA(0, 0), a2, voffA);
            PG8_BAR; PG8_WAIT_L(0); PG8_MMA(1, 0, At, B0); PG8_BAR; PG8_SCHED;
            PG8_STAGE(PG8_SB(0, 1), b2 + hstepB, voffB);
            PG8_WAIT_V(6); PG8_BAR; PG8_MMA(1, 1, At, B1); PG8_BAR;
            PG8_LDB(B0, 1, 0); PG8_SCHED; PG8_LDA(At, 1, 0); PG8_STAGE(PG8_SA(0, 1), a2 + hstepA, voffA);
            PG8_WAIT_L(8); PG8_BAR; PG8_WAIT_L(0); PG8_MMA(0, 0, At, B0); PG8_BAR; PG8_SCHED;
            PG8_LDB(B1, 1, 1); PG8_STAGE(PG8_SB(1, 0), b3, voffB);
            PG8_BAR; PG8_WAIT_L(0); PG8_MMA(0, 1, At, B1); PG8_BAR;
            PG8_LDA(At, 1, 1); PG8_STAGE(PG8_SA(1, 0), a3, voffA);
            PG8_BAR; PG8_WAIT_L(0); PG8_MMA(1, 0, At, B0); PG8_BAR; PG8_SCHED;
            PG8_STAGE(PG8_SB(1, 1), b3 + hstepB, voffB);
            PG8_WAIT_V(6); PG8_BAR; PG8_MMA(1, 1, At, B1); PG8_BAR;
        }
        PG8_STAMP();
        if constexpr (!Epi::AFTER_DRAIN) { E(acc, cur, wr, wc, fr, fq); S.done(cur); }
        PG8_STAMP();
        if (!has_next) break;
#pragma unroll
        for (int a = 0; a < 2; ++a)
#pragma unroll
            for (int b = 0; b < 2; ++b)
#pragma unroll
                for (int m = 0; m < 4; ++m)
#pragma unroll
                    for (int n = 0; n < 2; ++n) acc[a][b][m][n] = (f32x4){0.f, 0.f, 0.f, 0.f};
        cur = nxt; cA = nA; cB = nB; ++ui;
    }
    PG8_WAIT_V(0);
    if (wr == 0) PG8_BAR;
    PG8_BAR;
    if constexpr (Epi::AFTER_DRAIN) { E.fused(acc, cur, wr, wc, fr, fq, lds, wid, lane); S.done(cur); }
    PG8_STAMP();
    if (STAMP && wid == 0) { stamps[lane] = lane < nts ? (((unsigned long long)(unsigned)ts_hi << 32) | (unsigned)ts_lo) : 0ull;
        if (lane == 62) stamps[62] = rt_entry; if (lane == 63) stamps[63] = (unsigned long long)wall_clock64(); }
#undef PG8_STAMP
#undef PG8_SA
#undef PG8_SB
#undef PG8_STAGE
#undef PG8_LDA
#undef PG8_LDB
#undef PG8_MMA
#undef PG8_WAIT_V
#undef PG8_WAIT_L
#undef PG8_BAR
#undef PG8_SCHED
}
}

DI int rowmap(int n, int mode) { return mode == 0 ? n : ((n >> 4) * 32 + (n & 15) + (mode == 2 ? 16 : 0)); }
DI void tconv_tile(const Ctx& c, const float* src, int ld, int N, bf16_t* dst, int ld_dst, int mode, int tk, int tn) {
    bf16_t* T = (bf16_t*)c.smem;
    const int k0 = tk * 64, n0 = tn * 64, tid = c.tid;
    __syncthreads();
#pragma unroll
    for (int i = 0; i < 2; ++i) {
        const int kk = (tid >> 4) + i * 32, n4 = (tid & 15) * 4;
        float4 v = make_float4(0.f, 0.f, 0.f, 0.f);
        if (n0 + n4 < N) v = *(const float4*)(src + (size_t)(k0 + kk) * ld + n0 + n4);
        T[(n4 + 0) * 72 + kk] = f2bf(v.x); T[(n4 + 1) * 72 + kk] = f2bf(v.y); T[(n4 + 2) * 72 + kk] = f2bf(v.z); T[(n4 + 3) * 72 + kk] = f2bf(v.w);
    }
    __syncthreads();
    const int n = tid >> 3, k8 = (tid & 7) * 8;
    if (n0 + n < N) *(u32x4*)(dst + (size_t)rowmap(n0 + n, mode) * ld_dst + k0 + k8) = *(const u32x4*)(T + n * 72 + k8);
}
DI void tconv(const Ctx& c, const float* src, int ld, int K, int N, bf16_t* dst, int ld_dst, int mode, int rot) {
    const int ntk = K / 64, ntn = (N + 63) / 64, nt = ntk * ntn, G = gridDim.x;
    for (int t = (blockIdx.x + G - (rot % G)) % G; t < nt; t += G) tconv_tile(c, src, ld, N, dst, ld_dst, mode, t / ntn, t % ntn);
}

DI void wconv(const Ctx& c, const float* src, int ld, int K, int N, bf16_t* dst, int ld_dst, int rot) {
    const int ntk = K / 64, ntn = (N + 63) / 64, nt = ntk * ntn, GW = gridDim.x * 8, w0 = blockIdx.x * 8 + c.wave;
    for (int t = (w0 + GW - (rot % GW)) % GW; t < nt; t += GW) {
        const int tk = t / ntn, tn = t % ntn, n = tn * 64 + c.lane;
        if (n < N) {
            const float* sp = src + (size_t)(tk * 64) * ld + n; bf16_t* dp = dst + (size_t)n * ld_dst + tk * 64;
#pragma unroll
            for (int kb = 0; kb < 8; ++kb) {
                float v[8];
#pragma unroll
                for (int j = 0; j < 8; ++j) v[j] = sp[(size_t)(kb * 8 + j) * ld];
                u32x4 w4; w4.x = pack2(v[0], v[1]); w4.y = pack2(v[2], v[3]); w4.z = pack2(v[4], v[5]); w4.w = pack2(v[6], v[7]);
                *(u32x4*)(dp + kb * 8) = w4;
            }
        }
    }
}
DI void phase_prologue(const Ctx& c) {
    unsigned char* wsm = c.ws + WS_WSM;
    const int tid = c.tid, G = gridDim.x, gtid = blockIdx.x * NTHR + tid, gn = G * NTHR;
    {
        const float4* x = (const float4*)c.in[0]; const float4* cx = (const float4*)c.in[2]; float4* H = (float4*)(c.ws + WS_H);
        for (size_t i = gtid; i < (size_t)NZ * 256; i += gn) {
            const int z = (int)(i >> 8), q = (int)(i & 255), b = z / TZ, s = z % TZ;
            H[i] = (s < CTX) ? cx[((size_t)b * CTX + s) * 256 + q] : x[((size_t)b * SEQ + (s - CTX)) * 256 + q];
        }
    }
    {
        float* rope = (float*)(wsm + OFF_ROPE);
        for (int i = gtid; i < SEQ * 16; i += gn) {
            const int t = i >> 4, a = (i >> 3) & 1, f = i & 7;
            const float pos = (float)(a == 0 ? (t >> 6) : (t & 63));
            const float inv = powf(10000.f, -(float)f / 8.f);
            float sn, cs; sincosf(pos * inv, &sn, &cs);
            rope[i * 2] = cs; rope[i * 2 + 1] = sn;
        }
    }
    {
        float* s5t = (float*)(wsm + OFF_S5T);
        for (int i = gtid; i < NL * 2 * 16 * 64; i += gn) {
            const int ldg = i >> 6;
            const double lr = c.in[24][i], li = c.in[25][i], dt = exp((double)c.in[26][ldg]);
            const double mag = exp(lr * dt), are = mag * cos(li * dt), aim = mag * sin(li * dt);
            const double m256 = exp(lr * dt * 64.0), a256r = m256 * cos(li * dt * 64.0), a256i = m256 * sin(li * dt * 64.0);
            const double den = lr * lr + li * li, nr = are - 1.0, ni = aim;
            const double cfr = (nr * lr + ni * li) / den, cfi = (ni * lr - nr * li) / den;
            float* o = s5t + (size_t)i * 36;
            o[0] = (float)are; o[1] = (float)aim; o[2] = (float)a256r; o[3] = (float)a256i;
            for (int ch = 0; ch < 16; ++ch) {
                const double br = c.in[27][(size_t)i * 16 + ch], bi = c.in[28][(size_t)i * 16 + ch];
                o[4 + ch] = (float)(cfr * br - cfi * bi); o[20 + ch] = (float)(cfr * bi + cfi * br);
            }
        }
    }
    {
        float* rwt = (float*)(wsm + OFF_RWT);
        for (int i = gtid; i < NL * 36 * 1024; i += gn) {
            const int l = i / (36 * 1024), e = (i / 1024) % 36, d = i & 1023;
            rwt[i] = e < 4 ? c.in[41][((size_t)l * 1024 + d) * 4 + e] : c.in[43][((size_t)l * 1024 + d) * 32 + (e - 4)];
        }
    }
    if (blockIdx.x == 0 && tid < NL) {
        float s1 = 0.f, s2 = 0.f;
        for (int i = 0; i < 32; ++i) { s1 += c.in[34][tid * 32 + i] * c.in[35][tid * 32 + i]; s2 += c.in[36][tid * 32 + i] * c.in[37][tid * 32 + i]; }
        ((float*)(wsm + OFF_LAM))[tid] = expf(s1) - expf(s2) + (0.8f - 0.6f * expf(-0.3f * (float)tid));
    }
    {
        float* sv = (float*)c.smem;
        float* red = sv + 3 * 1024;
        __syncthreads();
        for (int i = tid; i < 3 * 1024; i += NTHR) { const float v = i < 2048 ? c.in[1][i] : c.in[3][i - 2048]; sv[i] = siluf_(v); }
        __syncthreads();
        float* modv = (float*)(wsm + OFF_MODV);
        for (int u = blockIdx.x; u < NL * 96; u += G) {
            const int l = u / 96, col = (u % 96) * 64 + (tid & 63), ks = tid >> 6;
            const float* w = c.in[4] + (size_t)l * 1024 * 6144 + col;
            float a0 = 0.f, a1 = 0.f, a2 = 0.f;
            for (int k = ks * 128; k < ks * 128 + 128; ++k) { const float wv = w[(size_t)k * 6144]; a0 += sv[k] * wv; a1 += sv[1024 + k] * wv; a2 += sv[2048 + k] * wv; }
            red[(ks * 64 + (tid & 63)) * 3 + 0] = a0; red[(ks * 64 + (tid & 63)) * 3 + 1] = a1; red[(ks * 64 + (tid & 63)) * 3 + 2] = a2;
            __syncthreads();
            if (tid < 192) {
                const int cc = tid & 63, sel = tid >> 6; float s = 0.f;
                for (int k2 = 0; k2 < 8; ++k2) s += red[(k2 * 64 + cc) * 3 + sel];
                const int colo = (u % 96) * 64 + cc;
                modv[((size_t)l * 3 + sel) * 6144 + colo] = s + c.in[5][l * 6144 + colo];
            }
            __syncthreads();
        }
    }
    for (int l = 0; l < NL; ++l) {
        wconv(c, c.in[8] + (size_t)l * 1024 * NIN, NIN, 1024, NIN, (bf16_t*)(wsm + OFF_WINT + l * SZ_WINT), 1024, l * 700);
        tconv(c, c.in[11] + (size_t)l * 256 * 384, 384, 256, 384, (bf16_t*)(wsm + OFF_WUQT + l * SZ_WUQT), 256, 0, 40);
        tconv(c, c.in[12] + (size_t)l * 128 * 512, 512, 128, 512, (bf16_t*)(wsm + OFF_WUKVT + l * SZ_WUKVT), 128, 0, 70);
        for (int d = 0; d < 2; ++d) {
            tconv(c, c.in[15] + (size_t)(l * 2 + d) * 64 * 256, 256, 64, 256, (bf16_t*)(wsm + OFF_W2T + l * SZ_W2T) + d * 256 * 64, 64, 0, 90 + d * 8);
            tconv(c, c.in[17] + (size_t)(l * 2 + d) * 64 * 256, 256, 64, 256, (bf16_t*)(wsm + OFF_A2T + l * SZ_A2T) + d * 256 * 64, 64, 0, 110 + d * 8);
        }
        tconv(c, c.in[18] + (size_t)l * 128 * 256, 256, 128, 256, (bf16_t*)(wsm + OFF_G2T + l * SZ_G2T), 128, 0, 130);
        tconv(c, c.in[32] + (size_t)l * 256 * 256, 256, 256, 256, (bf16_t*)(wsm + OFF_GLUT + l * SZ_GLUT), 256, 0, 140);
        for (int n = 0; n < 4; ++n)
            wconv(c, c.in[39] + (size_t)(l * 4 + n) * 256 * 1024, 1024, 256, 1024, (bf16_t*)(wsm + OFF_WBT + l * SZ_WBT) + n * 256, 1024, 300 + n * 64 + l * 1000);
        wconv(c, c.in[40] + (size_t)l * 1024 * 1024, 1024, 1024, 1024, (bf16_t*)(wsm + OFF_WOUTT + l * SZ_WOUTT), 1024, 1200 + l * 400);
    }
}

DI void phase_expert_convert(const Ctx& c, int l) {
    const int G = gridDim.x, lane = c.lane;
    for (int t = blockIdx.x * 8 + c.wave; t < 32 * 384; t += G * 8) {
        const int e = t / 384, r = t % 384;
        const float* src; bf16_t* dst; int ld, ldd, mode, tk, tn;
        if (r < 128)      { src = c.in[45] + ((size_t)l * 32 + e) * 1024 * 512; dst = (bf16_t*)(c.ws + WS_EXPW + (size_t)e * SZ_WGU); ld = 512; ldd = 1024; mode = 1; tk = r / 8; tn = r % 8; }
        else if (r < 256) { src = c.in[46] + ((size_t)l * 32 + e) * 1024 * 512; dst = (bf16_t*)(c.ws + WS_EXPW + (size_t)e * SZ_WGU); ld = 512; ldd = 1024; mode = 2; tk = (r - 128) / 8; tn = (r - 128) % 8; }
        else              { src = c.in[47] + ((size_t)l * 32 + e) * 512 * 1024; dst = (bf16_t*)(c.ws + WS_EXPW + 32 * SZ_WGU + (size_t)e * SZ_WD); ld = 1024; ldd = 512; mode = 0; tk = (r - 256) / 16; tn = (r - 256) % 16; }
        const int n = tn * 64 + lane; const float* sp = src + (size_t)(tk * 64) * ld + n; bf16_t* dp = dst + (size_t)rowmap(n, mode) * ldd + tk * 64;
        float v[64];
#pragma unroll
        for (int k = 0; k < 64; ++k) v[k] = __builtin_nontemporal_load(sp + (size_t)k * ld);
#pragma unroll
        for (int kb = 0; kb < 8; ++kb) {
            u32x4 w4; w4.x = pack2(v[kb * 8], v[kb * 8 + 1]); w4.y = pack2(v[kb * 8 + 2], v[kb * 8 + 3]); w4.z = pack2(v[kb * 8 + 4], v[kb * 8 + 5]); w4.w = pack2(v[kb * 8 + 6], v[kb * 8 + 7]);
            *(u32x4*)(dp + kb * 8) = w4;
        }
    }
}

DI void phase_norm1(const Ctx& c, int l) {
    const float* modv = (const float*)(c.ws + WS_WSM + OFF_MODV);
    float* H = (float*)(c.ws + WS_H); const bf16_t* Y = (const bf16_t*)(c.ws + WS_P);
    bf16_t* XN = (bf16_t*)(c.ws + WS_BUFA);
    const float* g1 = c.in[6] + l * 1024;
    for (int row = blockIdx.x * 8 + c.wave; row < NZ; row += gridDim.x * 8) {
        const int b = row / TZ, s = row % TZ, sel = s < CTX ? 2 : b;
        float4 v[4]; float ss = 0.f;
#pragma unroll
        for (int q = 0; q < 4; ++q) {
            const int col = q * 256 + c.lane * 4;
            v[q] = *(const float4*)(H + (size_t)row * D + col);
            if (l > 0) {
                float ya[4], yb[4]; unpack4(*(const u32x2*)(Y + (size_t)row * D + col), ya); unpack4(*(const u32x2*)(Y + ((size_t)NZ + row) * D + col), yb);
                const float4 m5 = *(const float4*)(modv + ((size_t)(l - 1) * 3 + sel) * 6144 + 5 * 1024 + col);
                v[q].x += m5.x * (ya[0] + yb[0]); v[q].y += m5.y * (ya[1] + yb[1]); v[q].z += m5.z * (ya[2] + yb[2]); v[q].w += m5.w * (ya[3] + yb[3]);
                *(float4*)(H + (size_t)row * D + col) = v[q];
            }
            ss += v[q].x * v[q].x + v[q].y * v[q].y + v[q].z * v[q].z + v[q].w * v[q].w;
        }
        ss = wave_sum(ss);
        const float rs = rsqrtf(ss * (1.f / 1024.f) + 1e-6f);
#pragma unroll
        for (int q = 0; q < 4; ++q) {
            const int col = q * 256 + c.lane * 4;
            const float4 g = *(const float4*)(g1 + col), m0 = *(const float4*)(modv + ((size_t)l * 3 + sel) * 6144 + col), m1 = *(const float4*)(modv + ((size_t)l * 3 + sel) * 6144 + 1024 + col);
            *(u32x2*)(XN + (size_t)row * D + col) = pack4(v[q].x * rs * g.x * (1.f + m1.x) + m0.x, v[q].y * rs * g.y * (1.f + m1.y) + m0.y,
                                                          v[q].z * rs * g.z * (1.f + m1.z) + m0.z, v[q].w * rs * g.w * (1.f + m1.w) + m0.w);
        }
    }
}

DI void phase_final(const Ctx& c) {
    const float* modv = (const float*)(c.ws + WS_WSM + OFF_MODV);
    const float* H = (const float*)(c.ws + WS_H); const bf16_t* Y = (const bf16_t*)(c.ws + WS_P);
    const float* g = c.in[48];
    for (int r = blockIdx.x * 8 + c.wave; r < NB * SEQ; r += gridDim.x * 8) {
        const int b = r / SEQ, t = r % SEQ, row = b * TZ + CTX + t;
        float4 v[4]; float ss = 0.f;
#pragma unroll
        for (int q = 0; q < 4; ++q) {
            const int col = q * 256 + c.lane * 4;
            v[q] = *(const float4*)(H + (size_t)row * D + col);
            float ya[4], yb[4]; unpack4(*(const u32x2*)(Y + (size_t)row * D + col), ya); unpack4(*(const u32x2*)(Y + ((size_t)NZ + row) * D + col), yb);
            const float4 m5 = *(const float4*)(modv + ((size_t)(NL - 1) * 3 + b) * 6144 + 5 * 1024 + col);
            v[q].x += m5.x * (ya[0] + yb[0]); v[q].y += m5.y * (ya[1] + yb[1]); v[q].z += m5.z * (ya[2] + yb[2]); v[q].w += m5.w * (ya[3] + yb[3]);
            ss += v[q].x * v[q].x + v[q].y * v[q].y + v[q].z * v[q].z + v[q].w * v[q].w;
        }
        ss = wave_sum(ss);
        const float rs = rsqrtf(ss * (1.f / 1024.f) + 1e-6f);
#pragma unroll
        for (int q = 0; q < 4; ++q) {
            const int col = q * 256 + c.lane * 4; const float4 gg = *(const float4*)(g + col);
            *(float4*)(c.out + (size_t)r * D + col) = make_float4(v[q].x * rs * gg.x, v[q].y * rs * gg.y, v[q].z * rs * gg.z, v[q].w * rs * gg.w);
        }
    }
}

struct EpiInproj {
    static constexpr bool PERM = true, AFTER_DRAIN = false;
    bf16_t *PM, *PS, *PR, *PD, *GT;
    DI void operator()(const pg8::f32x4 (&acc)[2][2][4][2], const pg8::Unit& u, int wr, int wc, int fr, int fq) const {
        const int row0 = u.pm * 256 + wr * 64 + fr, col0 = u.pn * 256 + wc * 32 + 8 * fq;
#pragma unroll
        for (int bj = 0; bj < 2; ++bj) {
            const int col = col0 + bj * 128;
            bf16_t* dst; int ld, cc; bool gate = false;
            if (col < 416) { dst = PM; ld = 416; cc = col; }
            else if (col < 1440) { dst = PR; ld = 1024; cc = col - 416; }
            else if (col < 1696) { dst = PS; ld = 256; cc = col - 1440; }
            else if (col < 2464) { dst = PD; ld = 768; cc = col - 1696; }
            else if (col < NIN) { dst = GT; ld = 4096; cc = col - 2464; gate = true; }
            else continue;
#pragma unroll
            for (int ai = 0; ai < 2; ++ai)
#pragma unroll
                for (int m = 0; m < 4; ++m) {
                    const int row = row0 + ai * 128 + m * 16; pg8::f32x4 v0 = acc[ai][bj][m][0], v1 = acc[ai][bj][m][1];
                    if (gate) { v0[0] = sigmoidf_(v0[0]); v0[1] = sigmoidf_(v0[1]); v0[2] = sigmoidf_(v0[2]); v0[3] = sigmoidf_(v0[3]);
                                v1[0] = sigmoidf_(v1[0]); v1[1] = sigmoidf_(v1[1]); v1[2] = sigmoidf_(v1[2]); v1[3] = sigmoidf_(v1[3]); }
                    u32x4 w; w.x = pack2(v0[0], v0[1]); w.y = pack2(v0[2], v0[3]); w.z = pack2(v1[0], v1[1]); w.w = pack2(v1[2], v1[3]);
                    *(u32x4*)(dst + (size_t)row * ld + cc) = w;
                }
        }
    }
};
DI void phase_inproj(const Ctx& c, int l) {
    EpiInproj E; E.PM = (bf16_t*)(c.ws + WS_P + P_PM); E.PS = (bf16_t*)(c.ws + WS_P + P_PS); E.PR = (bf16_t*)(c.ws + WS_P + P_PR); E.PD = (bf16_t*)(c.ws + WS_P + P_PD); E.GT = (bf16_t*)(c.ws + WS_GT);
    pg8::Gemm g{(const bf16_t*)(c.ws + WS_BUFA), (const bf16_t*)(c.ws + WS_WSM + OFF_WINT + l * SZ_WINT), NZ, NINP, 1024, 1024, 1024};
    pg8::StaticOrder S; S.init(NZ, NINP, (int)gridDim.x, (int)blockIdx.x);
    __syncthreads();
    pg8::gemm_phase<EpiInproj, pg8::StaticOrder, false>((PG8_LAS unsigned char*)c.smem, g, S, E, nullptr, c.tid);
}

DI void phase_prep(const Ctx& c, int l) {
    unsigned char* ws = c.ws; const int lane = c.lane, wave = c.wave, tid = c.tid;
    const bf16_t* PM = (const bf16_t*)(ws + WS_P + P_PM); const bf16_t* PR = (const bf16_t*)(ws + WS_P + P_PR); const bf16_t* PD = (const bf16_t*)(ws + WS_P + P_PD);
    bf16_t* CQN = (bf16_t*)(ws + WS_MISC + MS_CQN); bf16_t* TW = (bf16_t*)(ws + WS_MISC + MS_TW); bf16_t* AL = (bf16_t*)(ws + WS_MISC + MS_AL); bf16_t* SG = (bf16_t*)(ws + WS_MISC + MS_SG);
    bf16_t* KM = (bf16_t*)(ws + WS_EXPW + MX_KM); bf16_t* QD = (bf16_t*)(ws + WS_EXPW + MX_QD); bf16_t* KD_ = (bf16_t*)(ws + WS_EXPW + MX_KD); bf16_t* VDT = (bf16_t*)(ws + WS_EXPW + MX_VDT);
    bf16_t* RB = (bf16_t*)(ws + WS_EXPW + MX_RB); bf16_t* KB = (bf16_t*)(ws + WS_EXPW + MX_KB); bf16_t* VB = (bf16_t*)(ws + WS_EXPW + MX_VB); bf16_t* KKB = (bf16_t*)(ws + WS_EXPW + MX_KKB);
    const float* rope = (const float*)(ws + WS_WSM + OFF_ROPE);
    const float* gq = c.in[9] + l * 256; const float* gkv = c.in[10] + l * 128; const float* mu = c.in[13] + l * 1024; const float* k_k = c.in[19] + l * 256;
    bf16_t* Vs = (bf16_t*)c.smem;
    const float qsc = 0.17677669529663687f * LOG2E;
    for (int tile = blockIdx.x; tile < NZ / 16; tile += gridDim.x) {
        __syncthreads();
#pragma unroll 2
        for (int i = 0; i < 2; ++i) {
            const int rt = wave * 2 + i, z = tile * 16 + rt, b = z / TZ, s = z % TZ; const bool lat = s >= CTX; const int tl = lat ? s - CTX : 0;
            {
                const bf16_t* pm = PM + (size_t)z * 416;
                float x[4]; unpack4(*(const u32x2*)(pm + lane * 4), x);
                float ss = wave_sum(x[0] * x[0] + x[1] * x[1] + x[2] * x[2] + x[3] * x[3]);
                float rs = rsqrtf(ss * (1.f / 256.f) + 1e-6f);
                const float4 g = *(const float4*)(gq + lane * 4);
                *(u32x2*)(CQN + (size_t)z * 384 + lane * 4) = pack4(x[0] * rs * g.x, x[1] * rs * g.y, x[2] * rs * g.z, x[3] * rs * g.w);
                const unsigned u2 = *(const unsigned*)(pm + 256 + lane * 2); const float y0 = lo2f(u2), y1 = hi2f(u2);
                ss = wave_sum(y0 * y0 + y1 * y1); rs = rsqrtf(ss * (1.f / 128.f) + 1e-6f);
                const float2 g2 = *(const float2*)(gkv + lane * 2);
                *(unsigned*)(CQN + (size_t)z * 384 + 256 + lane * 2) = pack2(y0 * rs * g2.x, y1 * rs * g2.y);
                float kr = bf2f(pm[384 + (lane & 31)]);
                const float pr = __shfl_xor(kr, 8, 64);
                if (lat) { const float* cs = rope + ((size_t)tl * 16 + ((lane & 31) >> 4) * 8 + (lane & 7)) * 2; kr = kr * cs[0] + ((lane & 8) ? pr : -pr) * cs[1]; }
                if (lane < 32) {
                    const bf16_t kv = f2bf(kr);
#pragma unroll
                    for (int h = 0; h < 4; ++h) KM[((size_t)(b * 4 + h) * TZ + s) * 96 + 64 + lane] = kv;
                }
            }
            {
                const bf16_t* pd = PD + (size_t)z * 768;
                const int i0 = lane * 4, hh = i0 >> 6, ii = i0 & 31, nn = (i0 >> 5) & 1;
                const float* cs = rope + ((size_t)tl * 16 + (ii >> 4) * 8 + (ii & 7)) * 2;
                const bool hi = (ii & 8) != 0;
#pragma unroll
                for (int w = 0; w < 2; ++w) {
                    float x[4]; unpack4(*(const u32x2*)(pd + w * 256 + i0), x);
                    float o[4];
#pragma unroll
                    for (int j = 0; j < 4; ++j) {
                        const float p = __shfl_xor(x[j], 2, 64);
                        o[j] = lat ? (x[j] * cs[2 * j] + (hi ? p : -p) * cs[2 * j + 1]) : x[j];
                        if (w == 0) o[j] *= qsc;
                    }
                    bf16_t* dst = (w == 0 ? QD : KD_) + ((size_t)(b * 4 + hh) * TZ + s) * 64 + nn * 32 + ii;
                    *(u32x2*)dst = pack4(o[0], o[1], o[2], o[3]);
                }
                *(u32x2*)(Vs + rt * 264 + i0) = *(const u32x2*)(pd + 512 + i0);
            }
            {
                const bf16_t* pr = PR + (size_t)z * 1024;
                const bool hp = (s != 0) && (s != CTX), hn = (s != CTX - 1) && (s != TZ - 1);
#pragma unroll
                for (int q = 0; q < 4; ++q) {
                    const int col = q * 256 + lane * 4;
                    float cu[4], pv[4] = {0.f, 0.f, 0.f, 0.f}, nx[4] = {0.f, 0.f, 0.f, 0.f};
                    unpack4(*(const u32x2*)(pr + col), cu);
                    if (hp) unpack4(*(const u32x2*)(pr - 1024 + col), pv);
                    if (hn) unpack4(*(const u32x2*)(pr + 1024 + col), nx);
                    const float4 m = *(const float4*)(mu + col);
                    float zv[4];
                    zv[0] = cu[0] + (0.5f * (pv[0] + nx[0]) - cu[0]) * m.x; zv[1] = cu[1] + (0.5f * (pv[1] + nx[1]) - cu[1]) * m.y;
                    zv[2] = cu[2] + (0.5f * (pv[2] + nx[2]) - cu[2]) * m.z; zv[3] = cu[3] + (0.5f * (pv[3] + nx[3]) - cu[3]) * m.w;
                    if (q == 0) *(u32x2*)(RB + (size_t)z * 256 + lane * 4) = pack4(zv[0], zv[1], zv[2], zv[3]);
                    else if (q == 1) {
                        *(u32x2*)(KB + (size_t)z * 256 + lane * 4) = pack4(zv[0], zv[1], zv[2], zv[3]);
                        const float4 kk4 = *(const float4*)(k_k + lane * 4);
                        const float a0 = zv[0] * kk4.x, a1 = zv[1] * kk4.y, a2 = zv[2] * kk4.z, a3 = zv[3] * kk4.w;
                        const float ssq = sum16(a0 * a0 + a1 * a1 + a2 * a2 + a3 * a3);
                        const float inv = 1.f / fmaxf(sqrtf(ssq), 1e-12f);
                        *(u32x2*)(KKB + (size_t)z * 256 + lane * 4) = pack4(a0 * inv, a1 * inv, a2 * inv, a3 * inv);
                    } else if (q == 2) *(u32x2*)(VB + (size_t)z * 256 + lane * 4) = pack4(zv[0], zv[1], zv[2], zv[3]);
                    else {
                        if (lane < 16) *(u32x2*)(TW + (size_t)z * 64 + lane * 4) = pack4(tanhf(zv[0]), tanhf(zv[1]), tanhf(zv[2]), tanhf(zv[3]));
                        else if (lane < 32) *(u32x2*)(AL + (size_t)z * 64 + (lane - 16) * 4) = pack4(zv[0], zv[1], zv[2], zv[3]);
                        else *(u32x2*)(SG + (size_t)z * 128 + (lane - 32) * 4) = pack4(sigmoidf_(zv[0]), sigmoidf_(zv[1]), sigmoidf_(zv[2]), sigmoidf_(zv[3]));
                    }
                }
            }
        }
        __syncthreads();
        {
            const int z0 = tile * 16, b = z0 / TZ, s0 = z0 % TZ;
#pragma unroll
            for (int i = 0; i < 1; ++i) {
                const int ch = tid, dv = ch >> 1, r8 = (ch & 1) * 8;
                bf16_t v[8];
#pragma unroll
                for (int j = 0; j < 8; ++j) v[j] = Vs[(r8 + j) * 264 + dv];
                u32x4 o; o.x = v[0] | ((unsigned)v[1] << 16); o.y = v[2] | ((unsigned)v[3] << 16); o.z = v[4] | ((unsigned)v[5] << 16); o.w = v[6] | ((unsigned)v[7] << 16);
                *(u32x4*)(VDT + ((size_t)(b * 4 + (dv >> 6)) * 64 + (dv & 63)) * TZ + s0 + r8) = o;
            }
        }
    }
}

constexpr int S5C = 64, S5N = TZ / S5C, S5NC = CTX / S5C;
DI int s5_tok(int dir, int i) { return dir == 0 ? i : (i < CTX ? CTX - 1 - i : TZ - 1 - (i - CTX)); }
DI void s5_stage_u(const Ctx& c, float* U, int b, int dir, int chunk, int g0, int ng) {
    const bf16_t* PS = (const bf16_t*)(c.ws + WS_P + P_PS);
    const int per = ng * 4;
    for (int e = c.tid; e < S5C * per; e += NTHR) {
        const int i = e / per, c4 = (e % per) * 4, s = s5_tok(dir, chunk * S5C + i);
        float x[4]; unpack4(*(const u32x2*)(PS + (size_t)(b * TZ + s) * 256 + g0 * 16 + c4), x);
        *(float4*)(U + i * (ng * 16) + c4) = make_float4(x[0], x[1], x[2], x[3]);
    }
}
DI void phase_s5_local(const Ctx& c, int l) {
    float* U = (float*)c.smem;
    const float* s5t = (const float*)(c.ws + WS_WSM + OFF_S5T);
    float* E = (float*)(c.ws + WS_WSM + OFF_S5E);
    for (int u = blockIdx.x; u < 2 * 2 * S5N * 2; u += gridDim.x) {
        const int gq = u & 1, chunk = (u >> 1) % S5N, dir = (u / (2 * S5N)) & 1, b = u / (4 * S5N);
        __syncthreads();
        s5_stage_u(c, U, b, dir, chunk, gq * 8, 8);
        __syncthreads();
        const int g = gq * 8 + c.wave, p = c.lane;
        const float* tb = s5t + ((size_t)((l * 2 + dir) * 16 + g) * 64 + p) * 36;
        const float are = tb[0], aim = tb[1];
        float br[16], bi[16];
#pragma unroll
        for (int ch = 0; ch < 16; ++ch) { br[ch] = tb[4 + ch]; bi[ch] = tb[20 + ch]; }
        float xr = 0.f, xi = 0.f;
        for (int i = 0; i < S5C; ++i) {
            const float* uu = U + i * 128 + c.wave * 16;
            float sr = 0.f, si = 0.f;
#pragma unroll
            for (int q = 0; q < 4; ++q) { const float4 v = *(const float4*)(uu + q * 4);
                sr += br[q * 4] * v.x + br[q * 4 + 1] * v.y + br[q * 4 + 2] * v.z + br[q * 4 + 3] * v.w;
                si += bi[q * 4] * v.x + bi[q * 4 + 1] * v.y + bi[q * 4 + 2] * v.z + bi[q * 4 + 3] * v.w; }
            const float nr = are * xr - aim * xi + sr, ni = are * xi + aim * xr + si; xr = nr; xi = ni;
        }
        *(float2*)(E + ((size_t)(((b * 2 + dir) * 16 + g) * S5N + chunk) * 64 + p) * 2) = make_float2(xr, xi);
    }
}
DI void phase_s5_carry(const Ctx& c, int l) {
    const int gt = blockIdx.x * NTHR + c.tid;
    if (gt < 2 * 2 * 16 * 64) {
        const int p = gt & 63, g = (gt >> 6) & 15, dir = (gt >> 10) & 1, b = gt >> 11;
        const float* tb = (const float*)(c.ws + WS_WSM + OFF_S5T) + ((size_t)((l * 2 + dir) * 16 + g) * 64 + p) * 36;
        const float ar = tb[2], ai = tb[3];
        const float* E = (const float*)(c.ws + WS_WSM + OFF_S5E) + (size_t)(((b * 2 + dir) * 16 + g) * S5N) * 128;
        float* C = (float*)(c.ws + WS_WSM + OFF_S5C) + (size_t)(((b * 2 + dir) * 16 + g) * S5N) * 128;
        float xr = 0.f, xi = 0.f;
        for (int ch = 0; ch < S5N; ++ch) {
            const float2 e = *(const float2*)(E + ch * 128 + p * 2);
            *(float2*)(C + ch * 128 + p * 2) = make_float2(xr, xi);
            const float nr = ar * xr - ai * xi + e.x, ni = ar * xi + ai * xr + e.y; xr = nr; xi = ni;
        }
    }
}

constexpr int S5_US = 0, S5_YS = 8192, S5_WV = S5_YS + 2 * 64 * 64 * 4;
template <bool LOCAL>
DI void phase_s5_final_unit(const Ctx& c, int l, int u) {
    unsigned char* L = c.smem;
    const float* s5t = (const float*)(c.ws + WS_WSM + OFF_S5T);
    const float* CIN = (const float*)(c.ws + WS_WSM + OFF_S5C);
    const bf16_t* PS = (const bf16_t*)(c.ws + WS_P + P_PS);
    const int gq = u & 3, ct = (u >> 2) % S5N, b = u / (4 * S5N);
    const int wave = c.wave, lane = c.lane, gl = wave >> 1, dir = wave & 1, g = gq * 4 + gl, n16 = lane & 15, q4 = lane >> 4;
    __syncthreads();
    {
        const int t = c.tid >> 3, part = c.tid & 7;
        *(u32x4*)(L + S5_US + t * 128 + part * 16) = *(const u32x4*)(PS + (size_t)(b * TZ + ct * S5C + t) * 256 + gq * 64 + part * 8);
    }
    typedef short s16x4 __attribute__((ext_vector_type(4)));
    const float* tbase = s5t + ((size_t)((l * 2 + dir) * 16 + g) * 64) * 36;
    s16x4 bfr[8], cfr[8];
#pragma unroll
    for (int j = 0; j < 8; ++j) {
        const int pp = 16 * j + n16, p = pp & 63; const float* tb = tbase + (size_t)p * 36 + (pp < 64 ? 4 : 20) + 4 * q4;
        u32x2 w2; w2.x = pack2(tb[0], tb[1]); w2.y = pack2(tb[2], tb[3]);
        bfr[j] = __builtin_bit_cast(s16x4, w2);
    }
    {
        const float* cre = c.in[29] + ((size_t)((l * 2 + dir) * 16 + g) * 16 + n16) * 64; const float* cim = c.in[30] + ((size_t)((l * 2 + dir) * 16 + g) * 16 + n16) * 64;
#pragma unroll
        for (int s = 0; s < 8; ++s) {
            const int pp = 16 * s + 4 * q4; const float sg = pp < 64 ? 1.f : -1.f; const float* src = (pp < 64 ? cre + pp : cim + (pp - 64));
            u32x2 w2; w2.x = pack2(sg * src[0], sg * src[1]); w2.y = pack2(sg * src[2], sg * src[3]);
            cfr[s] = __builtin_bit_cast(s16x4, w2);
        }
    }
    const float are = tbase[(size_t)lane * 36], aim = tbase[(size_t)lane * 36 + 1];
    const int cd = dir == 0 ? ct : (ct < S5NC ? S5NC - 1 - ct : S5N + S5NC - 1 - ct);
    float xr = 0.f, xi = 0.f;
    if (!LOCAL) { const float2 ci = *(const float2*)(CIN + ((size_t)(((b * 2 + dir) * 16 + g) * S5N + cd) * 64 + lane) * 2); xr = ci.x; xi = ci.y; }
    const float dsk = c.in[31][(size_t)l * 256 + g * 16 + n16];
    bf16_t* BU = (bf16_t*)(L + S5_WV + wave * 8192); bf16_t* XB = BU + 16 * 128;
    float* YS = (float*)(L + S5_YS) + dir * 64 * 64;
    __syncthreads();
#pragma unroll 1
    for (int sb = 0; sb < 4; ++sb) {
        const int stepA = 16 * sb + n16, tlA = dir == 0 ? stepA : 63 - stepA;
        const s16x4 af = __builtin_bit_cast(s16x4, *(const u32x2*)(L + S5_US + tlA * 128 + gl * 32 + q4 * 8));
#pragma unroll
        for (int j = 0; j < 8; ++j) {
            f32x4 acc = {0.f, 0.f, 0.f, 0.f};
            acc = __builtin_amdgcn_mfma_f32_16x16x16bf16_1k(af, bfr[j], acc, 0, 0, 0);
#pragma unroll
            for (int rr = 0; rr < 4; ++rr) {
                const unsigned me = pack2(acc[rr], 0.f) & 0xffffu, nb = (unsigned)__shfl_xor((int)me, 1, 64);
                if ((n16 & 1) == 0) *(unsigned*)(BU + (4 * q4 + rr) * 128 + 16 * j + n16) = me | (nb << 16);
            }
        }
        asm volatile("s_waitcnt lgkmcnt(0)" ::: "memory");
        __builtin_amdgcn_wave_barrier();
#pragma unroll
        for (int ii = 0; ii < 16; ++ii) {
            const float br = bf2f(BU[ii * 128 + lane]), bi = bf2f(BU[ii * 128 + 64 + lane]);
            const float nr = are * xr - aim * xi + br, ni = are * xi + aim * xr + bi; xr = nr; xi = ni;
            if (!LOCAL) {
                const unsigned mr = pack2(xr, 0.f) & 0xffffu, mi = pack2(xi, 0.f) & 0xffffu, nr2 = (unsigned)__shfl_xor((int)mr, 1, 64), ni2 = (unsigned)__shfl_xor((int)mi, 1, 64);
                if ((lane & 1) == 0) { *(unsigned*)(XB + ii * 128 + lane) = mr | (nr2 << 16); *(unsigned*)(XB + ii * 128 + 64 + lane) = mi | (ni2 << 16); }
            }
        }
        asm volatile("s_waitcnt lgkmcnt(0)" ::: "memory");
        __builtin_amdgcn_wave_barrier();
        if (LOCAL) continue;
        f32x4 ya = {0.f, 0.f, 0.f, 0.f};
#pragma unroll
        for (int s = 0; s < 8; ++s) {
            const s16x4 xf = __builtin_bit_cast(s16x4, *(const u32x2*)((const unsigned char*)XB + n16 * 256 + (16 * s + 4 * q4) * 2));
            ya = __builtin_amdgcn_mfma_f32_16x16x16bf16_1k(xf, cfr[s], ya, 0, 0, 0);
        }
#pragma unroll
        for (int rr = 0; rr < 4; ++rr) {
            const int step = 16 * sb + 4 * q4 + rr, tl = dir == 0 ? step : 63 - step;
            float y = ya[rr];
            if (dir == 0) y += dsk * bf2f(*(const bf16_t*)(L + S5_US + tl * 128 + (gl * 16 + n16) * 2));
            YS[tl * 64 + gl * 16 + n16] = y;
        }
    }
    if (LOCAL) { *(float2*)((float*)(c.ws + WS_WSM + OFF_S5E) + ((size_t)(((b * 2 + dir) * 16 + g) * S5N + cd) * 64 + lane) * 2) = make_float2(xr, xi); return; }
    __syncthreads();
    bf16_t* ZG = (bf16_t*)(c.ws + WS_MISC + MS_ZG);
    {
        const float* Y0 = (const float*)(L + S5_YS); const float* Y1 = Y0 + 64 * 64;
        for (int e = c.tid; e < 64 * 16; e += NTHR) {
            const int i = e >> 4, c4 = (e & 15) * 4; const float4 y0 = *(const float4*)(Y0 + i * 64 + c4), y1 = *(const float4*)(Y1 + i * 64 + c4);
            *(u32x2*)(ZG + (size_t)(b * TZ + ct * S5C + i) * 256 + gq * 64 + c4) = pack4(gelu_tanh(y0.x + y1.x), gelu_tanh(y0.y + y1.y), gelu_tanh(y0.z + y1.z), gelu_tanh(y0.w + y1.w));
        }
    }
}

DI void phase_small_gemms(const Ctx& c, int l) {
    unsigned char* ws = c.ws; unsigned char* wsm = ws + WS_WSM;
    const bf16_t* CQN = (const bf16_t*)(ws + WS_MISC + MS_CQN);
    const float* rope = (const float*)(wsm + OFF_ROPE);
    constexpr int NMT = NZ / 256;
    int base = 0;
    const int G = gridDim.x, bid = blockIdx.x;
    {
        const bf16_t* W = (const bf16_t*)(wsm + OFF_WUQT + l * SZ_WUQT); bf16_t* QM = (bf16_t*)(ws + WS_EXPW + MX_QM);
        const float qs = 0.10206207261596577f * LOG2E;
        for (int u = (bid + G - base % G) % G; u < NMT * 3; u += G) {
            const int mt = u / 3, nt = u % 3, r0 = mt * 256, c0 = nt * 128;
            gemm_tile<4, 0>(c, 256, [&](int i) { return CQN + (size_t)(r0 + i) * 384; }, [&](int i) { return W + (size_t)(c0 + i) * 256; }, NoHook(),
                [&](f32x4 (&acc)[4][4], int wr, int wc, int fr, int fq) {
#pragma unroll
                    for (int n = 0; n < 4; ++n) {
                        const int col = c0 + wc + n * 16 + fq * 4, h = col / 96, d = col % 96;
                        const bool rp = d >= 64;
#pragma unroll
                        for (int m = 0; m < 4; ++m) {
                            const int row = r0 + wr + m * 16 + fr, b = row / TZ, s = row % TZ; f32x4 v = acc[m][n];
                            f32x4 pv; pv[0] = __shfl_xor(v[0], 32, 64); pv[1] = __shfl_xor(v[1], 32, 64); pv[2] = __shfl_xor(v[2], 32, 64); pv[3] = __shfl_xor(v[3], 32, 64);
                            if (rp && s >= CTX) {
                                const int i0 = d - 64;
                                const float* cs = rope + ((size_t)(s - CTX) * 16 + (i0 >> 4) * 8 + (i0 & 7)) * 2;
                                const bool hi = (i0 & 8) != 0;
#pragma unroll
                                for (int j = 0; j < 4; ++j) v[j] = v[j] * cs[2 * j] + (hi ? pv[j] : -pv[j]) * cs[2 * j + 1];
                            }
                            *(u32x2*)(QM + ((size_t)(b * 4 + h) * TZ + s) * 96 + d) = pack4(v[0] * qs, v[1] * qs, v[2] * qs, v[3] * qs);
                        }
                    }
                });
        }
        base += NMT * 3;
    }
    {
        const bf16_t* W = (const bf16_t*)(wsm + OFF_WUKVT + l * SZ_WUKVT); bf16_t* KM = (bf16_t*)(ws + WS_EXPW + MX_KM); bf16_t* VMT = (bf16_t*)(ws + WS_EXPW + MX_VMT);
        for (int u = (bid + G - base % G) % G; u < NMT * 4; u += G) {
            const int mt = u / 4, nt = u % 4, r0 = mt * 256, c0 = nt * 128;
            gemm_tile<4, 0>(c, 128, [&](int i) { return CQN + (size_t)(r0 + i) * 384 + 256; }, [&](int i) { return W + (size_t)(c0 + i) * 128; }, NoHook(),
                [&](f32x4 (&acc)[4][4], int wr, int wc, int fr, int fq) {
#pragma unroll
                    for (int n = 0; n < 4; ++n) {
                        const int col = c0 + wc + n * 16 + fq * 4, h = col >> 7, d = col & 127;
#pragma unroll
                        for (int m = 0; m < 4; ++m) {
                            const int row = r0 + wr + m * 16 + fr, b = row / TZ, s = row % TZ; const f32x4 v = acc[m][n];
                            if (d < 64) *(u32x2*)(KM + ((size_t)(b * 4 + h) * TZ + s) * 96 + d) = pack4(v[0], v[1], v[2], v[3]);
                            else {
#pragma unroll
                                for (int j = 0; j < 4; ++j) VMT[((size_t)(b * 4 + h) * 64 + (d - 64 + j)) * TZ + s] = f2bf(v[j]);
                            }
                        }
                    }
                });
        }
        base += NMT * 4;
    }
    bf16_t* SE = (bf16_t*)(ws + WS_P + P_PR); bf16_t* SAD = SE + (size_t)2 * NZ * 256; bf16_t* SKD = SAD + (size_t)2 * NZ * 256;
    {
        const bf16_t* A = (const bf16_t*)(ws + WS_MISC + MS_TW); const bf16_t* W = (const bf16_t*)(wsm + OFF_W2T + l * SZ_W2T);
        const float* w0 = c.in[14] + (size_t)l * 512;
        for (int u = (bid + G - base % G) % G; u < NMT * 4; u += G) {
            const int mt = u / 4, nt = u % 4, r0 = mt * 256, c0 = nt * 128;
            gemm_tile<4, 0>(c, 64, [&](int i) { return A + (size_t)(r0 + i) * 64; }, [&](int i) { return W + (size_t)(c0 + i) * 64; }, NoHook(),
                [&](f32x4 (&acc)[4][4], int wr, int wc, int fr, int fq) {
#pragma unroll
                    for (int n = 0; n < 4; ++n) {
                        const int col = c0 + wc + n * 16 + fq * 4, d = col >> 8, cc = col & 255; const float4 w0v = *(const float4*)(w0 + col);
#pragma unroll
                        for (int m = 0; m < 4; ++m) {
                            const int row = r0 + wr + m * 16 + fr; const f32x4 v = acc[m][n]; float e[4];
                            const float x[4] = {w0v.x + v[0], w0v.y + v[1], w0v.z + v[2], w0v.w + v[3]};
#pragma unroll
                            for (int j = 0; j < 4; ++j) e[j] = 0.6065306597126334f * sigmoidf_(x[j]);
                            *(u32x2*)(SE + ((size_t)d * NZ + row) * 256 + cc) = pack4(e[0], e[1], e[2], e[3]);
                        }
                    }
                });
        }
        base += NMT * 4;
    }
    {
        const bf16_t* A = (const bf16_t*)(ws + WS_MISC + MS_AL); const bf16_t* W = (const bf16_t*)(wsm + OFF_A2T + l * SZ_A2T);
        const float* a0 = c.in[16] + (size_t)l * 512; const float* k_a = c.in[20] + (size_t)l * 256; const bf16_t* KB = (const bf16_t*)(ws + WS_EXPW + MX_KB);
        for (int u = (bid + G - base % G) % G; u < NMT * 4; u += G) {
            const int mt = u / 4, nt = u % 4, r0 = mt * 256, c0 = nt * 128;
            gemm_tile<4, 0>(c, 64, [&](int i) { return A + (size_t)(r0 + i) * 64; }, [&](int i) { return W + (size_t)(c0 + i) * 64; }, NoHook(),
                [&](f32x4 (&acc)[4][4], int wr, int wc, int fr, int fq) {
#pragma unroll
                    for (int n = 0; n < 4; ++n) {
                        const int col = c0 + wc + n * 16 + fq * 4, d = col >> 8, cc = col & 255; const float4 a0v = *(const float4*)(a0 + col), kav = *(const float4*)(k_a + cc);
#pragma unroll
                        for (int m = 0; m < 4; ++m) {
                            const int row = r0 + wr + m * 16 + fr; const f32x4 v = acc[m][n];
                            const float ad0 = sigmoidf_(a0v.x + v[0]), ad1 = sigmoidf_(a0v.y + v[1]), ad2 = sigmoidf_(a0v.z + v[2]), ad3 = sigmoidf_(a0v.w + v[3]);
                            float k[4]; unpack4(*(const u32x2*)(KB + (size_t)row * 256 + cc), k);
                            *(u32x2*)(SAD + ((size_t)d * NZ + row) * 256 + cc) = pack4(ad0, ad1, ad2, ad3);
                            *(u32x2*)(SKD + ((size_t)d * NZ + row) * 256 + cc) = pack4(k[0] * (1.f + (ad0 - 1.f) * kav.x), k[1] * (1.f + (ad1 - 1.f) * kav.y), k[2] * (1.f + (ad2 - 1.f) * kav.z), k[3] * (1.f + (ad3 - 1.f) * kav.w));
                        }
                    }
                });
        }
        base += NMT * 4;
    }
    {
        const bf16_t* A = (const bf16_t*)(ws + WS_MISC + MS_SG); const bf16_t* W = (const bf16_t*)(wsm + OFF_G2T + l * SZ_G2T); bf16_t* GG = (bf16_t*)(ws + WS_MISC + MS_GG);
        for (int u = (bid + G - base % G) % G; u < NMT * 2; u += G) {
            const int mt = u / 2, nt = u % 2, r0 = mt * 256, c0 = nt * 128;
            gemm_tile<4, 0>(c, 128, [&](int i) { return A + (size_t)(r0 + i) * 128; }, [&](int i) { return W + (size_t)(c0 + i) * 128; }, NoHook(),
                [&](f32x4 (&acc)[4][4], int wr, int wc, int fr, int fq) {
#pragma unroll
                    for (int n = 0; n < 4; ++n)
#pragma unroll
                        for (int m = 0; m < 4; ++m) { const f32x4 v = acc[m][n];
                            *(u32x2*)(GG + (size_t)(r0 + wr + m * 16 + fr) * 256 + c0 + wc + n * 16 + fq * 4) = pack4(v[0], v[1], v[2], v[3]); }
                });
        }
        base += NMT * 2;
    }
}

DI int krow(int s, int h, int j) { return 16 * s + 8 * (j >> 2) + 4 * h + (j & 3); }
#ifndef ATT_THR
#define ATT_THR 64.f
#endif
constexpr int ATT_PARK = 56 * 1024;
template <int MODE>
DI void attn_pass(const Ctx& c, int l, int b, int h, int q0, int nkeys) {
    constexpr int DROW = MODE == 0 ? 96 : 64;
    constexpr int DQ = MODE == 0 ? 96 : 32, KS = DQ / 16;
    constexpr int DOFF = MODE == 2 ? 32 : 0;
    constexpr int TK = 128;
    constexpr int KPITCH = DQ * 2 + 16;
    constexpr int VPITCH = TK * 2 + 16;
    constexpr int KBYTES = TK * KPITCH, VBYTES = 64 * VPITCH, STG = KBYTES + VBYTES;
    static_assert(MODE == 0 || 2 * STG <= ATT_PARK, "the staging buffers must stay below the parked o1");
    unsigned char* ws = c.ws; int tid_ = c.tid; asm volatile("" : "+v"(tid_));
    const int tid = tid_, lane = tid & 63, wave = __builtin_amdgcn_readfirstlane(tid >> 6), r = lane & 31, hh = lane >> 5;
    const bf16_t* Q = (const bf16_t*)(ws + WS_EXPW + (MODE == 0 ? MX_QM : MX_QD)) + (size_t)(b * 4 + h) * TZ * DROW + DOFF;
    const bf16_t* Kp = (const bf16_t*)(ws + WS_EXPW + (MODE == 0 ? MX_KM : MX_KD)) + (size_t)(b * 4 + h) * TZ * DROW + DOFF;
    const bf16_t* Vt = (const bf16_t*)(ws + WS_EXPW + (MODE == 0 ? MX_VMT : MX_VDT)) + (size_t)(b * 4 + h) * 64 * TZ;
    unsigned char* smem = c.smem;
    bf16x8 qf[KS];
    const int qrow = q0 + wave * 32 + r;
#pragma unroll
    for (int ks = 0; ks < KS; ++ks) qf[ks] = *(const bf16x8*)(Q + (size_t)qrow * DROW + ks * 16 + hh * 8);
    f32x16 oacc[2];
    float mref = 0.f, lrun = 0.f;
#pragma unroll
    for (int t = 0; t < 2; ++t)
#pragma unroll
        for (int i = 0; i < 16; ++i) oacc[t][i] = 0.f;
    constexpr int CPR = DQ / 8, KCH = TK * CPR, NKR = KCH / NTHR;
    static_assert(KCH % NTHR == 0, "whole staging rounds");
    u32x4 kreg[NKR], vreg[2];
    const bf16_t* kp[NKR]; int koff[NKR];
#pragma unroll
    for (int i = 0; i < NKR; ++i) { const int ch = tid + i * NTHR; kp[i] = Kp + ((long)(ch / CPR) - 64) * DROW + (ch % CPR) * 8; koff[i] = (ch / CPR) * KPITCH + (ch % CPR) * 16; }
    const bf16_t* vp = Vt + (size_t)(tid >> 4) * TZ + (tid & 15) * 8 - 64;
    const int voff = (tid >> 4) * VPITCH + (tid & 15) * 16;
    auto gloadK = [&]() {
#pragma unroll
        for (int i = 0; i < NKR; ++i) { kreg[i] = *(const u32x4*)kp[i]; kp[i] += TK * DROW; }
    };
    auto gloadV = [&]() { vreg[0] = *(const u32x4*)vp; vreg[1] = *(const u32x4*)(vp + (size_t)32 * TZ); vp += TK; };
    auto lstoreK = [&](int buf) {
        unsigned char* sk = smem + buf * STG;
#pragma unroll
        for (int i = 0; i < NKR; ++i) *(u32x4*)(sk + koff[i]) = kreg[i];
    };
    auto lstoreV = [&](int buf) { unsigned char* sv = smem + buf * STG + KBYTES; *(u32x4*)(sv + voff) = vreg[0]; *(u32x4*)(sv + voff + 32 * VPITCH) = vreg[1]; };
    const int kbase = r * KPITCH + hh * 16, vbase = KBYTES + r * VPITCH + hh * 8;
    auto ldfrag = [&](const unsigned char* kb, const unsigned char* vb, int ci) -> u32x4 {
        if (ci < 8) {
            const int kg = ci >> 2, s = (ci >> 1) & 1, t = ci & 1;
            const unsigned char* vrow = vb + t * 32 * VPITCH + (kg * 32 + 16 * s) * 2;
            const u32x2 lo = *(const u32x2*)vrow, hi2 = *(const u32x2*)(vrow + 16);
            u32x4 vv; vv.x = lo.x; vv.y = lo.y; vv.z = hi2.x; vv.w = hi2.y; return vv;
        }
        const int q = ci - 8, kg = q & 1, ks = q >> 1;
        return *(const u32x4*)(kb + kg * 32 * KPITCH + ks * 32);
    };
    constexpr int NM = 8 + 2 * KS;
    const f32x16 zero16 = {0.f, 0.f, 0.f, 0.f, 0.f, 0.f, 0.f, 0.f, 0.f, 0.f, 0.f, 0.f, 0.f, 0.f, 0.f, 0.f};
    auto pv_all = [&](const u32x4 (&P)[4], const unsigned char* vb) {
#pragma unroll
        for (int ci = 0; ci < 8; ++ci) { const u32x4 f = ldfrag(vb, vb, ci); oacc[ci & 1] = __builtin_amdgcn_mfma_f32_32x32x16_bf16(__builtin_bit_cast(bf16x8, f), __builtin_bit_cast(bf16x8, P[ci >> 1]), oacc[ci & 1], 0, 0, 0); }
    };
    auto iter = [&](f32x16 (&Sc)[2], f32x16 (&Sn)[2], u32x4 (&Pp)[4], u32x4 (&Pn)[4], const unsigned char* kb, const unsigned char* vb, bool first) {
        u32x4 fcur = ldfrag(kb, vb, 0), fnx1 = ldfrag(kb, vb, 1);
        if (__any(mref != 0.f)) {
#pragma unroll
            for (int kg = 0; kg < 2; ++kg)
#pragma unroll
                for (int i = 0; i < 16; ++i) Sc[kg][i] -= mref;
        }
        f32x2 ps = {0.f, 0.f};
        __builtin_amdgcn_sched_barrier(0);
#pragma unroll
        for (int ci = 0; ci < NM; ++ci) {
            u32x4 fnx2 = fnx1;
            if (ci + 2 < NM) fnx2 = ldfrag(kb, vb, ci + 2);
            if (ci < 8) oacc[ci & 1] = __builtin_amdgcn_mfma_f32_32x32x16_bf16(__builtin_bit_cast(bf16x8, fcur), __builtin_bit_cast(bf16x8, Pp[ci >> 1]), oacc[ci & 1], 0, 0, 0);
            else { const int q = ci - 8, kg = q & 1, ks = q >> 1; Sn[kg] = __builtin_amdgcn_mfma_f32_32x32x16_bf16(__builtin_bit_cast(bf16x8, fcur), qf[ks], ks == 0 ? zero16 : Sn[kg], 0, 0, 0); }
#pragma unroll
            for (int p = (ci * 16) / NM; p < ((ci + 1) * 16) / NM; ++p) {
                const int kg = p >> 3, q = p & 7;
                const float p0 = __builtin_amdgcn_exp2f(Sc[kg][2 * q]), p1 = __builtin_amdgcn_exp2f(Sc[kg][2 * q + 1]);
                ps += (f32x2){p0, p1};
                unsigned pk = pack2(p0, p1); asm volatile("" : "+v"(pk));
                Pn[kg * 2 + (q >> 2)][q & 3] = pk;
            }
            asm volatile("" : "+v"(ps));
            fcur = fnx1; fnx1 = fnx2;
            __builtin_amdgcn_sched_barrier(0);
        }
        const float pst = ps.x + ps.y;
        const bool bad = !(pst < 0x1p90f) || (first && pst < 0x1p-20f);
        if (__any(bad)) {
            float mx = Sc[0][0];
#pragma unroll
            for (int kg = 0; kg < 2; ++kg)
#pragma unroll
                for (int i = 0; i < 16; ++i) mx = fmaxf(mx, Sc[kg][i]);
            mx = fmaxf(mx, __shfl_xor(mx, 32, 64));
            const bool need = (mx > ATT_THR) || (first && mx < -32.f);
            const float d = need ? mx : 0.f;
            const float alpha = first ? 1.f : __builtin_amdgcn_exp2f(-d);
            mref += d; lrun *= alpha;
#pragma unroll
            for (int t = 0; t < 2; ++t)
#pragma unroll
                for (int i = 0; i < 16; ++i) oacc[t][i] *= alpha;
            ps = (f32x2){0.f, 0.f};
#pragma unroll
            for (int pq = 0; pq < 16; ++pq) {
                const int kg = pq >> 3, q = pq & 7;
                const float p0 = __builtin_amdgcn_exp2f(Sc[kg][2 * q] - d), p1 = __builtin_amdgcn_exp2f(Sc[kg][2 * q + 1] - d);
                ps += (f32x2){p0, p1};
                Pn[kg * 2 + (q >> 2)][q & 3] = pack2(p0, p1);
            }
        }
        lrun += ps.x + ps.y;
    };
    const int NT = nkeys / TK;
    f32x16 S0[2], S1[2]; u32x4 PA[4], PB[4];
#pragma unroll
    for (int q = 0; q < 4; ++q) PA[q] = (u32x4){0u, 0u, 0u, 0u};
    __syncthreads();
    gloadK();
    lstoreK(1);
    gloadK();
    if ((tid & 15) >= 8) gloadV(); else { vreg[0] = (u32x4){0u, 0u, 0u, 0u}; vreg[1] = vreg[0]; vp += TK; }
    __syncthreads();
    {
        const unsigned char* kb = smem + STG + 64 * KPITCH + kbase;
#pragma unroll
        for (int q = 0; q < 2 * KS; ++q) { const int kg = q & 1, ks = q >> 1; const u32x4 f = ldfrag(kb, kb, 8 + q); S0[kg] = __builtin_amdgcn_mfma_f32_32x32x16_bf16(__builtin_bit_cast(bf16x8, f), qf[ks], ks == 0 ? zero16 : S0[kg], 0, 0, 0); }
    }
    for (int s = 0; s < NT; ++s) {
        lstoreK(s & 1); lstoreV(s & 1);
        if (s + 1 < NT) gloadK();
        gloadV();
        __syncthreads();
        const unsigned char* sb = smem + (s & 1) * STG;
        iter(S0, S1, PA, PB, sb + kbase, sb + vbase, s == 0);
        iter(S1, S0, PB, PA, sb + 64 * KPITCH + kbase, sb + 128 + vbase, false);
    }
    lstoreV(NT & 1);
    __syncthreads();
    pv_all(PA, smem + (NT & 1) * STG + vbase);
    const float inv = 1.f / (lrun + __shfl_xor(lrun, 32, 64));
    bf16_t* Ycat = (bf16_t*)(ws + WS_BUFA);
    const int zrow = b * TZ + qrow;
    float* park = (float*)(smem + ATT_PARK) + tid;
    if (MODE == 0) {
#pragma unroll
        for (int t = 0; t < 2; ++t)
#pragma unroll
            for (int i4 = 0; i4 < 4; ++i4) {
                const int dv = t * 32 + 8 * i4 + 4 * hh;
                *(u32x2*)(Ycat + (size_t)zrow * D + h * 64 + dv) = pack4(oacc[t][4 * i4] * inv, oacc[t][4 * i4 + 1] * inv, oacc[t][4 * i4 + 2] * inv, oacc[t][4 * i4 + 3] * inv);
            }
    } else if (MODE == 1) {
#pragma unroll
        for (int t = 0; t < 2; ++t)
#pragma unroll
            for (int i = 0; i < 16; ++i) park[(t * 16 + i) * NTHR] = oacc[t][i] * inv;
    } else {
        const float lam = ((const float*)(ws + WS_WSM + OFF_LAM))[l];
        const float lam_init = 0.8f - 0.6f * __expf(-0.3f * (float)l);
        float ss = 0.f;
#pragma unroll
        for (int t = 0; t < 2; ++t)
#pragma unroll
            for (int i = 0; i < 16; ++i) { const float o = park[(t * 16 + i) * NTHR] - lam * oacc[t][i] * inv; oacc[t][i] = o; ss += o * o; }
        ss += __shfl_xor(ss, 32, 64);
        const float rs = rsqrtf(ss * (1.f / 64.f) + 1e-5f) * (1.f - lam_init);
        const float* sg = c.in[38] + l * 64;
#pragma unroll
        for (int t = 0; t < 2; ++t)
#pragma unroll
            for (int i4 = 0; i4 < 4; ++i4) {
                const int dv = t * 32 + 8 * i4 + 4 * hh; const float4 g = *(const float4*)(sg + dv);
                *(u32x2*)(Ycat + (size_t)zrow * D + 768 + h * 64 + dv) = pack4(oacc[t][4 * i4] * rs * g.x, oacc[t][4 * i4 + 1] * rs * g.y, oacc[t][4 * i4 + 2] * rs * g.z, oacc[t][4 * i4 + 3] * rs * g.w);
            }
    }
}
DI void phase_attention(const Ctx& c, int l) {
    const int nu = 512 + (l == 0 ? 16 : 0);
    for (int u = blockIdx.x; u < nu; u += gridDim.x) {
        int b, h, q0, nk; bool mla;
        if (u < 512) { const int k = u & 255, bh = k & 7; b = bh >> 2; h = bh & 3; q0 = CTX + (k >> 3) * 256; nk = TZ; mla = u < 256; }
        else { const int k = u - 512; b = (k >> 2) & 1; h = k & 3; q0 = 0; nk = CTX; mla = k < 8; }
        if (mla) attn_pass<0>(c, l, b, h, q0, nk);
        else { attn_pass<1>(c, l, b, h, q0, nk); attn_pass<2>(c, l, b, h, q0, nk); }
    }
}

DI int rw_tok(int dir, int i) { return dir == 0 ? i : (i < CTX ? CTX - 1 - i : TZ - 1 - (i - CTX)); }
constexpr int RW_TS = 32;
constexpr int RW_STEP_F = 6 * 64 + 2;
constexpr int RW_BUF_F = RW_TS * RW_STEP_F;
template <int CTRL> DI float dpp_add(float x) { return x + __int_as_float(__builtin_amdgcn_update_dpp(0, __float_as_int(x), CTRL, 0xf, 0xf, false)); }
DI float red16(float x) { x = dpp_add<0xB1>(x); x = dpp_add<0x4E>(x); x = dpp_add<0x141>(x); x = dpp_add<0x140>(x); return x; }
DI float red8(float x) { x = dpp_add<0xB1>(x); x = dpp_add<0x4E>(x); x = dpp_add<0x141>(x); return x; }
struct RwRegs { u32x4 r, v, kk, e, ad, kd; };
DI void rw_load(const Ctx& c, int b, int h, int dir, int chunk, int t, RwRegs& g) {
    const bf16_t* RB = (const bf16_t*)(c.ws + WS_EXPW + MX_RB); const bf16_t* VB = (const bf16_t*)(c.ws + WS_EXPW + MX_VB); const bf16_t* KKB = (const bf16_t*)(c.ws + WS_EXPW + MX_KKB);
    const bf16_t* SE = (const bf16_t*)(c.ws + WS_P + P_PR) + (size_t)dir * NZ * 256; const bf16_t* SAD = SE + (size_t)2 * NZ * 256; const bf16_t* SKD = SAD + (size_t)2 * NZ * 256;
    const int i = chunk * RW_TS + (t >> 3), z = b * TZ + rw_tok(dir, i); const size_t o = (size_t)z * 256 + h * 64 + (t & 7) * 8;
    g.r = *(const u32x4*)(RB + o); g.v = *(const u32x4*)(VB + o); g.kk = *(const u32x4*)(KKB + o);
    g.e = *(const u32x4*)(SE + o); g.ad = *(const u32x4*)(SAD + o); g.kd = *(const u32x4*)(SKD + o);
}
DI void up8(const u32x4& u, float (&f)[8]) { f[0] = lo2f(u.x); f[1] = hi2f(u.x); f[2] = lo2f(u.y); f[3] = hi2f(u.y); f[4] = lo2f(u.z); f[5] = hi2f(u.z); f[6] = lo2f(u.w); f[7] = hi2f(u.w); }
DI void rw_process(const RwRegs& g, int t, float* buf) {
    float r[8], v[8], kk[8], e[8], ad[8], kd[8];
    up8(g.r, r); up8(g.v, v); up8(g.kk, kk); up8(g.e, e); up8(g.ad, ad); up8(g.kd, kd);
    float* f = buf + (t >> 3) * RW_STEP_F + (t & 7) * 8;
    float w[8], bv[8], wr[8]; float br = 0.f, kr = 0.f;
#pragma unroll
    for (int j = 0; j < 8; ++j) { w[j] = __expf(-e[j]); bv[j] = kk[j] * ad[j]; wr[j] = w[j] * r[j]; br += bv[j] * r[j]; kr += kd[j] * r[j]; }
    *(float4*)(f) = make_float4(w[0], w[1], w[2], w[3]); *(float4*)(f + 4) = make_float4(w[4], w[5], w[6], w[7]);
    *(float4*)(f + 64) = make_float4(kk[0], kk[1], kk[2], kk[3]); *(float4*)(f + 68) = make_float4(kk[4], kk[5], kk[6], kk[7]);
    *(float4*)(f + 128) = make_float4(bv[0], bv[1], bv[2], bv[3]); *(float4*)(f + 132) = make_float4(bv[4], bv[5], bv[6], bv[7]);
    *(float4*)(f + 192) = make_float4(kd[0], kd[1], kd[2], kd[3]); *(float4*)(f + 196) = make_float4(kd[4], kd[5], kd[6], kd[7]);
    *(float4*)(f + 256) = make_float4(wr[0], wr[1], wr[2], wr[3]); *(float4*)(f + 260) = make_float4(wr[4], wr[5], wr[6], wr[7]);
    *(float4*)(f + 320) = make_float4(v[0], v[1], v[2], v[3]); *(float4*)(f + 324) = make_float4(v[4], v[5], v[6], v[7]);
    br = red8(br); kr = red8(kr);
    if ((t & 7) == 0) { float* s = buf + (t >> 3) * RW_STEP_F + 384; s[0] = br; s[1] = kr; }
}
struct RwStep { float4 w, kk, bv, kd, wr; float vv, br, kr; };
DI void rw_ld(RwStep& s, const float* f, int kq, int row) {
    s.w = *(const float4*)(f + kq * 4); s.kk = *(const float4*)(f + 64 + kq * 4); s.bv = *(const float4*)(f + 128 + kq * 4);
    s.kd = *(const float4*)(f + 192 + kq * 4); s.wr = *(const float4*)(f + 256 + kq * 4); s.vv = f[320 + row]; s.br = f[384]; s.kr = f[385];
}
DI void phase_rwkv_scan_unit(const Ctx& c, int l, int u) {
    const int rg = u & 3, chain = u >> 2, dir = chain & 1, h = (chain >> 1) & 3, b = chain >> 3;
    float* buf0 = (float*)c.smem; float* buf1 = buf0 + RW_BUF_F;
    float* ybuf = buf1 + RW_BUF_F;
    float* YO = (float*)(c.ws + WS_BUFB) + (size_t)dir * NZ * 256 + (size_t)b * TZ * 256 + h * 64 + rg * 16;
    const int wave = c.wave, lane = c.lane, rr = lane >> 4, kq = lane & 15, rl = (wave & 3) * 4 + rr, row = rg * 16 + rl;
    const int t = c.tid - 256;
    float S0 = 0.f, S1 = 0.f, S2 = 0.f, S3 = 0.f;
    constexpr int NCH = TZ / RW_TS;
    RwRegs g;
    __syncthreads();
    if (wave >= 4) { rw_load(c, b, h, dir, 0, t, g); rw_process(g, t, buf0); rw_load(c, b, h, dir, 1, t, g); }
    __syncthreads();
    for (int ch = 0; ch < NCH; ++ch) {
        float* cur = buf0 + (ch & 1) * RW_BUF_F; float* nxt = buf0 + ((ch + 1) & 1) * RW_BUF_F;
        if (wave >= 4) {
            if (ch > 0) {
                const float* yb = ybuf + ((ch - 1) & 1) * RW_TS * 16;
#pragma unroll
                for (int i = 0; i < 2; ++i) { const int e = t + i * 256, st = e >> 4, rw = e & 15; YO[(size_t)rw_tok(dir, (ch - 1) * RW_TS + st) * 256 + rw] = yb[e]; }
            }
            if (ch + 1 < NCH) rw_process(g, t, nxt);
            if (ch + 2 < NCH) rw_load(c, b, h, dir, ch + 2, t, g);
        } else {
            float* yb = ybuf + (ch & 1) * RW_TS * 16 + rl;
            RwStep s0, s1;
            rw_ld(s0, cur, kq, row);
#pragma unroll 4
            for (int st = 0; st < RW_TS; st += 2) {
                rw_ld(s1, cur + (st + 1) * RW_STEP_F, kq, row);
                {
                    float sa = -((S0 * s0.kk.x + S1 * s0.kk.y) + (S2 * s0.kk.z + S3 * s0.kk.w));
                    float q = (S0 * s0.wr.x + S1 * s0.wr.y) + (S2 * s0.wr.z + S3 * s0.wr.w);
                    sa = red16(sa); q = red16(q);
                    S0 = fmaf(sa, s0.bv.x, fmaf(S0, s0.w.x, s0.vv * s0.kd.x)); S1 = fmaf(sa, s0.bv.y, fmaf(S1, s0.w.y, s0.vv * s0.kd.y));
                    S2 = fmaf(sa, s0.bv.z, fmaf(S2, s0.w.z, s0.vv * s0.kd.z)); S3 = fmaf(sa, s0.bv.w, fmaf(S3, s0.w.w, s0.vv * s0.kd.w));
                    yb[st * 16] = q + sa * s0.br + s0.vv * s0.kr;
                }
                if (st + 2 < RW_TS) rw_ld(s0, cur + (st + 2) * RW_STEP_F, kq, row);
                {
                    float sa = -((S0 * s1.kk.x + S1 * s1.kk.y) + (S2 * s1.kk.z + S3 * s1.kk.w));
                    float q = (S0 * s1.wr.x + S1 * s1.wr.y) + (S2 * s1.wr.z + S3 * s1.wr.w);
                    sa = red16(sa); q = red16(q);
                    S0 = fmaf(sa, s1.bv.x, fmaf(S0, s1.w.x, s1.vv * s1.kd.x)); S1 = fmaf(sa, s1.bv.y, fmaf(S1, s1.w.y, s1.vv * s1.kd.y));
                    S2 = fmaf(sa, s1.bv.z, fmaf(S2, s1.w.z, s1.vv * s1.kd.z)); S3 = fmaf(sa, s1.bv.w, fmaf(S3, s1.w.w, s1.vv * s1.kd.w));
                    yb[(st + 1) * 16] = q + sa * s1.br + s1.vv * s1.kr;
                }
            }
        }
        __syncthreads();
    }
    if (wave >= 4) {
        const float* yb = ybuf + ((NCH - 1) & 1) * RW_TS * 16;
#pragma unroll
        for (int i = 0; i < 2; ++i) { const int e = t + i * 256, st = e >> 4, rw = e & 15; YO[(size_t)rw_tok(dir, (NCH - 1) * RW_TS + st) * 256 + rw] = yb[e]; }
    }
}

constexpr int LA_AN = 0, LA_RN = 8192, LA_BN = 16384, LA_KN = 24576, LA_AT = 32768, LA_BHT = 40960, LA_KHT = 49152, LA_VT = 57344,
              LA_NBA = 65536  , LA_NKA = 81920, LA_NBRT = 90112, LA_NKRT = 98304, LA_P63 = 106496;
constexpr int LA_TMT = LA_AN, LA_M1 = LA_BN, LA_W1T = LA_KN, LA_Z1 = LA_NBA;
DI int crow(int reg, int h) { return (reg & 3) + 8 * (reg >> 2) + 4 * h; }
DI void mm_tile(f32x16& acc, const unsigned char* A, int i0, const unsigned char* BT, int j0, int r, int h) {
#pragma unroll
    for (int ks = 0; ks < 4; ++ks) {
        const bf16x8 a = *(const bf16x8*)(A + (i0 + r) * 128 + ks * 32 + h * 16);
        const bf16x8 b = *(const bf16x8*)(BT + (j0 + r) * 128 + ks * 32 + h * 16);
        acc = __builtin_amdgcn_mfma_f32_32x32x16_bf16(a, b, acc, 0, 0, 0);
    }
}
DI void zero16(f32x16& a) {
#pragma unroll
    for (int i = 0; i < 16; ++i) a[i] = 0.f;
}
DI void phase_rwkv_chunk_unit(const Ctx& c, int l, int unit) {
    unsigned char* L = c.smem; unsigned char* ws = c.ws;
    const int chain = unit / RNC, ch = unit % RNC, dir = chain & 1, hd = (chain >> 1) & 3, b = chain >> 3;
    const int tid = c.tid, lane = c.lane, wave = c.wave, r = lane & 31, h = lane >> 5;
    const bf16_t* RB = (const bf16_t*)(ws + WS_EXPW + MX_RB); const bf16_t* VB = (const bf16_t*)(ws + WS_EXPW + MX_VB); const bf16_t* KKB = (const bf16_t*)(ws + WS_EXPW + MX_KKB);
    const bf16_t* SE = (const bf16_t*)(ws + WS_P + P_PR) + (size_t)dir * NZ * 256; const bf16_t* SAD = SE + (size_t)2 * NZ * 256; const bf16_t* SKD = SAD + (size_t)2 * NZ * 256;
    float* CUM = (float*)(L + LA_NBA);
    __syncthreads();
    const int t = tid >> 3, k0 = (tid & 7) * 8;
    float rr[8], vv[8], kk[8], ee[8], ad[8], kd[8];
    {
        const int z = b * TZ + rw_tok(dir, ch * RC + t); const size_t o = (size_t)z * 256 + hd * 64 + k0;
        up8(*(const u32x4*)(RB + o), rr); up8(*(const u32x4*)(VB + o), vv); up8(*(const u32x4*)(KKB + o), kk);
        up8(*(const u32x4*)(SE + o), ee); up8(*(const u32x4*)(SAD + o), ad); up8(*(const u32x4*)(SKD + o), kd);
        *(float4*)(CUM + t * 64 + k0) = make_float4(ee[0], ee[1], ee[2], ee[3]); *(float4*)(CUM + t * 64 + k0 + 4) = make_float4(ee[4], ee[5], ee[6], ee[7]);
    }
    __syncthreads();
    if (wave == 0) { float cm = 0.f;
#pragma unroll 8
        for (int i = 0; i < RC; ++i) { cm += CUM[i * 64 + lane]; CUM[i * 64 + lane] = cm; } }
    __syncthreads();
    {
        float cm[8], c63[8];
        { const float4 a = *(const float4*)(CUM + t * 64 + k0), bq = *(const float4*)(CUM + t * 64 + k0 + 4); cm[0] = a.x; cm[1] = a.y; cm[2] = a.z; cm[3] = a.w; cm[4] = bq.x; cm[5] = bq.y; cm[6] = bq.z; cm[7] = bq.w; }
        { const float4 a = *(const float4*)(CUM + 63 * 64 + k0), bq = *(const float4*)(CUM + 63 * 64 + k0 + 4); c63[0] = a.x; c63[1] = a.y; c63[2] = a.z; c63[3] = a.w; c63[4] = bq.x; c63[5] = bq.y; c63[6] = bq.z; c63[7] = bq.w; }
        float at[8], rt[8], bt[8], kt[8], bh[8], kh[8];
#pragma unroll
        for (int j = 0; j < 8; ++j) {
            const float pt = __expf(-cm[j]), pp = __expf(-(cm[j] - ee[j])), ip = __expf(cm[j]), ph = __expf(-(c63[j] - cm[j])), bb = kk[j] * ad[j];
            at[j] = -kk[j] * pp; rt[j] = rr[j] * pt; bt[j] = bb * ip; kt[j] = kd[j] * ip; bh[j] = bb * ph; kh[j] = kd[j] * ph;
        }
        u32x4 w4;
        w4.x = pack2(at[0], at[1]); w4.y = pack2(at[2], at[3]); w4.z = pack2(at[4], at[5]); w4.w = pack2(at[6], at[7]); *(u32x4*)(L + LA_AN + t * 128 + k0 * 2) = w4;
        w4.x = pack2(rt[0], rt[1]); w4.y = pack2(rt[2], rt[3]); w4.z = pack2(rt[4], rt[5]); w4.w = pack2(rt[6], rt[7]); *(u32x4*)(L + LA_RN + t * 128 + k0 * 2) = w4;
        w4.x = pack2(bt[0], bt[1]); w4.y = pack2(bt[2], bt[3]); w4.z = pack2(bt[4], bt[5]); w4.w = pack2(bt[6], bt[7]); *(u32x4*)(L + LA_BN + t * 128 + k0 * 2) = w4;
        w4.x = pack2(kt[0], kt[1]); w4.y = pack2(kt[2], kt[3]); w4.z = pack2(kt[4], kt[5]); w4.w = pack2(kt[6], kt[7]); *(u32x4*)(L + LA_KN + t * 128 + k0 * 2) = w4;
#pragma unroll
        for (int j = 0; j < 8; ++j) {
            *(bf16_t*)(L + LA_AT + (k0 + j) * 128 + t * 2) = f2bf(at[j]); *(bf16_t*)(L + LA_BHT + (k0 + j) * 128 + t * 2) = f2bf(bh[j]);
            *(bf16_t*)(L + LA_KHT + (k0 + j) * 128 + t * 2) = f2bf(kh[j]); *(bf16_t*)(L + LA_VT + (k0 + j) * 128 + t * 2) = f2bf(vv[j]);
        }
        if (t == 63) {
            float* p63 = (float*)(L + LA_P63); float* gp = (float*)(ws + WS_RW + RW_P63) + (size_t)unit * 64;
#pragma unroll
            for (int j = 0; j < 8; ++j) { const float p = __expf(-c63[j]); p63[k0 + j] = p; gp[k0 + j] = p; }
        }
    }
    __syncthreads();
    {
        const int p = wave >> 1, i0 = (wave & 1) * 32;
        const unsigned char* A = L + (p == 0 ? LA_BN : p == 1 ? LA_KN : LA_RN);
        const unsigned char* BT = L + (p < 2 ? LA_AN : p == 2 ? LA_BN : LA_KN);
#pragma unroll
        for (int jt = 0; jt < 2; ++jt) {
            const int j0 = jt * 32; f32x16 acc; zero16(acc);
            mm_tile(acc, A, i0, BT, j0, r, h);
            const int col = j0 + r;
#pragma unroll
            for (int g = 0; g < 16; ++g) {
                const int row = i0 + crow(g, h);
                if (p == 0) ((float*)(L + LA_NBA))[row * 64 + col] = (row < col) ? acc[g] : 0.f;
                else if (p == 1) *(bf16_t*)(L + LA_NKA + row * 128 + col * 2) = f2bf((row < col) ? acc[g] : 0.f);
                else *(bf16_t*)(L + (p == 2 ? LA_NBRT : LA_NKRT) + row * 128 + col * 2) = f2bf((col <= row) ? acc[g] : 0.f);
            }
        }
    }
    __syncthreads();
    {
        constexpr int X0 = LA_BN, X1 = LA_KN, X3 = 108544, X4 = X3 + 8192, X5 = LA_NBA + 16384 - 16384, X6 = LA_NBA + 8192;
        float nv[8];
        { const int s = tid >> 3, t0 = (tid & 7) * 8; const float* N = (const float*)(L + LA_NBA) + s * 64 + t0;
          const float4 a = *(const float4*)N, bq = *(const float4*)(N + 4); nv[0] = a.x; nv[1] = a.y; nv[2] = a.z; nv[3] = a.w; nv[4] = bq.x; nv[5] = bq.y; nv[6] = bq.z; nv[7] = bq.w; }
        __syncthreads();
        {
            const int s = tid >> 3, t0 = (tid & 7) * 8;
            u32x4 w4; w4.x = pack2(nv[0], nv[1]); w4.y = pack2(nv[2], nv[3]); w4.z = pack2(nv[4], nv[5]); w4.w = pack2(nv[6], nv[7]);
            *(u32x4*)(L + X0 + s * 128 + t0 * 2) = w4;
#pragma unroll
            for (int j = 0; j < 8; ++j) *(bf16_t*)(L + X1 + (t0 + j) * 128 + s * 2) = f2bf(nv[j]);
#pragma unroll
            for (int j = 0; j < 8; ++j) if (t0 + j == s) nv[j] += 1.f;
            w4.x = pack2(nv[0], nv[1]); w4.y = pack2(nv[2], nv[3]); w4.z = pack2(nv[4], nv[5]); w4.w = pack2(nv[6], nv[7]);
            *(u32x4*)(L + X5 + s * 128 + t0 * 2) = w4;
        }
        __syncthreads();
        const int ti0 = ((wave >> 1) & 1) * 32, tj0 = (wave & 1) * 32;
        if (wave < 4) {
            f32x16 acc; zero16(acc); mm_tile(acc, L + X0, ti0, L + X1, tj0, r, h);
#pragma unroll
            for (int g4 = 0; g4 < 4; ++g4) *(u32x2*)(L + X4 + (tj0 + r) * 128 + (ti0 + 8 * g4 + 4 * h) * 2) = pack4(acc[4 * g4], acc[4 * g4 + 1], acc[4 * g4 + 2], acc[4 * g4 + 3]);
#pragma unroll
            for (int g = 0; g < 16; ++g) *(bf16_t*)(L + X3 + (ti0 + crow(g, h)) * 128 + (tj0 + r) * 2) = f2bf(acc[g]);
        }
        __syncthreads();
#pragma unroll
        for (int k = 1; k <= 5; ++k) {
            const int qa = (k & 1) ? X3 : X0, qt = (k & 1) ? X4 : X1, nqa = (k & 1) ? X0 : X3, nqt = (k & 1) ? X1 : X4;
            const int pa = (k & 1) ? X5 : X6, npa = (k & 1) ? X6 : X5;
            if (wave >= 4) {
                f32x16 acc; zero16(acc); mm_tile(acc, L + pa, ti0, L + qt, tj0, r, h);
#pragma unroll
                for (int g = 0; g < 16; ++g) acc[g] += bf2f(*(const bf16_t*)(L + pa + (ti0 + crow(g, h)) * 128 + (tj0 + r) * 2));
                if (k < 5) {
#pragma unroll
                    for (int g = 0; g < 16; ++g) *(bf16_t*)(L + npa + (ti0 + crow(g, h)) * 128 + (tj0 + r) * 2) = f2bf(acc[g]);
                } else {
#pragma unroll
                    for (int g4 = 0; g4 < 4; ++g4) *(u32x2*)(L + LA_TMT + (tj0 + r) * 128 + (ti0 + 8 * g4 + 4 * h) * 2) = pack4(acc[4 * g4], acc[4 * g4 + 1], acc[4 * g4 + 2], acc[4 * g4 + 3]);
                }
            } else if (k < 5) {
                f32x16 acc; zero16(acc); mm_tile(acc, L + qa, ti0, L + qt, tj0, r, h);
#pragma unroll
                for (int g4 = 0; g4 < 4; ++g4) *(u32x2*)(L + nqt + (tj0 + r) * 128 + (ti0 + 8 * g4 + 4 * h) * 2) = pack4(acc[4 * g4], acc[4 * g4 + 1], acc[4 * g4 + 2], acc[4 * g4 + 3]);
#pragma unroll
                for (int g = 0; g < 16; ++g) *(bf16_t*)(L + nqa + (ti0 + crow(g, h)) * 128 + (tj0 + r) * 2) = f2bf(acc[g]);
            }
            __syncthreads();
        }
    }
    {
        const int p = wave >> 2, i0 = ((wave >> 1) & 1) * 32, j0 = (wave & 1) * 32; f32x16 acc; zero16(acc);
        if (p == 0) {
            mm_tile(acc, L + LA_TMT, i0, L + LA_AT, j0, r, h);
#pragma unroll
            for (int g4 = 0; g4 < 4; ++g4) *(u32x2*)(L + LA_M1 + (j0 + r) * 128 + (i0 + 8 * g4 + 4 * h) * 2) = pack4(acc[4 * g4], acc[4 * g4 + 1], acc[4 * g4 + 2], acc[4 * g4 + 3]);
        } else {
            mm_tile(acc, L + LA_NKA, i0, L + LA_TMT, j0, r, h);
#pragma unroll
            for (int g4 = 0; g4 < 4; ++g4) *(u32x2*)(L + LA_W1T + (j0 + r) * 128 + (i0 + 8 * g4 + 4 * h) * 2) = pack4(acc[4 * g4], acc[4 * g4 + 1], acc[4 * g4 + 2], acc[4 * g4 + 3]);
        }
    }
    __syncthreads();
    if (wave < 4) {
        const int i0 = (wave >> 1) * 32, j0 = (wave & 1) * 32; f32x16 acc; zero16(acc);
        mm_tile(acc, L + LA_W1T, i0, L + LA_VT, j0, r, h);
#pragma unroll
        for (int g4 = 0; g4 < 4; ++g4) *(u32x2*)(L + LA_Z1 + (j0 + r) * 128 + (i0 + 8 * g4 + 4 * h) * 2) = pack4(acc[4 * g4], acc[4 * g4 + 1], acc[4 * g4 + 2], acc[4 * g4 + 3]);
    }
    __syncthreads();
    {
        const int p = wave >> 1, i0 = (wave & 1) * 32;
        bf16_t* GM3 = (bf16_t*)(ws + WS_RW + RW_M3) + (size_t)unit * 4096; bf16_t* GM2 = (bf16_t*)(ws + WS_RW + RW_M2) + (size_t)unit * 4096; bf16_t* GZ5 = (bf16_t*)(ws + WS_RW + RW_Z5) + (size_t)unit * 4096;
        float* YO = (float*)(ws + WS_BUFB) + (size_t)dir * NZ * 256;
#pragma unroll
        for (int jt = 0; jt < 2; ++jt) {
            const int j0 = jt * 32; f32x16 acc; zero16(acc);
            if (p == 0) {
                mm_tile(acc, L + LA_M1, i0, L + LA_NBRT, j0, r, h);
#pragma unroll
                for (int g4 = 0; g4 < 4; ++g4) { const int tt = j0 + r, kq = i0 + 8 * g4 + 4 * h; float rv[4]; unpack4(*(const u32x2*)(L + LA_RN + tt * 128 + kq * 2), rv);
                    *(u32x2*)(GM2 + tt * 64 + kq) = pack4(acc[4 * g4] + rv[0], acc[4 * g4 + 1] + rv[1], acc[4 * g4 + 2] + rv[2], acc[4 * g4 + 3] + rv[3]); }
            } else if (p == 1) {
                mm_tile(acc, L + LA_NBRT, i0, L + LA_Z1, j0, r, h); mm_tile(acc, L + LA_NKRT, i0, L + LA_VT, j0, r, h);
#pragma unroll
                for (int g = 0; g < 16; ++g) { const int tt = i0 + crow(g, h); YO[(size_t)(b * TZ + rw_tok(dir, ch * RC + tt)) * 256 + hd * 64 + j0 + r] = acc[g]; }
            } else if (p == 2) {
                mm_tile(acc, L + LA_M1, i0, L + LA_BHT, j0, r, h);
#pragma unroll
                for (int g4 = 0; g4 < 4; ++g4) *(u32x2*)(GM3 + (j0 + r) * 64 + i0 + 8 * g4 + 4 * h) = pack4(acc[4 * g4], acc[4 * g4 + 1], acc[4 * g4 + 2], acc[4 * g4 + 3]);
            } else {
                mm_tile(acc, L + LA_BHT, i0, L + LA_Z1, j0, r, h); mm_tile(acc, L + LA_KHT, i0, L + LA_VT, j0, r, h);
#pragma unroll
                for (int g4 = 0; g4 < 4; ++g4) *(u32x2*)(GZ5 + (j0 + r) * 64 + i0 + 8 * g4 + 4 * h) = pack4(acc[4 * g4], acc[4 * g4 + 1], acc[4 * g4 + 2], acc[4 * g4 + 3]);
            }
        }
    }
}
DI void phase_rwkv_chunks(const Ctx& c, int l) {
    for (int u = blockIdx.x; u < 16 * RNC; u += gridDim.x) phase_rwkv_chunk_unit(c, l, u);
}
DI bf16x8 pack8(const f32x16& x, int s) {
    u32x4 p; p.x = pack2(x[8 * s], x[8 * s + 1]); p.y = pack2(x[8 * s + 2], x[8 * s + 3]); p.z = pack2(x[8 * s + 4], x[8 * s + 5]); p.w = pack2(x[8 * s + 6], x[8 * s + 7]);
    return __builtin_bit_cast(bf16x8, p);
}
DI bf16x8 ldfrag(const bf16_t* rowp, int s, int h) {
    const u32x2 lo = *(const u32x2*)(rowp + 16 * s + 4 * h), hi = *(const u32x2*)(rowp + 16 * s + 8 + 4 * h);
    u32x4 v; v.x = lo.x; v.y = lo.y; v.z = hi.x; v.w = hi.y; return __builtin_bit_cast(bf16x8, v);
}
constexpr int SQ_PITCH = 144, SQ_MAT = 64 * SQ_PITCH;
constexpr int SQA_M3 = 0, SQA_Z5 = SQ_MAT, SQA_P63 = 2 * SQ_MAT, SQA_BYTES = SQA_P63 + 256;
constexpr int SQB_M2 = 0, SQB_Y = SQ_MAT, SQB_BYTES = SQB_Y + 64 * 64 * 4;
constexpr int SQ_A0 = 0, SQ_B0 = 2 * SQA_BYTES, SQ_XB = SQ_B0 + 2 * SQB_BYTES;
DI bf16x8 ldfrag_l(const unsigned char* rowp, int s, int h) {
    const u32x2 lo = *(const u32x2*)(rowp + (16 * s + 4 * h) * 2), hi = *(const u32x2*)(rowp + (16 * s + 8 + 4 * h) * 2);
    u32x4 v; v.x = lo.x; v.y = lo.y; v.z = hi.x; v.w = hi.y; return __builtin_bit_cast(bf16x8, v);
}
struct SqRegsA { u32x4 m3[2], z5[2], p63; };
struct SqRegsB { u32x4 m2[2], y[4]; };
DI void sqa_gload(const Ctx& c, size_t unit, int lt, SqRegsA& g) {
    const unsigned char* g3 = c.ws + WS_RW + RW_M3 + unit * 8192; const unsigned char* g5 = c.ws + WS_RW + RW_Z5 + unit * 8192;
#pragma unroll
    for (int i = 0; i < 2; ++i) { const int id = lt + i * 256; g.m3[i] = *(const u32x4*)(g3 + id * 16); g.z5[i] = *(const u32x4*)(g5 + id * 16); }
    if (lt < 16) g.p63 = *(const u32x4*)(c.ws + WS_RW + RW_P63 + unit * 256 + lt * 16);
}
DI void sqa_lstore(unsigned char* st, int lt, const SqRegsA& g) {
#pragma unroll
    for (int i = 0; i < 2; ++i) { const int id = lt + i * 256, row = id >> 3, part = id & 7;
        *(u32x4*)(st + SQA_M3 + row * SQ_PITCH + part * 16) = g.m3[i]; *(u32x4*)(st + SQA_Z5 + row * SQ_PITCH + part * 16) = g.z5[i]; }
    if (lt < 16) *(u32x4*)(st + SQA_P63 + lt * 16) = g.p63;
}
DI void sqb_gload(const Ctx& c, size_t unit, const float* YO, int dir, int ch, int lt, SqRegsB& g) {
    const unsigned char* g2 = c.ws + WS_RW + RW_M2 + unit * 8192;
#pragma unroll
    for (int i = 0; i < 2; ++i) g.m2[i] = *(const u32x4*)(g2 + (lt + i * 256) * 16);
#pragma unroll
    for (int i = 0; i < 4; ++i) { const int id = lt + i * 256; g.y[i] = *(const u32x4*)(YO + (size_t)rw_tok(dir, ch * RC + (id >> 4)) * 256 + (id & 15) * 4); }
}
DI void sqb_lstore(unsigned char* st, int lt, const SqRegsB& g) {
#pragma unroll
    for (int i = 0; i < 2; ++i) { const int id = lt + i * 256; *(u32x4*)(st + SQB_M2 + (id >> 3) * SQ_PITCH + (id & 7) * 16) = g.m2[i]; }
#pragma unroll
    for (int i = 0; i < 4; ++i) { const int id = lt + i * 256; *(u32x4*)(st + SQB_Y + (id >> 4) * 256 + (id & 15) * 16) = g.y[i]; }
}
DI void sqb_store_y(float* YO, int dir, int ch, const unsigned char* st, int lt) {
#pragma unroll
    for (int i = 0; i < 4; ++i) { const int id = lt + i * 256; *(u32x4*)(YO + (size_t)rw_tok(dir, ch * RC + (id >> 4)) * 256 + (id & 15) * 4) = *(const u32x4*)(st + SQB_Y + (id >> 4) * 256 + (id & 15) * 16); }
}
DI void phase_rwkv_seq_block(const Ctx& c, int l, int chain) {
    unsigned char* L = c.smem; const int lane = c.lane, wave = c.wave, r = lane & 31, h = lane >> 5;
    const int dir = chain & 1, hd = (chain >> 1) & 3, b = chain >> 3, lt = c.tid - 256, vh = wave & 1;
    const size_t unit0 = (size_t)chain * RNC;
    __syncthreads();
    if (wave >= 4) {
        float* YO = (float*)(c.ws + WS_BUFB) + (size_t)dir * NZ * 256 + (size_t)b * TZ * 256 + hd * 64;
        SqRegsA ga; SqRegsB gb;
        sqa_gload(c, unit0, lt, ga); sqa_lstore(L + SQ_A0, lt, ga); sqa_gload(c, unit0 + 1, lt, ga); sqb_gload(c, unit0, YO, dir, 0, lt, gb);
        __syncthreads();
#pragma unroll 1
        for (int ch = 0; ch <= RNC; ++ch) {
            unsigned char* sb = L + SQ_B0 + (ch & 1) * SQB_BYTES;
            if (ch >= 2) sqb_store_y(YO, dir, ch - 2, sb, lt);
            if (ch < RNC) sqb_lstore(sb, lt, gb);
            if (ch + 1 < RNC) { sqb_gload(c, unit0 + ch + 1, YO, dir, ch + 1, lt, gb); sqa_lstore(L + SQ_A0 + ((ch + 1) & 1) * SQA_BYTES, lt, ga); }
            if (ch + 2 < RNC) sqa_gload(c, unit0 + ch + 2, lt, ga);
            __syncthreads();
        }
        sqb_store_y(YO, dir, RNC - 1, L + SQ_B0 + ((RNC - 1) & 1) * SQB_BYTES, lt);
    } else if (wave < 2) {
        f32x16 x[2]; zero16(x[0]); zero16(x[1]);
        __syncthreads();
#pragma unroll 1
        for (int ch = 0; ch <= RNC; ++ch) {
            if (ch < RNC) {
                const unsigned char* st = L + SQ_A0 + (ch & 1) * SQA_BYTES;
                unsigned char* xbuf = L + SQ_XB + ((ch & 1) * 2 + vh) * 4096 + lane * 16;
                bf16x8 xb[4];
#pragma unroll
                for (int s = 0; s < 4; ++s) { xb[s] = pack8(x[s >> 1], s & 1); *(bf16x8*)(xbuf + s * 1024) = xb[s]; }
                f32x16 xn0, xn1;
#pragma unroll
                for (int i = 0; i < 2; ++i) {
                    f32x16 xa;
#pragma unroll
                    for (int g4 = 0; g4 < 4; ++g4) {
                        float z5[4]; unpack4(*(const u32x2*)(st + SQA_Z5 + (vh * 32 + r) * SQ_PITCH + (32 * i + 8 * g4 + 4 * h) * 2), z5);
                        const float4 p4 = *(const float4*)(st + SQA_P63 + (32 * i + 8 * g4 + 4 * h) * 4);
                        xa[4 * g4] = fmaf(p4.x, x[i][4 * g4], z5[0]); xa[4 * g4 + 1] = fmaf(p4.y, x[i][4 * g4 + 1], z5[1]);
                        xa[4 * g4 + 2] = fmaf(p4.z, x[i][4 * g4 + 2], z5[2]); xa[4 * g4 + 3] = fmaf(p4.w, x[i][4 * g4 + 3], z5[3]);
                    }
#pragma unroll
                    for (int s = 0; s < 4; ++s) xa = __builtin_amdgcn_mfma_f32_32x32x16_bf16(ldfrag_l(st + SQA_M3 + (32 * i + r) * SQ_PITCH, s, h), xb[s], xa, 0, 0, 0);
                    if (i == 0) xn0 = xa; else xn1 = xa;
                }
                x[0] = xn0; x[1] = xn1;
            }
            __syncthreads();
        }
    } else {
        __syncthreads();
#pragma unroll 1
        for (int ch = 0; ch <= RNC; ++ch) {
            if (ch >= 1) {
                const int cy = ch - 1;
                unsigned char* st = L + SQ_B0 + (cy & 1) * SQB_BYTES;
                const unsigned char* xbuf = L + SQ_XB + ((cy & 1) * 2 + vh) * 4096 + lane * 16;
                bf16x8 xb[4];
#pragma unroll
                for (int s = 0; s < 4; ++s) xb[s] = *(const bf16x8*)(xbuf + s * 1024);
#pragma unroll
                for (int i = 0; i < 2; ++i) {
                    f32x16 ya;
#pragma unroll
                    for (int g = 0; g < 16; ++g) ya[g] = *((const float*)(st + SQB_Y) + (32 * i + crow(g, h)) * 64 + vh * 32 + r);
#pragma unroll
                    for (int s = 0; s < 4; ++s) ya = __builtin_amdgcn_mfma_f32_32x32x16_bf16(ldfrag_l(st + SQB_M2 + (32 * i + r) * SQ_PITCH, s, h), xb[s], ya, 0, 0, 0);
#pragma unroll
                    for (int g = 0; g < 16; ++g) *((float*)(st + SQB_Y) + (32 * i + crow(g, h)) * 64 + vh * 32 + r) = ya[g];
                }
            }
            __syncthreads();
        }
    }
}
DI void phase_mixers2(const Ctx& c, int l) {
    const int G = gridDim.x, bid = blockIdx.x;
    if (G >= 128) {
        if (bid < 16) phase_rwkv_seq_block(c, l, bid);
        else for (int u = bid - 16; u < 2 * S5N * 4; u += G - 16) phase_s5_final_unit<false>(c, l, u);
    } else {
        for (int u = bid; u < 16; u += G) phase_rwkv_seq_block(c, l, u);
        for (int u = bid; u < 2 * S5N * 4; u += G) phase_s5_final_unit<false>(c, l, u);
    }
}

DI void phase_post(const Ctx& c, int l) {
    unsigned char* ws = c.ws; const int lane = c.lane;
    const float* YF = (const float*)(ws + WS_BUFB); const float* YB = YF + (size_t)NZ * 256;
    const bf16_t* RB = (const bf16_t*)(ws + WS_EXPW + MX_RB); const bf16_t* VB = (const bf16_t*)(ws + WS_EXPW + MX_VB);
    const bf16_t* SKD = (const bf16_t*)(ws + WS_P + P_PR) + (size_t)4 * NZ * 256; const bf16_t* GG = (const bf16_t*)(ws + WS_MISC + MS_GG);
    bf16_t* Ycat = (bf16_t*)(ws + WS_BUFA);
    const float* r_k = c.in[21] + l * 256; const float* lg = c.in[22] + l * 256; const float* lb = c.in[23] + l * 256;
    for (int z = blockIdx.x * 8 + c.wave; z < NZ; z += gridDim.x * 8) {
        const size_t o = (size_t)z * 256 + lane * 4;
        const float4 yf = *(const float4*)(YF + o), yb = *(const float4*)(YB + o);
        const float y0 = yf.x + yb.x, y1 = yf.y + yb.y, y2 = yf.z + yb.z, y3 = yf.w + yb.w;
        const float mean = sum16(y0 + y1 + y2 + y3) * (1.f / 64.f);
        const float d0 = y0 - mean, d1 = y1 - mean, d2 = y2 - mean, d3 = y3 - mean;
        const float var = sum16(d0 * d0 + d1 * d1 + d2 * d2 + d3 * d3) * (1.f / 64.f);
        const float rs = rsqrtf(var + 64e-5f);
        float r[4], v[4], k0[4], k1[4], gg[4];
        unpack4(*(const u32x2*)(RB + o), r); unpack4(*(const u32x2*)(VB + o), v); unpack4(*(const u32x2*)(SKD + o), k0); unpack4(*(const u32x2*)(SKD + (size_t)NZ * 256 + o), k1);
        unpack4(*(const u32x2*)(GG + o), gg);
        const float4 rk = *(const float4*)(r_k + lane * 4), g4 = *(const float4*)(lg + lane * 4), b4 = *(const float4*)(lb + lane * 4);
        const float bs = sum16(r[0] * (k0[0] + k1[0]) * rk.x + r[1] * (k0[1] + k1[1]) * rk.y + r[2] * (k0[2] + k1[2]) * rk.z + r[3] * (k0[3] + k1[3]) * rk.w);
        *(u32x2*)(Ycat + (size_t)z * D + 256 + lane * 4) = pack4((d0 * rs * g4.x + b4.x + bs * v[0]) * gg[0], (d1 * rs * g4.y + b4.y + bs * v[1]) * gg[1],
                                                                (d2 * rs * g4.z + b4.z + bs * v[2]) * gg[2], (d3 * rs * g4.w + b4.w + bs * v[3]) * gg[3]);
    }
    {
        const bf16_t* ZG = (const bf16_t*)(ws + WS_MISC + MS_ZG); const bf16_t* W = (const bf16_t*)(ws + WS_WSM + OFF_GLUT + l * SZ_GLUT);
        const float* gb = c.in[33] + l * 256;
        for (int u = blockIdx.x; u < (NZ / 256) * 2; u += gridDim.x) {
            const int mt = u / 2, nt = u % 2, r0 = mt * 256, c0 = nt * 128;
            gemm_tile<4, 0>(c, 256, [&](int i) { return ZG + (size_t)(r0 + i) * 256; }, [&](int i) { return W + (size_t)(c0 + i) * 256; }, NoHook(),
                [&](f32x4 (&acc)[4][4], int wr, int wc, int fr, int fq) {
#pragma unroll
                    for (int n = 0; n < 4; ++n) {
                        const int col = c0 + wc + n * 16 + fq * 4; const float4 bb = *(const float4*)(gb + col);
#pragma unroll
                        for (int m = 0; m < 4; ++m) {
                            const int row = r0 + wr + m * 16 + fr; const f32x4 v = acc[m][n];
                            float zg[4]; unpack4(*(const u32x2*)(ZG + (size_t)row * 256 + col), zg);
                            *(u32x2*)(Ycat + (size_t)row * D + 512 + col) = pack4(zg[0] * sigmoidf_(v[0] + bb.x), zg[1] * sigmoidf_(v[1] + bb.y), zg[2] * sigmoidf_(v[2] + bb.z), zg[3] * sigmoidf_(v[3] + bb.w));
                        }
                    }
                });
        }
    }
}

DI bool skip_mt(int l, int mt) { return l == NL - 1 && (mt % 33) == 0; }
DI void phase_merge1(const Ctx& c, int l) {
    const bf16_t* Ycat = (const bf16_t*)(c.ws + WS_BUFA); const bf16_t* W = (const bf16_t*)(c.ws + WS_WSM + OFF_WBT + l * SZ_WBT);
    const bf16_t* GT = (const bf16_t*)(c.ws + WS_GT); bf16_t* MG = (bf16_t*)(c.ws + WS_BUFB);
    if (blockIdx.x == 0 && c.tid < 32) ((unsigned*)(c.ws + WS_CTL))[CW_CNT + l * 32 + c.tid] = 0u;
    for (int u = blockIdx.x; u < (NZ / 256) * 8; u += gridDim.x) {
        const int mt = u / 8, nt = u % 8, r0 = mt * 256, c0 = nt * 128;
        if (skip_mt(l, mt)) continue;
        f32x4 macc[4][4];
#pragma unroll
        for (int m = 0; m < 4; ++m)
#pragma unroll
            for (int n = 0; n < 4; ++n) macc[m][n] = (f32x4){0.f, 0.f, 0.f, 0.f};
        gemm_tile<4, 256>(c, 1024, [&](int i) { return Ycat + (size_t)(r0 + i) * D; }, [&](int i) { return W + (size_t)(c0 + i) * D; },
            [&](f32x4 (&acc)[4][4], int seg, int wr, int wc, int fr, int fq) {
#pragma unroll
                for (int m = 0; m < 4; ++m)
#pragma unroll
                    for (int n = 0; n < 4; ++n) {
                        float g[4]; unpack4(*(const u32x2*)(GT + (size_t)(r0 + wr + m * 16 + fr) * 4096 + seg * 1024 + c0 + wc + n * 16 + fq * 4), g);
                        macc[m][n][0] += g[0] * acc[m][n][0]; macc[m][n][1] += g[1] * acc[m][n][1]; macc[m][n][2] += g[2] * acc[m][n][2]; macc[m][n][3] += g[3] * acc[m][n][3];
                        acc[m][n] = (f32x4){0.f, 0.f, 0.f, 0.f};
                    }
            },
            [&](f32x4 (&)[4][4], int wr, int wc, int fr, int fq) {
#pragma unroll
                for (int m = 0; m < 4; ++m)
#pragma unroll
                    for (int n = 0; n < 4; ++n)
                        *(u32x2*)(MG + (size_t)(r0 + wr + m * 16 + fr) * D + c0 + wc + n * 16 + fq * 4) = pack4(macc[m][n][0], macc[m][n][1], macc[m][n][2], macc[m][n][3]);
            });
    }
}
struct EpiMerge2 {
    static constexpr bool PERM = false, AFTER_DRAIN = false;
    float* H; const float* modv; int l;
    DI void operator()(const pg8::f32x4 (&acc)[2][2][4][2], const pg8::Unit& u, int wr, int wc, int fr, int fq) const {
        if (skip_mt(l, u.pm)) return;
        const int sel = (u.pm % 33) == 0 ? 2 : u.pm / 33;
        const int row0 = u.pm * 256 + wr * 64 + fr, col0 = u.pn * 256 + wc * 32 + 4 * fq;
#pragma unroll
        for (int bj = 0; bj < 2; ++bj)
#pragma unroll
            for (int n = 0; n < 2; ++n) {
                const int col = col0 + bj * 128 + n * 16; const float4 m2 = *(const float4*)(modv + ((size_t)l * 3 + sel) * 6144 + 2 * 1024 + col);
#pragma unroll
                for (int ai = 0; ai < 2; ++ai)
#pragma unroll
                    for (int m = 0; m < 4; ++m) {
                        float4* hp = (float4*)(H + (size_t)(row0 + ai * 128 + m * 16) * D + col); float4 hv = *hp; const pg8::f32x4 v = acc[ai][bj][m][n];
                        hv.x += m2.x * v[0]; hv.y += m2.y * v[1]; hv.z += m2.z * v[2]; hv.w += m2.w * v[3]; *hp = hv;
                    }
            }
    }
};
struct LatOrder {
    int G, c;
    DI bool next(int i, pg8::Unit& u) const { const int L = i * G + c; if (L >= 256) return false; const int pl = L >> 2; u.pm = (pl >> 5) * 33 + 1 + (pl & 31); u.pn = L & 3; return true; }
    DI void a_ready(const pg8::Unit&) const {}
    DI void done(const pg8::Unit&) const {}
};
DI void phase_merge2(const Ctx& c, int l) {
    EpiMerge2 E; E.H = (float*)(c.ws + WS_H); E.modv = (const float*)(c.ws + WS_WSM + OFF_MODV); E.l = l;
    pg8::Gemm g{(const bf16_t*)(c.ws + WS_BUFB), (const bf16_t*)(c.ws + WS_WSM + OFF_WOUTT + l * SZ_WOUTT), NZ, 1024, 1024, 1024, 1024};
    __syncthreads();
    if (l == NL - 1) {
        LatOrder S; S.G = (int)gridDim.x; S.c = (int)blockIdx.x;
        pg8::gemm_phase<EpiMerge2, LatOrder, false>((PG8_LAS unsigned char*)c.smem, g, S, E, nullptr, c.tid);
    } else {
        pg8::StaticOrder S; S.init(NZ, 1024, (int)gridDim.x, (int)blockIdx.x);
        pg8::gemm_phase<EpiMerge2, pg8::StaticOrder, false>((PG8_LAS unsigned char*)c.smem, g, S, E, nullptr, c.tid);
    }
}

constexpr int RT_PITCH = 68;
constexpr int RT_RED_W = 8 * 4 * RT_PITCH;
DI void phase_norm2_route(const Ctx& c, int l) {
    unsigned char* ws = c.ws; const int lane = c.lane, wave = c.wave, tid = c.tid;
    const float* modv = (const float*)(ws + WS_WSM + OFF_MODV); const float* H = (const float*)(ws + WS_H);
    bf16_t* XN = (bf16_t*)(ws + WS_BUFA); const float* g2 = c.in[7] + l * 1024;
    const float* rwt = (const float*)(ws + WS_WSM + OFF_RWT) + (size_t)l * 36 * 1024;
    const float* bg = c.in[42] + l * 4; const float* be = c.in[44] + l * 32;
    unsigned* cnt = (unsigned*)(ws + WS_CTL) + CW_CNT + l * 32;
    int* list = (int*)(ws + WS_GT + GT_LIST); float* lw = (float*)(ws + WS_GT + GT_LW);
    float* red = (float*)c.smem + wave * RT_RED_W;
    float* lgs = (float*)c.smem + 8 * RT_RED_W + wave * 8 * 40;
    int* hist = (int*)((float*)c.smem + 8 * RT_RED_W + 8 * 8 * 40);
    int* sel = hist + 64;
    float* selw = (float*)(sel + 128);
    const int ngroups = (l == NL - 1) ? (NB * SEQ / 64) : (NZ / 64);
    for (int grp = blockIdx.x; grp < ngroups; grp += gridDim.x) {
        __syncthreads();
        if (tid < 32) hist[tid] = 0;
        __syncthreads();
        float x[8][16];
#pragma unroll
        for (int i = 0; i < 8; ++i) {
            const int rl = wave * 8 + i; int row;
            if (l == NL - 1) { const int rr = grp * 64 + rl; row = (rr / SEQ) * TZ + CTX + (rr % SEQ); } else row = grp * 64 + rl;
#pragma unroll
            for (int q = 0; q < 4; ++q) { const float4 v = *(const float4*)(H + (size_t)row * D + q * 256 + lane * 4); x[i][q * 4] = v.x; x[i][q * 4 + 1] = v.y; x[i][q * 4 + 2] = v.z; x[i][q * 4 + 3] = v.w; }
        }
#pragma unroll
        for (int i = 0; i < 8; ++i) {
            const int rl = wave * 8 + i; int row;
            if (l == NL - 1) { const int rr = grp * 64 + rl; row = (rr / SEQ) * TZ + CTX + (rr % SEQ); } else row = grp * 64 + rl;
            const int b = row / TZ, s = row % TZ, sel3 = s < CTX ? 2 : b;
            float ss = 0.f;
#pragma unroll
            for (int j = 0; j < 16; ++j) ss += x[i][j] * x[i][j];
            ss = wave_sum(ss);
            const float rs = rsqrtf(ss * (1.f / 1024.f) + 1e-6f);
#pragma unroll
            for (int q = 0; q < 4; ++q) {
                const int col = q * 256 + lane * 4;
                const float4 g = *(const float4*)(g2 + col), m3 = *(const float4*)(modv + ((size_t)l * 3 + sel3) * 6144 + 3 * 1024 + col), m4 = *(const float4*)(modv + ((size_t)l * 3 + sel3) * 6144 + 4 * 1024 + col);
                x[i][q * 4] = x[i][q * 4] * rs * g.x * (1.f + m4.x) + m3.x; x[i][q * 4 + 1] = x[i][q * 4 + 1] * rs * g.y * (1.f + m4.y) + m3.y;
                x[i][q * 4 + 2] = x[i][q * 4 + 2] * rs * g.z * (1.f + m4.z) + m3.z; x[i][q * 4 + 3] = x[i][q * 4 + 3] * rs * g.w * (1.f + m4.w) + m3.w;
                *(u32x2*)(XN + (size_t)row * D + col) = pack4(x[i][q * 4], x[i][q * 4 + 1], x[i][q * 4 + 2], x[i][q * 4 + 3]);
            }
        }
#pragma unroll 1
        for (int ec = 0; ec < 9; ++ec) {
#pragma unroll
            for (int ee = 0; ee < 4; ++ee) {
                const int e = ec * 4 + ee;
                float4 w[4];
#pragma unroll
                for (int q = 0; q < 4; ++q) w[q] = *(const float4*)(rwt + (size_t)e * 1024 + q * 256 + lane * 4);
#pragma unroll
                for (int i = 0; i < 8; ++i) {
                    float a = 0.f;
#pragma unroll
                    for (int q = 0; q < 4; ++q) a += x[i][q * 4] * w[q].x + x[i][q * 4 + 1] * w[q].y + x[i][q * 4 + 2] * w[q].z + x[i][q * 4 + 3] * w[q].w;
                    red[(i * 4 + ee) * RT_PITCH + lane] = a;
                }
            }
            __builtin_amdgcn_wave_barrier();
            if (lane < 32) {
                float s0 = 0.f, s1 = 0.f, s2 = 0.f, s3 = 0.f;
#pragma unroll
                for (int q = 0; q < 16; ++q) { const float4 v = *(const float4*)(red + lane * RT_PITCH + q * 4); s0 += v.x; s1 += v.y; s2 += v.z; s3 += v.w; }
                const int e = ec * 4 + (lane & 3);
                lgs[(lane >> 2) * 40 + e] = (s0 + s1) + (s2 + s3) + (e < 4 ? bg[e] : be[e - 4]);
            }
            __builtin_amdgcn_wave_barrier();
        }
        if (lane < 8) {
            const float* lg = lgs + lane * 40;
            float gm = lg[0]; int gsel = 0;
#pragma unroll
            for (int g = 1; g < 4; ++g) if (lg[g] > gm) { gm = lg[g]; gsel = g; }
            const float gs = __expf(lg[0] - gm) + __expf(lg[1] - gm) + __expf(lg[2] - gm) + __expf(lg[3] - gm);
            const float pg = 1.f / gs;
            float l1 = -1e30f, l2 = -1e30f; int e1 = 0, e2 = 0;
#pragma unroll
            for (int j = 0; j < 8; ++j) {
                const float v = lg[4 + gsel * 8 + j]; const int e = gsel * 8 + j;
                if (v > l1) { l2 = l1; e2 = e1; l1 = v; e1 = e; } else if (v > l2) { l2 = v; e2 = e; }
            }
            const float tt = __expf(l2 - l1), w1 = pg / (1.f + tt), w2 = pg * tt / (1.f + tt);
            const int rl = wave * 8 + lane;
            const int r1 = atomicAdd(&hist[e1], 1), r2 = atomicAdd(&hist[e2], 1);
            sel[rl * 2] = e1 | (r1 << 8); sel[rl * 2 + 1] = e2 | (r2 << 8); selw[rl * 2] = w1; selw[rl * 2 + 1] = w2;
        }
        __syncthreads();
        if (tid < 32) hist[32 + tid] = (int)atomicAdd(&cnt[tid], (unsigned)hist[tid]);
        __syncthreads();
        if (tid < 128) {
            const int rl = tid >> 1, j = tid & 1, sv = sel[tid], e = sv & 255, rk = sv >> 8;
            int row;
            if (l == NL - 1) { const int rr = grp * 64 + rl; row = (rr / SEQ) * TZ + CTX + (rr % SEQ); } else row = grp * 64 + rl;
            const size_t pos = (size_t)e * MOE_CAP + hist[32 + e] + rk;
            list[pos] = row * 2 + j; lw[pos] = selw[tid];
        }
    }
    phase_expert_convert(c, l);
}

DI void moe_prefix(const Ctx& c, int l, int* tiles  , int* cnts  ) {
    __syncthreads();
    if (c.tid == 0) {
        const unsigned* cnt = (const unsigned*)(c.ws + WS_CTL) + CW_CNT + l * 32; int acc = 0;
        for (int e = 0; e < 32; ++e) { const int n = (int)__hip_atomic_load(cnt + e, __ATOMIC_RELAXED, __HIP_MEMORY_SCOPE_AGENT); cnts[e] = n; tiles[e] = acc; acc += (n + 127) / 128; }
        tiles[32] = acc;
    }
    __syncthreads();
}
DI void phase_moe1(const Ctx& c, int l) {
    unsigned char* ws = c.ws;
    int* tiles = (int*)(c.smem + 120 * 1024); int* cnts = tiles + 40;
    moe_prefix(c, l, tiles, cnts);
    const bf16_t* XN = (const bf16_t*)(ws + WS_BUFA); bf16_t* HM = (bf16_t*)(ws + WS_GT + GT_HM); const int* list = (const int*)(ws + WS_GT + GT_LIST);
    const int nt_total = tiles[32];
    for (int u = blockIdx.x; u < nt_total * 4; u += gridDim.x) {
        const int mtg = u >> 2, nt = u & 3;
        int e = 0;
        for (int k = 1; k < 32; ++k) if (tiles[k] <= mtg) e = k;
        const int mt = mtg - tiles[e], n_e = cnts[e];
        const int* le = list + (size_t)e * MOE_CAP;
        const bf16_t* W = (const bf16_t*)(ws + WS_EXPW + (size_t)e * SZ_WGU);
        gemm_tile<2, 0>(c, 1024,
            [&](int i) { int p = mt * 128 + i; if (p >= n_e) p = n_e - 1; return XN + (size_t)(le[p] >> 1) * D; },
            [&](int i) { return W + (size_t)(nt * 256 + i) * D; }, NoHook(),
            [&](f32x4 (&acc)[4][4], int wr, int wc, int fr, int fq) {
#pragma unroll
                for (int np = 0; np < 2; ++np) {
                    const int hc = (nt * 256 + wc + np * 32) / 2 + fq * 4;
#pragma unroll
                    for (int m = 0; m < 4; ++m) {
                        const int p = mt * 128 + wr + m * 16 + fr;
                        const f32x4 g = acc[m][np * 2], uu = acc[m][np * 2 + 1];
                        *(u32x2*)(HM + ((size_t)mtg * 128 + wr + m * 16 + fr) * 512 + hc) = pack4(siluf_(g[0]) * uu[0], siluf_(g[1]) * uu[1], siluf_(g[2]) * uu[2], siluf_(g[3]) * uu[3]);
                        (void)p;
                    }
                }
            });
    }
}
DI void phase_moe2(const Ctx& c, int l) {
    unsigned char* ws = c.ws;
    int* tiles = (int*)(c.smem + 120 * 1024); int* cnts = tiles + 40;
    moe_prefix(c, l, tiles, cnts);
    const bf16_t* HM = (const bf16_t*)(ws + WS_GT + GT_HM); const int* list = (const int*)(ws + WS_GT + GT_LIST); const float* lw = (const float*)(ws + WS_GT + GT_LW);
    bf16_t* Y2 = (bf16_t*)(ws + WS_P);
    const int nt_total = tiles[32];
    for (int u = blockIdx.x; u < nt_total * 4; u += gridDim.x) {
        const int mtg = u >> 2, nt = u & 3;
        int e = 0;
        for (int k = 1; k < 32; ++k) if (tiles[k] <= mtg) e = k;
        const int mt = mtg - tiles[e], n_e = cnts[e];
        const int* le = list + (size_t)e * MOE_CAP; const float* lwe = lw + (size_t)e * MOE_CAP;
        const bf16_t* W = (const bf16_t*)(ws + WS_EXPW + 32 * SZ_WGU + (size_t)e * SZ_WD);
        gemm_tile<2, 0>(c, 512,
            [&](int i) { return HM + ((size_t)mtg * 128 + i) * 512; },
            [&](int i) { return W + (size_t)(nt * 256 + i) * 512; }, NoHook(),
            [&](f32x4 (&acc)[4][4], int wr, int wc, int fr, int fq) {
#pragma unroll
                for (int m = 0; m < 4; ++m) {
                    const int p = mt * 128 + wr + m * 16 + fr;
                    if (p < n_e) {
                        const int ent = le[p]; const float wt = lwe[p];
                        bf16_t* yrow = Y2 + ((size_t)(ent & 1) * NZ + (ent >> 1)) * D + nt * 256 + wc + fq * 4;
#pragma unroll
                        for (int n = 0; n < 4; ++n) *(u32x2*)(yrow + n * 16) = pack4(wt * acc[m][n][0], wt * acc[m][n][1], wt * acc[m][n][2], wt * acc[m][n][3]);
                    }
                }
            });
    }
}

constexpr int LDS_BYTES = 128 * 1024 + 256;
constexpr int STEPS_PER_LAYER = 12, N_STEPS = 2 + NL * STEPS_PER_LAYER;
#ifndef FUSED
#define FUSED 1
#endif

DI const void* launder_ptr(const void* p) {
    const unsigned long long v = (unsigned long long)p;
    unsigned lo = __builtin_amdgcn_readfirstlane((unsigned)v), hi = __builtin_amdgcn_readfirstlane((unsigned)(v >> 32));
    asm volatile("" : "+s"(lo), "+s"(hi) :: "memory");
    return (const void*)(((unsigned long long)hi << 32) | lo);
}
template <int KIND> DI void run_step(const Ctx& c0, int l) {
#ifdef PHM
    if (!((PHM >> KIND) & 1)) return;
#endif
    Ctx c = c0;
    { int z = 0; asm volatile("" : "+s"(z) :: "memory"); c.in = c0.in + z; c.ws = c0.ws + z; c.out = c0.out + z; }
    { int t = c0.tid; asm volatile("" : "+v"(t)); c.tid = t; c.lane = t & 63; c.wave = __builtin_amdgcn_readfirstlane(t >> 6); }
    if (KIND == 0) phase_prologue(c);
    if (KIND == 1) phase_norm1(c, l);
    if (KIND == 2) phase_inproj(c, l);
    if (KIND == 3) { phase_prep(c, l); for (int u = blockIdx.x; u < 2 * S5N * 4; u += gridDim.x) phase_s5_final_unit<true>(c, l, u); }
    if (KIND == 4) { phase_small_gemms(c, l); phase_s5_carry(c, l); }
    if (KIND == 5) { phase_attention(c, l); phase_rwkv_chunks(c, l); }
    if (KIND == 6) phase_mixers2(c, l);
    if (KIND == 7) phase_post(c, l);
    if (KIND == 8) phase_merge1(c, l);
    if (KIND == 9) phase_merge2(c, l);
    if (KIND == 10) phase_norm2_route(c, l);
    if (KIND == 11) phase_moe1(c, l);
    if (KIND == 12) phase_moe2(c, l);
    if (KIND == 13) phase_final(c);
}

#if !FUSED
template <int KIND> __global__ void __launch_bounds__(NTHR, 2) k_step(Args a) {
    extern __shared__ __attribute__((aligned(16))) unsigned char lds[];
    Ctx c; c.in = a.in; c.out = a.out; c.ws = a.ws; c.smem = lds; c.tid = threadIdx.x; c.lane = threadIdx.x & 63; c.wave = __builtin_amdgcn_readfirstlane(threadIdx.x >> 6);
    run_step<KIND>(c, a.s_lo);
}
template <int KIND> static void launch_step(const Args& a, int grid, hipStream_t stream) {
    static bool attr = false;
    if (!attr) { (void)hipFuncSetAttribute((const void*)k_step<KIND>, hipFuncAttributeMaxDynamicSharedMemorySize, LDS_BYTES); attr = true; }
    hipLaunchKernelGGL(k_step<KIND>, dim3(grid), dim3(NTHR), LDS_BYTES, stream, a);
}
#else
__global__ void __launch_bounds__(NTHR, 2) fwd_kernel(Args a) {
    extern __shared__ __attribute__((aligned(16))) unsigned char lds[];
    Ctx c; c.in = a.in; c.out = a.out; c.ws = a.ws; c.smem = lds; c.tid = threadIdx.x; c.lane = threadIdx.x & 63; c.wave = __builtin_amdgcn_readfirstlane(threadIdx.x >> 6);
    volatile LAS unsigned* xbw = (volatile LAS unsigned*)(lds + LDS_BYTES - 16);
    for (int i = threadIdx.x; i < LDS_BYTES / 16; i += NTHR) ((uint4*)lds)[i] = make_uint4(0u, 0u, 0u, 0u);
    __syncthreads();
    if (threadIdx.x == 0) { xbw[0] = 0u; xbw[1] = 0u; }
    __syncthreads();
    XcdBarrier bar = xcd_barrier_post((unsigned*)(a.ws + WS_CTL) + CW_BAR, xbw);
#ifndef REP_MASK
#define REP_MASK 0
#endif
#define GBAR() do { XcdBarrier bb = bar; int zz = 0; asm volatile("" : "+s"(zz) :: "memory"); bb.bar = bar.bar + zz; xcd_barrier(bb); } while (0)
#define STEP(K, L) do { run_step<K>(c, L); GBAR(); if ((REP_MASK >> K) & 1) { run_step<K>(c, L); GBAR(); } } while (0)
    STEP(0, 0);
    for (int l = 0; l < NL; ++l) {
        STEP(1, l); STEP(2, l); STEP(3, l); STEP(4, l); STEP(5, l); STEP(6, l); STEP(7, l); STEP(8, l); STEP(9, l); STEP(10, l); STEP(11, l); STEP(12, l);
    }
#undef STEP
    run_step<13>(c, 0);
}
#endif

extern "C" void kernel_launch(void* const* d_in, const int* in_sizes, int n_in, void* d_out, int out_size, void* d_ws, size_t ws_size, hipStream_t stream) {
    static int grid = 0;
    if (grid == 0) {
        if (n_in != 49 || out_size != NB * SEQ * D || ws_size < WS_END) { fprintf(stderr, "kernel_launch: unexpected problem (n_in %d out %d ws %zu need %zu)\n", n_in, out_size, ws_size, (size_t)WS_END); grid = -1; return; }
        int dev = 0, cus = 0;
        if (hipGetDevice(&dev) != hipSuccess || hipDeviceGetAttribute(&cus, hipDeviceAttributeMultiprocessorCount, dev) != hipSuccess) { grid = -1; return; }
#if FUSED
        int per_cu = 0;
        if (hipFuncSetAttribute((const void*)fwd_kernel, hipFuncAttributeMaxDynamicSharedMemorySize, LDS_BYTES) != hipSuccess) { fprintf(stderr, "kernel_launch: hipFuncSetAttribute failed\n"); grid = -1; return; }
        if (hipOccupancyMaxActiveBlocksPerMultiprocessor(&per_cu, (const void*)fwd_kernel, NTHR, LDS_BYTES) != hipSuccess || per_cu < 1) { fprintf(stderr, "kernel_launch: occupancy query says %d\n", per_cu); }
        (void)hipGetLastError();
#endif
        grid = cus;
    }
    if (grid < 0) return;
    (void)hipMemsetAsync((char*)d_ws + WS_CTL, 0, CTL_BYTES, stream);
    Args a{};
    for (int i = 0; i < 49; ++i) a.in[i] = (const float*)d_in[i];
    a.out = (float*)d_out; a.ws = (unsigned char*)d_ws;
#if !FUSED
    a.s_lo = 0; a.s_hi = 0; launch_step<0>(a, grid, stream);
    for (int l = 0; l < NL; ++l) {
        a.s_lo = l;
        launch_step<1>(a, grid, stream); launch_step<2>(a, grid, stream); launch_step<3>(a, grid, stream); launch_step<4>(a, grid, stream);
        launch_step<5>(a, grid, stream); launch_step<6>(a, grid, stream); launch_step<7>(a, grid, stream); launch_step<8>(a, grid, stream);
        launch_step<9>(a, grid, stream); launch_step<10>(a, grid, stream); launch_step<11>(a, grid, stream); launch_step<12>(a, grid, stream);
    }
    a.s_lo = 0; launch_step<13>(a, grid, stream);
#else
    a.s_lo = 0; a.s_hi = N_STEPS; hipLaunchKernelGGL(fwd_kernel, dim3(grid), dim3(NTHR), LDS_BYTES, stream, a);
#endif
}
```

```cpp
#include <hip/hip_runtime.h>
#include <stdint.h>
#include <stdio.h>

#define DI __device__ __forceinline__
#define LAS __attribute__((address_space(3)))
typedef unsigned short bf16_t;
typedef short bf16x8 __attribute__((ext_vector_type(8)));
typedef short s16x4 __attribute__((ext_vector_type(4)));
typedef float f32x4 __attribute__((ext_vector_type(4)));
typedef float f32x16 __attribute__((ext_vector_type(16)));
typedef float f32x2 __attribute__((ext_vector_type(2)));
typedef __bf16 bf16x2v __attribute__((ext_vector_type(2)));
typedef unsigned u32x4 __attribute__((ext_vector_type(4)));
typedef unsigned u32x2 __attribute__((ext_vector_type(2)));

constexpr int D = 1024, NB = 2, SEQ = 8192, CTX = 256, TZ = 8448, NZ = 16896, NL = 2;
constexpr int NIN = 6560, NINP = 6656;
constexpr int NTHR = 512;
constexpr float LOG2E = 1.4426950408889634f;

#define XB_TMO      128
#define XB_XCNT(j)  (256  + 64 * (j))
#define XB_XSUB(j)  (1280 + 64 * (j))
#define XB_XGEN(j)  (2304 + 64 * (j))
#define XB_TOP      3328
#define XB_TOPGEN   3392
#define XCD_BAR_WORDS 3456
#define XB_SPIN_CAP (1u << 18)

__device__ __forceinline__ unsigned xb_ld(unsigned* p)              { return __hip_atomic_load(p, __ATOMIC_RELAXED, __HIP_MEMORY_SCOPE_AGENT); }
__device__ __forceinline__ unsigned xb_add(unsigned* p, unsigned v) { return __hip_atomic_fetch_add(p, v, __ATOMIC_RELAXED, __HIP_MEMORY_SCOPE_AGENT); }
__device__ __forceinline__ unsigned xb_xcc_id() { return (unsigned)__builtin_amdgcn_s_getreg((3 << 11) | 20) & 0xFu; }
#define XB_SPIN(cond, bar) do { unsigned _sp = 0; while (cond) { __builtin_amdgcn_s_sleep(1); \
    if ((++_sp & 255u) == 0u) { if (xb_ld(&(bar)[XB_TMO])) break; if (_sp > XB_SPIN_CAP) { atomicAdd(&(bar)[XB_TMO], 1u); break; } } } } while (0)

struct XcdBarrier { unsigned* bar; unsigned x; volatile LAS unsigned* st; };

__device__ __forceinline__ XcdBarrier xcd_barrier_post(unsigned* bar, volatile LAS unsigned* st) {
    XcdBarrier b; b.bar = bar; b.x = xb_xcc_id(); b.st = st;
    if (threadIdx.x == 0) (void)xb_add(&bar[XB_XCNT(b.x)], 1u);
    return b;
}
__device__ __forceinline__ void xcd_barrier_complete(unsigned* bar, unsigned x, unsigned& nloc, unsigned& nx) {
    const unsigned G = gridDim.x * gridDim.y * gridDim.z;
    unsigned sum, cnt, mine, sp = 0u;
    for (;;) {
        sum = 0u; cnt = 0u; mine = 0u;
#pragma unroll
        for (unsigned j = 0; j < 16; ++j) { const unsigned c = xb_ld(&bar[XB_XCNT(j)]); sum += c; cnt += (c > 0u) ? 1u : 0u; mine = (j == x) ? c : mine; }
        if (sum == G) break;
        __builtin_amdgcn_s_sleep(1);
        if ((++sp & 255u) == 0u) { if (xb_ld(&bar[XB_TMO])) break; if (sp > XB_SPIN_CAP) { atomicAdd(&bar[XB_TMO], 1u); break; } }
    }
    nloc = mine > 0u ? mine : 1u; nx = cnt > 0u ? cnt : 1u;
}
__device__ __forceinline__ void xcd_barrier(const XcdBarrier& b) {
    asm volatile("s_waitcnt vmcnt(0)" ::: "memory");
    __syncthreads();
    if (threadIdx.x == 0) {
        unsigned* bar = b.bar;
        __builtin_amdgcn_s_waitcnt(0);
        unsigned nloc = b.st[0], nx = b.st[1];
        if (nloc == 0u) { xcd_barrier_complete(bar, b.x, nloc, nx); b.st[0] = nloc; b.st[1] = nx; }
        const unsigned old = xb_add(&bar[XB_XSUB(b.x)], 1u);
        const unsigned gen = old / nloc;
        if (old + 1u == (gen + 1u) * nloc) {
            __builtin_amdgcn_fence(__ATOMIC_RELEASE, "agent");
            asm volatile("s_waitcnt vmcnt(0)" ::: "memory");
            const unsigned og = xb_add(&bar[XB_TOP], 1u);
            const unsigned tg = og / nx;
            if (og + 1u == (tg + 1u) * nx) xb_add(&bar[XB_TOPGEN], 1u);
            else XB_SPIN(xb_ld(&bar[XB_TOPGEN]) == tg, bar);
            __builtin_amdgcn_fence(__ATOMIC_ACQUIRE, "agent");
            xb_add(&bar[XB_XGEN(b.x)], 1u);
            asm volatile("s_waitcnt vmcnt(0)" ::: "memory");
        } else {
            XB_SPIN(xb_ld(&bar[XB_XGEN(b.x)]) == gen, bar);
            __builtin_amdgcn_fence(__ATOMIC_ACQUIRE, "agent");
            asm volatile("s_waitcnt vmcnt(0)" ::: "memory");
        }
    }
    __syncthreads();
}

DI float bf2f(bf16_t v) { return __uint_as_float((unsigned)v << 16); }
DI unsigned pack2(float a, float b) { f32x2 v = {a, b}; bf16x2v r = __builtin_convertvector(v, bf16x2v); return __builtin_bit_cast(unsigned, r); }
DI bf16_t f2bf(float a) { return (bf16_t)(pack2(a, 0.f) & 0xffffu); }
DI float lo2f(unsigned u) { return __uint_as_float(u << 16); }
DI float hi2f(unsigned u) { return __uint_as_float(u & 0xffff0000u); }
DI float wave_sum(float v) {
#pragma unroll
    for (int m = 32; m >= 1; m >>= 1) v += __shfl_xor(v, m, 64);
    return v;
}
DI float sum16(float v) {
#pragma unroll
    for (int m = 8; m >= 1; m >>= 1) v += __shfl_xor(v, m, 64);
    return v;
}
DI float sigmoidf_(float x) { return __builtin_amdgcn_rcpf(1.f + __expf(-x)); }
DI float siluf_(float x) { return x * __builtin_amdgcn_rcpf(1.f + __expf(-x)); }
DI float gelu_tanh(float x) { const float u = 0.7978845608028654f * (x + 0.044715f * x * x * x); return x * __builtin_amdgcn_rcpf(1.f + __expf(-2.f * u)); }
DI float tanhf_(float x) { return 2.f * __builtin_amdgcn_rcpf(1.f + __expf(-2.f * x)) - 1.f; }
DI void unpack4(u32x2 u, float (&f)[4]) { f[0] = lo2f(u.x); f[1] = hi2f(u.x); f[2] = lo2f(u.y); f[3] = hi2f(u.y); }
DI u32x2 pack4(float a, float b, float c, float d) { u32x2 r; r.x = pack2(a, b); r.y = pack2(c, d); return r; }

constexpr size_t algn(size_t x) { return (x + 255) & ~(size_t)255; }
constexpr size_t WS_CTL   = 0;
constexpr size_t CTL_BYTES = 64 * 1024;
constexpr size_t WS_H     = WS_CTL + CTL_BYTES;
constexpr size_t WS_WSM   = WS_H + (size_t)NZ * D * 4;
constexpr size_t SZ_WINT = (size_t)NINP * D * 2, SZ_WUQT = 384 * 256 * 2, SZ_WUKVT = 512 * 128 * 2, SZ_W2T = 512 * 64 * 2, SZ_A2T = 512 * 64 * 2,
                 SZ_G2T = 256 * 128 * 2, SZ_GLUT = 256 * 256 * 2, SZ_WBT = (size_t)D * D * 2, SZ_WOUTT = (size_t)D * D * 2;
constexpr size_t OFF_WINT = 0, OFF_WUQT = OFF_WINT + NL * SZ_WINT, OFF_WUKVT = OFF_WUQT + NL * SZ_WUQT, OFF_W2T = OFF_WUKVT + NL * SZ_WUKVT,
                 OFF_A2T = OFF_W2T + NL * SZ_W2T, OFF_G2T = OFF_A2T + NL * SZ_A2T, OFF_GLUT = OFF_G2T + NL * SZ_G2T, OFF_WBT = OFF_GLUT + NL * SZ_GLUT,
                 OFF_WOUTT = OFF_WBT + NL * SZ_WBT, OFF_MODV = OFF_WOUTT + NL * SZ_WOUTT,
                 OFF_ROPE = OFF_MODV + (size_t)NL * 3 * 6144 * 4,
                 OFF_S5T = OFF_ROPE + (size_t)SEQ * 16 * 2 * 4,
                 OFF_RWT = OFF_S5T + (size_t)NL * 2 * 16 * 64 * 36 * 4,
                 OFF_LAM = OFF_RWT + (size_t)NL * 36 * 1024 * 4,
                 OFF_S5E = OFF_LAM + 256,
                 OFF_S5C = OFF_S5E,
                 WSM_BYTES = algn(OFF_S5E + (size_t)2 * 2 * 16 * 132 * 64 * 2 * 4);
constexpr size_t WS_EXPW  = WS_WSM + WSM_BYTES;
constexpr size_t SZ_WGU = (size_t)1024 * 1024 * 2, SZ_WD = (size_t)1024 * 512 * 2;
constexpr size_t EXPW_BYTES = 32 * (SZ_WGU + SZ_WD);
constexpr size_t SZ_QM = (size_t)NB * 4 * TZ * 96 * 2, SZ_VMT = (size_t)NB * 4 * 64 * TZ * 2, SZ_QD = (size_t)NB * 4 * TZ * 64 * 2, SZ_R256 = (size_t)NZ * 256 * 2;
constexpr size_t MX_QM = 0, MX_KM = MX_QM + SZ_QM, MX_VMT = MX_KM + SZ_QM, MX_QD = MX_VMT + SZ_VMT, MX_KD = MX_QD + SZ_QD, MX_VDT = MX_KD + SZ_QD,
                 MX_RB = MX_VDT + SZ_VMT, MX_KB = MX_RB + SZ_R256, MX_VB = MX_KB + SZ_R256, MX_KKB = MX_VB + SZ_R256, MX_END = MX_KKB + SZ_R256;
static_assert(MX_END <= EXPW_BYTES, "mixer operands must fit the expert-weight region");
constexpr size_t WS_BUFA  = WS_EXPW + EXPW_BYTES;
constexpr size_t WS_BUFB  = WS_BUFA + (size_t)NZ * D * 2;
constexpr size_t WS_P     = WS_BUFB + (size_t)NZ * D * 2;
constexpr size_t P_PM = 0, P_PS = P_PM + (size_t)NZ * 416 * 2, P_PR = P_PS + (size_t)NZ * 256 * 2, P_PD = P_PR + (size_t)NZ * 1024 * 2, P_BYTES = P_PD + (size_t)NZ * 768 * 2;
static_assert((size_t)6 * SZ_R256 <= (size_t)NZ * (1024 + 768) * 2, "scan operands must fit PR|PD");
static_assert((size_t)2 * NZ * D * 2 <= P_BYTES, "the MoE outputs (2 x bf16 [NZ][D]) must fit the P region");
constexpr size_t WS_GT    = WS_P + P_BYTES;
constexpr size_t GT_BYTES = (size_t)NZ * 4096 * 2;
constexpr int MOE_CAP = 33792;
constexpr size_t GT_HM = 0, GT_LIST = GT_HM + (size_t)(33792 + 32 * 128) * 512 * 2, GT_LW = GT_LIST + (size_t)32 * MOE_CAP * 4, GT_END = GT_LW + (size_t)32 * MOE_CAP * 4;
static_assert(GT_END <= GT_BYTES, "MoE scratch must fit the gate region");
constexpr size_t WS_MISC  = WS_GT + GT_BYTES;
constexpr size_t MS_CQN = 0, MS_TW = MS_CQN + (size_t)NZ * 384 * 2, MS_AL = MS_TW + (size_t)NZ * 64 * 2, MS_SG = MS_AL + (size_t)NZ * 64 * 2,
                 MS_GG = MS_SG + (size_t)NZ * 128 * 2, MS_ZG = MS_GG + SZ_R256, MS_END = MS_ZG + SZ_R256;
constexpr size_t WS_RW    = WS_MISC + MS_END;
constexpr int RC = 64, RNC = TZ / RC;
constexpr size_t SZ_RWM = (size_t)16 * RNC * 4096 * 2;
constexpr size_t RW_M3 = 0, RW_M2 = SZ_RWM, RW_Z5 = 2 * SZ_RWM, RW_P63 = 3 * SZ_RWM, RW_END = RW_P63 + (size_t)16 * RNC * 64 * 4;
constexpr size_t WS_END   = WS_RW + RW_END;

constexpr int CW_BAR = 0;
constexpr int CW_CNT = 4096;

struct Args { const float* in[49]; float* out; unsigned char* ws; int s_lo, s_hi; };

struct Ctx {
    const float* const* in; float* out; unsigned char* ws; unsigned char* smem; int tid, lane, wave;
};

template <int WM> struct GCfg { static constexpr int WN = 8 / WM, BM = 64 * WM, BN = 64 * WN, ABYTES = BM * 128, BBYTES = BN * 128, STAGE = ABYTES + BBYTES; };

template <int WM, int SEGK, class ARow, class BRow, class Hook, class Epi>
DI void gemm_tile(const Ctx& c, int K, ARow arow, BRow brow, Hook hook, Epi epi) {
    typedef GCfg<WM> G;
    const int tid = c.tid, lane = c.lane, wave = c.wave;
    const int wm = wave / G::WN, wn = wave % G::WN, fr = lane & 15, fq = lane >> 4;
    unsigned char* smem = c.smem;
    constexpr int NA = G::BM / 64, NBq = G::BN / 64;
    const int r0 = tid >> 3, coff = ((tid & 7) ^ (r0 & 7)) * 8;
    const bf16_t* asrc[NA];
#pragma unroll
    for (int i = 0; i < NA; ++i) asrc[i] = arow(r0 + 64 * i) + coff;
    auto stage = [&](int kt, int buf) {
        unsigned char* sa = smem + buf * G::STAGE; unsigned char* sb = sa + G::ABYTES;
#pragma unroll
        for (int i = 0; i < NA; ++i) __builtin_amdgcn_global_load_lds((const unsigned*)(asrc[i] + kt * 64), (unsigned*)(sa + (tid + i * NTHR) * 16), 16, 0, 0);
#pragma unroll
        for (int i = 0; i < NBq; ++i) __builtin_amdgcn_global_load_lds((const unsigned*)(brow(r0 + 64 * i) + coff + kt * 64), (unsigned*)(sb + (tid + i * NTHR) * 16), 16, 0, 0);
    };
    f32x4 acc[4][4];
#pragma unroll
    for (int m = 0; m < 4; ++m)
#pragma unroll
        for (int n = 0; n < 4; ++n) acc[m][n] = (f32x4){0.f, 0.f, 0.f, 0.f};
    const int T = K / 64;
    __syncthreads();
    stage(0, 0);
    for (int t = 0; t < T; ++t) {
        asm volatile("s_waitcnt vmcnt(0)" ::: "memory");
        __syncthreads();
        if (t + 1 < T) stage(t + 1, (t + 1) & 1);
        const unsigned char* sa = smem + (t & 1) * G::STAGE; const unsigned char* sb = sa + G::ABYTES;
#pragma unroll
        for (int ks = 0; ks < 2; ++ks) {
            bf16x8 af[4], bfr[4];
            const int sl = ((ks * 4 + fq) ^ (fr & 7)) * 16;
#pragma unroll
            for (int m = 0; m < 4; ++m) af[m] = *(const bf16x8*)(sa + (wm * 64 + m * 16 + fr) * 128 + sl);
#pragma unroll
            for (int n = 0; n < 4; ++n) bfr[n] = *(const bf16x8*)(sb + (wn * 64 + n * 16 + fr) * 128 + sl);
#pragma unroll
            for (int m = 0; m < 4; ++m)
#pragma unroll
                for (int n = 0; n < 4; ++n) acc[m][n] = __builtin_amdgcn_mfma_f32_16x16x32_bf16(bfr[n], af[m], acc[m][n], 0, 0, 0);
        }
        if (SEGK > 0) { if (((t + 1) * 64) % (SEGK > 0 ? SEGK : 64) == 0) hook(acc, ((t + 1) * 64) / (SEGK > 0 ? SEGK : 64) - 1, wm * 64, wn * 64, fr, fq); }
    }
    epi(acc, wm * 64, wn * 64, fr, fq);
}
struct NoHook { DI void operator()(f32x4 (&)[4][4], int, int, int, int, int) const {} };

#ifndef INPROJ_WGM
#define INPROJ_WGM 4
#define MERGE2_WGM 8
#endif
namespace pg8 {
#define PG8_LAS __attribute__((address_space(3)))
typedef unsigned short bf16_t;
typedef short bf16x8 __attribute__((ext_vector_type(8)));
typedef float f32x4 __attribute__((ext_vector_type(4)));
constexpr int BM = 256, BK = 64, HALF = 128, HTB = HALF * BK * 2  , STAGE_BYTES = 8 * HTB, NXCD = 8, WGM = 4;

__host__ __device__ __forceinline__ int lds_byte(int r, int c) { const int st = (r >> 4) * 2 + (c >> 5), rr = r & 15, cc = c & 31, ob = rr * 64 + cc * 2; return st * 1024 + (ob ^ (((ob >> 9) & 1) << 5)); }
__host__ __device__ __forceinline__ void stage_rc(int b, int& R, int& C) { const int st = b / 1024, sb = b % 1024, swz = sb ^ (((sb >> 9) & 1) << 5); R = (st >> 1) * 16 + swz / 64; C = (st & 1) * 32 + (swz % 64) / 2; }
__host__ __device__ __forceinline__ int perm32(int rho) { const int n = rho >> 4, i = rho & 15; return 8 * (i >> 2) + 4 * n + (i & 3); }

struct Unit { int pm, pn; };
struct Gemm { const bf16_t* A; const bf16_t* Bt; int M, N, K, lda, ldb; };

struct StaticOrder {
    int nM, nN, nwg, G, c, wgm;
    __host__ __device__ void init(int M, int N, int G_, int c_, int wgm_ = WGM) { nM = M / BM; nN = N / BM; nwg = nM * nN; G = G_; c = c_; wgm = wgm_; }
    __host__ __device__ bool next(int i, Unit& u) const {
        const long L = (long)i * G + c; if (L >= nwg) return false;
        int wgid = (int)L; { const int q = nwg / NXCD, r = nwg % NXCD, xcd = wgid % NXCD, off = wgid / NXCD; wgid = (xcd < r ? xcd * (q + 1) : r * (q + 1) + (xcd - r) * q) + off; }
        const int nig = wgm * nN, gid = wgid / nig, fm = gid * wgm, gsz = (nM - fm) < wgm ? (nM - fm) : wgm;
        u.pm = fm + ((wgid % nig) % gsz); u.pn = (wgid % nig) / gsz; return true;
    }
    __device__ __forceinline__ void a_ready(const Unit&) const {}
    __device__ __forceinline__ void done(const Unit&) const {}
};
template <class Epi, class Sched, bool STAMP = false>
__device__ __forceinline__ void gemm_phase(PG8_LAS unsigned char* lds, const Gemm g, const Sched& S, const Epi& E, unsigned long long* stamps, int tid_in) {
    const int tid = tid_in, wid = __builtin_amdgcn_readfirstlane(tid >> 6), lane = tid & 63, wr = wid >> 2, wc = wid & 3, fr = lane & 15, fq = lane >> 4;
    const int K = g.K, nt = K / BK;
    int ts_lo = 0, ts_hi = 0, nts = 0; const unsigned long long rt_entry = STAMP ? (unsigned long long)wall_clock64() : 0ull;
#define PG8_STAMP() do { if (STAMP && wid == 0 && nts < 64) { const unsigned long long _c = (unsigned long long)clock64(); \
        ts_lo = (lane == nts) ? (int)(unsigned)_c : ts_lo; ts_hi = (lane == nts) ? (int)(unsigned)(_c >> 32) : ts_hi; ++nts; } } while (0)
    PG8_STAMP();
    unsigned voffA[2], voffB[2];
#pragma unroll
    for (int i = 0; i < 2; ++i) { int R, C; stage_rc(tid * 16 + i * 8192, R, C); const int Rb = Epi::PERM ? ((R & ~31) + perm32(R & 31)) : R;
        voffA[i] = (unsigned)(R * g.lda + C) * 2u; voffB[i] = (unsigned)(Rb * g.ldb + C) * 2u; }
    const size_t kstep = (size_t)(BK * 2);
    const size_t hstepA = (size_t)HALF * g.lda * 2, hstepB = (size_t)HALF * g.ldb * 2;
    const size_t tstepA = 2 * hstepA, tstepB = 2 * hstepB;
    const unsigned ldsw = (unsigned)wid * 1024u;
    const int aoff = lds_byte(wr * 64 + fr, fq * 8), boff = lds_byte(wc * 32 + fr, fq * 8);
#define PG8_SA(b, h) (((b) * 2 + (h)) * HTB)
#define PG8_SB(b, h) ((4 + (b) * 2 + (h)) * HTB)
#define PG8_STAGE(bufoff, gbase, voff) do { _Pragma("unroll") for (int _i = 0; _i < 2; ++_i) \
        __builtin_amdgcn_global_load_lds((const unsigned*)((const char*)(gbase) + (voff)[_i]), (PG8_LAS unsigned*)(lds + (bufoff) + ldsw + _i * 8192), 16, 0, 0); } while (0)
#define PG8_LDA(dst, b, h) do { _Pragma("unroll") for (int m = 0; m < 4; ++m) _Pragma("unroll") for (int k = 0; k < 2; ++k) dst[m][k] = *(const PG8_LAS bf16x8*)(lds + PG8_SA(b, h) + aoff + m * 2048 + k * 1024); } while (0)
#define PG8_LDB(dst, b, h) do { _Pragma("unroll") for (int n = 0; n < 2; ++n) _Pragma("unroll") for (int k = 0; k < 2; ++k) dst[n][k] = *(const PG8_LAS bf16x8*)(lds + PG8_SB(b, h) + boff + n * 2048 + k * 1024); } while (0)
#define PG8_MMA(ai, bj, At, Bt) do { __builtin_amdgcn_s_setprio(1); _Pragma("unroll") for (int m = 0; m < 4; ++m) _Pragma("unroll") for (int n = 0; n < 2; ++n) _Pragma("unroll") for (int k = 0; k < 2; ++k) \
        acc[ai][bj][m][n] = __builtin_amdgcn_mfma_f32_16x16x32_bf16(Bt[n][k], At[m][k], acc[ai][bj][m][n], 0, 0, 0); __builtin_amdgcn_s_setprio(0); } while (0)
#define PG8_WAIT_V(n) asm volatile("s_waitcnt vmcnt(" #n ")" ::: "memory")
#define PG8_WAIT_L(n) asm volatile("s_waitcnt lgkmcnt(" #n ")" ::: "memory")
#define PG8_BAR __builtin_amdgcn_s_barrier()
#define PG8_SCHED __builtin_amdgcn_sched_barrier(0)
    Unit cur, nxt; int ui = 0;
    if (!S.next(0, cur)) return;
    f32x4 acc[2][2][4][2];
#pragma unroll
    for (int a = 0; a < 2; ++a)
#pragma unroll
        for (int b = 0; b < 2; ++b)
#pragma unroll
            for (int m = 0; m < 4; ++m)
#pragma unroll
                for (int n = 0; n < 2; ++n) acc[a][b][m][n] = (f32x4){0.f, 0.f, 0.f, 0.f};
    bf16x8 At[4][2], B0[2][2], B1[2][2];
    const char* cA = (const char*)g.A + (size_t)cur.pm * tstepA; const char* cB = (const char*)g.Bt + (size_t)cur.pn * tstepB;
    S.a_ready(cur);
    PG8_STAGE(PG8_SB(0, 0), cB, voffB); PG8_STAGE(PG8_SA(0, 0), cA, voffA); PG8_STAGE(PG8_SB(0, 1), cB + hstepB, voffB); PG8_STAGE(PG8_SA(0, 1), cA + hstepA, voffA);
    if (wr == 1) PG8_BAR;
    PG8_WAIT_V(4); PG8_BAR;
    PG8_STAGE(PG8_SB(1, 0), cB + kstep, voffB); PG8_STAGE(PG8_SA(1, 0), cA + kstep, voffA); PG8_STAGE(PG8_SB(1, 1), cB + hstepB + kstep, voffB);
    PG8_WAIT_V(6); PG8_BAR;
    PG8_STAMP();
    for (;;) {
        const bool has_next = S.next(ui + 1, nxt);
        const char* nA = has_next ? (const char*)g.A + (size_t)nxt.pm * tstepA : cA; const char* nB = has_next ? (const char*)g.Bt + (size_t)nxt.pn * tstepB : cB;
        for (int t = 0; t < nt; t += 2) {
            const bool last = (t == nt - 2);
            const char* a1 = cA + (size_t)(t + 1) * kstep;
            const char* a2 = last ? nA : cA + (size_t)(t + 2) * kstep; const char* b2 = last ? nB : cB + (size_t)(t + 2) * kstep;
            const char* a3 = a2 + kstep; const char* b3 = b2 + kstep;
            if (last && has_next) S.a_ready(nxt);
            PG8_LDB(B0, 0, 0); PG8_SCHED; PG8_LDA(At, 0, 0); PG8_STAGE(PG8_SA(1, 1), a1 + hstepA, voffA);
            PG8_WAIT_L(8); PG8_BAR; PG8_WAIT_L(0); PG8_MMA(0, 0, At, B0); PG8_BAR; PG8_SCHED;
            PG8_LDB(B1, 0, 1); PG8_STAGE(PG8_SB(0, 0), b2, voffB);
            PG8_BAR; PG8_WAIT_L(0); PG8_MMA(0, 1, At, B1); PG8_BAR;
            PG8_LDA(At, 0, 1); PG8_STAGE(PG8_SA(0, 0), a2, voffA);
            PG8_BAR; PG8_WAIT_L(0); PG8_MMA(1, 0, At, B0); PG8_BAR; PG8_SCHED;
            PG8_STAGE(PG8_SB(0, 1), b2 + hstepB, voffB);
            PG8_WAIT_V(6); PG8_BAR; PG8_MMA(1, 1, At, B1); PG8_BAR;
            PG8_LDB(B0, 1, 0); PG8_SCHED; PG8_LDA(At, 1, 0); PG8_STAGE(PG8_SA(0, 1), a2 + hstepA, voffA);
            PG8_WAIT_L(8); PG8_BAR; PG8_WAIT_L(0); PG8_MMA(0, 0, At, B0); PG8_BAR; PG8_SCHED;
            PG8_LDB(B1, 1, 1); PG8_STAGE(PG8_SB(1, 0), b3, voffB);
            PG8_BAR; PG8_WAIT_L(0); PG8_MMA(0, 1, At, B1); PG8_BAR;
            PG8_LDA(At, 1, 1); PG8_STAGE(PG8_SA(1, 0), a3, voffA);
            PG8_BAR; PG8_WAIT_L(0); PG8_MMA(1, 0, At, B0); PG8_BAR; PG8_SCHED;
            PG8_STAGE(PG8_SB(1, 1), b3 + hstepB, voffB);
            PG8_WAIT_V(6); PG8_BAR; PG8_MMA(1, 1, At, B1); PG8_BAR;
        }
        PG8_STAMP();
        if constexpr (!Epi::AFTER_DRAIN) { E(acc, cur, wr, wc, fr, fq); S.done(cur); }
        PG8_STAMP();
        if (!has_next) break;
#pragma unroll
        for (int a = 0; a < 2; ++a)
#pragma unroll
            for (int b = 0; b < 2; ++b)
#pragma unroll
                for (int m = 0; m < 4; ++m)
#pragma unroll
                    for (int n = 0; n < 2; ++n) acc[a][b][m][n] = (f32x4){0.f, 0.f, 0.f, 0.f};
        cur = nxt; cA = nA; cB = nB; ++ui;
    }
    PG8_WAIT_V(0);
    if (wr == 0) PG8_BAR;
    PG8_BAR;
    if constexpr (Epi::AFTER_DRAIN) { E.fused(acc, cur, wr, wc, fr, fq, lds, wid, lane); S.done(cur); }
    PG8_STAMP();
    if (STAMP && wid == 0) { stamps[lane] = lane < nts ? (((unsigned long long)(unsigned)ts_hi << 32) | (unsigned)ts_lo) : 0ull;
        if (lane == 62) stamps[62] = rt_entry; if (lane == 63) stamps[63] = (unsigned long long)wall_clock64(); }
#undef PG8_STAMP
#undef PG8_SA
#undef PG8_SB
#undef PG8_STAGE
#undef PG8_LDA
#undef PG8_LDB
#undef PG8_MMA
#undef PG8_WAIT_V
#undef PG8_WAIT_L
#undef PG8_BAR
#undef PG8_SCHED
}
}

DI int rowmap(int n, int mode) { return mode == 0 ? n : ((n >> 4) * 32 + (n & 15) + (mode == 2 ? 16 : 0)); }
DI void tconv_tile(const Ctx& c, const float* src, int ld, int N, bf16_t* dst, int ld_dst, int mode, int tk, int tn) {
    bf16_t* T = (bf16_t*)c.smem;
    const int k0 = tk * 64, n0 = tn * 64, tid = c.tid;
    __syncthreads();
#pragma unroll
    for (int i = 0; i < 2; ++i) {
        const int kk = (tid >> 4) + i * 32, n4 = (tid & 15) * 4;
        float4 v = make_float4(0.f, 0.f, 0.f, 0.f);
        if (n0 + n4 < N) v = *(const float4*)(src + (size_t)(k0 + kk) * ld + n0 + n4);
        T[(n4 + 0) * 72 + kk] = f2bf(v.x); T[(n4 + 1) * 72 + kk] = f2bf(v.y); T[(n4 + 2) * 72 + kk] = f2bf(v.z); T[(n4 + 3) * 72 + kk] = f2bf(v.w);
    }
    __syncthreads();
    const int n = tid >> 3, k8 = (tid & 7) * 8;
    if (n0 + n < N) *(u32x4*)(dst + (size_t)rowmap(n0 + n, mode) * ld_dst + k0 + k8) = *(const u32x4*)(T + n * 72 + k8);
}
DI void tconv(const Ctx& c, const float* src, int ld, int K, int N, bf16_t* dst, int ld_dst, int mode, int rot) {
    const int ntk = K / 64, ntn = (N + 63) / 64, nt = ntk * ntn, G = gridDim.x;
    for (int t = (blockIdx.x + G - (rot % G)) % G; t < nt; t += G) tconv_tile(c, src, ld, N, dst, ld_dst, mode, t / ntn, t % ntn);
}

DI void wconv(const Ctx& c, const float* src, int ld, int K, int N, bf16_t* dst, int ld_dst, int rot) {
    const int ntk = K / 64, ntn = (N + 63) / 64, nt = ntk * ntn, GW = gridDim.x * 8, w0 = blockIdx.x * 8 + c.wave;
    for (int t = (w0 + GW - (rot % GW)) % GW; t < nt; t += GW) {
        const int tk = t / ntn, tn = t % ntn, n = tn * 64 + c.lane;
        if (n < N) {
            const float* sp = src + (size_t)(tk * 64) * ld + n; bf16_t* dp = dst + (size_t)n * ld_dst + tk * 64;
#pragma unroll
            for (int kb = 0; kb < 8; ++kb) {
                float v[8];
#pragma unroll
                for (int j = 0; j < 8; ++j) v[j] = sp[(size_t)(kb * 8 + j) * ld];
                u32x4 w4; w4.x = pack2(v[0], v[1]); w4.y = pack2(v[2], v[3]); w4.z = pack2(v[4], v[5]); w4.w = pack2(v[6], v[7]);
                *(u32x4*)(dp + kb * 8) = w4;
            }
        }
    }
}
DI void phase_prologue(const Ctx& c) {
    unsigned char* wsm = c.ws + WS_WSM;
    const int tid = c.tid, G = gridDim.x, gtid = blockIdx.x * NTHR + tid, gn = G * NTHR;
    {
        const float4* x = (const float4*)c.in[0]; const float4* cx = (const float4*)c.in[2]; float4* H = (float4*)(c.ws + WS_H);
        for (size_t i = gtid; i < (size_t)NZ * 256; i += gn) {
            const int z = (int)(i >> 8), q = (int)(i & 255), b = z / TZ, s = z % TZ;
            H[i] = (s < CTX) ? cx[((size_t)b * CTX + s) * 256 + q] : x[((size_t)b * SEQ + (s - CTX)) * 256 + q];
        }
    }
    {
        float* rope = (float*)(wsm + OFF_ROPE);
        for (int i = gtid; i < SEQ * 16; i += gn) {
            const int t = i >> 4, a = (i >> 3) & 1, f = i & 7;
            const float pos = (float)(a == 0 ? (t >> 6) : (t & 63));
            const float inv = powf(10000.f, -(float)f / 8.f);
            float sn, cs; sincosf(pos * inv, &sn, &cs);
            rope[i * 2] = cs; rope[i * 2 + 1] = sn;
        }
    }
    {
        float* s5t = (float*)(wsm + OFF_S5T);
        for (int i = blockIdx.x + tid * G; i < NL * 2 * 16 * 64; i += G * NTHR) {
            const int ldg = i >> 6;
            const double lr = c.in[24][i], li = c.in[25][i], dt = exp((double)c.in[26][ldg]);
            const double mag = exp(lr * dt), are = mag * cos(li * dt), aim = mag * sin(li * dt);
            const double m256 = exp(lr * dt * 64.0), a256r = m256 * cos(li * dt * 64.0), a256i = m256 * sin(li * dt * 64.0);
            const double den = lr * lr + li * li, nr = are - 1.0, ni = aim;
            const double cfr = (nr * lr + ni * li) / den, cfi = (ni * lr - nr * li) / den;
            float* o = s5t + (size_t)i * 36;
            o[0] = (float)are; o[1] = (float)aim; o[2] = (float)a256r; o[3] = (float)a256i;
            for (int ch = 0; ch < 16; ++ch) {
                const double br = c.in[27][(size_t)i * 16 + ch], bi = c.in[28][(size_t)i * 16 + ch];
                o[4 + ch] = (float)(cfr * br - cfi * bi); o[20 + ch] = (float)(cfr * bi + cfi * br);
            }
        }
    }
    {
        float* rwt = (float*)(wsm + OFF_RWT);
        for (int i = gtid; i < NL * 36 * 1024; i += gn) {
            const int l = i / (36 * 1024), e = (i / 1024) % 36, d = i & 1023;
            rwt[i] = e < 4 ? c.in[41][((size_t)l * 1024 + d) * 4 + e] : c.in[43][((size_t)l * 1024 + d) * 32 + (e - 4)];
        }
    }
    if (blockIdx.x == 0 && tid < NL) {
        float s1 = 0.f, s2 = 0.f;
        for (int i = 0; i < 32; ++i) { s1 += c.in[34][tid * 32 + i] * c.in[35][tid * 32 + i]; s2 += c.in[36][tid * 32 + i] * c.in[37][tid * 32 + i]; }
        ((float*)(wsm + OFF_LAM))[tid] = expf(s1) - expf(s2) + (0.8f - 0.6f * expf(-0.3f * (float)tid));
    }
    {
        float* sv = (float*)c.smem;
        float* red = sv + 3 * 1024;
        __syncthreads();
        for (int i = tid; i < 3 * 1024; i += NTHR) { const float v = i < 2048 ? c.in[1][i] : c.in[3][i - 2048]; sv[i] = siluf_(v); }
        __syncthreads();
        float* modv = (float*)(wsm + OFF_MODV);
        for (int u = blockIdx.x; u < NL * 96; u += G) {
            const int l = u / 96, col = (u % 96) * 64 + (tid & 63), ks = tid >> 6;
            const float* w = c.in[4] + (size_t)l * 1024 * 6144 + col;
            float a0 = 0.f, a1 = 0.f, a2 = 0.f;
            for (int k = ks * 128; k < ks * 128 + 128; ++k) { const float wv = w[(size_t)k * 6144]; a0 += sv[k] * wv; a1 += sv[1024 + k] * wv; a2 += sv[2048 + k] * wv; }
            red[(ks * 64 + (tid & 63)) * 3 + 0] = a0; red[(ks * 64 + (tid & 63)) * 3 + 1] = a1; red[(ks * 64 + (tid & 63)) * 3 + 2] = a2;
            __syncthreads();
            if (tid < 192) {
                const int cc = tid & 63, sel = tid >> 6; float s = 0.f;
                for (int k2 = 0; k2 < 8; ++k2) s += red[(k2 * 64 + cc) * 3 + sel];
                const int colo = (u % 96) * 64 + cc;
                modv[((size_t)l * 3 + sel) * 6144 + colo] = s + c.in[5][l * 6144 + colo];
            }
            __syncthreads();
        }
    }
    for (int l = 0; l < NL; ++l) {
        wconv(c, c.in[8] + (size_t)l * 1024 * NIN, NIN, 1024, NIN, (bf16_t*)(wsm + OFF_WINT + l * SZ_WINT), 1024, l * 700);
        tconv(c, c.in[11] + (size_t)l * 256 * 384, 384, 256, 384, (bf16_t*)(wsm + OFF_WUQT + l * SZ_WUQT), 256, 0, 40);
        tconv(c, c.in[12] + (size_t)l * 128 * 512, 512, 128, 512, (bf16_t*)(wsm + OFF_WUKVT + l * SZ_WUKVT), 128, 0, 70);
        for (int d = 0; d < 2; ++d) {
            tconv(c, c.in[15] + (size_t)(l * 2 + d) * 64 * 256, 256, 64, 256, (bf16_t*)(wsm + OFF_W2T + l * SZ_W2T) + d * 256 * 64, 64, 0, 90 + d * 8);
            tconv(c, c.in[17] + (size_t)(l * 2 + d) * 64 * 256, 256, 64, 256, (bf16_t*)(wsm + OFF_A2T + l * SZ_A2T) + d * 256 * 64, 64, 0, 110 + d * 8);
        }
        tconv(c, c.in[18] + (size_t)l * 128 * 256, 256, 128, 256, (bf16_t*)(wsm + OFF_G2T + l * SZ_G2T), 128, 0, 130);
        tconv(c, c.in[32] + (size_t)l * 256 * 256, 256, 256, 256, (bf16_t*)(wsm + OFF_GLUT + l * SZ_GLUT), 256, 0, 140);
        for (int n = 0; n < 4; ++n)
            wconv(c, c.in[39] + (size_t)(l * 4 + n) * 256 * 1024, 1024, 256, 1024, (bf16_t*)(wsm + OFF_WBT + l * SZ_WBT) + n * 256, 1024, 300 + n * 64 + l * 1000);
        wconv(c, c.in[40] + (size_t)l * 1024 * 1024, 1024, 1024, 1024, (bf16_t*)(wsm + OFF_WOUTT + l * SZ_WOUTT), 1024, 1200 + l * 400);
    }
}

DI void phase_expert_convert(const Ctx& c, int l) {
    const int G = gridDim.x, lane = c.lane;
    for (int t = blockIdx.x * 8 + c.wave; t < 32 * 384; t += G * 8) {
        const int e = t / 384, r = t % 384;
        const float* src; bf16_t* dst; int ld, ldd, mode, tk, tn;
        if (r < 128)      { src = c.in[45] + ((size_t)l * 32 + e) * 1024 * 512; dst = (bf16_t*)(c.ws + WS_EXPW + (size_t)e * SZ_WGU); ld = 512; ldd = 1024; mode = 1; tk = r / 8; tn = r % 8; }
        else if (r < 256) { src = c.in[46] + ((size_t)l * 32 + e) * 1024 * 512; dst = (bf16_t*)(c.ws + WS_EXPW + (size_t)e * SZ_WGU); ld = 512; ldd = 1024; mode = 2; tk = (r - 128) / 8; tn = (r - 128) % 8; }
        else              { src = c.in[47] + ((size_t)l * 32 + e) * 512 * 1024; dst = (bf16_t*)(c.ws + WS_EXPW + 32 * SZ_WGU + (size_t)e * SZ_WD); ld = 1024; ldd = 512; mode = 0; tk = (r - 256) / 16; tn = (r - 256) % 16; }
        const int n = tn * 64 + lane; const float* sp = src + (size_t)(tk * 64) * ld + n; bf16_t* dp = dst + (size_t)rowmap(n, mode) * ldd + tk * 64;
        float v[64];
#pragma unroll
        for (int k = 0; k < 64; ++k) v[k] = __builtin_nontemporal_load(sp + (size_t)k * ld);
#pragma unroll
        for (int kb = 0; kb < 8; ++kb) {
            u32x4 w4; w4.x = pack2(v[kb * 8], v[kb * 8 + 1]); w4.y = pack2(v[kb * 8 + 2], v[kb * 8 + 3]); w4.z = pack2(v[kb * 8 + 4], v[kb * 8 + 5]); w4.w = pack2(v[kb * 8 + 6], v[kb * 8 + 7]);
            *(u32x4*)(dp + kb * 8) = w4;
        }
    }
}

DI void phase_norm1(const Ctx& c, int l) {
    const float* modv = (const float*)(c.ws + WS_WSM + OFF_MODV);
    float* H = (float*)(c.ws + WS_H); const bf16_t* Y = (const bf16_t*)(c.ws + WS_P);
    bf16_t* XN = (bf16_t*)(c.ws + WS_BUFA);
    const float* g1 = c.in[6] + l * 1024;
    for (int row = blockIdx.x * 8 + c.wave; row < NZ; row += gridDim.x * 8) {
        const int b = row / TZ, s = row % TZ, sel = s < CTX ? 2 : b;
        float4 v[4]; float ss = 0.f;
#pragma unroll
        for (int q = 0; q < 4; ++q) {
            const int col = q * 256 + c.lane * 4;
            v[q] = *(const float4*)(H + (size_t)row * D + col);
            if (l > 0) {
                float ya[4], yb[4]; unpack4(*(const u32x2*)(Y + (size_t)row * D + col), ya); unpack4(*(const u32x2*)(Y + ((size_t)NZ + row) * D + col), yb);
                const float4 m5 = *(const float4*)(modv + ((size_t)(l - 1) * 3 + sel) * 6144 + 5 * 1024 + col);
                v[q].x += m5.x * (ya[0] + yb[0]); v[q].y += m5.y * (ya[1] + yb[1]); v[q].z += m5.z * (ya[2] + yb[2]); v[q].w += m5.w * (ya[3] + yb[3]);
                *(float4*)(H + (size_t)row * D + col) = v[q];
            }
            ss += v[q].x * v[q].x + v[q].y * v[q].y + v[q].z * v[q].z + v[q].w * v[q].w;
        }
        ss = wave_sum(ss);
        const float rs = rsqrtf(ss * (1.f / 1024.f) + 1e-6f);
#pragma unroll
        for (int q = 0; q < 4; ++q) {
            const int col = q * 256 + c.lane * 4;
            const float4 g = *(const float4*)(g1 + col), m0 = *(const float4*)(modv + ((size_t)l * 3 + sel) * 6144 + col), m1 = *(const float4*)(modv + ((size_t)l * 3 + sel) * 6144 + 1024 + col);
            *(u32x2*)(XN + (size_t)row * D + col) = pack4(v[q].x * rs * g.x * (1.f + m1.x) + m0.x, v[q].y * rs * g.y * (1.f + m1.y) + m0.y,
                                                          v[q].z * rs * g.z * (1.f + m1.z) + m0.z, v[q].w * rs * g.w * (1.f + m1.w) + m0.w);
        }
    }
}

DI void phase_final(const Ctx& c) {
    const float* modv = (const float*)(c.ws + WS_WSM + OFF_MODV);
    const float* H = (const float*)(c.ws + WS_H); const bf16_t* Y = (const bf16_t*)(c.ws + WS_P);
    const float* g = c.in[48];
    for (int r = blockIdx.x * 8 + c.wave; r < NB * SEQ; r += gridDim.x * 8) {
        const int b = r / SEQ, t = r % SEQ, row = b * TZ + CTX + t;
        float4 v[4]; float ss = 0.f;
#pragma unroll
        for (int q = 0; q < 4; ++q) {
            const int col = q * 256 + c.lane * 4;
            v[q] = *(const float4*)(H + (size_t)row * D + col);
            float ya[4], yb[4]; unpack4(*(const u32x2*)(Y + (size_t)row * D + col), ya); unpack4(*(const u32x2*)(Y + ((size_t)NZ + row) * D + col), yb);
            const float4 m5 = *(const float4*)(modv + ((size_t)(NL - 1) * 3 + b) * 6144 + 5 * 1024 + col);
            v[q].x += m5.x * (ya[0] + yb[0]); v[q].y += m5.y * (ya[1] + yb[1]); v[q].z += m5.z * (ya[2] + yb[2]); v[q].w += m5.w * (ya[3] + yb[3]);
            ss += v[q].x * v[q].x + v[q].y * v[q].y + v[q].z * v[q].z + v[q].w * v[q].w;
        }
        ss = wave_sum(ss);
        const float rs = rsqrtf(ss * (1.f / 1024.f) + 1e-6f);
#pragma unroll
        for (int q = 0; q < 4; ++q) {
            const int col = q * 256 + c.lane * 4; const float4 gg = *(const float4*)(g + col);
            *(float4*)(c.out + (size_t)r * D + col) = make_float4(v[q].x * rs * gg.x, v[q].y * rs * gg.y, v[q].z * rs * gg.z, v[q].w * rs * gg.w);
        }
    }
}

struct EpiInproj {
    static constexpr bool PERM = true, AFTER_DRAIN = false;
    bf16_t *PM, *PS, *PR, *PD, *GT;
    DI void operator()(const pg8::f32x4 (&acc)[2][2][4][2], const pg8::Unit& u, int wr, int wc, int fr, int fq) const {
        const int row0 = u.pm * 256 + wr * 64 + fr, col0 = u.pn * 256 + wc * 32 + 8 * fq;
#pragma unroll
        for (int bj = 0; bj < 2; ++bj) {
            const int col = col0 + bj * 128;
            bf16_t* dst; int ld, cc; bool gate = false;
            if (col < 416) { dst = PM; ld = 416; cc = col; }
            else if (col < 1440) { dst = PR; ld = 1024; cc = col - 416; }
            else if (col < 1696) { dst = PS; ld = 256; cc = col - 1440; }
            else if (col < 2464) { dst = PD; ld = 768; cc = col - 1696; }
            else if (col < NIN) { dst = GT; ld = 4096; cc = col - 2464; gate = true; }
            else continue;
#pragma unroll
            for (int ai = 0; ai < 2; ++ai)
#pragma unroll
                for (int m = 0; m < 4; ++m) {
                    const int row = row0 + ai * 128 + m * 16; pg8::f32x4 v0 = acc[ai][bj][m][0], v1 = acc[ai][bj][m][1];
                    if (gate) { v0[0] = sigmoidf_(v0[0]); v0[1] = sigmoidf_(v0[1]); v0[2] = sigmoidf_(v0[2]); v0[3] = sigmoidf_(v0[3]);
                                v1[0] = sigmoidf_(v1[0]); v1[1] = sigmoidf_(v1[1]); v1[2] = sigmoidf_(v1[2]); v1[3] = sigmoidf_(v1[3]); }
                    u32x4 w; w.x = pack2(v0[0], v0[1]); w.y = pack2(v0[2], v0[3]); w.z = pack2(v1[0], v1[1]); w.w = pack2(v1[2], v1[3]);
                    *(u32x4*)(dst + (size_t)row * ld + cc) = w;
                }
        }
    }
};
DI void phase_inproj(const Ctx& c, int l) {
    EpiInproj E; E.PM = (bf16_t*)(c.ws + WS_P + P_PM); E.PS = (bf16_t*)(c.ws + WS_P + P_PS); E.PR = (bf16_t*)(c.ws + WS_P + P_PR); E.PD = (bf16_t*)(c.ws + WS_P + P_PD); E.GT = (bf16_t*)(c.ws + WS_GT);
    pg8::Gemm g{(const bf16_t*)(c.ws + WS_BUFA), (const bf16_t*)(c.ws + WS_WSM + OFF_WINT + l * SZ_WINT), NZ, NINP, 1024, 1024, 1024};
    pg8::StaticOrder S; S.init(NZ, NINP, (int)gridDim.x, (int)blockIdx.x, INPROJ_WGM);
    __syncthreads();
    pg8::gemm_phase<EpiInproj, pg8::StaticOrder, false>((PG8_LAS unsigned char*)c.smem, g, S, E, nullptr, c.tid);
}

DI void phase_prep(const Ctx& c, int l) {
    unsigned char* ws = c.ws; const int lane = c.lane, wave = c.wave, tid = c.tid;
    const bf16_t* PM = (const bf16_t*)(ws + WS_P + P_PM); const bf16_t* PR = (const bf16_t*)(ws + WS_P + P_PR); const bf16_t* PD = (const bf16_t*)(ws + WS_P + P_PD);
    bf16_t* CQN = (bf16_t*)(ws + WS_MISC + MS_CQN); bf16_t* TW = (bf16_t*)(ws + WS_MISC + MS_TW); bf16_t* AL = (bf16_t*)(ws + WS_MISC + MS_AL); bf16_t* SG = (bf16_t*)(ws + WS_MISC + MS_SG);
    bf16_t* KM = (bf16_t*)(ws + WS_EXPW + MX_KM); bf16_t* QD = (bf16_t*)(ws + WS_EXPW + MX_QD); bf16_t* KD_ = (bf16_t*)(ws + WS_EXPW + MX_KD); bf16_t* VDT = (bf16_t*)(ws + WS_EXPW + MX_VDT);
    bf16_t* RB = (bf16_t*)(ws + WS_EXPW + MX_RB); bf16_t* KB = (bf16_t*)(ws + WS_EXPW + MX_KB); bf16_t* VB = (bf16_t*)(ws + WS_EXPW + MX_VB); bf16_t* KKB = (bf16_t*)(ws + WS_EXPW + MX_KKB);
    const float* rope = (const float*)(ws + WS_WSM + OFF_ROPE);
    const float* gq = c.in[9] + l * 256; const float* gkv = c.in[10] + l * 128; const float* mu = c.in[13] + l * 1024; const float* k_k = c.in[19] + l * 256;
    bf16_t* Vs = (bf16_t*)c.smem;
    const float qsc = 0.17677669529663687f * LOG2E;
    for (int tile = blockIdx.x; tile < NZ / 16; tile += gridDim.x) {
        __syncthreads();
#pragma unroll 2
        for (int i = 0; i < 2; ++i) {
            const int rt = wave * 2 + i, z = tile * 16 + rt, b = z / TZ, s = z % TZ; const bool lat = s >= CTX; const int tl = lat ? s - CTX : 0;
            {
                const bf16_t* pm = PM + (size_t)z * 416;
                float x[4]; unpack4(*(const u32x2*)(pm + lane * 4), x);
                float ss = wave_sum(x[0] * x[0] + x[1] * x[1] + x[2] * x[2] + x[3] * x[3]);
                float rs = rsqrtf(ss * (1.f / 256.f) + 1e-6f);
                const float4 g = *(const float4*)(gq + lane * 4);
                *(u32x2*)(CQN + (size_t)z * 384 + lane * 4) = pack4(x[0] * rs * g.x, x[1] * rs * g.y, x[2] * rs * g.z, x[3] * rs * g.w);
                const unsigned u2 = *(const unsigned*)(pm + 256 + lane * 2); const float y0 = lo2f(u2), y1 = hi2f(u2);
                ss = wave_sum(y0 * y0 + y1 * y1); rs = rsqrtf(ss * (1.f / 128.f) + 1e-6f);
                const float2 g2 = *(const float2*)(gkv + lane * 2);
                *(unsigned*)(CQN + (size_t)z * 384 + 256 + lane * 2) = pack2(y0 * rs * g2.x, y1 * rs * g2.y);
                float kr = bf2f(pm[384 + (lane & 31)]);
                const float pr = __shfl_xor(kr, 8, 64);
                if (lat) { const float* cs = rope + ((size_t)tl * 16 + ((lane & 31) >> 4) * 8 + (lane & 7)) * 2; kr = kr * cs[0] + ((lane & 8) ? pr : -pr) * cs[1]; }
                if (lane < 32) {
                    const bf16_t kv = f2bf(kr);
#pragma unroll
                    for (int h = 0; h < 4; ++h) KM[((size_t)(b * 4 + h) * TZ + s) * 96 + 64 + lane] = kv;
                }
            }
            {
                const bf16_t* pd = PD + (size_t)z * 768;
                const int i0 = lane * 4, hh = i0 >> 6, ii = i0 & 31, nn = (i0 >> 5) & 1;
                const float* cs = rope + ((size_t)tl * 16 + (ii >> 4) * 8 + (ii & 7)) * 2;
                const bool hi = (ii & 8) != 0;
#pragma unroll
                for (int w = 0; w < 2; ++w) {
                    float x[4]; unpack4(*(const u32x2*)(pd + w * 256 + i0), x);
                    float o[4];
#pragma unroll
                    for (int j = 0; j < 4; ++j) {
                        const float p = __shfl_xor(x[j], 2, 64);
                        o[j] = lat ? (x[j] * cs[2 * j] + (hi ? p : -p) * cs[2 * j + 1]) : x[j];
                        if (w == 0) o[j] *= qsc;
                    }
                    bf16_t* dst = (w == 0 ? QD : KD_) + ((size_t)(b * 4 + hh) * TZ + s) * 64 + nn * 32 + ii;
                    *(u32x2*)dst = pack4(o[0], o[1], o[2], o[3]);
                }
                *(u32x2*)(Vs + rt * 264 + i0) = *(const u32x2*)(pd + 512 + i0);
            }
            {
                const bf16_t* pr = PR + (size_t)z * 1024;
                const bool hp = (s != 0) && (s != CTX), hn = (s != CTX - 1) && (s != TZ - 1);
#pragma unroll
                for (int q = 0; q < 4; ++q) {
                    const int col = q * 256 + lane * 4;
                    float cu[4], pv[4] = {0.f, 0.f, 0.f, 0.f}, nx[4] = {0.f, 0.f, 0.f, 0.f};
                    unpack4(*(const u32x2*)(pr + col), cu);
                    if (hp) unpack4(*(const u32x2*)(pr - 1024 + col), pv);
                    if (hn) unpack4(*(const u32x2*)(pr + 1024 + col), nx);
                    const float4 m = *(const float4*)(mu + col);
                    float zv[4];
                    zv[0] = cu[0] + (0.5f * (pv[0] + nx[0]) - cu[0]) * m.x; zv[1] = cu[1] + (0.5f * (pv[1] + nx[1]) - cu[1]) * m.y;
                    zv[2] = cu[2] + (0.5f * (pv[2] + nx[2]) - cu[2]) * m.z; zv[3] = cu[3] + (0.5f * (pv[3] + nx[3]) - cu[3]) * m.w;
                    if (q == 0) *(u32x2*)(RB + (size_t)z * 256 + lane * 4) = pack4(zv[0], zv[1], zv[2], zv[3]);
                    else if (q == 1) {
                        *(u32x2*)(KB + (size_t)z * 256 + lane * 4) = pack4(zv[0], zv[1], zv[2], zv[3]);
                        const float4 kk4 = *(const float4*)(k_k + lane * 4);
                        const float a0 = zv[0] * kk4.x, a1 = zv[1] * kk4.y, a2 = zv[2] * kk4.z, a3 = zv[3] * kk4.w;
                        const float ssq = sum16(a0 * a0 + a1 * a1 + a2 * a2 + a3 * a3);
                        const float inv = 1.f / fmaxf(sqrtf(ssq), 1e-12f);
                        *(u32x2*)(KKB + (size_t)z * 256 + lane * 4) = pack4(a0 * inv, a1 * inv, a2 * inv, a3 * inv);
                    } else if (q == 2) *(u32x2*)(VB + (size_t)z * 256 + lane * 4) = pack4(zv[0], zv[1], zv[2], zv[3]);
                    else {
                        if (lane < 16) *(u32x2*)(TW + (size_t)z * 64 + lane * 4) = pack4(tanhf_(zv[0]), tanhf_(zv[1]), tanhf_(zv[2]), tanhf_(zv[3]));
                        else if (lane < 32) *(u32x2*)(AL + (size_t)z * 64 + (lane - 16) * 4) = pack4(zv[0], zv[1], zv[2], zv[3]);
                        else *(u32x2*)(SG + (size_t)z * 128 + (lane - 32) * 4) = pack4(sigmoidf_(zv[0]), sigmoidf_(zv[1]), sigmoidf_(zv[2]), sigmoidf_(zv[3]));
                    }
                }
            }
        }
        __syncthreads();
        {
            const int z0 = tile * 16, b = z0 / TZ, s0 = z0 % TZ;
#pragma unroll
            for (int i = 0; i < 1; ++i) {
                const int ch = tid, dv = ch >> 1, r8 = (ch & 1) * 8;
                bf16_t v[8];
#pragma unroll
                for (int j = 0; j < 8; ++j) v[j] = Vs[(r8 + j) * 264 + dv];
                u32x4 o; o.x = v[0] | ((unsigned)v[1] << 16); o.y = v[2] | ((unsigned)v[3] << 16); o.z = v[4] | ((unsigned)v[5] << 16); o.w = v[6] | ((unsigned)v[7] << 16);
                *(u32x4*)(VDT + ((size_t)(b * 4 + (dv >> 6)) * 64 + (dv & 63)) * TZ + s0 + r8) = o;
            }
        }
    }
}

constexpr int S5C = 64, S5N = TZ / S5C, S5NC = CTX / S5C;
DI int s5_tok(int dir, int i) { return dir == 0 ? i : (i < CTX ? CTX - 1 - i : TZ - 1 - (i - CTX)); }
DI void s5_stage_u(const Ctx& c, float* U, int b, int dir, int chunk, int g0, int ng) {
    const bf16_t* PS = (const bf16_t*)(c.ws + WS_P + P_PS);
    const int per = ng * 4;
    for (int e = c.tid; e < S5C * per; e += NTHR) {
        const int i = e / per, c4 = (e % per) * 4, s = s5_tok(dir, chunk * S5C + i);
        float x[4]; unpack4(*(const u32x2*)(PS + (size_t)(b * TZ + s) * 256 + g0 * 16 + c4), x);
        *(float4*)(U + i * (ng * 16) + c4) = make_float4(x[0], x[1], x[2], x[3]);
    }
}
DI void phase_s5_local(const Ctx& c, int l) {
    float* U = (float*)c.smem;
    const float* s5t = (const float*)(c.ws + WS_WSM + OFF_S5T);
    float* E = (float*)(c.ws + WS_WSM + OFF_S5E);
    for (int u = blockIdx.x; u < 2 * 2 * S5N * 2; u += gridDim.x) {
        const int gq = u & 1, chunk = (u >> 1) % S5N, dir = (u / (2 * S5N)) & 1, b = u / (4 * S5N);
        __syncthreads();
        s5_stage_u(c, U, b, dir, chunk, gq * 8, 8);
        __syncthreads();
        const int g = gq * 8 + c.wave, p = c.lane;
        const float* tb = s5t + ((size_t)((l * 2 + dir) * 16 + g) * 64 + p) * 36;
        const float are = tb[0], aim = tb[1];
        float br[16], bi[16];
#pragma unroll
        for (int ch = 0; ch < 16; ++ch) { br[ch] = tb[4 + ch]; bi[ch] = tb[20 + ch]; }
        float xr = 0.f, xi = 0.f;
        for (int i = 0; i < S5C; ++i) {
            const float* uu = U + i * 128 + c.wave * 16;
            float sr = 0.f, si = 0.f;
#pragma unroll
            for (int q = 0; q < 4; ++q) { const float4 v = *(const float4*)(uu + q * 4);
                sr += br[q * 4] * v.x + br[q * 4 + 1] * v.y + br[q * 4 + 2] * v.z + br[q * 4 + 3] * v.w;
                si += bi[q * 4] * v.x + bi[q * 4 + 1] * v.y + bi[q * 4 + 2] * v.z + bi[q * 4 + 3] * v.w; }
            const float nr = are * xr - aim * xi + sr, ni = are * xi + aim * xr + si; xr = nr; xi = ni;
        }
        *(float2*)(E + ((size_t)(((b * 2 + dir) * 16 + g) * S5N + chunk) * 64 + p) * 2) = make_float2(xr, xi);
    }
}
DI void phase_s5_carry(const Ctx& c, int l) {
    const int gt = blockIdx.x * NTHR + c.tid;
    if (gt < 2 * 2 * 16 * 64) {
        const int p = gt & 63, g = (gt >> 6) & 15, dir = (gt >> 10) & 1, b = gt >> 11;
        const float* tb = (const float*)(c.ws + WS_WSM + OFF_S5T) + ((size_t)((l * 2 + dir) * 16 + g) * 64 + p) * 36;
        const float ar = tb[2], ai = tb[3];
        const float* E = (const float*)(c.ws + WS_WSM + OFF_S5E) + (size_t)(((b * 2 + dir) * 16 + g) * S5N) * 128;
        float* C = (float*)(c.ws + WS_WSM + OFF_S5C) + (size_t)(((b * 2 + dir) * 16 + g) * S5N) * 128;
        float xr = 0.f, xi = 0.f;
        for (int ch = 0; ch < S5N; ++ch) {
            const float2 e = *(const float2*)(E + ch * 128 + p * 2);
            *(float2*)(C + ch * 128 + p * 2) = make_float2(xr, xi);
            const float nr = ar * xr - ai * xi + e.x, ni = ar * xi + ai * xr + e.y; xr = nr; xi = ni;
        }
    }
}

constexpr int S5_US = 0, S5_YS = 8192, S5_WV = S5_YS + 2 * 64 * 64 * 4;
template <bool LOCAL>
DI void phase_s5_final_unit(const Ctx& c, int l, int u) {
    unsigned char* L = c.smem;
    const float* s5t = (const float*)(c.ws + WS_WSM + OFF_S5T);
    const float* CIN = (const float*)(c.ws + WS_WSM + OFF_S5C);
    const bf16_t* PS = (const bf16_t*)(c.ws + WS_P + P_PS);
    const int gq = u & 3, ct = (u >> 2) % S5N, b = u / (4 * S5N);
    const int wave = c.wave, lane = c.lane, gl = wave >> 1, dir = wave & 1, g = gq * 4 + gl, n16 = lane & 15, q4 = lane >> 4;
    __syncthreads();
    {
        const int t = c.tid >> 3, part = c.tid & 7;
        *(u32x4*)(L + S5_US + t * 128 + part * 16) = *(const u32x4*)(PS + (size_t)(b * TZ + ct * S5C + t) * 256 + gq * 64 + part * 8);
    }
    typedef short s16x4 __attribute__((ext_vector_type(4)));
    const float* tbase = s5t + ((size_t)((l * 2 + dir) * 16 + g) * 64) * 36;
    s16x4 bfr[8], cfr[8];
#pragma unroll
    for (int j = 0; j < 8; ++j) {
        const int pp = 16 * j + n16, p = pp & 63; const float* tb = tbase + (size_t)p * 36 + (pp < 64 ? 4 : 20) + 4 * q4;
        u32x2 w2; w2.x = pack2(tb[0], tb[1]); w2.y = pack2(tb[2], tb[3]);
        bfr[j] = __builtin_bit_cast(s16x4, w2);
    }
    {
        const float* cre = c.in[29] + ((size_t)((l * 2 + dir) * 16 + g) * 16 + n16) * 64; const float* cim = c.in[30] + ((size_t)((l * 2 + dir) * 16 + g) * 16 + n16) * 64;
#pragma unroll
        for (int s = 0; s < 8; ++s) {
            const int pp = 16 * s + 4 * q4; const float sg = pp < 64 ? 1.f : -1.f; const float* src = (pp < 64 ? cre + pp : cim + (pp - 64));
            u32x2 w2; w2.x = pack2(sg * src[0], sg * src[1]); w2.y = pack2(sg * src[2], sg * src[3]);
            cfr[s] = __builtin_bit_cast(s16x4, w2);
        }
    }
    const float are = tbase[(size_t)lane * 36], aim = tbase[(size_t)lane * 36 + 1];
    const int cd = dir == 0 ? ct : (ct < S5NC ? S5NC - 1 - ct : S5N + S5NC - 1 - ct);
    float xr = 0.f, xi = 0.f;
    if (!LOCAL) { const float2 ci = *(const float2*)(CIN + ((size_t)(((b * 2 + dir) * 16 + g) * S5N + cd) * 64 + lane) * 2); xr = ci.x; xi = ci.y; }
    const float dsk = c.in[31][(size_t)l * 256 + g * 16 + n16];
    bf16_t* BU = (bf16_t*)(L + S5_WV + wave * 8192); bf16_t* XB = BU + 16 * 128;
    float* YS = (float*)(L + S5_YS) + dir * 64 * 64;
    __syncthreads();
#pragma unroll 1
    for (int sb = 0; sb < 4; ++sb) {
        const int stepA = 16 * sb + n16, tlA = dir == 0 ? stepA : 63 - stepA;
        const s16x4 af = __builtin_bit_cast(s16x4, *(const u32x2*)(L + S5_US + tlA * 128 + gl * 32 + q4 * 8));
#pragma unroll
        for (int j = 0; j < 8; ++j) {
            f32x4 acc = {0.f, 0.f, 0.f, 0.f};
            acc = __builtin_amdgcn_mfma_f32_16x16x16bf16_1k(af, bfr[j], acc, 0, 0, 0);
#pragma unroll
            for (int rr = 0; rr < 4; ++rr) BU[(4 * q4 + rr) * 128 + 16 * j + n16] = f2bf(acc[rr]);
        }
        __builtin_amdgcn_wave_barrier();
#pragma unroll
        for (int ii = 0; ii < 16; ++ii) {
            const float br = bf2f(BU[ii * 128 + lane]), bi = bf2f(BU[ii * 128 + 64 + lane]);
            const float nr = are * xr - aim * xi + br, ni = are * xi + aim * xr + bi; xr = nr; xi = ni;
            if (!LOCAL) { XB[ii * 128 + lane] = f2bf(xr); XB[ii * 128 + 64 + lane] = f2bf(xi); }
        }
        __builtin_amdgcn_wave_barrier();
        if (LOCAL) continue;
        f32x4 ya = {0.f, 0.f, 0.f, 0.f};
#pragma unroll
        for (int s = 0; s < 8; ++s) {
            const s16x4 xf = __builtin_bit_cast(s16x4, *(const u32x2*)((const unsigned char*)XB + n16 * 256 + (16 * s + 4 * q4) * 2));
            ya = __builtin_amdgcn_mfma_f32_16x16x16bf16_1k(xf, cfr[s], ya, 0, 0, 0);
        }
#pragma unroll
        for (int rr = 0; rr < 4; ++rr) {
            const int step = 16 * sb + 4 * q4 + rr, tl = dir == 0 ? step : 63 - step;
            float y = ya[rr];
            if (dir == 0) y += dsk * bf2f(*(const bf16_t*)(L + S5_US + tl * 128 + (gl * 16 + n16) * 2));
            YS[tl * 64 + gl * 16 + n16] = y;
        }
    }
    if (LOCAL) { *(float2*)((float*)(c.ws + WS_WSM + OFF_S5E) + ((size_t)(((b * 2 + dir) * 16 + g) * S5N + cd) * 64 + lane) * 2) = make_float2(xr, xi); return; }
    __syncthreads();
    bf16_t* ZG = (bf16_t*)(c.ws + WS_MISC + MS_ZG);
    {
        const float* Y0 = (const float*)(L + S5_YS); const float* Y1 = Y0 + 64 * 64;
        for (int e = c.tid; e < 64 * 16; e += NTHR) {
            const int i = e >> 4, c4 = (e & 15) * 4; const float4 y0 = *(const float4*)(Y0 + i * 64 + c4), y1 = *(const float4*)(Y1 + i * 64 + c4);
            *(u32x2*)(ZG + (size_t)(b * TZ + ct * S5C + i) * 256 + gq * 64 + c4) = pack4(gelu_tanh(y0.x + y1.x), gelu_tanh(y0.y + y1.y), gelu_tanh(y0.z + y1.z), gelu_tanh(y0.w + y1.w));
        }
    }
}

DI void phase_small_gemms(const Ctx& c, int l) {
    unsigned char* ws = c.ws; unsigned char* wsm = ws + WS_WSM;
    const bf16_t* CQN = (const bf16_t*)(ws + WS_MISC + MS_CQN);
    const float* rope = (const float*)(wsm + OFF_ROPE);
    constexpr int NMT = NZ / 256;
    int base = 0;
    const int G = gridDim.x, bid = blockIdx.x;
    {
        const bf16_t* W = (const bf16_t*)(wsm + OFF_WUQT + l * SZ_WUQT); bf16_t* QM = (bf16_t*)(ws + WS_EXPW + MX_QM);
        const float qs = 0.10206207261596577f * LOG2E;
        for (int u = (bid + G - base % G) % G; u < NMT * 3; u += G) {
            const int mt = u / 3, nt = u % 3, r0 = mt * 256, c0 = nt * 128;
            gemm_tile<4, 0>(c, 256, [&](int i) { return CQN + (size_t)(r0 + i) * 384; }, [&](int i) { return W + (size_t)(c0 + i) * 256; }, NoHook(),
                [&](f32x4 (&acc)[4][4], int wr, int wc, int fr, int fq) {
#pragma unroll
                    for (int n = 0; n < 4; ++n) {
                        const int col = c0 + wc + n * 16 + fq * 4, h = col / 96, d = col % 96;
                        const bool rp = d >= 64;
#pragma unroll
                        for (int m = 0; m < 4; ++m) {
                            const int row = r0 + wr + m * 16 + fr, b = row / TZ, s = row % TZ; f32x4 v = acc[m][n];
                            f32x4 pv; pv[0] = __shfl_xor(v[0], 32, 64); pv[1] = __shfl_xor(v[1], 32, 64); pv[2] = __shfl_xor(v[2], 32, 64); pv[3] = __shfl_xor(v[3], 32, 64);
                            if (rp && s >= CTX) {
                                const int i0 = d - 64;
                                const float* cs = rope + ((size_t)(s - CTX) * 16 + (i0 >> 4) * 8 + (i0 & 7)) * 2;
                                const bool hi = (i0 & 8) != 0;
#pragma unroll
                                for (int j = 0; j < 4; ++j) v[j] = v[j] * cs[2 * j] + (hi ? pv[j] : -pv[j]) * cs[2 * j + 1];
                            }
                            *(u32x2*)(QM + ((size_t)(b * 4 + h) * TZ + s) * 96 + d) = pack4(v[0] * qs, v[1] * qs, v[2] * qs, v[3] * qs);
                        }
                    }
                });
        }
        base += NMT * 3;
    }
    {
        const bf16_t* W = (const bf16_t*)(wsm + OFF_WUKVT + l * SZ_WUKVT); bf16_t* KM = (bf16_t*)(ws + WS_EXPW + MX_KM); bf16_t* VMT = (bf16_t*)(ws + WS_EXPW + MX_VMT);
        for (int u = (bid + G - base % G) % G; u < NMT * 4; u += G) {
            const int mt = u / 4, nt = u % 4, r0 = mt * 256, c0 = nt * 128;
            gemm_tile<4, 0>(c, 128, [&](int i) { return CQN + (size_t)(r0 + i) * 384 + 256; }, [&](int i) { return W + (size_t)(c0 + i) * 128; }, NoHook(),
                [&](f32x4 (&acc)[4][4], int wr, int wc, int fr, int fq) {
#pragma unroll
                    for (int n = 0; n < 4; ++n) {
                        const int col = c0 + wc + n * 16 + fq * 4, h = col >> 7, d = col & 127;
#pragma unroll
                        for (int m = 0; m < 4; ++m) {
                            const int row = r0 + wr + m * 16 + fr, b = row / TZ, s = row % TZ; const f32x4 v = acc[m][n];
                            if (d < 64) *(u32x2*)(KM + ((size_t)(b * 4 + h) * TZ + s) * 96 + d) = pack4(v[0], v[1], v[2], v[3]);
                            else {
#pragma unroll
                                for (int j = 0; j < 4; ++j) VMT[((size_t)(b * 4 + h) * 64 + (d - 64 + j)) * TZ + s] = f2bf(v[j]);
                            }
                        }
                    }
                });
        }
        base += NMT * 4;
    }
    bf16_t* SE = (bf16_t*)(ws + WS_P + P_PR); bf16_t* SAD = SE + (size_t)2 * NZ * 256; bf16_t* SKD = SAD + (size_t)2 * NZ * 256;
    {
        const bf16_t* A = (const bf16_t*)(ws + WS_MISC + MS_TW); const bf16_t* W = (const bf16_t*)(wsm + OFF_W2T + l * SZ_W2T);
        const float* w0 = c.in[14] + (size_t)l * 512;
        for (int u = (bid + G - base % G) % G; u < NMT * 4; u += G) {
            const int mt = u / 4, nt = u % 4, r0 = mt * 256, c0 = nt * 128;
            gemm_tile<4, 0>(c, 64, [&](int i) { return A + (size_t)(r0 + i) * 64; }, [&](int i) { return W + (size_t)(c0 + i) * 64; }, NoHook(),
                [&](f32x4 (&acc)[4][4], int wr, int wc, int fr, int fq) {
#pragma unroll
                    for (int n = 0; n < 4; ++n) {
                        const int col = c0 + wc + n * 16 + fq * 4, d = col >> 8, cc = col & 255; const float4 w0v = *(const float4*)(w0 + col);
#pragma unroll
                        for (int m = 0; m < 4; ++m) {
                            const int row = r0 + wr + m * 16 + fr; const f32x4 v = acc[m][n]; float e[4];
                            const float x[4] = {w0v.x + v[0], w0v.y + v[1], w0v.z + v[2], w0v.w + v[3]};
#pragma unroll
                            for (int j = 0; j < 4; ++j) e[j] = 0.6065306597126334f * sigmoidf_(x[j]);
                            *(u32x2*)(SE + ((size_t)d * NZ + row) * 256 + cc) = pack4(e[0], e[1], e[2], e[3]);
                        }
                    }
                });
        }
        base += NMT * 4;
    }
    {
        const bf16_t* A = (const bf16_t*)(ws + WS_MISC + MS_AL); const bf16_t* W = (const bf16_t*)(wsm + OFF_A2T + l * SZ_A2T);
        const float* a0 = c.in[16] + (size_t)l * 512; const float* k_a = c.in[20] + (size_t)l * 256; const bf16_t* KB = (const bf16_t*)(ws + WS_EXPW + MX_KB);
        for (int u = (bid + G - base % G) % G; u < NMT * 4; u += G) {
            const int mt = u / 4, nt = u % 4, r0 = mt * 256, c0 = nt * 128;
            gemm_tile<4, 0>(c, 64, [&](int i) { return A + (size_t)(r0 + i) * 64; }, [&](int i) { return W + (size_t)(c0 + i) * 64; }, NoHook(),
                [&](f32x4 (&acc)[4][4], int wr, int wc, int fr, int fq) {
#pragma unroll
                    for (int n = 0; n < 4; ++n) {
                        const int col = c0 + wc + n * 16 + fq * 4, d = col >> 8, cc = col & 255; const float4 a0v = *(const float4*)(a0 + col), kav = *(const float4*)(k_a + cc);
#pragma unroll
                        for (int m = 0; m < 4; ++m) {
                            const int row = r0 + wr + m * 16 + fr; const f32x4 v = acc[m][n];
                            const float ad0 = sigmoidf_(a0v.x + v[0]), ad1 = sigmoidf_(a0v.y + v[1]), ad2 = sigmoidf_(a0v.z + v[2]), ad3 = sigmoidf_(a0v.w + v[3]);
                            float k[4]; unpack4(*(const u32x2*)(KB + (size_t)row * 256 + cc), k);
                            *(u32x2*)(SAD + ((size_t)d * NZ + row) * 256 + cc) = pack4(ad0, ad1, ad2, ad3);
                            *(u32x2*)(SKD + ((size_t)d * NZ + row) * 256 + cc) = pack4(k[0] * (1.f + (ad0 - 1.f) * kav.x), k[1] * (1.f + (ad1 - 1.f) * kav.y), k[2] * (1.f + (ad2 - 1.f) * kav.z), k[3] * (1.f + (ad3 - 1.f) * kav.w));
                        }
                    }
                });
        }
        base += NMT * 4;
    }
    {
        const bf16_t* A = (const bf16_t*)(ws + WS_MISC + MS_SG); const bf16_t* W = (const bf16_t*)(wsm + OFF_G2T + l * SZ_G2T); bf16_t* GG = (bf16_t*)(ws + WS_MISC + MS_GG);
        for (int u = (bid + G - base % G) % G; u < NMT * 2; u += G) {
            const int mt = u / 2, nt = u % 2, r0 = mt * 256, c0 = nt * 128;
            gemm_tile<4, 0>(c, 128, [&](int i) { return A + (size_t)(r0 + i) * 128; }, [&](int i) { return W + (size_t)(c0 + i) * 128; }, NoHook(),
                [&](f32x4 (&acc)[4][4], int wr, int wc, int fr, int fq) {
#pragma unroll
                    for (int n = 0; n < 4; ++n)
#pragma unroll
                        for (int m = 0; m < 4; ++m) { const f32x4 v = acc[m][n];
                            *(u32x2*)(GG + (size_t)(r0 + wr + m * 16 + fr) * 256 + c0 + wc + n * 16 + fq * 4) = pack4(v[0], v[1], v[2], v[3]); }
                });
        }
        base += NMT * 2;
    }
}

DI int krow(int s, int h, int j) { return 16 * s + 8 * (j >> 2) + 4 * h + (j & 3); }
#ifndef ATT_THR
#define ATT_THR 64.f
#endif
constexpr int ATT_PARK = 56 * 1024;
template <int MODE>
DI void attn_pass(const Ctx& c, int l, int b, int h, int q0, int nkeys) {
    constexpr int DROW = MODE == 0 ? 96 : 64;
    constexpr int DQ = MODE == 0 ? 96 : 32, KS = DQ / 16;
    constexpr int DOFF = MODE == 2 ? 32 : 0;
    constexpr int TK = 128;
    constexpr int KPITCH = DQ * 2 + 16;
    constexpr int VPITCH = TK * 2 + 16;
    constexpr int KBYTES = TK * KPITCH, VBYTES = 64 * VPITCH, STG = KBYTES + VBYTES;
    static_assert(MODE == 0 || 2 * STG <= ATT_PARK, "the staging buffers must stay below the parked o1");
    unsigned char* ws = c.ws; int tid_ = c.tid; asm volatile("" : "+v"(tid_));
    const int tid = tid_, lane = tid & 63, wave = __builtin_amdgcn_readfirstlane(tid >> 6), r = lane & 31, hh = lane >> 5;
    const bf16_t* Q = (const bf16_t*)(ws + WS_EXPW + (MODE == 0 ? MX_QM : MX_QD)) + (size_t)(b * 4 + h) * TZ * DROW + DOFF;
    const bf16_t* Kp = (const bf16_t*)(ws + WS_EXPW + (MODE == 0 ? MX_KM : MX_KD)) + (size_t)(b * 4 + h) * TZ * DROW + DOFF;
    const bf16_t* Vt = (const bf16_t*)(ws + WS_EXPW + (MODE == 0 ? MX_VMT : MX_VDT)) + (size_t)(b * 4 + h) * 64 * TZ;
    unsigned char* smem = c.smem;
    bf16x8 qf[KS];
    const int qrow = q0 + wave * 32 + r;
#pragma unroll
    for (int ks = 0; ks < KS; ++ks) qf[ks] = *(const bf16x8*)(Q + (size_t)qrow * DROW + ks * 16 + hh * 8);
    f32x16 oacc[2];
    float mref = 0.f, lrun = 0.f;
#pragma unroll
    for (int t = 0; t < 2; ++t)
#pragma unroll
        for (int i = 0; i < 16; ++i) oacc[t][i] = 0.f;
    constexpr int CPR = DQ / 8, KCH = TK * CPR, NKR = KCH / NTHR;
    static_assert(KCH % NTHR == 0, "whole staging rounds");
    u32x4 kreg[NKR], vreg[2];
    const bf16_t* kp[NKR]; int koff[NKR];
#pragma unroll
    for (int i = 0; i < NKR; ++i) { const int ch = tid + i * NTHR; kp[i] = Kp + ((long)(ch / CPR) - 64) * DROW + (ch % CPR) * 8; koff[i] = (ch / CPR) * KPITCH + (ch % CPR) * 16; }
    const bf16_t* vp = Vt + (size_t)(tid >> 4) * TZ + (tid & 15) * 8 - 64;
    const int voff = (tid >> 4) * VPITCH + (tid & 15) * 16;
    auto gloadK = [&]() {
#pragma unroll
        for (int i = 0; i < NKR; ++i) { kreg[i] = *(const u32x4*)kp[i]; kp[i] += TK * DROW; }
    };
    auto gloadV = [&]() { vreg[0] = *(const u32x4*)vp; vreg[1] = *(const u32x4*)(vp + (size_t)32 * TZ); vp += TK; };
    auto lstoreK = [&](int buf) {
        unsigned char* sk = smem + buf * STG;
#pragma unroll
        for (int i = 0; i < NKR; ++i) *(u32x4*)(sk + koff[i]) = kreg[i];
    };
    auto lstoreV = [&](int buf) { unsigned char* sv = smem + buf * STG + KBYTES; *(u32x4*)(sv + voff) = vreg[0]; *(u32x4*)(sv + voff + 32 * VPITCH) = vreg[1]; };
    const int kbase = r * KPITCH + hh * 16, vbase = KBYTES + r * VPITCH + hh * 8;
    auto ldfrag = [&](const unsigned char* kb, const unsigned char* vb, int ci) -> u32x4 {
        if (ci < 8) {
            const int kg = ci >> 2, s = (ci >> 1) & 1, t = ci & 1;
            const unsigned char* vrow = vb + t * 32 * VPITCH + (kg * 32 + 16 * s) * 2;
            const u32x2 lo = *(const u32x2*)vrow, hi2 = *(const u32x2*)(vrow + 16);
            u32x4 vv; vv.x = lo.x; vv.y = lo.y; vv.z = hi2.x; vv.w = hi2.y; return vv;
        }
        const int q = ci - 8, kg = q & 1, ks = q >> 1;
        return *(const u32x4*)(kb + kg * 32 * KPITCH + ks * 32);
    };
    constexpr int NM = 8 + 2 * KS;
    const f32x16 zero16 = {0.f, 0.f, 0.f, 0.f, 0.f, 0.f, 0.f, 0.f, 0.f, 0.f, 0.f, 0.f, 0.f, 0.f, 0.f, 0.f};
    auto pv_all = [&](const u32x4 (&P)[4], const unsigned char* vb) {
#pragma unroll
        for (int ci = 0; ci < 8; ++ci) { const u32x4 f = ldfrag(vb, vb, ci); oacc[ci & 1] = __builtin_amdgcn_mfma_f32_32x32x16_bf16(__builtin_bit_cast(bf16x8, f), __builtin_bit_cast(bf16x8, P[ci >> 1]), oacc[ci & 1], 0, 0, 0); }
    };
    auto iter = [&](f32x16 (&Sc)[2], f32x16 (&Sn)[2], u32x4 (&Pp)[4], u32x4 (&Pn)[4], const unsigned char* kb, const unsigned char* vb, bool first) {
        u32x4 fcur = ldfrag(kb, vb, 0), fnx1 = ldfrag(kb, vb, 1);
        if (__any(mref != 0.f)) {
#pragma unroll
            for (int kg = 0; kg < 2; ++kg)
#pragma unroll
                for (int i = 0; i < 16; ++i) Sc[kg][i] -= mref;
        }
        f32x2 ps = {0.f, 0.f};
        __builtin_amdgcn_sched_barrier(0);
#pragma unroll
        for (int ci = 0; ci < NM; ++ci) {
            u32x4 fnx2 = fnx1;
            if (ci + 2 < NM) fnx2 = ldfrag(kb, vb, ci + 2);
            if (ci < 8) oacc[ci & 1] = __builtin_amdgcn_mfma_f32_32x32x16_bf16(__builtin_bit_cast(bf16x8, fcur), __builtin_bit_cast(bf16x8, Pp[ci >> 1]), oacc[ci & 1], 0, 0, 0);
            else { const int q = ci - 8, kg = q & 1, ks = q >> 1; Sn[kg] = __builtin_amdgcn_mfma_f32_32x32x16_bf16(__builtin_bit_cast(bf16x8, fcur), qf[ks], ks == 0 ? zero16 : Sn[kg], 0, 0, 0); }
#pragma unroll
            for (int p = (ci * 16) / NM; p < ((ci + 1) * 16) / NM; ++p) {
                const int kg = p >> 3, q = p & 7;
                const float p0 = __builtin_amdgcn_exp2f(Sc[kg][2 * q]), p1 = __builtin_amdgcn_exp2f(Sc[kg][2 * q + 1]);
                ps += (f32x2){p0, p1};
                unsigned pk = pack2(p0, p1); asm volatile("" : "+v"(pk));
                Pn[kg * 2 + (q >> 2)][q & 3] = pk;
            }
            asm volatile("" : "+v"(ps));
            fcur = fnx1; fnx1 = fnx2;
            __builtin_amdgcn_sched_barrier(0);
        }
        const float pst = ps.x + ps.y;
        const bool bad = !(pst < 0x1p90f) || (first && pst < 0x1p-20f);
        if (__any(bad)) {
            float mx = Sc[0][0];
#pragma unroll
            for (int kg = 0; kg < 2; ++kg)
#pragma unroll
                for (int i = 0; i < 16; ++i) mx = fmaxf(mx, Sc[kg][i]);
            mx = fmaxf(mx, __shfl_xor(mx, 32, 64));
            const bool need = (mx > ATT_THR) || (first && mx < -32.f);
            const float d = need ? mx : 0.f;
            const float alpha = first ? 1.f : __builtin_amdgcn_exp2f(-d);
            mref += d; lrun *= alpha;
#pragma unroll
            for (int t = 0; t < 2; ++t)
#pragma unroll
                for (int i = 0; i < 16; ++i) oacc[t][i] *= alpha;
            ps = (f32x2){0.f, 0.f};
#pragma unroll
            for (int pq = 0; pq < 16; ++pq) {
                const int kg = pq >> 3, q = pq & 7;
                const float p0 = __builtin_amdgcn_exp2f(Sc[kg][2 * q] - d), p1 = __builtin_amdgcn_exp2f(Sc[kg][2 * q + 1] - d);
                ps += (f32x2){p0, p1};
                Pn[kg * 2 + (q >> 2)][q & 3] = pack2(p0, p1);
            }
        }
        lrun += ps.x + ps.y;
    };
    const int NT = nkeys / TK;
    f32x16 S0[2], S1[2]; u32x4 PA[4], PB[4];
#pragma unroll
    for (int q = 0; q < 4; ++q) PA[q] = (u32x4){0u, 0u, 0u, 0u};
    __syncthreads();
    gloadK();
    lstoreK(1);
    gloadK();
    if ((tid & 15) >= 8) gloadV(); else { vreg[0] = (u32x4){0u, 0u, 0u, 0u}; vreg[1] = vreg[0]; vp += TK; }
    __syncthreads();
    {
        const unsigned char* kb = smem + STG + 64 * KPITCH + kbase;
#pragma unroll
        for (int q = 0; q < 2 * KS; ++q) { const int kg = q & 1, ks = q >> 1; const u32x4 f = ldfrag(kb, kb, 8 + q); S0[kg] = __builtin_amdgcn_mfma_f32_32x32x16_bf16(__builtin_bit_cast(bf16x8, f), qf[ks], ks == 0 ? zero16 : S0[kg], 0, 0, 0); }
    }
    for (int s = 0; s < NT; ++s) {
        lstoreK(s & 1); lstoreV(s & 1);
        if (s + 1 < NT) gloadK();
        gloadV();
        __syncthreads();
        const unsigned char* sb = smem + (s & 1) * STG;
        iter(S0, S1, PA, PB, sb + kbase, sb + vbase, s == 0);
        iter(S1, S0, PB, PA, sb + 64 * KPITCH + kbase, sb + 128 + vbase, false);
    }
    lstoreV(NT & 1);
    __syncthreads();
    pv_all(PA, smem + (NT & 1) * STG + vbase);
    const float inv = 1.f / (lrun + __shfl_xor(lrun, 32, 64));
    bf16_t* Ycat = (bf16_t*)(ws + WS_BUFA);
    const int zrow = b * TZ + qrow;
    float* park = (float*)(smem + ATT_PARK) + tid;
    if (MODE == 0) {
#pragma unroll
        for (int t = 0; t < 2; ++t)
#pragma unroll
            for (int i4 = 0; i4 < 4; ++i4) {
                const int dv = t * 32 + 8 * i4 + 4 * hh;
                *(u32x2*)(Ycat + (size_t)zrow * D + h * 64 + dv) = pack4(oacc[t][4 * i4] * inv, oacc[t][4 * i4 + 1] * inv, oacc[t][4 * i4 + 2] * inv, oacc[t][4 * i4 + 3] * inv);
            }
    } else if (MODE == 1) {
#pragma unroll
        for (int t = 0; t < 2; ++t)
#pragma unroll
            for (int i = 0; i < 16; ++i) park[(t * 16 + i) * NTHR] = oacc[t][i] * inv;
    } else {
        const float lam = ((const float*)(ws + WS_WSM + OFF_LAM))[l];
        const float lam_init = 0.8f - 0.6f * __expf(-0.3f * (float)l);
        float ss = 0.f;
#pragma unroll
        for (int t = 0; t < 2; ++t)
#pragma unroll
            for (int i = 0; i < 16; ++i) { const float o = park[(t * 16 + i) * NTHR] - lam * oacc[t][i] * inv; oacc[t][i] = o; ss += o * o; }
        ss += __shfl_xor(ss, 32, 64);
        const float rs = rsqrtf(ss * (1.f / 64.f) + 1e-5f) * (1.f - lam_init);
        const float* sg = c.in[38] + l * 64;
#pragma unroll
        for (int t = 0; t < 2; ++t)
#pragma unroll
            for (int i4 = 0; i4 < 4; ++i4) {
                const int dv = t * 32 + 8 * i4 + 4 * hh; const float4 g = *(const float4*)(sg + dv);
                *(u32x2*)(Ycat + (size_t)zrow * D + 768 + h * 64 + dv) = pack4(oacc[t][4 * i4] * rs * g.x, oacc[t][4 * i4 + 1] * rs * g.y, oacc[t][4 * i4 + 2] * rs * g.z, oacc[t][4 * i4 + 3] * rs * g.w);
            }
    }
}
DI void phase_attention(const Ctx& c, int l) {
    const int nu = 512 + (l == 0 ? 16 : 0);
    for (int u = blockIdx.x; u < nu; u += gridDim.x) {
        int b, h, q0, nk; bool mla;
        if (u < 512) { const int k = u & 255, bh = k & 7; b = bh >> 2; h = bh & 3; q0 = CTX + (k >> 3) * 256; nk = TZ; mla = u < 256; }
        else { const int k = u - 512; b = (k >> 2) & 1; h = k & 3; q0 = 0; nk = CTX; mla = k < 8; }
        if (mla) attn_pass<0>(c, l, b, h, q0, nk);
        else { attn_pass<1>(c, l, b, h, q0, nk); attn_pass<2>(c, l, b, h, q0, nk); }
    }
}

DI int rw_tok(int dir, int i) { return dir == 0 ? i : (i < CTX ? CTX - 1 - i : TZ - 1 - (i - CTX)); }
constexpr int RW_TS = 32;
constexpr int RW_STEP_F = 6 * 64 + 2;
constexpr int RW_BUF_F = RW_TS * RW_STEP_F;
template <int CTRL> DI float dpp_add(float x) { return x + __int_as_float(__builtin_amdgcn_update_dpp(0, __float_as_int(x), CTRL, 0xf, 0xf, false)); }
DI float red16(float x) { x = dpp_add<0xB1>(x); x = dpp_add<0x4E>(x); x = dpp_add<0x141>(x); x = dpp_add<0x140>(x); return x; }
DI float red8(float x) { x = dpp_add<0xB1>(x); x = dpp_add<0x4E>(x); x = dpp_add<0x141>(x); return x; }
struct RwRegs { u32x4 r, v, kk, e, ad, kd; };
DI void rw_load(const Ctx& c, int b, int h, int dir, int chunk, int t, RwRegs& g) {
    const bf16_t* RB = (const bf16_t*)(c.ws + WS_EXPW + MX_RB); const bf16_t* VB = (const bf16_t*)(c.ws + WS_EXPW + MX_VB); const bf16_t* KKB = (const bf16_t*)(c.ws + WS_EXPW + MX_KKB);
    const bf16_t* SE = (const bf16_t*)(c.ws + WS_P + P_PR) + (size_t)dir * NZ * 256; const bf16_t* SAD = SE + (size_t)2 * NZ * 256; const bf16_t* SKD = SAD + (size_t)2 * NZ * 256;
    const int i = chunk * RW_TS + (t >> 3), z = b * TZ + rw_tok(dir, i); const size_t o = (size_t)z * 256 + h * 64 + (t & 7) * 8;
    g.r = *(const u32x4*)(RB + o); g.v = *(const u32x4*)(VB + o); g.kk = *(const u32x4*)(KKB + o);
    g.e = *(const u32x4*)(SE + o); g.ad = *(const u32x4*)(SAD + o); g.kd = *(const u32x4*)(SKD + o);
}
DI void up8(const u32x4& u, float (&f)[8]) { f[0] = lo2f(u.x); f[1] = hi2f(u.x); f[2] = lo2f(u.y); f[3] = hi2f(u.y); f[4] = lo2f(u.z); f[5] = hi2f(u.z); f[6] = lo2f(u.w); f[7] = hi2f(u.w); }
DI void rw_process(const RwRegs& g, int t, float* buf) {
    float r[8], v[8], kk[8], e[8], ad[8], kd[8];
    up8(g.r, r); up8(g.v, v); up8(g.kk, kk); up8(g.e, e); up8(g.ad, ad); up8(g.kd, kd);
    float* f = buf + (t >> 3) * RW_STEP_F + (t & 7) * 8;
    float w[8], bv[8], wr[8]; float br = 0.f, kr = 0.f;
#pragma unroll
    for (int j = 0; j < 8; ++j) { w[j] = __expf(-e[j]); bv[j] = kk[j] * ad[j]; wr[j] = w[j] * r[j]; br += bv[j] * r[j]; kr += kd[j] * r[j]; }
    *(float4*)(f) = make_float4(w[0], w[1], w[2], w[3]); *(float4*)(f + 4) = make_float4(w[4], w[5], w[6], w[7]);
    *(float4*)(f + 64) = make_float4(kk[0], kk[1], kk[2], kk[3]); *(float4*)(f + 68) = make_float4(kk[4], kk[5], kk[6], kk[7]);
    *(float4*)(f + 128) = make_float4(bv[0], bv[1], bv[2], bv[3]); *(float4*)(f + 132) = make_float4(bv[4], bv[5], bv[6], bv[7]);
    *(float4*)(f + 192) = make_float4(kd[0], kd[1], kd[2], kd[3]); *(float4*)(f + 196) = make_float4(kd[4], kd[5], kd[6], kd[7]);
    *(float4*)(f + 256) = make_float4(wr[0], wr[1], wr[2], wr[3]); *(float4*)(f + 260) = make_float4(wr[4], wr[5], wr[6], wr[7]);
    *(float4*)(f + 320) = make_float4(v[0], v[1], v[2], v[3]); *(float4*)(f + 324) = make_float4(v[4], v[5], v[6], v[7]);
    br = red8(br); kr = red8(kr);
    if ((t & 7) == 0) { float* s = buf + (t >> 3) * RW_STEP_F + 384; s[0] = br; s[1] = kr; }
}
struct RwStep { float4 w, kk, bv, kd, wr; float vv, br, kr; };
DI void rw_ld(RwStep& s, const float* f, int kq, int row) {
    s.w = *(const float4*)(f + kq * 4); s.kk = *(const float4*)(f + 64 + kq * 4); s.bv = *(const float4*)(f + 128 + kq * 4);
    s.kd = *(const float4*)(f + 192 + kq * 4); s.wr = *(const float4*)(f + 256 + kq * 4); s.vv = f[320 + row]; s.br = f[384]; s.kr = f[385];
}
DI void phase_rwkv_scan_unit(const Ctx& c, int l, int u) {
    const int rg = u & 3, chain = u >> 2, dir = chain & 1, h = (chain >> 1) & 3, b = chain >> 3;
    float* buf0 = (float*)c.smem; float* buf1 = buf0 + RW_BUF_F;
    float* ybuf = buf1 + RW_BUF_F;
    float* YO = (float*)(c.ws + WS_BUFB) + (size_t)dir * NZ * 256 + (size_t)b * TZ * 256 + h * 64 + rg * 16;
    const int wave = c.wave, lane = c.lane, rr = lane >> 4, kq = lane & 15, rl = (wave & 3) * 4 + rr, row = rg * 16 + rl;
    const int t = c.tid - 256;
    float S0 = 0.f, S1 = 0.f, S2 = 0.f, S3 = 0.f;
    constexpr int NCH = TZ / RW_TS;
    RwRegs g;
    __syncthreads();
    if (wave >= 4) { rw_load(c, b, h, dir, 0, t, g); rw_process(g, t, buf0); rw_load(c, b, h, dir, 1, t, g); }
    __syncthreads();
    for (int ch = 0; ch < NCH; ++ch) {
        float* cur = buf0 + (ch & 1) * RW_BUF_F; float* nxt = buf0 + ((ch + 1) & 1) * RW_BUF_F;
        if (wave >= 4) {
            if (ch > 0) {
                const float* yb = ybuf + ((ch - 1) & 1) * RW_TS * 16;
#pragma unroll
                for (int i = 0; i < 2; ++i) { const int e = t + i * 256, st = e >> 4, rw = e & 15; YO[(size_t)rw_tok(dir, (ch - 1) * RW_TS + st) * 256 + rw] = yb[e]; }
            }
            if (ch + 1 < NCH) rw_process(g, t, nxt);
            if (ch + 2 < NCH) rw_load(c, b, h, dir, ch + 2, t, g);
        } else {
            float* yb = ybuf + (ch & 1) * RW_TS * 16 + rl;
            RwStep s0, s1;
            rw_ld(s0, cur, kq, row);
#pragma unroll 4
            for (int st = 0; st < RW_TS; st += 2) {
                rw_ld(s1, cur + (st + 1) * RW_STEP_F, kq, row);
                {
                    float sa = -((S0 * s0.kk.x + S1 * s0.kk.y) + (S2 * s0.kk.z + S3 * s0.kk.w));
                    float q = (S0 * s0.wr.x + S1 * s0.wr.y) + (S2 * s0.wr.z + S3 * s0.wr.w);
                    sa = red16(sa); q = red16(q);
                    S0 = fmaf(sa, s0.bv.x, fmaf(S0, s0.w.x, s0.vv * s0.kd.x)); S1 = fmaf(sa, s0.bv.y, fmaf(S1, s0.w.y, s0.vv * s0.kd.y));
                    S2 = fmaf(sa, s0.bv.z, fmaf(S2, s0.w.z, s0.vv * s0.kd.z)); S3 = fmaf(sa, s0.bv.w, fmaf(S3, s0.w.w, s0.vv * s0.kd.w));
                    yb[st * 16] = q + sa * s0.br + s0.vv * s0.kr;
                }
                if (st + 2 < RW_TS) rw_ld(s0, cur + (st + 2) * RW_STEP_F, kq, row);
                {
                    float sa = -((S0 * s1.kk.x + S1 * s1.kk.y) + (S2 * s1.kk.z + S3 * s1.kk.w));
                    float q = (S0 * s1.wr.x + S1 * s1.wr.y) + (S2 * s1.wr.z + S3 * s1.wr.w);
                    sa = red16(sa); q = red16(q);
                    S0 = fmaf(sa, s1.bv.x, fmaf(S0, s1.w.x, s1.vv * s1.kd.x)); S1 = fmaf(sa, s1.bv.y, fmaf(S1, s1.w.y, s1.vv * s1.kd.y));
                    S2 = fmaf(sa, s1.bv.z, fmaf(S2, s1.w.z, s1.vv * s1.kd.z)); S3 = fmaf(sa, s1.bv.w, fmaf(S3, s1.w.w, s1.vv * s1.kd.w));
                    yb[(st + 1) * 16] = q + sa * s1.br + s1.vv * s1.kr;
                }
            }
        }
        __syncthreads();
    }
    if (wave >= 4) {
        const float* yb = ybuf + ((NCH - 1) & 1) * RW_TS * 16;
#pragma unroll
        for (int i = 0; i < 2; ++i) { const int e = t + i * 256, st = e >> 4, rw = e & 15; YO[(size_t)rw_tok(dir, (NCH - 1) * RW_TS + st) * 256 + rw] = yb[e]; }
    }
}

constexpr int LA_AN = 0, LA_RN = 8192, LA_BN = 16384, LA_KN = 24576, LA_AT = 32768, LA_BHT = 40960, LA_KHT = 49152, LA_VT = 57344,
              LA_NBA = 65536  , LA_NKA = 81920, LA_NBRT = 90112, LA_NKRT = 98304, LA_P63 = 106496;
constexpr int LA_TMT = LA_AN, LA_M1 = LA_BN, LA_W1T = LA_KN, LA_Z1 = LA_NBA;
DI int crow(int reg, int h) { return (reg & 3) + 8 * (reg >> 2) + 4 * h; }
DI void mm_tile(f32x16& acc, const unsigned char* A, int i0, const unsigned char* BT, int j0, int r, int h) {
#pragma unroll
    for (int ks = 0; ks < 4; ++ks) {
        const bf16x8 a = *(const bf16x8*)(A + (i0 + r) * 128 + ks * 32 + h * 16);
        const bf16x8 b = *(const bf16x8*)(BT + (j0 + r) * 128 + ks * 32 + h * 16);
        acc = __builtin_amdgcn_mfma_f32_32x32x16_bf16(a, b, acc, 0, 0, 0);
    }
}
DI void zero16(f32x16& a) {
#pragma unroll
    for (int i = 0; i < 16; ++i) a[i] = 0.f;
}
DI void phase_rwkv_chunk_unit(const Ctx& c, int l, int unit) {
    unsigned char* L = c.smem; unsigned char* ws = c.ws;
    const int chain = unit / RNC, ch = unit % RNC, dir = chain & 1, hd = (chain >> 1) & 3, b = chain >> 3;
    const int tid = c.tid, lane = c.lane, wave = c.wave, r = lane & 31, h = lane >> 5;
    const bf16_t* RB = (const bf16_t*)(ws + WS_EXPW + MX_RB); const bf16_t* VB = (const bf16_t*)(ws + WS_EXPW + MX_VB); const bf16_t* KKB = (const bf16_t*)(ws + WS_EXPW + MX_KKB);
    const bf16_t* SE = (const bf16_t*)(ws + WS_P + P_PR) + (size_t)dir * NZ * 256; const bf16_t* SAD = SE + (size_t)2 * NZ * 256; const bf16_t* SKD = SAD + (size_t)2 * NZ * 256;
    float* CUM = (float*)(L + LA_NBA);
    __syncthreads();
    const int t = tid >> 3, k0 = (tid & 7) * 8;
    float rr[8], vv[8], kk[8], ee[8], ad[8], kd[8];
    {
        const int z = b * TZ + rw_tok(dir, ch * RC + t); const size_t o = (size_t)z * 256 + hd * 64 + k0;
        up8(*(const u32x4*)(RB + o), rr); up8(*(const u32x4*)(VB + o), vv); up8(*(const u32x4*)(KKB + o), kk);
        up8(*(const u32x4*)(SE + o), ee); up8(*(const u32x4*)(SAD + o), ad); up8(*(const u32x4*)(SKD + o), kd);
        *(float4*)(CUM + t * 64 + k0) = make_float4(ee[0], ee[1], ee[2], ee[3]); *(float4*)(CUM + t * 64 + k0 + 4) = make_float4(ee[4], ee[5], ee[6], ee[7]);
    }
    __syncthreads();
    if (wave == 0) { float cm = 0.f;
#pragma unroll 8
        for (int i = 0; i < RC; ++i) { cm += CUM[i * 64 + lane]; CUM[i * 64 + lane] = cm; } }
    __syncthreads();
    {
        float cm[8], c63[8];
        { const float4 a = *(const float4*)(CUM + t * 64 + k0), bq = *(const float4*)(CUM + t * 64 + k0 + 4); cm[0] = a.x; cm[1] = a.y; cm[2] = a.z; cm[3] = a.w; cm[4] = bq.x; cm[5] = bq.y; cm[6] = bq.z; cm[7] = bq.w; }
        { const float4 a = *(const float4*)(CUM + 63 * 64 + k0), bq = *(const float4*)(CUM + 63 * 64 + k0 + 4); c63[0] = a.x; c63[1] = a.y; c63[2] = a.z; c63[3] = a.w; c63[4] = bq.x; c63[5] = bq.y; c63[6] = bq.z; c63[7] = bq.w; }
        float at[8], rt[8], bt[8], kt[8], bh[8], kh[8];
#pragma unroll
        for (int j = 0; j < 8; ++j) {
            const float pt = __expf(-cm[j]), pp = __expf(-(cm[j] - ee[j])), ip = __expf(cm[j]), ph = __expf(-(c63[j] - cm[j])), bb = kk[j] * ad[j];
            at[j] = -kk[j] * pp; rt[j] = rr[j] * pt; bt[j] = bb * ip; kt[j] = kd[j] * ip; bh[j] = bb * ph; kh[j] = kd[j] * ph;
        }
        u32x4 w4;
        w4.x = pack2(at[0], at[1]); w4.y = pack2(at[2], at[3]); w4.z = pack2(at[4], at[5]); w4.w = pack2(at[6], at[7]); *(u32x4*)(L + LA_AN + t * 128 + k0 * 2) = w4;
        w4.x = pack2(rt[0], rt[1]); w4.y = pack2(rt[2], rt[3]); w4.z = pack2(rt[4], rt[5]); w4.w = pack2(rt[6], rt[7]); *(u32x4*)(L + LA_RN + t * 128 + k0 * 2) = w4;
        w4.x = pack2(bt[0], bt[1]); w4.y = pack2(bt[2], bt[3]); w4.z = pack2(bt[4], bt[5]); w4.w = pack2(bt[6], bt[7]); *(u32x4*)(L + LA_BN + t * 128 + k0 * 2) = w4;
        w4.x = pack2(kt[0], kt[1]); w4.y = pack2(kt[2], kt[3]); w4.z = pack2(kt[4], kt[5]); w4.w = pack2(kt[6], kt[7]); *(u32x4*)(L + LA_KN + t * 128 + k0 * 2) = w4;
#pragma unroll
        for (int j = 0; j < 8; ++j) {
            *(bf16_t*)(L + LA_AT + (k0 + j) * 128 + t * 2) = f2bf(at[j]); *(bf16_t*)(L + LA_BHT + (k0 + j) * 128 + t * 2) = f2bf(bh[j]);
            *(bf16_t*)(L + LA_KHT + (k0 + j) * 128 + t * 2) = f2bf(kh[j]); *(bf16_t*)(L + LA_VT + (k0 + j) * 128 + t * 2) = f2bf(vv[j]);
        }
        if (t == 63) {
            float* p63 = (float*)(L + LA_P63); float* gp = (float*)(ws + WS_RW + RW_P63) + (size_t)unit * 64;
#pragma unroll
            for (int j = 0; j < 8; ++j) { const float p = __expf(-c63[j]); p63[k0 + j] = p; gp[k0 + j] = p; }
        }
    }
    __syncthreads();
    {
        const int p = wave >> 1, i0 = (wave & 1) * 32;
        const unsigned char* A = L + (p == 0 ? LA_BN : p == 1 ? LA_KN : LA_RN);
        const unsigned char* BT = L + (p < 2 ? LA_AN : p == 2 ? LA_BN : LA_KN);
#pragma unroll
        for (int jt = 0; jt < 2; ++jt) {
            const int j0 = jt * 32; f32x16 acc; zero16(acc);
            mm_tile(acc, A, i0, BT, j0, r, h);
            const int col = j0 + r;
#pragma unroll
            for (int g = 0; g < 16; ++g) {
                const int row = i0 + crow(g, h);
                if (p == 0) ((float*)(L + LA_NBA))[row * 64 + col] = (row < col) ? acc[g] : 0.f;
                else if (p == 1) *(bf16_t*)(L + LA_NKA + row * 128 + col * 2) = f2bf((row < col) ? acc[g] : 0.f);
                else *(bf16_t*)(L + (p == 2 ? LA_NBRT : LA_NKRT) + row * 128 + col * 2) = f2bf((col <= row) ? acc[g] : 0.f);
            }
        }
    }
    __syncthreads();
    {
        constexpr int X0 = LA_BN, X1 = LA_KN, X3 = 108544, X4 = X3 + 8192, X5 = LA_NBA + 16384 - 16384, X6 = LA_NBA + 8192;
        float nv[8];
        { const int s = tid >> 3, t0 = (tid & 7) * 8; const float* N = (const float*)(L + LA_NBA) + s * 64 + t0;
          const float4 a = *(const float4*)N, bq = *(const float4*)(N + 4); nv[0] = a.x; nv[1] = a.y; nv[2] = a.z; nv[3] = a.w; nv[4] = bq.x; nv[5] = bq.y; nv[6] = bq.z; nv[7] = bq.w; }
        __syncthreads();
        {
            const int s = tid >> 3, t0 = (tid & 7) * 8;
            u32x4 w4; w4.x = pack2(nv[0], nv[1]); w4.y = pack2(nv[2], nv[3]); w4.z = pack2(nv[4], nv[5]); w4.w = pack2(nv[6], nv[7]);
            *(u32x4*)(L + X0 + s * 128 + t0 * 2) = w4;
#pragma unroll
            for (int j = 0; j < 8; ++j) *(bf16_t*)(L + X1 + (t0 + j) * 128 + s * 2) = f2bf(nv[j]);
#pragma unroll
            for (int j = 0; j < 8; ++j) if (t0 + j == s) nv[j] += 1.f;
            w4.x = pack2(nv[0], nv[1]); w4.y = pack2(nv[2], nv[3]); w4.z = pack2(nv[4], nv[5]); w4.w = pack2(nv[6], nv[7]);
            *(u32x4*)(L + X5 + s * 128 + t0 * 2) = w4;
        }
        __syncthreads();
        const int ti0 = ((wave >> 1) & 1) * 32, tj0 = (wave & 1) * 32;
        if (wave < 4) {
            f32x16 acc; zero16(acc); mm_tile(acc, L + X0, ti0, L + X1, tj0, r, h);
#pragma unroll
            for (int g4 = 0; g4 < 4; ++g4) *(u32x2*)(L + X4 + (tj0 + r) * 128 + (ti0 + 8 * g4 + 4 * h) * 2) = pack4(acc[4 * g4], acc[4 * g4 + 1], acc[4 * g4 + 2], acc[4 * g4 + 3]);
#pragma unroll
            for (int g = 0; g < 16; ++g) *(bf16_t*)(L + X3 + (ti0 + crow(g, h)) * 128 + (tj0 + r) * 2) = f2bf(acc[g]);
        }
        __syncthreads();
#pragma unroll
        for (int k = 1; k <= 5; ++k) {
            const int qa = (k & 1) ? X3 : X0, qt = (k & 1) ? X4 : X1, nqa = (k & 1) ? X0 : X3, nqt = (k & 1) ? X1 : X4;
            const int pa = (k & 1) ? X5 : X6, npa = (k & 1) ? X6 : X5;
            if (wave >= 4) {
                f32x16 acc; zero16(acc); mm_tile(acc, L + pa, ti0, L + qt, tj0, r, h);
#pragma unroll
                for (int g = 0; g < 16; ++g) acc[g] += bf2f(*(const bf16_t*)(L + pa + (ti0 + crow(g, h)) * 128 + (tj0 + r) * 2));
                if (k < 5) {
#pragma unroll
                    for (int g = 0; g < 16; ++g) *(bf16_t*)(L + npa + (ti0 + crow(g, h)) * 128 + (tj0 + r) * 2) = f2bf(acc[g]);
                } else {
#pragma unroll
                    for (int g4 = 0; g4 < 4; ++g4) *(u32x2*)(L + LA_TMT + (tj0 + r) * 128 + (ti0 + 8 * g4 + 4 * h) * 2) = pack4(acc[4 * g4], acc[4 * g4 + 1], acc[4 * g4 + 2], acc[4 * g4 + 3]);
                }
            } else if (k < 5) {
                f32x16 acc; zero16(acc); mm_tile(acc, L + qa, ti0, L + qt, tj0, r, h);
#pragma unroll
                for (int g4 = 0; g4 < 4; ++g4) *(u32x2*)(L + nqt + (tj0 + r) * 128 + (ti0 + 8 * g4 + 4 * h) * 2) = pack4(acc[4 * g4], acc[4 * g4 + 1], acc[4 * g4 + 2], acc[4 * g4 + 3]);
#pragma unroll
                for (int g = 0; g < 16; ++g) *(bf16_t*)(L + nqa + (ti0 + crow(g, h)) * 128 + (tj0 + r) * 2) = f2bf(acc[g]);
            }
            __syncthreads();
        }
    }
    {
        const int p = wave >> 2, i0 = ((wave >> 1) & 1) * 32, j0 = (wave & 1) * 32; f32x16 acc; zero16(acc);
        if (p == 0) {
            mm_tile(acc, L + LA_TMT, i0, L + LA_AT, j0, r, h);
#pragma unroll
            for (int g4 = 0; g4 < 4; ++g4) *(u32x2*)(L + LA_M1 + (j0 + r) * 128 + (i0 + 8 * g4 + 4 * h) * 2) = pack4(acc[4 * g4], acc[4 * g4 + 1], acc[4 * g4 + 2], acc[4 * g4 + 3]);
        } else {
            mm_tile(acc, L + LA_NKA, i0, L + LA_TMT, j0, r, h);
#pragma unroll
            for (int g4 = 0; g4 < 4; ++g4) *(u32x2*)(L + LA_W1T + (j0 + r) * 128 + (i0 + 8 * g4 + 4 * h) * 2) = pack4(acc[4 * g4], acc[4 * g4 + 1], acc[4 * g4 + 2], acc[4 * g4 + 3]);
        }
    }
    __syncthreads();
    if (wave < 4) {
        const int i0 = (wave >> 1) * 32, j0 = (wave & 1) * 32; f32x16 acc; zero16(acc);
        mm_tile(acc, L + LA_W1T, i0, L + LA_VT, j0, r, h);
#pragma unroll
        for (int g4 = 0; g4 < 4; ++g4) *(u32x2*)(L + LA_Z1 + (j0 + r) * 128 + (i0 + 8 * g4 + 4 * h) * 2) = pack4(acc[4 * g4], acc[4 * g4 + 1], acc[4 * g4 + 2], acc[4 * g4 + 3]);
    }
    __syncthreads();
    {
        const int p = wave >> 1, i0 = (wave & 1) * 32;
        bf16_t* GM3 = (bf16_t*)(ws + WS_RW + RW_M3) + (size_t)unit * 4096; bf16_t* GM2 = (bf16_t*)(ws + WS_RW + RW_M2) + (size_t)unit * 4096; bf16_t* GZ5 = (bf16_t*)(ws + WS_RW + RW_Z5) + (size_t)unit * 4096;
        float* YO = (float*)(ws + WS_BUFB) + (size_t)dir * NZ * 256;
#pragma unroll
        for (int jt = 0; jt < 2; ++jt) {
            const int j0 = jt * 32; f32x16 acc; zero16(acc);
            if (p == 0) {
                mm_tile(acc, L + LA_M1, i0, L + LA_NBRT, j0, r, h);
#pragma unroll
                for (int g4 = 0; g4 < 4; ++g4) { const int tt = j0 + r, kq = i0 + 8 * g4 + 4 * h; float rv[4]; unpack4(*(const u32x2*)(L + LA_RN + tt * 128 + kq * 2), rv);
                    *(u32x2*)(GM2 + tt * 64 + kq) = pack4(acc[4 * g4] + rv[0], acc[4 * g4 + 1] + rv[1], acc[4 * g4 + 2] + rv[2], acc[4 * g4 + 3] + rv[3]); }
            } else if (p == 1) {
                mm_tile(acc, L + LA_NBRT, i0, L + LA_Z1, j0, r, h); mm_tile(acc, L + LA_NKRT, i0, L + LA_VT, j0, r, h);
#pragma unroll
                for (int g = 0; g < 16; ++g) { const int tt = i0 + crow(g, h); YO[(size_t)(b * TZ + rw_tok(dir, ch * RC + tt)) * 256 + hd * 64 + j0 + r] = acc[g]; }
            } else if (p == 2) {
                mm_tile(acc, L + LA_M1, i0, L + LA_BHT, j0, r, h);
#pragma unroll
                for (int g4 = 0; g4 < 4; ++g4) *(u32x2*)(GM3 + (j0 + r) * 64 + i0 + 8 * g4 + 4 * h) = pack4(acc[4 * g4], acc[4 * g4 + 1], acc[4 * g4 + 2], acc[4 * g4 + 3]);
            } else {
                mm_tile(acc, L + LA_BHT, i0, L + LA_Z1, j0, r, h); mm_tile(acc, L + LA_KHT, i0, L + LA_VT, j0, r, h);
#pragma unroll
                for (int g4 = 0; g4 < 4; ++g4) *(u32x2*)(GZ5 + (j0 + r) * 64 + i0 + 8 * g4 + 4 * h) = pack4(acc[4 * g4], acc[4 * g4 + 1], acc[4 * g4 + 2], acc[4 * g4 + 3]);
            }
        }
    }
}
DI void phase_rwkv_chunks(const Ctx& c, int l) {
    for (int u = blockIdx.x; u < 16 * RNC; u += gridDim.x) phase_rwkv_chunk_unit(c, l, u);
}
DI bf16x8 pack8(const f32x16& x, int s) {
    u32x4 p; p.x = pack2(x[8 * s], x[8 * s + 1]); p.y = pack2(x[8 * s + 2], x[8 * s + 3]); p.z = pack2(x[8 * s + 4], x[8 * s + 5]); p.w = pack2(x[8 * s + 6], x[8 * s + 7]);
    return __builtin_bit_cast(bf16x8, p);
}
DI bf16x8 ldfrag(const bf16_t* rowp, int s, int h) {
    const u32x2 lo = *(const u32x2*)(rowp + 16 * s + 4 * h), hi = *(const u32x2*)(rowp + 16 * s + 8 + 4 * h);
    u32x4 v; v.x = lo.x; v.y = lo.y; v.z = hi.x; v.w = hi.y; return __builtin_bit_cast(bf16x8, v);
}
constexpr int SQ_PITCH = 144, SQ_MAT = 64 * SQ_PITCH;
constexpr int SQA_M3 = 0, SQA_Z5 = SQ_MAT, SQA_P63 = 2 * SQ_MAT, SQA_BYTES = SQA_P63 + 256;
constexpr int SQB_M2 = 0, SQB_Y = SQ_MAT, SQB_BYTES = SQB_Y + 64 * 64 * 4;
constexpr int SQ_NST = 3;
constexpr int SQ_A0 = 0, SQ_B0 = SQ_NST * SQA_BYTES, SQ_XB = SQ_B0 + SQ_NST * SQB_BYTES, SQ_END = SQ_XB + 4 * 4096;
DI bf16x8 ldfrag_l(const unsigned char* rowp, int s, int h) {
    const u32x2 lo = *(const u32x2*)(rowp + (16 * s + 4 * h) * 2), hi = *(const u32x2*)(rowp + (16 * s + 8 + 4 * h) * 2);
    u32x4 v; v.x = lo.x; v.y = lo.y; v.z = hi.x; v.w = hi.y; return __builtin_bit_cast(bf16x8, v);
}
struct SqRegsA { u32x4 m3[2], z5[2], p63; };
struct SqRegsB { u32x4 m2[2], y[4]; };
DI void sqa_gload(const Ctx& c, size_t unit, int lt, SqRegsA& g) {
    const unsigned char* g3 = c.ws + WS_RW + RW_M3 + unit * 8192; const unsigned char* g5 = c.ws + WS_RW + RW_Z5 + unit * 8192;
#pragma unroll
    for (int i = 0; i < 2; ++i) { const int id = lt + i * 256; g.m3[i] = *(const u32x4*)(g3 + id * 16); g.z5[i] = *(const u32x4*)(g5 + id * 16); }
    if (lt < 16) g.p63 = *(const u32x4*)(c.ws + WS_RW + RW_P63 + unit * 256 + lt * 16);
}
DI void sqa_lstore(unsigned char* st, int lt, const SqRegsA& g) {
#pragma unroll
    for (int i = 0; i < 2; ++i) { const int id = lt + i * 256, row = id >> 3, part = id & 7;
        *(u32x4*)(st + SQA_M3 + row * SQ_PITCH + part * 16) = g.m3[i]; *(u32x4*)(st + SQA_Z5 + row * SQ_PITCH + part * 16) = g.z5[i]; }
    if (lt < 16) *(u32x4*)(st + SQA_P63 + lt * 16) = g.p63;
}
DI void sqb_gload(const Ctx& c, size_t unit, const float* YO, int dir, int ch, int lt, SqRegsB& g) {
    const unsigned char* g2 = c.ws + WS_RW + RW_M2 + unit * 8192;
#pragma unroll
    for (int i = 0; i < 2; ++i) g.m2[i] = *(const u32x4*)(g2 + (lt + i * 256) * 16);
#pragma unroll
    for (int i = 0; i < 4; ++i) { const int id = lt + i * 256; g.y[i] = *(const u32x4*)(YO + (size_t)rw_tok(dir, ch * RC + (id >> 4)) * 256 + (id & 15) * 4); }
}
DI void sqb_lstore(unsigned char* st, int lt, const SqRegsB& g) {
#pragma unroll
    for (int i = 0; i < 2; ++i) { const int id = lt + i * 256; *(u32x4*)(st + SQB_M2 + (id >> 3) * SQ_PITCH + (id & 7) * 16) = g.m2[i]; }
#pragma unroll
    for (int i = 0; i < 4; ++i) { const int id = lt + i * 256; *(u32x4*)(st + SQB_Y + (id >> 4) * 256 + (id & 15) * 16) = g.y[i]; }
}
DI void sqb_store_y(float* YO, int dir, int ch, const unsigned char* st, int lt, int vhb) {
#pragma unroll
    for (int i = 0; i < 2; ++i) { const int id = lt + i * 256; *(u32x4*)(YO + (size_t)rw_tok(dir, ch * RC + (id >> 3)) * 256 + vhb * 32 + (id & 7) * 4) = *(const u32x4*)(st + SQB_Y + id * 16); }
}
DI void phase_rwkv_seq_block(const Ctx& c, int l, int chain, int vhb) {
    unsigned char* L = c.smem; const int lane = c.lane, wave = c.wave, r = lane & 31, h = lane >> 5;
    const int dir = chain & 1, hd = (chain >> 1) & 3, b = chain >> 3, lt = c.tid - 256, vh = vhb; const bool act = (wave & 1) == 0;
    const size_t unit0 = (size_t)chain * RNC;
    __syncthreads();
    if (wave >= 4) {
        float* YO = (float*)(c.ws + WS_BUFB) + (size_t)dir * NZ * 256 + (size_t)b * TZ * 256 + hd * 64;
        const int lt2 = lt & 255;
        int moff[3], mdst[3];
#pragma unroll
        for (int i = 0; i < 3; ++i) { const int id = i < 2 ? lt2 + 256 * i : 512 + lane; const int row = id / 9, ck = id - row * 9; moff[i] = row * 128 + (ck == 8 ? 7 : ck) * 16; mdst[i] = id * 16; }
        int zoff[2], zdst[2];
#pragma unroll
        for (int i = 0; i < 2; ++i) { const int id = i == 0 ? lt2 : 256 + lane; int row = id / 9; const int ck = id - row * 9; zdst[i] = (vhb * 32 * 9 + id) * 16; row += vhb * 32; if (row > 63) row = 63; zoff[i] = row * 128 + (ck == 8 ? 7 : ck) * 16; }
        const unsigned char* gM3 = c.ws + WS_RW + RW_M3; const unsigned char* gZ5 = c.ws + WS_RW + RW_Z5; const unsigned char* gM2 = c.ws + WS_RW + RW_M2; const unsigned char* gP = c.ws + WS_RW + RW_P63;
        auto dmaA = [&](int ch, int stg) {
            const size_t unit = unit0 + (ch < RNC ? ch : RNC - 1); unsigned char* st = L + SQ_A0 + stg * SQA_BYTES;
#pragma unroll
            for (int i = 0; i < 3; ++i) __builtin_amdgcn_global_load_lds((const unsigned*)(gM3 + unit * 8192 + moff[i]), (unsigned*)(st + SQA_M3 + mdst[i]), 16, 0, 0);
            __builtin_amdgcn_global_load_lds((const unsigned*)(gZ5 + unit * 8192 + zoff[0]), (unsigned*)(st + SQA_Z5 + zdst[0]), 16, 0, 0);
            if (lane < 32) __builtin_amdgcn_global_load_lds((const unsigned*)(gZ5 + unit * 8192 + zoff[1]), (unsigned*)(st + SQA_Z5 + zdst[1]), 16, 0, 0);
            if (lane < 16) __builtin_amdgcn_global_load_lds((const unsigned*)(gP + unit * 256 + lane * 16), (unsigned*)(st + SQA_P63 + lane * 16), 16, 0, 0);
        };
        auto dmaB = [&](int ch, int stg) {
            const int cc = ch < RNC ? ch : RNC - 1; const size_t unit = unit0 + cc; unsigned char* st = L + SQ_B0 + stg * SQB_BYTES;
#pragma unroll
            for (int i = 0; i < 3; ++i) __builtin_amdgcn_global_load_lds((const unsigned*)(gM2 + unit * 8192 + moff[i]), (unsigned*)(st + SQB_M2 + mdst[i]), 16, 0, 0);
#pragma unroll
            for (int i = 0; i < 2; ++i) { const int id = lt2 + i * 256; __builtin_amdgcn_global_load_lds((const unsigned*)(YO + (size_t)rw_tok(dir, cc * RC + (id >> 3)) * 256 + vhb * 32 + (id & 7) * 4), (unsigned*)(st + SQB_Y + id * 16), 16, 0, 0); }
        };
        dmaA(0, 0); dmaA(1, 1); dmaB(0, 0);
        asm volatile("s_waitcnt vmcnt(0)" ::: "memory");
        __builtin_amdgcn_s_barrier();
        int sa2 = 2, sb1 = 1;
#pragma unroll 1
        for (int ch = 0; ch <= RNC; ++ch) {
            if (ch >= 2) sqb_store_y(YO, dir, ch - 2, L + SQ_B0 + sb1 * SQB_BYTES, lt2, vhb);
            asm volatile("" ::: "memory");
            dmaA(ch + 2, sa2); dmaB(ch + 1, sb1);
            asm volatile("s_waitcnt vmcnt(11)" ::: "memory");
            __builtin_amdgcn_s_barrier();
            asm volatile("" ::: "memory");
            sa2 = sa2 == 2 ? 0 : sa2 + 1; sb1 = sb1 == 2 ? 0 : sb1 + 1;
        }
        sqb_store_y(YO, dir, RNC - 1, L + SQ_B0 + ((RNC - 1) % 3) * SQB_BYTES, lt2, vhb);
    } else if (wave < 2) {
        f32x16 x[2]; zero16(x[0]); zero16(x[1]);
        __syncthreads();
#pragma unroll 1
        for (int ch = 0; ch <= RNC; ++ch) {
            if (ch < RNC && act) {
                const unsigned char* st = L + SQ_A0 + (ch % 3) * SQA_BYTES;
                unsigned char* xbuf = L + SQ_XB + ((ch & 1) * 2 + vh) * 4096 + lane * 16;
                bf16x8 xb[4];
#pragma unroll
                for (int s = 0; s < 4; ++s) { xb[s] = pack8(x[s >> 1], s & 1); *(bf16x8*)(xbuf + s * 1024) = xb[s]; }
                f32x16 xn0, xn1;
#pragma unroll
                for (int i = 0; i < 2; ++i) {
                    f32x16 xa;
#pragma unroll
                    for (int g4 = 0; g4 < 4; ++g4) {
                        float z5[4]; unpack4(*(const u32x2*)(st + SQA_Z5 + (vh * 32 + r) * SQ_PITCH + (32 * i + 8 * g4 + 4 * h) * 2), z5);
                        const float4 p4 = *(const float4*)(st + SQA_P63 + (32 * i + 8 * g4 + 4 * h) * 4);
                        xa[4 * g4] = fmaf(p4.x, x[i][4 * g4], z5[0]); xa[4 * g4 + 1] = fmaf(p4.y, x[i][4 * g4 + 1], z5[1]);
                        xa[4 * g4 + 2] = fmaf(p4.z, x[i][4 * g4 + 2], z5[2]); xa[4 * g4 + 3] = fmaf(p4.w, x[i][4 * g4 + 3], z5[3]);
                    }
#pragma unroll
                    for (int s = 0; s < 4; ++s) xa = __builtin_amdgcn_mfma_f32_32x32x16_bf16(ldfrag_l(st + SQA_M3 + (32 * i + r) * SQ_PITCH, s, h), xb[s], xa, 0, 0, 0);
                    if (i == 0) xn0 = xa; else xn1 = xa;
                }
                x[0] = xn0; x[1] = xn1;
            }
            __syncthreads();
        }
    } else {
        __syncthreads();
#pragma unroll 1
        for (int ch = 0; ch <= RNC; ++ch) {
            if (ch >= 1 && act) {
                const int cy = ch - 1;
                unsigned char* st = L + SQ_B0 + (cy % 3) * SQB_BYTES;
                const unsigned char* xbuf = L + SQ_XB + ((cy & 1) * 2 + vh) * 4096 + lane * 16;
                bf16x8 xb[4];
#pragma unroll
                for (int s = 0; s < 4; ++s) xb[s] = *(const bf16x8*)(xbuf + s * 1024);
#pragma unroll
                for (int i = 0; i < 2; ++i) {
                    f32x16 ya;
#pragma unroll
                    for (int g = 0; g < 16; ++g) ya[g] = *((const float*)(st + SQB_Y) + (32 * i + crow(g, h)) * 32 + r);
#pragma unroll
                    for (int s = 0; s < 4; ++s) ya = __builtin_amdgcn_mfma_f32_32x32x16_bf16(ldfrag_l(st + SQB_M2 + (32 * i + r) * SQ_PITCH, s, h), xb[s], ya, 0, 0, 0);
#pragma unroll
                    for (int g = 0; g < 16; ++g) *((float*)(st + SQB_Y) + (32 * i + crow(g, h)) * 32 + r) = ya[g];
                }
            }
            __syncthreads();
        }
    }
}
DI void phase_mixers2(const Ctx& c, int l) {
    const int G = gridDim.x, bid = blockIdx.x;
    if (G >= 128) {
        if (bid < 32) phase_rwkv_seq_block(c, l, bid >> 1, bid & 1);
        else for (int u = bid - 32; u < 2 * S5N * 4; u += G - 32) phase_s5_final_unit<false>(c, l, u);
    } else {
        for (int u = bid; u < 32; u += G) phase_rwkv_seq_block(c, l, u >> 1, u & 1);
        for (int u = bid; u < 2 * S5N * 4; u += G) phase_s5_final_unit<false>(c, l, u);
    }
}

DI void phase_post(const Ctx& c, int l) {
    unsigned char* ws = c.ws; const int lane = c.lane;
    const float* YF = (const float*)(ws + WS_BUFB); const float* YB = YF + (size_t)NZ * 256;
    const bf16_t* RB = (const bf16_t*)(ws + WS_EXPW + MX_RB); const bf16_t* VB = (const bf16_t*)(ws + WS_EXPW + MX_VB);
    const bf16_t* SKD = (const bf16_t*)(ws + WS_P + P_PR) + (size_t)4 * NZ * 256; const bf16_t* GG = (const bf16_t*)(ws + WS_MISC + MS_GG);
    bf16_t* Ycat = (bf16_t*)(ws + WS_BUFA);
    const float* r_k = c.in[21] + l * 256; const float* lg = c.in[22] + l * 256; const float* lb = c.in[23] + l * 256;
    for (int z = blockIdx.x * 8 + c.wave; z < NZ; z += gridDim.x * 8) {
        const size_t o = (size_t)z * 256 + lane * 4;
        const float4 yf = *(const float4*)(YF + o), yb = *(const float4*)(YB + o);
        const float y0 = yf.x + yb.x, y1 = yf.y + yb.y, y2 = yf.z + yb.z, y3 = yf.w + yb.w;
        const float mean = sum16(y0 + y1 + y2 + y3) * (1.f / 64.f);
        const float d0 = y0 - mean, d1 = y1 - mean, d2 = y2 - mean, d3 = y3 - mean;
        const float var = sum16(d0 * d0 + d1 * d1 + d2 * d2 + d3 * d3) * (1.f / 64.f);
        const float rs = rsqrtf(var + 64e-5f);
        float r[4], v[4], k0[4], k1[4], gg[4];
        unpack4(*(const u32x2*)(RB + o), r); unpack4(*(const u32x2*)(VB + o), v); unpack4(*(const u32x2*)(SKD + o), k0); unpack4(*(const u32x2*)(SKD + (size_t)NZ * 256 + o), k1);
        unpack4(*(const u32x2*)(GG + o), gg);
        const float4 rk = *(const float4*)(r_k + lane * 4), g4 = *(const float4*)(lg + lane * 4), b4 = *(const float4*)(lb + lane * 4);
        const float bs = sum16(r[0] * (k0[0] + k1[0]) * rk.x + r[1] * (k0[1] + k1[1]) * rk.y + r[2] * (k0[2] + k1[2]) * rk.z + r[3] * (k0[3] + k1[3]) * rk.w);
        *(u32x2*)(Ycat + (size_t)z * D + 256 + lane * 4) = pack4((d0 * rs * g4.x + b4.x + bs * v[0]) * gg[0], (d1 * rs * g4.y + b4.y + bs * v[1]) * gg[1],
                                                                (d2 * rs * g4.z + b4.z + bs * v[2]) * gg[2], (d3 * rs * g4.w + b4.w + bs * v[3]) * gg[3]);
    }
    {
        const bf16_t* ZG = (const bf16_t*)(ws + WS_MISC + MS_ZG); const bf16_t* W = (const bf16_t*)(ws + WS_WSM + OFF_GLUT + l * SZ_GLUT);
        const float* gb = c.in[33] + l * 256;
        for (int u = blockIdx.x; u < (NZ / 256) * 2; u += gridDim.x) {
            const int mt = u / 2, nt = u % 2, r0 = mt * 256, c0 = nt * 128;
            gemm_tile<4, 0>(c, 256, [&](int i) { return ZG + (size_t)(r0 + i) * 256; }, [&](int i) { return W + (size_t)(c0 + i) * 256; }, NoHook(),
                [&](f32x4 (&acc)[4][4], int wr, int wc, int fr, int fq) {
#pragma unroll
                    for (int n = 0; n < 4; ++n) {
                        const int col = c0 + wc + n * 16 + fq * 4; const float4 bb = *(const float4*)(gb + col);
#pragma unroll
                        for (int m = 0; m < 4; ++m) {
                            const int row = r0 + wr + m * 16 + fr; const f32x4 v = acc[m][n];
                            float zg[4]; unpack4(*(const u32x2*)(ZG + (size_t)row * 256 + col), zg);
                            *(u32x2*)(Ycat + (size_t)row * D + 512 + col) = pack4(zg[0] * sigmoidf_(v[0] + bb.x), zg[1] * sigmoidf_(v[1] + bb.y), zg[2] * sigmoidf_(v[2] + bb.z), zg[3] * sigmoidf_(v[3] + bb.w));
                        }
                    }
                });
        }
    }
}

DI bool skip_mt(int l, int mt) { return l == NL - 1 && (mt % 33) == 0; }
DI bool merge_split(int l) { return l == 0 && NL > 1 && gridDim.x == 256; }
DI void phase_merge1(const Ctx& c, int l, int part) {
    const bf16_t* Ycat = (const bf16_t*)(c.ws + WS_BUFA); const bf16_t* W = (const bf16_t*)(c.ws + WS_WSM + OFF_WBT + l * SZ_WBT);
    const bf16_t* GT = (const bf16_t*)(c.ws + WS_GT); bf16_t* MG = (bf16_t*)(c.ws + WS_BUFB);
    if (part == 0 && blockIdx.x == 0 && c.tid < 32) ((unsigned*)(c.ws + WS_CTL))[CW_CNT + l * 32 + c.tid] = 0u;
    const bool split = merge_split(l);
    const int u_lo = part == 0 ? (int)blockIdx.x : 512 + (int)blockIdx.x, u_hi = part == 0 ? (split ? 512 : (NZ / 256) * 8) : (NZ / 256) * 8;
    for (int u = u_lo; u < u_hi; u += gridDim.x) {
        const int mt = u / 8, nt = u % 8, r0 = mt * 256, c0 = nt * 128;
        if (skip_mt(l, mt)) continue;
        f32x4 macc[4][4];
#pragma unroll
        for (int m = 0; m < 4; ++m)
#pragma unroll
            for (int n = 0; n < 4; ++n) macc[m][n] = (f32x4){0.f, 0.f, 0.f, 0.f};
        gemm_tile<4, 256>(c, 1024, [&](int i) { return Ycat + (size_t)(r0 + i) * D; }, [&](int i) { return W + (size_t)(c0 + i) * D; },
            [&](f32x4 (&acc)[4][4], int seg, int wr, int wc, int fr, int fq) {
#pragma unroll
                for (int m = 0; m < 4; ++m)
#pragma unroll
                    for (int n = 0; n < 4; ++n) {
                        float g[4]; unpack4(*(const u32x2*)(GT + (size_t)(r0 + wr + m * 16 + fr) * 4096 + seg * 1024 + c0 + wc + n * 16 + fq * 4), g);
                        macc[m][n][0] += g[0] * acc[m][n][0]; macc[m][n][1] += g[1] * acc[m][n][1]; macc[m][n][2] += g[2] * acc[m][n][2]; macc[m][n][3] += g[3] * acc[m][n][3];
                        acc[m][n] = (f32x4){0.f, 0.f, 0.f, 0.f};
                    }
            },
            [&](f32x4 (&)[4][4], int wr, int wc, int fr, int fq) {
#pragma unroll
                for (int m = 0; m < 4; ++m)
#pragma unroll
                    for (int n = 0; n < 4; ++n)
                        *(u32x2*)(MG + (size_t)(r0 + wr + m * 16 + fr) * D + c0 + wc + n * 16 + fq * 4) = pack4(macc[m][n][0], macc[m][n][1], macc[m][n][2], macc[m][n][3]);
            });
    }
}
struct EpiMerge2 {
    static constexpr bool PERM = false, AFTER_DRAIN = false;
    float* H; const float* modv; int l;
    DI void operator()(const pg8::f32x4 (&acc)[2][2][4][2], const pg8::Unit& u, int wr, int wc, int fr, int fq) const {
        if (skip_mt(l, u.pm)) return;
        const int sel = (u.pm % 33) == 0 ? 2 : u.pm / 33;
        const int row0 = u.pm * 256 + wr * 64 + fr, col0 = u.pn * 256 + wc * 32 + 4 * fq;
#pragma unroll
        for (int bj = 0; bj < 2; ++bj)
#pragma unroll
            for (int n = 0; n < 2; ++n) {
                const int col = col0 + bj * 128 + n * 16; const float4 m2 = *(const float4*)(modv + ((size_t)l * 3 + sel) * 6144 + 2 * 1024 + col);
#pragma unroll
                for (int ai = 0; ai < 2; ++ai)
#pragma unroll
                    for (int m = 0; m < 4; ++m) {
                        float4* hp = (float4*)(H + (size_t)(row0 + ai * 128 + m * 16) * D + col); float4 hv = *hp; const pg8::f32x4 v = acc[ai][bj][m][n];
                        hv.x += m2.x * v[0]; hv.y += m2.y * v[1]; hv.z += m2.z * v[2]; hv.w += m2.w * v[3]; *hp = hv;
                    }
            }
    }
};
struct LatOrder {
    int G, c;
    DI bool next(int i, pg8::Unit& u) const { const int L = i * G + c; if (L >= 256) return false; const int pl = L >> 2; u.pm = (pl >> 5) * 33 + 1 + (pl & 31); u.pn = L & 3; return true; }
    DI void a_ready(const pg8::Unit&) const {}
    DI void done(const pg8::Unit&) const {}
};
struct SplitOrder {
    int mode, c;
    DI bool next(int i, pg8::Unit& u) const {
        if (i > 0) return false;
        int L; if (mode == 1) { if (c < 16) return false; L = c - 16; } else { if (c >= 24) return false; L = 240 + c; }
        u.pm = L >> 2; u.pn = L & 3; return true;
    }
    DI void a_ready(const pg8::Unit&) const {}
    DI void done(const pg8::Unit&) const {}
};
DI void phase_merge2(const Ctx& c, int l, int mode) {
    EpiMerge2 E; E.H = (float*)(c.ws + WS_H); E.modv = (const float*)(c.ws + WS_WSM + OFF_MODV); E.l = l;
    pg8::Gemm g{(const bf16_t*)(c.ws + WS_BUFB), (const bf16_t*)(c.ws + WS_WSM + OFF_WOUTT + l * SZ_WOUTT), NZ, 1024, 1024, 1024, 1024};
    __syncthreads();
    if (mode != 0) {
        SplitOrder S; S.mode = mode; S.c = (int)blockIdx.x;
        pg8::gemm_phase<EpiMerge2, SplitOrder, false>((PG8_LAS unsigned char*)c.smem, g, S, E, nullptr, c.tid);
    } else if (l == NL - 1) {
        LatOrder S; S.G = (int)gridDim.x; S.c = (int)blockIdx.x;
        pg8::gemm_phase<EpiMerge2, LatOrder, false>((PG8_LAS unsigned char*)c.smem, g, S, E, nullptr, c.tid);
    } else {
        pg8::StaticOrder S; S.init(NZ, 1024, (int)gridDim.x, (int)blockIdx.x, MERGE2_WGM);
        pg8::gemm_phase<EpiMerge2, pg8::StaticOrder, false>((PG8_LAS unsigned char*)c.smem, g, S, E, nullptr, c.tid);
    }
}

constexpr int RT_PITCH = 68;
constexpr int RT_RED_W = 8 * 4 * RT_PITCH;
DI void phase_norm2_route(const Ctx& c, int l) {
    unsigned char* ws = c.ws; const int lane = c.lane, wave = c.wave, tid = c.tid;
    const float* modv = (const float*)(ws + WS_WSM + OFF_MODV); const float* H = (const float*)(ws + WS_H);
    bf16_t* XN = (bf16_t*)(ws + WS_BUFA); const float* g2 = c.in[7] + l * 1024;
    const float* rwt = (const float*)(ws + WS_WSM + OFF_RWT) + (size_t)l * 36 * 1024;
    const float* bg = c.in[42] + l * 4; const float* be = c.in[44] + l * 32;
    unsigned* cnt = (unsigned*)(ws + WS_CTL) + CW_CNT + l * 32;
    int* list = (int*)(ws + WS_GT + GT_LIST); float* lw = (float*)(ws + WS_GT + GT_LW);
    float* red = (float*)c.smem + wave * RT_RED_W;
    float* lgs = (float*)c.smem + 8 * RT_RED_W + wave * 8 * 40;
    int* hist = (int*)((float*)c.smem + 8 * RT_RED_W + 8 * 8 * 40);
    int* sel = hist + 64;
    float* selw = (float*)(sel + 128);
    const int ngroups = (l == NL - 1) ? (NB * SEQ / 64) : (NZ / 64);
    for (int grp = blockIdx.x; grp < ngroups; grp += gridDim.x) {
        __syncthreads();
        if (tid < 32) hist[tid] = 0;
        __syncthreads();
        float x[8][16];
#pragma unroll
        for (int i = 0; i < 8; ++i) {
            const int rl = wave * 8 + i; int row;
            if (l == NL - 1) { const int rr = grp * 64 + rl; row = (rr / SEQ) * TZ + CTX + (rr % SEQ); } else row = grp * 64 + rl;
#pragma unroll
            for (int q = 0; q < 4; ++q) { const float4 v = *(const float4*)(H + (size_t)row * D + q * 256 + lane * 4); x[i][q * 4] = v.x; x[i][q * 4 + 1] = v.y; x[i][q * 4 + 2] = v.z; x[i][q * 4 + 3] = v.w; }
        }
#pragma unroll
        for (int i = 0; i < 8; ++i) {
            const int rl = wave * 8 + i; int row;
            if (l == NL - 1) { const int rr = grp * 64 + rl; row = (rr / SEQ) * TZ + CTX + (rr % SEQ); } else row = grp * 64 + rl;
            const int b = row / TZ, s = row % TZ, sel3 = s < CTX ? 2 : b;
            float ss = 0.f;
#pragma unroll
            for (int j = 0; j < 16; ++j) ss += x[i][j] * x[i][j];
            ss = wave_sum(ss);
            const float rs = rsqrtf(ss * (1.f / 1024.f) + 1e-6f);
#pragma unroll
            for (int q = 0; q < 4; ++q) {
                const int col = q * 256 + lane * 4;
                const float4 g = *(const float4*)(g2 + col), m3 = *(const float4*)(modv + ((size_t)l * 3 + sel3) * 6144 + 3 * 1024 + col), m4 = *(const float4*)(modv + ((size_t)l * 3 + sel3) * 6144 + 4 * 1024 + col);
                x[i][q * 4] = x[i][q * 4] * rs * g.x * (1.f + m4.x) + m3.x; x[i][q * 4 + 1] = x[i][q * 4 + 1] * rs * g.y * (1.f + m4.y) + m3.y;
                x[i][q * 4 + 2] = x[i][q * 4 + 2] * rs * g.z * (1.f + m4.z) + m3.z; x[i][q * 4 + 3] = x[i][q * 4 + 3] * rs * g.w * (1.f + m4.w) + m3.w;
                *(u32x2*)(XN + (size_t)row * D + col) = pack4(x[i][q * 4], x[i][q * 4 + 1], x[i][q * 4 + 2], x[i][q * 4 + 3]);
            }
        }
#pragma unroll 1
        for (int ec = 0; ec < 9; ++ec) {
#pragma unroll
            for (int ee = 0; ee < 4; ++ee) {
                const int e = ec * 4 + ee;
                float4 w[4];
#pragma unroll
                for (int q = 0; q < 4; ++q) w[q] = *(const float4*)(rwt + (size_t)e * 1024 + q * 256 + lane * 4);
#pragma unroll
                for (int i = 0; i < 8; ++i) {
                    float a = 0.f;
#pragma unroll
                    for (int q = 0; q < 4; ++q) a += x[i][q * 4] * w[q].x + x[i][q * 4 + 1] * w[q].y + x[i][q * 4 + 2] * w[q].z + x[i][q * 4 + 3] * w[q].w;
                    red[(i * 4 + ee) * RT_PITCH + lane] = a;
                }
            }
            __builtin_amdgcn_wave_barrier();
            if (lane < 32) {
                float s0 = 0.f, s1 = 0.f, s2 = 0.f, s3 = 0.f;
#pragma unroll
                for (int q = 0; q < 16; ++q) { const float4 v = *(const float4*)(red + lane * RT_PITCH + q * 4); s0 += v.x; s1 += v.y; s2 += v.z; s3 += v.w; }
                const int e = ec * 4 + (lane & 3);
                lgs[(lane >> 2) * 40 + e] = (s0 + s1) + (s2 + s3) + (e < 4 ? bg[e] : be[e - 4]);
            }
            __builtin_amdgcn_wave_barrier();
        }
        if (lane < 8) {
            const float* lg = lgs + lane * 40;
            float gm = lg[0]; int gsel = 0;
#pragma unroll
            for (int g = 1; g < 4; ++g) if (lg[g] > gm) { gm = lg[g]; gsel = g; }
            const float gs = __expf(lg[0] - gm) + __expf(lg[1] - gm) + __expf(lg[2] - gm) + __expf(lg[3] - gm);
            const float pg = 1.f / gs;
            float l1 = -1e30f, l2 = -1e30f; int e1 = 0, e2 = 0;
#pragma unroll
            for (int j = 0; j < 8; ++j) {
                const float v = lg[4 + gsel * 8 + j]; const int e = gsel * 8 + j;
                if (v > l1) { l2 = l1; e2 = e1; l1 = v; e1 = e; } else if (v > l2) { l2 = v; e2 = e; }
            }
            const float tt = __expf(l2 - l1), w1 = pg / (1.f + tt), w2 = pg * tt / (1.f + tt);
            const int rl = wave * 8 + lane;
            const int r1 = atomicAdd(&hist[e1], 1), r2 = atomicAdd(&hist[e2], 1);
            sel[rl * 2] = e1 | (r1 << 8); sel[rl * 2 + 1] = e2 | (r2 << 8); selw[rl * 2] = w1; selw[rl * 2 + 1] = w2;
        }
        __syncthreads();
        if (tid < 32) hist[32 + tid] = (int)atomicAdd(&cnt[tid], (unsigned)hist[tid]);
        __syncthreads();
        if (tid < 128) {
            const int rl = tid >> 1, j = tid & 1, sv = sel[tid], e = sv & 255, rk = sv >> 8;
            int row;
            if (l == NL - 1) { const int rr = grp * 64 + rl; row = (rr / SEQ) * TZ + CTX + (rr % SEQ); } else row = grp * 64 + rl;
            const size_t pos = (size_t)e * MOE_CAP + hist[32 + e] + rk;
            list[pos] = row * 2 + j; lw[pos] = selw[tid];
        }
    }
    phase_expert_convert(c, l);
}

DI void moe_prefix(const Ctx& c, int l, int* tiles  , int* cnts  ) {
    __syncthreads();
    if (c.tid < 64) {
        const unsigned* cnt = (const unsigned*)(c.ws + WS_CTL) + CW_CNT + l * 32;
        const int n = c.tid < 32 ? (int)__hip_atomic_load(cnt + c.tid, __ATOMIC_RELAXED, __HIP_MEMORY_SCOPE_AGENT) : 0;
        const int nt = (n + 127) / 128; int inc = nt;
#pragma unroll
        for (int d = 1; d < 32; d <<= 1) { const int v = __shfl_up(inc, d, 64); if ((c.tid & 63) >= d) inc += v; }
        if (c.tid < 32) { cnts[c.tid] = n; tiles[c.tid] = inc - nt; }
        if (c.tid == 31) tiles[32] = inc;
    }
    __syncthreads();
}
DI void phase_moe1(const Ctx& c, int l) {
    unsigned char* ws = c.ws;
    int* tiles = (int*)(c.smem + 120 * 1024); int* cnts = tiles + 40;
    moe_prefix(c, l, tiles, cnts);
    const bf16_t* XN = (const bf16_t*)(ws + WS_BUFA); bf16_t* HM = (bf16_t*)(ws + WS_GT + GT_HM); const int* list = (const int*)(ws + WS_GT + GT_LIST);
    const int nt_total = tiles[32];
    for (int u = blockIdx.x; u < nt_total * 4; u += gridDim.x) {
        const int mtg = u >> 2, nt = u & 3;
        int e = 0;
        for (int k = 1; k < 32; ++k) if (tiles[k] <= mtg) e = k;
        const int mt = mtg - tiles[e], n_e = cnts[e];
        const int* le = list + (size_t)e * MOE_CAP;
        const bf16_t* W = (const bf16_t*)(ws + WS_EXPW + (size_t)e * SZ_WGU);
        gemm_tile<2, 0>(c, 1024,
            [&](int i) { int p = mt * 128 + i; if (p >= n_e) p = n_e - 1; return XN + (size_t)(le[p] >> 1) * D; },
            [&](int i) { return W + (size_t)(nt * 256 + i) * D; }, NoHook(),
            [&](f32x4 (&acc)[4][4], int wr, int wc, int fr, int fq) {
#pragma unroll
                for (int np = 0; np < 2; ++np) {
                    const int hc = (nt * 256 + wc + np * 32) / 2 + fq * 4;
#pragma unroll
                    for (int m = 0; m < 4; ++m) {
                        const int p = mt * 128 + wr + m * 16 + fr;
                        const f32x4 g = acc[m][np * 2], uu = acc[m][np * 2 + 1];
                        *(u32x2*)(HM + ((size_t)mtg * 128 + wr + m * 16 + fr) * 512 + hc) = pack4(siluf_(g[0]) * uu[0], siluf_(g[1]) * uu[1], siluf_(g[2]) * uu[2], siluf_(g[3]) * uu[3]);
                        (void)p;
                    }
                }
            });
    }
}
DI void phase_moe2(const Ctx& c, int l) {
    unsigned char* ws = c.ws;
    int* tiles = (int*)(c.smem + 120 * 1024); int* cnts = tiles + 40;
    moe_prefix(c, l, tiles, cnts);
    const bf16_t* HM = (const bf16_t*)(ws + WS_GT + GT_HM); const int* list = (const int*)(ws + WS_GT + GT_LIST); const float* lw = (const float*)(ws + WS_GT + GT_LW);
    bf16_t* Y2 = (bf16_t*)(ws + WS_P);
    const int nt_total = tiles[32];
    for (int u = blockIdx.x; u < nt_total * 4; u += gridDim.x) {
        const int mtg = u >> 2, nt = u & 3;
        int e = 0;
        for (int k = 1; k < 32; ++k) if (tiles[k] <= mtg) e = k;
        const int mt = mtg - tiles[e], n_e = cnts[e];
        const int* le = list + (size_t)e * MOE_CAP; const float* lwe = lw + (size_t)e * MOE_CAP;
        const bf16_t* W = (const bf16_t*)(ws + WS_EXPW + 32 * SZ_WGU + (size_t)e * SZ_WD);
        gemm_tile<2, 0>(c, 512,
            [&](int i) { return HM + ((size_t)mtg * 128 + i) * 512; },
            [&](int i) { return W + (size_t)(nt * 256 + i) * 512; }, NoHook(),
            [&](f32x4 (&acc)[4][4], int wr, int wc, int fr, int fq) {
#pragma unroll
                for (int m = 0; m < 4; ++m) {
                    const int p = mt * 128 + wr + m * 16 + fr;
                    if (p < n_e) {
                        const int ent = le[p]; const float wt = lwe[p];
                        bf16_t* yrow = Y2 + ((size_t)(ent & 1) * NZ + (ent >> 1)) * D + nt * 256 + wc + fq * 4;
#pragma unroll
                        for (int n = 0; n < 4; ++n) *(u32x2*)(yrow + n * 16) = pack4(wt * acc[m][n][0], wt * acc[m][n][1], wt * acc[m][n][2], wt * acc[m][n][3]);
                    }
                }
            });
    }
}

constexpr int LDS_BYTES = 150 * 1024 + 256;
static_assert(SQ_END <= LDS_BYTES - 256, "RWKV sequential stages must fit the LDS allocation");
constexpr int STEPS_PER_LAYER = 12, N_STEPS = 2 + NL * STEPS_PER_LAYER;
#ifndef FUSED
#define FUSED 1
#endif

DI const void* launder_ptr(const void* p) {
    const unsigned long long v = (unsigned long long)p;
    unsigned lo = __builtin_amdgcn_readfirstlane((unsigned)v), hi = __builtin_amdgcn_readfirstlane((unsigned)(v >> 32));
    asm volatile("" : "+s"(lo), "+s"(hi) :: "memory");
    return (const void*)(((unsigned long long)hi << 32) | lo);
}
template <int KIND> DI void run_step(const Ctx& c0, int l) {
#ifdef PHM
    if (!((PHM >> KIND) & 1)) return;
#endif
    Ctx c = c0;
    { int z = 0; asm volatile("" : "+s"(z) :: "memory"); c.in = c0.in + z; c.ws = c0.ws + z; c.out = c0.out + z; }
    { int t = c0.tid; asm volatile("" : "+v"(t)); c.tid = t; c.lane = t & 63; c.wave = __builtin_amdgcn_readfirstlane(t >> 6); }
    if (KIND == 0) phase_prologue(c);
    if (KIND == 1) phase_norm1(c, l);
    if (KIND == 2) phase_inproj(c, l);
    if (KIND == 3) { phase_prep(c, l); for (int u = blockIdx.x; u < 2 * S5N * 4; u += gridDim.x) phase_s5_final_unit<true>(c, l, u); }
    if (KIND == 4) { phase_small_gemms(c, l); phase_s5_carry(c, l); }
    if (KIND == 5) { phase_attention(c, l); phase_rwkv_chunks(c, l); }
    if (KIND == 6) phase_mixers2(c, l);
    if (KIND == 7) phase_post(c, l);
    if (KIND == 8) phase_merge1(c, l, 0);
    if (KIND == 9) { if (!merge_split(l)) phase_merge2(c, l, 0); else if (blockIdx.x < 16) phase_merge1(c, l, 1); else phase_merge2(c, l, 1); }
    if (KIND == 14) { if (merge_split(l)) phase_merge2(c, l, 2); }
    if (KIND == 10) phase_norm2_route(c, l);
    if (KIND == 11) phase_moe1(c, l);
    if (KIND == 12) phase_moe2(c, l);
    if (KIND == 13) phase_final(c);
}

#if !FUSED
template <int KIND> __global__ void __launch_bounds__(NTHR, 2) k_step(Args a) {
    extern __shared__ __attribute__((aligned(16))) unsigned char lds[];
    Ctx c; c.in = a.in; c.out = a.out; c.ws = a.ws; c.smem = lds; c.tid = threadIdx.x; c.lane = threadIdx.x & 63; c.wave = __builtin_amdgcn_readfirstlane(threadIdx.x >> 6);
    run_step<KIND>(c, a.s_lo);
}
template <int KIND> static void launch_step(const Args& a, int grid, hipStream_t stream) {
    static bool attr = false;
    if (!attr) { (void)hipFuncSetAttribute((const void*)k_step<KIND>, hipFuncAttributeMaxDynamicSharedMemorySize, LDS_BYTES); attr = true; }
    hipLaunchKernelGGL(k_step<KIND>, dim3(grid), dim3(NTHR), LDS_BYTES, stream, a);
}
#else
__global__ void __launch_bounds__(NTHR, 2) fwd_kernel(Args a) {
    extern __shared__ __attribute__((aligned(16))) unsigned char lds[];
    Ctx c; c.in = a.in; c.out = a.out; c.ws = a.ws; c.smem = lds; c.tid = threadIdx.x; c.lane = threadIdx.x & 63; c.wave = __builtin_amdgcn_readfirstlane(threadIdx.x >> 6);
    volatile LAS unsigned* xbw = (volatile LAS unsigned*)(lds + LDS_BYTES - 16);
    for (int i = threadIdx.x; i < LDS_BYTES / 16; i += NTHR) ((uint4*)lds)[i] = make_uint4(0u, 0u, 0u, 0u);
    __syncthreads();
    if (threadIdx.x == 0) { xbw[0] = 0u; xbw[1] = 0u; }
    __syncthreads();
    XcdBarrier bar = xcd_barrier_post((unsigned*)(a.ws + WS_CTL) + CW_BAR, xbw);
#ifndef REP_MASK
#define REP_MASK 0
#endif
#define GBAR() do { XcdBarrier bb = bar; int zz = 0; asm volatile("" : "+s"(zz) :: "memory"); bb.bar = bar.bar + zz; xcd_barrier(bb); } while (0)
#define STEP(K, L) do { run_step<K>(c, L); GBAR(); if ((REP_MASK >> K) & 1) { run_step<K>(c, L); GBAR(); } } while (0)
    STEP(0, 0);
    for (int l = 0; l < NL; ++l) {
        STEP(1, l); STEP(2, l); STEP(3, l); STEP(4, l); STEP(5, l); STEP(6, l); STEP(7, l); STEP(8, l); STEP(9, l); if (l == 0 && NL > 1) STEP(14, l); STEP(10, l); STEP(11, l); STEP(12, l);
    }
#undef STEP
    run_step<13>(c, 0);
}
#endif

extern "C" void kernel_launch(void* const* d_in, const int* in_sizes, int n_in, void* d_out, int out_size, void* d_ws, size_t ws_size, hipStream_t stream) {
    static int grid = 0;
    if (grid == 0) {
        if (n_in != 49 || out_size != NB * SEQ * D || ws_size < WS_END) { fprintf(stderr, "kernel_launch: unexpected problem (n_in %d out %d ws %zu need %zu)\n", n_in, out_size, ws_size, (size_t)WS_END); grid = -1; return; }
        int dev = 0, cus = 0;
        if (hipGetDevice(&dev) != hipSuccess || hipDeviceGetAttribute(&cus, hipDeviceAttributeMultiprocessorCount, dev) != hipSuccess) { grid = -1; return; }
#if FUSED
        int per_cu = 0;
        if (hipFuncSetAttribute((const void*)fwd_kernel, hipFuncAttributeMaxDynamicSharedMemorySize, LDS_BYTES) != hipSuccess) { fprintf(stderr, "kernel_launch: hipFuncSetAttribute failed\n"); grid = -1; return; }
        if (hipOccupancyMaxActiveBlocksPerMultiprocessor(&per_cu, (const void*)fwd_kernel, NTHR, LDS_BYTES) != hipSuccess || per_cu < 1) { fprintf(stderr, "kernel_launch: occupancy query says %d\n", per_cu); }
        (void)hipGetLastError();
#endif
        grid = cus;
    }
    if (grid < 0) return;
    (void)hipMemsetAsync((char*)d_ws + WS_CTL, 0, CTL_BYTES, stream);
    Args a{};
    for (int i = 0; i < 49; ++i) a.in[i] = (const float*)d_in[i];
    a.out = (float*)d_out; a.ws = (unsigned char*)d_ws;
#if !FUSED
    a.s_lo = 0; a.s_hi = 0; launch_step<0>(a, grid, stream);
    for (int l = 0; l < NL; ++l) {
        a.s_lo = l;
        launch_step<1>(a, grid, stream); launch_step<2>(a, grid, stream); launch_step<3>(a, grid, stream); launch_step<4>(a, grid, stream);
        launch_step<5>(a, grid, stream); launch_step<6>(a, grid, stream); launch_step<7>(a, grid, stream); launch_step<8>(a, grid, stream);
        launch_step<9>(a, grid, stream); if (l == 0 && NL > 1) launch_step<14>(a, grid, stream); launch_step<10>(a, grid, stream); launch_step<11>(a, grid, stream); launch_step<12>(a, grid, stream);
    }
    a.s_lo = 0; launch_step<13>(a, grid, stream);
#else
    a.s_lo = 0; a.s_hi = N_STEPS; hipLaunchKernelGGL(fwd_kernel, dim3(grid), dim3(NTHR), LDS_BYTES, stream, a);
#endif
}
```

```cpp
#include <hip/hip_runtime.h>
#include <stdint.h>
#include <stdio.h>

#define DI __device__ __forceinline__
#define LAS __attribute__((address_space(3)))
typedef unsigned short bf16_t;
typedef short bf16x8 __attribute__((ext_vector_type(8)));
typedef short s16x4 __attribute__((ext_vector_type(4)));
typedef float f32x4 __attribute__((ext_vector_type(4)));
typedef float f32x16 __attribute__((ext_vector_type(16)));
typedef float f32x2 __attribute__((ext_vector_type(2)));
typedef __bf16 bf16x2v __attribute__((ext_vector_type(2)));
typedef unsigned u32x4 __attribute__((ext_vector_type(4)));
typedef unsigned u32x2 __attribute__((ext_vector_type(2)));

constexpr int D = 1024, NB = 2, SEQ = 8192, CTX = 256, TZ = 8448, NZ = 16896, NL = 2;
constexpr int NIN = 6560, NINP = 6656;
constexpr int NTHR = 512;
constexpr float LOG2E = 1.4426950408889634f;

#define XB_TMO      128
#define XB_XCNT(j)  (256  + 64 * (j))
#define XB_XSUB(j)  (1280 + 64 * (j))
#define XB_XGEN(j)  (2304 + 64 * (j))
#define XB_TOP      3328
#define XB_TOPGEN   3392
#define XCD_BAR_WORDS 3456
#define XB_SPIN_CAP (1u << 18)

__device__ __forceinline__ unsigned xb_ld(unsigned* p)              { return __hip_atomic_load(p, __ATOMIC_RELAXED, __HIP_MEMORY_SCOPE_AGENT); }
__device__ __forceinline__ unsigned xb_add(unsigned* p, unsigned v) { return __hip_atomic_fetch_add(p, v, __ATOMIC_RELAXED, __HIP_MEMORY_SCOPE_AGENT); }
__device__ __forceinline__ unsigned xb_xcc_id() { return (unsigned)__builtin_amdgcn_s_getreg((3 << 11) | 20) & 0xFu; }
#define XB_SPIN(cond, bar) do { unsigned _sp = 0; while (cond) { __builtin_amdgcn_s_sleep(1); \
    if ((++_sp & 255u) == 0u) { if (xb_ld(&(bar)[XB_TMO])) break; if (_sp > XB_SPIN_CAP) { atomicAdd(&(bar)[XB_TMO], 1u); break; } } } } while (0)

struct XcdBarrier { unsigned* bar; unsigned x; volatile LAS unsigned* st; };

__device__ __forceinline__ XcdBarrier xcd_barrier_post(unsigned* bar, volatile LAS unsigned* st) {
    XcdBarrier b; b.bar = bar; b.x = xb_xcc_id(); b.st = st;
    if (threadIdx.x == 0) (void)xb_add(&bar[XB_XCNT(b.x)], 1u);
    return b;
}
__device__ __forceinline__ void xcd_barrier_complete(unsigned* bar, unsigned x, unsigned& nloc, unsigned& nx) {
    const unsigned G = gridDim.x * gridDim.y * gridDim.z;
    unsigned sum, cnt, mine, sp = 0u;
    for (;;) {
        sum = 0u; cnt = 0u; mine = 0u;
#pragma unroll
        for (unsigned j = 0; j < 16; ++j) { const unsigned c = xb_ld(&bar[XB_XCNT(j)]); sum += c; cnt += (c > 0u) ? 1u : 0u; mine = (j == x) ? c : mine; }
        if (sum == G) break;
        __builtin_amdgcn_s_sleep(1);
        if ((++sp & 255u) == 0u) { if (xb_ld(&bar[XB_TMO])) break; if (sp > XB_SPIN_CAP) { atomicAdd(&bar[XB_TMO], 1u); break; } }
    }
    nloc = mine > 0u ? mine : 1u; nx = cnt > 0u ? cnt : 1u;
}
__device__ __forceinline__ void xcd_barrier(const XcdBarrier& b) {
    asm volatile("s_waitcnt vmcnt(0)" ::: "memory");
    __syncthreads();
    if (threadIdx.x == 0) {
        unsigned* bar = b.bar;
        __builtin_amdgcn_s_waitcnt(0);
        unsigned nloc = b.st[0], nx = b.st[1];
        if (nloc == 0u) { xcd_barrier_complete(bar, b.x, nloc, nx); b.st[0] = nloc; b.st[1] = nx; }
        const unsigned old = xb_add(&bar[XB_XSUB(b.x)], 1u);
        const unsigned gen = old / nloc;
        if (old + 1u == (gen + 1u) * nloc) {
            __builtin_amdgcn_fence(__ATOMIC_RELEASE, "agent");
            asm volatile("s_waitcnt vmcnt(0)" ::: "memory");
            const unsigned og = xb_add(&bar[XB_TOP], 1u);
            const unsigned tg = og / nx;
            if (og + 1u == (tg + 1u) * nx) xb_add(&bar[XB_TOPGEN], 1u);
            else XB_SPIN(xb_ld(&bar[XB_TOPGEN]) == tg, bar);
            __builtin_amdgcn_fence(__ATOMIC_ACQUIRE, "agent");
            xb_add(&bar[XB_XGEN(b.x)], 1u);
            asm volatile("s_waitcnt vmcnt(0)" ::: "memory");
        } else {
            XB_SPIN(xb_ld(&bar[XB_XGEN(b.x)]) == gen, bar);
            __builtin_amdgcn_fence(__ATOMIC_ACQUIRE, "agent");
            asm volatile("s_waitcnt vmcnt(0)" ::: "memory");
        }
    }
    __syncthreads();
}

DI float bf2f(bf16_t v) { return __uint_as_float((unsigned)v << 16); }
DI unsigned pack2(float a, float b) { f32x2 v = {a, b}; bf16x2v r = __builtin_convertvector(v, bf16x2v); return __builtin_bit_cast(unsigned, r); }
DI bf16_t f2bf(float a) { return (bf16_t)(pack2(a, 0.f) & 0xffffu); }
DI float lo2f(unsigned u) { return __uint_as_float(u << 16); }
DI float hi2f(unsigned u) { return __uint_as_float(u & 0xffff0000u); }
DI float wave_sum(float v) {
#pragma unroll
    for (int m = 32; m >= 1; m >>= 1) v += __shfl_xor(v, m, 64);
    return v;
}
DI float sum16(float v) {
#pragma unroll
    for (int m = 8; m >= 1; m >>= 1) v += __shfl_xor(v, m, 64);
    return v;
}
DI float sigmoidf_(float x) { return __builtin_amdgcn_rcpf(1.f + __expf(-x)); }
DI float siluf_(float x) { return x * __builtin_amdgcn_rcpf(1.f + __expf(-x)); }
DI float gelu_tanh(float x) { const float u = 0.7978845608028654f * (x + 0.044715f * x * x * x); return x * __builtin_amdgcn_rcpf(1.f + __expf(-2.f * u)); }
DI float tanhf_(float x) { return 2.f * __builtin_amdgcn_rcpf(1.f + __expf(-2.f * x)) - 1.f; }
DI void unpack4(u32x2 u, float (&f)[4]) { f[0] = lo2f(u.x); f[1] = hi2f(u.x); f[2] = lo2f(u.y); f[3] = hi2f(u.y); }
DI u32x2 pack4(float a, float b, float c, float d) { u32x2 r; r.x = pack2(a, b); r.y = pack2(c, d); return r; }

constexpr size_t algn(size_t x) { return (x + 255) & ~(size_t)255; }
constexpr size_t WS_CTL   = 0;
constexpr size_t CTL_BYTES = 64 * 1024;
constexpr size_t WS_H     = WS_CTL + CTL_BYTES;
constexpr size_t WS_WSM   = WS_H + (size_t)NZ * D * 4;
constexpr size_t SZ_WINT = (size_t)NINP * D * 2, SZ_WUQT = 384 * 256 * 2, SZ_WUKVT = 512 * 128 * 2, SZ_W2T = 512 * 64 * 2, SZ_A2T = 512 * 64 * 2,
                 SZ_G2T = 256 * 128 * 2, SZ_GLUT = 256 * 256 * 2, SZ_WBT = (size_t)D * D * 2, SZ_WOUTT = (size_t)D * D * 2;
constexpr size_t OFF_WINT = 0, OFF_WUQT = OFF_WINT + NL * SZ_WINT, OFF_WUKVT = OFF_WUQT + NL * SZ_WUQT, OFF_W2T = OFF_WUKVT + NL * SZ_WUKVT,
                 OFF_A2T = OFF_W2T + NL * SZ_W2T, OFF_G2T = OFF_A2T + NL * SZ_A2T, OFF_GLUT = OFF_G2T + NL * SZ_G2T, OFF_WBT = OFF_GLUT + NL * SZ_GLUT,
                 OFF_WOUTT = OFF_WBT + NL * SZ_WBT, OFF_MODV = OFF_WOUTT + NL * SZ_WOUTT,
                 OFF_ROPE = OFF_MODV + (size_t)NL * 3 * 6144 * 4,
                 OFF_S5T = OFF_ROPE + (size_t)SEQ * 16 * 2 * 4,
                 OFF_RWT = OFF_S5T + (size_t)NL * 2 * 16 * 64 * 36 * 4,
                 OFF_LAM = OFF_RWT + (size_t)NL * 36 * 1024 * 4,
                 OFF_S5E = OFF_LAM + 256,
                 OFF_S5C = OFF_S5E,
                 WSM_BYTES = algn(OFF_S5E + (size_t)2 * 2 * 16 * 132 * 64 * 2 * 4);
constexpr size_t WS_EXPW  = WS_WSM + WSM_BYTES;
constexpr size_t SZ_WGU = (size_t)1024 * 1024 * 2, SZ_WD = (size_t)1024 * 512 * 2;
constexpr size_t EXPW_BYTES = 32 * (SZ_WGU + SZ_WD);
constexpr size_t SZ_QM = (size_t)NB * 4 * TZ * 96 * 2, SZ_VMT = (size_t)NB * 4 * 64 * TZ * 2, SZ_QD = (size_t)NB * 4 * TZ * 64 * 2, SZ_R256 = (size_t)NZ * 256 * 2;
constexpr size_t MX_QM = 0, MX_KM = MX_QM + SZ_QM, MX_VMT = MX_KM + SZ_QM, MX_QD = MX_VMT + SZ_VMT, MX_KD = MX_QD + SZ_QD, MX_VDT = MX_KD + SZ_QD,
                 MX_RB = MX_VDT + SZ_VMT, MX_KB = MX_RB + SZ_R256, MX_VB = MX_KB + SZ_R256, MX_KKB = MX_VB + SZ_R256, MX_END = MX_KKB + SZ_R256;
static_assert(MX_END <= EXPW_BYTES, "mixer operands must fit the expert-weight region");
constexpr size_t WS_BUFA  = WS_EXPW + EXPW_BYTES;
constexpr size_t WS_BUFB  = WS_BUFA + (size_t)NZ * D * 2;
constexpr size_t WS_P     = WS_BUFB + (size_t)NZ * D * 2;
constexpr size_t P_PM = 0, P_PS = P_PM + (size_t)NZ * 416 * 2, P_PR = P_PS + (size_t)NZ * 256 * 2, P_PD = P_PR + (size_t)NZ * 1024 * 2, P_BYTES = P_PD + (size_t)NZ * 768 * 2;
static_assert((size_t)6 * SZ_R256 <= (size_t)NZ * (1024 + 768) * 2, "scan operands must fit PR|PD");
static_assert((size_t)2 * NZ * D * 2 <= P_BYTES, "the MoE outputs (2 x bf16 [NZ][D]) must fit the P region");
constexpr size_t WS_GT    = WS_P + P_BYTES;
constexpr size_t GT_BYTES = (size_t)NZ * 4096 * 2;
constexpr int MOE_CAP = 33792;
constexpr size_t GT_HM = 0, GT_LIST = GT_HM + (size_t)(33792 + 32 * 128) * 512 * 2, GT_LW = GT_LIST + (size_t)32 * MOE_CAP * 4, GT_END = GT_LW + (size_t)32 * MOE_CAP * 4;
static_assert(GT_END <= GT_BYTES, "MoE scratch must fit the gate region");
constexpr size_t WS_MISC  = WS_GT + GT_BYTES;
constexpr size_t MS_CQN = 0, MS_TW = MS_CQN + (size_t)NZ * 384 * 2, MS_AL = MS_TW + (size_t)NZ * 64 * 2, MS_SG = MS_AL + (size_t)NZ * 64 * 2,
                 MS_GG = MS_SG + (size_t)NZ * 128 * 2, MS_ZG = MS_GG + SZ_R256, MS_END = MS_ZG + SZ_R256;
constexpr size_t WS_RW    = WS_MISC + MS_END;
constexpr int RC = 64, RNC = TZ / RC;
constexpr size_t SZ_RWM = (size_t)16 * RNC * 4096 * 2;
constexpr size_t RW_M3 = 0, RW_M2 = SZ_RWM, RW_Z5 = 2 * SZ_RWM, RW_P63 = 3 * SZ_RWM, RW_END = RW_P63 + (size_t)16 * RNC * 64 * 4;
constexpr size_t WS_END   = WS_RW + RW_END;

constexpr int CW_BAR = 0;
constexpr int CW_CNT = 4096;

struct Args { const float* in[49]; float* out; unsigned char* ws; int s_lo, s_hi; };

struct Ctx {
    const float* const* in; float* out; unsigned char* ws; unsigned char* smem; int tid, lane, wave;
};

template <int WM> struct GCfg { static constexpr int WN = 8 / WM, BM = 64 * WM, BN = 64 * WN, ABYTES = BM * 128, BBYTES = BN * 128, STAGE = ABYTES + BBYTES; };

template <int WM, int SEGK, class ARow, class BRow, class Hook, class Epi>
DI void gemm_tile(const Ctx& c, int K, ARow arow, BRow brow, Hook hook, Epi epi) {
    typedef GCfg<WM> G;
    const int tid = c.tid, lane = c.lane, wave = c.wave;
    const int wm = wave / G::WN, wn = wave % G::WN, fr = lane & 15, fq = lane >> 4;
    unsigned char* smem = c.smem;
    constexpr int NA = G::BM / 64, NBq = G::BN / 64;
    const int r0 = tid >> 3, coff = ((tid & 7) ^ (r0 & 7)) * 8;
    auto stage = [&](int kt, int buf) {
        unsigned char* sa = smem + buf * G::STAGE; unsigned char* sb = sa + G::ABYTES;
#pragma unroll
        for (int i = 0; i < NA; ++i) __builtin_amdgcn_global_load_lds((const unsigned*)(arow(r0 + 64 * i) + coff + kt * 64), (unsigned*)(sa + (tid + i * NTHR) * 16), 16, 0, 0);
#pragma unroll
        for (int i = 0; i < NBq; ++i) __builtin_amdgcn_global_load_lds((const unsigned*)(brow(r0 + 64 * i) + coff + kt * 64), (unsigned*)(sb + (tid + i * NTHR) * 16), 16, 0, 0);
    };
    f32x4 acc[4][4];
#pragma unroll
    for (int m = 0; m < 4; ++m)
#pragma unroll
        for (int n = 0; n < 4; ++n) acc[m][n] = (f32x4){0.f, 0.f, 0.f, 0.f};
    const int T = K / 64;
    __syncthreads();
    stage(0, 0);
    for (int t = 0; t < T; ++t) {
        asm volatile("s_waitcnt vmcnt(0)" ::: "memory");
        __syncthreads();
        if (t + 1 < T) stage(t + 1, (t + 1) & 1);
        const unsigned char* sa = smem + (t & 1) * G::STAGE; const unsigned char* sb = sa + G::ABYTES;
#pragma unroll
        for (int ks = 0; ks < 2; ++ks) {
            bf16x8 af[4], bfr[4];
            const int sl = ((ks * 4 + fq) ^ (fr & 7)) * 16;
#pragma unroll
            for (int m = 0; m < 4; ++m) af[m] = *(const bf16x8*)(sa + (wm * 64 + m * 16 + fr) * 128 + sl);
#pragma unroll
            for (int n = 0; n < 4; ++n) bfr[n] = *(const bf16x8*)(sb + (wn * 64 + n * 16 + fr) * 128 + sl);
#pragma unroll
            for (int m = 0; m < 4; ++m)
#pragma unroll
                for (int n = 0; n < 4; ++n) acc[m][n] = __builtin_amdgcn_mfma_f32_16x16x32_bf16(bfr[n], af[m], acc[m][n], 0, 0, 0);
        }
        if (SEGK > 0) { if (((t + 1) * 64) % (SEGK > 0 ? SEGK : 64) == 0) hook(acc, ((t + 1) * 64) / (SEGK > 0 ? SEGK : 64) - 1, wm * 64, wn * 64, fr, fq); }
    }
    epi(acc, wm * 64, wn * 64, fr, fq);
}
struct NoHook { DI void operator()(f32x4 (&)[4][4], int, int, int, int, int) const {} };

#ifndef INPROJ_WGM
#define INPROJ_WGM 4
#define MERGE2_WGM 8
#endif
namespace pg8 {
#define PG8_LAS __attribute__((address_space(3)))
typedef unsigned short bf16_t;
typedef short bf16x8 __attribute__((ext_vector_type(8)));
typedef float f32x4 __attribute__((ext_vector_type(4)));
constexpr int BM = 256, BK = 64, HALF = 128, HTB = HALF * BK * 2  , STAGE_BYTES = 8 * HTB, NXCD = 8, WGM = 4;

__host__ __device__ __forceinline__ int lds_byte(int r, int c) { const int st = (r >> 4) * 2 + (c >> 5), rr = r & 15, cc = c & 31, ob = rr * 64 + cc * 2; return st * 1024 + (ob ^ (((ob >> 9) & 1) << 5)); }
__host__ __device__ __forceinline__ void stage_rc(int b, int& R, int& C) { const int st = b / 1024, sb = b % 1024, swz = sb ^ (((sb >> 9) & 1) << 5); R = (st >> 1) * 16 + swz / 64; C = (st & 1) * 32 + (swz % 64) / 2; }
__host__ __device__ __forceinline__ int perm32(int rho) { const int n = rho >> 4, i = rho & 15; return 8 * (i >> 2) + 4 * n + (i & 3); }

struct Unit { int pm, pn; };
struct Gemm { const bf16_t* A; const bf16_t* Bt; int M, N, K, lda, ldb; };

struct StaticOrder {
    int nM, nN, nwg, G, c, wgm;
    __host__ __device__ void init(int M, int N, int G_, int c_, int wgm_ = WGM) { nM = M / BM; nN = N / BM; nwg = nM * nN; G = G_; c = c_; wgm = wgm_; }
    __host__ __device__ bool next(int i, Unit& u) const {
        const long L = (long)i * G + c; if (L >= nwg) return false;
        int wgid = (int)L; { const int q = nwg / NXCD, r = nwg % NXCD, xcd = wgid % NXCD, off = wgid / NXCD; wgid = (xcd < r ? xcd * (q + 1) : r * (q + 1) + (xcd - r) * q) + off; }
        const int nig = wgm * nN, gid = wgid / nig, fm = gid * wgm, gsz = (nM - fm) < wgm ? (nM - fm) : wgm;
        u.pm = fm + ((wgid % nig) % gsz); u.pn = (wgid % nig) / gsz; return true;
    }
    __device__ __forceinline__ void a_ready(const Unit&) const {}
    __device__ __forceinline__ void done(const Unit&) const {}
};
template <class Epi, class Sched, bool STAMP = false>
__device__ __forceinline__ void gemm_phase(PG8_LAS unsigned char* lds, const Gemm g, const Sched& S, const Epi& E, unsigned long long* stamps, int tid_in) {
    const int tid = tid_in, wid = __builtin_amdgcn_readfirstlane(tid >> 6), lane = tid & 63, wr = wid >> 2, wc = wid & 3, fr = lane & 15, fq = lane >> 4;
    const int K = g.K, nt = K / BK;
    int ts_lo = 0, ts_hi = 0, nts = 0; const unsigned long long rt_entry = STAMP ? (unsigned long long)wall_clock64() : 0ull;
#define PG8_STAMP() do { if (STAMP && wid == 0 && nts < 64) { const unsigned long long _c = (unsigned long long)clock64(); \
        ts_lo = (lane == nts) ? (int)(unsigned)_c : ts_lo; ts_hi = (lane == nts) ? (int)(unsigned)(_c >> 32) : ts_hi; ++nts; } } while (0)
    PG8_STAMP();
    unsigned voffA[2], voffB[2];
#pragma unroll
    for (int i = 0; i < 2; ++i) { int R, C; stage_rc(tid * 16 + i * 8192, R, C); const int Rb = Epi::PERM ? ((R & ~31) + perm32(R & 31)) : R;
        voffA[i] = (unsigned)(R * g.lda + C) * 2u; voffB[i] = (unsigned)(Rb * g.ldb + C) * 2u; }
    const size_t kstep = (size_t)(BK * 2);
    const size_t hstepA = (size_t)HALF * g.lda * 2, hstepB = (size_t)HALF * g.ldb * 2;
    const size_t tstepA = 2 * hstepA, tstepB = 2 * hstepB;
    const unsigned ldsw = (unsigned)wid * 1024u;
    const int aoff = lds_byte(wr * 64 + fr, fq * 8), boff = lds_byte(wc * 32 + fr, fq * 8);
#define PG8_SA(b, h) (((b) * 2 + (h)) * HTB)
#define PG8_SB(b, h) ((4 + (b) * 2 + (h)) * HTB)
#define PG8_STAGE(bufoff, gbase, voff) do { _Pragma("unroll") for (int _i = 0; _i < 2; ++_i) \
        __builtin_amdgcn_global_load_lds((const unsigned*)((const char*)(gbase) + (voff)[_i]), (PG8_LAS unsigned*)(lds + (bufoff) + ldsw + _i * 8192), 16, 0, 0); } while (0)
#define PG8_LDA(dst, b, h) do { _Pragma("unroll") for (int m = 0; m < 4; ++m) _Pragma("unroll") for (int k = 0; k < 2; ++k) dst[m][k] = *(const PG8_LAS bf16x8*)(lds + PG8_SA(b, h) + aoff + m * 2048 + k * 1024); } while (0)
#define PG8_LDB(dst, b, h) do { _Pragma("unroll") for (int n = 0; n < 2; ++n) _Pragma("unroll") for (int k = 0; k < 2; ++k) dst[n][k] = *(const PG8_LAS bf16x8*)(lds + PG8_SB(b, h) + boff + n * 2048 + k * 1024); } while (0)
#define PG8_MMA(ai, bj, At, Bt) do { __builtin_amdgcn_s_setprio(1); _Pragma("unroll") for (int m = 0; m < 4; ++m) _Pragma("unroll") for (int n = 0; n < 2; ++n) _Pragma("unroll") for (int k = 0; k < 2; ++k) \
        acc[ai][bj][m][n] = __builtin_amdgcn_mfma_f32_16x16x32_bf16(Bt[n][k], At[m][k], acc[ai][bj][m][n], 0, 0, 0); __builtin_amdgcn_s_setprio(0); } while (0)
#define PG8_WAIT_V(n) asm volatile("s_waitcnt vmcnt(" #n ")" ::: "memory")
#define PG8_WAIT_L(n) asm volatile("s_waitcnt lgkmcnt(" #n ")" ::: "memory")
#define PG8_BAR __builtin_amdgcn_s_barrier()
#define PG8_SCHED __builtin_amdgcn_sched_barrier(0)
    Unit cur, nxt; int ui = 0;
    if (!S.next(0, cur)) return;
    f32x4 acc[2][2][4][2];
#pragma unroll
    for (int a = 0; a < 2; ++a)
#pragma unroll
        for (int b = 0; b < 2; ++b)
#pragma unroll
            for (int m = 0; m < 4; ++m)
#pragma unroll
                for (int n = 0; n < 2; ++n) acc[a][b][m][n] = (f32x4){0.f, 0.f, 0.f, 0.f};
    bf16x8 At[4][2], B0[2][2], B1[2][2];
    const char* cA = (const char*)g.A + (size_t)cur.pm * tstepA; const char* cB = (const char*)g.Bt + (size_t)cur.pn * tstepB;
    S.a_ready(cur);
    PG8_STAGE(PG8_SB(0, 0), cB, voffB); PG8_STAGE(PG8_SA(0, 0), cA, voffA); PG8_STAGE(PG8_SB(0, 1), cB + hstepB, voffB); PG8_STAGE(PG8_SA(0, 1), cA + hstepA, voffA);
    if (wr == 1) PG8_BAR;
    PG8_WAIT_V(4); PG8_BAR;
    PG8_STAGE(PG8_SB(1, 0), cB + kstep, voffB); PG8_STAGE(PG8_SA(1, 0), cA + kstep, voffA); PG8_STAGE(PG8_SB(1, 1), cB + hstepB + kstep, voffB);
    PG8_WAIT_V(6); PG8_BAR;
    PG8_STAMP();
    for (;;) {
        const bool has_next = S.next(ui + 1, nxt);
        const char* nA = has_next ? (const char*)g.A + (size_t)nxt.pm * tstepA : cA; const char* nB = has_next ? (const char*)g.Bt + (size_t)nxt.pn * tstepB : cB;
        for (int t = 0; t < nt; t += 2) {
            const bool last = (t == nt - 2);
            const char* a1 = cA + (size_t)(t + 1) * kstep;
            const char* a2 = last ? nA : cA + (size_t)(t + 2) * kstep; const char* b2 = last ? nB : cB + (size_t)(t + 2) * kstep;
            const char* a3 = a2 + kstep; const char* b3 = b2 + kstep;
            if (last && has_next) S.a_ready(nxt);
            PG8_LDB(B0, 0, 0); PG8_SCHED; PG8_LDA(At, 0, 0); PG8_STAGE(PG8_SA(1, 1), a1 + hstepA, voffA);
            PG8_WAIT_L(8); PG8_BAR; PG8_WAIT_L(0); PG8_MMA(0, 0, At, B0); PG8_BAR; PG8_SCHED;
            PG8_LDB(B1, 0, 1); PG8_STAGE(PG8_SB(0, 0), b2, voffB);
            PG8_BAR; PG8_WAIT_L(0); PG8_MMA(0, 1, At, B1); PG8_BAR;
            PG8_LDA(At, 0, 1); PG8_STAGE(PG8_SA(0, 0), a2, voffA);
            PG8_BAR; PG8_WAIT_L(0); PG8_MMA(1, 0, At, B0); PG8_BAR; PG8_SCHED;
            PG8_STAGE(PG8_SB(0, 1), b2 + hstepB, voffB);
            PG8_WAIT_V(6); PG8_BAR; PG8_MMA(1, 1, At, B1); PG8_BAR;
            PG8_LDB(B0, 1, 0); PG8_SCHED; PG8_LDA(At, 1, 0); PG8_STAGE(PG8_SA(0, 1), a2 + hstepA, voffA);
            PG8_WAIT_L(8); PG8_BAR; PG8_WAIT_L(0); PG8_MMA(0, 0, At, B0); PG8_BAR; PG8_SCHED;
            PG8_LDB(B1, 1, 1); PG8_STAGE(PG8_SB(1, 0), b3, voffB);
            PG8_BAR; PG8_WAIT_L(0); PG8_MMA(0, 1, At, B1); PG8_BAR;
            PG8_LDA(At, 1, 1); PG8_STAGE(PG8_SA(1, 0), a3, voffA);
            PG8_BAR; PG8_WAIT_L(0); PG8_MMA(1, 0, At, B0); PG8_BAR; PG8_SCHED;
            PG8_STAGE(PG8_SB(1, 1), b3 + hstepB, voffB);
            PG8_WAIT_V(6); PG8_BAR; PG8_MMA(1, 1, At, B1); PG8_BAR;
        }
        PG8_STAMP();
        if constexpr (!Epi::AFTER_DRAIN) { E(acc, cur, wr, wc, fr, fq); S.done(cur); }
        PG8_STAMP();
        if (!has_next) break;
#pragma unroll
        for (int a = 0; a < 2; ++a)
#pragma unroll
            for (int b = 0; b < 2; ++b)
#pragma unroll
                for (int m = 0; m < 4; ++m)
#pragma unroll
                    for (int n = 0; n < 2; ++n) acc[a][b][m][n] = (f32x4){0.f, 0.f, 0.f, 0.f};
        cur = nxt; cA = nA; cB = nB; ++ui;
    }
    PG8_WAIT_V(0);
    if (wr == 0) PG8_BAR;
    PG8_BAR;
    if constexpr (Epi::AFTER_DRAIN) { E.fused(acc, cur, wr, wc, fr, fq, lds, wid, lane); S.done(cur); }
    PG8_STAMP();
    if (STAMP && wid == 0) { stamps[lane] = lane < nts ? (((unsigned long long)(unsigned)ts_hi << 32) | (unsigned)ts_lo) : 0ull;
        if (lane == 62) stamps[62] = rt_entry; if (lane == 63) stamps[63] = (unsigned long long)wall_clock64(); }
#undef PG8_STAMP
#undef PG8_SA
#undef PG8_SB
#undef PG8_STAGE
#undef PG8_LDA
#undef PG8_LDB
#undef PG8_MMA
#undef PG8_WAIT_V
#undef PG8_WAIT_L
#undef PG8_BAR
#undef PG8_SCHED
}
}

DI int rowmap(int n, int mode) { return mode == 0 ? n : ((n >> 4) * 32 + (n & 15) + (mode == 2 ? 16 : 0)); }
DI void tconv_tile(const Ctx& c, const float* src, int ld, int N, bf16_t* dst, int ld_dst, int mode, int tk, int tn) {
    bf16_t* T = (bf16_t*)c.smem;
    const int k0 = tk * 64, n0 = tn * 64, tid = c.tid;
    __syncthreads();
#pragma unroll
    for (int i = 0; i < 2; ++i) {
        const int kk = (tid >> 4) + i * 32, n4 = (tid & 15) * 4;
        float4 v = make_float4(0.f, 0.f, 0.f, 0.f);
        if (n0 + n4 < N) v = *(const float4*)(src + (size_t)(k0 + kk) * ld + n0 + n4);
        T[(n4 + 0) * 72 + kk] = f2bf(v.x); T[(n4 + 1) * 72 + kk] = f2bf(v.y); T[(n4 + 2) * 72 + kk] = f2bf(v.z); T[(n4 + 3) * 72 + kk] = f2bf(v.w);
    }
    __syncthreads();
    const int n = tid >> 3, k8 = (tid & 7) * 8;
    if (n0 + n < N) *(u32x4*)(dst + (size_t)rowmap(n0 + n, mode) * ld_dst + k0 + k8) = *(const u32x4*)(T + n * 72 + k8);
}
DI void tconv(const Ctx& c, const float* src, int ld, int K, int N, bf16_t* dst, int ld_dst, int mode, int rot) {
    const int ntk = K / 64, ntn = (N + 63) / 64, nt = ntk * ntn, G = gridDim.x;
    for (int t = (blockIdx.x + G - (rot % G)) % G; t < nt; t += G) tconv_tile(c, src, ld, N, dst, ld_dst, mode, t / ntn, t % ntn);
}

DI void wconv(const Ctx& c, const float* src, int ld, int K, int N, bf16_t* dst, int ld_dst, int rot) {
    const int ntk = K / 64, ntn = (N + 63) / 64, nt = ntk * ntn, GW = gridDim.x * 8, w0 = blockIdx.x * 8 + c.wave;
    for (int t = (w0 + GW - (rot % GW)) % GW; t < nt; t += GW) {
        const int tk = t / ntn, tn = t % ntn, n = tn * 64 + c.lane;
        if (n < N) {
            const float* sp = src + (size_t)(tk * 64) * ld + n; bf16_t* dp = dst + (size_t)n * ld_dst + tk * 64;
#pragma unroll
            for (int kb = 0; kb < 8; ++kb) {
                float v[8];
#pragma unroll
                for (int j = 0; j < 8; ++j) v[j] = sp[(size_t)(kb * 8 + j) * ld];
                u32x4 w4; w4.x = pack2(v[0], v[1]); w4.y = pack2(v[2], v[3]); w4.z = pack2(v[4], v[5]); w4.w = pack2(v[6], v[7]);
                *(u32x4*)(dp + kb * 8) = w4;
            }
        }
    }
}
DI void phase_prologue(const Ctx& c) {
    unsigned char* wsm = c.ws + WS_WSM;
    const int tid = c.tid, G = gridDim.x, gtid = blockIdx.x * NTHR + tid, gn = G * NTHR;
    {
        const float4* x = (const float4*)c.in[0]; const float4* cx = (const float4*)c.in[2]; float4* H = (float4*)(c.ws + WS_H);
        for (size_t i = gtid; i < (size_t)NZ * 256; i += gn) {
            const int z = (int)(i >> 8), q = (int)(i & 255), b = z / TZ, s = z % TZ;
            H[i] = (s < CTX) ? cx[((size_t)b * CTX + s) * 256 + q] : x[((size_t)b * SEQ + (s - CTX)) * 256 + q];
        }
    }
    {
        float* rope = (float*)(wsm + OFF_ROPE);
        for (int i = gtid; i < SEQ * 16; i += gn) {
            const int t = i >> 4, a = (i >> 3) & 1, f = i & 7;
            const float pos = (float)(a == 0 ? (t >> 6) : (t & 63));
            const float inv = powf(10000.f, -(float)f / 8.f);
            float sn, cs; sincosf(pos * inv, &sn, &cs);
            rope[i * 2] = cs; rope[i * 2 + 1] = sn;
        }
    }
    {
        float* s5t = (float*)(wsm + OFF_S5T);
        for (int i = blockIdx.x + tid * G; i < NL * 2 * 16 * 64; i += G * NTHR) {
            const int ldg = i >> 6;
            const double lr = c.in[24][i], li = c.in[25][i], dt = exp((double)c.in[26][ldg]);
            const double mag = exp(lr * dt), are = mag * cos(li * dt), aim = mag * sin(li * dt);
            const double m256 = exp(lr * dt * 64.0), a256r = m256 * cos(li * dt * 64.0), a256i = m256 * sin(li * dt * 64.0);
            const double den = lr * lr + li * li, nr = are - 1.0, ni = aim;
            const double cfr = (nr * lr + ni * li) / den, cfi = (ni * lr - nr * li) / den;
            float* o = s5t + (size_t)i * 36;
            o[0] = (float)are; o[1] = (float)aim; o[2] = (float)a256r; o[3] = (float)a256i;
            for (int ch = 0; ch < 16; ++ch) {
                const double br = c.in[27][(size_t)i * 16 + ch], bi = c.in[28][(size_t)i * 16 + ch];
                o[4 + ch] = (float)(cfr * br - cfi * bi); o[20 + ch] = (float)(cfr * bi + cfi * br);
            }
        }
    }
    {
        float* rwt = (float*)(wsm + OFF_RWT);
        for (int i = gtid; i < NL * 36 * 1024; i += gn) {
            const int l = i / (36 * 1024), e = (i / 1024) % 36, d = i & 1023;
            rwt[i] = e < 4 ? c.in[41][((size_t)l * 1024 + d) * 4 + e] : c.in[43][((size_t)l * 1024 + d) * 32 + (e - 4)];
        }
    }
    if (blockIdx.x == 0 && tid < NL) {
        float s1 = 0.f, s2 = 0.f;
        for (int i = 0; i < 32; ++i) { s1 += c.in[34][tid * 32 + i] * c.in[35][tid * 32 + i]; s2 += c.in[36][tid * 32 + i] * c.in[37][tid * 32 + i]; }
        ((float*)(wsm + OFF_LAM))[tid] = expf(s1) - expf(s2) + (0.8f - 0.6f * expf(-0.3f * (float)tid));
    }
    {
        float* sv = (float*)c.smem;
        float* red = sv + 3 * 1024;
        __syncthreads();
        for (int i = tid; i < 3 * 1024; i += NTHR) { const float v = i < 2048 ? c.in[1][i] : c.in[3][i - 2048]; sv[i] = siluf_(v); }
        __syncthreads();
        float* modv = (float*)(wsm + OFF_MODV);
        for (int u = blockIdx.x; u < NL * 96; u += G) {
            const int l = u / 96, col = (u % 96) * 64 + (tid & 63), ks = tid >> 6;
            const float* w = c.in[4] + (size_t)l * 1024 * 6144 + col;
            float a0 = 0.f, a1 = 0.f, a2 = 0.f;
            for (int k = ks * 128; k < ks * 128 + 128; ++k) { const float wv = w[(size_t)k * 6144]; a0 += sv[k] * wv; a1 += sv[1024 + k] * wv; a2 += sv[2048 + k] * wv; }
            red[(ks * 64 + (tid & 63)) * 3 + 0] = a0; red[(ks * 64 + (tid & 63)) * 3 + 1] = a1; red[(ks * 64 + (tid & 63)) * 3 + 2] = a2;
            __syncthreads();
            if (tid < 192) {
                const int cc = tid & 63, sel = tid >> 6; float s = 0.f;
                for (int k2 = 0; k2 < 8; ++k2) s += red[(k2 * 64 + cc) * 3 + sel];
                const int colo = (u % 96) * 64 + cc;
                modv[((size_t)l * 3 + sel) * 6144 + colo] = s + c.in[5][l * 6144 + colo];
            }
            __syncthreads();
        }
    }
    for (int l = 0; l < NL; ++l) {
        wconv(c, c.in[8] + (size_t)l * 1024 * NIN, NIN, 1024, NIN, (bf16_t*)(wsm + OFF_WINT + l * SZ_WINT), 1024, l * 700);
        tconv(c, c.in[11] + (size_t)l * 256 * 384, 384, 256, 384, (bf16_t*)(wsm + OFF_WUQT + l * SZ_WUQT), 256, 0, 40);
        tconv(c, c.in[12] + (size_t)l * 128 * 512, 512, 128, 512, (bf16_t*)(wsm + OFF_WUKVT + l * SZ_WUKVT), 128, 0, 70);
        for (int d = 0; d < 2; ++d) {
            tconv(c, c.in[15] + (size_t)(l * 2 + d) * 64 * 256, 256, 64, 256, (bf16_t*)(wsm + OFF_W2T + l * SZ_W2T) + d * 256 * 64, 64, 0, 90 + d * 8);
            tconv(c, c.in[17] + (size_t)(l * 2 + d) * 64 * 256, 256, 64, 256, (bf16_t*)(wsm + OFF_A2T + l * SZ_A2T) + d * 256 * 64, 64, 0, 110 + d * 8);
        }
        tconv(c, c.in[18] + (size_t)l * 128 * 256, 256, 128, 256, (bf16_t*)(wsm + OFF_G2T + l * SZ_G2T), 128, 0, 130);
        tconv(c, c.in[32] + (size_t)l * 256 * 256, 256, 256, 256, (bf16_t*)(wsm + OFF_GLUT + l * SZ_GLUT), 256, 0, 140);
        for (int n = 0; n < 4; ++n)
            wconv(c, c.in[39] + (size_t)(l * 4 + n) * 256 * 1024, 1024, 256, 1024, (bf16_t*)(wsm + OFF_WBT + l * SZ_WBT) + n * 256, 1024, 300 + n * 64 + l * 1000);
        wconv(c, c.in[40] + (size_t)l * 1024 * 1024, 1024, 1024, 1024, (bf16_t*)(wsm + OFF_WOUTT + l * SZ_WOUTT), 1024, 1200 + l * 400);
    }
}

DI void phase_expert_convert(const Ctx& c, int l) {
    const int G = gridDim.x, lane = c.lane;
    for (int t = blockIdx.x * 8 + c.wave; t < 32 * 384; t += G * 8) {
        const int e = t / 384, r = t % 384;
        const float* src; bf16_t* dst; int ld, ldd, mode, tk, tn;
        if (r < 128)      { src = c.in[45] + ((size_t)l * 32 + e) * 1024 * 512; dst = (bf16_t*)(c.ws + WS_EXPW + (size_t)e * SZ_WGU); ld = 512; ldd = 1024; mode = 1; tk = r / 8; tn = r % 8; }
        else if (r < 256) { src = c.in[46] + ((size_t)l * 32 + e) * 1024 * 512; dst = (bf16_t*)(c.ws + WS_EXPW + (size_t)e * SZ_WGU); ld = 512; ldd = 1024; mode = 2; tk = (r - 128) / 8; tn = (r - 128) % 8; }
        else              { src = c.in[47] + ((size_t)l * 32 + e) * 512 * 1024; dst = (bf16_t*)(c.ws + WS_EXPW + 32 * SZ_WGU + (size_t)e * SZ_WD); ld = 1024; ldd = 512; mode = 0; tk = (r - 256) / 16; tn = (r - 256) % 16; }
        const int n = tn * 64 + lane; const float* sp = src + (size_t)(tk * 64) * ld + n; bf16_t* dp = dst + (size_t)rowmap(n, mode) * ldd + tk * 64;
        float v[64];
#pragma unroll
        for (int k = 0; k < 64; ++k) v[k] = __builtin_nontemporal_load(sp + (size_t)k * ld);
#pragma unroll
        for (int kb = 0; kb < 8; ++kb) {
            u32x4 w4; w4.x = pack2(v[kb * 8], v[kb * 8 + 1]); w4.y = pack2(v[kb * 8 + 2], v[kb * 8 + 3]); w4.z = pack2(v[kb * 8 + 4], v[kb * 8 + 5]); w4.w = pack2(v[kb * 8 + 6], v[kb * 8 + 7]);
            *(u32x4*)(dp + kb * 8) = w4;
        }
    }
}

DI void phase_norm1(const Ctx& c, int l) {
    const float* modv = (const float*)(c.ws + WS_WSM + OFF_MODV);
    float* H = (float*)(c.ws + WS_H); const bf16_t* Y = (const bf16_t*)(c.ws + WS_P);
    bf16_t* XN = (bf16_t*)(c.ws + WS_BUFA);
    const float* g1 = c.in[6] + l * 1024;
    for (int row = blockIdx.x * 8 + c.wave; row < NZ; row += gridDim.x * 8) {
        const int b = row / TZ, s = row % TZ, sel = s < CTX ? 2 : b;
        float4 v[4]; float ss = 0.f;
#pragma unroll
        for (int q = 0; q < 4; ++q) {
            const int col = q * 256 + c.lane * 4;
            v[q] = *(const float4*)(H + (size_t)row * D + col);
            if (l > 0) {
                float ya[4], yb[4]; unpack4(*(const u32x2*)(Y + (size_t)row * D + col), ya); unpack4(*(const u32x2*)(Y + ((size_t)NZ + row) * D + col), yb);
                const float4 m5 = *(const float4*)(modv + ((size_t)(l - 1) * 3 + sel) * 6144 + 5 * 1024 + col);
                v[q].x += m5.x * (ya[0] + yb[0]); v[q].y += m5.y * (ya[1] + yb[1]); v[q].z += m5.z * (ya[2] + yb[2]); v[q].w += m5.w * (ya[3] + yb[3]);
                *(float4*)(H + (size_t)row * D + col) = v[q];
            }
            ss += v[q].x * v[q].x + v[q].y * v[q].y + v[q].z * v[q].z + v[q].w * v[q].w;
        }
        ss = wave_sum(ss);
        const float rs = rsqrtf(ss * (1.f / 1024.f) + 1e-6f);
#pragma unroll
        for (int q = 0; q < 4; ++q) {
            const int col = q * 256 + c.lane * 4;
            const float4 g = *(const float4*)(g1 + col), m0 = *(const float4*)(modv + ((size_t)l * 3 + sel) * 6144 + col), m1 = *(const float4*)(modv + ((size_t)l * 3 + sel) * 6144 + 1024 + col);
            *(u32x2*)(XN + (size_t)row * D + col) = pack4(v[q].x * rs * g.x * (1.f + m1.x) + m0.x, v[q].y * rs * g.y * (1.f + m1.y) + m0.y,
                                                          v[q].z * rs * g.z * (1.f + m1.z) + m0.z, v[q].w * rs * g.w * (1.f + m1.w) + m0.w);
        }
    }
}

DI void phase_final(const Ctx& c) {
    const float* modv = (const float*)(c.ws + WS_WSM + OFF_MODV);
    const float* H = (const float*)(c.ws + WS_H); const bf16_t* Y = (const bf16_t*)(c.ws + WS_P);
    const float* g = c.in[48];
    for (int r = blockIdx.x * 8 + c.wave; r < NB * SEQ; r += gridDim.x * 8) {
        const int b = r / SEQ, t = r % SEQ, row = b * TZ + CTX + t;
        float4 v[4]; float ss = 0.f;
#pragma unroll
        for (int q = 0; q < 4; ++q) {
            const int col = q * 256 + c.lane * 4;
            v[q] = *(const float4*)(H + (size_t)row * D + col);
            float ya[4], yb[4]; unpack4(*(const u32x2*)(Y + (size_t)row * D + col), ya); unpack4(*(const u32x2*)(Y + ((size_t)NZ + row) * D + col), yb);
            const float4 m5 = *(const float4*)(modv + ((size_t)(NL - 1) * 3 + b) * 6144 + 5 * 1024 + col);
            v[q].x += m5.x * (ya[0] + yb[0]); v[q].y += m5.y * (ya[1] + yb[1]); v[q].z += m5.z * (ya[2] + yb[2]); v[q].w += m5.w * (ya[3] + yb[3]);
            ss += v[q].x * v[q].x + v[q].y * v[q].y + v[q].z * v[q].z + v[q].w * v[q].w;
        }
        ss = wave_sum(ss);
        const float rs = rsqrtf(ss * (1.f / 1024.f) + 1e-6f);
#pragma unroll
        for (int q = 0; q < 4; ++q) {
            const int col = q * 256 + c.lane * 4; const float4 gg = *(const float4*)(g + col);
            *(float4*)(c.out + (size_t)r * D + col) = make_float4(v[q].x * rs * gg.x, v[q].y * rs * gg.y, v[q].z * rs * gg.z, v[q].w * rs * gg.w);
        }
    }
}

struct EpiInproj {
    static constexpr bool PERM = true, AFTER_DRAIN = false;
    bf16_t *PM, *PS, *PR, *PD, *GT;
    DI void operator()(const pg8::f32x4 (&acc)[2][2][4][2], const pg8::Unit& u, int wr, int wc, int fr, int fq) const {
        const int row0 = u.pm * 256 + wr * 64 + fr, col0 = u.pn * 256 + wc * 32 + 8 * fq;
#pragma unroll
        for (int bj = 0; bj < 2; ++bj) {
            const int col = col0 + bj * 128;
            bf16_t* dst; int ld, cc; bool gate = false;
            if (col < 416) { dst = PM; ld = 416; cc = col; }
            else if (col < 1440) { dst = PR; ld = 1024; cc = col - 416; }
            else if (col < 1696) { dst = PS; ld = 256; cc = col - 1440; }
            else if (col < 2464) { dst = PD; ld = 768; cc = col - 1696; }
            else if (col < NIN) { dst = GT; ld = 4096; cc = col - 2464; gate = true; }
            else continue;
#pragma unroll
            for (int ai = 0; ai < 2; ++ai)
#pragma unroll
                for (int m = 0; m < 4; ++m) {
                    const int row = row0 + ai * 128 + m * 16; pg8::f32x4 v0 = acc[ai][bj][m][0], v1 = acc[ai][bj][m][1];
                    if (gate) { v0[0] = sigmoidf_(v0[0]); v0[1] = sigmoidf_(v0[1]); v0[2] = sigmoidf_(v0[2]); v0[3] = sigmoidf_(v0[3]);
                                v1[0] = sigmoidf_(v1[0]); v1[1] = sigmoidf_(v1[1]); v1[2] = sigmoidf_(v1[2]); v1[3] = sigmoidf_(v1[3]); }
                    u32x4 w; w.x = pack2(v0[0], v0[1]); w.y = pack2(v0[2], v0[3]); w.z = pack2(v1[0], v1[1]); w.w = pack2(v1[2], v1[3]);
                    *(u32x4*)(dst + (size_t)row * ld + cc) = w;
                }
        }
    }
};
DI void phase_inproj(const Ctx& c, int l) {
    EpiInproj E; E.PM = (bf16_t*)(c.ws + WS_P + P_PM); E.PS = (bf16_t*)(c.ws + WS_P + P_PS); E.PR = (bf16_t*)(c.ws + WS_P + P_PR); E.PD = (bf16_t*)(c.ws + WS_P + P_PD); E.GT = (bf16_t*)(c.ws + WS_GT);
    pg8::Gemm g{(const bf16_t*)(c.ws + WS_BUFA), (const bf16_t*)(c.ws + WS_WSM + OFF_WINT + l * SZ_WINT), NZ, NINP, 1024, 1024, 1024};
    pg8::StaticOrder S; S.init(NZ, NINP, (int)gridDim.x, (int)blockIdx.x, INPROJ_WGM);
    __syncthreads();
    pg8::gemm_phase<EpiInproj, pg8::StaticOrder, false>((PG8_LAS unsigned char*)c.smem, g, S, E, nullptr, c.tid);
}

DI void phase_prep(const Ctx& c, int l) {
    unsigned char* ws = c.ws; const int lane = c.lane, wave = c.wave, tid = c.tid;
    const bf16_t* PM = (const bf16_t*)(ws + WS_P + P_PM); const bf16_t* PR = (const bf16_t*)(ws + WS_P + P_PR); const bf16_t* PD = (const bf16_t*)(ws + WS_P + P_PD);
    bf16_t* CQN = (bf16_t*)(ws + WS_MISC + MS_CQN); bf16_t* TW = (bf16_t*)(ws + WS_MISC + MS_TW); bf16_t* AL = (bf16_t*)(ws + WS_MISC + MS_AL); bf16_t* SG = (bf16_t*)(ws + WS_MISC + MS_SG);
    bf16_t* KM = (bf16_t*)(ws + WS_EXPW + MX_KM); bf16_t* QD = (bf16_t*)(ws + WS_EXPW + MX_QD); bf16_t* KD_ = (bf16_t*)(ws + WS_EXPW + MX_KD); bf16_t* VDT = (bf16_t*)(ws + WS_EXPW + MX_VDT);
    bf16_t* RB = (bf16_t*)(ws + WS_EXPW + MX_RB); bf16_t* KB = (bf16_t*)(ws + WS_EXPW + MX_KB); bf16_t* VB = (bf16_t*)(ws + WS_EXPW + MX_VB); bf16_t* KKB = (bf16_t*)(ws + WS_EXPW + MX_KKB);
    const float* rope = (const float*)(ws + WS_WSM + OFF_ROPE);
    const float* gq = c.in[9] + l * 256; const float* gkv = c.in[10] + l * 128; const float* mu = c.in[13] + l * 1024; const float* k_k = c.in[19] + l * 256;
    bf16_t* Vs = (bf16_t*)c.smem;
    const float qsc = 0.17677669529663687f * LOG2E;
    for (int tile = blockIdx.x; tile < NZ / 16; tile += gridDim.x) {
        __syncthreads();
        struct PrepRow { u32x2 pmq; unsigned pmkv; bf16_t pmr; float2 csm; u32x2 pdq, pdk, pdv; float4 csa, csb; u32x2 cu[4], pv[4], nx[4]; };
        PrepRow R[2];
#pragma unroll
        for (int i = 0; i < 2; ++i) {
            const int rt = wave * 2 + i, z = tile * 16 + rt, s = z % TZ; const bool lat = s >= CTX; const int tl = lat ? s - CTX : 0;
            PrepRow& r = R[i];
            const bf16_t* pm = PM + (size_t)z * 416;
            r.pmq = *(const u32x2*)(pm + lane * 4); r.pmkv = *(const unsigned*)(pm + 256 + lane * 2); r.pmr = pm[384 + (lane & 31)];
            r.csm = *(const float2*)(rope + ((size_t)tl * 16 + ((lane & 31) >> 4) * 8 + (lane & 7)) * 2);
            const bf16_t* pd = PD + (size_t)z * 768; const int i0 = lane * 4, ii = i0 & 31;
            r.pdq = *(const u32x2*)(pd + i0); r.pdk = *(const u32x2*)(pd + 256 + i0); r.pdv = *(const u32x2*)(pd + 512 + i0);
            const float* cs = rope + ((size_t)tl * 16 + (ii >> 4) * 8 + (ii & 7)) * 2;
            r.csa = *(const float4*)cs; r.csb = *(const float4*)(cs + 4);
            const bf16_t* pr = PR + (size_t)z * 1024;
            const bool hp = (s != 0) && (s != CTX), hn = (s != CTX - 1) && (s != TZ - 1);
#pragma unroll
            for (int q = 0; q < 4; ++q) {
                const int col = q * 256 + lane * 4;
                r.cu[q] = *(const u32x2*)(pr + col); r.pv[q] = (u32x2){0u, 0u}; r.nx[q] = (u32x2){0u, 0u};
                if (hp) r.pv[q] = *(const u32x2*)(pr - 1024 + col);
                if (hn) r.nx[q] = *(const u32x2*)(pr + 1024 + col);
            }
        }
#pragma unroll
        for (int i = 0; i < 2; ++i) {
            const int rt = wave * 2 + i, z = tile * 16 + rt, b = z / TZ, s = z % TZ; const bool lat = s >= CTX;
            const PrepRow& r = R[i];
            {
                float x[4]; unpack4(r.pmq, x);
                float ss = wave_sum(x[0] * x[0] + x[1] * x[1] + x[2] * x[2] + x[3] * x[3]);
                float rs = rsqrtf(ss * (1.f / 256.f) + 1e-6f);
                const float4 g = *(const float4*)(gq + lane * 4);
                *(u32x2*)(CQN + (size_t)z * 384 + lane * 4) = pack4(x[0] * rs * g.x, x[1] * rs * g.y, x[2] * rs * g.z, x[3] * rs * g.w);
                const float y0 = lo2f(r.pmkv), y1 = hi2f(r.pmkv);
                ss = wave_sum(y0 * y0 + y1 * y1); rs = rsqrtf(ss * (1.f / 128.f) + 1e-6f);
                const float2 g2 = *(const float2*)(gkv + lane * 2);
                *(unsigned*)(CQN + (size_t)z * 384 + 256 + lane * 2) = pack2(y0 * rs * g2.x, y1 * rs * g2.y);
                float kr = bf2f(r.pmr);
                const float pr = __shfl_xor(kr, 8, 64);
                if (lat) kr = kr * r.csm.x + ((lane & 8) ? pr : -pr) * r.csm.y;
                if (lane < 32) {
                    const bf16_t kv = f2bf(kr);
#pragma unroll
                    for (int h = 0; h < 4; ++h) KM[((size_t)(b * 4 + h) * TZ + s) * 96 + 64 + lane] = kv;
                }
            }
            {
                const int i0 = lane * 4, hh = i0 >> 6, ii = i0 & 31, nn = (i0 >> 5) & 1;
                const float cs[8] = {r.csa.x, r.csa.y, r.csa.z, r.csa.w, r.csb.x, r.csb.y, r.csb.z, r.csb.w};
                const bool hi = (ii & 8) != 0;
#pragma unroll
                for (int w = 0; w < 2; ++w) {
                    float x[4]; unpack4(w == 0 ? r.pdq : r.pdk, x);
                    float o[4];
#pragma unroll
                    for (int j = 0; j < 4; ++j) {
                        const float p = __shfl_xor(x[j], 2, 64);
                        o[j] = lat ? (x[j] * cs[2 * j] + (hi ? p : -p) * cs[2 * j + 1]) : x[j];
                        if (w == 0) o[j] *= qsc;
                    }
                    bf16_t* dst = (w == 0 ? QD : KD_) + ((size_t)(b * 4 + hh) * TZ + s) * 64 + nn * 32 + ii;
                    *(u32x2*)dst = pack4(o[0], o[1], o[2], o[3]);
                }
                *(u32x2*)(Vs + rt * 264 + i0) = r.pdv;
            }
            {
#pragma unroll
                for (int q = 0; q < 4; ++q) {
                    const int col = q * 256 + lane * 4;
                    float cu[4], pv[4], nx[4];
                    unpack4(r.cu[q], cu); unpack4(r.pv[q], pv); unpack4(r.nx[q], nx);
                    const float4 m = *(const float4*)(mu + col);
                    float zv[4];
                    zv[0] = cu[0] + (0.5f * (pv[0] + nx[0]) - cu[0]) * m.x; zv[1] = cu[1] + (0.5f * (pv[1] + nx[1]) - cu[1]) * m.y;
                    zv[2] = cu[2] + (0.5f * (pv[2] + nx[2]) - cu[2]) * m.z; zv[3] = cu[3] + (0.5f * (pv[3] + nx[3]) - cu[3]) * m.w;
                    if (q == 0) *(u32x2*)(RB + (size_t)z * 256 + lane * 4) = pack4(zv[0], zv[1], zv[2], zv[3]);
                    else if (q == 1) {
                        *(u32x2*)(KB + (size_t)z * 256 + lane * 4) = pack4(zv[0], zv[1], zv[2], zv[3]);
                        const float4 kk4 = *(const float4*)(k_k + lane * 4);
                        const float a0 = zv[0] * kk4.x, a1 = zv[1] * kk4.y, a2 = zv[2] * kk4.z, a3 = zv[3] * kk4.w;
                        const float ssq = sum16(a0 * a0 + a1 * a1 + a2 * a2 + a3 * a3);
                        const float inv = 1.f / fmaxf(sqrtf(ssq), 1e-12f);
                        *(u32x2*)(KKB + (size_t)z * 256 + lane * 4) = pack4(a0 * inv, a1 * inv, a2 * inv, a3 * inv);
                    } else if (q == 2) *(u32x2*)(VB + (size_t)z * 256 + lane * 4) = pack4(zv[0], zv[1], zv[2], zv[3]);
                    else {
                        if (lane < 16) *(u32x2*)(TW + (size_t)z * 64 + lane * 4) = pack4(tanhf_(zv[0]), tanhf_(zv[1]), tanhf_(zv[2]), tanhf_(zv[3]));
                        else if (lane < 32) *(u32x2*)(AL + (size_t)z * 64 + (lane - 16) * 4) = pack4(zv[0], zv[1], zv[2], zv[3]);
                        else *(u32x2*)(SG + (size_t)z * 128 + (lane - 32) * 4) = pack4(sigmoidf_(zv[0]), sigmoidf_(zv[1]), sigmoidf_(zv[2]), sigmoidf_(zv[3]));
                    }
                }
            }
        }
        __syncthreads();
        {
            const int z0 = tile * 16, b = z0 / TZ, s0 = z0 % TZ;
#pragma unroll
            for (int i = 0; i < 1; ++i) {
                const int ch = tid, dv = ch >> 1, r8 = (ch & 1) * 8;
                bf16_t v[8];
#pragma unroll
                for (int j = 0; j < 8; ++j) v[j] = Vs[(r8 + j) * 264 + dv];
                u32x4 o; o.x = v[0] | ((unsigned)v[1] << 16); o.y = v[2] | ((unsigned)v[3] << 16); o.z = v[4] | ((unsigned)v[5] << 16); o.w = v[6] | ((unsigned)v[7] << 16);
                *(u32x4*)(VDT + ((size_t)(b * 4 + (dv >> 6)) * 64 + (dv & 63)) * TZ + s0 + r8) = o;
            }
        }
    }
}

constexpr int S5C = 64, S5N = TZ / S5C, S5NC = CTX / S5C;
DI int s5_tok(int dir, int i) { return dir == 0 ? i : (i < CTX ? CTX - 1 - i : TZ - 1 - (i - CTX)); }
DI void s5_stage_u(const Ctx& c, float* U, int b, int dir, int chunk, int g0, int ng) {
    const bf16_t* PS = (const bf16_t*)(c.ws + WS_P + P_PS);
    const int per = ng * 4;
    for (int e = c.tid; e < S5C * per; e += NTHR) {
        const int i = e / per, c4 = (e % per) * 4, s = s5_tok(dir, chunk * S5C + i);
        float x[4]; unpack4(*(const u32x2*)(PS + (size_t)(b * TZ + s) * 256 + g0 * 16 + c4), x);
        *(float4*)(U + i * (ng * 16) + c4) = make_float4(x[0], x[1], x[2], x[3]);
    }
}
DI void phase_s5_local(const Ctx& c, int l) {
    float* U = (float*)c.smem;
    const float* s5t = (const float*)(c.ws + WS_WSM + OFF_S5T);
    float* E = (float*)(c.ws + WS_WSM + OFF_S5E);
    for (int u = blockIdx.x; u < 2 * 2 * S5N * 2; u += gridDim.x) {
        const int gq = u & 1, chunk = (u >> 1) % S5N, dir = (u / (2 * S5N)) & 1, b = u / (4 * S5N);
        __syncthreads();
        s5_stage_u(c, U, b, dir, chunk, gq * 8, 8);
        __syncthreads();
        const int g = gq * 8 + c.wave, p = c.lane;
        const float* tb = s5t + ((size_t)((l * 2 + dir) * 16 + g) * 64 + p) * 36;
        const float are = tb[0], aim = tb[1];
        float br[16], bi[16];
#pragma unroll
        for (int ch = 0; ch < 16; ++ch) { br[ch] = tb[4 + ch]; bi[ch] = tb[20 + ch]; }
        float xr = 0.f, xi = 0.f;
        for (int i = 0; i < S5C; ++i) {
            const float* uu = U + i * 128 + c.wave * 16;
            float sr = 0.f, si = 0.f;
#pragma unroll
            for (int q = 0; q < 4; ++q) { const float4 v = *(const float4*)(uu + q * 4);
                sr += br[q * 4] * v.x + br[q * 4 + 1] * v.y + br[q * 4 + 2] * v.z + br[q * 4 + 3] * v.w;
                si += bi[q * 4] * v.x + bi[q * 4 + 1] * v.y + bi[q * 4 + 2] * v.z + bi[q * 4 + 3] * v.w; }
            const float nr = are * xr - aim * xi + sr, ni = are * xi + aim * xr + si; xr = nr; xi = ni;
        }
        *(float2*)(E + ((size_t)(((b * 2 + dir) * 16 + g) * S5N + chunk) * 64 + p) * 2) = make_float2(xr, xi);
    }
}
DI void phase_s5_carry(const Ctx& c, int l) {
    const int gt = blockIdx.x * NTHR + c.tid;
    if (gt < 2 * 2 * 16 * 64) {
        const int p = gt & 63, g = (gt >> 6) & 15, dir = (gt >> 10) & 1, b = gt >> 11;
        const float* tb = (const float*)(c.ws + WS_WSM + OFF_S5T) + ((size_t)((l * 2 + dir) * 16 + g) * 64 + p) * 36;
        const float ar = tb[2], ai = tb[3];
        const float* E = (const float*)(c.ws + WS_WSM + OFF_S5E) + (size_t)(((b * 2 + dir) * 16 + g) * S5N) * 128;
        float* C = (float*)(c.ws + WS_WSM + OFF_S5C) + (size_t)(((b * 2 + dir) * 16 + g) * S5N) * 128;
        float xr = 0.f, xi = 0.f;
        for (int ch = 0; ch < S5N; ++ch) {
            const float2 e = *(const float2*)(E + ch * 128 + p * 2);
            *(float2*)(C + ch * 128 + p * 2) = make_float2(xr, xi);
            const float nr = ar * xr - ai * xi + e.x, ni = ar * xi + ai * xr + e.y; xr = nr; xi = ni;
        }
    }
}

constexpr int S5_US = 0, S5_YS = 8192, S5_WV = S5_YS + 2 * 64 * 64 * 4;
template <bool LOCAL>
DI void phase_s5_final_unit(const Ctx& c, int l, int u) {
    unsigned char* L = c.smem;
    const float* s5t = (const float*)(c.ws + WS_WSM + OFF_S5T);
    const float* CIN = (const float*)(c.ws + WS_WSM + OFF_S5C);
    const bf16_t* PS = (const bf16_t*)(c.ws + WS_P + P_PS);
    const int gq = u & 3, ct = (u >> 2) % S5N, b = u / (4 * S5N);
    const int wave = c.wave, lane = c.lane, gl = wave >> 1, dir = wave & 1, g = gq * 4 + gl, n16 = lane & 15, q4 = lane >> 4;
    __syncthreads();
    {
        const int t = c.tid >> 3, part = c.tid & 7;
        *(u32x4*)(L + S5_US + t * 128 + part * 16) = *(const u32x4*)(PS + (size_t)(b * TZ + ct * S5C + t) * 256 + gq * 64 + part * 8);
    }
    typedef short s16x4 __attribute__((ext_vector_type(4)));
    const float* tbase = s5t + ((size_t)((l * 2 + dir) * 16 + g) * 64) * 36;
    s16x4 bfr[8], cfr[8];
#pragma unroll
    for (int j = 0; j < 8; ++j) {
        const int pp = 16 * j + n16, p = pp & 63; const float* tb = tbase + (size_t)p * 36 + (pp < 64 ? 4 : 20) + 4 * q4;
        u32x2 w2; w2.x = pack2(tb[0], tb[1]); w2.y = pack2(tb[2], tb[3]);
        bfr[j] = __builtin_bit_cast(s16x4, w2);
    }
    {
        const float* cre = c.in[29] + ((size_t)((l * 2 + dir) * 16 + g) * 16 + n16) * 64; const float* cim = c.in[30] + ((size_t)((l * 2 + dir) * 16 + g) * 16 + n16) * 64;
#pragma unroll
        for (int s = 0; s < 8; ++s) {
            const int pp = 16 * s + 4 * q4; const float sg = pp < 64 ? 1.f : -1.f; const float* src = (pp < 64 ? cre + pp : cim + (pp - 64));
            u32x2 w2; w2.x = pack2(sg * src[0], sg * src[1]); w2.y = pack2(sg * src[2], sg * src[3]);
            cfr[s] = __builtin_bit_cast(s16x4, w2);
        }
    }
    const float are = tbase[(size_t)lane * 36], aim = tbase[(size_t)lane * 36 + 1];
    const int cd = dir == 0 ? ct : (ct < S5NC ? S5NC - 1 - ct : S5N + S5NC - 1 - ct);
    float xr = 0.f, xi = 0.f;
    if (!LOCAL) { const float2 ci = *(const float2*)(CIN + ((size_t)(((b * 2 + dir) * 16 + g) * S5N + cd) * 64 + lane) * 2); xr = ci.x; xi = ci.y; }
    const float dsk = c.in[31][(size_t)l * 256 + g * 16 + n16];
    bf16_t* BU = (bf16_t*)(L + S5_WV + wave * 8192); bf16_t* XB = BU + 16 * 128;
    float* YS = (float*)(L + S5_YS) + dir * 64 * 64;
    __syncthreads();
#pragma unroll 1
    for (int sb = 0; sb < 4; ++sb) {
        const int stepA = 16 * sb + n16, tlA = dir == 0 ? stepA : 63 - stepA;
        const s16x4 af = __builtin_bit_cast(s16x4, *(const u32x2*)(L + S5_US + tlA * 128 + gl * 32 + q4 * 8));
#pragma unroll
        for (int j = 0; j < 8; ++j) {
            f32x4 acc = {0.f, 0.f, 0.f, 0.f};
            acc = __builtin_amdgcn_mfma_f32_16x16x16bf16_1k(af, bfr[j], acc, 0, 0, 0);
#pragma unroll
            for (int rr = 0; rr < 4; ++rr) BU[(4 * q4 + rr) * 128 + 16 * j + n16] = f2bf(acc[rr]);
        }
        __builtin_amdgcn_wave_barrier();
#pragma unroll
        for (int ii = 0; ii < 16; ++ii) {
            const float br = bf2f(BU[ii * 128 + lane]), bi = bf2f(BU[ii * 128 + 64 + lane]);
            const float nr = are * xr - aim * xi + br, ni = are * xi + aim * xr + bi; xr = nr; xi = ni;
            if (!LOCAL) { XB[ii * 128 + lane] = f2bf(xr); XB[ii * 128 + 64 + lane] = f2bf(xi); }
        }
        __builtin_amdgcn_wave_barrier();
        if (LOCAL) continue;
        f32x4 ya = {0.f, 0.f, 0.f, 0.f};
#pragma unroll
        for (int s = 0; s < 8; ++s) {
            const s16x4 xf = __builtin_bit_cast(s16x4, *(const u32x2*)((const unsigned char*)XB + n16 * 256 + (16 * s + 4 * q4) * 2));
            ya = __builtin_amdgcn_mfma_f32_16x16x16bf16_1k(xf, cfr[s], ya, 0, 0, 0);
        }
#pragma unroll
        for (int rr = 0; rr < 4; ++rr) {
            const int step = 16 * sb + 4 * q4 + rr, tl = dir == 0 ? step : 63 - step;
            float y = ya[rr];
            if (dir == 0) y += dsk * bf2f(*(const bf16_t*)(L + S5_US + tl * 128 + (gl * 16 + n16) * 2));
            YS[tl * 64 + gl * 16 + n16] = y;
        }
    }
    if (LOCAL) { *(float2*)((float*)(c.ws + WS_WSM + OFF_S5E) + ((size_t)(((b * 2 + dir) * 16 + g) * S5N + cd) * 64 + lane) * 2) = make_float2(xr, xi); return; }
    __syncthreads();
    bf16_t* ZG = (bf16_t*)(c.ws + WS_MISC + MS_ZG);
    {
        const float* Y0 = (const float*)(L + S5_YS); const float* Y1 = Y0 + 64 * 64;
        for (int e = c.tid; e < 64 * 16; e += NTHR) {
            const int i = e >> 4, c4 = (e & 15) * 4; const float4 y0 = *(const float4*)(Y0 + i * 64 + c4), y1 = *(const float4*)(Y1 + i * 64 + c4);
            *(u32x2*)(ZG + (size_t)(b * TZ + ct * S5C + i) * 256 + gq * 64 + c4) = pack4(gelu_tanh(y0.x + y1.x), gelu_tanh(y0.y + y1.y), gelu_tanh(y0.z + y1.z), gelu_tanh(y0.w + y1.w));
        }
    }
}

DI void phase_small_gemms(const Ctx& c, int l) {
    unsigned char* ws = c.ws; unsigned char* wsm = ws + WS_WSM;
    const bf16_t* CQN = (const bf16_t*)(ws + WS_MISC + MS_CQN);
    const float* rope = (const float*)(wsm + OFF_ROPE);
    constexpr int NMT = NZ / 256;
    int base = 0;
    const int G = gridDim.x, bid = blockIdx.x;
    {
        const bf16_t* W = (const bf16_t*)(wsm + OFF_WUQT + l * SZ_WUQT); bf16_t* QM = (bf16_t*)(ws + WS_EXPW + MX_QM);
        const float qs = 0.10206207261596577f * LOG2E;
        for (int u = (bid + G - base % G) % G; u < NMT * 3; u += G) {
            const int mt = u / 3, nt = u % 3, r0 = mt * 256, c0 = nt * 128;
            gemm_tile<4, 0>(c, 256, [&](int i) { return CQN + (size_t)(r0 + i) * 384; }, [&](int i) { return W + (size_t)(c0 + i) * 256; }, NoHook(),
                [&](f32x4 (&acc)[4][4], int wr, int wc, int fr, int fq) {
#pragma unroll
                    for (int n = 0; n < 4; ++n) {
                        const int col = c0 + wc + n * 16 + fq * 4, h = col / 96, d = col % 96;
                        const bool rp = d >= 64;
#pragma unroll
                        for (int m = 0; m < 4; ++m) {
                            const int row = r0 + wr + m * 16 + fr, b = row / TZ, s = row % TZ; f32x4 v = acc[m][n];
                            f32x4 pv; pv[0] = __shfl_xor(v[0], 32, 64); pv[1] = __shfl_xor(v[1], 32, 64); pv[2] = __shfl_xor(v[2], 32, 64); pv[3] = __shfl_xor(v[3], 32, 64);
                            if (rp && s >= CTX) {
                                const int i0 = d - 64;
                                const float* cs = rope + ((size_t)(s - CTX) * 16 + (i0 >> 4) * 8 + (i0 & 7)) * 2;
                                const bool hi = (i0 & 8) != 0;
#pragma unroll
                                for (int j = 0; j < 4; ++j) v[j] = v[j] * cs[2 * j] + (hi ? pv[j] : -pv[j]) * cs[2 * j + 1];
                            }
                            *(u32x2*)(QM + ((size_t)(b * 4 + h) * TZ + s) * 96 + d) = pack4(v[0] * qs, v[1] * qs, v[2] * qs, v[3] * qs);
                        }
                    }
                });
        }
        base += NMT * 3;
    }
    {
        const bf16_t* W = (const bf16_t*)(wsm + OFF_WUKVT + l * SZ_WUKVT); bf16_t* KM = (bf16_t*)(ws + WS_EXPW + MX_KM); bf16_t* VMT = (bf16_t*)(ws + WS_EXPW + MX_VMT);
        for (int u = (bid + G - base % G) % G; u < NMT * 4; u += G) {
            const int mt = u / 4, nt = u % 4, r0 = mt * 256, c0 = nt * 128;
            gemm_tile<4, 0>(c, 128, [&](int i) { return CQN + (size_t)(r0 + i) * 384 + 256; }, [&](int i) { return W + (size_t)(c0 + i) * 128; }, NoHook(),
                [&](f32x4 (&acc)[4][4], int wr, int wc, int fr, int fq) {
#pragma unroll
                    for (int n = 0; n < 4; ++n) {
                        const int col = c0 + wc + n * 16 + fq * 4, h = col >> 7, d = col & 127;
#pragma unroll
                        for (int m = 0; m < 4; ++m) {
                            const int row = r0 + wr + m * 16 + fr, b = row / TZ, s = row % TZ; const f32x4 v = acc[m][n];
                            if (d < 64) *(u32x2*)(KM + ((size_t)(b * 4 + h) * TZ + s) * 96 + d) = pack4(v[0], v[1], v[2], v[3]);
                            else {
#pragma unroll
                                for (int j = 0; j < 4; ++j) VMT[((size_t)(b * 4 + h) * 64 + (d - 64 + j)) * TZ + s] = f2bf(v[j]);
                            }
                        }
                    }
                });
        }
        base += NMT * 4;
    }
    bf16_t* SE = (bf16_t*)(ws + WS_P + P_PR); bf16_t* SAD = SE + (size_t)2 * NZ * 256; bf16_t* SKD = SAD + (size_t)2 * NZ * 256;
    {
        const bf16_t* A = (const bf16_t*)(ws + WS_MISC + MS_TW); const bf16_t* W = (const bf16_t*)(wsm + OFF_W2T + l * SZ_W2T);
        const float* w0 = c.in[14] + (size_t)l * 512;
        for (int u = (bid + G - base % G) % G; u < NMT * 4; u += G) {
            const int mt = u / 4, nt = u % 4, r0 = mt * 256, c0 = nt * 128;
            gemm_tile<4, 0>(c, 64, [&](int i) { return A + (size_t)(r0 + i) * 64; }, [&](int i) { return W + (size_t)(c0 + i) * 64; }, NoHook(),
                [&](f32x4 (&acc)[4][4], int wr, int wc, int fr, int fq) {
#pragma unroll
                    for (int n = 0; n < 4; ++n) {
                        const int col = c0 + wc + n * 16 + fq * 4, d = col >> 8, cc = col & 255; const float4 w0v = *(const float4*)(w0 + col);
#pragma unroll
                        for (int m = 0; m < 4; ++m) {
                            const int row = r0 + wr + m * 16 + fr; const f32x4 v = acc[m][n]; float e[4];
                            const float x[4] = {w0v.x + v[0], w0v.y + v[1], w0v.z + v[2], w0v.w + v[3]};
#pragma unroll
                            for (int j = 0; j < 4; ++j) e[j] = 0.6065306597126334f * sigmoidf_(x[j]);
                            *(u32x2*)(SE + ((size_t)d * NZ + row) * 256 + cc) = pack4(e[0], e[1], e[2], e[3]);
                        }
                    }
                });
        }
        base += NMT * 4;
    }
    {
        const bf16_t* A = (const bf16_t*)(ws + WS_MISC + MS_AL); const bf16_t* W = (const bf16_t*)(wsm + OFF_A2T + l * SZ_A2T);
        const float* a0 = c.in[16] + (size_t)l * 512; const float* k_a = c.in[20] + (size_t)l * 256; const bf16_t* KB = (const bf16_t*)(ws + WS_EXPW + MX_KB);
        for (int u = (bid + G - base % G) % G; u < NMT * 4; u += G) {
            const int mt = u / 4, nt = u % 4, r0 = mt * 256, c0 = nt * 128;
            gemm_tile<4, 0>(c, 64, [&](int i) { return A + (size_t)(r0 + i) * 64; }, [&](int i) { return W + (size_t)(c0 + i) * 64; }, NoHook(),
                [&](f32x4 (&acc)[4][4], int wr, int wc, int fr, int fq) {
#pragma unroll
                    for (int n = 0; n < 4; ++n) {
                        const int col = c0 + wc + n * 16 + fq * 4, d = col >> 8, cc = col & 255; const float4 a0v = *(const float4*)(a0 + col), kav = *(const float4*)(k_a + cc);
#pragma unroll
                        for (int m = 0; m < 4; ++m) {
                            const int row = r0 + wr + m * 16 + fr; const f32x4 v = acc[m][n];
                            const float ad0 = sigmoidf_(a0v.x + v[0]), ad1 = sigmoidf_(a0v.y + v[1]), ad2 = sigmoidf_(a0v.z + v[2]), ad3 = sigmoidf_(a0v.w + v[3]);
                            float k[4]; unpack4(*(const u32x2*)(KB + (size_t)row * 256 + cc), k);
                            *(u32x2*)(SAD + ((size_t)d * NZ + row) * 256 + cc) = pack4(ad0, ad1, ad2, ad3);
                            *(u32x2*)(SKD + ((size_t)d * NZ + row) * 256 + cc) = pack4(k[0] * (1.f + (ad0 - 1.f) * kav.x), k[1] * (1.f + (ad1 - 1.f) * kav.y), k[2] * (1.f + (ad2 - 1.f) * kav.z), k[3] * (1.f + (ad3 - 1.f) * kav.w));
                        }
                    }
                });
        }
        base += NMT * 4;
    }
    {
        const bf16_t* A = (const bf16_t*)(ws + WS_MISC + MS_SG); const bf16_t* W = (const bf16_t*)(wsm + OFF_G2T + l * SZ_G2T); bf16_t* GG = (bf16_t*)(ws + WS_MISC + MS_GG);
        for (int u = (bid + G - base % G) % G; u < NMT * 2; u += G) {
            const int mt = u / 2, nt = u % 2, r0 = mt * 256, c0 = nt * 128;
            gemm_tile<4, 0>(c, 128, [&](int i) { return A + (size_t)(r0 + i) * 128; }, [&](int i) { return W + (size_t)(c0 + i) * 128; }, NoHook(),
                [&](f32x4 (&acc)[4][4], int wr, int wc, int fr, int fq) {
#pragma unroll
                    for (int n = 0; n < 4; ++n)
#pragma unroll
                        for (int m = 0; m < 4; ++m) { const f32x4 v = acc[m][n];
                            *(u32x2*)(GG + (size_t)(r0 + wr + m * 16 + fr) * 256 + c0 + wc + n * 16 + fq * 4) = pack4(v[0], v[1], v[2], v[3]); }
                });
        }
        base += NMT * 2;
    }
}

DI int krow(int s, int h, int j) { return 16 * s + 8 * (j >> 2) + 4 * h + (j & 3); }
#ifndef ATT_THR
#define ATT_THR 64.f
#endif
constexpr int ATT_PARK = 56 * 1024;
template <int MODE>
DI void attn_pass(const Ctx& c, int l, int b, int h, int q0, int nkeys) {
    constexpr int DROW = MODE == 0 ? 96 : 64;
    constexpr int DQ = MODE == 0 ? 96 : 32, KS = DQ / 16;
    constexpr int DOFF = MODE == 2 ? 32 : 0;
    constexpr int TK = 128;
    constexpr int KPITCH = DQ * 2 + 16;
    constexpr int VPITCH = TK * 2 + 16;
    constexpr int KBYTES = TK * KPITCH, VBYTES = 64 * VPITCH, STG = KBYTES + VBYTES;
    static_assert(MODE == 0 || 2 * STG <= ATT_PARK, "the staging buffers must stay below the parked o1");
    unsigned char* ws = c.ws; int tid_ = c.tid; asm volatile("" : "+v"(tid_));
    const int tid = tid_, lane = tid & 63, wave = __builtin_amdgcn_readfirstlane(tid >> 6), r = lane & 31, hh = lane >> 5;
    const bf16_t* Q = (const bf16_t*)(ws + WS_EXPW + (MODE == 0 ? MX_QM : MX_QD)) + (size_t)(b * 4 + h) * TZ * DROW + DOFF;
    const bf16_t* Kp = (const bf16_t*)(ws + WS_EXPW + (MODE == 0 ? MX_KM : MX_KD)) + (size_t)(b * 4 + h) * TZ * DROW + DOFF;
    const bf16_t* Vt = (const bf16_t*)(ws + WS_EXPW + (MODE == 0 ? MX_VMT : MX_VDT)) + (size_t)(b * 4 + h) * 64 * TZ;
    unsigned char* smem = c.smem;
    bf16x8 qf[KS];
    const int qrow = q0 + wave * 32 + r;
#pragma unroll
    for (int ks = 0; ks < KS; ++ks) qf[ks] = *(const bf16x8*)(Q + (size_t)qrow * DROW + ks * 16 + hh * 8);
    f32x16 oacc[2];
    float mref = 0.f, lrun = 0.f;
#pragma unroll
    for (int t = 0; t < 2; ++t)
#pragma unroll
        for (int i = 0; i < 16; ++i) oacc[t][i] = 0.f;
    constexpr int CPR = DQ / 8, KCH = TK * CPR, NKR = KCH / NTHR;
    static_assert(KCH % NTHR == 0, "whole staging rounds");
    u32x4 kreg[NKR], vreg[2];
    const bf16_t* kp[NKR]; int koff[NKR];
#pragma unroll
    for (int i = 0; i < NKR; ++i) { const int ch = tid + i * NTHR; kp[i] = Kp + ((long)(ch / CPR) - 64) * DROW + (ch % CPR) * 8; koff[i] = (ch / CPR) * KPITCH + (ch % CPR) * 16; }
    const bf16_t* vp = Vt + (size_t)(tid >> 4) * TZ + (tid & 15) * 8 - 64;
    const int voff = (tid >> 4) * VPITCH + (tid & 15) * 16;
    auto gloadK = [&]() {
#pragma unroll
        for (int i = 0; i < NKR; ++i) { kreg[i] = *(const u32x4*)kp[i]; kp[i] += TK * DROW; }
    };
    auto gloadV = [&]() { vreg[0] = *(const u32x4*)vp; vreg[1] = *(const u32x4*)(vp + (size_t)32 * TZ); vp += TK; };
    auto lstoreK = [&](int buf) {
        unsigned char* sk = smem + buf * STG;
#pragma unroll
        for (int i = 0; i < NKR; ++i) *(u32x4*)(sk + koff[i]) = kreg[i];
    };
    auto lstoreV = [&](int buf) { unsigned char* sv = smem + buf * STG + KBYTES; *(u32x4*)(sv + voff) = vreg[0]; *(u32x4*)(sv + voff + 32 * VPITCH) = vreg[1]; };
    const int kbase = r * KPITCH + hh * 16, vbase = KBYTES + r * VPITCH + hh * 8;
    auto ldfrag = [&](const unsigned char* kb, const unsigned char* vb, int ci) -> u32x4 {
        if (ci < 8) {
            const int kg = ci >> 2, s = (ci >> 1) & 1, t = ci & 1;
            const unsigned char* vrow = vb + t * 32 * VPITCH + (kg * 32 + 16 * s) * 2;
            const u32x2 lo = *(const u32x2*)vrow, hi2 = *(const u32x2*)(vrow + 16);
            u32x4 vv; vv.x = lo.x; vv.y = lo.y; vv.z = hi2.x; vv.w = hi2.y; return vv;
        }
        const int q = ci - 8, kg = q & 1, ks = q >> 1;
        return *(const u32x4*)(kb + kg * 32 * KPITCH + ks * 32);
    };
    constexpr int NM = 8 + 2 * KS;
    const f32x16 zero16 = {0.f, 0.f, 0.f, 0.f, 0.f, 0.f, 0.f, 0.f, 0.f, 0.f, 0.f, 0.f, 0.f, 0.f, 0.f, 0.f};
    auto pv_all = [&](const u32x4 (&P)[4], const unsigned char* vb) {
#pragma unroll
        for (int ci = 0; ci < 8; ++ci) { const u32x4 f = ldfrag(vb, vb, ci); oacc[ci & 1] = __builtin_amdgcn_mfma_f32_32x32x16_bf16(__builtin_bit_cast(bf16x8, f), __builtin_bit_cast(bf16x8, P[ci >> 1]), oacc[ci & 1], 0, 0, 0); }
    };
    auto iter = [&](f32x16 (&Sc)[2], f32x16 (&Sn)[2], u32x4 (&Pp)[4], u32x4 (&Pn)[4], const unsigned char* kb, const unsigned char* vb, bool first) {
        u32x4 fcur = ldfrag(kb, vb, 0), fnx1 = ldfrag(kb, vb, 1);
        if (__any(mref != 0.f)) {
#pragma unroll
            for (int kg = 0; kg < 2; ++kg)
#pragma unroll
                for (int i = 0; i < 16; ++i) Sc[kg][i] -= mref;
        }
        f32x2 ps = {0.f, 0.f};
        __builtin_amdgcn_sched_barrier(0);
#pragma unroll
        for (int ci = 0; ci < NM; ++ci) {
            u32x4 fnx2 = fnx1;
            if (ci + 2 < NM) fnx2 = ldfrag(kb, vb, ci + 2);
            if (ci < 8) oacc[ci & 1] = __builtin_amdgcn_mfma_f32_32x32x16_bf16(__builtin_bit_cast(bf16x8, fcur), __builtin_bit_cast(bf16x8, Pp[ci >> 1]), oacc[ci & 1], 0, 0, 0);
            else { const int q = ci - 8, kg = q & 1, ks = q >> 1; Sn[kg] = __builtin_amdgcn_mfma_f32_32x32x16_bf16(__builtin_bit_cast(bf16x8, fcur), qf[ks], ks == 0 ? zero16 : Sn[kg], 0, 0, 0); }
#pragma unroll
            for (int p = (ci * 16) / NM; p < ((ci + 1) * 16) / NM; ++p) {
                const int kg = p >> 3, q = p & 7;
                const float p0 = __builtin_amdgcn_exp2f(Sc[kg][2 * q]), p1 = __builtin_amdgcn_exp2f(Sc[kg][2 * q + 1]);
                ps += (f32x2){p0, p1};
                unsigned pk = pack2(p0, p1); asm volatile("" : "+v"(pk));
                Pn[kg * 2 + (q >> 2)][q & 3] = pk;
            }
            asm volatile("" : "+v"(ps));
            fcur = fnx1; fnx1 = fnx2;
            __builtin_amdgcn_sched_barrier(0);
        }
        const float pst = ps.x + ps.y;
        const bool bad = !(pst < 0x1p90f) || (first && pst < 0x1p-20f);
        if (__any(bad)) {
            float mx = Sc[0][0];
#pragma unroll
            for (int kg = 0; kg < 2; ++kg)
#pragma unroll
                for (int i = 0; i < 16; ++i) mx = fmaxf(mx, Sc[kg][i]);
            mx = fmaxf(mx, __shfl_xor(mx, 32, 64));
            const bool need = (mx > ATT_THR) || (first && mx < -32.f);
            const float d = need ? mx : 0.f;
            const float alpha = first ? 1.f : __builtin_amdgcn_exp2f(-d);
            mref += d; lrun *= alpha;
#pragma unroll
            for (int t = 0; t < 2; ++t)
#pragma unroll
                for (int i = 0; i < 16; ++i) oacc[t][i] *= alpha;
            ps = (f32x2){0.f, 0.f};
#pragma unroll
            for (int pq = 0; pq < 16; ++pq) {
                const int kg = pq >> 3, q = pq & 7;
                const float p0 = __builtin_amdgcn_exp2f(Sc[kg][2 * q] - d), p1 = __builtin_amdgcn_exp2f(Sc[kg][2 * q + 1] - d);
                ps += (f32x2){p0, p1};
                Pn[kg * 2 + (q >> 2)][q & 3] = pack2(p0, p1);
            }
        }
        lrun += ps.x + ps.y;
    };
    const int NT = nkeys / TK;
    f32x16 S0[2], S1[2]; u32x4 PA[4], PB[4];
#pragma unroll
    for (int q = 0; q < 4; ++q) PA[q] = (u32x4){0u, 0u, 0u, 0u};
    __syncthreads();
    gloadK();
    lstoreK(1);
    gloadK();
    if ((tid & 15) >= 8) gloadV(); else { vreg[0] = (u32x4){0u, 0u, 0u, 0u}; vreg[1] = vreg[0]; vp += TK; }
    __syncthreads();
    {
        const unsigned char* kb = smem + STG + 64 * KPITCH + kbase;
#pragma unroll
        for (int q = 0; q < 2 * KS; ++q) { const int kg = q & 1, ks = q >> 1; const u32x4 f = ldfrag(kb, kb, 8 + q); S0[kg] = __builtin_amdgcn_mfma_f32_32x32x16_bf16(__builtin_bit_cast(bf16x8, f), qf[ks], ks == 0 ? zero16 : S0[kg], 0, 0, 0); }
    }
    for (int s = 0; s < NT; ++s) {
        lstoreK(s & 1); lstoreV(s & 1);
        if (s + 1 < NT) gloadK();
        gloadV();
        __syncthreads();
        const unsigned char* sb = smem + (s & 1) * STG;
        iter(S0, S1, PA, PB, sb + kbase, sb + vbase, s == 0);
        iter(S1, S0, PB, PA, sb + 64 * KPITCH + kbase, sb + 128 + vbase, false);
    }
    lstoreV(NT & 1);
    __syncthreads();
    pv_all(PA, smem + (NT & 1) * STG + vbase);
    const float inv = 1.f / (lrun + __shfl_xor(lrun, 32, 64));
    bf16_t* Ycat = (bf16_t*)(ws + WS_BUFA);
    const int zrow = b * TZ + qrow;
    float* park = (float*)(smem + ATT_PARK) + tid;
    if (MODE == 0) {
#pragma unroll
        for (int t = 0; t < 2; ++t)
#pragma unroll
            for (int i4 = 0; i4 < 4; ++i4) {
                const int dv = t * 32 + 8 * i4 + 4 * hh;
                *(u32x2*)(Ycat + (size_t)zrow * D + h * 64 + dv) = pack4(oacc[t][4 * i4] * inv, oacc[t][4 * i4 + 1] * inv, oacc[t][4 * i4 + 2] * inv, oacc[t][4 * i4 + 3] * inv);
            }
    } else if (MODE == 1) {
#pragma unroll
        for (int t = 0; t < 2; ++t)
#pragma unroll
            for (int i = 0; i < 16; ++i) park[(t * 16 + i) * NTHR] = oacc[t][i] * inv;
    } else {
        const float lam = ((const float*)(ws + WS_WSM + OFF_LAM))[l];
        const float lam_init = 0.8f - 0.6f * __expf(-0.3f * (float)l);
        float ss = 0.f;
#pragma unroll
        for (int t = 0; t < 2; ++t)
#pragma unroll
            for (int i = 0; i < 16; ++i) { const float o = park[(t * 16 + i) * NTHR] - lam * oacc[t][i] * inv; oacc[t][i] = o; ss += o * o; }
        ss += __shfl_xor(ss, 32, 64);
        const float rs = rsqrtf(ss * (1.f / 64.f) + 1e-5f) * (1.f - lam_init);
        const float* sg = c.in[38] + l * 64;
#pragma unroll
        for (int t = 0; t < 2; ++t)
#pragma unroll
            for (int i4 = 0; i4 < 4; ++i4) {
                const int dv = t * 32 + 8 * i4 + 4 * hh; const float4 g = *(const float4*)(sg + dv);
                *(u32x2*)(Ycat + (size_t)zrow * D + 768 + h * 64 + dv) = pack4(oacc[t][4 * i4] * rs * g.x, oacc[t][4 * i4 + 1] * rs * g.y, oacc[t][4 * i4 + 2] * rs * g.z, oacc[t][4 * i4 + 3] * rs * g.w);
            }
    }
}
DI void phase_attention(const Ctx& c, int l) {
    const int nu = 512 + (l == 0 ? 16 : 0);
    for (int u = blockIdx.x; u < nu; u += gridDim.x) {
        int b, h, q0, nk; bool mla;
        if (u < 512) { const int k = u & 255, bh = k & 7; b = bh >> 2; h = bh & 3; q0 = CTX + (k >> 3) * 256; nk = TZ; mla = u < 256; }
        else { const int k = u - 512; b = (k >> 2) & 1; h = k & 3; q0 = 0; nk = CTX; mla = k < 8; }
        if (mla) attn_pass<0>(c, l, b, h, q0, nk);
        else { attn_pass<1>(c, l, b, h, q0, nk); attn_pass<2>(c, l, b, h, q0, nk); }
    }
}

DI int rw_tok(int dir, int i) { return dir == 0 ? i : (i < CTX ? CTX - 1 - i : TZ - 1 - (i - CTX)); }
constexpr int RW_TS = 32;
constexpr int RW_STEP_F = 6 * 64 + 2;
constexpr int RW_BUF_F = RW_TS * RW_STEP_F;
template <int CTRL> DI float dpp_add(float x) { return x + __int_as_float(__builtin_amdgcn_update_dpp(0, __float_as_int(x), CTRL, 0xf, 0xf, false)); }
DI float red16(float x) { x = dpp_add<0xB1>(x); x = dpp_add<0x4E>(x); x = dpp_add<0x141>(x); x = dpp_add<0x140>(x); return x; }
DI float red8(float x) { x = dpp_add<0xB1>(x); x = dpp_add<0x4E>(x); x = dpp_add<0x141>(x); return x; }
struct RwRegs { u32x4 r, v, kk, e, ad, kd; };
DI void rw_load(const Ctx& c, int b, int h, int dir, int chunk, int t, RwRegs& g) {
    const bf16_t* RB = (const bf16_t*)(c.ws + WS_EXPW + MX_RB); const bf16_t* VB = (const bf16_t*)(c.ws + WS_EXPW + MX_VB); const bf16_t* KKB = (const bf16_t*)(c.ws + WS_EXPW + MX_KKB);
    const bf16_t* SE = (const bf16_t*)(c.ws + WS_P + P_PR) + (size_t)dir * NZ * 256; const bf16_t* SAD = SE + (size_t)2 * NZ * 256; const bf16_t* SKD = SAD + (size_t)2 * NZ * 256;
    const int i = chunk * RW_TS + (t >> 3), z = b * TZ + rw_tok(dir, i); const size_t o = (size_t)z * 256 + h * 64 + (t & 7) * 8;
    g.r = *(const u32x4*)(RB + o); g.v = *(const u32x4*)(VB + o); g.kk = *(const u32x4*)(KKB + o);
    g.e = *(const u32x4*)(SE + o); g.ad = *(const u32x4*)(SAD + o); g.kd = *(const u32x4*)(SKD + o);
}
DI void up8(const u32x4& u, float (&f)[8]) { f[0] = lo2f(u.x); f[1] = hi2f(u.x); f[2] = lo2f(u.y); f[3] = hi2f(u.y); f[4] = lo2f(u.z); f[5] = hi2f(u.z); f[6] = lo2f(u.w); f[7] = hi2f(u.w); }
DI void rw_process(const RwRegs& g, int t, float* buf) {
    float r[8], v[8], kk[8], e[8], ad[8], kd[8];
    up8(g.r, r); up8(g.v, v); up8(g.kk, kk); up8(g.e, e); up8(g.ad, ad); up8(g.kd, kd);
    float* f = buf + (t >> 3) * RW_STEP_F + (t & 7) * 8;
    float w[8], bv[8], wr[8]; float br = 0.f, kr = 0.f;
#pragma unroll
    for (int j = 0; j < 8; ++j) { w[j] = __expf(-e[j]); bv[j] = kk[j] * ad[j]; wr[j] = w[j] * r[j]; br += bv[j] * r[j]; kr += kd[j] * r[j]; }
    *(float4*)(f) = make_float4(w[0], w[1], w[2], w[3]); *(float4*)(f + 4) = make_float4(w[4], w[5], w[6], w[7]);
    *(float4*)(f + 64) = make_float4(kk[0], kk[1], kk[2], kk[3]); *(float4*)(f + 68) = make_float4(kk[4], kk[5], kk[6], kk[7]);
    *(float4*)(f + 128) = make_float4(bv[0], bv[1], bv[2], bv[3]); *(float4*)(f + 132) = make_float4(bv[4], bv[5], bv[6], bv[7]);
    *(float4*)(f + 192) = make_float4(kd[0], kd[1], kd[2], kd[3]); *(float4*)(f + 196) = make_float4(kd[4], kd[5], kd[6], kd[7]);
    *(float4*)(f + 256) = make_float4(wr[0], wr[1], wr[2], wr[3]); *(float4*)(f + 260) = make_float4(wr[4], wr[5], wr[6], wr[7]);
    *(float4*)(f + 320) = make_float4(v[0], v[1], v[2], v[3]); *(float4*)(f + 324) = make_float4(v[4], v[5], v[6], v[7]);
    br = red8(br); kr = red8(kr);
    if ((t & 7) == 0) { float* s = buf + (t >> 3) * RW_STEP_F + 384; s[0] = br; s[1] = kr; }
}
struct RwStep { float4 w, kk, bv, kd, wr; float vv, br, kr; };
DI void rw_ld(RwStep& s, const float* f, int kq, int row) {
    s.w = *(const float4*)(f + kq * 4); s.kk = *(const float4*)(f + 64 + kq * 4); s.bv = *(const float4*)(f + 128 + kq * 4);
    s.kd = *(const float4*)(f + 192 + kq * 4); s.wr = *(const float4*)(f + 256 + kq * 4); s.vv = f[320 + row]; s.br = f[384]; s.kr = f[385];
}
DI void phase_rwkv_scan_unit(const Ctx& c, int l, int u) {
    const int rg = u & 3, chain = u >> 2, dir = chain & 1, h = (chain >> 1) & 3, b = chain >> 3;
    float* buf0 = (float*)c.smem; float* buf1 = buf0 + RW_BUF_F;
    float* ybuf = buf1 + RW_BUF_F;
    float* YO = (float*)(c.ws + WS_BUFB) + (size_t)dir * NZ * 256 + (size_t)b * TZ * 256 + h * 64 + rg * 16;
    const int wave = c.wave, lane = c.lane, rr = lane >> 4, kq = lane & 15, rl = (wave & 3) * 4 + rr, row = rg * 16 + rl;
    const int t = c.tid - 256;
    float S0 = 0.f, S1 = 0.f, S2 = 0.f, S3 = 0.f;
    constexpr int NCH = TZ / RW_TS;
    RwRegs g;
    __syncthreads();
    if (wave >= 4) { rw_load(c, b, h, dir, 0, t, g); rw_process(g, t, buf0); rw_load(c, b, h, dir, 1, t, g); }
    __syncthreads();
    for (int ch = 0; ch < NCH; ++ch) {
        float* cur = buf0 + (ch & 1) * RW_BUF_F; float* nxt = buf0 + ((ch + 1) & 1) * RW_BUF_F;
        if (wave >= 4) {
            if (ch > 0) {
                const float* yb = ybuf + ((ch - 1) & 1) * RW_TS * 16;
#pragma unroll
                for (int i = 0; i < 2; ++i) { const int e = t + i * 256, st = e >> 4, rw = e & 15; YO[(size_t)rw_tok(dir, (ch - 1) * RW_TS + st) * 256 + rw] = yb[e]; }
            }
            if (ch + 1 < NCH) rw_process(g, t, nxt);
            if (ch + 2 < NCH) rw_load(c, b, h, dir, ch + 2, t, g);
        } else {
            float* yb = ybuf + (ch & 1) * RW_TS * 16 + rl;
            RwStep s0, s1;
            rw_ld(s0, cur, kq, row);
#pragma unroll 4
            for (int st = 0; st < RW_TS; st += 2) {
                rw_ld(s1, cur + (st + 1) * RW_STEP_F, kq, row);
                {
                    float sa = -((S0 * s0.kk.x + S1 * s0.kk.y) + (S2 * s0.kk.z + S3 * s0.kk.w));
                    float q = (S0 * s0.wr.x + S1 * s0.wr.y) + (S2 * s0.wr.z + S3 * s0.wr.w);
                    sa = red16(sa); q = red16(q);
                    S0 = fmaf(sa, s0.bv.x, fmaf(S0, s0.w.x, s0.vv * s0.kd.x)); S1 = fmaf(sa, s0.bv.y, fmaf(S1, s0.w.y, s0.vv * s0.kd.y));
                    S2 = fmaf(sa, s0.bv.z, fmaf(S2, s0.w.z, s0.vv * s0.kd.z)); S3 = fmaf(sa, s0.bv.w, fmaf(S3, s0.w.w, s0.vv * s0.kd.w));
                    yb[st * 16] = q + sa * s0.br + s0.vv * s0.kr;
                }
                if (st + 2 < RW_TS) rw_ld(s0, cur + (st + 2) * RW_STEP_F, kq, row);
                {
                    float sa = -((S0 * s1.kk.x + S1 * s1.kk.y) + (S2 * s1.kk.z + S3 * s1.kk.w));
                    float q = (S0 * s1.wr.x + S1 * s1.wr.y) + (S2 * s1.wr.z + S3 * s1.wr.w);
                    sa = red16(sa); q = red16(q);
                    S0 = fmaf(sa, s1.bv.x, fmaf(S0, s1.w.x, s1.vv * s1.kd.x)); S1 = fmaf(sa, s1.bv.y, fmaf(S1, s1.w.y, s1.vv * s1.kd.y));
                    S2 = fmaf(sa, s1.bv.z, fmaf(S2, s1.w.z, s1.vv * s1.kd.z)); S3 = fmaf(sa, s1.bv.w, fmaf(S3, s1.w.w, s1.vv * s1.kd.w));
                    yb[(st + 1) * 16] = q + sa * s1.br + s1.vv * s1.kr;
                }
            }
        }
        __syncthreads();
    }
    if (wave >= 4) {
        const float* yb = ybuf + ((NCH - 1) & 1) * RW_TS * 16;
#pragma unroll
        for (int i = 0; i < 2; ++i) { const int e = t + i * 256, st = e >> 4, rw = e & 15; YO[(size_t)rw_tok(dir, (NCH - 1) * RW_TS + st) * 256 + rw] = yb[e]; }
    }
}

constexpr int LA_AN = 0, LA_RN = 8192, LA_BN = 16384, LA_KN = 24576, LA_AT = 32768, LA_BHT = 40960, LA_KHT = 49152, LA_VT = 57344,
              LA_NBA = 65536  , LA_NKA = 81920, LA_NBRT = 90112, LA_NKRT = 98304, LA_P63 = 106496;
constexpr int LA_TMT = LA_AN, LA_M1 = LA_BN, LA_W1T = LA_KN, LA_Z1 = LA_NBA;
DI int crow(int reg, int h) { return (reg & 3) + 8 * (reg >> 2) + 4 * h; }
DI void mm_tile(f32x16& acc, const unsigned char* A, int i0, const unsigned char* BT, int j0, int r, int h) {
#pragma unroll
    for (int ks = 0; ks < 4; ++ks) {
        const bf16x8 a = *(const bf16x8*)(A + (i0 + r) * 128 + ks * 32 + h * 16);
        const bf16x8 b = *(const bf16x8*)(BT + (j0 + r) * 128 + ks * 32 + h * 16);
        acc = __builtin_amdgcn_mfma_f32_32x32x16_bf16(a, b, acc, 0, 0, 0);
    }
}
DI void zero16(f32x16& a) {
#pragma unroll
    for (int i = 0; i < 16; ++i) a[i] = 0.f;
}
DI void phase_rwkv_chunk_unit(const Ctx& c, int l, int unit) {
    unsigned char* L = c.smem; unsigned char* ws = c.ws;
    const int chain = unit / RNC, ch = unit % RNC, dir = chain & 1, hd = (chain >> 1) & 3, b = chain >> 3;
    const int tid = c.tid, lane = c.lane, wave = c.wave, r = lane & 31, h = lane >> 5;
    const bf16_t* RB = (const bf16_t*)(ws + WS_EXPW + MX_RB); const bf16_t* VB = (const bf16_t*)(ws + WS_EXPW + MX_VB); const bf16_t* KKB = (const bf16_t*)(ws + WS_EXPW + MX_KKB);
    const bf16_t* SE = (const bf16_t*)(ws + WS_P + P_PR) + (size_t)dir * NZ * 256; const bf16_t* SAD = SE + (size_t)2 * NZ * 256; const bf16_t* SKD = SAD + (size_t)2 * NZ * 256;
    float* CUM = (float*)(L + LA_NBA);
    __syncthreads();
    const int t = tid >> 3, k0 = (tid & 7) * 8;
    float rr[8], vv[8], kk[8], ee[8], ad[8], kd[8];
    {
        const int z = b * TZ + rw_tok(dir, ch * RC + t); const size_t o = (size_t)z * 256 + hd * 64 + k0;
        up8(*(const u32x4*)(RB + o), rr); up8(*(const u32x4*)(VB + o), vv); up8(*(const u32x4*)(KKB + o), kk);
        up8(*(const u32x4*)(SE + o), ee); up8(*(const u32x4*)(SAD + o), ad); up8(*(const u32x4*)(SKD + o), kd);
        *(float4*)(CUM + t * 64 + k0) = make_float4(ee[0], ee[1], ee[2], ee[3]); *(float4*)(CUM + t * 64 + k0 + 4) = make_float4(ee[4], ee[5], ee[6], ee[7]);
    }
    __syncthreads();
    if (wave == 0) { float cm = 0.f;
#pragma unroll 8
        for (int i = 0; i < RC; ++i) { cm += CUM[i * 64 + lane]; CUM[i * 64 + lane] = cm; } }
    __syncthreads();
    {
        float cm[8], c63[8];
        { const float4 a = *(const float4*)(CUM + t * 64 + k0), bq = *(const float4*)(CUM + t * 64 + k0 + 4); cm[0] = a.x; cm[1] = a.y; cm[2] = a.z; cm[3] = a.w; cm[4] = bq.x; cm[5] = bq.y; cm[6] = bq.z; cm[7] = bq.w; }
        { const float4 a = *(const float4*)(CUM + 63 * 64 + k0), bq = *(const float4*)(CUM + 63 * 64 + k0 + 4); c63[0] = a.x; c63[1] = a.y; c63[2] = a.z; c63[3] = a.w; c63[4] = bq.x; c63[5] = bq.y; c63[6] = bq.z; c63[7] = bq.w; }
        float at[8], rt[8], bt[8], kt[8], bh[8], kh[8];
#pragma unroll
        for (int j = 0; j < 8; ++j) {
            const float pt = __expf(-cm[j]), pp = __expf(-(cm[j] - ee[j])), ip = __expf(cm[j]), ph = __expf(-(c63[j] - cm[j])), bb = kk[j] * ad[j];
            at[j] = -kk[j] * pp; rt[j] = rr[j] * pt; bt[j] = bb * ip; kt[j] = kd[j] * ip; bh[j] = bb * ph; kh[j] = kd[j] * ph;
        }
        u32x4 w4;
        w4.x = pack2(at[0], at[1]); w4.y = pack2(at[2], at[3]); w4.z = pack2(at[4], at[5]); w4.w = pack2(at[6], at[7]); *(u32x4*)(L + LA_AN + t * 128 + k0 * 2) = w4;
        w4.x = pack2(rt[0], rt[1]); w4.y = pack2(rt[2], rt[3]); w4.z = pack2(rt[4], rt[5]); w4.w = pack2(rt[6], rt[7]); *(u32x4*)(L + LA_RN + t * 128 + k0 * 2) = w4;
        w4.x = pack2(bt[0], bt[1]); w4.y = pack2(bt[2], bt[3]); w4.z = pack2(bt[4], bt[5]); w4.w = pack2(bt[6], bt[7]); *(u32x4*)(L + LA_BN + t * 128 + k0 * 2) = w4;
        w4.x = pack2(kt[0], kt[1]); w4.y = pack2(kt[2], kt[3]); w4.z = pack2(kt[4], kt[5]); w4.w = pack2(kt[6], kt[7]); *(u32x4*)(L + LA_KN + t * 128 + k0 * 2) = w4;
#pragma unroll
        for (int j = 0; j < 8; ++j) {
            *(bf16_t*)(L + LA_AT + (k0 + j) * 128 + t * 2) = f2bf(at[j]); *(bf16_t*)(L + LA_BHT + (k0 + j) * 128 + t * 2) = f2bf(bh[j]);
            *(bf16_t*)(L + LA_KHT + (k0 + j) * 128 + t * 2) = f2bf(kh[j]); *(bf16_t*)(L + LA_VT + (k0 + j) * 128 + t * 2) = f2bf(vv[j]);
        }
        if (t == 63) {
            float* p63 = (float*)(L + LA_P63); float* gp = (float*)(ws + WS_RW + RW_P63) + (size_t)unit * 64;
#pragma unroll
            for (int j = 0; j < 8; ++j) { const float p = __expf(-c63[j]); p63[k0 + j] = p; gp[k0 + j] = p; }
        }
    }
    __syncthreads();
    {
        const int p = wave >> 1, i0 = (wave & 1) * 32;
        const unsigned char* A = L + (p == 0 ? LA_BN : p == 1 ? LA_KN : LA_RN);
        const unsigned char* BT = L + (p < 2 ? LA_AN : p == 2 ? LA_BN : LA_KN);
#pragma unroll
        for (int jt = 0; jt < 2; ++jt) {
            const int j0 = jt * 32; f32x16 acc; zero16(acc);
            mm_tile(acc, A, i0, BT, j0, r, h);
            const int col = j0 + r;
#pragma unroll
            for (int g = 0; g < 16; ++g) {
                const int row = i0 + crow(g, h);
                if (p == 0) ((float*)(L + LA_NBA))[row * 64 + col] = (row < col) ? acc[g] : 0.f;
                else if (p == 1) *(bf16_t*)(L + LA_NKA + row * 128 + col * 2) = f2bf((row < col) ? acc[g] : 0.f);
                else *(bf16_t*)(L + (p == 2 ? LA_NBRT : LA_NKRT) + row * 128 + col * 2) = f2bf((col <= row) ? acc[g] : 0.f);
            }
        }
    }
    __syncthreads();
    {
        constexpr int X0 = LA_BN, X1 = LA_KN, X3 = 108544, X4 = X3 + 8192, X5 = LA_NBA + 16384 - 16384, X6 = LA_NBA + 8192;
        float nv[8];
        { const int s = tid >> 3, t0 = (tid & 7) * 8; const float* N = (const float*)(L + LA_NBA) + s * 64 + t0;
          const float4 a = *(const float4*)N, bq = *(const float4*)(N + 4); nv[0] = a.x; nv[1] = a.y; nv[2] = a.z; nv[3] = a.w; nv[4] = bq.x; nv[5] = bq.y; nv[6] = bq.z; nv[7] = bq.w; }
        __syncthreads();
        {
            const int s = tid >> 3, t0 = (tid & 7) * 8;
            u32x4 w4; w4.x = pack2(nv[0], nv[1]); w4.y = pack2(nv[2], nv[3]); w4.z = pack2(nv[4], nv[5]); w4.w = pack2(nv[6], nv[7]);
            *(u32x4*)(L + X0 + s * 128 + t0 * 2) = w4;
#pragma unroll
            for (int j = 0; j < 8; ++j) *(bf16_t*)(L + X1 + (t0 + j) * 128 + s * 2) = f2bf(nv[j]);
#pragma unroll
            for (int j = 0; j < 8; ++j) if (t0 + j == s) nv[j] += 1.f;
            w4.x = pack2(nv[0], nv[1]); w4.y = pack2(nv[2], nv[3]); w4.z = pack2(nv[4], nv[5]); w4.w = pack2(nv[6], nv[7]);
            *(u32x4*)(L + X5 + s * 128 + t0 * 2) = w4;
        }
        __syncthreads();
        const int ti0 = ((wave >> 1) & 1) * 32, tj0 = (wave & 1) * 32;
        if (wave < 4) {
            f32x16 acc; zero16(acc); mm_tile(acc, L + X0, ti0, L + X1, tj0, r, h);
#pragma unroll
            for (int g4 = 0; g4 < 4; ++g4) *(u32x2*)(L + X4 + (tj0 + r) * 128 + (ti0 + 8 * g4 + 4 * h) * 2) = pack4(acc[4 * g4], acc[4 * g4 + 1], acc[4 * g4 + 2], acc[4 * g4 + 3]);
#pragma unroll
            for (int g = 0; g < 16; ++g) *(bf16_t*)(L + X3 + (ti0 + crow(g, h)) * 128 + (tj0 + r) * 2) = f2bf(acc[g]);
        }
        __syncthreads();
#pragma unroll
        for (int k = 1; k <= 5; ++k) {
            const int qa = (k & 1) ? X3 : X0, qt = (k & 1) ? X4 : X1, nqa = (k & 1) ? X0 : X3, nqt = (k & 1) ? X1 : X4;
            const int pa = (k & 1) ? X5 : X6, npa = (k & 1) ? X6 : X5;
            if (wave >= 4) {
                f32x16 acc; zero16(acc); mm_tile(acc, L + pa, ti0, L + qt, tj0, r, h);
#pragma unroll
                for (int g = 0; g < 16; ++g) acc[g] += bf2f(*(const bf16_t*)(L + pa + (ti0 + crow(g, h)) * 128 + (tj0 + r) * 2));
                if (k < 5) {
#pragma unroll
                    for (int g = 0; g < 16; ++g) *(bf16_t*)(L + npa + (ti0 + crow(g, h)) * 128 + (tj0 + r) * 2) = f2bf(acc[g]);
                } else {
#pragma unroll
                    for (int g4 = 0; g4 < 4; ++g4) *(u32x2*)(L + LA_TMT + (tj0 + r) * 128 + (ti0 + 8 * g4 + 4 * h) * 2) = pack4(acc[4 * g4], acc[4 * g4 + 1], acc[4 * g4 + 2], acc[4 * g4 + 3]);
                }
            } else if (k < 5) {
                f32x16 acc; zero16(acc); mm_tile(acc, L + qa, ti0, L + qt, tj0, r, h);
#pragma unroll
                for (int g4 = 0; g4 < 4; ++g4) *(u32x2*)(L + nqt + (tj0 + r) * 128 + (ti0 + 8 * g4 + 4 * h) * 2) = pack4(acc[4 * g4], acc[4 * g4 + 1], acc[4 * g4 + 2], acc[4 * g4 + 3]);
#pragma unroll
                for (int g = 0; g < 16; ++g) *(bf16_t*)(L + nqa + (ti0 + crow(g, h)) * 128 + (tj0 + r) * 2) = f2bf(acc[g]);
            }
            __syncthreads();
        }
    }
    {
        const int p = wave >> 2, i0 = ((wave >> 1) & 1) * 32, j0 = (wave & 1) * 32; f32x16 acc; zero16(acc);
        if (p == 0) {
            mm_tile(acc, L + LA_TMT, i0, L + LA_AT, j0, r, h);
#pragma unroll
            for (int g4 = 0; g4 < 4; ++g4) *(u32x2*)(L + LA_M1 + (j0 + r) * 128 + (i0 + 8 * g4 + 4 * h) * 2) = pack4(acc[4 * g4], acc[4 * g4 + 1], acc[4 * g4 + 2], acc[4 * g4 + 3]);
        } else {
            mm_tile(acc, L + LA_NKA, i0, L + LA_TMT, j0, r, h);
#pragma unroll
            for (int g4 = 0; g4 < 4; ++g4) *(u32x2*)(L + LA_W1T + (j0 + r) * 128 + (i0 + 8 * g4 + 4 * h) * 2) = pack4(acc[4 * g4], acc[4 * g4 + 1], acc[4 * g4 + 2], acc[4 * g4 + 3]);
        }
    }
    __syncthreads();
    if (wave < 4) {
        const int i0 = (wave >> 1) * 32, j0 = (wave & 1) * 32; f32x16 acc; zero16(acc);
        mm_tile(acc, L + LA_W1T, i0, L + LA_VT, j0, r, h);
#pragma unroll
        for (int g4 = 0; g4 < 4; ++g4) *(u32x2*)(L + LA_Z1 + (j0 + r) * 128 + (i0 + 8 * g4 + 4 * h) * 2) = pack4(acc[4 * g4], acc[4 * g4 + 1], acc[4 * g4 + 2], acc[4 * g4 + 3]);
    }
    __syncthreads();
    {
        const int p = wave >> 1, i0 = (wave & 1) * 32;
        bf16_t* GM3 = (bf16_t*)(ws + WS_RW + RW_M3) + (size_t)unit * 4096; bf16_t* GM2 = (bf16_t*)(ws + WS_RW + RW_M2) + (size_t)unit * 4096; bf16_t* GZ5 = (bf16_t*)(ws + WS_RW + RW_Z5) + (size_t)unit * 4096;
        float* YO = (float*)(ws + WS_BUFB) + (size_t)dir * NZ * 256;
#pragma unroll
        for (int jt = 0; jt < 2; ++jt) {
            const int j0 = jt * 32; f32x16 acc; zero16(acc);
            if (p == 0) {
                mm_tile(acc, L + LA_M1, i0, L + LA_NBRT, j0, r, h);
#pragma unroll
                for (int g4 = 0; g4 < 4; ++g4) { const int tt = j0 + r, kq = i0 + 8 * g4 + 4 * h; float rv[4]; unpack4(*(const u32x2*)(L + LA_RN + tt * 128 + kq * 2), rv);
                    *(u32x2*)(GM2 + tt * 64 + kq) = pack4(acc[4 * g4] + rv[0], acc[4 * g4 + 1] + rv[1], acc[4 * g4 + 2] + rv[2], acc[4 * g4 + 3] + rv[3]); }
            } else if (p == 1) {
                mm_tile(acc, L + LA_NBRT, i0, L + LA_Z1, j0, r, h); mm_tile(acc, L + LA_NKRT, i0, L + LA_VT, j0, r, h);
#pragma unroll
                for (int g = 0; g < 16; ++g) { const int tt = i0 + crow(g, h); YO[(size_t)(b * TZ + rw_tok(dir, ch * RC + tt)) * 256 + hd * 64 + j0 + r] = acc[g]; }
            } else if (p == 2) {
                mm_tile(acc, L + LA_M1, i0, L + LA_BHT, j0, r, h);
#pragma unroll
                for (int g4 = 0; g4 < 4; ++g4) *(u32x2*)(GM3 + (j0 + r) * 64 + i0 + 8 * g4 + 4 * h) = pack4(acc[4 * g4], acc[4 * g4 + 1], acc[4 * g4 + 2], acc[4 * g4 + 3]);
            } else {
                mm_tile(acc, L + LA_BHT, i0, L + LA_Z1, j0, r, h); mm_tile(acc, L + LA_KHT, i0, L + LA_VT, j0, r, h);
#pragma unroll
                for (int g4 = 0; g4 < 4; ++g4) *(u32x2*)(GZ5 + (j0 + r) * 64 + i0 + 8 * g4 + 4 * h) = pack4(acc[4 * g4], acc[4 * g4 + 1], acc[4 * g4 + 2], acc[4 * g4 + 3]);
            }
        }
    }
}
DI void phase_rwkv_chunks(const Ctx& c, int l) {
    for (int u = blockIdx.x; u < 16 * RNC; u += gridDim.x) phase_rwkv_chunk_unit(c, l, u);
}
DI bf16x8 pack8(const f32x16& x, int s) {
    u32x4 p; p.x = pack2(x[8 * s], x[8 * s + 1]); p.y = pack2(x[8 * s + 2], x[8 * s + 3]); p.z = pack2(x[8 * s + 4], x[8 * s + 5]); p.w = pack2(x[8 * s + 6], x[8 * s + 7]);
    return __builtin_bit_cast(bf16x8, p);
}
DI bf16x8 ldfrag(const bf16_t* rowp, int s, int h) {
    const u32x2 lo = *(const u32x2*)(rowp + 16 * s + 4 * h), hi = *(const u32x2*)(rowp + 16 * s + 8 + 4 * h);
    u32x4 v; v.x = lo.x; v.y = lo.y; v.z = hi.x; v.w = hi.y; return __builtin_bit_cast(bf16x8, v);
}
constexpr int SQ_PITCH = 144, SQ_MAT = 64 * SQ_PITCH;
constexpr int SQA_M3 = 0, SQA_Z5 = SQ_MAT, SQA_P63 = 2 * SQ_MAT, SQA_BYTES = SQA_P63 + 256;
constexpr int SQB_M2 = 0, SQB_Y = SQ_MAT, SQB_BYTES = SQB_Y + 64 * 64 * 4;
constexpr int SQ_NST = 3;
constexpr int SQ_A0 = 0, SQ_B0 = SQ_NST * SQA_BYTES, SQ_XB = SQ_B0 + SQ_NST * SQB_BYTES, SQ_END = SQ_XB + 4 * 4096;
DI bf16x8 ldfrag_l(const unsigned char* rowp, int s, int h) {
    const u32x2 lo = *(const u32x2*)(rowp + (16 * s + 4 * h) * 2), hi = *(const u32x2*)(rowp + (16 * s + 8 + 4 * h) * 2);
    u32x4 v; v.x = lo.x; v.y = lo.y; v.z = hi.x; v.w = hi.y; return __builtin_bit_cast(bf16x8, v);
}
struct SqRegsA { u32x4 m3[2], z5[2], p63; };
struct SqRegsB { u32x4 m2[2], y[4]; };
DI void sqa_gload(const Ctx& c, size_t unit, int lt, SqRegsA& g) {
    const unsigned char* g3 = c.ws + WS_RW + RW_M3 + unit * 8192; const unsigned char* g5 = c.ws + WS_RW + RW_Z5 + unit * 8192;
#pragma unroll
    for (int i = 0; i < 2; ++i) { const int id = lt + i * 256; g.m3[i] = *(const u32x4*)(g3 + id * 16); g.z5[i] = *(const u32x4*)(g5 + id * 16); }
    if (lt < 16) g.p63 = *(const u32x4*)(c.ws + WS_RW + RW_P63 + unit * 256 + lt * 16);
}
DI void sqa_lstore(unsigned char* st, int lt, const SqRegsA& g) {
#pragma unroll
    for (int i = 0; i < 2; ++i) { const int id = lt + i * 256, row = id >> 3, part = id & 7;
        *(u32x4*)(st + SQA_M3 + row * SQ_PITCH + part * 16) = g.m3[i]; *(u32x4*)(st + SQA_Z5 + row * SQ_PITCH + part * 16) = g.z5[i]; }
    if (lt < 16) *(u32x4*)(st + SQA_P63 + lt * 16) = g.p63;
}
DI void sqb_gload(const Ctx& c, size_t unit, const float* YO, int dir, int ch, int lt, SqRegsB& g) {
    const unsigned char* g2 = c.ws + WS_RW + RW_M2 + unit * 8192;
#pragma unroll
    for (int i = 0; i < 2; ++i) g.m2[i] = *(const u32x4*)(g2 + (lt + i * 256) * 16);
#pragma unroll
    for (int i = 0; i < 4; ++i) { const int id = lt + i * 256; g.y[i] = *(const u32x4*)(YO + (size_t)rw_tok(dir, ch * RC + (id >> 4)) * 256 + (id & 15) * 4); }
}
DI void sqb_lstore(unsigned char* st, int lt, const SqRegsB& g) {
#pragma unroll
    for (int i = 0; i < 2; ++i) { const int id = lt + i * 256; *(u32x4*)(st + SQB_M2 + (id >> 3) * SQ_PITCH + (id & 7) * 16) = g.m2[i]; }
#pragma unroll
    for (int i = 0; i < 4; ++i) { const int id = lt + i * 256; *(u32x4*)(st + SQB_Y + (id >> 4) * 256 + (id & 15) * 16) = g.y[i]; }
}
DI void sqb_store_y(float* YO, int dir, int ch, const unsigned char* st, int lt, int vhb) {
#pragma unroll
    for (int i = 0; i < 2; ++i) { const int id = lt + i * 256; *(u32x4*)(YO + (size_t)rw_tok(dir, ch * RC + (id >> 3)) * 256 + vhb * 32 + (id & 7) * 4) = *(const u32x4*)(st + SQB_Y + id * 16); }
}
DI void phase_rwkv_seq_block(const Ctx& c, int l, int chain, int vhb) {
    unsigned char* L = c.smem; const int lane = c.lane, wave = c.wave, r = lane & 31, h = lane >> 5;
    const int dir = chain & 1, hd = (chain >> 1) & 3, b = chain >> 3, lt = c.tid - 256, vh = vhb; const bool act = (wave & 1) == 0;
    const size_t unit0 = (size_t)chain * RNC;
    __syncthreads();
    if (wave >= 4) {
        float* YO = (float*)(c.ws + WS_BUFB) + (size_t)dir * NZ * 256 + (size_t)b * TZ * 256 + hd * 64;
        const int lt2 = lt & 255;
        int moff[3], mdst[3];
#pragma unroll
        for (int i = 0; i < 3; ++i) { const int id = i < 2 ? lt2 + 256 * i : 512 + lane; const int row = id / 9, ck = id - row * 9; moff[i] = row * 128 + (ck == 8 ? 7 : ck) * 16; mdst[i] = id * 16; }
        int zoff[2], zdst[2];
#pragma unroll
        for (int i = 0; i < 2; ++i) { const int id = i == 0 ? lt2 : 256 + lane; int row = id / 9; const int ck = id - row * 9; zdst[i] = (vhb * 32 * 9 + id) * 16; row += vhb * 32; if (row > 63) row = 63; zoff[i] = row * 128 + (ck == 8 ? 7 : ck) * 16; }
        const unsigned char* gM3 = c.ws + WS_RW + RW_M3; const unsigned char* gZ5 = c.ws + WS_RW + RW_Z5; const unsigned char* gM2 = c.ws + WS_RW + RW_M2; const unsigned char* gP = c.ws + WS_RW + RW_P63;
        auto dmaA = [&](int ch, int stg) {
            const size_t unit = unit0 + (ch < RNC ? ch : RNC - 1); unsigned char* st = L + SQ_A0 + stg * SQA_BYTES;
#pragma unroll
            for (int i = 0; i < 3; ++i) __builtin_amdgcn_global_load_lds((const unsigned*)(gM3 + unit * 8192 + moff[i]), (unsigned*)(st + SQA_M3 + mdst[i]), 16, 0, 0);
            __builtin_amdgcn_global_load_lds((const unsigned*)(gZ5 + unit * 8192 + zoff[0]), (unsigned*)(st + SQA_Z5 + zdst[0]), 16, 0, 0);
            if (lane < 32) __builtin_amdgcn_global_load_lds((const unsigned*)(gZ5 + unit * 8192 + zoff[1]), (unsigned*)(st + SQA_Z5 + zdst[1]), 16, 0, 0);
            if (lane < 16) __builtin_amdgcn_global_load_lds((const unsigned*)(gP + unit * 256 + lane * 16), (unsigned*)(st + SQA_P63 + lane * 16), 16, 0, 0);
        };
        auto dmaB = [&](int ch, int stg) {
            const int cc = ch < RNC ? ch : RNC - 1; const size_t unit = unit0 + cc; unsigned char* st = L + SQ_B0 + stg * SQB_BYTES;
#pragma unroll
            for (int i = 0; i < 3; ++i) __builtin_amdgcn_global_load_lds((const unsigned*)(gM2 + unit * 8192 + moff[i]), (unsigned*)(st + SQB_M2 + mdst[i]), 16, 0, 0);
#pragma unroll
            for (int i = 0; i < 2; ++i) { const int id = lt2 + i * 256; __builtin_amdgcn_global_load_lds((const unsigned*)(YO + (size_t)rw_tok(dir, cc * RC + (id >> 3)) * 256 + vhb * 32 + (id & 7) * 4), (unsigned*)(st + SQB_Y + id * 16), 16, 0, 0); }
        };
        dmaA(0, 0); dmaA(1, 1); dmaB(0, 0);
        asm volatile("s_waitcnt vmcnt(0)" ::: "memory");
        __builtin_amdgcn_s_barrier();
        int sa2 = 2, sb1 = 1;
#pragma unroll 1
        for (int ch = 0; ch <= RNC; ++ch) {
            if (ch >= 2) sqb_store_y(YO, dir, ch - 2, L + SQ_B0 + sb1 * SQB_BYTES, lt2, vhb);
            asm volatile("" ::: "memory");
            dmaA(ch + 2, sa2); dmaB(ch + 1, sb1);
            asm volatile("s_waitcnt vmcnt(11)" ::: "memory");
            __builtin_amdgcn_s_barrier();
            asm volatile("" ::: "memory");
            sa2 = sa2 == 2 ? 0 : sa2 + 1; sb1 = sb1 == 2 ? 0 : sb1 + 1;
        }
        sqb_store_y(YO, dir, RNC - 1, L + SQ_B0 + ((RNC - 1) % 3) * SQB_BYTES, lt2, vhb);
    } else if (wave < 2) {
        f32x16 x[2]; zero16(x[0]); zero16(x[1]);
        __syncthreads();
#pragma unroll 1
        for (int ch = 0; ch <= RNC; ++ch) {
            if (ch < RNC && act) {
                const unsigned char* st = L + SQ_A0 + (ch % 3) * SQA_BYTES;
                unsigned char* xbuf = L + SQ_XB + ((ch & 1) * 2 + vh) * 4096 + lane * 16;
                bf16x8 xb[4];
#pragma unroll
                for (int s = 0; s < 4; ++s) { xb[s] = pack8(x[s >> 1], s & 1); *(bf16x8*)(xbuf + s * 1024) = xb[s]; }
                f32x16 xn0, xn1;
#pragma unroll
                for (int i = 0; i < 2; ++i) {
                    f32x16 xa;
#pragma unroll
                    for (int g4 = 0; g4 < 4; ++g4) {
                        float z5[4]; unpack4(*(const u32x2*)(st + SQA_Z5 + (vh * 32 + r) * SQ_PITCH + (32 * i + 8 * g4 + 4 * h) * 2), z5);
                        const float4 p4 = *(const float4*)(st + SQA_P63 + (32 * i + 8 * g4 + 4 * h) * 4);
                        xa[4 * g4] = fmaf(p4.x, x[i][4 * g4], z5[0]); xa[4 * g4 + 1] = fmaf(p4.y, x[i][4 * g4 + 1], z5[1]);
                        xa[4 * g4 + 2] = fmaf(p4.z, x[i][4 * g4 + 2], z5[2]); xa[4 * g4 + 3] = fmaf(p4.w, x[i][4 * g4 + 3], z5[3]);
                    }
#pragma unroll
                    for (int s = 0; s < 4; ++s) xa = __builtin_amdgcn_mfma_f32_32x32x16_bf16(ldfrag_l(st + SQA_M3 + (32 * i + r) * SQ_PITCH, s, h), xb[s], xa, 0, 0, 0);
                    if (i == 0) xn0 = xa; else xn1 = xa;
                }
                x[0] = xn0; x[1] = xn1;
            }
            __syncthreads();
        }
    } else {
        __syncthreads();
#pragma unroll 1
        for (int ch = 0; ch <= RNC; ++ch) {
            if (ch >= 1 && act) {
                const int cy = ch - 1;
                unsigned char* st = L + SQ_B0 + (cy % 3) * SQB_BYTES;
                const unsigned char* xbuf = L + SQ_XB + ((cy & 1) * 2 + vh) * 4096 + lane * 16;
                bf16x8 xb[4];
#pragma unroll
                for (int s = 0; s < 4; ++s) xb[s] = *(const bf16x8*)(xbuf + s * 1024);
#pragma unroll
                for (int i = 0; i < 2; ++i) {
                    f32x16 ya;
#pragma unroll
                    for (int g = 0; g < 16; ++g) ya[g] = *((const float*)(st + SQB_Y) + (32 * i + crow(g, h)) * 32 + r);
#pragma unroll
                    for (int s = 0; s < 4; ++s) ya = __builtin_amdgcn_mfma_f32_32x32x16_bf16(ldfrag_l(st + SQB_M2 + (32 * i + r) * SQ_PITCH, s, h), xb[s], ya, 0, 0, 0);
#pragma unroll
                    for (int g = 0; g < 16; ++g) *((float*)(st + SQB_Y) + (32 * i + crow(g, h)) * 32 + r) = ya[g];
                }
            }
            __syncthreads();
        }
    }
}
DI void phase_mixers2(const Ctx& c, int l) {
    const int G = gridDim.x, bid = blockIdx.x;
    if (G >= 128) {
        if (bid < 32) phase_rwkv_seq_block(c, l, bid >> 1, bid & 1);
        else for (int u = bid - 32; u < 2 * S5N * 4; u += G - 32) phase_s5_final_unit<false>(c, l, u);
    } else {
        for (int u = bid; u < 32; u += G) phase_rwkv_seq_block(c, l, u >> 1, u & 1);
        for (int u = bid; u < 2 * S5N * 4; u += G) phase_s5_final_unit<false>(c, l, u);
    }
}

DI void phase_post(const Ctx& c, int l) {
    unsigned char* ws = c.ws; const int lane = c.lane;
    const float* YF = (const float*)(ws + WS_BUFB); const float* YB = YF + (size_t)NZ * 256;
    const bf16_t* RB = (const bf16_t*)(ws + WS_EXPW + MX_RB); const bf16_t* VB = (const bf16_t*)(ws + WS_EXPW + MX_VB);
    const bf16_t* SKD = (const bf16_t*)(ws + WS_P + P_PR) + (size_t)4 * NZ * 256; const bf16_t* GG = (const bf16_t*)(ws + WS_MISC + MS_GG);
    bf16_t* Ycat = (bf16_t*)(ws + WS_BUFA);
    const float* r_k = c.in[21] + l * 256; const float* lg = c.in[22] + l * 256; const float* lb = c.in[23] + l * 256;
    for (int z = blockIdx.x * 8 + c.wave; z < NZ; z += gridDim.x * 8) {
        const size_t o = (size_t)z * 256 + lane * 4;
        const float4 yf = *(const float4*)(YF + o), yb = *(const float4*)(YB + o);
        const float y0 = yf.x + yb.x, y1 = yf.y + yb.y, y2 = yf.z + yb.z, y3 = yf.w + yb.w;
        const float mean = sum16(y0 + y1 + y2 + y3) * (1.f / 64.f);
        const float d0 = y0 - mean, d1 = y1 - mean, d2 = y2 - mean, d3 = y3 - mean;
        const float var = sum16(d0 * d0 + d1 * d1 + d2 * d2 + d3 * d3) * (1.f / 64.f);
        const float rs = rsqrtf(var + 64e-5f);
        float r[4], v[4], k0[4], k1[4], gg[4];
        unpack4(*(const u32x2*)(RB + o), r); unpack4(*(const u32x2*)(VB + o), v); unpack4(*(const u32x2*)(SKD + o), k0); unpack4(*(const u32x2*)(SKD + (size_t)NZ * 256 + o), k1);
        unpack4(*(const u32x2*)(GG + o), gg);
        const float4 rk = *(const float4*)(r_k + lane * 4), g4 = *(const float4*)(lg + lane * 4), b4 = *(const float4*)(lb + lane * 4);
        const float bs = sum16(r[0] * (k0[0] + k1[0]) * rk.x + r[1] * (k0[1] + k1[1]) * rk.y + r[2] * (k0[2] + k1[2]) * rk.z + r[3] * (k0[3] + k1[3]) * rk.w);
        *(u32x2*)(Ycat + (size_t)z * D + 256 + lane * 4) = pack4((d0 * rs * g4.x + b4.x + bs * v[0]) * gg[0], (d1 * rs * g4.y + b4.y + bs * v[1]) * gg[1],
                                                                (d2 * rs * g4.z + b4.z + bs * v[2]) * gg[2], (d3 * rs * g4.w + b4.w + bs * v[3]) * gg[3]);
    }
    {
        const bf16_t* ZG = (const bf16_t*)(ws + WS_MISC + MS_ZG); const bf16_t* W = (const bf16_t*)(ws + WS_WSM + OFF_GLUT + l * SZ_GLUT);
        const float* gb = c.in[33] + l * 256;
        for (int u = blockIdx.x; u < (NZ / 256) * 2; u += gridDim.x) {
            const int mt = u / 2, nt = u % 2, r0 = mt * 256, c0 = nt * 128;
            gemm_tile<4, 0>(c, 256, [&](int i) { return ZG + (size_t)(r0 + i) * 256; }, [&](int i) { return W + (size_t)(c0 + i) * 256; }, NoHook(),
                [&](f32x4 (&acc)[4][4], int wr, int wc, int fr, int fq) {
#pragma unroll
                    for (int n = 0; n < 4; ++n) {
                        const int col = c0 + wc + n * 16 + fq * 4; const float4 bb = *(const float4*)(gb + col);
#pragma unroll
                        for (int m = 0; m < 4; ++m) {
                            const int row = r0 + wr + m * 16 + fr; const f32x4 v = acc[m][n];
                            float zg[4]; unpack4(*(const u32x2*)(ZG + (size_t)row * 256 + col), zg);
                            *(u32x2*)(Ycat + (size_t)row * D + 512 + col) = pack4(zg[0] * sigmoidf_(v[0] + bb.x), zg[1] * sigmoidf_(v[1] + bb.y), zg[2] * sigmoidf_(v[2] + bb.z), zg[3] * sigmoidf_(v[3] + bb.w));
                        }
                    }
                });
        }
    }
}

DI bool skip_mt(int l, int mt) { return l == NL - 1 && (mt % 33) == 0; }
DI bool merge_split(int l) { return l == 0 && NL > 1 && gridDim.x == 256; }
DI void phase_merge1(const Ctx& c, int l, int part) {
    const bf16_t* Ycat = (const bf16_t*)(c.ws + WS_BUFA); const bf16_t* W = (const bf16_t*)(c.ws + WS_WSM + OFF_WBT + l * SZ_WBT);
    const bf16_t* GT = (const bf16_t*)(c.ws + WS_GT); bf16_t* MG = (bf16_t*)(c.ws + WS_BUFB);
    if (part == 0 && blockIdx.x == 0 && c.tid < 32) ((unsigned*)(c.ws + WS_CTL))[CW_CNT + l * 32 + c.tid] = 0u;
    const bool split = merge_split(l);
    const int u_lo = part == 0 ? (int)blockIdx.x : 512 + (int)blockIdx.x, u_hi = part == 0 ? (split ? 512 : (NZ / 256) * 8) : (NZ / 256) * 8;
    for (int u = u_lo; u < u_hi; u += gridDim.x) {
        const int mt = u / 8, nt = u % 8, r0 = mt * 256, c0 = nt * 128;
        if (skip_mt(l, mt)) continue;
        f32x4 macc[4][4];
#pragma unroll
        for (int m = 0; m < 4; ++m)
#pragma unroll
            for (int n = 0; n < 4; ++n) macc[m][n] = (f32x4){0.f, 0.f, 0.f, 0.f};
        gemm_tile<4, 256>(c, 1024, [&](int i) { return Ycat + (size_t)(r0 + i) * D; }, [&](int i) { return W + (size_t)(c0 + i) * D; },
            [&](f32x4 (&acc)[4][4], int seg, int wr, int wc, int fr, int fq) {
#pragma unroll
                for (int m = 0; m < 4; ++m)
#pragma unroll
                    for (int n = 0; n < 4; ++n) {
                        float g[4]; unpack4(*(const u32x2*)(GT + (size_t)(r0 + wr + m * 16 + fr) * 4096 + seg * 1024 + c0 + wc + n * 16 + fq * 4), g);
                        macc[m][n][0] += g[0] * acc[m][n][0]; macc[m][n][1] += g[1] * acc[m][n][1]; macc[m][n][2] += g[2] * acc[m][n][2]; macc[m][n][3] += g[3] * acc[m][n][3];
                        acc[m][n] = (f32x4){0.f, 0.f, 0.f, 0.f};
                    }
            },
            [&](f32x4 (&)[4][4], int wr, int wc, int fr, int fq) {
#pragma unroll
                for (int m = 0; m < 4; ++m)
#pragma unroll
                    for (int n = 0; n < 4; ++n)
                        *(u32x2*)(MG + (size_t)(r0 + wr + m * 16 + fr) * D + c0 + wc + n * 16 + fq * 4) = pack4(macc[m][n][0], macc[m][n][1], macc[m][n][2], macc[m][n][3]);
            });
    }
}
struct EpiMerge2 {
    static constexpr bool PERM = false, AFTER_DRAIN = false;
    float* H; const float* modv; int l;
    DI void operator()(const pg8::f32x4 (&acc)[2][2][4][2], const pg8::Unit& u, int wr, int wc, int fr, int fq) const {
        if (skip_mt(l, u.pm)) return;
        const int sel = (u.pm % 33) == 0 ? 2 : u.pm / 33;
        const int row0 = u.pm * 256 + wr * 64 + fr, col0 = u.pn * 256 + wc * 32 + 4 * fq;
#pragma unroll
        for (int bj = 0; bj < 2; ++bj)
#pragma unroll
            for (int n = 0; n < 2; ++n) {
                const int col = col0 + bj * 128 + n * 16; const float4 m2 = *(const float4*)(modv + ((size_t)l * 3 + sel) * 6144 + 2 * 1024 + col);
#pragma unroll
                for (int ai = 0; ai < 2; ++ai)
#pragma unroll
                    for (int m = 0; m < 4; ++m) {
                        float4* hp = (float4*)(H + (size_t)(row0 + ai * 128 + m * 16) * D + col); float4 hv = *hp; const pg8::f32x4 v = acc[ai][bj][m][n];
                        hv.x += m2.x * v[0]; hv.y += m2.y * v[1]; hv.z += m2.z * v[2]; hv.w += m2.w * v[3]; *hp = hv;
                    }
            }
    }
};
struct LatOrder {
    int G, c;
    DI bool next(int i, pg8::Unit& u) const { const int L = i * G + c; if (L >= 256) return false; const int pl = L >> 2; u.pm = (pl >> 5) * 33 + 1 + (pl & 31); u.pn = L & 3; return true; }
    DI void a_ready(const pg8::Unit&) const {}
    DI void done(const pg8::Unit&) const {}
};
struct SplitOrder {
    int mode, c;
    DI bool next(int i, pg8::Unit& u) const {
        if (i > 0) return false;
        int L; if (mode == 1) { if (c < 16) return false; L = c - 16; } else { if (c >= 24) return false; L = 240 + c; }
        u.pm = L >> 2; u.pn = L & 3; return true;
    }
    DI void a_ready(const pg8::Unit&) const {}
    DI void done(const pg8::Unit&) const {}
};
DI void phase_merge2(const Ctx& c, int l, int mode) {
    EpiMerge2 E; E.H = (float*)(c.ws + WS_H); E.modv = (const float*)(c.ws + WS_WSM + OFF_MODV); E.l = l;
    pg8::Gemm g{(const bf16_t*)(c.ws + WS_BUFB), (const bf16_t*)(c.ws + WS_WSM + OFF_WOUTT + l * SZ_WOUTT), NZ, 1024, 1024, 1024, 1024};
    __syncthreads();
    if (mode != 0) {
        SplitOrder S; S.mode = mode; S.c = (int)blockIdx.x;
        pg8::gemm_phase<EpiMerge2, SplitOrder, false>((PG8_LAS unsigned char*)c.smem, g, S, E, nullptr, c.tid);
    } else if (l == NL - 1) {
        LatOrder S; S.G = (int)gridDim.x; S.c = (int)blockIdx.x;
        pg8::gemm_phase<EpiMerge2, LatOrder, false>((PG8_LAS unsigned char*)c.smem, g, S, E, nullptr, c.tid);
    } else {
        pg8::StaticOrder S; S.init(NZ, 1024, (int)gridDim.x, (int)blockIdx.x, MERGE2_WGM);
        pg8::gemm_phase<EpiMerge2, pg8::StaticOrder, false>((PG8_LAS unsigned char*)c.smem, g, S, E, nullptr, c.tid);
    }
}

constexpr int RT_PITCH = 68;
constexpr int RT_RED_W = 8 * 4 * RT_PITCH;
DI void phase_norm2_route(const Ctx& c, int l) {
    unsigned char* ws = c.ws; const int lane = c.lane, wave = c.wave, tid = c.tid;
    const float* modv = (const float*)(ws + WS_WSM + OFF_MODV); const float* H = (const float*)(ws + WS_H);
    bf16_t* XN = (bf16_t*)(ws + WS_BUFA); const float* g2 = c.in[7] + l * 1024;
    const float* rwt = (const float*)(ws + WS_WSM + OFF_RWT) + (size_t)l * 36 * 1024;
    const float* bg = c.in[42] + l * 4; const float* be = c.in[44] + l * 32;
    unsigned* cnt = (unsigned*)(ws + WS_CTL) + CW_CNT + l * 32;
    int* list = (int*)(ws + WS_GT + GT_LIST); float* lw = (float*)(ws + WS_GT + GT_LW);
    float* red = (float*)c.smem + wave * RT_RED_W;
    float* lgs = (float*)c.smem + 8 * RT_RED_W + wave * 8 * 40;
    int* hist = (int*)((float*)c.smem + 8 * RT_RED_W + 8 * 8 * 40);
    int* sel = hist + 64;
    float* selw = (float*)(sel + 128);
    const int ngroups = (l == NL - 1) ? (NB * SEQ / 64) : (NZ / 64);
    for (int grp = blockIdx.x; grp < ngroups; grp += gridDim.x) {
        __syncthreads();
        if (tid < 32) hist[tid] = 0;
        __syncthreads();
        float x[8][16];
#pragma unroll
        for (int i = 0; i < 8; ++i) {
            const int rl = wave * 8 + i; int row;
            if (l == NL - 1) { const int rr = grp * 64 + rl; row = (rr / SEQ) * TZ + CTX + (rr % SEQ); } else row = grp * 64 + rl;
#pragma unroll
            for (int q = 0; q < 4; ++q) { const float4 v = *(const float4*)(H + (size_t)row * D + q * 256 + lane * 4); x[i][q * 4] = v.x; x[i][q * 4 + 1] = v.y; x[i][q * 4 + 2] = v.z; x[i][q * 4 + 3] = v.w; }
        }
#pragma unroll
        for (int i = 0; i < 8; ++i) {
            const int rl = wave * 8 + i; int row;
            if (l == NL - 1) { const int rr = grp * 64 + rl; row = (rr / SEQ) * TZ + CTX + (rr % SEQ); } else row = grp * 64 + rl;
            const int b = row / TZ, s = row % TZ, sel3 = s < CTX ? 2 : b;
            float ss = 0.f;
#pragma unroll
            for (int j = 0; j < 16; ++j) ss += x[i][j] * x[i][j];
            ss = wave_sum(ss);
            const float rs = rsqrtf(ss * (1.f / 1024.f) + 1e-6f);
#pragma unroll
            for (int q = 0; q < 4; ++q) {
                const int col = q * 256 + lane * 4;
                const float4 g = *(const float4*)(g2 + col), m3 = *(const float4*)(modv + ((size_t)l * 3 + sel3) * 6144 + 3 * 1024 + col), m4 = *(const float4*)(modv + ((size_t)l * 3 + sel3) * 6144 + 4 * 1024 + col);
                x[i][q * 4] = x[i][q * 4] * rs * g.x * (1.f + m4.x) + m3.x; x[i][q * 4 + 1] = x[i][q * 4 + 1] * rs * g.y * (1.f + m4.y) + m3.y;
                x[i][q * 4 + 2] = x[i][q * 4 + 2] * rs * g.z * (1.f + m4.z) + m3.z; x[i][q * 4 + 3] = x[i][q * 4 + 3] * rs * g.w * (1.f + m4.w) + m3.w;
                *(u32x2*)(XN + (size_t)row * D + col) = pack4(x[i][q * 4], x[i][q * 4 + 1], x[i][q * 4 + 2], x[i][q * 4 + 3]);
            }
        }
#pragma unroll 1
        for (int ec = 0; ec < 9; ++ec) {
#pragma unroll
            for (int ee = 0; ee < 4; ++ee) {
                const int e = ec * 4 + ee;
                float4 w[4];
#pragma unroll
                for (int q = 0; q < 4; ++q) w[q] = *(const float4*)(rwt + (size_t)e * 1024 + q * 256 + lane * 4);
#pragma unroll
                for (int i = 0; i < 8; ++i) {
                    float a = 0.f;
#pragma unroll
                    for (int q = 0; q < 4; ++q) a += x[i][q * 4] * w[q].x + x[i][q * 4 + 1] * w[q].y + x[i][q * 4 + 2] * w[q].z + x[i][q * 4 + 3] * w[q].w;
                    red[(i * 4 + ee) * RT_PITCH + lane] = a;
                }
            }
            __builtin_amdgcn_wave_barrier();
            if (lane < 32) {
                float s0 = 0.f, s1 = 0.f, s2 = 0.f, s3 = 0.f;
#pragma unroll
                for (int q = 0; q < 16; ++q) { const float4 v = *(const float4*)(red + lane * RT_PITCH + q * 4); s0 += v.x; s1 += v.y; s2 += v.z; s3 += v.w; }
                const int e = ec * 4 + (lane & 3);
                lgs[(lane >> 2) * 40 + e] = (s0 + s1) + (s2 + s3) + (e < 4 ? bg[e] : be[e - 4]);
            }
            __builtin_amdgcn_wave_barrier();
        }
        if (lane < 8) {
            const float* lg = lgs + lane * 40;
            float gm = lg[0]; int gsel = 0;
#pragma unroll
            for (int g = 1; g < 4; ++g) if (lg[g] > gm) { gm = lg[g]; gsel = g; }
            const float gs = __expf(lg[0] - gm) + __expf(lg[1] - gm) + __expf(lg[2] - gm) + __expf(lg[3] - gm);
            const float pg = 1.f / gs;
            float l1 = -1e30f, l2 = -1e30f; int e1 = 0, e2 = 0;
#pragma unroll
            for (int j = 0; j < 8; ++j) {
                const float v = lg[4 + gsel * 8 + j]; const int e = gsel * 8 + j;
                if (v > l1) { l2 = l1; e2 = e1; l1 = v; e1 = e; } else if (v > l2) { l2 = v; e2 = e; }
            }
            const float tt = __expf(l2 - l1), w1 = pg / (1.f + tt), w2 = pg * tt / (1.f + tt);
            const int rl = wave * 8 + lane;
            const int r1 = atomicAdd(&hist[e1], 1), r2 = atomicAdd(&hist[e2], 1);
            sel[rl * 2] = e1 | (r1 << 8); sel[rl * 2 + 1] = e2 | (r2 << 8); selw[rl * 2] = w1; selw[rl * 2 + 1] = w2;
        }
        __syncthreads();
        if (tid < 32) hist[32 + tid] = (int)atomicAdd(&cnt[tid], (unsigned)hist[tid]);
        __syncthreads();
        if (tid < 128) {
            const int rl = tid >> 1, j = tid & 1, sv = sel[tid], e = sv & 255, rk = sv >> 8;
            int row;
            if (l == NL - 1) { const int rr = grp * 64 + rl; row = (rr / SEQ) * TZ + CTX + (rr % SEQ); } else row = grp * 64 + rl;
            const size_t pos = (size_t)e * MOE_CAP + hist[32 + e] + rk;
            list[pos] = row * 2 + j; lw[pos] = selw[tid];
        }
    }
    phase_expert_convert(c, l);
}

DI void moe_prefix(const Ctx& c, int l, int* tiles  , int* cnts  ) {
    __syncthreads();
    if (c.tid == 0) {
        const unsigned* cnt = (const unsigned*)(c.ws + WS_CTL) + CW_CNT + l * 32; int acc = 0;
        for (int e = 0; e < 32; ++e) { const int n = (int)__hip_atomic_load(cnt + e, __ATOMIC_RELAXED, __HIP_MEMORY_SCOPE_AGENT); cnts[e] = n; tiles[e] = acc; acc += (n + 127) / 128; }
        tiles[32] = acc;
    }
    __syncthreads();
}
DI void phase_moe1(const Ctx& c, int l) {
    unsigned char* ws = c.ws;
    int* tiles = (int*)(c.smem + 120 * 1024); int* cnts = tiles + 40;
    moe_prefix(c, l, tiles, cnts);
    const bf16_t* XN = (const bf16_t*)(ws + WS_BUFA); bf16_t* HM = (bf16_t*)(ws + WS_GT + GT_HM); const int* list = (const int*)(ws + WS_GT + GT_LIST);
    const int nt_total = tiles[32];
    for (int u = blockIdx.x; u < nt_total * 4; u += gridDim.x) {
        const int mtg = u >> 2, nt = u & 3;
        int e = 0;
        for (int k = 1; k < 32; ++k) if (tiles[k] <= mtg) e = k;
        const int mt = mtg - tiles[e], n_e = cnts[e];
        const int* le = list + (size_t)e * MOE_CAP;
        const bf16_t* W = (const bf16_t*)(ws + WS_EXPW + (size_t)e * SZ_WGU);
        gemm_tile<2, 0>(c, 1024,
            [&](int i) { int p = mt * 128 + i; if (p >= n_e) p = n_e - 1; return XN + (size_t)(le[p] >> 1) * D; },
            [&](int i) { return W + (size_t)(nt * 256 + i) * D; }, NoHook(),
            [&](f32x4 (&acc)[4][4], int wr, int wc, int fr, int fq) {
#pragma unroll
                for (int np = 0; np < 2; ++np) {
                    const int hc = (nt * 256 + wc + np * 32) / 2 + fq * 4;
#pragma unroll
                    for (int m = 0; m < 4; ++m) {
                        const int p = mt * 128 + wr + m * 16 + fr;
                        const f32x4 g = acc[m][np * 2], uu = acc[m][np * 2 + 1];
                        *(u32x2*)(HM + ((size_t)mtg * 128 + wr + m * 16 + fr) * 512 + hc) = pack4(siluf_(g[0]) * uu[0], siluf_(g[1]) * uu[1], siluf_(g[2]) * uu[2], siluf_(g[3]) * uu[3]);
                        (void)p;
                    }
                }
            });
    }
}
DI void phase_moe2(const Ctx& c, int l) {
    unsigned char* ws = c.ws;
    int* tiles = (int*)(c.smem + 120 * 1024); int* cnts = tiles + 40;
    moe_prefix(c, l, tiles, cnts);
    const bf16_t* HM = (const bf16_t*)(ws + WS_GT + GT_HM); const int* list = (const int*)(ws + WS_GT + GT_LIST); const float* lw = (const float*)(ws + WS_GT + GT_LW);
    bf16_t* Y2 = (bf16_t*)(ws + WS_P);
    const int nt_total = tiles[32];
    for (int u = blockIdx.x; u < nt_total * 4; u += gridDim.x) {
        const int mtg = u >> 2, nt = u & 3;
        int e = 0;
        for (int k = 1; k < 32; ++k) if (tiles[k] <= mtg) e = k;
        const int mt = mtg - tiles[e], n_e = cnts[e];
        const int* le = list + (size_t)e * MOE_CAP; const float* lwe = lw + (size_t)e * MOE_CAP;
        const bf16_t* W = (const bf16_t*)(ws + WS_EXPW + 32 * SZ_WGU + (size_t)e * SZ_WD);
        gemm_tile<2, 0>(c, 512,
            [&](int i) { return HM + ((size_t)mtg * 128 + i) * 512; },
            [&](int i) { return W + (size_t)(nt * 256 + i) * 512; }, NoHook(),
            [&](f32x4 (&acc)[4][4], int wr, int wc, int fr, int fq) {
#pragma unroll
                for (int m = 0; m < 4; ++m) {
                    const int p = mt * 128 + wr + m * 16 + fr;
                    if (p < n_e) {
                        const int ent = le[p]; const float wt = lwe[p];
                        bf16_t* yrow = Y2 + ((size_t)(ent & 1) * NZ + (ent >> 1)) * D + nt * 256 + wc + fq * 4;
#pragma unroll
                        for (int n = 0; n < 4; ++n) *(u32x2*)(yrow + n * 16) = pack4(wt * acc[m][n][0], wt * acc[m][n][1], wt * acc[m][n][2], wt * acc[m][n][3]);
                    }
                }
            });
    }
}

constexpr int LDS_BYTES = 150 * 1024 + 256;
static_assert(SQ_END <= LDS_BYTES - 256, "RWKV sequential stages must fit the LDS allocation");
constexpr int STEPS_PER_LAYER = 12, N_STEPS = 2 + NL * STEPS_PER_LAYER;
#ifndef FUSED
#define FUSED 1
#endif

DI const void* launder_ptr(const void* p) {
    const unsigned long long v = (unsigned long long)p;
    unsigned lo = __builtin_amdgcn_readfirstlane((unsigned)v), hi = __builtin_amdgcn_readfirstlane((unsigned)(v >> 32));
    asm volatile("" : "+s"(lo), "+s"(hi) :: "memory");
    return (const void*)(((unsigned long long)hi << 32) | lo);
}
template <int KIND> DI void run_step(const Ctx& c0, int l) {
#ifdef PHM
    if (!((PHM >> KIND) & 1)) return;
#endif
    Ctx c = c0;
    { int z = 0; asm volatile("" : "+s"(z) :: "memory"); c.in = c0.in + z; c.ws = c0.ws + z; c.out = c0.out + z; }
    { int t = c0.tid; asm volatile("" : "+v"(t)); c.tid = t; c.lane = t & 63; c.wave = __builtin_amdgcn_readfirstlane(t >> 6); }
    if (KIND == 0) phase_prologue(c);
    if (KIND == 1) phase_norm1(c, l);
    if (KIND == 2) phase_inproj(c, l);
    if (KIND == 3) { phase_prep(c, l); for (int u = blockIdx.x; u < 2 * S5N * 4; u += gridDim.x) phase_s5_final_unit<true>(c, l, u); }
    if (KIND == 4) { phase_small_gemms(c, l); phase_s5_carry(c, l); }
    if (KIND == 5) { phase_attention(c, l); phase_rwkv_chunks(c, l); }
    if (KIND == 6) phase_mixers2(c, l);
    if (KIND == 7) phase_post(c, l);
    if (KIND == 8) phase_merge1(c, l, 0);
    if (KIND == 9) { if (!merge_split(l)) phase_merge2(c, l, 0); else if (blockIdx.x < 16) phase_merge1(c, l, 1); else phase_merge2(c, l, 1); }
    if (KIND == 14) { if (merge_split(l)) phase_merge2(c, l, 2); }
    if (KIND == 10) phase_norm2_route(c, l);
    if (KIND == 11) phase_moe1(c, l);
    if (KIND == 12) phase_moe2(c, l);
    if (KIND == 13) phase_final(c);
}

#if !FUSED
template <int KIND> __global__ void __launch_bounds__(NTHR, 2) k_step(Args a) {
    extern __shared__ __attribute__((aligned(16))) unsigned char lds[];
    Ctx c; c.in = a.in; c.out = a.out; c.ws = a.ws; c.smem = lds; c.tid = threadIdx.x; c.lane = threadIdx.x & 63; c.wave = __builtin_amdgcn_readfirstlane(threadIdx.x >> 6);
    run_step<KIND>(c, a.s_lo);
}
template <int KIND> static void launch_step(const Args& a, int grid, hipStream_t stream) {
    static bool attr = false;
    if (!attr) { (void)hipFuncSetAttribute((const void*)k_step<KIND>, hipFuncAttributeMaxDynamicSharedMemorySize, LDS_BYTES); attr = true; }
    hipLaunchKernelGGL(k_step<KIND>, dim3(grid), dim3(NTHR), LDS_BYTES, stream, a);
}
#else
__global__ void __launch_bounds__(NTHR, 2) fwd_kernel(Args a) {
    extern __shared__ __attribute__((aligned(16))) unsigned char lds[];
    Ctx c; c.in = a.in; c.out = a.out; c.ws = a.ws; c.smem = lds; c.tid = threadIdx.x; c.lane = threadIdx.x & 63; c.wave = __builtin_amdgcn_readfirstlane(threadIdx.x >> 6);
    volatile LAS unsigned* xbw = (volatile LAS unsigned*)(lds + LDS_BYTES - 16);
    for (int i = threadIdx.x; i < LDS_BYTES / 16; i += NTHR) ((uint4*)lds)[i] = make_uint4(0u, 0u, 0u, 0u);
    __syncthreads();
    if (threadIdx.x == 0) { xbw[0] = 0u; xbw[1] = 0u; }
    __syncthreads();
    XcdBarrier bar = xcd_barrier_post((unsigned*)(a.ws + WS_CTL) + CW_BAR, xbw);
#ifndef REP_MASK
#define REP_MASK 0
#endif
#define GBAR() do { XcdBarrier bb = bar; int zz = 0; asm volatile("" : "+s"(zz) :: "memory"); bb.bar = bar.bar + zz; xcd_barrier(bb); } while (0)
#define STEP(K, L) do { run_step<K>(c, L); GBAR(); if ((REP_MASK >> K) & 1) { run_step<K>(c, L); GBAR(); } } while (0)
    STEP(0, 0);
    for (int l = 0; l < NL; ++l) {
        STEP(1, l); STEP(2, l); STEP(3, l); STEP(4, l); STEP(5, l); STEP(6, l); STEP(7, l); STEP(8, l); STEP(9, l); if (l == 0 && NL > 1) STEP(14, l); STEP(10, l); STEP(11, l); STEP(12, l);
    }
#undef STEP
    run_step<13>(c, 0);
}
#endif

extern "C" void kernel_launch(void* const* d_in, const int* in_sizes, int n_in, void* d_out, int out_size, void* d_ws, size_t ws_size, hipStream_t stream) {
    static int grid = 0;
    if (grid == 0) {
        if (n_in != 49 || out_size != NB * SEQ * D || ws_size < WS_END) { fprintf(stderr, "kernel_launch: unexpected problem (n_in %d out %d ws %zu need %zu)\n", n_in, out_size, ws_size, (size_t)WS_END); grid = -1; return; }
        int dev = 0, cus = 0;
        if (hipGetDevice(&dev) != hipSuccess || hipDeviceGetAttribute(&cus, hipDeviceAttributeMultiprocessorCount, dev) != hipSuccess) { grid = -1; return; }
#if FUSED
        int per_cu = 0;
        if (hipFuncSetAttribute((const void*)fwd_kernel, hipFuncAttributeMaxDynamicSharedMemorySize, LDS_BYTES) != hipSuccess) { fprintf(stderr, "kernel_launch: hipFuncSetAttribute failed\n"); grid = -1; return; }
        if (hipOccupancyMaxActiveBlocksPerMultiprocessor(&per_cu, (const void*)fwd_kernel, NTHR, LDS_BYTES) != hipSuccess || per_cu < 1) { fprintf(stderr, "kernel_launch: occupancy query says %d\n", per_cu); }
        (void)hipGetLastError();
#endif
        grid = cus;
    }
    if (grid < 0) return;
    (void)hipMemsetAsync((char*)d_ws + WS_CTL, 0, CTL_BYTES, stream);
    Args a{};
    for (int i = 0; i < 49; ++i) a.in[i] = (const float*)d_in[i];
    a.out = (float*)d_out; a.ws = (unsigned char*)d_ws;
#if !FUSED
    a.s_lo = 0; a.s_hi = 0; launch_step<0>(a, grid, stream);
    for (int l = 0; l < NL; ++l) {
        a.s_lo = l;
        launch_step<1>(a, grid, stream); launch_step<2>(a, grid, stream); launch_step<3>(a, grid, stream); launch_step<4>(a, grid, stream);
        launch_step<5>(a, grid, stream); launch_step<6>(a, grid, stream); launch_step<7>(a, grid, stream); launch_step<8>(a, grid, stream);
        launch_step<9>(a, grid, stream); if (l == 0 && NL > 1) launch_step<14>(a, grid, stream); launch_step<10>(a, grid, stream); launch_step<11>(a, grid, stream); launch_step<12>(a, grid, stream);
    }
    a.s_lo = 0; launch_step<13>(a, grid, stream);
#else
    a.s_lo = 0; a.s_hi = N_STEPS; hipLaunchKernelGGL(fwd_kernel, dim3(grid), dim3(NTHR), LDS_BYTES, stream, a);
#endif
}
```

```cpp
#include <hip/hip_runtime.h>
#include <stdint.h>
#include <stdio.h>

#define DI __device__ __forceinline__
#define LAS __attribute__((address_space(3)))
typedef unsigned short bf16_t;
typedef short bf16x8 __attribute__((ext_vector_type(8)));
typedef short s16x4 __attribute__((ext_vector_type(4)));
typedef float f32x4 __attribute__((ext_vector_type(4)));
typedef float f32x16 __attribute__((ext_vector_type(16)));
typedef float f32x2 __attribute__((ext_vector_type(2)));
typedef __bf16 bf16x2v __attribute__((ext_vector_type(2)));
typedef unsigned u32x4 __attribute__((ext_vector_type(4)));
typedef unsigned u32x2 __attribute__((ext_vector_type(2)));

constexpr int D = 1024, NB = 2, SEQ = 8192, CTX = 256, TZ = 8448, NZ = 16896, NL = 2;
constexpr int NIN = 6560, NINP = 6656;
constexpr int NTHR = 512;
constexpr float LOG2E = 1.4426950408889634f;

#define XB_TMO      128
#define XB_XCNT(j)  (256  + 64 * (j))
#define XB_XSUB(j)  (1280 + 64 * (j))
#define XB_XGEN(j)  (2304 + 64 * (j))
#define XB_TOP      3328
#define XB_TOPGEN   3392
#define XCD_BAR_WORDS 3456
#define XB_SPIN_CAP (1u << 18)

__device__ __forceinline__ unsigned xb_ld(unsigned* p)              { return __hip_atomic_load(p, __ATOMIC_RELAXED, __HIP_MEMORY_SCOPE_AGENT); }
__device__ __forceinline__ unsigned xb_add(unsigned* p, unsigned v) { return __hip_atomic_fetch_add(p, v, __ATOMIC_RELAXED, __HIP_MEMORY_SCOPE_AGENT); }
__device__ __forceinline__ unsigned xb_xcc_id() { return (unsigned)__builtin_amdgcn_s_getreg((3 << 11) | 20) & 0xFu; }
#define XB_SPIN(cond, bar) do { unsigned _sp = 0; while (cond) { __builtin_amdgcn_s_sleep(1); \
    if ((++_sp & 255u) == 0u) { if (xb_ld(&(bar)[XB_TMO])) break; if (_sp > XB_SPIN_CAP) { atomicAdd(&(bar)[XB_TMO], 1u); break; } } } } while (0)

struct XcdBarrier { unsigned* bar; unsigned x; volatile LAS unsigned* st; };

__device__ __forceinline__ XcdBarrier xcd_barrier_post(unsigned* bar, volatile LAS unsigned* st) {
    XcdBarrier b; b.bar = bar; b.x = xb_xcc_id(); b.st = st;
    if (threadIdx.x == 0) (void)xb_add(&bar[XB_XCNT(b.x)], 1u);
    return b;
}
__device__ __forceinline__ void xcd_barrier_complete(unsigned* bar, unsigned x, unsigned& nloc, unsigned& nx) {
    const unsigned G = gridDim.x * gridDim.y * gridDim.z;
    unsigned sum, cnt, mine, sp = 0u;
    for (;;) {
        sum = 0u; cnt = 0u; mine = 0u;
#pragma unroll
        for (unsigned j = 0; j < 16; ++j) { const unsigned c = xb_ld(&bar[XB_XCNT(j)]); sum += c; cnt += (c > 0u) ? 1u : 0u; mine = (j == x) ? c : mine; }
        if (sum == G) break;
        __builtin_amdgcn_s_sleep(1);
        if ((++sp & 255u) == 0u) { if (xb_ld(&bar[XB_TMO])) break; if (sp > XB_SPIN_CAP) { atomicAdd(&bar[XB_TMO], 1u); break; } }
    }
    nloc = mine > 0u ? mine : 1u; nx = cnt > 0u ? cnt : 1u;
}
__device__ __forceinline__ void xcd_barrier(const XcdBarrier& b) {
    asm volatile("s_waitcnt vmcnt(0)" ::: "memory");
    __syncthreads();
    if (threadIdx.x == 0) {
        unsigned* bar = b.bar;
        __builtin_amdgcn_s_waitcnt(0);
        unsigned nloc = b.st[0], nx = b.st[1];
        if (nloc == 0u) { xcd_barrier_complete(bar, b.x, nloc, nx); b.st[0] = nloc; b.st[1] = nx; }
        const unsigned old = xb_add(&bar[XB_XSUB(b.x)], 1u);
        const unsigned gen = old / nloc;
        if (old + 1u == (gen + 1u) * nloc) {
            __builtin_amdgcn_fence(__ATOMIC_RELEASE, "agent");
            asm volatile("s_waitcnt vmcnt(0)" ::: "memory");
            const unsigned og = xb_add(&bar[XB_TOP], 1u);
            const unsigned tg = og / nx;
            if (og + 1u == (tg + 1u) * nx) xb_add(&bar[XB_TOPGEN], 1u);
            else XB_SPIN(xb_ld(&bar[XB_TOPGEN]) == tg, bar);
            __builtin_amdgcn_fence(__ATOMIC_ACQUIRE, "agent");
            xb_add(&bar[XB_XGEN(b.x)], 1u);
            asm volatile("s_waitcnt vmcnt(0)" ::: "memory");
        } else {
            XB_SPIN(xb_ld(&bar[XB_XGEN(b.x)]) == gen, bar);
            __builtin_amdgcn_fence(__ATOMIC_ACQUIRE, "agent");
            asm volatile("s_waitcnt vmcnt(0)" ::: "memory");
        }
    }
    __syncthreads();
}

DI float bf2f(bf16_t v) { return __uint_as_float((unsigned)v << 16); }
DI unsigned pack2(float a, float b) { f32x2 v = {a, b}; bf16x2v r = __builtin_convertvector(v, bf16x2v); return __builtin_bit_cast(unsigned, r); }
DI bf16_t f2bf(float a) { return (bf16_t)(pack2(a, 0.f) & 0xffffu); }
DI float lo2f(unsigned u) { return __uint_as_float(u << 16); }
DI float hi2f(unsigned u) { return __uint_as_float(u & 0xffff0000u); }
DI float wave_sum(float v) {
#pragma unroll
    for (int m = 32; m >= 1; m >>= 1) v += __shfl_xor(v, m, 64);
    return v;
}
DI float sum16(float v) {
#pragma unroll
    for (int m = 8; m >= 1; m >>= 1) v += __shfl_xor(v, m, 64);
    return v;
}
DI float sigmoidf_(float x) { return __builtin_amdgcn_rcpf(1.f + __expf(-x)); }
DI float siluf_(float x) { return x * __builtin_amdgcn_rcpf(1.f + __expf(-x)); }
DI float gelu_tanh(float x) { const float u = 0.7978845608028654f * (x + 0.044715f * x * x * x); return x * __builtin_amdgcn_rcpf(1.f + __expf(-2.f * u)); }
DI float tanhf_(float x) { return 2.f * __builtin_amdgcn_rcpf(1.f + __expf(-2.f * x)) - 1.f; }
DI void unpack4(u32x2 u, float (&f)[4]) { f[0] = lo2f(u.x); f[1] = hi2f(u.x); f[2] = lo2f(u.y); f[3] = hi2f(u.y); }
DI u32x2 pack4(float a, float b, float c, float d) { u32x2 r; r.x = pack2(a, b); r.y = pack2(c, d); return r; }

constexpr size_t algn(size_t x) { return (x + 255) & ~(size_t)255; }
constexpr size_t WS_CTL   = 0;
constexpr size_t CTL_BYTES = 64 * 1024;
constexpr size_t WS_H     = WS_CTL + CTL_BYTES;
constexpr size_t WS_WSM   = WS_H + (size_t)NZ * D * 4;
constexpr size_t SZ_WINT = (size_t)NINP * D * 2, SZ_WUQT = 384 * 256 * 2, SZ_WUKVT = 512 * 128 * 2, SZ_W2T = 512 * 64 * 2, SZ_A2T = 512 * 64 * 2,
                 SZ_G2T = 256 * 128 * 2, SZ_GLUT = 256 * 256 * 2, SZ_WBT = (size_t)D * D * 2, SZ_WOUTT = (size_t)D * D * 2;
constexpr size_t OFF_WINT = 0, OFF_WUQT = OFF_WINT + NL * SZ_WINT, OFF_WUKVT = OFF_WUQT + NL * SZ_WUQT, OFF_W2T = OFF_WUKVT + NL * SZ_WUKVT,
                 OFF_A2T = OFF_W2T + NL * SZ_W2T, OFF_G2T = OFF_A2T + NL * SZ_A2T, OFF_GLUT = OFF_G2T + NL * SZ_G2T, OFF_WBT = OFF_GLUT + NL * SZ_GLUT,
                 OFF_WOUTT = OFF_WBT + NL * SZ_WBT, OFF_MODV = OFF_WOUTT + NL * SZ_WOUTT,
                 OFF_ROPE = OFF_MODV + (size_t)NL * 3 * 6144 * 4,
                 OFF_S5T = OFF_ROPE + (size_t)SEQ * 16 * 2 * 4,
                 OFF_RWT = OFF_S5T + (size_t)NL * 2 * 16 * 64 * 36 * 4,
                 OFF_LAM = OFF_RWT + (size_t)NL * 36 * 1024 * 4,
                 OFF_S5E = OFF_LAM + 256,
                 OFF_S5C = OFF_S5E,
                 WSM_BYTES = algn(OFF_S5E + (size_t)2 * 2 * 16 * 132 * 64 * 2 * 4);
constexpr size_t WS_EXPW  = WS_WSM + WSM_BYTES;
constexpr size_t SZ_WGU = (size_t)1024 * 1024 * 2, SZ_WD = (size_t)1024 * 512 * 2;
constexpr size_t EXPW_BYTES = 32 * (SZ_WGU + SZ_WD);
constexpr size_t SZ_QM = (size_t)NB * 4 * TZ * 96 * 2, SZ_VMT = (size_t)NB * 4 * 64 * TZ * 2, SZ_QD = (size_t)NB * 4 * TZ * 64 * 2, SZ_R256 = (size_t)NZ * 256 * 2;
constexpr size_t MX_QM = 0, MX_KM = MX_QM + SZ_QM, MX_VMT = MX_KM + SZ_QM, MX_QD = MX_VMT + SZ_VMT, MX_KD = MX_QD + SZ_QD, MX_VDT = MX_KD + SZ_QD,
                 MX_RB = MX_VDT + SZ_VMT, MX_KB = MX_RB + SZ_R256, MX_VB = MX_KB + SZ_R256, MX_KKB = MX_VB + SZ_R256, MX_END = MX_KKB + SZ_R256;
static_assert(MX_END <= EXPW_BYTES, "mixer operands must fit the expert-weight region");
constexpr size_t WS_BUFA  = WS_EXPW + EXPW_BYTES;
constexpr size_t WS_BUFB  = WS_BUFA + (size_t)NZ * D * 2;
constexpr size_t WS_P     = WS_BUFB + (size_t)NZ * D * 2;
constexpr size_t P_PM = 0, P_PS = P_PM + (size_t)NZ * 416 * 2, P_PR = P_PS + (size_t)NZ * 256 * 2, P_PD = P_PR + (size_t)NZ * 1024 * 2, P_BYTES = P_PD + (size_t)NZ * 768 * 2;
static_assert((size_t)6 * SZ_R256 <= (size_t)NZ * (1024 + 768) * 2, "scan operands must fit PR|PD");
static_assert((size_t)2 * NZ * D * 2 <= P_BYTES, "the MoE outputs (2 x bf16 [NZ][D]) must fit the P region");
constexpr size_t WS_GT    = WS_P + P_BYTES;
constexpr size_t GT_BYTES = (size_t)NZ * 4096 * 2;
constexpr int MOE_CAP = 33792;
constexpr size_t GT_HM = 0, GT_LIST = GT_HM + (size_t)(33792 + 32 * 128) * 512 * 2, GT_LW = GT_LIST + (size_t)32 * MOE_CAP * 4, GT_END = GT_LW + (size_t)32 * MOE_CAP * 4;
static_assert(GT_END <= GT_BYTES, "MoE scratch must fit the gate region");
constexpr size_t WS_MISC  = WS_GT + GT_BYTES;
constexpr size_t MS_CQN = 0, MS_TW = MS_CQN + (size_t)NZ * 384 * 2, MS_AL = MS_TW + (size_t)NZ * 64 * 2, MS_SG = MS_AL + (size_t)NZ * 64 * 2,
                 MS_GG = MS_SG + (size_t)NZ * 128 * 2, MS_ZG = MS_GG + SZ_R256, MS_END = MS_ZG + SZ_R256;
constexpr size_t WS_RW    = WS_MISC + MS_END;
constexpr int RC = 64, RNC = TZ / RC;
constexpr size_t SZ_RWM = (size_t)16 * RNC * 4096 * 2;
constexpr size_t RW_M3 = 0, RW_M2 = SZ_RWM, RW_Z5 = 2 * SZ_RWM, RW_P63 = 3 * SZ_RWM, RW_END = RW_P63 + (size_t)16 * RNC * 64 * 4;
constexpr size_t WS_END   = WS_RW + RW_END;

constexpr int CW_BAR = 0;
constexpr int CW_CNT = 4096;

struct Args { const float* in[49]; float* out; unsigned char* ws; int s_lo, s_hi; };

struct Ctx {
    const float* const* in; float* out; unsigned char* ws; unsigned char* smem; int tid, lane, wave;
};

template <int WM> struct GCfg { static constexpr int WN = 8 / WM, BM = 64 * WM, BN = 64 * WN, ABYTES = BM * 128, BBYTES = BN * 128, STAGE = ABYTES + BBYTES; };

template <int WM, int SEGK, class ARow, class BRow, class Hook, class Epi>
DI void gemm_tile(const Ctx& c, int K, ARow arow, BRow brow, Hook hook, Epi epi) {
    typedef GCfg<WM> G;
    const int tid = c.tid, lane = c.lane, wave = c.wave;
    const int wm = wave / G::WN, wn = wave % G::WN, fr = lane & 15, fq = lane >> 4;
    unsigned char* smem = c.smem;
    constexpr int NA = G::BM / 64, NBq = G::BN / 64;
    const int r0 = tid >> 3, coff = ((tid & 7) ^ (r0 & 7)) * 8;
    auto stage = [&](int kt, int buf) {
        unsigned char* sa = smem + buf * G::STAGE; unsigned char* sb = sa + G::ABYTES;
#pragma unroll
        for (int i = 0; i < NA; ++i) __builtin_amdgcn_global_load_lds((const unsigned*)(arow(r0 + 64 * i) + coff + kt * 64), (unsigned*)(sa + (tid + i * NTHR) * 16), 16, 0, 0);
#pragma unroll
        for (int i = 0; i < NBq; ++i) __builtin_amdgcn_global_load_lds((const unsigned*)(brow(r0 + 64 * i) + coff + kt * 64), (unsigned*)(sb + (tid + i * NTHR) * 16), 16, 0, 0);
    };
    f32x4 acc[4][4];
#pragma unroll
    for (int m = 0; m < 4; ++m)
#pragma unroll
        for (int n = 0; n < 4; ++n) acc[m][n] = (f32x4){0.f, 0.f, 0.f, 0.f};
    const int T = K / 64;
    __syncthreads();
    stage(0, 0);
    for (int t = 0; t < T; ++t) {
        asm volatile("s_waitcnt vmcnt(0)" ::: "memory");
        __syncthreads();
        if (t + 1 < T) stage(t + 1, (t + 1) & 1);
        const unsigned char* sa = smem + (t & 1) * G::STAGE; const unsigned char* sb = sa + G::ABYTES;
#pragma unroll
        for (int ks = 0; ks < 2; ++ks) {
            bf16x8 af[4], bfr[4];
            const int sl = ((ks * 4 + fq) ^ (fr & 7)) * 16;
#pragma unroll
            for (int m = 0; m < 4; ++m) af[m] = *(const bf16x8*)(sa + (wm * 64 + m * 16 + fr) * 128 + sl);
#pragma unroll
            for (int n = 0; n < 4; ++n) bfr[n] = *(const bf16x8*)(sb + (wn * 64 + n * 16 + fr) * 128 + sl);
#pragma unroll
            for (int m = 0; m < 4; ++m)
#pragma unroll
                for (int n = 0; n < 4; ++n) acc[m][n] = __builtin_amdgcn_mfma_f32_16x16x32_bf16(bfr[n], af[m], acc[m][n], 0, 0, 0);
        }
        if (SEGK > 0) { if (((t + 1) * 64) % (SEGK > 0 ? SEGK : 64) == 0) hook(acc, ((t + 1) * 64) / (SEGK > 0 ? SEGK : 64) - 1, wm * 64, wn * 64, fr, fq); }
    }
    epi(acc, wm * 64, wn * 64, fr, fq);
}
struct NoHook { DI void operator()(f32x4 (&)[4][4], int, int, int, int, int) const {} };

#ifndef INPROJ_WGM
#define INPROJ_WGM 4
#define MERGE2_WGM 8
#endif
namespace pg8 {
#define PG8_LAS __attribute__((address_space(3)))
typedef unsigned short bf16_t;
typedef short bf16x8 __attribute__((ext_vector_type(8)));
typedef float f32x4 __attribute__((ext_vector_type(4)));
constexpr int BM = 256, BK = 64, HALF = 128, HTB = HALF * BK * 2  , STAGE_BYTES = 8 * HTB, NXCD = 8, WGM = 4;

__host__ __device__ __forceinline__ int lds_byte(int r, int c) { const int st = (r >> 4) * 2 + (c >> 5), rr = r & 15, cc = c & 31, ob = rr * 64 + cc * 2; return st * 1024 + (ob ^ (((ob >> 9) & 1) << 5)); }
__host__ __device__ __forceinline__ void stage_rc(int b, int& R, int& C) { const int st = b / 1024, sb = b % 1024, swz = sb ^ (((sb >> 9) & 1) << 5); R = (st >> 1) * 16 + swz / 64; C = (st & 1) * 32 + (swz % 64) / 2; }
__host__ __device__ __forceinline__ int perm32(int rho) { const int n = rho >> 4, i = rho & 15; return 8 * (i >> 2) + 4 * n + (i & 3); }

struct Unit { int pm, pn; };
struct Gemm { const bf16_t* A; const bf16_t* Bt; int M, N, K, lda, ldb; };

struct StaticOrder {
    int nM, nN, nwg, G, c, wgm;
    __host__ __device__ void init(int M, int N, int G_, int c_, int wgm_ = WGM) { nM = M / BM; nN = N / BM; nwg = nM * nN; G = G_; c = c_; wgm = wgm_; }
    __host__ __device__ bool next(int i, Unit& u) const {
        const long L = (long)i * G + c; if (L >= nwg) return false;
        int wgid = (int)L; { const int q = nwg / NXCD, r = nwg % NXCD, xcd = wgid % NXCD, off = wgid / NXCD; wgid = (xcd < r ? xcd * (q + 1) : r * (q + 1) + (xcd - r) * q) + off; }
        const int nig = wgm * nN, gid = wgid / nig, fm = gid * wgm, gsz = (nM - fm) < wgm ? (nM - fm) : wgm;
        u.pm = fm + ((wgid % nig) % gsz); u.pn = (wgid % nig) / gsz; return true;
    }
    __device__ __forceinline__ void a_ready(const Unit&) const {}
    __device__ __forceinline__ void done(const Unit&) const {}
};
template <class Epi, class Sched, bool STAMP = false>
__device__ __forceinline__ void gemm_phase(PG8_LAS unsigned char* lds, const Gemm g, const Sched& S, const Epi& E, unsigned long long* stamps, int tid_in) {
    const int tid = tid_in, wid = __builtin_amdgcn_readfirstlane(tid >> 6), lane = tid & 63, wr = wid >> 2, wc = wid & 3, fr = lane & 15, fq = lane >> 4;
    const int K = g.K, nt = K / BK;
    int ts_lo = 0, ts_hi = 0, nts = 0; const unsigned long long rt_entry = STAMP ? (unsigned long long)wall_clock64() : 0ull;
#define PG8_STAMP() do { if (STAMP && wid == 0 && nts < 64) { const unsigned long long _c = (unsigned long long)clock64(); \
        ts_lo = (lane == nts) ? (int)(unsigned)_c : ts_lo; ts_hi = (lane == nts) ? (int)(unsigned)(_c >> 32) : ts_hi; ++nts; } } while (0)
    PG8_STAMP();
    unsigned voffA[2], voffB[2];
#pragma unroll
    for (int i = 0; i < 2; ++i) { int R, C; stage_rc(tid * 16 + i * 8192, R, C); const int Rb = Epi::PERM ? ((R & ~31) + perm32(R & 31)) : R;
        voffA[i] = (unsigned)(R * g.lda + C) * 2u; voffB[i] = (unsigned)(Rb * g.ldb + C) * 2u; }
    const size_t kstep = (size_t)(BK * 2);
    const size_t hstepA = (size_t)HALF * g.lda * 2, hstepB = (size_t)HALF * g.ldb * 2;
    const size_t tstepA = 2 * hstepA, tstepB = 2 * hstepB;
    const unsigned ldsw = (unsigned)wid * 1024u;
    const int aoff = lds_byte(wr * 64 + fr, fq * 8), boff = lds_byte(wc * 32 + fr, fq * 8);
#define PG8_SA(b, h) (((b) * 2 + (h)) * HTB)
#define PG8_SB(b, h) ((4 + (b) * 2 + (h)) * HTB)
#define PG8_STAGE(bufoff, gbase, voff) do { _Pragma("unroll") for (int _i = 0; _i < 2; ++_i) \
        __builtin_amdgcn_global_load_lds((const unsigned*)((const char*)(gbase) + (voff)[_i]), (PG8_LAS unsigned*)(lds + (bufoff) + ldsw + _i * 8192), 16, 0, 0); } while (0)
#define PG8_LDA(dst, b, h) do { _Pragma("unroll") for (int m = 0; m < 4; ++m) _Pragma("unroll") for (int k = 0; k < 2; ++k) dst[m][k] = *(const PG8_LAS bf16x8*)(lds + PG8_SA(b, h) + aoff + m * 2048 + k * 1024); } while (0)
#define PG8_LDB(dst, b, h) do { _Pragma("unroll") for (int n = 0; n < 2; ++n) _Pragma("unroll") for (int k = 0; k < 2; ++k) dst[n][k] = *(const PG8_LAS bf16x8*)(lds + PG8_SB(b, h) + boff + n * 2048 + k * 1024); } while (0)
#define PG8_MMA(ai, bj, At, Bt) do { __builtin_amdgcn_s_setprio(1); _Pragma("unroll") for (int m = 0; m < 4; ++m) _Pragma("unroll") for (int n = 0; n < 2; ++n) _Pragma("unroll") for (int k = 0; k < 2; ++k) \
        acc[ai][bj][m][n] = __builtin_amdgcn_mfma_f32_16x16x32_bf16(Bt[n][k], At[m][k], acc[ai][bj][m][n], 0, 0, 0); __builtin_amdgcn_s_setprio(0); } while (0)
#define PG8_WAIT_V(n) asm volatile("s_waitcnt vmcnt(" #n ")" ::: "memory")
#define PG8_WAIT_L(n) asm volatile("s_waitcnt lgkmcnt(" #n ")" ::: "memory")
#define PG8_BAR __builtin_amdgcn_s_barrier()
#define PG8_SCHED __builtin_amdgcn_sched_barrier(0)
    Unit cur, nxt; int ui = 0;
    if (!S.next(0, cur)) return;
    f32x4 acc[2][2][4][2];
#pragma unroll
    for (int a = 0; a < 2; ++a)
#pragma unroll
        for (int b = 0; b < 2; ++b)
#pragma unroll
            for (int m = 0; m < 4; ++m)
#pragma unroll
                for (int n = 0; n < 2; ++n) acc[a][b][m][n] = (f32x4){0.f, 0.f, 0.f, 0.f};
    bf16x8 At[4][2], B0[2][2], B1[2][2];
    const char* cA = (const char*)g.A + (size_t)cur.pm * tstepA; const char* cB = (const char*)g.Bt + (size_t)cur.pn * tstepB;
    S.a_ready(cur);
    PG8_STAGE(PG8_SB(0, 0), cB, voffB); PG8_STAGE(PG8_SA(0, 0), cA, voffA); PG8_STAGE(PG8_SB(0, 1), cB + hstepB, voffB); PG8_STAGE(PG8_SA(0, 1), cA + hstepA, voffA);
    if (wr == 1) PG8_BAR;
    PG8_WAIT_V(4); PG8_BAR;
    PG8_STAGE(PG8_SB(1, 0), cB + kstep, voffB); PG8_STAGE(PG8_SA(1, 0), cA + kstep, voffA); PG8_STAGE(PG8_SB(1, 1), cB + hstepB + kstep, voffB);
    PG8_WAIT_V(6); PG8_BAR;
    PG8_STAMP();
    for (;;) {
        const bool has_next = S.next(ui + 1, nxt);
        const char* nA = has_next ? (const char*)g.A + (size_t)nxt.pm * tstepA : cA; const char* nB = has_next ? (const char*)g.Bt + (size_t)nxt.pn * tstepB : cB;
        for (int t = 0; t < nt; t += 2) {
            const bool last = (t == nt - 2);
            const char* a1 = cA + (size_t)(t + 1) * kstep;
            const char* a2 = last ? nA : cA + (size_t)(t + 2) * kstep; const char* b2 = last ? nB : cB + (size_t)(t + 2) * kstep;
            const char* a3 = a2 + kstep; const char* b3 = b2 + kstep;
            if (last && has_next) S.a_ready(nxt);
            PG8_LDB(B0, 0, 0); PG8_SCHED; PG8_LDA(At, 0, 0); PG8_STAGE(PG8_SA(1, 1), a1 + hstepA, voffA);
            PG8_WAIT_L(8); PG8_BAR; PG8_WAIT_L(0); PG8_MMA(0, 0, At, B0); PG8_BAR; PG8_SCHED;
            PG8_LDB(B1, 0, 1); PG8_STAGE(PG8_SB(0, 0), b2, voffB);
            PG8_BAR; PG8_WAIT_L(0); PG8_MMA(0, 1, At, B1); PG8_BAR;
            PG8_LDA(At, 0, 1); PG8_STAGE(PG8_SA(0, 0), a2, voffA);
            PG8_BAR; PG8_WAIT_L(0); PG8_MMA(1, 0, At, B0); PG8_BAR; PG8_SCHED;
            PG8_STAGE(PG8_SB(0, 1), b2 + hstepB, voffB);
            PG8_WAIT_V(6); PG8_BAR; PG8_MMA(1, 1, At, B1); PG8_BAR;
            PG8_LDB(B0, 1, 0); PG8_SCHED; PG8_LDA(At, 1, 0); PG8_STAGE(PG8_SA(0, 1), a2 + hstepA, voffA);
            PG8_WAIT_L(8); PG8_BAR; PG8_WAIT_L(0); PG8_MMA(0, 0, At, B0); PG8_BAR; PG8_SCHED;
            PG8_LDB(B1, 1, 1); PG8_STAGE(PG8_SB(1, 0), b3, voffB);
            PG8_BAR; PG8_WAIT_L(0); PG8_MMA(0, 1, At, B1); PG8_BAR;
            PG8_LDA(At, 1, 1); PG8_STAGE(PG8_SA(1, 0), a3, voffA);
            PG8_BAR; PG8_WAIT_L(0); PG8_MMA(1, 0, At, B0); PG8_BAR; PG8_SCHED;
            PG8_STAGE(PG8_SB(1, 1), b3 + hstepB, voffB);
            PG8_WAIT_V(6); PG8_BAR; PG8_MMA(1, 1, At, B1); PG8_BAR;
        }
        PG8_STAMP();
        if constexpr (!Epi::AFTER_DRAIN) { E(acc, cur, wr, wc, fr, fq); S.done(cur); }
        PG8_STAMP();
        if (!has_next) break;
#pragma unroll
        for (int a = 0; a < 2; ++a)
#pragma unroll
            for (int b = 0; b < 2; ++b)
#pragma unroll
                for (int m = 0; m < 4; ++m)
#pragma unroll
                    for (int n = 0; n < 2; ++n) acc[a][b][m][n] = (f32x4){0.f, 0.f, 0.f, 0.f};
        cur = nxt; cA = nA; cB = nB; ++ui;
    }
    PG8_WAIT_V(0);
    if (wr == 0) PG8_BAR;
    PG8_BAR;
    if constexpr (Epi::AFTER_DRAIN) { E.fused(acc, cur, wr, wc, fr, fq, lds, wid, lane); S.done(cur); }
    PG8_STAMP();
    if (STAMP && wid == 0) { stamps[lane] = lane < nts ? (((unsigned long long)(unsigned)ts_hi << 32) | (unsigned)ts_lo) : 0ull;
        if (lane == 62) stamps[62] = rt_entry; if (lane == 63) stamps[63] = (unsigned long long)wall_clock64(); }
#undef PG8_STAMP
#undef PG8_SA
#undef PG8_SB
#undef PG8_STAGE
#undef PG8_LDA
#undef PG8_LDB
#undef PG8_MMA
#undef PG8_WAIT_V
#undef PG8_WAIT_L
#undef PG8_BAR
#undef PG8_SCHED
}
}

DI int rowmap(int n, int mode) { return mode == 0 ? n : ((n >> 4) * 32 + (n & 15) + (mode == 2 ? 16 : 0)); }
DI void tconv_tile(const Ctx& c, const float* src, int ld, int N, bf16_t* dst, int ld_dst, int mode, int tk, int tn) {
    bf16_t* T = (bf16_t*)c.smem;
    const int k0 = tk * 64, n0 = tn * 64, tid = c.tid;
    __syncthreads();
#pragma unroll
    for (int i = 0; i < 2; ++i) {
        const int kk = (tid >> 4) + i * 32, n4 = (tid & 15) * 4;
        float4 v = make_float4(0.f, 0.f, 0.f, 0.f);
        if (n0 + n4 < N) v = *(const float4*)(src + (size_t)(k0 + kk) * ld + n0 + n4);
        T[(n4 + 0) * 72 + kk] = f2bf(v.x); T[(n4 + 1) * 72 + kk] = f2bf(v.y); T[(n4 + 2) * 72 + kk] = f2bf(v.z); T[(n4 + 3) * 72 + kk] = f2bf(v.w);
    }
    __syncthreads();
    const int n = tid >> 3, k8 = (tid & 7) * 8;
    if (n0 + n < N) *(u32x4*)(dst + (size_t)rowmap(n0 + n, mode) * ld_dst + k0 + k8) = *(const u32x4*)(T + n * 72 + k8);
}
DI void tconv(const Ctx& c, const float* src, int ld, int K, int N, bf16_t* dst, int ld_dst, int mode, int rot) {
    const int ntk = K / 64, ntn = (N + 63) / 64, nt = ntk * ntn, G = gridDim.x;
    for (int t = (blockIdx.x + G - (rot % G)) % G; t < nt; t += G) tconv_tile(c, src, ld, N, dst, ld_dst, mode, t / ntn, t % ntn);
}

DI void wconv(const Ctx& c, const float* src, int ld, int K, int N, bf16_t* dst, int ld_dst, int rot) {
    const int ntk = K / 64, ntn = (N + 63) / 64, nt = ntk * ntn, GW = gridDim.x * 8, w0 = blockIdx.x * 8 + c.wave;
    for (int t = (w0 + GW - (rot % GW)) % GW; t < nt; t += GW) {
        const int tk = t / ntn, tn = t % ntn, n = tn * 64 + c.lane;
        if (n < N) {
            const float* sp = src + (size_t)(tk * 64) * ld + n; bf16_t* dp = dst + (size_t)n * ld_dst + tk * 64;
#pragma unroll
            for (int kb = 0; kb < 8; ++kb) {
                float v[8];
#pragma unroll
                for (int j = 0; j < 8; ++j) v[j] = sp[(size_t)(kb * 8 + j) * ld];
                u32x4 w4; w4.x = pack2(v[0], v[1]); w4.y = pack2(v[2], v[3]); w4.z = pack2(v[4], v[5]); w4.w = pack2(v[6], v[7]);
                *(u32x4*)(dp + kb * 8) = w4;
            }
        }
    }
}
DI void phase_prologue(const Ctx& c) {
    unsigned char* wsm = c.ws + WS_WSM;
    const int tid = c.tid, G = gridDim.x, gtid = blockIdx.x * NTHR + tid, gn = G * NTHR;
    {
        const float4* x = (const float4*)c.in[0]; const float4* cx = (const float4*)c.in[2]; float4* H = (float4*)(c.ws + WS_H);
        for (size_t i = gtid; i < (size_t)NZ * 256; i += gn) {
            const int z = (int)(i >> 8), q = (int)(i & 255), b = z / TZ, s = z % TZ;
            H[i] = (s < CTX) ? cx[((size_t)b * CTX + s) * 256 + q] : x[((size_t)b * SEQ + (s - CTX)) * 256 + q];
        }
    }
    {
        float* rope = (float*)(wsm + OFF_ROPE);
        for (int i = gtid; i < SEQ * 16; i += gn) {
            const int t = i >> 4, a = (i >> 3) & 1, f = i & 7;
            const float pos = (float)(a == 0 ? (t >> 6) : (t & 63));
            const float inv = powf(10000.f, -(float)f / 8.f);
            float sn, cs; sincosf(pos * inv, &sn, &cs);
            rope[i * 2] = cs; rope[i * 2 + 1] = sn;
        }
    }
    {
        float* s5t = (float*)(wsm + OFF_S5T);
        for (int i = blockIdx.x + tid * G; i < NL * 2 * 16 * 64; i += G * NTHR) {
            const int ldg = i >> 6;
            const double lr = c.in[24][i], li = c.in[25][i], dt = exp((double)c.in[26][ldg]);
            const double mag = exp(lr * dt), are = mag * cos(li * dt), aim = mag * sin(li * dt);
            const double m256 = exp(lr * dt * 64.0), a256r = m256 * cos(li * dt * 64.0), a256i = m256 * sin(li * dt * 64.0);
            const double den = lr * lr + li * li, nr = are - 1.0, ni = aim;
            const double cfr = (nr * lr + ni * li) / den, cfi = (ni * lr - nr * li) / den;
            float* o = s5t + (size_t)i * 36;
            o[0] = (float)are; o[1] = (float)aim; o[2] = (float)a256r; o[3] = (float)a256i;
            for (int ch = 0; ch < 16; ++ch) {
                const double br = c.in[27][(size_t)i * 16 + ch], bi = c.in[28][(size_t)i * 16 + ch];
                o[4 + ch] = (float)(cfr * br - cfi * bi); o[20 + ch] = (float)(cfr * bi + cfi * br);
            }
        }
    }
    {
        float* rwt = (float*)(wsm + OFF_RWT);
        for (int i = gtid; i < NL * 36 * 1024; i += gn) {
            const int l = i / (36 * 1024), e = (i / 1024) % 36, d = i & 1023;
            rwt[i] = e < 4 ? c.in[41][((size_t)l * 1024 + d) * 4 + e] : c.in[43][((size_t)l * 1024 + d) * 32 + (e - 4)];
        }
    }
    if (blockIdx.x == 0 && tid < NL) {
        float s1 = 0.f, s2 = 0.f;
        for (int i = 0; i < 32; ++i) { s1 += c.in[34][tid * 32 + i] * c.in[35][tid * 32 + i]; s2 += c.in[36][tid * 32 + i] * c.in[37][tid * 32 + i]; }
        ((float*)(wsm + OFF_LAM))[tid] = expf(s1) - expf(s2) + (0.8f - 0.6f * expf(-0.3f * (float)tid));
    }
    {
        float* sv = (float*)c.smem;
        float* red = sv + 3 * 1024;
        __syncthreads();
        for (int i = tid; i < 3 * 1024; i += NTHR) { const float v = i < 2048 ? c.in[1][i] : c.in[3][i - 2048]; sv[i] = siluf_(v); }
        __syncthreads();
        float* modv = (float*)(wsm + OFF_MODV);
        for (int u = blockIdx.x; u < NL * 96; u += G) {
            const int l = u / 96, col = (u % 96) * 64 + (tid & 63), ks = tid >> 6;
            const float* w = c.in[4] + (size_t)l * 1024 * 6144 + col;
            float a0 = 0.f, a1 = 0.f, a2 = 0.f;
            for (int k = ks * 128; k < ks * 128 + 128; ++k) { const float wv = w[(size_t)k * 6144]; a0 += sv[k] * wv; a1 += sv[1024 + k] * wv; a2 += sv[2048 + k] * wv; }
            red[(ks * 64 + (tid & 63)) * 3 + 0] = a0; red[(ks * 64 + (tid & 63)) * 3 + 1] = a1; red[(ks * 64 + (tid & 63)) * 3 + 2] = a2;
            __syncthreads();
            if (tid < 192) {
                const int cc = tid & 63, sel = tid >> 6; float s = 0.f;
                for (int k2 = 0; k2 < 8; ++k2) s += red[(k2 * 64 + cc) * 3 + sel];
                const int colo = (u % 96) * 64 + cc;
                modv[((size_t)l * 3 + sel) * 6144 + colo] = s + c.in[5][l * 6144 + colo];
            }
            __syncthreads();
        }
    }
    for (int l = 0; l < NL; ++l) {
        wconv(c, c.in[8] + (size_t)l * 1024 * NIN, NIN, 1024, NIN, (bf16_t*)(wsm + OFF_WINT + l * SZ_WINT), 1024, l * 700);
        tconv(c, c.in[11] + (size_t)l * 256 * 384, 384, 256, 384, (bf16_t*)(wsm + OFF_WUQT + l * SZ_WUQT), 256, 0, 40);
        tconv(c, c.in[12] + (size_t)l * 128 * 512, 512, 128, 512, (bf16_t*)(wsm + OFF_WUKVT + l * SZ_WUKVT), 128, 0, 70);
        for (int d = 0; d < 2; ++d) {
            tconv(c, c.in[15] + (size_t)(l * 2 + d) * 64 * 256, 256, 64, 256, (bf16_t*)(wsm + OFF_W2T + l * SZ_W2T) + d * 256 * 64, 64, 0, 90 + d * 8);
            tconv(c, c.in[17] + (size_t)(l * 2 + d) * 64 * 256, 256, 64, 256, (bf16_t*)(wsm + OFF_A2T + l * SZ_A2T) + d * 256 * 64, 64, 0, 110 + d * 8);
        }
        tconv(c, c.in[18] + (size_t)l * 128 * 256, 256, 128, 256, (bf16_t*)(wsm + OFF_G2T + l * SZ_G2T), 128, 0, 130);
        tconv(c, c.in[32] + (size_t)l * 256 * 256, 256, 256, 256, (bf16_t*)(wsm + OFF_GLUT + l * SZ_GLUT), 256, 0, 140);
        for (int n = 0; n < 4; ++n)
            wconv(c, c.in[39] + (size_t)(l * 4 + n) * 256 * 1024, 1024, 256, 1024, (bf16_t*)(wsm + OFF_WBT + l * SZ_WBT) + n * 256, 1024, 300 + n * 64 + l * 1000);
        wconv(c, c.in[40] + (size_t)l * 1024 * 1024, 1024, 1024, 1024, (bf16_t*)(wsm + OFF_WOUTT + l * SZ_WOUTT), 1024, 1200 + l * 400);
    }
}

DI void phase_expert_convert(const Ctx& c, int l) {
    const int G = gridDim.x, lane = c.lane;
    for (int t = blockIdx.x * 8 + c.wave; t < 32 * 384; t += G * 8) {
        const int e = t / 384, r = t % 384;
        const float* src; bf16_t* dst; int ld, ldd, mode, tk, tn;
        if (r < 128)      { src = c.in[45] + ((size_t)l * 32 + e) * 1024 * 512; dst = (bf16_t*)(c.ws + WS_EXPW + (size_t)e * SZ_WGU); ld = 512; ldd = 1024; mode = 1; tk = r / 8; tn = r % 8; }
        else if (r < 256) { src = c.in[46] + ((size_t)l * 32 + e) * 1024 * 512; dst = (bf16_t*)(c.ws + WS_EXPW + (size_t)e * SZ_WGU); ld = 512; ldd = 1024; mode = 2; tk = (r - 128) / 8; tn = (r - 128) % 8; }
        else              { src = c.in[47] + ((size_t)l * 32 + e) * 512 * 1024; dst = (bf16_t*)(c.ws + WS_EXPW + 32 * SZ_WGU + (size_t)e * SZ_WD); ld = 1024; ldd = 512; mode = 0; tk = (r - 256) / 16; tn = (r - 256) % 16; }
        const int n = tn * 64 + lane; const float* sp = src + (size_t)(tk * 64) * ld + n; bf16_t* dp = dst + (size_t)rowmap(n, mode) * ldd + tk * 64;
        float v[64];
#pragma unroll
        for (int k = 0; k < 64; ++k) v[k] = __builtin_nontemporal_load(sp + (size_t)k * ld);
#pragma unroll
        for (int kb = 0; kb < 8; ++kb) {
            u32x4 w4; w4.x = pack2(v[kb * 8], v[kb * 8 + 1]); w4.y = pack2(v[kb * 8 + 2], v[kb * 8 + 3]); w4.z = pack2(v[kb * 8 + 4], v[kb * 8 + 5]); w4.w = pack2(v[kb * 8 + 6], v[kb * 8 + 7]);
            *(u32x4*)(dp + kb * 8) = w4;
        }
    }
}

DI void phase_norm1(const Ctx& c, int l) {
    const float* modv = (const float*)(c.ws + WS_WSM + OFF_MODV);
    float* H = (float*)(c.ws + WS_H); const bf16_t* Y = (const bf16_t*)(c.ws + WS_P);
    bf16_t* XN = (bf16_t*)(c.ws + WS_BUFA);
    const float* g1 = c.in[6] + l * 1024;
    float4 gv[4];
#pragma unroll
    for (int q = 0; q < 4; ++q) gv[q] = *(const float4*)(g1 + q * 256 + c.lane * 4);
    for (int row = blockIdx.x * 8 + c.wave; row < NZ; row += gridDim.x * 8) {
        const int b = row / TZ, s = row % TZ, sel = s < CTX ? 2 : b;
        float4 v[4], m0[4], m1[4], m5[4]; u32x2 ya2[4], yb2[4];
#pragma unroll
        for (int q = 0; q < 4; ++q) {
            const int col = q * 256 + c.lane * 4;
            v[q] = *(const float4*)(H + (size_t)row * D + col);
            m0[q] = *(const float4*)(modv + ((size_t)l * 3 + sel) * 6144 + col); m1[q] = *(const float4*)(modv + ((size_t)l * 3 + sel) * 6144 + 1024 + col);
            if (l > 0) { ya2[q] = *(const u32x2*)(Y + (size_t)row * D + col); yb2[q] = *(const u32x2*)(Y + ((size_t)NZ + row) * D + col);
                         m5[q] = *(const float4*)(modv + ((size_t)(l - 1) * 3 + sel) * 6144 + 5 * 1024 + col); }
        }
        float ss = 0.f;
#pragma unroll
        for (int q = 0; q < 4; ++q) {
            const int col = q * 256 + c.lane * 4;
            if (l > 0) {
                float ya[4], yb[4]; unpack4(ya2[q], ya); unpack4(yb2[q], yb);
                v[q].x += m5[q].x * (ya[0] + yb[0]); v[q].y += m5[q].y * (ya[1] + yb[1]); v[q].z += m5[q].z * (ya[2] + yb[2]); v[q].w += m5[q].w * (ya[3] + yb[3]);
                *(float4*)(H + (size_t)row * D + col) = v[q];
            }
            ss += v[q].x * v[q].x + v[q].y * v[q].y + v[q].z * v[q].z + v[q].w * v[q].w;
        }
        ss = wave_sum(ss);
        const float rs = rsqrtf(ss * (1.f / 1024.f) + 1e-6f);
#pragma unroll
        for (int q = 0; q < 4; ++q) {
            const int col = q * 256 + c.lane * 4;
            *(u32x2*)(XN + (size_t)row * D + col) = pack4(v[q].x * rs * gv[q].x * (1.f + m1[q].x) + m0[q].x, v[q].y * rs * gv[q].y * (1.f + m1[q].y) + m0[q].y,
                                                          v[q].z * rs * gv[q].z * (1.f + m1[q].z) + m0[q].z, v[q].w * rs * gv[q].w * (1.f + m1[q].w) + m0[q].w);
        }
    }
}

DI void phase_final(const Ctx& c) {
    const float* modv = (const float*)(c.ws + WS_WSM + OFF_MODV);
    const float* H = (const float*)(c.ws + WS_H); const bf16_t* Y = (const bf16_t*)(c.ws + WS_P);
    const float* g = c.in[48];
    float4 gv[4];
#pragma unroll
    for (int q = 0; q < 4; ++q) gv[q] = *(const float4*)(g + q * 256 + c.lane * 4);
    for (int r = blockIdx.x * 8 + c.wave; r < NB * SEQ; r += gridDim.x * 8) {
        const int b = r / SEQ, t = r % SEQ, row = b * TZ + CTX + t;
        float4 v[4]; float ss = 0.f;
#pragma unroll
        for (int q = 0; q < 4; ++q) {
            const int col = q * 256 + c.lane * 4;
            v[q] = *(const float4*)(H + (size_t)row * D + col);
            float ya[4], yb[4]; unpack4(*(const u32x2*)(Y + (size_t)row * D + col), ya); unpack4(*(const u32x2*)(Y + ((size_t)NZ + row) * D + col), yb);
            const float4 m5 = *(const float4*)(modv + ((size_t)(NL - 1) * 3 + b) * 6144 + 5 * 1024 + col);
            v[q].x += m5.x * (ya[0] + yb[0]); v[q].y += m5.y * (ya[1] + yb[1]); v[q].z += m5.z * (ya[2] + yb[2]); v[q].w += m5.w * (ya[3] + yb[3]);
            ss += v[q].x * v[q].x + v[q].y * v[q].y + v[q].z * v[q].z + v[q].w * v[q].w;
        }
        ss = wave_sum(ss);
        const float rs = rsqrtf(ss * (1.f / 1024.f) + 1e-6f);
#pragma unroll
        for (int q = 0; q < 4; ++q) {
            const int col = q * 256 + c.lane * 4; const float4 gg = gv[q];
            *(float4*)(c.out + (size_t)r * D + col) = make_float4(v[q].x * rs * gg.x, v[q].y * rs * gg.y, v[q].z * rs * gg.z, v[q].w * rs * gg.w);
        }
    }
}

struct EpiInproj {
    static constexpr bool PERM = true, AFTER_DRAIN = false;
    bf16_t *PM, *PS, *PR, *PD, *GT;
    DI void operator()(const pg8::f32x4 (&acc)[2][2][4][2], const pg8::Unit& u, int wr, int wc, int fr, int fq) const {
        const int row0 = u.pm * 256 + wr * 64 + fr, col0 = u.pn * 256 + wc * 32 + 8 * fq;
#pragma unroll
        for (int bj = 0; bj < 2; ++bj) {
            const int col = col0 + bj * 128;
            bf16_t* dst; int ld, cc; bool gate = false;
            if (col < 416) { dst = PM; ld = 416; cc = col; }
            else if (col < 1440) { dst = PR; ld = 1024; cc = col - 416; }
            else if (col < 1696) { dst = PS; ld = 256; cc = col - 1440; }
            else if (col < 2464) { dst = PD; ld = 768; cc = col - 1696; }
            else if (col < NIN) { dst = GT; ld = 4096; cc = col - 2464; gate = true; }
            else continue;
#pragma unroll
            for (int ai = 0; ai < 2; ++ai)
#pragma unroll
                for (int m = 0; m < 4; ++m) {
                    const int row = row0 + ai * 128 + m * 16; pg8::f32x4 v0 = acc[ai][bj][m][0], v1 = acc[ai][bj][m][1];
                    if (gate) { v0[0] = sigmoidf_(v0[0]); v0[1] = sigmoidf_(v0[1]); v0[2] = sigmoidf_(v0[2]); v0[3] = sigmoidf_(v0[3]);
                                v1[0] = sigmoidf_(v1[0]); v1[1] = sigmoidf_(v1[1]); v1[2] = sigmoidf_(v1[2]); v1[3] = sigmoidf_(v1[3]); }
                    u32x4 w; w.x = pack2(v0[0], v0[1]); w.y = pack2(v0[2], v0[3]); w.z = pack2(v1[0], v1[1]); w.w = pack2(v1[2], v1[3]);
                    *(u32x4*)(dst + (size_t)row * ld + cc) = w;
                }
        }
    }
};
DI void phase_inproj(const Ctx& c, int l) {
    EpiInproj E; E.PM = (bf16_t*)(c.ws + WS_P + P_PM); E.PS = (bf16_t*)(c.ws + WS_P + P_PS); E.PR = (bf16_t*)(c.ws + WS_P + P_PR); E.PD = (bf16_t*)(c.ws + WS_P + P_PD); E.GT = (bf16_t*)(c.ws + WS_GT);
    pg8::Gemm g{(const bf16_t*)(c.ws + WS_BUFA), (const bf16_t*)(c.ws + WS_WSM + OFF_WINT + l * SZ_WINT), NZ, NINP, 1024, 1024, 1024};
    pg8::StaticOrder S; S.init(NZ, NINP, (int)gridDim.x, (int)blockIdx.x, INPROJ_WGM);
    __syncthreads();
    pg8::gemm_phase<EpiInproj, pg8::StaticOrder, false>((PG8_LAS unsigned char*)c.smem, g, S, E, nullptr, c.tid);
}

DI void phase_prep(const Ctx& c, int l) {
    unsigned char* ws = c.ws; const int lane = c.lane, wave = c.wave, tid = c.tid;
    const bf16_t* PM = (const bf16_t*)(ws + WS_P + P_PM); const bf16_t* PR = (const bf16_t*)(ws + WS_P + P_PR); const bf16_t* PD = (const bf16_t*)(ws + WS_P + P_PD);
    bf16_t* CQN = (bf16_t*)(ws + WS_MISC + MS_CQN); bf16_t* TW = (bf16_t*)(ws + WS_MISC + MS_TW); bf16_t* AL = (bf16_t*)(ws + WS_MISC + MS_AL); bf16_t* SG = (bf16_t*)(ws + WS_MISC + MS_SG);
    bf16_t* KM = (bf16_t*)(ws + WS_EXPW + MX_KM); bf16_t* QD = (bf16_t*)(ws + WS_EXPW + MX_QD); bf16_t* KD_ = (bf16_t*)(ws + WS_EXPW + MX_KD); bf16_t* VDT = (bf16_t*)(ws + WS_EXPW + MX_VDT);
    bf16_t* RB = (bf16_t*)(ws + WS_EXPW + MX_RB); bf16_t* KB = (bf16_t*)(ws + WS_EXPW + MX_KB); bf16_t* VB = (bf16_t*)(ws + WS_EXPW + MX_VB); bf16_t* KKB = (bf16_t*)(ws + WS_EXPW + MX_KKB);
    const float* rope = (const float*)(ws + WS_WSM + OFF_ROPE);
    const float* gq = c.in[9] + l * 256; const float* gkv = c.in[10] + l * 128; const float* mu = c.in[13] + l * 1024; const float* k_k = c.in[19] + l * 256;
    bf16_t* Vs = (bf16_t*)c.smem;
    const float qsc = 0.17677669529663687f * LOG2E;
    for (int tile = blockIdx.x; tile < NZ / 16; tile += gridDim.x) {
        __syncthreads();
        struct PrepRow { u32x2 pmq; unsigned pmkv; bf16_t pmr; float2 csm; u32x2 pdq, pdk, pdv; float4 csa, csb; u32x2 cu[4], pv[4], nx[4]; };
        PrepRow R[2];
#pragma unroll
        for (int i = 0; i < 2; ++i) {
            const int rt = wave * 2 + i, z = tile * 16 + rt, s = z % TZ; const bool lat = s >= CTX; const int tl = lat ? s - CTX : 0;
            PrepRow& r = R[i];
            const bf16_t* pm = PM + (size_t)z * 416;
            r.pmq = *(const u32x2*)(pm + lane * 4); r.pmkv = *(const unsigned*)(pm + 256 + lane * 2); r.pmr = pm[384 + (lane & 31)];
            r.csm = *(const float2*)(rope + ((size_t)tl * 16 + ((lane & 31) >> 4) * 8 + (lane & 7)) * 2);
            const bf16_t* pd = PD + (size_t)z * 768; const int i0 = lane * 4, ii = i0 & 31;
            r.pdq = *(const u32x2*)(pd + i0); r.pdk = *(const u32x2*)(pd + 256 + i0); r.pdv = *(const u32x2*)(pd + 512 + i0);
            const float* cs = rope + ((size_t)tl * 16 + (ii >> 4) * 8 + (ii & 7)) * 2;
            r.csa = *(const float4*)cs; r.csb = *(const float4*)(cs + 4);
            const bf16_t* pr = PR + (size_t)z * 1024;
            const bool hp = (s != 0) && (s != CTX), hn = (s != CTX - 1) && (s != TZ - 1);
#pragma unroll
            for (int q = 0; q < 4; ++q) {
                const int col = q * 256 + lane * 4;
                r.cu[q] = *(const u32x2*)(pr + col); r.pv[q] = (u32x2){0u, 0u}; r.nx[q] = (u32x2){0u, 0u};
                if (hp) r.pv[q] = *(const u32x2*)(pr - 1024 + col);
                if (hn) r.nx[q] = *(const u32x2*)(pr + 1024 + col);
            }
        }
#pragma unroll
        for (int i = 0; i < 2; ++i) {
            const int rt = wave * 2 + i, z = tile * 16 + rt, b = z / TZ, s = z % TZ; const bool lat = s >= CTX;
            const PrepRow& r = R[i];
            {
                float x[4]; unpack4(r.pmq, x);
                float ss = wave_sum(x[0] * x[0] + x[1] * x[1] + x[2] * x[2] + x[3] * x[3]);
                float rs = rsqrtf(ss * (1.f / 256.f) + 1e-6f);
                const float4 g = *(const float4*)(gq + lane * 4);
                *(u32x2*)(CQN + (size_t)z * 384 + lane * 4) = pack4(x[0] * rs * g.x, x[1] * rs * g.y, x[2] * rs * g.z, x[3] * rs * g.w);
                const float y0 = lo2f(r.pmkv), y1 = hi2f(r.pmkv);
                ss = wave_sum(y0 * y0 + y1 * y1); rs = rsqrtf(ss * (1.f / 128.f) + 1e-6f);
                const float2 g2 = *(const float2*)(gkv + lane * 2);
                *(unsigned*)(CQN + (size_t)z * 384 + 256 + lane * 2) = pack2(y0 * rs * g2.x, y1 * rs * g2.y);
                float kr = bf2f(r.pmr);
                const float pr = __shfl_xor(kr, 8, 64);
                if (lat) kr = kr * r.csm.x + ((lane & 8) ? pr : -pr) * r.csm.y;
                if (lane < 32) {
                    const bf16_t kv = f2bf(kr);
#pragma unroll
                    for (int h = 0; h < 4; ++h) KM[((size_t)(b * 4 + h) * TZ + s) * 96 + 64 + lane] = kv;
                }
            }
            {
                const int i0 = lane * 4, hh = i0 >> 6, ii = i0 & 31, nn = (i0 >> 5) & 1;
                const float cs[8] = {r.csa.x, r.csa.y, r.csa.z, r.csa.w, r.csb.x, r.csb.y, r.csb.z, r.csb.w};
                const bool hi = (ii & 8) != 0;
#pragma unroll
                for (int w = 0; w < 2; ++w) {
                    float x[4]; unpack4(w == 0 ? r.pdq : r.pdk, x);
                    float o[4];
#pragma unroll
                    for (int j = 0; j < 4; ++j) {
                        const float p = __shfl_xor(x[j], 2, 64);
                        o[j] = lat ? (x[j] * cs[2 * j] + (hi ? p : -p) * cs[2 * j + 1]) : x[j];
                        if (w == 0) o[j] *= qsc;
                    }
                    bf16_t* dst = (w == 0 ? QD : KD_) + ((size_t)(b * 4 + hh) * TZ + s) * 64 + nn * 32 + ii;
                    *(u32x2*)dst = pack4(o[0], o[1], o[2], o[3]);
                }
                *(u32x2*)(Vs + rt * 264 + i0) = r.pdv;
            }
            {
#pragma unroll
                for (int q = 0; q < 4; ++q) {
                    const int col = q * 256 + lane * 4;
                    float cu[4], pv[4], nx[4];
                    unpack4(r.cu[q], cu); unpack4(r.pv[q], pv); unpack4(r.nx[q], nx);
                    const float4 m = *(const float4*)(mu + col);
                    float zv[4];
                    zv[0] = cu[0] + (0.5f * (pv[0] + nx[0]) - cu[0]) * m.x; zv[1] = cu[1] + (0.5f * (pv[1] + nx[1]) - cu[1]) * m.y;
                    zv[2] = cu[2] + (0.5f * (pv[2] + nx[2]) - cu[2]) * m.z; zv[3] = cu[3] + (0.5f * (pv[3] + nx[3]) - cu[3]) * m.w;
                    if (q == 0) *(u32x2*)(RB + (size_t)z * 256 + lane * 4) = pack4(zv[0], zv[1], zv[2], zv[3]);
                    else if (q == 1) {
                        *(u32x2*)(KB + (size_t)z * 256 + lane * 4) = pack4(zv[0], zv[1], zv[2], zv[3]);
                        const float4 kk4 = *(const float4*)(k_k + lane * 4);
                        const float a0 = zv[0] * kk4.x, a1 = zv[1] * kk4.y, a2 = zv[2] * kk4.z, a3 = zv[3] * kk4.w;
                        const float ssq = sum16(a0 * a0 + a1 * a1 + a2 * a2 + a3 * a3);
                        const float inv = 1.f / fmaxf(sqrtf(ssq), 1e-12f);
                        *(u32x2*)(KKB + (size_t)z * 256 + lane * 4) = pack4(a0 * inv, a1 * inv, a2 * inv, a3 * inv);
                    } else if (q == 2) *(u32x2*)(VB + (size_t)z * 256 + lane * 4) = pack4(zv[0], zv[1], zv[2], zv[3]);
                    else {
                        if (lane < 16) *(u32x2*)(TW + (size_t)z * 64 + lane * 4) = pack4(tanhf_(zv[0]), tanhf_(zv[1]), tanhf_(zv[2]), tanhf_(zv[3]));
                        else if (lane < 32) *(u32x2*)(AL + (size_t)z * 64 + (lane - 16) * 4) = pack4(zv[0], zv[1], zv[2], zv[3]);
                        else *(u32x2*)(SG + (size_t)z * 128 + (lane - 32) * 4) = pack4(sigmoidf_(zv[0]), sigmoidf_(zv[1]), sigmoidf_(zv[2]), sigmoidf_(zv[3]));
                    }
                }
            }
        }
        __syncthreads();
        {
            const int z0 = tile * 16, b = z0 / TZ, s0 = z0 % TZ;
#pragma unroll
            for (int i = 0; i < 1; ++i) {
                const int ch = tid, dv = ch >> 1, r8 = (ch & 1) * 8;
                bf16_t v[8];
#pragma unroll
                for (int j = 0; j < 8; ++j) v[j] = Vs[(r8 + j) * 264 + dv];
                u32x4 o; o.x = v[0] | ((unsigned)v[1] << 16); o.y = v[2] | ((unsigned)v[3] << 16); o.z = v[4] | ((unsigned)v[5] << 16); o.w = v[6] | ((unsigned)v[7] << 16);
                *(u32x4*)(VDT + ((size_t)(b * 4 + (dv >> 6)) * 64 + (dv & 63)) * TZ + s0 + r8) = o;
            }
        }
    }
}

constexpr int S5C = 64, S5N = TZ / S5C, S5NC = CTX / S5C;
DI int s5_tok(int dir, int i) { return dir == 0 ? i : (i < CTX ? CTX - 1 - i : TZ - 1 - (i - CTX)); }
DI void s5_stage_u(const Ctx& c, float* U, int b, int dir, int chunk, int g0, int ng) {
    const bf16_t* PS = (const bf16_t*)(c.ws + WS_P + P_PS);
    const int per = ng * 4;
    for (int e = c.tid; e < S5C * per; e += NTHR) {
        const int i = e / per, c4 = (e % per) * 4, s = s5_tok(dir, chunk * S5C + i);
        float x[4]; unpack4(*(const u32x2*)(PS + (size_t)(b * TZ + s) * 256 + g0 * 16 + c4), x);
        *(float4*)(U + i * (ng * 16) + c4) = make_float4(x[0], x[1], x[2], x[3]);
    }
}
DI void phase_s5_local(const Ctx& c, int l) {
    float* U = (float*)c.smem;
    const float* s5t = (const float*)(c.ws + WS_WSM + OFF_S5T);
    float* E = (float*)(c.ws + WS_WSM + OFF_S5E);
    for (int u = blockIdx.x; u < 2 * 2 * S5N * 2; u += gridDim.x) {
        const int gq = u & 1, chunk = (u >> 1) % S5N, dir = (u / (2 * S5N)) & 1, b = u / (4 * S5N);
        __syncthreads();
        s5_stage_u(c, U, b, dir, chunk, gq * 8, 8);
        __syncthreads();
        const int g = gq * 8 + c.wave, p = c.lane;
        const float* tb = s5t + ((size_t)((l * 2 + dir) * 16 + g) * 64 + p) * 36;
        const float are = tb[0], aim = tb[1];
        float br[16], bi[16];
#pragma unroll
        for (int ch = 0; ch < 16; ++ch) { br[ch] = tb[4 + ch]; bi[ch] = tb[20 + ch]; }
        float xr = 0.f, xi = 0.f;
        for (int i = 0; i < S5C; ++i) {
            const float* uu = U + i * 128 + c.wave * 16;
            float sr = 0.f, si = 0.f;
#pragma unroll
            for (int q = 0; q < 4; ++q) { const float4 v = *(const float4*)(uu + q * 4);
                sr += br[q * 4] * v.x + br[q * 4 + 1] * v.y + br[q * 4 + 2] * v.z + br[q * 4 + 3] * v.w;
                si += bi[q * 4] * v.x + bi[q * 4 + 1] * v.y + bi[q * 4 + 2] * v.z + bi[q * 4 + 3] * v.w; }
            const float nr = are * xr - aim * xi + sr, ni = are * xi + aim * xr + si; xr = nr; xi = ni;
        }
        *(float2*)(E + ((size_t)(((b * 2 + dir) * 16 + g) * S5N + chunk) * 64 + p) * 2) = make_float2(xr, xi);
    }
}
DI void phase_s5_carry(const Ctx& c, int l) {
    const int gt = blockIdx.x * NTHR + c.tid;
    if (gt < 2 * 2 * 16 * 64) {
        const int p = gt & 63, g = (gt >> 6) & 15, dir = (gt >> 10) & 1, b = gt >> 11;
        const float* tb = (const float*)(c.ws + WS_WSM + OFF_S5T) + ((size_t)((l * 2 + dir) * 16 + g) * 64 + p) * 36;
        const float ar = tb[2], ai = tb[3];
        const float* E = (const float*)(c.ws + WS_WSM + OFF_S5E) + (size_t)(((b * 2 + dir) * 16 + g) * S5N) * 128;
        float* C = (float*)(c.ws + WS_WSM + OFF_S5C) + (size_t)(((b * 2 + dir) * 16 + g) * S5N) * 128;
        float xr = 0.f, xi = 0.f;
        for (int ch = 0; ch < S5N; ++ch) {
            const float2 e = *(const float2*)(E + ch * 128 + p * 2);
            *(float2*)(C + ch * 128 + p * 2) = make_float2(xr, xi);
            const float nr = ar * xr - ai * xi + e.x, ni = ar * xi + ai * xr + e.y; xr = nr; xi = ni;
        }
    }
}

constexpr int S5_US = 0, S5_YS = 8192, S5_WV = S5_YS + 2 * 64 * 64 * 4;
template <bool LOCAL>
DI void phase_s5_final_unit(const Ctx& c, int l, int u) {
    unsigned char* L = c.smem;
    const float* s5t = (const float*)(c.ws + WS_WSM + OFF_S5T);
    const float* CIN = (const float*)(c.ws + WS_WSM + OFF_S5C);
    const bf16_t* PS = (const bf16_t*)(c.ws + WS_P + P_PS);
    const int gq = u & 3, ct = (u >> 2) % S5N, b = u / (4 * S5N);
    const int wave = c.wave, lane = c.lane, gl = wave >> 1, dir = wave & 1, g = gq * 4 + gl, n16 = lane & 15, q4 = lane >> 4;
    __syncthreads();
    {
        const int t = c.tid >> 3, part = c.tid & 7;
        *(u32x4*)(L + S5_US + t * 128 + part * 16) = *(const u32x4*)(PS + (size_t)(b * TZ + ct * S5C + t) * 256 + gq * 64 + part * 8);
    }
    typedef short s16x4 __attribute__((ext_vector_type(4)));
    const float* tbase = s5t + ((size_t)((l * 2 + dir) * 16 + g) * 64) * 36;
    s16x4 bfr[8], cfr[8];
#pragma unroll
    for (int j = 0; j < 8; ++j) {
        const int pp = 16 * j + n16, p = pp & 63; const float* tb = tbase + (size_t)p * 36 + (pp < 64 ? 4 : 20) + 4 * q4;
        u32x2 w2; w2.x = pack2(tb[0], tb[1]); w2.y = pack2(tb[2], tb[3]);
        bfr[j] = __builtin_bit_cast(s16x4, w2);
    }
    {
        const float* cre = c.in[29] + ((size_t)((l * 2 + dir) * 16 + g) * 16 + n16) * 64; const float* cim = c.in[30] + ((size_t)((l * 2 + dir) * 16 + g) * 16 + n16) * 64;
#pragma unroll
        for (int s = 0; s < 8; ++s) {
            const int pp = 16 * s + 4 * q4; const float sg = pp < 64 ? 1.f : -1.f; const float* src = (pp < 64 ? cre + pp : cim + (pp - 64));
            u32x2 w2; w2.x = pack2(sg * src[0], sg * src[1]); w2.y = pack2(sg * src[2], sg * src[3]);
            cfr[s] = __builtin_bit_cast(s16x4, w2);
        }
    }
    const float are = tbase[(size_t)lane * 36], aim = tbase[(size_t)lane * 36 + 1];
    const int cd = dir == 0 ? ct : (ct < S5NC ? S5NC - 1 - ct : S5N + S5NC - 1 - ct);
    float xr = 0.f, xi = 0.f;
    if (!LOCAL) { const float2 ci = *(const float2*)(CIN + ((size_t)(((b * 2 + dir) * 16 + g) * S5N + cd) * 64 + lane) * 2); xr = ci.x; xi = ci.y; }
    const float dsk = c.in[31][(size_t)l * 256 + g * 16 + n16];
    bf16_t* BU = (bf16_t*)(L + S5_WV + wave * 8192); bf16_t* XB = BU + 16 * 128;
    float* YS = (float*)(L + S5_YS) + dir * 64 * 64;
    __syncthreads();
#pragma unroll 1
    for (int sb = 0; sb < 4; ++sb) {
        const int stepA = 16 * sb + n16, tlA = dir == 0 ? stepA : 63 - stepA;
        const s16x4 af = __builtin_bit_cast(s16x4, *(const u32x2*)(L + S5_US + tlA * 128 + gl * 32 + q4 * 8));
#pragma unroll
        for (int j = 0; j < 8; ++j) {
            f32x4 acc = {0.f, 0.f, 0.f, 0.f};
            acc = __builtin_amdgcn_mfma_f32_16x16x16bf16_1k(af, bfr[j], acc, 0, 0, 0);
#pragma unroll
            for (int rr = 0; rr < 4; ++rr) BU[(4 * q4 + rr) * 128 + 16 * j + n16] = f2bf(acc[rr]);
        }
        __builtin_amdgcn_wave_barrier();
#pragma unroll
        for (int ii = 0; ii < 16; ++ii) {
            const float br = bf2f(BU[ii * 128 + lane]), bi = bf2f(BU[ii * 128 + 64 + lane]);
            const float nr = are * xr - aim * xi + br, ni = are * xi + aim * xr + bi; xr = nr; xi = ni;
            if (!LOCAL) { XB[ii * 128 + lane] = f2bf(xr); XB[ii * 128 + 64 + lane] = f2bf(xi); }
        }
        __builtin_amdgcn_wave_barrier();
        if (LOCAL) continue;
        f32x4 ya = {0.f, 0.f, 0.f, 0.f};
#pragma unroll
        for (int s = 0; s < 8; ++s) {
            const s16x4 xf = __builtin_bit_cast(s16x4, *(const u32x2*)((const unsigned char*)XB + n16 * 256 + (16 * s + 4 * q4) * 2));
            ya = __builtin_amdgcn_mfma_f32_16x16x16bf16_1k(xf, cfr[s], ya, 0, 0, 0);
        }
#pragma unroll
        for (int rr = 0; rr < 4; ++rr) {
            const int step = 16 * sb + 4 * q4 + rr, tl = dir == 0 ? step : 63 - step;
            float y = ya[rr];
            if (dir == 0) y += dsk * bf2f(*(const bf16_t*)(L + S5_US + tl * 128 + (gl * 16 + n16) * 2));
            YS[tl * 64 + gl * 16 + n16] = y;
        }
    }
    if (LOCAL) { *(float2*)((float*)(c.ws + WS_WSM + OFF_S5E) + ((size_t)(((b * 2 + dir) * 16 + g) * S5N + cd) * 64 + lane) * 2) = make_float2(xr, xi); return; }
    __syncthreads();
    bf16_t* ZG = (bf16_t*)(c.ws + WS_MISC + MS_ZG);
    {
        const float* Y0 = (const float*)(L + S5_YS); const float* Y1 = Y0 + 64 * 64;
        for (int e = c.tid; e < 64 * 16; e += NTHR) {
            const int i = e >> 4, c4 = (e & 15) * 4; const float4 y0 = *(const float4*)(Y0 + i * 64 + c4), y1 = *(const float4*)(Y1 + i * 64 + c4);
            *(u32x2*)(ZG + (size_t)(b * TZ + ct * S5C + i) * 256 + gq * 64 + c4) = pack4(gelu_tanh(y0.x + y1.x), gelu_tanh(y0.y + y1.y), gelu_tanh(y0.z + y1.z), gelu_tanh(y0.w + y1.w));
        }
    }
}

DI void phase_small_gemms(const Ctx& c, int l) {
    unsigned char* ws = c.ws; unsigned char* wsm = ws + WS_WSM;
    const bf16_t* CQN = (const bf16_t*)(ws + WS_MISC + MS_CQN);
    const float* rope = (const float*)(wsm + OFF_ROPE);
    constexpr int NMT = NZ / 256;
    int base = 0;
    const int G = gridDim.x, bid = blockIdx.x;
    {
        const bf16_t* W = (const bf16_t*)(wsm + OFF_WUQT + l * SZ_WUQT); bf16_t* QM = (bf16_t*)(ws + WS_EXPW + MX_QM);
        const float qs = 0.10206207261596577f * LOG2E;
        for (int u = (bid + G - base % G) % G; u < NMT * 3; u += G) {
            const int mt = u / 3, nt = u % 3, r0 = mt * 256, c0 = nt * 128;
            gemm_tile<4, 0>(c, 256, [&](int i) { return CQN + (size_t)(r0 + i) * 384; }, [&](int i) { return W + (size_t)(c0 + i) * 256; }, NoHook(),
                [&](f32x4 (&acc)[4][4], int wr, int wc, int fr, int fq) {
#pragma unroll
                    for (int n = 0; n < 4; ++n) {
                        const int col = c0 + wc + n * 16 + fq * 4, h = col / 96, d = col % 96;
                        const bool rp = d >= 64;
#pragma unroll
                        for (int m = 0; m < 4; ++m) {
                            const int row = r0 + wr + m * 16 + fr, b = row / TZ, s = row % TZ; f32x4 v = acc[m][n];
                            f32x4 pv; pv[0] = __shfl_xor(v[0], 32, 64); pv[1] = __shfl_xor(v[1], 32, 64); pv[2] = __shfl_xor(v[2], 32, 64); pv[3] = __shfl_xor(v[3], 32, 64);
                            if (rp && s >= CTX) {
                                const int i0 = d - 64;
                                const float* cs = rope + ((size_t)(s - CTX) * 16 + (i0 >> 4) * 8 + (i0 & 7)) * 2;
                                const bool hi = (i0 & 8) != 0;
#pragma unroll
                                for (int j = 0; j < 4; ++j) v[j] = v[j] * cs[2 * j] + (hi ? pv[j] : -pv[j]) * cs[2 * j + 1];
                            }
                            *(u32x2*)(QM + ((size_t)(b * 4 + h) * TZ + s) * 96 + d) = pack4(v[0] * qs, v[1] * qs, v[2] * qs, v[3] * qs);
                        }
                    }
                });
        }
        base += NMT * 3;
    }
    {
        const bf16_t* W = (const bf16_t*)(wsm + OFF_WUKVT + l * SZ_WUKVT); bf16_t* KM = (bf16_t*)(ws + WS_EXPW + MX_KM); bf16_t* VMT = (bf16_t*)(ws + WS_EXPW + MX_VMT);
        for (int u = (bid + G - base % G) % G; u < NMT * 4; u += G) {
            const int mt = u / 4, nt = u % 4, r0 = mt * 256, c0 = nt * 128;
            gemm_tile<4, 0>(c, 128, [&](int i) { return CQN + (size_t)(r0 + i) * 384 + 256; }, [&](int i) { return W + (size_t)(c0 + i) * 128; }, NoHook(),
                [&](f32x4 (&acc)[4][4], int wr, int wc, int fr, int fq) {
#pragma unroll
                    for (int n = 0; n < 4; ++n) {
                        const int col = c0 + wc + n * 16 + fq * 4, h = col >> 7, d = col & 127;
#pragma unroll
                        for (int m = 0; m < 4; ++m) {
                            const int row = r0 + wr + m * 16 + fr, b = row / TZ, s = row % TZ; const f32x4 v = acc[m][n];
                            if (d < 64) *(u32x2*)(KM + ((size_t)(b * 4 + h) * TZ + s) * 96 + d) = pack4(v[0], v[1], v[2], v[3]);
                            else {
#pragma unroll
                                for (int j = 0; j < 4; ++j) VMT[((size_t)(b * 4 + h) * 64 + (d - 64 + j)) * TZ + s] = f2bf(v[j]);
                            }
                        }
                    }
                });
        }
        base += NMT * 4;
    }
    bf16_t* SE = (bf16_t*)(ws + WS_P + P_PR); bf16_t* SAD = SE + (size_t)2 * NZ * 256; bf16_t* SKD = SAD + (size_t)2 * NZ * 256;
    {
        const bf16_t* A = (const bf16_t*)(ws + WS_MISC + MS_TW); const bf16_t* W = (const bf16_t*)(wsm + OFF_W2T + l * SZ_W2T);
        const float* w0 = c.in[14] + (size_t)l * 512;
        for (int u = (bid + G - base % G) % G; u < NMT * 4; u += G) {
            const int mt = u / 4, nt = u % 4, r0 = mt * 256, c0 = nt * 128;
            gemm_tile<4, 0>(c, 64, [&](int i) { return A + (size_t)(r0 + i) * 64; }, [&](int i) { return W + (size_t)(c0 + i) * 64; }, NoHook(),
                [&](f32x4 (&acc)[4][4], int wr, int wc, int fr, int fq) {
#pragma unroll
                    for (int n = 0; n < 4; ++n) {
                        const int col = c0 + wc + n * 16 + fq * 4, d = col >> 8, cc = col & 255; const float4 w0v = *(const float4*)(w0 + col);
#pragma unroll
                        for (int m = 0; m < 4; ++m) {
                            const int row = r0 + wr + m * 16 + fr; const f32x4 v = acc[m][n]; float e[4];
                            const float x[4] = {w0v.x + v[0], w0v.y + v[1], w0v.z + v[2], w0v.w + v[3]};
#pragma unroll
                            for (int j = 0; j < 4; ++j) e[j] = 0.6065306597126334f * sigmoidf_(x[j]);
                            *(u32x2*)(SE + ((size_t)d * NZ + row) * 256 + cc) = pack4(e[0], e[1], e[2], e[3]);
                        }
                    }
                });
        }
        base += NMT * 4;
    }
    {
        const bf16_t* A = (const bf16_t*)(ws + WS_MISC + MS_AL); const bf16_t* W = (const bf16_t*)(wsm + OFF_A2T + l * SZ_A2T);
        const float* a0 = c.in[16] + (size_t)l * 512; const float* k_a = c.in[20] + (size_t)l * 256; const bf16_t* KB = (const bf16_t*)(ws + WS_EXPW + MX_KB);
        for (int u = (bid + G - base % G) % G; u < NMT * 4; u += G) {
            const int mt = u / 4, nt = u % 4, r0 = mt * 256, c0 = nt * 128;
            gemm_tile<4, 0>(c, 64, [&](int i) { return A + (size_t)(r0 + i) * 64; }, [&](int i) { return W + (size_t)(c0 + i) * 64; }, NoHook(),
                [&](f32x4 (&acc)[4][4], int wr, int wc, int fr, int fq) {
#pragma unroll
                    for (int n = 0; n < 4; ++n) {
                        const int col = c0 + wc + n * 16 + fq * 4, d = col >> 8, cc = col & 255; const float4 a0v = *(const float4*)(a0 + col), kav = *(const float4*)(k_a + cc);
#pragma unroll
                        for (int m = 0; m < 4; ++m) {
                            const int row = r0 + wr + m * 16 + fr; const f32x4 v = acc[m][n];
                            const float ad0 = sigmoidf_(a0v.x + v[0]), ad1 = sigmoidf_(a0v.y + v[1]), ad2 = sigmoidf_(a0v.z + v[2]), ad3 = sigmoidf_(a0v.w + v[3]);
                            float k[4]; unpack4(*(const u32x2*)(KB + (size_t)row * 256 + cc), k);
                            *(u32x2*)(SAD + ((size_t)d * NZ + row) * 256 + cc) = pack4(ad0, ad1, ad2, ad3);
                            *(u32x2*)(SKD + ((size_t)d * NZ + row) * 256 + cc) = pack4(k[0] * (1.f + (ad0 - 1.f) * kav.x), k[1] * (1.f + (ad1 - 1.f) * kav.y), k[2] * (1.f + (ad2 - 1.f) * kav.z), k[3] * (1.f + (ad3 - 1.f) * kav.w));
                        }
                    }
                });
        }
        base += NMT * 4;
    }
    {
        const bf16_t* A = (const bf16_t*)(ws + WS_MISC + MS_SG); const bf16_t* W = (const bf16_t*)(wsm + OFF_G2T + l * SZ_G2T); bf16_t* GG = (bf16_t*)(ws + WS_MISC + MS_GG);
        for (int u = (bid + G - base % G) % G; u < NMT * 2; u += G) {
            const int mt = u / 2, nt = u % 2, r0 = mt * 256, c0 = nt * 128;
            gemm_tile<4, 0>(c, 128, [&](int i) { return A + (size_t)(r0 + i) * 128; }, [&](int i) { return W + (size_t)(c0 + i) * 128; }, NoHook(),
                [&](f32x4 (&acc)[4][4], int wr, int wc, int fr, int fq) {
#pragma unroll
                    for (int n = 0; n < 4; ++n)
#pragma unroll
                        for (int m = 0; m < 4; ++m) { const f32x4 v = acc[m][n];
                            *(u32x2*)(GG + (size_t)(r0 + wr + m * 16 + fr) * 256 + c0 + wc + n * 16 + fq * 4) = pack4(v[0], v[1], v[2], v[3]); }
                });
        }
        base += NMT * 2;
    }
}

DI int krow(int s, int h, int j) { return 16 * s + 8 * (j >> 2) + 4 * h + (j & 3); }
#ifndef ATT_THR
#define ATT_THR 64.f
#endif
constexpr int ATT_PARK = 56 * 1024;
template <int MODE>
DI void attn_pass(const Ctx& c, int l, int b, int h, int q0, int nkeys) {
    constexpr int DROW = MODE == 0 ? 96 : 64;
    constexpr int DQ = MODE == 0 ? 96 : 32, KS = DQ / 16;
    constexpr int DOFF = MODE == 2 ? 32 : 0;
    constexpr int TK = 128;
    constexpr int KPITCH = DQ * 2 + 16;
    constexpr int VPITCH = TK * 2 + 16;
    constexpr int KBYTES = TK * KPITCH, VBYTES = 64 * VPITCH, STG = KBYTES + VBYTES;
    static_assert(MODE == 0 || 2 * STG <= ATT_PARK, "the staging buffers must stay below the parked o1");
    unsigned char* ws = c.ws; int tid_ = c.tid; asm volatile("" : "+v"(tid_));
    const int tid = tid_, lane = tid & 63, wave = __builtin_amdgcn_readfirstlane(tid >> 6), r = lane & 31, hh = lane >> 5;
    const bf16_t* Q = (const bf16_t*)(ws + WS_EXPW + (MODE == 0 ? MX_QM : MX_QD)) + (size_t)(b * 4 + h) * TZ * DROW + DOFF;
    const bf16_t* Kp = (const bf16_t*)(ws + WS_EXPW + (MODE == 0 ? MX_KM : MX_KD)) + (size_t)(b * 4 + h) * TZ * DROW + DOFF;
    const bf16_t* Vt = (const bf16_t*)(ws + WS_EXPW + (MODE == 0 ? MX_VMT : MX_VDT)) + (size_t)(b * 4 + h) * 64 * TZ;
    unsigned char* smem = c.smem;
    bf16x8 qf[KS];
    const int qrow = q0 + wave * 32 + r;
#pragma unroll
    for (int ks = 0; ks < KS; ++ks) qf[ks] = *(const bf16x8*)(Q + (size_t)qrow * DROW + ks * 16 + hh * 8);
    f32x16 oacc[2];
    float mref = 0.f, lrun = 0.f;
#pragma unroll
    for (int t = 0; t < 2; ++t)
#pragma unroll
        for (int i = 0; i < 16; ++i) oacc[t][i] = 0.f;
    constexpr int CPR = DQ / 8, KCH = TK * CPR, NKR = KCH / NTHR;
    static_assert(KCH % NTHR == 0, "whole staging rounds");
    u32x4 kreg[NKR], vreg[2];
    const bf16_t* kp[NKR]; int koff[NKR];
#pragma unroll
    for (int i = 0; i < NKR; ++i) { const int ch = tid + i * NTHR; kp[i] = Kp + ((long)(ch / CPR) - 64) * DROW + (ch % CPR) * 8; koff[i] = (ch / CPR) * KPITCH + (ch % CPR) * 16; }
    const bf16_t* vp = Vt + (size_t)(tid >> 4) * TZ + (tid & 15) * 8 - 64;
    const int voff = (tid >> 4) * VPITCH + (tid & 15) * 16;
    auto gloadK = [&]() {
#pragma unroll
        for (int i = 0; i < NKR; ++i) { kreg[i] = *(const u32x4*)kp[i]; kp[i] += TK * DROW; }
    };
    auto gloadV = [&]() { vreg[0] = *(const u32x4*)vp; vreg[1] = *(const u32x4*)(vp + (size_t)32 * TZ); vp += TK; };
    auto lstoreK = [&](int buf) {
        unsigned char* sk = smem + buf * STG;
#pragma unroll
        for (int i = 0; i < NKR; ++i) *(u32x4*)(sk + koff[i]) = kreg[i];
    };
    auto lstoreV = [&](int buf) { unsigned char* sv = smem + buf * STG + KBYTES; *(u32x4*)(sv + voff) = vreg[0]; *(u32x4*)(sv + voff + 32 * VPITCH) = vreg[1]; };
    const int kbase = r * KPITCH + hh * 16, vbase = KBYTES + r * VPITCH + hh * 8;
    auto ldfrag = [&](const unsigned char* kb, const unsigned char* vb, int ci) -> u32x4 {
        if (ci < 8) {
            const int kg = ci >> 2, s = (ci >> 1) & 1, t = ci & 1;
            const unsigned char* vrow = vb + t * 32 * VPITCH + (kg * 32 + 16 * s) * 2;
            const u32x2 lo = *(const u32x2*)vrow, hi2 = *(const u32x2*)(vrow + 16);
            u32x4 vv; vv.x = lo.x; vv.y = lo.y; vv.z = hi2.x; vv.w = hi2.y; return vv;
        }
        const int q = ci - 8, kg = q & 1, ks = q >> 1;
        return *(const u32x4*)(kb + kg * 32 * KPITCH + ks * 32);
    };
    constexpr int NM = 8 + 2 * KS;
    const f32x16 zero16 = {0.f, 0.f, 0.f, 0.f, 0.f, 0.f, 0.f, 0.f, 0.f, 0.f, 0.f, 0.f, 0.f, 0.f, 0.f, 0.f};
    auto pv_all = [&](const u32x4 (&P)[4], const unsigned char* vb) {
#pragma unroll
        for (int ci = 0; ci < 8; ++ci) { const u32x4 f = ldfrag(vb, vb, ci); oacc[ci & 1] = __builtin_amdgcn_mfma_f32_32x32x16_bf16(__builtin_bit_cast(bf16x8, f), __builtin_bit_cast(bf16x8, P[ci >> 1]), oacc[ci & 1], 0, 0, 0); }
    };
    auto iter = [&](f32x16 (&Sc)[2], f32x16 (&Sn)[2], u32x4 (&Pp)[4], u32x4 (&Pn)[4], const unsigned char* kb, const unsigned char* vb, bool first) {
        u32x4 fcur = ldfrag(kb, vb, 0), fnx1 = ldfrag(kb, vb, 1);
        if (__any(mref != 0.f)) {
#pragma unroll
            for (int kg = 0; kg < 2; ++kg)
#pragma unroll
                for (int i = 0; i < 16; ++i) Sc[kg][i] -= mref;
        }
        f32x2 ps = {0.f, 0.f};
        __builtin_amdgcn_sched_barrier(0);
#pragma unroll
        for (int ci = 0; ci < NM; ++ci) {
            u32x4 fnx2 = fnx1;
            if (ci + 2 < NM) fnx2 = ldfrag(kb, vb, ci + 2);
            if (ci < 8) oacc[ci & 1] = __builtin_amdgcn_mfma_f32_32x32x16_bf16(__builtin_bit_cast(bf16x8, fcur), __builtin_bit_cast(bf16x8, Pp[ci >> 1]), oacc[ci & 1], 0, 0, 0);
            else { const int q = ci - 8, kg = q & 1, ks = q >> 1; Sn[kg] = __builtin_amdgcn_mfma_f32_32x32x16_bf16(__builtin_bit_cast(bf16x8, fcur), qf[ks], ks == 0 ? zero16 : Sn[kg], 0, 0, 0); }
#pragma unroll
            for (int p = (ci * 16) / NM; p < ((ci + 1) * 16) / NM; ++p) {
                const int kg = p >> 3, q = p & 7;
                const float p0 = __builtin_amdgcn_exp2f(Sc[kg][2 * q]), p1 = __builtin_amdgcn_exp2f(Sc[kg][2 * q + 1]);
                ps += (f32x2){p0, p1};
                unsigned pk = pack2(p0, p1); asm volatile("" : "+v"(pk));
                Pn[kg * 2 + (q >> 2)][q & 3] = pk;
            }
            asm volatile("" : "+v"(ps));
            fcur = fnx1; fnx1 = fnx2;
            __builtin_amdgcn_sched_barrier(0);
        }
        const float pst = ps.x + ps.y;
        const bool bad = !(pst < 0x1p90f) || (first && pst < 0x1p-20f);
        if (__any(bad)) {
            float mx = Sc[0][0];
#pragma unroll
            for (int kg = 0; kg < 2; ++kg)
#pragma unroll
                for (int i = 0; i < 16; ++i) mx = fmaxf(mx, Sc[kg][i]);
            mx = fmaxf(mx, __shfl_xor(mx, 32, 64));
            const bool need = (mx > ATT_THR) || (first && mx < -32.f);
            const float d = need ? mx : 0.f;
            const float alpha = first ? 1.f : __builtin_amdgcn_exp2f(-d);
            mref += d; lrun *= alpha;
#pragma unroll
            for (int t = 0; t < 2; ++t)
#pragma unroll
                for (int i = 0; i < 16; ++i) oacc[t][i] *= alpha;
            ps = (f32x2){0.f, 0.f};
#pragma unroll
            for (int pq = 0; pq < 16; ++pq) {
                const int kg = pq >> 3, q = pq & 7;
                const float p0 = __builtin_amdgcn_exp2f(Sc[kg][2 * q] - d), p1 = __builtin_amdgcn_exp2f(Sc[kg][2 * q + 1] - d);
                ps += (f32x2){p0, p1};
                Pn[kg * 2 + (q >> 2)][q & 3] = pack2(p0, p1);
            }
        }
        lrun += ps.x + ps.y;
    };
    const int NT = nkeys / TK;
    f32x16 S0[2], S1[2]; u32x4 PA[4], PB[4];
#pragma unroll
    for (int q = 0; q < 4; ++q) PA[q] = (u32x4){0u, 0u, 0u, 0u};
    __syncthreads();
    gloadK();
    lstoreK(1);
    gloadK();
    if ((tid & 15) >= 8) gloadV(); else { vreg[0] = (u32x4){0u, 0u, 0u, 0u}; vreg[1] = vreg[0]; vp += TK; }
    __syncthreads();
    {
        const unsigned char* kb = smem + STG + 64 * KPITCH + kbase;
#pragma unroll
        for (int q = 0; q < 2 * KS; ++q) { const int kg = q & 1, ks = q >> 1; const u32x4 f = ldfrag(kb, kb, 8 + q); S0[kg] = __builtin_amdgcn_mfma_f32_32x32x16_bf16(__builtin_bit_cast(bf16x8, f), qf[ks], ks == 0 ? zero16 : S0[kg], 0, 0, 0); }
    }
    for (int s = 0; s < NT; ++s) {
        lstoreK(s & 1); lstoreV(s & 1);
        if (s + 1 < NT) gloadK();
        gloadV();
        __syncthreads();
        const unsigned char* sb = smem + (s & 1) * STG;
        iter(S0, S1, PA, PB, sb + kbase, sb + vbase, s == 0);
        iter(S1, S0, PB, PA, sb + 64 * KPITCH + kbase, sb + 128 + vbase, false);
    }
    lstoreV(NT & 1);
    __syncthreads();
    pv_all(PA, smem + (NT & 1) * STG + vbase);
    const float inv = 1.f / (lrun + __shfl_xor(lrun, 32, 64));
    bf16_t* Ycat = (bf16_t*)(ws + WS_BUFA);
    const int zrow = b * TZ + qrow;
    float* park = (float*)(smem + ATT_PARK) + tid;
    if (MODE == 0) {
#pragma unroll
        for (int t = 0; t < 2; ++t)
#pragma unroll
            for (int i4 = 0; i4 < 4; ++i4) {
                const int dv = t * 32 + 8 * i4 + 4 * hh;
                *(u32x2*)(Ycat + (size_t)zrow * D + h * 64 + dv) = pack4(oacc[t][4 * i4] * inv, oacc[t][4 * i4 + 1] * inv, oacc[t][4 * i4 + 2] * inv, oacc[t][4 * i4 + 3] * inv);
            }
    } else if (MODE == 1) {
#pragma unroll
        for (int t = 0; t < 2; ++t)
#pragma unroll
            for (int i = 0; i < 16; ++i) park[(t * 16 + i) * NTHR] = oacc[t][i] * inv;
    } else {
        const float lam = ((const float*)(ws + WS_WSM + OFF_LAM))[l];
        const float lam_init = 0.8f - 0.6f * __expf(-0.3f * (float)l);
        float ss = 0.f;
#pragma unroll
        for (int t = 0; t < 2; ++t)
#pragma unroll
            for (int i = 0; i < 16; ++i) { const float o = park[(t * 16 + i) * NTHR] - lam * oacc[t][i] * inv; oacc[t][i] = o; ss += o * o; }
        ss += __shfl_xor(ss, 32, 64);
        const float rs = rsqrtf(ss * (1.f / 64.f) + 1e-5f) * (1.f - lam_init);
        const float* sg = c.in[38] + l * 64;
#pragma unroll
        for (int t = 0; t < 2; ++t)
#pragma unroll
            for (int i4 = 0; i4 < 4; ++i4) {
                const int dv = t * 32 + 8 * i4 + 4 * hh; const float4 g = *(const float4*)(sg + dv);
                *(u32x2*)(Ycat + (size_t)zrow * D + 768 + h * 64 + dv) = pack4(oacc[t][4 * i4] * rs * g.x, oacc[t][4 * i4 + 1] * rs * g.y, oacc[t][4 * i4 + 2] * rs * g.z, oacc[t][4 * i4 + 3] * rs * g.w);
            }
    }
}
DI void phase_attention(const Ctx& c, int l) {
    const int nu = 512 + (l == 0 ? 16 : 0);
    for (int u = blockIdx.x; u < nu; u += gridDim.x) {
        int b, h, q0, nk; bool mla;
        if (u < 512) { const int k = u & 255, bh = k & 7; b = bh >> 2; h = bh & 3; q0 = CTX + (k >> 3) * 256; nk = TZ; mla = u < 256; }
        else { const int k = u - 512; b = (k >> 2) & 1; h = k & 3; q0 = 0; nk = CTX; mla = k < 8; }
        if (mla) attn_pass<0>(c, l, b, h, q0, nk);
        else { attn_pass<1>(c, l, b, h, q0, nk); attn_pass<2>(c, l, b, h, q0, nk); }
    }
}

DI int rw_tok(int dir, int i) { return dir == 0 ? i : (i < CTX ? CTX - 1 - i : TZ - 1 - (i - CTX)); }
constexpr int RW_TS = 32;
constexpr int RW_STEP_F = 6 * 64 + 2;
constexpr int RW_BUF_F = RW_TS * RW_STEP_F;
template <int CTRL> DI float dpp_add(float x) { return x + __int_as_float(__builtin_amdgcn_update_dpp(0, __float_as_int(x), CTRL, 0xf, 0xf, false)); }
DI float red16(float x) { x = dpp_add<0xB1>(x); x = dpp_add<0x4E>(x); x = dpp_add<0x141>(x); x = dpp_add<0x140>(x); return x; }
DI float red8(float x) { x = dpp_add<0xB1>(x); x = dpp_add<0x4E>(x); x = dpp_add<0x141>(x); return x; }
struct RwRegs { u32x4 r, v, kk, e, ad, kd; };
DI void rw_load(const Ctx& c, int b, int h, int dir, int chunk, int t, RwRegs& g) {
    const bf16_t* RB = (const bf16_t*)(c.ws + WS_EXPW + MX_RB); const bf16_t* VB = (const bf16_t*)(c.ws + WS_EXPW + MX_VB); const bf16_t* KKB = (const bf16_t*)(c.ws + WS_EXPW + MX_KKB);
    const bf16_t* SE = (const bf16_t*)(c.ws + WS_P + P_PR) + (size_t)dir * NZ * 256; const bf16_t* SAD = SE + (size_t)2 * NZ * 256; const bf16_t* SKD = SAD + (size_t)2 * NZ * 256;
    const int i = chunk * RW_TS + (t >> 3), z = b * TZ + rw_tok(dir, i); const size_t o = (size_t)z * 256 + h * 64 + (t & 7) * 8;
    g.r = *(const u32x4*)(RB + o); g.v = *(const u32x4*)(VB + o); g.kk = *(const u32x4*)(KKB + o);
    g.e = *(const u32x4*)(SE + o); g.ad = *(const u32x4*)(SAD + o); g.kd = *(const u32x4*)(SKD + o);
}
DI void up8(const u32x4& u, float (&f)[8]) { f[0] = lo2f(u.x); f[1] = hi2f(u.x); f[2] = lo2f(u.y); f[3] = hi2f(u.y); f[4] = lo2f(u.z); f[5] = hi2f(u.z); f[6] = lo2f(u.w); f[7] = hi2f(u.w); }
DI void rw_process(const RwRegs& g, int t, float* buf) {
    float r[8], v[8], kk[8], e[8], ad[8], kd[8];
    up8(g.r, r); up8(g.v, v); up8(g.kk, kk); up8(g.e, e); up8(g.ad, ad); up8(g.kd, kd);
    float* f = buf + (t >> 3) * RW_STEP_F + (t & 7) * 8;
    float w[8], bv[8], wr[8]; float br = 0.f, kr = 0.f;
#pragma unroll
    for (int j = 0; j < 8; ++j) { w[j] = __expf(-e[j]); bv[j] = kk[j] * ad[j]; wr[j] = w[j] * r[j]; br += bv[j] * r[j]; kr += kd[j] * r[j]; }
    *(float4*)(f) = make_float4(w[0], w[1], w[2], w[3]); *(float4*)(f + 4) = make_float4(w[4], w[5], w[6], w[7]);
    *(float4*)(f + 64) = make_float4(kk[0], kk[1], kk[2], kk[3]); *(float4*)(f + 68) = make_float4(kk[4], kk[5], kk[6], kk[7]);
    *(float4*)(f + 128) = make_float4(bv[0], bv[1], bv[2], bv[3]); *(float4*)(f + 132) = make_float4(bv[4], bv[5], bv[6], bv[7]);
    *(float4*)(f + 192) = make_float4(kd[0], kd[1], kd[2], kd[3]); *(float4*)(f + 196) = make_float4(kd[4], kd[5], kd[6], kd[7]);
    *(float4*)(f + 256) = make_float4(wr[0], wr[1], wr[2], wr[3]); *(float4*)(f + 260) = make_float4(wr[4], wr[5], wr[6], wr[7]);
    *(float4*)(f + 320) = make_float4(v[0], v[1], v[2], v[3]); *(float4*)(f + 324) = make_float4(v[4], v[5], v[6], v[7]);
    br = red8(br); kr = red8(kr);
    if ((t & 7) == 0) { float* s = buf + (t >> 3) * RW_STEP_F + 384; s[0] = br; s[1] = kr; }
}
struct RwStep { float4 w, kk, bv, kd, wr; float vv, br, kr; };
DI void rw_ld(RwStep& s, const float* f, int kq, int row) {
    s.w = *(const float4*)(f + kq * 4); s.kk = *(const float4*)(f + 64 + kq * 4); s.bv = *(const float4*)(f + 128 + kq * 4);
    s.kd = *(const float4*)(f + 192 + kq * 4); s.wr = *(const float4*)(f + 256 + kq * 4); s.vv = f[320 + row]; s.br = f[384]; s.kr = f[385];
}
DI void phase_rwkv_scan_unit(const Ctx& c, int l, int u) {
    const int rg = u & 3, chain = u >> 2, dir = chain & 1, h = (chain >> 1) & 3, b = chain >> 3;
    float* buf0 = (float*)c.smem; float* buf1 = buf0 + RW_BUF_F;
    float* ybuf = buf1 + RW_BUF_F;
    float* YO = (float*)(c.ws + WS_BUFB) + (size_t)dir * NZ * 256 + (size_t)b * TZ * 256 + h * 64 + rg * 16;
    const int wave = c.wave, lane = c.lane, rr = lane >> 4, kq = lane & 15, rl = (wave & 3) * 4 + rr, row = rg * 16 + rl;
    const int t = c.tid - 256;
    float S0 = 0.f, S1 = 0.f, S2 = 0.f, S3 = 0.f;
    constexpr int NCH = TZ / RW_TS;
    RwRegs g;
    __syncthreads();
    if (wave >= 4) { rw_load(c, b, h, dir, 0, t, g); rw_process(g, t, buf0); rw_load(c, b, h, dir, 1, t, g); }
    __syncthreads();
    for (int ch = 0; ch < NCH; ++ch) {
        float* cur = buf0 + (ch & 1) * RW_BUF_F; float* nxt = buf0 + ((ch + 1) & 1) * RW_BUF_F;
        if (wave >= 4) {
            if (ch > 0) {
                const float* yb = ybuf + ((ch - 1) & 1) * RW_TS * 16;
#pragma unroll
                for (int i = 0; i < 2; ++i) { const int e = t + i * 256, st = e >> 4, rw = e & 15; YO[(size_t)rw_tok(dir, (ch - 1) * RW_TS + st) * 256 + rw] = yb[e]; }
            }
            if (ch + 1 < NCH) rw_process(g, t, nxt);
            if (ch + 2 < NCH) rw_load(c, b, h, dir, ch + 2, t, g);
        } else {
            float* yb = ybuf + (ch & 1) * RW_TS * 16 + rl;
            RwStep s0, s1;
            rw_ld(s0, cur, kq, row);
#pragma unroll 4
            for (int st = 0; st < RW_TS; st += 2) {
                rw_ld(s1, cur + (st + 1) * RW_STEP_F, kq, row);
                {
                    float sa = -((S0 * s0.kk.x + S1 * s0.kk.y) + (S2 * s0.kk.z + S3 * s0.kk.w));
                    float q = (S0 * s0.wr.x + S1 * s0.wr.y) + (S2 * s0.wr.z + S3 * s0.wr.w);
                    sa = red16(sa); q = red16(q);
                    S0 = fmaf(sa, s0.bv.x, fmaf(S0, s0.w.x, s0.vv * s0.kd.x)); S1 = fmaf(sa, s0.bv.y, fmaf(S1, s0.w.y, s0.vv * s0.kd.y));
                    S2 = fmaf(sa, s0.bv.z, fmaf(S2, s0.w.z, s0.vv * s0.kd.z)); S3 = fmaf(sa, s0.bv.w, fmaf(S3, s0.w.w, s0.vv * s0.kd.w));
                    yb[st * 16] = q + sa * s0.br + s0.vv * s0.kr;
                }
                if (st + 2 < RW_TS) rw_ld(s0, cur + (st + 2) * RW_STEP_F, kq, row);
                {
                    float sa = -((S0 * s1.kk.x + S1 * s1.kk.y) + (S2 * s1.kk.z + S3 * s1.kk.w));
                    float q = (S0 * s1.wr.x + S1 * s1.wr.y) + (S2 * s1.wr.z + S3 * s1.wr.w);
                    sa = red16(sa); q = red16(q);
                    S0 = fmaf(sa, s1.bv.x, fmaf(S0, s1.w.x, s1.vv * s1.kd.x)); S1 = fmaf(sa, s1.bv.y, fmaf(S1, s1.w.y, s1.vv * s1.kd.y));
                    S2 = fmaf(sa, s1.bv.z, fmaf(S2, s1.w.z, s1.vv * s1.kd.z)); S3 = fmaf(sa, s1.bv.w, fmaf(S3, s1.w.w, s1.vv * s1.kd.w));
                    yb[(st + 1) * 16] = q + sa * s1.br + s1.vv * s1.kr;
                }
            }
        }
        __syncthreads();
    }
    if (wave >= 4) {
        const float* yb = ybuf + ((NCH - 1) & 1) * RW_TS * 16;
#pragma unroll
        for (int i = 0; i < 2; ++i) { const int e = t + i * 256, st = e >> 4, rw = e & 15; YO[(size_t)rw_tok(dir, (NCH - 1) * RW_TS + st) * 256 + rw] = yb[e]; }
    }
}

constexpr int LA_AN = 0, LA_RN = 8192, LA_BN = 16384, LA_KN = 24576, LA_AT = 32768, LA_BHT = 40960, LA_KHT = 49152, LA_VT = 57344,
              LA_NBA = 65536  , LA_NKA = 81920, LA_NBRT = 90112, LA_NKRT = 98304, LA_P63 = 106496;
constexpr int LA_TMT = LA_AN, LA_M1 = LA_BN, LA_W1T = LA_KN, LA_Z1 = LA_NBA;
DI int crow(int reg, int h) { return (reg & 3) + 8 * (reg >> 2) + 4 * h; }
DI void mm_tile(f32x16& acc, const unsigned char* A, int i0, const unsigned char* BT, int j0, int r, int h) {
#pragma unroll
    for (int ks = 0; ks < 4; ++ks) {
        const bf16x8 a = *(const bf16x8*)(A + (i0 + r) * 128 + ks * 32 + h * 16);
        const bf16x8 b = *(const bf16x8*)(BT + (j0 + r) * 128 + ks * 32 + h * 16);
        acc = __builtin_amdgcn_mfma_f32_32x32x16_bf16(a, b, acc, 0, 0, 0);
    }
}
DI void zero16(f32x16& a) {
#pragma unroll
    for (int i = 0; i < 16; ++i) a[i] = 0.f;
}
DI void phase_rwkv_chunk_unit(const Ctx& c, int l, int unit) {
    unsigned char* L = c.smem; unsigned char* ws = c.ws;
    const int chain = unit / RNC, ch = unit % RNC, dir = chain & 1, hd = (chain >> 1) & 3, b = chain >> 3;
    const int tid = c.tid, lane = c.lane, wave = c.wave, r = lane & 31, h = lane >> 5;
    const bf16_t* RB = (const bf16_t*)(ws + WS_EXPW + MX_RB); const bf16_t* VB = (const bf16_t*)(ws + WS_EXPW + MX_VB); const bf16_t* KKB = (const bf16_t*)(ws + WS_EXPW + MX_KKB);
    const bf16_t* SE = (const bf16_t*)(ws + WS_P + P_PR) + (size_t)dir * NZ * 256; const bf16_t* SAD = SE + (size_t)2 * NZ * 256; const bf16_t* SKD = SAD + (size_t)2 * NZ * 256;
    float* CUM = (float*)(L + LA_NBA);
    __syncthreads();
    const int t = tid >> 3, k0 = (tid & 7) * 8;
    float rr[8], vv[8], kk[8], ee[8], ad[8], kd[8];
    {
        const int z = b * TZ + rw_tok(dir, ch * RC + t); const size_t o = (size_t)z * 256 + hd * 64 + k0;
        up8(*(const u32x4*)(RB + o), rr); up8(*(const u32x4*)(VB + o), vv); up8(*(const u32x4*)(KKB + o), kk);
        up8(*(const u32x4*)(SE + o), ee); up8(*(const u32x4*)(SAD + o), ad); up8(*(const u32x4*)(SKD + o), kd);
        *(float4*)(CUM + t * 64 + k0) = make_float4(ee[0], ee[1], ee[2], ee[3]); *(float4*)(CUM + t * 64 + k0 + 4) = make_float4(ee[4], ee[5], ee[6], ee[7]);
    }
    __syncthreads();
    if (wave == 0) { float cm = 0.f;
#pragma unroll 8
        for (int i = 0; i < RC; ++i) { cm += CUM[i * 64 + lane]; CUM[i * 64 + lane] = cm; } }
    __syncthreads();
    {
        float cm[8], c63[8];
        { const float4 a = *(const float4*)(CUM + t * 64 + k0), bq = *(const float4*)(CUM + t * 64 + k0 + 4); cm[0] = a.x; cm[1] = a.y; cm[2] = a.z; cm[3] = a.w; cm[4] = bq.x; cm[5] = bq.y; cm[6] = bq.z; cm[7] = bq.w; }
        { const float4 a = *(const float4*)(CUM + 63 * 64 + k0), bq = *(const float4*)(CUM + 63 * 64 + k0 + 4); c63[0] = a.x; c63[1] = a.y; c63[2] = a.z; c63[3] = a.w; c63[4] = bq.x; c63[5] = bq.y; c63[6] = bq.z; c63[7] = bq.w; }
        float at[8], rt[8], bt[8], kt[8], bh[8], kh[8];
#pragma unroll
        for (int j = 0; j < 8; ++j) {
            const float pt = __expf(-cm[j]), pp = __expf(-(cm[j] - ee[j])), ip = __expf(cm[j]), ph = __expf(-(c63[j] - cm[j])), bb = kk[j] * ad[j];
            at[j] = -kk[j] * pp; rt[j] = rr[j] * pt; bt[j] = bb * ip; kt[j] = kd[j] * ip; bh[j] = bb * ph; kh[j] = kd[j] * ph;
        }
        u32x4 w4;
        w4.x = pack2(at[0], at[1]); w4.y = pack2(at[2], at[3]); w4.z = pack2(at[4], at[5]); w4.w = pack2(at[6], at[7]); *(u32x4*)(L + LA_AN + t * 128 + k0 * 2) = w4;
        w4.x = pack2(rt[0], rt[1]); w4.y = pack2(rt[2], rt[3]); w4.z = pack2(rt[4], rt[5]); w4.w = pack2(rt[6], rt[7]); *(u32x4*)(L + LA_RN + t * 128 + k0 * 2) = w4;
        w4.x = pack2(bt[0], bt[1]); w4.y = pack2(bt[2], bt[3]); w4.z = pack2(bt[4], bt[5]); w4.w = pack2(bt[6], bt[7]); *(u32x4*)(L + LA_BN + t * 128 + k0 * 2) = w4;
        w4.x = pack2(kt[0], kt[1]); w4.y = pack2(kt[2], kt[3]); w4.z = pack2(kt[4], kt[5]); w4.w = pack2(kt[6], kt[7]); *(u32x4*)(L + LA_KN + t * 128 + k0 * 2) = w4;
#pragma unroll
        for (int j = 0; j < 8; ++j) {
            *(bf16_t*)(L + LA_AT + (k0 + j) * 128 + t * 2) = f2bf(at[j]); *(bf16_t*)(L + LA_BHT + (k0 + j) * 128 + t * 2) = f2bf(bh[j]);
            *(bf16_t*)(L + LA_KHT + (k0 + j) * 128 + t * 2) = f2bf(kh[j]); *(bf16_t*)(L + LA_VT + (k0 + j) * 128 + t * 2) = f2bf(vv[j]);
        }
        if (t == 63) {
            float* p63 = (float*)(L + LA_P63); float* gp = (float*)(ws + WS_RW + RW_P63) + (size_t)unit * 64;
#pragma unroll
            for (int j = 0; j < 8; ++j) { const float p = __expf(-c63[j]); p63[k0 + j] = p; gp[k0 + j] = p; }
        }
    }
    __syncthreads();
    {
        const int p = wave >> 1, i0 = (wave & 1) * 32;
        const unsigned char* A = L + (p == 0 ? LA_BN : p == 1 ? LA_KN : LA_RN);
        const unsigned char* BT = L + (p < 2 ? LA_AN : p == 2 ? LA_BN : LA_KN);
#pragma unroll
        for (int jt = 0; jt < 2; ++jt) {
            const int j0 = jt * 32; f32x16 acc; zero16(acc);
            mm_tile(acc, A, i0, BT, j0, r, h);
            const int col = j0 + r;
#pragma unroll
            for (int g = 0; g < 16; ++g) {
                const int row = i0 + crow(g, h);
                if (p == 0) ((float*)(L + LA_NBA))[row * 64 + col] = (row < col) ? acc[g] : 0.f;
                else if (p == 1) *(bf16_t*)(L + LA_NKA + row * 128 + col * 2) = f2bf((row < col) ? acc[g] : 0.f);
                else *(bf16_t*)(L + (p == 2 ? LA_NBRT : LA_NKRT) + row * 128 + col * 2) = f2bf((col <= row) ? acc[g] : 0.f);
            }
        }
    }
    __syncthreads();
    {
        constexpr int X0 = LA_BN, X1 = LA_KN, X3 = 108544, X4 = X3 + 8192, X5 = LA_NBA + 16384 - 16384, X6 = LA_NBA + 8192;
        float nv[8];
        { const int s = tid >> 3, t0 = (tid & 7) * 8; const float* N = (const float*)(L + LA_NBA) + s * 64 + t0;
          const float4 a = *(const float4*)N, bq = *(const float4*)(N + 4); nv[0] = a.x; nv[1] = a.y; nv[2] = a.z; nv[3] = a.w; nv[4] = bq.x; nv[5] = bq.y; nv[6] = bq.z; nv[7] = bq.w; }
        __syncthreads();
        {
            const int s = tid >> 3, t0 = (tid & 7) * 8;
            u32x4 w4; w4.x = pack2(nv[0], nv[1]); w4.y = pack2(nv[2], nv[3]); w4.z = pack2(nv[4], nv[5]); w4.w = pack2(nv[6], nv[7]);
            *(u32x4*)(L + X0 + s * 128 + t0 * 2) = w4;
#pragma unroll
            for (int j = 0; j < 8; ++j) *(bf16_t*)(L + X1 + (t0 + j) * 128 + s * 2) = f2bf(nv[j]);
#pragma unroll
            for (int j = 0; j < 8; ++j) if (t0 + j == s) nv[j] += 1.f;
            w4.x = pack2(nv[0], nv[1]); w4.y = pack2(nv[2], nv[3]); w4.z = pack2(nv[4], nv[5]); w4.w = pack2(nv[6], nv[7]);
            *(u32x4*)(L + X5 + s * 128 + t0 * 2) = w4;
        }
        __syncthreads();
        const int ti0 = ((wave >> 1) & 1) * 32, tj0 = (wave & 1) * 32;
        if (wave < 4) {
            f32x16 acc; zero16(acc); mm_tile(acc, L + X0, ti0, L + X1, tj0, r, h);
#pragma unroll
            for (int g4 = 0; g4 < 4; ++g4) *(u32x2*)(L + X4 + (tj0 + r) * 128 + (ti0 + 8 * g4 + 4 * h) * 2) = pack4(acc[4 * g4], acc[4 * g4 + 1], acc[4 * g4 + 2], acc[4 * g4 + 3]);
#pragma unroll
            for (int g = 0; g < 16; ++g) *(bf16_t*)(L + X3 + (ti0 + crow(g, h)) * 128 + (tj0 + r) * 2) = f2bf(acc[g]);
        }
        __syncthreads();
#pragma unroll
        for (int k = 1; k <= 5; ++k) {
            const int qa = (k & 1) ? X3 : X0, qt = (k & 1) ? X4 : X1, nqa = (k & 1) ? X0 : X3, nqt = (k & 1) ? X1 : X4;
            const int pa = (k & 1) ? X5 : X6, npa = (k & 1) ? X6 : X5;
            if (wave >= 4) {
                f32x16 acc; zero16(acc); mm_tile(acc, L + pa, ti0, L + qt, tj0, r, h);
#pragma unroll
                for (int g = 0; g < 16; ++g) acc[g] += bf2f(*(const bf16_t*)(L + pa + (ti0 + crow(g, h)) * 128 + (tj0 + r) * 2));
                if (k < 5) {
#pragma unroll
                    for (int g = 0; g < 16; ++g) *(bf16_t*)(L + npa + (ti0 + crow(g, h)) * 128 + (tj0 + r) * 2) = f2bf(acc[g]);
                } else {
#pragma unroll
                    for (int g4 = 0; g4 < 4; ++g4) *(u32x2*)(L + LA_TMT + (tj0 + r) * 128 + (ti0 + 8 * g4 + 4 * h) * 2) = pack4(acc[4 * g4], acc[4 * g4 + 1], acc[4 * g4 + 2], acc[4 * g4 + 3]);
                }
            } else if (k < 5) {
                f32x16 acc; zero16(acc); mm_tile(acc, L + qa, ti0, L + qt, tj0, r, h);
#pragma unroll
                for (int g4 = 0; g4 < 4; ++g4) *(u32x2*)(L + nqt + (tj0 + r) * 128 + (ti0 + 8 * g4 + 4 * h) * 2) = pack4(acc[4 * g4], acc[4 * g4 + 1], acc[4 * g4 + 2], acc[4 * g4 + 3]);
#pragma unroll
                for (int g = 0; g < 16; ++g) *(bf16_t*)(L + nqa + (ti0 + crow(g, h)) * 128 + (tj0 + r) * 2) = f2bf(acc[g]);
            }
            __syncthreads();
        }
    }
    {
        const int p = wave >> 2, i0 = ((wave >> 1) & 1) * 32, j0 = (wave & 1) * 32; f32x16 acc; zero16(acc);
        if (p == 0) {
            mm_tile(acc, L + LA_TMT, i0, L + LA_AT, j0, r, h);
#pragma unroll
            for (int g4 = 0; g4 < 4; ++g4) *(u32x2*)(L + LA_M1 + (j0 + r) * 128 + (i0 + 8 * g4 + 4 * h) * 2) = pack4(acc[4 * g4], acc[4 * g4 + 1], acc[4 * g4 + 2], acc[4 * g4 + 3]);
        } else {
            mm_tile(acc, L + LA_NKA, i0, L + LA_TMT, j0, r, h);
#pragma unroll
            for (int g4 = 0; g4 < 4; ++g4) *(u32x2*)(L + LA_W1T + (j0 + r) * 128 + (i0 + 8 * g4 + 4 * h) * 2) = pack4(acc[4 * g4], acc[4 * g4 + 1], acc[4 * g4 + 2], acc[4 * g4 + 3]);
        }
    }
    __syncthreads();
    if (wave < 4) {
        const int i0 = (wave >> 1) * 32, j0 = (wave & 1) * 32; f32x16 acc; zero16(acc);
        mm_tile(acc, L + LA_W1T, i0, L + LA_VT, j0, r, h);
#pragma unroll
        for (int g4 = 0; g4 < 4; ++g4) *(u32x2*)(L + LA_Z1 + (j0 + r) * 128 + (i0 + 8 * g4 + 4 * h) * 2) = pack4(acc[4 * g4], acc[4 * g4 + 1], acc[4 * g4 + 2], acc[4 * g4 + 3]);
    }
    __syncthreads();
    {
        const int p = wave >> 1, i0 = (wave & 1) * 32;
        bf16_t* GM3 = (bf16_t*)(ws + WS_RW + RW_M3) + (size_t)unit * 4096; bf16_t* GM2 = (bf16_t*)(ws + WS_RW + RW_M2) + (size_t)unit * 4096; bf16_t* GZ5 = (bf16_t*)(ws + WS_RW + RW_Z5) + (size_t)unit * 4096;
        float* YO = (float*)(ws + WS_BUFB) + (size_t)dir * NZ * 256;
#pragma unroll
        for (int jt = 0; jt < 2; ++jt) {
            const int j0 = jt * 32; f32x16 acc; zero16(acc);
            if (p == 0) {
                mm_tile(acc, L + LA_M1, i0, L + LA_NBRT, j0, r, h);
#pragma unroll
                for (int g4 = 0; g4 < 4; ++g4) { const int tt = j0 + r, kq = i0 + 8 * g4 + 4 * h; float rv[4]; unpack4(*(const u32x2*)(L + LA_RN + tt * 128 + kq * 2), rv);
                    *(u32x2*)(GM2 + tt * 64 + kq) = pack4(acc[4 * g4] + rv[0], acc[4 * g4 + 1] + rv[1], acc[4 * g4 + 2] + rv[2], acc[4 * g4 + 3] + rv[3]); }
            } else if (p == 1) {
                mm_tile(acc, L + LA_NBRT, i0, L + LA_Z1, j0, r, h); mm_tile(acc, L + LA_NKRT, i0, L + LA_VT, j0, r, h);
#pragma unroll
                for (int g = 0; g < 16; ++g) { const int tt = i0 + crow(g, h); YO[(size_t)(b * TZ + rw_tok(dir, ch * RC + tt)) * 256 + hd * 64 + j0 + r] = acc[g]; }
            } else if (p == 2) {
                mm_tile(acc, L + LA_M1, i0, L + LA_BHT, j0, r, h);
#pragma unroll
                for (int g4 = 0; g4 < 4; ++g4) *(u32x2*)(GM3 + (j0 + r) * 64 + i0 + 8 * g4 + 4 * h) = pack4(acc[4 * g4], acc[4 * g4 + 1], acc[4 * g4 + 2], acc[4 * g4 + 3]);
            } else {
                mm_tile(acc, L + LA_BHT, i0, L + LA_Z1, j0, r, h); mm_tile(acc, L + LA_KHT, i0, L + LA_VT, j0, r, h);
#pragma unroll
                for (int g4 = 0; g4 < 4; ++g4) *(u32x2*)(GZ5 + (j0 + r) * 64 + i0 + 8 * g4 + 4 * h) = pack4(acc[4 * g4], acc[4 * g4 + 1], acc[4 * g4 + 2], acc[4 * g4 + 3]);
            }
        }
    }
}
DI void phase_rwkv_chunks(const Ctx& c, int l) {
    for (int u = blockIdx.x; u < 16 * RNC; u += gridDim.x) phase_rwkv_chunk_unit(c, l, u);
}
DI bf16x8 pack8(const f32x16& x, int s) {
    u32x4 p; p.x = pack2(x[8 * s], x[8 * s + 1]); p.y = pack2(x[8 * s + 2], x[8 * s + 3]); p.z = pack2(x[8 * s + 4], x[8 * s + 5]); p.w = pack2(x[8 * s + 6], x[8 * s + 7]);
    return __builtin_bit_cast(bf16x8, p);
}
DI bf16x8 ldfrag(const bf16_t* rowp, int s, int h) {
    const u32x2 lo = *(const u32x2*)(rowp + 16 * s + 4 * h), hi = *(const u32x2*)(rowp + 16 * s + 8 + 4 * h);
    u32x4 v; v.x = lo.x; v.y = lo.y; v.z = hi.x; v.w = hi.y; return __builtin_bit_cast(bf16x8, v);
}
constexpr int SQ_PITCH = 144, SQ_MAT = 64 * SQ_PITCH;
constexpr int SQA_M3 = 0, SQA_Z5 = SQ_MAT, SQA_P63 = 2 * SQ_MAT, SQA_BYTES = SQA_P63 + 256;
constexpr int SQB_M2 = 0, SQB_Y = SQ_MAT, SQB_BYTES = SQB_Y + 64 * 64 * 4;
constexpr int SQ_NST = 3;
constexpr int SQ_A0 = 0, SQ_B0 = SQ_NST * SQA_BYTES, SQ_XB = SQ_B0 + SQ_NST * SQB_BYTES, SQ_END = SQ_XB + 4 * 4096;
DI bf16x8 ldfrag_l(const unsigned char* rowp, int s, int h) {
    const u32x2 lo = *(const u32x2*)(rowp + (16 * s + 4 * h) * 2), hi = *(const u32x2*)(rowp + (16 * s + 8 + 4 * h) * 2);
    u32x4 v; v.x = lo.x; v.y = lo.y; v.z = hi.x; v.w = hi.y; return __builtin_bit_cast(bf16x8, v);
}
struct SqRegsA { u32x4 m3[2], z5[2], p63; };
struct SqRegsB { u32x4 m2[2], y[4]; };
DI void sqa_gload(const Ctx& c, size_t unit, int lt, SqRegsA& g) {
    const unsigned char* g3 = c.ws + WS_RW + RW_M3 + unit * 8192; const unsigned char* g5 = c.ws + WS_RW + RW_Z5 + unit * 8192;
#pragma unroll
    for (int i = 0; i < 2; ++i) { const int id = lt + i * 256; g.m3[i] = *(const u32x4*)(g3 + id * 16); g.z5[i] = *(const u32x4*)(g5 + id * 16); }
    if (lt < 16) g.p63 = *(const u32x4*)(c.ws + WS_RW + RW_P63 + unit * 256 + lt * 16);
}
DI void sqa_lstore(unsigned char* st, int lt, const SqRegsA& g) {
#pragma unroll
    for (int i = 0; i < 2; ++i) { const int id = lt + i * 256, row = id >> 3, part = id & 7;
        *(u32x4*)(st + SQA_M3 + row * SQ_PITCH + part * 16) = g.m3[i]; *(u32x4*)(st + SQA_Z5 + row * SQ_PITCH + part * 16) = g.z5[i]; }
    if (lt < 16) *(u32x4*)(st + SQA_P63 + lt * 16) = g.p63;
}
DI void sqb_gload(const Ctx& c, size_t unit, const float* YO, int dir, int ch, int lt, SqRegsB& g) {
    const unsigned char* g2 = c.ws + WS_RW + RW_M2 + unit * 8192;
#pragma unroll
    for (int i = 0; i < 2; ++i) g.m2[i] = *(const u32x4*)(g2 + (lt + i * 256) * 16);
#pragma unroll
    for (int i = 0; i < 4; ++i) { const int id = lt + i * 256; g.y[i] = *(const u32x4*)(YO + (size_t)rw_tok(dir, ch * RC + (id >> 4)) * 256 + (id & 15) * 4); }
}
DI void sqb_lstore(unsigned char* st, int lt, const SqRegsB& g) {
#pragma unroll
    for (int i = 0; i < 2; ++i) { const int id = lt + i * 256; *(u32x4*)(st + SQB_M2 + (id >> 3) * SQ_PITCH + (id & 7) * 16) = g.m2[i]; }
#pragma unroll
    for (int i = 0; i < 4; ++i) { const int id = lt + i * 256; *(u32x4*)(st + SQB_Y + (id >> 4) * 256 + (id & 15) * 16) = g.y[i]; }
}
DI void sqb_store_y(float* YO, int dir, int ch, const unsigned char* st, int lt, int vhb) {
#pragma unroll
    for (int i = 0; i < 2; ++i) { const int id = lt + i * 256; *(u32x4*)(YO + (size_t)rw_tok(dir, ch * RC + (id >> 3)) * 256 + vhb * 32 + (id & 7) * 4) = *(const u32x4*)(st + SQB_Y + id * 16); }
}
DI void phase_rwkv_seq_block(const Ctx& c, int l, int chain, int vhb) {
    unsigned char* L = c.smem; const int lane = c.lane, wave = c.wave, r = lane & 31, h = lane >> 5;
    const int dir = chain & 1, hd = (chain >> 1) & 3, b = chain >> 3, lt = c.tid - 256, vh = vhb; const bool act = (wave & 1) == 0;
    const size_t unit0 = (size_t)chain * RNC;
    __syncthreads();
    if (wave >= 4) {
        float* YO = (float*)(c.ws + WS_BUFB) + (size_t)dir * NZ * 256 + (size_t)b * TZ * 256 + hd * 64;
        const int lt2 = lt & 255;
        int moff[3], mdst[3];
#pragma unroll
        for (int i = 0; i < 3; ++i) { const int id = i < 2 ? lt2 + 256 * i : 512 + lane; const int row = id / 9, ck = id - row * 9; moff[i] = row * 128 + (ck == 8 ? 7 : ck) * 16; mdst[i] = id * 16; }
        int zoff[2], zdst[2];
#pragma unroll
        for (int i = 0; i < 2; ++i) { const int id = i == 0 ? lt2 : 256 + lane; int row = id / 9; const int ck = id - row * 9; zdst[i] = (vhb * 32 * 9 + id) * 16; row += vhb * 32; if (row > 63) row = 63; zoff[i] = row * 128 + (ck == 8 ? 7 : ck) * 16; }
        const unsigned char* gM3 = c.ws + WS_RW + RW_M3; const unsigned char* gZ5 = c.ws + WS_RW + RW_Z5; const unsigned char* gM2 = c.ws + WS_RW + RW_M2; const unsigned char* gP = c.ws + WS_RW + RW_P63;
        auto dmaA = [&](int ch, int stg) {
            const size_t unit = unit0 + (ch < RNC ? ch : RNC - 1); unsigned char* st = L + SQ_A0 + stg * SQA_BYTES;
#pragma unroll
            for (int i = 0; i < 3; ++i) __builtin_amdgcn_global_load_lds((const unsigned*)(gM3 + unit * 8192 + moff[i]), (unsigned*)(st + SQA_M3 + mdst[i]), 16, 0, 0);
            __builtin_amdgcn_global_load_lds((const unsigned*)(gZ5 + unit * 8192 + zoff[0]), (unsigned*)(st + SQA_Z5 + zdst[0]), 16, 0, 0);
            if (lane < 32) __builtin_amdgcn_global_load_lds((const unsigned*)(gZ5 + unit * 8192 + zoff[1]), (unsigned*)(st + SQA_Z5 + zdst[1]), 16, 0, 0);
            if (lane < 16) __builtin_amdgcn_global_load_lds((const unsigned*)(gP + unit * 256 + lane * 16), (unsigned*)(st + SQA_P63 + lane * 16), 16, 0, 0);
        };
        auto dmaB = [&](int ch, int stg) {
            const int cc = ch < RNC ? ch : RNC - 1; const size_t unit = unit0 + cc; unsigned char* st = L + SQ_B0 + stg * SQB_BYTES;
#pragma unroll
            for (int i = 0; i < 3; ++i) __builtin_amdgcn_global_load_lds((const unsigned*)(gM2 + unit * 8192 + moff[i]), (unsigned*)(st + SQB_M2 + mdst[i]), 16, 0, 0);
#pragma unroll
            for (int i = 0; i < 2; ++i) { const int id = lt2 + i * 256; __builtin_amdgcn_global_load_lds((const unsigned*)(YO + (size_t)rw_tok(dir, cc * RC + (id >> 3)) * 256 + vhb * 32 + (id & 7) * 4), (unsigned*)(st + SQB_Y + id * 16), 16, 0, 0); }
        };
        dmaA(0, 0); dmaA(1, 1); dmaB(0, 0);
        asm volatile("s_waitcnt vmcnt(0)" ::: "memory");
        __builtin_amdgcn_s_barrier();
        int sa2 = 2, sb1 = 1;
#pragma unroll 1
        for (int ch = 0; ch <= RNC; ++ch) {
            if (ch >= 2) sqb_store_y(YO, dir, ch - 2, L + SQ_B0 + sb1 * SQB_BYTES, lt2, vhb);
            asm volatile("" ::: "memory");
            dmaA(ch + 2, sa2); dmaB(ch + 1, sb1);
            asm volatile("s_waitcnt vmcnt(11)" ::: "memory");
            __builtin_amdgcn_s_barrier();
            asm volatile("" ::: "memory");
            sa2 = sa2 == 2 ? 0 : sa2 + 1; sb1 = sb1 == 2 ? 0 : sb1 + 1;
        }
        sqb_store_y(YO, dir, RNC - 1, L + SQ_B0 + ((RNC - 1) % 3) * SQB_BYTES, lt2, vhb);
    } else if (wave < 2) {
        f32x16 x[2]; zero16(x[0]); zero16(x[1]);
        __syncthreads();
#pragma unroll 1
        for (int ch = 0; ch <= RNC; ++ch) {
            if (ch < RNC && act) {
                const unsigned char* st = L + SQ_A0 + (ch % 3) * SQA_BYTES;
                unsigned char* xbuf = L + SQ_XB + ((ch & 1) * 2 + vh) * 4096 + lane * 16;
                bf16x8 xb[4];
#pragma unroll
                for (int s = 0; s < 4; ++s) { xb[s] = pack8(x[s >> 1], s & 1); *(bf16x8*)(xbuf + s * 1024) = xb[s]; }
                f32x16 xn0, xn1;
#pragma unroll
                for (int i = 0; i < 2; ++i) {
                    f32x16 xa;
#pragma unroll
                    for (int g4 = 0; g4 < 4; ++g4) {
                        float z5[4]; unpack4(*(const u32x2*)(st + SQA_Z5 + (vh * 32 + r) * SQ_PITCH + (32 * i + 8 * g4 + 4 * h) * 2), z5);
                        const float4 p4 = *(const float4*)(st + SQA_P63 + (32 * i + 8 * g4 + 4 * h) * 4);
                        xa[4 * g4] = fmaf(p4.x, x[i][4 * g4], z5[0]); xa[4 * g4 + 1] = fmaf(p4.y, x[i][4 * g4 + 1], z5[1]);
                        xa[4 * g4 + 2] = fmaf(p4.z, x[i][4 * g4 + 2], z5[2]); xa[4 * g4 + 3] = fmaf(p4.w, x[i][4 * g4 + 3], z5[3]);
                    }
#pragma unroll
                    for (int s = 0; s < 4; ++s) xa = __builtin_amdgcn_mfma_f32_32x32x16_bf16(ldfrag_l(st + SQA_M3 + (32 * i + r) * SQ_PITCH, s, h), xb[s], xa, 0, 0, 0);
                    if (i == 0) xn0 = xa; else xn1 = xa;
                }
                x[0] = xn0; x[1] = xn1;
            }
            __syncthreads();
        }
    } else {
        __syncthreads();
#pragma unroll 1
        for (int ch = 0; ch <= RNC; ++ch) {
            if (ch >= 1 && act) {
                const int cy = ch - 1;
                unsigned char* st = L + SQ_B0 + (cy % 3) * SQB_BYTES;
                const unsigned char* xbuf = L + SQ_XB + ((cy & 1) * 2 + vh) * 4096 + lane * 16;
                bf16x8 xb[4];
#pragma unroll
                for (int s = 0; s < 4; ++s) xb[s] = *(const bf16x8*)(xbuf + s * 1024);
#pragma unroll
                for (int i = 0; i < 2; ++i) {
                    f32x16 ya;
#pragma unroll
                    for (int g = 0; g < 16; ++g) ya[g] = *((const float*)(st + SQB_Y) + (32 * i + crow(g, h)) * 32 + r);
#pragma unroll
                    for (int s = 0; s < 4; ++s) ya = __builtin_amdgcn_mfma_f32_32x32x16_bf16(ldfrag_l(st + SQB_M2 + (32 * i + r) * SQ_PITCH, s, h), xb[s], ya, 0, 0, 0);
#pragma unroll
                    for (int g = 0; g < 16; ++g) *((float*)(st + SQB_Y) + (32 * i + crow(g, h)) * 32 + r) = ya[g];
                }
            }
            __syncthreads();
        }
    }
}
DI void phase_mixers2(const Ctx& c, int l) {
    const int G = gridDim.x, bid = blockIdx.x;
    if (G >= 128) {
        if (bid < 32) phase_rwkv_seq_block(c, l, bid >> 1, bid & 1);
        else for (int u = bid - 32; u < 2 * S5N * 4; u += G - 32) phase_s5_final_unit<false>(c, l, u);
    } else {
        for (int u = bid; u < 32; u += G) phase_rwkv_seq_block(c, l, u >> 1, u & 1);
        for (int u = bid; u < 2 * S5N * 4; u += G) phase_s5_final_unit<false>(c, l, u);
    }
}

DI void phase_post(const Ctx& c, int l) {
    unsigned char* ws = c.ws; const int lane = c.lane;
    const float* YF = (const float*)(ws + WS_BUFB); const float* YB = YF + (size_t)NZ * 256;
    const bf16_t* RB = (const bf16_t*)(ws + WS_EXPW + MX_RB); const bf16_t* VB = (const bf16_t*)(ws + WS_EXPW + MX_VB);
    const bf16_t* SKD = (const bf16_t*)(ws + WS_P + P_PR) + (size_t)4 * NZ * 256; const bf16_t* GG = (const bf16_t*)(ws + WS_MISC + MS_GG);
    bf16_t* Ycat = (bf16_t*)(ws + WS_BUFA);
    const float* r_k = c.in[21] + l * 256; const float* lg = c.in[22] + l * 256; const float* lb = c.in[23] + l * 256;
    for (int z = blockIdx.x * 8 + c.wave; z < NZ; z += gridDim.x * 8) {
        const size_t o = (size_t)z * 256 + lane * 4;
        const float4 yf = *(const float4*)(YF + o), yb = *(const float4*)(YB + o);
        const float y0 = yf.x + yb.x, y1 = yf.y + yb.y, y2 = yf.z + yb.z, y3 = yf.w + yb.w;
        const float mean = sum16(y0 + y1 + y2 + y3) * (1.f / 64.f);
        const float d0 = y0 - mean, d1 = y1 - mean, d2 = y2 - mean, d3 = y3 - mean;
        const float var = sum16(d0 * d0 + d1 * d1 + d2 * d2 + d3 * d3) * (1.f / 64.f);
        const float rs = rsqrtf(var + 64e-5f);
        float r[4], v[4], k0[4], k1[4], gg[4];
        unpack4(*(const u32x2*)(RB + o), r); unpack4(*(const u32x2*)(VB + o), v); unpack4(*(const u32x2*)(SKD + o), k0); unpack4(*(const u32x2*)(SKD + (size_t)NZ * 256 + o), k1);
        unpack4(*(const u32x2*)(GG + o), gg);
        const float4 rk = *(const float4*)(r_k + lane * 4), g4 = *(const float4*)(lg + lane * 4), b4 = *(const float4*)(lb + lane * 4);
        const float bs = sum16(r[0] * (k0[0] + k1[0]) * rk.x + r[1] * (k0[1] + k1[1]) * rk.y + r[2] * (k0[2] + k1[2]) * rk.z + r[3] * (k0[3] + k1[3]) * rk.w);
        *(u32x2*)(Ycat + (size_t)z * D + 256 + lane * 4) = pack4((d0 * rs * g4.x + b4.x + bs * v[0]) * gg[0], (d1 * rs * g4.y + b4.y + bs * v[1]) * gg[1],
                                                                (d2 * rs * g4.z + b4.z + bs * v[2]) * gg[2], (d3 * rs * g4.w + b4.w + bs * v[3]) * gg[3]);
    }
    {
        const bf16_t* ZG = (const bf16_t*)(ws + WS_MISC + MS_ZG); const bf16_t* W = (const bf16_t*)(ws + WS_WSM + OFF_GLUT + l * SZ_GLUT);
        const float* gb = c.in[33] + l * 256;
        for (int u = blockIdx.x; u < (NZ / 256) * 2; u += gridDim.x) {
            const int mt = u / 2, nt = u % 2, r0 = mt * 256, c0 = nt * 128;
            gemm_tile<4, 0>(c, 256, [&](int i) { return ZG + (size_t)(r0 + i) * 256; }, [&](int i) { return W + (size_t)(c0 + i) * 256; }, NoHook(),
                [&](f32x4 (&acc)[4][4], int wr, int wc, int fr, int fq) {
#pragma unroll
                    for (int n = 0; n < 4; ++n) {
                        const int col = c0 + wc + n * 16 + fq * 4; const float4 bb = *(const float4*)(gb + col);
#pragma unroll
                        for (int m = 0; m < 4; ++m) {
                            const int row = r0 + wr + m * 16 + fr; const f32x4 v = acc[m][n];
                            float zg[4]; unpack4(*(const u32x2*)(ZG + (size_t)row * 256 + col), zg);
                            *(u32x2*)(Ycat + (size_t)row * D + 512 + col) = pack4(zg[0] * sigmoidf_(v[0] + bb.x), zg[1] * sigmoidf_(v[1] + bb.y), zg[2] * sigmoidf_(v[2] + bb.z), zg[3] * sigmoidf_(v[3] + bb.w));
                        }
                    }
                });
        }
    }
}

DI bool skip_mt(int l, int mt) { return l == NL - 1 && (mt % 33) == 0; }
DI bool merge_split(int l) { return l == 0 && NL > 1 && gridDim.x == 256; }
DI void phase_merge1(const Ctx& c, int l, int part) {
    const bf16_t* Ycat = (const bf16_t*)(c.ws + WS_BUFA); const bf16_t* W = (const bf16_t*)(c.ws + WS_WSM + OFF_WBT + l * SZ_WBT);
    const bf16_t* GT = (const bf16_t*)(c.ws + WS_GT); bf16_t* MG = (bf16_t*)(c.ws + WS_BUFB);
    if (part == 0 && blockIdx.x == 0 && c.tid < 32) ((unsigned*)(c.ws + WS_CTL))[CW_CNT + l * 32 + c.tid] = 0u;
    const bool split = merge_split(l);
    const int u_lo = part == 0 ? (int)blockIdx.x : 512 + (int)blockIdx.x, u_hi = part == 0 ? (split ? 512 : (NZ / 256) * 8) : (NZ / 256) * 8;
    for (int u = u_lo; u < u_hi; u += gridDim.x) {
        const int mt = u / 8, nt = u % 8, r0 = mt * 256, c0 = nt * 128;
        if (skip_mt(l, mt)) continue;
        f32x4 macc[4][4];
#pragma unroll
        for (int m = 0; m < 4; ++m)
#pragma unroll
            for (int n = 0; n < 4; ++n) macc[m][n] = (f32x4){0.f, 0.f, 0.f, 0.f};
        gemm_tile<4, 256>(c, 1024, [&](int i) { return Ycat + (size_t)(r0 + i) * D; }, [&](int i) { return W + (size_t)(c0 + i) * D; },
            [&](f32x4 (&acc)[4][4], int seg, int wr, int wc, int fr, int fq) {
#pragma unroll
                for (int m = 0; m < 4; ++m)
#pragma unroll
                    for (int n = 0; n < 4; ++n) {
                        float g[4]; unpack4(*(const u32x2*)(GT + (size_t)(r0 + wr + m * 16 + fr) * 4096 + seg * 1024 + c0 + wc + n * 16 + fq * 4), g);
                        macc[m][n][0] += g[0] * acc[m][n][0]; macc[m][n][1] += g[1] * acc[m][n][1]; macc[m][n][2] += g[2] * acc[m][n][2]; macc[m][n][3] += g[3] * acc[m][n][3];
                        acc[m][n] = (f32x4){0.f, 0.f, 0.f, 0.f};
                    }
            },
            [&](f32x4 (&)[4][4], int wr, int wc, int fr, int fq) {
#pragma unroll
                for (int m = 0; m < 4; ++m)
#pragma unroll
                    for (int n = 0; n < 4; ++n)
                        *(u32x2*)(MG + (size_t)(r0 + wr + m * 16 + fr) * D + c0 + wc + n * 16 + fq * 4) = pack4(macc[m][n][0], macc[m][n][1], macc[m][n][2], macc[m][n][3]);
            });
    }
}
struct EpiMerge2 {
    static constexpr bool PERM = false, AFTER_DRAIN = false;
    float* H; const float* modv; int l;
    DI void operator()(const pg8::f32x4 (&acc)[2][2][4][2], const pg8::Unit& u, int wr, int wc, int fr, int fq) const {
        if (skip_mt(l, u.pm)) return;
        const int sel = (u.pm % 33) == 0 ? 2 : u.pm / 33;
        const int row0 = u.pm * 256 + wr * 64 + fr, col0 = u.pn * 256 + wc * 32 + 4 * fq;
#pragma unroll
        for (int bj = 0; bj < 2; ++bj)
#pragma unroll
            for (int n = 0; n < 2; ++n) {
                const int col = col0 + bj * 128 + n * 16; const float4 m2 = *(const float4*)(modv + ((size_t)l * 3 + sel) * 6144 + 2 * 1024 + col);
#pragma unroll
                for (int ai = 0; ai < 2; ++ai)
#pragma unroll
                    for (int m = 0; m < 4; ++m) {
                        float4* hp = (float4*)(H + (size_t)(row0 + ai * 128 + m * 16) * D + col); float4 hv = *hp; const pg8::f32x4 v = acc[ai][bj][m][n];
                        hv.x += m2.x * v[0]; hv.y += m2.y * v[1]; hv.z += m2.z * v[2]; hv.w += m2.w * v[3]; *hp = hv;
                    }
            }
    }
};
struct LatOrder {
    int G, c;
    DI bool next(int i, pg8::Unit& u) const { const int L = i * G + c; if (L >= 256) return false; const int pl = L >> 2; u.pm = (pl >> 5) * 33 + 1 + (pl & 31); u.pn = L & 3; return true; }
    DI void a_ready(const pg8::Unit&) const {}
    DI void done(const pg8::Unit&) const {}
};
struct SplitOrder {
    int mode, c;
    DI bool next(int i, pg8::Unit& u) const {
        if (i > 0) return false;
        int L; if (mode == 1) { if (c < 16) return false; L = c - 16; } else { if (c >= 24) return false; L = 240 + c; }
        u.pm = L >> 2; u.pn = L & 3; return true;
    }
    DI void a_ready(const pg8::Unit&) const {}
    DI void done(const pg8::Unit&) const {}
};
DI void phase_merge2(const Ctx& c, int l, int mode) {
    EpiMerge2 E; E.H = (float*)(c.ws + WS_H); E.modv = (const float*)(c.ws + WS_WSM + OFF_MODV); E.l = l;
    pg8::Gemm g{(const bf16_t*)(c.ws + WS_BUFB), (const bf16_t*)(c.ws + WS_WSM + OFF_WOUTT + l * SZ_WOUTT), NZ, 1024, 1024, 1024, 1024};
    __syncthreads();
    if (mode != 0) {
        SplitOrder S; S.mode = mode; S.c = (int)blockIdx.x;
        pg8::gemm_phase<EpiMerge2, SplitOrder, false>((PG8_LAS unsigned char*)c.smem, g, S, E, nullptr, c.tid);
    } else if (l == NL - 1) {
        LatOrder S; S.G = (int)gridDim.x; S.c = (int)blockIdx.x;
        pg8::gemm_phase<EpiMerge2, LatOrder, false>((PG8_LAS unsigned char*)c.smem, g, S, E, nullptr, c.tid);
    } else {
        pg8::StaticOrder S; S.init(NZ, 1024, (int)gridDim.x, (int)blockIdx.x, MERGE2_WGM);
        pg8::gemm_phase<EpiMerge2, pg8::StaticOrder, false>((PG8_LAS unsigned char*)c.smem, g, S, E, nullptr, c.tid);
    }
}

constexpr int RT_PITCH = 68;
constexpr int RT_RED_W = 8 * 4 * RT_PITCH;
DI void phase_norm2_route(const Ctx& c, int l) {
    unsigned char* ws = c.ws; const int lane = c.lane, wave = c.wave, tid = c.tid;
    const float* modv = (const float*)(ws + WS_WSM + OFF_MODV); const float* H = (const float*)(ws + WS_H);
    bf16_t* XN = (bf16_t*)(ws + WS_BUFA); const float* g2 = c.in[7] + l * 1024;
    const float* rwt = (const float*)(ws + WS_WSM + OFF_RWT) + (size_t)l * 36 * 1024;
    const float* bg = c.in[42] + l * 4; const float* be = c.in[44] + l * 32;
    unsigned* cnt = (unsigned*)(ws + WS_CTL) + CW_CNT + l * 32;
    int* list = (int*)(ws + WS_GT + GT_LIST); float* lw = (float*)(ws + WS_GT + GT_LW);
    float* red = (float*)c.smem + wave * RT_RED_W;
    float* lgs = (float*)c.smem + 8 * RT_RED_W + wave * 8 * 40;
    int* hist = (int*)((float*)c.smem + 8 * RT_RED_W + 8 * 8 * 40);
    int* sel = hist + 64;
    float* selw = (float*)(sel + 128);
    const int ngroups = (l == NL - 1) ? (NB * SEQ / 64) : (NZ / 64);
    for (int grp = blockIdx.x; grp < ngroups; grp += gridDim.x) {
        __syncthreads();
        if (tid < 32) hist[tid] = 0;
        __syncthreads();
        float x[8][16];
#pragma unroll
        for (int i = 0; i < 8; ++i) {
            const int rl = wave * 8 + i; int row;
            if (l == NL - 1) { const int rr = grp * 64 + rl; row = (rr / SEQ) * TZ + CTX + (rr % SEQ); } else row = grp * 64 + rl;
#pragma unroll
            for (int q = 0; q < 4; ++q) { const float4 v = *(const float4*)(H + (size_t)row * D + q * 256 + lane * 4); x[i][q * 4] = v.x; x[i][q * 4 + 1] = v.y; x[i][q * 4 + 2] = v.z; x[i][q * 4 + 3] = v.w; }
        }
        float4 gq4[4], m3q[4], m4q[4];
        {
            int row0; if (l == NL - 1) { const int rr = grp * 64; row0 = (rr / SEQ) * TZ + CTX + (rr % SEQ); } else row0 = grp * 64;
            const int b0 = row0 / TZ, s0 = row0 % TZ, sel0 = s0 < CTX ? 2 : b0;
#pragma unroll
            for (int q = 0; q < 4; ++q) { const int col = q * 256 + lane * 4; gq4[q] = *(const float4*)(g2 + col);
                m3q[q] = *(const float4*)(modv + ((size_t)l * 3 + sel0) * 6144 + 3 * 1024 + col); m4q[q] = *(const float4*)(modv + ((size_t)l * 3 + sel0) * 6144 + 4 * 1024 + col); }
        }
#pragma unroll
        for (int i = 0; i < 8; ++i) {
            const int rl = wave * 8 + i; int row;
            if (l == NL - 1) { const int rr = grp * 64 + rl; row = (rr / SEQ) * TZ + CTX + (rr % SEQ); } else row = grp * 64 + rl;
            float ss = 0.f;
#pragma unroll
            for (int j = 0; j < 16; ++j) ss += x[i][j] * x[i][j];
            ss = wave_sum(ss);
            const float rs = rsqrtf(ss * (1.f / 1024.f) + 1e-6f);
#pragma unroll
            for (int q = 0; q < 4; ++q) {
                const int col = q * 256 + lane * 4;
                const float4 g = gq4[q], m3 = m3q[q], m4 = m4q[q];
                x[i][q * 4] = x[i][q * 4] * rs * g.x * (1.f + m4.x) + m3.x; x[i][q * 4 + 1] = x[i][q * 4 + 1] * rs * g.y * (1.f + m4.y) + m3.y;
                x[i][q * 4 + 2] = x[i][q * 4 + 2] * rs * g.z * (1.f + m4.z) + m3.z; x[i][q * 4 + 3] = x[i][q * 4 + 3] * rs * g.w * (1.f + m4.w) + m3.w;
                *(u32x2*)(XN + (size_t)row * D + col) = pack4(x[i][q * 4], x[i][q * 4 + 1], x[i][q * 4 + 2], x[i][q * 4 + 3]);
            }
        }
#pragma unroll 1
        for (int ec = 0; ec < 9; ++ec) {
#pragma unroll
            for (int ee = 0; ee < 4; ++ee) {
                const int e = ec * 4 + ee;
                float4 w[4];
#pragma unroll
                for (int q = 0; q < 4; ++q) w[q] = *(const float4*)(rwt + (size_t)e * 1024 + q * 256 + lane * 4);
#pragma unroll
                for (int i = 0; i < 8; ++i) {
                    float a = 0.f;
#pragma unroll
                    for (int q = 0; q < 4; ++q) a += x[i][q * 4] * w[q].x + x[i][q * 4 + 1] * w[q].y + x[i][q * 4 + 2] * w[q].z + x[i][q * 4 + 3] * w[q].w;
                    red[(i * 4 + ee) * RT_PITCH + lane] = a;
                }
            }
            __builtin_amdgcn_wave_barrier();
            if (lane < 32) {
                float s0 = 0.f, s1 = 0.f, s2 = 0.f, s3 = 0.f;
#pragma unroll
                for (int q = 0; q < 16; ++q) { const float4 v = *(const float4*)(red + lane * RT_PITCH + q * 4); s0 += v.x; s1 += v.y; s2 += v.z; s3 += v.w; }
                const int e = ec * 4 + (lane & 3);
                lgs[(lane >> 2) * 40 + e] = (s0 + s1) + (s2 + s3) + (e < 4 ? bg[e] : be[e - 4]);
            }
            __builtin_amdgcn_wave_barrier();
        }
        if (lane < 8) {
            const float* lg = lgs + lane * 40;
            float gm = lg[0]; int gsel = 0;
#pragma unroll
            for (int g = 1; g < 4; ++g) if (lg[g] > gm) { gm = lg[g]; gsel = g; }
            const float gs = __expf(lg[0] - gm) + __expf(lg[1] - gm) + __expf(lg[2] - gm) + __expf(lg[3] - gm);
            const float pg = 1.f / gs;
            float l1 = -1e30f, l2 = -1e30f; int e1 = 0, e2 = 0;
#pragma unroll
            for (int j = 0; j < 8; ++j) {
                const float v = lg[4 + gsel * 8 + j]; const int e = gsel * 8 + j;
                if (v > l1) { l2 = l1; e2 = e1; l1 = v; e1 = e; } else if (v > l2) { l2 = v; e2 = e; }
            }
            const float tt = __expf(l2 - l1), w1 = pg / (1.f + tt), w2 = pg * tt / (1.f + tt);
            const int rl = wave * 8 + lane;
            const int r1 = atomicAdd(&hist[e1], 1), r2 = atomicAdd(&hist[e2], 1);
            sel[rl * 2] = e1 | (r1 << 8); sel[rl * 2 + 1] = e2 | (r2 << 8); selw[rl * 2] = w1; selw[rl * 2 + 1] = w2;
        }
        __syncthreads();
        if (tid < 32) hist[32 + tid] = (int)atomicAdd(&cnt[tid], (unsigned)hist[tid]);
        __syncthreads();
        if (tid < 128) {
            const int rl = tid >> 1, j = tid & 1, sv = sel[tid], e = sv & 255, rk = sv >> 8;
            int row;
            if (l == NL - 1) { const int rr = grp * 64 + rl; row = (rr / SEQ) * TZ + CTX + (rr % SEQ); } else row = grp * 64 + rl;
            const size_t pos = (size_t)e * MOE_CAP + hist[32 + e] + rk;
            list[pos] = row * 2 + j; lw[pos] = selw[tid];
        }
    }
    phase_expert_convert(c, l);
}

DI void moe_prefix(const Ctx& c, int l, int* tiles  , int* cnts  ) {
    __syncthreads();
    if (c.tid == 0) {
        const unsigned* cnt = (const unsigned*)(c.ws + WS_CTL) + CW_CNT + l * 32; int acc = 0;
        for (int e = 0; e < 32; ++e) { const int n = (int)__hip_atomic_load(cnt + e, __ATOMIC_RELAXED, __HIP_MEMORY_SCOPE_AGENT); cnts[e] = n; tiles[e] = acc; acc += (n + 127) / 128; }
        tiles[32] = acc;
    }
    __syncthreads();
}
DI void phase_moe1(const Ctx& c, int l) {
    unsigned char* ws = c.ws;
    int* tiles = (int*)(c.smem + 120 * 1024); int* cnts = tiles + 40;
    moe_prefix(c, l, tiles, cnts);
    const bf16_t* XN = (const bf16_t*)(ws + WS_BUFA); bf16_t* HM = (bf16_t*)(ws + WS_GT + GT_HM); const int* list = (const int*)(ws + WS_GT + GT_LIST);
    const int nt_total = tiles[32];
    for (int u = blockIdx.x; u < nt_total * 4; u += gridDim.x) {
        const int mtg = u >> 2, nt = u & 3;
        int e = 0;
        for (int k = 1; k < 32; ++k) if (tiles[k] <= mtg) e = k;
        const int mt = mtg - tiles[e], n_e = cnts[e];
        const int* le = list + (size_t)e * MOE_CAP;
        const bf16_t* W = (const bf16_t*)(ws + WS_EXPW + (size_t)e * SZ_WGU);
        gemm_tile<2, 0>(c, 1024,
            [&](int i) { int p = mt * 128 + i; if (p >= n_e) p = n_e - 1; return XN + (size_t)(le[p] >> 1) * D; },
            [&](int i) { return W + (size_t)(nt * 256 + i) * D; }, NoHook(),
            [&](f32x4 (&acc)[4][4], int wr, int wc, int fr, int fq) {
#pragma unroll
                for (int np = 0; np < 2; ++np) {
                    const int hc = (nt * 256 + wc + np * 32) / 2 + fq * 4;
#pragma unroll
                    for (int m = 0; m < 4; ++m) {
                        const int p = mt * 128 + wr + m * 16 + fr;
                        const f32x4 g = acc[m][np * 2], uu = acc[m][np * 2 + 1];
                        *(u32x2*)(HM + ((size_t)mtg * 128 + wr + m * 16 + fr) * 512 + hc) = pack4(siluf_(g[0]) * uu[0], siluf_(g[1]) * uu[1], siluf_(g[2]) * uu[2], siluf_(g[3]) * uu[3]);
                        (void)p;
                    }
                }
            });
    }
}
DI void phase_moe2(const Ctx& c, int l) {
    unsigned char* ws = c.ws;
    int* tiles = (int*)(c.smem + 120 * 1024); int* cnts = tiles + 40;
    moe_prefix(c, l, tiles, cnts);
    const bf16_t* HM = (const bf16_t*)(ws + WS_GT + GT_HM); const int* list = (const int*)(ws + WS_GT + GT_LIST); const float* lw = (const float*)(ws + WS_GT + GT_LW);
    bf16_t* Y2 = (bf16_t*)(ws + WS_P);
    const int nt_total = tiles[32];
    for (int u = blockIdx.x; u < nt_total * 4; u += gridDim.x) {
        const int mtg = u >> 2, nt = u & 3;
        int e = 0;
        for (int k = 1; k < 32; ++k) if (tiles[k] <= mtg) e = k;
        const int mt = mtg - tiles[e], n_e = cnts[e];
        const int* le = list + (size_t)e * MOE_CAP; const float* lwe = lw + (size_t)e * MOE_CAP;
        const bf16_t* W = (const bf16_t*)(ws + WS_EXPW + 32 * SZ_WGU + (size_t)e * SZ_WD);
        gemm_tile<2, 0>(c, 512,
            [&](int i) { return HM + ((size_t)mtg * 128 + i) * 512; },
            [&](int i) { return W + (size_t)(nt * 256 + i) * 512; }, NoHook(),
            [&](f32x4 (&acc)[4][4], int wr, int wc, int fr, int fq) {
#pragma unroll
                for (int m = 0; m < 4; ++m) {
                    const int p = mt * 128 + wr + m * 16 + fr;
                    if (p < n_e) {
                        const int ent = le[p]; const float wt = lwe[p];
                        bf16_t* yrow = Y2 + ((size_t)(ent & 1) * NZ + (ent >> 1)) * D + nt * 256 + wc + fq * 4;
#pragma unroll
                        for (int n = 0; n < 4; ++n) *(u32x2*)(yrow + n * 16) = pack4(wt * acc[m][n][0], wt * acc[m][n][1], wt * acc[m][n][2], wt * acc[m][n][3]);
                    }
                }
            });
    }
}

constexpr int LDS_BYTES = 150 * 1024 + 256;
static_assert(SQ_END <= LDS_BYTES - 256, "RWKV sequential stages must fit the LDS allocation");
constexpr int STEPS_PER_LAYER = 12, N_STEPS = 2 + NL * STEPS_PER_LAYER;
#ifndef FUSED
#define FUSED 1
#endif

DI const void* launder_ptr(const void* p) {
    const unsigned long long v = (unsigned long long)p;
    unsigned lo = __builtin_amdgcn_readfirstlane((unsigned)v), hi = __builtin_amdgcn_readfirstlane((unsigned)(v >> 32));
    asm volatile("" : "+s"(lo), "+s"(hi) :: "memory");
    return (const void*)(((unsigned long long)hi << 32) | lo);
}
template <int KIND> DI void run_step(const Ctx& c0, int l) {
#ifdef PHM
    if (!((PHM >> KIND) & 1)) return;
#endif
    Ctx c = c0;
    { int z = 0; asm volatile("" : "+s"(z) :: "memory"); c.in = c0.in + z; c.ws = c0.ws + z; c.out = c0.out + z; }
    { int t = c0.tid; asm volatile("" : "+v"(t)); c.tid = t; c.lane = t & 63; c.wave = __builtin_amdgcn_readfirstlane(t >> 6); }
    if (KIND == 0) phase_prologue(c);
    if (KIND == 1) phase_norm1(c, l);
    if (KIND == 2) phase_inproj(c, l);
    if (KIND == 3) { phase_prep(c, l); for (int u = blockIdx.x; u < 2 * S5N * 4; u += gridDim.x) phase_s5_final_unit<true>(c, l, u); }
    if (KIND == 4) { phase_small_gemms(c, l); phase_s5_carry(c, l); }
    if (KIND == 5) { phase_attention(c, l); phase_rwkv_chunks(c, l); }
    if (KIND == 6) phase_mixers2(c, l);
    if (KIND == 7) phase_post(c, l);
    if (KIND == 8) phase_merge1(c, l, 0);
    if (KIND == 9) { if (!merge_split(l)) phase_merge2(c, l, 0); else if (blockIdx.x < 16) phase_merge1(c, l, 1); else phase_merge2(c, l, 1); }
    if (KIND == 14) { if (merge_split(l)) phase_merge2(c, l, 2); }
    if (KIND == 10) phase_norm2_route(c, l);
    if (KIND == 11) phase_moe1(c, l);
    if (KIND == 12) phase_moe2(c, l);
    if (KIND == 13) phase_final(c);
}

#if !FUSED
template <int KIND> __global__ void __launch_bounds__(NTHR, 2) k_step(Args a) {
    extern __shared__ __attribute__((aligned(16))) unsigned char lds[];
    Ctx c; c.in = a.in; c.out = a.out; c.ws = a.ws; c.smem = lds; c.tid = threadIdx.x; c.lane = threadIdx.x & 63; c.wave = __builtin_amdgcn_readfirstlane(threadIdx.x >> 6);
    run_step<KIND>(c, a.s_lo);
}
template <int KIND> static void launch_step(const Args& a, int grid, hipStream_t stream) {
    static bool attr = false;
    if (!attr) { (void)hipFuncSetAttribute((const void*)k_step<KIND>, hipFuncAttributeMaxDynamicSharedMemorySize, LDS_BYTES); attr = true; }
    hipLaunchKernelGGL(k_step<KIND>, dim3(grid), dim3(NTHR), LDS_BYTES, stream, a);
}
#else
__global__ void __launch_bounds__(NTHR, 2) fwd_kernel(Args a) {
    extern __shared__ __attribute__((aligned(16))) unsigned char lds[];
    Ctx c; c.in = a.in; c.out = a.out; c.ws = a.ws; c.smem = lds; c.tid = threadIdx.x; c.lane = threadIdx.x & 63; c.wave = __builtin_amdgcn_readfirstlane(threadIdx.x >> 6);
    volatile LAS unsigned* xbw = (volatile LAS unsigned*)(lds + LDS_BYTES - 16);
    for (int i = threadIdx.x; i < LDS_BYTES / 16; i += NTHR) ((uint4*)lds)[i] = make_uint4(0u, 0u, 0u, 0u);
    __syncthreads();
    if (threadIdx.x == 0) { xbw[0] = 0u; xbw[1] = 0u; }
    __syncthreads();
    XcdBarrier bar = xcd_barrier_post((unsigned*)(a.ws + WS_CTL) + CW_BAR, xbw);
#ifndef REP_MASK
#define REP_MASK 0
#endif
#define GBAR() do { XcdBarrier bb = bar; int zz = 0; asm volatile("" : "+s"(zz) :: "memory"); bb.bar = bar.bar + zz; xcd_barrier(bb); } while (0)
#define STEP(K, L) do { run_step<K>(c, L); GBAR(); if ((REP_MASK >> K) & 1) { run_step<K>(c, L); GBAR(); } } while (0)
    STEP(0, 0);
    for (int l = 0; l < NL; ++l) {
        STEP(1, l); STEP(2, l); STEP(3, l); STEP(4, l); STEP(5, l); STEP(6, l); STEP(7, l); STEP(8, l); STEP(9, l); if (l == 0 && NL > 1) STEP(14, l); STEP(10, l); STEP(11, l); STEP(12, l);
    }
#undef STEP
    run_step<13>(c, 0);
}
#endif

extern "C" void kernel_launch(void* const* d_in, const int* in_sizes, int n_in, void* d_out, int out_size, void* d_ws, size_t ws_size, hipStream_t stream) {
    static int grid = 0;
    if (grid == 0) {
        if (n_in != 49 || out_size != NB * SEQ * D || ws_size < WS_END) { fprintf(stderr, "kernel_launch: unexpected problem (n_in %d out %d ws %zu need %zu)\n", n_in, out_size, ws_size, (size_t)WS_END); grid = -1; return; }
        int dev = 0, cus = 0;
        if (hipGetDevice(&dev) != hipSuccess || hipDeviceGetAttribute(&cus, hipDeviceAttributeMultiprocessorCount, dev) != hipSuccess) { grid = -1; return; }
#if FUSED
        int per_cu = 0;
        if (hipFuncSetAttribute((const void*)fwd_kernel, hipFuncAttributeMaxDynamicSharedMemorySize, LDS_BYTES) != hipSuccess) { fprintf(stderr, "kernel_launch: hipFuncSetAttribute failed\n"); grid = -1; return; }
        if (hipOccupancyMaxActiveBlocksPerMultiprocessor(&per_cu, (const void*)fwd_kernel, NTHR, LDS_BYTES) != hipSuccess || per_cu < 1) { fprintf(stderr, "kernel_launch: occupancy query says %d\n", per_cu); }
        (void)hipGetLastError();
#endif
        grid = cus;
    }
    if (grid < 0) return;
    (void)hipMemsetAsync((char*)d_ws + WS_CTL, 0, CTL_BYTES, stream);
    Args a{};
    for (int i = 0; i < 49; ++i) a.in[i] = (const float*)d_in[i];
    a.out = (float*)d_out; a.ws = (unsigned char*)d_ws;
#if !FUSED
    a.s_lo = 0; a.s_hi = 0; launch_step<0>(a, grid, stream);
    for (int l = 0; l < NL; ++l) {
        a.s_lo = l;
        launch_step<1>(a, grid, stream); launch_step<2>(a, grid, stream); launch_step<3>(a, grid, stream); launch_step<4>(a, grid, stream);
        launch_step<5>(a, grid, stream); launch_step<6>(a, grid, stream); launch_step<7>(a, grid, stream); launch_step<8>(a, grid, stream);
        launch_step<9>(a, grid, stream); if (l == 0 && NL > 1) launch_step<14>(a, grid, stream); launch_step<10>(a, grid, stream); launch_step<11>(a, grid, stream); launch_step<12>(a, grid, stream);
    }
    a.s_lo = 0; launch_step<13>(a, grid, stream);
#else
    a.s_lo = 0; a.s_hi = N_STEPS; hipLaunchKernelGGL(fwd_kernel, dim3(grid), dim3(NTHR), LDS_BYTES, stream, a);
#endif
}
```

```cpp
#include <hip/hip_runtime.h>
#include <stdint.h>
#include <stdio.h>

#define DI __device__ __forceinline__
#define LAS __attribute__((address_space(3)))
typedef unsigned short bf16_t;
typedef short bf16x8 __attribute__((ext_vector_type(8)));
typedef short s16x4 __attribute__((ext_vector_type(4)));
typedef float f32x4 __attribute__((ext_vector_type(4)));
typedef float f32x16 __attribute__((ext_vector_type(16)));
typedef float f32x2 __attribute__((ext_vector_type(2)));
typedef __bf16 bf16x2v __attribute__((ext_vector_type(2)));
typedef unsigned u32x4 __attribute__((ext_vector_type(4)));
typedef unsigned u32x2 __attribute__((ext_vector_type(2)));

constexpr int D = 1024, NB = 2, SEQ = 8192, CTX = 256, TZ = 8448, NZ = 16896, NL = 2;
constexpr int NIN = 6560, NINP = 6656;
constexpr int NTHR = 512;
constexpr float LOG2E = 1.4426950408889634f;

#define XB_TMO      128
#define XB_XCNT(j)  (256  + 64 * (j))
#define XB_XSUB(j)  (1280 + 64 * (j))
#define XB_XGEN(j)  (2304 + 64 * (j))
#define XB_TOP      3328
#define XB_TOPGEN   3392
#define XCD_BAR_WORDS 3456
#define XB_SPIN_CAP (1u << 18)

__device__ __forceinline__ unsigned xb_ld(unsigned* p)              { return __hip_atomic_load(p, __ATOMIC_RELAXED, __HIP_MEMORY_SCOPE_AGENT); }
__device__ __forceinline__ unsigned xb_add(unsigned* p, unsigned v) { return __hip_atomic_fetch_add(p, v, __ATOMIC_RELAXED, __HIP_MEMORY_SCOPE_AGENT); }
__device__ __forceinline__ unsigned xb_xcc_id() { return (unsigned)__builtin_amdgcn_s_getreg((3 << 11) | 20) & 0xFu; }
#define XB_SPIN(cond, bar) do { unsigned _sp = 0; while (cond) { __builtin_amdgcn_s_sleep(1); \
    if ((++_sp & 255u) == 0u) { if (xb_ld(&(bar)[XB_TMO])) break; if (_sp > XB_SPIN_CAP) { atomicAdd(&(bar)[XB_TMO], 1u); break; } } } } while (0)

struct XcdBarrier { unsigned* bar; unsigned x; volatile LAS unsigned* st; };

__device__ __forceinline__ XcdBarrier xcd_barrier_post(unsigned* bar, volatile LAS unsigned* st) {
    XcdBarrier b; b.bar = bar; b.x = xb_xcc_id(); b.st = st;
    if (threadIdx.x == 0) (void)xb_add(&bar[XB_XCNT(b.x)], 1u);
    return b;
}
__device__ __forceinline__ void xcd_barrier_complete(unsigned* bar, unsigned x, unsigned& nloc, unsigned& nx) {
    const unsigned G = gridDim.x * gridDim.y * gridDim.z;
    unsigned sum, cnt, mine, sp = 0u;
    for (;;) {
        sum = 0u; cnt = 0u; mine = 0u;
#pragma unroll
        for (unsigned j = 0; j < 16; ++j) { const unsigned c = xb_ld(&bar[XB_XCNT(j)]); sum += c; cnt += (c > 0u) ? 1u : 0u; mine = (j == x) ? c : mine; }
        if (sum == G) break;
        __builtin_amdgcn_s_sleep(1);
        if ((++sp & 255u) == 0u) { if (xb_ld(&bar[XB_TMO])) break; if (sp > XB_SPIN_CAP) { atomicAdd(&bar[XB_TMO], 1u); break; } }
    }
    nloc = mine > 0u ? mine : 1u; nx = cnt > 0u ? cnt : 1u;
}
__device__ __forceinline__ void xcd_barrier(const XcdBarrier& b) {
    asm volatile("s_waitcnt vmcnt(0)" ::: "memory");
    __syncthreads();
    if (threadIdx.x == 0) {
        unsigned* bar = b.bar;
        __builtin_amdgcn_s_waitcnt(0);
        unsigned nloc = b.st[0], nx = b.st[1];
        if (nloc == 0u) { xcd_barrier_complete(bar, b.x, nloc, nx); b.st[0] = nloc; b.st[1] = nx; }
        const unsigned old = xb_add(&bar[XB_XSUB(b.x)], 1u);
        const unsigned gen = old / nloc;
        if (old + 1u == (gen + 1u) * nloc) {
            __builtin_amdgcn_fence(__ATOMIC_RELEASE, "agent");
            asm volatile("s_waitcnt vmcnt(0)" ::: "memory");
            const unsigned og = xb_add(&bar[XB_TOP], 1u);
            const unsigned tg = og / nx;
            if (og + 1u == (tg + 1u) * nx) xb_add(&bar[XB_TOPGEN], 1u);
            else XB_SPIN(xb_ld(&bar[XB_TOPGEN]) == tg, bar);
            __builtin_amdgcn_fence(__ATOMIC_ACQUIRE, "agent");
            xb_add(&bar[XB_XGEN(b.x)], 1u);
            asm volatile("s_waitcnt vmcnt(0)" ::: "memory");
        } else {
            XB_SPIN(xb_ld(&bar[XB_XGEN(b.x)]) == gen, bar);
            __builtin_amdgcn_fence(__ATOMIC_ACQUIRE, "agent");
            asm volatile("s_waitcnt vmcnt(0)" ::: "memory");
        }
    }
    __syncthreads();
}

DI float bf2f(bf16_t v) { return __uint_as_float((unsigned)v << 16); }
DI unsigned pack2(float a, float b) { f32x2 v = {a, b}; bf16x2v r = __builtin_convertvector(v, bf16x2v); return __builtin_bit_cast(unsigned, r); }
DI bf16_t f2bf(float a) { return (bf16_t)(pack2(a, 0.f) & 0xffffu); }
DI float lo2f(unsigned u) { return __uint_as_float(u << 16); }
DI float hi2f(unsigned u) { return __uint_as_float(u & 0xffff0000u); }
DI float wave_sum(float v) {
#pragma unroll
    for (int m = 32; m >= 1; m >>= 1) v += __shfl_xor(v, m, 64);
    return v;
}
DI float sum16(float v) {
#pragma unroll
    for (int m = 8; m >= 1; m >>= 1) v += __shfl_xor(v, m, 64);
    return v;
}
DI float sigmoidf_(float x) { return __builtin_amdgcn_rcpf(1.f + __expf(-x)); }
DI float siluf_(float x) { return x * __builtin_amdgcn_rcpf(1.f + __expf(-x)); }
DI float gelu_tanh(float x) { const float u = 0.7978845608028654f * (x + 0.044715f * x * x * x); return x * __builtin_amdgcn_rcpf(1.f + __expf(-2.f * u)); }
DI float tanhf_(float x) { return 2.f * __builtin_amdgcn_rcpf(1.f + __expf(-2.f * x)) - 1.f; }
DI void unpack4(u32x2 u, float (&f)[4]) { f[0] = lo2f(u.x); f[1] = hi2f(u.x); f[2] = lo2f(u.y); f[3] = hi2f(u.y); }
DI u32x2 pack4(float a, float b, float c, float d) { u32x2 r; r.x = pack2(a, b); r.y = pack2(c, d); return r; }

constexpr size_t algn(size_t x) { return (x + 255) & ~(size_t)255; }
constexpr size_t WS_CTL   = 0;
constexpr size_t CTL_BYTES = 64 * 1024;
constexpr size_t WS_H     = WS_CTL + CTL_BYTES;
constexpr size_t WS_WSM   = WS_H + (size_t)NZ * D * 4;
constexpr size_t SZ_WINT = (size_t)NINP * D * 2, SZ_WUQT = 384 * 256 * 2, SZ_WUKVT = 512 * 128 * 2, SZ_W2T = 512 * 64 * 2, SZ_A2T = 512 * 64 * 2,
                 SZ_G2T = 256 * 128 * 2, SZ_GLUT = 256 * 256 * 2, SZ_WBT = (size_t)D * D * 2, SZ_WOUTT = (size_t)D * D * 2;
constexpr size_t OFF_WINT = 0, OFF_WUQT = OFF_WINT + NL * SZ_WINT, OFF_WUKVT = OFF_WUQT + NL * SZ_WUQT, OFF_W2T = OFF_WUKVT + NL * SZ_WUKVT,
                 OFF_A2T = OFF_W2T + NL * SZ_W2T, OFF_G2T = OFF_A2T + NL * SZ_A2T, OFF_GLUT = OFF_G2T + NL * SZ_G2T, OFF_WBT = OFF_GLUT + NL * SZ_GLUT,
                 OFF_WOUTT = OFF_WBT + NL * SZ_WBT, OFF_MODV = OFF_WOUTT + NL * SZ_WOUTT,
                 OFF_ROPE = OFF_MODV + (size_t)NL * 3 * 6144 * 4,
                 OFF_S5T = OFF_ROPE + (size_t)SEQ * 16 * 2 * 4,
                 OFF_RWT = OFF_S5T + (size_t)NL * 2 * 16 * 64 * 36 * 4,
                 OFF_LAM = OFF_RWT + (size_t)NL * 36 * 1024 * 4,
                 OFF_S5E = OFF_LAM + 256,
                 OFF_S5C = OFF_S5E,
                 WSM_BYTES = algn(OFF_S5E + (size_t)2 * 2 * 16 * 132 * 64 * 2 * 4);
constexpr size_t WS_EXPW  = WS_WSM + WSM_BYTES;
constexpr size_t SZ_WGU = (size_t)1024 * 1024 * 2, SZ_WD = (size_t)1024 * 512 * 2;
constexpr size_t EXPW_BYTES = 32 * (SZ_WGU + SZ_WD);
constexpr size_t SZ_QM = (size_t)NB * 4 * TZ * 96 * 2, SZ_VMT = (size_t)NB * 4 * 64 * TZ * 2, SZ_QD = (size_t)NB * 4 * TZ * 64 * 2, SZ_R256 = (size_t)NZ * 256 * 2;
constexpr size_t MX_QM = 0, MX_KM = MX_QM + SZ_QM, MX_VMT = MX_KM + SZ_QM, MX_QD = MX_VMT + SZ_VMT, MX_KD = MX_QD + SZ_QD, MX_VDT = MX_KD + SZ_QD,
                 MX_RB = MX_VDT + SZ_VMT, MX_KB = MX_RB + SZ_R256, MX_VB = MX_KB + SZ_R256, MX_KKB = MX_VB + SZ_R256, MX_END = MX_KKB + SZ_R256;
static_assert(MX_END <= EXPW_BYTES, "mixer operands must fit the expert-weight region");
constexpr size_t WS_BUFA  = WS_EXPW + EXPW_BYTES;
constexpr size_t WS_BUFB  = WS_BUFA + (size_t)NZ * D * 2;
constexpr size_t WS_P     = WS_BUFB + (size_t)NZ * D * 2;
constexpr size_t P_PM = 0, P_PS = P_PM + (size_t)NZ * 416 * 2, P_PR = P_PS + (size_t)NZ * 256 * 2, P_PD = P_PR + (size_t)NZ * 1024 * 2, P_BYTES = P_PD + (size_t)NZ * 768 * 2;
static_assert((size_t)6 * SZ_R256 <= (size_t)NZ * (1024 + 768) * 2, "scan operands must fit PR|PD");
static_assert((size_t)2 * NZ * D * 2 <= P_BYTES, "the MoE outputs (2 x bf16 [NZ][D]) must fit the P region");
constexpr size_t WS_GT    = WS_P + P_BYTES;
constexpr size_t GT_BYTES = (size_t)NZ * 4096 * 2;
constexpr int MOE_CAP = 33792;
constexpr size_t GT_HM = 0, GT_LIST = GT_HM + (size_t)(33792 + 32 * 128) * 512 * 2, GT_LW = GT_LIST + (size_t)32 * MOE_CAP * 4, GT_END = GT_LW + (size_t)32 * MOE_CAP * 4;
static_assert(GT_END <= GT_BYTES, "MoE scratch must fit the gate region");
constexpr size_t WS_MISC  = WS_GT + GT_BYTES;
constexpr size_t MS_CQN = 0, MS_TW = MS_CQN + (size_t)NZ * 384 * 2, MS_AL = MS_TW + (size_t)NZ * 64 * 2, MS_SG = MS_AL + (size_t)NZ * 64 * 2,
                 MS_GG = MS_SG + (size_t)NZ * 128 * 2, MS_ZG = MS_GG + SZ_R256, MS_END = MS_ZG + SZ_R256;
constexpr size_t WS_RW    = WS_MISC + MS_END;
constexpr int RC = 64, RNC = TZ / RC;
constexpr size_t SZ_RWM = (size_t)16 * RNC * 4096 * 2;
constexpr size_t RW_M3 = 0, RW_M2 = SZ_RWM, RW_Z5 = 2 * SZ_RWM, RW_P63 = 3 * SZ_RWM, RW_END = RW_P63 + (size_t)16 * RNC * 64 * 4;
constexpr size_t WS_END   = WS_RW + RW_END;

constexpr int CW_BAR = 0;
constexpr int CW_CNT = 4096;

struct Args { const float* in[49]; float* out; unsigned char* ws; int s_lo, s_hi; };

struct Ctx {
    const float* const* in; float* out; unsigned char* ws; unsigned char* smem; int tid, lane, wave;
};

template <int WM> struct GCfg { static constexpr int WN = 8 / WM, BM = 64 * WM, BN = 64 * WN, ABYTES = BM * 128, BBYTES = BN * 128, STAGE = ABYTES + BBYTES; };

template <int WM, int SEGK, class ARow, class BRow, class Hook, class Epi>
DI void gemm_tile(const Ctx& c, int K, ARow arow, BRow brow, Hook hook, Epi epi) {
    typedef GCfg<WM> G;
    const int tid = c.tid, lane = c.lane, wave = c.wave;
    const int wm = wave / G::WN, wn = wave % G::WN, fr = lane & 15, fq = lane >> 4;
    unsigned char* smem = c.smem;
    constexpr int NA = G::BM / 64, NBq = G::BN / 64;
    const int r0 = tid >> 3, coff = ((tid & 7) ^ (r0 & 7)) * 8;
    auto stage = [&](int kt, int buf) {
        unsigned char* sa = smem + buf * G::STAGE; unsigned char* sb = sa + G::ABYTES;
#pragma unroll
        for (int i = 0; i < NA; ++i) __builtin_amdgcn_global_load_lds((const unsigned*)(arow(r0 + 64 * i) + coff + kt * 64), (unsigned*)(sa + (tid + i * NTHR) * 16), 16, 0, 0);
#pragma unroll
        for (int i = 0; i < NBq; ++i) __builtin_amdgcn_global_load_lds((const unsigned*)(brow(r0 + 64 * i) + coff + kt * 64), (unsigned*)(sb + (tid + i * NTHR) * 16), 16, 0, 0);
    };
    f32x4 acc[4][4];
#pragma unroll
    for (int m = 0; m < 4; ++m)
#pragma unroll
        for (int n = 0; n < 4; ++n) acc[m][n] = (f32x4){0.f, 0.f, 0.f, 0.f};
    const int T = K / 64;
    __syncthreads();
    stage(0, 0);
    for (int t = 0; t < T; ++t) {
        asm volatile("s_waitcnt vmcnt(0)" ::: "memory");
        __syncthreads();
        if (t + 1 < T) stage(t + 1, (t + 1) & 1);
        const unsigned char* sa = smem + (t & 1) * G::STAGE; const unsigned char* sb = sa + G::ABYTES;
#pragma unroll
        for (int ks = 0; ks < 2; ++ks) {
            bf16x8 af[4], bfr[4];
            const int sl = ((ks * 4 + fq) ^ (fr & 7)) * 16;
#pragma unroll
            for (int m = 0; m < 4; ++m) af[m] = *(const bf16x8*)(sa + (wm * 64 + m * 16 + fr) * 128 + sl);
#pragma unroll
            for (int n = 0; n < 4; ++n) bfr[n] = *(const bf16x8*)(sb + (wn * 64 + n * 16 + fr) * 128 + sl);
#pragma unroll
            for (int m = 0; m < 4; ++m)
#pragma unroll
                for (int n = 0; n < 4; ++n) acc[m][n] = __builtin_amdgcn_mfma_f32_16x16x32_bf16(bfr[n], af[m], acc[m][n], 0, 0, 0);
        }
        if (SEGK > 0) { if (((t + 1) * 64) % (SEGK > 0 ? SEGK : 64) == 0) hook(acc, ((t + 1) * 64) / (SEGK > 0 ? SEGK : 64) - 1, wm * 64, wn * 64, fr, fq); }
    }
    epi(acc, wm * 64, wn * 64, fr, fq);
}
struct NoHook { DI void operator()(f32x4 (&)[4][4], int, int, int, int, int) const {} };

#ifndef INPROJ_WGM
#define INPROJ_WGM 4
#define MERGE2_WGM 8
#endif
namespace pg8 {
#define PG8_LAS __attribute__((address_space(3)))
typedef unsigned short bf16_t;
typedef short bf16x8 __attribute__((ext_vector_type(8)));
typedef float f32x4 __attribute__((ext_vector_type(4)));
constexpr int BM = 256, BK = 64, HALF = 128, HTB = HALF * BK * 2  , STAGE_BYTES = 8 * HTB, NXCD = 8, WGM = 4;

__host__ __device__ __forceinline__ int lds_byte(int r, int c) { const int st = (r >> 4) * 2 + (c >> 5), rr = r & 15, cc = c & 31, ob = rr * 64 + cc * 2; return st * 1024 + (ob ^ (((ob >> 9) & 1) << 5)); }
__host__ __device__ __forceinline__ void stage_rc(int b, int& R, int& C) { const int st = b / 1024, sb = b % 1024, swz = sb ^ (((sb >> 9) & 1) << 5); R = (st >> 1) * 16 + swz / 64; C = (st & 1) * 32 + (swz % 64) / 2; }
__host__ __device__ __forceinline__ int perm32(int rho) { const int n = rho >> 4, i = rho & 15; return 8 * (i >> 2) + 4 * n + (i & 3); }

struct Unit { int pm, pn; };
struct Gemm { const bf16_t* A; const bf16_t* Bt; int M, N, K, lda, ldb; };

struct StaticOrder {
    int nM, nN, nwg, G, c, wgm;
    __host__ __device__ void init(int M, int N, int G_, int c_, int wgm_ = WGM) { nM = M / BM; nN = N / BM; nwg = nM * nN; G = G_; c = c_; wgm = wgm_; }
    __host__ __device__ bool next(int i, Unit& u) const {
        const long L = (long)i * G + c; if (L >= nwg) return false;
        int wgid = (int)L; { const int q = nwg / NXCD, r = nwg % NXCD, xcd = wgid % NXCD, off = wgid / NXCD; wgid = (xcd < r ? xcd * (q + 1) : r * (q + 1) + (xcd - r) * q) + off; }
        const int nig = wgm * nN, gid = wgid / nig, fm = gid * wgm, gsz = (nM - fm) < wgm ? (nM - fm) : wgm;
        u.pm = fm + ((wgid % nig) % gsz); u.pn = (wgid % nig) / gsz; return true;
    }
    __device__ __forceinline__ void a_ready(const Unit&) const {}
    __device__ __forceinline__ void done(const Unit&) const {}
};
template <class Epi, class Sched, bool STAMP = false>
__device__ __forceinline__ void gemm_phase(PG8_LAS unsigned char* lds, const Gemm g, const Sched& S, const Epi& E, unsigned long long* stamps, int tid_in) {
    const int tid = tid_in, wid = __builtin_amdgcn_readfirstlane(tid >> 6), lane = tid & 63, wr = wid >> 2, wc = wid & 3, fr = lane & 15, fq = lane >> 4;
    const int K = g.K, nt = K / BK;
    int ts_lo = 0, ts_hi = 0, nts = 0; const unsigned long long rt_entry = STAMP ? (unsigned long long)wall_clock64() : 0ull;
#define PG8_STAMP() do { if (STAMP && wid == 0 && nts < 64) { const unsigned long long _c = (unsigned long long)clock64(); \
        ts_lo = (lane == nts) ? (int)(unsigned)_c : ts_lo; ts_hi = (lane == nts) ? (int)(unsigned)(_c >> 32) : ts_hi; ++nts; } } while (0)
    PG8_STAMP();
    unsigned voffA[2], voffB[2];
#pragma unroll
    for (int i = 0; i < 2; ++i) { int R, C; stage_rc(tid * 16 + i * 8192, R, C); const int Rb = Epi::PERM ? ((R & ~31) + perm32(R & 31)) : R;
        voffA[i] = (unsigned)(R * g.lda + C) * 2u; voffB[i] = (unsigned)(Rb * g.ldb + C) * 2u; }
    const size_t kstep = (size_t)(BK * 2);
    const size_t hstepA = (size_t)HALF * g.lda * 2, hstepB = (size_t)HALF * g.ldb * 2;
    const size_t tstepA = 2 * hstepA, tstepB = 2 * hstepB;
    const unsigned ldsw = (unsigned)wid * 1024u;
    const int aoff = lds_byte(wr * 64 + fr, fq * 8), boff = lds_byte(wc * 32 + fr, fq * 8);
#define PG8_SA(b, h) (((b) * 2 + (h)) * HTB)
#define PG8_SB(b, h) ((4 + (b) * 2 + (h)) * HTB)
#define PG8_STAGE(bufoff, gbase, voff) do { _Pragma("unroll") for (int _i = 0; _i < 2; ++_i) \
        __builtin_amdgcn_global_load_lds((const unsigned*)((const char*)(gbase) + (voff)[_i]), (PG8_LAS unsigned*)(lds + (bufoff) + ldsw + _i * 8192), 16, 0, 0); } while (0)
#define PG8_LDA(dst, b, h) do { _Pragma("unroll") for (int m = 0; m < 4; ++m) _Pragma("unroll") for (int k = 0; k < 2; ++k) dst[m][k] = *(const PG8_LAS bf16x8*)(lds + PG8_SA(b, h) + aoff + m * 2048 + k * 1024); } while (0)
#define PG8_LDB(dst, b, h) do { _Pragma("unroll") for (int n = 0; n < 2; ++n) _Pragma("unroll") for (int k = 0; k < 2; ++k) dst[n][k] = *(const PG8_LAS bf16x8*)(lds + PG8_SB(b, h) + boff + n * 2048 + k * 1024); } while (0)
#define PG8_MMA(ai, bj, At, Bt) do { __builtin_amdgcn_s_setprio(1); _Pragma("unroll") for (int m = 0; m < 4; ++m) _Pragma("unroll") for (int n = 0; n < 2; ++n) _Pragma("unroll") for (int k = 0; k < 2; ++k) \
        acc[ai][bj][m][n] = __builtin_amdgcn_mfma_f32_16x16x32_bf16(Bt[n][k], At[m][k], acc[ai][bj][m][n], 0, 0, 0); __builtin_amdgcn_s_setprio(0); } while (0)
#define PG8_WAIT_V(n) asm volatile("s_waitcnt vmcnt(" #n ")" ::: "memory")
#define PG8_WAIT_L(n) asm volatile("s_waitcnt lgkmcnt(" #n ")" ::: "memory")
#define PG8_BAR __builtin_amdgcn_s_barrier()
#define PG8_SCHED __builtin_amdgcn_sched_barrier(0)
    Unit cur, nxt; int ui = 0;
    if (!S.next(0, cur)) return;
    f32x4 acc[2][2][4][2];
#pragma unroll
    for (int a = 0; a < 2; ++a)
#pragma unroll
        for (int b = 0; b < 2; ++b)
#pragma unroll
            for (int m = 0; m < 4; ++m)
#pragma unroll
                for (int n = 0; n < 2; ++n) acc[a][b][m][n] = (f32x4){0.f, 0.f, 0.f, 0.f};
    bf16x8 At[4][2], B0[2][2], B1[2][2];
    const char* cA = (const char*)g.A + (size_t)cur.pm * tstepA; const char* cB = (const char*)g.Bt + (size_t)cur.pn * tstepB;
    S.a_ready(cur);
    PG8_STAGE(PG8_SB(0, 0), cB, voffB); PG8_STAGE(PG8_SA(0, 0), cA, voffA); PG8_STAGE(PG8_SB(0, 1), cB + hstepB, voffB); PG8_STAGE(PG8_SA(0, 1), cA + hstepA, voffA);
    if (wr == 1) PG8_BAR;
    PG8_WAIT_V(4); PG8_BAR;
    PG8_STAGE(PG8_SB(1, 0), cB + kstep, voffB); PG8_STAGE(PG8_SA(1, 0), cA + kstep, voffA); PG8_STAGE(PG8_SB(1, 1), cB + hstepB + kstep, voffB);
    PG8_WAIT_V(6); PG8_BAR;
    PG8_STAMP();
    for (;;) {
        const bool has_next = S.next(ui + 1, nxt);
        const char* nA = has_next ? (const char*)g.A + (size_t)nxt.pm * tstepA : cA; const char* nB = has_next ? (const char*)g.Bt + (size_t)nxt.pn * tstepB : cB;
        for (int t = 0; t < nt; t += 2) {
            const bool last = (t == nt - 2);
            const char* a1 = cA + (size_t)(t + 1) * kstep;
            const char* a2 = last ? nA : cA + (size_t)(t + 2) * kstep; const char* b2 = last ? nB : cB + (size_t)(t + 2) * kstep;
            const char* a3 = a2 + kstep; const char* b3 = b2 + kstep;
            if (last && has_next) S.a_ready(nxt);
            PG8_LDB(B0, 0, 0); PG8_SCHED; PG8_LDA(At, 0, 0); PG8_STAGE(PG8_SA(1, 1), a1 + hstepA, voffA);
            PG8_WAIT_L(8); PG8_BAR; PG8_WAIT_L(0); PG8_MMA(0, 0, At, B0); PG8_BAR; PG8_SCHED;
            PG8_LDB(B1, 0, 1); PG8_STAGE(PG8_SB(0, 0), b2, voffB);
            PG8_BAR; PG8_WAIT_L(0); PG8_MMA(0, 1, At, B1); PG8_BAR;
            PG8_LDA(At, 0, 1); PG8_STAGE(PG8_SA(0, 0), a2, voffA);
            PG8_BAR; PG8_WAIT_L(0); PG8_MMA(1, 0, At, B0); PG8_BAR; PG8_SCHED;
            PG8_STAGE(PG8_SB(0, 1), b2 + hstepB, voffB);
            PG8_WAIT_V(6); PG8_BAR; PG8_MMA(1, 1, At, B1); PG8_BAR;
            PG8_LDB(B0, 1, 0); PG8_SCHED; PG8_LDA(At, 1, 0); PG8_STAGE(PG8_SA(0, 1), a2 + hstepA, voffA);
            PG8_WAIT_L(8); PG8_BAR; PG8_WAIT_L(0); PG8_MMA(0, 0, At, B0); PG8_BAR; PG8_SCHED;
            PG8_LDB(B1, 1, 1); PG8_STAGE(PG8_SB(1, 0), b3, voffB);
            PG8_BAR; PG8_WAIT_L(0); PG8_MMA(0, 1, At, B1); PG8_BAR;
            PG8_LDA(At, 1, 1); PG8_STAGE(PG8_SA(1, 0), a3, voffA);
            PG8_BAR; PG8_WAIT_L(0); PG8_MMA(1, 0, At, B0); PG8_BAR; PG8_SCHED;
            PG8_STAGE(PG8_SB(1, 1), b3 + hstepB, voffB);
            PG8_WAIT_V(6); PG8_BAR; PG8_MMA(1, 1, At, B1); PG8_BAR;
        }
        PG8_STAMP();
        if constexpr (!Epi::AFTER_DRAIN) { E(acc, cur, wr, wc, fr, fq); S.done(cur); }
        PG8_STAMP();
        if (!has_next) break;
#pragma unroll
        for (int a = 0; a < 2; ++a)
#pragma unroll
            for (int b = 0; b < 2; ++b)
#pragma unroll
                for (int m = 0; m < 4; ++m)
#pragma unroll
                    for (int n = 0; n < 2; ++n) acc[a][b][m][n] = (f32x4){0.f, 0.f, 0.f, 0.f};
        cur = nxt; cA = nA; cB = nB; ++ui;
    }
    PG8_WAIT_V(0);
    if (wr == 0) PG8_BAR;
    PG8_BAR;
    if constexpr (Epi::AFTER_DRAIN) { E.fused(acc, cur, wr, wc, fr, fq, lds, wid, lane); S.done(cur); }
    PG8_STAMP();
    if (STAMP && wid == 0) { stamps[lane] = lane < nts ? (((unsigned long long)(unsigned)ts_hi << 32) | (unsigned)ts_lo) : 0ull;
        if (lane == 62) stamps[62] = rt_entry; if (lane == 63) stamps[63] = (unsigned long long)wall_clock64(); }
#undef PG8_STAMP
#undef PG8_SA
#undef PG8_SB
#undef PG8_STAGE
#undef PG8_LDA
#undef PG8_LDB
#undef PG8_MMA
#undef PG8_WAIT_V
#undef PG8_WAIT_L
#undef PG8_BAR
#undef PG8_SCHED
}
}

DI int rowmap(int n, int mode) { return mode == 0 ? n : ((n >> 4) * 32 + (n & 15) + (mode == 2 ? 16 : 0)); }
DI void tconv_tile(const Ctx& c, const float* src, int ld, int N, bf16_t* dst, int ld_dst, int mode, int tk, int tn) {
    bf16_t* T = (bf16_t*)c.smem;
    const int k0 = tk * 64, n0 = tn * 64, tid = c.tid;
    __syncthreads();
#pragma unroll
    for (int i = 0; i < 2; ++i) {
        const int kk = (tid >> 4) + i * 32, n4 = (tid & 15) * 4;
        float4 v = make_float4(0.f, 0.f, 0.f, 0.f);
        if (n0 + n4 < N) v = *(const float4*)(src + (size_t)(k0 + kk) * ld + n0 + n4);
        T[(n4 + 0) * 72 + kk] = f2bf(v.x); T[(n4 + 1) * 72 + kk] = f2bf(v.y); T[(n4 + 2) * 72 + kk] = f2bf(v.z); T[(n4 + 3) * 72 + kk] = f2bf(v.w);
    }
    __syncthreads();
    const int n = tid >> 3, k8 = (tid & 7) * 8;
    if (n0 + n < N) *(u32x4*)(dst + (size_t)rowmap(n0 + n, mode) * ld_dst + k0 + k8) = *(const u32x4*)(T + n * 72 + k8);
}
DI void tconv(const Ctx& c, const float* src, int ld, int K, int N, bf16_t* dst, int ld_dst, int mode, int rot) {
    const int ntk = K / 64, ntn = (N + 63) / 64, nt = ntk * ntn, G = gridDim.x;
    for (int t = (blockIdx.x + G - (rot % G)) % G; t < nt; t += G) tconv_tile(c, src, ld, N, dst, ld_dst, mode, t / ntn, t % ntn);
}

DI void wconv(const Ctx& c, const float* src, int ld, int K, int N, bf16_t* dst, int ld_dst, int rot) {
    const int ntk = K / 64, ntn = (N + 63) / 64, nt = ntk * ntn, GW = gridDim.x * 8, w0 = blockIdx.x * 8 + c.wave;
    for (int t = (w0 + GW - (rot % GW)) % GW; t < nt; t += GW) {
        const int tk = t / ntn, tn = t % ntn, n = tn * 64 + c.lane;
        if (n < N) {
            const float* sp = src + (size_t)(tk * 64) * ld + n; bf16_t* dp = dst + (size_t)n * ld_dst + tk * 64;
#pragma unroll
            for (int kb = 0; kb < 8; ++kb) {
                float v[8];
#pragma unroll
                for (int j = 0; j < 8; ++j) v[j] = sp[(size_t)(kb * 8 + j) * ld];
                u32x4 w4; w4.x = pack2(v[0], v[1]); w4.y = pack2(v[2], v[3]); w4.z = pack2(v[4], v[5]); w4.w = pack2(v[6], v[7]);
                *(u32x4*)(dp + kb * 8) = w4;
            }
        }
    }
}
DI void phase_prologue(const Ctx& c) {
    unsigned char* wsm = c.ws + WS_WSM;
    const int tid = c.tid, G = gridDim.x, gtid = blockIdx.x * NTHR + tid, gn = G * NTHR;
    {
        const float4* x = (const float4*)c.in[0]; const float4* cx = (const float4*)c.in[2]; float4* H = (float4*)(c.ws + WS_H);
        for (size_t i = gtid; i < (size_t)NZ * 256; i += gn) {
            const int z = (int)(i >> 8), q = (int)(i & 255), b = z / TZ, s = z % TZ;
            H[i] = (s < CTX) ? cx[((size_t)b * CTX + s) * 256 + q] : x[((size_t)b * SEQ + (s - CTX)) * 256 + q];
        }
    }
    {
        float* rope = (float*)(wsm + OFF_ROPE);
        for (int i = gtid; i < SEQ * 16; i += gn) {
            const int t = i >> 4, a = (i >> 3) & 1, f = i & 7;
            const float pos = (float)(a == 0 ? (t >> 6) : (t & 63));
            const float inv = powf(10000.f, -(float)f / 8.f);
            float sn, cs; sincosf(pos * inv, &sn, &cs);
            rope[i * 2] = cs; rope[i * 2 + 1] = sn;
        }
    }
    {
        float* s5t = (float*)(wsm + OFF_S5T);
        for (int i = blockIdx.x + tid * G; i < NL * 2 * 16 * 64; i += G * NTHR) {
            const int ldg = i >> 6;
            const double lr = c.in[24][i], li = c.in[25][i], dt = exp((double)c.in[26][ldg]);
            const double mag = exp(lr * dt), are = mag * cos(li * dt), aim = mag * sin(li * dt);
            const double m256 = exp(lr * dt * 64.0), a256r = m256 * cos(li * dt * 64.0), a256i = m256 * sin(li * dt * 64.0);
            const double den = lr * lr + li * li, nr = are - 1.0, ni = aim;
            const double cfr = (nr * lr + ni * li) / den, cfi = (ni * lr - nr * li) / den;
            float* o = s5t + (size_t)i * 36;
            o[0] = (float)are; o[1] = (float)aim; o[2] = (float)a256r; o[3] = (float)a256i;
            for (int ch = 0; ch < 16; ++ch) {
                const double br = c.in[27][(size_t)i * 16 + ch], bi = c.in[28][(size_t)i * 16 + ch];
                o[4 + ch] = (float)(cfr * br - cfi * bi); o[20 + ch] = (float)(cfr * bi + cfi * br);
            }
        }
    }
    {
        float* rwt = (float*)(wsm + OFF_RWT);
        for (int i = gtid; i < NL * 36 * 1024; i += gn) {
            const int l = i / (36 * 1024), e = (i / 1024) % 36, d = i & 1023;
            rwt[i] = e < 4 ? c.in[41][((size_t)l * 1024 + d) * 4 + e] : c.in[43][((size_t)l * 1024 + d) * 32 + (e - 4)];
        }
    }
    if (blockIdx.x == 0 && tid < NL) {
        float s1 = 0.f, s2 = 0.f;
        for (int i = 0; i < 32; ++i) { s1 += c.in[34][tid * 32 + i] * c.in[35][tid * 32 + i]; s2 += c.in[36][tid * 32 + i] * c.in[37][tid * 32 + i]; }
        ((float*)(wsm + OFF_LAM))[tid] = expf(s1) - expf(s2) + (0.8f - 0.6f * expf(-0.3f * (float)tid));
    }
    {
        float* sv = (float*)c.smem;
        float* red = sv + 3 * 1024;
        __syncthreads();
        for (int i = tid; i < 3 * 1024; i += NTHR) { const float v = i < 2048 ? c.in[1][i] : c.in[3][i - 2048]; sv[i] = siluf_(v); }
        __syncthreads();
        float* modv = (float*)(wsm + OFF_MODV);
        for (int u = blockIdx.x; u < NL * 96; u += G) {
            const int l = u / 96, col = (u % 96) * 64 + (tid & 63), ks = tid >> 6;
            const float* w = c.in[4] + (size_t)l * 1024 * 6144 + col;
            float a0 = 0.f, a1 = 0.f, a2 = 0.f;
            for (int k = ks * 128; k < ks * 128 + 128; ++k) { const float wv = w[(size_t)k * 6144]; a0 += sv[k] * wv; a1 += sv[1024 + k] * wv; a2 += sv[2048 + k] * wv; }
            red[(ks * 64 + (tid & 63)) * 3 + 0] = a0; red[(ks * 64 + (tid & 63)) * 3 + 1] = a1; red[(ks * 64 + (tid & 63)) * 3 + 2] = a2;
            __syncthreads();
            if (tid < 192) {
                const int cc = tid & 63, sel = tid >> 6; float s = 0.f;
                for (int k2 = 0; k2 < 8; ++k2) s += red[(k2 * 64 + cc) * 3 + sel];
                const int colo = (u % 96) * 64 + cc;
                modv[((size_t)l * 3 + sel) * 6144 + colo] = s + c.in[5][l * 6144 + colo];
            }
            __syncthreads();
        }
    }
    for (int l = 0; l < NL; ++l) {
        wconv(c, c.in[8] + (size_t)l * 1024 * NIN, NIN, 1024, NIN, (bf16_t*)(wsm + OFF_WINT + l * SZ_WINT), 1024, l * 700);
        tconv(c, c.in[11] + (size_t)l * 256 * 384, 384, 256, 384, (bf16_t*)(wsm + OFF_WUQT + l * SZ_WUQT), 256, 0, 40);
        tconv(c, c.in[12] + (size_t)l * 128 * 512, 512, 128, 512, (bf16_t*)(wsm + OFF_WUKVT + l * SZ_WUKVT), 128, 0, 70);
        for (int d = 0; d < 2; ++d) {
            tconv(c, c.in[15] + (size_t)(l * 2 + d) * 64 * 256, 256, 64, 256, (bf16_t*)(wsm + OFF_W2T + l * SZ_W2T) + d * 256 * 64, 64, 0, 90 + d * 8);
            tconv(c, c.in[17] + (size_t)(l * 2 + d) * 64 * 256, 256, 64, 256, (bf16_t*)(wsm + OFF_A2T + l * SZ_A2T) + d * 256 * 64, 64, 0, 110 + d * 8);
        }
        tconv(c, c.in[18] + (size_t)l * 128 * 256, 256, 128, 256, (bf16_t*)(wsm + OFF_G2T + l * SZ_G2T), 128, 0, 130);
        tconv(c, c.in[32] + (size_t)l * 256 * 256, 256, 256, 256, (bf16_t*)(wsm + OFF_GLUT + l * SZ_GLUT), 256, 0, 140);
        for (int n = 0; n < 4; ++n)
            wconv(c, c.in[39] + (size_t)(l * 4 + n) * 256 * 1024, 1024, 256, 1024, (bf16_t*)(wsm + OFF_WBT + l * SZ_WBT) + n * 256, 1024, 300 + n * 64 + l * 1000);
        wconv(c, c.in[40] + (size_t)l * 1024 * 1024, 1024, 1024, 1024, (bf16_t*)(wsm + OFF_WOUTT + l * SZ_WOUTT), 1024, 1200 + l * 400);
    }
}

DI void phase_expert_convert(const Ctx& c, int l) {
    const int G = gridDim.x, lane = c.lane;
    for (int t = blockIdx.x * 8 + c.wave; t < 32 * 384; t += G * 8) {
        const int e = t / 384, r = t % 384;
        const float* src; bf16_t* dst; int ld, ldd, mode, tk, tn;
        if (r < 128)      { src = c.in[45] + ((size_t)l * 32 + e) * 1024 * 512; dst = (bf16_t*)(c.ws + WS_EXPW + (size_t)e * SZ_WGU); ld = 512; ldd = 1024; mode = 1; tk = r / 8; tn = r % 8; }
        else if (r < 256) { src = c.in[46] + ((size_t)l * 32 + e) * 1024 * 512; dst = (bf16_t*)(c.ws + WS_EXPW + (size_t)e * SZ_WGU); ld = 512; ldd = 1024; mode = 2; tk = (r - 128) / 8; tn = (r - 128) % 8; }
        else              { src = c.in[47] + ((size_t)l * 32 + e) * 512 * 1024; dst = (bf16_t*)(c.ws + WS_EXPW + 32 * SZ_WGU + (size_t)e * SZ_WD); ld = 1024; ldd = 512; mode = 0; tk = (r - 256) / 16; tn = (r - 256) % 16; }
        const int n = tn * 64 + lane; const float* sp = src + (size_t)(tk * 64) * ld + n; bf16_t* dp = dst + (size_t)rowmap(n, mode) * ldd + tk * 64;
        float v[64];
#pragma unroll
        for (int k = 0; k < 64; ++k) v[k] = __builtin_nontemporal_load(sp + (size_t)k * ld);
#pragma unroll
        for (int kb = 0; kb < 8; ++kb) {
            u32x4 w4; w4.x = pack2(v[kb * 8], v[kb * 8 + 1]); w4.y = pack2(v[kb * 8 + 2], v[kb * 8 + 3]); w4.z = pack2(v[kb * 8 + 4], v[kb * 8 + 5]); w4.w = pack2(v[kb * 8 + 6], v[kb * 8 + 7]);
            *(u32x4*)(dp + kb * 8) = w4;
        }
    }
}

DI void phase_norm1(const Ctx& c, int l) {
    const float* modv = (const float*)(c.ws + WS_WSM + OFF_MODV);
    float* H = (float*)(c.ws + WS_H); const bf16_t* Y = (const bf16_t*)(c.ws + WS_P);
    bf16_t* XN = (bf16_t*)(c.ws + WS_BUFA);
    const float* g1 = c.in[6] + l * 1024;
    float4 gv[4];
#pragma unroll
    for (int q = 0; q < 4; ++q) gv[q] = *(const float4*)(g1 + q * 256 + c.lane * 4);
    for (int row = blockIdx.x * 8 + c.wave; row < NZ; row += gridDim.x * 8) {
        const int b = row / TZ, s = row % TZ, sel = s < CTX ? 2 : b;
        float4 v[4], m0[4], m1[4], m5[4]; u32x2 ya2[4], yb2[4];
#pragma unroll
        for (int q = 0; q < 4; ++q) {
            const int col = q * 256 + c.lane * 4;
            v[q] = *(const float4*)(H + (size_t)row * D + col);
            m0[q] = *(const float4*)(modv + ((size_t)l * 3 + sel) * 6144 + col); m1[q] = *(const float4*)(modv + ((size_t)l * 3 + sel) * 6144 + 1024 + col);
            if (l > 0) { ya2[q] = *(const u32x2*)(Y + (size_t)row * D + col); yb2[q] = *(const u32x2*)(Y + ((size_t)NZ + row) * D + col);
                         m5[q] = *(const float4*)(modv + ((size_t)(l - 1) * 3 + sel) * 6144 + 5 * 1024 + col); }
        }
        float ss = 0.f;
#pragma unroll
        for (int q = 0; q < 4; ++q) {
            const int col = q * 256 + c.lane * 4;
            if (l > 0) {
                float ya[4], yb[4]; unpack4(ya2[q], ya); unpack4(yb2[q], yb);
                v[q].x += m5[q].x * (ya[0] + yb[0]); v[q].y += m5[q].y * (ya[1] + yb[1]); v[q].z += m5[q].z * (ya[2] + yb[2]); v[q].w += m5[q].w * (ya[3] + yb[3]);
                *(float4*)(H + (size_t)row * D + col) = v[q];
            }
            ss += v[q].x * v[q].x + v[q].y * v[q].y + v[q].z * v[q].z + v[q].w * v[q].w;
        }
        ss = wave_sum(ss);
        const float rs = rsqrtf(ss * (1.f / 1024.f) + 1e-6f);
#pragma unroll
        for (int q = 0; q < 4; ++q) {
            const int col = q * 256 + c.lane * 4;
            *(u32x2*)(XN + (size_t)row * D + col) = pack4(v[q].x * rs * gv[q].x * (1.f + m1[q].x) + m0[q].x, v[q].y * rs * gv[q].y * (1.f + m1[q].y) + m0[q].y,
                                                          v[q].z * rs * gv[q].z * (1.f + m1[q].z) + m0[q].z, v[q].w * rs * gv[q].w * (1.f + m1[q].w) + m0[q].w);
        }
    }
}

DI void phase_final(const Ctx& c) {
    const float* modv = (const float*)(c.ws + WS_WSM + OFF_MODV);
    const float* H = (const float*)(c.ws + WS_H); const bf16_t* Y = (const bf16_t*)(c.ws + WS_P);
    const float* g = c.in[48];
    float4 gv[4];
#pragma unroll
    for (int q = 0; q < 4; ++q) gv[q] = *(const float4*)(g + q * 256 + c.lane * 4);
    for (int r = blockIdx.x * 8 + c.wave; r < NB * SEQ; r += gridDim.x * 8) {
        const int b = r / SEQ, t = r % SEQ, row = b * TZ + CTX + t;
        float4 v[4]; float ss = 0.f;
#pragma unroll
        for (int q = 0; q < 4; ++q) {
            const int col = q * 256 + c.lane * 4;
            v[q] = *(const float4*)(H + (size_t)row * D + col);
            float ya[4], yb[4]; unpack4(*(const u32x2*)(Y + (size_t)row * D + col), ya); unpack4(*(const u32x2*)(Y + ((size_t)NZ + row) * D + col), yb);
            const float4 m5 = *(const float4*)(modv + ((size_t)(NL - 1) * 3 + b) * 6144 + 5 * 1024 + col);
            v[q].x += m5.x * (ya[0] + yb[0]); v[q].y += m5.y * (ya[1] + yb[1]); v[q].z += m5.z * (ya[2] + yb[2]); v[q].w += m5.w * (ya[3] + yb[3]);
            ss += v[q].x * v[q].x + v[q].y * v[q].y + v[q].z * v[q].z + v[q].w * v[q].w;
        }
        ss = wave_sum(ss);
        const float rs = rsqrtf(ss * (1.f / 1024.f) + 1e-6f);
#pragma unroll
        for (int q = 0; q < 4; ++q) {
            const int col = q * 256 + c.lane * 4; const float4 gg = gv[q];
            *(float4*)(c.out + (size_t)r * D + col) = make_float4(v[q].x * rs * gg.x, v[q].y * rs * gg.y, v[q].z * rs * gg.z, v[q].w * rs * gg.w);
        }
    }
}

struct EpiInproj {
    static constexpr bool PERM = true, AFTER_DRAIN = false;
    bf16_t *PM, *PS, *PR, *PD, *GT;
    DI void operator()(const pg8::f32x4 (&acc)[2][2][4][2], const pg8::Unit& u, int wr, int wc, int fr, int fq) const {
        const int row0 = u.pm * 256 + wr * 64 + fr, col0 = u.pn * 256 + wc * 32 + 8 * fq;
#pragma unroll
        for (int bj = 0; bj < 2; ++bj) {
            const int col = col0 + bj * 128;
            bf16_t* dst; int ld, cc; bool gate = false;
            if (col < 416) { dst = PM; ld = 416; cc = col; }
            else if (col < 1440) { dst = PR; ld = 1024; cc = col - 416; }
            else if (col < 1696) { dst = PS; ld = 256; cc = col - 1440; }
            else if (col < 2464) { dst = PD; ld = 768; cc = col - 1696; }
            else if (col < NIN) { dst = GT; ld = 4096; cc = col - 2464; gate = true; }
            else continue;
#pragma unroll
            for (int ai = 0; ai < 2; ++ai)
#pragma unroll
                for (int m = 0; m < 4; ++m) {
                    const int row = row0 + ai * 128 + m * 16; pg8::f32x4 v0 = acc[ai][bj][m][0], v1 = acc[ai][bj][m][1];
                    if (gate) { v0[0] = sigmoidf_(v0[0]); v0[1] = sigmoidf_(v0[1]); v0[2] = sigmoidf_(v0[2]); v0[3] = sigmoidf_(v0[3]);
                                v1[0] = sigmoidf_(v1[0]); v1[1] = sigmoidf_(v1[1]); v1[2] = sigmoidf_(v1[2]); v1[3] = sigmoidf_(v1[3]); }
                    u32x4 w; w.x = pack2(v0[0], v0[1]); w.y = pack2(v0[2], v0[3]); w.z = pack2(v1[0], v1[1]); w.w = pack2(v1[2], v1[3]);
                    *(u32x4*)(dst + (size_t)row * ld + cc) = w;
                }
        }
    }
};
DI void phase_inproj(const Ctx& c, int l) {
    EpiInproj E; E.PM = (bf16_t*)(c.ws + WS_P + P_PM); E.PS = (bf16_t*)(c.ws + WS_P + P_PS); E.PR = (bf16_t*)(c.ws + WS_P + P_PR); E.PD = (bf16_t*)(c.ws + WS_P + P_PD); E.GT = (bf16_t*)(c.ws + WS_GT);
    pg8::Gemm g{(const bf16_t*)(c.ws + WS_BUFA), (const bf16_t*)(c.ws + WS_WSM + OFF_WINT + l * SZ_WINT), NZ, NINP, 1024, 1024, 1024};
    pg8::StaticOrder S; S.init(NZ, NINP, (int)gridDim.x, (int)blockIdx.x, INPROJ_WGM);
    __syncthreads();
    pg8::gemm_phase<EpiInproj, pg8::StaticOrder, false>((PG8_LAS unsigned char*)c.smem, g, S, E, nullptr, c.tid);
}

DI void phase_prep(const Ctx& c, int l) {
    unsigned char* ws = c.ws; const int lane = c.lane, wave = c.wave, tid = c.tid;
    const bf16_t* PM = (const bf16_t*)(ws + WS_P + P_PM); const bf16_t* PR = (const bf16_t*)(ws + WS_P + P_PR); const bf16_t* PD = (const bf16_t*)(ws + WS_P + P_PD);
    bf16_t* CQN = (bf16_t*)(ws + WS_MISC + MS_CQN); bf16_t* TW = (bf16_t*)(ws + WS_MISC + MS_TW); bf16_t* AL = (bf16_t*)(ws + WS_MISC + MS_AL); bf16_t* SG = (bf16_t*)(ws + WS_MISC + MS_SG);
    bf16_t* KM = (bf16_t*)(ws + WS_EXPW + MX_KM); bf16_t* QD = (bf16_t*)(ws + WS_EXPW + MX_QD); bf16_t* KD_ = (bf16_t*)(ws + WS_EXPW + MX_KD); bf16_t* VDT = (bf16_t*)(ws + WS_EXPW + MX_VDT);
    bf16_t* RB = (bf16_t*)(ws + WS_EXPW + MX_RB); bf16_t* KB = (bf16_t*)(ws + WS_EXPW + MX_KB); bf16_t* VB = (bf16_t*)(ws + WS_EXPW + MX_VB); bf16_t* KKB = (bf16_t*)(ws + WS_EXPW + MX_KKB);
    const float* rope = (const float*)(ws + WS_WSM + OFF_ROPE);
    const float* gq = c.in[9] + l * 256; const float* gkv = c.in[10] + l * 128; const float* mu = c.in[13] + l * 1024; const float* k_k = c.in[19] + l * 256;
    bf16_t* Vs = (bf16_t*)c.smem;
    const float qsc = 0.17677669529663687f * LOG2E;
    for (int tile = blockIdx.x; tile < NZ / 16; tile += gridDim.x) {
        __syncthreads();
        struct PrepRow { u32x2 pmq; unsigned pmkv; bf16_t pmr; float2 csm; u32x2 pdq, pdk, pdv; float4 csa, csb; u32x2 cu[4], pv[4], nx[4]; };
        PrepRow R[2];
#pragma unroll
        for (int i = 0; i < 2; ++i) {
            const int rt = wave * 2 + i, z = tile * 16 + rt, s = z % TZ; const bool lat = s >= CTX; const int tl = lat ? s - CTX : 0;
            PrepRow& r = R[i];
            const bf16_t* pm = PM + (size_t)z * 416;
            r.pmq = *(const u32x2*)(pm + lane * 4); r.pmkv = *(const unsigned*)(pm + 256 + lane * 2); r.pmr = pm[384 + (lane & 31)];
            r.csm = *(const float2*)(rope + ((size_t)tl * 16 + ((lane & 31) >> 4) * 8 + (lane & 7)) * 2);
            const bf16_t* pd = PD + (size_t)z * 768; const int i0 = lane * 4, ii = i0 & 31;
            r.pdq = *(const u32x2*)(pd + i0); r.pdk = *(const u32x2*)(pd + 256 + i0); r.pdv = *(const u32x2*)(pd + 512 + i0);
            const float* cs = rope + ((size_t)tl * 16 + (ii >> 4) * 8 + (ii & 7)) * 2;
            r.csa = *(const float4*)cs; r.csb = *(const float4*)(cs + 4);
            const bf16_t* pr = PR + (size_t)z * 1024;
            const bool hp = (s != 0) && (s != CTX), hn = (s != CTX - 1) && (s != TZ - 1);
#pragma unroll
            for (int q = 0; q < 4; ++q) {
                const int col = q * 256 + lane * 4;
                r.cu[q] = *(const u32x2*)(pr + col); r.pv[q] = (u32x2){0u, 0u}; r.nx[q] = (u32x2){0u, 0u};
                if (hp) r.pv[q] = *(const u32x2*)(pr - 1024 + col);
                if (hn) r.nx[q] = *(const u32x2*)(pr + 1024 + col);
            }
        }
#pragma unroll
        for (int i = 0; i < 2; ++i) {
            const int rt = wave * 2 + i, z = tile * 16 + rt, b = z / TZ, s = z % TZ; const bool lat = s >= CTX;
            const PrepRow& r = R[i];
            {
                float x[4]; unpack4(r.pmq, x);
                float ss = wave_sum(x[0] * x[0] + x[1] * x[1] + x[2] * x[2] + x[3] * x[3]);
                float rs = rsqrtf(ss * (1.f / 256.f) + 1e-6f);
                const float4 g = *(const float4*)(gq + lane * 4);
                *(u32x2*)(CQN + (size_t)z * 384 + lane * 4) = pack4(x[0] * rs * g.x, x[1] * rs * g.y, x[2] * rs * g.z, x[3] * rs * g.w);
                const float y0 = lo2f(r.pmkv), y1 = hi2f(r.pmkv);
                ss = wave_sum(y0 * y0 + y1 * y1); rs = rsqrtf(ss * (1.f / 128.f) + 1e-6f);
                const float2 g2 = *(const float2*)(gkv + lane * 2);
                *(unsigned*)(CQN + (size_t)z * 384 + 256 + lane * 2) = pack2(y0 * rs * g2.x, y1 * rs * g2.y);
                float kr = bf2f(r.pmr);
                const float pr = __shfl_xor(kr, 8, 64);
                if (lat) kr = kr * r.csm.x + ((lane & 8) ? pr : -pr) * r.csm.y;
                if (lane < 32) {
                    const bf16_t kv = f2bf(kr);
#pragma unroll
                    for (int h = 0; h < 4; ++h) KM[((size_t)(b * 4 + h) * TZ + s) * 96 + 64 + lane] = kv;
                }
            }
            {
                const int i0 = lane * 4, hh = i0 >> 6, ii = i0 & 31, nn = (i0 >> 5) & 1;
                const float cs[8] = {r.csa.x, r.csa.y, r.csa.z, r.csa.w, r.csb.x, r.csb.y, r.csb.z, r.csb.w};
                const bool hi = (ii & 8) != 0;
#pragma unroll
                for (int w = 0; w < 2; ++w) {
                    float x[4]; unpack4(w == 0 ? r.pdq : r.pdk, x);
                    float o[4];
#pragma unroll
                    for (int j = 0; j < 4; ++j) {
                        const float p = __shfl_xor(x[j], 2, 64);
                        o[j] = lat ? (x[j] * cs[2 * j] + (hi ? p : -p) * cs[2 * j + 1]) : x[j];
                        if (w == 0) o[j] *= qsc;
                    }
                    bf16_t* dst = (w == 0 ? QD : KD_) + ((size_t)(b * 4 + hh) * TZ + s) * 64 + nn * 32 + ii;
                    *(u32x2*)dst = pack4(o[0], o[1], o[2], o[3]);
                }
                *(u32x2*)(Vs + rt * 264 + i0) = r.pdv;
            }
            {
#pragma unroll
                for (int q = 0; q < 4; ++q) {
                    const int col = q * 256 + lane * 4;
                    float cu[4], pv[4], nx[4];
                    unpack4(r.cu[q], cu); unpack4(r.pv[q], pv); unpack4(r.nx[q], nx);
                    const float4 m = *(const float4*)(mu + col);
                    float zv[4];
                    zv[0] = cu[0] + (0.5f * (pv[0] + nx[0]) - cu[0]) * m.x; zv[1] = cu[1] + (0.5f * (pv[1] + nx[1]) - cu[1]) * m.y;
                    zv[2] = cu[2] + (0.5f * (pv[2] + nx[2]) - cu[2]) * m.z; zv[3] = cu[3] + (0.5f * (pv[3] + nx[3]) - cu[3]) * m.w;
                    if (q == 0) *(u32x2*)(RB + (size_t)z * 256 + lane * 4) = pack4(zv[0], zv[1], zv[2], zv[3]);
                    else if (q == 1) {
                        *(u32x2*)(KB + (size_t)z * 256 + lane * 4) = pack4(zv[0], zv[1], zv[2], zv[3]);
                        const float4 kk4 = *(const float4*)(k_k + lane * 4);
                        const float a0 = zv[0] * kk4.x, a1 = zv[1] * kk4.y, a2 = zv[2] * kk4.z, a3 = zv[3] * kk4.w;
                        const float ssq = sum16(a0 * a0 + a1 * a1 + a2 * a2 + a3 * a3);
                        const float inv = 1.f / fmaxf(sqrtf(ssq), 1e-12f);
                        *(u32x2*)(KKB + (size_t)z * 256 + lane * 4) = pack4(a0 * inv, a1 * inv, a2 * inv, a3 * inv);
                    } else if (q == 2) *(u32x2*)(VB + (size_t)z * 256 + lane * 4) = pack4(zv[0], zv[1], zv[2], zv[3]);
                    else {
                        if (lane < 16) *(u32x2*)(TW + (size_t)z * 64 + lane * 4) = pack4(tanhf_(zv[0]), tanhf_(zv[1]), tanhf_(zv[2]), tanhf_(zv[3]));
                        else if (lane < 32) *(u32x2*)(AL + (size_t)z * 64 + (lane - 16) * 4) = pack4(zv[0], zv[1], zv[2], zv[3]);
                        else *(u32x2*)(SG + (size_t)z * 128 + (lane - 32) * 4) = pack4(sigmoidf_(zv[0]), sigmoidf_(zv[1]), sigmoidf_(zv[2]), sigmoidf_(zv[3]));
                    }
                }
            }
        }
        __syncthreads();
        {
            const int z0 = tile * 16, b = z0 / TZ, s0 = z0 % TZ;
#pragma unroll
            for (int i = 0; i < 1; ++i) {
                const int ch = tid, dv = ch >> 1, r8 = (ch & 1) * 8;
                bf16_t v[8];
#pragma unroll
                for (int j = 0; j < 8; ++j) v[j] = Vs[(r8 + j) * 264 + dv];
                u32x4 o; o.x = v[0] | ((unsigned)v[1] << 16); o.y = v[2] | ((unsigned)v[3] << 16); o.z = v[4] | ((unsigned)v[5] << 16); o.w = v[6] | ((unsigned)v[7] << 16);
                *(u32x4*)(VDT + ((size_t)(b * 4 + (dv >> 6)) * 64 + (dv & 63)) * TZ + s0 + r8) = o;
            }
        }
    }
}

constexpr int S5C = 64, S5N = TZ / S5C, S5NC = CTX / S5C;
DI int s5_tok(int dir, int i) { return dir == 0 ? i : (i < CTX ? CTX - 1 - i : TZ - 1 - (i - CTX)); }
DI void s5_stage_u(const Ctx& c, float* U, int b, int dir, int chunk, int g0, int ng) {
    const bf16_t* PS = (const bf16_t*)(c.ws + WS_P + P_PS);
    const int per = ng * 4;
    for (int e = c.tid; e < S5C * per; e += NTHR) {
        const int i = e / per, c4 = (e % per) * 4, s = s5_tok(dir, chunk * S5C + i);
        float x[4]; unpack4(*(const u32x2*)(PS + (size_t)(b * TZ + s) * 256 + g0 * 16 + c4), x);
        *(float4*)(U + i * (ng * 16) + c4) = make_float4(x[0], x[1], x[2], x[3]);
    }
}
DI void phase_s5_local(const Ctx& c, int l) {
    float* U = (float*)c.smem;
    const float* s5t = (const float*)(c.ws + WS_WSM + OFF_S5T);
    float* E = (float*)(c.ws + WS_WSM + OFF_S5E);
    for (int u = blockIdx.x; u < 2 * 2 * S5N * 2; u += gridDim.x) {
        const int gq = u & 1, chunk = (u >> 1) % S5N, dir = (u / (2 * S5N)) & 1, b = u / (4 * S5N);
        __syncthreads();
        s5_stage_u(c, U, b, dir, chunk, gq * 8, 8);
        __syncthreads();
        const int g = gq * 8 + c.wave, p = c.lane;
        const float* tb = s5t + ((size_t)((l * 2 + dir) * 16 + g) * 64 + p) * 36;
        const float are = tb[0], aim = tb[1];
        float br[16], bi[16];
#pragma unroll
        for (int ch = 0; ch < 16; ++ch) { br[ch] = tb[4 + ch]; bi[ch] = tb[20 + ch]; }
        float xr = 0.f, xi = 0.f;
        for (int i = 0; i < S5C; ++i) {
            const float* uu = U + i * 128 + c.wave * 16;
            float sr = 0.f, si = 0.f;
#pragma unroll
            for (int q = 0; q < 4; ++q) { const float4 v = *(const float4*)(uu + q * 4);
                sr += br[q * 4] * v.x + br[q * 4 + 1] * v.y + br[q * 4 + 2] * v.z + br[q * 4 + 3] * v.w;
                si += bi[q * 4] * v.x + bi[q * 4 + 1] * v.y + bi[q * 4 + 2] * v.z + bi[q * 4 + 3] * v.w; }
            const float nr = are * xr - aim * xi + sr, ni = are * xi + aim * xr + si; xr = nr; xi = ni;
        }
        *(float2*)(E + ((size_t)(((b * 2 + dir) * 16 + g) * S5N + chunk) * 64 + p) * 2) = make_float2(xr, xi);
    }
}
DI void phase_s5_carry(const Ctx& c, int l) {
    const int gt = blockIdx.x * NTHR + c.tid;
    if (gt < 2 * 2 * 16 * 64) {
        const int p = gt & 63, g = (gt >> 6) & 15, dir = (gt >> 10) & 1, b = gt >> 11;
        const float* tb = (const float*)(c.ws + WS_WSM + OFF_S5T) + ((size_t)((l * 2 + dir) * 16 + g) * 64 + p) * 36;
        const float ar = tb[2], ai = tb[3];
        const float* E = (const float*)(c.ws + WS_WSM + OFF_S5E) + (size_t)(((b * 2 + dir) * 16 + g) * S5N) * 128;
        float* C = (float*)(c.ws + WS_WSM + OFF_S5C) + (size_t)(((b * 2 + dir) * 16 + g) * S5N) * 128;
        float xr = 0.f, xi = 0.f;
        for (int ch = 0; ch < S5N; ++ch) {
            const float2 e = *(const float2*)(E + ch * 128 + p * 2);
            *(float2*)(C + ch * 128 + p * 2) = make_float2(xr, xi);
            const float nr = ar * xr - ai * xi + e.x, ni = ar * xi + ai * xr + e.y; xr = nr; xi = ni;
        }
    }
}

constexpr int S5_US = 0, S5_YS = 8192, S5_WV = S5_YS + 2 * 64 * 64 * 4;
template <bool LOCAL>
DI void phase_s5_final_unit(const Ctx& c, int l, int u) {
    unsigned char* L = c.smem;
    const float* s5t = (const float*)(c.ws + WS_WSM + OFF_S5T);
    const float* CIN = (const float*)(c.ws + WS_WSM + OFF_S5C);
    const bf16_t* PS = (const bf16_t*)(c.ws + WS_P + P_PS);
    const int gq = u & 3, ct = (u >> 2) % S5N, b = u / (4 * S5N);
    const int wave = c.wave, lane = c.lane, gl = wave >> 1, dir = wave & 1, g = gq * 4 + gl, n16 = lane & 15, q4 = lane >> 4;
    __syncthreads();
    {
        const int t = c.tid >> 3, part = c.tid & 7;
        *(u32x4*)(L + S5_US + t * 128 + part * 16) = *(const u32x4*)(PS + (size_t)(b * TZ + ct * S5C + t) * 256 + gq * 64 + part * 8);
    }
    typedef short s16x4 __attribute__((ext_vector_type(4)));
    const float* tbase = s5t + ((size_t)((l * 2 + dir) * 16 + g) * 64) * 36;
    s16x4 bfr[8], cfr[8];
#pragma unroll
    for (int j = 0; j < 8; ++j) {
        const int pp = 16 * j + n16, p = pp & 63; const float* tb = tbase + (size_t)p * 36 + (pp < 64 ? 4 : 20) + 4 * q4;
        u32x2 w2; w2.x = pack2(tb[0], tb[1]); w2.y = pack2(tb[2], tb[3]);
        bfr[j] = __builtin_bit_cast(s16x4, w2);
    }
    {
        const float* cre = c.in[29] + ((size_t)((l * 2 + dir) * 16 + g) * 16 + n16) * 64; const float* cim = c.in[30] + ((size_t)((l * 2 + dir) * 16 + g) * 16 + n16) * 64;
#pragma unroll
        for (int s = 0; s < 8; ++s) {
            const int pp = 16 * s + 4 * q4; const float sg = pp < 64 ? 1.f : -1.f; const float* src = (pp < 64 ? cre + pp : cim + (pp - 64));
            u32x2 w2; w2.x = pack2(sg * src[0], sg * src[1]); w2.y = pack2(sg * src[2], sg * src[3]);
            cfr[s] = __builtin_bit_cast(s16x4, w2);
        }
    }
    const float are = tbase[(size_t)lane * 36], aim = tbase[(size_t)lane * 36 + 1];
    const int cd = dir == 0 ? ct : (ct < S5NC ? S5NC - 1 - ct : S5N + S5NC - 1 - ct);
    float xr = 0.f, xi = 0.f;
    if (!LOCAL) { const float2 ci = *(const float2*)(CIN + ((size_t)(((b * 2 + dir) * 16 + g) * S5N + cd) * 64 + lane) * 2); xr = ci.x; xi = ci.y; }
    const float dsk = c.in[31][(size_t)l * 256 + g * 16 + n16];
    bf16_t* BU = (bf16_t*)(L + S5_WV + wave * 8192); bf16_t* XB = BU + 16 * 128;
    float* YS = (float*)(L + S5_YS) + dir * 64 * 64;
    __syncthreads();
#pragma unroll 1
    for (int sb = 0; sb < 4; ++sb) {
        const int stepA = 16 * sb + n16, tlA = dir == 0 ? stepA : 63 - stepA;
        const s16x4 af = __builtin_bit_cast(s16x4, *(const u32x2*)(L + S5_US + tlA * 128 + gl * 32 + q4 * 8));
#pragma unroll
        for (int j = 0; j < 8; ++j) {
            f32x4 acc = {0.f, 0.f, 0.f, 0.f};
            acc = __builtin_amdgcn_mfma_f32_16x16x16bf16_1k(af, bfr[j], acc, 0, 0, 0);
#pragma unroll
            for (int rr = 0; rr < 4; ++rr) BU[(4 * q4 + rr) * 128 + 16 * j + n16] = f2bf(acc[rr]);
        }
        __builtin_amdgcn_wave_barrier();
#pragma unroll
        for (int ii = 0; ii < 16; ++ii) {
            const float br = bf2f(BU[ii * 128 + lane]), bi = bf2f(BU[ii * 128 + 64 + lane]);
            const float nr = are * xr - aim * xi + br, ni = are * xi + aim * xr + bi; xr = nr; xi = ni;
            if (!LOCAL) { XB[ii * 128 + lane] = f2bf(xr); XB[ii * 128 + 64 + lane] = f2bf(xi); }
        }
        __builtin_amdgcn_wave_barrier();
        if (LOCAL) continue;
        f32x4 ya = {0.f, 0.f, 0.f, 0.f};
#pragma unroll
        for (int s = 0; s < 8; ++s) {
            const s16x4 xf = __builtin_bit_cast(s16x4, *(const u32x2*)((const unsigned char*)XB + n16 * 256 + (16 * s + 4 * q4) * 2));
            ya = __builtin_amdgcn_mfma_f32_16x16x16bf16_1k(xf, cfr[s], ya, 0, 0, 0);
        }
#pragma unroll
        for (int rr = 0; rr < 4; ++rr) {
            const int step = 16 * sb + 4 * q4 + rr, tl = dir == 0 ? step : 63 - step;
            float y = ya[rr];
            if (dir == 0) y += dsk * bf2f(*(const bf16_t*)(L + S5_US + tl * 128 + (gl * 16 + n16) * 2));
            YS[tl * 64 + gl * 16 + n16] = y;
        }
    }
    if (LOCAL) { *(float2*)((float*)(c.ws + WS_WSM + OFF_S5E) + ((size_t)(((b * 2 + dir) * 16 + g) * S5N + cd) * 64 + lane) * 2) = make_float2(xr, xi); return; }
    __syncthreads();
    bf16_t* ZG = (bf16_t*)(c.ws + WS_MISC + MS_ZG);
    {
        const float* Y0 = (const float*)(L + S5_YS); const float* Y1 = Y0 + 64 * 64;
        for (int e = c.tid; e < 64 * 16; e += NTHR) {
            const int i = e >> 4, c4 = (e & 15) * 4; const float4 y0 = *(const float4*)(Y0 + i * 64 + c4), y1 = *(const float4*)(Y1 + i * 64 + c4);
            *(u32x2*)(ZG + (size_t)(b * TZ + ct * S5C + i) * 256 + gq * 64 + c4) = pack4(gelu_tanh(y0.x + y1.x), gelu_tanh(y0.y + y1.y), gelu_tanh(y0.z + y1.z), gelu_tanh(y0.w + y1.w));
        }
    }
}

DI void phase_small_gemms(const Ctx& c, int l) {
    unsigned char* ws = c.ws; unsigned char* wsm = ws + WS_WSM;
    const bf16_t* CQN = (const bf16_t*)(ws + WS_MISC + MS_CQN);
    const float* rope = (const float*)(wsm + OFF_ROPE);
    constexpr int NMT = NZ / 256;
    int base = 0;
    const int G = gridDim.x, bid = blockIdx.x;
    {
        const bf16_t* W = (const bf16_t*)(wsm + OFF_WUQT + l * SZ_WUQT); bf16_t* QM = (bf16_t*)(ws + WS_EXPW + MX_QM);
        const float qs = 0.10206207261596577f * LOG2E;
        for (int u = (bid + G - base % G) % G; u < NMT * 3; u += G) {
            const int mt = u / 3, nt = u % 3, r0 = mt * 256, c0 = nt * 128;
            gemm_tile<4, 0>(c, 256, [&](int i) { return CQN + (size_t)(r0 + i) * 384; }, [&](int i) { return W + (size_t)(c0 + i) * 256; }, NoHook(),
                [&](f32x4 (&acc)[4][4], int wr, int wc, int fr, int fq) {
#pragma unroll
                    for (int n = 0; n < 4; ++n) {
                        const int col = c0 + wc + n * 16 + fq * 4, h = col / 96, d = col % 96;
                        const bool rp = d >= 64;
#pragma unroll
                        for (int m = 0; m < 4; ++m) {
                            const int row = r0 + wr + m * 16 + fr, b = row / TZ, s = row % TZ; f32x4 v = acc[m][n];
                            f32x4 pv; pv[0] = __shfl_xor(v[0], 32, 64); pv[1] = __shfl_xor(v[1], 32, 64); pv[2] = __shfl_xor(v[2], 32, 64); pv[3] = __shfl_xor(v[3], 32, 64);
                            if (rp && s >= CTX) {
                                const int i0 = d - 64;
                                const float* cs = rope + ((size_t)(s - CTX) * 16 + (i0 >> 4) * 8 + (i0 & 7)) * 2;
                                const bool hi = (i0 & 8) != 0;
#pragma unroll
                                for (int j = 0; j < 4; ++j) v[j] = v[j] * cs[2 * j] + (hi ? pv[j] : -pv[j]) * cs[2 * j + 1];
                            }
                            *(u32x2*)(QM + ((size_t)(b * 4 + h) * TZ + s) * 96 + d) = pack4(v[0] * qs, v[1] * qs, v[2] * qs, v[3] * qs);
                        }
                    }
                });
        }
        base += NMT * 3;
    }
    {
        const bf16_t* W = (const bf16_t*)(wsm + OFF_WUKVT + l * SZ_WUKVT); bf16_t* KM = (bf16_t*)(ws + WS_EXPW + MX_KM); bf16_t* VMT = (bf16_t*)(ws + WS_EXPW + MX_VMT);
        for (int u = (bid + G - base % G) % G; u < NMT * 4; u += G) {
            const int mt = u / 4, nt = u % 4, r0 = mt * 256, c0 = nt * 128;
            gemm_tile<4, 0>(c, 128, [&](int i) { return CQN + (size_t)(r0 + i) * 384 + 256; }, [&](int i) { return W + (size_t)(c0 + i) * 128; }, NoHook(),
                [&](f32x4 (&acc)[4][4], int wr, int wc, int fr, int fq) {
#pragma unroll
                    for (int n = 0; n < 4; ++n) {
                        const int col = c0 + wc + n * 16 + fq * 4, h = col >> 7, d = col & 127;
#pragma unroll
                        for (int m = 0; m < 4; ++m) {
                            const int row = r0 + wr + m * 16 + fr, b = row / TZ, s = row % TZ; const f32x4 v = acc[m][n];
                            if (d < 64) *(u32x2*)(KM + ((size_t)(b * 4 + h) * TZ + s) * 96 + d) = pack4(v[0], v[1], v[2], v[3]);
                            else {
#pragma unroll
                                for (int j = 0; j < 4; ++j) VMT[((size_t)(b * 4 + h) * 64 + (d - 64 + j)) * TZ + s] = f2bf(v[j]);
                            }
                        }
                    }
                });
        }
        base += NMT * 4;
    }
    bf16_t* SE = (bf16_t*)(ws + WS_P + P_PR); bf16_t* SAD = SE + (size_t)2 * NZ * 256; bf16_t* SKD = SAD + (size_t)2 * NZ * 256;
    {
        const bf16_t* A = (const bf16_t*)(ws + WS_MISC + MS_TW); const bf16_t* W = (const bf16_t*)(wsm + OFF_W2T + l * SZ_W2T);
        const float* w0 = c.in[14] + (size_t)l * 512;
        for (int u = (bid + G - base % G) % G; u < NMT * 4; u += G) {
            const int mt = u / 4, nt = u % 4, r0 = mt * 256, c0 = nt * 128;
            gemm_tile<4, 0>(c, 64, [&](int i) { return A + (size_t)(r0 + i) * 64; }, [&](int i) { return W + (size_t)(c0 + i) * 64; }, NoHook(),
                [&](f32x4 (&acc)[4][4], int wr, int wc, int fr, int fq) {
#pragma unroll
                    for (int n = 0; n < 4; ++n) {
                        const int col = c0 + wc + n * 16 + fq * 4, d = col >> 8, cc = col & 255; const float4 w0v = *(const float4*)(w0 + col);
#pragma unroll
                        for (int m = 0; m < 4; ++m) {
                            const int row = r0 + wr + m * 16 + fr; const f32x4 v = acc[m][n]; float e[4];
                            const float x[4] = {w0v.x + v[0], w0v.y + v[1], w0v.z + v[2], w0v.w + v[3]};
#pragma unroll
                            for (int j = 0; j < 4; ++j) e[j] = 0.6065306597126334f * sigmoidf_(x[j]);
                            *(u32x2*)(SE + ((size_t)d * NZ + row) * 256 + cc) = pack4(e[0], e[1], e[2], e[3]);
                        }
                    }
                });
        }
        base += NMT * 4;
    }
    {
        const bf16_t* A = (const bf16_t*)(ws + WS_MISC + MS_AL); const bf16_t* W = (const bf16_t*)(wsm + OFF_A2T + l * SZ_A2T);
        const float* a0 = c.in[16] + (size_t)l * 512; const float* k_a = c.in[20] + (size_t)l * 256; const bf16_t* KB = (const bf16_t*)(ws + WS_EXPW + MX_KB);
        for (int u = (bid + G - base % G) % G; u < NMT * 4; u += G) {
            const int mt = u / 4, nt = u % 4, r0 = mt * 256, c0 = nt * 128;
            gemm_tile<4, 0>(c, 64, [&](int i) { return A + (size_t)(r0 + i) * 64; }, [&](int i) { return W + (size_t)(c0 + i) * 64; }, NoHook(),
                [&](f32x4 (&acc)[4][4], int wr, int wc, int fr, int fq) {
                    u32x2 kq[4][4]; float4 a0q[4], kaq[4];
#pragma unroll
                    for (int n = 0; n < 4; ++n) {
                        const int col = c0 + wc + n * 16 + fq * 4, cc = col & 255; a0q[n] = *(const float4*)(a0 + col); kaq[n] = *(const float4*)(k_a + cc);
#pragma unroll
                        for (int m = 0; m < 4; ++m) kq[m][n] = *(const u32x2*)(KB + (size_t)(r0 + wr + m * 16 + fr) * 256 + cc);
                    }
#pragma unroll
                    for (int n = 0; n < 4; ++n) {
                        const int col = c0 + wc + n * 16 + fq * 4, d = col >> 8, cc = col & 255; const float4 a0v = a0q[n], kav = kaq[n];
#pragma unroll
                        for (int m = 0; m < 4; ++m) {
                            const int row = r0 + wr + m * 16 + fr; const f32x4 v = acc[m][n];
                            const float ad0 = sigmoidf_(a0v.x + v[0]), ad1 = sigmoidf_(a0v.y + v[1]), ad2 = sigmoidf_(a0v.z + v[2]), ad3 = sigmoidf_(a0v.w + v[3]);
                            float k[4]; unpack4(kq[m][n], k);
                            *(u32x2*)(SAD + ((size_t)d * NZ + row) * 256 + cc) = pack4(ad0, ad1, ad2, ad3);
                            *(u32x2*)(SKD + ((size_t)d * NZ + row) * 256 + cc) = pack4(k[0] * (1.f + (ad0 - 1.f) * kav.x), k[1] * (1.f + (ad1 - 1.f) * kav.y), k[2] * (1.f + (ad2 - 1.f) * kav.z), k[3] * (1.f + (ad3 - 1.f) * kav.w));
                        }
                    }
                });
        }
        base += NMT * 4;
    }
    {
        const bf16_t* A = (const bf16_t*)(ws + WS_MISC + MS_SG); const bf16_t* W = (const bf16_t*)(wsm + OFF_G2T + l * SZ_G2T); bf16_t* GG = (bf16_t*)(ws + WS_MISC + MS_GG);
        for (int u = (bid + G - base % G) % G; u < NMT * 2; u += G) {
            const int mt = u / 2, nt = u % 2, r0 = mt * 256, c0 = nt * 128;
            gemm_tile<4, 0>(c, 128, [&](int i) { return A + (size_t)(r0 + i) * 128; }, [&](int i) { return W + (size_t)(c0 + i) * 128; }, NoHook(),
                [&](f32x4 (&acc)[4][4], int wr, int wc, int fr, int fq) {
#pragma unroll
                    for (int n = 0; n < 4; ++n)
#pragma unroll
                        for (int m = 0; m < 4; ++m) { const f32x4 v = acc[m][n];
                            *(u32x2*)(GG + (size_t)(r0 + wr + m * 16 + fr) * 256 + c0 + wc + n * 16 + fq * 4) = pack4(v[0], v[1], v[2], v[3]); }
                });
        }
        base += NMT * 2;
    }
}

DI int krow(int s, int h, int j) { return 16 * s + 8 * (j >> 2) + 4 * h + (j & 3); }
#ifndef ATT_THR
#define ATT_THR 64.f
#endif
constexpr int ATT_PARK = 56 * 1024;
template <int MODE>
DI void attn_pass(const Ctx& c, int l, int b, int h, int q0, int nkeys) {
    constexpr int DROW = MODE == 0 ? 96 : 64;
    constexpr int DQ = MODE == 0 ? 96 : 32, KS = DQ / 16;
    constexpr int DOFF = MODE == 2 ? 32 : 0;
    constexpr int TK = 128;
    constexpr int KPITCH = DQ * 2 + 16;
    constexpr int VPITCH = TK * 2 + 16;
    constexpr int KBYTES = TK * KPITCH, VBYTES = 64 * VPITCH, STG = KBYTES + VBYTES;
    static_assert(MODE == 0 || 2 * STG <= ATT_PARK, "the staging buffers must stay below the parked o1");
    unsigned char* ws = c.ws; int tid_ = c.tid; asm volatile("" : "+v"(tid_));
    const int tid = tid_, lane = tid & 63, wave = __builtin_amdgcn_readfirstlane(tid >> 6), r = lane & 31, hh = lane >> 5;
    const bf16_t* Q = (const bf16_t*)(ws + WS_EXPW + (MODE == 0 ? MX_QM : MX_QD)) + (size_t)(b * 4 + h) * TZ * DROW + DOFF;
    const bf16_t* Kp = (const bf16_t*)(ws + WS_EXPW + (MODE == 0 ? MX_KM : MX_KD)) + (size_t)(b * 4 + h) * TZ * DROW + DOFF;
    const bf16_t* Vt = (const bf16_t*)(ws + WS_EXPW + (MODE == 0 ? MX_VMT : MX_VDT)) + (size_t)(b * 4 + h) * 64 * TZ;
    unsigned char* smem = c.smem;
    bf16x8 qf[KS];
    const int qrow = q0 + wave * 32 + r;
#pragma unroll
    for (int ks = 0; ks < KS; ++ks) qf[ks] = *(const bf16x8*)(Q + (size_t)qrow * DROW + ks * 16 + hh * 8);
    f32x16 oacc[2];
    float mref = 0.f, lrun = 0.f;
#pragma unroll
    for (int t = 0; t < 2; ++t)
#pragma unroll
        for (int i = 0; i < 16; ++i) oacc[t][i] = 0.f;
    constexpr int CPR = DQ / 8, KCH = TK * CPR, NKR = KCH / NTHR;
    static_assert(KCH % NTHR == 0, "whole staging rounds");
    u32x4 kreg[NKR], vreg[2];
    const bf16_t* kp[NKR]; int koff[NKR];
#pragma unroll
    for (int i = 0; i < NKR; ++i) { const int ch = tid + i * NTHR; kp[i] = Kp + ((long)(ch / CPR) - 64) * DROW + (ch % CPR) * 8; koff[i] = (ch / CPR) * KPITCH + (ch % CPR) * 16; }
    const bf16_t* vp = Vt + (size_t)(tid >> 4) * TZ + (tid & 15) * 8 - 64;
    const int voff = (tid >> 4) * VPITCH + (tid & 15) * 16;
    auto gloadK = [&]() {
#pragma unroll
        for (int i = 0; i < NKR; ++i) { kreg[i] = *(const u32x4*)kp[i]; kp[i] += TK * DROW; }
    };
    auto gloadV = [&]() { vreg[0] = *(const u32x4*)vp; vreg[1] = *(const u32x4*)(vp + (size_t)32 * TZ); vp += TK; };
    auto lstoreK = [&](int buf) {
        unsigned char* sk = smem + buf * STG;
#pragma unroll
        for (int i = 0; i < NKR; ++i) *(u32x4*)(sk + koff[i]) = kreg[i];
    };
    auto lstoreV = [&](int buf) { unsigned char* sv = smem + buf * STG + KBYTES; *(u32x4*)(sv + voff) = vreg[0]; *(u32x4*)(sv + voff + 32 * VPITCH) = vreg[1]; };
    const int kbase = r * KPITCH + hh * 16, vbase = KBYTES + r * VPITCH + hh * 8;
    auto ldfrag = [&](const unsigned char* kb, const unsigned char* vb, int ci) -> u32x4 {
        if (ci < 8) {
            const int kg = ci >> 2, s = (ci >> 1) & 1, t = ci & 1;
            const unsigned char* vrow = vb + t * 32 * VPITCH + (kg * 32 + 16 * s) * 2;
            const u32x2 lo = *(const u32x2*)vrow, hi2 = *(const u32x2*)(vrow + 16);
            u32x4 vv; vv.x = lo.x; vv.y = lo.y; vv.z = hi2.x; vv.w = hi2.y; return vv;
        }
        const int q = ci - 8, kg = q & 1, ks = q >> 1;
        return *(const u32x4*)(kb + kg * 32 * KPITCH + ks * 32);
    };
    constexpr int NM = 8 + 2 * KS;
    const f32x16 zero16 = {0.f, 0.f, 0.f, 0.f, 0.f, 0.f, 0.f, 0.f, 0.f, 0.f, 0.f, 0.f, 0.f, 0.f, 0.f, 0.f};
    auto pv_all = [&](const u32x4 (&P)[4], const unsigned char* vb) {
#pragma unroll
        for (int ci = 0; ci < 8; ++ci) { const u32x4 f = ldfrag(vb, vb, ci); oacc[ci & 1] = __builtin_amdgcn_mfma_f32_32x32x16_bf16(__builtin_bit_cast(bf16x8, f), __builtin_bit_cast(bf16x8, P[ci >> 1]), oacc[ci & 1], 0, 0, 0); }
    };
    auto iter = [&](f32x16 (&Sc)[2], f32x16 (&Sn)[2], u32x4 (&Pp)[4], u32x4 (&Pn)[4], const unsigned char* kb, const unsigned char* vb, bool first) {
        u32x4 fcur = ldfrag(kb, vb, 0), fnx1 = ldfrag(kb, vb, 1);
        if (__any(mref != 0.f)) {
#pragma unroll
            for (int kg = 0; kg < 2; ++kg)
#pragma unroll
                for (int i = 0; i < 16; ++i) Sc[kg][i] -= mref;
        }
        f32x2 ps = {0.f, 0.f};
        __builtin_amdgcn_sched_barrier(0);
#pragma unroll
        for (int ci = 0; ci < NM; ++ci) {
            u32x4 fnx2 = fnx1;
            if (ci + 2 < NM) fnx2 = ldfrag(kb, vb, ci + 2);
            if (ci < 8) oacc[ci & 1] = __builtin_amdgcn_mfma_f32_32x32x16_bf16(__builtin_bit_cast(bf16x8, fcur), __builtin_bit_cast(bf16x8, Pp[ci >> 1]), oacc[ci & 1], 0, 0, 0);
            else { const int q = ci - 8, kg = q & 1, ks = q >> 1; Sn[kg] = __builtin_amdgcn_mfma_f32_32x32x16_bf16(__builtin_bit_cast(bf16x8, fcur), qf[ks], ks == 0 ? zero16 : Sn[kg], 0, 0, 0); }
#pragma unroll
            for (int p = (ci * 16) / NM; p < ((ci + 1) * 16) / NM; ++p) {
                const int kg = p >> 3, q = p & 7;
                const float p0 = __builtin_amdgcn_exp2f(Sc[kg][2 * q]), p1 = __builtin_amdgcn_exp2f(Sc[kg][2 * q + 1]);
                ps += (f32x2){p0, p1};
                unsigned pk = pack2(p0, p1); asm volatile("" : "+v"(pk));
                Pn[kg * 2 + (q >> 2)][q & 3] = pk;
            }
            asm volatile("" : "+v"(ps));
            fcur = fnx1; fnx1 = fnx2;
            __builtin_amdgcn_sched_barrier(0);
        }
        const float pst = ps.x + ps.y;
        const bool bad = !(pst < 0x1p90f) || (first && pst < 0x1p-20f);
        if (__any(bad)) {
            float mx = Sc[0][0];
#pragma unroll
            for (int kg = 0; kg < 2; ++kg)
#pragma unroll
                for (int i = 0; i < 16; ++i) mx = fmaxf(mx, Sc[kg][i]);
            mx = fmaxf(mx, __shfl_xor(mx, 32, 64));
            const bool need = (mx > ATT_THR) || (first && mx < -32.f);
            const float d = need ? mx : 0.f;
            const float alpha = first ? 1.f : __builtin_amdgcn_exp2f(-d);
            mref += d; lrun *= alpha;
#pragma unroll
            for (int t = 0; t < 2; ++t)
#pragma unroll
                for (int i = 0; i < 16; ++i) oacc[t][i] *= alpha;
            ps = (f32x2){0.f, 0.f};
#pragma unroll
            for (int pq = 0; pq < 16; ++pq) {
                const int kg = pq >> 3, q = pq & 7;
                const float p0 = __builtin_amdgcn_exp2f(Sc[kg][2 * q] - d), p1 = __builtin_amdgcn_exp2f(Sc[kg][2 * q + 1] - d);
                ps += (f32x2){p0, p1};
                Pn[kg * 2 + (q >> 2)][q & 3] = pack2(p0, p1);
            }
        }
        lrun += ps.x + ps.y;
    };
    const int NT = nkeys / TK;
    f32x16 S0[2], S1[2]; u32x4 PA[4], PB[4];
#pragma unroll
    for (int q = 0; q < 4; ++q) PA[q] = (u32x4){0u, 0u, 0u, 0u};
    __syncthreads();
    gloadK();
    lstoreK(1);
    gloadK();
    if ((tid & 15) >= 8) gloadV(); else { vreg[0] = (u32x4){0u, 0u, 0u, 0u}; vreg[1] = vreg[0]; vp += TK; }
    __syncthreads();
    {
        const unsigned char* kb = smem + STG + 64 * KPITCH + kbase;
#pragma unroll
        for (int q = 0; q < 2 * KS; ++q) { const int kg = q & 1, ks = q >> 1; const u32x4 f = ldfrag(kb, kb, 8 + q); S0[kg] = __builtin_amdgcn_mfma_f32_32x32x16_bf16(__builtin_bit_cast(bf16x8, f), qf[ks], ks == 0 ? zero16 : S0[kg], 0, 0, 0); }
    }
    for (int s = 0; s < NT; ++s) {
        lstoreK(s & 1); lstoreV(s & 1);
        if (s + 1 < NT) gloadK();
        gloadV();
        __syncthreads();
        const unsigned char* sb = smem + (s & 1) * STG;
        iter(S0, S1, PA, PB, sb + kbase, sb + vbase, s == 0);
        iter(S1, S0, PB, PA, sb + 64 * KPITCH + kbase, sb + 128 + vbase, false);
    }
    lstoreV(NT & 1);
    __syncthreads();
    pv_all(PA, smem + (NT & 1) * STG + vbase);
    const float inv = 1.f / (lrun + __shfl_xor(lrun, 32, 64));
    bf16_t* Ycat = (bf16_t*)(ws + WS_BUFA);
    const int zrow = b * TZ + qrow;
    float* park = (float*)(smem + ATT_PARK) + tid;
    if (MODE == 0) {
#pragma unroll
        for (int t = 0; t < 2; ++t)
#pragma unroll
            for (int i4 = 0; i4 < 4; ++i4) {
                const int dv = t * 32 + 8 * i4 + 4 * hh;
                *(u32x2*)(Ycat + (size_t)zrow * D + h * 64 + dv) = pack4(oacc[t][4 * i4] * inv, oacc[t][4 * i4 + 1] * inv, oacc[t][4 * i4 + 2] * inv, oacc[t][4 * i4 + 3] * inv);
            }
    } else if (MODE == 1) {
#pragma unroll
        for (int t = 0; t < 2; ++t)
#pragma unroll
            for (int i = 0; i < 16; ++i) park[(t * 16 + i) * NTHR] = oacc[t][i] * inv;
    } else {
        const float lam = ((const float*)(ws + WS_WSM + OFF_LAM))[l];
        const float lam_init = 0.8f - 0.6f * __expf(-0.3f * (float)l);
        float ss = 0.f;
#pragma unroll
        for (int t = 0; t < 2; ++t)
#pragma unroll
            for (int i = 0; i < 16; ++i) { const float o = park[(t * 16 + i) * NTHR] - lam * oacc[t][i] * inv; oacc[t][i] = o; ss += o * o; }
        ss += __shfl_xor(ss, 32, 64);
        const float rs = rsqrtf(ss * (1.f / 64.f) + 1e-5f) * (1.f - lam_init);
        const float* sg = c.in[38] + l * 64;
        float4 gq[2][4];
#pragma unroll
        for (int t = 0; t < 2; ++t)
#pragma unroll
            for (int i4 = 0; i4 < 4; ++i4) gq[t][i4] = *(const float4*)(sg + t * 32 + 8 * i4 + 4 * hh);
#pragma unroll
        for (int t = 0; t < 2; ++t)
#pragma unroll
            for (int i4 = 0; i4 < 4; ++i4) {
                const int dv = t * 32 + 8 * i4 + 4 * hh; const float4 g = gq[t][i4];
                *(u32x2*)(Ycat + (size_t)zrow * D + 768 + h * 64 + dv) = pack4(oacc[t][4 * i4] * rs * g.x, oacc[t][4 * i4 + 1] * rs * g.y, oacc[t][4 * i4 + 2] * rs * g.z, oacc[t][4 * i4 + 3] * rs * g.w);
            }
    }
}
DI void phase_attention(const Ctx& c, int l) {
    const int nu = 512 + (l == 0 ? 16 : 0);
    for (int u = blockIdx.x; u < nu; u += gridDim.x) {
        int b, h, q0, nk; bool mla;
        if (u < 512) { const int k = u & 255, bh = k & 7; b = bh >> 2; h = bh & 3; q0 = CTX + (k >> 3) * 256; nk = TZ; mla = u < 256; }
        else { const int k = u - 512; b = (k >> 2) & 1; h = k & 3; q0 = 0; nk = CTX; mla = k < 8; }
        if (mla) attn_pass<0>(c, l, b, h, q0, nk);
        else { attn_pass<1>(c, l, b, h, q0, nk); attn_pass<2>(c, l, b, h, q0, nk); }
    }
}

DI int rw_tok(int dir, int i) { return dir == 0 ? i : (i < CTX ? CTX - 1 - i : TZ - 1 - (i - CTX)); }
constexpr int RW_TS = 32;
constexpr int RW_STEP_F = 6 * 64 + 2;
constexpr int RW_BUF_F = RW_TS * RW_STEP_F;
template <int CTRL> DI float dpp_add(float x) { return x + __int_as_float(__builtin_amdgcn_update_dpp(0, __float_as_int(x), CTRL, 0xf, 0xf, false)); }
DI float red16(float x) { x = dpp_add<0xB1>(x); x = dpp_add<0x4E>(x); x = dpp_add<0x141>(x); x = dpp_add<0x140>(x); return x; }
DI float red8(float x) { x = dpp_add<0xB1>(x); x = dpp_add<0x4E>(x); x = dpp_add<0x141>(x); return x; }
struct RwRegs { u32x4 r, v, kk, e, ad, kd; };
DI void rw_load(const Ctx& c, int b, int h, int dir, int chunk, int t, RwRegs& g) {
    const bf16_t* RB = (const bf16_t*)(c.ws + WS_EXPW + MX_RB); const bf16_t* VB = (const bf16_t*)(c.ws + WS_EXPW + MX_VB); const bf16_t* KKB = (const bf16_t*)(c.ws + WS_EXPW + MX_KKB);
    const bf16_t* SE = (const bf16_t*)(c.ws + WS_P + P_PR) + (size_t)dir * NZ * 256; const bf16_t* SAD = SE + (size_t)2 * NZ * 256; const bf16_t* SKD = SAD + (size_t)2 * NZ * 256;
    const int i = chunk * RW_TS + (t >> 3), z = b * TZ + rw_tok(dir, i); const size_t o = (size_t)z * 256 + h * 64 + (t & 7) * 8;
    g.r = *(const u32x4*)(RB + o); g.v = *(const u32x4*)(VB + o); g.kk = *(const u32x4*)(KKB + o);
    g.e = *(const u32x4*)(SE + o); g.ad = *(const u32x4*)(SAD + o); g.kd = *(const u32x4*)(SKD + o);
}
DI void up8(const u32x4& u, float (&f)[8]) { f[0] = lo2f(u.x); f[1] = hi2f(u.x); f[2] = lo2f(u.y); f[3] = hi2f(u.y); f[4] = lo2f(u.z); f[5] = hi2f(u.z); f[6] = lo2f(u.w); f[7] = hi2f(u.w); }
DI void rw_process(const RwRegs& g, int t, float* buf) {
    float r[8], v[8], kk[8], e[8], ad[8], kd[8];
    up8(g.r, r); up8(g.v, v); up8(g.kk, kk); up8(g.e, e); up8(g.ad, ad); up8(g.kd, kd);
    float* f = buf + (t >> 3) * RW_STEP_F + (t & 7) * 8;
    float w[8], bv[8], wr[8]; float br = 0.f, kr = 0.f;
#pragma unroll
    for (int j = 0; j < 8; ++j) { w[j] = __expf(-e[j]); bv[j] = kk[j] * ad[j]; wr[j] = w[j] * r[j]; br += bv[j] * r[j]; kr += kd[j] * r[j]; }
    *(float4*)(f) = make_float4(w[0], w[1], w[2], w[3]); *(float4*)(f + 4) = make_float4(w[4], w[5], w[6], w[7]);
    *(float4*)(f + 64) = make_float4(kk[0], kk[1], kk[2], kk[3]); *(float4*)(f + 68) = make_float4(kk[4], kk[5], kk[6], kk[7]);
    *(float4*)(f + 128) = make_float4(bv[0], bv[1], bv[2], bv[3]); *(float4*)(f + 132) = make_float4(bv[4], bv[5], bv[6], bv[7]);
    *(float4*)(f + 192) = make_float4(kd[0], kd[1], kd[2], kd[3]); *(float4*)(f + 196) = make_float4(kd[4], kd[5], kd[6], kd[7]);
    *(float4*)(f + 256) = make_float4(wr[0], wr[1], wr[2], wr[3]); *(float4*)(f + 260) = make_float4(wr[4], wr[5], wr[6], wr[7]);
    *(float4*)(f + 320) = make_float4(v[0], v[1], v[2], v[3]); *(float4*)(f + 324) = make_float4(v[4], v[5], v[6], v[7]);
    br = red8(br); kr = red8(kr);
    if ((t & 7) == 0) { float* s = buf + (t >> 3) * RW_STEP_F + 384; s[0] = br; s[1] = kr; }
}
struct RwStep { float4 w, kk, bv, kd, wr; float vv, br, kr; };
DI void rw_ld(RwStep& s, const float* f, int kq, int row) {
    s.w = *(const float4*)(f + kq * 4); s.kk = *(const float4*)(f + 64 + kq * 4); s.bv = *(const float4*)(f + 128 + kq * 4);
    s.kd = *(const float4*)(f + 192 + kq * 4); s.wr = *(const float4*)(f + 256 + kq * 4); s.vv = f[320 + row]; s.br = f[384]; s.kr = f[385];
}
DI void phase_rwkv_scan_unit(const Ctx& c, int l, int u) {
    const int rg = u & 3, chain = u >> 2, dir = chain & 1, h = (chain >> 1) & 3, b = chain >> 3;
    float* buf0 = (float*)c.smem; float* buf1 = buf0 + RW_BUF_F;
    float* ybuf = buf1 + RW_BUF_F;
    float* YO = (float*)(c.ws + WS_BUFB) + (size_t)dir * NZ * 256 + (size_t)b * TZ * 256 + h * 64 + rg * 16;
    const int wave = c.wave, lane = c.lane, rr = lane >> 4, kq = lane & 15, rl = (wave & 3) * 4 + rr, row = rg * 16 + rl;
    const int t = c.tid - 256;
    float S0 = 0.f, S1 = 0.f, S2 = 0.f, S3 = 0.f;
    constexpr int NCH = TZ / RW_TS;
    RwRegs g;
    __syncthreads();
    if (wave >= 4) { rw_load(c, b, h, dir, 0, t, g); rw_process(g, t, buf0); rw_load(c, b, h, dir, 1, t, g); }
    __syncthreads();
    for (int ch = 0; ch < NCH; ++ch) {
        float* cur = buf0 + (ch & 1) * RW_BUF_F; float* nxt = buf0 + ((ch + 1) & 1) * RW_BUF_F;
        if (wave >= 4) {
            if (ch > 0) {
                const float* yb = ybuf + ((ch - 1) & 1) * RW_TS * 16;
#pragma unroll
                for (int i = 0; i < 2; ++i) { const int e = t + i * 256, st = e >> 4, rw = e & 15; YO[(size_t)rw_tok(dir, (ch - 1) * RW_TS + st) * 256 + rw] = yb[e]; }
            }
            if (ch + 1 < NCH) rw_process(g, t, nxt);
            if (ch + 2 < NCH) rw_load(c, b, h, dir, ch + 2, t, g);
        } else {
            float* yb = ybuf + (ch & 1) * RW_TS * 16 + rl;
            RwStep s0, s1;
            rw_ld(s0, cur, kq, row);
#pragma unroll 4
            for (int st = 0; st < RW_TS; st += 2) {
                rw_ld(s1, cur + (st + 1) * RW_STEP_F, kq, row);
                {
                    float sa = -((S0 * s0.kk.x + S1 * s0.kk.y) + (S2 * s0.kk.z + S3 * s0.kk.w));
                    float q = (S0 * s0.wr.x + S1 * s0.wr.y) + (S2 * s0.wr.z + S3 * s0.wr.w);
                    sa = red16(sa); q = red16(q);
                    S0 = fmaf(sa, s0.bv.x, fmaf(S0, s0.w.x, s0.vv * s0.kd.x)); S1 = fmaf(sa, s0.bv.y, fmaf(S1, s0.w.y, s0.vv * s0.kd.y));
                    S2 = fmaf(sa, s0.bv.z, fmaf(S2, s0.w.z, s0.vv * s0.kd.z)); S3 = fmaf(sa, s0.bv.w, fmaf(S3, s0.w.w, s0.vv * s0.kd.w));
                    yb[st * 16] = q + sa * s0.br + s0.vv * s0.kr;
                }
                if (st + 2 < RW_TS) rw_ld(s0, cur + (st + 2) * RW_STEP_F, kq, row);
                {
                    float sa = -((S0 * s1.kk.x + S1 * s1.kk.y) + (S2 * s1.kk.z + S3 * s1.kk.w));
                    float q = (S0 * s1.wr.x + S1 * s1.wr.y) + (S2 * s1.wr.z + S3 * s1.wr.w);
                    sa = red16(sa); q = red16(q);
                    S0 = fmaf(sa, s1.bv.x, fmaf(S0, s1.w.x, s1.vv * s1.kd.x)); S1 = fmaf(sa, s1.bv.y, fmaf(S1, s1.w.y, s1.vv * s1.kd.y));
                    S2 = fmaf(sa, s1.bv.z, fmaf(S2, s1.w.z, s1.vv * s1.kd.z)); S3 = fmaf(sa, s1.bv.w, fmaf(S3, s1.w.w, s1.vv * s1.kd.w));
                    yb[(st + 1) * 16] = q + sa * s1.br + s1.vv * s1.kr;
                }
            }
        }
        __syncthreads();
    }
    if (wave >= 4) {
        const float* yb = ybuf + ((NCH - 1) & 1) * RW_TS * 16;
#pragma unroll
        for (int i = 0; i < 2; ++i) { const int e = t + i * 256, st = e >> 4, rw = e & 15; YO[(size_t)rw_tok(dir, (NCH - 1) * RW_TS + st) * 256 + rw] = yb[e]; }
    }
}

constexpr int LA_AN = 0, LA_RN = 8192, LA_BN = 16384, LA_KN = 24576, LA_AT = 32768, LA_BHT = 40960, LA_KHT = 49152, LA_VT = 57344,
              LA_NBA = 65536  , LA_NKA = 81920, LA_NBRT = 90112, LA_NKRT = 98304, LA_P63 = 106496;
constexpr int LA_TMT = LA_AN, LA_M1 = LA_BN, LA_W1T = LA_KN, LA_Z1 = LA_NBA;
DI int crow(int reg, int h) { return (reg & 3) + 8 * (reg >> 2) + 4 * h; }
DI void mm_tile(f32x16& acc, const unsigned char* A, int i0, const unsigned char* BT, int j0, int r, int h) {
#pragma unroll
    for (int ks = 0; ks < 4; ++ks) {
        const bf16x8 a = *(const bf16x8*)(A + (i0 + r) * 128 + ks * 32 + h * 16);
        const bf16x8 b = *(const bf16x8*)(BT + (j0 + r) * 128 + ks * 32 + h * 16);
        acc = __builtin_amdgcn_mfma_f32_32x32x16_bf16(a, b, acc, 0, 0, 0);
    }
}
DI void zero16(f32x16& a) {
#pragma unroll
    for (int i = 0; i < 16; ++i) a[i] = 0.f;
}
DI void phase_rwkv_chunk_unit(const Ctx& c, int l, int unit) {
    unsigned char* L = c.smem; unsigned char* ws = c.ws;
    const int chain = unit / RNC, ch = unit % RNC, dir = chain & 1, hd = (chain >> 1) & 3, b = chain >> 3;
    const int tid = c.tid, lane = c.lane, wave = c.wave, r = lane & 31, h = lane >> 5;
    const bf16_t* RB = (const bf16_t*)(ws + WS_EXPW + MX_RB); const bf16_t* VB = (const bf16_t*)(ws + WS_EXPW + MX_VB); const bf16_t* KKB = (const bf16_t*)(ws + WS_EXPW + MX_KKB);
    const bf16_t* SE = (const bf16_t*)(ws + WS_P + P_PR) + (size_t)dir * NZ * 256; const bf16_t* SAD = SE + (size_t)2 * NZ * 256; const bf16_t* SKD = SAD + (size_t)2 * NZ * 256;
    float* CUM = (float*)(L + LA_NBA);
    __syncthreads();
    const int t = tid >> 3, k0 = (tid & 7) * 8;
    float rr[8], vv[8], kk[8], ee[8], ad[8], kd[8];
    {
        const int z = b * TZ + rw_tok(dir, ch * RC + t); const size_t o = (size_t)z * 256 + hd * 64 + k0;
        up8(*(const u32x4*)(RB + o), rr); up8(*(const u32x4*)(VB + o), vv); up8(*(const u32x4*)(KKB + o), kk);
        up8(*(const u32x4*)(SE + o), ee); up8(*(const u32x4*)(SAD + o), ad); up8(*(const u32x4*)(SKD + o), kd);
        *(float4*)(CUM + t * 64 + k0) = make_float4(ee[0], ee[1], ee[2], ee[3]); *(float4*)(CUM + t * 64 + k0 + 4) = make_float4(ee[4], ee[5], ee[6], ee[7]);
    }
    __syncthreads();
    if (wave == 0) { float cm = 0.f;
#pragma unroll 8
        for (int i = 0; i < RC; ++i) { cm += CUM[i * 64 + lane]; CUM[i * 64 + lane] = cm; } }
    __syncthreads();
    {
        float cm[8], c63[8];
        { const float4 a = *(const float4*)(CUM + t * 64 + k0), bq = *(const float4*)(CUM + t * 64 + k0 + 4); cm[0] = a.x; cm[1] = a.y; cm[2] = a.z; cm[3] = a.w; cm[4] = bq.x; cm[5] = bq.y; cm[6] = bq.z; cm[7] = bq.w; }
        { const float4 a = *(const float4*)(CUM + 63 * 64 + k0), bq = *(const float4*)(CUM + 63 * 64 + k0 + 4); c63[0] = a.x; c63[1] = a.y; c63[2] = a.z; c63[3] = a.w; c63[4] = bq.x; c63[5] = bq.y; c63[6] = bq.z; c63[7] = bq.w; }
        float at[8], rt[8], bt[8], kt[8], bh[8], kh[8];
#pragma unroll
        for (int j = 0; j < 8; ++j) {
            const float pt = __expf(-cm[j]), pp = __expf(-(cm[j] - ee[j])), ip = __expf(cm[j]), ph = __expf(-(c63[j] - cm[j])), bb = kk[j] * ad[j];
            at[j] = -kk[j] * pp; rt[j] = rr[j] * pt; bt[j] = bb * ip; kt[j] = kd[j] * ip; bh[j] = bb * ph; kh[j] = kd[j] * ph;
        }
        u32x4 w4;
        w4.x = pack2(at[0], at[1]); w4.y = pack2(at[2], at[3]); w4.z = pack2(at[4], at[5]); w4.w = pack2(at[6], at[7]); *(u32x4*)(L + LA_AN + t * 128 + k0 * 2) = w4;
        w4.x = pack2(rt[0], rt[1]); w4.y = pack2(rt[2], rt[3]); w4.z = pack2(rt[4], rt[5]); w4.w = pack2(rt[6], rt[7]); *(u32x4*)(L + LA_RN + t * 128 + k0 * 2) = w4;
        w4.x = pack2(bt[0], bt[1]); w4.y = pack2(bt[2], bt[3]); w4.z = pack2(bt[4], bt[5]); w4.w = pack2(bt[6], bt[7]); *(u32x4*)(L + LA_BN + t * 128 + k0 * 2) = w4;
        w4.x = pack2(kt[0], kt[1]); w4.y = pack2(kt[2], kt[3]); w4.z = pack2(kt[4], kt[5]); w4.w = pack2(kt[6], kt[7]); *(u32x4*)(L + LA_KN + t * 128 + k0 * 2) = w4;
#pragma unroll
        for (int j = 0; j < 8; ++j) {
            *(bf16_t*)(L + LA_AT + (k0 + j) * 128 + t * 2) = f2bf(at[j]); *(bf16_t*)(L + LA_BHT + (k0 + j) * 128 + t * 2) = f2bf(bh[j]);
            *(bf16_t*)(L + LA_KHT + (k0 + j) * 128 + t * 2) = f2bf(kh[j]); *(bf16_t*)(L + LA_VT + (k0 + j) * 128 + t * 2) = f2bf(vv[j]);
        }
        if (t == 63) {
            float* p63 = (float*)(L + LA_P63); float* gp = (float*)(ws + WS_RW + RW_P63) + (size_t)unit * 64;
#pragma unroll
            for (int j = 0; j < 8; ++j) { const float p = __expf(-c63[j]); p63[k0 + j] = p; gp[k0 + j] = p; }
        }
    }
    __syncthreads();
    {
        const int p = wave >> 1, i0 = (wave & 1) * 32;
        const unsigned char* A = L + (p == 0 ? LA_BN : p == 1 ? LA_KN : LA_RN);
        const unsigned char* BT = L + (p < 2 ? LA_AN : p == 2 ? LA_BN : LA_KN);
#pragma unroll
        for (int jt = 0; jt < 2; ++jt) {
            const int j0 = jt * 32; f32x16 acc; zero16(acc);
            mm_tile(acc, A, i0, BT, j0, r, h);
            const int col = j0 + r;
#pragma unroll
            for (int g = 0; g < 16; ++g) {
                const int row = i0 + crow(g, h);
                if (p == 0) ((float*)(L + LA_NBA))[row * 64 + col] = (row < col) ? acc[g] : 0.f;
                else if (p == 1) *(bf16_t*)(L + LA_NKA + row * 128 + col * 2) = f2bf((row < col) ? acc[g] : 0.f);
                else *(bf16_t*)(L + (p == 2 ? LA_NBRT : LA_NKRT) + row * 128 + col * 2) = f2bf((col <= row) ? acc[g] : 0.f);
            }
        }
    }
    __syncthreads();
    {
        constexpr int X0 = LA_BN, X1 = LA_KN, X3 = 108544, X4 = X3 + 8192, X5 = LA_NBA + 16384 - 16384, X6 = LA_NBA + 8192;
        float nv[8];
        { const int s = tid >> 3, t0 = (tid & 7) * 8; const float* N = (const float*)(L + LA_NBA) + s * 64 + t0;
          const float4 a = *(const float4*)N, bq = *(const float4*)(N + 4); nv[0] = a.x; nv[1] = a.y; nv[2] = a.z; nv[3] = a.w; nv[4] = bq.x; nv[5] = bq.y; nv[6] = bq.z; nv[7] = bq.w; }
        __syncthreads();
        {
            const int s = tid >> 3, t0 = (tid & 7) * 8;
            u32x4 w4; w4.x = pack2(nv[0], nv[1]); w4.y = pack2(nv[2], nv[3]); w4.z = pack2(nv[4], nv[5]); w4.w = pack2(nv[6], nv[7]);
            *(u32x4*)(L + X0 + s * 128 + t0 * 2) = w4;
#pragma unroll
            for (int j = 0; j < 8; ++j) *(bf16_t*)(L + X1 + (t0 + j) * 128 + s * 2) = f2bf(nv[j]);
#pragma unroll
            for (int j = 0; j < 8; ++j) if (t0 + j == s) nv[j] += 1.f;
            w4.x = pack2(nv[0], nv[1]); w4.y = pack2(nv[2], nv[3]); w4.z = pack2(nv[4], nv[5]); w4.w = pack2(nv[6], nv[7]);
            *(u32x4*)(L + X5 + s * 128 + t0 * 2) = w4;
        }
        __syncthreads();
        const int ti0 = ((wave >> 1) & 1) * 32, tj0 = (wave & 1) * 32;
        if (wave < 4) {
            f32x16 acc; zero16(acc); mm_tile(acc, L + X0, ti0, L + X1, tj0, r, h);
#pragma unroll
            for (int g4 = 0; g4 < 4; ++g4) *(u32x2*)(L + X4 + (tj0 + r) * 128 + (ti0 + 8 * g4 + 4 * h) * 2) = pack4(acc[4 * g4], acc[4 * g4 + 1], acc[4 * g4 + 2], acc[4 * g4 + 3]);
#pragma unroll
            for (int g = 0; g < 16; ++g) *(bf16_t*)(L + X3 + (ti0 + crow(g, h)) * 128 + (tj0 + r) * 2) = f2bf(acc[g]);
        }
        __syncthreads();
#pragma unroll
        for (int k = 1; k <= 5; ++k) {
            const int qa = (k & 1) ? X3 : X0, qt = (k & 1) ? X4 : X1, nqa = (k & 1) ? X0 : X3, nqt = (k & 1) ? X1 : X4;
            const int pa = (k & 1) ? X5 : X6, npa = (k & 1) ? X6 : X5;
            if (wave >= 4) {
                f32x16 acc; zero16(acc); mm_tile(acc, L + pa, ti0, L + qt, tj0, r, h);
#pragma unroll
                for (int g = 0; g < 16; ++g) acc[g] += bf2f(*(const bf16_t*)(L + pa + (ti0 + crow(g, h)) * 128 + (tj0 + r) * 2));
                if (k < 5) {
#pragma unroll
                    for (int g = 0; g < 16; ++g) *(bf16_t*)(L + npa + (ti0 + crow(g, h)) * 128 + (tj0 + r) * 2) = f2bf(acc[g]);
                } else {
#pragma unroll
                    for (int g4 = 0; g4 < 4; ++g4) *(u32x2*)(L + LA_TMT + (tj0 + r) * 128 + (ti0 + 8 * g4 + 4 * h) * 2) = pack4(acc[4 * g4], acc[4 * g4 + 1], acc[4 * g4 + 2], acc[4 * g4 + 3]);
                }
            } else if (k < 5) {
                f32x16 acc; zero16(acc); mm_tile(acc, L + qa, ti0, L + qt, tj0, r, h);
#pragma unroll
                for (int g4 = 0; g4 < 4; ++g4) *(u32x2*)(L + nqt + (tj0 + r) * 128 + (ti0 + 8 * g4 + 4 * h) * 2) = pack4(acc[4 * g4], acc[4 * g4 + 1], acc[4 * g4 + 2], acc[4 * g4 + 3]);
#pragma unroll
                for (int g = 0; g < 16; ++g) *(bf16_t*)(L + nqa + (ti0 + crow(g, h)) * 128 + (tj0 + r) * 2) = f2bf(acc[g]);
            }
            __syncthreads();
        }
    }
    {
        const int p = wave >> 2, i0 = ((wave >> 1) & 1) * 32, j0 = (wave & 1) * 32; f32x16 acc; zero16(acc);
        if (p == 0) {
            mm_tile(acc, L + LA_TMT, i0, L + LA_AT, j0, r, h);
#pragma unroll
            for (int g4 = 0; g4 < 4; ++g4) *(u32x2*)(L + LA_M1 + (j0 + r) * 128 + (i0 + 8 * g4 + 4 * h) * 2) = pack4(acc[4 * g4], acc[4 * g4 + 1], acc[4 * g4 + 2], acc[4 * g4 + 3]);
        } else {
            mm_tile(acc, L + LA_NKA, i0, L + LA_TMT, j0, r, h);
#pragma unroll
            for (int g4 = 0; g4 < 4; ++g4) *(u32x2*)(L + LA_W1T + (j0 + r) * 128 + (i0 + 8 * g4 + 4 * h) * 2) = pack4(acc[4 * g4], acc[4 * g4 + 1], acc[4 * g4 + 2], acc[4 * g4 + 3]);
        }
    }
    __syncthreads();
    if (wave < 4) {
        const int i0 = (wave >> 1) * 32, j0 = (wave & 1) * 32; f32x16 acc; zero16(acc);
        mm_tile(acc, L + LA_W1T, i0, L + LA_VT, j0, r, h);
#pragma unroll
        for (int g4 = 0; g4 < 4; ++g4) *(u32x2*)(L + LA_Z1 + (j0 + r) * 128 + (i0 + 8 * g4 + 4 * h) * 2) = pack4(acc[4 * g4], acc[4 * g4 + 1], acc[4 * g4 + 2], acc[4 * g4 + 3]);
    }
    __syncthreads();
    {
        const int p = wave >> 1, i0 = (wave & 1) * 32;
        bf16_t* GM3 = (bf16_t*)(ws + WS_RW + RW_M3) + (size_t)unit * 4096; bf16_t* GM2 = (bf16_t*)(ws + WS_RW + RW_M2) + (size_t)unit * 4096; bf16_t* GZ5 = (bf16_t*)(ws + WS_RW + RW_Z5) + (size_t)unit * 4096;
        float* YO = (float*)(ws + WS_BUFB) + (size_t)dir * NZ * 256;
#pragma unroll
        for (int jt = 0; jt < 2; ++jt) {
            const int j0 = jt * 32; f32x16 acc; zero16(acc);
            if (p == 0) {
                mm_tile(acc, L + LA_M1, i0, L + LA_NBRT, j0, r, h);
#pragma unroll
                for (int g4 = 0; g4 < 4; ++g4) { const int tt = j0 + r, kq = i0 + 8 * g4 + 4 * h; float rv[4]; unpack4(*(const u32x2*)(L + LA_RN + tt * 128 + kq * 2), rv);
                    *(u32x2*)(GM2 + tt * 64 + kq) = pack4(acc[4 * g4] + rv[0], acc[4 * g4 + 1] + rv[1], acc[4 * g4 + 2] + rv[2], acc[4 * g4 + 3] + rv[3]); }
            } else if (p == 1) {
                mm_tile(acc, L + LA_NBRT, i0, L + LA_Z1, j0, r, h); mm_tile(acc, L + LA_NKRT, i0, L + LA_VT, j0, r, h);
#pragma unroll
                for (int g = 0; g < 16; ++g) { const int tt = i0 + crow(g, h); YO[(size_t)(b * TZ + rw_tok(dir, ch * RC + tt)) * 256 + hd * 64 + j0 + r] = acc[g]; }
            } else if (p == 2) {
                mm_tile(acc, L + LA_M1, i0, L + LA_BHT, j0, r, h);
#pragma unroll
                for (int g4 = 0; g4 < 4; ++g4) *(u32x2*)(GM3 + (j0 + r) * 64 + i0 + 8 * g4 + 4 * h) = pack4(acc[4 * g4], acc[4 * g4 + 1], acc[4 * g4 + 2], acc[4 * g4 + 3]);
            } else {
                mm_tile(acc, L + LA_BHT, i0, L + LA_Z1, j0, r, h); mm_tile(acc, L + LA_KHT, i0, L + LA_VT, j0, r, h);
#pragma unroll
                for (int g4 = 0; g4 < 4; ++g4) *(u32x2*)(GZ5 + (j0 + r) * 64 + i0 + 8 * g4 + 4 * h) = pack4(acc[4 * g4], acc[4 * g4 + 1], acc[4 * g4 + 2], acc[4 * g4 + 3]);
            }
        }
    }
}
DI void phase_rwkv_chunks(const Ctx& c, int l) {
    for (int u = blockIdx.x; u < 16 * RNC; u += gridDim.x) phase_rwkv_chunk_unit(c, l, u);
}
DI bf16x8 pack8(const f32x16& x, int s) {
    u32x4 p; p.x = pack2(x[8 * s], x[8 * s + 1]); p.y = pack2(x[8 * s + 2], x[8 * s + 3]); p.z = pack2(x[8 * s + 4], x[8 * s + 5]); p.w = pack2(x[8 * s + 6], x[8 * s + 7]);
    return __builtin_bit_cast(bf16x8, p);
}
DI bf16x8 ldfrag(const bf16_t* rowp, int s, int h) {
    const u32x2 lo = *(const u32x2*)(rowp + 16 * s + 4 * h), hi = *(const u32x2*)(rowp + 16 * s + 8 + 4 * h);
    u32x4 v; v.x = lo.x; v.y = lo.y; v.z = hi.x; v.w = hi.y; return __builtin_bit_cast(bf16x8, v);
}
constexpr int SQ_PITCH = 144, SQ_MAT = 64 * SQ_PITCH;
constexpr int SQA_M3 = 0, SQA_Z5 = SQ_MAT, SQA_P63 = 2 * SQ_MAT, SQA_BYTES = SQA_P63 + 256;
constexpr int SQB_M2 = 0, SQB_Y = SQ_MAT, SQB_BYTES = SQB_Y + 64 * 64 * 4;
constexpr int SQ_NST = 3;
constexpr int SQ_A0 = 0, SQ_B0 = SQ_NST * SQA_BYTES, SQ_XB = SQ_B0 + SQ_NST * SQB_BYTES, SQ_END = SQ_XB + 4 * 4096;
DI bf16x8 ldfrag_l(const unsigned char* rowp, int s, int h) {
    const u32x2 lo = *(const u32x2*)(rowp + (16 * s + 4 * h) * 2), hi = *(const u32x2*)(rowp + (16 * s + 8 + 4 * h) * 2);
    u32x4 v; v.x = lo.x; v.y = lo.y; v.z = hi.x; v.w = hi.y; return __builtin_bit_cast(bf16x8, v);
}
struct SqRegsA { u32x4 m3[2], z5[2], p63; };
struct SqRegsB { u32x4 m2[2], y[4]; };
DI void sqa_gload(const Ctx& c, size_t unit, int lt, SqRegsA& g) {
    const unsigned char* g3 = c.ws + WS_RW + RW_M3 + unit * 8192; const unsigned char* g5 = c.ws + WS_RW + RW_Z5 + unit * 8192;
#pragma unroll
    for (int i = 0; i < 2; ++i) { const int id = lt + i * 256; g.m3[i] = *(const u32x4*)(g3 + id * 16); g.z5[i] = *(const u32x4*)(g5 + id * 16); }
    if (lt < 16) g.p63 = *(const u32x4*)(c.ws + WS_RW + RW_P63 + unit * 256 + lt * 16);
}
DI void sqa_lstore(unsigned char* st, int lt, const SqRegsA& g) {
#pragma unroll
    for (int i = 0; i < 2; ++i) { const int id = lt + i * 256, row = id >> 3, part = id & 7;
        *(u32x4*)(st + SQA_M3 + row * SQ_PITCH + part * 16) = g.m3[i]; *(u32x4*)(st + SQA_Z5 + row * SQ_PITCH + part * 16) = g.z5[i]; }
    if (lt < 16) *(u32x4*)(st + SQA_P63 + lt * 16) = g.p63;
}
DI void sqb_gload(const Ctx& c, size_t unit, const float* YO, int dir, int ch, int lt, SqRegsB& g) {
    const unsigned char* g2 = c.ws + WS_RW + RW_M2 + unit * 8192;
#pragma unroll
    for (int i = 0; i < 2; ++i) g.m2[i] = *(const u32x4*)(g2 + (lt + i * 256) * 16);
#pragma unroll
    for (int i = 0; i < 4; ++i) { const int id = lt + i * 256; g.y[i] = *(const u32x4*)(YO + (size_t)rw_tok(dir, ch * RC + (id >> 4)) * 256 + (id & 15) * 4); }
}
DI void sqb_lstore(unsigned char* st, int lt, const SqRegsB& g) {
#pragma unroll
    for (int i = 0; i < 2; ++i) { const int id = lt + i * 256; *(u32x4*)(st + SQB_M2 + (id >> 3) * SQ_PITCH + (id & 7) * 16) = g.m2[i]; }
#pragma unroll
    for (int i = 0; i < 4; ++i) { const int id = lt + i * 256; *(u32x4*)(st + SQB_Y + (id >> 4) * 256 + (id & 15) * 16) = g.y[i]; }
}
DI void sqb_store_y(float* YO, int dir, int ch, const unsigned char* st, int lt, int vhb) {
#pragma unroll
    for (int i = 0; i < 2; ++i) { const int id = lt + i * 256; *(u32x4*)(YO + (size_t)rw_tok(dir, ch * RC + (id >> 3)) * 256 + vhb * 32 + (id & 7) * 4) = *(const u32x4*)(st + SQB_Y + id * 16); }
}
DI void phase_rwkv_seq_block(const Ctx& c, int l, int chain, int vhb) {
    unsigned char* L = c.smem; const int lane = c.lane, wave = c.wave, r = lane & 31, h = lane >> 5;
    const int dir = chain & 1, hd = (chain >> 1) & 3, b = chain >> 3, lt = c.tid - 256, vh = vhb; const bool act = (wave & 1) == 0;
    const size_t unit0 = (size_t)chain * RNC;
    __syncthreads();
    if (wave >= 4) {
        float* YO = (float*)(c.ws + WS_BUFB) + (size_t)dir * NZ * 256 + (size_t)b * TZ * 256 + hd * 64;
        const int lt2 = lt & 255;
        int moff[3], mdst[3];
#pragma unroll
        for (int i = 0; i < 3; ++i) { const int id = i < 2 ? lt2 + 256 * i : 512 + lane; const int row = id / 9, ck = id - row * 9; moff[i] = row * 128 + (ck == 8 ? 7 : ck) * 16; mdst[i] = id * 16; }
        int zoff[2], zdst[2];
#pragma unroll
        for (int i = 0; i < 2; ++i) { const int id = i == 0 ? lt2 : 256 + lane; int row = id / 9; const int ck = id - row * 9; zdst[i] = (vhb * 32 * 9 + id) * 16; row += vhb * 32; if (row > 63) row = 63; zoff[i] = row * 128 + (ck == 8 ? 7 : ck) * 16; }
        const unsigned char* gM3 = c.ws + WS_RW + RW_M3; const unsigned char* gZ5 = c.ws + WS_RW + RW_Z5; const unsigned char* gM2 = c.ws + WS_RW + RW_M2; const unsigned char* gP = c.ws + WS_RW + RW_P63;
        auto dmaA = [&](int ch, int stg) {
            const size_t unit = unit0 + (ch < RNC ? ch : RNC - 1); unsigned char* st = L + SQ_A0 + stg * SQA_BYTES;
#pragma unroll
            for (int i = 0; i < 3; ++i) __builtin_amdgcn_global_load_lds((const unsigned*)(gM3 + unit * 8192 + moff[i]), (unsigned*)(st + SQA_M3 + mdst[i]), 16, 0, 0);
            __builtin_amdgcn_global_load_lds((const unsigned*)(gZ5 + unit * 8192 + zoff[0]), (unsigned*)(st + SQA_Z5 + zdst[0]), 16, 0, 0);
            if (lane < 32) __builtin_amdgcn_global_load_lds((const unsigned*)(gZ5 + unit * 8192 + zoff[1]), (unsigned*)(st + SQA_Z5 + zdst[1]), 16, 0, 0);
            if (lane < 16) __builtin_amdgcn_global_load_lds((const unsigned*)(gP + unit * 256 + lane * 16), (unsigned*)(st + SQA_P63 + lane * 16), 16, 0, 0);
        };
        auto dmaB = [&](int ch, int stg) {
            const int cc = ch < RNC ? ch : RNC - 1; const size_t unit = unit0 + cc; unsigned char* st = L + SQ_B0 + stg * SQB_BYTES;
#pragma unroll
            for (int i = 0; i < 3; ++i) __builtin_amdgcn_global_load_lds((const unsigned*)(gM2 + unit * 8192 + moff[i]), (unsigned*)(st + SQB_M2 + mdst[i]), 16, 0, 0);
#pragma unroll
            for (int i = 0; i < 2; ++i) { const int id = lt2 + i * 256; __builtin_amdgcn_global_load_lds((const unsigned*)(YO + (size_t)rw_tok(dir, cc * RC + (id >> 3)) * 256 + vhb * 32 + (id & 7) * 4), (unsigned*)(st + SQB_Y + id * 16), 16, 0, 0); }
        };
        dmaA(0, 0); dmaA(1, 1); dmaB(0, 0);
        asm volatile("s_waitcnt vmcnt(0)" ::: "memory");
        __builtin_amdgcn_s_barrier();
        int sa2 = 2, sb1 = 1;
#pragma unroll 1
        for (int ch = 0; ch <= RNC; ++ch) {
            if (ch >= 2) sqb_store_y(YO, dir, ch - 2, L + SQ_B0 + sb1 * SQB_BYTES, lt2, vhb);
            asm volatile("" ::: "memory");
            dmaA(ch + 2, sa2); dmaB(ch + 1, sb1);
            asm volatile("s_waitcnt vmcnt(11)" ::: "memory");
            __builtin_amdgcn_s_barrier();
            asm volatile("" ::: "memory");
            sa2 = sa2 == 2 ? 0 : sa2 + 1; sb1 = sb1 == 2 ? 0 : sb1 + 1;
        }
        sqb_store_y(YO, dir, RNC - 1, L + SQ_B0 + ((RNC - 1) % 3) * SQB_BYTES, lt2, vhb);
    } else if (wave < 2) {
        f32x16 x[2]; zero16(x[0]); zero16(x[1]);
        __syncthreads();
#pragma unroll 1
        for (int ch = 0; ch <= RNC; ++ch) {
            if (ch < RNC && act) {
                const unsigned char* st = L + SQ_A0 + (ch % 3) * SQA_BYTES;
                unsigned char* xbuf = L + SQ_XB + ((ch & 1) * 2 + vh) * 4096 + lane * 16;
                bf16x8 xb[4];
#pragma unroll
                for (int s = 0; s < 4; ++s) { xb[s] = pack8(x[s >> 1], s & 1); *(bf16x8*)(xbuf + s * 1024) = xb[s]; }
                f32x16 xn0, xn1;
#pragma unroll
                for (int i = 0; i < 2; ++i) {
                    f32x16 xa;
#pragma unroll
                    for (int g4 = 0; g4 < 4; ++g4) {
                        float z5[4]; unpack4(*(const u32x2*)(st + SQA_Z5 + (vh * 32 + r) * SQ_PITCH + (32 * i + 8 * g4 + 4 * h) * 2), z5);
                        const float4 p4 = *(const float4*)(st + SQA_P63 + (32 * i + 8 * g4 + 4 * h) * 4);
                        xa[4 * g4] = fmaf(p4.x, x[i][4 * g4], z5[0]); xa[4 * g4 + 1] = fmaf(p4.y, x[i][4 * g4 + 1], z5[1]);
                        xa[4 * g4 + 2] = fmaf(p4.z, x[i][4 * g4 + 2], z5[2]); xa[4 * g4 + 3] = fmaf(p4.w, x[i][4 * g4 + 3], z5[3]);
                    }
#pragma unroll
                    for (int s = 0; s < 4; ++s) xa = __builtin_amdgcn_mfma_f32_32x32x16_bf16(ldfrag_l(st + SQA_M3 + (32 * i + r) * SQ_PITCH, s, h), xb[s], xa, 0, 0, 0);
                    if (i == 0) xn0 = xa; else xn1 = xa;
                }
                x[0] = xn0; x[1] = xn1;
            }
            __syncthreads();
        }
    } else {
        __syncthreads();
#pragma unroll 1
        for (int ch = 0; ch <= RNC; ++ch) {
            if (ch >= 1 && act) {
                const int cy = ch - 1;
                unsigned char* st = L + SQ_B0 + (cy % 3) * SQB_BYTES;
                const unsigned char* xbuf = L + SQ_XB + ((cy & 1) * 2 + vh) * 4096 + lane * 16;
                bf16x8 xb[4];
#pragma unroll
                for (int s = 0; s < 4; ++s) xb[s] = *(const bf16x8*)(xbuf + s * 1024);
#pragma unroll
                for (int i = 0; i < 2; ++i) {
                    f32x16 ya;
#pragma unroll
                    for (int g = 0; g < 16; ++g) ya[g] = *((const float*)(st + SQB_Y) + (32 * i + crow(g, h)) * 32 + r);
#pragma unroll
                    for (int s = 0; s < 4; ++s) ya = __builtin_amdgcn_mfma_f32_32x32x16_bf16(ldfrag_l(st + SQB_M2 + (32 * i + r) * SQ_PITCH, s, h), xb[s], ya, 0, 0, 0);
#pragma unroll
                    for (int g = 0; g < 16; ++g) *((float*)(st + SQB_Y) + (32 * i + crow(g, h)) * 32 + r) = ya[g];
                }
            }
            __syncthreads();
        }
    }
}
DI void phase_mixers2(const Ctx& c, int l) {
    const int G = gridDim.x, bid = blockIdx.x;
    if (G >= 128) {
        if (bid < 32) phase_rwkv_seq_block(c, l, bid >> 1, bid & 1);
        else for (int u = bid - 32; u < 2 * S5N * 4; u += G - 32) phase_s5_final_unit<false>(c, l, u);
    } else {
        for (int u = bid; u < 32; u += G) phase_rwkv_seq_block(c, l, u >> 1, u & 1);
        for (int u = bid; u < 2 * S5N * 4; u += G) phase_s5_final_unit<false>(c, l, u);
    }
}

DI void phase_post(const Ctx& c, int l) {
    unsigned char* ws = c.ws; const int lane = c.lane;
    const float* YF = (const float*)(ws + WS_BUFB); const float* YB = YF + (size_t)NZ * 256;
    const bf16_t* RB = (const bf16_t*)(ws + WS_EXPW + MX_RB); const bf16_t* VB = (const bf16_t*)(ws + WS_EXPW + MX_VB);
    const bf16_t* SKD = (const bf16_t*)(ws + WS_P + P_PR) + (size_t)4 * NZ * 256; const bf16_t* GG = (const bf16_t*)(ws + WS_MISC + MS_GG);
    bf16_t* Ycat = (bf16_t*)(ws + WS_BUFA);
    const float* r_k = c.in[21] + l * 256; const float* lg = c.in[22] + l * 256; const float* lb = c.in[23] + l * 256;
    for (int z = blockIdx.x * 8 + c.wave; z < NZ; z += gridDim.x * 8) {
        const size_t o = (size_t)z * 256 + lane * 4;
        const float4 yf = *(const float4*)(YF + o), yb = *(const float4*)(YB + o);
        const float y0 = yf.x + yb.x, y1 = yf.y + yb.y, y2 = yf.z + yb.z, y3 = yf.w + yb.w;
        const float mean = sum16(y0 + y1 + y2 + y3) * (1.f / 64.f);
        const float d0 = y0 - mean, d1 = y1 - mean, d2 = y2 - mean, d3 = y3 - mean;
        const float var = sum16(d0 * d0 + d1 * d1 + d2 * d2 + d3 * d3) * (1.f / 64.f);
        const float rs = rsqrtf(var + 64e-5f);
        float r[4], v[4], k0[4], k1[4], gg[4];
        unpack4(*(const u32x2*)(RB + o), r); unpack4(*(const u32x2*)(VB + o), v); unpack4(*(const u32x2*)(SKD + o), k0); unpack4(*(const u32x2*)(SKD + (size_t)NZ * 256 + o), k1);
        unpack4(*(const u32x2*)(GG + o), gg);
        const float4 rk = *(const float4*)(r_k + lane * 4), g4 = *(const float4*)(lg + lane * 4), b4 = *(const float4*)(lb + lane * 4);
        const float bs = sum16(r[0] * (k0[0] + k1[0]) * rk.x + r[1] * (k0[1] + k1[1]) * rk.y + r[2] * (k0[2] + k1[2]) * rk.z + r[3] * (k0[3] + k1[3]) * rk.w);
        *(u32x2*)(Ycat + (size_t)z * D + 256 + lane * 4) = pack4((d0 * rs * g4.x + b4.x + bs * v[0]) * gg[0], (d1 * rs * g4.y + b4.y + bs * v[1]) * gg[1],
                                                                (d2 * rs * g4.z + b4.z + bs * v[2]) * gg[2], (d3 * rs * g4.w + b4.w + bs * v[3]) * gg[3]);
    }
    {
        const bf16_t* ZG = (const bf16_t*)(ws + WS_MISC + MS_ZG); const bf16_t* W = (const bf16_t*)(ws + WS_WSM + OFF_GLUT + l * SZ_GLUT);
        const float* gb = c.in[33] + l * 256;
        for (int u = blockIdx.x; u < (NZ / 256) * 2; u += gridDim.x) {
            const int mt = u / 2, nt = u % 2, r0 = mt * 256, c0 = nt * 128;
            gemm_tile<4, 0>(c, 256, [&](int i) { return ZG + (size_t)(r0 + i) * 256; }, [&](int i) { return W + (size_t)(c0 + i) * 256; }, NoHook(),
                [&](f32x4 (&acc)[4][4], int wr, int wc, int fr, int fq) {
                    u32x2 zq[4][4]; float4 bq[4];
#pragma unroll
                    for (int n = 0; n < 4; ++n) {
                        const int col = c0 + wc + n * 16 + fq * 4; bq[n] = *(const float4*)(gb + col);
#pragma unroll
                        for (int m = 0; m < 4; ++m) zq[m][n] = *(const u32x2*)(ZG + (size_t)(r0 + wr + m * 16 + fr) * 256 + col);
                    }
#pragma unroll
                    for (int n = 0; n < 4; ++n) {
                        const int col = c0 + wc + n * 16 + fq * 4; const float4 bb = bq[n];
#pragma unroll
                        for (int m = 0; m < 4; ++m) {
                            const int row = r0 + wr + m * 16 + fr; const f32x4 v = acc[m][n];
                            float zg[4]; unpack4(zq[m][n], zg);
                            *(u32x2*)(Ycat + (size_t)row * D + 512 + col) = pack4(zg[0] * sigmoidf_(v[0] + bb.x), zg[1] * sigmoidf_(v[1] + bb.y), zg[2] * sigmoidf_(v[2] + bb.z), zg[3] * sigmoidf_(v[3] + bb.w));
                        }
                    }
                });
        }
    }
}

DI bool skip_mt(int l, int mt) { return l == NL - 1 && (mt % 33) == 0; }
DI bool merge_split(int l) { return l == 0 && NL > 1 && gridDim.x == 256; }
DI void phase_merge1(const Ctx& c, int l, int part) {
    const bf16_t* Ycat = (const bf16_t*)(c.ws + WS_BUFA); const bf16_t* W = (const bf16_t*)(c.ws + WS_WSM + OFF_WBT + l * SZ_WBT);
    const bf16_t* GT = (const bf16_t*)(c.ws + WS_GT); bf16_t* MG = (bf16_t*)(c.ws + WS_BUFB);
    if (part == 0 && blockIdx.x == 0 && c.tid < 32) ((unsigned*)(c.ws + WS_CTL))[CW_CNT + l * 32 + c.tid] = 0u;
    const bool split = merge_split(l);
    const int u_lo = part == 0 ? (int)blockIdx.x : 512 + (int)blockIdx.x, u_hi = part == 0 ? (split ? 512 : (NZ / 256) * 8) : (NZ / 256) * 8;
    for (int u = u_lo; u < u_hi; u += gridDim.x) {
        const int mt = u / 8, nt = u % 8, r0 = mt * 256, c0 = nt * 128;
        if (skip_mt(l, mt)) continue;
        f32x4 macc[4][4];
#pragma unroll
        for (int m = 0; m < 4; ++m)
#pragma unroll
            for (int n = 0; n < 4; ++n) macc[m][n] = (f32x4){0.f, 0.f, 0.f, 0.f};
        gemm_tile<4, 256>(c, 1024, [&](int i) { return Ycat + (size_t)(r0 + i) * D; }, [&](int i) { return W + (size_t)(c0 + i) * D; },
            [&](f32x4 (&acc)[4][4], int seg, int wr, int wc, int fr, int fq) {
#pragma unroll
                for (int m = 0; m < 4; ++m)
#pragma unroll
                    for (int n = 0; n < 4; ++n) {
                        float g[4]; unpack4(*(const u32x2*)(GT + (size_t)(r0 + wr + m * 16 + fr) * 4096 + seg * 1024 + c0 + wc + n * 16 + fq * 4), g);
                        macc[m][n][0] += g[0] * acc[m][n][0]; macc[m][n][1] += g[1] * acc[m][n][1]; macc[m][n][2] += g[2] * acc[m][n][2]; macc[m][n][3] += g[3] * acc[m][n][3];
                        acc[m][n] = (f32x4){0.f, 0.f, 0.f, 0.f};
                    }
            },
            [&](f32x4 (&)[4][4], int wr, int wc, int fr, int fq) {
#pragma unroll
                for (int m = 0; m < 4; ++m)
#pragma unroll
                    for (int n = 0; n < 4; ++n)
                        *(u32x2*)(MG + (size_t)(r0 + wr + m * 16 + fr) * D + c0 + wc + n * 16 + fq * 4) = pack4(macc[m][n][0], macc[m][n][1], macc[m][n][2], macc[m][n][3]);
            });
    }
}
struct EpiMerge2 {
    static constexpr bool PERM = false, AFTER_DRAIN = false;
    float* H; const float* modv; int l;
    DI void operator()(const pg8::f32x4 (&acc)[2][2][4][2], const pg8::Unit& u, int wr, int wc, int fr, int fq) const {
        if (skip_mt(l, u.pm)) return;
        const int sel = (u.pm % 33) == 0 ? 2 : u.pm / 33;
        const int row0 = u.pm * 256 + wr * 64 + fr, col0 = u.pn * 256 + wc * 32 + 4 * fq;
#pragma unroll
        for (int bj = 0; bj < 2; ++bj)
#pragma unroll
            for (int n = 0; n < 2; ++n) {
                const int col = col0 + bj * 128 + n * 16; const float4 m2 = *(const float4*)(modv + ((size_t)l * 3 + sel) * 6144 + 2 * 1024 + col);
#pragma unroll
                for (int ai = 0; ai < 2; ++ai)
#pragma unroll
                    for (int m = 0; m < 4; ++m) {
                        float4* hp = (float4*)(H + (size_t)(row0 + ai * 128 + m * 16) * D + col); float4 hv = *hp; const pg8::f32x4 v = acc[ai][bj][m][n];
                        hv.x += m2.x * v[0]; hv.y += m2.y * v[1]; hv.z += m2.z * v[2]; hv.w += m2.w * v[3]; *hp = hv;
                    }
            }
    }
};
struct LatOrder {
    int G, c;
    DI bool next(int i, pg8::Unit& u) const { const int L = i * G + c; if (L >= 256) return false; const int pl = L >> 2; u.pm = (pl >> 5) * 33 + 1 + (pl & 31); u.pn = L & 3; return true; }
    DI void a_ready(const pg8::Unit&) const {}
    DI void done(const pg8::Unit&) const {}
};
struct SplitOrder {
    int mode, c;
    DI bool next(int i, pg8::Unit& u) const {
        if (i > 0) return false;
        int L; if (mode == 1) { if (c < 16) return false; L = c - 16; } else { if (c >= 24) return false; L = 240 + c; }
        u.pm = L >> 2; u.pn = L & 3; return true;
    }
    DI void a_ready(const pg8::Unit&) const {}
    DI void done(const pg8::Unit&) const {}
};
DI void phase_merge2(const Ctx& c, int l, int mode) {
    EpiMerge2 E; E.H = (float*)(c.ws + WS_H); E.modv = (const float*)(c.ws + WS_WSM + OFF_MODV); E.l = l;
    pg8::Gemm g{(const bf16_t*)(c.ws + WS_BUFB), (const bf16_t*)(c.ws + WS_WSM + OFF_WOUTT + l * SZ_WOUTT), NZ, 1024, 1024, 1024, 1024};
    __syncthreads();
    if (mode != 0) {
        SplitOrder S; S.mode = mode; S.c = (int)blockIdx.x;
        pg8::gemm_phase<EpiMerge2, SplitOrder, false>((PG8_LAS unsigned char*)c.smem, g, S, E, nullptr, c.tid);
    } else if (l == NL - 1) {
        LatOrder S; S.G = (int)gridDim.x; S.c = (int)blockIdx.x;
        pg8::gemm_phase<EpiMerge2, LatOrder, false>((PG8_LAS unsigned char*)c.smem, g, S, E, nullptr, c.tid);
    } else {
        pg8::StaticOrder S; S.init(NZ, 1024, (int)gridDim.x, (int)blockIdx.x, MERGE2_WGM);
        pg8::gemm_phase<EpiMerge2, pg8::StaticOrder, false>((PG8_LAS unsigned char*)c.smem, g, S, E, nullptr, c.tid);
    }
}

constexpr int RT_PITCH = 68;
constexpr int RT_RED_W = 8 * 4 * RT_PITCH;
DI void phase_norm2_route(const Ctx& c, int l) {
    unsigned char* ws = c.ws; const int lane = c.lane, wave = c.wave, tid = c.tid;
    const float* modv = (const float*)(ws + WS_WSM + OFF_MODV); const float* H = (const float*)(ws + WS_H);
    bf16_t* XN = (bf16_t*)(ws + WS_BUFA); const float* g2 = c.in[7] + l * 1024;
    const float* rwt = (const float*)(ws + WS_WSM + OFF_RWT) + (size_t)l * 36 * 1024;
    const float* bg = c.in[42] + l * 4; const float* be = c.in[44] + l * 32;
    unsigned* cnt = (unsigned*)(ws + WS_CTL) + CW_CNT + l * 32;
    int* list = (int*)(ws + WS_GT + GT_LIST); float* lw = (float*)(ws + WS_GT + GT_LW);
    float* red = (float*)c.smem + wave * RT_RED_W;
    float* lgs = (float*)c.smem + 8 * RT_RED_W + wave * 8 * 40;
    int* hist = (int*)((float*)c.smem + 8 * RT_RED_W + 8 * 8 * 40);
    int* sel = hist + 64;
    float* selw = (float*)(sel + 128);
    const int ngroups = (l == NL - 1) ? (NB * SEQ / 64) : (NZ / 64);
    for (int grp = blockIdx.x; grp < ngroups; grp += gridDim.x) {
        __syncthreads();
        if (tid < 32) hist[tid] = 0;
        __syncthreads();
        float x[8][16];
#pragma unroll
        for (int i = 0; i < 8; ++i) {
            const int rl = wave * 8 + i; int row;
            if (l == NL - 1) { const int rr = grp * 64 + rl; row = (rr / SEQ) * TZ + CTX + (rr % SEQ); } else row = grp * 64 + rl;
#pragma unroll
            for (int q = 0; q < 4; ++q) { const float4 v = *(const float4*)(H + (size_t)row * D + q * 256 + lane * 4); x[i][q * 4] = v.x; x[i][q * 4 + 1] = v.y; x[i][q * 4 + 2] = v.z; x[i][q * 4 + 3] = v.w; }
        }
        float4 gq4[4], m3q[4], m4q[4];
        {
            int row0; if (l == NL - 1) { const int rr = grp * 64; row0 = (rr / SEQ) * TZ + CTX + (rr % SEQ); } else row0 = grp * 64;
            const int b0 = row0 / TZ, s0 = row0 % TZ, sel0 = s0 < CTX ? 2 : b0;
#pragma unroll
            for (int q = 0; q < 4; ++q) { const int col = q * 256 + lane * 4; gq4[q] = *(const float4*)(g2 + col);
                m3q[q] = *(const float4*)(modv + ((size_t)l * 3 + sel0) * 6144 + 3 * 1024 + col); m4q[q] = *(const float4*)(modv + ((size_t)l * 3 + sel0) * 6144 + 4 * 1024 + col); }
        }
#pragma unroll
        for (int i = 0; i < 8; ++i) {
            const int rl = wave * 8 + i; int row;
            if (l == NL - 1) { const int rr = grp * 64 + rl; row = (rr / SEQ) * TZ + CTX + (rr % SEQ); } else row = grp * 64 + rl;
            float ss = 0.f;
#pragma unroll
            for (int j = 0; j < 16; ++j) ss += x[i][j] * x[i][j];
            ss = wave_sum(ss);
            const float rs = rsqrtf(ss * (1.f / 1024.f) + 1e-6f);
#pragma unroll
            for (int q = 0; q < 4; ++q) {
                const int col = q * 256 + lane * 4;
                const float4 g = gq4[q], m3 = m3q[q], m4 = m4q[q];
                x[i][q * 4] = x[i][q * 4] * rs * g.x * (1.f + m4.x) + m3.x; x[i][q * 4 + 1] = x[i][q * 4 + 1] * rs * g.y * (1.f + m4.y) + m3.y;
                x[i][q * 4 + 2] = x[i][q * 4 + 2] * rs * g.z * (1.f + m4.z) + m3.z; x[i][q * 4 + 3] = x[i][q * 4 + 3] * rs * g.w * (1.f + m4.w) + m3.w;
                *(u32x2*)(XN + (size_t)row * D + col) = pack4(x[i][q * 4], x[i][q * 4 + 1], x[i][q * 4 + 2], x[i][q * 4 + 3]);
            }
        }
#pragma unroll 1
        for (int ec = 0; ec < 9; ++ec) {
#pragma unroll
            for (int ee = 0; ee < 4; ++ee) {
                const int e = ec * 4 + ee;
                float4 w[4];
#pragma unroll
                for (int q = 0; q < 4; ++q) w[q] = *(const float4*)(rwt + (size_t)e * 1024 + q * 256 + lane * 4);
#pragma unroll
                for (int i = 0; i < 8; ++i) {
                    float a = 0.f;
#pragma unroll
                    for (int q = 0; q < 4; ++q) a += x[i][q * 4] * w[q].x + x[i][q * 4 + 1] * w[q].y + x[i][q * 4 + 2] * w[q].z + x[i][q * 4 + 3] * w[q].w;
                    red[(i * 4 + ee) * RT_PITCH + lane] = a;
                }
            }
            __builtin_amdgcn_wave_barrier();
            if (lane < 32) {
                float s0 = 0.f, s1 = 0.f, s2 = 0.f, s3 = 0.f;
#pragma unroll
                for (int q = 0; q < 16; ++q) { const float4 v = *(const float4*)(red + lane * RT_PITCH + q * 4); s0 += v.x; s1 += v.y; s2 += v.z; s3 += v.w; }
                const int e = ec * 4 + (lane & 3);
                lgs[(lane >> 2) * 40 + e] = (s0 + s1) + (s2 + s3) + (e < 4 ? bg[e] : be[e - 4]);
            }
            __builtin_amdgcn_wave_barrier();
        }
        if (lane < 8) {
            const float* lg = lgs + lane * 40;
            float gm = lg[0]; int gsel = 0;
#pragma unroll
            for (int g = 1; g < 4; ++g) if (lg[g] > gm) { gm = lg[g]; gsel = g; }
            const float gs = __expf(lg[0] - gm) + __expf(lg[1] - gm) + __expf(lg[2] - gm) + __expf(lg[3] - gm);
            const float pg = 1.f / gs;
            float l1 = -1e30f, l2 = -1e30f; int e1 = 0, e2 = 0;
#pragma unroll
            for (int j = 0; j < 8; ++j) {
                const float v = lg[4 + gsel * 8 + j]; const int e = gsel * 8 + j;
                if (v > l1) { l2 = l1; e2 = e1; l1 = v; e1 = e; } else if (v > l2) { l2 = v; e2 = e; }
            }
            const float tt = __expf(l2 - l1), w1 = pg / (1.f + tt), w2 = pg * tt / (1.f + tt);
            const int rl = wave * 8 + lane;
            const int r1 = atomicAdd(&hist[e1], 1), r2 = atomicAdd(&hist[e2], 1);
            sel[rl * 2] = e1 | (r1 << 8); sel[rl * 2 + 1] = e2 | (r2 << 8); selw[rl * 2] = w1; selw[rl * 2 + 1] = w2;
        }
        __syncthreads();
        if (tid < 32) hist[32 + tid] = (int)atomicAdd(&cnt[tid], (unsigned)hist[tid]);
        __syncthreads();
        if (tid < 128) {
            const int rl = tid >> 1, j = tid & 1, sv = sel[tid], e = sv & 255, rk = sv >> 8;
            int row;
            if (l == NL - 1) { const int rr = grp * 64 + rl; row = (rr / SEQ) * TZ + CTX + (rr % SEQ); } else row = grp * 64 + rl;
            const size_t pos = (size_t)e * MOE_CAP + hist[32 + e] + rk;
            list[pos] = row * 2 + j; lw[pos] = selw[tid];
        }
    }
    phase_expert_convert(c, l);
}

DI void moe_prefix(const Ctx& c, int l, int* tiles  , int* cnts  ) {
    __syncthreads();
    if (c.tid == 0) {
        const unsigned* cnt = (const unsigned*)(c.ws + WS_CTL) + CW_CNT + l * 32; int acc = 0;
        for (int e = 0; e < 32; ++e) { const int n = (int)__hip_atomic_load(cnt + e, __ATOMIC_RELAXED, __HIP_MEMORY_SCOPE_AGENT); cnts[e] = n; tiles[e] = acc; acc += (n + 127) / 128; }
        tiles[32] = acc;
    }
    __syncthreads();
}
DI void phase_moe1(const Ctx& c, int l) {
    unsigned char* ws = c.ws;
    int* tiles = (int*)(c.smem + 120 * 1024); int* cnts = tiles + 40;
    moe_prefix(c, l, tiles, cnts);
    const bf16_t* XN = (const bf16_t*)(ws + WS_BUFA); bf16_t* HM = (bf16_t*)(ws + WS_GT + GT_HM); const int* list = (const int*)(ws + WS_GT + GT_LIST);
    const int nt_total = tiles[32];
    for (int u = blockIdx.x; u < nt_total * 4; u += gridDim.x) {
        const int mtg = u >> 2, nt = u & 3;
        int e = 0;
        for (int k = 1; k < 32; ++k) if (tiles[k] <= mtg) e = k;
        const int mt = mtg - tiles[e], n_e = cnts[e];
        const int* le = list + (size_t)e * MOE_CAP;
        const bf16_t* W = (const bf16_t*)(ws + WS_EXPW + (size_t)e * SZ_WGU);
        gemm_tile<2, 0>(c, 1024,
            [&](int i) { int p = mt * 128 + i; if (p >= n_e) p = n_e - 1; return XN + (size_t)(le[p] >> 1) * D; },
            [&](int i) { return W + (size_t)(nt * 256 + i) * D; }, NoHook(),
            [&](f32x4 (&acc)[4][4], int wr, int wc, int fr, int fq) {
#pragma unroll
                for (int np = 0; np < 2; ++np) {
                    const int hc = (nt * 256 + wc + np * 32) / 2 + fq * 4;
#pragma unroll
                    for (int m = 0; m < 4; ++m) {
                        const int p = mt * 128 + wr + m * 16 + fr;
                        const f32x4 g = acc[m][np * 2], uu = acc[m][np * 2 + 1];
                        *(u32x2*)(HM + ((size_t)mtg * 128 + wr + m * 16 + fr) * 512 + hc) = pack4(siluf_(g[0]) * uu[0], siluf_(g[1]) * uu[1], siluf_(g[2]) * uu[2], siluf_(g[3]) * uu[3]);
                        (void)p;
                    }
                }
            });
    }
}
DI void phase_moe2(const Ctx& c, int l) {
    unsigned char* ws = c.ws;
    int* tiles = (int*)(c.smem + 120 * 1024); int* cnts = tiles + 40;
    moe_prefix(c, l, tiles, cnts);
    const bf16_t* HM = (const bf16_t*)(ws + WS_GT + GT_HM); const int* list = (const int*)(ws + WS_GT + GT_LIST); const float* lw = (const float*)(ws + WS_GT + GT_LW);
    bf16_t* Y2 = (bf16_t*)(ws + WS_P);
    const int nt_total = tiles[32];
    for (int u = blockIdx.x; u < nt_total * 4; u += gridDim.x) {
        const int mtg = u >> 2, nt = u & 3;
        int e = 0;
        for (int k = 1; k < 32; ++k) if (tiles[k] <= mtg) e = k;
        const int mt = mtg - tiles[e], n_e = cnts[e];
        const int* le = list + (size_t)e * MOE_CAP; const float* lwe = lw + (size_t)e * MOE_CAP;
        const bf16_t* W = (const bf16_t*)(ws + WS_EXPW + 32 * SZ_WGU + (size_t)e * SZ_WD);
        gemm_tile<2, 0>(c, 512,
            [&](int i) { return HM + ((size_t)mtg * 128 + i) * 512; },
            [&](int i) { return W + (size_t)(nt * 256 + i) * 512; }, NoHook(),
            [&](f32x4 (&acc)[4][4], int wr, int wc, int fr, int fq) {
                int ent4[4]; float wt4[4];
#pragma unroll
                for (int m = 0; m < 4; ++m) { const int p = mt * 128 + wr + m * 16 + fr; const int pc = p < n_e ? p : n_e - 1; ent4[m] = le[pc]; wt4[m] = lwe[pc]; }
#pragma unroll
                for (int m = 0; m < 4; ++m) {
                    const int p = mt * 128 + wr + m * 16 + fr;
                    if (p < n_e) {
                        const int ent = ent4[m]; const float wt = wt4[m];
                        bf16_t* yrow = Y2 + ((size_t)(ent & 1) * NZ + (ent >> 1)) * D + nt * 256 + wc + fq * 4;
#pragma unroll
                        for (int n = 0; n < 4; ++n) *(u32x2*)(yrow + n * 16) = pack4(wt * acc[m][n][0], wt * acc[m][n][1], wt * acc[m][n][2], wt * acc[m][n][3]);
                    }
                }
            });
    }
}

constexpr int LDS_BYTES = 150 * 1024 + 256;
static_assert(SQ_END <= LDS_BYTES - 256, "RWKV sequential stages must fit the LDS allocation");
constexpr int STEPS_PER_LAYER = 12, N_STEPS = 2 + NL * STEPS_PER_LAYER;
#ifndef FUSED
#define FUSED 1
#endif

DI const void* launder_ptr(const void* p) {
    const unsigned long long v = (unsigned long long)p;
    unsigned lo = __builtin_amdgcn_readfirstlane((unsigned)v), hi = __builtin_amdgcn_readfirstlane((unsigned)(v >> 32));
    asm volatile("" : "+s"(lo), "+s"(hi) :: "memory");
    return (const void*)(((unsigned long long)hi << 32) | lo);
}
template <int KIND> DI void run_step(const Ctx& c0, int l) {
#ifdef PHM
    if (!((PHM >> KIND) & 1)) return;
#endif
    Ctx c = c0;
    { int z = 0; asm volatile("" : "+s"(z) :: "memory"); c.in = c0.in + z; c.ws = c0.ws + z; c.out = c0.out + z; }
    { int t = c0.tid; asm volatile("" : "+v"(t)); c.tid = t; c.lane = t & 63; c.wave = __builtin_amdgcn_readfirstlane(t >> 6); }
    if (KIND == 0) phase_prologue(c);
    if (KIND == 1) phase_norm1(c, l);
    if (KIND == 2) phase_inproj(c, l);
    if (KIND == 3) { phase_prep(c, l); for (int u = blockIdx.x; u < 2 * S5N * 4; u += gridDim.x) phase_s5_final_unit<true>(c, l, u); }
    if (KIND == 4) { phase_small_gemms(c, l); phase_s5_carry(c, l); }
    if (KIND == 5) { phase_attention(c, l); phase_rwkv_chunks(c, l); }
    if (KIND == 6) phase_mixers2(c, l);
    if (KIND == 7) phase_post(c, l);
    if (KIND == 8) phase_merge1(c, l, 0);
    if (KIND == 9) { if (!merge_split(l)) phase_merge2(c, l, 0); else if (blockIdx.x < 16) phase_merge1(c, l, 1); else phase_merge2(c, l, 1); }
    if (KIND == 14) { if (merge_split(l)) phase_merge2(c, l, 2); }
    if (KIND == 10) phase_norm2_route(c, l);
    if (KIND == 11) phase_moe1(c, l);
    if (KIND == 12) phase_moe2(c, l);
    if (KIND == 13) phase_final(c);
}

#if !FUSED
template <int KIND> __global__ void __launch_bounds__(NTHR, 2) k_step(Args a) {
    extern __shared__ __attribute__((aligned(16))) unsigned char lds[];
    Ctx c; c.in = a.in; c.out = a.out; c.ws = a.ws; c.smem = lds; c.tid = threadIdx.x; c.lane = threadIdx.x & 63; c.wave = __builtin_amdgcn_readfirstlane(threadIdx.x >> 6);
    run_step<KIND>(c, a.s_lo);
}
template <int KIND> static void launch_step(const Args& a, int grid, hipStream_t stream) {
    static bool attr = false;
    if (!attr) { (void)hipFuncSetAttribute((const void*)k_step<KIND>, hipFuncAttributeMaxDynamicSharedMemorySize, LDS_BYTES); attr = true; }
    hipLaunchKernelGGL(k_step<KIND>, dim3(grid), dim3(NTHR), LDS_BYTES, stream, a);
}
#else
__global__ void __launch_bounds__(NTHR, 2) fwd_kernel(Args a) {
    extern __shared__ __attribute__((aligned(16))) unsigned char lds[];
    Ctx c; c.in = a.in; c.out = a.out; c.ws = a.ws; c.smem = lds; c.tid = threadIdx.x; c.lane = threadIdx.x & 63; c.wave = __builtin_amdgcn_readfirstlane(threadIdx.x >> 6);
    volatile LAS unsigned* xbw = (volatile LAS unsigned*)(lds + LDS_BYTES - 16);
    for (int i = threadIdx.x; i < LDS_BYTES / 16; i += NTHR) ((uint4*)lds)[i] = make_uint4(0u, 0u, 0u, 0u);
    __syncthreads();
    if (threadIdx.x == 0) { xbw[0] = 0u; xbw[1] = 0u; }
    __syncthreads();
    XcdBarrier bar = xcd_barrier_post((unsigned*)(a.ws + WS_CTL) + CW_BAR, xbw);
#ifndef REP_MASK
#define REP_MASK 0
#endif
#define GBAR() do { XcdBarrier bb = bar; int zz = 0; asm volatile("" : "+s"(zz) :: "memory"); bb.bar = bar.bar + zz; xcd_barrier(bb); } while (0)
#define STEP(K, L) do { run_step<K>(c, L); GBAR(); if ((REP_MASK >> K) & 1) { run_step<K>(c, L); GBAR(); } } while (0)
    STEP(0, 0);
    for (int l = 0; l < NL; ++l) {
        STEP(1, l); STEP(2, l); STEP(3, l); STEP(4, l); STEP(5, l); STEP(6, l); STEP(7, l); STEP(8, l); STEP(9, l); if (l == 0 && NL > 1) STEP(14, l); STEP(10, l); STEP(11, l); STEP(12, l);
    }
#undef STEP
    run_step<13>(c, 0);
}
#endif

extern "C" void kernel_launch(void* const* d_in, const int* in_sizes, int n_in, void* d_out, int out_size, void* d_ws, size_t ws_size, hipStream_t stream) {
    static int grid = 0;
    if (grid == 0) {
        if (n_in != 49 || out_size != NB * SEQ * D || ws_size < WS_END) { fprintf(stderr, "kernel_launch: unexpected problem (n_in %d out %d ws %zu need %zu)\n", n_in, out_size, ws_size, (size_t)WS_END); grid = -1; return; }
        int dev = 0, cus = 0;
        if (hipGetDevice(&dev) != hipSuccess || hipDeviceGetAttribute(&cus, hipDeviceAttributeMultiprocessorCount, dev) != hipSuccess) { grid = -1; return; }
#if FUSED
        int per_cu = 0;
        if (hipFuncSetAttribute((const void*)fwd_kernel, hipFuncAttributeMaxDynamicSharedMemorySize, LDS_BYTES) != hipSuccess) { fprintf(stderr, "kernel_launch: hipFuncSetAttribute failed\n"); grid = -1; return; }
        if (hipOccupancyMaxActiveBlocksPerMultiprocessor(&per_cu, (const void*)fwd_kernel, NTHR, LDS_BYTES) != hipSuccess || per_cu < 1) { fprintf(stderr, "kernel_launch: occupancy query says %d\n", per_cu); }
        (void)hipGetLastError();
#endif
        grid = cus;
    }
    if (grid < 0) return;
    (void)hipMemsetAsync((char*)d_ws + WS_CTL, 0, CTL_BYTES, stream);
    Args a{};
    for (int i = 0; i < 49; ++i) a.in[i] = (const float*)d_in[i];
    a.out = (float*)d_out; a.ws = (unsigned char*)d_ws;
#if !FUSED
    a.s_lo = 0; a.s_hi = 0; launch_step<0>(a, grid, stream);
    for (int l = 0; l < NL; ++l) {
        a.s_lo = l;
        launch_step<1>(a, grid, stream); launch_step<2>(a, grid, stream); launch_step<3>(a, grid, stream); launch_step<4>(a, grid, stream);
        launch_step<5>(a, grid, stream); launch_step<6>(a, grid, stream); launch_step<7>(a, grid, stream); launch_step<8>(a, grid, stream);
        launch_step<9>(a, grid, stream); if (l == 0 && NL > 1) launch_step<14>(a, grid, stream); launch_step<10>(a, grid, stream); launch_step<11>(a, grid, stream); launch_step<12>(a, grid, stream);
    }
    a.s_lo = 0; launch_step<13>(a, grid, stream);
#else
    a.s_lo = 0; a.s_hi = N_STEPS; hipLaunchKernelGGL(fwd_kernel, dim3(grid), dim3(NTHR), LDS_BYTES, stream, a);
#endif
}
```

```cpp
#include <hip/hip_runtime.h>
#include <stdint.h>
#include <stdio.h>

#define DI __device__ __forceinline__
#define LAS __attribute__((address_space(3)))
typedef unsigned short bf16_t;
typedef short bf16x8 __attribute__((ext_vector_type(8)));
typedef short s16x4 __attribute__((ext_vector_type(4)));
typedef float f32x4 __attribute__((ext_vector_type(4)));
typedef float f32x16 __attribute__((ext_vector_type(16)));
typedef float f32x2 __attribute__((ext_vector_type(2)));
typedef __bf16 bf16x2v __attribute__((ext_vector_type(2)));
typedef unsigned u32x4 __attribute__((ext_vector_type(4)));
typedef unsigned u32x2 __attribute__((ext_vector_type(2)));

constexpr int D = 1024, NB = 2, SEQ = 8192, CTX = 256, TZ = 8448, NZ = 16896, NL = 2;
constexpr int NIN = 6560, NINP = 6656;
constexpr int NTHR = 512;
constexpr float LOG2E = 1.4426950408889634f;

#define XB_TMO      128
#define XB_XCNT(j)  (256  + 64 * (j))
#define XB_XSUB(j)  (1280 + 64 * (j))
#define XB_XGEN(j)  (2304 + 64 * (j))
#define XB_TOP      3328
#define XB_TOPGEN   3392
#define XCD_BAR_WORDS 3456
#define XB_SPIN_CAP (1u << 18)

__device__ __forceinline__ unsigned xb_ld(unsigned* p)              { return __hip_atomic_load(p, __ATOMIC_RELAXED, __HIP_MEMORY_SCOPE_AGENT); }
__device__ __forceinline__ unsigned xb_add(unsigned* p, unsigned v) { return __hip_atomic_fetch_add(p, v, __ATOMIC_RELAXED, __HIP_MEMORY_SCOPE_AGENT); }
__device__ __forceinline__ unsigned xb_xcc_id() { return (unsigned)__builtin_amdgcn_s_getreg((3 << 11) | 20) & 0xFu; }
#define XB_SPIN(cond, bar) do { unsigned _sp = 0; while (cond) { __builtin_amdgcn_s_sleep(1); \
    if ((++_sp & 255u) == 0u) { if (xb_ld(&(bar)[XB_TMO])) break; if (_sp > XB_SPIN_CAP) { atomicAdd(&(bar)[XB_TMO], 1u); break; } } } } while (0)

struct XcdBarrier { unsigned* bar; unsigned x; volatile LAS unsigned* st; };

__device__ __forceinline__ XcdBarrier xcd_barrier_post(unsigned* bar, volatile LAS unsigned* st) {
    XcdBarrier b; b.bar = bar; b.x = xb_xcc_id(); b.st = st;
    if (threadIdx.x == 0) (void)xb_add(&bar[XB_XCNT(b.x)], 1u);
    return b;
}
__device__ __forceinline__ void xcd_barrier_complete(unsigned* bar, unsigned x, unsigned& nloc, unsigned& nx) {
    const unsigned G = gridDim.x * gridDim.y * gridDim.z;
    unsigned sum, cnt, mine, sp = 0u;
    for (;;) {
        sum = 0u; cnt = 0u; mine = 0u;
#pragma unroll
        for (unsigned j = 0; j < 16; ++j) { const unsigned c = xb_ld(&bar[XB_XCNT(j)]); sum += c; cnt += (c > 0u) ? 1u : 0u; mine = (j == x) ? c : mine; }
        if (sum == G) break;
        __builtin_amdgcn_s_sleep(1);
        if ((++sp & 255u) == 0u) { if (xb_ld(&bar[XB_TMO])) break; if (sp > XB_SPIN_CAP) { atomicAdd(&bar[XB_TMO], 1u); break; } }
    }
    nloc = mine > 0u ? mine : 1u; nx = cnt > 0u ? cnt : 1u;
}
__device__ __forceinline__ void xcd_barrier(const XcdBarrier& b) {
    asm volatile("s_waitcnt vmcnt(0)" ::: "memory");
    __syncthreads();
    if (threadIdx.x == 0) {
        unsigned* bar = b.bar;
        __builtin_amdgcn_s_waitcnt(0);
        unsigned nloc = b.st[0], nx = b.st[1];
        if (nloc == 0u) { xcd_barrier_complete(bar, b.x, nloc, nx); b.st[0] = nloc; b.st[1] = nx; }
        const unsigned old = xb_add(&bar[XB_XSUB(b.x)], 1u);
        const unsigned gen = old / nloc;
        if (old + 1u == (gen + 1u) * nloc) {
            __builtin_amdgcn_fence(__ATOMIC_RELEASE, "agent");
            asm volatile("s_waitcnt vmcnt(0)" ::: "memory");
            const unsigned og = xb_add(&bar[XB_TOP], 1u);
            const unsigned tg = og / nx;
            if (og + 1u == (tg + 1u) * nx) xb_add(&bar[XB_TOPGEN], 1u);
            else XB_SPIN(xb_ld(&bar[XB_TOPGEN]) == tg, bar);
            __builtin_amdgcn_fence(__ATOMIC_ACQUIRE, "agent");
            xb_add(&bar[XB_XGEN(b.x)], 1u);
            asm volatile("s_waitcnt vmcnt(0)" ::: "memory");
        } else {
            XB_SPIN(xb_ld(&bar[XB_XGEN(b.x)]) == gen, bar);
            __builtin_amdgcn_fence(__ATOMIC_ACQUIRE, "agent");
            asm volatile("s_waitcnt vmcnt(0)" ::: "memory");
        }
    }
    __syncthreads();
}

DI float bf2f(bf16_t v) { return __uint_as_float((unsigned)v << 16); }
DI unsigned pack2(float a, float b) { f32x2 v = {a, b}; bf16x2v r = __builtin_convertvector(v, bf16x2v); return __builtin_bit_cast(unsigned, r); }
DI bf16_t f2bf(float a) { return (bf16_t)(pack2(a, 0.f) & 0xffffu); }
DI float lo2f(unsigned u) { return __uint_as_float(u << 16); }
DI float hi2f(unsigned u) { return __uint_as_float(u & 0xffff0000u); }
DI float wave_sum(float v) {
#pragma unroll
    for (int m = 32; m >= 1; m >>= 1) v += __shfl_xor(v, m, 64);
    return v;
}
DI float sum16(float v) {
#pragma unroll
    for (int m = 8; m >= 1; m >>= 1) v += __shfl_xor(v, m, 64);
    return v;
}
DI float sigmoidf_(float x) { return __builtin_amdgcn_rcpf(1.f + __expf(-x)); }
DI float siluf_(float x) { return x * __builtin_amdgcn_rcpf(1.f + __expf(-x)); }
DI float gelu_tanh(float x) { const float u = 0.7978845608028654f * (x + 0.044715f * x * x * x); return x * __builtin_amdgcn_rcpf(1.f + __expf(-2.f * u)); }
DI float tanhf_(float x) { return 2.f * __builtin_amdgcn_rcpf(1.f + __expf(-2.f * x)) - 1.f; }
DI void unpack4(u32x2 u, float (&f)[4]) { f[0] = lo2f(u.x); f[1] = hi2f(u.x); f[2] = lo2f(u.y); f[3] = hi2f(u.y); }
DI u32x2 pack4(float a, float b, float c, float d) { u32x2 r; r.x = pack2(a, b); r.y = pack2(c, d); return r; }

constexpr size_t algn(size_t x) { return (x + 255) & ~(size_t)255; }
constexpr size_t WS_CTL   = 0;
constexpr size_t CTL_BYTES = 64 * 1024;
constexpr size_t WS_H     = WS_CTL + CTL_BYTES;
constexpr size_t WS_WSM   = WS_H + (size_t)NZ * D * 4;
constexpr size_t SZ_WINT = (size_t)NINP * D * 2, SZ_WUQT = 384 * 256 * 2, SZ_WUKVT = 512 * 128 * 2, SZ_W2T = 512 * 64 * 2, SZ_A2T = 512 * 64 * 2,
                 SZ_G2T = 256 * 128 * 2, SZ_GLUT = 256 * 256 * 2, SZ_WBT = (size_t)D * D * 2, SZ_WOUTT = (size_t)D * D * 2;
constexpr size_t OFF_WINT = 0, OFF_WUQT = OFF_WINT + NL * SZ_WINT, OFF_WUKVT = OFF_WUQT + NL * SZ_WUQT, OFF_W2T = OFF_WUKVT + NL * SZ_WUKVT,
                 OFF_A2T = OFF_W2T + NL * SZ_W2T, OFF_G2T = OFF_A2T + NL * SZ_A2T, OFF_GLUT = OFF_G2T + NL * SZ_G2T, OFF_WBT = OFF_GLUT + NL * SZ_GLUT,
                 OFF_WOUTT = OFF_WBT + NL * SZ_WBT, OFF_MODV = OFF_WOUTT + NL * SZ_WOUTT,
                 OFF_ROPE = OFF_MODV + (size_t)NL * 3 * 6144 * 4,
                 OFF_S5T = OFF_ROPE + (size_t)SEQ * 16 * 2 * 4,
                 OFF_RWT = OFF_S5T + (size_t)NL * 2 * 16 * 64 * 36 * 4,
                 OFF_LAM = OFF_RWT + (size_t)NL * 36 * 1024 * 4,
                 OFF_S5E = OFF_LAM + 256,
                 OFF_S5C = OFF_S5E,
                 WSM_BYTES = algn(OFF_S5E + (size_t)2 * 2 * 16 * 132 * 64 * 2 * 4);
constexpr size_t WS_EXPW  = WS_WSM + WSM_BYTES;
constexpr size_t SZ_WGU = (size_t)1024 * 1024 * 2, SZ_WD = (size_t)1024 * 512 * 2;
constexpr size_t EXPW_BYTES = 32 * (SZ_WGU + SZ_WD);
constexpr size_t SZ_QM = (size_t)NB * 4 * TZ * 96 * 2, SZ_VMT = (size_t)NB * 4 * 64 * TZ * 2, SZ_QD = (size_t)NB * 4 * TZ * 64 * 2, SZ_R256 = (size_t)NZ * 256 * 2;
constexpr size_t MX_QM = 0, MX_KM = MX_QM + SZ_QM, MX_VMT = MX_KM + SZ_QM, MX_QD = MX_VMT + SZ_VMT, MX_KD = MX_QD + SZ_QD, MX_VDT = MX_KD + SZ_QD,
                 MX_RB = MX_VDT + SZ_VMT, MX_KB = MX_RB + SZ_R256, MX_VB = MX_KB + SZ_R256, MX_KKB = MX_VB + SZ_R256, MX_END = MX_KKB + SZ_R256;
static_assert(MX_END <= EXPW_BYTES, "mixer operands must fit the expert-weight region");
constexpr size_t WS_BUFA  = WS_EXPW + EXPW_BYTES;
constexpr size_t WS_BUFB  = WS_BUFA + (size_t)NZ * D * 2;
constexpr size_t WS_P     = WS_BUFB + (size_t)NZ * D * 2;
constexpr size_t P_PM = 0, P_PS = P_PM + (size_t)NZ * 416 * 2, P_PR = P_PS + (size_t)NZ * 256 * 2, P_PD = P_PR + (size_t)NZ * 1024 * 2, P_BYTES = P_PD + (size_t)NZ * 768 * 2;
static_assert((size_t)6 * SZ_R256 <= (size_t)NZ * (1024 + 768) * 2, "scan operands must fit PR|PD");
static_assert((size_t)2 * NZ * D * 2 <= P_BYTES, "the MoE outputs (2 x bf16 [NZ][D]) must fit the P region");
constexpr size_t WS_GT    = WS_P + P_BYTES;
constexpr size_t GT_BYTES = (size_t)NZ * 4096 * 2;
constexpr int MOE_CAP = 33792;
constexpr size_t GT_HM = 0, GT_LIST = GT_HM + (size_t)(33792 + 32 * 128) * 512 * 2, GT_LW = GT_LIST + (size_t)32 * MOE_CAP * 4, GT_END = GT_LW + (size_t)32 * MOE_CAP * 4;
static_assert(GT_END <= GT_BYTES, "MoE scratch must fit the gate region");
constexpr size_t WS_MISC  = WS_GT + GT_BYTES;
constexpr size_t MS_CQN = 0, MS_TW = MS_CQN + (size_t)NZ * 384 * 2, MS_AL = MS_TW + (size_t)NZ * 64 * 2, MS_SG = MS_AL + (size_t)NZ * 64 * 2,
                 MS_GG = MS_SG + (size_t)NZ * 128 * 2, MS_ZG = MS_GG + SZ_R256, MS_END = MS_ZG + SZ_R256;
constexpr size_t WS_RW    = WS_MISC + MS_END;
constexpr int RC = 64, RNC = TZ / RC;
constexpr size_t SZ_RWM = (size_t)16 * RNC * 4096 * 2;
constexpr size_t RW_M3 = 0, RW_M2 = SZ_RWM, RW_Z5 = 2 * SZ_RWM, RW_P63 = 3 * SZ_RWM, RW_END = RW_P63 + (size_t)16 * RNC * 64 * 4;
constexpr size_t WS_END   = WS_RW + RW_END;

constexpr int CW_BAR = 0;
constexpr int CW_CNT = 4096;

struct Args { const float* in[49]; float* out; unsigned char* ws; int s_lo, s_hi; };

struct Ctx {
    const float* const* in; float* out; unsigned char* ws; unsigned char* smem; int tid, lane, wave;
};

template <int WM> struct GCfg { static constexpr int WN = 8 / WM, BM = 64 * WM, BN = 64 * WN, ABYTES = BM * 128, BBYTES = BN * 128, STAGE = ABYTES + BBYTES; };

template <int WM, int SEGK, class ARow, class BRow, class Hook, class Epi>
DI void gemm_tile(const Ctx& c, int K, ARow arow, BRow brow, Hook hook, Epi epi) {
    typedef GCfg<WM> G;
    const int tid = c.tid, lane = c.lane, wave = c.wave;
    const int wm = wave / G::WN, wn = wave % G::WN, fr = lane & 15, fq = lane >> 4;
    unsigned char* smem = c.smem;
    constexpr int NA = G::BM / 64, NBq = G::BN / 64;
    const int r0 = tid >> 3, coff = ((tid & 7) ^ (r0 & 7)) * 8;
    auto stage = [&](int kt, int buf) {
        unsigned char* sa = smem + buf * G::STAGE; unsigned char* sb = sa + G::ABYTES;
#pragma unroll
        for (int i = 0; i < NA; ++i) __builtin_amdgcn_global_load_lds((const unsigned*)(arow(r0 + 64 * i) + coff + kt * 64), (unsigned*)(sa + (tid + i * NTHR) * 16), 16, 0, 0);
#pragma unroll
        for (int i = 0; i < NBq; ++i) __builtin_amdgcn_global_load_lds((const unsigned*)(brow(r0 + 64 * i) + coff + kt * 64), (unsigned*)(sb + (tid + i * NTHR) * 16), 16, 0, 0);
    };
    f32x4 acc[4][4];
#pragma unroll
    for (int m = 0; m < 4; ++m)
#pragma unroll
        for (int n = 0; n < 4; ++n) acc[m][n] = (f32x4){0.f, 0.f, 0.f, 0.f};
    const int T = K / 64;
    __syncthreads();
    stage(0, 0);
    for (int t = 0; t < T; ++t) {
        asm volatile("s_waitcnt vmcnt(0)" ::: "memory");
        __syncthreads();
        if (t + 1 < T) stage(t + 1, (t + 1) & 1);
        const unsigned char* sa = smem + (t & 1) * G::STAGE; const unsigned char* sb = sa + G::ABYTES;
#pragma unroll
        for (int ks = 0; ks < 2; ++ks) {
            bf16x8 af[4], bfr[4];
            const int sl = ((ks * 4 + fq) ^ (fr & 7)) * 16;
#pragma unroll
            for (int m = 0; m < 4; ++m) af[m] = *(const bf16x8*)(sa + (wm * 64 + m * 16 + fr) * 128 + sl);
#pragma unroll
            for (int n = 0; n < 4; ++n) bfr[n] = *(const bf16x8*)(sb + (wn * 64 + n * 16 + fr) * 128 + sl);
#pragma unroll
            for (int m = 0; m < 4; ++m)
#pragma unroll
                for (int n = 0; n < 4; ++n) acc[m][n] = __builtin_amdgcn_mfma_f32_16x16x32_bf16(bfr[n], af[m], acc[m][n], 0, 0, 0);
        }
        if (SEGK > 0) { if (((t + 1) * 64) % (SEGK > 0 ? SEGK : 64) == 0) hook(acc, ((t + 1) * 64) / (SEGK > 0 ? SEGK : 64) - 1, wm * 64, wn * 64, fr, fq); }
    }
    epi(acc, wm * 64, wn * 64, fr, fq);
}
struct NoHook { DI void operator()(f32x4 (&)[4][4], int, int, int, int, int) const {} };

#ifndef INPROJ_WGM
#define INPROJ_WGM 4
#define MERGE2_WGM 8
#endif
namespace pg8 {
#define PG8_LAS __attribute__((address_space(3)))
typedef unsigned short bf16_t;
typedef short bf16x8 __attribute__((ext_vector_type(8)));
typedef float f32x4 __attribute__((ext_vector_type(4)));
constexpr int BM = 256, BK = 64, HALF = 128, HTB = HALF * BK * 2  , STAGE_BYTES = 8 * HTB, NXCD = 8, WGM = 4;

__host__ __device__ __forceinline__ int lds_byte(int r, int c) { const int st = (r >> 4) * 2 + (c >> 5), rr = r & 15, cc = c & 31, ob = rr * 64 + cc * 2; return st * 1024 + (ob ^ (((ob >> 9) & 1) << 5)); }
__host__ __device__ __forceinline__ void stage_rc(int b, int& R, int& C) { const int st = b / 1024, sb = b % 1024, swz = sb ^ (((sb >> 9) & 1) << 5); R = (st >> 1) * 16 + swz / 64; C = (st & 1) * 32 + (swz % 64) / 2; }
__host__ __device__ __forceinline__ int perm32(int rho) { const int n = rho >> 4, i = rho & 15; return 8 * (i >> 2) + 4 * n + (i & 3); }

struct Unit { int pm, pn; };
struct Gemm { const bf16_t* A; const bf16_t* Bt; int M, N, K, lda, ldb; };

struct StaticOrder {
    int nM, nN, nwg, G, c, wgm;
    __host__ __device__ void init(int M, int N, int G_, int c_, int wgm_ = WGM) { nM = M / BM; nN = N / BM; nwg = nM * nN; G = G_; c = c_; wgm = wgm_; }
    __host__ __device__ bool next(int i, Unit& u) const {
        const long L = (long)i * G + c; if (L >= nwg) return false;
        int wgid = (int)L; { const int q = nwg / NXCD, r = nwg % NXCD, xcd = wgid % NXCD, off = wgid / NXCD; wgid = (xcd < r ? xcd * (q + 1) : r * (q + 1) + (xcd - r) * q) + off; }
        const int nig = wgm * nN, gid = wgid / nig, fm = gid * wgm, gsz = (nM - fm) < wgm ? (nM - fm) : wgm;
        u.pm = fm + ((wgid % nig) % gsz); u.pn = (wgid % nig) / gsz; return true;
    }
    __device__ __forceinline__ void a_ready(const Unit&) const {}
    __device__ __forceinline__ void done(const Unit&) const {}
};
template <class Epi, class Sched, bool STAMP = false>
__device__ __forceinline__ void gemm_phase(PG8_LAS unsigned char* lds, const Gemm g, const Sched& S, const Epi& E, unsigned long long* stamps, int tid_in) {
    const int tid = tid_in, wid = __builtin_amdgcn_readfirstlane(tid >> 6), lane = tid & 63, wr = wid >> 2, wc = wid & 3, fr = lane & 15, fq = lane >> 4;
    const int K = g.K, nt = K / BK;
    int ts_lo = 0, ts_hi = 0, nts = 0; const unsigned long long rt_entry = STAMP ? (unsigned long long)wall_clock64() : 0ull;
#define PG8_STAMP() do { if (STAMP && wid == 0 && nts < 64) { const unsigned long long _c = (unsigned long long)clock64(); \
        ts_lo = (lane == nts) ? (int)(unsigned)_c : ts_lo; ts_hi = (lane == nts) ? (int)(unsigned)(_c >> 32) : ts_hi; ++nts; } } while (0)
    PG8_STAMP();
    unsigned voffA[2], voffB[2];
#pragma unroll
    for (int i = 0; i < 2; ++i) { int R, C; stage_rc(tid * 16 + i * 8192, R, C); const int Rb = Epi::PERM ? ((R & ~31) + perm32(R & 31)) : R;
        voffA[i] = (unsigned)(R * g.lda + C) * 2u; voffB[i] = (unsigned)(Rb * g.ldb + C) * 2u; }
    const size_t kstep = (size_t)(BK * 2);
    const size_t hstepA = (size_t)HALF * g.lda * 2, hstepB = (size_t)HALF * g.ldb * 2;
    const size_t tstepA = 2 * hstepA, tstepB = 2 * hstepB;
    const unsigned ldsw = (unsigned)wid * 1024u;
    const int aoff = lds_byte(wr * 64 + fr, fq * 8), boff = lds_byte(wc * 32 + fr, fq * 8);
#define PG8_SA(b, h) (((b) * 2 + (h)) * HTB)
#define PG8_SB(b, h) ((4 + (b) * 2 + (h)) * HTB)
#define PG8_STAGE(bufoff, gbase, voff) do { _Pragma("unroll") for (int _i = 0; _i < 2; ++_i) \
        __builtin_amdgcn_global_load_lds((const unsigned*)((const char*)(gbase) + (voff)[_i]), (PG8_LAS unsigned*)(lds + (bufoff) + ldsw + _i * 8192), 16, 0, 0); } while (0)
#define PG8_LDA(dst, b, h) do { _Pragma("unroll") for (int m = 0; m < 4; ++m) _Pragma("unroll") for (int k = 0; k < 2; ++k) dst[m][k] = *(const PG8_LAS bf16x8*)(lds + PG8_SA(b, h) + aoff + m * 2048 + k * 1024); } while (0)
#define PG8_LDB(dst, b, h) do { _Pragma("unroll") for (int n = 0; n < 2; ++n) _Pragma("unroll") for (int k = 0; k < 2; ++k) dst[n][k] = *(const PG8_LAS bf16x8*)(lds + PG8_SB(b, h) + boff + n * 2048 + k * 1024); } while (0)
#define PG8_MMA(ai, bj, At, Bt) do { __builtin_amdgcn_s_setprio(1); _Pragma("unroll") for (int m = 0; m < 4; ++m) _Pragma("unroll") for (int n = 0; n < 2; ++n) _Pragma("unroll") for (int k = 0; k < 2; ++k) \
        acc[ai][bj][m][n] = __builtin_amdgcn_mfma_f32_16x16x32_bf16(Bt[n][k], At[m][k], acc[ai][bj][m][n], 0, 0, 0); __builtin_amdgcn_s_setprio(0); } while (0)
#define PG8_WAIT_V(n) asm volatile("s_waitcnt vmcnt(" #n ")" ::: "memory")
#define PG8_WAIT_L(n) asm volatile("s_waitcnt lgkmcnt(" #n ")" ::: "memory")
#define PG8_BAR __builtin_amdgcn_s_barrier()
#define PG8_SCHED __builtin_amdgcn_sched_barrier(0)
    Unit cur, nxt; int ui = 0;
    if (!S.next(0, cur)) return;
    f32x4 acc[2][2][4][2];
#pragma unroll
    for (int a = 0; a < 2; ++a)
#pragma unroll
        for (int b = 0; b < 2; ++b)
#pragma unroll
            for (int m = 0; m < 4; ++m)
#pragma unroll
                for (int n = 0; n < 2; ++n) acc[a][b][m][n] = (f32x4){0.f, 0.f, 0.f, 0.f};
    bf16x8 At[4][2], B0[2][2], B1[2][2];
    const char* cA = (const char*)g.A + (size_t)cur.pm * tstepA; const char* cB = (const char*)g.Bt + (size_t)cur.pn * tstepB;
    S.a_ready(cur);
    PG8_STAGE(PG8_SB(0, 0), cB, voffB); PG8_STAGE(PG8_SA(0, 0), cA, voffA); PG8_STAGE(PG8_SB(0, 1), cB + hstepB, voffB); PG8_STAGE(PG8_SA(0, 1), cA + hstepA, voffA);
    if (wr == 1) PG8_BAR;
    PG8_WAIT_V(4); PG8_BAR;
    PG8_STAGE(PG8_SB(1, 0), cB + kstep, voffB); PG8_STAGE(PG8_SA(1, 0), cA + kstep, voffA); PG8_STAGE(PG8_SB(1, 1), cB + hstepB + kstep, voffB);
    PG8_WAIT_V(6); PG8_BAR;
    PG8_STAMP();
    for (;;) {
        const bool has_next = S.next(ui + 1, nxt);
        const char* nA = has_next ? (const char*)g.A + (size_t)nxt.pm * tstepA : cA; const char* nB = has_next ? (const char*)g.Bt + (size_t)nxt.pn * tstepB : cB;
        for (int t = 0; t < nt; t += 2) {
            const bool last = (t == nt - 2);
            const char* a1 = cA + (size_t)(t + 1) * kstep;
            const char* a2 = last ? nA : cA + (size_t)(t + 2) * kstep; const char* b2 = last ? nB : cB + (size_t)(t + 2) * kstep;
            const char* a3 = a2 + kstep; const char* b3 = b2 + kstep;
            if (last && has_next) S.a_ready(nxt);
            PG8_LDB(B0, 0, 0); PG8_SCHED; PG8_LDA(At, 0, 0); PG8_STAGE(PG8_SA(1, 1), a1 + hstepA, voffA);
            PG8_WAIT_L(8); PG8_BAR; PG8_WAIT_L(0); PG8_MMA(0, 0, At, B0); PG8_BAR; PG8_SCHED;
            PG8_LDB(B1, 0, 1); PG8_STAGE(PG8_SB(0, 0), b2, voffB);
            PG8_BAR; PG8_WAIT_L(0); PG8_MMA(0, 1, At, B1); PG8_BAR;
            PG8_LDA(At, 0, 1); PG8_STAGE(PG8_SA(0, 0), a2, voffA);
            PG8_BAR; PG8_WAIT_L(0); PG8_MMA(1, 0, At, B0); PG8_BAR; PG8_SCHED;
            PG8_STAGE(PG8_SB(0, 1), b2 + hstepB, voffB);
            PG8_WAIT_V(6); PG8_BAR; PG8_MMA(1, 1, At, B1); PG8_BAR;
            PG8_LDB(B0, 1, 0); PG8_SCHED; PG8_LDA(At, 1, 0); PG8_STAGE(PG8_SA(0, 1), a2 + hstepA, voffA);
            PG8_WAIT_L(8); PG8_BAR; PG8_WAIT_L(0); PG8_MMA(0, 0, At, B0); PG8_BAR; PG8_SCHED;
            PG8_LDB(B1, 1, 1); PG8_STAGE(PG8_SB(1, 0), b3, voffB);
            PG8_BAR; PG8_WAIT_L(0); PG8_MMA(0, 1, At, B1); PG8_BAR;
            PG8_LDA(At, 1, 1); PG8_STAGE(PG8_SA(1, 0), a3, voffA);
            PG8_BAR; PG8_WAIT_L(0); PG8_MMA(1, 0, At, B0); PG8_BAR; PG8_SCHED;
            PG8_STAGE(PG8_SB(1, 1), b3 + hstepB, voffB);
            PG8_WAIT_V(6); PG8_BAR; PG8_MMA(1, 1, At, B1); PG8_BAR;
        }
        PG8_STAMP();
        if constexpr (!Epi::AFTER_DRAIN) { E(acc, cur, wr, wc, fr, fq); S.done(cur); }
        PG8_STAMP();
        if (!has_next) break;
#pragma unroll
        for (int a = 0; a < 2; ++a)
#pragma unroll
            for (int b = 0; b < 2; ++b)
#pragma unroll
                for (int m = 0; m < 4; ++m)
#pragma unroll
                    for (int n = 0; n < 2; ++n) acc[a][b][m][n] = (f32x4){0.f, 0.f, 0.f, 0.f};
        cur = nxt; cA = nA; cB = nB; ++ui;
    }
    PG8_WAIT_V(0);
    if (wr == 0) PG8_BAR;
    PG8_BAR;
    if constexpr (Epi::AFTER_DRAIN) { E.fused(acc, cur, wr, wc, fr, fq, lds, wid, lane); S.done(cur); }
    PG8_STAMP();
    if (STAMP && wid == 0) { stamps[lane] = lane < nts ? (((unsigned long long)(unsigned)ts_hi << 32) | (unsigned)ts_lo) : 0ull;
        if (lane == 62) stamps[62] = rt_entry; if (lane == 63) stamps[63] = (unsigned long long)wall_clock64(); }
#undef PG8_STAMP
#undef PG8_SA
#undef PG8_SB
#undef PG8_STAGE
#undef PG8_LDA
#undef PG8_LDB
#undef PG8_MMA
#undef PG8_WAIT_V
#undef PG8_WAIT_L
#undef PG8_BAR
#undef PG8_SCHED
}
}

DI int rowmap(int n, int mode) { return mode == 0 ? n : ((n >> 4) * 32 + (n & 15) + (mode == 2 ? 16 : 0)); }
DI void tconv_tile(const Ctx& c, const float* src, int ld, int N, bf16_t* dst, int ld_dst, int mode, int tk, int tn) {
    bf16_t* T = (bf16_t*)c.smem;
    const int k0 = tk * 64, n0 = tn * 64, tid = c.tid;
    __syncthreads();
#pragma unroll
    for (int i = 0; i < 2; ++i) {
        const int kk = (tid >> 4) + i * 32, n4 = (tid & 15) * 4;
        float4 v = make_float4(0.f, 0.f, 0.f, 0.f);
        if (n0 + n4 < N) v = *(const float4*)(src + (size_t)(k0 + kk) * ld + n0 + n4);
        T[(n4 + 0) * 72 + kk] = f2bf(v.x); T[(n4 + 1) * 72 + kk] = f2bf(v.y); T[(n4 + 2) * 72 + kk] = f2bf(v.z); T[(n4 + 3) * 72 + kk] = f2bf(v.w);
    }
    __syncthreads();
    const int n = tid >> 3, k8 = (tid & 7) * 8;
    if (n0 + n < N) *(u32x4*)(dst + (size_t)rowmap(n0 + n, mode) * ld_dst + k0 + k8) = *(const u32x4*)(T + n * 72 + k8);
}
DI void tconv(const Ctx& c, const float* src, int ld, int K, int N, bf16_t* dst, int ld_dst, int mode, int rot) {
    const int ntk = K / 64, ntn = (N + 63) / 64, nt = ntk * ntn, G = gridDim.x;
    for (int t = (blockIdx.x + G - (rot % G)) % G; t < nt; t += G) tconv_tile(c, src, ld, N, dst, ld_dst, mode, t / ntn, t % ntn);
}

DI void wconv(const Ctx& c, const float* src, int ld, int K, int N, bf16_t* dst, int ld_dst, int rot) {
    const int ntk = K / 64, ntn = (N + 63) / 64, nt = ntk * ntn, GW = gridDim.x * 8, w0 = blockIdx.x * 8 + c.wave;
    for (int t = (w0 + GW - (rot % GW)) % GW; t < nt; t += GW) {
        const int tk = t / ntn, tn = t % ntn, n = tn * 64 + c.lane;
        if (n < N) {
            const float* sp = src + (size_t)(tk * 64) * ld + n; bf16_t* dp = dst + (size_t)n * ld_dst + tk * 64;
#pragma unroll
            for (int kb = 0; kb < 8; ++kb) {
                float v[8];
#pragma unroll
                for (int j = 0; j < 8; ++j) v[j] = sp[(size_t)(kb * 8 + j) * ld];
                u32x4 w4; w4.x = pack2(v[0], v[1]); w4.y = pack2(v[2], v[3]); w4.z = pack2(v[4], v[5]); w4.w = pack2(v[6], v[7]);
                *(u32x4*)(dp + kb * 8) = w4;
            }
        }
    }
}
DI void phase_prologue(const Ctx& c) {
    unsigned char* wsm = c.ws + WS_WSM;
    const int tid = c.tid, G = gridDim.x, gtid = blockIdx.x * NTHR + tid, gn = G * NTHR;
    {
        const float4* x = (const float4*)c.in[0]; const float4* cx = (const float4*)c.in[2]; float4* H = (float4*)(c.ws + WS_H);
        for (size_t i = gtid; i < (size_t)NZ * 256; i += gn) {
            const int z = (int)(i >> 8), q = (int)(i & 255), b = z / TZ, s = z % TZ;
            H[i] = (s < CTX) ? cx[((size_t)b * CTX + s) * 256 + q] : x[((size_t)b * SEQ + (s - CTX)) * 256 + q];
        }
    }
    {
        float* rope = (float*)(wsm + OFF_ROPE);
        for (int i = gtid; i < SEQ * 16; i += gn) {
            const int t = i >> 4, a = (i >> 3) & 1, f = i & 7;
            const float pos = (float)(a == 0 ? (t >> 6) : (t & 63));
            const float inv = powf(10000.f, -(float)f / 8.f);
            float sn, cs; sincosf(pos * inv, &sn, &cs);
            rope[i * 2] = cs; rope[i * 2 + 1] = sn;
        }
    }
    {
        float* s5t = (float*)(wsm + OFF_S5T);
        for (int i = blockIdx.x + tid * G; i < NL * 2 * 16 * 64; i += G * NTHR) {
            const int ldg = i >> 6;
            const double lr = c.in[24][i], li = c.in[25][i], dt = exp((double)c.in[26][ldg]);
            const double mag = exp(lr * dt), are = mag * cos(li * dt), aim = mag * sin(li * dt);
            const double m256 = exp(lr * dt * 64.0), a256r = m256 * cos(li * dt * 64.0), a256i = m256 * sin(li * dt * 64.0);
            const double den = lr * lr + li * li, nr = are - 1.0, ni = aim;
            const double cfr = (nr * lr + ni * li) / den, cfi = (ni * lr - nr * li) / den;
            float* o = s5t + (size_t)i * 36;
            o[0] = (float)are; o[1] = (float)aim; o[2] = (float)a256r; o[3] = (float)a256i;
            for (int ch = 0; ch < 16; ++ch) {
                const double br = c.in[27][(size_t)i * 16 + ch], bi = c.in[28][(size_t)i * 16 + ch];
                o[4 + ch] = (float)(cfr * br - cfi * bi); o[20 + ch] = (float)(cfr * bi + cfi * br);
            }
        }
    }
    {
        float* rwt = (float*)(wsm + OFF_RWT);
        for (int i = gtid; i < NL * 36 * 1024; i += gn) {
            const int l = i / (36 * 1024), e = (i / 1024) % 36, d = i & 1023;
            rwt[i] = e < 4 ? c.in[41][((size_t)l * 1024 + d) * 4 + e] : c.in[43][((size_t)l * 1024 + d) * 32 + (e - 4)];
        }
    }
    if (blockIdx.x == 0 && tid < NL) {
        float s1 = 0.f, s2 = 0.f;
        for (int i = 0; i < 32; ++i) { s1 += c.in[34][tid * 32 + i] * c.in[35][tid * 32 + i]; s2 += c.in[36][tid * 32 + i] * c.in[37][tid * 32 + i]; }
        ((float*)(wsm + OFF_LAM))[tid] = expf(s1) - expf(s2) + (0.8f - 0.6f * expf(-0.3f * (float)tid));
    }
    {
        float* sv = (float*)c.smem;
        float* red = sv + 3 * 1024;
        __syncthreads();
        for (int i = tid; i < 3 * 1024; i += NTHR) { const float v = i < 2048 ? c.in[1][i] : c.in[3][i - 2048]; sv[i] = siluf_(v); }
        __syncthreads();
        float* modv = (float*)(wsm + OFF_MODV);
        for (int u = blockIdx.x; u < NL * 96; u += G) {
            const int l = u / 96, col = (u % 96) * 64 + (tid & 63), ks = tid >> 6;
            const float* w = c.in[4] + (size_t)l * 1024 * 6144 + col;
            float a0 = 0.f, a1 = 0.f, a2 = 0.f;
            for (int k = ks * 128; k < ks * 128 + 128; ++k) { const float wv = w[(size_t)k * 6144]; a0 += sv[k] * wv; a1 += sv[1024 + k] * wv; a2 += sv[2048 + k] * wv; }
            red[(ks * 64 + (tid & 63)) * 3 + 0] = a0; red[(ks * 64 + (tid & 63)) * 3 + 1] = a1; red[(ks * 64 + (tid & 63)) * 3 + 2] = a2;
            __syncthreads();
            if (tid < 192) {
                const int cc = tid & 63, sel = tid >> 6; float s = 0.f;
                for (int k2 = 0; k2 < 8; ++k2) s += red[(k2 * 64 + cc) * 3 + sel];
                const int colo = (u % 96) * 64 + cc;
                modv[((size_t)l * 3 + sel) * 6144 + colo] = s + c.in[5][l * 6144 + colo];
            }
            __syncthreads();
        }
    }
    for (int l = 0; l < NL; ++l) {
        wconv(c, c.in[8] + (size_t)l * 1024 * NIN, NIN, 1024, NIN, (bf16_t*)(wsm + OFF_WINT + l * SZ_WINT), 1024, l * 700);
        tconv(c, c.in[11] + (size_t)l * 256 * 384, 384, 256, 384, (bf16_t*)(wsm + OFF_WUQT + l * SZ_WUQT), 256, 0, 40);
        tconv(c, c.in[12] + (size_t)l * 128 * 512, 512, 128, 512, (bf16_t*)(wsm + OFF_WUKVT + l * SZ_WUKVT), 128, 0, 70);
        for (int d = 0; d < 2; ++d) {
            tconv(c, c.in[15] + (size_t)(l * 2 + d) * 64 * 256, 256, 64, 256, (bf16_t*)(wsm + OFF_W2T + l * SZ_W2T) + d * 256 * 64, 64, 0, 90 + d * 8);
            tconv(c, c.in[17] + (size_t)(l * 2 + d) * 64 * 256, 256, 64, 256, (bf16_t*)(wsm + OFF_A2T + l * SZ_A2T) + d * 256 * 64, 64, 0, 110 + d * 8);
        }
        tconv(c, c.in[18] + (size_t)l * 128 * 256, 256, 128, 256, (bf16_t*)(wsm + OFF_G2T + l * SZ_G2T), 128, 0, 130);
        tconv(c, c.in[32] + (size_t)l * 256 * 256, 256, 256, 256, (bf16_t*)(wsm + OFF_GLUT + l * SZ_GLUT), 256, 0, 140);
        for (int n = 0; n < 4; ++n)
            wconv(c, c.in[39] + (size_t)(l * 4 + n) * 256 * 1024, 1024, 256, 1024, (bf16_t*)(wsm + OFF_WBT + l * SZ_WBT) + n * 256, 1024, 300 + n * 64 + l * 1000);
        wconv(c, c.in[40] + (size_t)l * 1024 * 1024, 1024, 1024, 1024, (bf16_t*)(wsm + OFF_WOUTT + l * SZ_WOUTT), 1024, 1200 + l * 400);
    }
}

DI void phase_expert_convert(const Ctx& c, int l) {
    const int G = gridDim.x, lane = c.lane;
    for (int t = blockIdx.x * 8 + c.wave; t < 32 * 384; t += G * 8) {
        const int e = t / 384, r = t % 384;
        const float* src; bf16_t* dst; int ld, ldd, mode, tk, tn;
        if (r < 128)      { src = c.in[45] + ((size_t)l * 32 + e) * 1024 * 512; dst = (bf16_t*)(c.ws + WS_EXPW + (size_t)e * SZ_WGU); ld = 512; ldd = 1024; mode = 1; tk = r / 8; tn = r % 8; }
        else if (r < 256) { src = c.in[46] + ((size_t)l * 32 + e) * 1024 * 512; dst = (bf16_t*)(c.ws + WS_EXPW + (size_t)e * SZ_WGU); ld = 512; ldd = 1024; mode = 2; tk = (r - 128) / 8; tn = (r - 128) % 8; }
        else              { src = c.in[47] + ((size_t)l * 32 + e) * 512 * 1024; dst = (bf16_t*)(c.ws + WS_EXPW + 32 * SZ_WGU + (size_t)e * SZ_WD); ld = 1024; ldd = 512; mode = 0; tk = (r - 256) / 16; tn = (r - 256) % 16; }
        const int n = tn * 64 + lane; const float* sp = src + (size_t)(tk * 64) * ld + n; bf16_t* dp = dst + (size_t)rowmap(n, mode) * ldd + tk * 64;
        float v[64];
#pragma unroll
        for (int k = 0; k < 64; ++k) v[k] = __builtin_nontemporal_load(sp + (size_t)k * ld);
#pragma unroll
        for (int kb = 0; kb < 8; ++kb) {
            u32x4 w4; w4.x = pack2(v[kb * 8], v[kb * 8 + 1]); w4.y = pack2(v[kb * 8 + 2], v[kb * 8 + 3]); w4.z = pack2(v[kb * 8 + 4], v[kb * 8 + 5]); w4.w = pack2(v[kb * 8 + 6], v[kb * 8 + 7]);
            *(u32x4*)(dp + kb * 8) = w4;
        }
    }
}

DI void phase_norm1(const Ctx& c, int l) {
    const float* modv = (const float*)(c.ws + WS_WSM + OFF_MODV);
    float* H = (float*)(c.ws + WS_H); const bf16_t* Y = (const bf16_t*)(c.ws + WS_P);
    bf16_t* XN = (bf16_t*)(c.ws + WS_BUFA);
    const float* g1 = c.in[6] + l * 1024;
    float4 gv[4];
#pragma unroll
    for (int q = 0; q < 4; ++q) gv[q] = *(const float4*)(g1 + q * 256 + c.lane * 4);
    for (int row = blockIdx.x * 8 + c.wave; row < NZ; row += gridDim.x * 8) {
        const int b = row / TZ, s = row % TZ, sel = s < CTX ? 2 : b;
        float4 v[4], m0[4], m1[4], m5[4]; u32x2 ya2[4], yb2[4];
#pragma unroll
        for (int q = 0; q < 4; ++q) {
            const int col = q * 256 + c.lane * 4;
            v[q] = *(const float4*)(H + (size_t)row * D + col);
            m0[q] = *(const float4*)(modv + ((size_t)l * 3 + sel) * 6144 + col); m1[q] = *(const float4*)(modv + ((size_t)l * 3 + sel) * 6144 + 1024 + col);
            if (l > 0) { ya2[q] = *(const u32x2*)(Y + (size_t)row * D + col); yb2[q] = *(const u32x2*)(Y + ((size_t)NZ + row) * D + col);
                         m5[q] = *(const float4*)(modv + ((size_t)(l - 1) * 3 + sel) * 6144 + 5 * 1024 + col); }
        }
        float ss = 0.f;
#pragma unroll
        for (int q = 0; q < 4; ++q) {
            const int col = q * 256 + c.lane * 4;
            if (l > 0) {
                float ya[4], yb[4]; unpack4(ya2[q], ya); unpack4(yb2[q], yb);
                v[q].x += m5[q].x * (ya[0] + yb[0]); v[q].y += m5[q].y * (ya[1] + yb[1]); v[q].z += m5[q].z * (ya[2] + yb[2]); v[q].w += m5[q].w * (ya[3] + yb[3]);
                *(float4*)(H + (size_t)row * D + col) = v[q];
            }
            ss += v[q].x * v[q].x + v[q].y * v[q].y + v[q].z * v[q].z + v[q].w * v[q].w;
        }
        ss = wave_sum(ss);
        const float rs = rsqrtf(ss * (1.f / 1024.f) + 1e-6f);
#pragma unroll
        for (int q = 0; q < 4; ++q) {
            const int col = q * 256 + c.lane * 4;
            *(u32x2*)(XN + (size_t)row * D + col) = pack4(v[q].x * rs * gv[q].x * (1.f + m1[q].x) + m0[q].x, v[q].y * rs * gv[q].y * (1.f + m1[q].y) + m0[q].y,
                                                          v[q].z * rs * gv[q].z * (1.f + m1[q].z) + m0[q].z, v[q].w * rs * gv[q].w * (1.f + m1[q].w) + m0[q].w);
        }
    }
}

DI void phase_final(const Ctx& c) {
    const float* modv = (const float*)(c.ws + WS_WSM + OFF_MODV);
    const float* H = (const float*)(c.ws + WS_H); const bf16_t* Y = (const bf16_t*)(c.ws + WS_P);
    const float* g = c.in[48];
    float4 gv[4];
#pragma unroll
    for (int q = 0; q < 4; ++q) gv[q] = *(const float4*)(g + q * 256 + c.lane * 4);
    for (int r = blockIdx.x * 8 + c.wave; r < NB * SEQ; r += gridDim.x * 8) {
        const int b = r / SEQ, t = r % SEQ, row = b * TZ + CTX + t;
        float4 v[4]; float ss = 0.f;
#pragma unroll
        for (int q = 0; q < 4; ++q) {
            const int col = q * 256 + c.lane * 4;
            v[q] = *(const float4*)(H + (size_t)row * D + col);
            float ya[4], yb[4]; unpack4(*(const u32x2*)(Y + (size_t)row * D + col), ya); unpack4(*(const u32x2*)(Y + ((size_t)NZ + row) * D + col), yb);
            const float4 m5 = *(const float4*)(modv + ((size_t)(NL - 1) * 3 + b) * 6144 + 5 * 1024 + col);
            v[q].x += m5.x * (ya[0] + yb[0]); v[q].y += m5.y * (ya[1] + yb[1]); v[q].z += m5.z * (ya[2] + yb[2]); v[q].w += m5.w * (ya[3] + yb[3]);
            ss += v[q].x * v[q].x + v[q].y * v[q].y + v[q].z * v[q].z + v[q].w * v[q].w;
        }
        ss = wave_sum(ss);
        const float rs = rsqrtf(ss * (1.f / 1024.f) + 1e-6f);
#pragma unroll
        for (int q = 0; q < 4; ++q) {
            const int col = q * 256 + c.lane * 4; const float4 gg = gv[q];
            *(float4*)(c.out + (size_t)r * D + col) = make_float4(v[q].x * rs * gg.x, v[q].y * rs * gg.y, v[q].z * rs * gg.z, v[q].w * rs * gg.w);
        }
    }
}

struct EpiInproj {
    static constexpr bool PERM = true, AFTER_DRAIN = false;
    bf16_t *PM, *PS, *PR, *PD, *GT;
    DI void operator()(const pg8::f32x4 (&acc)[2][2][4][2], const pg8::Unit& u, int wr, int wc, int fr, int fq) const {
        const int row0 = u.pm * 256 + wr * 64 + fr, col0 = u.pn * 256 + wc * 32 + 8 * fq;
#pragma unroll
        for (int bj = 0; bj < 2; ++bj) {
            const int col = col0 + bj * 128;
            bf16_t* dst; int ld, cc; bool gate = false;
            if (col < 416) { dst = PM; ld = 416; cc = col; }
            else if (col < 1440) { dst = PR; ld = 1024; cc = col - 416; }
            else if (col < 1696) { dst = PS; ld = 256; cc = col - 1440; }
            else if (col < 2464) { dst = PD; ld = 768; cc = col - 1696; }
            else if (col < NIN) { dst = GT; ld = 4096; cc = col - 2464; gate = true; }
            else continue;
#pragma unroll
            for (int ai = 0; ai < 2; ++ai)
#pragma unroll
                for (int m = 0; m < 4; ++m) {
                    const int row = row0 + ai * 128 + m * 16; pg8::f32x4 v0 = acc[ai][bj][m][0], v1 = acc[ai][bj][m][1];
                    if (gate) { v0[0] = sigmoidf_(v0[0]); v0[1] = sigmoidf_(v0[1]); v0[2] = sigmoidf_(v0[2]); v0[3] = sigmoidf_(v0[3]);
                                v1[0] = sigmoidf_(v1[0]); v1[1] = sigmoidf_(v1[1]); v1[2] = sigmoidf_(v1[2]); v1[3] = sigmoidf_(v1[3]); }
                    u32x4 w; w.x = pack2(v0[0], v0[1]); w.y = pack2(v0[2], v0[3]); w.z = pack2(v1[0], v1[1]); w.w = pack2(v1[2], v1[3]);
                    *(u32x4*)(dst + (size_t)row * ld + cc) = w;
                }
        }
    }
};
DI void phase_inproj(const Ctx& c, int l) {
    EpiInproj E; E.PM = (bf16_t*)(c.ws + WS_P + P_PM); E.PS = (bf16_t*)(c.ws + WS_P + P_PS); E.PR = (bf16_t*)(c.ws + WS_P + P_PR); E.PD = (bf16_t*)(c.ws + WS_P + P_PD); E.GT = (bf16_t*)(c.ws + WS_GT);
    pg8::Gemm g{(const bf16_t*)(c.ws + WS_BUFA), (const bf16_t*)(c.ws + WS_WSM + OFF_WINT + l * SZ_WINT), NZ, NINP, 1024, 1024, 1024};
    pg8::StaticOrder S; S.init(NZ, NINP, (int)gridDim.x, (int)blockIdx.x, INPROJ_WGM);
    __syncthreads();
    pg8::gemm_phase<EpiInproj, pg8::StaticOrder, false>((PG8_LAS unsigned char*)c.smem, g, S, E, nullptr, c.tid);
}

DI void phase_prep(const Ctx& c, int l) {
    unsigned char* ws = c.ws; const int lane = c.lane, wave = c.wave, tid = c.tid;
    const bf16_t* PM = (const bf16_t*)(ws + WS_P + P_PM); const bf16_t* PR = (const bf16_t*)(ws + WS_P + P_PR); const bf16_t* PD = (const bf16_t*)(ws + WS_P + P_PD);
    bf16_t* CQN = (bf16_t*)(ws + WS_MISC + MS_CQN); bf16_t* TW = (bf16_t*)(ws + WS_MISC + MS_TW); bf16_t* AL = (bf16_t*)(ws + WS_MISC + MS_AL); bf16_t* SG = (bf16_t*)(ws + WS_MISC + MS_SG);
    bf16_t* KM = (bf16_t*)(ws + WS_EXPW + MX_KM); bf16_t* QD = (bf16_t*)(ws + WS_EXPW + MX_QD); bf16_t* KD_ = (bf16_t*)(ws + WS_EXPW + MX_KD); bf16_t* VDT = (bf16_t*)(ws + WS_EXPW + MX_VDT);
    bf16_t* RB = (bf16_t*)(ws + WS_EXPW + MX_RB); bf16_t* KB = (bf16_t*)(ws + WS_EXPW + MX_KB); bf16_t* VB = (bf16_t*)(ws + WS_EXPW + MX_VB); bf16_t* KKB = (bf16_t*)(ws + WS_EXPW + MX_KKB);
    const float* rope = (const float*)(ws + WS_WSM + OFF_ROPE);
    const float* gq = c.in[9] + l * 256; const float* gkv = c.in[10] + l * 128; const float* mu = c.in[13] + l * 1024; const float* k_k = c.in[19] + l * 256;
    bf16_t* Vs = (bf16_t*)c.smem;
    const float qsc = 0.17677669529663687f * LOG2E;
    for (int tile = blockIdx.x; tile < NZ / 16; tile += gridDim.x) {
        __syncthreads();
        struct PrepRow { u32x2 pmq; unsigned pmkv; bf16_t pmr; float2 csm; u32x2 pdq, pdk, pdv; float4 csa, csb; u32x2 cu[4], pv[4], nx[4]; };
        PrepRow R[2];
#pragma unroll
        for (int i = 0; i < 2; ++i) {
            const int rt = wave * 2 + i, z = tile * 16 + rt, s = z % TZ; const bool lat = s >= CTX; const int tl = lat ? s - CTX : 0;
            PrepRow& r = R[i];
            const bf16_t* pm = PM + (size_t)z * 416;
            r.pmq = *(const u32x2*)(pm + lane * 4); r.pmkv = *(const unsigned*)(pm + 256 + lane * 2); r.pmr = pm[384 + (lane & 31)];
            r.csm = *(const float2*)(rope + ((size_t)tl * 16 + ((lane & 31) >> 4) * 8 + (lane & 7)) * 2);
            const bf16_t* pd = PD + (size_t)z * 768; const int i0 = lane * 4, ii = i0 & 31;
            r.pdq = *(const u32x2*)(pd + i0); r.pdk = *(const u32x2*)(pd + 256 + i0); r.pdv = *(const u32x2*)(pd + 512 + i0);
            const float* cs = rope + ((size_t)tl * 16 + (ii >> 4) * 8 + (ii & 7)) * 2;
            r.csa = *(const float4*)cs; r.csb = *(const float4*)(cs + 4);
            const bf16_t* pr = PR + (size_t)z * 1024;
            const bool hp = (s != 0) && (s != CTX), hn = (s != CTX - 1) && (s != TZ - 1);
#pragma unroll
            for (int q = 0; q < 4; ++q) {
                const int col = q * 256 + lane * 4;
                r.cu[q] = *(const u32x2*)(pr + col); r.pv[q] = (u32x2){0u, 0u}; r.nx[q] = (u32x2){0u, 0u};
                if (hp) r.pv[q] = *(const u32x2*)(pr - 1024 + col);
                if (hn) r.nx[q] = *(const u32x2*)(pr + 1024 + col);
            }
        }
#pragma unroll
        for (int i = 0; i < 2; ++i) {
            const int rt = wave * 2 + i, z = tile * 16 + rt, b = z / TZ, s = z % TZ; const bool lat = s >= CTX;
            const PrepRow& r = R[i];
            {
                float x[4]; unpack4(r.pmq, x);
                float ss = wave_sum(x[0] * x[0] + x[1] * x[1] + x[2] * x[2] + x[3] * x[3]);
                float rs = rsqrtf(ss * (1.f / 256.f) + 1e-6f);
                const float4 g = *(const float4*)(gq + lane * 4);
                *(u32x2*)(CQN + (size_t)z * 384 + lane * 4) = pack4(x[0] * rs * g.x, x[1] * rs * g.y, x[2] * rs * g.z, x[3] * rs * g.w);
                const float y0 = lo2f(r.pmkv), y1 = hi2f(r.pmkv);
                ss = wave_sum(y0 * y0 + y1 * y1); rs = rsqrtf(ss * (1.f / 128.f) + 1e-6f);
                const float2 g2 = *(const float2*)(gkv + lane * 2);
                *(unsigned*)(CQN + (size_t)z * 384 + 256 + lane * 2) = pack2(y0 * rs * g2.x, y1 * rs * g2.y);
                float kr = bf2f(r.pmr);
                const float pr = __shfl_xor(kr, 8, 64);
                if (lat) kr = kr * r.csm.x + ((lane & 8) ? pr : -pr) * r.csm.y;
                if (lane < 32) {
                    const bf16_t kv = f2bf(kr);
#pragma unroll
                    for (int h = 0; h < 4; ++h) KM[((size_t)(b * 4 + h) * TZ + s) * 96 + 64 + lane] = kv;
                }
            }
            {
                const int i0 = lane * 4, hh = i0 >> 6, ii = i0 & 31, nn = (i0 >> 5) & 1;
                const float cs[8] = {r.csa.x, r.csa.y, r.csa.z, r.csa.w, r.csb.x, r.csb.y, r.csb.z, r.csb.w};
                const bool hi = (ii & 8) != 0;
#pragma unroll
                for (int w = 0; w < 2; ++w) {
                    float x[4]; unpack4(w == 0 ? r.pdq : r.pdk, x);
                    float o[4];
#pragma unroll
                    for (int j = 0; j < 4; ++j) {
                        const float p = __shfl_xor(x[j], 2, 64);
                        o[j] = lat ? (x[j] * cs[2 * j] + (hi ? p : -p) * cs[2 * j + 1]) : x[j];
                        if (w == 0) o[j] *= qsc;
                    }
                    bf16_t* dst = (w == 0 ? QD : KD_) + ((size_t)(b * 4 + hh) * TZ + s) * 64 + nn * 32 + ii;
                    *(u32x2*)dst = pack4(o[0], o[1], o[2], o[3]);
                }
                *(u32x2*)(Vs + rt * 264 + i0) = r.pdv;
            }
            {
#pragma unroll
                for (int q = 0; q < 4; ++q) {
                    const int col = q * 256 + lane * 4;
                    float cu[4], pv[4], nx[4];
                    unpack4(r.cu[q], cu); unpack4(r.pv[q], pv); unpack4(r.nx[q], nx);
                    const float4 m = *(const float4*)(mu + col);
                    float zv[4];
                    zv[0] = cu[0] + (0.5f * (pv[0] + nx[0]) - cu[0]) * m.x; zv[1] = cu[1] + (0.5f * (pv[1] + nx[1]) - cu[1]) * m.y;
                    zv[2] = cu[2] + (0.5f * (pv[2] + nx[2]) - cu[2]) * m.z; zv[3] = cu[3] + (0.5f * (pv[3] + nx[3]) - cu[3]) * m.w;
                    if (q == 0) *(u32x2*)(RB + (size_t)z * 256 + lane * 4) = pack4(zv[0], zv[1], zv[2], zv[3]);
                    else if (q == 1) {
                        *(u32x2*)(KB + (size_t)z * 256 + lane * 4) = pack4(zv[0], zv[1], zv[2], zv[3]);
                        const float4 kk4 = *(const float4*)(k_k + lane * 4);
                        const float a0 = zv[0] * kk4.x, a1 = zv[1] * kk4.y, a2 = zv[2] * kk4.z, a3 = zv[3] * kk4.w;
                        const float ssq = sum16(a0 * a0 + a1 * a1 + a2 * a2 + a3 * a3);
                        const float inv = 1.f / fmaxf(sqrtf(ssq), 1e-12f);
                        *(u32x2*)(KKB + (size_t)z * 256 + lane * 4) = pack4(a0 * inv, a1 * inv, a2 * inv, a3 * inv);
                    } else if (q == 2) *(u32x2*)(VB + (size_t)z * 256 + lane * 4) = pack4(zv[0], zv[1], zv[2], zv[3]);
                    else {
                        if (lane < 16) *(u32x2*)(TW + (size_t)z * 64 + lane * 4) = pack4(tanhf_(zv[0]), tanhf_(zv[1]), tanhf_(zv[2]), tanhf_(zv[3]));
                        else if (lane < 32) *(u32x2*)(AL + (size_t)z * 64 + (lane - 16) * 4) = pack4(zv[0], zv[1], zv[2], zv[3]);
                        else *(u32x2*)(SG + (size_t)z * 128 + (lane - 32) * 4) = pack4(sigmoidf_(zv[0]), sigmoidf_(zv[1]), sigmoidf_(zv[2]), sigmoidf_(zv[3]));
                    }
                }
            }
        }
        __syncthreads();
        {
            const int z0 = tile * 16, b = z0 / TZ, s0 = z0 % TZ;
#pragma unroll
            for (int i = 0; i < 1; ++i) {
                const int ch = tid, dv = ch >> 1, r8 = (ch & 1) * 8;
                bf16_t v[8];
#pragma unroll
                for (int j = 0; j < 8; ++j) v[j] = Vs[(r8 + j) * 264 + dv];
                u32x4 o; o.x = v[0] | ((unsigned)v[1] << 16); o.y = v[2] | ((unsigned)v[3] << 16); o.z = v[4] | ((unsigned)v[5] << 16); o.w = v[6] | ((unsigned)v[7] << 16);
                *(u32x4*)(VDT + ((size_t)(b * 4 + (dv >> 6)) * 64 + (dv & 63)) * TZ + s0 + r8) = o;
            }
        }
    }
}

constexpr int S5C = 64, S5N = TZ / S5C, S5NC = CTX / S5C;
DI int s5_tok(int dir, int i) { return dir == 0 ? i : (i < CTX ? CTX - 1 - i : TZ - 1 - (i - CTX)); }
DI void s5_stage_u(const Ctx& c, float* U, int b, int dir, int chunk, int g0, int ng) {
    const bf16_t* PS = (const bf16_t*)(c.ws + WS_P + P_PS);
    const int per = ng * 4;
    for (int e = c.tid; e < S5C * per; e += NTHR) {
        const int i = e / per, c4 = (e % per) * 4, s = s5_tok(dir, chunk * S5C + i);
        float x[4]; unpack4(*(const u32x2*)(PS + (size_t)(b * TZ + s) * 256 + g0 * 16 + c4), x);
        *(float4*)(U + i * (ng * 16) + c4) = make_float4(x[0], x[1], x[2], x[3]);
    }
}
DI void phase_s5_local(const Ctx& c, int l) {
    float* U = (float*)c.smem;
    const float* s5t = (const float*)(c.ws + WS_WSM + OFF_S5T);
    float* E = (float*)(c.ws + WS_WSM + OFF_S5E);
    for (int u = blockIdx.x; u < 2 * 2 * S5N * 2; u += gridDim.x) {
        const int gq = u & 1, chunk = (u >> 1) % S5N, dir = (u / (2 * S5N)) & 1, b = u / (4 * S5N);
        __syncthreads();
        s5_stage_u(c, U, b, dir, chunk, gq * 8, 8);
        __syncthreads();
        const int g = gq * 8 + c.wave, p = c.lane;
        const float* tb = s5t + ((size_t)((l * 2 + dir) * 16 + g) * 64 + p) * 36;
        const float are = tb[0], aim = tb[1];
        float br[16], bi[16];
#pragma unroll
        for (int ch = 0; ch < 16; ++ch) { br[ch] = tb[4 + ch]; bi[ch] = tb[20 + ch]; }
        float xr = 0.f, xi = 0.f;
        for (int i = 0; i < S5C; ++i) {
            const float* uu = U + i * 128 + c.wave * 16;
            float sr = 0.f, si = 0.f;
#pragma unroll
            for (int q = 0; q < 4; ++q) { const float4 v = *(const float4*)(uu + q * 4);
                sr += br[q * 4] * v.x + br[q * 4 + 1] * v.y + br[q * 4 + 2] * v.z + br[q * 4 + 3] * v.w;
                si += bi[q * 4] * v.x + bi[q * 4 + 1] * v.y + bi[q * 4 + 2] * v.z + bi[q * 4 + 3] * v.w; }
            const float nr = are * xr - aim * xi + sr, ni = are * xi + aim * xr + si; xr = nr; xi = ni;
        }
        *(float2*)(E + ((size_t)(((b * 2 + dir) * 16 + g) * S5N + chunk) * 64 + p) * 2) = make_float2(xr, xi);
    }
}
DI void phase_s5_carry(const Ctx& c, int l) {
    const int gt = blockIdx.x * NTHR + c.tid;
    if (gt < 2 * 2 * 16 * 64) {
        const int p = gt & 63, g = (gt >> 6) & 15, dir = (gt >> 10) & 1, b = gt >> 11;
        const float* tb = (const float*)(c.ws + WS_WSM + OFF_S5T) + ((size_t)((l * 2 + dir) * 16 + g) * 64 + p) * 36;
        const float ar = tb[2], ai = tb[3];
        const float* E = (const float*)(c.ws + WS_WSM + OFF_S5E) + (size_t)(((b * 2 + dir) * 16 + g) * S5N) * 128;
        float* C = (float*)(c.ws + WS_WSM + OFF_S5C) + (size_t)(((b * 2 + dir) * 16 + g) * S5N) * 128;
        float xr = 0.f, xi = 0.f;
        for (int ch = 0; ch < S5N; ++ch) {
            const float2 e = *(const float2*)(E + ch * 128 + p * 2);
            *(float2*)(C + ch * 128 + p * 2) = make_float2(xr, xi);
            const float nr = ar * xr - ai * xi + e.x, ni = ar * xi + ai * xr + e.y; xr = nr; xi = ni;
        }
    }
}

constexpr int S5_US = 0, S5_YS = 8192, S5_WV = S5_YS + 2 * 64 * 64 * 4;
template <bool LOCAL>
DI void phase_s5_final_unit(const Ctx& c, int l, int u) {
    unsigned char* L = c.smem;
    const float* s5t = (const float*)(c.ws + WS_WSM + OFF_S5T);
    const float* CIN = (const float*)(c.ws + WS_WSM + OFF_S5C);
    const bf16_t* PS = (const bf16_t*)(c.ws + WS_P + P_PS);
    const int gq = u & 3, ct = (u >> 2) % S5N, b = u / (4 * S5N);
    const int wave = c.wave, lane = c.lane, gl = wave >> 1, dir = wave & 1, g = gq * 4 + gl, n16 = lane & 15, q4 = lane >> 4;
    __syncthreads();
    {
        const int t = c.tid >> 3, part = c.tid & 7;
        *(u32x4*)(L + S5_US + t * 128 + part * 16) = *(const u32x4*)(PS + (size_t)(b * TZ + ct * S5C + t) * 256 + gq * 64 + part * 8);
    }
    typedef short s16x4 __attribute__((ext_vector_type(4)));
    const float* tbase = s5t + ((size_t)((l * 2 + dir) * 16 + g) * 64) * 36;
    s16x4 bfr[8], cfr[8];
#pragma unroll
    for (int j = 0; j < 8; ++j) {
        const int pp = 16 * j + n16, p = pp & 63; const float* tb = tbase + (size_t)p * 36 + (pp < 64 ? 4 : 20) + 4 * q4;
        u32x2 w2; w2.x = pack2(tb[0], tb[1]); w2.y = pack2(tb[2], tb[3]);
        bfr[j] = __builtin_bit_cast(s16x4, w2);
    }
    {
        const float* cre = c.in[29] + ((size_t)((l * 2 + dir) * 16 + g) * 16 + n16) * 64; const float* cim = c.in[30] + ((size_t)((l * 2 + dir) * 16 + g) * 16 + n16) * 64;
#pragma unroll
        for (int s = 0; s < 8; ++s) {
            const int pp = 16 * s + 4 * q4; const float sg = pp < 64 ? 1.f : -1.f; const float* src = (pp < 64 ? cre + pp : cim + (pp - 64));
            u32x2 w2; w2.x = pack2(sg * src[0], sg * src[1]); w2.y = pack2(sg * src[2], sg * src[3]);
            cfr[s] = __builtin_bit_cast(s16x4, w2);
        }
    }
    const float are = tbase[(size_t)lane * 36], aim = tbase[(size_t)lane * 36 + 1];
    const int cd = dir == 0 ? ct : (ct < S5NC ? S5NC - 1 - ct : S5N + S5NC - 1 - ct);
    float xr = 0.f, xi = 0.f;
    if (!LOCAL) { const float2 ci = *(const float2*)(CIN + ((size_t)(((b * 2 + dir) * 16 + g) * S5N + cd) * 64 + lane) * 2); xr = ci.x; xi = ci.y; }
    const float dsk = c.in[31][(size_t)l * 256 + g * 16 + n16];
    bf16_t* BU = (bf16_t*)(L + S5_WV + wave * 8192); bf16_t* XB = BU + 16 * 128;
    float* YS = (float*)(L + S5_YS) + dir * 64 * 64;
    __syncthreads();
#pragma unroll 1
    for (int sb = 0; sb < 4; ++sb) {
        const int stepA = 16 * sb + n16, tlA = dir == 0 ? stepA : 63 - stepA;
        const s16x4 af = __builtin_bit_cast(s16x4, *(const u32x2*)(L + S5_US + tlA * 128 + gl * 32 + q4 * 8));
#pragma unroll
        for (int j = 0; j < 8; ++j) {
            f32x4 acc = {0.f, 0.f, 0.f, 0.f};
            acc = __builtin_amdgcn_mfma_f32_16x16x16bf16_1k(af, bfr[j], acc, 0, 0, 0);
#pragma unroll
            for (int rr = 0; rr < 4; ++rr) BU[(4 * q4 + rr) * 128 + 16 * j + n16] = f2bf(acc[rr]);
        }
        __builtin_amdgcn_wave_barrier();
#pragma unroll
        for (int ii = 0; ii < 16; ++ii) {
            const float br = bf2f(BU[ii * 128 + lane]), bi = bf2f(BU[ii * 128 + 64 + lane]);
            const float nr = are * xr - aim * xi + br, ni = are * xi + aim * xr + bi; xr = nr; xi = ni;
            if (!LOCAL) { XB[ii * 128 + lane] = f2bf(xr); XB[ii * 128 + 64 + lane] = f2bf(xi); }
        }
        __builtin_amdgcn_wave_barrier();
        if (LOCAL) continue;
        f32x4 ya = {0.f, 0.f, 0.f, 0.f};
#pragma unroll
        for (int s = 0; s < 8; ++s) {
            const s16x4 xf = __builtin_bit_cast(s16x4, *(const u32x2*)((const unsigned char*)XB + n16 * 256 + (16 * s + 4 * q4) * 2));
            ya = __builtin_amdgcn_mfma_f32_16x16x16bf16_1k(xf, cfr[s], ya, 0, 0, 0);
        }
#pragma unroll
        for (int rr = 0; rr < 4; ++rr) {
            const int step = 16 * sb + 4 * q4 + rr, tl = dir == 0 ? step : 63 - step;
            float y = ya[rr];
            if (dir == 0) y += dsk * bf2f(*(const bf16_t*)(L + S5_US + tl * 128 + (gl * 16 + n16) * 2));
            YS[tl * 64 + gl * 16 + n16] = y;
        }
    }
    if (LOCAL) { *(float2*)((float*)(c.ws + WS_WSM + OFF_S5E) + ((size_t)(((b * 2 + dir) * 16 + g) * S5N + cd) * 64 + lane) * 2) = make_float2(xr, xi); return; }
    __syncthreads();
    bf16_t* ZG = (bf16_t*)(c.ws + WS_MISC + MS_ZG);
    {
        const float* Y0 = (const float*)(L + S5_YS); const float* Y1 = Y0 + 64 * 64;
        for (int e = c.tid; e < 64 * 16; e += NTHR) {
            const int i = e >> 4, c4 = (e & 15) * 4; const float4 y0 = *(const float4*)(Y0 + i * 64 + c4), y1 = *(const float4*)(Y1 + i * 64 + c4);
            *(u32x2*)(ZG + (size_t)(b * TZ + ct * S5C + i) * 256 + gq * 64 + c4) = pack4(gelu_tanh(y0.x + y1.x), gelu_tanh(y0.y + y1.y), gelu_tanh(y0.z + y1.z), gelu_tanh(y0.w + y1.w));
        }
    }
}

DI void phase_small_gemms(const Ctx& c, int l) {
    unsigned char* ws = c.ws; unsigned char* wsm = ws + WS_WSM;
    const bf16_t* CQN = (const bf16_t*)(ws + WS_MISC + MS_CQN);
    const float* rope = (const float*)(wsm + OFF_ROPE);
    constexpr int NMT = NZ / 256;
    int base = 0;
    const int G = gridDim.x, bid = blockIdx.x;
    {
        const bf16_t* W = (const bf16_t*)(wsm + OFF_WUQT + l * SZ_WUQT); bf16_t* QM = (bf16_t*)(ws + WS_EXPW + MX_QM);
        const float qs = 0.10206207261596577f * LOG2E;
        for (int u = (bid + G - base % G) % G; u < NMT * 3; u += G) {
            const int mt = u / 3, nt = u % 3, r0 = mt * 256, c0 = nt * 128;
            gemm_tile<4, 0>(c, 256, [&](int i) { return CQN + (size_t)(r0 + i) * 384; }, [&](int i) { return W + (size_t)(c0 + i) * 256; }, NoHook(),
                [&](f32x4 (&acc)[4][4], int wr, int wc, int fr, int fq) {
#pragma unroll
                    for (int n = 0; n < 4; ++n) {
                        const int col = c0 + wc + n * 16 + fq * 4, h = col / 96, d = col % 96;
                        const bool rp = d >= 64;
#pragma unroll
                        for (int m = 0; m < 4; ++m) {
                            const int row = r0 + wr + m * 16 + fr, b = row / TZ, s = row % TZ; f32x4 v = acc[m][n];
                            f32x4 pv; pv[0] = __shfl_xor(v[0], 32, 64); pv[1] = __shfl_xor(v[1], 32, 64); pv[2] = __shfl_xor(v[2], 32, 64); pv[3] = __shfl_xor(v[3], 32, 64);
                            if (rp && s >= CTX) {
                                const int i0 = d - 64;
                                const float* cs = rope + ((size_t)(s - CTX) * 16 + (i0 >> 4) * 8 + (i0 & 7)) * 2;
                                const bool hi = (i0 & 8) != 0;
#pragma unroll
                                for (int j = 0; j < 4; ++j) v[j] = v[j] * cs[2 * j] + (hi ? pv[j] : -pv[j]) * cs[2 * j + 1];
                            }
                            *(u32x2*)(QM + ((size_t)(b * 4 + h) * TZ + s) * 96 + d) = pack4(v[0] * qs, v[1] * qs, v[2] * qs, v[3] * qs);
                        }
                    }
                });
        }
        base += NMT * 3;
    }
    {
        const bf16_t* W = (const bf16_t*)(wsm + OFF_WUKVT + l * SZ_WUKVT); bf16_t* KM = (bf16_t*)(ws + WS_EXPW + MX_KM); bf16_t* VMT = (bf16_t*)(ws + WS_EXPW + MX_VMT);
        for (int u = (bid + G - base % G) % G; u < NMT * 4; u += G) {
            const int mt = u / 4, nt = u % 4, r0 = mt * 256, c0 = nt * 128;
            gemm_tile<4, 0>(c, 128, [&](int i) { return CQN + (size_t)(r0 + i) * 384 + 256; }, [&](int i) { return W + (size_t)(c0 + i) * 128; }, NoHook(),
                [&](f32x4 (&acc)[4][4], int wr, int wc, int fr, int fq) {
#pragma unroll
                    for (int n = 0; n < 4; ++n) {
                        const int col = c0 + wc + n * 16 + fq * 4, h = col >> 7, d = col & 127;
#pragma unroll
                        for (int m = 0; m < 4; ++m) {
                            const int row = r0 + wr + m * 16 + fr, b = row / TZ, s = row % TZ; const f32x4 v = acc[m][n];
                            if (d < 64) *(u32x2*)(KM + ((size_t)(b * 4 + h) * TZ + s) * 96 + d) = pack4(v[0], v[1], v[2], v[3]);
                            else {
#pragma unroll
                                for (int j = 0; j < 4; ++j) VMT[((size_t)(b * 4 + h) * 64 + (d - 64 + j)) * TZ + s] = f2bf(v[j]);
                            }
                        }
                    }
                });
        }
        base += NMT * 4;
    }
    bf16_t* SE = (bf16_t*)(ws + WS_P + P_PR); bf16_t* SAD = SE + (size_t)2 * NZ * 256; bf16_t* SKD = SAD + (size_t)2 * NZ * 256;
    {
        const bf16_t* A = (const bf16_t*)(ws + WS_MISC + MS_TW); const bf16_t* W = (const bf16_t*)(wsm + OFF_W2T + l * SZ_W2T);
        const float* w0 = c.in[14] + (size_t)l * 512;
        for (int u = (bid + G - base % G) % G; u < NMT * 4; u += G) {
            const int mt = u / 4, nt = u % 4, r0 = mt * 256, c0 = nt * 128;
            gemm_tile<4, 0>(c, 64, [&](int i) { return A + (size_t)(r0 + i) * 64; }, [&](int i) { return W + (size_t)(c0 + i) * 64; }, NoHook(),
                [&](f32x4 (&acc)[4][4], int wr, int wc, int fr, int fq) {
#pragma unroll
                    for (int n = 0; n < 4; ++n) {
                        const int col = c0 + wc + n * 16 + fq * 4, d = col >> 8, cc = col & 255; const float4 w0v = *(const float4*)(w0 + col);
#pragma unroll
                        for (int m = 0; m < 4; ++m) {
                            const int row = r0 + wr + m * 16 + fr; const f32x4 v = acc[m][n]; float e[4];
                            const float x[4] = {w0v.x + v[0], w0v.y + v[1], w0v.z + v[2], w0v.w + v[3]};
#pragma unroll
                            for (int j = 0; j < 4; ++j) e[j] = 0.6065306597126334f * sigmoidf_(x[j]);
                            *(u32x2*)(SE + ((size_t)d * NZ + row) * 256 + cc) = pack4(e[0], e[1], e[2], e[3]);
                        }
                    }
                });
        }
        base += NMT * 4;
    }
    {
        const bf16_t* A = (const bf16_t*)(ws + WS_MISC + MS_AL); const bf16_t* W = (const bf16_t*)(wsm + OFF_A2T + l * SZ_A2T);
        const float* a0 = c.in[16] + (size_t)l * 512; const float* k_a = c.in[20] + (size_t)l * 256; const bf16_t* KB = (const bf16_t*)(ws + WS_EXPW + MX_KB);
        for (int u = (bid + G - base % G) % G; u < NMT * 4; u += G) {
            const int mt = u / 4, nt = u % 4, r0 = mt * 256, c0 = nt * 128;
            gemm_tile<4, 0>(c, 64, [&](int i) { return A + (size_t)(r0 + i) * 64; }, [&](int i) { return W + (size_t)(c0 + i) * 64; }, NoHook(),
                [&](f32x4 (&acc)[4][4], int wr, int wc, int fr, int fq) {
                    u32x2 kq[4][4]; float4 a0q[4], kaq[4];
#pragma unroll
                    for (int n = 0; n < 4; ++n) {
                        const int col = c0 + wc + n * 16 + fq * 4, cc = col & 255; a0q[n] = *(const float4*)(a0 + col); kaq[n] = *(const float4*)(k_a + cc);
#pragma unroll
                        for (int m = 0; m < 4; ++m) kq[m][n] = *(const u32x2*)(KB + (size_t)(r0 + wr + m * 16 + fr) * 256 + cc);
                    }
#pragma unroll
                    for (int n = 0; n < 4; ++n) {
                        const int col = c0 + wc + n * 16 + fq * 4, d = col >> 8, cc = col & 255; const float4 a0v = a0q[n], kav = kaq[n];
#pragma unroll
                        for (int m = 0; m < 4; ++m) {
                            const int row = r0 + wr + m * 16 + fr; const f32x4 v = acc[m][n];
                            const float ad0 = sigmoidf_(a0v.x + v[0]), ad1 = sigmoidf_(a0v.y + v[1]), ad2 = sigmoidf_(a0v.z + v[2]), ad3 = sigmoidf_(a0v.w + v[3]);
                            float k[4]; unpack4(kq[m][n], k);
                            *(u32x2*)(SAD + ((size_t)d * NZ + row) * 256 + cc) = pack4(ad0, ad1, ad2, ad3);
                            *(u32x2*)(SKD + ((size_t)d * NZ + row) * 256 + cc) = pack4(k[0] * (1.f + (ad0 - 1.f) * kav.x), k[1] * (1.f + (ad1 - 1.f) * kav.y), k[2] * (1.f + (ad2 - 1.f) * kav.z), k[3] * (1.f + (ad3 - 1.f) * kav.w));
                        }
                    }
                });
        }
        base += NMT * 4;
    }
    {
        const bf16_t* A = (const bf16_t*)(ws + WS_MISC + MS_SG); const bf16_t* W = (const bf16_t*)(wsm + OFF_G2T + l * SZ_G2T); bf16_t* GG = (bf16_t*)(ws + WS_MISC + MS_GG);
        for (int u = (bid + G - base % G) % G; u < NMT * 2; u += G) {
            const int mt = u / 2, nt = u % 2, r0 = mt * 256, c0 = nt * 128;
            gemm_tile<4, 0>(c, 128, [&](int i) { return A + (size_t)(r0 + i) * 128; }, [&](int i) { return W + (size_t)(c0 + i) * 128; }, NoHook(),
                [&](f32x4 (&acc)[4][4], int wr, int wc, int fr, int fq) {
#pragma unroll
                    for (int n = 0; n < 4; ++n)
#pragma unroll
                        for (int m = 0; m < 4; ++m) { const f32x4 v = acc[m][n];
                            *(u32x2*)(GG + (size_t)(r0 + wr + m * 16 + fr) * 256 + c0 + wc + n * 16 + fq * 4) = pack4(v[0], v[1], v[2], v[3]); }
                });
        }
        base += NMT * 2;
    }
}

DI int krow(int s, int h, int j) { return 16 * s + 8 * (j >> 2) + 4 * h + (j & 3); }
#ifndef ATT_THR
#define ATT_THR 64.f
#endif
constexpr int ATT_PARK = 56 * 1024;
template <int MODE>
DI void attn_pass(const Ctx& c, int l, int b, int h, int q0, int nkeys) {
    constexpr int DROW = MODE == 0 ? 96 : 64;
    constexpr int DQ = MODE == 0 ? 96 : 32, KS = DQ / 16;
    constexpr int DOFF = MODE == 2 ? 32 : 0;
    constexpr int TK = 128;
    constexpr int KPITCH = DQ * 2 + 16;
    constexpr int VPITCH = TK * 2 + 16;
    constexpr int KBYTES = TK * KPITCH, VBYTES = 64 * VPITCH, STG = KBYTES + VBYTES;
    static_assert(MODE == 0 || 2 * STG <= ATT_PARK, "the staging buffers must stay below the parked o1");
    unsigned char* ws = c.ws; int tid_ = c.tid; asm volatile("" : "+v"(tid_));
    const int tid = tid_, lane = tid & 63, wave = __builtin_amdgcn_readfirstlane(tid >> 6), r = lane & 31, hh = lane >> 5;
    const bf16_t* Q = (const bf16_t*)(ws + WS_EXPW + (MODE == 0 ? MX_QM : MX_QD)) + (size_t)(b * 4 + h) * TZ * DROW + DOFF;
    const bf16_t* Kp = (const bf16_t*)(ws + WS_EXPW + (MODE == 0 ? MX_KM : MX_KD)) + (size_t)(b * 4 + h) * TZ * DROW + DOFF;
    const bf16_t* Vt = (const bf16_t*)(ws + WS_EXPW + (MODE == 0 ? MX_VMT : MX_VDT)) + (size_t)(b * 4 + h) * 64 * TZ;
    unsigned char* smem = c.smem;
    bf16x8 qf[KS];
    const int qrow = q0 + wave * 32 + r;
#pragma unroll
    for (int ks = 0; ks < KS; ++ks) qf[ks] = *(const bf16x8*)(Q + (size_t)qrow * DROW + ks * 16 + hh * 8);
    f32x16 oacc[2];
    float mref = 0.f, lrun = 0.f;
#pragma unroll
    for (int t = 0; t < 2; ++t)
#pragma unroll
        for (int i = 0; i < 16; ++i) oacc[t][i] = 0.f;
    constexpr int CPR = DQ / 8, KCH = TK * CPR, NKR = KCH / NTHR;
    static_assert(KCH % NTHR == 0, "whole staging rounds");
    u32x4 kreg[NKR], vreg[2];
    const bf16_t* kp[NKR]; int koff[NKR];
#pragma unroll
    for (int i = 0; i < NKR; ++i) { const int ch = tid + i * NTHR; kp[i] = Kp + ((long)(ch / CPR) - 64) * DROW + (ch % CPR) * 8; koff[i] = (ch / CPR) * KPITCH + (ch % CPR) * 16; }
    const bf16_t* vp = Vt + (size_t)(tid >> 4) * TZ + (tid & 15) * 8 - 64;
    const int voff = (tid >> 4) * VPITCH + (tid & 15) * 16;
    auto gloadK = [&]() {
#pragma unroll
        for (int i = 0; i < NKR; ++i) { kreg[i] = *(const u32x4*)kp[i]; kp[i] += TK * DROW; }
    };
    auto gloadV = [&]() { vreg[0] = *(const u32x4*)vp; vreg[1] = *(const u32x4*)(vp + (size_t)32 * TZ); vp += TK; };
    auto lstoreK = [&](int buf) {
        unsigned char* sk = smem + buf * STG;
#pragma unroll
        for (int i = 0; i < NKR; ++i) *(u32x4*)(sk + koff[i]) = kreg[i];
    };
    auto lstoreV = [&](int buf) { unsigned char* sv = smem + buf * STG + KBYTES; *(u32x4*)(sv + voff) = vreg[0]; *(u32x4*)(sv + voff + 32 * VPITCH) = vreg[1]; };
    const int kbase = r * KPITCH + hh * 16, vbase = KBYTES + r * VPITCH + hh * 8;
    auto ldfrag = [&](const unsigned char* kb, const unsigned char* vb, int ci) -> u32x4 {
        if (ci < 8) {
            const int kg = ci >> 2, s = (ci >> 1) & 1, t = ci & 1;
            const unsigned char* vrow = vb + t * 32 * VPITCH + (kg * 32 + 16 * s) * 2;
            const u32x2 lo = *(const u32x2*)vrow, hi2 = *(const u32x2*)(vrow + 16);
            u32x4 vv; vv.x = lo.x; vv.y = lo.y; vv.z = hi2.x; vv.w = hi2.y; return vv;
        }
        const int q = ci - 8, kg = q & 1, ks = q >> 1;
        return *(const u32x4*)(kb + kg * 32 * KPITCH + ks * 32);
    };
    constexpr int NM = 8 + 2 * KS;
    const f32x16 zero16 = {0.f, 0.f, 0.f, 0.f, 0.f, 0.f, 0.f, 0.f, 0.f, 0.f, 0.f, 0.f, 0.f, 0.f, 0.f, 0.f};
    auto pv_all = [&](const u32x4 (&P)[4], const unsigned char* vb) {
#pragma unroll
        for (int ci = 0; ci < 8; ++ci) { const u32x4 f = ldfrag(vb, vb, ci); oacc[ci & 1] = __builtin_amdgcn_mfma_f32_32x32x16_bf16(__builtin_bit_cast(bf16x8, f), __builtin_bit_cast(bf16x8, P[ci >> 1]), oacc[ci & 1], 0, 0, 0); }
    };
    auto iter = [&](f32x16 (&Sc)[2], f32x16 (&Sn)[2], u32x4 (&Pp)[4], u32x4 (&Pn)[4], const unsigned char* kb, const unsigned char* vb, bool first) {
        u32x4 fcur = ldfrag(kb, vb, 0), fnx1 = ldfrag(kb, vb, 1);
        if (__any(mref != 0.f)) {
#pragma unroll
            for (int kg = 0; kg < 2; ++kg)
#pragma unroll
                for (int i = 0; i < 16; ++i) Sc[kg][i] -= mref;
        }
        f32x2 ps = {0.f, 0.f};
        __builtin_amdgcn_sched_barrier(0);
#pragma unroll
        for (int ci = 0; ci < NM; ++ci) {
            u32x4 fnx2 = fnx1;
            if (ci + 2 < NM) fnx2 = ldfrag(kb, vb, ci + 2);
            if (ci < 8) oacc[ci & 1] = __builtin_amdgcn_mfma_f32_32x32x16_bf16(__builtin_bit_cast(bf16x8, fcur), __builtin_bit_cast(bf16x8, Pp[ci >> 1]), oacc[ci & 1], 0, 0, 0);
            else { const int q = ci - 8, kg = q & 1, ks = q >> 1; Sn[kg] = __builtin_amdgcn_mfma_f32_32x32x16_bf16(__builtin_bit_cast(bf16x8, fcur), qf[ks], ks == 0 ? zero16 : Sn[kg], 0, 0, 0); }
#pragma unroll
            for (int p = (ci * 16) / NM; p < ((ci + 1) * 16) / NM; ++p) {
                const int kg = p >> 3, q = p & 7;
                const float p0 = __builtin_amdgcn_exp2f(Sc[kg][2 * q]), p1 = __builtin_amdgcn_exp2f(Sc[kg][2 * q + 1]);
                ps += (f32x2){p0, p1};
                unsigned pk = pack2(p0, p1); asm volatile("" : "+v"(pk));
                Pn[kg * 2 + (q >> 2)][q & 3] = pk;
            }
            asm volatile("" : "+v"(ps));
            fcur = fnx1; fnx1 = fnx2;
            __builtin_amdgcn_sched_barrier(0);
        }
        const float pst = ps.x + ps.y;
        const bool bad = !(pst < 0x1p90f) || (first && pst < 0x1p-20f);
        if (__any(bad)) {
            float mx = Sc[0][0];
#pragma unroll
            for (int kg = 0; kg < 2; ++kg)
#pragma unroll
                for (int i = 0; i < 16; ++i) mx = fmaxf(mx, Sc[kg][i]);
            mx = fmaxf(mx, __shfl_xor(mx, 32, 64));
            const bool need = (mx > ATT_THR) || (first && mx < -32.f);
            const float d = need ? mx : 0.f;
            const float alpha = first ? 1.f : __builtin_amdgcn_exp2f(-d);
            mref += d; lrun *= alpha;
#pragma unroll
            for (int t = 0; t < 2; ++t)
#pragma unroll
                for (int i = 0; i < 16; ++i) oacc[t][i] *= alpha;
            ps = (f32x2){0.f, 0.f};
#pragma unroll
            for (int pq = 0; pq < 16; ++pq) {
                const int kg = pq >> 3, q = pq & 7;
                const float p0 = __builtin_amdgcn_exp2f(Sc[kg][2 * q] - d), p1 = __builtin_amdgcn_exp2f(Sc[kg][2 * q + 1] - d);
                ps += (f32x2){p0, p1};
                Pn[kg * 2 + (q >> 2)][q & 3] = pack2(p0, p1);
            }
        }
        lrun += ps.x + ps.y;
    };
    const int NT = nkeys / TK;
    f32x16 S0[2], S1[2]; u32x4 PA[4], PB[4];
#pragma unroll
    for (int q = 0; q < 4; ++q) PA[q] = (u32x4){0u, 0u, 0u, 0u};
    __syncthreads();
    gloadK();
    lstoreK(1);
    gloadK();
    if ((tid & 15) >= 8) gloadV(); else { vreg[0] = (u32x4){0u, 0u, 0u, 0u}; vreg[1] = vreg[0]; vp += TK; }
    __syncthreads();
    {
        const unsigned char* kb = smem + STG + 64 * KPITCH + kbase;
#pragma unroll
        for (int q = 0; q < 2 * KS; ++q) { const int kg = q & 1, ks = q >> 1; const u32x4 f = ldfrag(kb, kb, 8 + q); S0[kg] = __builtin_amdgcn_mfma_f32_32x32x16_bf16(__builtin_bit_cast(bf16x8, f), qf[ks], ks == 0 ? zero16 : S0[kg], 0, 0, 0); }
    }
    for (int s = 0; s < NT; ++s) {
        lstoreK(s & 1); lstoreV(s & 1);
        if (s + 1 < NT) gloadK();
        gloadV();
        __syncthreads();
        const unsigned char* sb = smem + (s & 1) * STG;
        iter(S0, S1, PA, PB, sb + kbase, sb + vbase, s == 0);
        iter(S1, S0, PB, PA, sb + 64 * KPITCH + kbase, sb + 128 + vbase, false);
    }
    lstoreV(NT & 1);
    __syncthreads();
    pv_all(PA, smem + (NT & 1) * STG + vbase);
    const float inv = 1.f / (lrun + __shfl_xor(lrun, 32, 64));
    bf16_t* Ycat = (bf16_t*)(ws + WS_BUFA);
    const int zrow = b * TZ + qrow;
    float* park = (float*)(smem + ATT_PARK) + tid;
    if (MODE == 0) {
#pragma unroll
        for (int t = 0; t < 2; ++t)
#pragma unroll
            for (int i4 = 0; i4 < 4; ++i4) {
                const int dv = t * 32 + 8 * i4 + 4 * hh;
                *(u32x2*)(Ycat + (size_t)zrow * D + h * 64 + dv) = pack4(oacc[t][4 * i4] * inv, oacc[t][4 * i4 + 1] * inv, oacc[t][4 * i4 + 2] * inv, oacc[t][4 * i4 + 3] * inv);
            }
    } else if (MODE == 1) {
#pragma unroll
        for (int t = 0; t < 2; ++t)
#pragma unroll
            for (int i = 0; i < 16; ++i) park[(t * 16 + i) * NTHR] = oacc[t][i] * inv;
    } else {
        const float lam = ((const float*)(ws + WS_WSM + OFF_LAM))[l];
        const float lam_init = 0.8f - 0.6f * __expf(-0.3f * (float)l);
        float ss = 0.f;
#pragma unroll
        for (int t = 0; t < 2; ++t)
#pragma unroll
            for (int i = 0; i < 16; ++i) { const float o = park[(t * 16 + i) * NTHR] - lam * oacc[t][i] * inv; oacc[t][i] = o; ss += o * o; }
        ss += __shfl_xor(ss, 32, 64);
        const float rs = rsqrtf(ss * (1.f / 64.f) + 1e-5f) * (1.f - lam_init);
        const float* sg = c.in[38] + l * 64;
        float4 gq[2][4];
#pragma unroll
        for (int t = 0; t < 2; ++t)
#pragma unroll
            for (int i4 = 0; i4 < 4; ++i4) gq[t][i4] = *(const float4*)(sg + t * 32 + 8 * i4 + 4 * hh);
#pragma unroll
        for (int t = 0; t < 2; ++t)
#pragma unroll
            for (int i4 = 0; i4 < 4; ++i4) {
                const int dv = t * 32 + 8 * i4 + 4 * hh; const float4 g = gq[t][i4];
                *(u32x2*)(Ycat + (size_t)zrow * D + 768 + h * 64 + dv) = pack4(oacc[t][4 * i4] * rs * g.x, oacc[t][4 * i4 + 1] * rs * g.y, oacc[t][4 * i4 + 2] * rs * g.z, oacc[t][4 * i4 + 3] * rs * g.w);
            }
    }
}
DI void phase_attention(const Ctx& c, int l) {
    const int nu = 512 + (l == 0 ? 16 : 0);
    for (int u = blockIdx.x; u < nu; u += gridDim.x) {
        int b, h, q0, nk; bool mla;
        if (u < 512) { const int k = u & 255, bh = k & 7; b = bh >> 2; h = bh & 3; q0 = CTX + (k >> 3) * 256; nk = TZ; mla = u < 256; }
        else { const int k = u - 512; b = (k >> 2) & 1; h = k & 3; q0 = 0; nk = CTX; mla = k < 8; }
        if (mla) attn_pass<0>(c, l, b, h, q0, nk);
        else { attn_pass<1>(c, l, b, h, q0, nk); attn_pass<2>(c, l, b, h, q0, nk); }
    }
}

DI int rw_tok(int dir, int i) { return dir == 0 ? i : (i < CTX ? CTX - 1 - i : TZ - 1 - (i - CTX)); }
constexpr int RW_TS = 32;
constexpr int RW_STEP_F = 6 * 64 + 2;
constexpr int RW_BUF_F = RW_TS * RW_STEP_F;
template <int CTRL> DI float dpp_add(float x) { return x + __int_as_float(__builtin_amdgcn_update_dpp(0, __float_as_int(x), CTRL, 0xf, 0xf, false)); }
DI float red16(float x) { x = dpp_add<0xB1>(x); x = dpp_add<0x4E>(x); x = dpp_add<0x141>(x); x = dpp_add<0x140>(x); return x; }
DI float red8(float x) { x = dpp_add<0xB1>(x); x = dpp_add<0x4E>(x); x = dpp_add<0x141>(x); return x; }
struct RwRegs { u32x4 r, v, kk, e, ad, kd; };
DI void rw_load(const Ctx& c, int b, int h, int dir, int chunk, int t, RwRegs& g) {
    const bf16_t* RB = (const bf16_t*)(c.ws + WS_EXPW + MX_RB); const bf16_t* VB = (const bf16_t*)(c.ws + WS_EXPW + MX_VB); const bf16_t* KKB = (const bf16_t*)(c.ws + WS_EXPW + MX_KKB);
    const bf16_t* SE = (const bf16_t*)(c.ws + WS_P + P_PR) + (size_t)dir * NZ * 256; const bf16_t* SAD = SE + (size_t)2 * NZ * 256; const bf16_t* SKD = SAD + (size_t)2 * NZ * 256;
    const int i = chunk * RW_TS + (t >> 3), z = b * TZ + rw_tok(dir, i); const size_t o = (size_t)z * 256 + h * 64 + (t & 7) * 8;
    g.r = *(const u32x4*)(RB + o); g.v = *(const u32x4*)(VB + o); g.kk = *(const u32x4*)(KKB + o);
    g.e = *(const u32x4*)(SE + o); g.ad = *(const u32x4*)(SAD + o); g.kd = *(const u32x4*)(SKD + o);
}
DI void up8(const u32x4& u, float (&f)[8]) { f[0] = lo2f(u.x); f[1] = hi2f(u.x); f[2] = lo2f(u.y); f[3] = hi2f(u.y); f[4] = lo2f(u.z); f[5] = hi2f(u.z); f[6] = lo2f(u.w); f[7] = hi2f(u.w); }
DI void rw_process(const RwRegs& g, int t, float* buf) {
    float r[8], v[8], kk[8], e[8], ad[8], kd[8];
    up8(g.r, r); up8(g.v, v); up8(g.kk, kk); up8(g.e, e); up8(g.ad, ad); up8(g.kd, kd);
    float* f = buf + (t >> 3) * RW_STEP_F + (t & 7) * 8;
    float w[8], bv[8], wr[8]; float br = 0.f, kr = 0.f;
#pragma unroll
    for (int j = 0; j < 8; ++j) { w[j] = __expf(-e[j]); bv[j] = kk[j] * ad[j]; wr[j] = w[j] * r[j]; br += bv[j] * r[j]; kr += kd[j] * r[j]; }
    *(float4*)(f) = make_float4(w[0], w[1], w[2], w[3]); *(float4*)(f + 4) = make_float4(w[4], w[5], w[6], w[7]);
    *(float4*)(f + 64) = make_float4(kk[0], kk[1], kk[2], kk[3]); *(float4*)(f + 68) = make_float4(kk[4], kk[5], kk[6], kk[7]);
    *(float4*)(f + 128) = make_float4(bv[0], bv[1], bv[2], bv[3]); *(float4*)(f + 132) = make_float4(bv[4], bv[5], bv[6], bv[7]);
    *(float4*)(f + 192) = make_float4(kd[0], kd[1], kd[2], kd[3]); *(float4*)(f + 196) = make_float4(kd[4], kd[5], kd[6], kd[7]);
    *(float4*)(f + 256) = make_float4(wr[0], wr[1], wr[2], wr[3]); *(float4*)(f + 260) = make_float4(wr[4], wr[5], wr[6], wr[7]);
    *(float4*)(f + 320) = make_float4(v[0], v[1], v[2], v[3]); *(float4*)(f + 324) = make_float4(v[4], v[5], v[6], v[7]);
    br = red8(br); kr = red8(kr);
    if ((t & 7) == 0) { float* s = buf + (t >> 3) * RW_STEP_F + 384; s[0] = br; s[1] = kr; }
}
struct RwStep { float4 w, kk, bv, kd, wr; float vv, br, kr; };
DI void rw_ld(RwStep& s, const float* f, int kq, int row) {
    s.w = *(const float4*)(f + kq * 4); s.kk = *(const float4*)(f + 64 + kq * 4); s.bv = *(const float4*)(f + 128 + kq * 4);
    s.kd = *(const float4*)(f + 192 + kq * 4); s.wr = *(const float4*)(f + 256 + kq * 4); s.vv = f[320 + row]; s.br = f[384]; s.kr = f[385];
}
DI void phase_rwkv_scan_unit(const Ctx& c, int l, int u) {
    const int rg = u & 3, chain = u >> 2, dir = chain & 1, h = (chain >> 1) & 3, b = chain >> 3;
    float* buf0 = (float*)c.smem; float* buf1 = buf0 + RW_BUF_F;
    float* ybuf = buf1 + RW_BUF_F;
    float* YO = (float*)(c.ws + WS_BUFB) + (size_t)dir * NZ * 256 + (size_t)b * TZ * 256 + h * 64 + rg * 16;
    const int wave = c.wave, lane = c.lane, rr = lane >> 4, kq = lane & 15, rl = (wave & 3) * 4 + rr, row = rg * 16 + rl;
    const int t = c.tid - 256;
    float S0 = 0.f, S1 = 0.f, S2 = 0.f, S3 = 0.f;
    constexpr int NCH = TZ / RW_TS;
    RwRegs g;
    __syncthreads();
    if (wave >= 4) { rw_load(c, b, h, dir, 0, t, g); rw_process(g, t, buf0); rw_load(c, b, h, dir, 1, t, g); }
    __syncthreads();
    for (int ch = 0; ch < NCH; ++ch) {
        float* cur = buf0 + (ch & 1) * RW_BUF_F; float* nxt = buf0 + ((ch + 1) & 1) * RW_BUF_F;
        if (wave >= 4) {
            if (ch > 0) {
                const float* yb = ybuf + ((ch - 1) & 1) * RW_TS * 16;
#pragma unroll
                for (int i = 0; i < 2; ++i) { const int e = t + i * 256, st = e >> 4, rw = e & 15; YO[(size_t)rw_tok(dir, (ch - 1) * RW_TS + st) * 256 + rw] = yb[e]; }
            }
            if (ch + 1 < NCH) rw_process(g, t, nxt);
            if (ch + 2 < NCH) rw_load(c, b, h, dir, ch + 2, t, g);
        } else {
            float* yb = ybuf + (ch & 1) * RW_TS * 16 + rl;
            RwStep s0, s1;
            rw_ld(s0, cur, kq, row);
#pragma unroll 4
            for (int st = 0; st < RW_TS; st += 2) {
                rw_ld(s1, cur + (st + 1) * RW_STEP_F, kq, row);
                {
                    float sa = -((S0 * s0.kk.x + S1 * s0.kk.y) + (S2 * s0.kk.z + S3 * s0.kk.w));
                    float q = (S0 * s0.wr.x + S1 * s0.wr.y) + (S2 * s0.wr.z + S3 * s0.wr.w);
                    sa = red16(sa); q = red16(q);
                    S0 = fmaf(sa, s0.bv.x, fmaf(S0, s0.w.x, s0.vv * s0.kd.x)); S1 = fmaf(sa, s0.bv.y, fmaf(S1, s0.w.y, s0.vv * s0.kd.y));
                    S2 = fmaf(sa, s0.bv.z, fmaf(S2, s0.w.z, s0.vv * s0.kd.z)); S3 = fmaf(sa, s0.bv.w, fmaf(S3, s0.w.w, s0.vv * s0.kd.w));
                    yb[st * 16] = q + sa * s0.br + s0.vv * s0.kr;
                }
                if (st + 2 < RW_TS) rw_ld(s0, cur + (st + 2) * RW_STEP_F, kq, row);
                {
                    float sa = -((S0 * s1.kk.x + S1 * s1.kk.y) + (S2 * s1.kk.z + S3 * s1.kk.w));
                    float q = (S0 * s1.wr.x + S1 * s1.wr.y) + (S2 * s1.wr.z + S3 * s1.wr.w);
                    sa = red16(sa); q = red16(q);
                    S0 = fmaf(sa, s1.bv.x, fmaf(S0, s1.w.x, s1.vv * s1.kd.x)); S1 = fmaf(sa, s1.bv.y, fmaf(S1, s1.w.y, s1.vv * s1.kd.y));
                    S2 = fmaf(sa, s1.bv.z, fmaf(S2, s1.w.z, s1.vv * s1.kd.z)); S3 = fmaf(sa, s1.bv.w, fmaf(S3, s1.w.w, s1.vv * s1.kd.w));
                    yb[(st + 1) * 16] = q + sa * s1.br + s1.vv * s1.kr;
                }
            }
        }
        __syncthreads();
    }
    if (wave >= 4) {
        const float* yb = ybuf + ((NCH - 1) & 1) * RW_TS * 16;
#pragma unroll
        for (int i = 0; i < 2; ++i) { const int e = t + i * 256, st = e >> 4, rw = e & 15; YO[(size_t)rw_tok(dir, (NCH - 1) * RW_TS + st) * 256 + rw] = yb[e]; }
    }
}

constexpr int LA_AN = 0, LA_RN = 8192, LA_BN = 16384, LA_KN = 24576, LA_AT = 32768, LA_BHT = 40960, LA_KHT = 49152, LA_VT = 57344,
              LA_NBA = 65536  , LA_NKA = 81920, LA_NBRT = 90112, LA_NKRT = 98304, LA_P63 = 106496;
constexpr int LA_TMT = LA_AN, LA_M1 = LA_BN, LA_W1T = LA_KN, LA_Z1 = LA_NBA;
DI int crow(int reg, int h) { return (reg & 3) + 8 * (reg >> 2) + 4 * h; }
DI void mm_tile(f32x16& acc, const unsigned char* A, int i0, const unsigned char* BT, int j0, int r, int h) {
#pragma unroll
    for (int ks = 0; ks < 4; ++ks) {
        const bf16x8 a = *(const bf16x8*)(A + (i0 + r) * 128 + ks * 32 + h * 16);
        const bf16x8 b = *(const bf16x8*)(BT + (j0 + r) * 128 + ks * 32 + h * 16);
        acc = __builtin_amdgcn_mfma_f32_32x32x16_bf16(a, b, acc, 0, 0, 0);
    }
}
DI void zero16(f32x16& a) {
#pragma unroll
    for (int i = 0; i < 16; ++i) a[i] = 0.f;
}
struct RwRaw { u32x4 r, v, kk, e, ad, kd; };
DI void rw_chunk_load(const Ctx& c, int unit, RwRaw& g) {
    unsigned char* ws = c.ws;
    const int chain = unit / RNC, ch = unit % RNC, dir = chain & 1, hd = (chain >> 1) & 3, b = chain >> 3, t = c.tid >> 3, k0 = (c.tid & 7) * 8;
    const bf16_t* RB = (const bf16_t*)(ws + WS_EXPW + MX_RB); const bf16_t* VB = (const bf16_t*)(ws + WS_EXPW + MX_VB); const bf16_t* KKB = (const bf16_t*)(ws + WS_EXPW + MX_KKB);
    const bf16_t* SE = (const bf16_t*)(ws + WS_P + P_PR) + (size_t)dir * NZ * 256; const bf16_t* SAD = SE + (size_t)2 * NZ * 256; const bf16_t* SKD = SAD + (size_t)2 * NZ * 256;
    const int z = b * TZ + rw_tok(dir, ch * RC + t); const size_t o = (size_t)z * 256 + hd * 64 + k0;
    g.r = *(const u32x4*)(RB + o); g.v = *(const u32x4*)(VB + o); g.kk = *(const u32x4*)(KKB + o);
    g.e = *(const u32x4*)(SE + o); g.ad = *(const u32x4*)(SAD + o); g.kd = *(const u32x4*)(SKD + o);
}
DI void phase_rwkv_chunk_unit(const Ctx& c, int l, int unit, RwRaw& graw, int next_unit) {
    unsigned char* L = c.smem; unsigned char* ws = c.ws;
    const int chain = unit / RNC, ch = unit % RNC, dir = chain & 1, hd = (chain >> 1) & 3, b = chain >> 3;
    const int tid = c.tid, lane = c.lane, wave = c.wave, r = lane & 31, h = lane >> 5;
    const bf16_t* RB = (const bf16_t*)(ws + WS_EXPW + MX_RB); const bf16_t* VB = (const bf16_t*)(ws + WS_EXPW + MX_VB); const bf16_t* KKB = (const bf16_t*)(ws + WS_EXPW + MX_KKB);
    const bf16_t* SE = (const bf16_t*)(ws + WS_P + P_PR) + (size_t)dir * NZ * 256; const bf16_t* SAD = SE + (size_t)2 * NZ * 256; const bf16_t* SKD = SAD + (size_t)2 * NZ * 256;
    float* CUM = (float*)(L + LA_NBA);
    __syncthreads();
    const int t = tid >> 3, k0 = (tid & 7) * 8;
    float rr[8], vv[8], kk[8], ee[8], ad[8], kd[8];
    {
        up8(graw.r, rr); up8(graw.v, vv); up8(graw.kk, kk); up8(graw.e, ee); up8(graw.ad, ad); up8(graw.kd, kd);
        *(float4*)(CUM + t * 64 + k0) = make_float4(ee[0], ee[1], ee[2], ee[3]); *(float4*)(CUM + t * 64 + k0 + 4) = make_float4(ee[4], ee[5], ee[6], ee[7]);
    }
    __syncthreads();
    if (wave == 0) { float cm = 0.f;
#pragma unroll 8
        for (int i = 0; i < RC; ++i) { cm += CUM[i * 64 + lane]; CUM[i * 64 + lane] = cm; } }
    __syncthreads();
    {
        float cm[8], c63[8];
        { const float4 a = *(const float4*)(CUM + t * 64 + k0), bq = *(const float4*)(CUM + t * 64 + k0 + 4); cm[0] = a.x; cm[1] = a.y; cm[2] = a.z; cm[3] = a.w; cm[4] = bq.x; cm[5] = bq.y; cm[6] = bq.z; cm[7] = bq.w; }
        { const float4 a = *(const float4*)(CUM + 63 * 64 + k0), bq = *(const float4*)(CUM + 63 * 64 + k0 + 4); c63[0] = a.x; c63[1] = a.y; c63[2] = a.z; c63[3] = a.w; c63[4] = bq.x; c63[5] = bq.y; c63[6] = bq.z; c63[7] = bq.w; }
        float at[8], rt[8], bt[8], kt[8], bh[8], kh[8];
#pragma unroll
        for (int j = 0; j < 8; ++j) {
            const float pt = __expf(-cm[j]), pp = __expf(-(cm[j] - ee[j])), ip = __expf(cm[j]), ph = __expf(-(c63[j] - cm[j])), bb = kk[j] * ad[j];
            at[j] = -kk[j] * pp; rt[j] = rr[j] * pt; bt[j] = bb * ip; kt[j] = kd[j] * ip; bh[j] = bb * ph; kh[j] = kd[j] * ph;
        }
        u32x4 w4;
        w4.x = pack2(at[0], at[1]); w4.y = pack2(at[2], at[3]); w4.z = pack2(at[4], at[5]); w4.w = pack2(at[6], at[7]); *(u32x4*)(L + LA_AN + t * 128 + k0 * 2) = w4;
        w4.x = pack2(rt[0], rt[1]); w4.y = pack2(rt[2], rt[3]); w4.z = pack2(rt[4], rt[5]); w4.w = pack2(rt[6], rt[7]); *(u32x4*)(L + LA_RN + t * 128 + k0 * 2) = w4;
        w4.x = pack2(bt[0], bt[1]); w4.y = pack2(bt[2], bt[3]); w4.z = pack2(bt[4], bt[5]); w4.w = pack2(bt[6], bt[7]); *(u32x4*)(L + LA_BN + t * 128 + k0 * 2) = w4;
        w4.x = pack2(kt[0], kt[1]); w4.y = pack2(kt[2], kt[3]); w4.z = pack2(kt[4], kt[5]); w4.w = pack2(kt[6], kt[7]); *(u32x4*)(L + LA_KN + t * 128 + k0 * 2) = w4;
#pragma unroll
        for (int j = 0; j < 8; ++j) {
            *(bf16_t*)(L + LA_AT + (k0 + j) * 128 + t * 2) = f2bf(at[j]); *(bf16_t*)(L + LA_BHT + (k0 + j) * 128 + t * 2) = f2bf(bh[j]);
            *(bf16_t*)(L + LA_KHT + (k0 + j) * 128 + t * 2) = f2bf(kh[j]); *(bf16_t*)(L + LA_VT + (k0 + j) * 128 + t * 2) = f2bf(vv[j]);
        }
        if (t == 63) {
            float* p63 = (float*)(L + LA_P63); float* gp = (float*)(ws + WS_RW + RW_P63) + (size_t)unit * 64;
#pragma unroll
            for (int j = 0; j < 8; ++j) { const float p = __expf(-c63[j]); p63[k0 + j] = p; gp[k0 + j] = p; }
        }
    }
    __syncthreads();
    {
        const int p = wave >> 1, i0 = (wave & 1) * 32;
        const unsigned char* A = L + (p == 0 ? LA_BN : p == 1 ? LA_KN : LA_RN);
        const unsigned char* BT = L + (p < 2 ? LA_AN : p == 2 ? LA_BN : LA_KN);
#pragma unroll
        for (int jt = 0; jt < 2; ++jt) {
            const int j0 = jt * 32; f32x16 acc; zero16(acc);
            mm_tile(acc, A, i0, BT, j0, r, h);
            const int col = j0 + r;
#pragma unroll
            for (int g = 0; g < 16; ++g) {
                const int row = i0 + crow(g, h);
                if (p == 0) ((float*)(L + LA_NBA))[row * 64 + col] = (row < col) ? acc[g] : 0.f;
                else if (p == 1) *(bf16_t*)(L + LA_NKA + row * 128 + col * 2) = f2bf((row < col) ? acc[g] : 0.f);
                else *(bf16_t*)(L + (p == 2 ? LA_NBRT : LA_NKRT) + row * 128 + col * 2) = f2bf((col <= row) ? acc[g] : 0.f);
            }
        }
    }
    __syncthreads();
    {
        constexpr int X0 = LA_BN, X1 = LA_KN, X3 = 108544, X4 = X3 + 8192, X5 = LA_NBA + 16384 - 16384, X6 = LA_NBA + 8192;
        float nv[8];
        { const int s = tid >> 3, t0 = (tid & 7) * 8; const float* N = (const float*)(L + LA_NBA) + s * 64 + t0;
          const float4 a = *(const float4*)N, bq = *(const float4*)(N + 4); nv[0] = a.x; nv[1] = a.y; nv[2] = a.z; nv[3] = a.w; nv[4] = bq.x; nv[5] = bq.y; nv[6] = bq.z; nv[7] = bq.w; }
        __syncthreads();
        {
            const int s = tid >> 3, t0 = (tid & 7) * 8;
            u32x4 w4; w4.x = pack2(nv[0], nv[1]); w4.y = pack2(nv[2], nv[3]); w4.z = pack2(nv[4], nv[5]); w4.w = pack2(nv[6], nv[7]);
            *(u32x4*)(L + X0 + s * 128 + t0 * 2) = w4;
#pragma unroll
            for (int j = 0; j < 8; ++j) *(bf16_t*)(L + X1 + (t0 + j) * 128 + s * 2) = f2bf(nv[j]);
#pragma unroll
            for (int j = 0; j < 8; ++j) if (t0 + j == s) nv[j] += 1.f;
            w4.x = pack2(nv[0], nv[1]); w4.y = pack2(nv[2], nv[3]); w4.z = pack2(nv[4], nv[5]); w4.w = pack2(nv[6], nv[7]);
            *(u32x4*)(L + X5 + s * 128 + t0 * 2) = w4;
        }
        __syncthreads();
        const int ti0 = ((wave >> 1) & 1) * 32, tj0 = (wave & 1) * 32;
        if (wave < 4) {
            f32x16 acc; zero16(acc); mm_tile(acc, L + X0, ti0, L + X1, tj0, r, h);
#pragma unroll
            for (int g4 = 0; g4 < 4; ++g4) *(u32x2*)(L + X4 + (tj0 + r) * 128 + (ti0 + 8 * g4 + 4 * h) * 2) = pack4(acc[4 * g4], acc[4 * g4 + 1], acc[4 * g4 + 2], acc[4 * g4 + 3]);
#pragma unroll
            for (int g = 0; g < 16; ++g) *(bf16_t*)(L + X3 + (ti0 + crow(g, h)) * 128 + (tj0 + r) * 2) = f2bf(acc[g]);
        }
        __syncthreads();
#pragma unroll
        for (int k = 1; k <= 5; ++k) {
            const int qa = (k & 1) ? X3 : X0, qt = (k & 1) ? X4 : X1, nqa = (k & 1) ? X0 : X3, nqt = (k & 1) ? X1 : X4;
            const int pa = (k & 1) ? X5 : X6, npa = (k & 1) ? X6 : X5;
            if (wave >= 4) {
                f32x16 acc; zero16(acc); mm_tile(acc, L + pa, ti0, L + qt, tj0, r, h);
#pragma unroll
                for (int g = 0; g < 16; ++g) acc[g] += bf2f(*(const bf16_t*)(L + pa + (ti0 + crow(g, h)) * 128 + (tj0 + r) * 2));
                if (k < 5) {
#pragma unroll
                    for (int g = 0; g < 16; ++g) *(bf16_t*)(L + npa + (ti0 + crow(g, h)) * 128 + (tj0 + r) * 2) = f2bf(acc[g]);
                } else {
#pragma unroll
                    for (int g4 = 0; g4 < 4; ++g4) *(u32x2*)(L + LA_TMT + (tj0 + r) * 128 + (ti0 + 8 * g4 + 4 * h) * 2) = pack4(acc[4 * g4], acc[4 * g4 + 1], acc[4 * g4 + 2], acc[4 * g4 + 3]);
                }
            } else if (k < 5) {
                f32x16 acc; zero16(acc); mm_tile(acc, L + qa, ti0, L + qt, tj0, r, h);
#pragma unroll
                for (int g4 = 0; g4 < 4; ++g4) *(u32x2*)(L + nqt + (tj0 + r) * 128 + (ti0 + 8 * g4 + 4 * h) * 2) = pack4(acc[4 * g4], acc[4 * g4 + 1], acc[4 * g4 + 2], acc[4 * g4 + 3]);
#pragma unroll
                for (int g = 0; g < 16; ++g) *(bf16_t*)(L + nqa + (ti0 + crow(g, h)) * 128 + (tj0 + r) * 2) = f2bf(acc[g]);
            }
            __syncthreads();
        }
    }
    {
        const int p = wave >> 2, i0 = ((wave >> 1) & 1) * 32, j0 = (wave & 1) * 32; f32x16 acc; zero16(acc);
        if (p == 0) {
            mm_tile(acc, L + LA_TMT, i0, L + LA_AT, j0, r, h);
#pragma unroll
            for (int g4 = 0; g4 < 4; ++g4) *(u32x2*)(L + LA_M1 + (j0 + r) * 128 + (i0 + 8 * g4 + 4 * h) * 2) = pack4(acc[4 * g4], acc[4 * g4 + 1], acc[4 * g4 + 2], acc[4 * g4 + 3]);
        } else {
            mm_tile(acc, L + LA_NKA, i0, L + LA_TMT, j0, r, h);
#pragma unroll
            for (int g4 = 0; g4 < 4; ++g4) *(u32x2*)(L + LA_W1T + (j0 + r) * 128 + (i0 + 8 * g4 + 4 * h) * 2) = pack4(acc[4 * g4], acc[4 * g4 + 1], acc[4 * g4 + 2], acc[4 * g4 + 3]);
        }
    }
    __syncthreads();
    if (wave < 4) {
        const int i0 = (wave >> 1) * 32, j0 = (wave & 1) * 32; f32x16 acc; zero16(acc);
        mm_tile(acc, L + LA_W1T, i0, L + LA_VT, j0, r, h);
#pragma unroll
        for (int g4 = 0; g4 < 4; ++g4) *(u32x2*)(L + LA_Z1 + (j0 + r) * 128 + (i0 + 8 * g4 + 4 * h) * 2) = pack4(acc[4 * g4], acc[4 * g4 + 1], acc[4 * g4 + 2], acc[4 * g4 + 3]);
    }
    __syncthreads();
    if (next_unit >= 0) rw_chunk_load(c, next_unit, graw);
    {
        const int p = wave >> 1, i0 = (wave & 1) * 32;
        bf16_t* GM3 = (bf16_t*)(ws + WS_RW + RW_M3) + (size_t)unit * 4096; bf16_t* GM2 = (bf16_t*)(ws + WS_RW + RW_M2) + (size_t)unit * 4096; bf16_t* GZ5 = (bf16_t*)(ws + WS_RW + RW_Z5) + (size_t)unit * 4096;
        float* YO = (float*)(ws + WS_BUFB) + (size_t)dir * NZ * 256;
#pragma unroll
        for (int jt = 0; jt < 2; ++jt) {
            const int j0 = jt * 32; f32x16 acc; zero16(acc);
            if (p == 0) {
                mm_tile(acc, L + LA_M1, i0, L + LA_NBRT, j0, r, h);
#pragma unroll
                for (int g4 = 0; g4 < 4; ++g4) { const int tt = j0 + r, kq = i0 + 8 * g4 + 4 * h; float rv[4]; unpack4(*(const u32x2*)(L + LA_RN + tt * 128 + kq * 2), rv);
                    *(u32x2*)(GM2 + tt * 64 + kq) = pack4(acc[4 * g4] + rv[0], acc[4 * g4 + 1] + rv[1], acc[4 * g4 + 2] + rv[2], acc[4 * g4 + 3] + rv[3]); }
            } else if (p == 1) {
                mm_tile(acc, L + LA_NBRT, i0, L + LA_Z1, j0, r, h); mm_tile(acc, L + LA_NKRT, i0, L + LA_VT, j0, r, h);
#pragma unroll
                for (int g = 0; g < 16; ++g) { const int tt = i0 + crow(g, h); YO[(size_t)(b * TZ + rw_tok(dir, ch * RC + tt)) * 256 + hd * 64 + j0 + r] = acc[g]; }
            } else if (p == 2) {
                mm_tile(acc, L + LA_M1, i0, L + LA_BHT, j0, r, h);
#pragma unroll
                for (int g4 = 0; g4 < 4; ++g4) *(u32x2*)(GM3 + (j0 + r) * 64 + i0 + 8 * g4 + 4 * h) = pack4(acc[4 * g4], acc[4 * g4 + 1], acc[4 * g4 + 2], acc[4 * g4 + 3]);
            } else {
                mm_tile(acc, L + LA_BHT, i0, L + LA_Z1, j0, r, h); mm_tile(acc, L + LA_KHT, i0, L + LA_VT, j0, r, h);
#pragma unroll
                for (int g4 = 0; g4 < 4; ++g4) *(u32x2*)(GZ5 + (j0 + r) * 64 + i0 + 8 * g4 + 4 * h) = pack4(acc[4 * g4], acc[4 * g4 + 1], acc[4 * g4 + 2], acc[4 * g4 + 3]);
            }
        }
    }
}
DI void phase_rwkv_chunks(const Ctx& c, int l) {
    RwRaw g; int u = blockIdx.x;
    if (u < 16 * RNC) rw_chunk_load(c, u, g);
    for (; u < 16 * RNC; u += gridDim.x) phase_rwkv_chunk_unit(c, l, u, g, u + (int)gridDim.x < 16 * RNC ? u + (int)gridDim.x : -1);
}
DI bf16x8 pack8(const f32x16& x, int s) {
    u32x4 p; p.x = pack2(x[8 * s], x[8 * s + 1]); p.y = pack2(x[8 * s + 2], x[8 * s + 3]); p.z = pack2(x[8 * s + 4], x[8 * s + 5]); p.w = pack2(x[8 * s + 6], x[8 * s + 7]);
    return __builtin_bit_cast(bf16x8, p);
}
DI bf16x8 ldfrag(const bf16_t* rowp, int s, int h) {
    const u32x2 lo = *(const u32x2*)(rowp + 16 * s + 4 * h), hi = *(const u32x2*)(rowp + 16 * s + 8 + 4 * h);
    u32x4 v; v.x = lo.x; v.y = lo.y; v.z = hi.x; v.w = hi.y; return __builtin_bit_cast(bf16x8, v);
}
constexpr int SQ_PITCH = 144, SQ_MAT = 64 * SQ_PITCH;
constexpr int SQA_M3 = 0, SQA_Z5 = SQ_MAT, SQA_P63 = 2 * SQ_MAT, SQA_BYTES = SQA_P63 + 256;
constexpr int SQB_M2 = 0, SQB_Y = SQ_MAT, SQB_BYTES = SQB_Y + 64 * 64 * 4;
constexpr int SQ_NST = 3;
constexpr int SQ_A0 = 0, SQ_B0 = SQ_NST * SQA_BYTES, SQ_XB = SQ_B0 + SQ_NST * SQB_BYTES, SQ_END = SQ_XB + 4 * 4096;
DI bf16x8 ldfrag_l(const unsigned char* rowp, int s, int h) {
    const u32x2 lo = *(const u32x2*)(rowp + (16 * s + 4 * h) * 2), hi = *(const u32x2*)(rowp + (16 * s + 8 + 4 * h) * 2);
    u32x4 v; v.x = lo.x; v.y = lo.y; v.z = hi.x; v.w = hi.y; return __builtin_bit_cast(bf16x8, v);
}
struct SqRegsA { u32x4 m3[2], z5[2], p63; };
struct SqRegsB { u32x4 m2[2], y[4]; };
DI void sqa_gload(const Ctx& c, size_t unit, int lt, SqRegsA& g) {
    const unsigned char* g3 = c.ws + WS_RW + RW_M3 + unit * 8192; const unsigned char* g5 = c.ws + WS_RW + RW_Z5 + unit * 8192;
#pragma unroll
    for (int i = 0; i < 2; ++i) { const int id = lt + i * 256; g.m3[i] = *(const u32x4*)(g3 + id * 16); g.z5[i] = *(const u32x4*)(g5 + id * 16); }
    if (lt < 16) g.p63 = *(const u32x4*)(c.ws + WS_RW + RW_P63 + unit * 256 + lt * 16);
}
DI void sqa_lstore(unsigned char* st, int lt, const SqRegsA& g) {
#pragma unroll
    for (int i = 0; i < 2; ++i) { const int id = lt + i * 256, row = id >> 3, part = id & 7;
        *(u32x4*)(st + SQA_M3 + row * SQ_PITCH + part * 16) = g.m3[i]; *(u32x4*)(st + SQA_Z5 + row * SQ_PITCH + part * 16) = g.z5[i]; }
    if (lt < 16) *(u32x4*)(st + SQA_P63 + lt * 16) = g.p63;
}
DI void sqb_gload(const Ctx& c, size_t unit, const float* YO, int dir, int ch, int lt, SqRegsB& g) {
    const unsigned char* g2 = c.ws + WS_RW + RW_M2 + unit * 8192;
#pragma unroll
    for (int i = 0; i < 2; ++i) g.m2[i] = *(const u32x4*)(g2 + (lt + i * 256) * 16);
#pragma unroll
    for (int i = 0; i < 4; ++i) { const int id = lt + i * 256; g.y[i] = *(const u32x4*)(YO + (size_t)rw_tok(dir, ch * RC + (id >> 4)) * 256 + (id & 15) * 4); }
}
DI void sqb_lstore(unsigned char* st, int lt, const SqRegsB& g) {
#pragma unroll
    for (int i = 0; i < 2; ++i) { const int id = lt + i * 256; *(u32x4*)(st + SQB_M2 + (id >> 3) * SQ_PITCH + (id & 7) * 16) = g.m2[i]; }
#pragma unroll
    for (int i = 0; i < 4; ++i) { const int id = lt + i * 256; *(u32x4*)(st + SQB_Y + (id >> 4) * 256 + (id & 15) * 16) = g.y[i]; }
}
DI void sqb_store_y(float* YO, int dir, int ch, const unsigned char* st, int lt, int vhb) {
#pragma unroll
    for (int i = 0; i < 2; ++i) { const int id = lt + i * 256; *(u32x4*)(YO + (size_t)rw_tok(dir, ch * RC + (id >> 3)) * 256 + vhb * 32 + (id & 7) * 4) = *(const u32x4*)(st + SQB_Y + id * 16); }
}
DI void phase_rwkv_seq_block(const Ctx& c, int l, int chain, int vhb) {
    unsigned char* L = c.smem; const int lane = c.lane, wave = c.wave, r = lane & 31, h = lane >> 5;
    const int dir = chain & 1, hd = (chain >> 1) & 3, b = chain >> 3, lt = c.tid - 256, vh = vhb; const bool act = (wave & 1) == 0;
    const size_t unit0 = (size_t)chain * RNC;
    __syncthreads();
    if (wave >= 4) {
        float* YO = (float*)(c.ws + WS_BUFB) + (size_t)dir * NZ * 256 + (size_t)b * TZ * 256 + hd * 64;
        const int lt2 = lt & 255;
        int moff[3], mdst[3];
#pragma unroll
        for (int i = 0; i < 3; ++i) { const int id = i < 2 ? lt2 + 256 * i : 512 + lane; const int row = id / 9, ck = id - row * 9; moff[i] = row * 128 + (ck == 8 ? 7 : ck) * 16; mdst[i] = id * 16; }
        int zoff[2], zdst[2];
#pragma unroll
        for (int i = 0; i < 2; ++i) { const int id = i == 0 ? lt2 : 256 + lane; int row = id / 9; const int ck = id - row * 9; zdst[i] = (vhb * 32 * 9 + id) * 16; row += vhb * 32; if (row > 63) row = 63; zoff[i] = row * 128 + (ck == 8 ? 7 : ck) * 16; }
        const unsigned char* gM3 = c.ws + WS_RW + RW_M3; const unsigned char* gZ5 = c.ws + WS_RW + RW_Z5; const unsigned char* gM2 = c.ws + WS_RW + RW_M2; const unsigned char* gP = c.ws + WS_RW + RW_P63;
        auto dmaA = [&](int ch, int stg) {
            const size_t unit = unit0 + (ch < RNC ? ch : RNC - 1); unsigned char* st = L + SQ_A0 + stg * SQA_BYTES;
#pragma unroll
            for (int i = 0; i < 3; ++i) __builtin_amdgcn_global_load_lds((const unsigned*)(gM3 + unit * 8192 + moff[i]), (unsigned*)(st + SQA_M3 + mdst[i]), 16, 0, 0);
            __builtin_amdgcn_global_load_lds((const unsigned*)(gZ5 + unit * 8192 + zoff[0]), (unsigned*)(st + SQA_Z5 + zdst[0]), 16, 0, 0);
            if (lane < 32) __builtin_amdgcn_global_load_lds((const unsigned*)(gZ5 + unit * 8192 + zoff[1]), (unsigned*)(st + SQA_Z5 + zdst[1]), 16, 0, 0);
            if (lane < 16) __builtin_amdgcn_global_load_lds((const unsigned*)(gP + unit * 256 + lane * 16), (unsigned*)(st + SQA_P63 + lane * 16), 16, 0, 0);
        };
        auto dmaB = [&](int ch, int stg) {
            const int cc = ch < RNC ? ch : RNC - 1; const size_t unit = unit0 + cc; unsigned char* st = L + SQ_B0 + stg * SQB_BYTES;
#pragma unroll
            for (int i = 0; i < 3; ++i) __builtin_amdgcn_global_load_lds((const unsigned*)(gM2 + unit * 8192 + moff[i]), (unsigned*)(st + SQB_M2 + mdst[i]), 16, 0, 0);
#pragma unroll
            for (int i = 0; i < 2; ++i) { const int id = lt2 + i * 256; __builtin_amdgcn_global_load_lds((const unsigned*)(YO + (size_t)rw_tok(dir, cc * RC + (id >> 3)) * 256 + vhb * 32 + (id & 7) * 4), (unsigned*)(st + SQB_Y + id * 16), 16, 0, 0); }
        };
        dmaA(0, 0); dmaA(1, 1); dmaB(0, 0);
        asm volatile("s_waitcnt vmcnt(0)" ::: "memory");
        __builtin_amdgcn_s_barrier();
        int sa2 = 2, sb1 = 1;
#pragma unroll 1
        for (int ch = 0; ch <= RNC; ++ch) {
            if (ch >= 2) sqb_store_y(YO, dir, ch - 2, L + SQ_B0 + sb1 * SQB_BYTES, lt2, vhb);
            asm volatile("" ::: "memory");
            dmaA(ch + 2, sa2); dmaB(ch + 1, sb1);
            asm volatile("s_waitcnt vmcnt(11)" ::: "memory");
            __builtin_amdgcn_s_barrier();
            asm volatile("" ::: "memory");
            sa2 = sa2 == 2 ? 0 : sa2 + 1; sb1 = sb1 == 2 ? 0 : sb1 + 1;
        }
        sqb_store_y(YO, dir, RNC - 1, L + SQ_B0 + ((RNC - 1) % 3) * SQB_BYTES, lt2, vhb);
    } else if (wave < 2) {
        f32x16 x[2]; zero16(x[0]); zero16(x[1]);
        __syncthreads();
#pragma unroll 1
        for (int ch = 0; ch <= RNC; ++ch) {
            if (ch < RNC && act) {
                const unsigned char* st = L + SQ_A0 + (ch % 3) * SQA_BYTES;
                unsigned char* xbuf = L + SQ_XB + ((ch & 1) * 2 + vh) * 4096 + lane * 16;
                bf16x8 xb[4];
#pragma unroll
                for (int s = 0; s < 4; ++s) { xb[s] = pack8(x[s >> 1], s & 1); *(bf16x8*)(xbuf + s * 1024) = xb[s]; }
                f32x16 xn0, xn1;
#pragma unroll
                for (int i = 0; i < 2; ++i) {
                    f32x16 xa;
#pragma unroll
                    for (int g4 = 0; g4 < 4; ++g4) {
                        float z5[4]; unpack4(*(const u32x2*)(st + SQA_Z5 + (vh * 32 + r) * SQ_PITCH + (32 * i + 8 * g4 + 4 * h) * 2), z5);
                        const float4 p4 = *(const float4*)(st + SQA_P63 + (32 * i + 8 * g4 + 4 * h) * 4);
                        xa[4 * g4] = fmaf(p4.x, x[i][4 * g4], z5[0]); xa[4 * g4 + 1] = fmaf(p4.y, x[i][4 * g4 + 1], z5[1]);
                        xa[4 * g4 + 2] = fmaf(p4.z, x[i][4 * g4 + 2], z5[2]); xa[4 * g4 + 3] = fmaf(p4.w, x[i][4 * g4 + 3], z5[3]);
                    }
#pragma unroll
                    for (int s = 0; s < 4; ++s) xa = __builtin_amdgcn_mfma_f32_32x32x16_bf16(ldfrag_l(st + SQA_M3 + (32 * i + r) * SQ_PITCH, s, h), xb[s], xa, 0, 0, 0);
                    if (i == 0) xn0 = xa; else xn1 = xa;
                }
                x[0] = xn0; x[1] = xn1;
            }
            __syncthreads();
        }
    } else {
        __syncthreads();
#pragma unroll 1
        for (int ch = 0; ch <= RNC; ++ch) {
            if (ch >= 1 && act) {
                const int cy = ch - 1;
                unsigned char* st = L + SQ_B0 + (cy % 3) * SQB_BYTES;
                const unsigned char* xbuf = L + SQ_XB + ((cy & 1) * 2 + vh) * 4096 + lane * 16;
                bf16x8 xb[4];
#pragma unroll
                for (int s = 0; s < 4; ++s) xb[s] = *(const bf16x8*)(xbuf + s * 1024);
#pragma unroll
                for (int i = 0; i < 2; ++i) {
                    f32x16 ya;
#pragma unroll
                    for (int g = 0; g < 16; ++g) ya[g] = *((const float*)(st + SQB_Y) + (32 * i + crow(g, h)) * 32 + r);
#pragma unroll
                    for (int s = 0; s < 4; ++s) ya = __builtin_amdgcn_mfma_f32_32x32x16_bf16(ldfrag_l(st + SQB_M2 + (32 * i + r) * SQ_PITCH, s, h), xb[s], ya, 0, 0, 0);
#pragma unroll
                    for (int g = 0; g < 16; ++g) *((float*)(st + SQB_Y) + (32 * i + crow(g, h)) * 32 + r) = ya[g];
                }
            }
            __syncthreads();
        }
    }
}
DI void phase_mixers2(const Ctx& c, int l) {
    const int G = gridDim.x, bid = blockIdx.x;
    if (G >= 128) {
        if (bid < 32) phase_rwkv_seq_block(c, l, bid >> 1, bid & 1);
        else for (int u = bid - 32; u < 2 * S5N * 4; u += G - 32) phase_s5_final_unit<false>(c, l, u);
    } else {
        for (int u = bid; u < 32; u += G) phase_rwkv_seq_block(c, l, u >> 1, u & 1);
        for (int u = bid; u < 2 * S5N * 4; u += G) phase_s5_final_unit<false>(c, l, u);
    }
}

DI void phase_post(const Ctx& c, int l) {
    unsigned char* ws = c.ws; const int lane = c.lane;
    const float* YF = (const float*)(ws + WS_BUFB); const float* YB = YF + (size_t)NZ * 256;
    const bf16_t* RB = (const bf16_t*)(ws + WS_EXPW + MX_RB); const bf16_t* VB = (const bf16_t*)(ws + WS_EXPW + MX_VB);
    const bf16_t* SKD = (const bf16_t*)(ws + WS_P + P_PR) + (size_t)4 * NZ * 256; const bf16_t* GG = (const bf16_t*)(ws + WS_MISC + MS_GG);
    bf16_t* Ycat = (bf16_t*)(ws + WS_BUFA);
    const float* r_k = c.in[21] + l * 256; const float* lg = c.in[22] + l * 256; const float* lb = c.in[23] + l * 256;
    for (int z = blockIdx.x * 8 + c.wave; z < NZ; z += gridDim.x * 8) {
        const size_t o = (size_t)z * 256 + lane * 4;
        const float4 yf = *(const float4*)(YF + o), yb = *(const float4*)(YB + o);
        const float y0 = yf.x + yb.x, y1 = yf.y + yb.y, y2 = yf.z + yb.z, y3 = yf.w + yb.w;
        const float mean = sum16(y0 + y1 + y2 + y3) * (1.f / 64.f);
        const float d0 = y0 - mean, d1 = y1 - mean, d2 = y2 - mean, d3 = y3 - mean;
        const float var = sum16(d0 * d0 + d1 * d1 + d2 * d2 + d3 * d3) * (1.f / 64.f);
        const float rs = rsqrtf(var + 64e-5f);
        float r[4], v[4], k0[4], k1[4], gg[4];
        unpack4(*(const u32x2*)(RB + o), r); unpack4(*(const u32x2*)(VB + o), v); unpack4(*(const u32x2*)(SKD + o), k0); unpack4(*(const u32x2*)(SKD + (size_t)NZ * 256 + o), k1);
        unpack4(*(const u32x2*)(GG + o), gg);
        const float4 rk = *(const float4*)(r_k + lane * 4), g4 = *(const float4*)(lg + lane * 4), b4 = *(const float4*)(lb + lane * 4);
        const float bs = sum16(r[0] * (k0[0] + k1[0]) * rk.x + r[1] * (k0[1] + k1[1]) * rk.y + r[2] * (k0[2] + k1[2]) * rk.z + r[3] * (k0[3] + k1[3]) * rk.w);
        *(u32x2*)(Ycat + (size_t)z * D + 256 + lane * 4) = pack4((d0 * rs * g4.x + b4.x + bs * v[0]) * gg[0], (d1 * rs * g4.y + b4.y + bs * v[1]) * gg[1],
                                                                (d2 * rs * g4.z + b4.z + bs * v[2]) * gg[2], (d3 * rs * g4.w + b4.w + bs * v[3]) * gg[3]);
    }
    {
        const bf16_t* ZG = (const bf16_t*)(ws + WS_MISC + MS_ZG); const bf16_t* W = (const bf16_t*)(ws + WS_WSM + OFF_GLUT + l * SZ_GLUT);
        const float* gb = c.in[33] + l * 256;
        for (int u = blockIdx.x; u < (NZ / 256) * 2; u += gridDim.x) {
            const int mt = u / 2, nt = u % 2, r0 = mt * 256, c0 = nt * 128;
            gemm_tile<4, 0>(c, 256, [&](int i) { return ZG + (size_t)(r0 + i) * 256; }, [&](int i) { return W + (size_t)(c0 + i) * 256; }, NoHook(),
                [&](f32x4 (&acc)[4][4], int wr, int wc, int fr, int fq) {
                    u32x2 zq[4][4]; float4 bq[4];
#pragma unroll
                    for (int n = 0; n < 4; ++n) {
                        const int col = c0 + wc + n * 16 + fq * 4; bq[n] = *(const float4*)(gb + col);
#pragma unroll
                        for (int m = 0; m < 4; ++m) zq[m][n] = *(const u32x2*)(ZG + (size_t)(r0 + wr + m * 16 + fr) * 256 + col);
                    }
#pragma unroll
                    for (int n = 0; n < 4; ++n) {
                        const int col = c0 + wc + n * 16 + fq * 4; const float4 bb = bq[n];
#pragma unroll
                        for (int m = 0; m < 4; ++m) {
                            const int row = r0 + wr + m * 16 + fr; const f32x4 v = acc[m][n];
                            float zg[4]; unpack4(zq[m][n], zg);
                            *(u32x2*)(Ycat + (size_t)row * D + 512 + col) = pack4(zg[0] * sigmoidf_(v[0] + bb.x), zg[1] * sigmoidf_(v[1] + bb.y), zg[2] * sigmoidf_(v[2] + bb.z), zg[3] * sigmoidf_(v[3] + bb.w));
                        }
                    }
                });
        }
    }
}

DI bool skip_mt(int l, int mt) { return l == NL - 1 && (mt % 33) == 0; }
DI bool merge_split(int l) { return l == 0 && NL > 1 && gridDim.x == 256; }
DI void phase_merge1(const Ctx& c, int l, int part) {
    const bf16_t* Ycat = (const bf16_t*)(c.ws + WS_BUFA); const bf16_t* W = (const bf16_t*)(c.ws + WS_WSM + OFF_WBT + l * SZ_WBT);
    const bf16_t* GT = (const bf16_t*)(c.ws + WS_GT); bf16_t* MG = (bf16_t*)(c.ws + WS_BUFB);
    if (part == 0 && blockIdx.x == 0 && c.tid < 32) ((unsigned*)(c.ws + WS_CTL))[CW_CNT + l * 32 + c.tid] = 0u;
    const bool split = merge_split(l);
    const int u_lo = part == 0 ? (int)blockIdx.x : 512 + (int)blockIdx.x, u_hi = part == 0 ? (split ? 512 : (NZ / 256) * 8) : (NZ / 256) * 8;
    for (int u = u_lo; u < u_hi; u += gridDim.x) {
        const int mt = u / 8, nt = u % 8, r0 = mt * 256, c0 = nt * 128;
        if (skip_mt(l, mt)) continue;
        f32x4 macc[4][4];
#pragma unroll
        for (int m = 0; m < 4; ++m)
#pragma unroll
            for (int n = 0; n < 4; ++n) macc[m][n] = (f32x4){0.f, 0.f, 0.f, 0.f};
        gemm_tile<4, 256>(c, 1024, [&](int i) { return Ycat + (size_t)(r0 + i) * D; }, [&](int i) { return W + (size_t)(c0 + i) * D; },
            [&](f32x4 (&acc)[4][4], int seg, int wr, int wc, int fr, int fq) {
#pragma unroll
                for (int m = 0; m < 4; ++m)
#pragma unroll
                    for (int n = 0; n < 4; ++n) {
                        float g[4]; unpack4(*(const u32x2*)(GT + (size_t)(r0 + wr + m * 16 + fr) * 4096 + seg * 1024 + c0 + wc + n * 16 + fq * 4), g);
                        macc[m][n][0] += g[0] * acc[m][n][0]; macc[m][n][1] += g[1] * acc[m][n][1]; macc[m][n][2] += g[2] * acc[m][n][2]; macc[m][n][3] += g[3] * acc[m][n][3];
                        acc[m][n] = (f32x4){0.f, 0.f, 0.f, 0.f};
                    }
            },
            [&](f32x4 (&)[4][4], int wr, int wc, int fr, int fq) {
#pragma unroll
                for (int m = 0; m < 4; ++m)
#pragma unroll
                    for (int n = 0; n < 4; ++n)
                        *(u32x2*)(MG + (size_t)(r0 + wr + m * 16 + fr) * D + c0 + wc + n * 16 + fq * 4) = pack4(macc[m][n][0], macc[m][n][1], macc[m][n][2], macc[m][n][3]);
            });
    }
}
struct EpiMerge2 {
    static constexpr bool PERM = false, AFTER_DRAIN = false;
    float* H; const float* modv; int l;
    DI void operator()(const pg8::f32x4 (&acc)[2][2][4][2], const pg8::Unit& u, int wr, int wc, int fr, int fq) const {
        if (skip_mt(l, u.pm)) return;
        const int sel = (u.pm % 33) == 0 ? 2 : u.pm / 33;
        const int row0 = u.pm * 256 + wr * 64 + fr, col0 = u.pn * 256 + wc * 32 + 4 * fq;
#pragma unroll
        for (int bj = 0; bj < 2; ++bj)
#pragma unroll
            for (int n = 0; n < 2; ++n) {
                const int col = col0 + bj * 128 + n * 16; const float4 m2 = *(const float4*)(modv + ((size_t)l * 3 + sel) * 6144 + 2 * 1024 + col);
#pragma unroll
                for (int ai = 0; ai < 2; ++ai)
#pragma unroll
                    for (int m = 0; m < 4; ++m) {
                        float4* hp = (float4*)(H + (size_t)(row0 + ai * 128 + m * 16) * D + col); float4 hv = *hp; const pg8::f32x4 v = acc[ai][bj][m][n];
                        hv.x += m2.x * v[0]; hv.y += m2.y * v[1]; hv.z += m2.z * v[2]; hv.w += m2.w * v[3]; *hp = hv;
                    }
            }
    }
};
struct LatOrder {
    int G, c;
    DI bool next(int i, pg8::Unit& u) const { const int L = i * G + c; if (L >= 256) return false; const int pl = L >> 2; u.pm = (pl >> 5) * 33 + 1 + (pl & 31); u.pn = L & 3; return true; }
    DI void a_ready(const pg8::Unit&) const {}
    DI void done(const pg8::Unit&) const {}
};
struct SplitOrder {
    int mode, c;
    DI bool next(int i, pg8::Unit& u) const {
        if (i > 0) return false;
        int L; if (mode == 1) { if (c < 16) return false; L = c - 16; } else { if (c >= 24) return false; L = 240 + c; }
        u.pm = L >> 2; u.pn = L & 3; return true;
    }
    DI void a_ready(const pg8::Unit&) const {}
    DI void done(const pg8::Unit&) const {}
};
DI void phase_merge2(const Ctx& c, int l, int mode) {
    EpiMerge2 E; E.H = (float*)(c.ws + WS_H); E.modv = (const float*)(c.ws + WS_WSM + OFF_MODV); E.l = l;
    pg8::Gemm g{(const bf16_t*)(c.ws + WS_BUFB), (const bf16_t*)(c.ws + WS_WSM + OFF_WOUTT + l * SZ_WOUTT), NZ, 1024, 1024, 1024, 1024};
    __syncthreads();
    if (mode != 0) {
        SplitOrder S; S.mode = mode; S.c = (int)blockIdx.x;
        pg8::gemm_phase<EpiMerge2, SplitOrder, false>((PG8_LAS unsigned char*)c.smem, g, S, E, nullptr, c.tid);
    } else if (l == NL - 1) {
        LatOrder S; S.G = (int)gridDim.x; S.c = (int)blockIdx.x;
        pg8::gemm_phase<EpiMerge2, LatOrder, false>((PG8_LAS unsigned char*)c.smem, g, S, E, nullptr, c.tid);
    } else {
        pg8::StaticOrder S; S.init(NZ, 1024, (int)gridDim.x, (int)blockIdx.x, MERGE2_WGM);
        pg8::gemm_phase<EpiMerge2, pg8::StaticOrder, false>((PG8_LAS unsigned char*)c.smem, g, S, E, nullptr, c.tid);
    }
}

constexpr int RT_PITCH = 68;
constexpr int RT_RED_W = 8 * 4 * RT_PITCH;
DI void phase_norm2_route(const Ctx& c, int l) {
    unsigned char* ws = c.ws; const int lane = c.lane, wave = c.wave, tid = c.tid;
    const float* modv = (const float*)(ws + WS_WSM + OFF_MODV); const float* H = (const float*)(ws + WS_H);
    bf16_t* XN = (bf16_t*)(ws + WS_BUFA); const float* g2 = c.in[7] + l * 1024;
    const float* rwt = (const float*)(ws + WS_WSM + OFF_RWT) + (size_t)l * 36 * 1024;
    const float* bg = c.in[42] + l * 4; const float* be = c.in[44] + l * 32;
    unsigned* cnt = (unsigned*)(ws + WS_CTL) + CW_CNT + l * 32;
    int* list = (int*)(ws + WS_GT + GT_LIST); float* lw = (float*)(ws + WS_GT + GT_LW);
    float* red = (float*)c.smem + wave * RT_RED_W;
    float* lgs = (float*)c.smem + 8 * RT_RED_W + wave * 8 * 40;
    int* hist = (int*)((float*)c.smem + 8 * RT_RED_W + 8 * 8 * 40);
    int* sel = hist + 64;
    float* selw = (float*)(sel + 128);
    const int ngroups = (l == NL - 1) ? (NB * SEQ / 64) : (NZ / 64);
    for (int grp = blockIdx.x; grp < ngroups; grp += gridDim.x) {
        __syncthreads();
        if (tid < 32) hist[tid] = 0;
        __syncthreads();
        float x[8][16];
#pragma unroll
        for (int i = 0; i < 8; ++i) {
            const int rl = wave * 8 + i; int row;
            if (l == NL - 1) { const int rr = grp * 64 + rl; row = (rr / SEQ) * TZ + CTX + (rr % SEQ); } else row = grp * 64 + rl;
#pragma unroll
            for (int q = 0; q < 4; ++q) { const float4 v = *(const float4*)(H + (size_t)row * D + q * 256 + lane * 4); x[i][q * 4] = v.x; x[i][q * 4 + 1] = v.y; x[i][q * 4 + 2] = v.z; x[i][q * 4 + 3] = v.w; }
        }
        float4 gq4[4], m3q[4], m4q[4];
        {
            int row0; if (l == NL - 1) { const int rr = grp * 64; row0 = (rr / SEQ) * TZ + CTX + (rr % SEQ); } else row0 = grp * 64;
            const int b0 = row0 / TZ, s0 = row0 % TZ, sel0 = s0 < CTX ? 2 : b0;
#pragma unroll
            for (int q = 0; q < 4; ++q) { const int col = q * 256 + lane * 4; gq4[q] = *(const float4*)(g2 + col);
                m3q[q] = *(const float4*)(modv + ((size_t)l * 3 + sel0) * 6144 + 3 * 1024 + col); m4q[q] = *(const float4*)(modv + ((size_t)l * 3 + sel0) * 6144 + 4 * 1024 + col); }
        }
#pragma unroll
        for (int i = 0; i < 8; ++i) {
            const int rl = wave * 8 + i; int row;
            if (l == NL - 1) { const int rr = grp * 64 + rl; row = (rr / SEQ) * TZ + CTX + (rr % SEQ); } else row = grp * 64 + rl;
            float ss = 0.f;
#pragma unroll
            for (int j = 0; j < 16; ++j) ss += x[i][j] * x[i][j];
            ss = wave_sum(ss);
            const float rs = rsqrtf(ss * (1.f / 1024.f) + 1e-6f);
#pragma unroll
            for (int q = 0; q < 4; ++q) {
                const int col = q * 256 + lane * 4;
                const float4 g = gq4[q], m3 = m3q[q], m4 = m4q[q];
                x[i][q * 4] = x[i][q * 4] * rs * g.x * (1.f + m4.x) + m3.x; x[i][q * 4 + 1] = x[i][q * 4 + 1] * rs * g.y * (1.f + m4.y) + m3.y;
                x[i][q * 4 + 2] = x[i][q * 4 + 2] * rs * g.z * (1.f + m4.z) + m3.z; x[i][q * 4 + 3] = x[i][q * 4 + 3] * rs * g.w * (1.f + m4.w) + m3.w;
                *(u32x2*)(XN + (size_t)row * D + col) = pack4(x[i][q * 4], x[i][q * 4 + 1], x[i][q * 4 + 2], x[i][q * 4 + 3]);
            }
        }
#pragma unroll 1
        for (int ec = 0; ec < 9; ++ec) {
#pragma unroll
            for (int ee = 0; ee < 4; ++ee) {
                const int e = ec * 4 + ee;
                float4 w[4];
#pragma unroll
                for (int q = 0; q < 4; ++q) w[q] = *(const float4*)(rwt + (size_t)e * 1024 + q * 256 + lane * 4);
#pragma unroll
                for (int i = 0; i < 8; ++i) {
                    float a = 0.f;
#pragma unroll
                    for (int q = 0; q < 4; ++q) a += x[i][q * 4] * w[q].x + x[i][q * 4 + 1] * w[q].y + x[i][q * 4 + 2] * w[q].z + x[i][q * 4 + 3] * w[q].w;
                    red[(i * 4 + ee) * RT_PITCH + lane] = a;
                }
            }
            __builtin_amdgcn_wave_barrier();
            if (lane < 32) {
                float s0 = 0.f, s1 = 0.f, s2 = 0.f, s3 = 0.f;
#pragma unroll
                for (int q = 0; q < 16; ++q) { const float4 v = *(const float4*)(red + lane * RT_PITCH + q * 4); s0 += v.x; s1 += v.y; s2 += v.z; s3 += v.w; }
                const int e = ec * 4 + (lane & 3);
                lgs[(lane >> 2) * 40 + e] = (s0 + s1) + (s2 + s3) + (e < 4 ? bg[e] : be[e - 4]);
            }
            __builtin_amdgcn_wave_barrier();
        }
        if (lane < 8) {
            const float* lg = lgs + lane * 40;
            float gm = lg[0]; int gsel = 0;
#pragma unroll
            for (int g = 1; g < 4; ++g) if (lg[g] > gm) { gm = lg[g]; gsel = g; }
            const float gs = __expf(lg[0] - gm) + __expf(lg[1] - gm) + __expf(lg[2] - gm) + __expf(lg[3] - gm);
            const float pg = 1.f / gs;
            float l1 = -1e30f, l2 = -1e30f; int e1 = 0, e2 = 0;
#pragma unroll
            for (int j = 0; j < 8; ++j) {
                const float v = lg[4 + gsel * 8 + j]; const int e = gsel * 8 + j;
                if (v > l1) { l2 = l1; e2 = e1; l1 = v; e1 = e; } else if (v > l2) { l2 = v; e2 = e; }
            }
            const float tt = __expf(l2 - l1), w1 = pg / (1.f + tt), w2 = pg * tt / (1.f + tt);
            const int rl = wave * 8 + lane;
            const int r1 = atomicAdd(&hist[e1], 1), r2 = atomicAdd(&hist[e2], 1);
            sel[rl * 2] = e1 | (r1 << 8); sel[rl * 2 + 1] = e2 | (r2 << 8); selw[rl * 2] = w1; selw[rl * 2 + 1] = w2;
        }
        __syncthreads();
        if (tid < 32) hist[32 + tid] = (int)atomicAdd(&cnt[tid], (unsigned)hist[tid]);
        __syncthreads();
        if (tid < 128) {
            const int rl = tid >> 1, j = tid & 1, sv = sel[tid], e = sv & 255, rk = sv >> 8;
            int row;
            if (l == NL - 1) { const int rr = grp * 64 + rl; row = (rr / SEQ) * TZ + CTX + (rr % SEQ); } else row = grp * 64 + rl;
            const size_t pos = (size_t)e * MOE_CAP + hist[32 + e] + rk;
            list[pos] = row * 2 + j; lw[pos] = selw[tid];
        }
    }
    phase_expert_convert(c, l);
}

DI void moe_prefix(const Ctx& c, int l, int* tiles  , int* cnts  ) {
    __syncthreads();
    if (c.tid == 0) {
        const unsigned* cnt = (const unsigned*)(c.ws + WS_CTL) + CW_CNT + l * 32; int acc = 0;
        for (int e = 0; e < 32; ++e) { const int n = (int)__hip_atomic_load(cnt + e, __ATOMIC_RELAXED, __HIP_MEMORY_SCOPE_AGENT); cnts[e] = n; tiles[e] = acc; acc += (n + 127) / 128; }
        tiles[32] = acc;
    }
    __syncthreads();
}
DI void phase_moe1(const Ctx& c, int l) {
    unsigned char* ws = c.ws;
    int* tiles = (int*)(c.smem + 120 * 1024); int* cnts = tiles + 40;
    moe_prefix(c, l, tiles, cnts);
    const bf16_t* XN = (const bf16_t*)(ws + WS_BUFA); bf16_t* HM = (bf16_t*)(ws + WS_GT + GT_HM); const int* list = (const int*)(ws + WS_GT + GT_LIST);
    const int nt_total = tiles[32];
    for (int u = blockIdx.x; u < nt_total * 4; u += gridDim.x) {
        const int mtg = u >> 2, nt = u & 3;
        int e = 0;
        for (int k = 1; k < 32; ++k) if (tiles[k] <= mtg) e = k;
        const int mt = mtg - tiles[e], n_e = cnts[e];
        const int* le = list + (size_t)e * MOE_CAP;
        const bf16_t* W = (const bf16_t*)(ws + WS_EXPW + (size_t)e * SZ_WGU);
        gemm_tile<2, 0>(c, 1024,
            [&](int i) { int p = mt * 128 + i; if (p >= n_e) p = n_e - 1; return XN + (size_t)(le[p] >> 1) * D; },
            [&](int i) { return W + (size_t)(nt * 256 + i) * D; }, NoHook(),
            [&](f32x4 (&acc)[4][4], int wr, int wc, int fr, int fq) {
#pragma unroll
                for (int np = 0; np < 2; ++np) {
                    const int hc = (nt * 256 + wc + np * 32) / 2 + fq * 4;
#pragma unroll
                    for (int m = 0; m < 4; ++m) {
                        const int p = mt * 128 + wr + m * 16 + fr;
                        const f32x4 g = acc[m][np * 2], uu = acc[m][np * 2 + 1];
                        *(u32x2*)(HM + ((size_t)mtg * 128 + wr + m * 16 + fr) * 512 + hc) = pack4(siluf_(g[0]) * uu[0], siluf_(g[1]) * uu[1], siluf_(g[2]) * uu[2], siluf_(g[3]) * uu[3]);
                        (void)p;
                    }
                }
            });
    }
}
DI void phase_moe2(const Ctx& c, int l) {
    unsigned char* ws = c.ws;
    int* tiles = (int*)(c.smem + 120 * 1024); int* cnts = tiles + 40;
    moe_prefix(c, l, tiles, cnts);
    const bf16_t* HM = (const bf16_t*)(ws + WS_GT + GT_HM); const int* list = (const int*)(ws + WS_GT + GT_LIST); const float* lw = (const float*)(ws + WS_GT + GT_LW);
    bf16_t* Y2 = (bf16_t*)(ws + WS_P);
    const int nt_total = tiles[32];
    for (int u = blockIdx.x; u < nt_total * 4; u += gridDim.x) {
        const int mtg = u >> 2, nt = u & 3;
        int e = 0;
        for (int k = 1; k < 32; ++k) if (tiles[k] <= mtg) e = k;
        const int mt = mtg - tiles[e], n_e = cnts[e];
        const int* le = list + (size_t)e * MOE_CAP; const float* lwe = lw + (size_t)e * MOE_CAP;
        const bf16_t* W = (const bf16_t*)(ws + WS_EXPW + 32 * SZ_WGU + (size_t)e * SZ_WD);
        gemm_tile<2, 0>(c, 512,
            [&](int i) { return HM + ((size_t)mtg * 128 + i) * 512; },
            [&](int i) { return W + (size_t)(nt * 256 + i) * 512; }, NoHook(),
            [&](f32x4 (&acc)[4][4], int wr, int wc, int fr, int fq) {
                int ent4[4]; float wt4[4];
#pragma unroll
                for (int m = 0; m < 4; ++m) { const int p = mt * 128 + wr + m * 16 + fr; const int pc = p < n_e ? p : n_e - 1; ent4[m] = le[pc]; wt4[m] = lwe[pc]; }
#pragma unroll
                for (int m = 0; m < 4; ++m) {
                    const int p = mt * 128 + wr + m * 16 + fr;
                    if (p < n_e) {
                        const int ent = ent4[m]; const float wt = wt4[m];
                        bf16_t* yrow = Y2 + ((size_t)(ent & 1) * NZ + (ent >> 1)) * D + nt * 256 + wc + fq * 4;
#pragma unroll
                        for (int n = 0; n < 4; ++n) *(u32x2*)(yrow + n * 16) = pack4(wt * acc[m][n][0], wt * acc[m][n][1], wt * acc[m][n][2], wt * acc[m][n][3]);
                    }
                }
            });
    }
}

constexpr int LDS_BYTES = 150 * 1024 + 256;
static_assert(SQ_END <= LDS_BYTES - 256, "RWKV sequential stages must fit the LDS allocation");
constexpr int STEPS_PER_LAYER = 12, N_STEPS = 2 + NL * STEPS_PER_LAYER;
#ifndef FUSED
#define FUSED 1
#endif

DI const void* launder_ptr(const void* p) {
    const unsigned long long v = (unsigned long long)p;
    unsigned lo = __builtin_amdgcn_readfirstlane((unsigned)v), hi = __builtin_amdgcn_readfirstlane((unsigned)(v >> 32));
    asm volatile("" : "+s"(lo), "+s"(hi) :: "memory");
    return (const void*)(((unsigned long long)hi << 32) | lo);
}
template <int KIND> DI void run_step(const Ctx& c0, int l) {
#ifdef PHM
    if (!((PHM >> KIND) & 1)) return;
#endif
    Ctx c = c0;
    { int z = 0; asm volatile("" : "+s"(z) :: "memory"); c.in = c0.in + z; c.ws = c0.ws + z; c.out = c0.out + z; }
    { int t = c0.tid; asm volatile("" : "+v"(t)); c.tid = t; c.lane = t & 63; c.wave = __builtin_amdgcn_readfirstlane(t >> 6); }
    if (KIND == 0) phase_prologue(c);
    if (KIND == 1) phase_norm1(c, l);
    if (KIND == 2) phase_inproj(c, l);
    if (KIND == 3) { phase_prep(c, l); for (int u = blockIdx.x; u < 2 * S5N * 4; u += gridDim.x) phase_s5_final_unit<true>(c, l, u); }
    if (KIND == 4) { phase_small_gemms(c, l); phase_s5_carry(c, l); }
    if (KIND == 5) { phase_attention(c, l); phase_rwkv_chunks(c, l); }
    if (KIND == 6) phase_mixers2(c, l);
    if (KIND == 7) phase_post(c, l);
    if (KIND == 8) phase_merge1(c, l, 0);
    if (KIND == 9) { if (!merge_split(l)) phase_merge2(c, l, 0); else if (blockIdx.x < 16) phase_merge1(c, l, 1); else phase_merge2(c, l, 1); }
    if (KIND == 14) { if (merge_split(l)) phase_merge2(c, l, 2); }
    if (KIND == 10) phase_norm2_route(c, l);
    if (KIND == 11) phase_moe1(c, l);
    if (KIND == 12) phase_moe2(c, l);
    if (KIND == 13) phase_final(c);
}

#if !FUSED
template <int KIND> __global__ void __launch_bounds__(NTHR, 2) k_step(Args a) {
    extern __shared__ __attribute__((aligned(16))) unsigned char lds[];
    Ctx c; c.in = a.in; c.out = a.out; c.ws = a.ws; c.smem = lds; c.tid = threadIdx.x; c.lane = threadIdx.x & 63; c.wave = __builtin_amdgcn_readfirstlane(threadIdx.x >> 6);
    run_step<KIND>(c, a.s_lo);
}
template <int KIND> static void launch_step(const Args& a, int grid, hipStream_t stream) {
    static bool attr = false;
    if (!attr) { (void)hipFuncSetAttribute((const void*)k_step<KIND>, hipFuncAttributeMaxDynamicSharedMemorySize, LDS_BYTES); attr = true; }
    hipLaunchKernelGGL(k_step<KIND>, dim3(grid), dim3(NTHR), LDS_BYTES, stream, a);
}
#else
__global__ void __launch_bounds__(NTHR, 2) fwd_kernel(Args a) {
    extern __shared__ __attribute__((aligned(16))) unsigned char lds[];
    Ctx c; c.in = a.in; c.out = a.out; c.ws = a.ws; c.smem = lds; c.tid = threadIdx.x; c.lane = threadIdx.x & 63; c.wave = __builtin_amdgcn_readfirstlane(threadIdx.x >> 6);
    volatile LAS unsigned* xbw = (volatile LAS unsigned*)(lds + LDS_BYTES - 16);
    for (int i = threadIdx.x; i < LDS_BYTES / 16; i += NTHR) ((uint4*)lds)[i] = make_uint4(0u, 0u, 0u, 0u);
    __syncthreads();
    if (threadIdx.x == 0) { xbw[0] = 0u; xbw[1] = 0u; }
    __syncthreads();
    XcdBarrier bar = xcd_barrier_post((unsigned*)(a.ws + WS_CTL) + CW_BAR, xbw);
#ifndef REP_MASK
#define REP_MASK 0
#endif
#define GBAR() do { XcdBarrier bb = bar; int zz = 0; asm volatile("" : "+s"(zz) :: "memory"); bb.bar = bar.bar + zz; xcd_barrier(bb); } while (0)
#define STEP(K, L) do { run_step<K>(c, L); GBAR(); if ((REP_MASK >> K) & 1) { run_step<K>(c, L); GBAR(); } } while (0)
    STEP(0, 0);
    for (int l = 0; l < NL; ++l) {
        STEP(1, l); STEP(2, l); STEP(3, l); STEP(4, l); STEP(5, l); STEP(6, l); STEP(7, l); STEP(8, l); STEP(9, l); if (l == 0 && NL > 1) STEP(14, l); STEP(10, l); STEP(11, l); STEP(12, l);
    }
#undef STEP
    run_step<13>(c, 0);
}
#endif

extern "C" void kernel_launch(void* const* d_in, const int* in_sizes, int n_in, void* d_out, int out_size, void* d_ws, size_t ws_size, hipStream_t stream) {
    static int grid = 0;
    if (grid == 0) {
        if (n_in != 49 || out_size != NB * SEQ * D || ws_size < WS_END) { fprintf(stderr, "kernel_launch: unexpected problem (n_in %d out %d ws %zu need %zu)\n", n_in, out_size, ws_size, (size_t)WS_END); grid = -1; return; }
        int dev = 0, cus = 0;
        if (hipGetDevice(&dev) != hipSuccess || hipDeviceGetAttribute(&cus, hipDeviceAttributeMultiprocessorCount, dev) != hipSuccess) { grid = -1; return; }
#if FUSED
        int per_cu = 0;
        if (hipFuncSetAttribute((const void*)fwd_kernel, hipFuncAttributeMaxDynamicSharedMemorySize, LDS_BYTES) != hipSuccess) { fprintf(stderr, "kernel_launch: hipFuncSetAttribute failed\n"); grid = -1; return; }
        if (hipOccupancyMaxActiveBlocksPerMultiprocessor(&per_cu, (const void*)fwd_kernel, NTHR, LDS_BYTES) != hipSuccess || per_cu < 1) { fprintf(stderr, "kernel_launch: occupancy query says %d\n", per_cu); }
        (void)hipGetLastError();
#endif
        grid = cus;
    }
    if (grid < 0) return;
    (void)hipMemsetAsync((char*)d_ws + WS_CTL, 0, CTL_BYTES, stream);
    Args a{};
    for (int i = 0; i < 49; ++i) a.in[i] = (const float*)d_in[i];
    a.out = (float*)d_out; a.ws = (unsigned char*)d_ws;
#if !FUSED
    a.s_lo = 0; a.s_hi = 0; launch_step<0>(a, grid, stream);
    for (int l = 0; l < NL; ++l) {
        a.s_lo = l;
        launch_step<1>(a, grid, stream); launch_step<2>(a, grid, stream); launch_step<3>(a, grid, stream); launch_step<4>(a, grid, stream);
        launch_step<5>(a, grid, stream); launch_step<6>(a, grid, stream); launch_step<7>(a, grid, stream); launch_step<8>(a, grid, stream);
        launch_step<9>(a, grid, stream); if (l == 0 && NL > 1) launch_step<14>(a, grid, stream); launch_step<10>(a, grid, stream); launch_step<11>(a, grid, stream); launch_step<12>(a, grid, stream);
    }
    a.s_lo = 0; launch_step<13>(a, grid, stream);
#else
    a.s_lo = 0; a.s_hi = N_STEPS; hipLaunchKernelGGL(fwd_kernel, dim3(grid), dim3(NTHR), LDS_BYTES, stream, a);
#endif
}
```
